# Optimizing an MI355X kernel written in HIP

```python
import jax, jax.numpy as jnp
from jax import lax
import numpy as np

D_MODEL = 2048
BATCH = 4
SEQ = 8192
DEPTH = 1

CHUNK = 64
LEFT_CHUNKS = 8
ATT_HEADS = 16
ATT_HEAD_DIM = 64
ATT_WIDTH = ATT_HEADS * ATT_HEAD_DIM
MAX_PAST_DIST = 256
REL_TABLE = MAX_PAST_DIST + CHUNK
RWKV_HEADS = 16
RWKV_HEAD_DIM = 64
RWKV_WIDTH = RWKV_HEADS * RWKV_HEAD_DIM
DECAY_LORA = 96
ICLR_LORA = 96
GATE_LORA = 256
SHIFT_WIDTH = 3 * RWKV_WIDTH + DECAY_LORA + ICLR_LORA + GATE_LORA
D_IN = 3 * ATT_WIDTH + SHIFT_WIDTH + 2 * D_MODEL
N_EXPERTS = 32
TOP_K = 4
D_EXPERT = D_MODEL
SWIGLU_LIMIT = 7.0
SWIGLU_ALPHA = 1.702
MOE_BLOCK = 256
LN_EPS = 1e-5
GN_EPS = 64e-5
DEEPNORM_ALPHA = (2 * DEPTH) ** 0.25
DEEPNORM_BETA = (8 * DEPTH) ** -0.25

kernel_name = 'hybrid_chunkattn_rwkv7_moe_deepnorm'


def _layer_norm(x, w, b):
    xf = x.astype(jnp.float32)
    mu = jnp.mean(xf, axis=-1, keepdims=True)
    var = jnp.mean(jnp.square(xf - mu), axis=-1, keepdims=True)
    return ((xf - mu) * lax.rsqrt(var + LN_EPS) * w + b).astype(x.dtype)


def _chunk_attention(q, k, v, rel_bias):
    B, S, H, Dh = q.shape
    n_chunks = S // CHUNK
    pad = LEFT_CHUNKS * CHUNK
    band = pad + CHUNK
    kp = jnp.pad(k, ((0, 0), (pad, 0), (0, 0), (0, 0)))
    vp = jnp.pad(v, ((0, 0), (pad, 0), (0, 0), (0, 0)))
    qi = jnp.arange(CHUNK)[:, None]
    kj = jnp.arange(band)[None, :]
    dist = qi + pad - kj
    idx = jnp.minimum(dist, MAX_PAST_DIST) + (CHUNK - 1)
    bias = rel_bias.astype(jnp.float32)[:, idx]
    scale = Dh ** -0.5
    key_slot = jnp.arange(band)

    def one_chunk(c):
        start = c * CHUNK
        qc = lax.dynamic_slice_in_dim(q, start, CHUNK, axis=1)
        kc = lax.dynamic_slice_in_dim(kp, start, band, axis=1)
        vc = lax.dynamic_slice_in_dim(vp, start, band, axis=1)
        s = jnp.einsum('bqhd,bkhd->bhqk', qc, kc).astype(jnp.float32) * scale + bias
        valid = key_slot + start >= pad
        s = jnp.where(valid, s, jnp.finfo(jnp.float32).min)
        p = jax.nn.softmax(s, axis=-1)
        return jnp.einsum('bhqk,bkhd->bqhd', p.astype(vc.dtype), vc)

    out = lax.map(one_chunk, jnp.arange(n_chunks))
    return jnp.moveaxis(out, 0, 1).reshape(B, S, H * Dh)


def _rwkv7_scan(r, decay, k, v, a, b):
    B, S, H, N = r.shape
    xs = tuple(jnp.moveaxis(t, 1, 0) for t in (r, decay, k, v, a, b))

    def step(state, inp):
        r_t, w_t, k_t, v_t, a_t, b_t = inp
        sa = jnp.einsum('bhvk,bhk->bhv', state, a_t)
        state = (state * w_t[:, :, None, :] + sa[..., None] * b_t[:, :, None, :]
                 + v_t[..., None] * k_t[:, :, None, :])
        y = jnp.einsum('bhvk,bhk->bhv', state, r_t)
        return state, y

    state0 = jnp.zeros((B, H, N, N), jnp.float32)
    _, ys = lax.scan(step, state0, xs)
    return jnp.moveaxis(ys, 0, 1)


def _rwkv7_time_mix(r, k, v, wd, ad, gd, w0, w_up, a0, a_up, g_up, k_k, k_a, r_k, lnx_w, lnx_b):
    B, S, _ = r.shape
    H, N = RWKV_HEADS, RWKV_HEAD_DIM
    out_dtype = r.dtype
    f32 = jnp.float32
    r, k, v = r.astype(f32), k.astype(f32), v.astype(f32)
    w = -jax.nn.softplus(-(w0 + jnp.tanh(wd) @ w_up).astype(f32)) - 0.5
    decay = jnp.exp(-jnp.exp(w))
    a = jax.nn.sigmoid((a0 + ad @ a_up).astype(f32))
    g = (jax.nn.sigmoid(gd) @ g_up).astype(f32)
    heads = lambda t: t.reshape(B, S, H, N)
    kk = heads(k * k_k)
    kk = kk / jnp.maximum(jnp.sqrt(jnp.sum(jnp.square(kk), axis=-1, keepdims=True)), 1e-12)
    k = k * (1.0 + (a - 1.0) * k_a)
    rh, kh, vh, ah = heads(r), heads(k), heads(v), heads(a)
    y = _rwkv7_scan(rh, heads(decay), kh, vh, -kk, kk * ah)
    mu = jnp.mean(y, axis=-1, keepdims=True)
    var = jnp.mean(jnp.square(y - mu), axis=-1, keepdims=True)
    y = ((y - mu) * lax.rsqrt(var + GN_EPS)).reshape(B, S, H * N) * lnx_w + lnx_b
    bonus = (jnp.sum(rh * kh * r_k, axis=-1, keepdims=True) * vh).reshape(B, S, H * N)
    return ((y + bonus) * g).astype(out_dtype)


def _token_mixing(x, w_in, rel_bias, shift_mu, w0, w_up, a0, a_up, g_up, k_k, k_a, r_k,
                  lnx_w, lnx_b, proj_a, proj_b, w_out):
    B, S, D = x.shape
    proj = jnp.einsum('bsd,de->bse', x, w_in)
    o1 = 3 * ATT_WIDTH
    o2 = o1 + SHIFT_WIDTH
    q, k, v = jnp.split(proj[..., :o1], 3, axis=-1)
    seg = proj[..., o1:o2]
    prev = jnp.pad(seg, ((0, 0), (1, 0), (0, 0)))[:, :-1]
    seg = seg + (prev - seg) * shift_mu
    W = RWKV_WIDTH
    r_b, k_b, v_b, wd, ad, gd = jnp.split(
        seg, [W, 2 * W, 3 * W, 3 * W + DECAY_LORA, 3 * W + DECAY_LORA + ICLR_LORA], axis=-1)
    gate_a, gate_b = jnp.split(jax.nn.sigmoid(proj[..., o2:]), 2, axis=-1)
    heads = lambda t: t.reshape(B, S, ATT_HEADS, ATT_HEAD_DIM)
    y_a = _chunk_attention(heads(q), heads(k), heads(v), rel_bias)
    y_b = _rwkv7_time_mix(r_b, k_b, v_b, wd, ad, gd, w0, w_up, a0, a_up, g_up,
                          k_k, k_a, r_k, lnx_w, lnx_b)
    merged = (gate_a * jnp.einsum('bsc,cd->bsd', y_a, proj_a)
              + gate_b * jnp.einsum('bsc,cd->bsd', y_b, proj_b))
    return jnp.einsum('bsd,de->bse', merged, w_out)


def _moe(h, w_router, b_router, w_gu, b_gu, w_down, b_down):
    T, D = h.shape
    logits = jnp.einsum('td,de->te', h, w_router).astype(jnp.float32) + b_router.astype(jnp.float32)
    top_v, top_i = lax.top_k(logits, TOP_K)
    gate = jax.nn.softmax(top_v, axis=-1)
    M = T * TOP_K
    slot_e = top_i.reshape(M).astype(jnp.int32)
    slot_t = jnp.arange(M, dtype=jnp.int32) // TOP_K
    slot_g = gate.reshape(M)
    order = jnp.argsort(slot_e)
    e_sorted = slot_e[order]
    counts = jnp.zeros((N_EXPERTS,), jnp.int32).at[slot_e].add(1)
    starts = jnp.cumsum(counts) - counts
    padded = (counts + MOE_BLOCK - 1) // MOE_BLOCK * MOE_BLOCK
    pad_ends = jnp.cumsum(padded)
    pad_starts = pad_ends - padded
    dest = pad_starts[e_sorted] + (jnp.arange(M, dtype=jnp.int32) - starts[e_sorted])
    n_blocks = (M + N_EXPERTS * (MOE_BLOCK - 1) + MOE_BLOCK - 1) // MOE_BLOCK
    R = n_blocks * MOE_BLOCK
    row_tok = jnp.zeros((R,), jnp.int32).at[dest].set(slot_t[order])
    row_w = jnp.zeros((R,), jnp.float32).at[dest].set(slot_g[order])
    blk_e = jnp.minimum(jnp.searchsorted(pad_ends, jnp.arange(n_blocks) * MOE_BLOCK, side='right'),
                        N_EXPERTS - 1)

    def body(acc, inp):
        e, toks, wts = inp
        xb = h[toks]
        gu = xb @ w_gu[e] + b_gu[e]
        g, u = jnp.split(gu, 2, axis=-1)
        g = jnp.minimum(g, SWIGLU_LIMIT)
        u = jnp.clip(u, -SWIGLU_LIMIT, SWIGLU_LIMIT)
        act = (u + 1.0) * (g * jax.nn.sigmoid(SWIGLU_ALPHA * g))
        y = act @ w_down[e] + b_down[e]
        acc = acc.at[toks].add((y * wts[:, None]).astype(acc.dtype))
        return acc, None

    out, _ = lax.scan(body, jnp.zeros_like(h),
                      (blk_e, row_tok.reshape(n_blocks, MOE_BLOCK), row_w.reshape(n_blocks, MOE_BLOCK)))
    return out


def setup_inputs(seed: int = 0) -> dict:
    key = jax.random.key(seed)
    ks = jax.random.split(key, 27)
    f32 = jnp.float32
    L = DEPTH
    nrm = lambda k, shape, scale: jax.random.normal(k, shape, f32) * scale
    F = D_EXPERT
    return {
        'x': nrm(ks[0], (BATCH, SEQ, D_MODEL), 1.0),
        'w_in': nrm(ks[1], (L, D_MODEL, D_IN), D_MODEL ** -0.5),
        'rel_bias': nrm(ks[2], (L, ATT_HEADS, REL_TABLE), 0.2),
        'shift_mu': jax.random.uniform(ks[3], (L, SHIFT_WIDTH), f32, 0.1, 0.9),
        'w0': jax.random.uniform(ks[4], (L, RWKV_WIDTH), f32, -4.0, 0.0),
        'w_up': nrm(ks[5], (L, DECAY_LORA, RWKV_WIDTH), 0.5 * DECAY_LORA ** -0.5),
        'a0': nrm(ks[6], (L, RWKV_WIDTH), 0.3),
        'a_up': nrm(ks[7], (L, ICLR_LORA, RWKV_WIDTH), 0.5 * ICLR_LORA ** -0.5),
        'g_up': nrm(ks[8], (L, GATE_LORA, RWKV_WIDTH), GATE_LORA ** -0.5),
        'k_k': 0.85 + nrm(ks[9], (L, RWKV_WIDTH), 0.05),
        'k_a': 1.0 + nrm(ks[10], (L, RWKV_WIDTH), 0.05),
        'r_k': nrm(ks[11], (L, RWKV_HEADS, RWKV_HEAD_DIM), 0.1),
        'lnx_w': 1.0 + nrm(ks[12], (L, RWKV_WIDTH), 0.05),
        'lnx_b': nrm(ks[13], (L, RWKV_WIDTH), 0.01),
        'proj_a': nrm(ks[14], (L, ATT_WIDTH, D_MODEL), DEEPNORM_BETA * ATT_WIDTH ** -0.5),
        'proj_b': nrm(ks[15], (L, RWKV_WIDTH, D_MODEL), DEEPNORM_BETA * RWKV_WIDTH ** -0.5),
        'w_out': nrm(ks[16], (L, D_MODEL, D_MODEL), DEEPNORM_BETA * D_MODEL ** -0.5),
        'ln1_w': 1.0 + nrm(ks[17], (L, D_MODEL), 0.05),
        'ln1_b': nrm(ks[18], (L, D_MODEL), 0.01),
        'w_router': nrm(ks[19], (L, D_MODEL, N_EXPERTS), D_MODEL ** -0.5),
        'b_router': nrm(ks[20], (L, N_EXPERTS), 0.01),
        'w_gu': nrm(ks[21], (L, N_EXPERTS, D_MODEL, 2 * F), D_MODEL ** -0.5),
        'b_gu': nrm(ks[22], (L, N_EXPERTS, 2 * F), 0.01),
        'w_down': nrm(ks[23], (L, N_EXPERTS, F, D_MODEL), DEEPNORM_BETA * F ** -0.5),
        'b_down': nrm(ks[24], (L, N_EXPERTS, D_MODEL), 0.01),
        'ln2_w': 1.0 + nrm(ks[25], (L, D_MODEL), 0.05),
        'ln2_b': nrm(ks[26], (L, D_MODEL), 0.01),
    }


def reference(x, w_in, rel_bias, shift_mu, w0, w_up, a0, a_up, g_up, k_k, k_a, r_k, lnx_w, lnx_b,
              proj_a, proj_b, w_out, ln1_w, ln1_b, w_router, b_router, w_gu, b_gu, w_down, b_down,
              ln2_w, ln2_b):
    h = x
    B, S, D = x.shape
    for l in range(DEPTH):
        mix = _token_mixing(h, w_in[l], rel_bias[l], shift_mu[l], w0[l], w_up[l], a0[l], a_up[l],
                            g_up[l], k_k[l], k_a[l], r_k[l], lnx_w[l], lnx_b[l],
                            proj_a[l], proj_b[l], w_out[l])
        h = _layer_norm(DEEPNORM_ALPHA * h + mix, ln1_w[l], ln1_b[l])
        ffn = _moe(h.reshape(B * S, D), w_router[l], b_router[l], w_gu[l], b_gu[l],
                   w_down[l], b_down[l]).reshape(B, S, D)
        h = _layer_norm(DEEPNORM_ALPHA * h + ffn, ln2_w[l], ln2_b[l])
    return h
```

```cpp
#define STAGE 4
#include <hip/hip_runtime.h>
#include <cstdio>
#include <cstdint>

#define GAS __attribute__((address_space(1)))
#define LAS __attribute__((address_space(3)))
typedef unsigned short bf16;
typedef unsigned v4u __attribute__((ext_vector_type(4)));
typedef unsigned v2u __attribute__((ext_vector_type(2)));
typedef float f32x4 __attribute__((ext_vector_type(4)));
typedef float f32x2 __attribute__((ext_vector_type(2)));
typedef float f32x16 __attribute__((ext_vector_type(16)));
typedef short bf16x8 __attribute__((ext_vector_type(8)));
typedef short bf16x4 __attribute__((ext_vector_type(4)));
typedef GAS unsigned gu32;

constexpr int NWAVES = 8;
constexpr int BATCH = 4, SEQ = 8192, D = 2048, T = BATCH * SEQ;
constexpr int CHUNK = 64, LEFT = 8, AH = 16, AD = 64, AW = 1024;
constexpr int REL_TABLE = 320, MAX_PAST = 256;
constexpr int RH = 16, RN = 64, RW = 1024, DLORA = 96, ALORA = 96, GLORA = 256;
constexpr int SHIFT_W = 3 * RW + DLORA + ALORA + GLORA;
constexpr int D_IN = 3 * AW + SHIFT_W + 2 * D;
constexpr int NE = 32, TOPK = 4, FF = 2048;
constexpr int MSLOT = T * TOPK;
constexpr int NBLK_MAX = (MSLOT + NE * 255 + 255) / 256;
constexpr int RROWS = NBLK_MAX * 256;
constexpr float LN_EPS = 1e-5f, GN_EPS = 64e-5f;
constexpr float DN_ALPHA = 1.189207115002721f;
constexpr int PROJ_LD = 9728, PJ_Q = 0, PJ_K = 1024, PJ_SEG = 2048, SEG_PAD = 3584, PJ_GA = 5632, PJ_GB = 7680;
constexpr int LORA_LD = 512;

constexpr size_t MiB = 1u << 20;
constexpr size_t WS_CTL = 0, CTL_ZERO_BYTES = 1 * MiB;
constexpr size_t WS_TOPI = 2 * MiB;
constexpr size_t WS_GATE = 3 * MiB;
constexpr size_t WS_ROWSLOT = 4 * MiB;
constexpr size_t WS_ROWW = 5 * MiB;
constexpr size_t WS_WLA = 6 * MiB;
constexpr size_t WS_WLG = 7 * MiB;
constexpr size_t WS_PAT = 8 * MiB;
constexpr size_t WS_PBT = 12 * MiB;
constexpr size_t WS_WOT = 16 * MiB;
constexpr size_t WS_WVT = 24 * MiB;
constexpr size_t WS_WINT = 28 * MiB;
constexpr size_t WS_WGUT = 128 * MiB;
constexpr size_t WS_WDNT = 640 * MiB;
constexpr size_t WS_BASE0 = 1024 * MiB;
constexpr size_t WS_PROJ = WS_BASE0;
constexpr size_t WS_VT = WS_PROJ + 608 * MiB;
constexpr size_t WS_YA = WS_VT + 64 * MiB;
constexpr size_t WS_RKV = WS_YA + 64 * MiB;
constexpr size_t WS_LORAIN = WS_RKV + 192 * MiB;
constexpr size_t WS_DECAY = WS_LORAIN + 32 * MiB;
constexpr size_t WS_ICLR = WS_DECAY + 128 * MiB;
constexpr size_t WS_G = WS_ICLR + 128 * MiB;
constexpr size_t WS_YSCAN = WS_G + 64 * MiB;
constexpr size_t WS_YB = WS_YSCAN + 128 * MiB;
constexpr size_t WS_MERGED = WS_YB + 64 * MiB;
constexpr size_t WS_XB16 = WS_MERGED + 128 * MiB;
constexpr size_t WS_MIX_END = WS_XB16 + 128 * MiB;
constexpr size_t WS_Z = 2816 * MiB;
constexpr size_t WS_H1 = 3072 * MiB;
constexpr size_t WS_H1B = 3328 * MiB;
constexpr size_t WS_END = 3456 * MiB;
constexpr size_t WS_XG = WS_BASE0;
constexpr size_t WS_ACT = WS_BASE0 + 544 * MiB;
constexpr size_t WS_YSLOT = WS_BASE0 + 1088 * MiB;
static_assert(WS_MIX_END <= WS_Z && WS_YSLOT + 512 * MiB <= WS_Z, "ws map");
static_assert(WS_WINT + (size_t)PROJ_LD * D * 2 <= WS_WGUT, "ws map");

constexpr int CW_CNT = 512;
constexpr int CW_CUR = 576;
constexpr int CW_BAR = 4096;

constexpr int RING_OFF = 0, RING_BYTES = 131072;
constexpr int LDS_BYTES = 160 * 1024;
constexpr int MISC_OFF = LDS_BYTES - 512;
constexpr int TAB_OFF = LDS_BYTES - 1024;

#define RLX_AGENT __ATOMIC_RELAXED, __HIP_MEMORY_SCOPE_AGENT
#define LDS_WAIT() asm volatile("s_waitcnt lgkmcnt(0)" ::: "memory")
#define VM_WAIT() asm volatile("s_waitcnt vmcnt(0)" ::: "memory")
__device__ __forceinline__ unsigned f2bf(float f) { unsigned u = __builtin_bit_cast(unsigned, f); return (u + 0x7fffu + ((u >> 16) & 1u)) >> 16; }
__device__ __forceinline__ unsigned pk2(float lo, float hi) { return f2bf(lo) | (f2bf(hi) << 16); }
__device__ __forceinline__ float bf2f(unsigned short h) { return __builtin_bit_cast(float, (unsigned)h << 16); }
__device__ __forceinline__ float bflo(unsigned w) { return __builtin_bit_cast(float, w << 16); }
__device__ __forceinline__ float bfhi(unsigned w) { return __builtin_bit_cast(float, w & 0xffff0000u); }
__device__ __forceinline__ float fsigmoid(float x) { return __builtin_amdgcn_rcpf(1.0f + __expf(-x)); }
__device__ __forceinline__ float wave_sum(float v) {
#pragma unroll
    for (int o = 1; o < 64; o <<= 1) v += __shfl_xor(v, o);
    return v;
}
namespace pg8 {
#define PG8_LAS __attribute__((address_space(3)))
typedef unsigned short bf16_t;
typedef unsigned u32x4 __attribute__((ext_vector_type(4)));
constexpr int BM = 256, BK = 64, HALF = 128, HTB = HALF * BK * 2, STAGE_BYTES = 8 * HTB, NXCD = 8, WGM = 8;

__host__ __device__ __forceinline__ int lds_byte(int r, int c) { const int st = (r >> 4) * 2 + (c >> 5), rr = r & 15, cc = c & 31, ob = rr * 64 + cc * 2; return st * 1024 + (ob ^ (((ob >> 9) & 1) << 5)); }
__host__ __device__ __forceinline__ void stage_rc(int b, int& R, int& C) { const int st = b / 1024, sb = b % 1024, swz = sb ^ (((sb >> 9) & 1) << 5); R = (st >> 1) * 16 + swz / 64; C = (st & 1) * 32 + (swz % 64) / 2; }
__host__ __device__ __forceinline__ int perm32(int rho) { const int n = rho >> 4, i = rho & 15; return 8 * (i >> 2) + 4 * n + (i & 3); }

struct Unit { int pm, pn, aux; };

struct Tiler {
    int nM, nN, nwg, G, c;
    __device__ __forceinline__ void init(int nM_, int nN_, int G_, int c_) { nM = nM_; nN = nN_; nwg = nM * nN; G = G_; c = c_; }
    __device__ __forceinline__ bool map(int i, int& pm, int& pn) const {
        const long L = (long)i * G + c; if (L >= nwg) return false;
        int wgid = (int)L; { const int q = nwg / NXCD, r = nwg % NXCD, xcd = wgid % NXCD, off = wgid / NXCD; wgid = (xcd < r ? xcd * (q + 1) : r * (q + 1) + (xcd - r) * q) + off; }
        const int nig = WGM * nN, gid = wgid / nig, fm = gid * WGM, gsz = (nM - fm) < WGM ? (nM - fm) : WGM;
        pm = fm + ((wgid % nig) % gsz); pn = (wgid % nig) / gsz; return true;
    }
};
struct SchedPlain {
    Tiler t; const char* A; const char* B; size_t tsA, tsB;
    __device__ __forceinline__ bool next(int i, Unit& u) const { u.aux = 0; return t.map(i, u.pm, u.pn); }
    __device__ __forceinline__ void bases(const Unit& u, const char*& a, const char*& b) const { a = A + (size_t)u.pm * tsA; b = B + (size_t)u.pn * tsB; }
};
struct SchedTwo {
    Tiler t; const char* A0; const char* A1; const char* B0; const char* B1; size_t tsA, tsB;
    __device__ __forceinline__ bool next(int i, Unit& u) const { u.aux = i & 1; return t.map(i >> 1, u.pm, u.pn); }
    __device__ __forceinline__ void bases(const Unit& u, const char*& a, const char*& b) const { a = (u.aux ? A1 : A0) + (size_t)u.pm * tsA; b = (u.aux ? B1 : B0) + (size_t)u.pn * tsB; }
};
struct SchedMoe {
    Tiler t; const char* A; const char* B; size_t tsA, tsB, es; const PG8_LAS int* pad_end;
    __device__ __forceinline__ bool next(int i, Unit& u) const {
        if (!t.map(i, u.pm, u.pn)) return false;
        const int row0 = u.pm * BM; int e = 0;
#pragma unroll
        for (int j = 0; j < 32; ++j) e += (pad_end[j] <= row0) ? 1 : 0;
        u.aux = e < 31 ? e : 31; return true;
    }
    __device__ __forceinline__ void bases(const Unit& u, const char*& a, const char*& b) const { a = A + (size_t)u.pm * tsA; b = B + (size_t)u.aux * es + (size_t)u.pn * tsB; }
};

__device__ __forceinline__ unsigned cvt_pk_bf16(float lo, float hi) { unsigned r; asm volatile("v_cvt_pk_bf16_f32 %0, %1, %2" : "=v"(r) : "v"(lo), "v"(hi)); return r; }
__device__ __forceinline__ u32x4 pack8(const f32x4& v0, const f32x4& v1) { u32x4 w; w.x = cvt_pk_bf16(v0[0], v0[1]); w.y = cvt_pk_bf16(v0[2], v0[3]); w.z = cvt_pk_bf16(v1[0], v1[1]); w.w = cvt_pk_bf16(v1[2], v1[3]); return w; }

template <class Epi, class Sched, bool ALIGN_EPI>
__device__ __forceinline__ void gemm_phase(PG8_LAS unsigned char* lds, const int lda, const int ldb, const int K, const Sched& S, const Epi& E) {
    const int tid = threadIdx.x, wid = __builtin_amdgcn_readfirstlane(tid >> 6), lane = tid & 63, wr = wid >> 2, wc = wid & 3, fr = lane & 15, fq = lane >> 4;
    const int nt = K / BK;
    unsigned voffA[2], voffB[2];
#pragma unroll
    for (int i = 0; i < 2; ++i) { int R, C; stage_rc(tid * 16 + i * 8192, R, C); const int Rb = (R & ~31) + perm32(R & 31);
        voffA[i] = (unsigned)(R * lda + C) * 2u; voffB[i] = (unsigned)(Rb * ldb + C) * 2u; }
    const size_t kstep = (size_t)(BK * 2);
    const size_t hsA = (size_t)HALF * lda * 2, hsB = (size_t)HALF * ldb * 2;
    const unsigned ldsw = (unsigned)wid * 1024u;
    const int aoff = lds_byte(wr * 64 + fr, fq * 8), boff = lds_byte(wc * 32 + fr, fq * 8);
#define PG8_SA(b, h) (((b) * 2 + (h)) * HTB)
#define PG8_SB(b, h) ((4 + (b) * 2 + (h)) * HTB)
#define PG8_STAGE(bufoff, gbase, voff) do { _Pragma("unroll") for (int _i = 0; _i < 2; ++_i) \
        __builtin_amdgcn_global_load_lds((const unsigned*)((const char*)(gbase) + (voff)[_i]), (PG8_LAS unsigned*)(lds + (bufoff) + ldsw + _i * 8192), 16, 0, 0); } while (0)
#define PG8_LDA(dst, b, h) do { _Pragma("unroll") for (int m = 0; m < 4; ++m) _Pragma("unroll") for (int k = 0; k < 2; ++k) dst[m][k] = *(const PG8_LAS bf16x8*)(lds + PG8_SA(b, h) + aoff + m * 2048 + k * 1024); } while (0)
#define PG8_LDB(dst, b, h) do { _Pragma("unroll") for (int n = 0; n < 2; ++n) _Pragma("unroll") for (int k = 0; k < 2; ++k) dst[n][k] = *(const PG8_LAS bf16x8*)(lds + PG8_SB(b, h) + boff + n * 2048 + k * 1024); } while (0)
#define PG8_MMA(ai, bj, At, Bt) do { __builtin_amdgcn_s_setprio(1); _Pragma("unroll") for (int m = 0; m < 4; ++m) _Pragma("unroll") for (int n = 0; n < 2; ++n) _Pragma("unroll") for (int k = 0; k < 2; ++k) \
        acc[ai][bj][m][n] = __builtin_amdgcn_mfma_f32_16x16x32_bf16(Bt[n][k], At[m][k], acc[ai][bj][m][n], 0, 0, 0); __builtin_amdgcn_s_setprio(0); } while (0)
#define PG8_WAIT_V(n) asm volatile("s_waitcnt vmcnt(" #n ")" ::: "memory")
#define PG8_WAIT_L(n) asm volatile("s_waitcnt lgkmcnt(" #n ")" ::: "memory")
#define PG8_BAR __builtin_amdgcn_s_barrier()
#define PG8_SCHED __builtin_amdgcn_sched_barrier(0)
#define PG8_ZERO() do { _Pragma("unroll") for (int a = 0; a < 2; ++a) _Pragma("unroll") for (int b = 0; b < 2; ++b) _Pragma("unroll") for (int m = 0; m < 4; ++m) _Pragma("unroll") for (int n = 0; n < 2; ++n) acc[a][b][m][n] = (f32x4){0.f, 0.f, 0.f, 0.f}; } while (0)
    Unit cur, nxt; int ui = 0;
    if (!S.next(0, cur)) return;
    f32x4 acc[2][2][4][2];
    PG8_ZERO();
    bf16x8 At[4][2], B0[2][2], B1[2][2];
    const char* cA; const char* cB; S.bases(cur, cA, cB);
    PG8_STAGE(PG8_SB(0, 0), cB, voffB); PG8_STAGE(PG8_SB(0, 1), cB + hsB, voffB); PG8_STAGE(PG8_SA(0, 0), cA, voffA); PG8_STAGE(PG8_SA(0, 1), cA + hsA, voffA);
    if (wr == 1) PG8_BAR;
    PG8_WAIT_V(2); PG8_BAR;
    PG8_STAGE(PG8_SB(1, 0), cB + kstep, voffB); PG8_STAGE(PG8_SA(1, 0), cA + kstep, voffA); PG8_STAGE(PG8_SB(1, 1), cB + hsB + kstep, voffB);
    PG8_WAIT_V(6); PG8_BAR;
    for (;;) {
        const bool has_next = S.next(ui + 1, nxt);
        const char* nA = cA; const char* nB = cB; if (has_next) S.bases(nxt, nA, nB);
#pragma unroll 1
        for (int t = 0; t < nt; t += 2) {
            const bool last = (t == nt - 2);
            const char* a1 = cA + (size_t)(t + 1) * kstep;
            const char* a2 = last ? nA : cA + (size_t)(t + 2) * kstep; const char* b2 = last ? nB : cB + (size_t)(t + 2) * kstep;
            const char* a3 = a2 + kstep; const char* b3 = b2 + kstep;
            PG8_LDB(B0, 0, 0); PG8_LDB(B1, 0, 1); PG8_SCHED; PG8_LDA(At, 0, 0); PG8_STAGE(PG8_SA(1, 1), a1 + hsA, voffA);
            PG8_WAIT_V(8); PG8_WAIT_L(0); PG8_BAR; PG8_MMA(0, 0, At, B0); PG8_MMA(0, 1, At, B1); PG8_BAR; PG8_SCHED;
            PG8_LDA(At, 0, 1); PG8_STAGE(PG8_SB(0, 0), b2, voffB); PG8_STAGE(PG8_SB(0, 1), b2 + hsB, voffB); PG8_STAGE(PG8_SA(0, 0), a2, voffA);
            PG8_WAIT_V(8); PG8_WAIT_L(0); PG8_BAR; PG8_MMA(1, 0, At, B0); PG8_MMA(1, 1, At, B1); PG8_BAR; PG8_SCHED;
            PG8_LDB(B0, 1, 0); PG8_LDB(B1, 1, 1); PG8_SCHED; PG8_LDA(At, 1, 0); PG8_STAGE(PG8_SA(0, 1), a2 + hsA, voffA);
            PG8_WAIT_V(8); PG8_WAIT_L(0); PG8_BAR; PG8_MMA(0, 0, At, B0); PG8_MMA(0, 1, At, B1); PG8_BAR; PG8_SCHED;
            PG8_LDA(At, 1, 1); PG8_STAGE(PG8_SB(1, 0), b3, voffB); PG8_STAGE(PG8_SB(1, 1), b3 + hsB, voffB); PG8_STAGE(PG8_SA(1, 0), a3, voffA);
            PG8_WAIT_V(8); PG8_WAIT_L(0); PG8_BAR; PG8_MMA(1, 0, At, B0); PG8_MMA(1, 1, At, B1); PG8_BAR; PG8_SCHED;
        }
        if constexpr (ALIGN_EPI) { if (wr == 0) PG8_BAR; }
        const bool keep = E(acc, cur, wr, wc, fr, fq);
        if (!has_next) break;
        if (!keep) PG8_ZERO();
        cur = nxt; cA = nA; cB = nB; ++ui;
        if constexpr (ALIGN_EPI) { if (wr == 1) PG8_BAR; }
    }
    PG8_WAIT_V(0);
    if constexpr (!ALIGN_EPI) { if (wr == 0) PG8_BAR; }
    PG8_BAR;
#undef PG8_SA
#undef PG8_SB
#undef PG8_STAGE
#undef PG8_LDA
#undef PG8_LDB
#undef PG8_MMA
#undef PG8_WAIT_V
#undef PG8_WAIT_L
#undef PG8_BAR
#undef PG8_SCHED
#undef PG8_ZERO
}
}
namespace pg8 {
#define EPI_ROWLOOP _Pragma("unroll") for (int ai = 0; ai < 2; ++ai) _Pragma("unroll") for (int m = 0; m < 4; ++m)
struct EpiProj {
    bf16_t* O;
    __device__ __forceinline__ bool operator()(f32x4 (&acc)[2][2][4][2], const Unit& u, int wr, int wc, int fr, int fq) const {
        const int row0 = u.pm * BM + wr * 64 + fr, col0 = u.pn * BM + wc * 32 + 8 * fq;
        const int mode = (u.pn < 4) ? 1 : (u.pn >= 22 ? 2 : 0);
        EPI_ROWLOOP { bf16_t* rowp = O + (size_t)(row0 + ai * HALF + m * 16) * PROJ_LD + col0;
#pragma unroll
            for (int bj = 0; bj < 2; ++bj) { f32x4 v0 = acc[ai][bj][m][0], v1 = acc[ai][bj][m][1];
                if (mode == 1) { v0 = v0 * 0.125f; v1 = v1 * 0.125f; }
                else if (mode == 2) {
#pragma unroll
                    for (int j = 0; j < 4; ++j) { v0[j] = fsigmoid(v0[j]); v1[j] = fsigmoid(v1[j]); } }
                *(u32x4*)(rowp + bj * HALF) = pack8(v0, v1); } }
        return false;
    }
};
struct EpiBf16 {
    bf16_t* O; int ldc;
    __device__ __forceinline__ bool operator()(f32x4 (&acc)[2][2][4][2], const Unit& u, int wr, int wc, int fr, int fq) const {
        const int row0 = u.pm * BM + wr * 64 + fr, col0 = u.pn * BM + wc * 32 + 8 * fq;
        EPI_ROWLOOP { bf16_t* rowp = O + (size_t)(row0 + ai * HALF + m * 16) * ldc + col0;
#pragma unroll
            for (int bj = 0; bj < 2; ++bj) *(u32x4*)(rowp + bj * HALF) = pack8(acc[ai][bj][m][0], acc[ai][bj][m][1]); }
        return false;
    }
};
template <bool ISDEC> struct EpiLoraA {
    float* OUT; const float* par;
    __device__ __forceinline__ bool operator()(f32x4 (&acc)[2][2][4][2], const Unit& u, int wr, int wc, int fr, int fq) const {
        const int row0 = u.pm * BM + wr * 64 + fr, col0 = u.pn * BM + wc * 32 + 8 * fq;
        f32x4 pv[2][2];
#pragma unroll
        for (int bj = 0; bj < 2; ++bj)
#pragma unroll
            for (int n = 0; n < 2; ++n) pv[bj][n] = *(const f32x4*)(par + col0 + bj * HALF + 4 * n);
        EPI_ROWLOOP { float* rowp = OUT + (size_t)(row0 + ai * HALF + m * 16) * RW + col0;
#pragma unroll
            for (int bj = 0; bj < 2; ++bj)
#pragma unroll
                for (int n = 0; n < 2; ++n) { f32x4 v = acc[ai][bj][m][n] + pv[bj][n];
#pragma unroll
                    for (int j = 0; j < 4; ++j) {
                        if (ISDEC) { const float y = -v[j]; const float sp = fmaxf(y, 0.f) + __logf(1.0f + __expf(-fabsf(y))); const float w = -sp - 0.5f; v[j] = __expf(-__expf(w)); }
                        else v[j] = fsigmoid(v[j]); }
                    *(f32x4*)(rowp + bj * HALF + 4 * n) = v; } }
        return false;
    }
};
struct EpiMerged {
    const bf16_t* PROJ; bf16_t* O;
    __device__ __forceinline__ bool operator()(f32x4 (&acc)[2][2][4][2], const Unit& u, int wr, int wc, int fr, int fq) const {
        const int row0 = u.pm * BM + wr * 64 + fr, col0 = u.pn * BM + wc * 32 + 8 * fq;
        EPI_ROWLOOP { const int row = row0 + ai * HALF + m * 16; const bf16_t* gp = PROJ + (size_t)row * PROJ_LD + col0;
#pragma unroll
            for (int bj = 0; bj < 2; ++bj) {
                const u32x4 gb = *(const u32x4*)(gp + PJ_GB + bj * HALF);
                f32x4 b0 = (f32x4){bflo(gb.x), bfhi(gb.x), bflo(gb.y), bfhi(gb.y)}, b1 = (f32x4){bflo(gb.z), bfhi(gb.z), bflo(gb.w), bfhi(gb.w)};
                if (u.aux == 0) {
                    const u32x4 ga = *(const u32x4*)(gp + PJ_GA + bj * HALF);
                    f32x4 a0 = (f32x4){bflo(ga.x), bfhi(ga.x), bflo(ga.y), bfhi(ga.y)}, a1 = (f32x4){bflo(ga.z), bfhi(ga.z), bflo(ga.w), bfhi(ga.w)};
#pragma unroll
                    for (int j = 0; j < 4; ++j) { acc[ai][bj][m][0][j] *= a0[j] / fmaxf(b0[j], 1e-30f); acc[ai][bj][m][1][j] *= a1[j] / fmaxf(b1[j], 1e-30f); }
                } else {
                    *(u32x4*)(O + (size_t)row * D + col0 + bj * HALF) = pack8(acc[ai][bj][m][0] * b0, acc[ai][bj][m][1] * b1);
                } } }
        return u.aux == 0;
    }
};
struct EpiZ {
    const float* X; float* Z;
    __device__ __forceinline__ bool operator()(f32x4 (&acc)[2][2][4][2], const Unit& u, int wr, int wc, int fr, int fq) const {
        const int row0 = u.pm * BM + wr * 64 + fr, col0 = u.pn * BM + wc * 32 + 8 * fq;
        EPI_ROWLOOP { const size_t off = (size_t)(row0 + ai * HALF + m * 16) * D + col0;
#pragma unroll
            for (int bj = 0; bj < 2; ++bj)
#pragma unroll
                for (int n = 0; n < 2; ++n) { const f32x4 xv = *(const f32x4*)(X + off + bj * HALF + 4 * n); *(f32x4*)(Z + off + bj * HALF + 4 * n) = xv * DN_ALPHA + acc[ai][bj][m][n]; } }
        return false;
    }
};
struct EpiSwiglu {
    bf16_t* ACT; const float* bgu;
    __device__ __forceinline__ bool operator()(f32x4 (&acc)[2][2][4][2], const Unit& u, int wr, int wc, int fr, int fq) const {
        const int row0 = u.pm * BM + wr * 64 + fr, col0 = u.pn * HALF + wc * 32 + 8 * fq;
        const float* bp = bgu + (size_t)u.aux * (2 * FF) + col0;
        f32x4 bg[2], bu[2];
#pragma unroll
        for (int n = 0; n < 2; ++n) { bg[n] = *(const f32x4*)(bp + 4 * n); bu[n] = *(const f32x4*)(bp + FF + 4 * n); }
        EPI_ROWLOOP { f32x4 o[2];
#pragma unroll
            for (int n = 0; n < 2; ++n) { const f32x4 g = acc[ai][0][m][n] + bg[n], uu = acc[ai][1][m][n] + bu[n];
#pragma unroll
                for (int j = 0; j < 4; ++j) { const float gc = fminf(g[j], 7.0f), uc = fminf(fmaxf(uu[j], -7.0f), 7.0f); o[n][j] = (uc + 1.0f) * (gc * fsigmoid(1.702f * gc)); } }
            *(u32x4*)(ACT + (size_t)(row0 + ai * HALF + m * 16) * FF + col0) = pack8(o[0], o[1]); }
        return false;
    }
};
struct EpiDown {
    bf16_t* YS; const float* bdn; const int* rowslot; const float* roww;
    __device__ __forceinline__ bool operator()(f32x4 (&acc)[2][2][4][2], const Unit& u, int wr, int wc, int fr, int fq) const {
        const int row0 = u.pm * BM + wr * 64 + fr, col0 = u.pn * BM + wc * 32 + 8 * fq;
        const float* bp = bdn + (size_t)u.aux * D + col0;
        f32x4 bv[2][2];
#pragma unroll
        for (int bj = 0; bj < 2; ++bj)
#pragma unroll
            for (int n = 0; n < 2; ++n) bv[bj][n] = *(const f32x4*)(bp + bj * HALF + 4 * n);
        EPI_ROWLOOP { const int row = row0 + ai * HALF + m * 16; const int slot = rowslot[row]; const float w = roww[row];
            if (slot >= 0) { bf16_t* rowp = YS + (size_t)slot * D + col0;
#pragma unroll
                for (int bj = 0; bj < 2; ++bj) *(u32x4*)(rowp + bj * HALF) = pack8((acc[ai][bj][m][0] + bv[bj][0]) * w, (acc[ai][bj][m][1] + bv[bj][1]) * w); } }
        return false;
    }
};
#undef EPI_ROWLOOP
}

#define XB_TMO      128
#define XB_XCNT(j)  (256  + 64 * (j))
#define XB_XSUB(j)  (1280 + 64 * (j))
#define XB_XGEN(j)  (2304 + 64 * (j))
#define XB_TOP      3328
#define XB_TOPGEN   3392
#define XCD_BAR_WORDS 3456
#define XB_SPIN_CAP (1u << 18)

__device__ __forceinline__ unsigned xb_ld(unsigned* p)              { return __hip_atomic_load(p, __ATOMIC_RELAXED, __HIP_MEMORY_SCOPE_AGENT); }
__device__ __forceinline__ unsigned xb_add(unsigned* p, unsigned v) { return __hip_atomic_fetch_add(p, v, __ATOMIC_RELAXED, __HIP_MEMORY_SCOPE_AGENT); }
__device__ __forceinline__ unsigned xb_xcc_id() { return (unsigned)__builtin_amdgcn_s_getreg((3 << 11) | 20) & 0xFu; }
#define XB_SPIN(cond, bar) do { unsigned _sp = 0; while (cond) { __builtin_amdgcn_s_sleep(1); \
    if ((++_sp & 255u) == 0u) { if (xb_ld(&(bar)[XB_TMO])) break; if (_sp > XB_SPIN_CAP) { atomicAdd(&(bar)[XB_TMO], 1u); break; } } } } while (0)

struct XcdBarrier {
    unsigned* bar; unsigned x;
    volatile LAS unsigned* st;
};

__device__ __forceinline__ XcdBarrier xcd_barrier_post(unsigned* bar, volatile LAS unsigned* st) {
    XcdBarrier b; b.bar = bar; b.x = xb_xcc_id(); b.st = st;
    if (threadIdx.x == 0) (void)xb_add(&bar[XB_XCNT(b.x)], 1u);
    return b;
}
__device__ __forceinline__ void xcd_barrier_complete(unsigned* bar, unsigned x, unsigned& nloc, unsigned& nx) {
    const unsigned G = gridDim.x * gridDim.y * gridDim.z;
    unsigned sum, cnt, mine, sp = 0u;
    for (;;) {
        sum = 0u; cnt = 0u; mine = 0u;
#pragma unroll
        for (unsigned j = 0; j < 16; ++j) { const unsigned c = xb_ld(&bar[XB_XCNT(j)]); sum += c; cnt += (c > 0u) ? 1u : 0u; mine = (j == x) ? c : mine; }
        if (sum == G) break;
        __builtin_amdgcn_s_sleep(1);
        if ((++sp & 255u) == 0u) { if (xb_ld(&bar[XB_TMO])) break; if (sp > XB_SPIN_CAP) { atomicAdd(&bar[XB_TMO], 1u); break; } }
    }
    nloc = mine > 0u ? mine : 1u; nx = cnt > 0u ? cnt : 1u;
}

__device__ __forceinline__ void xcd_barrier(const XcdBarrier& b) {
    asm volatile("s_waitcnt vmcnt(0)" ::: "memory");
    __syncthreads();
    if (threadIdx.x == 0) {
        unsigned* bar = b.bar;
        __builtin_amdgcn_s_waitcnt(0);
        unsigned nloc = b.st[0], nx = b.st[1];
        if (nloc == 0u) { xcd_barrier_complete(bar, b.x, nloc, nx); b.st[0] = nloc; b.st[1] = nx; }
        const unsigned old = xb_add(&bar[XB_XSUB(b.x)], 1u);
        const unsigned gen = old / nloc;
        if (old + 1u == (gen + 1u) * nloc) {
            __builtin_amdgcn_fence(__ATOMIC_RELEASE, "agent");
            asm volatile("s_waitcnt vmcnt(0)" ::: "memory");
            const unsigned og = xb_add(&bar[XB_TOP], 1u);
            const unsigned tg = og / nx;
            if (og + 1u == (tg + 1u) * nx) xb_add(&bar[XB_TOPGEN], 1u);
            else XB_SPIN(xb_ld(&bar[XB_TOPGEN]) == tg, bar);
            __builtin_amdgcn_fence(__ATOMIC_ACQUIRE, "agent");
            xb_add(&bar[XB_XGEN(b.x)], 1u);
            asm volatile("s_waitcnt vmcnt(0)" ::: "memory");
        } else {
            XB_SPIN(xb_ld(&bar[XB_XGEN(b.x)]) == gen, bar);
            __builtin_amdgcn_fence(__ATOMIC_ACQUIRE, "agent");
            asm volatile("s_waitcnt vmcnt(0)" ::: "memory");
        }
    }
    __syncthreads();
}
struct Frame {
    LAS unsigned char* lds;
    volatile LAS unsigned* MISC;
    gu32* ctl;
    int tid, lane, wave;
    int vcu, G;
    unsigned char* ws;
};

__device__ __forceinline__ void tr_item(const float* W, size_t ldw, int k0, int c0, bf16* WT, size_t ldt, int drow0, LAS float* scr, int lane) {
    const int kr = lane >> 4, cq = lane & 15;
    f32x4 v[16];
#pragma unroll
    for (int i = 0; i < 16; ++i) v[i] = *(const GAS f32x4*)(W + (size_t)(k0 + 4 * i + kr) * ldw + c0 + 4 * cq);
#pragma unroll
    for (int i = 0; i < 16; ++i)
#pragma unroll
        for (int j = 0; j < 4; ++j) scr[(4 * cq + j) * 65 + 4 * i + kr] = v[i][j];
    LDS_WAIT(); asm volatile("" ::: "memory");
    const int c = lane & 7;
#pragma unroll
    for (int jj = 0; jj < 8; ++jj) { const int n = (lane >> 3) + 8 * jj; const LAS float* s = scr + n * 65 + 8 * c;
        v4u o; o.x = pk2(s[0], s[1]); o.y = pk2(s[2], s[3]); o.z = pk2(s[4], s[5]); o.w = pk2(s[6], s[7]);
        *(GAS v4u*)(WT + (size_t)(drow0 + n) * ldt + k0 + 8 * c) = o; }
    LDS_WAIT(); asm volatile("" ::: "memory");
}

struct In {
    const float *x, *w_in, *rel_bias, *shift_mu, *w0, *w_up, *a0, *a_up, *g_up, *k_k, *k_a, *r_k, *lnx_w, *lnx_b, *proj_a, *proj_b, *w_out,
                *ln1_w, *ln1_b, *w_router, *b_router, *w_gu, *b_gu, *w_down, *b_down, *ln2_w, *ln2_b;
};

__device__ __forceinline__ void p0_prologue(Frame& F, const In& I) {
    LAS float* scr = (LAS float*)(F.lds + F.wave * 16640);
    const int gw = F.vcu * NWAVES + F.wave, NGW = F.G * NWAVES;
    unsigned char* ws = F.ws;
    constexpr int J0 = 32 * 167, J1 = 16 * 32, J2 = 16 * 32, J3 = 32 * 32, J4 = 32 * 32 * 64, J5 = 32 * 32 * 32;
    constexpr int NITEMS = J0 + J1 + J2 + J3 + J4 + J5;
    for (int it = gw; it < NITEMS; it += NGW) {
        int r = it;
        if (r < J0) { const int kb = r / 167, cb = r % 167, c0 = cb * 64; bf16* dst; int drow;
            if (c0 < 2048) { dst = (bf16*)(ws + WS_WINT); drow = c0; }
            else if (c0 < 3072) { dst = (bf16*)(ws + WS_WVT); drow = c0 - 2048; }
            else if (c0 < 6592) { dst = (bf16*)(ws + WS_WINT); drow = PJ_SEG + (c0 - 3072); }
            else { dst = (bf16*)(ws + WS_WINT); drow = PJ_GA + (c0 - 6592); }
            tr_item(I.w_in, D_IN, kb * 64, c0, dst, D, drow, scr, F.lane); continue; } r -= J0;
        if (r < J1) { const int kb = r / 32, cb = r % 32; tr_item(I.proj_a, D, kb * 64, cb * 64, (bf16*)(ws + WS_PAT), AW, cb * 64, scr, F.lane); continue; } r -= J1;
        if (r < J2) { const int kb = r / 32, cb = r % 32; tr_item(I.proj_b, D, kb * 64, cb * 64, (bf16*)(ws + WS_PBT), RW, cb * 64, scr, F.lane); continue; } r -= J2;
        if (r < J3) { const int kb = r / 32, cb = r % 32; tr_item(I.w_out, D, kb * 64, cb * 64, (bf16*)(ws + WS_WOT), D, cb * 64, scr, F.lane); continue; } r -= J3;
        if (r < J4) { const int e = r / 2048, q = r % 2048, kb = q / 64, cb = q % 64, c0 = cb * 64;
            const int cc = c0 & 2047, drow = (cc >> 7) * 256 + (c0 >= 2048 ? 128 : 0) + (cc & 127);
            tr_item(I.w_gu + (size_t)e * D * 2 * FF, 2 * FF, kb * 64, c0, (bf16*)(ws + WS_WGUT) + (size_t)e * 2 * FF * D, D, drow, scr, F.lane); continue; } r -= J4;
        { const int e = r / 1024, q = r % 1024, kb = q / 32, cb = q % 32;
            tr_item(I.w_down + (size_t)e * FF * D, D, kb * 64, cb * 64, (bf16*)(ws + WS_WDNT) + (size_t)e * D * FF, FF, cb * 64, scr, F.lane); }
    }
    const int gt = F.vcu * (NWAVES * 64) + F.tid, NGT = F.G * NWAVES * 64;
    for (int i = gt; i < 2048 * 256; i += NGT) { const int n = i >> 8, k = i & 255; float v = 0.f;
        if (n < 1024) { if (k < DLORA) v = I.w_up[(size_t)k * RW + n]; }
        else { if (k >= 128 && k < 128 + ALORA) v = I.a_up[(size_t)(k - 128) * RW + (n - 1024)]; }
        ((bf16*)(ws + WS_WLA))[i] = (bf16)f2bf(v); }
    for (int i = gt; i < 1024 * 256; i += NGT) { const int n = i >> 8, k = i & 255; ((bf16*)(ws + WS_WLG))[i] = (bf16)f2bf(I.g_up[(size_t)k * RW + n]); }
    for (int i = gt; i < 64 * D / 8; i += NGT) ((GAS v4u*)((bf16*)(ws + WS_WINT) + (size_t)(PJ_SEG + SHIFT_W) * D))[i] = (v4u){0u, 0u, 0u, 0u};
    for (int i = gt; i < RROWS; i += NGT) ((int*)(ws + WS_ROWSLOT))[i] = -1;
    for (size_t i = gt; i < (size_t)T * D / 8; i += NGT) { const f32x4 a = ((const GAS f32x4*)I.x)[2 * i], b = ((const GAS f32x4*)I.x)[2 * i + 1];
        v4u o; o.x = pk2(a.x, a.y); o.y = pk2(a.z, a.w); o.z = pk2(b.x, b.y); o.w = pk2(b.z, b.w); ((GAS v4u*)(ws + WS_XB16))[i] = o; }
}

constexpr int P8_HS = 0, P8_PITCH = 2052, P8_PART = 131328, P8_LOG = 147712, P8_HIST = 149760;
template <bool SKIP_MIX>
__device__ __forceinline__ void p8_ln_router(Frame& F, const In& I) {
    LAS float* hs = (LAS float*)(F.lds + P8_HS); LAS float* part = (LAS float*)(F.lds + P8_PART); LAS float* lg = (LAS float*)(F.lds + P8_LOG); LAS int* hist = (LAS int*)(F.lds + P8_HIST);
    const int lane = F.lane, w = F.wave;
    if (F.tid < 32) hist[F.tid] = 0;
    const int kq = lane >> 4, col = lane & 15;
    float ln_w[32], ln_b[32];
#pragma unroll
    for (int j = 0; j < 8; ++j) { const f32x4 a = *(const GAS f32x4*)(I.ln1_w + 4 * lane + 256 * j), b = *(const GAS f32x4*)(I.ln1_b + 4 * lane + 256 * j);
#pragma unroll
        for (int e = 0; e < 4; ++e) { ln_w[4 * j + e] = a[e]; ln_b[4 * j + e] = b[e]; } }
    __syncthreads();
    const float* zsrc = SKIP_MIX ? I.x : (const float*)(F.ws + WS_Z);
    for (int g = F.vcu; g < T / 16; g += F.G) {
        const int tok0 = g * 16;
#pragma unroll 1
        for (int tt = 0; tt < 2; ++tt) {
            const int tl = 2 * w + tt; const size_t tok = (size_t)(tok0 + tl);
            const GAS f32x4* zr = (const GAS f32x4*)(zsrc + tok * D) + lane;
            f32x4 v[8]; float s = 0.f;
#pragma unroll
            for (int j = 0; j < 8; ++j) { v[j] = zr[64 * j]; if (SKIP_MIX) v[j] = v[j] * DN_ALPHA; s += (v[j].x + v[j].y) + (v[j].z + v[j].w); }
            const float mean = wave_sum(s) * (1.f / D); float s2 = 0.f;
#pragma unroll
            for (int j = 0; j < 8; ++j) { v[j] = v[j] - mean; s2 += (v[j].x * v[j].x + v[j].y * v[j].y) + (v[j].z * v[j].z + v[j].w * v[j].w); }
            const float rstd = 1.f / sqrtf(wave_sum(s2) * (1.f / D) + LN_EPS);
            GAS f32x4* h1 = (GAS f32x4*)((float*)(F.ws + WS_H1) + tok * D) + lane;
            GAS v2u* h1b = (GAS v2u*)((bf16*)(F.ws + WS_H1B) + tok * D) + lane;
#pragma unroll
            for (int j = 0; j < 8; ++j) { f32x4 h;
#pragma unroll
                for (int e = 0; e < 4; ++e) h[e] = v[j][e] * rstd * ln_w[4 * j + e] + ln_b[4 * j + e];
                h1[64 * j] = h; h1b[64 * j] = (v2u){pk2(h.x, h.y), pk2(h.z, h.w)};
                *(LAS f32x4*)(hs + tl * P8_PITCH + 4 * lane + 256 * j) = h; }
        }
        __syncthreads();
        f32x4 c0 = (f32x4){0.f, 0.f, 0.f, 0.f}, c1 = c0;
        const LAS float* ap = hs + col * P8_PITCH + 256 * w + 4 * kq;
        const float* bp = I.w_router + (size_t)(256 * w + 4 * kq) * NE + col;
#pragma unroll 4
        for (int kk = 0; kk < 16; ++kk) {
            const f32x4 a = *(const LAS f32x4*)(ap + 16 * kk);
#pragma unroll
            for (int e = 0; e < 4; ++e) {
                const float b0 = bp[(size_t)(16 * kk + e) * NE], b1 = bp[(size_t)(16 * kk + e) * NE + 16];
                c0 = __builtin_amdgcn_mfma_f32_16x16x4f32(a[e], b0, c0, 0, 0, 0);
                c1 = __builtin_amdgcn_mfma_f32_16x16x4f32(a[e], b1, c1, 0, 0, 0);
            }
        }
#pragma unroll
        for (int i = 0; i < 4; ++i) { part[(w * 16 + 4 * kq + i) * 32 + col] = c0[i]; part[(w * 16 + 4 * kq + i) * 32 + 16 + col] = c1[i]; }
        __syncthreads();
        { const int tl = F.tid >> 5, e = F.tid & 31; float s = I.b_router[e];
#pragma unroll
            for (int ww = 0; ww < 8; ++ww) s += part[(ww * 16 + tl) * 32 + e];
            lg[tl * 32 + e] = s; }
        __syncthreads();
        if (F.tid < 16) {
            const int tl = F.tid; float lv[32];
#pragma unroll
            for (int e = 0; e < 32; ++e) lv[e] = lg[tl * 32 + e];
            int ti[4]; float tv[4];
#pragma unroll
            for (int k = 0; k < 4; ++k) { float best = -3.4e38f; int bi = 0;
#pragma unroll
                for (int e = 0; e < 32; ++e) { const bool tk = lv[e] > best; best = tk ? lv[e] : best; bi = tk ? e : bi; }
                ti[k] = bi; tv[k] = best;
#pragma unroll
                for (int e = 0; e < 32; ++e) lv[e] = (e == bi) ? -3.4e38f : lv[e]; }
            float ex[4], sum = 0.f;
#pragma unroll
            for (int k = 0; k < 4; ++k) { ex[k] = __expf(tv[k] - tv[0]); sum += ex[k]; }
            const float inv = 1.f / sum;
            *(GAS v4u*)((int*)(F.ws + WS_TOPI) + (size_t)(tok0 + tl) * 4) = (v4u){(unsigned)ti[0], (unsigned)ti[1], (unsigned)ti[2], (unsigned)ti[3]};
            *(GAS f32x4*)((float*)(F.ws + WS_GATE) + (size_t)(tok0 + tl) * 4) = (f32x4){ex[0] * inv, ex[1] * inv, ex[2] * inv, ex[3] * inv};
#pragma unroll
            for (int k = 0; k < 4; ++k) __hip_atomic_fetch_add(&hist[ti[k]], 1, __ATOMIC_RELAXED, __HIP_MEMORY_SCOPE_WORKGROUP);
        }
        __syncthreads();
    }
    if (F.tid < 32) { const int c = hist[F.tid]; if (c) __hip_atomic_fetch_add(F.ctl + CW_CNT + F.tid, (unsigned)c, RLX_AGENT); }
}

template <bool SKIP_MOE>
__device__ __forceinline__ void p12_final(Frame& F, const In& I, float* out) {
    const int lane = F.lane; const int gw = F.vcu * NWAVES + F.wave, NGW = F.G * NWAVES;
    float ln_w[32], ln_b[32];
#pragma unroll
    for (int j = 0; j < 8; ++j) { const f32x4 a = *(const GAS f32x4*)(I.ln2_w + 4 * lane + 256 * j), b = *(const GAS f32x4*)(I.ln2_b + 4 * lane + 256 * j);
#pragma unroll
        for (int e = 0; e < 4; ++e) { ln_w[4 * j + e] = a[e]; ln_b[4 * j + e] = b[e]; } }
    for (int tok = gw; tok < T; tok += NGW) {
        const GAS f32x4* hr = (const GAS f32x4*)((const float*)(F.ws + WS_H1) + (size_t)tok * D) + lane;
        f32x4 v[8]; float s = 0.f;
#pragma unroll
        for (int j = 0; j < 8; ++j) v[j] = hr[64 * j] * DN_ALPHA;
        if (!SKIP_MOE) {
#pragma unroll
            for (int k = 0; k < 4; ++k) { const GAS v2u* yr = (const GAS v2u*)((const bf16*)(F.ws + WS_YSLOT) + ((size_t)tok * 4 + k) * D) + lane;
#pragma unroll
                for (int j = 0; j < 8; ++j) { const v2u y = yr[64 * j]; v[j].x += bflo(y.x); v[j].y += bfhi(y.x); v[j].z += bflo(y.y); v[j].w += bfhi(y.y); } }
        }
#pragma unroll
        for (int j = 0; j < 8; ++j) s += (v[j].x + v[j].y) + (v[j].z + v[j].w);
        const float mean = wave_sum(s) * (1.f / D); float s2 = 0.f;
#pragma unroll
        for (int j = 0; j < 8; ++j) { v[j] = v[j] - mean; s2 += (v[j].x * v[j].x + v[j].y * v[j].y) + (v[j].z * v[j].z + v[j].w * v[j].w); }
        const float rstd = 1.f / sqrtf(wave_sum(s2) * (1.f / D) + LN_EPS);
        GAS f32x4* o = (GAS f32x4*)(out + (size_t)tok * D) + lane;
#pragma unroll
        for (int j = 0; j < 8; ++j) { f32x4 h;
#pragma unroll
            for (int e = 0; e < 4; ++e) h[e] = v[j][e] * rstd * ln_w[4 * j + e] + ln_b[4 * j + e];
            o[64 * j] = h; }
    }
}
__device__ __forceinline__ void moe_tables(Frame& F) {
    LAS int* tab = (LAS int*)(F.lds + TAB_OFF);
    if (F.tid == 0) { int run = 0;
        for (int e = 0; e < NE; ++e) { const int c = (int)__hip_atomic_load(F.ctl + CW_CNT + e, RLX_AGENT); const int p = (c + 255) / 256 * 256; tab[32 + e] = run; run += p; tab[e] = run; }
        tab[64] = run / 256; }
    __syncthreads();
}

__device__ __forceinline__ void p9_scatter(Frame& F, const In& I) {
    moe_tables(F);
    LAS int* tab = (LAS int*)(F.lds + TAB_OFF);
    LAS int* lh = (LAS int*)(F.lds + 0);
    LAS int* lb = (LAS int*)(F.lds + 128);
    LAS int* dst = (LAS int*)(F.lds + 256);
    const int* topi = (const int*)(F.ws + WS_TOPI); const float* gate = (const float*)(F.ws + WS_GATE);
    for (int ch = F.vcu; ch < T / 128; ch += F.G) {
        if (F.tid < 32) lh[F.tid] = 0;
        __syncthreads();
        const int s = ch * 512 + F.tid; const int e = topi[s]; const float gv = gate[s];
        const int rank = __hip_atomic_fetch_add(&lh[e], 1, __ATOMIC_RELAXED, __HIP_MEMORY_SCOPE_WORKGROUP);
        __syncthreads();
        if (F.tid < 32) { const int c = lh[F.tid]; lb[F.tid] = c ? (int)__hip_atomic_fetch_add(F.ctl + CW_CUR + F.tid, (unsigned)c, RLX_AGENT) : 0; }
        __syncthreads();
        const int d = tab[32 + e] + lb[e] + rank;
        ((int*)(F.ws + WS_ROWSLOT))[d] = s; ((float*)(F.ws + WS_ROWW))[d] = gv; dst[F.tid] = d;
        __syncthreads();
        for (int i = F.wave; i < 512; i += NWAVES) {
            const int tok = ch * 128 + (i >> 2); const int dd = dst[i];
            const GAS v4u* src = (const GAS v4u*)((const bf16*)(F.ws + WS_H1B) + (size_t)tok * D) + F.lane;
            GAS v4u* o = (GAS v4u*)((bf16*)(F.ws + WS_XG) + (size_t)dd * D) + F.lane;
            v4u v[4];
#pragma unroll
            for (int j = 0; j < 4; ++j) v[j] = src[64 * j];
#pragma unroll
            for (int j = 0; j < 4; ++j) o[64 * j] = v[j];
        }
        __syncthreads();
    }
}

__device__ __forceinline__ void p10_moe_up(Frame& F, const In& I) {
    moe_tables(F);
    LAS int* tab = (LAS int*)(F.lds + TAB_OFF);
    pg8::SchedMoe S; S.t.init(tab[64], 16, F.G, (int)blockIdx.x);
    S.A = (const char*)(F.ws + WS_XG); S.B = (const char*)(F.ws + WS_WGUT); S.tsA = (size_t)256 * D * 2; S.tsB = (size_t)256 * D * 2; S.es = (size_t)2 * FF * D * 2; S.pad_end = tab;
    pg8::EpiSwiglu E{(bf16*)(F.ws + WS_ACT), I.b_gu};
    pg8::gemm_phase<pg8::EpiSwiglu, pg8::SchedMoe, true>(F.lds + RING_OFF, D, D, D, S, E);
}
__device__ __forceinline__ void p11_moe_down(Frame& F, const In& I) {
    moe_tables(F);
    LAS int* tab = (LAS int*)(F.lds + TAB_OFF);
    pg8::SchedMoe S; S.t.init(tab[64], 8, F.G, (int)blockIdx.x);
    S.A = (const char*)(F.ws + WS_ACT); S.B = (const char*)(F.ws + WS_WDNT); S.tsA = (size_t)256 * FF * 2; S.tsB = (size_t)256 * FF * 2; S.es = (size_t)D * FF * 2; S.pad_end = tab;
    pg8::EpiDown E{(bf16*)(F.ws + WS_YSLOT), I.b_down, (const int*)(F.ws + WS_ROWSLOT), (const float*)(F.ws + WS_ROWW)};
    pg8::gemm_phase<pg8::EpiDown, pg8::SchedMoe, true>(F.lds + RING_OFF, FF, FF, FF, S, E);
}

__device__ __forceinline__ void p1_proj(Frame& F, const In& I) {
    { pg8::SchedPlain S; S.t.init(T / 256, PROJ_LD / 256, F.G, (int)blockIdx.x);
      S.A = (const char*)(F.ws + WS_XB16); S.B = (const char*)(F.ws + WS_WINT); S.tsA = (size_t)256 * D * 2; S.tsB = (size_t)256 * D * 2;
      pg8::EpiProj E{(bf16*)(F.ws + WS_PROJ)};
      pg8::gemm_phase<pg8::EpiProj, pg8::SchedPlain, true>(F.lds + RING_OFF, D, D, D, S, E); }
    { pg8::SchedPlain S; S.t.init(AW / 256, T / 256, F.G, (int)blockIdx.x);
      S.A = (const char*)(F.ws + WS_WVT); S.B = (const char*)(F.ws + WS_XB16); S.tsA = (size_t)256 * D * 2; S.tsB = (size_t)256 * D * 2;
      pg8::EpiBf16 E{(bf16*)(F.ws + WS_VT), T};
      pg8::gemm_phase<pg8::EpiBf16, pg8::SchedPlain, true>(F.lds + RING_OFF, D, D, D, S, E); }
}

__device__ __forceinline__ float ftanh(float x) { return 2.0f * fsigmoid(2.0f * x) - 1.0f; }
__device__ __forceinline__ void p2_shift_attn(Frame& F, const In& I) {
    const int lane = F.lane; const int gw = F.vcu * NWAVES + F.wave, NGW = F.G * NWAVES;
    const bf16* PROJ = (const bf16*)(F.ws + WS_PROJ);
    for (int tok = gw; tok < T; tok += NGW) {
        const bool first = (tok % SEQ) == 0;
        const bf16* cur = PROJ + (size_t)tok * PROJ_LD + PJ_SEG; const bf16* prv = cur - PROJ_LD;
        bf16* rkv = (bf16*)(F.ws + WS_RKV) + (size_t)tok * (3 * RW); bf16* lin = (bf16*)(F.ws + WS_LORAIN) + (size_t)tok * LORA_LD;
#pragma unroll 1
        for (int it = 0; it < 7; ++it) { const int gi = it * 64 + lane; if (gi >= SHIFT_W / 8) break; const int c = gi * 8;
            const v4u cv = *(const GAS v4u*)(cur + c); v4u pv = (v4u){0u, 0u, 0u, 0u}; if (!first) pv = *(const GAS v4u*)(prv + c);
            const f32x4 m0 = *(const GAS f32x4*)(I.shift_mu + c), m1 = *(const GAS f32x4*)(I.shift_mu + c + 4);
            float v[8]; const unsigned cw[4] = {cv.x, cv.y, cv.z, cv.w}, pw[4] = {pv.x, pv.y, pv.z, pv.w};
#pragma unroll
            for (int j = 0; j < 4; ++j) { const float c0 = bflo(cw[j]), c1 = bfhi(cw[j]), p0 = bflo(pw[j]), p1 = bfhi(pw[j]); const float mu0 = (j < 2) ? m0[2 * j] : m1[2 * j - 4], mu1 = (j < 2) ? m0[2 * j + 1] : m1[2 * j - 3];
                v[2 * j] = c0 + (p0 - c0) * mu0; v[2 * j + 1] = c1 + (p1 - c1) * mu1; }
            bf16* dstp;
            if (c < 3 * RW) dstp = rkv + c;
            else if (c < 3 * RW + DLORA) { dstp = lin + (c - 3 * RW);
#pragma unroll
                for (int j = 0; j < 8; ++j) v[j] = ftanh(v[j]); }
            else if (c < 3 * RW + DLORA + ALORA) dstp = lin + 128 + (c - 3 * RW - DLORA);
            else { dstp = lin + 256 + (c - 3 * RW - DLORA - ALORA);
#pragma unroll
                for (int j = 0; j < 8; ++j) v[j] = fsigmoid(v[j]); }
            *(GAS v4u*)dstp = (v4u){pk2(v[0], v[1]), pk2(v[2], v[3]), pk2(v[4], v[5]), pk2(v[6], v[7])};
        }
        if (lane < 8) { const int c = (lane < 4) ? (DLORA + 8 * lane) : (128 + ALORA + 8 * (lane - 4)); *(GAS v4u*)(lin + c) = (v4u){0u, 0u, 0u, 0u}; }
    }
#if STAGE == 3
    { const int gt = F.vcu * (NWAVES * 64) + F.tid, NGT = F.G * NWAVES * 64;
      for (size_t i = gt; i < (size_t)T * RW / 8; i += NGT) ((GAS v4u*)(F.ws + WS_YB))[i] = (v4u){0u, 0u, 0u, 0u}; }
#endif
    LAS float* tbl = (LAS float*)(F.lds + 0);
    const bf16* VT = (const bf16*)(F.ws + WS_VT); bf16* YA = (bf16*)(F.ws + WS_YA);
    const int r = lane & 31, hh = lane >> 5;
    for (int grp = F.vcu; grp < BATCH * AH * 4; grp += F.G) {
        const int bh = grp >> 2, b = bh >> 4, h = bh & 15, qb0 = (grp & 3) * 64;
        __syncthreads();
        if (F.tid < REL_TABLE) tbl[F.tid] = I.rel_bias[h * REL_TABLE + F.tid];
        __syncthreads();
#pragma unroll 1
        for (int i8 = 0; i8 < 8; ++i8) {
            const int qb = qb0 + F.wave + 8 * i8, q0 = qb * 32, c = q0 >> 6;
            const size_t tokq = (size_t)b * SEQ + q0 + r;
            bf16x8 qf[4];
#pragma unroll
            for (int s = 0; s < 4; ++s) qf[s] = *(const GAS bf16x8*)(PROJ + tokq * PROJ_LD + PJ_Q + h * 64 + 16 * s + 8 * hh);
            f32x16 o0, o1;
#pragma unroll
            for (int i = 0; i < 16; ++i) { o0[i] = 0.f; o1[i] = 0.f; }
            float m_run = -1e30f, l_run = 0.f;
            const int kt0 = (c > LEFT ? c - LEFT : 0) * 2, kt1 = (c + 1) * 2;
#pragma unroll 1
            for (int kt = kt0; kt < kt1; ++kt) {
                const int kpos0 = kt * 32; const size_t tokk = (size_t)b * SEQ + kpos0 + r;
                bf16x8 kf[4];
#pragma unroll
                for (int s = 0; s < 4; ++s) kf[s] = *(const GAS bf16x8*)(PROJ + tokk * PROJ_LD + PJ_K + h * 64 + 16 * s + 8 * hh);
                bf16x4 vlo[2][2], vhi[2][2];
#pragma unroll
                for (int mt = 0; mt < 2; ++mt)
#pragma unroll
                    for (int s2 = 0; s2 < 2; ++s2) { const bf16* vr = VT + (size_t)(h * 64 + 32 * mt + r) * T + (size_t)b * SEQ + kpos0 + 16 * s2 + 4 * hh;
                        vlo[mt][s2] = *(const GAS bf16x4*)vr; vhi[mt][s2] = *(const GAS bf16x4*)(vr + 8); }
                f32x16 st;
#pragma unroll
                for (int i = 0; i < 16; ++i) st[i] = 0.f;
#pragma unroll
                for (int s = 0; s < 4; ++s) st = __builtin_amdgcn_mfma_f32_32x32x16_bf16(kf[s], qf[s], st, 0, 0, 0);
                const int dbase = (q0 + r) - (kpos0 + 4 * hh);
                float mx = -1e30f;
#pragma unroll
                for (int i = 0; i < 16; ++i) { int d = dbase - ((i & 3) + 8 * (i >> 2)); d = d < MAX_PAST ? d : MAX_PAST; st[i] += tbl[d + 63]; mx = fmaxf(mx, st[i]); }
                mx = fmaxf(mx, __shfl_xor(mx, 32));
                const float m_new = fmaxf(m_run, mx), alpha = __expf(m_run - m_new);
                float ls = 0.f;
#pragma unroll
                for (int i = 0; i < 16; ++i) { st[i] = __expf(st[i] - m_new); ls += st[i]; }
                l_run = l_run * alpha + ls; m_run = m_new;
#pragma unroll
                for (int i = 0; i < 16; ++i) { o0[i] *= alpha; o1[i] *= alpha; }
#pragma unroll
                for (int s2 = 0; s2 < 2; ++s2) {
                    v4u pw; pw.x = pk2(st[8 * s2 + 0], st[8 * s2 + 1]); pw.y = pk2(st[8 * s2 + 2], st[8 * s2 + 3]); pw.z = pk2(st[8 * s2 + 4], st[8 * s2 + 5]); pw.w = pk2(st[8 * s2 + 6], st[8 * s2 + 7]);
                    const bf16x8 pf = __builtin_bit_cast(bf16x8, pw);
                    bf16x8 va, vb;
#pragma unroll
                    for (int j = 0; j < 4; ++j) { va[j] = vlo[0][s2][j]; va[4 + j] = vhi[0][s2][j]; vb[j] = vlo[1][s2][j]; vb[4 + j] = vhi[1][s2][j]; }
                    o0 = __builtin_amdgcn_mfma_f32_32x32x16_bf16(va, pf, o0, 0, 0, 0);
                    o1 = __builtin_amdgcn_mfma_f32_32x32x16_bf16(vb, pf, o1, 0, 0, 0);
                }
            }
            const float inv = 1.0f / (l_run + __shfl_xor(l_run, 32));
            bf16* yo = YA + tokq * AW + h * 64 + 4 * hh;
#pragma unroll
            for (int g4 = 0; g4 < 4; ++g4) {
                *(GAS v2u*)(yo + 8 * g4) = (v2u){pk2(o0[4 * g4] * inv, o0[4 * g4 + 1] * inv), pk2(o0[4 * g4 + 2] * inv, o0[4 * g4 + 3] * inv)};
                *(GAS v2u*)(yo + 32 + 8 * g4) = (v2u){pk2(o1[4 * g4] * inv, o1[4 * g4 + 1] * inv), pk2(o1[4 * g4 + 2] * inv, o1[4 * g4 + 3] * inv)};
            }
        }
    }
}

__device__ __forceinline__ void p6_merged(Frame& F, const In& I) {
    pg8::SchedTwo S; S.t.init(T / 256, D / 256, F.G, (int)blockIdx.x);
    S.A0 = (const char*)(F.ws + WS_YA); S.A1 = (const char*)(F.ws + WS_YB); S.B0 = (const char*)(F.ws + WS_PAT); S.B1 = (const char*)(F.ws + WS_PBT);
    S.tsA = (size_t)256 * AW * 2; S.tsB = (size_t)256 * AW * 2;
    pg8::EpiMerged E{(const bf16*)(F.ws + WS_PROJ), (bf16*)(F.ws + WS_MERGED)};
    pg8::gemm_phase<pg8::EpiMerged, pg8::SchedTwo, true>(F.lds + RING_OFF, AW, AW, AW, S, E);
}
__device__ __forceinline__ void p7_mix(Frame& F, const In& I) {
    pg8::SchedPlain S; S.t.init(T / 256, D / 256, F.G, (int)blockIdx.x);
    S.A = (const char*)(F.ws + WS_MERGED); S.B = (const char*)(F.ws + WS_WOT); S.tsA = (size_t)256 * D * 2; S.tsB = (size_t)256 * D * 2;
    pg8::EpiZ E{I.x, (float*)(F.ws + WS_Z)};
    pg8::gemm_phase<pg8::EpiZ, pg8::SchedPlain, true>(F.lds + RING_OFF, D, D, D, S, E);
}

__device__ __forceinline__ void p3_lora(Frame& F, const In& I) {
    { pg8::SchedPlain S; S.t.init(T / 256, 4, F.G, (int)blockIdx.x);
      S.A = (const char*)(F.ws + WS_LORAIN); S.B = (const char*)(F.ws + WS_WLA); S.tsA = (size_t)256 * LORA_LD * 2; S.tsB = (size_t)256 * 256 * 2;
      pg8::EpiLoraA<true> E{(float*)(F.ws + WS_DECAY), I.w0};
      pg8::gemm_phase<pg8::EpiLoraA<true>, pg8::SchedPlain, true>(F.lds + RING_OFF, LORA_LD, 256, 256, S, E); }
    { pg8::SchedPlain S; S.t.init(T / 256, 4, F.G, (int)blockIdx.x);
      S.A = (const char*)(F.ws + WS_LORAIN); S.B = (const char*)(F.ws + WS_WLA) + (size_t)1024 * 256 * 2; S.tsA = (size_t)256 * LORA_LD * 2; S.tsB = (size_t)256 * 256 * 2;
      pg8::EpiLoraA<false> E{(float*)(F.ws + WS_ICLR), I.a0};
      pg8::gemm_phase<pg8::EpiLoraA<false>, pg8::SchedPlain, true>(F.lds + RING_OFF, LORA_LD, 256, 256, S, E); }
    { pg8::SchedPlain S; S.t.init(T / 256, 4, F.G, (int)blockIdx.x);
      S.A = (const char*)(F.ws + WS_LORAIN) + 512; S.B = (const char*)(F.ws + WS_WLG); S.tsA = (size_t)256 * LORA_LD * 2; S.tsB = (size_t)256 * 256 * 2;
      pg8::EpiBf16 E{(bf16*)(F.ws + WS_G), RW};
      pg8::gemm_phase<pg8::EpiBf16, pg8::SchedPlain, true>(F.lds + RING_OFF, LORA_LD, 256, 256, S, E); }
}

__device__ __forceinline__ float dpp_f(float x, const int ctrl_sel) {
    const int xi = __builtin_bit_cast(int, x); int r;
    if (ctrl_sel == 0) r = __builtin_amdgcn_update_dpp(0, xi, 0xB1, 0xF, 0xF, false);
    else if (ctrl_sel == 1) r = __builtin_amdgcn_update_dpp(0, xi, 0x4E, 0xF, 0xF, false);
    else if (ctrl_sel == 2) r = __builtin_amdgcn_update_dpp(0, xi, 0x124, 0xF, 0xF, false);
    else r = __builtin_amdgcn_update_dpp(0, xi, 0x128, 0xF, 0xF, false);
    return __builtin_bit_cast(float, r);
}
__device__ __forceinline__ float rowsum16(float x) { x += dpp_f(x, 0); x += dpp_f(x, 1); x += dpp_f(x, 2); x += dpp_f(x, 3); return x; }
__device__ __forceinline__ float quadsum(float x) { x += dpp_f(x, 0); x += dpp_f(x, 1); return x; }
constexpr int SC_TC = 32, SC_ARR = SC_TC * 64, SC_BUF = 5 * SC_ARR;
constexpr int SC_V_OFF = 2 * SC_BUF, SC_Y_OFF = SC_V_OFF + 2 * SC_TC * 16;
#define SC_BAR() do { asm volatile("s_waitcnt lgkmcnt(0)" ::: "memory"); __builtin_amdgcn_s_barrier(); asm volatile("" ::: "memory"); } while (0)
__device__ __forceinline__ void p4_scan(Frame& F, const In& I) {
    LAS float* L = (LAS float*)(F.lds + 0);
    const int lane = F.lane;
    const bf16* RKV = (const bf16*)(F.ws + WS_RKV); const float* DEC = (const float*)(F.ws + WS_DECAY); const float* ICL = (const float*)(F.ws + WS_ICLR);
    float* YS = (float*)(F.ws + WS_YSCAN);
    constexpr int NCH = SEQ / SC_TC;
    for (int unit = F.vcu; unit < BATCH * RH * 4; unit += F.G) {
        const int bh = unit >> 2, rq = unit & 3, b = bh >> 4, h = bh & 15;
        const size_t tok_base = (size_t)b * SEQ;
        __syncthreads();
        if (F.wave >= 4) {
            const int lw = F.wave - 4; const int hc = h * 64 + lane;
            const float kkp = I.k_k[hc], kap = I.k_a[hc];
            unsigned short rr_[8], kk_[8], vv_[8]; float dc_[8], ic_[8];
#define SC_LOAD(ch) do { _Pragma("unroll") for (int i = 0; i < 8; ++i) { const size_t tok = tok_base + (size_t)(ch) * SC_TC + lw + 4 * i; \
                rr_[i] = RKV[tok * (3 * RW) + hc]; kk_[i] = RKV[tok * (3 * RW) + RW + hc]; vv_[i] = RKV[tok * (3 * RW) + 2 * RW + h * 64 + rq * 16 + (lane & 15)]; \
                dc_[i] = DEC[tok * RW + hc]; ic_[i] = ICL[tok * RW + hc]; } } while (0)
#define SC_WRITE(ch) do { LAS float* B_ = L + ((ch) & 1) * SC_BUF; LAS float* V_ = L + SC_V_OFF + ((ch) & 1) * (SC_TC * 16); \
            _Pragma("unroll") for (int i = 0; i < 8; ++i) { const int s = lw + 4 * i; const float rr = bf2f(rr_[i]), k0 = bf2f(kk_[i]), ic = ic_[i]; \
                const float kkv = k0 * kkp; const float n2 = wave_sum(kkv * kkv); const float kkn = kkv / fmaxf(sqrtf(n2), 1e-12f); \
                B_[0 * SC_ARR + s * 64 + lane] = rr; B_[1 * SC_ARR + s * 64 + lane] = dc_[i]; B_[2 * SC_ARR + s * 64 + lane] = k0 * (1.0f + (ic - 1.0f) * kap); \
                B_[3 * SC_ARR + s * 64 + lane] = -kkn; B_[4 * SC_ARR + s * 64 + lane] = kkn * ic; if (lane < 16) V_[s * 16 + lane] = bf2f(vv_[i]); } } while (0)
#define SC_FLUSH(ch) do { const LAS float* Y_ = L + SC_Y_OFF + ((ch) & 1) * (SC_TC * 16); const int lt = lw * 64 + lane; \
            _Pragma("unroll") for (int i = 0; i < 2; ++i) { const int idx = lt + 256 * i, s = idx >> 4, j = idx & 15; \
                YS[(tok_base + (size_t)(ch) * SC_TC + s) * RW + h * 64 + rq * 16 + j] = Y_[idx]; } } while (0)
            SC_LOAD(0); SC_WRITE(0); SC_LOAD(1);
            SC_BAR();
#pragma unroll 1
            for (int ch = 0; ch < NCH; ++ch) {
                if (ch + 1 < NCH) SC_WRITE(ch + 1);
                if (ch + 2 < NCH) SC_LOAD(ch + 2);
                if (ch >= 1) SC_FLUSH(ch - 1);
                SC_BAR();
            }
            SC_FLUSH(NCH - 1);
#undef SC_LOAD
#undef SC_WRITE
#undef SC_FLUSH
        } else {
            const int cw = F.wave, kq = lane & 15, row = 4 * cw + (lane >> 4);
            f32x4 S = (f32x4){0.f, 0.f, 0.f, 0.f};
            SC_BAR();
#pragma unroll 1
            for (int ch = 0; ch < NCH; ++ch) {
                const LAS float* B_ = L + (ch & 1) * SC_BUF + 4 * kq; const LAS float* V_ = L + SC_V_OFF + (ch & 1) * (SC_TC * 16) + row; LAS float* Y_ = L + SC_Y_OFF + (ch & 1) * (SC_TC * 16) + row;
#pragma unroll 4
                for (int s = 0; s < SC_TC; ++s) {
                    const f32x4 r4 = *(const LAS f32x4*)(B_ + 0 * SC_ARR + s * 64), w4 = *(const LAS f32x4*)(B_ + 1 * SC_ARR + s * 64), k4 = *(const LAS f32x4*)(B_ + 2 * SC_ARR + s * 64);
                    const f32x4 a4 = *(const LAS f32x4*)(B_ + 3 * SC_ARR + s * 64), b4 = *(const LAS f32x4*)(B_ + 4 * SC_ARR + s * 64);
                    const float vv = V_[s * 16];
                    float sa = (S.x * a4.x + S.y * a4.y) + (S.z * a4.z + S.w * a4.w);
                    sa = rowsum16(sa);
                    S = S * w4 + (b4 * sa + k4 * vv);
                    float y = (S.x * r4.x + S.y * r4.y) + (S.z * r4.z + S.w * r4.w);
                    y = rowsum16(y);
                    if (kq == 0) Y_[s * 16] = y;
                }
                SC_BAR();
            }
        }
    }
}

__device__ __forceinline__ void p5_post(Frame& F, const In& I) {
    const int lane = F.lane; const int gw = F.vcu * NWAVES + F.wave, NGW = F.G * NWAVES;
    const bf16* RKV = (const bf16*)(F.ws + WS_RKV); const float* ICL = (const float*)(F.ws + WS_ICLR); const float* YS = (const float*)(F.ws + WS_YSCAN);
    const bf16* G = (const bf16*)(F.ws + WS_G); bf16* YB = (bf16*)(F.ws + WS_YB);
    const int c0 = lane * 16;
    for (int tok = gw; tok < T; tok += NGW) {
        float y[16], rr[16], kk[16], vv[16], ic[16], gg[16];
#pragma unroll
        for (int q = 0; q < 4; ++q) { const f32x4 a = *(const GAS f32x4*)(YS + (size_t)tok * RW + c0 + 4 * q), c = *(const GAS f32x4*)(ICL + (size_t)tok * RW + c0 + 4 * q);
#pragma unroll
            for (int e = 0; e < 4; ++e) { y[4 * q + e] = a[e]; ic[4 * q + e] = c[e]; } }
#pragma unroll
        for (int q = 0; q < 2; ++q) {
            const v4u a = *(const GAS v4u*)(RKV + (size_t)tok * (3 * RW) + c0 + 8 * q), bb = *(const GAS v4u*)(RKV + (size_t)tok * (3 * RW) + RW + c0 + 8 * q),
                      c = *(const GAS v4u*)(RKV + (size_t)tok * (3 * RW) + 2 * RW + c0 + 8 * q), d = *(const GAS v4u*)(G + (size_t)tok * RW + c0 + 8 * q);
            const unsigned aw[4] = {a.x, a.y, a.z, a.w}, bw[4] = {bb.x, bb.y, bb.z, bb.w}, cw[4] = {c.x, c.y, c.z, c.w}, dw[4] = {d.x, d.y, d.z, d.w};
#pragma unroll
            for (int e = 0; e < 4; ++e) { rr[8 * q + 2 * e] = bflo(aw[e]); rr[8 * q + 2 * e + 1] = bfhi(aw[e]); kk[8 * q + 2 * e] = bflo(bw[e]); kk[8 * q + 2 * e + 1] = bfhi(bw[e]);
                vv[8 * q + 2 * e] = bflo(cw[e]); vv[8 * q + 2 * e + 1] = bfhi(cw[e]); gg[8 * q + 2 * e] = bflo(dw[e]); gg[8 * q + 2 * e + 1] = bfhi(dw[e]); } }
        float s = 0.f, bs = 0.f;
#pragma unroll
        for (int e = 0; e < 16; ++e) { s += y[e]; const float kp = kk[e] * (1.0f + (ic[e] - 1.0f) * I.k_a[c0 + e]); bs += rr[e] * kp * I.r_k[c0 + e]; }
        s = quadsum(s); bs = quadsum(bs);
        const float mean = s * (1.f / 64.f); float s2 = 0.f;
#pragma unroll
        for (int e = 0; e < 16; ++e) { y[e] -= mean; s2 += y[e] * y[e]; }
        s2 = quadsum(s2);
        const float rstd = 1.f / sqrtf(s2 * (1.f / 64.f) + GN_EPS);
        float o[16];
#pragma unroll
        for (int e = 0; e < 16; ++e) o[e] = (y[e] * rstd * I.lnx_w[c0 + e] + I.lnx_b[c0 + e] + bs * vv[e]) * gg[e];
#pragma unroll
        for (int q = 0; q < 2; ++q) *(GAS v4u*)(YB + (size_t)tok * RW + c0 + 8 * q) = (v4u){pk2(o[8 * q], o[8 * q + 1]), pk2(o[8 * q + 2], o[8 * q + 3]), pk2(o[8 * q + 4], o[8 * q + 5]), pk2(o[8 * q + 6], o[8 * q + 7])};
    }
}
#ifndef STAGE
#define STAGE 4
#endif
struct Args { In in; float* out; unsigned char* ws; };
__global__ void __launch_bounds__(NWAVES * 64, 2) mk_fwd(Args args) {
    extern __shared__ __attribute__((aligned(16))) unsigned char lds[];
    Frame F;
    F.lds = (LAS unsigned char*)lds;
    F.MISC = (volatile LAS unsigned*)(F.lds + MISC_OFF);
    F.tid = threadIdx.x; F.lane = F.tid & 63; F.wave = __builtin_amdgcn_readfirstlane(F.tid >> 6);
    F.G = gridDim.x; { const int bx = blockIdx.x; F.vcu = (F.G % 8 == 0) ? (bx % 8) * (F.G / 8) + bx / 8 : bx; }
    F.ws = args.ws;
    F.ctl = (gu32*)(args.ws + WS_CTL);
    for (int u = F.tid; u < (LDS_BYTES - MISC_OFF) / 4; u += NWAVES * 64) ((LAS unsigned*)(F.lds + MISC_OFF))[u] = 0u;
    __syncthreads();
    XcdBarrier bar = xcd_barrier_post((unsigned*)(F.ctl + CW_BAR), F.MISC + 8);
    const In& I = args.in;
#define GRID_BAR() xcd_barrier(bar)

#if STAGE >= 2
    p0_prologue(F, I);
    GRID_BAR();
#endif
#if STAGE >= 3
    p1_proj(F, I);
    GRID_BAR();
    p2_shift_attn(F, I);
    GRID_BAR();
#if STAGE >= 4
    p3_lora(F, I);
    GRID_BAR();
    p4_scan(F, I);
    GRID_BAR();
    p5_post(F, I);
    GRID_BAR();
#endif
    p6_merged(F, I);
    GRID_BAR();
    p7_mix(F, I);
    GRID_BAR();
#endif
    p8_ln_router<(STAGE < 3)>(F, I);
    GRID_BAR();
#if STAGE >= 2
    p9_scatter(F, I);
    GRID_BAR();
    p10_moe_up(F, I);
    GRID_BAR();
    p11_moe_down(F, I);
    GRID_BAR();
#endif
    p12_final<(STAGE < 2)>(F, I, args.out);
}

extern "C" void kernel_launch(void* const* d_in, const int* in_sizes, int n_in, void* d_out, int out_size, void* d_ws, size_t ws_size, hipStream_t stream) {
    static int grid = 0;
    if (grid == 0) {
        if (n_in != 27 || in_sizes[0] != T * D || out_size != T * D || ws_size < WS_END) { fprintf(stderr, "kernel_launch: unexpected shapes (n_in %d, in0 %d, out %d, ws %zu)\n", n_in, n_in > 0 ? in_sizes[0] : -1, out_size, ws_size); grid = -1; return; }
        int dev = 0, cus = 0, per_cu = 0;
        if (hipGetDevice(&dev) != hipSuccess || hipDeviceGetAttribute(&cus, hipDeviceAttributeMultiprocessorCount, dev) != hipSuccess) { grid = -1; return; }
        if (hipFuncSetAttribute((const void*)mk_fwd, hipFuncAttributeMaxDynamicSharedMemorySize, LDS_BYTES) != hipSuccess) { fprintf(stderr, "kernel_launch: hipFuncSetAttribute failed\n"); grid = -1; return; }
        if (hipOccupancyMaxActiveBlocksPerMultiprocessor(&per_cu, (const void*)mk_fwd, NWAVES * 64, LDS_BYTES) != hipSuccess || per_cu < 1)
            fprintf(stderr, "kernel_launch: occupancy query reports %d\n", per_cu);
        (void)hipGetLastError();
        grid = cus;
    }
    if (grid < 0) return;
    if (hipMemsetAsync((char*)d_ws + WS_CTL, 0, CTL_ZERO_BYTES, stream) != hipSuccess) return;
    Args a{};
    const float** ip = (const float**)&a.in;
    for (int i = 0; i < 27; ++i) ip[i] = (const float*)d_in[i];
    a.out = (float*)d_out; a.ws = (unsigned char*)d_ws;
    hipLaunchKernelGGL(mk_fwd, dim3(grid), dim3(NWAVES * 64), LDS_BYTES, stream, a);
    const hipError_t le = hipPeekAtLastError();
    if (le != hipSuccess) fprintf(stderr, "kernel_launch: launch failed: %s\n", hipGetErrorName(le));
}
```

```cpp
#define STAGE 4
#include <hip/hip_runtime.h>
#include <cstdio>
#include <cstdint>

#define GAS __attribute__((address_space(1)))
#define LAS __attribute__((address_space(3)))
typedef unsigned short bf16;
typedef unsigned v4u __attribute__((ext_vector_type(4)));
typedef unsigned v2u __attribute__((ext_vector_type(2)));
typedef float f32x4 __attribute__((ext_vector_type(4)));
typedef float f32x2 __attribute__((ext_vector_type(2)));
typedef float f32x16 __attribute__((ext_vector_type(16)));
typedef short bf16x8 __attribute__((ext_vector_type(8)));
typedef short bf16x4 __attribute__((ext_vector_type(4)));
typedef GAS unsigned gu32;

constexpr int NWAVES = 8;
constexpr int BATCH = 4, SEQ = 8192, D = 2048, T = BATCH * SEQ;
constexpr int CHUNK = 64, LEFT = 8, AH = 16, AD = 64, AW = 1024;
constexpr int REL_TABLE = 320, MAX_PAST = 256;
constexpr int RH = 16, RN = 64, RW = 1024, DLORA = 96, ALORA = 96, GLORA = 256;
constexpr int SHIFT_W = 3 * RW + DLORA + ALORA + GLORA;
constexpr int D_IN = 3 * AW + SHIFT_W + 2 * D;
constexpr int NE = 32, TOPK = 4, FF = 2048;
constexpr int MSLOT = T * TOPK;
constexpr int NBLK_MAX = (MSLOT + NE * 255 + 255) / 256;
constexpr int RROWS = NBLK_MAX * 256;
constexpr float LN_EPS = 1e-5f, GN_EPS = 64e-5f;
constexpr float DN_ALPHA = 1.189207115002721f;
constexpr int PROJ_LD = 9728, PJ_Q = 0, PJ_K = 1024, PJ_SEG = 2048, SEG_PAD = 3584, PJ_GA = 5632, PJ_GB = 7680;
constexpr int LORA_LD = 512;

constexpr size_t MiB = 1u << 20;
constexpr size_t WS_CTL = 0, CTL_ZERO_BYTES = 1 * MiB;
constexpr size_t WS_TOPI = 2 * MiB;
constexpr size_t WS_GATE = 3 * MiB;
constexpr size_t WS_ROWSLOT = 4 * MiB;
constexpr size_t WS_ROWW = 5 * MiB;
constexpr size_t WS_WLA = 6 * MiB;
constexpr size_t WS_WLG = 7 * MiB;
constexpr size_t WS_PAT = 8 * MiB;
constexpr size_t WS_PBT = 12 * MiB;
constexpr size_t WS_WOT = 16 * MiB;
constexpr size_t WS_WVT = 24 * MiB;
constexpr size_t WS_WINT = 28 * MiB;
constexpr size_t WS_WGUT = 128 * MiB;
constexpr size_t WS_WDNT = 640 * MiB;
constexpr size_t WS_BASE0 = 1024 * MiB;
constexpr size_t WS_PROJ = WS_BASE0;
constexpr size_t WS_VT = WS_PROJ + 608 * MiB;
constexpr size_t WS_YA = WS_VT + 64 * MiB;
constexpr size_t WS_RKV = WS_YA + 64 * MiB;
constexpr size_t WS_LORAIN = WS_RKV + 192 * MiB;
constexpr size_t WS_DECAY = WS_LORAIN + 32 * MiB;
constexpr size_t WS_ICLR = WS_DECAY + 128 * MiB;
constexpr size_t WS_G = WS_ICLR + 128 * MiB;
constexpr size_t WS_YSCAN = WS_G + 64 * MiB;
constexpr size_t WS_YB = WS_YSCAN + 128 * MiB;
constexpr size_t WS_MERGED = WS_YB + 64 * MiB;
constexpr size_t WS_XB16 = WS_MERGED + 128 * MiB;
constexpr size_t WS_MIX_END = WS_XB16 + 128 * MiB;
constexpr size_t WS_Z = 2816 * MiB;
constexpr size_t WS_H1 = 3072 * MiB;
constexpr size_t WS_H1B = 3328 * MiB;
constexpr size_t WS_END = 3456 * MiB;
constexpr size_t WS_XG = WS_BASE0;
constexpr size_t WS_ACT = WS_BASE0 + 544 * MiB;
constexpr size_t WS_YSLOT = WS_BASE0 + 1088 * MiB;
static_assert(WS_MIX_END <= WS_Z && WS_YSLOT + 512 * MiB <= WS_Z, "ws map");
static_assert(WS_WINT + (size_t)PROJ_LD * D * 2 <= WS_WGUT, "ws map");

constexpr int CW_CNT = 512;
constexpr int CW_CUR = 576;
constexpr int CW_BAR = 4096;

constexpr int RING_OFF = 0, RING_BYTES = 131072;
constexpr int LDS_BYTES = 160 * 1024;
constexpr int MISC_OFF = LDS_BYTES - 512;
constexpr int TAB_OFF = LDS_BYTES - 1024;

#define RLX_AGENT __ATOMIC_RELAXED, __HIP_MEMORY_SCOPE_AGENT
#define LDS_WAIT() asm volatile("s_waitcnt lgkmcnt(0)" ::: "memory")
#define VM_WAIT() asm volatile("s_waitcnt vmcnt(0)" ::: "memory")
__device__ __forceinline__ unsigned f2bf(float f) { unsigned u = __builtin_bit_cast(unsigned, f); return (u + 0x7fffu + ((u >> 16) & 1u)) >> 16; }
__device__ __forceinline__ unsigned pk2(float lo, float hi) { return f2bf(lo) | (f2bf(hi) << 16); }
__device__ __forceinline__ float bf2f(unsigned short h) { return __builtin_bit_cast(float, (unsigned)h << 16); }
__device__ __forceinline__ float bflo(unsigned w) { return __builtin_bit_cast(float, w << 16); }
__device__ __forceinline__ float bfhi(unsigned w) { return __builtin_bit_cast(float, w & 0xffff0000u); }
__device__ __forceinline__ float fsigmoid(float x) { return __builtin_amdgcn_rcpf(1.0f + __expf(-x)); }
__device__ __forceinline__ float dpp_f(float x, const int ctrl_sel) {
    const int xi = __builtin_bit_cast(int, x); int r;
    if (ctrl_sel == 0) r = __builtin_amdgcn_update_dpp(0, xi, 0xB1, 0xF, 0xF, false);
    else if (ctrl_sel == 1) r = __builtin_amdgcn_update_dpp(0, xi, 0x4E, 0xF, 0xF, false);
    else if (ctrl_sel == 2) r = __builtin_amdgcn_update_dpp(0, xi, 0x124, 0xF, 0xF, false);
    else r = __builtin_amdgcn_update_dpp(0, xi, 0x128, 0xF, 0xF, false);
    return __builtin_bit_cast(float, r);
}
__device__ __forceinline__ float rowsum16(float x) { x += dpp_f(x, 0); x += dpp_f(x, 1); x += dpp_f(x, 2); x += dpp_f(x, 3); return x; }
__device__ __forceinline__ float quadsum(float x) { x += dpp_f(x, 0); x += dpp_f(x, 1); return x; }
__device__ __forceinline__ float wave_sum(float v) {
    v = rowsum16(v);
    const int vi = __builtin_bit_cast(int, v);
    const float s0 = __builtin_bit_cast(float, __builtin_amdgcn_readlane(vi, 0)), s1 = __builtin_bit_cast(float, __builtin_amdgcn_readlane(vi, 16));
    const float s2 = __builtin_bit_cast(float, __builtin_amdgcn_readlane(vi, 32)), s3 = __builtin_bit_cast(float, __builtin_amdgcn_readlane(vi, 48));
    return (s0 + s1) + (s2 + s3);
}
namespace pg8 {
#define PG8_LAS __attribute__((address_space(3)))
typedef unsigned short bf16_t;
typedef unsigned u32x4 __attribute__((ext_vector_type(4)));
constexpr int BM = 256, BK = 64, HALF = 128, HTB = HALF * BK * 2, STAGE_BYTES = 8 * HTB, NXCD = 8, WGM = 8;

__host__ __device__ __forceinline__ int lds_byte(int r, int c) { const int st = (r >> 4) * 2 + (c >> 5), rr = r & 15, cc = c & 31, ob = rr * 64 + cc * 2; return st * 1024 + (ob ^ (((ob >> 9) & 1) << 5)); }
__host__ __device__ __forceinline__ void stage_rc(int b, int& R, int& C) { const int st = b / 1024, sb = b % 1024, swz = sb ^ (((sb >> 9) & 1) << 5); R = (st >> 1) * 16 + swz / 64; C = (st & 1) * 32 + (swz % 64) / 2; }
__host__ __device__ __forceinline__ int perm32(int rho) { const int n = rho >> 4, i = rho & 15; return 8 * (i >> 2) + 4 * n + (i & 3); }

struct Unit { int pm, pn, aux; };

struct Tiler {
    int nM, nN, nwg, G, c;
    __device__ __forceinline__ void init(int nM_, int nN_, int G_, int c_) { nM = nM_; nN = nN_; nwg = nM * nN; G = G_; c = c_; }
    __device__ __forceinline__ bool map(int i, int& pm, int& pn) const {
        const long L = (long)i * G + c; if (L >= nwg) return false;
        int wgid = (int)L; { const int q = nwg / NXCD, r = nwg % NXCD, xcd = wgid % NXCD, off = wgid / NXCD; wgid = (xcd < r ? xcd * (q + 1) : r * (q + 1) + (xcd - r) * q) + off; }
        const int nig = WGM * nN, gid = wgid / nig, fm = gid * WGM, gsz = (nM - fm) < WGM ? (nM - fm) : WGM;
        pm = fm + ((wgid % nig) % gsz); pn = (wgid % nig) / gsz; return true;
    }
};
struct SchedPlain {
    Tiler t; const char* A; const char* B; size_t tsA, tsB;
    __device__ __forceinline__ bool next(int i, Unit& u) const { u.aux = 0; return t.map(i, u.pm, u.pn); }
    __device__ __forceinline__ void bases(const Unit& u, const char*& a, const char*& b) const { a = A + (size_t)u.pm * tsA; b = B + (size_t)u.pn * tsB; }
};
struct SchedTwo {
    Tiler t; const char* A0; const char* A1; const char* B0; const char* B1; size_t tsA, tsB;
    __device__ __forceinline__ bool next(int i, Unit& u) const { u.aux = i & 1; return t.map(i >> 1, u.pm, u.pn); }
    __device__ __forceinline__ void bases(const Unit& u, const char*& a, const char*& b) const { a = (u.aux ? A1 : A0) + (size_t)u.pm * tsA; b = (u.aux ? B1 : B0) + (size_t)u.pn * tsB; }
};
struct SchedMoe {
    Tiler t; const char* A; const char* B; size_t tsA, tsB, es; const PG8_LAS int* pad_end;
    __device__ __forceinline__ bool next(int i, Unit& u) const {
        if (!t.map(i, u.pm, u.pn)) return false;
        const int row0 = u.pm * BM; int e = 0;
#pragma unroll
        for (int j = 0; j < 32; ++j) e += (pad_end[j] <= row0) ? 1 : 0;
        u.aux = e < 31 ? e : 31; return true;
    }
    __device__ __forceinline__ void bases(const Unit& u, const char*& a, const char*& b) const { a = A + (size_t)u.pm * tsA; b = B + (size_t)u.aux * es + (size_t)u.pn * tsB; }
};

__device__ __forceinline__ unsigned cvt_pk_bf16(float lo, float hi) { unsigned r; asm volatile("v_cvt_pk_bf16_f32 %0, %1, %2" : "=v"(r) : "v"(lo), "v"(hi)); return r; }
__device__ __forceinline__ u32x4 pack8(const f32x4& v0, const f32x4& v1) { u32x4 w; w.x = cvt_pk_bf16(v0[0], v0[1]); w.y = cvt_pk_bf16(v0[2], v0[3]); w.z = cvt_pk_bf16(v1[0], v1[1]); w.w = cvt_pk_bf16(v1[2], v1[3]); return w; }

template <class Epi, class Sched, bool ALIGN_EPI>
__device__ __forceinline__ void gemm_phase(PG8_LAS unsigned char* lds, const int lda, const int ldb, const int K, const Sched& S, const Epi& E) {
    const int tid = threadIdx.x, wid = __builtin_amdgcn_readfirstlane(tid >> 6), lane = tid & 63, wr = wid >> 2, wc = wid & 3, fr = lane & 15, fq = lane >> 4;
    const int nt = K / BK;
    unsigned voffA[2], voffB[2];
#pragma unroll
    for (int i = 0; i < 2; ++i) { int R, C; stage_rc(tid * 16 + i * 8192, R, C); const int Rb = (R & ~31) + perm32(R & 31);
        voffA[i] = (unsigned)(R * lda + C) * 2u; voffB[i] = (unsigned)(Rb * ldb + C) * 2u; }
    const size_t kstep = (size_t)(BK * 2);
    const size_t hsA = (size_t)HALF * lda * 2, hsB = (size_t)HALF * ldb * 2;
    const unsigned ldsw = (unsigned)wid * 1024u;
    const int aoff = lds_byte(wr * 64 + fr, fq * 8), boff = lds_byte(wc * 32 + fr, fq * 8);
#define PG8_SA(b, h) (((b) * 2 + (h)) * HTB)
#define PG8_SB(b, h) ((4 + (b) * 2 + (h)) * HTB)
#define PG8_STAGE(bufoff, gbase, voff) do { _Pragma("unroll") for (int _i = 0; _i < 2; ++_i) \
        __builtin_amdgcn_global_load_lds((const unsigned*)((const char*)(gbase) + (voff)[_i]), (PG8_LAS unsigned*)(lds + (bufoff) + ldsw + _i * 8192), 16, 0, 0); } while (0)
#define PG8_LDA(dst, b, h) do { _Pragma("unroll") for (int m = 0; m < 4; ++m) _Pragma("unroll") for (int k = 0; k < 2; ++k) dst[m][k] = *(const PG8_LAS bf16x8*)(lds + PG8_SA(b, h) + aoff + m * 2048 + k * 1024); } while (0)
#define PG8_LDB(dst, b, h) do { _Pragma("unroll") for (int n = 0; n < 2; ++n) _Pragma("unroll") for (int k = 0; k < 2; ++k) dst[n][k] = *(const PG8_LAS bf16x8*)(lds + PG8_SB(b, h) + boff + n * 2048 + k * 1024); } while (0)
#define PG8_MMA(ai, bj, At, Bt) do { __builtin_amdgcn_s_setprio(1); _Pragma("unroll") for (int m = 0; m < 4; ++m) _Pragma("unroll") for (int n = 0; n < 2; ++n) _Pragma("unroll") for (int k = 0; k < 2; ++k) \
        acc[ai][bj][m][n] = __builtin_amdgcn_mfma_f32_16x16x32_bf16(Bt[n][k], At[m][k], acc[ai][bj][m][n], 0, 0, 0); __builtin_amdgcn_s_setprio(0); } while (0)
#define PG8_WAIT_V(n) asm volatile("s_waitcnt vmcnt(" #n ")" ::: "memory")
#define PG8_WAIT_L(n) asm volatile("s_waitcnt lgkmcnt(" #n ")" ::: "memory")
#define PG8_BAR __builtin_amdgcn_s_barrier()
#define PG8_SCHED __builtin_amdgcn_sched_barrier(0)
#define PG8_ZERO() do { _Pragma("unroll") for (int a = 0; a < 2; ++a) _Pragma("unroll") for (int b = 0; b < 2; ++b) _Pragma("unroll") for (int m = 0; m < 4; ++m) _Pragma("unroll") for (int n = 0; n < 2; ++n) acc[a][b][m][n] = (f32x4){0.f, 0.f, 0.f, 0.f}; } while (0)
    Unit cur, nxt; int ui = 0;
    if (!S.next(0, cur)) return;
    f32x4 acc[2][2][4][2];
    PG8_ZERO();
    bf16x8 At[4][2], B0[2][2], B1[2][2];
    const char* cA; const char* cB; S.bases(cur, cA, cB);
    PG8_STAGE(PG8_SB(0, 0), cB, voffB); PG8_STAGE(PG8_SB(0, 1), cB + hsB, voffB); PG8_STAGE(PG8_SA(0, 0), cA, voffA); PG8_STAGE(PG8_SA(0, 1), cA + hsA, voffA);
    if (wr == 1) PG8_BAR;
    PG8_WAIT_V(2); PG8_BAR;
    PG8_STAGE(PG8_SB(1, 0), cB + kstep, voffB); PG8_STAGE(PG8_SA(1, 0), cA + kstep, voffA); PG8_STAGE(PG8_SB(1, 1), cB + hsB + kstep, voffB);
    PG8_WAIT_V(6); PG8_BAR;
    for (;;) {
        const bool has_next = S.next(ui + 1, nxt);
        const char* nA = cA; const char* nB = cB; if (has_next) S.bases(nxt, nA, nB);
#pragma unroll 1
        for (int t = 0; t < nt; t += 2) {
            const bool last = (t == nt - 2);
            const char* a1 = cA + (size_t)(t + 1) * kstep;
            const char* a2 = last ? nA : cA + (size_t)(t + 2) * kstep; const char* b2 = last ? nB : cB + (size_t)(t + 2) * kstep;
            const char* a3 = a2 + kstep; const char* b3 = b2 + kstep;
            PG8_LDB(B0, 0, 0); PG8_LDB(B1, 0, 1); PG8_SCHED; PG8_LDA(At, 0, 0); PG8_STAGE(PG8_SA(1, 1), a1 + hsA, voffA);
            PG8_WAIT_V(8); PG8_WAIT_L(0); PG8_BAR; PG8_MMA(0, 0, At, B0); PG8_MMA(0, 1, At, B1); PG8_BAR; PG8_SCHED;
            PG8_LDA(At, 0, 1); PG8_STAGE(PG8_SB(0, 0), b2, voffB); PG8_STAGE(PG8_SB(0, 1), b2 + hsB, voffB); PG8_STAGE(PG8_SA(0, 0), a2, voffA);
            PG8_WAIT_V(8); PG8_WAIT_L(0); PG8_BAR; PG8_MMA(1, 0, At, B0); PG8_MMA(1, 1, At, B1); PG8_BAR; PG8_SCHED;
            PG8_LDB(B0, 1, 0); PG8_LDB(B1, 1, 1); PG8_SCHED; PG8_LDA(At, 1, 0); PG8_STAGE(PG8_SA(0, 1), a2 + hsA, voffA);
            PG8_WAIT_V(8); PG8_WAIT_L(0); PG8_BAR; PG8_MMA(0, 0, At, B0); PG8_MMA(0, 1, At, B1); PG8_BAR; PG8_SCHED;
            PG8_LDA(At, 1, 1); PG8_STAGE(PG8_SB(1, 0), b3, voffB); PG8_STAGE(PG8_SB(1, 1), b3 + hsB, voffB); PG8_STAGE(PG8_SA(1, 0), a3, voffA);
            PG8_WAIT_V(8); PG8_WAIT_L(0); PG8_BAR; PG8_MMA(1, 0, At, B0); PG8_MMA(1, 1, At, B1); PG8_BAR; PG8_SCHED;
        }
        if constexpr (ALIGN_EPI) { if (wr == 0) PG8_BAR; }
        const bool keep = E(acc, cur, wr, wc, fr, fq);
        if (!has_next) break;
        if (!keep) PG8_ZERO();
        cur = nxt; cA = nA; cB = nB; ++ui;
        if constexpr (ALIGN_EPI) { if (wr == 1) PG8_BAR; }
    }
    PG8_WAIT_V(0);
    if constexpr (!ALIGN_EPI) { if (wr == 0) PG8_BAR; }
    PG8_BAR;
#undef PG8_SA
#undef PG8_SB
#undef PG8_STAGE
#undef PG8_LDA
#undef PG8_LDB
#undef PG8_MMA
#undef PG8_WAIT_V
#undef PG8_WAIT_L
#undef PG8_BAR
#undef PG8_SCHED
#undef PG8_ZERO
}
}
namespace pg8 {
#define EPI_ROWLOOP _Pragma("unroll") for (int ai = 0; ai < 2; ++ai) _Pragma("unroll") for (int m = 0; m < 4; ++m)
struct EpiProj {
    bf16_t* O;
    __device__ __forceinline__ bool operator()(f32x4 (&acc)[2][2][4][2], const Unit& u, int wr, int wc, int fr, int fq) const {
        const int row0 = u.pm * BM + wr * 64 + fr, col0 = u.pn * BM + wc * 32 + 8 * fq;
        const int mode = (u.pn < 4) ? 1 : (u.pn >= 22 ? 2 : 0);
        EPI_ROWLOOP { bf16_t* rowp = O + (size_t)(row0 + ai * HALF + m * 16) * PROJ_LD + col0;
#pragma unroll
            for (int bj = 0; bj < 2; ++bj) { f32x4 v0 = acc[ai][bj][m][0], v1 = acc[ai][bj][m][1];
                if (mode == 1) { v0 = v0 * 0.125f; v1 = v1 * 0.125f; }
                else if (mode == 2) {
#pragma unroll
                    for (int j = 0; j < 4; ++j) { v0[j] = fsigmoid(v0[j]); v1[j] = fsigmoid(v1[j]); } }
                *(u32x4*)(rowp + bj * HALF) = pack8(v0, v1); } }
        return false;
    }
};
struct EpiBf16 {
    bf16_t* O; int ldc;
    __device__ __forceinline__ bool operator()(f32x4 (&acc)[2][2][4][2], const Unit& u, int wr, int wc, int fr, int fq) const {
        const int row0 = u.pm * BM + wr * 64 + fr, col0 = u.pn * BM + wc * 32 + 8 * fq;
        EPI_ROWLOOP { bf16_t* rowp = O + (size_t)(row0 + ai * HALF + m * 16) * ldc + col0;
#pragma unroll
            for (int bj = 0; bj < 2; ++bj) *(u32x4*)(rowp + bj * HALF) = pack8(acc[ai][bj][m][0], acc[ai][bj][m][1]); }
        return false;
    }
};
template <bool ISDEC> struct EpiLoraA {
    float* OUT; const float* par;
    __device__ __forceinline__ bool operator()(f32x4 (&acc)[2][2][4][2], const Unit& u, int wr, int wc, int fr, int fq) const {
        const int row0 = u.pm * BM + wr * 64 + fr, col0 = u.pn * BM + wc * 32 + 8 * fq;
        f32x4 pv[2][2];
#pragma unroll
        for (int bj = 0; bj < 2; ++bj)
#pragma unroll
            for (int n = 0; n < 2; ++n) pv[bj][n] = *(const f32x4*)(par + col0 + bj * HALF + 4 * n);
        EPI_ROWLOOP { float* rowp = OUT + (size_t)(row0 + ai * HALF + m * 16) * RW + col0;
#pragma unroll
            for (int bj = 0; bj < 2; ++bj)
#pragma unroll
                for (int n = 0; n < 2; ++n) { f32x4 v = acc[ai][bj][m][n] + pv[bj][n];
#pragma unroll
                    for (int j = 0; j < 4; ++j) {
                        if (ISDEC) { const float y = -v[j]; const float sp = fmaxf(y, 0.f) + __logf(1.0f + __expf(-fabsf(y))); const float w = -sp - 0.5f; v[j] = __expf(-__expf(w)); }
                        else v[j] = fsigmoid(v[j]); }
                    *(f32x4*)(rowp + bj * HALF + 4 * n) = v; } }
        return false;
    }
};
struct EpiMerged {
    const bf16_t* PROJ; bf16_t* O;
    __device__ __forceinline__ bool operator()(f32x4 (&acc)[2][2][4][2], const Unit& u, int wr, int wc, int fr, int fq) const {
        const int row0 = u.pm * BM + wr * 64 + fr, col0 = u.pn * BM + wc * 32 + 8 * fq;
        EPI_ROWLOOP { const int row = row0 + ai * HALF + m * 16; const bf16_t* gp = PROJ + (size_t)row * PROJ_LD + col0;
#pragma unroll
            for (int bj = 0; bj < 2; ++bj) {
                const u32x4 gb = *(const u32x4*)(gp + PJ_GB + bj * HALF);
                f32x4 b0 = (f32x4){bflo(gb.x), bfhi(gb.x), bflo(gb.y), bfhi(gb.y)}, b1 = (f32x4){bflo(gb.z), bfhi(gb.z), bflo(gb.w), bfhi(gb.w)};
                if (u.aux == 0) {
                    const u32x4 ga = *(const u32x4*)(gp + PJ_GA + bj * HALF);
                    f32x4 a0 = (f32x4){bflo(ga.x), bfhi(ga.x), bflo(ga.y), bfhi(ga.y)}, a1 = (f32x4){bflo(ga.z), bfhi(ga.z), bflo(ga.w), bfhi(ga.w)};
#pragma unroll
                    for (int j = 0; j < 4; ++j) { acc[ai][bj][m][0][j] *= a0[j] / fmaxf(b0[j], 1e-30f); acc[ai][bj][m][1][j] *= a1[j] / fmaxf(b1[j], 1e-30f); }
                } else {
                    *(u32x4*)(O + (size_t)row * D + col0 + bj * HALF) = pack8(acc[ai][bj][m][0] * b0, acc[ai][bj][m][1] * b1);
                } } }
        return u.aux == 0;
    }
};
struct EpiZ {
    const float* X; float* Z;
    __device__ __forceinline__ bool operator()(f32x4 (&acc)[2][2][4][2], const Unit& u, int wr, int wc, int fr, int fq) const {
        const int row0 = u.pm * BM + wr * 64 + fr, col0 = u.pn * BM + wc * 32 + 8 * fq;
        EPI_ROWLOOP { const size_t off = (size_t)(row0 + ai * HALF + m * 16) * D + col0;
#pragma unroll
            for (int bj = 0; bj < 2; ++bj)
#pragma unroll
                for (int n = 0; n < 2; ++n) { const f32x4 xv = *(const f32x4*)(X + off + bj * HALF + 4 * n); *(f32x4*)(Z + off + bj * HALF + 4 * n) = xv * DN_ALPHA + acc[ai][bj][m][n]; } }
        return false;
    }
};
struct EpiSwiglu {
    bf16_t* ACT; const float* bgu;
    __device__ __forceinline__ bool operator()(f32x4 (&acc)[2][2][4][2], const Unit& u, int wr, int wc, int fr, int fq) const {
        const int row0 = u.pm * BM + wr * 64 + fr, col0 = u.pn * HALF + wc * 32 + 8 * fq;
        const float* bp = bgu + (size_t)u.aux * (2 * FF) + col0;
        f32x4 bg[2], bu[2];
#pragma unroll
        for (int n = 0; n < 2; ++n) { bg[n] = *(const f32x4*)(bp + 4 * n); bu[n] = *(const f32x4*)(bp + FF + 4 * n); }
        EPI_ROWLOOP { f32x4 o[2];
#pragma unroll
            for (int n = 0; n < 2; ++n) { const f32x4 g = acc[ai][0][m][n] + bg[n], uu = acc[ai][1][m][n] + bu[n];
#pragma unroll
                for (int j = 0; j < 4; ++j) { const float gc = fminf(g[j], 7.0f), uc = fminf(fmaxf(uu[j], -7.0f), 7.0f); o[n][j] = (uc + 1.0f) * (gc * fsigmoid(1.702f * gc)); } }
            *(u32x4*)(ACT + (size_t)(row0 + ai * HALF + m * 16) * FF + col0) = pack8(o[0], o[1]); }
        return false;
    }
};
struct EpiDown {
    bf16_t* YS; const float* bdn; const int* rowslot; const float* roww;
    __device__ __forceinline__ bool operator()(f32x4 (&acc)[2][2][4][2], const Unit& u, int wr, int wc, int fr, int fq) const {
        const int row0 = u.pm * BM + wr * 64 + fr, col0 = u.pn * BM + wc * 32 + 8 * fq;
        const float* bp = bdn + (size_t)u.aux * D + col0;
        f32x4 bv[2][2];
#pragma unroll
        for (int bj = 0; bj < 2; ++bj)
#pragma unroll
            for (int n = 0; n < 2; ++n) bv[bj][n] = *(const f32x4*)(bp + bj * HALF + 4 * n);
        EPI_ROWLOOP { const int row = row0 + ai * HALF + m * 16; const int slot = rowslot[row]; const float w = roww[row];
            if (slot >= 0) { bf16_t* rowp = YS + (size_t)slot * D + col0;
#pragma unroll
                for (int bj = 0; bj < 2; ++bj) *(u32x4*)(rowp + bj * HALF) = pack8((acc[ai][bj][m][0] + bv[bj][0]) * w, (acc[ai][bj][m][1] + bv[bj][1]) * w); } }
        return false;
    }
};
#undef EPI_ROWLOOP
}

#define XB_TMO      128
#define XB_XCNT(j)  (256  + 64 * (j))
#define XB_XSUB(j)  (1280 + 64 * (j))
#define XB_XGEN(j)  (2304 + 64 * (j))
#define XB_TOP      3328
#define XB_TOPGEN   3392
#define XCD_BAR_WORDS 3456
#define XB_SPIN_CAP (1u << 18)

__device__ __forceinline__ unsigned xb_ld(unsigned* p)              { return __hip_atomic_load(p, __ATOMIC_RELAXED, __HIP_MEMORY_SCOPE_AGENT); }
__device__ __forceinline__ unsigned xb_add(unsigned* p, unsigned v) { return __hip_atomic_fetch_add(p, v, __ATOMIC_RELAXED, __HIP_MEMORY_SCOPE_AGENT); }
__device__ __forceinline__ unsigned xb_xcc_id() { return (unsigned)__builtin_amdgcn_s_getreg((3 << 11) | 20) & 0xFu; }
#define XB_SPIN(cond, bar) do { unsigned _sp = 0; while (cond) { __builtin_amdgcn_s_sleep(1); \
    if ((++_sp & 255u) == 0u) { if (xb_ld(&(bar)[XB_TMO])) break; if (_sp > XB_SPIN_CAP) { atomicAdd(&(bar)[XB_TMO], 1u); break; } } } } while (0)

struct XcdBarrier {
    unsigned* bar; unsigned x;
    volatile LAS unsigned* st;
};

__device__ __forceinline__ XcdBarrier xcd_barrier_post(unsigned* bar, volatile LAS unsigned* st) {
    XcdBarrier b; b.bar = bar; b.x = xb_xcc_id(); b.st = st;
    if (threadIdx.x == 0) (void)xb_add(&bar[XB_XCNT(b.x)], 1u);
    return b;
}
__device__ __forceinline__ void xcd_barrier_complete(unsigned* bar, unsigned x, unsigned& nloc, unsigned& nx) {
    const unsigned G = gridDim.x * gridDim.y * gridDim.z;
    unsigned sum, cnt, mine, sp = 0u;
    for (;;) {
        sum = 0u; cnt = 0u; mine = 0u;
#pragma unroll
        for (unsigned j = 0; j < 16; ++j) { const unsigned c = xb_ld(&bar[XB_XCNT(j)]); sum += c; cnt += (c > 0u) ? 1u : 0u; mine = (j == x) ? c : mine; }
        if (sum == G) break;
        __builtin_amdgcn_s_sleep(1);
        if ((++sp & 255u) == 0u) { if (xb_ld(&bar[XB_TMO])) break; if (sp > XB_SPIN_CAP) { atomicAdd(&bar[XB_TMO], 1u); break; } }
    }
    nloc = mine > 0u ? mine : 1u; nx = cnt > 0u ? cnt : 1u;
}

__device__ __forceinline__ void xcd_barrier(const XcdBarrier& b) {
    asm volatile("s_waitcnt vmcnt(0)" ::: "memory");
    __syncthreads();
    if (threadIdx.x == 0) {
        unsigned* bar = b.bar;
        __builtin_amdgcn_s_waitcnt(0);
        unsigned nloc = b.st[0], nx = b.st[1];
        if (nloc == 0u) { xcd_barrier_complete(bar, b.x, nloc, nx); b.st[0] = nloc; b.st[1] = nx; }
        const unsigned old = xb_add(&bar[XB_XSUB(b.x)], 1u);
        const unsigned gen = old / nloc;
        if (old + 1u == (gen + 1u) * nloc) {
            __builtin_amdgcn_fence(__ATOMIC_RELEASE, "agent");
            asm volatile("s_waitcnt vmcnt(0)" ::: "memory");
            const unsigned og = xb_add(&bar[XB_TOP], 1u);
            const unsigned tg = og / nx;
            if (og + 1u == (tg + 1u) * nx) xb_add(&bar[XB_TOPGEN], 1u);
            else XB_SPIN(xb_ld(&bar[XB_TOPGEN]) == tg, bar);
            __builtin_amdgcn_fence(__ATOMIC_ACQUIRE, "agent");
            xb_add(&bar[XB_XGEN(b.x)], 1u);
            asm volatile("s_waitcnt vmcnt(0)" ::: "memory");
        } else {
            XB_SPIN(xb_ld(&bar[XB_XGEN(b.x)]) == gen, bar);
            __builtin_amdgcn_fence(__ATOMIC_ACQUIRE, "agent");
            asm volatile("s_waitcnt vmcnt(0)" ::: "memory");
        }
    }
    __syncthreads();
}
struct Frame {
    LAS unsigned char* lds;
    volatile LAS unsigned* MISC;
    gu32* ctl;
    int tid, lane, wave;
    int vcu, G;
    unsigned char* ws;
};

__device__ __forceinline__ void tr_item(const float* W, size_t ldw, int k0, int c0, bf16* WT, size_t ldt, int drow0, LAS float* scr, int lane) {
    const int kr = lane >> 4, cq = lane & 15;
    f32x4 v[16];
#pragma unroll
    for (int i = 0; i < 16; ++i) v[i] = *(const GAS f32x4*)(W + (size_t)(k0 + 4 * i + kr) * ldw + c0 + 4 * cq);
#pragma unroll
    for (int i = 0; i < 16; ++i)
#pragma unroll
        for (int j = 0; j < 4; ++j) scr[(4 * cq + j) * 65 + 4 * i + kr] = v[i][j];
    LDS_WAIT(); asm volatile("" ::: "memory");
    const int c = lane & 7;
#pragma unroll
    for (int jj = 0; jj < 8; ++jj) { const int n = (lane >> 3) + 8 * jj; const LAS float* s = scr + n * 65 + 8 * c;
        v4u o; o.x = pk2(s[0], s[1]); o.y = pk2(s[2], s[3]); o.z = pk2(s[4], s[5]); o.w = pk2(s[6], s[7]);
        *(GAS v4u*)(WT + (size_t)(drow0 + n) * ldt + k0 + 8 * c) = o; }
    LDS_WAIT(); asm volatile("" ::: "memory");
}

struct In {
    const float *x, *w_in, *rel_bias, *shift_mu, *w0, *w_up, *a0, *a_up, *g_up, *k_k, *k_a, *r_k, *lnx_w, *lnx_b, *proj_a, *proj_b, *w_out,
                *ln1_w, *ln1_b, *w_router, *b_router, *w_gu, *b_gu, *w_down, *b_down, *ln2_w, *ln2_b;
};

__device__ __forceinline__ void p0_prologue(Frame& F, const In& I) {
    LAS float* scr = (LAS float*)(F.lds + F.wave * 16640);
    const int gw = F.vcu * NWAVES + F.wave, NGW = F.G * NWAVES;
    unsigned char* ws = F.ws;
    constexpr int J0 = 32 * 167, J1 = 16 * 32, J2 = 16 * 32, J3 = 32 * 32, J4 = 32 * 32 * 64, J5 = 32 * 32 * 32;
    constexpr int NITEMS = J0 + J1 + J2 + J3 + J4 + J5;
    for (int it = gw; it < NITEMS; it += NGW) {
        int r = it;
        if (r < J0) { const int kb = r / 167, cb = r % 167, c0 = cb * 64; bf16* dst; int drow;
            if (c0 < 2048) { dst = (bf16*)(ws + WS_WINT); drow = c0; }
            else if (c0 < 3072) { dst = (bf16*)(ws + WS_WVT); drow = c0 - 2048; }
            else if (c0 < 6592) { dst = (bf16*)(ws + WS_WINT); drow = PJ_SEG + (c0 - 3072); }
            else { dst = (bf16*)(ws + WS_WINT); drow = PJ_GA + (c0 - 6592); }
            tr_item(I.w_in, D_IN, kb * 64, c0, dst, D, drow, scr, F.lane); continue; } r -= J0;
        if (r < J1) { const int kb = r / 32, cb = r % 32; tr_item(I.proj_a, D, kb * 64, cb * 64, (bf16*)(ws + WS_PAT), AW, cb * 64, scr, F.lane); continue; } r -= J1;
        if (r < J2) { const int kb = r / 32, cb = r % 32; tr_item(I.proj_b, D, kb * 64, cb * 64, (bf16*)(ws + WS_PBT), RW, cb * 64, scr, F.lane); continue; } r -= J2;
        if (r < J3) { const int kb = r / 32, cb = r % 32; tr_item(I.w_out, D, kb * 64, cb * 64, (bf16*)(ws + WS_WOT), D, cb * 64, scr, F.lane); continue; } r -= J3;
        if (r < J4) { const int e = r / 2048, q = r % 2048, kb = q / 64, cb = q % 64, c0 = cb * 64;
            const int cc = c0 & 2047, drow = (cc >> 7) * 256 + (c0 >= 2048 ? 128 : 0) + (cc & 127);
            tr_item(I.w_gu + (size_t)e * D * 2 * FF, 2 * FF, kb * 64, c0, (bf16*)(ws + WS_WGUT) + (size_t)e * 2 * FF * D, D, drow, scr, F.lane); continue; } r -= J4;
        { const int e = r / 1024, q = r % 1024, kb = q / 32, cb = q % 32;
            tr_item(I.w_down + (size_t)e * FF * D, D, kb * 64, cb * 64, (bf16*)(ws + WS_WDNT) + (size_t)e * D * FF, FF, cb * 64, scr, F.lane); }
    }
    const int gt = F.vcu * (NWAVES * 64) + F.tid, NGT = F.G * NWAVES * 64;
    for (int i = gt; i < 2048 * 256; i += NGT) { const int n = i >> 8, k = i & 255; float v = 0.f;
        if (n < 1024) { if (k < DLORA) v = I.w_up[(size_t)k * RW + n]; }
        else { if (k >= 128 && k < 128 + ALORA) v = I.a_up[(size_t)(k - 128) * RW + (n - 1024)]; }
        ((bf16*)(ws + WS_WLA))[i] = (bf16)f2bf(v); }
    for (int i = gt; i < 1024 * 256; i += NGT) { const int n = i >> 8, k = i & 255; ((bf16*)(ws + WS_WLG))[i] = (bf16)f2bf(I.g_up[(size_t)k * RW + n]); }
    for (int i = gt; i < 64 * D / 8; i += NGT) ((GAS v4u*)((bf16*)(ws + WS_WINT) + (size_t)(PJ_SEG + SHIFT_W) * D))[i] = (v4u){0u, 0u, 0u, 0u};
    for (int i = gt; i < RROWS; i += NGT) ((int*)(ws + WS_ROWSLOT))[i] = -1;
    for (size_t i = gt; i < (size_t)T * D / 8; i += NGT) { const f32x4 a = ((const GAS f32x4*)I.x)[2 * i], b = ((const GAS f32x4*)I.x)[2 * i + 1];
        v4u o; o.x = pk2(a.x, a.y); o.y = pk2(a.z, a.w); o.z = pk2(b.x, b.y); o.w = pk2(b.z, b.w); ((GAS v4u*)(ws + WS_XB16))[i] = o; }
}

constexpr int P8_HS = 0, P8_PITCH = 2052, P8_PART = 131328, P8_LOG = 147712, P8_HIST = 149760;
template <bool SKIP_MIX>
__device__ __forceinline__ void p8_ln_router(Frame& F, const In& I) {
    LAS float* hs = (LAS float*)(F.lds + P8_HS); LAS float* part = (LAS float*)(F.lds + P8_PART); LAS float* lg = (LAS float*)(F.lds + P8_LOG); LAS int* hist = (LAS int*)(F.lds + P8_HIST);
    const int lane = F.lane, w = F.wave;
    if (F.tid < 32) hist[F.tid] = 0;
    const int kq = lane >> 4, col = lane & 15;
    float ln_w[32], ln_b[32];
#pragma unroll
    for (int j = 0; j < 8; ++j) { const f32x4 a = *(const GAS f32x4*)(I.ln1_w + 4 * lane + 256 * j), b = *(const GAS f32x4*)(I.ln1_b + 4 * lane + 256 * j);
#pragma unroll
        for (int e = 0; e < 4; ++e) { ln_w[4 * j + e] = a[e]; ln_b[4 * j + e] = b[e]; } }
    __syncthreads();
    const float* zsrc = SKIP_MIX ? I.x : (const float*)(F.ws + WS_Z);
    for (int g = F.vcu; g < T / 16; g += F.G) {
        const int tok0 = g * 16;
#pragma unroll 1
        for (int tt = 0; tt < 2; ++tt) {
            const int tl = 2 * w + tt; const size_t tok = (size_t)(tok0 + tl);
            const GAS f32x4* zr = (const GAS f32x4*)(zsrc + tok * D) + lane;
            f32x4 v[8]; float s = 0.f;
#pragma unroll
            for (int j = 0; j < 8; ++j) { v[j] = zr[64 * j]; if (SKIP_MIX) v[j] = v[j] * DN_ALPHA; s += (v[j].x + v[j].y) + (v[j].z + v[j].w); }
            const float mean = wave_sum(s) * (1.f / D); float s2 = 0.f;
#pragma unroll
            for (int j = 0; j < 8; ++j) { v[j] = v[j] - mean; s2 += (v[j].x * v[j].x + v[j].y * v[j].y) + (v[j].z * v[j].z + v[j].w * v[j].w); }
            const float rstd = 1.f / sqrtf(wave_sum(s2) * (1.f / D) + LN_EPS);
            GAS f32x4* h1 = (GAS f32x4*)((float*)(F.ws + WS_H1) + tok * D) + lane;
            GAS v2u* h1b = (GAS v2u*)((bf16*)(F.ws + WS_H1B) + tok * D) + lane;
#pragma unroll
            for (int j = 0; j < 8; ++j) { f32x4 h;
#pragma unroll
                for (int e = 0; e < 4; ++e) h[e] = v[j][e] * rstd * ln_w[4 * j + e] + ln_b[4 * j + e];
                h1[64 * j] = h; h1b[64 * j] = (v2u){pk2(h.x, h.y), pk2(h.z, h.w)};
                *(LAS f32x4*)(hs + tl * P8_PITCH + 4 * lane + 256 * j) = h; }
        }
        __syncthreads();
        f32x4 c0 = (f32x4){0.f, 0.f, 0.f, 0.f}, c1 = c0;
        const LAS float* ap = hs + col * P8_PITCH + 256 * w + 4 * kq;
        const float* bp = I.w_router + (size_t)(256 * w + 4 * kq) * NE + col;
#pragma unroll 4
        for (int kk = 0; kk < 16; ++kk) {
            const f32x4 a = *(const LAS f32x4*)(ap + 16 * kk);
#pragma unroll
            for (int e = 0; e < 4; ++e) {
                const float b0 = bp[(size_t)(16 * kk + e) * NE], b1 = bp[(size_t)(16 * kk + e) * NE + 16];
                c0 = __builtin_amdgcn_mfma_f32_16x16x4f32(a[e], b0, c0, 0, 0, 0);
                c1 = __builtin_amdgcn_mfma_f32_16x16x4f32(a[e], b1, c1, 0, 0, 0);
            }
        }
#pragma unroll
        for (int i = 0; i < 4; ++i) { part[(w * 16 + 4 * kq + i) * 32 + col] = c0[i]; part[(w * 16 + 4 * kq + i) * 32 + 16 + col] = c1[i]; }
        __syncthreads();
        { const int tl = F.tid >> 5, e = F.tid & 31; float s = I.b_router[e];
#pragma unroll
            for (int ww = 0; ww < 8; ++ww) s += part[(ww * 16 + tl) * 32 + e];
            lg[tl * 32 + e] = s; }
        __syncthreads();
        if (F.tid < 16) {
            const int tl = F.tid; float lv[32];
#pragma unroll
            for (int e = 0; e < 32; ++e) lv[e] = lg[tl * 32 + e];
            int ti[4]; float tv[4];
#pragma unroll
            for (int k = 0; k < 4; ++k) { float best = -3.4e38f; int bi = 0;
#pragma unroll
                for (int e = 0; e < 32; ++e) { const bool tk = lv[e] > best; best = tk ? lv[e] : best; bi = tk ? e : bi; }
                ti[k] = bi; tv[k] = best;
#pragma unroll
                for (int e = 0; e < 32; ++e) lv[e] = (e == bi) ? -3.4e38f : lv[e]; }
            float ex[4], sum = 0.f;
#pragma unroll
            for (int k = 0; k < 4; ++k) { ex[k] = __expf(tv[k] - tv[0]); sum += ex[k]; }
            const float inv = 1.f / sum;
            *(GAS v4u*)((int*)(F.ws + WS_TOPI) + (size_t)(tok0 + tl) * 4) = (v4u){(unsigned)ti[0], (unsigned)ti[1], (unsigned)ti[2], (unsigned)ti[3]};
            *(GAS f32x4*)((float*)(F.ws + WS_GATE) + (size_t)(tok0 + tl) * 4) = (f32x4){ex[0] * inv, ex[1] * inv, ex[2] * inv, ex[3] * inv};
#pragma unroll
            for (int k = 0; k < 4; ++k) __hip_atomic_fetch_add(&hist[ti[k]], 1, __ATOMIC_RELAXED, __HIP_MEMORY_SCOPE_WORKGROUP);
        }
        __syncthreads();
    }
    if (F.tid < 32) { const int c = hist[F.tid]; if (c) __hip_atomic_fetch_add(F.ctl + CW_CNT + F.tid, (unsigned)c, RLX_AGENT); }
}

template <bool SKIP_MOE>
__device__ __forceinline__ void p12_final(Frame& F, const In& I, float* out) {
    const int lane = F.lane; const int gw = F.vcu * NWAVES + F.wave, NGW = F.G * NWAVES;
    float ln_w[32], ln_b[32];
#pragma unroll
    for (int j = 0; j < 8; ++j) { const f32x4 a = *(const GAS f32x4*)(I.ln2_w + 4 * lane + 256 * j), b = *(const GAS f32x4*)(I.ln2_b + 4 * lane + 256 * j);
#pragma unroll
        for (int e = 0; e < 4; ++e) { ln_w[4 * j + e] = a[e]; ln_b[4 * j + e] = b[e]; } }
    for (int tok = gw; tok < T; tok += NGW) {
        const GAS f32x4* hr = (const GAS f32x4*)((const float*)(F.ws + WS_H1) + (size_t)tok * D) + lane;
        f32x4 v[8]; float s = 0.f;
#pragma unroll
        for (int j = 0; j < 8; ++j) v[j] = hr[64 * j] * DN_ALPHA;
        if (!SKIP_MOE) {
#pragma unroll
            for (int k = 0; k < 4; ++k) { const GAS v2u* yr = (const GAS v2u*)((const bf16*)(F.ws + WS_YSLOT) + ((size_t)tok * 4 + k) * D) + lane;
#pragma unroll
                for (int j = 0; j < 8; ++j) { const v2u y = yr[64 * j]; v[j].x += bflo(y.x); v[j].y += bfhi(y.x); v[j].z += bflo(y.y); v[j].w += bfhi(y.y); } }
        }
#pragma unroll
        for (int j = 0; j < 8; ++j) s += (v[j].x + v[j].y) + (v[j].z + v[j].w);
        const float mean = wave_sum(s) * (1.f / D); float s2 = 0.f;
#pragma unroll
        for (int j = 0; j < 8; ++j) { v[j] = v[j] - mean; s2 += (v[j].x * v[j].x + v[j].y * v[j].y) + (v[j].z * v[j].z + v[j].w * v[j].w); }
        const float rstd = 1.f / sqrtf(wave_sum(s2) * (1.f / D) + LN_EPS);
        GAS f32x4* o = (GAS f32x4*)(out + (size_t)tok * D) + lane;
#pragma unroll
        for (int j = 0; j < 8; ++j) { f32x4 h;
#pragma unroll
            for (int e = 0; e < 4; ++e) h[e] = v[j][e] * rstd * ln_w[4 * j + e] + ln_b[4 * j + e];
            o[64 * j] = h; }
    }
}
__device__ __forceinline__ void moe_tables(Frame& F) {
    LAS int* tab = (LAS int*)(F.lds + TAB_OFF);
    if (F.tid == 0) { int run = 0;
        for (int e = 0; e < NE; ++e) { const int c = (int)__hip_atomic_load(F.ctl + CW_CNT + e, RLX_AGENT); const int p = (c + 255) / 256 * 256; tab[32 + e] = run; run += p; tab[e] = run; }
        tab[64] = run / 256; }
    __syncthreads();
}

__device__ __forceinline__ void p9_scatter(Frame& F, const In& I) {
    moe_tables(F);
    LAS int* tab = (LAS int*)(F.lds + TAB_OFF);
    LAS int* lh = (LAS int*)(F.lds + 0);
    LAS int* lb = (LAS int*)(F.lds + 128);
    LAS int* dst = (LAS int*)(F.lds + 256);
    const int* topi = (const int*)(F.ws + WS_TOPI); const float* gate = (const float*)(F.ws + WS_GATE);
    for (int ch = F.vcu; ch < T / 128; ch += F.G) {
        if (F.tid < 32) lh[F.tid] = 0;
        __syncthreads();
        const int s = ch * 512 + F.tid; const int e = topi[s]; const float gv = gate[s];
        const int rank = __hip_atomic_fetch_add(&lh[e], 1, __ATOMIC_RELAXED, __HIP_MEMORY_SCOPE_WORKGROUP);
        __syncthreads();
        if (F.tid < 32) { const int c = lh[F.tid]; lb[F.tid] = c ? (int)__hip_atomic_fetch_add(F.ctl + CW_CUR + F.tid, (unsigned)c, RLX_AGENT) : 0; }
        __syncthreads();
        const int d = tab[32 + e] + lb[e] + rank;
        ((int*)(F.ws + WS_ROWSLOT))[d] = s; ((float*)(F.ws + WS_ROWW))[d] = gv; dst[F.tid] = d;
        __syncthreads();
        for (int i = F.wave; i < 512; i += NWAVES) {
            const int tok = ch * 128 + (i >> 2); const int dd = dst[i];
            const GAS v4u* src = (const GAS v4u*)((const bf16*)(F.ws + WS_H1B) + (size_t)tok * D) + F.lane;
            GAS v4u* o = (GAS v4u*)((bf16*)(F.ws + WS_XG) + (size_t)dd * D) + F.lane;
            v4u v[4];
#pragma unroll
            for (int j = 0; j < 4; ++j) v[j] = src[64 * j];
#pragma unroll
            for (int j = 0; j < 4; ++j) o[64 * j] = v[j];
        }
        __syncthreads();
    }
}

__device__ __forceinline__ void p10_moe_up(Frame& F, const In& I) {
    moe_tables(F);
    LAS int* tab = (LAS int*)(F.lds + TAB_OFF);
    pg8::SchedMoe S; S.t.init(tab[64], 16, F.G, (int)blockIdx.x);
    S.A = (const char*)(F.ws + WS_XG); S.B = (const char*)(F.ws + WS_WGUT); S.tsA = (size_t)256 * D * 2; S.tsB = (size_t)256 * D * 2; S.es = (size_t)2 * FF * D * 2; S.pad_end = tab;
    pg8::EpiSwiglu E{(bf16*)(F.ws + WS_ACT), I.b_gu};
    pg8::gemm_phase<pg8::EpiSwiglu, pg8::SchedMoe, true>(F.lds + RING_OFF, D, D, D, S, E);
}
__device__ __forceinline__ void p11_moe_down(Frame& F, const In& I) {
    moe_tables(F);
    LAS int* tab = (LAS int*)(F.lds + TAB_OFF);
    pg8::SchedMoe S; S.t.init(tab[64], 8, F.G, (int)blockIdx.x);
    S.A = (const char*)(F.ws + WS_ACT); S.B = (const char*)(F.ws + WS_WDNT); S.tsA = (size_t)256 * FF * 2; S.tsB = (size_t)256 * FF * 2; S.es = (size_t)D * FF * 2; S.pad_end = tab;
    pg8::EpiDown E{(bf16*)(F.ws + WS_YSLOT), I.b_down, (const int*)(F.ws + WS_ROWSLOT), (const float*)(F.ws + WS_ROWW)};
    pg8::gemm_phase<pg8::EpiDown, pg8::SchedMoe, true>(F.lds + RING_OFF, FF, FF, FF, S, E);
}

__device__ __forceinline__ void p1_proj(Frame& F, const In& I) {
    { pg8::SchedPlain S; S.t.init(T / 256, PROJ_LD / 256, F.G, (int)blockIdx.x);
      S.A = (const char*)(F.ws + WS_XB16); S.B = (const char*)(F.ws + WS_WINT); S.tsA = (size_t)256 * D * 2; S.tsB = (size_t)256 * D * 2;
      pg8::EpiProj E{(bf16*)(F.ws + WS_PROJ)};
      pg8::gemm_phase<pg8::EpiProj, pg8::SchedPlain, true>(F.lds + RING_OFF, D, D, D, S, E); }
    { pg8::SchedPlain S; S.t.init(AW / 256, T / 256, F.G, (int)blockIdx.x);
      S.A = (const char*)(F.ws + WS_WVT); S.B = (const char*)(F.ws + WS_XB16); S.tsA = (size_t)256 * D * 2; S.tsB = (size_t)256 * D * 2;
      pg8::EpiBf16 E{(bf16*)(F.ws + WS_VT), T};
      pg8::gemm_phase<pg8::EpiBf16, pg8::SchedPlain, true>(F.lds + RING_OFF, D, D, D, S, E); }
}

__device__ __forceinline__ float ftanh(float x) { return 2.0f * fsigmoid(2.0f * x) - 1.0f; }
__device__ __forceinline__ void p2_shift_attn(Frame& F, const In& I) {
    const int lane = F.lane; const int gw = F.vcu * NWAVES + F.wave, NGW = F.G * NWAVES;
    const bf16* PROJ = (const bf16*)(F.ws + WS_PROJ);
    for (int tok = gw; tok < T; tok += NGW) {
        const bool first = (tok % SEQ) == 0;
        const bf16* cur = PROJ + (size_t)tok * PROJ_LD + PJ_SEG; const bf16* prv = cur - PROJ_LD;
        bf16* rkv = (bf16*)(F.ws + WS_RKV) + (size_t)tok * (3 * RW); bf16* lin = (bf16*)(F.ws + WS_LORAIN) + (size_t)tok * LORA_LD;
#pragma unroll 1
        for (int it = 0; it < 7; ++it) { const int gi = it * 64 + lane; if (gi >= SHIFT_W / 8) break; const int c = gi * 8;
            const v4u cv = *(const GAS v4u*)(cur + c); v4u pv = (v4u){0u, 0u, 0u, 0u}; if (!first) pv = *(const GAS v4u*)(prv + c);
            const f32x4 m0 = *(const GAS f32x4*)(I.shift_mu + c), m1 = *(const GAS f32x4*)(I.shift_mu + c + 4);
            float v[8]; const unsigned cw[4] = {cv.x, cv.y, cv.z, cv.w}, pw[4] = {pv.x, pv.y, pv.z, pv.w};
#pragma unroll
            for (int j = 0; j < 4; ++j) { const float c0 = bflo(cw[j]), c1 = bfhi(cw[j]), p0 = bflo(pw[j]), p1 = bfhi(pw[j]); const float mu0 = (j < 2) ? m0[2 * j] : m1[2 * j - 4], mu1 = (j < 2) ? m0[2 * j + 1] : m1[2 * j - 3];
                v[2 * j] = c0 + (p0 - c0) * mu0; v[2 * j + 1] = c1 + (p1 - c1) * mu1; }
            bf16* dstp;
            if (c < 3 * RW) dstp = rkv + c;
            else if (c < 3 * RW + DLORA) { dstp = lin + (c - 3 * RW);
#pragma unroll
                for (int j = 0; j < 8; ++j) v[j] = ftanh(v[j]); }
            else if (c < 3 * RW + DLORA + ALORA) dstp = lin + 128 + (c - 3 * RW - DLORA);
            else { dstp = lin + 256 + (c - 3 * RW - DLORA - ALORA);
#pragma unroll
                for (int j = 0; j < 8; ++j) v[j] = fsigmoid(v[j]); }
            *(GAS v4u*)dstp = (v4u){pk2(v[0], v[1]), pk2(v[2], v[3]), pk2(v[4], v[5]), pk2(v[6], v[7])};
        }
        if (lane < 8) { const int c = (lane < 4) ? (DLORA + 8 * lane) : (128 + ALORA + 8 * (lane - 4)); *(GAS v4u*)(lin + c) = (v4u){0u, 0u, 0u, 0u}; }
    }
#if STAGE == 3
    { const int gt = F.vcu * (NWAVES * 64) + F.tid, NGT = F.G * NWAVES * 64;
      for (size_t i = gt; i < (size_t)T * RW / 8; i += NGT) ((GAS v4u*)(F.ws + WS_YB))[i] = (v4u){0u, 0u, 0u, 0u}; }
#endif
    LAS float* tbl = (LAS float*)(F.lds + 0);
    const bf16* VT = (const bf16*)(F.ws + WS_VT); bf16* YA = (bf16*)(F.ws + WS_YA);
    const int r = lane & 31, hh = lane >> 5;
    for (int grp = F.vcu; grp < BATCH * AH * 4; grp += F.G) {
        const int bh = grp >> 2, b = bh >> 4, h = bh & 15, qb0 = (grp & 3) * 64;
        __syncthreads();
        if (F.tid < REL_TABLE) tbl[F.tid] = I.rel_bias[h * REL_TABLE + F.tid];
        __syncthreads();
#pragma unroll 1
        for (int i8 = 0; i8 < 8; ++i8) {
            const int qb = qb0 + F.wave + 8 * i8, q0 = qb * 32, c = q0 >> 6;
            const size_t tokq = (size_t)b * SEQ + q0 + r;
            bf16x8 qf[4];
#pragma unroll
            for (int s = 0; s < 4; ++s) qf[s] = *(const GAS bf16x8*)(PROJ + tokq * PROJ_LD + PJ_Q + h * 64 + 16 * s + 8 * hh);
            f32x16 o0, o1;
#pragma unroll
            for (int i = 0; i < 16; ++i) { o0[i] = 0.f; o1[i] = 0.f; }
            float m_run = -1e30f, l_run = 0.f;
            const int kt0 = (c > LEFT ? c - LEFT : 0) * 2, kt1 = (c + 1) * 2;
#pragma unroll 1
            for (int kt = kt0; kt < kt1; ++kt) {
                const int kpos0 = kt * 32; const size_t tokk = (size_t)b * SEQ + kpos0 + r;
                bf16x8 kf[4];
#pragma unroll
                for (int s = 0; s < 4; ++s) kf[s] = *(const GAS bf16x8*)(PROJ + tokk * PROJ_LD + PJ_K + h * 64 + 16 * s + 8 * hh);
                bf16x4 vlo[2][2], vhi[2][2];
#pragma unroll
                for (int mt = 0; mt < 2; ++mt)
#pragma unroll
                    for (int s2 = 0; s2 < 2; ++s2) { const bf16* vr = VT + (size_t)(h * 64 + 32 * mt + r) * T + (size_t)b * SEQ + kpos0 + 16 * s2 + 4 * hh;
                        vlo[mt][s2] = *(const GAS bf16x4*)vr; vhi[mt][s2] = *(const GAS bf16x4*)(vr + 8); }
                f32x16 st;
#pragma unroll
                for (int i = 0; i < 16; ++i) st[i] = 0.f;
#pragma unroll
                for (int s = 0; s < 4; ++s) st = __builtin_amdgcn_mfma_f32_32x32x16_bf16(kf[s], qf[s], st, 0, 0, 0);
                const int dbase = (q0 + r) - (kpos0 + 4 * hh);
                float mx = -1e30f;
#pragma unroll
                for (int i = 0; i < 16; ++i) { int d = dbase - ((i & 3) + 8 * (i >> 2)); d = d < MAX_PAST ? d : MAX_PAST; st[i] += tbl[d + 63]; mx = fmaxf(mx, st[i]); }
                mx = fmaxf(mx, __shfl_xor(mx, 32));
                const float m_new = fmaxf(m_run, mx), alpha = __expf(m_run - m_new);
                float ls = 0.f;
#pragma unroll
                for (int i = 0; i < 16; ++i) { st[i] = __expf(st[i] - m_new); ls += st[i]; }
                l_run = l_run * alpha + ls; m_run = m_new;
#pragma unroll
                for (int i = 0; i < 16; ++i) { o0[i] *= alpha; o1[i] *= alpha; }
#pragma unroll
                for (int s2 = 0; s2 < 2; ++s2) {
                    v4u pw; pw.x = pk2(st[8 * s2 + 0], st[8 * s2 + 1]); pw.y = pk2(st[8 * s2 + 2], st[8 * s2 + 3]); pw.z = pk2(st[8 * s2 + 4], st[8 * s2 + 5]); pw.w = pk2(st[8 * s2 + 6], st[8 * s2 + 7]);
                    const bf16x8 pf = __builtin_bit_cast(bf16x8, pw);
                    bf16x8 va, vb;
#pragma unroll
                    for (int j = 0; j < 4; ++j) { va[j] = vlo[0][s2][j]; va[4 + j] = vhi[0][s2][j]; vb[j] = vlo[1][s2][j]; vb[4 + j] = vhi[1][s2][j]; }
                    o0 = __builtin_amdgcn_mfma_f32_32x32x16_bf16(va, pf, o0, 0, 0, 0);
                    o1 = __builtin_amdgcn_mfma_f32_32x32x16_bf16(vb, pf, o1, 0, 0, 0);
                }
            }
            const float inv = 1.0f / (l_run + __shfl_xor(l_run, 32));
            bf16* yo = YA + tokq * AW + h * 64 + 4 * hh;
#pragma unroll
            for (int g4 = 0; g4 < 4; ++g4) {
                *(GAS v2u*)(yo + 8 * g4) = (v2u){pk2(o0[4 * g4] * inv, o0[4 * g4 + 1] * inv), pk2(o0[4 * g4 + 2] * inv, o0[4 * g4 + 3] * inv)};
                *(GAS v2u*)(yo + 32 + 8 * g4) = (v2u){pk2(o1[4 * g4] * inv, o1[4 * g4 + 1] * inv), pk2(o1[4 * g4 + 2] * inv, o1[4 * g4 + 3] * inv)};
            }
        }
    }
}

__device__ __forceinline__ void p6_merged(Frame& F, const In& I) {
    pg8::SchedTwo S; S.t.init(T / 256, D / 256, F.G, (int)blockIdx.x);
    S.A0 = (const char*)(F.ws + WS_YA); S.A1 = (const char*)(F.ws + WS_YB); S.B0 = (const char*)(F.ws + WS_PAT); S.B1 = (const char*)(F.ws + WS_PBT);
    S.tsA = (size_t)256 * AW * 2; S.tsB = (size_t)256 * AW * 2;
    pg8::EpiMerged E{(const bf16*)(F.ws + WS_PROJ), (bf16*)(F.ws + WS_MERGED)};
    pg8::gemm_phase<pg8::EpiMerged, pg8::SchedTwo, true>(F.lds + RING_OFF, AW, AW, AW, S, E);
}
__device__ __forceinline__ void p7_mix(Frame& F, const In& I) {
    pg8::SchedPlain S; S.t.init(T / 256, D / 256, F.G, (int)blockIdx.x);
    S.A = (const char*)(F.ws + WS_MERGED); S.B = (const char*)(F.ws + WS_WOT); S.tsA = (size_t)256 * D * 2; S.tsB = (size_t)256 * D * 2;
    pg8::EpiZ E{I.x, (float*)(F.ws + WS_Z)};
    pg8::gemm_phase<pg8::EpiZ, pg8::SchedPlain, true>(F.lds + RING_OFF, D, D, D, S, E);
}

__device__ __forceinline__ void p3_lora(Frame& F, const In& I) {
    { pg8::SchedPlain S; S.t.init(T / 256, 4, F.G, (int)blockIdx.x);
      S.A = (const char*)(F.ws + WS_LORAIN); S.B = (const char*)(F.ws + WS_WLA); S.tsA = (size_t)256 * LORA_LD * 2; S.tsB = (size_t)256 * 256 * 2;
      pg8::EpiLoraA<true> E{(float*)(F.ws + WS_DECAY), I.w0};
      pg8::gemm_phase<pg8::EpiLoraA<true>, pg8::SchedPlain, true>(F.lds + RING_OFF, LORA_LD, 256, 256, S, E); }
    { pg8::SchedPlain S; S.t.init(T / 256, 4, F.G, (int)blockIdx.x);
      S.A = (const char*)(F.ws + WS_LORAIN); S.B = (const char*)(F.ws + WS_WLA) + (size_t)1024 * 256 * 2; S.tsA = (size_t)256 * LORA_LD * 2; S.tsB = (size_t)256 * 256 * 2;
      pg8::EpiLoraA<false> E{(float*)(F.ws + WS_ICLR), I.a0};
      pg8::gemm_phase<pg8::EpiLoraA<false>, pg8::SchedPlain, true>(F.lds + RING_OFF, LORA_LD, 256, 256, S, E); }
    { pg8::SchedPlain S; S.t.init(T / 256, 4, F.G, (int)blockIdx.x);
      S.A = (const char*)(F.ws + WS_LORAIN) + 512; S.B = (const char*)(F.ws + WS_WLG); S.tsA = (size_t)256 * LORA_LD * 2; S.tsB = (size_t)256 * 256 * 2;
      pg8::EpiBf16 E{(bf16*)(F.ws + WS_G), RW};
      pg8::gemm_phase<pg8::EpiBf16, pg8::SchedPlain, true>(F.lds + RING_OFF, LORA_LD, 256, 256, S, E); }
}

constexpr int SC_TC = 32, SC_ARR = SC_TC * 64, SC_BUF = 5 * SC_ARR;
constexpr int SC_V_OFF = 2 * SC_BUF, SC_Y_OFF = SC_V_OFF + 2 * SC_TC * 16;
#define SC_BAR() do { asm volatile("s_waitcnt lgkmcnt(0)" ::: "memory"); __builtin_amdgcn_s_barrier(); asm volatile("" ::: "memory"); } while (0)
__device__ __forceinline__ void p4_scan(Frame& F, const In& I) {
    LAS float* L = (LAS float*)(F.lds + 0);
    const int lane = F.lane;
    const bf16* RKV = (const bf16*)(F.ws + WS_RKV); const float* DEC = (const float*)(F.ws + WS_DECAY); const float* ICL = (const float*)(F.ws + WS_ICLR);
    float* YS = (float*)(F.ws + WS_YSCAN);
    constexpr int NCH = SEQ / SC_TC;
    for (int unit = F.vcu; unit < BATCH * RH * 4; unit += F.G) {
        const int bh = unit >> 2, rq = unit & 3, b = bh >> 4, h = bh & 15;
        const size_t tok_base = (size_t)b * SEQ;
        __syncthreads();
        if (F.wave >= 4) {
            const int lw = F.wave - 4; const int hc = h * 64 + lane;
            const float kkp = I.k_k[hc], kap = I.k_a[hc];
            unsigned short rr_[8], kk_[8], vv_[8]; float dc_[8], ic_[8];
#define SC_LOAD(ch) do { _Pragma("unroll") for (int i = 0; i < 8; ++i) { const size_t tok = tok_base + (size_t)(ch) * SC_TC + lw + 4 * i; \
                rr_[i] = RKV[tok * (3 * RW) + hc]; kk_[i] = RKV[tok * (3 * RW) + RW + hc]; vv_[i] = RKV[tok * (3 * RW) + 2 * RW + h * 64 + rq * 16 + (lane & 15)]; \
                dc_[i] = DEC[tok * RW + hc]; ic_[i] = ICL[tok * RW + hc]; } } while (0)
#define SC_WRITE(ch) do { LAS float* B_ = L + ((ch) & 1) * SC_BUF; LAS float* V_ = L + SC_V_OFF + ((ch) & 1) * (SC_TC * 16); \
            _Pragma("unroll") for (int i = 0; i < 8; ++i) { const int s = lw + 4 * i; const float rr = bf2f(rr_[i]), k0 = bf2f(kk_[i]), ic = ic_[i]; \
                const float kkv = k0 * kkp; const float n2 = wave_sum(kkv * kkv); const float kkn = kkv / fmaxf(sqrtf(n2), 1e-12f); \
                B_[0 * SC_ARR + s * 64 + lane] = rr; B_[1 * SC_ARR + s * 64 + lane] = dc_[i]; B_[2 * SC_ARR + s * 64 + lane] = k0 * (1.0f + (ic - 1.0f) * kap); \
                B_[3 * SC_ARR + s * 64 + lane] = -kkn; B_[4 * SC_ARR + s * 64 + lane] = kkn * ic; if (lane < 16) V_[s * 16 + lane] = bf2f(vv_[i]); } } while (0)
#define SC_FLUSH(ch) do { const LAS float* Y_ = L + SC_Y_OFF + ((ch) & 1) * (SC_TC * 16); const int lt = lw * 64 + lane; \
            _Pragma("unroll") for (int i = 0; i < 2; ++i) { const int idx = lt + 256 * i, s = idx >> 4, j = idx & 15; \
                YS[(tok_base + (size_t)(ch) * SC_TC + s) * RW + h * 64 + rq * 16 + j] = Y_[idx]; } } while (0)
            SC_LOAD(0); SC_WRITE(0); SC_LOAD(1);
            SC_BAR();
#pragma unroll 1
            for (int ch = 0; ch < NCH; ++ch) {
                if (ch + 1 < NCH) SC_WRITE(ch + 1);
                if (ch + 2 < NCH) SC_LOAD(ch + 2);
                SC_BAR();
            }
#undef SC_LOAD
#undef SC_WRITE
#undef SC_FLUSH
        } else {
            const int cw = F.wave, kq = lane & 15, row = 4 * cw + (lane >> 4);
            f32x4 S = (f32x4){0.f, 0.f, 0.f, 0.f};
            SC_BAR();
#pragma unroll 1
            for (int ch = 0; ch < NCH; ++ch) {
                const LAS float* B_ = L + (ch & 1) * SC_BUF + 4 * kq; const LAS float* V_ = L + SC_V_OFF + (ch & 1) * (SC_TC * 16) + row; float* Yg = YS + (tok_base + (size_t)ch * SC_TC) * RW + h * 64 + rq * 16 + row;
                float ysel = 0.f;
                f32x4 R4[3], W4[3], K4[3], A4[3], B4[3]; float VV[3];
#define SC_LD(s, q) do { R4[q] = *(const LAS f32x4*)(B_ + 0 * SC_ARR + (s) * 64); W4[q] = *(const LAS f32x4*)(B_ + 1 * SC_ARR + (s) * 64); K4[q] = *(const LAS f32x4*)(B_ + 2 * SC_ARR + (s) * 64); \
                         A4[q] = *(const LAS f32x4*)(B_ + 3 * SC_ARR + (s) * 64); B4[q] = *(const LAS f32x4*)(B_ + 4 * SC_ARR + (s) * 64); VV[q] = V_[(s) * 16]; } while (0)
                SC_LD(0, 0); SC_LD(1, 1);
#pragma unroll
                for (int s = 0; s < SC_TC; ++s) {
                    if (s + 2 < SC_TC) SC_LD(s + 2, (s + 2) % 3);
                    __builtin_amdgcn_sched_barrier(0);
                    const int q = s % 3;
                    float sa = (S.x * A4[q].x + S.y * A4[q].y) + (S.z * A4[q].z + S.w * A4[q].w);
                    sa = rowsum16(sa);
                    S = S * W4[q] + (B4[q] * sa + K4[q] * VV[q]);
                    float y = (S.x * R4[q].x + S.y * R4[q].y) + (S.z * R4[q].z + S.w * R4[q].w);
                    y = rowsum16(y);
                    ysel = (kq == (s & 15)) ? y : ysel;
                    if ((s & 15) == 15) Yg[(size_t)(s - 15 + kq) * RW] = ysel;
                    __builtin_amdgcn_sched_barrier(0);
                }
#undef SC_LD
                SC_BAR();
            }
        }
    }
}

__device__ __forceinline__ void p5_post(Frame& F, const In& I) {
    const int lane = F.lane; const int gw = F.vcu * NWAVES + F.wave, NGW = F.G * NWAVES;
    const bf16* RKV = (const bf16*)(F.ws + WS_RKV); const float* ICL = (const float*)(F.ws + WS_ICLR); const float* YS = (const float*)(F.ws + WS_YSCAN);
    const bf16* G = (const bf16*)(F.ws + WS_G); bf16* YB = (bf16*)(F.ws + WS_YB);
    const int c0 = lane * 16;
    for (int tok = gw; tok < T; tok += NGW) {
        float y[16], rr[16], kk[16], vv[16], ic[16], gg[16];
#pragma unroll
        for (int q = 0; q < 4; ++q) { const f32x4 a = *(const GAS f32x4*)(YS + (size_t)tok * RW + c0 + 4 * q), c = *(const GAS f32x4*)(ICL + (size_t)tok * RW + c0 + 4 * q);
#pragma unroll
            for (int e = 0; e < 4; ++e) { y[4 * q + e] = a[e]; ic[4 * q + e] = c[e]; } }
#pragma unroll
        for (int q = 0; q < 2; ++q) {
            const v4u a = *(const GAS v4u*)(RKV + (size_t)tok * (3 * RW) + c0 + 8 * q), bb = *(const GAS v4u*)(RKV + (size_t)tok * (3 * RW) + RW + c0 + 8 * q),
                      c = *(const GAS v4u*)(RKV + (size_t)tok * (3 * RW) + 2 * RW + c0 + 8 * q), d = *(const GAS v4u*)(G + (size_t)tok * RW + c0 + 8 * q);
            const unsigned aw[4] = {a.x, a.y, a.z, a.w}, bw[4] = {bb.x, bb.y, bb.z, bb.w}, cw[4] = {c.x, c.y, c.z, c.w}, dw[4] = {d.x, d.y, d.z, d.w};
#pragma unroll
            for (int e = 0; e < 4; ++e) { rr[8 * q + 2 * e] = bflo(aw[e]); rr[8 * q + 2 * e + 1] = bfhi(aw[e]); kk[8 * q + 2 * e] = bflo(bw[e]); kk[8 * q + 2 * e + 1] = bfhi(bw[e]);
                vv[8 * q + 2 * e] = bflo(cw[e]); vv[8 * q + 2 * e + 1] = bfhi(cw[e]); gg[8 * q + 2 * e] = bflo(dw[e]); gg[8 * q + 2 * e + 1] = bfhi(dw[e]); } }
        float s = 0.f, bs = 0.f;
#pragma unroll
        for (int e = 0; e < 16; ++e) { s += y[e]; const float kp = kk[e] * (1.0f + (ic[e] - 1.0f) * I.k_a[c0 + e]); bs += rr[e] * kp * I.r_k[c0 + e]; }
        s = quadsum(s); bs = quadsum(bs);
        const float mean = s * (1.f / 64.f); float s2 = 0.f;
#pragma unroll
        for (int e = 0; e < 16; ++e) { y[e] -= mean; s2 += y[e] * y[e]; }
        s2 = quadsum(s2);
        const float rstd = 1.f / sqrtf(s2 * (1.f / 64.f) + GN_EPS);
        float o[16];
#pragma unroll
        for (int e = 0; e < 16; ++e) o[e] = (y[e] * rstd * I.lnx_w[c0 + e] + I.lnx_b[c0 + e] + bs * vv[e]) * gg[e];
#pragma unroll
        for (int q = 0; q < 2; ++q) *(GAS v4u*)(YB + (size_t)tok * RW + c0 + 8 * q) = (v4u){pk2(o[8 * q], o[8 * q + 1]), pk2(o[8 * q + 2], o[8 * q + 3]), pk2(o[8 * q + 4], o[8 * q + 5]), pk2(o[8 * q + 6], o[8 * q + 7])};
    }
}
#ifndef STAGE
#define STAGE 4
#endif
struct Args { In in; float* out; unsigned char* ws; };
__global__ void __launch_bounds__(NWAVES * 64, 2) mk_fwd(Args args) {
    extern __shared__ __attribute__((aligned(16))) unsigned char lds[];
    Frame F;
    F.lds = (LAS unsigned char*)lds;
    F.MISC = (volatile LAS unsigned*)(F.lds + MISC_OFF);
    F.tid = threadIdx.x; F.lane = F.tid & 63; F.wave = __builtin_amdgcn_readfirstlane(F.tid >> 6);
    F.G = gridDim.x; { const int bx = blockIdx.x; F.vcu = (F.G % 8 == 0) ? (bx % 8) * (F.G / 8) + bx / 8 : bx; }
    F.ws = args.ws;
    F.ctl = (gu32*)(args.ws + WS_CTL);
    for (int u = F.tid; u < (LDS_BYTES - MISC_OFF) / 4; u += NWAVES * 64) ((LAS unsigned*)(F.lds + MISC_OFF))[u] = 0u;
    __syncthreads();
    XcdBarrier bar = xcd_barrier_post((unsigned*)(F.ctl + CW_BAR), F.MISC + 8);
    const In& I = args.in;
#define GRID_BAR() xcd_barrier(bar)
#ifndef DUP_PHASE
#define DUP_PHASE -1
#endif
#define RUN(n, call) do { call; if (DUP_PHASE == (n)) { GRID_BAR(); call; } } while (0)

#if STAGE >= 2
    RUN(0, p0_prologue(F, I));
    GRID_BAR();
#endif
#if STAGE >= 3
    RUN(1, p1_proj(F, I));
    GRID_BAR();
    RUN(2, p2_shift_attn(F, I));
    GRID_BAR();
#if STAGE >= 4
    RUN(3, p3_lora(F, I));
    GRID_BAR();
    RUN(4, p4_scan(F, I));
    GRID_BAR();
    RUN(5, p5_post(F, I));
    GRID_BAR();
#endif
    RUN(6, p6_merged(F, I));
    GRID_BAR();
    RUN(7, p7_mix(F, I));
    GRID_BAR();
#endif
    p8_ln_router<(STAGE < 3)>(F, I);
    GRID_BAR();
#if STAGE >= 2
    p9_scatter(F, I);
    GRID_BAR();
    RUN(10, p10_moe_up(F, I));
    GRID_BAR();
    RUN(11, p11_moe_down(F, I));
    GRID_BAR();
#endif
    RUN(12, p12_final<(STAGE < 2)>(F, I, args.out));
}

extern "C" void kernel_launch(void* const* d_in, const int* in_sizes, int n_in, void* d_out, int out_size, void* d_ws, size_t ws_size, hipStream_t stream) {
    static int grid = 0;
    if (grid == 0) {
        if (n_in != 27 || in_sizes[0] != T * D || out_size != T * D || ws_size < WS_END) { fprintf(stderr, "kernel_launch: unexpected shapes (n_in %d, in0 %d, out %d, ws %zu)\n", n_in, n_in > 0 ? in_sizes[0] : -1, out_size, ws_size); grid = -1; return; }
        int dev = 0, cus = 0, per_cu = 0;
        if (hipGetDevice(&dev) != hipSuccess || hipDeviceGetAttribute(&cus, hipDeviceAttributeMultiprocessorCount, dev) != hipSuccess) { grid = -1; return; }
        if (hipFuncSetAttribute((const void*)mk_fwd, hipFuncAttributeMaxDynamicSharedMemorySize, LDS_BYTES) != hipSuccess) { fprintf(stderr, "kernel_launch: hipFuncSetAttribute failed\n"); grid = -1; return; }
        if (hipOccupancyMaxActiveBlocksPerMultiprocessor(&per_cu, (const void*)mk_fwd, NWAVES * 64, LDS_BYTES) != hipSuccess || per_cu < 1)
            fprintf(stderr, "kernel_launch: occupancy query reports %d\n", per_cu);
        (void)hipGetLastError();
        grid = cus;
    }
    if (grid < 0) return;
    if (hipMemsetAsync((char*)d_ws + WS_CTL, 0, CTL_ZERO_BYTES, stream) != hipSuccess) return;
    Args a{};
    const float** ip = (const float**)&a.in;
    for (int i = 0; i < 27; ++i) ip[i] = (const float*)d_in[i];
    a.out = (float*)d_out; a.ws = (unsigned char*)d_ws;
    hipLaunchKernelGGL(mk_fwd, dim3(grid), dim3(NWAVES * 64), LDS_BYTES, stream, a);
    const hipError_t le = hipPeekAtLastError();
    if (le != hipSuccess) fprintf(stderr, "kernel_launch: launch failed: %s\n", hipGetErrorName(le));
}
```

```cpp
#define STAGE 4
#include <hip/hip_runtime.h>
#include <cstdio>
#include <cstdint>

#define GAS __attribute__((address_space(1)))
#define LAS __attribute__((address_space(3)))
typedef unsigned short bf16;
typedef unsigned v4u __attribute__((ext_vector_type(4)));
typedef unsigned v2u __attribute__((ext_vector_type(2)));
typedef float f32x4 __attribute__((ext_vector_type(4)));
typedef float f32x2 __attribute__((ext_vector_type(2)));
typedef float f32x16 __attribute__((ext_vector_type(16)));
typedef short bf16x8 __attribute__((ext_vector_type(8)));
typedef short bf16x4 __attribute__((ext_vector_type(4)));
typedef GAS unsigned gu32;

constexpr int NWAVES = 8;
constexpr int BATCH = 4, SEQ = 8192, D = 2048, T = BATCH * SEQ;
constexpr int CHUNK = 64, LEFT = 8, AH = 16, AD = 64, AW = 1024;
constexpr int REL_TABLE = 320, MAX_PAST = 256;
constexpr int RH = 16, RN = 64, RW = 1024, DLORA = 96, ALORA = 96, GLORA = 256;
constexpr int SHIFT_W = 3 * RW + DLORA + ALORA + GLORA;
constexpr int D_IN = 3 * AW + SHIFT_W + 2 * D;
constexpr int NE = 32, TOPK = 4, FF = 2048;
constexpr int MSLOT = T * TOPK;
constexpr int NBLK_MAX = (MSLOT + NE * 255 + 255) / 256;
constexpr int RROWS = NBLK_MAX * 256;
constexpr float LN_EPS = 1e-5f, GN_EPS = 64e-5f;
constexpr float DN_ALPHA = 1.189207115002721f;
constexpr int PROJ_LD = 9728, PJ_Q = 0, PJ_K = 1024, PJ_SEG = 2048, SEG_PAD = 3584, PJ_GA = 5632, PJ_GB = 7680;
constexpr int LORA_LD = 512;

constexpr size_t MiB = 1u << 20;
constexpr size_t WS_CTL = 0, CTL_ZERO_BYTES = 1 * MiB;
constexpr size_t WS_TOPI = 2 * MiB;
constexpr size_t WS_GATE = 3 * MiB;
constexpr size_t WS_ROWSLOT = 4 * MiB;
constexpr size_t WS_ROWW = 5 * MiB;
constexpr size_t WS_WLA = 6 * MiB;
constexpr size_t WS_WLG = 7 * MiB;
constexpr size_t WS_PAT = 8 * MiB;
constexpr size_t WS_PBT = 12 * MiB;
constexpr size_t WS_WOT = 16 * MiB;
constexpr size_t WS_WVT = 24 * MiB;
constexpr size_t WS_WINT = 28 * MiB;
constexpr size_t WS_WGUT = 128 * MiB;
constexpr size_t WS_WDNT = 640 * MiB;
constexpr size_t WS_BASE0 = 1024 * MiB;
constexpr size_t WS_PROJ = WS_BASE0;
constexpr size_t WS_VT = WS_PROJ + 608 * MiB;
constexpr size_t WS_YA = WS_VT + 64 * MiB;
constexpr size_t WS_RKV = WS_YA + 64 * MiB;
constexpr size_t WS_LORAIN = WS_RKV + 192 * MiB;
constexpr size_t WS_DECAY = WS_LORAIN + 32 * MiB;
constexpr size_t WS_ICLR = WS_DECAY + 128 * MiB;
constexpr size_t WS_G = WS_ICLR + 128 * MiB;
constexpr size_t WS_YSCAN = WS_G + 64 * MiB;
constexpr size_t WS_YB = WS_YSCAN + 128 * MiB;
constexpr size_t WS_MERGED = WS_YB + 64 * MiB;
constexpr size_t WS_XB16 = WS_MERGED + 128 * MiB;
constexpr size_t WS_MIX_END = WS_XB16 + 128 * MiB;
constexpr size_t WS_Z = 2816 * MiB;
constexpr size_t WS_H1 = 3072 * MiB;
constexpr size_t WS_H1B = 3328 * MiB;
constexpr size_t WS_END = 3456 * MiB;
constexpr size_t WS_XG = WS_BASE0;
constexpr size_t WS_ACT = WS_BASE0 + 544 * MiB;
constexpr size_t WS_YSLOT = WS_BASE0 + 1088 * MiB;
static_assert(WS_MIX_END <= WS_Z && WS_YSLOT + 512 * MiB <= WS_Z, "ws map");
static_assert(WS_WINT + (size_t)PROJ_LD * D * 2 <= WS_WGUT, "ws map");

constexpr int CW_CNT = 512;
constexpr int CW_CUR = 576;
constexpr int CW_BAR = 4096;

constexpr int RING_OFF = 0, RING_BYTES = 131072;
constexpr int LDS_BYTES = 160 * 1024;
constexpr int MISC_OFF = LDS_BYTES - 512;
constexpr int TAB_OFF = LDS_BYTES - 1024;

#define RLX_AGENT __ATOMIC_RELAXED, __HIP_MEMORY_SCOPE_AGENT
#define LDS_WAIT() asm volatile("s_waitcnt lgkmcnt(0)" ::: "memory")
#define VM_WAIT() asm volatile("s_waitcnt vmcnt(0)" ::: "memory")
__device__ __forceinline__ unsigned f2bf(float f) { unsigned u = __builtin_bit_cast(unsigned, f); return (u + 0x7fffu + ((u >> 16) & 1u)) >> 16; }
__device__ __forceinline__ unsigned pk2(float lo, float hi) { return f2bf(lo) | (f2bf(hi) << 16); }
__device__ __forceinline__ float bf2f(unsigned short h) { return __builtin_bit_cast(float, (unsigned)h << 16); }
__device__ __forceinline__ float bflo(unsigned w) { return __builtin_bit_cast(float, w << 16); }
__device__ __forceinline__ float bfhi(unsigned w) { return __builtin_bit_cast(float, w & 0xffff0000u); }
__device__ __forceinline__ float fsigmoid(float x) { return __builtin_amdgcn_rcpf(1.0f + __expf(-x)); }
__device__ __forceinline__ float dpp_f(float x, const int ctrl_sel) {
    const int xi = __builtin_bit_cast(int, x); int r;
    if (ctrl_sel == 0) r = __builtin_amdgcn_update_dpp(0, xi, 0xB1, 0xF, 0xF, false);
    else if (ctrl_sel == 1) r = __builtin_amdgcn_update_dpp(0, xi, 0x4E, 0xF, 0xF, false);
    else if (ctrl_sel == 2) r = __builtin_amdgcn_update_dpp(0, xi, 0x124, 0xF, 0xF, false);
    else r = __builtin_amdgcn_update_dpp(0, xi, 0x128, 0xF, 0xF, false);
    return __builtin_bit_cast(float, r);
}
__device__ __forceinline__ float rowsum16(float x) { x += dpp_f(x, 0); x += dpp_f(x, 1); x += dpp_f(x, 2); x += dpp_f(x, 3); return x; }
__device__ __forceinline__ float quadsum(float x) { x += dpp_f(x, 0); x += dpp_f(x, 1); return x; }
__device__ __forceinline__ float wave_sum(float v) {
    v = rowsum16(v);
    const int vi = __builtin_bit_cast(int, v);
    const float s0 = __builtin_bit_cast(float, __builtin_amdgcn_readlane(vi, 0)), s1 = __builtin_bit_cast(float, __builtin_amdgcn_readlane(vi, 16));
    const float s2 = __builtin_bit_cast(float, __builtin_amdgcn_readlane(vi, 32)), s3 = __builtin_bit_cast(float, __builtin_amdgcn_readlane(vi, 48));
    return (s0 + s1) + (s2 + s3);
}
namespace pg8 {
#define PG8_LAS __attribute__((address_space(3)))
typedef unsigned short bf16_t;
typedef unsigned u32x4 __attribute__((ext_vector_type(4)));
constexpr int BM = 256, BK = 64, HALF = 128, HTB = HALF * BK * 2, STAGE_BYTES = 8 * HTB, NXCD = 8, WGM = 8;

__host__ __device__ __forceinline__ int lds_byte(int r, int c) { const int st = (r >> 4) * 2 + (c >> 5), rr = r & 15, cc = c & 31, ob = rr * 64 + cc * 2; return st * 1024 + (ob ^ (((ob >> 9) & 1) << 5)); }
__host__ __device__ __forceinline__ void stage_rc(int b, int& R, int& C) { const int st = b / 1024, sb = b % 1024, swz = sb ^ (((sb >> 9) & 1) << 5); R = (st >> 1) * 16 + swz / 64; C = (st & 1) * 32 + (swz % 64) / 2; }
__host__ __device__ __forceinline__ int perm32(int rho) { const int n = rho >> 4, i = rho & 15; return 8 * (i >> 2) + 4 * n + (i & 3); }

struct Unit { int pm, pn, aux; };

struct Tiler {
    int nM, nN, nwg, G, c;
    __device__ __forceinline__ void init(int nM_, int nN_, int G_, int c_) { nM = nM_; nN = nN_; nwg = nM * nN; G = G_; c = c_; }
    __device__ __forceinline__ bool map(int i, int& pm, int& pn) const {
        const long L = (long)i * G + c; if (L >= nwg) return false;
        int wgid = (int)L; { const int q = nwg / NXCD, r = nwg % NXCD, xcd = wgid % NXCD, off = wgid / NXCD; wgid = (xcd < r ? xcd * (q + 1) : r * (q + 1) + (xcd - r) * q) + off; }
        const int nig = WGM * nN, gid = wgid / nig, fm = gid * WGM, gsz = (nM - fm) < WGM ? (nM - fm) : WGM;
        pm = fm + ((wgid % nig) % gsz); pn = (wgid % nig) / gsz; return true;
    }
};
struct SchedPlain {
    Tiler t; unsigned A, B, tsA, tsB;
    __device__ __forceinline__ bool next(int i, Unit& u) const { u.aux = 0; return t.map(i, u.pm, u.pn); }
    __device__ __forceinline__ void bases(const Unit& u, unsigned& a, unsigned& b) const { a = A + (unsigned)u.pm * tsA; b = B + (unsigned)u.pn * tsB; }
};
struct SchedTwo {
    Tiler t; unsigned A0, A1, B0, B1, tsA, tsB;
    __device__ __forceinline__ bool next(int i, Unit& u) const { u.aux = i & 1; return t.map(i >> 1, u.pm, u.pn); }
    __device__ __forceinline__ void bases(const Unit& u, unsigned& a, unsigned& b) const { a = (u.aux ? A1 : A0) + (unsigned)u.pm * tsA; b = (u.aux ? B1 : B0) + (unsigned)u.pn * tsB; }
};
struct SchedMoe {
    Tiler t; unsigned A, B, tsA, tsB, es; const PG8_LAS int* pad_end;
    __device__ __forceinline__ bool next(int i, Unit& u) const {
        if (!t.map(i, u.pm, u.pn)) return false;
        const int row0 = u.pm * BM; int e = 0;
#pragma unroll
        for (int j = 0; j < 32; ++j) e += (pad_end[j] <= row0) ? 1 : 0;
        u.aux = __builtin_amdgcn_readfirstlane(e < 31 ? e : 31); return true;
    }
    __device__ __forceinline__ void bases(const Unit& u, unsigned& a, unsigned& b) const { a = A + (unsigned)u.pm * tsA; b = B + (unsigned)u.aux * es + (unsigned)u.pn * tsB; }
};

__device__ __forceinline__ unsigned cvt_pk_bf16(float lo, float hi) { unsigned r; asm volatile("v_cvt_pk_bf16_f32 %0, %1, %2" : "=v"(r) : "v"(lo), "v"(hi)); return r; }
__device__ __forceinline__ u32x4 pack8(const f32x4& v0, const f32x4& v1) { u32x4 w; w.x = cvt_pk_bf16(v0[0], v0[1]); w.y = cvt_pk_bf16(v0[2], v0[3]); w.z = cvt_pk_bf16(v1[0], v1[1]); w.w = cvt_pk_bf16(v1[2], v1[3]); return w; }

typedef int i32x8 __attribute__((ext_vector_type(8)));
typedef int i32x4 __attribute__((ext_vector_type(4)));
__device__ __forceinline__ i32x8 cat8(const bf16x8& a, const bf16x8& b) { return __builtin_shufflevector(__builtin_bit_cast(i32x4, a), __builtin_bit_cast(i32x4, b), 0, 1, 2, 3, 4, 5, 6, 7); }
constexpr int F8_SCALES = 0x00007f79;
template <class Epi, class Sched, bool ALIGN_EPI, bool F8 = false>
__device__ __forceinline__ void gemm_phase(PG8_LAS unsigned char* lds, const __amdgpu_buffer_rsrc_t rsrc, const int lda, const int ldb, const int K, const Sched& S, const Epi& E) {
    int tid_ = threadIdx.x; asm volatile("" : "+v"(tid_));
    const int tid = tid_, wid = __builtin_amdgcn_readfirstlane(tid >> 6), lane = tid & 63, wr = wid >> 2, wc = wid & 3, fr = lane & 15, fq = lane >> 4;
    const int nt = K / BK;
    unsigned voffA, voffB;
    { int R, C; stage_rc(tid * 16, R, C); const int Rb = (R & ~31) + perm32(R & 31); voffA = (unsigned)(R * lda + C) * 2u; voffB = (unsigned)(Rb * ldb + C) * 2u; }
    const unsigned p1voffA = 64u * (unsigned)lda * 2u, p1voffB = 64u * (unsigned)ldb * 2u;
    const unsigned kstep = (unsigned)(BK * 2);
    const unsigned hsA = (unsigned)HALF * lda * 2, hsB = (unsigned)HALF * ldb * 2;
    const unsigned ldsw = (unsigned)wid * 1024u;
    const int aoff = lds_byte(wr * 64 + fr, fq * 8), boff = lds_byte(wc * 32 + fr, fq * 8);
#define PG8_SA(b, h) (((b) * 2 + (h)) * HTB)
#define PG8_SB(b, h) ((4 + (b) * 2 + (h)) * HTB)
#define PG8_STAGE(bufoff, goff, voff) do { _Pragma("unroll") for (int _i = 0; _i < 2; ++_i) \
        __builtin_amdgcn_raw_ptr_buffer_load_lds(rsrc, (PG8_LAS void*)(lds + (bufoff) + ldsw + _i * 8192), 16, (int)(voff), (int)((goff) + _i * p1##voff), 0, 0); } while (0)
#define PG8_LD8(addr) __builtin_shufflevector(*(const PG8_LAS i32x4*)(addr), *(const PG8_LAS i32x4*)((addr) + 1024), 0, 1, 2, 3, 4, 5, 6, 7)
#define PG8_LDA(dst, b, h) do { _Pragma("unroll") for (int m = 0; m < 4; ++m) dst[m] = PG8_LD8(lds + PG8_SA(b, h) + aoff + m * 2048); } while (0)
#define PG8_LDB(dst, b, h) do { _Pragma("unroll") for (int n = 0; n < 2; ++n) dst[n] = PG8_LD8(lds + PG8_SB(b, h) + boff + n * 2048); } while (0)
#define PG8_LO(v) __builtin_bit_cast(bf16x8, __builtin_shufflevector(v, v, 0, 1, 2, 3))
#define PG8_HI(v) __builtin_bit_cast(bf16x8, __builtin_shufflevector(v, v, 4, 5, 6, 7))
#define PG8_MMA(ai, bj, At, Bt) do { __builtin_amdgcn_s_setprio(1); \
        if constexpr (!F8) { _Pragma("unroll") for (int m = 0; m < 4; ++m) _Pragma("unroll") for (int n = 0; n < 2; ++n) { \
            acc[ai][bj][m][n] = __builtin_amdgcn_mfma_f32_16x16x32_bf16(PG8_LO(Bt[n]), PG8_LO(At[m]), acc[ai][bj][m][n], 0, 0, 0); \
            acc[ai][bj][m][n] = __builtin_amdgcn_mfma_f32_16x16x32_bf16(PG8_HI(Bt[n]), PG8_HI(At[m]), acc[ai][bj][m][n], 0, 0, 0); } } \
        else { _Pragma("unroll") for (int m = 0; m < 4; ++m) _Pragma("unroll") for (int n = 0; n < 2; ++n) \
            acc[ai][bj][m][n] = __builtin_amdgcn_mfma_scale_f32_16x16x128_f8f6f4(Bt[n], At[m], acc[ai][bj][m][n], 0, 0, 0, F8_SCALES, 1, F8_SCALES); } \
        __builtin_amdgcn_s_setprio(0); } while (0)
#define PG8_WAIT_V(n) asm volatile("s_waitcnt vmcnt(" #n ")" ::: "memory")
#define PG8_WAIT_L(n) asm volatile("s_waitcnt lgkmcnt(" #n ")" ::: "memory")
#define PG8_BAR __builtin_amdgcn_s_barrier()
#define PG8_SCHED __builtin_amdgcn_sched_barrier(0)
#define PG8_ZERO() do { _Pragma("unroll") for (int a = 0; a < 2; ++a) _Pragma("unroll") for (int b = 0; b < 2; ++b) _Pragma("unroll") for (int m = 0; m < 4; ++m) _Pragma("unroll") for (int n = 0; n < 2; ++n) acc[a][b][m][n] = (f32x4){0.f, 0.f, 0.f, 0.f}; } while (0)
    Unit cur, nxt; int ui = 0;
    if (!S.next(0, cur)) return;
    f32x4 acc[2][2][4][2];
    PG8_ZERO();
    i32x8 At[4], B0[2], B1[2];
    unsigned cA, cB; S.bases(cur, cA, cB); cA = __builtin_amdgcn_readfirstlane(cA); cB = __builtin_amdgcn_readfirstlane(cB);
    PG8_STAGE(PG8_SB(0, 0), cB, voffB); PG8_STAGE(PG8_SB(0, 1), cB + hsB, voffB); PG8_STAGE(PG8_SA(0, 0), cA, voffA); PG8_STAGE(PG8_SA(0, 1), cA + hsA, voffA);
    if (wr == 1) PG8_BAR;
    PG8_WAIT_V(2); PG8_BAR;
    PG8_STAGE(PG8_SB(1, 0), cB + kstep, voffB); PG8_STAGE(PG8_SA(1, 0), cA + kstep, voffA); PG8_STAGE(PG8_SB(1, 1), cB + hsB + kstep, voffB);
    PG8_WAIT_V(6); PG8_BAR;
    for (;;) {
        const bool has_next = S.next(ui + 1, nxt);
        unsigned nA = cA, nB = cB; if (has_next) { S.bases(nxt, nA, nB); nA = __builtin_amdgcn_readfirstlane(nA); nB = __builtin_amdgcn_readfirstlane(nB); }
#pragma unroll 1
        for (int t = 0; t < nt; t += 2) {
            const bool last = (t == nt - 2);
            const unsigned a1 = cA + (unsigned)(t + 1) * kstep;
            const unsigned a2 = last ? nA : cA + (unsigned)(t + 2) * kstep, b2 = last ? nB : cB + (unsigned)(t + 2) * kstep;
            const unsigned a3 = a2 + kstep, b3 = b2 + kstep;
            PG8_LDB(B0, 0, 0); PG8_LDB(B1, 0, 1); PG8_SCHED; PG8_LDA(At, 0, 0); PG8_STAGE(PG8_SA(1, 1), a1 + hsA, voffA);
            PG8_WAIT_V(8); PG8_WAIT_L(0); PG8_BAR; PG8_MMA(0, 0, At, B0); PG8_MMA(0, 1, At, B1); PG8_BAR; PG8_SCHED;
            PG8_LDA(At, 0, 1); PG8_STAGE(PG8_SB(0, 0), b2, voffB); PG8_STAGE(PG8_SB(0, 1), b2 + hsB, voffB); PG8_STAGE(PG8_SA(0, 0), a2, voffA);
            PG8_WAIT_V(8); PG8_WAIT_L(0); PG8_BAR; PG8_MMA(1, 0, At, B0); PG8_MMA(1, 1, At, B1); PG8_BAR; PG8_SCHED;
            PG8_LDB(B0, 1, 0); PG8_LDB(B1, 1, 1); PG8_SCHED; PG8_LDA(At, 1, 0); PG8_STAGE(PG8_SA(0, 1), a2 + hsA, voffA);
            PG8_WAIT_V(8); PG8_WAIT_L(0); PG8_BAR; PG8_MMA(0, 0, At, B0); PG8_MMA(0, 1, At, B1); PG8_BAR; PG8_SCHED;
            PG8_LDA(At, 1, 1); PG8_STAGE(PG8_SB(1, 0), b3, voffB); PG8_STAGE(PG8_SB(1, 1), b3 + hsB, voffB); PG8_STAGE(PG8_SA(1, 0), a3, voffA);
            PG8_WAIT_V(8); PG8_WAIT_L(0); PG8_BAR; PG8_MMA(1, 0, At, B0); PG8_MMA(1, 1, At, B1); PG8_BAR; PG8_SCHED;
        }
        if constexpr (ALIGN_EPI) { if (wr == 0) PG8_BAR; }
        bool keep; { int t2 = threadIdx.x; asm volatile("" : "+v"(t2)); const int w2 = __builtin_amdgcn_readfirstlane(t2 >> 6), l2 = t2 & 63; keep = E(acc, cur, w2 >> 2, w2 & 3, l2 & 15, l2 >> 4); }
        if (!has_next) break;
        if (!keep) PG8_ZERO();
        cur = nxt; cA = nA; cB = nB; ++ui;
        if constexpr (ALIGN_EPI) { if (wr == 1) PG8_BAR; }
    }
    PG8_WAIT_V(0);
    if constexpr (!ALIGN_EPI) { if (wr == 0) PG8_BAR; }
    PG8_BAR;
#undef PG8_SA
#undef PG8_SB
#undef PG8_STAGE
#undef PG8_LDA
#undef PG8_LDB
#undef PG8_LD8
#undef PG8_LO
#undef PG8_HI
#undef PG8_MMA
#undef PG8_WAIT_V
#undef PG8_WAIT_L
#undef PG8_BAR
#undef PG8_SCHED
#undef PG8_ZERO
}
}
namespace pg8 {
#define EPI_ROWLOOP _Pragma("unroll") for (int ai = 0; ai < 2; ++ai) _Pragma("unroll") for (int m = 0; m < 4; ++m)
struct EpiProj {
    bf16_t* O;
    __device__ __forceinline__ bool operator()(f32x4 (&acc)[2][2][4][2], const Unit& u, int wr, int wc, int fr, int fq) const {
        const int row0 = u.pm * BM + wr * 64 + fr, col0 = u.pn * BM + wc * 32 + 8 * fq;
        const int mode = (u.pn < 4) ? 1 : (u.pn >= 22 ? 2 : 0);
        EPI_ROWLOOP { bf16_t* rowp = O + (size_t)(row0 + ai * HALF + m * 16) * PROJ_LD + col0;
#pragma unroll
            for (int bj = 0; bj < 2; ++bj) { f32x4 v0 = acc[ai][bj][m][0], v1 = acc[ai][bj][m][1];
                if (mode == 1) { v0 = v0 * 0.125f; v1 = v1 * 0.125f; }
                else if (mode == 2) {
#pragma unroll
                    for (int j = 0; j < 4; ++j) { v0[j] = fsigmoid(v0[j]); v1[j] = fsigmoid(v1[j]); } }
                *(u32x4*)(rowp + bj * HALF) = pack8(v0, v1); } }
        return false;
    }
};
struct EpiBf16 {
    bf16_t* O; int ldc;
    __device__ __forceinline__ bool operator()(f32x4 (&acc)[2][2][4][2], const Unit& u, int wr, int wc, int fr, int fq) const {
        const int row0 = u.pm * BM + wr * 64 + fr, col0 = u.pn * BM + wc * 32 + 8 * fq;
        EPI_ROWLOOP { bf16_t* rowp = O + (size_t)(row0 + ai * HALF + m * 16) * ldc + col0;
#pragma unroll
            for (int bj = 0; bj < 2; ++bj) *(u32x4*)(rowp + bj * HALF) = pack8(acc[ai][bj][m][0], acc[ai][bj][m][1]); }
        return false;
    }
};
template <bool ISDEC> struct EpiLoraA {
    float* OUT; const float* par;
    __device__ __forceinline__ bool operator()(f32x4 (&acc)[2][2][4][2], const Unit& u, int wr, int wc, int fr, int fq) const {
        const int row0 = u.pm * BM + wr * 64 + fr, col0 = u.pn * BM + wc * 32 + 8 * fq;
        f32x4 pv[2][2];
#pragma unroll
        for (int bj = 0; bj < 2; ++bj)
#pragma unroll
            for (int n = 0; n < 2; ++n) pv[bj][n] = *(const f32x4*)(par + col0 + bj * HALF + 4 * n);
        EPI_ROWLOOP { float* rowp = OUT + (size_t)(row0 + ai * HALF + m * 16) * RW + col0;
#pragma unroll
            for (int bj = 0; bj < 2; ++bj)
#pragma unroll
                for (int n = 0; n < 2; ++n) { f32x4 v = acc[ai][bj][m][n] + pv[bj][n];
#pragma unroll
                    for (int j = 0; j < 4; ++j) {
                        if (ISDEC) { const float y = -v[j]; const float sp = fmaxf(y, 0.f) + __logf(1.0f + __expf(-fabsf(y))); const float w = -sp - 0.5f; v[j] = __expf(-__expf(w)); }
                        else v[j] = fsigmoid(v[j]); }
                    *(f32x4*)(rowp + bj * HALF + 4 * n) = v; } }
        return false;
    }
};
struct EpiMerged {
    const bf16_t* PROJ; bf16_t* O;
    __device__ __forceinline__ bool operator()(f32x4 (&acc)[2][2][4][2], const Unit& u, int wr, int wc, int fr, int fq) const {
        const int row0 = u.pm * BM + wr * 64 + fr, col0 = u.pn * BM + wc * 32 + 8 * fq;
        EPI_ROWLOOP { const int row = row0 + ai * HALF + m * 16; const bf16_t* gp = PROJ + (size_t)row * PROJ_LD + col0;
#pragma unroll
            for (int bj = 0; bj < 2; ++bj) {
                const u32x4 gb = *(const u32x4*)(gp + PJ_GB + bj * HALF);
                f32x4 b0 = (f32x4){bflo(gb.x), bfhi(gb.x), bflo(gb.y), bfhi(gb.y)}, b1 = (f32x4){bflo(gb.z), bfhi(gb.z), bflo(gb.w), bfhi(gb.w)};
                if (u.aux == 0) {
                    const u32x4 ga = *(const u32x4*)(gp + PJ_GA + bj * HALF);
                    f32x4 a0 = (f32x4){bflo(ga.x), bfhi(ga.x), bflo(ga.y), bfhi(ga.y)}, a1 = (f32x4){bflo(ga.z), bfhi(ga.z), bflo(ga.w), bfhi(ga.w)};
#pragma unroll
                    for (int j = 0; j < 4; ++j) { acc[ai][bj][m][0][j] *= a0[j] / fmaxf(b0[j], 1e-30f); acc[ai][bj][m][1][j] *= a1[j] / fmaxf(b1[j], 1e-30f); }
                } else {
                    *(u32x4*)(O + (size_t)row * D + col0 + bj * HALF) = pack8(acc[ai][bj][m][0] * b0, acc[ai][bj][m][1] * b1);
                } } }
        return u.aux == 0;
    }
};
struct EpiZ {
    const float* X; float* Z;
    __device__ __forceinline__ bool operator()(f32x4 (&acc)[2][2][4][2], const Unit& u, int wr, int wc, int fr, int fq) const {
        const int row0 = u.pm * BM + wr * 64 + fr, col0 = u.pn * BM + wc * 32 + 8 * fq;
        EPI_ROWLOOP { const size_t off = (size_t)(row0 + ai * HALF + m * 16) * D + col0;
#pragma unroll
            for (int bj = 0; bj < 2; ++bj)
#pragma unroll
                for (int n = 0; n < 2; ++n) { const f32x4 xv = *(const f32x4*)(X + off + bj * HALF + 4 * n); *(f32x4*)(Z + off + bj * HALF + 4 * n) = xv * DN_ALPHA + acc[ai][bj][m][n]; } }
        return false;
    }
};
struct EpiSwiglu {
    unsigned char* ACT; const float* bgu;
    __device__ __forceinline__ bool operator()(f32x4 (&acc)[2][2][4][2], const Unit& u, int wr, int wc, int fr, int fq) const {
        const int row0 = u.pm * BM + wr * 64 + fr, col0 = u.pn * HALF + wc * 32 + 8 * fq;
        const float* bp = bgu + (size_t)u.aux * (2 * FF) + col0;
        f32x4 bg[2], bu[2];
#pragma unroll
        for (int n = 0; n < 2; ++n) { bg[n] = *(const f32x4*)(bp + 4 * n); bu[n] = *(const f32x4*)(bp + FF + 4 * n); }
        EPI_ROWLOOP { f32x4 o[2];
#pragma unroll
            for (int n = 0; n < 2; ++n) { const f32x4 g = acc[ai][0][m][n] + bg[n], uu = acc[ai][1][m][n] + bu[n];
#pragma unroll
                for (int j = 0; j < 4; ++j) { const float gc = fminf(g[j], 7.0f), uc = fminf(fmaxf(uu[j], -7.0f), 7.0f); o[n][j] = (uc + 1.0f) * (gc * fsigmoid(1.702f * gc)); } }
            int w0 = __builtin_amdgcn_cvt_pk_fp8_f32(o[0][0], o[0][1], 0, false); w0 = __builtin_amdgcn_cvt_pk_fp8_f32(o[0][2], o[0][3], w0, true);
            int w1 = __builtin_amdgcn_cvt_pk_fp8_f32(o[1][0], o[1][1], 0, false); w1 = __builtin_amdgcn_cvt_pk_fp8_f32(o[1][2], o[1][3], w1, true);
            *(v2u*)(ACT + (size_t)(row0 + ai * HALF + m * 16) * FF + col0) = (v2u){(unsigned)w0, (unsigned)w1}; }
        return false;
    }
};
struct EpiDown {
    bf16_t* YS; const float* bdn; const int* rowslot; const float* roww;
    __device__ __forceinline__ bool operator()(f32x4 (&acc)[2][2][4][2], const Unit& u, int wr, int wc, int fr, int fq) const {
        const int row0 = u.pm * BM + wr * 64 + fr, col0 = u.pn * BM + wc * 32 + 8 * fq;
        const float* bp = bdn + (size_t)u.aux * D + col0;
        f32x4 bv[2][2];
#pragma unroll
        for (int bj = 0; bj < 2; ++bj)
#pragma unroll
            for (int n = 0; n < 2; ++n) bv[bj][n] = *(const f32x4*)(bp + bj * HALF + 4 * n);
        EPI_ROWLOOP { const int row = row0 + ai * HALF + m * 16; const int slot = rowslot[row]; const float w = roww[row];
            if (slot >= 0) { bf16_t* rowp = YS + (size_t)slot * D + col0;
#pragma unroll
                for (int bj = 0; bj < 2; ++bj) *(u32x4*)(rowp + bj * HALF) = pack8((acc[ai][bj][m][0] + bv[bj][0]) * w, (acc[ai][bj][m][1] + bv[bj][1]) * w); } }
        return false;
    }
};
#undef EPI_ROWLOOP
}

#define XB_TMO      128
#define XB_XCNT(j)  (256  + 64 * (j))
#define XB_XSUB(j)  (1280 + 64 * (j))
#define XB_XGEN(j)  (2304 + 64 * (j))
#define XB_TOP      3328
#define XB_TOPGEN   3392
#define XCD_BAR_WORDS 3456
#define XB_SPIN_CAP (1u << 18)

__device__ __forceinline__ unsigned xb_ld(unsigned* p)              { return __hip_atomic_load(p, __ATOMIC_RELAXED, __HIP_MEMORY_SCOPE_AGENT); }
__device__ __forceinline__ unsigned xb_add(unsigned* p, unsigned v) { return __hip_atomic_fetch_add(p, v, __ATOMIC_RELAXED, __HIP_MEMORY_SCOPE_AGENT); }
__device__ __forceinline__ unsigned xb_xcc_id() { return (unsigned)__builtin_amdgcn_s_getreg((3 << 11) | 20) & 0xFu; }
#define XB_SPIN(cond, bar) do { unsigned _sp = 0; while (cond) { __builtin_amdgcn_s_sleep(1); \
    if ((++_sp & 255u) == 0u) { if (xb_ld(&(bar)[XB_TMO])) break; if (_sp > XB_SPIN_CAP) { atomicAdd(&(bar)[XB_TMO], 1u); break; } } } } while (0)

struct XcdBarrier {
    unsigned* bar; unsigned x;
    volatile LAS unsigned* st;
};

__device__ __forceinline__ XcdBarrier xcd_barrier_post(unsigned* bar, volatile LAS unsigned* st) {
    XcdBarrier b; b.bar = bar; b.x = xb_xcc_id(); b.st = st;
    if (threadIdx.x == 0) (void)xb_add(&bar[XB_XCNT(b.x)], 1u);
    return b;
}
__device__ __forceinline__ void xcd_barrier_complete(unsigned* bar, unsigned x, unsigned& nloc, unsigned& nx) {
    const unsigned G = gridDim.x * gridDim.y * gridDim.z;
    unsigned sum, cnt, mine, sp = 0u;
    for (;;) {
        sum = 0u; cnt = 0u; mine = 0u;
#pragma unroll
        for (unsigned j = 0; j < 16; ++j) { const unsigned c = xb_ld(&bar[XB_XCNT(j)]); sum += c; cnt += (c > 0u) ? 1u : 0u; mine = (j == x) ? c : mine; }
        if (sum == G) break;
        __builtin_amdgcn_s_sleep(1);
        if ((++sp & 255u) == 0u) { if (xb_ld(&bar[XB_TMO])) break; if (sp > XB_SPIN_CAP) { atomicAdd(&bar[XB_TMO], 1u); break; } }
    }
    nloc = mine > 0u ? mine : 1u; nx = cnt > 0u ? cnt : 1u;
}

__device__ __forceinline__ void xcd_barrier(const XcdBarrier& b) {
    asm volatile("s_waitcnt vmcnt(0)" ::: "memory");
    __syncthreads();
    if (threadIdx.x == 0) {
        unsigned* bar = b.bar;
        __builtin_amdgcn_s_waitcnt(0);
        unsigned nloc = b.st[0], nx = b.st[1];
        if (nloc == 0u) { xcd_barrier_complete(bar, b.x, nloc, nx); b.st[0] = nloc; b.st[1] = nx; }
        const unsigned old = xb_add(&bar[XB_XSUB(b.x)], 1u);
        const unsigned gen = old / nloc;
        if (old + 1u == (gen + 1u) * nloc) {
            __builtin_amdgcn_fence(__ATOMIC_RELEASE, "agent");
            asm volatile("s_waitcnt vmcnt(0)" ::: "memory");
            const unsigned og = xb_add(&bar[XB_TOP], 1u);
            const unsigned tg = og / nx;
            if (og + 1u == (tg + 1u) * nx) xb_add(&bar[XB_TOPGEN], 1u);
            else XB_SPIN(xb_ld(&bar[XB_TOPGEN]) == tg, bar);
            __builtin_amdgcn_fence(__ATOMIC_ACQUIRE, "agent");
            xb_add(&bar[XB_XGEN(b.x)], 1u);
            asm volatile("s_waitcnt vmcnt(0)" ::: "memory");
        } else {
            XB_SPIN(xb_ld(&bar[XB_XGEN(b.x)]) == gen, bar);
            __builtin_amdgcn_fence(__ATOMIC_ACQUIRE, "agent");
            asm volatile("s_waitcnt vmcnt(0)" ::: "memory");
        }
    }
    __syncthreads();
}
struct Frame {
    LAS unsigned char* lds;
    volatile LAS unsigned* MISC;
    gu32* ctl;
    int tid, lane, wave;
    int vcu, G;
    unsigned char* ws;
    __amdgpu_buffer_rsrc_t rsrc;
};

#define PHASE_FRAME(F0) Frame F = (F0); { int t_ = threadIdx.x; asm volatile("" : "+v"(t_)); F.tid = t_; F.lane = t_ & 63; F.wave = __builtin_amdgcn_readfirstlane(t_ >> 6); }

__device__ __forceinline__ void tr_item(const float* W, size_t ldw, int k0, int c0, bf16* WT, size_t ldt, int drow0, LAS float* scr, int lane) {
    const int kr = lane >> 4, cq = lane & 15;
    f32x4 v[16];
#pragma unroll
    for (int i = 0; i < 16; ++i) v[i] = *(const GAS f32x4*)(W + (size_t)(k0 + 4 * i + kr) * ldw + c0 + 4 * cq);
#pragma unroll
    for (int i = 0; i < 16; ++i)
#pragma unroll
        for (int j = 0; j < 4; ++j) scr[(4 * cq + j) * 65 + 4 * i + kr] = v[i][j];
    LDS_WAIT(); asm volatile("" ::: "memory");
    const int c = lane & 7;
#pragma unroll
    for (int jj = 0; jj < 8; ++jj) { const int n = (lane >> 3) + 8 * jj; const LAS float* s = scr + n * 65 + 8 * c;
        v4u o; o.x = pk2(s[0], s[1]); o.y = pk2(s[2], s[3]); o.z = pk2(s[4], s[5]); o.w = pk2(s[6], s[7]);
        *(GAS v4u*)(WT + (size_t)(drow0 + n) * ldt + k0 + 8 * c) = o; }
    LDS_WAIT(); asm volatile("" ::: "memory");
}

__device__ __forceinline__ void tr_item_f8(const float* W, size_t ldw, int k0, int c0, unsigned char* WT, size_t ldt, int drow0, LAS float* scr, int lane, float sc) {
    const int kr = lane >> 4, cq = lane & 15;
    f32x4 v[16];
#pragma unroll
    for (int i = 0; i < 16; ++i) v[i] = *(const GAS f32x4*)(W + (size_t)(k0 + 4 * i + kr) * ldw + c0 + 4 * cq);
#pragma unroll
    for (int i = 0; i < 16; ++i)
#pragma unroll
        for (int j = 0; j < 4; ++j) scr[(4 * cq + j) * 65 + 4 * i + kr] = v[i][j] * sc;
    LDS_WAIT(); asm volatile("" ::: "memory");
    const int c = lane & 3;
#pragma unroll
    for (int jj = 0; jj < 4; ++jj) { const int n = (lane >> 2) + 16 * jj; const LAS float* s = scr + n * 65 + 16 * c;
        int w[4];
#pragma unroll
        for (int q = 0; q < 4; ++q) { w[q] = __builtin_amdgcn_cvt_pk_fp8_f32(s[4 * q], s[4 * q + 1], 0, false); w[q] = __builtin_amdgcn_cvt_pk_fp8_f32(s[4 * q + 2], s[4 * q + 3], w[q], true); }
        *(GAS v4u*)(WT + (size_t)(drow0 + n) * ldt + k0 + 16 * c) = (v4u){(unsigned)w[0], (unsigned)w[1], (unsigned)w[2], (unsigned)w[3]}; }
    LDS_WAIT(); asm volatile("" ::: "memory");
}

struct In {
    const float *x, *w_in, *rel_bias, *shift_mu, *w0, *w_up, *a0, *a_up, *g_up, *k_k, *k_a, *r_k, *lnx_w, *lnx_b, *proj_a, *proj_b, *w_out,
                *ln1_w, *ln1_b, *w_router, *b_router, *w_gu, *b_gu, *w_down, *b_down, *ln2_w, *ln2_b;
};

__device__ __forceinline__ void p0_prologue(Frame& F0, const In& I) {
    PHASE_FRAME(F0);
    LAS float* scr = (LAS float*)(F.lds + F.wave * 16640);
    const int gw = F.vcu * NWAVES + F.wave, NGW = F.G * NWAVES;
    unsigned char* ws = F.ws;
    constexpr int J0 = 32 * 167, J1 = 16 * 32, J2 = 16 * 32, J3 = 32 * 32, J4 = 32 * 32 * 64, J5 = 32 * 32 * 32;
    constexpr int NITEMS = J0 + J1 + J2 + J3 + J4 + J5;
    for (int it = gw; it < NITEMS; it += NGW) {
        int r = it;
        if (r < J0) { const int kb = r / 167, cb = r % 167, c0 = cb * 64; bf16* dst; int drow;
            if (c0 < 2048) { dst = (bf16*)(ws + WS_WINT); drow = c0; }
            else if (c0 < 3072) { dst = (bf16*)(ws + WS_WVT); drow = c0 - 2048; }
            else if (c0 < 6592) { dst = (bf16*)(ws + WS_WINT); drow = PJ_SEG + (c0 - 3072); }
            else { dst = (bf16*)(ws + WS_WINT); drow = PJ_GA + (c0 - 6592); }
            tr_item(I.w_in, D_IN, kb * 64, c0, dst, D, drow, scr, F.lane); continue; } r -= J0;
        if (r < J1) { const int kb = r / 32, cb = r % 32; tr_item(I.proj_a, D, kb * 64, cb * 64, (bf16*)(ws + WS_PAT), AW, cb * 64, scr, F.lane); continue; } r -= J1;
        if (r < J2) { const int kb = r / 32, cb = r % 32; tr_item(I.proj_b, D, kb * 64, cb * 64, (bf16*)(ws + WS_PBT), RW, cb * 64, scr, F.lane); continue; } r -= J2;
        if (r < J3) { const int kb = r / 32, cb = r % 32; tr_item(I.w_out, D, kb * 64, cb * 64, (bf16*)(ws + WS_WOT), D, cb * 64, scr, F.lane); continue; } r -= J3;
        if (r < J4) { const int e = r / 2048, q = r % 2048, kb = q / 64, cb = q % 64, c0 = cb * 64;
            const int cc = c0 & 2047, drow = (cc >> 7) * 256 + (c0 >= 2048 ? 128 : 0) + (cc & 127);
            tr_item_f8(I.w_gu + (size_t)e * D * 2 * FF, 2 * FF, kb * 64, c0, (unsigned char*)(ws + WS_WGUT) + (size_t)e * 2 * FF * D, D, drow, scr, F.lane, 64.0f); continue; } r -= J4;
        { const int e = r / 1024, q = r % 1024, kb = q / 32, cb = q % 32;
            tr_item_f8(I.w_down + (size_t)e * FF * D, D, kb * 64, cb * 64, (unsigned char*)(ws + WS_WDNT) + (size_t)e * D * FF, FF, cb * 64, scr, F.lane, 64.0f); }
    }
    const int gt = F.vcu * (NWAVES * 64) + F.tid, NGT = F.G * NWAVES * 64;
    for (int i = gt; i < 2048 * 256; i += NGT) { const int n = i >> 8, k = i & 255; float v = 0.f;
        if (n < 1024) { if (k < DLORA) v = I.w_up[(size_t)k * RW + n]; }
        else { if (k >= 128 && k < 128 + ALORA) v = I.a_up[(size_t)(k - 128) * RW + (n - 1024)]; }
        ((bf16*)(ws + WS_WLA))[i] = (bf16)f2bf(v); }
    for (int i = gt; i < 1024 * 256; i += NGT) { const int n = i >> 8, k = i & 255; ((bf16*)(ws + WS_WLG))[i] = (bf16)f2bf(I.g_up[(size_t)k * RW + n]); }
    for (int i = gt; i < 64 * D / 8; i += NGT) ((GAS v4u*)((bf16*)(ws + WS_WINT) + (size_t)(PJ_SEG + SHIFT_W) * D))[i] = (v4u){0u, 0u, 0u, 0u};
    for (int i = gt; i < RROWS; i += NGT) ((int*)(ws + WS_ROWSLOT))[i] = -1;
    for (size_t i = gt; i < (size_t)T * D / 8; i += NGT) { const f32x4 a = ((const GAS f32x4*)I.x)[2 * i], b = ((const GAS f32x4*)I.x)[2 * i + 1];
        v4u o; o.x = pk2(a.x, a.y); o.y = pk2(a.z, a.w); o.z = pk2(b.x, b.y); o.w = pk2(b.z, b.w); ((GAS v4u*)(ws + WS_XB16))[i] = o; }
}

constexpr int P8_HS = 0, P8_PITCH = 2052, P8_PART = 131328, P8_LOG = 147712, P8_HIST = 149760;
template <bool SKIP_MIX>
__device__ __forceinline__ void p8_ln_router(Frame& F0, const In& I) {
    PHASE_FRAME(F0);
    LAS float* hs = (LAS float*)(F.lds + P8_HS); LAS float* part = (LAS float*)(F.lds + P8_PART); LAS float* lg = (LAS float*)(F.lds + P8_LOG); LAS int* hist = (LAS int*)(F.lds + P8_HIST);
    const int lane = F.lane, w = F.wave;
    if (F.tid < 32) hist[F.tid] = 0;
    const int kq = lane >> 4, col = lane & 15;
    float ln_w[32], ln_b[32];
#pragma unroll
    for (int j = 0; j < 8; ++j) { const f32x4 a = *(const GAS f32x4*)(I.ln1_w + 4 * lane + 256 * j), b = *(const GAS f32x4*)(I.ln1_b + 4 * lane + 256 * j);
#pragma unroll
        for (int e = 0; e < 4; ++e) { ln_w[4 * j + e] = a[e]; ln_b[4 * j + e] = b[e]; } }
    __syncthreads();
    const float* zsrc = SKIP_MIX ? I.x : (const float*)(F.ws + WS_Z);
    for (int g = F.vcu; g < T / 16; g += F.G) {
        const int tok0 = g * 16;
#pragma unroll 1
        for (int tt = 0; tt < 2; ++tt) {
            const int tl = 2 * w + tt; const size_t tok = (size_t)(tok0 + tl);
            const GAS f32x4* zr = (const GAS f32x4*)(zsrc + tok * D) + lane;
            f32x4 v[8]; float s = 0.f;
#pragma unroll
            for (int j = 0; j < 8; ++j) { v[j] = zr[64 * j]; if (SKIP_MIX) v[j] = v[j] * DN_ALPHA; s += (v[j].x + v[j].y) + (v[j].z + v[j].w); }
            const float mean = wave_sum(s) * (1.f / D); float s2 = 0.f;
#pragma unroll
            for (int j = 0; j < 8; ++j) { v[j] = v[j] - mean; s2 += (v[j].x * v[j].x + v[j].y * v[j].y) + (v[j].z * v[j].z + v[j].w * v[j].w); }
            const float rstd = 1.f / sqrtf(wave_sum(s2) * (1.f / D) + LN_EPS);
            GAS f32x4* h1 = (GAS f32x4*)((float*)(F.ws + WS_H1) + tok * D) + lane;
            GAS unsigned* h1b = (GAS unsigned*)((unsigned char*)(F.ws + WS_H1B) + tok * D) + lane;
#pragma unroll
            for (int j = 0; j < 8; ++j) { f32x4 h;
#pragma unroll
                for (int e = 0; e < 4; ++e) h[e] = v[j][e] * rstd * ln_w[4 * j + e] + ln_b[4 * j + e];
                h1[64 * j] = h; { int w8 = __builtin_amdgcn_cvt_pk_fp8_f32(h.x, h.y, 0, false); w8 = __builtin_amdgcn_cvt_pk_fp8_f32(h.z, h.w, w8, true); h1b[64 * j] = (unsigned)w8; }
                *(LAS f32x4*)(hs + tl * P8_PITCH + 4 * lane + 256 * j) = h; }
        }
        __syncthreads();
        f32x4 c0 = (f32x4){0.f, 0.f, 0.f, 0.f}, c1 = c0;
        const LAS float* ap = hs + col * P8_PITCH + 256 * w + 4 * kq;
        const float* bp = I.w_router + (size_t)(256 * w + 4 * kq) * NE + col;
#pragma unroll 4
        for (int kk = 0; kk < 16; ++kk) {
            const f32x4 a = *(const LAS f32x4*)(ap + 16 * kk);
#pragma unroll
            for (int e = 0; e < 4; ++e) {
                const float b0 = bp[(size_t)(16 * kk + e) * NE], b1 = bp[(size_t)(16 * kk + e) * NE + 16];
                c0 = __builtin_amdgcn_mfma_f32_16x16x4f32(a[e], b0, c0, 0, 0, 0);
                c1 = __builtin_amdgcn_mfma_f32_16x16x4f32(a[e], b1, c1, 0, 0, 0);
            }
        }
#pragma unroll
        for (int i = 0; i < 4; ++i) { part[(w * 16 + 4 * kq + i) * 32 + col] = c0[i]; part[(w * 16 + 4 * kq + i) * 32 + 16 + col] = c1[i]; }
        __syncthreads();
        { const int tl = F.tid >> 5, e = F.tid & 31; float s = I.b_router[e];
#pragma unroll
            for (int ww = 0; ww < 8; ++ww) s += part[(ww * 16 + tl) * 32 + e];
            lg[tl * 32 + e] = s; }
        __syncthreads();
        if (F.tid < 16) {
            const int tl = F.tid; float lv[32];
#pragma unroll
            for (int e = 0; e < 32; ++e) lv[e] = lg[tl * 32 + e];
            int ti[4]; float tv[4];
#pragma unroll
            for (int k = 0; k < 4; ++k) { float best = -3.4e38f; int bi = 0;
#pragma unroll
                for (int e = 0; e < 32; ++e) { const bool tk = lv[e] > best; best = tk ? lv[e] : best; bi = tk ? e : bi; }
                ti[k] = bi; tv[k] = best;
#pragma unroll
                for (int e = 0; e < 32; ++e) lv[e] = (e == bi) ? -3.4e38f : lv[e]; }
            float ex[4], sum = 0.f;
#pragma unroll
            for (int k = 0; k < 4; ++k) { ex[k] = __expf(tv[k] - tv[0]); sum += ex[k]; }
            const float inv = 1.f / sum;
            *(GAS v4u*)((int*)(F.ws + WS_TOPI) + (size_t)(tok0 + tl) * 4) = (v4u){(unsigned)ti[0], (unsigned)ti[1], (unsigned)ti[2], (unsigned)ti[3]};
            *(GAS f32x4*)((float*)(F.ws + WS_GATE) + (size_t)(tok0 + tl) * 4) = (f32x4){ex[0] * inv, ex[1] * inv, ex[2] * inv, ex[3] * inv};
#pragma unroll
            for (int k = 0; k < 4; ++k) __hip_atomic_fetch_add(&hist[ti[k]], 1, __ATOMIC_RELAXED, __HIP_MEMORY_SCOPE_WORKGROUP);
        }
        __syncthreads();
    }
    if (F.tid < 32) { const int c = hist[F.tid]; if (c) __hip_atomic_fetch_add(F.ctl + CW_CNT + F.tid, (unsigned)c, RLX_AGENT); }
}

template <bool SKIP_MOE>
__device__ __forceinline__ void p12_final(Frame& F0, const In& I, float* out) {
    PHASE_FRAME(F0);
    const int lane = F.lane; const int gw = F.vcu * NWAVES + F.wave, NGW = F.G * NWAVES;
    float ln_w[32], ln_b[32];
#pragma unroll
    for (int j = 0; j < 8; ++j) { const f32x4 a = *(const GAS f32x4*)(I.ln2_w + 4 * lane + 256 * j), b = *(const GAS f32x4*)(I.ln2_b + 4 * lane + 256 * j);
#pragma unroll
        for (int e = 0; e < 4; ++e) { ln_w[4 * j + e] = a[e]; ln_b[4 * j + e] = b[e]; } }
    for (int tok = gw; tok < T; tok += NGW) {
        const GAS f32x4* hr = (const GAS f32x4*)((const float*)(F.ws + WS_H1) + (size_t)tok * D) + lane;
        f32x4 v[8]; float s = 0.f;
#pragma unroll
        for (int j = 0; j < 8; ++j) v[j] = hr[64 * j] * DN_ALPHA;
        if (!SKIP_MOE) {
#pragma unroll
            for (int k = 0; k < 4; ++k) { const GAS v2u* yr = (const GAS v2u*)((const bf16*)(F.ws + WS_YSLOT) + ((size_t)tok * 4 + k) * D) + lane;
#pragma unroll
                for (int j = 0; j < 8; ++j) { const v2u y = yr[64 * j]; v[j].x += bflo(y.x); v[j].y += bfhi(y.x); v[j].z += bflo(y.y); v[j].w += bfhi(y.y); } }
        }
#pragma unroll
        for (int j = 0; j < 8; ++j) s += (v[j].x + v[j].y) + (v[j].z + v[j].w);
        const float mean = wave_sum(s) * (1.f / D); float s2 = 0.f;
#pragma unroll
        for (int j = 0; j < 8; ++j) { v[j] = v[j] - mean; s2 += (v[j].x * v[j].x + v[j].y * v[j].y) + (v[j].z * v[j].z + v[j].w * v[j].w); }
        const float rstd = 1.f / sqrtf(wave_sum(s2) * (1.f / D) + LN_EPS);
        GAS f32x4* o = (GAS f32x4*)(out + (size_t)tok * D) + lane;
#pragma unroll
        for (int j = 0; j < 8; ++j) { f32x4 h;
#pragma unroll
            for (int e = 0; e < 4; ++e) h[e] = v[j][e] * rstd * ln_w[4 * j + e] + ln_b[4 * j + e];
            o[64 * j] = h; }
    }
}
__device__ __forceinline__ void moe_tables(Frame& F) {
    LAS int* tab = (LAS int*)(F.lds + TAB_OFF);
    if (F.tid == 0) { int run = 0;
        for (int e = 0; e < NE; ++e) { const int c = (int)__hip_atomic_load(F.ctl + CW_CNT + e, RLX_AGENT); const int p = (c + 255) / 256 * 256; tab[32 + e] = run; run += p; tab[e] = run; }
        tab[64] = run / 256; }
    __syncthreads();
}

__device__ __forceinline__ void p9_scatter(Frame& F0, const In& I) {
    PHASE_FRAME(F0);
    moe_tables(F);
    LAS int* tab = (LAS int*)(F.lds + TAB_OFF);
    LAS int* lh = (LAS int*)(F.lds + 0);
    LAS int* lb = (LAS int*)(F.lds + 128);
    LAS int* dst = (LAS int*)(F.lds + 256);
    const int* topi = (const int*)(F.ws + WS_TOPI); const float* gate = (const float*)(F.ws + WS_GATE);
    for (int ch = F.vcu; ch < T / 128; ch += F.G) {
        if (F.tid < 32) lh[F.tid] = 0;
        __syncthreads();
        const int s = ch * 512 + F.tid; const int e = topi[s]; const float gv = gate[s];
        const int rank = __hip_atomic_fetch_add(&lh[e], 1, __ATOMIC_RELAXED, __HIP_MEMORY_SCOPE_WORKGROUP);
        __syncthreads();
        if (F.tid < 32) { const int c = lh[F.tid]; lb[F.tid] = c ? (int)__hip_atomic_fetch_add(F.ctl + CW_CUR + F.tid, (unsigned)c, RLX_AGENT) : 0; }
        __syncthreads();
        const int d = tab[32 + e] + lb[e] + rank;
        ((int*)(F.ws + WS_ROWSLOT))[d] = s; ((float*)(F.ws + WS_ROWW))[d] = gv; dst[F.tid] = d;
        __syncthreads();
        for (int i = F.wave; i < 512; i += NWAVES) {
            const int tok = ch * 128 + (i >> 2); const int dd = dst[i];
            const GAS v4u* src = (const GAS v4u*)((const unsigned char*)(F.ws + WS_H1B) + (size_t)tok * D) + F.lane;
            GAS v4u* o = (GAS v4u*)((unsigned char*)(F.ws + WS_XG) + (size_t)dd * D) + F.lane;
            v4u v[2];
#pragma unroll
            for (int j = 0; j < 2; ++j) v[j] = src[64 * j];
#pragma unroll
            for (int j = 0; j < 2; ++j) o[64 * j] = v[j];
        }
        __syncthreads();
    }
}

__device__ __forceinline__ void p10_moe_up(Frame& F0, const In& I) {
    PHASE_FRAME(F0);
    moe_tables(F);
    LAS int* tab = (LAS int*)(F.lds + TAB_OFF);
    pg8::SchedMoe S; S.t.init(tab[64], 16, F.G, (int)blockIdx.x);
    S.A = (unsigned)(WS_XG); S.B = (unsigned)(WS_WGUT); S.tsA = (unsigned)256 * D; S.tsB = (unsigned)256 * D; S.es = (unsigned)2 * FF * D; S.pad_end = tab;
    pg8::EpiSwiglu E{(unsigned char*)(F.ws + WS_ACT), I.b_gu};
    pg8::gemm_phase<pg8::EpiSwiglu, pg8::SchedMoe, true, true>(F.lds + RING_OFF, F.rsrc, D / 2, D / 2, D / 2, S, E);
}
__device__ __forceinline__ void p11_moe_down(Frame& F0, const In& I) {
    PHASE_FRAME(F0);
    moe_tables(F);
    LAS int* tab = (LAS int*)(F.lds + TAB_OFF);
    pg8::SchedMoe S; S.t.init(tab[64], 8, F.G, (int)blockIdx.x);
    S.A = (unsigned)(WS_ACT); S.B = (unsigned)(WS_WDNT); S.tsA = (unsigned)256 * FF; S.tsB = (unsigned)256 * FF; S.es = (unsigned)D * FF; S.pad_end = tab;
    pg8::EpiDown E{(bf16*)(F.ws + WS_YSLOT), I.b_down, (const int*)(F.ws + WS_ROWSLOT), (const float*)(F.ws + WS_ROWW)};
    pg8::gemm_phase<pg8::EpiDown, pg8::SchedMoe, true, true>(F.lds + RING_OFF, F.rsrc, FF / 2, FF / 2, FF / 2, S, E);
}

__device__ __forceinline__ void p1_proj(Frame& F0, const In& I) {
    PHASE_FRAME(F0);
    { pg8::SchedPlain S; S.t.init(T / 256, PROJ_LD / 256, F.G, (int)blockIdx.x);
      S.A = (unsigned)(WS_XB16); S.B = (unsigned)(WS_WINT); S.tsA = (unsigned)256 * D * 2; S.tsB = (unsigned)256 * D * 2;
      pg8::EpiProj E{(bf16*)(F.ws + WS_PROJ)};
      pg8::gemm_phase<pg8::EpiProj, pg8::SchedPlain, true>(F.lds + RING_OFF, F.rsrc, D, D, D, S, E); }
    { pg8::SchedPlain S; S.t.init(AW / 256, T / 256, F.G, (int)blockIdx.x);
      S.A = (unsigned)(WS_WVT); S.B = (unsigned)(WS_XB16); S.tsA = (unsigned)256 * D * 2; S.tsB = (unsigned)256 * D * 2;
      pg8::EpiBf16 E{(bf16*)(F.ws + WS_VT), T};
      pg8::gemm_phase<pg8::EpiBf16, pg8::SchedPlain, true>(F.lds + RING_OFF, F.rsrc, D, D, D, S, E); }
}

__device__ __forceinline__ float ftanh(float x) { return 2.0f * fsigmoid(2.0f * x) - 1.0f; }
__device__ __forceinline__ void p2_shift_attn(Frame& F0, const In& I) {
    PHASE_FRAME(F0);
    const int lane = F.lane; const int gw = F.vcu * NWAVES + F.wave, NGW = F.G * NWAVES;
    const bf16* PROJ = (const bf16*)(F.ws + WS_PROJ);
    for (int tok = gw; tok < T; tok += NGW) {
        const bool first = (tok % SEQ) == 0;
        const bf16* cur = PROJ + (size_t)tok * PROJ_LD + PJ_SEG; const bf16* prv = cur - PROJ_LD;
        bf16* rkv = (bf16*)(F.ws + WS_RKV) + (size_t)tok * (3 * RW); bf16* lin = (bf16*)(F.ws + WS_LORAIN) + (size_t)tok * LORA_LD;
#pragma unroll 1
        for (int it = 0; it < 7; ++it) { const int gi = it * 64 + lane; if (gi >= SHIFT_W / 8) break; const int c = gi * 8;
            const v4u cv = *(const GAS v4u*)(cur + c); v4u pv = (v4u){0u, 0u, 0u, 0u}; if (!first) pv = *(const GAS v4u*)(prv + c);
            const f32x4 m0 = *(const GAS f32x4*)(I.shift_mu + c), m1 = *(const GAS f32x4*)(I.shift_mu + c + 4);
            float v[8]; const unsigned cw[4] = {cv.x, cv.y, cv.z, cv.w}, pw[4] = {pv.x, pv.y, pv.z, pv.w};
#pragma unroll
            for (int j = 0; j < 4; ++j) { const float c0 = bflo(cw[j]), c1 = bfhi(cw[j]), p0 = bflo(pw[j]), p1 = bfhi(pw[j]); const float mu0 = (j < 2) ? m0[2 * j] : m1[2 * j - 4], mu1 = (j < 2) ? m0[2 * j + 1] : m1[2 * j - 3];
                v[2 * j] = c0 + (p0 - c0) * mu0; v[2 * j + 1] = c1 + (p1 - c1) * mu1; }
            bf16* dstp;
            if (c < 3 * RW) dstp = rkv + c;
            else if (c < 3 * RW + DLORA) { dstp = lin + (c - 3 * RW);
#pragma unroll
                for (int j = 0; j < 8; ++j) v[j] = ftanh(v[j]); }
            else if (c < 3 * RW + DLORA + ALORA) dstp = lin + 128 + (c - 3 * RW - DLORA);
            else { dstp = lin + 256 + (c - 3 * RW - DLORA - ALORA);
#pragma unroll
                for (int j = 0; j < 8; ++j) v[j] = fsigmoid(v[j]); }
            *(GAS v4u*)dstp = (v4u){pk2(v[0], v[1]), pk2(v[2], v[3]), pk2(v[4], v[5]), pk2(v[6], v[7])};
        }
        if (lane < 8) { const int c = (lane < 4) ? (DLORA + 8 * lane) : (128 + ALORA + 8 * (lane - 4)); *(GAS v4u*)(lin + c) = (v4u){0u, 0u, 0u, 0u}; }
    }
#if STAGE == 3
    { const int gt = F.vcu * (NWAVES * 64) + F.tid, NGT = F.G * NWAVES * 64;
      for (size_t i = gt; i < (size_t)T * RW / 8; i += NGT) ((GAS v4u*)(F.ws + WS_YB))[i] = (v4u){0u, 0u, 0u, 0u}; }
#endif
    LAS float* tbl = (LAS float*)(F.lds + 0);
    const bf16* VT = (const bf16*)(F.ws + WS_VT); bf16* YA = (bf16*)(F.ws + WS_YA);
    const int r = lane & 31, hh = lane >> 5;
    for (int grp = F.vcu; grp < BATCH * AH * 4; grp += F.G) {
        const int bh = grp >> 2, b = bh >> 4, h = bh & 15, qb0 = (grp & 3) * 64;
        __syncthreads();
        if (F.tid < REL_TABLE) tbl[F.tid] = I.rel_bias[h * REL_TABLE + F.tid];
        __syncthreads();
#pragma unroll 1
        for (int i8 = 0; i8 < 8; ++i8) {
            const int qb = qb0 + F.wave + 8 * i8, q0 = qb * 32, c = q0 >> 6;
            const size_t tokq = (size_t)b * SEQ + q0 + r;
            bf16x8 qf[4];
#pragma unroll
            for (int s = 0; s < 4; ++s) qf[s] = *(const GAS bf16x8*)(PROJ + tokq * PROJ_LD + PJ_Q + h * 64 + 16 * s + 8 * hh);
            f32x16 o0, o1;
#pragma unroll
            for (int i = 0; i < 16; ++i) { o0[i] = 0.f; o1[i] = 0.f; }
            float m_run = -1e30f, l_run = 0.f;
            const int kt0 = (c > LEFT ? c - LEFT : 0) * 2, kt1 = (c + 1) * 2;
#pragma unroll 1
            for (int kt = kt0; kt < kt1; ++kt) {
                const int kpos0 = kt * 32; const size_t tokk = (size_t)b * SEQ + kpos0 + r;
                bf16x8 kf[4];
#pragma unroll
                for (int s = 0; s < 4; ++s) kf[s] = *(const GAS bf16x8*)(PROJ + tokk * PROJ_LD + PJ_K + h * 64 + 16 * s + 8 * hh);
                bf16x4 vlo[2][2], vhi[2][2];
#pragma unroll
                for (int mt = 0; mt < 2; ++mt)
#pragma unroll
                    for (int s2 = 0; s2 < 2; ++s2) { const bf16* vr = VT + (size_t)(h * 64 + 32 * mt + r) * T + (size_t)b * SEQ + kpos0 + 16 * s2 + 4 * hh;
                        vlo[mt][s2] = *(const GAS bf16x4*)vr; vhi[mt][s2] = *(const GAS bf16x4*)(vr + 8); }
                f32x16 st;
#pragma unroll
                for (int i = 0; i < 16; ++i) st[i] = 0.f;
#pragma unroll
                for (int s = 0; s < 4; ++s) st = __builtin_amdgcn_mfma_f32_32x32x16_bf16(kf[s], qf[s], st, 0, 0, 0);
                const int dbase = (q0 + r) - (kpos0 + 4 * hh);
                float mx = -1e30f;
#pragma unroll
                for (int i = 0; i < 16; ++i) { int d = dbase - ((i & 3) + 8 * (i >> 2)); d = d < MAX_PAST ? d : MAX_PAST; st[i] += tbl[d + 63]; mx = fmaxf(mx, st[i]); }
                mx = fmaxf(mx, __shfl_xor(mx, 32));
                const float m_new = fmaxf(m_run, mx), alpha = __expf(m_run - m_new);
                float ls = 0.f;
#pragma unroll
                for (int i = 0; i < 16; ++i) { st[i] = __expf(st[i] - m_new); ls += st[i]; }
                l_run = l_run * alpha + ls; m_run = m_new;
#pragma unroll
                for (int i = 0; i < 16; ++i) { o0[i] *= alpha; o1[i] *= alpha; }
#pragma unroll
                for (int s2 = 0; s2 < 2; ++s2) {
                    v4u pw; pw.x = pk2(st[8 * s2 + 0], st[8 * s2 + 1]); pw.y = pk2(st[8 * s2 + 2], st[8 * s2 + 3]); pw.z = pk2(st[8 * s2 + 4], st[8 * s2 + 5]); pw.w = pk2(st[8 * s2 + 6], st[8 * s2 + 7]);
                    const bf16x8 pf = __builtin_bit_cast(bf16x8, pw);
                    bf16x8 va, vb;
#pragma unroll
                    for (int j = 0; j < 4; ++j) { va[j] = vlo[0][s2][j]; va[4 + j] = vhi[0][s2][j]; vb[j] = vlo[1][s2][j]; vb[4 + j] = vhi[1][s2][j]; }
                    o0 = __builtin_amdgcn_mfma_f32_32x32x16_bf16(va, pf, o0, 0, 0, 0);
                    o1 = __builtin_amdgcn_mfma_f32_32x32x16_bf16(vb, pf, o1, 0, 0, 0);
                }
            }
            const float inv = 1.0f / (l_run + __shfl_xor(l_run, 32));
            bf16* yo = YA + tokq * AW + h * 64 + 4 * hh;
#pragma unroll
            for (int g4 = 0; g4 < 4; ++g4) {
                *(GAS v2u*)(yo + 8 * g4) = (v2u){pk2(o0[4 * g4] * inv, o0[4 * g4 + 1] * inv), pk2(o0[4 * g4 + 2] * inv, o0[4 * g4 + 3] * inv)};
                *(GAS v2u*)(yo + 32 + 8 * g4) = (v2u){pk2(o1[4 * g4] * inv, o1[4 * g4 + 1] * inv), pk2(o1[4 * g4 + 2] * inv, o1[4 * g4 + 3] * inv)};
            }
        }
    }
}

__device__ __forceinline__ void p6_merged(Frame& F0, const In& I) {
    PHASE_FRAME(F0);
    pg8::SchedTwo S; S.t.init(T / 256, D / 256, F.G, (int)blockIdx.x);
    S.A0 = (unsigned)(WS_YA); S.A1 = (unsigned)(WS_YB); S.B0 = (unsigned)(WS_PAT); S.B1 = (unsigned)(WS_PBT);
    S.tsA = (unsigned)256 * AW * 2; S.tsB = (unsigned)256 * AW * 2;
    pg8::EpiMerged E{(const bf16*)(F.ws + WS_PROJ), (bf16*)(F.ws + WS_MERGED)};
    pg8::gemm_phase<pg8::EpiMerged, pg8::SchedTwo, true>(F.lds + RING_OFF, F.rsrc, AW, AW, AW, S, E);
}
__device__ __forceinline__ void p7_mix(Frame& F0, const In& I) {
    PHASE_FRAME(F0);
    pg8::SchedPlain S; S.t.init(T / 256, D / 256, F.G, (int)blockIdx.x);
    S.A = (unsigned)(WS_MERGED); S.B = (unsigned)(WS_WOT); S.tsA = (unsigned)256 * D * 2; S.tsB = (unsigned)256 * D * 2;
    pg8::EpiZ E{I.x, (float*)(F.ws + WS_Z)};
    pg8::gemm_phase<pg8::EpiZ, pg8::SchedPlain, true>(F.lds + RING_OFF, F.rsrc, D, D, D, S, E);
}

__device__ __forceinline__ void p3_lora(Frame& F0, const In& I) {
    PHASE_FRAME(F0);
    { pg8::SchedPlain S; S.t.init(T / 256, 4, F.G, (int)blockIdx.x);
      S.A = (unsigned)(WS_LORAIN); S.B = (unsigned)(WS_WLA); S.tsA = (unsigned)256 * LORA_LD * 2; S.tsB = (unsigned)256 * 256 * 2;
      pg8::EpiLoraA<true> E{(float*)(F.ws + WS_DECAY), I.w0};
      pg8::gemm_phase<pg8::EpiLoraA<true>, pg8::SchedPlain, true>(F.lds + RING_OFF, F.rsrc, LORA_LD, 256, 256, S, E); }
    { pg8::SchedPlain S; S.t.init(T / 256, 4, F.G, (int)blockIdx.x);
      S.A = (unsigned)(WS_LORAIN); S.B = (unsigned)(WS_WLA + (size_t)1024 * 256 * 2); S.tsA = (unsigned)256 * LORA_LD * 2; S.tsB = (unsigned)256 * 256 * 2;
      pg8::EpiLoraA<false> E{(float*)(F.ws + WS_ICLR), I.a0};
      pg8::gemm_phase<pg8::EpiLoraA<false>, pg8::SchedPlain, true>(F.lds + RING_OFF, F.rsrc, LORA_LD, 256, 256, S, E); }
    { pg8::SchedPlain S; S.t.init(T / 256, 4, F.G, (int)blockIdx.x);
      S.A = (unsigned)(WS_LORAIN + 512); S.B = (unsigned)(WS_WLG); S.tsA = (unsigned)256 * LORA_LD * 2; S.tsB = (unsigned)256 * 256 * 2;
      pg8::EpiBf16 E{(bf16*)(F.ws + WS_G), RW};
      pg8::gemm_phase<pg8::EpiBf16, pg8::SchedPlain, true>(F.lds + RING_OFF, F.rsrc, LORA_LD, 256, 256, S, E); }
}

constexpr int SC_TC = 32, SC_ARR = SC_TC * 64, SC_BUF = 5 * SC_ARR;
constexpr int SC_V_OFF = 2 * SC_BUF, SC_Y_OFF = SC_V_OFF + 2 * SC_TC * 16;
#define SC_BAR() do { asm volatile("s_waitcnt lgkmcnt(0)" ::: "memory"); __builtin_amdgcn_s_barrier(); asm volatile("" ::: "memory"); } while (0)
__device__ __forceinline__ void p4_scan(Frame& F0, const In& I) {
    PHASE_FRAME(F0);
    LAS float* L = (LAS float*)(F.lds + 0);
    const int lane = F.lane;
    const bf16* RKV = (const bf16*)(F.ws + WS_RKV); const float* DEC = (const float*)(F.ws + WS_DECAY); const float* ICL = (const float*)(F.ws + WS_ICLR);
    float* YS = (float*)(F.ws + WS_YSCAN);
    constexpr int NCH = SEQ / SC_TC;
    for (int unit = F.vcu; unit < BATCH * RH * 4; unit += F.G) {
        const int bh = unit >> 2, rq = unit & 3, b = bh >> 4, h = bh & 15;
        const size_t tok_base = (size_t)b * SEQ;
        __syncthreads();
        if (F.wave >= 4) {
            const int lw = F.wave - 4; const int hc = h * 64 + lane;
            const float kkp = I.k_k[hc], kap = I.k_a[hc];
            unsigned short rr_[8], kk_[8], vv_[8]; float dc_[8], ic_[8];
#define SC_LOAD(ch) do { _Pragma("unroll") for (int i = 0; i < 8; ++i) { const size_t tok = tok_base + (size_t)(ch) * SC_TC + lw + 4 * i; \
                rr_[i] = RKV[tok * (3 * RW) + hc]; kk_[i] = RKV[tok * (3 * RW) + RW + hc]; vv_[i] = RKV[tok * (3 * RW) + 2 * RW + h * 64 + rq * 16 + (lane & 15)]; \
                dc_[i] = DEC[tok * RW + hc]; ic_[i] = ICL[tok * RW + hc]; } } while (0)
#define SC_WRITE(ch) do { LAS float* B_ = L + ((ch) & 1) * SC_BUF; LAS float* V_ = L + SC_V_OFF + ((ch) & 1) * (SC_TC * 16); \
            _Pragma("unroll") for (int i = 0; i < 8; ++i) { const int s = lw + 4 * i; const float rr = bf2f(rr_[i]), k0 = bf2f(kk_[i]), ic = ic_[i]; \
                const float kkv = k0 * kkp; const float n2 = wave_sum(kkv * kkv); const float kkn = kkv / fmaxf(sqrtf(n2), 1e-12f); \
                B_[0 * SC_ARR + s * 64 + lane] = rr; B_[1 * SC_ARR + s * 64 + lane] = dc_[i]; B_[2 * SC_ARR + s * 64 + lane] = k0 * (1.0f + (ic - 1.0f) * kap); \
                B_[3 * SC_ARR + s * 64 + lane] = -kkn; B_[4 * SC_ARR + s * 64 + lane] = kkn * ic; if (lane < 16) V_[s * 16 + lane] = bf2f(vv_[i]); } } while (0)
#define SC_FLUSH(ch) do { const LAS float* Y_ = L + SC_Y_OFF + ((ch) & 1) * (SC_TC * 16); const int lt = lw * 64 + lane; \
            _Pragma("unroll") for (int i = 0; i < 2; ++i) { const int idx = lt + 256 * i, s = idx >> 4, j = idx & 15; \
                YS[(tok_base + (size_t)(ch) * SC_TC + s) * RW + h * 64 + rq * 16 + j] = Y_[idx]; } } while (0)
            SC_LOAD(0); SC_WRITE(0); SC_LOAD(1);
            SC_BAR();
#pragma unroll 1
            for (int ch = 0; ch < NCH; ++ch) {
                if (ch + 1 < NCH) SC_WRITE(ch + 1);
                if (ch + 2 < NCH) SC_LOAD(ch + 2);
                SC_BAR();
            }
#undef SC_LOAD
#undef SC_WRITE
#undef SC_FLUSH
        } else {
            const int cw = F.wave, kq = lane & 15, row = 4 * cw + (lane >> 4);
            f32x4 S = (f32x4){0.f, 0.f, 0.f, 0.f};
            SC_BAR();
#pragma unroll 1
            for (int ch = 0; ch < NCH; ++ch) {
                const LAS float* B_ = L + (ch & 1) * SC_BUF + 4 * kq; const LAS float* V_ = L + SC_V_OFF + (ch & 1) * (SC_TC * 16) + row; float* Yg = YS + (tok_base + (size_t)ch * SC_TC) * RW + h * 64 + rq * 16 + row;
                float ysel = 0.f;
                f32x4 R4[3], W4[3], K4[3], A4[3], B4[3]; float VV[3];
#define SC_LD(s, q) do { R4[q] = *(const LAS f32x4*)(B_ + 0 * SC_ARR + (s) * 64); W4[q] = *(const LAS f32x4*)(B_ + 1 * SC_ARR + (s) * 64); K4[q] = *(const LAS f32x4*)(B_ + 2 * SC_ARR + (s) * 64); \
                         A4[q] = *(const LAS f32x4*)(B_ + 3 * SC_ARR + (s) * 64); B4[q] = *(const LAS f32x4*)(B_ + 4 * SC_ARR + (s) * 64); VV[q] = V_[(s) * 16]; } while (0)
                SC_LD(0, 0); SC_LD(1, 1);
#pragma unroll
                for (int s = 0; s < SC_TC; ++s) {
                    if (s + 2 < SC_TC) SC_LD(s + 2, (s + 2) % 3);
                    __builtin_amdgcn_sched_barrier(0);
                    const int q = s % 3;
                    float sa = (S.x * A4[q].x + S.y * A4[q].y) + (S.z * A4[q].z + S.w * A4[q].w);
                    sa = rowsum16(sa);
                    S = S * W4[q] + (B4[q] * sa + K4[q] * VV[q]);
                    float y = (S.x * R4[q].x + S.y * R4[q].y) + (S.z * R4[q].z + S.w * R4[q].w);
                    y = rowsum16(y);
                    ysel = (kq == (s & 15)) ? y : ysel;
                    if ((s & 15) == 15) Yg[(size_t)(s - 15 + kq) * RW] = ysel;
                    __builtin_amdgcn_sched_barrier(0);
                }
#undef SC_LD
                SC_BAR();
            }
        }
    }
}

__device__ __forceinline__ void p5_post(Frame& F0, const In& I) {
    PHASE_FRAME(F0);
    const int lane = F.lane; const int gw = F.vcu * NWAVES + F.wave, NGW = F.G * NWAVES;
    const bf16* RKV = (const bf16*)(F.ws + WS_RKV); const float* ICL = (const float*)(F.ws + WS_ICLR); const float* YS = (const float*)(F.ws + WS_YSCAN);
    const bf16* G = (const bf16*)(F.ws + WS_G); bf16* YB = (bf16*)(F.ws + WS_YB);
    const int c0 = lane * 16;
    for (int tok = gw; tok < T; tok += NGW) {
        float y[16], rr[16], kk[16], vv[16], ic[16], gg[16];
#pragma unroll
        for (int q = 0; q < 4; ++q) { const f32x4 a = *(const GAS f32x4*)(YS + (size_t)tok * RW + c0 + 4 * q), c = *(const GAS f32x4*)(ICL + (size_t)tok * RW + c0 + 4 * q);
#pragma unroll
            for (int e = 0; e < 4; ++e) { y[4 * q + e] = a[e]; ic[4 * q + e] = c[e]; } }
#pragma unroll
        for (int q = 0; q < 2; ++q) {
            const v4u a = *(const GAS v4u*)(RKV + (size_t)tok * (3 * RW) + c0 + 8 * q), bb = *(const GAS v4u*)(RKV + (size_t)tok * (3 * RW) + RW + c0 + 8 * q),
                      c = *(const GAS v4u*)(RKV + (size_t)tok * (3 * RW) + 2 * RW + c0 + 8 * q), d = *(const GAS v4u*)(G + (size_t)tok * RW + c0 + 8 * q);
            const unsigned aw[4] = {a.x, a.y, a.z, a.w}, bw[4] = {bb.x, bb.y, bb.z, bb.w}, cw[4] = {c.x, c.y, c.z, c.w}, dw[4] = {d.x, d.y, d.z, d.w};
#pragma unroll
            for (int e = 0; e < 4; ++e) { rr[8 * q + 2 * e] = bflo(aw[e]); rr[8 * q + 2 * e + 1] = bfhi(aw[e]); kk[8 * q + 2 * e] = bflo(bw[e]); kk[8 * q + 2 * e + 1] = bfhi(bw[e]);
                vv[8 * q + 2 * e] = bflo(cw[e]); vv[8 * q + 2 * e + 1] = bfhi(cw[e]); gg[8 * q + 2 * e] = bflo(dw[e]); gg[8 * q + 2 * e + 1] = bfhi(dw[e]); } }
        float s = 0.f, bs = 0.f;
#pragma unroll
        for (int e = 0; e < 16; ++e) { s += y[e]; const float kp = kk[e] * (1.0f + (ic[e] - 1.0f) * I.k_a[c0 + e]); bs += rr[e] * kp * I.r_k[c0 + e]; }
        s = quadsum(s); bs = quadsum(bs);
        const float mean = s * (1.f / 64.f); float s2 = 0.f;
#pragma unroll
        for (int e = 0; e < 16; ++e) { y[e] -= mean; s2 += y[e] * y[e]; }
        s2 = quadsum(s2);
        const float rstd = 1.f / sqrtf(s2 * (1.f / 64.f) + GN_EPS);
        float o[16];
#pragma unroll
        for (int e = 0; e < 16; ++e) o[e] = (y[e] * rstd * I.lnx_w[c0 + e] + I.lnx_b[c0 + e] + bs * vv[e]) * gg[e];
#pragma unroll
        for (int q = 0; q < 2; ++q) *(GAS v4u*)(YB + (size_t)tok * RW + c0 + 8 * q) = (v4u){pk2(o[8 * q], o[8 * q + 1]), pk2(o[8 * q + 2], o[8 * q + 3]), pk2(o[8 * q + 4], o[8 * q + 5]), pk2(o[8 * q + 6], o[8 * q + 7])};
    }
}
#ifndef STAGE
#define STAGE 4
#endif
struct Args { In in; float* out; unsigned char* ws; };
__global__ void __launch_bounds__(NWAVES * 64, 2) mk_fwd(Args args) {
    extern __shared__ __attribute__((aligned(16))) unsigned char lds[];
    Frame F;
    F.lds = (LAS unsigned char*)lds;
    F.MISC = (volatile LAS unsigned*)(F.lds + MISC_OFF);
    F.tid = threadIdx.x; F.lane = F.tid & 63; F.wave = __builtin_amdgcn_readfirstlane(F.tid >> 6);
    F.G = gridDim.x; { const int bx = blockIdx.x; F.vcu = (F.G % 8 == 0) ? (bx % 8) * (F.G / 8) + bx / 8 : bx; }
    F.ws = args.ws;
    F.rsrc = __builtin_amdgcn_make_buffer_rsrc(args.ws, 0, 0xffffffff, 0x00020000);
    F.ctl = (gu32*)(args.ws + WS_CTL);
    for (int u = F.tid; u < (LDS_BYTES - MISC_OFF) / 4; u += NWAVES * 64) ((LAS unsigned*)(F.lds + MISC_OFF))[u] = 0u;
    __syncthreads();
    XcdBarrier bar = xcd_barrier_post((unsigned*)(F.ctl + CW_BAR), F.MISC + 8);
    const In& I = args.in;
#define GRID_BAR() xcd_barrier(bar)
#ifndef DUP_PHASE
#define DUP_PHASE -1
#endif
#define RUN(n, call) do { call; if (DUP_PHASE == (n)) { GRID_BAR(); call; } } while (0)

#if STAGE >= 2
    RUN(0, p0_prologue(F, I));
    GRID_BAR();
#endif
#if STAGE >= 3
    RUN(1, p1_proj(F, I));
    GRID_BAR();
    RUN(2, p2_shift_attn(F, I));
    GRID_BAR();
#if STAGE >= 4
    RUN(3, p3_lora(F, I));
    GRID_BAR();
    RUN(4, p4_scan(F, I));
    GRID_BAR();
    RUN(5, p5_post(F, I));
    GRID_BAR();
#endif
    RUN(6, p6_merged(F, I));
    GRID_BAR();
    RUN(7, p7_mix(F, I));
    GRID_BAR();
#endif
    p8_ln_router<(STAGE < 3)>(F, I);
    GRID_BAR();
#if STAGE >= 2
    p9_scatter(F, I);
    GRID_BAR();
    RUN(10, p10_moe_up(F, I));
    GRID_BAR();
    RUN(11, p11_moe_down(F, I));
    GRID_BAR();
#endif
    RUN(12, p12_final<(STAGE < 2)>(F, I, args.out));
}

extern "C" void kernel_launch(void* const* d_in, const int* in_sizes, int n_in, void* d_out, int out_size, void* d_ws, size_t ws_size, hipStream_t stream) {
    static int grid = 0;
    if (grid == 0) {
        if (n_in != 27 || in_sizes[0] != T * D || out_size != T * D || ws_size < WS_END) { fprintf(stderr, "kernel_launch: unexpected shapes (n_in %d, in0 %d, out %d, ws %zu)\n", n_in, n_in > 0 ? in_sizes[0] : -1, out_size, ws_size); grid = -1; return; }
        int dev = 0, cus = 0, per_cu = 0;
        if (hipGetDevice(&dev) != hipSuccess || hipDeviceGetAttribute(&cus, hipDeviceAttributeMultiprocessorCount, dev) != hipSuccess) { grid = -1; return; }
        if (hipFuncSetAttribute((const void*)mk_fwd, hipFuncAttributeMaxDynamicSharedMemorySize, LDS_BYTES) != hipSuccess) { fprintf(stderr, "kernel_launch: hipFuncSetAttribute failed\n"); grid = -1; return; }
        if (hipOccupancyMaxActiveBlocksPerMultiprocessor(&per_cu, (const void*)mk_fwd, NWAVES * 64, LDS_BYTES) != hipSuccess || per_cu < 1)
            fprintf(stderr, "kernel_launch: occupancy query reports %d\n", per_cu);
        (void)hipGetLastError();
        grid = cus;
    }
    if (grid < 0) return;
    if (hipMemsetAsync((char*)d_ws + WS_CTL, 0, CTL_ZERO_BYTES, stream) != hipSuccess) return;
    Args a{};
    const float** ip = (const float**)&a.in;
    for (int i = 0; i < 27; ++i) ip[i] = (const float*)d_in[i];
    a.out = (float*)d_out; a.ws = (unsigned char*)d_ws;
    hipLaunchKernelGGL(mk_fwd, dim3(grid), dim3(NWAVES * 64), LDS_BYTES, stream, a);
    const hipError_t le = hipPeekAtLastError();
    if (le != hipSuccess) fprintf(stderr, "kernel_launch: launch failed: %s\n", hipGetErrorName(le));
}
```

```cpp
#define STAGE 4
#include <hip/hip_runtime.h>
#include <cstdio>
#include <cstdint>

#define GAS __attribute__((address_space(1)))
#define LAS __attribute__((address_space(3)))
typedef unsigned short bf16;
typedef unsigned v4u __attribute__((ext_vector_type(4)));
typedef unsigned v2u __attribute__((ext_vector_type(2)));
typedef float f32x4 __attribute__((ext_vector_type(4)));
typedef float f32x2 __attribute__((ext_vector_type(2)));
typedef float f32x16 __attribute__((ext_vector_type(16)));
typedef short bf16x8 __attribute__((ext_vector_type(8)));
typedef short bf16x4 __attribute__((ext_vector_type(4)));
typedef GAS unsigned gu32;

constexpr int NWAVES = 8;
constexpr int BATCH = 4, SEQ = 8192, D = 2048, T = BATCH * SEQ;
constexpr int CHUNK = 64, LEFT = 8, AH = 16, AD = 64, AW = 1024;
constexpr int REL_TABLE = 320, MAX_PAST = 256;
constexpr int RH = 16, RN = 64, RW = 1024, DLORA = 96, ALORA = 96, GLORA = 256;
constexpr int SHIFT_W = 3 * RW + DLORA + ALORA + GLORA;
constexpr int D_IN = 3 * AW + SHIFT_W + 2 * D;
constexpr int NE = 32, TOPK = 4, FF = 2048;
constexpr int MSLOT = T * TOPK;
constexpr int NBLK_MAX = (MSLOT + NE * 255 + 255) / 256;
constexpr int RROWS = NBLK_MAX * 256;
constexpr float LN_EPS = 1e-5f, GN_EPS = 64e-5f;
constexpr float DN_ALPHA = 1.189207115002721f;
constexpr int PROJ_LD = 9728, PJ_Q = 0, PJ_K = 1024, PJ_SEG = 2048, SEG_PAD = 3584, PJ_GA = 5632, PJ_GB = 7680;
constexpr int LORA_LD = 512;

constexpr size_t MiB = 1u << 20;
constexpr size_t WS_CTL = 0, CTL_ZERO_BYTES = 1 * MiB;
constexpr size_t WS_TOPI = 2 * MiB;
constexpr size_t WS_GATE = 3 * MiB;
constexpr size_t WS_ROWSLOT = 4 * MiB;
constexpr size_t WS_ROWW = 5 * MiB;
constexpr size_t WS_WLA = 6 * MiB;
constexpr size_t WS_WLG = 7 * MiB;
constexpr size_t WS_PAT = 8 * MiB;
constexpr size_t WS_PBT = 12 * MiB;
constexpr size_t WS_WOT = 16 * MiB;
constexpr size_t WS_WVT = 24 * MiB;
constexpr size_t WS_WINT = 28 * MiB;
constexpr size_t WS_WGUT = 128 * MiB;
constexpr size_t WS_WDNT = 640 * MiB;
constexpr size_t WS_BASE0 = 1024 * MiB;
constexpr size_t WS_PROJ = WS_BASE0;
constexpr size_t WS_VT = WS_PROJ + 608 * MiB;
constexpr size_t WS_YA = WS_VT + 64 * MiB;
constexpr size_t WS_RKV = WS_YA + 64 * MiB;
constexpr size_t WS_LORAIN = WS_RKV + 192 * MiB;
constexpr size_t WS_DECAY = WS_LORAIN + 32 * MiB;
constexpr size_t WS_ICLR = WS_DECAY + 128 * MiB;
constexpr size_t WS_G = WS_ICLR + 128 * MiB;
constexpr size_t WS_YSCAN = WS_G + 64 * MiB;
constexpr size_t WS_YB = WS_YSCAN + 128 * MiB;
constexpr size_t WS_MERGED = WS_YB + 64 * MiB;
constexpr size_t WS_XB16 = WS_MERGED + 128 * MiB;
constexpr size_t WS_MIX_END = WS_XB16 + 128 * MiB;
constexpr size_t WS_Z = 2816 * MiB;
constexpr size_t WS_H1 = 3072 * MiB;
constexpr size_t WS_H1B = 3328 * MiB;
constexpr size_t WS_END = 3456 * MiB;
constexpr size_t WS_XG = WS_BASE0;
constexpr size_t WS_ACT = WS_BASE0 + 544 * MiB;
constexpr size_t WS_YSLOT = WS_BASE0 + 1088 * MiB;
static_assert(WS_MIX_END <= WS_Z && WS_YSLOT + 512 * MiB <= WS_Z, "ws map");
static_assert(WS_WINT + (size_t)PROJ_LD * D * 2 <= WS_WGUT, "ws map");

constexpr int CW_CNT = 512;
constexpr int CW_CUR = 576;
constexpr int CW_BAR = 4096;

constexpr int RING_OFF = 0, RING_BYTES = 131072;
constexpr int LDS_BYTES = 160 * 1024;
constexpr int MISC_OFF = LDS_BYTES - 512;
constexpr int TAB_OFF = LDS_BYTES - 1024;

#define RLX_AGENT __ATOMIC_RELAXED, __HIP_MEMORY_SCOPE_AGENT
#define LDS_WAIT() asm volatile("s_waitcnt lgkmcnt(0)" ::: "memory")
#define VM_WAIT() asm volatile("s_waitcnt vmcnt(0)" ::: "memory")
__device__ __forceinline__ unsigned f2bf(float f) { unsigned u = __builtin_bit_cast(unsigned, f); return (u + 0x7fffu + ((u >> 16) & 1u)) >> 16; }
__device__ __forceinline__ unsigned pk2(float lo, float hi) { return f2bf(lo) | (f2bf(hi) << 16); }
__device__ __forceinline__ float bf2f(unsigned short h) { return __builtin_bit_cast(float, (unsigned)h << 16); }
__device__ __forceinline__ float bflo(unsigned w) { return __builtin_bit_cast(float, w << 16); }
__device__ __forceinline__ float bfhi(unsigned w) { return __builtin_bit_cast(float, w & 0xffff0000u); }
__device__ __forceinline__ float fsigmoid(float x) { return __builtin_amdgcn_rcpf(1.0f + __expf(-x)); }
__device__ __forceinline__ float dpp_f(float x, const int ctrl_sel) {
    const int xi = __builtin_bit_cast(int, x); int r;
    if (ctrl_sel == 0) r = __builtin_amdgcn_update_dpp(0, xi, 0xB1, 0xF, 0xF, false);
    else if (ctrl_sel == 1) r = __builtin_amdgcn_update_dpp(0, xi, 0x4E, 0xF, 0xF, false);
    else if (ctrl_sel == 2) r = __builtin_amdgcn_update_dpp(0, xi, 0x124, 0xF, 0xF, false);
    else r = __builtin_amdgcn_update_dpp(0, xi, 0x128, 0xF, 0xF, false);
    return __builtin_bit_cast(float, r);
}
__device__ __forceinline__ float rowsum16(float x) { x += dpp_f(x, 0); x += dpp_f(x, 1); x += dpp_f(x, 2); x += dpp_f(x, 3); return x; }
__device__ __forceinline__ float quadsum(float x) { x += dpp_f(x, 0); x += dpp_f(x, 1); return x; }
__device__ __forceinline__ float wave_sum(float v) {
    v = rowsum16(v);
    const int vi = __builtin_bit_cast(int, v);
    const float s0 = __builtin_bit_cast(float, __builtin_amdgcn_readlane(vi, 0)), s1 = __builtin_bit_cast(float, __builtin_amdgcn_readlane(vi, 16));
    const float s2 = __builtin_bit_cast(float, __builtin_amdgcn_readlane(vi, 32)), s3 = __builtin_bit_cast(float, __builtin_amdgcn_readlane(vi, 48));
    return (s0 + s1) + (s2 + s3);
}
namespace pg8 {
#define PG8_LAS __attribute__((address_space(3)))
typedef unsigned short bf16_t;
typedef unsigned u32x4 __attribute__((ext_vector_type(4)));
constexpr int BM = 256, BK = 64, HALF = 128, HTB = HALF * BK * 2, STAGE_BYTES = 8 * HTB, NXCD = 8, WGM = 8;

__host__ __device__ __forceinline__ int lds_byte(int r, int c) { const int st = (r >> 4) * 2 + (c >> 5), rr = r & 15, cc = c & 31, ob = rr * 64 + cc * 2; return st * 1024 + (ob ^ (((ob >> 9) & 1) << 5)); }
__host__ __device__ __forceinline__ void stage_rc(int b, int& R, int& C) { const int st = b / 1024, sb = b % 1024, swz = sb ^ (((sb >> 9) & 1) << 5); R = (st >> 1) * 16 + swz / 64; C = (st & 1) * 32 + (swz % 64) / 2; }
__host__ __device__ __forceinline__ int perm32(int rho) { const int n = rho >> 4, i = rho & 15; return 8 * (i >> 2) + 4 * n + (i & 3); }

struct Unit { int pm, pn, aux; };

struct Tiler {
    int nM, nN, nwg, G, c;
    __device__ __forceinline__ void init(int nM_, int nN_, int G_, int c_) { nM = nM_; nN = nN_; nwg = nM * nN; G = G_; c = c_; }
    __device__ __forceinline__ bool map(int i, int& pm, int& pn) const {
        const long L = (long)i * G + c; if (L >= nwg) return false;
        int wgid = (int)L; { const int q = nwg / NXCD, r = nwg % NXCD, xcd = wgid % NXCD, off = wgid / NXCD; wgid = (xcd < r ? xcd * (q + 1) : r * (q + 1) + (xcd - r) * q) + off; }
        const int nig = WGM * nN, gid = wgid / nig, fm = gid * WGM, gsz = (nM - fm) < WGM ? (nM - fm) : WGM;
        pm = fm + ((wgid % nig) % gsz); pn = (wgid % nig) / gsz; return true;
    }
};
struct SchedPlain {
    Tiler t; unsigned A, B, tsA, tsB;
    __device__ __forceinline__ bool next(int i, Unit& u) const { u.aux = 0; return t.map(i, u.pm, u.pn); }
    __device__ __forceinline__ void bases(const Unit& u, unsigned& a, unsigned& b) const { a = A + (unsigned)u.pm * tsA; b = B + (unsigned)u.pn * tsB; }
};
struct SchedTwo {
    Tiler t; unsigned A0, A1, B0, B1, tsA, tsB;
    __device__ __forceinline__ bool next(int i, Unit& u) const { u.aux = i & 1; return t.map(i >> 1, u.pm, u.pn); }
    __device__ __forceinline__ void bases(const Unit& u, unsigned& a, unsigned& b) const { a = (u.aux ? A1 : A0) + (unsigned)u.pm * tsA; b = (u.aux ? B1 : B0) + (unsigned)u.pn * tsB; }
};
struct SchedMoe {
    Tiler t; unsigned A, B, tsA, tsB, es; const PG8_LAS int* pad_end;
    __device__ __forceinline__ bool next(int i, Unit& u) const {
        if (!t.map(i, u.pm, u.pn)) return false;
        const int row0 = u.pm * BM; int e = 0;
#pragma unroll
        for (int j = 0; j < 32; ++j) e += (pad_end[j] <= row0) ? 1 : 0;
        u.aux = __builtin_amdgcn_readfirstlane(e < 31 ? e : 31); return true;
    }
    __device__ __forceinline__ void bases(const Unit& u, unsigned& a, unsigned& b) const { a = A + (unsigned)u.pm * tsA; b = B + (unsigned)u.aux * es + (unsigned)u.pn * tsB; }
};

__device__ __forceinline__ unsigned cvt_pk_bf16(float lo, float hi) { unsigned r; asm volatile("v_cvt_pk_bf16_f32 %0, %1, %2" : "=v"(r) : "v"(lo), "v"(hi)); return r; }
__device__ __forceinline__ u32x4 pack8(const f32x4& v0, const f32x4& v1) { u32x4 w; w.x = cvt_pk_bf16(v0[0], v0[1]); w.y = cvt_pk_bf16(v0[2], v0[3]); w.z = cvt_pk_bf16(v1[0], v1[1]); w.w = cvt_pk_bf16(v1[2], v1[3]); return w; }

typedef int i32x8 __attribute__((ext_vector_type(8)));
typedef int i32x4 __attribute__((ext_vector_type(4)));
__device__ __forceinline__ i32x8 cat8(const bf16x8& a, const bf16x8& b) { return __builtin_shufflevector(__builtin_bit_cast(i32x4, a), __builtin_bit_cast(i32x4, b), 0, 1, 2, 3, 4, 5, 6, 7); }
constexpr int F8_SCALES = 0x00007f79;
template <class Epi, class Sched, bool ALIGN_EPI, bool F8 = false>
__device__ __forceinline__ void gemm_phase(PG8_LAS unsigned char* lds, const __amdgpu_buffer_rsrc_t rsrc, const int lda, const int ldb, const int K, const Sched& S, const Epi& E) {
    int tid_ = threadIdx.x; asm volatile("" : "+v"(tid_));
    const int tid = tid_, wid = __builtin_amdgcn_readfirstlane(tid >> 6), lane = tid & 63, wr = wid >> 2, wc = wid & 3, fr = lane & 15, fq = lane >> 4;
    const int nt = K / BK;
    unsigned voffA, voffB;
    { int R, C; stage_rc(tid * 16, R, C); const int Rb = (R & ~31) + perm32(R & 31); voffA = (unsigned)(R * lda + C) * 2u; voffB = (unsigned)(Rb * ldb + C) * 2u; }
    const unsigned p1voffA = 64u * (unsigned)lda * 2u, p1voffB = 64u * (unsigned)ldb * 2u;
    const unsigned kstep = (unsigned)(BK * 2);
    const unsigned hsA = (unsigned)HALF * lda * 2, hsB = (unsigned)HALF * ldb * 2;
    const unsigned ldsw = (unsigned)wid * 1024u;
    const int aoff = lds_byte(wr * 64 + fr, fq * 8), boff = lds_byte(wc * 32 + fr, fq * 8);
#define PG8_SA(b, h) (((b) * 2 + (h)) * HTB)
#define PG8_SB(b, h) ((4 + (b) * 2 + (h)) * HTB)
#define PG8_STAGE(bufoff, goff, voff) do { _Pragma("unroll") for (int _i = 0; _i < 2; ++_i) \
        __builtin_amdgcn_raw_ptr_buffer_load_lds(rsrc, (PG8_LAS void*)(lds + (bufoff) + ldsw + _i * 8192), 16, (int)(voff), (int)((goff) + _i * p1##voff), 0, 0); } while (0)
#define PG8_LD8(addr) __builtin_shufflevector(*(const PG8_LAS i32x4*)(addr), *(const PG8_LAS i32x4*)((addr) + 1024), 0, 1, 2, 3, 4, 5, 6, 7)
#define PG8_LDA(dst, b, h) do { _Pragma("unroll") for (int m = 0; m < 4; ++m) dst[m] = PG8_LD8(lds + PG8_SA(b, h) + aoff + m * 2048); } while (0)
#define PG8_LDB(dst, b, h) do { _Pragma("unroll") for (int n = 0; n < 2; ++n) dst[n] = PG8_LD8(lds + PG8_SB(b, h) + boff + n * 2048); } while (0)
#define PG8_LO(v) __builtin_bit_cast(bf16x8, __builtin_shufflevector(v, v, 0, 1, 2, 3))
#define PG8_HI(v) __builtin_bit_cast(bf16x8, __builtin_shufflevector(v, v, 4, 5, 6, 7))
#define PG8_MMA(ai, bj, At, Bt) do { __builtin_amdgcn_s_setprio(1); \
        if constexpr (!F8) { _Pragma("unroll") for (int m = 0; m < 4; ++m) _Pragma("unroll") for (int n = 0; n < 2; ++n) { \
            acc[ai][bj][m][n] = __builtin_amdgcn_mfma_f32_16x16x32_bf16(PG8_LO(Bt[n]), PG8_LO(At[m]), acc[ai][bj][m][n], 0, 0, 0); \
            acc[ai][bj][m][n] = __builtin_amdgcn_mfma_f32_16x16x32_bf16(PG8_HI(Bt[n]), PG8_HI(At[m]), acc[ai][bj][m][n], 0, 0, 0); } } \
        else { _Pragma("unroll") for (int m = 0; m < 4; ++m) _Pragma("unroll") for (int n = 0; n < 2; ++n) \
            acc[ai][bj][m][n] = __builtin_amdgcn_mfma_scale_f32_16x16x128_f8f6f4(Bt[n], At[m], acc[ai][bj][m][n], 0, 0, 0, F8_SCALES, 1, F8_SCALES); } \
        __builtin_amdgcn_s_setprio(0); } while (0)
#define PG8_WAIT_V(n) asm volatile("s_waitcnt vmcnt(" #n ")" ::: "memory")
#define PG8_WAIT_L(n) asm volatile("s_waitcnt lgkmcnt(" #n ")" ::: "memory")
#define PG8_BAR __builtin_amdgcn_s_barrier()
#define PG8_SCHED __builtin_amdgcn_sched_barrier(0)
#define PG8_ZERO() do { _Pragma("unroll") for (int a = 0; a < 2; ++a) _Pragma("unroll") for (int b = 0; b < 2; ++b) _Pragma("unroll") for (int m = 0; m < 4; ++m) _Pragma("unroll") for (int n = 0; n < 2; ++n) acc[a][b][m][n] = (f32x4){0.f, 0.f, 0.f, 0.f}; } while (0)
    Unit cur, nxt; int ui = 0;
    if (!S.next(0, cur)) return;
    f32x4 acc[2][2][4][2];
    PG8_ZERO();
    i32x8 At[4], B0[2], B1[2];
    unsigned cA, cB; S.bases(cur, cA, cB); cA = __builtin_amdgcn_readfirstlane(cA); cB = __builtin_amdgcn_readfirstlane(cB);
    PG8_STAGE(PG8_SB(0, 0), cB, voffB); PG8_STAGE(PG8_SB(0, 1), cB + hsB, voffB); PG8_STAGE(PG8_SA(0, 0), cA, voffA); PG8_STAGE(PG8_SA(0, 1), cA + hsA, voffA);
    if (wr == 1) PG8_BAR;
    PG8_WAIT_V(2); PG8_BAR;
    PG8_STAGE(PG8_SB(1, 0), cB + kstep, voffB); PG8_STAGE(PG8_SA(1, 0), cA + kstep, voffA); PG8_STAGE(PG8_SB(1, 1), cB + hsB + kstep, voffB);
    PG8_WAIT_V(6); PG8_BAR;
    for (;;) {
        const bool has_next = S.next(ui + 1, nxt);
        unsigned nA = cA, nB = cB; if (has_next) { S.bases(nxt, nA, nB); nA = __builtin_amdgcn_readfirstlane(nA); nB = __builtin_amdgcn_readfirstlane(nB); }
#pragma unroll 1
        for (int t = 0; t < nt; t += 2) {
            const bool last = (t == nt - 2);
            const unsigned a1 = cA + (unsigned)(t + 1) * kstep;
            const unsigned a2 = last ? nA : cA + (unsigned)(t + 2) * kstep, b2 = last ? nB : cB + (unsigned)(t + 2) * kstep;
            const unsigned a3 = a2 + kstep, b3 = b2 + kstep;
            PG8_LDB(B0, 0, 0); PG8_LDB(B1, 0, 1); PG8_SCHED; PG8_LDA(At, 0, 0); PG8_STAGE(PG8_SA(1, 1), a1 + hsA, voffA);
            PG8_WAIT_V(8); PG8_WAIT_L(0); PG8_BAR; PG8_MMA(0, 0, At, B0); PG8_MMA(0, 1, At, B1); PG8_BAR; PG8_SCHED;
            PG8_LDA(At, 0, 1); PG8_STAGE(PG8_SB(0, 0), b2, voffB); PG8_STAGE(PG8_SB(0, 1), b2 + hsB, voffB); PG8_STAGE(PG8_SA(0, 0), a2, voffA);
            PG8_WAIT_V(8); PG8_WAIT_L(0); PG8_BAR; PG8_MMA(1, 0, At, B0); PG8_MMA(1, 1, At, B1); PG8_BAR; PG8_SCHED;
            PG8_LDB(B0, 1, 0); PG8_LDB(B1, 1, 1); PG8_SCHED; PG8_LDA(At, 1, 0); PG8_STAGE(PG8_SA(0, 1), a2 + hsA, voffA);
            PG8_WAIT_V(8); PG8_WAIT_L(0); PG8_BAR; PG8_MMA(0, 0, At, B0); PG8_MMA(0, 1, At, B1); PG8_BAR; PG8_SCHED;
            PG8_LDA(At, 1, 1); PG8_STAGE(PG8_SB(1, 0), b3, voffB); PG8_STAGE(PG8_SB(1, 1), b3 + hsB, voffB); PG8_STAGE(PG8_SA(1, 0), a3, voffA);
            PG8_WAIT_V(8); PG8_WAIT_L(0); PG8_BAR; PG8_MMA(1, 0, At, B0); PG8_MMA(1, 1, At, B1); PG8_BAR; PG8_SCHED;
        }
        if constexpr (ALIGN_EPI) { if (wr == 0) PG8_BAR; }
        bool keep; { int t2 = threadIdx.x; asm volatile("" : "+v"(t2)); const int w2 = __builtin_amdgcn_readfirstlane(t2 >> 6), l2 = t2 & 63; keep = E(acc, cur, w2 >> 2, w2 & 3, l2 & 15, l2 >> 4); }
        if (!has_next) break;
        if (!keep) PG8_ZERO();
        cur = nxt; cA = nA; cB = nB; ++ui;
        if constexpr (ALIGN_EPI) { if (wr == 1) PG8_BAR; }
    }
    PG8_WAIT_V(0);
    if constexpr (!ALIGN_EPI) { if (wr == 0) PG8_BAR; }
    PG8_BAR;
#undef PG8_SA
#undef PG8_SB
#undef PG8_STAGE
#undef PG8_LDA
#undef PG8_LDB
#undef PG8_LD8
#undef PG8_LO
#undef PG8_HI
#undef PG8_MMA
#undef PG8_WAIT_V
#undef PG8_WAIT_L
#undef PG8_BAR
#undef PG8_SCHED
#undef PG8_ZERO
}
}
namespace pg8 {
#define EPI_ROWLOOP _Pragma("unroll") for (int ai = 0; ai < 2; ++ai) _Pragma("unroll") for (int m = 0; m < 4; ++m)
struct EpiProj {
    bf16_t* O;
    __device__ __forceinline__ bool operator()(f32x4 (&acc)[2][2][4][2], const Unit& u, int wr, int wc, int fr, int fq) const {
        const int row0 = u.pm * BM + wr * 64 + fr, col0 = u.pn * BM + wc * 32 + 8 * fq;
        const int mode = (u.pn < 4) ? 1 : (u.pn >= 22 ? 2 : 0);
        EPI_ROWLOOP { bf16_t* rowp = O + (size_t)(row0 + ai * HALF + m * 16) * PROJ_LD + col0;
#pragma unroll
            for (int bj = 0; bj < 2; ++bj) { f32x4 v0 = acc[ai][bj][m][0], v1 = acc[ai][bj][m][1];
                if (mode == 1) { v0 = v0 * 0.125f; v1 = v1 * 0.125f; }
                else if (mode == 2) {
#pragma unroll
                    for (int j = 0; j < 4; ++j) { v0[j] = fsigmoid(v0[j]); v1[j] = fsigmoid(v1[j]); } }
                *(u32x4*)(rowp + bj * HALF) = pack8(v0, v1); } }
        return false;
    }
};
struct EpiBf16 {
    bf16_t* O; int ldc;
    __device__ __forceinline__ bool operator()(f32x4 (&acc)[2][2][4][2], const Unit& u, int wr, int wc, int fr, int fq) const {
        const int row0 = u.pm * BM + wr * 64 + fr, col0 = u.pn * BM + wc * 32 + 8 * fq;
        EPI_ROWLOOP { bf16_t* rowp = O + (size_t)(row0 + ai * HALF + m * 16) * ldc + col0;
#pragma unroll
            for (int bj = 0; bj < 2; ++bj) *(u32x4*)(rowp + bj * HALF) = pack8(acc[ai][bj][m][0], acc[ai][bj][m][1]); }
        return false;
    }
};
template <bool ISDEC> struct EpiLoraA {
    float* OUT; const float* par;
    __device__ __forceinline__ bool operator()(f32x4 (&acc)[2][2][4][2], const Unit& u, int wr, int wc, int fr, int fq) const {
        const int row0 = u.pm * BM + wr * 64 + fr, col0 = u.pn * BM + wc * 32 + 8 * fq;
        f32x4 pv[2][2];
#pragma unroll
        for (int bj = 0; bj < 2; ++bj)
#pragma unroll
            for (int n = 0; n < 2; ++n) pv[bj][n] = *(const f32x4*)(par + col0 + bj * HALF + 4 * n);
        EPI_ROWLOOP { float* rowp = OUT + (size_t)(row0 + ai * HALF + m * 16) * RW + col0;
#pragma unroll
            for (int bj = 0; bj < 2; ++bj)
#pragma unroll
                for (int n = 0; n < 2; ++n) { f32x4 v = acc[ai][bj][m][n] + pv[bj][n];
#pragma unroll
                    for (int j = 0; j < 4; ++j) {
                        if (ISDEC) { const float y = -v[j]; const float sp = fmaxf(y, 0.f) + __logf(1.0f + __expf(-fabsf(y))); const float w = -sp - 0.5f; v[j] = __expf(-__expf(w)); }
                        else v[j] = fsigmoid(v[j]); }
                    *(f32x4*)(rowp + bj * HALF + 4 * n) = v; } }
        return false;
    }
};
struct EpiMerged {
    const bf16_t* PROJ; bf16_t* O;
    __device__ __forceinline__ bool operator()(f32x4 (&acc)[2][2][4][2], const Unit& u, int wr, int wc, int fr, int fq) const {
        const int row0 = u.pm * BM + wr * 64 + fr, col0 = u.pn * BM + wc * 32 + 8 * fq;
        EPI_ROWLOOP { const int row = row0 + ai * HALF + m * 16; const bf16_t* gp = PROJ + (size_t)row * PROJ_LD + col0;
#pragma unroll
            for (int bj = 0; bj < 2; ++bj) {
                const u32x4 gb = *(const u32x4*)(gp + PJ_GB + bj * HALF);
                f32x4 b0 = (f32x4){bflo(gb.x), bfhi(gb.x), bflo(gb.y), bfhi(gb.y)}, b1 = (f32x4){bflo(gb.z), bfhi(gb.z), bflo(gb.w), bfhi(gb.w)};
                if (u.aux == 0) {
                    const u32x4 ga = *(const u32x4*)(gp + PJ_GA + bj * HALF);
                    f32x4 a0 = (f32x4){bflo(ga.x), bfhi(ga.x), bflo(ga.y), bfhi(ga.y)}, a1 = (f32x4){bflo(ga.z), bfhi(ga.z), bflo(ga.w), bfhi(ga.w)};
#pragma unroll
                    for (int j = 0; j < 4; ++j) { acc[ai][bj][m][0][j] *= a0[j] / fmaxf(b0[j], 1e-30f); acc[ai][bj][m][1][j] *= a1[j] / fmaxf(b1[j], 1e-30f); }
                } else {
                    *(u32x4*)(O + (size_t)row * D + col0 + bj * HALF) = pack8(acc[ai][bj][m][0] * b0, acc[ai][bj][m][1] * b1);
                } } }
        return u.aux == 0;
    }
};
struct EpiZ {
    const float* X; float* Z;
    __device__ __forceinline__ bool operator()(f32x4 (&acc)[2][2][4][2], const Unit& u, int wr, int wc, int fr, int fq) const {
        const int row0 = u.pm * BM + wr * 64 + fr, col0 = u.pn * BM + wc * 32 + 8 * fq;
        EPI_ROWLOOP { const size_t off = (size_t)(row0 + ai * HALF + m * 16) * D + col0;
#pragma unroll
            for (int bj = 0; bj < 2; ++bj)
#pragma unroll
                for (int n = 0; n < 2; ++n) { const f32x4 xv = *(const f32x4*)(X + off + bj * HALF + 4 * n); *(f32x4*)(Z + off + bj * HALF + 4 * n) = xv * DN_ALPHA + acc[ai][bj][m][n]; } }
        return false;
    }
};
struct EpiSwiglu {
    unsigned char* ACT; const float* bgu;
    __device__ __forceinline__ bool operator()(f32x4 (&acc)[2][2][4][2], const Unit& u, int wr, int wc, int fr, int fq) const {
        const int row0 = u.pm * BM + wr * 64 + fr, col0 = u.pn * HALF + wc * 32 + 8 * fq;
        const float* bp = bgu + (size_t)u.aux * (2 * FF) + col0;
        f32x4 bg[2], bu[2];
#pragma unroll
        for (int n = 0; n < 2; ++n) { bg[n] = *(const f32x4*)(bp + 4 * n); bu[n] = *(const f32x4*)(bp + FF + 4 * n); }
        EPI_ROWLOOP { f32x4 o[2];
#pragma unroll
            for (int n = 0; n < 2; ++n) { const f32x4 g = acc[ai][0][m][n] + bg[n], uu = acc[ai][1][m][n] + bu[n];
#pragma unroll
                for (int j = 0; j < 4; ++j) { const float gc = fminf(g[j], 7.0f), uc = fminf(fmaxf(uu[j], -7.0f), 7.0f); o[n][j] = (uc + 1.0f) * (gc * fsigmoid(1.702f * gc)); } }
            int w0 = __builtin_amdgcn_cvt_pk_fp8_f32(o[0][0], o[0][1], 0, false); w0 = __builtin_amdgcn_cvt_pk_fp8_f32(o[0][2], o[0][3], w0, true);
            int w1 = __builtin_amdgcn_cvt_pk_fp8_f32(o[1][0], o[1][1], 0, false); w1 = __builtin_amdgcn_cvt_pk_fp8_f32(o[1][2], o[1][3], w1, true);
            *(v2u*)(ACT + (size_t)(row0 + ai * HALF + m * 16) * FF + col0) = (v2u){(unsigned)w0, (unsigned)w1}; }
        return false;
    }
};
struct EpiDown {
    bf16_t* YS; const float* bdn; const int* rowslot; const float* roww;
    __device__ __forceinline__ bool operator()(f32x4 (&acc)[2][2][4][2], const Unit& u, int wr, int wc, int fr, int fq) const {
        const int row0 = u.pm * BM + wr * 64 + fr, col0 = u.pn * BM + wc * 32 + 8 * fq;
        const float* bp = bdn + (size_t)u.aux * D + col0;
        f32x4 bv[2][2];
#pragma unroll
        for (int bj = 0; bj < 2; ++bj)
#pragma unroll
            for (int n = 0; n < 2; ++n) bv[bj][n] = *(const f32x4*)(bp + bj * HALF + 4 * n);
        EPI_ROWLOOP { const int row = row0 + ai * HALF + m * 16; const int slot = rowslot[row]; const float w = roww[row];
            if (slot >= 0) { bf16_t* rowp = YS + (size_t)slot * D + col0;
#pragma unroll
                for (int bj = 0; bj < 2; ++bj) *(u32x4*)(rowp + bj * HALF) = pack8((acc[ai][bj][m][0] + bv[bj][0]) * w, (acc[ai][bj][m][1] + bv[bj][1]) * w); } }
        return false;
    }
};
#undef EPI_ROWLOOP
}

#define XB_TMO      128
#define XB_XCNT(j)  (256  + 64 * (j))
#define XB_XSUB(j)  (1280 + 64 * (j))
#define XB_XGEN(j)  (2304 + 64 * (j))
#define XB_TOP      3328
#define XB_TOPGEN   3392
#define XCD_BAR_WORDS 3456
#define XB_SPIN_CAP (1u << 18)

__device__ __forceinline__ unsigned xb_ld(unsigned* p)              { return __hip_atomic_load(p, __ATOMIC_RELAXED, __HIP_MEMORY_SCOPE_AGENT); }
__device__ __forceinline__ unsigned xb_add(unsigned* p, unsigned v) { return __hip_atomic_fetch_add(p, v, __ATOMIC_RELAXED, __HIP_MEMORY_SCOPE_AGENT); }
__device__ __forceinline__ unsigned xb_xcc_id() { return (unsigned)__builtin_amdgcn_s_getreg((3 << 11) | 20) & 0xFu; }
#define XB_SPIN(cond, bar) do { unsigned _sp = 0; while (cond) { __builtin_amdgcn_s_sleep(1); \
    if ((++_sp & 255u) == 0u) { if (xb_ld(&(bar)[XB_TMO])) break; if (_sp > XB_SPIN_CAP) { atomicAdd(&(bar)[XB_TMO], 1u); break; } } } } while (0)

struct XcdBarrier {
    unsigned* bar; unsigned x;
    volatile LAS unsigned* st;
};

__device__ __forceinline__ XcdBarrier xcd_barrier_post(unsigned* bar, volatile LAS unsigned* st) {
    XcdBarrier b; b.bar = bar; b.x = xb_xcc_id(); b.st = st;
    if (threadIdx.x == 0) (void)xb_add(&bar[XB_XCNT(b.x)], 1u);
    return b;
}
__device__ __forceinline__ void xcd_barrier_complete(unsigned* bar, unsigned x, unsigned& nloc, unsigned& nx) {
    const unsigned G = gridDim.x * gridDim.y * gridDim.z;
    unsigned sum, cnt, mine, sp = 0u;
    for (;;) {
        sum = 0u; cnt = 0u; mine = 0u;
#pragma unroll
        for (unsigned j = 0; j < 16; ++j) { const unsigned c = xb_ld(&bar[XB_XCNT(j)]); sum += c; cnt += (c > 0u) ? 1u : 0u; mine = (j == x) ? c : mine; }
        if (sum == G) break;
        __builtin_amdgcn_s_sleep(1);
        if ((++sp & 255u) == 0u) { if (xb_ld(&bar[XB_TMO])) break; if (sp > XB_SPIN_CAP) { atomicAdd(&bar[XB_TMO], 1u); break; } }
    }
    nloc = mine > 0u ? mine : 1u; nx = cnt > 0u ? cnt : 1u;
}

__device__ __forceinline__ void xcd_barrier(const XcdBarrier& b) {
    asm volatile("s_waitcnt vmcnt(0)" ::: "memory");
    __syncthreads();
    if (threadIdx.x == 0) {
        unsigned* bar = b.bar;
        __builtin_amdgcn_s_waitcnt(0);
        unsigned nloc = b.st[0], nx = b.st[1];
        if (nloc == 0u) { xcd_barrier_complete(bar, b.x, nloc, nx); b.st[0] = nloc; b.st[1] = nx; }
        const unsigned old = xb_add(&bar[XB_XSUB(b.x)], 1u);
        const unsigned gen = old / nloc;
        if (old + 1u == (gen + 1u) * nloc) {
            __builtin_amdgcn_fence(__ATOMIC_RELEASE, "agent");
            asm volatile("s_waitcnt vmcnt(0)" ::: "memory");
            const unsigned og = xb_add(&bar[XB_TOP], 1u);
            const unsigned tg = og / nx;
            if (og + 1u == (tg + 1u) * nx) xb_add(&bar[XB_TOPGEN], 1u);
            else XB_SPIN(xb_ld(&bar[XB_TOPGEN]) == tg, bar);
            __builtin_amdgcn_fence(__ATOMIC_ACQUIRE, "agent");
            xb_add(&bar[XB_XGEN(b.x)], 1u);
            asm volatile("s_waitcnt vmcnt(0)" ::: "memory");
        } else {
            XB_SPIN(xb_ld(&bar[XB_XGEN(b.x)]) == gen, bar);
            __builtin_amdgcn_fence(__ATOMIC_ACQUIRE, "agent");
            asm volatile("s_waitcnt vmcnt(0)" ::: "memory");
        }
    }
    __syncthreads();
}
struct Frame {
    LAS unsigned char* lds;
    volatile LAS unsigned* MISC;
    gu32* ctl;
    int tid, lane, wave;
    int vcu, G;
    unsigned char* ws;
    __amdgpu_buffer_rsrc_t rsrc;
};

#define PHASE_FRAME(F0) Frame F = (F0); { int t_ = threadIdx.x; asm volatile("" : "+v"(t_)); F.tid = t_; F.lane = t_ & 63; F.wave = __builtin_amdgcn_readfirstlane(t_ >> 6); }

__device__ __forceinline__ void tr_item(const float* W, size_t ldw, int k0, int c0, bf16* WT, size_t ldt, int drow0, LAS float* scr, int lane) {
    const int kr = lane >> 4, cq = lane & 15;
    f32x4 v[16];
#pragma unroll
    for (int i = 0; i < 16; ++i) v[i] = *(const GAS f32x4*)(W + (size_t)(k0 + 4 * i + kr) * ldw + c0 + 4 * cq);
#pragma unroll
    for (int i = 0; i < 16; ++i)
#pragma unroll
        for (int j = 0; j < 4; ++j) scr[(4 * cq + j) * 65 + 4 * i + kr] = v[i][j];
    LDS_WAIT(); asm volatile("" ::: "memory");
    const int c = lane & 7;
#pragma unroll
    for (int jj = 0; jj < 8; ++jj) { const int n = (lane >> 3) + 8 * jj; const LAS float* s = scr + n * 65 + 8 * c;
        v4u o; o.x = pk2(s[0], s[1]); o.y = pk2(s[2], s[3]); o.z = pk2(s[4], s[5]); o.w = pk2(s[6], s[7]);
        *(GAS v4u*)(WT + (size_t)(drow0 + n) * ldt + k0 + 8 * c) = o; }
    LDS_WAIT(); asm volatile("" ::: "memory");
}

__device__ __forceinline__ void tr8_load(const float* W, size_t ldw, int k0, int c0, f32x4 (&v)[16], int lane) {
    const int kr = lane >> 4, cq = lane & 15;
#pragma unroll
    for (int i = 0; i < 16; ++i) v[i] = *(const GAS f32x4*)(W + (size_t)(k0 + 4 * i + kr) * ldw + c0 + 4 * cq);
}
__device__ __forceinline__ void tr8_finish(const f32x4 (&v)[16], int k0, unsigned char* WT, size_t ldt, int drow0, LAS float* scr, int lane, float sc) {
    const int kr = lane >> 4, cq = lane & 15;
#pragma unroll
    for (int i = 0; i < 16; ++i)
#pragma unroll
        for (int j = 0; j < 4; ++j) scr[(4 * cq + j) * 65 + 4 * i + kr] = v[i][j] * sc;
    LDS_WAIT(); asm volatile("" ::: "memory");
    const int c = lane & 3;
#pragma unroll
    for (int jj = 0; jj < 4; ++jj) { const int n = (lane >> 2) + 16 * jj; const LAS float* s = scr + n * 65 + 16 * c;
        int w[4];
#pragma unroll
        for (int q = 0; q < 4; ++q) { w[q] = __builtin_amdgcn_cvt_pk_fp8_f32(s[4 * q], s[4 * q + 1], 0, false); w[q] = __builtin_amdgcn_cvt_pk_fp8_f32(s[4 * q + 2], s[4 * q + 3], w[q], true); }
        *(GAS v4u*)(WT + (size_t)(drow0 + n) * ldt + k0 + 16 * c) = (v4u){(unsigned)w[0], (unsigned)w[1], (unsigned)w[2], (unsigned)w[3]}; }
    LDS_WAIT(); asm volatile("" ::: "memory");
}
constexpr int MOE_J4 = 32 * 32 * 64, MOE_J5 = 32 * 32 * 32, MOE_NITEMS = MOE_J4 + MOE_J5;
struct MoeItem { const float* W; size_t ldw; int k0, c0; unsigned char* WT; size_t ldt; int drow; };
__device__ __forceinline__ MoeItem moe_item(int r, const float* w_gu, const float* w_down, unsigned char* ws) {
    MoeItem m;
    if (r < MOE_J4) { const int e = r / 2048, q = r % 2048, kb = q / 64, cb = q % 64, c0 = cb * 64; const int cc = c0 & 2047;
        m.W = w_gu + (size_t)e * D * 2 * FF; m.ldw = 2 * FF; m.k0 = kb * 64; m.c0 = c0; m.WT = ws + WS_WGUT + (size_t)e * 2 * FF * D; m.ldt = D; m.drow = (cc >> 7) * 256 + (c0 >= 2048 ? 128 : 0) + (cc & 127); }
    else { r -= MOE_J4; const int e = r / 1024, q = r % 1024, kb = q / 32, cb = q % 32;
        m.W = w_down + (size_t)e * FF * D; m.ldw = D; m.k0 = kb * 64; m.c0 = cb * 64; m.WT = ws + WS_WDNT + (size_t)e * D * FF; m.ldt = FF; m.drow = cb * 64; }
    return m;
}

struct In {
    const float *x, *w_in, *rel_bias, *shift_mu, *w0, *w_up, *a0, *a_up, *g_up, *k_k, *k_a, *r_k, *lnx_w, *lnx_b, *proj_a, *proj_b, *w_out,
                *ln1_w, *ln1_b, *w_router, *b_router, *w_gu, *b_gu, *w_down, *b_down, *ln2_w, *ln2_b;
};

__device__ __forceinline__ void p0_prologue(Frame& F0, const In& I) {
    PHASE_FRAME(F0);
    LAS float* scr = (LAS float*)(F.lds + F.wave * 16640);
    const int gw = F.vcu * NWAVES + F.wave, NGW = F.G * NWAVES;
    unsigned char* ws = F.ws;
    constexpr int J0 = 32 * 167, J1 = 16 * 32, J2 = 16 * 32, J3 = 32 * 32;
    constexpr int NITEMS = J0 + J1 + J2 + J3;
    for (int it = gw; it < NITEMS; it += NGW) {
        int r = it;
        if (r < J0) { const int kb = r / 167, cb = r % 167, c0 = cb * 64; bf16* dst; int drow;
            if (c0 < 2048) { dst = (bf16*)(ws + WS_WINT); drow = c0; }
            else if (c0 < 3072) { dst = (bf16*)(ws + WS_WVT); drow = c0 - 2048; }
            else if (c0 < 6592) { dst = (bf16*)(ws + WS_WINT); drow = PJ_SEG + (c0 - 3072); }
            else { dst = (bf16*)(ws + WS_WINT); drow = PJ_GA + (c0 - 6592); }
            tr_item(I.w_in, D_IN, kb * 64, c0, dst, D, drow, scr, F.lane); continue; } r -= J0;
        if (r < J1) { const int kb = r / 32, cb = r % 32; tr_item(I.proj_a, D, kb * 64, cb * 64, (bf16*)(ws + WS_PAT), AW, cb * 64, scr, F.lane); continue; } r -= J1;
        if (r < J2) { const int kb = r / 32, cb = r % 32; tr_item(I.proj_b, D, kb * 64, cb * 64, (bf16*)(ws + WS_PBT), RW, cb * 64, scr, F.lane); continue; } r -= J2;
        { const int kb = r / 32, cb = r % 32; tr_item(I.w_out, D, kb * 64, cb * 64, (bf16*)(ws + WS_WOT), D, cb * 64, scr, F.lane); }
    }
    const int gt = F.vcu * (NWAVES * 64) + F.tid, NGT = F.G * NWAVES * 64;
    for (int i = gt; i < 2048 * 256; i += NGT) { const int n = i >> 8, k = i & 255; float v = 0.f;
        if (n < 1024) { if (k < DLORA) v = I.w_up[(size_t)k * RW + n]; }
        else { if (k >= 128 && k < 128 + ALORA) v = I.a_up[(size_t)(k - 128) * RW + (n - 1024)]; }
        ((bf16*)(ws + WS_WLA))[i] = (bf16)f2bf(v); }
    for (int i = gt; i < 1024 * 256; i += NGT) { const int n = i >> 8, k = i & 255; ((bf16*)(ws + WS_WLG))[i] = (bf16)f2bf(I.g_up[(size_t)k * RW + n]); }
    for (int i = gt; i < 64 * D / 8; i += NGT) ((GAS v4u*)((bf16*)(ws + WS_WINT) + (size_t)(PJ_SEG + SHIFT_W) * D))[i] = (v4u){0u, 0u, 0u, 0u};
    for (int i = gt; i < RROWS; i += NGT) ((int*)(ws + WS_ROWSLOT))[i] = -1;
    for (size_t i = gt; i < (size_t)T * D / 8; i += NGT) { const f32x4 a = ((const GAS f32x4*)I.x)[2 * i], b = ((const GAS f32x4*)I.x)[2 * i + 1];
        v4u o; o.x = pk2(a.x, a.y); o.y = pk2(a.z, a.w); o.z = pk2(b.x, b.y); o.w = pk2(b.z, b.w); ((GAS v4u*)(ws + WS_XB16))[i] = o; }
}

constexpr int P8_HS = 0, P8_PITCH = 2052, P8_PART = 131328, P8_LOG = 147712, P8_HIST = 149760;
template <bool SKIP_MIX>
__device__ __forceinline__ void p8_ln_router(Frame& F0, const In& I) {
    PHASE_FRAME(F0);
    LAS float* hs = (LAS float*)(F.lds + P8_HS); LAS float* part = (LAS float*)(F.lds + P8_PART); LAS float* lg = (LAS float*)(F.lds + P8_LOG); LAS int* hist = (LAS int*)(F.lds + P8_HIST);
    const int lane = F.lane, w = F.wave;
    if (F.tid < 32) hist[F.tid] = 0;
    const int kq = lane >> 4, col = lane & 15;
    float ln_w[32], ln_b[32];
#pragma unroll
    for (int j = 0; j < 8; ++j) { const f32x4 a = *(const GAS f32x4*)(I.ln1_w + 4 * lane + 256 * j), b = *(const GAS f32x4*)(I.ln1_b + 4 * lane + 256 * j);
#pragma unroll
        for (int e = 0; e < 4; ++e) { ln_w[4 * j + e] = a[e]; ln_b[4 * j + e] = b[e]; } }
    __syncthreads();
    const float* zsrc = SKIP_MIX ? I.x : (const float*)(F.ws + WS_Z);
    for (int g = F.vcu; g < T / 16; g += F.G) {
        const int tok0 = g * 16;
#pragma unroll 1
        for (int tt = 0; tt < 2; ++tt) {
            const int tl = 2 * w + tt; const size_t tok = (size_t)(tok0 + tl);
            const GAS f32x4* zr = (const GAS f32x4*)(zsrc + tok * D) + lane;
            f32x4 v[8]; float s = 0.f;
#pragma unroll
            for (int j = 0; j < 8; ++j) { v[j] = zr[64 * j]; if (SKIP_MIX) v[j] = v[j] * DN_ALPHA; s += (v[j].x + v[j].y) + (v[j].z + v[j].w); }
            const float mean = wave_sum(s) * (1.f / D); float s2 = 0.f;
#pragma unroll
            for (int j = 0; j < 8; ++j) { v[j] = v[j] - mean; s2 += (v[j].x * v[j].x + v[j].y * v[j].y) + (v[j].z * v[j].z + v[j].w * v[j].w); }
            const float rstd = 1.f / sqrtf(wave_sum(s2) * (1.f / D) + LN_EPS);
            GAS f32x4* h1 = (GAS f32x4*)((float*)(F.ws + WS_H1) + tok * D) + lane;
            GAS unsigned* h1b = (GAS unsigned*)((unsigned char*)(F.ws + WS_H1B) + tok * D) + lane;
#pragma unroll
            for (int j = 0; j < 8; ++j) { f32x4 h;
#pragma unroll
                for (int e = 0; e < 4; ++e) h[e] = v[j][e] * rstd * ln_w[4 * j + e] + ln_b[4 * j + e];
                h1[64 * j] = h; { int w8 = __builtin_amdgcn_cvt_pk_fp8_f32(h.x, h.y, 0, false); w8 = __builtin_amdgcn_cvt_pk_fp8_f32(h.z, h.w, w8, true); h1b[64 * j] = (unsigned)w8; }
                *(LAS f32x4*)(hs + tl * P8_PITCH + 4 * lane + 256 * j) = h; }
        }
        __syncthreads();
        f32x4 c0 = (f32x4){0.f, 0.f, 0.f, 0.f}, c1 = c0;
        const LAS float* ap = hs + col * P8_PITCH + 256 * w + 4 * kq;
        const float* bp = I.w_router + (size_t)(256 * w + 4 * kq) * NE + col;
#pragma unroll 4
        for (int kk = 0; kk < 16; ++kk) {
            const f32x4 a = *(const LAS f32x4*)(ap + 16 * kk);
#pragma unroll
            for (int e = 0; e < 4; ++e) {
                const float b0 = bp[(size_t)(16 * kk + e) * NE], b1 = bp[(size_t)(16 * kk + e) * NE + 16];
                c0 = __builtin_amdgcn_mfma_f32_16x16x4f32(a[e], b0, c0, 0, 0, 0);
                c1 = __builtin_amdgcn_mfma_f32_16x16x4f32(a[e], b1, c1, 0, 0, 0);
            }
        }
#pragma unroll
        for (int i = 0; i < 4; ++i) { part[(w * 16 + 4 * kq + i) * 32 + col] = c0[i]; part[(w * 16 + 4 * kq + i) * 32 + 16 + col] = c1[i]; }
        __syncthreads();
        { const int tl = F.tid >> 5, e = F.tid & 31; float s = I.b_router[e];
#pragma unroll
            for (int ww = 0; ww < 8; ++ww) s += part[(ww * 16 + tl) * 32 + e];
            lg[tl * 32 + e] = s; }
        __syncthreads();
        if (F.tid < 16) {
            const int tl = F.tid; float lv[32];
#pragma unroll
            for (int e = 0; e < 32; ++e) lv[e] = lg[tl * 32 + e];
            int ti[4]; float tv[4];
#pragma unroll
            for (int k = 0; k < 4; ++k) { float best = -3.4e38f; int bi = 0;
#pragma unroll
                for (int e = 0; e < 32; ++e) { const bool tk = lv[e] > best; best = tk ? lv[e] : best; bi = tk ? e : bi; }
                ti[k] = bi; tv[k] = best;
#pragma unroll
                for (int e = 0; e < 32; ++e) lv[e] = (e == bi) ? -3.4e38f : lv[e]; }
            float ex[4], sum = 0.f;
#pragma unroll
            for (int k = 0; k < 4; ++k) { ex[k] = __expf(tv[k] - tv[0]); sum += ex[k]; }
            const float inv = 1.f / sum;
            *(GAS v4u*)((int*)(F.ws + WS_TOPI) + (size_t)(tok0 + tl) * 4) = (v4u){(unsigned)ti[0], (unsigned)ti[1], (unsigned)ti[2], (unsigned)ti[3]};
            *(GAS f32x4*)((float*)(F.ws + WS_GATE) + (size_t)(tok0 + tl) * 4) = (f32x4){ex[0] * inv, ex[1] * inv, ex[2] * inv, ex[3] * inv};
#pragma unroll
            for (int k = 0; k < 4; ++k) __hip_atomic_fetch_add(&hist[ti[k]], 1, __ATOMIC_RELAXED, __HIP_MEMORY_SCOPE_WORKGROUP);
        }
        __syncthreads();
    }
    if (F.tid < 32) { const int c = hist[F.tid]; if (c) __hip_atomic_fetch_add(F.ctl + CW_CNT + F.tid, (unsigned)c, RLX_AGENT); }
}

template <bool SKIP_MOE>
__device__ __forceinline__ void p12_final(Frame& F0, const In& I, float* out) {
    PHASE_FRAME(F0);
    const int lane = F.lane; const int gw = F.vcu * NWAVES + F.wave, NGW = F.G * NWAVES;
    float ln_w[32], ln_b[32];
#pragma unroll
    for (int j = 0; j < 8; ++j) { const f32x4 a = *(const GAS f32x4*)(I.ln2_w + 4 * lane + 256 * j), b = *(const GAS f32x4*)(I.ln2_b + 4 * lane + 256 * j);
#pragma unroll
        for (int e = 0; e < 4; ++e) { ln_w[4 * j + e] = a[e]; ln_b[4 * j + e] = b[e]; } }
    for (int tok = gw; tok < T; tok += NGW) {
        const GAS f32x4* hr = (const GAS f32x4*)((const float*)(F.ws + WS_H1) + (size_t)tok * D) + lane;
        f32x4 v[8]; float s = 0.f;
#pragma unroll
        for (int j = 0; j < 8; ++j) v[j] = hr[64 * j] * DN_ALPHA;
        if (!SKIP_MOE) {
#pragma unroll
            for (int k = 0; k < 4; ++k) { const GAS v2u* yr = (const GAS v2u*)((const bf16*)(F.ws + WS_YSLOT) + ((size_t)tok * 4 + k) * D) + lane;
#pragma unroll
                for (int j = 0; j < 8; ++j) { const v2u y = yr[64 * j]; v[j].x += bflo(y.x); v[j].y += bfhi(y.x); v[j].z += bflo(y.y); v[j].w += bfhi(y.y); } }
        }
#pragma unroll
        for (int j = 0; j < 8; ++j) s += (v[j].x + v[j].y) + (v[j].z + v[j].w);
        const float mean = wave_sum(s) * (1.f / D); float s2 = 0.f;
#pragma unroll
        for (int j = 0; j < 8; ++j) { v[j] = v[j] - mean; s2 += (v[j].x * v[j].x + v[j].y * v[j].y) + (v[j].z * v[j].z + v[j].w * v[j].w); }
        const float rstd = 1.f / sqrtf(wave_sum(s2) * (1.f / D) + LN_EPS);
        GAS f32x4* o = (GAS f32x4*)(out + (size_t)tok * D) + lane;
#pragma unroll
        for (int j = 0; j < 8; ++j) { f32x4 h;
#pragma unroll
            for (int e = 0; e < 4; ++e) h[e] = v[j][e] * rstd * ln_w[4 * j + e] + ln_b[4 * j + e];
            o[64 * j] = h; }
    }
}
__device__ __forceinline__ void moe_tables(Frame& F) {
    LAS int* tab = (LAS int*)(F.lds + TAB_OFF);
    if (F.tid == 0) { int run = 0;
        for (int e = 0; e < NE; ++e) { const int c = (int)__hip_atomic_load(F.ctl + CW_CNT + e, RLX_AGENT); const int p = (c + 255) / 256 * 256; tab[32 + e] = run; run += p; tab[e] = run; }
        tab[64] = run / 256; }
    __syncthreads();
}

__device__ __forceinline__ void p9_scatter(Frame& F0, const In& I) {
    PHASE_FRAME(F0);
    moe_tables(F);
    LAS int* tab = (LAS int*)(F.lds + TAB_OFF);
    LAS int* lh = (LAS int*)(F.lds + 0);
    LAS int* lb = (LAS int*)(F.lds + 128);
    LAS int* dst = (LAS int*)(F.lds + 256);
    const int* topi = (const int*)(F.ws + WS_TOPI); const float* gate = (const float*)(F.ws + WS_GATE);
    for (int ch = F.vcu; ch < T / 128; ch += F.G) {
        if (F.tid < 32) lh[F.tid] = 0;
        __syncthreads();
        const int s = ch * 512 + F.tid; const int e = topi[s]; const float gv = gate[s];
        const int rank = __hip_atomic_fetch_add(&lh[e], 1, __ATOMIC_RELAXED, __HIP_MEMORY_SCOPE_WORKGROUP);
        __syncthreads();
        if (F.tid < 32) { const int c = lh[F.tid]; lb[F.tid] = c ? (int)__hip_atomic_fetch_add(F.ctl + CW_CUR + F.tid, (unsigned)c, RLX_AGENT) : 0; }
        __syncthreads();
        const int d = tab[32 + e] + lb[e] + rank;
        ((int*)(F.ws + WS_ROWSLOT))[d] = s; ((float*)(F.ws + WS_ROWW))[d] = gv; dst[F.tid] = d;
        __syncthreads();
        for (int i = F.wave; i < 512; i += NWAVES) {
            const int tok = ch * 128 + (i >> 2); const int dd = dst[i];
            const GAS v4u* src = (const GAS v4u*)((const unsigned char*)(F.ws + WS_H1B) + (size_t)tok * D) + F.lane;
            GAS v4u* o = (GAS v4u*)((unsigned char*)(F.ws + WS_XG) + (size_t)dd * D) + F.lane;
            v4u v[2];
#pragma unroll
            for (int j = 0; j < 2; ++j) v[j] = src[64 * j];
#pragma unroll
            for (int j = 0; j < 2; ++j) o[64 * j] = v[j];
        }
        __syncthreads();
    }
}

__device__ __forceinline__ void p10_moe_up(Frame& F0, const In& I) {
    PHASE_FRAME(F0);
    moe_tables(F);
    LAS int* tab = (LAS int*)(F.lds + TAB_OFF);
    pg8::SchedMoe S; S.t.init(tab[64], 16, F.G, (int)blockIdx.x);
    S.A = (unsigned)(WS_XG); S.B = (unsigned)(WS_WGUT); S.tsA = (unsigned)256 * D; S.tsB = (unsigned)256 * D; S.es = (unsigned)2 * FF * D; S.pad_end = tab;
    pg8::EpiSwiglu E{(unsigned char*)(F.ws + WS_ACT), I.b_gu};
    pg8::gemm_phase<pg8::EpiSwiglu, pg8::SchedMoe, true, true>(F.lds + RING_OFF, F.rsrc, D / 2, D / 2, D / 2, S, E);
}
__device__ __forceinline__ void p11_moe_down(Frame& F0, const In& I) {
    PHASE_FRAME(F0);
    moe_tables(F);
    LAS int* tab = (LAS int*)(F.lds + TAB_OFF);
    pg8::SchedMoe S; S.t.init(tab[64], 8, F.G, (int)blockIdx.x);
    S.A = (unsigned)(WS_ACT); S.B = (unsigned)(WS_WDNT); S.tsA = (unsigned)256 * FF; S.tsB = (unsigned)256 * FF; S.es = (unsigned)D * FF; S.pad_end = tab;
    pg8::EpiDown E{(bf16*)(F.ws + WS_YSLOT), I.b_down, (const int*)(F.ws + WS_ROWSLOT), (const float*)(F.ws + WS_ROWW)};
    pg8::gemm_phase<pg8::EpiDown, pg8::SchedMoe, true, true>(F.lds + RING_OFF, F.rsrc, FF / 2, FF / 2, FF / 2, S, E);
}

__device__ __forceinline__ void p1_proj(Frame& F0, const In& I) {
    PHASE_FRAME(F0);
    { pg8::SchedPlain S; S.t.init(T / 256, PROJ_LD / 256, F.G, (int)blockIdx.x);
      S.A = (unsigned)(WS_XB16); S.B = (unsigned)(WS_WINT); S.tsA = (unsigned)256 * D * 2; S.tsB = (unsigned)256 * D * 2;
      pg8::EpiProj E{(bf16*)(F.ws + WS_PROJ)};
      pg8::gemm_phase<pg8::EpiProj, pg8::SchedPlain, true>(F.lds + RING_OFF, F.rsrc, D, D, D, S, E); }
    { pg8::SchedPlain S; S.t.init(AW / 256, T / 256, F.G, (int)blockIdx.x);
      S.A = (unsigned)(WS_WVT); S.B = (unsigned)(WS_XB16); S.tsA = (unsigned)256 * D * 2; S.tsB = (unsigned)256 * D * 2;
      pg8::EpiBf16 E{(bf16*)(F.ws + WS_VT), T};
      pg8::gemm_phase<pg8::EpiBf16, pg8::SchedPlain, true>(F.lds + RING_OFF, F.rsrc, D, D, D, S, E); }
}

__device__ __forceinline__ float ftanh(float x) { return 2.0f * fsigmoid(2.0f * x) - 1.0f; }
__device__ __forceinline__ void p2_shift_attn(Frame& F0, const In& I) {
    PHASE_FRAME(F0);
    const int lane = F.lane; const int gw = F.vcu * NWAVES + F.wave, NGW = F.G * NWAVES;
    const bf16* PROJ = (const bf16*)(F.ws + WS_PROJ);
    for (int tok = gw; tok < T; tok += NGW) {
        const bool first = (tok % SEQ) == 0;
        const bf16* cur = PROJ + (size_t)tok * PROJ_LD + PJ_SEG; const bf16* prv = cur - PROJ_LD;
        bf16* rkv = (bf16*)(F.ws + WS_RKV) + (size_t)tok * (3 * RW); bf16* lin = (bf16*)(F.ws + WS_LORAIN) + (size_t)tok * LORA_LD;
#pragma unroll 1
        for (int it = 0; it < 7; ++it) { const int gi = it * 64 + lane; if (gi >= SHIFT_W / 8) break; const int c = gi * 8;
            const v4u cv = *(const GAS v4u*)(cur + c); v4u pv = (v4u){0u, 0u, 0u, 0u}; if (!first) pv = *(const GAS v4u*)(prv + c);
            const f32x4 m0 = *(const GAS f32x4*)(I.shift_mu + c), m1 = *(const GAS f32x4*)(I.shift_mu + c + 4);
            float v[8]; const unsigned cw[4] = {cv.x, cv.y, cv.z, cv.w}, pw[4] = {pv.x, pv.y, pv.z, pv.w};
#pragma unroll
            for (int j = 0; j < 4; ++j) { const float c0 = bflo(cw[j]), c1 = bfhi(cw[j]), p0 = bflo(pw[j]), p1 = bfhi(pw[j]); const float mu0 = (j < 2) ? m0[2 * j] : m1[2 * j - 4], mu1 = (j < 2) ? m0[2 * j + 1] : m1[2 * j - 3];
                v[2 * j] = c0 + (p0 - c0) * mu0; v[2 * j + 1] = c1 + (p1 - c1) * mu1; }
            bf16* dstp;
            if (c < 3 * RW) dstp = rkv + c;
            else if (c < 3 * RW + DLORA) { dstp = lin + (c - 3 * RW);
#pragma unroll
                for (int j = 0; j < 8; ++j) v[j] = ftanh(v[j]); }
            else if (c < 3 * RW + DLORA + ALORA) dstp = lin + 128 + (c - 3 * RW - DLORA);
            else { dstp = lin + 256 + (c - 3 * RW - DLORA - ALORA);
#pragma unroll
                for (int j = 0; j < 8; ++j) v[j] = fsigmoid(v[j]); }
            *(GAS v4u*)dstp = (v4u){pk2(v[0], v[1]), pk2(v[2], v[3]), pk2(v[4], v[5]), pk2(v[6], v[7])};
        }
        if (lane < 8) { const int c = (lane < 4) ? (DLORA + 8 * lane) : (128 + ALORA + 8 * (lane - 4)); *(GAS v4u*)(lin + c) = (v4u){0u, 0u, 0u, 0u}; }
    }
#if STAGE == 3
    { const int gt = F.vcu * (NWAVES * 64) + F.tid, NGT = F.G * NWAVES * 64;
      for (size_t i = gt; i < (size_t)T * RW / 8; i += NGT) ((GAS v4u*)(F.ws + WS_YB))[i] = (v4u){0u, 0u, 0u, 0u}; }
#endif
    LAS float* tbl = (LAS float*)(F.lds + 0);
    const bf16* VT = (const bf16*)(F.ws + WS_VT); bf16* YA = (bf16*)(F.ws + WS_YA);
    const int r = lane & 31, hh = lane >> 5;
    for (int grp = F.vcu; grp < BATCH * AH * 4; grp += F.G) {
        const int bh = grp >> 2, b = bh >> 4, h = bh & 15, qb0 = (grp & 3) * 64;
        __syncthreads();
        if (F.tid < REL_TABLE) tbl[F.tid] = I.rel_bias[h * REL_TABLE + F.tid];
        __syncthreads();
#pragma unroll 1
        for (int i8 = 0; i8 < 8; ++i8) {
            const int qb = qb0 + F.wave + 8 * i8, q0 = qb * 32, c = q0 >> 6;
            const size_t tokq = (size_t)b * SEQ + q0 + r;
            bf16x8 qf[4];
#pragma unroll
            for (int s = 0; s < 4; ++s) qf[s] = *(const GAS bf16x8*)(PROJ + tokq * PROJ_LD + PJ_Q + h * 64 + 16 * s + 8 * hh);
            f32x16 o0, o1;
#pragma unroll
            for (int i = 0; i < 16; ++i) { o0[i] = 0.f; o1[i] = 0.f; }
            float m_run = -1e30f, l_run = 0.f;
            const int kt0 = (c > LEFT ? c - LEFT : 0) * 2, kt1 = (c + 1) * 2;
            bf16x8 kf[4]; bf16x8 vf[2][2];
            const int rp = (r & 16) + 8 * ((r >> 2) & 1) + 4 * ((r >> 3) & 1) + (r & 3);
#define AT_LOAD(kt_) do { const int kp_ = (kt_) * 32; const size_t tk_ = (size_t)b * SEQ + kp_ + rp; \
                _Pragma("unroll") for (int s = 0; s < 4; ++s) kf[s] = *(const GAS bf16x8*)(PROJ + tk_ * PROJ_LD + PJ_K + h * 64 + 16 * s + 8 * hh); \
                _Pragma("unroll") for (int mt = 0; mt < 2; ++mt) _Pragma("unroll") for (int s2 = 0; s2 < 2; ++s2) \
                    vf[mt][s2] = *(const GAS bf16x8*)(VT + (size_t)(h * 64 + 32 * mt + r) * T + (size_t)b * SEQ + kp_ + 16 * s2 + 8 * hh); } while (0)
            AT_LOAD(kt0);
#pragma unroll 1
            for (int kt = kt0; kt < kt1; ++kt) {
                const int kpos0 = kt * 32;
                bf16x8 kc[4]; bf16x8 va[2], vb[2];
#pragma unroll
                for (int s = 0; s < 4; ++s) kc[s] = kf[s];
#pragma unroll
                for (int s2 = 0; s2 < 2; ++s2) { va[s2] = vf[0][s2]; vb[s2] = vf[1][s2]; }
                if (kt + 1 < kt1) AT_LOAD(kt + 1);
                f32x16 st;
#pragma unroll
                for (int i = 0; i < 16; ++i) st[i] = 0.f;
#pragma unroll
                for (int s = 0; s < 4; ++s) st = __builtin_amdgcn_mfma_f32_32x32x16_bf16(kc[s], qf[s], st, 0, 0, 0);
                const int dbase = (q0 + r) - (kpos0 + 8 * hh);
                float mx = -1e30f;
#pragma unroll
                for (int i = 0; i < 16; ++i) { int d = dbase - (16 * (i >> 3) + 4 * ((i >> 2) & 1) + (i & 3)); d = d < MAX_PAST ? d : MAX_PAST; st[i] += tbl[d + 63]; mx = fmaxf(mx, st[i]); }
                mx = fmaxf(mx, __shfl_xor(mx, 32));
                const float m_new = fmaxf(m_run, mx), alpha = __expf(m_run - m_new);
                float ls = 0.f;
#pragma unroll
                for (int i = 0; i < 16; ++i) { st[i] = __expf(st[i] - m_new); ls += st[i]; }
                l_run = l_run * alpha + ls; m_run = m_new;
#pragma unroll
                for (int i = 0; i < 16; ++i) { o0[i] *= alpha; o1[i] *= alpha; }
#pragma unroll
                for (int s2 = 0; s2 < 2; ++s2) {
                    v4u pw; pw.x = pg8::cvt_pk_bf16(st[8 * s2 + 0], st[8 * s2 + 1]); pw.y = pg8::cvt_pk_bf16(st[8 * s2 + 2], st[8 * s2 + 3]); pw.z = pg8::cvt_pk_bf16(st[8 * s2 + 4], st[8 * s2 + 5]); pw.w = pg8::cvt_pk_bf16(st[8 * s2 + 6], st[8 * s2 + 7]);
                    const bf16x8 pf = __builtin_bit_cast(bf16x8, pw);
                    o0 = __builtin_amdgcn_mfma_f32_32x32x16_bf16(va[s2], pf, o0, 0, 0, 0);
                    o1 = __builtin_amdgcn_mfma_f32_32x32x16_bf16(vb[s2], pf, o1, 0, 0, 0);
                }
            }
#undef AT_LOAD
            const float inv = 1.0f / (l_run + __shfl_xor(l_run, 32));
            bf16* yo = YA + tokq * AW + h * 64 + 4 * hh;
#pragma unroll
            for (int g4 = 0; g4 < 4; ++g4) {
                *(GAS v2u*)(yo + 8 * g4) = (v2u){pg8::cvt_pk_bf16(o0[4 * g4] * inv, o0[4 * g4 + 1] * inv), pg8::cvt_pk_bf16(o0[4 * g4 + 2] * inv, o0[4 * g4 + 3] * inv)};
                *(GAS v2u*)(yo + 32 + 8 * g4) = (v2u){pg8::cvt_pk_bf16(o1[4 * g4] * inv, o1[4 * g4 + 1] * inv), pg8::cvt_pk_bf16(o1[4 * g4 + 2] * inv, o1[4 * g4 + 3] * inv)};
            }
        }
    }
}

__device__ __forceinline__ void p6_merged(Frame& F0, const In& I) {
    PHASE_FRAME(F0);
    pg8::SchedTwo S; S.t.init(T / 256, D / 256, F.G, (int)blockIdx.x);
    S.A0 = (unsigned)(WS_YA); S.A1 = (unsigned)(WS_YB); S.B0 = (unsigned)(WS_PAT); S.B1 = (unsigned)(WS_PBT);
    S.tsA = (unsigned)256 * AW * 2; S.tsB = (unsigned)256 * AW * 2;
    pg8::EpiMerged E{(const bf16*)(F.ws + WS_PROJ), (bf16*)(F.ws + WS_MERGED)};
    pg8::gemm_phase<pg8::EpiMerged, pg8::SchedTwo, true>(F.lds + RING_OFF, F.rsrc, AW, AW, AW, S, E);
}
__device__ __forceinline__ void p7_mix(Frame& F0, const In& I) {
    PHASE_FRAME(F0);
    pg8::SchedPlain S; S.t.init(T / 256, D / 256, F.G, (int)blockIdx.x);
    S.A = (unsigned)(WS_MERGED); S.B = (unsigned)(WS_WOT); S.tsA = (unsigned)256 * D * 2; S.tsB = (unsigned)256 * D * 2;
    pg8::EpiZ E{I.x, (float*)(F.ws + WS_Z)};
    pg8::gemm_phase<pg8::EpiZ, pg8::SchedPlain, true>(F.lds + RING_OFF, F.rsrc, D, D, D, S, E);
}

__device__ __forceinline__ void p3_lora(Frame& F0, const In& I) {
    PHASE_FRAME(F0);
    { pg8::SchedPlain S; S.t.init(T / 256, 4, F.G, (int)blockIdx.x);
      S.A = (unsigned)(WS_LORAIN); S.B = (unsigned)(WS_WLA); S.tsA = (unsigned)256 * LORA_LD * 2; S.tsB = (unsigned)256 * 256 * 2;
      pg8::EpiLoraA<true> E{(float*)(F.ws + WS_DECAY), I.w0};
      pg8::gemm_phase<pg8::EpiLoraA<true>, pg8::SchedPlain, true>(F.lds + RING_OFF, F.rsrc, LORA_LD, 256, 256, S, E); }
    { pg8::SchedPlain S; S.t.init(T / 256, 4, F.G, (int)blockIdx.x);
      S.A = (unsigned)(WS_LORAIN); S.B = (unsigned)(WS_WLA + (size_t)1024 * 256 * 2); S.tsA = (unsigned)256 * LORA_LD * 2; S.tsB = (unsigned)256 * 256 * 2;
      pg8::EpiLoraA<false> E{(float*)(F.ws + WS_ICLR), I.a0};
      pg8::gemm_phase<pg8::EpiLoraA<false>, pg8::SchedPlain, true>(F.lds + RING_OFF, F.rsrc, LORA_LD, 256, 256, S, E); }
    { pg8::SchedPlain S; S.t.init(T / 256, 4, F.G, (int)blockIdx.x);
      S.A = (unsigned)(WS_LORAIN + 512); S.B = (unsigned)(WS_WLG); S.tsA = (unsigned)256 * LORA_LD * 2; S.tsB = (unsigned)256 * 256 * 2;
      pg8::EpiBf16 E{(bf16*)(F.ws + WS_G), RW};
      pg8::gemm_phase<pg8::EpiBf16, pg8::SchedPlain, true>(F.lds + RING_OFF, F.rsrc, LORA_LD, 256, 256, S, E); }
}

constexpr int SC_TC = 32, SC_ARR = SC_TC * 64, SC_BUF = 5 * SC_ARR;
constexpr int SC_V_OFF = 2 * SC_BUF, SC_Y_OFF = SC_V_OFF + 2 * SC_TC * 16;
constexpr int SC_TR_OFF = (SC_V_OFF + 2 * SC_TC * 16) * 4;
#define SC_BAR() do { asm volatile("s_waitcnt lgkmcnt(0)" ::: "memory"); __builtin_amdgcn_s_barrier(); asm volatile("" ::: "memory"); } while (0)
__device__ __forceinline__ void p4_scan(Frame& F0, const In& I) {
    PHASE_FRAME(F0);
    LAS float* L = (LAS float*)(F.lds + 0);
    const int lane = F.lane;
    const bf16* RKV = (const bf16*)(F.ws + WS_RKV); const float* DEC = (const float*)(F.ws + WS_DECAY); const float* ICL = (const float*)(F.ws + WS_ICLR);
    float* YS = (float*)(F.ws + WS_YSCAN);
    constexpr int NCH = SEQ / SC_TC;
    for (int unit = F.vcu; unit < BATCH * RH * 4; unit += F.G) {
        const int bh = unit >> 2, rq = unit & 3, b = bh >> 4, h = bh & 15;
        const size_t tok_base = (size_t)b * SEQ;
        __syncthreads();
        if (F.wave >= 4) {
            const int lw = F.wave - 4; const int hc = h * 64 + lane;
            const float kkp = I.k_k[hc], kap = I.k_a[hc];
            unsigned short rr_[8], kk_[8], vv_[8]; float dc_[8], ic_[8];
#define SC_LOAD(ch) do { _Pragma("unroll") for (int i = 0; i < 8; ++i) { const size_t tok = tok_base + (size_t)(ch) * SC_TC + lw + 4 * i; \
                rr_[i] = RKV[tok * (3 * RW) + hc]; kk_[i] = RKV[tok * (3 * RW) + RW + hc]; vv_[i] = RKV[tok * (3 * RW) + 2 * RW + h * 64 + rq * 16 + (lane & 15)]; \
                dc_[i] = DEC[tok * RW + hc]; ic_[i] = ICL[tok * RW + hc]; } } while (0)
#define SC_WRITE(ch) do { LAS float* B_ = L + ((ch) & 1) * SC_BUF; LAS float* V_ = L + SC_V_OFF + ((ch) & 1) * (SC_TC * 16); \
            _Pragma("unroll") for (int i = 0; i < 8; ++i) { const int s = lw + 4 * i; const float rr = bf2f(rr_[i]), k0 = bf2f(kk_[i]), ic = ic_[i]; \
                const float kkv = k0 * kkp; const float n2 = wave_sum(kkv * kkv); const float kkn = kkv * __builtin_amdgcn_rsqf(fmaxf(n2, 1e-24f)); \
                B_[0 * SC_ARR + s * 64 + lane] = rr; B_[1 * SC_ARR + s * 64 + lane] = dc_[i]; B_[2 * SC_ARR + s * 64 + lane] = k0 * (1.0f + (ic - 1.0f) * kap); \
                B_[3 * SC_ARR + s * 64 + lane] = -kkn; B_[4 * SC_ARR + s * 64 + lane] = kkn * ic; if (lane < 16) V_[s * 16 + lane] = bf2f(vv_[i]); } } while (0)
#define SC_FLUSH(ch) do { const LAS float* Y_ = L + SC_Y_OFF + ((ch) & 1) * (SC_TC * 16); const int lt = lw * 64 + lane; \
            _Pragma("unroll") for (int i = 0; i < 2; ++i) { const int idx = lt + 256 * i, s = idx >> 4, j = idx & 15; \
                YS[(tok_base + (size_t)(ch) * SC_TC + s) * RW + h * 64 + rq * 16 + j] = Y_[idx]; } } while (0)
            LAS float* tscr = (LAS float*)(F.lds + SC_TR_OFF + lw * 16640);
            f32x4 tv[16]; MoeItem mi; mi.WT = nullptr; mi.k0 = 0; mi.ldt = 0; mi.drow = 0;
            SC_LOAD(0); SC_WRITE(0); SC_LOAD(1);
            SC_BAR();
#pragma unroll 1
            for (int ch = 0; ch < NCH; ch += 2) {
                const int it = (ch >> 1) * 1024 + unit * 4 + lw; const bool has = it < MOE_NITEMS;
                SC_WRITE(ch + 1);
                if (ch + 2 < NCH) SC_LOAD(ch + 2);
                if (has) { mi = moe_item(it, I.w_gu, I.w_down, F.ws); tr8_load(mi.W, mi.ldw, mi.k0, mi.c0, tv, lane); }
                SC_BAR();
                if (ch + 2 < NCH) SC_WRITE(ch + 2);
                if (ch + 3 < NCH) SC_LOAD(ch + 3);
                if (has) tr8_finish(tv, mi.k0, mi.WT, mi.ldt, mi.drow, tscr, lane, 64.0f);
                SC_BAR();
            }
#undef SC_LOAD
#undef SC_WRITE
#undef SC_FLUSH
        } else {
            const int cw = F.wave, kq = lane & 15, row = 4 * cw + (lane >> 4);
            f32x4 S = (f32x4){0.f, 0.f, 0.f, 0.f};
            SC_BAR();
#pragma unroll 1
            for (int ch = 0; ch < NCH; ++ch) {
                const LAS float* B_ = L + (ch & 1) * SC_BUF + 4 * kq; const LAS float* V_ = L + SC_V_OFF + (ch & 1) * (SC_TC * 16) + row; float* Yg = YS + (tok_base + (size_t)ch * SC_TC) * RW + h * 64 + rq * 16 + row;
                float ysel = 0.f;
                f32x4 R4[3], W4[3], K4[3], A4[3], B4[3]; float VV[3];
#define SC_LD(s, q) do { R4[q] = *(const LAS f32x4*)(B_ + 0 * SC_ARR + (s) * 64); W4[q] = *(const LAS f32x4*)(B_ + 1 * SC_ARR + (s) * 64); K4[q] = *(const LAS f32x4*)(B_ + 2 * SC_ARR + (s) * 64); \
                         A4[q] = *(const LAS f32x4*)(B_ + 3 * SC_ARR + (s) * 64); B4[q] = *(const LAS f32x4*)(B_ + 4 * SC_ARR + (s) * 64); VV[q] = V_[(s) * 16]; } while (0)
                SC_LD(0, 0); SC_LD(1, 1);
#pragma unroll
                for (int s = 0; s < SC_TC; ++s) {
                    if (s + 2 < SC_TC) SC_LD(s + 2, (s + 2) % 3);
                    __builtin_amdgcn_sched_barrier(0);
                    const int q = s % 3;
                    float sa = (S.x * A4[q].x + S.y * A4[q].y) + (S.z * A4[q].z + S.w * A4[q].w);
                    sa = rowsum16(sa);
                    S = S * W4[q] + (B4[q] * sa + K4[q] * VV[q]);
                    float y = (S.x * R4[q].x + S.y * R4[q].y) + (S.z * R4[q].z + S.w * R4[q].w);
                    y = rowsum16(y);
                    ysel = (kq == (s & 15)) ? y : ysel;
                    if ((s & 15) == 15) Yg[(size_t)(s - 15 + kq) * RW] = ysel;
                    __builtin_amdgcn_sched_barrier(0);
                }
#undef SC_LD
                SC_BAR();
            }
        }
    }
}

__device__ __forceinline__ void p5_post(Frame& F0, const In& I) {
    PHASE_FRAME(F0);
    const int lane = F.lane; const int gw = F.vcu * NWAVES + F.wave, NGW = F.G * NWAVES;
    const bf16* RKV = (const bf16*)(F.ws + WS_RKV); const float* ICL = (const float*)(F.ws + WS_ICLR); const float* YS = (const float*)(F.ws + WS_YSCAN);
    const bf16* G = (const bf16*)(F.ws + WS_G); bf16* YB = (bf16*)(F.ws + WS_YB);
    const int c0 = lane * 16;
    for (int tok = gw; tok < T; tok += NGW) {
        float y[16], rr[16], kk[16], vv[16], ic[16], gg[16];
#pragma unroll
        for (int q = 0; q < 4; ++q) { const f32x4 a = *(const GAS f32x4*)(YS + (size_t)tok * RW + c0 + 4 * q), c = *(const GAS f32x4*)(ICL + (size_t)tok * RW + c0 + 4 * q);
#pragma unroll
            for (int e = 0; e < 4; ++e) { y[4 * q + e] = a[e]; ic[4 * q + e] = c[e]; } }
#pragma unroll
        for (int q = 0; q < 2; ++q) {
            const v4u a = *(const GAS v4u*)(RKV + (size_t)tok * (3 * RW) + c0 + 8 * q), bb = *(const GAS v4u*)(RKV + (size_t)tok * (3 * RW) + RW + c0 + 8 * q),
                      c = *(const GAS v4u*)(RKV + (size_t)tok * (3 * RW) + 2 * RW + c0 + 8 * q), d = *(const GAS v4u*)(G + (size_t)tok * RW + c0 + 8 * q);
            const unsigned aw[4] = {a.x, a.y, a.z, a.w}, bw[4] = {bb.x, bb.y, bb.z, bb.w}, cw[4] = {c.x, c.y, c.z, c.w}, dw[4] = {d.x, d.y, d.z, d.w};
#pragma unroll
            for (int e = 0; e < 4; ++e) { rr[8 * q + 2 * e] = bflo(aw[e]); rr[8 * q + 2 * e + 1] = bfhi(aw[e]); kk[8 * q + 2 * e] = bflo(bw[e]); kk[8 * q + 2 * e + 1] = bfhi(bw[e]);
                vv[8 * q + 2 * e] = bflo(cw[e]); vv[8 * q + 2 * e + 1] = bfhi(cw[e]); gg[8 * q + 2 * e] = bflo(dw[e]); gg[8 * q + 2 * e + 1] = bfhi(dw[e]); } }
        float s = 0.f, bs = 0.f;
#pragma unroll
        for (int e = 0; e < 16; ++e) { s += y[e]; const float kp = kk[e] * (1.0f + (ic[e] - 1.0f) * I.k_a[c0 + e]); bs += rr[e] * kp * I.r_k[c0 + e]; }
        s = quadsum(s); bs = quadsum(bs);
        const float mean = s * (1.f / 64.f); float s2 = 0.f;
#pragma unroll
        for (int e = 0; e < 16; ++e) { y[e] -= mean; s2 += y[e] * y[e]; }
        s2 = quadsum(s2);
        const float rstd = 1.f / sqrtf(s2 * (1.f / 64.f) + GN_EPS);
        float o[16];
#pragma unroll
        for (int e = 0; e < 16; ++e) o[e] = (y[e] * rstd * I.lnx_w[c0 + e] + I.lnx_b[c0 + e] + bs * vv[e]) * gg[e];
#pragma unroll
        for (int q = 0; q < 2; ++q) *(GAS v4u*)(YB + (size_t)tok * RW + c0 + 8 * q) = (v4u){pk2(o[8 * q], o[8 * q + 1]), pk2(o[8 * q + 2], o[8 * q + 3]), pk2(o[8 * q + 4], o[8 * q + 5]), pk2(o[8 * q + 6], o[8 * q + 7])};
    }
}
#ifndef STAGE
#define STAGE 4
#endif
struct Args { In in; float* out; unsigned char* ws; };
__global__ void __launch_bounds__(NWAVES * 64, 2) mk_fwd(Args args) {
    extern __shared__ __attribute__((aligned(16))) unsigned char lds[];
    Frame F;
    F.lds = (LAS unsigned char*)lds;
    F.MISC = (volatile LAS unsigned*)(F.lds + MISC_OFF);
    F.tid = threadIdx.x; F.lane = F.tid & 63; F.wave = __builtin_amdgcn_readfirstlane(F.tid >> 6);
    F.G = gridDim.x; { const int bx = blockIdx.x; F.vcu = (F.G % 8 == 0) ? (bx % 8) * (F.G / 8) + bx / 8 : bx; }
    F.ws = args.ws;
    F.rsrc = __builtin_amdgcn_make_buffer_rsrc(args.ws, 0, 0xffffffff, 0x00020000);
    F.ctl = (gu32*)(args.ws + WS_CTL);
    for (int u = F.tid; u < (LDS_BYTES - MISC_OFF) / 4; u += NWAVES * 64) ((LAS unsigned*)(F.lds + MISC_OFF))[u] = 0u;
    __syncthreads();
    XcdBarrier bar = xcd_barrier_post((unsigned*)(F.ctl + CW_BAR), F.MISC + 8);
    const In& I = args.in;
#define GRID_BAR() xcd_barrier(bar)
#ifndef DUP_PHASE
#define DUP_PHASE -1
#endif
#define RUN(n, call) do { call; if (DUP_PHASE == (n)) { GRID_BAR(); call; } } while (0)

#if STAGE >= 2
    RUN(0, p0_prologue(F, I));
    GRID_BAR();
#endif
#if STAGE >= 3
    RUN(1, p1_proj(F, I));
    GRID_BAR();
    RUN(2, p2_shift_attn(F, I));
    GRID_BAR();
#if STAGE >= 4
    RUN(3, p3_lora(F, I));
    GRID_BAR();
    RUN(4, p4_scan(F, I));
    GRID_BAR();
    RUN(5, p5_post(F, I));
    GRID_BAR();
#endif
    RUN(6, p6_merged(F, I));
    GRID_BAR();
    RUN(7, p7_mix(F, I));
    GRID_BAR();
#endif
    p8_ln_router<(STAGE < 3)>(F, I);
    GRID_BAR();
#if STAGE >= 2
    p9_scatter(F, I);
    GRID_BAR();
    RUN(10, p10_moe_up(F, I));
    GRID_BAR();
    RUN(11, p11_moe_down(F, I));
    GRID_BAR();
#endif
    RUN(12, p12_final<(STAGE < 2)>(F, I, args.out));
}

extern "C" void kernel_launch(void* const* d_in, const int* in_sizes, int n_in, void* d_out, int out_size, void* d_ws, size_t ws_size, hipStream_t stream) {
    static int grid = 0;
    if (grid == 0) {
        if (n_in != 27 || in_sizes[0] != T * D || out_size != T * D || ws_size < WS_END) { fprintf(stderr, "kernel_launch: unexpected shapes (n_in %d, in0 %d, out %d, ws %zu)\n", n_in, n_in > 0 ? in_sizes[0] : -1, out_size, ws_size); grid = -1; return; }
        int dev = 0, cus = 0, per_cu = 0;
        if (hipGetDevice(&dev) != hipSuccess || hipDeviceGetAttribute(&cus, hipDeviceAttributeMultiprocessorCount, dev) != hipSuccess) { grid = -1; return; }
        if (hipFuncSetAttribute((const void*)mk_fwd, hipFuncAttributeMaxDynamicSharedMemorySize, LDS_BYTES) != hipSuccess) { fprintf(stderr, "kernel_launch: hipFuncSetAttribute failed\n"); grid = -1; return; }
        if (hipOccupancyMaxActiveBlocksPerMultiprocessor(&per_cu, (const void*)mk_fwd, NWAVES * 64, LDS_BYTES) != hipSuccess || per_cu < 1)
            fprintf(stderr, "kernel_launch: occupancy query reports %d\n", per_cu);
        (void)hipGetLastError();
        grid = cus;
    }
    if (grid < 0) return;
    if (hipMemsetAsync((char*)d_ws + WS_CTL, 0, CTL_ZERO_BYTES, stream) != hipSuccess) return;
    Args a{};
    const float** ip = (const float**)&a.in;
    for (int i = 0; i < 27; ++i) ip[i] = (const float*)d_in[i];
    a.out = (float*)d_out; a.ws = (unsigned char*)d_ws;
    hipLaunchKernelGGL(mk_fwd, dim3(grid), dim3(NWAVES * 64), LDS_BYTES, stream, a);
    const hipError_t le = hipPeekAtLastError();
    if (le != hipSuccess) fprintf(stderr, "kernel_launch: launch failed: %s\n", hipGetErrorName(le));
}
```

```cpp
#define STAGE 4
#include <hip/hip_runtime.h>
#include <cstdio>
#include <cstdint>

#define GAS __attribute__((address_space(1)))
#define LAS __attribute__((address_space(3)))
typedef unsigned short bf16;
typedef unsigned v4u __attribute__((ext_vector_type(4)));
typedef unsigned v2u __attribute__((ext_vector_type(2)));
typedef float f32x4 __attribute__((ext_vector_type(4)));
typedef float f32x2 __attribute__((ext_vector_type(2)));
typedef float f32x16 __attribute__((ext_vector_type(16)));
typedef short bf16x8 __attribute__((ext_vector_type(8)));
typedef short bf16x4 __attribute__((ext_vector_type(4)));
typedef GAS unsigned gu32;

constexpr int NWAVES = 8;
constexpr int BATCH = 4, SEQ = 8192, D = 2048, T = BATCH * SEQ;
constexpr int CHUNK = 64, LEFT = 8, AH = 16, AD = 64, AW = 1024;
constexpr int REL_TABLE = 320, MAX_PAST = 256;
constexpr int RH = 16, RN = 64, RW = 1024, DLORA = 96, ALORA = 96, GLORA = 256;
constexpr int SHIFT_W = 3 * RW + DLORA + ALORA + GLORA;
constexpr int D_IN = 3 * AW + SHIFT_W + 2 * D;
constexpr int NE = 32, TOPK = 4, FF = 2048;
constexpr int MSLOT = T * TOPK;
constexpr int NBLK_MAX = (MSLOT + NE * 255 + 255) / 256;
constexpr int RROWS = NBLK_MAX * 256;
constexpr float LN_EPS = 1e-5f, GN_EPS = 64e-5f;
constexpr float DN_ALPHA = 1.189207115002721f;
constexpr int PROJ_LD = 9728, PJ_Q = 0, PJ_K = 1024, PJ_SEG = 2048, SEG_PAD = 3584, PJ_GA = 5632, PJ_GB = 7680;
constexpr int LORA_LD = 512;

constexpr size_t MiB = 1u << 20;
constexpr size_t WS_CTL = 0, CTL_ZERO_BYTES = 1 * MiB;
constexpr size_t WS_TOPI = 2 * MiB;
constexpr size_t WS_GATE = 3 * MiB;
constexpr size_t WS_ROWSLOT = 4 * MiB;
constexpr size_t WS_ROWW = 5 * MiB;
constexpr size_t WS_WLA = 6 * MiB;
constexpr size_t WS_WLG = 7 * MiB;
constexpr size_t WS_PAT = 8 * MiB;
constexpr size_t WS_PBT = 12 * MiB;
constexpr size_t WS_WOT = 16 * MiB;
constexpr size_t WS_WVT = 24 * MiB;
constexpr size_t WS_WINT = 28 * MiB;
constexpr size_t WS_WGUT = 128 * MiB;
constexpr size_t WS_WDNT = 640 * MiB;
constexpr size_t WS_BASE0 = 1024 * MiB;
constexpr size_t WS_PROJ = WS_BASE0;
constexpr size_t WS_VT = WS_PROJ + 608 * MiB;
constexpr size_t WS_YA = WS_VT + 64 * MiB;
constexpr size_t WS_RKV = WS_YA + 64 * MiB;
constexpr size_t WS_LORAIN = WS_RKV + 192 * MiB;
constexpr size_t WS_DECAY = WS_LORAIN + 32 * MiB;
constexpr size_t WS_ICLR = WS_DECAY + 128 * MiB;
constexpr size_t WS_G = WS_ICLR + 128 * MiB;
constexpr size_t WS_YSCAN = WS_G + 64 * MiB;
constexpr size_t WS_YB = WS_YSCAN + 128 * MiB;
constexpr size_t WS_MERGED = WS_YB + 64 * MiB;
constexpr size_t WS_XB16 = WS_MERGED + 128 * MiB;
constexpr size_t WS_MIX_END = WS_XB16 + 128 * MiB;
constexpr size_t WS_Z = 2816 * MiB;
constexpr size_t WS_H1 = 3072 * MiB;
constexpr size_t WS_H1B = 3328 * MiB;
constexpr size_t WS_CHK = 3456 * MiB;
constexpr size_t WS_END = 3712 * MiB;
constexpr size_t WS_XG = WS_BASE0;
constexpr size_t WS_ACT = WS_BASE0 + 544 * MiB;
constexpr size_t WS_YSLOT = WS_BASE0 + 1088 * MiB;
static_assert(WS_MIX_END <= WS_Z && WS_YSLOT + 512 * MiB <= WS_Z, "ws map");
static_assert(WS_WINT + (size_t)PROJ_LD * D * 2 <= WS_WGUT, "ws map");

constexpr int CW_CNT = 512;
constexpr int CW_CUR = 576;
constexpr int CW_BAR = 4096;

constexpr int RING_OFF = 0, RING_BYTES = 131072;
constexpr int LDS_BYTES = 160 * 1024;
constexpr int MISC_OFF = LDS_BYTES - 512;
constexpr int TAB_OFF = LDS_BYTES - 1024;

#define RLX_AGENT __ATOMIC_RELAXED, __HIP_MEMORY_SCOPE_AGENT
#define LDS_WAIT() asm volatile("s_waitcnt lgkmcnt(0)" ::: "memory")
#define VM_WAIT() asm volatile("s_waitcnt vmcnt(0)" ::: "memory")
__device__ __forceinline__ unsigned f2bf(float f) { unsigned u = __builtin_bit_cast(unsigned, f); return (u + 0x7fffu + ((u >> 16) & 1u)) >> 16; }
__device__ __forceinline__ unsigned pk2(float lo, float hi) { return f2bf(lo) | (f2bf(hi) << 16); }
__device__ __forceinline__ float bf2f(unsigned short h) { return __builtin_bit_cast(float, (unsigned)h << 16); }
__device__ __forceinline__ float bflo(unsigned w) { return __builtin_bit_cast(float, w << 16); }
__device__ __forceinline__ float bfhi(unsigned w) { return __builtin_bit_cast(float, w & 0xffff0000u); }
__device__ __forceinline__ float fsigmoid(float x) { return __builtin_amdgcn_rcpf(1.0f + __expf(-x)); }
__device__ __forceinline__ float dpp_f(float x, const int ctrl_sel) {
    const int xi = __builtin_bit_cast(int, x); int r;
    if (ctrl_sel == 0) r = __builtin_amdgcn_update_dpp(0, xi, 0xB1, 0xF, 0xF, false);
    else if (ctrl_sel == 1) r = __builtin_amdgcn_update_dpp(0, xi, 0x4E, 0xF, 0xF, false);
    else if (ctrl_sel == 2) r = __builtin_amdgcn_update_dpp(0, xi, 0x124, 0xF, 0xF, false);
    else r = __builtin_amdgcn_update_dpp(0, xi, 0x128, 0xF, 0xF, false);
    return __builtin_bit_cast(float, r);
}
__device__ __forceinline__ float rowsum16(float x) { x += dpp_f(x, 0); x += dpp_f(x, 1); x += dpp_f(x, 2); x += dpp_f(x, 3); return x; }
__device__ __forceinline__ float quadsum(float x) { x += dpp_f(x, 0); x += dpp_f(x, 1); return x; }
__device__ __forceinline__ float wave_sum(float v) {
    v = rowsum16(v);
    const int vi = __builtin_bit_cast(int, v);
    const float s0 = __builtin_bit_cast(float, __builtin_amdgcn_readlane(vi, 0)), s1 = __builtin_bit_cast(float, __builtin_amdgcn_readlane(vi, 16));
    const float s2 = __builtin_bit_cast(float, __builtin_amdgcn_readlane(vi, 32)), s3 = __builtin_bit_cast(float, __builtin_amdgcn_readlane(vi, 48));
    return (s0 + s1) + (s2 + s3);
}
namespace pg8 {
#define PG8_LAS __attribute__((address_space(3)))
typedef unsigned short bf16_t;
typedef unsigned u32x4 __attribute__((ext_vector_type(4)));
constexpr int BM = 256, BK = 64, HALF = 128, HTB = HALF * BK * 2, STAGE_BYTES = 8 * HTB, NXCD = 8, WGM = 8;

__host__ __device__ __forceinline__ int lds_byte(int r, int c) { const int st = (r >> 4) * 2 + (c >> 5), rr = r & 15, cc = c & 31, ob = rr * 64 + cc * 2; return st * 1024 + (ob ^ (((ob >> 9) & 1) << 5)); }
__host__ __device__ __forceinline__ void stage_rc(int b, int& R, int& C) { const int st = b / 1024, sb = b % 1024, swz = sb ^ (((sb >> 9) & 1) << 5); R = (st >> 1) * 16 + swz / 64; C = (st & 1) * 32 + (swz % 64) / 2; }
__host__ __device__ __forceinline__ int perm32(int rho) { const int n = rho >> 4, i = rho & 15; return 8 * (i >> 2) + 4 * n + (i & 3); }

struct Unit { int pm, pn, aux; };

struct Tiler {
    int nM, nN, nwg, G, c;
    __device__ __forceinline__ void init(int nM_, int nN_, int G_, int c_) { nM = nM_; nN = nN_; nwg = nM * nN; G = G_; c = c_; }
    __device__ __forceinline__ bool map(int i, int& pm, int& pn) const {
        const long L = (long)i * G + c; if (L >= nwg) return false;
        int wgid = (int)L; { const int q = nwg / NXCD, r = nwg % NXCD, xcd = wgid % NXCD, off = wgid / NXCD; wgid = (xcd < r ? xcd * (q + 1) : r * (q + 1) + (xcd - r) * q) + off; }
        const int nig = WGM * nN, gid = wgid / nig, fm = gid * WGM, gsz = (nM - fm) < WGM ? (nM - fm) : WGM;
        pm = fm + ((wgid % nig) % gsz); pn = (wgid % nig) / gsz; return true;
    }
};
struct SchedPlain {
    Tiler t; unsigned A, B, tsA, tsB;
    __device__ __forceinline__ bool next(int i, Unit& u) const { u.aux = 0; return t.map(i, u.pm, u.pn); }
    __device__ __forceinline__ void bases(const Unit& u, unsigned& a, unsigned& b) const { a = A + (unsigned)u.pm * tsA; b = B + (unsigned)u.pn * tsB; }
};
struct SchedTwo {
    Tiler t; unsigned A0, A1, B0, B1, tsA, tsB;
    __device__ __forceinline__ bool next(int i, Unit& u) const { u.aux = i & 1; return t.map(i >> 1, u.pm, u.pn); }
    __device__ __forceinline__ void bases(const Unit& u, unsigned& a, unsigned& b) const { a = (u.aux ? A1 : A0) + (unsigned)u.pm * tsA; b = (u.aux ? B1 : B0) + (unsigned)u.pn * tsB; }
};
struct SchedMoe {
    Tiler t; unsigned A, B, tsA, tsB, es; const PG8_LAS int* pad_end;
    __device__ __forceinline__ bool next(int i, Unit& u) const {
        if (!t.map(i, u.pm, u.pn)) return false;
        const int row0 = u.pm * BM; int e = 0;
#pragma unroll
        for (int j = 0; j < 32; ++j) e += (pad_end[j] <= row0) ? 1 : 0;
        u.aux = __builtin_amdgcn_readfirstlane(e < 31 ? e : 31); return true;
    }
    __device__ __forceinline__ void bases(const Unit& u, unsigned& a, unsigned& b) const { a = A + (unsigned)u.pm * tsA; b = B + (unsigned)u.aux * es + (unsigned)u.pn * tsB; }
};

typedef float f32x2_t_ __attribute__((ext_vector_type(2)));
typedef __bf16 bf16x2_t_ __attribute__((ext_vector_type(2)));
__device__ __forceinline__ unsigned cvt_pk_bf16(float lo, float hi) { const f32x2_t_ v = {lo, hi}; const bf16x2_t_ b = __builtin_convertvector(v, bf16x2_t_); return __builtin_bit_cast(unsigned, b); }
__device__ __forceinline__ u32x4 pack8(const f32x4& v0, const f32x4& v1) { u32x4 w; w.x = cvt_pk_bf16(v0[0], v0[1]); w.y = cvt_pk_bf16(v0[2], v0[3]); w.z = cvt_pk_bf16(v1[0], v1[1]); w.w = cvt_pk_bf16(v1[2], v1[3]); return w; }

typedef int i32x8 __attribute__((ext_vector_type(8)));
typedef int i32x4 __attribute__((ext_vector_type(4)));
__device__ __forceinline__ i32x8 cat8(const bf16x8& a, const bf16x8& b) { return __builtin_shufflevector(__builtin_bit_cast(i32x4, a), __builtin_bit_cast(i32x4, b), 0, 1, 2, 3, 4, 5, 6, 7); }
constexpr int F8_SCALES = 0x00007f79;
template <class Epi, class Sched, bool ALIGN_EPI, bool F8 = false>
__device__ __forceinline__ void gemm_phase(PG8_LAS unsigned char* lds, const __amdgpu_buffer_rsrc_t rsrc, const int lda, const int ldb, const int K, const Sched& S, const Epi& E) {
    int tid_ = threadIdx.x; asm volatile("" : "+v"(tid_));
    const int tid = tid_, wid = __builtin_amdgcn_readfirstlane(tid >> 6), lane = tid & 63, wr = wid >> 2, wc = wid & 3, fr = lane & 15, fq = lane >> 4;
    const int nt = K / BK;
    unsigned voffA, voffB;
    { int R, C; stage_rc(tid * 16, R, C); const int Rb = (R & ~31) + perm32(R & 31); voffA = (unsigned)(R * lda + C) * 2u; voffB = (unsigned)(Rb * ldb + C) * 2u; }
    const unsigned p1voffA = 64u * (unsigned)lda * 2u, p1voffB = 64u * (unsigned)ldb * 2u;
    const unsigned kstep = (unsigned)(BK * 2);
    const unsigned hsA = (unsigned)HALF * lda * 2, hsB = (unsigned)HALF * ldb * 2;
    const unsigned ldsw = (unsigned)wid * 1024u;
    const int aoff = lds_byte(wr * 64 + fr, fq * 8), boff = lds_byte(wc * 32 + fr, fq * 8);
#define PG8_SA(b, h) (((b) * 2 + (h)) * HTB)
#define PG8_SB(b, h) ((4 + (b) * 2 + (h)) * HTB)
#define PG8_STAGE(bufoff, goff, voff) do { _Pragma("unroll") for (int _i = 0; _i < 2; ++_i) \
        __builtin_amdgcn_raw_ptr_buffer_load_lds(rsrc, (PG8_LAS void*)(lds + (bufoff) + ldsw + _i * 8192), 16, (int)(voff), (int)((goff) + _i * p1##voff), 0, 0); } while (0)
#define PG8_LD8(addr) __builtin_shufflevector(*(const PG8_LAS i32x4*)(addr), *(const PG8_LAS i32x4*)((addr) + 1024), 0, 1, 2, 3, 4, 5, 6, 7)
#define PG8_LDA(dst, b, h) do { _Pragma("unroll") for (int m = 0; m < 4; ++m) dst[m] = PG8_LD8(lds + PG8_SA(b, h) + aoff + m * 2048); } while (0)
#define PG8_LDB(dst, b, h) do { _Pragma("unroll") for (int n = 0; n < 2; ++n) dst[n] = PG8_LD8(lds + PG8_SB(b, h) + boff + n * 2048); } while (0)
#define PG8_LO(v) __builtin_bit_cast(bf16x8, __builtin_shufflevector(v, v, 0, 1, 2, 3))
#define PG8_HI(v) __builtin_bit_cast(bf16x8, __builtin_shufflevector(v, v, 4, 5, 6, 7))
#define PG8_MMA(ai, bj, At, Bt) do { __builtin_amdgcn_s_setprio(1); \
        if constexpr (!F8) { _Pragma("unroll") for (int m = 0; m < 4; ++m) _Pragma("unroll") for (int n = 0; n < 2; ++n) { \
            acc[ai][bj][m][n] = __builtin_amdgcn_mfma_f32_16x16x32_bf16(PG8_LO(Bt[n]), PG8_LO(At[m]), acc[ai][bj][m][n], 0, 0, 0); \
            acc[ai][bj][m][n] = __builtin_amdgcn_mfma_f32_16x16x32_bf16(PG8_HI(Bt[n]), PG8_HI(At[m]), acc[ai][bj][m][n], 0, 0, 0); } } \
        else { _Pragma("unroll") for (int m = 0; m < 4; ++m) _Pragma("unroll") for (int n = 0; n < 2; ++n) \
            acc[ai][bj][m][n] = __builtin_amdgcn_mfma_scale_f32_16x16x128_f8f6f4(Bt[n], At[m], acc[ai][bj][m][n], 0, 0, 0, F8_SCALES, 1, F8_SCALES); } \
        __builtin_amdgcn_s_setprio(0); } while (0)
#define PG8_WAIT_V(n) asm volatile("s_waitcnt vmcnt(" #n ")" ::: "memory")
#define PG8_WAIT_L(n) asm volatile("s_waitcnt lgkmcnt(" #n ")" ::: "memory")
#define PG8_BAR __builtin_amdgcn_s_barrier()
#define PG8_SCHED __builtin_amdgcn_sched_barrier(0)
#define PG8_ZERO() do { _Pragma("unroll") for (int a = 0; a < 2; ++a) _Pragma("unroll") for (int b = 0; b < 2; ++b) _Pragma("unroll") for (int m = 0; m < 4; ++m) _Pragma("unroll") for (int n = 0; n < 2; ++n) acc[a][b][m][n] = (f32x4){0.f, 0.f, 0.f, 0.f}; } while (0)
    Unit cur, nxt; int ui = 0;
    if (!S.next(0, cur)) return;
    f32x4 acc[2][2][4][2];
    PG8_ZERO();
    i32x8 At[4], B0[2], B1[2];
    unsigned cA, cB; S.bases(cur, cA, cB); cA = __builtin_amdgcn_readfirstlane(cA); cB = __builtin_amdgcn_readfirstlane(cB);
    PG8_STAGE(PG8_SB(0, 0), cB, voffB); PG8_STAGE(PG8_SB(0, 1), cB + hsB, voffB); PG8_STAGE(PG8_SA(0, 0), cA, voffA); PG8_STAGE(PG8_SA(0, 1), cA + hsA, voffA);
    if (wr == 1) PG8_BAR;
    PG8_WAIT_V(2); PG8_BAR;
    PG8_STAGE(PG8_SB(1, 0), cB + kstep, voffB); PG8_STAGE(PG8_SA(1, 0), cA + kstep, voffA); PG8_STAGE(PG8_SB(1, 1), cB + hsB + kstep, voffB);
    PG8_WAIT_V(6); PG8_BAR;
    for (;;) {
        const bool has_next = S.next(ui + 1, nxt);
        unsigned nA = cA, nB = cB; if (has_next) { S.bases(nxt, nA, nB); nA = __builtin_amdgcn_readfirstlane(nA); nB = __builtin_amdgcn_readfirstlane(nB); }
#pragma unroll 1
        for (int t = 0; t < nt; t += 2) {
            const bool last = (t == nt - 2);
            const unsigned a1 = cA + (unsigned)(t + 1) * kstep;
            const unsigned a2 = last ? nA : cA + (unsigned)(t + 2) * kstep, b2 = last ? nB : cB + (unsigned)(t + 2) * kstep;
            const unsigned a3 = a2 + kstep, b3 = b2 + kstep;
            PG8_LDB(B0, 0, 0); PG8_LDB(B1, 0, 1); PG8_SCHED; PG8_LDA(At, 0, 0); PG8_STAGE(PG8_SA(1, 1), a1 + hsA, voffA);
            PG8_WAIT_V(8); PG8_WAIT_L(0); PG8_BAR; PG8_MMA(0, 0, At, B0); PG8_MMA(0, 1, At, B1); PG8_BAR; PG8_SCHED;
            PG8_LDA(At, 0, 1); PG8_STAGE(PG8_SB(0, 0), b2, voffB); PG8_STAGE(PG8_SB(0, 1), b2 + hsB, voffB); PG8_STAGE(PG8_SA(0, 0), a2, voffA);
            PG8_WAIT_V(8); PG8_WAIT_L(0); PG8_BAR; PG8_MMA(1, 0, At, B0); PG8_MMA(1, 1, At, B1); PG8_BAR; PG8_SCHED;
            PG8_LDB(B0, 1, 0); PG8_LDB(B1, 1, 1); PG8_SCHED; PG8_LDA(At, 1, 0); PG8_STAGE(PG8_SA(0, 1), a2 + hsA, voffA);
            PG8_WAIT_V(8); PG8_WAIT_L(0); PG8_BAR; PG8_MMA(0, 0, At, B0); PG8_MMA(0, 1, At, B1); PG8_BAR; PG8_SCHED;
            PG8_LDA(At, 1, 1); PG8_STAGE(PG8_SB(1, 0), b3, voffB); PG8_STAGE(PG8_SB(1, 1), b3 + hsB, voffB); PG8_STAGE(PG8_SA(1, 0), a3, voffA);
            PG8_WAIT_V(8); PG8_WAIT_L(0); PG8_BAR; PG8_MMA(1, 0, At, B0); PG8_MMA(1, 1, At, B1); PG8_BAR; PG8_SCHED;
        }
        if constexpr (ALIGN_EPI) { if (wr == 0) PG8_BAR; }
        bool keep; { int t2 = threadIdx.x; asm volatile("" : "+v"(t2)); const int w2 = __builtin_amdgcn_readfirstlane(t2 >> 6), l2 = t2 & 63; keep = E(acc, cur, w2 >> 2, w2 & 3, l2 & 15, l2 >> 4); }
        if (!has_next) break;
        if (!keep) PG8_ZERO();
        cur = nxt; cA = nA; cB = nB; ++ui;
        if constexpr (ALIGN_EPI) { if (wr == 1) PG8_BAR; }
    }
    PG8_WAIT_V(0);
    if constexpr (!ALIGN_EPI) { if (wr == 0) PG8_BAR; }
    PG8_BAR;
#undef PG8_SA
#undef PG8_SB
#undef PG8_STAGE
#undef PG8_LDA
#undef PG8_LDB
#undef PG8_LD8
#undef PG8_LO
#undef PG8_HI
#undef PG8_MMA
#undef PG8_WAIT_V
#undef PG8_WAIT_L
#undef PG8_BAR
#undef PG8_SCHED
#undef PG8_ZERO
}
}
namespace pg8 {
#define EPI_ROWLOOP _Pragma("unroll") for (int ai = 0; ai < 2; ++ai) _Pragma("unroll") for (int m = 0; m < 4; ++m)
struct EpiProj {
    bf16_t* O;
    __device__ __forceinline__ bool operator()(f32x4 (&acc)[2][2][4][2], const Unit& u, int wr, int wc, int fr, int fq) const {
        const int row0 = u.pm * BM + wr * 64 + fr, col0 = u.pn * BM + wc * 32 + 8 * fq;
        const int mode = (u.pn < 4) ? 1 : (u.pn >= 22 ? 2 : 0);
        EPI_ROWLOOP { bf16_t* rowp = O + (size_t)(row0 + ai * HALF + m * 16) * PROJ_LD + col0;
#pragma unroll
            for (int bj = 0; bj < 2; ++bj) { f32x4 v0 = acc[ai][bj][m][0], v1 = acc[ai][bj][m][1];
                if (mode == 1) { v0 = v0 * 0.125f; v1 = v1 * 0.125f; }
                else if (mode == 2) {
#pragma unroll
                    for (int j = 0; j < 4; ++j) { v0[j] = fsigmoid(v0[j]); v1[j] = fsigmoid(v1[j]); } }
                *(u32x4*)(rowp + bj * HALF) = pack8(v0, v1); } }
        return false;
    }
};
struct EpiBf16 {
    bf16_t* O; int ldc;
    __device__ __forceinline__ bool operator()(f32x4 (&acc)[2][2][4][2], const Unit& u, int wr, int wc, int fr, int fq) const {
        const int row0 = u.pm * BM + wr * 64 + fr, col0 = u.pn * BM + wc * 32 + 8 * fq;
        EPI_ROWLOOP { bf16_t* rowp = O + (size_t)(row0 + ai * HALF + m * 16) * ldc + col0;
#pragma unroll
            for (int bj = 0; bj < 2; ++bj) *(u32x4*)(rowp + bj * HALF) = pack8(acc[ai][bj][m][0], acc[ai][bj][m][1]); }
        return false;
    }
};
template <bool ISDEC> struct EpiLoraA {
    float* OUT; const float* par;
    __device__ __forceinline__ bool operator()(f32x4 (&acc)[2][2][4][2], const Unit& u, int wr, int wc, int fr, int fq) const {
        const int row0 = u.pm * BM + wr * 64 + fr, col0 = u.pn * BM + wc * 32 + 8 * fq;
        f32x4 pv[2][2];
#pragma unroll
        for (int bj = 0; bj < 2; ++bj)
#pragma unroll
            for (int n = 0; n < 2; ++n) pv[bj][n] = *(const f32x4*)(par + col0 + bj * HALF + 4 * n);
        EPI_ROWLOOP { float* rowp = OUT + (size_t)(row0 + ai * HALF + m * 16) * RW + col0;
#pragma unroll
            for (int bj = 0; bj < 2; ++bj)
#pragma unroll
                for (int n = 0; n < 2; ++n) { f32x4 v = acc[ai][bj][m][n] + pv[bj][n];
#pragma unroll
                    for (int j = 0; j < 4; ++j) {
                        if (ISDEC) { const float y = -v[j]; const float sp = fmaxf(y, 0.f) + __logf(1.0f + __expf(-fabsf(y))); const float w = -sp - 0.5f; v[j] = -__expf(w); }
                        else v[j] = fsigmoid(v[j]); }
                    *(f32x4*)(rowp + bj * HALF + 4 * n) = v; } }
        return false;
    }
};
struct EpiMerged {
    const bf16_t* PROJ; bf16_t* O;
    __device__ __forceinline__ bool operator()(f32x4 (&acc)[2][2][4][2], const Unit& u, int wr, int wc, int fr, int fq) const {
        const int row0 = u.pm * BM + wr * 64 + fr, col0 = u.pn * BM + wc * 32 + 8 * fq;
        EPI_ROWLOOP { const int row = row0 + ai * HALF + m * 16; const bf16_t* gp = PROJ + (size_t)row * PROJ_LD + col0;
#pragma unroll
            for (int bj = 0; bj < 2; ++bj) {
                const u32x4 gb = *(const u32x4*)(gp + PJ_GB + bj * HALF);
                f32x4 b0 = (f32x4){bflo(gb.x), bfhi(gb.x), bflo(gb.y), bfhi(gb.y)}, b1 = (f32x4){bflo(gb.z), bfhi(gb.z), bflo(gb.w), bfhi(gb.w)};
                if (u.aux == 0) {
                    const u32x4 ga = *(const u32x4*)(gp + PJ_GA + bj * HALF);
                    f32x4 a0 = (f32x4){bflo(ga.x), bfhi(ga.x), bflo(ga.y), bfhi(ga.y)}, a1 = (f32x4){bflo(ga.z), bfhi(ga.z), bflo(ga.w), bfhi(ga.w)};
#pragma unroll
                    for (int j = 0; j < 4; ++j) { acc[ai][bj][m][0][j] *= a0[j] / fmaxf(b0[j], 1e-30f); acc[ai][bj][m][1][j] *= a1[j] / fmaxf(b1[j], 1e-30f); }
                } else {
                    *(u32x4*)(O + (size_t)row * D + col0 + bj * HALF) = pack8(acc[ai][bj][m][0] * b0, acc[ai][bj][m][1] * b1);
                } } }
        return u.aux == 0;
    }
};
struct EpiZ {
    const float* X; float* Z;
    __device__ __forceinline__ bool operator()(f32x4 (&acc)[2][2][4][2], const Unit& u, int wr, int wc, int fr, int fq) const {
        const int row0 = u.pm * BM + wr * 64 + fr, col0 = u.pn * BM + wc * 32 + 8 * fq;
        EPI_ROWLOOP { const size_t off = (size_t)(row0 + ai * HALF + m * 16) * D + col0;
#pragma unroll
            for (int bj = 0; bj < 2; ++bj)
#pragma unroll
                for (int n = 0; n < 2; ++n) { const f32x4 xv = *(const f32x4*)(X + off + bj * HALF + 4 * n); *(f32x4*)(Z + off + bj * HALF + 4 * n) = xv * DN_ALPHA + acc[ai][bj][m][n]; } }
        return false;
    }
};
struct EpiSwiglu {
    unsigned char* ACT; const float* bgu;
    __device__ __forceinline__ bool operator()(f32x4 (&acc)[2][2][4][2], const Unit& u, int wr, int wc, int fr, int fq) const {
        const int row0 = u.pm * BM + wr * 64 + fr, col0 = u.pn * HALF + wc * 32 + 8 * fq;
        const float* bp = bgu + (size_t)u.aux * (2 * FF) + col0;
        f32x4 bg[2], bu[2];
#pragma unroll
        for (int n = 0; n < 2; ++n) { bg[n] = *(const f32x4*)(bp + 4 * n); bu[n] = *(const f32x4*)(bp + FF + 4 * n); }
        EPI_ROWLOOP { f32x4 o[2];
#pragma unroll
            for (int n = 0; n < 2; ++n) { const f32x4 g = acc[ai][0][m][n] + bg[n], uu = acc[ai][1][m][n] + bu[n];
#pragma unroll
                for (int j = 0; j < 4; ++j) { const float gc = fminf(g[j], 7.0f), uc = fminf(fmaxf(uu[j], -7.0f), 7.0f); o[n][j] = (uc + 1.0f) * (gc * fsigmoid(1.702f * gc)); } }
            int w0 = __builtin_amdgcn_cvt_pk_fp8_f32(o[0][0], o[0][1], 0, false); w0 = __builtin_amdgcn_cvt_pk_fp8_f32(o[0][2], o[0][3], w0, true);
            int w1 = __builtin_amdgcn_cvt_pk_fp8_f32(o[1][0], o[1][1], 0, false); w1 = __builtin_amdgcn_cvt_pk_fp8_f32(o[1][2], o[1][3], w1, true);
            *(v2u*)(ACT + (size_t)(row0 + ai * HALF + m * 16) * FF + col0) = (v2u){(unsigned)w0, (unsigned)w1}; }
        return false;
    }
};
struct EpiDown {
    bf16_t* YS; const float* bdn; const int* rowslot; const float* roww;
    __device__ __forceinline__ bool operator()(f32x4 (&acc)[2][2][4][2], const Unit& u, int wr, int wc, int fr, int fq) const {
        const int row0 = u.pm * BM + wr * 64 + fr, col0 = u.pn * BM + wc * 32 + 8 * fq;
        const float* bp = bdn + (size_t)u.aux * D + col0;
        f32x4 bv[2][2];
#pragma unroll
        for (int bj = 0; bj < 2; ++bj)
#pragma unroll
            for (int n = 0; n < 2; ++n) bv[bj][n] = *(const f32x4*)(bp + bj * HALF + 4 * n);
        EPI_ROWLOOP { const int row = row0 + ai * HALF + m * 16; const int slot = rowslot[row]; const float w = roww[row];
            if (slot >= 0) { bf16_t* rowp = YS + (size_t)slot * D + col0;
#pragma unroll
                for (int bj = 0; bj < 2; ++bj) *(u32x4*)(rowp + bj * HALF) = pack8((acc[ai][bj][m][0] + bv[bj][0]) * w, (acc[ai][bj][m][1] + bv[bj][1]) * w); } }
        return false;
    }
};
#undef EPI_ROWLOOP
}

#define XB_TMO      128
#define XB_XCNT(j)  (256  + 64 * (j))
#define XB_XSUB(j)  (1280 + 64 * (j))
#define XB_XGEN(j)  (2304 + 64 * (j))
#define XB_TOP      3328
#define XB_TOPGEN   3392
#define XCD_BAR_WORDS 3456
#define XB_SPIN_CAP (1u << 18)

__device__ __forceinline__ unsigned xb_ld(unsigned* p)              { return __hip_atomic_load(p, __ATOMIC_RELAXED, __HIP_MEMORY_SCOPE_AGENT); }
__device__ __forceinline__ unsigned xb_add(unsigned* p, unsigned v) { return __hip_atomic_fetch_add(p, v, __ATOMIC_RELAXED, __HIP_MEMORY_SCOPE_AGENT); }
__device__ __forceinline__ unsigned xb_xcc_id() { return (unsigned)__builtin_amdgcn_s_getreg((3 << 11) | 20) & 0xFu; }
#define XB_SPIN(cond, bar) do { unsigned _sp = 0; while (cond) { __builtin_amdgcn_s_sleep(1); \
    if ((++_sp & 255u) == 0u) { if (xb_ld(&(bar)[XB_TMO])) break; if (_sp > XB_SPIN_CAP) { atomicAdd(&(bar)[XB_TMO], 1u); break; } } } } while (0)

struct XcdBarrier {
    unsigned* bar; unsigned x;
    volatile LAS unsigned* st;
};

__device__ __forceinline__ XcdBarrier xcd_barrier_post(unsigned* bar, volatile LAS unsigned* st) {
    XcdBarrier b; b.bar = bar; b.x = xb_xcc_id(); b.st = st;
    if (threadIdx.x == 0) (void)xb_add(&bar[XB_XCNT(b.x)], 1u);
    return b;
}
__device__ __forceinline__ void xcd_barrier_complete(unsigned* bar, unsigned x, unsigned& nloc, unsigned& nx) {
    const unsigned G = gridDim.x * gridDim.y * gridDim.z;
    unsigned sum, cnt, mine, sp = 0u;
    for (;;) {
        sum = 0u; cnt = 0u; mine = 0u;
#pragma unroll
        for (unsigned j = 0; j < 16; ++j) { const unsigned c = xb_ld(&bar[XB_XCNT(j)]); sum += c; cnt += (c > 0u) ? 1u : 0u; mine = (j == x) ? c : mine; }
        if (sum == G) break;
        __builtin_amdgcn_s_sleep(1);
        if ((++sp & 255u) == 0u) { if (xb_ld(&bar[XB_TMO])) break; if (sp > XB_SPIN_CAP) { atomicAdd(&bar[XB_TMO], 1u); break; } }
    }
    nloc = mine > 0u ? mine : 1u; nx = cnt > 0u ? cnt : 1u;
}

__device__ __forceinline__ void xcd_barrier(const XcdBarrier& b) {
    asm volatile("s_waitcnt vmcnt(0)" ::: "memory");
    __syncthreads();
    if (threadIdx.x == 0) {
        unsigned* bar = b.bar;
        __builtin_amdgcn_s_waitcnt(0);
        unsigned nloc = b.st[0], nx = b.st[1];
        if (nloc == 0u) { xcd_barrier_complete(bar, b.x, nloc, nx); b.st[0] = nloc; b.st[1] = nx; }
        const unsigned old = xb_add(&bar[XB_XSUB(b.x)], 1u);
        const unsigned gen = old / nloc;
        if (old + 1u == (gen + 1u) * nloc) {
            __builtin_amdgcn_fence(__ATOMIC_RELEASE, "agent");
            asm volatile("s_waitcnt vmcnt(0)" ::: "memory");
            const unsigned og = xb_add(&bar[XB_TOP], 1u);
            const unsigned tg = og / nx;
            if (og + 1u == (tg + 1u) * nx) xb_add(&bar[XB_TOPGEN], 1u);
            else XB_SPIN(xb_ld(&bar[XB_TOPGEN]) == tg, bar);
            __builtin_amdgcn_fence(__ATOMIC_ACQUIRE, "agent");
            xb_add(&bar[XB_XGEN(b.x)], 1u);
            asm volatile("s_waitcnt vmcnt(0)" ::: "memory");
        } else {
            XB_SPIN(xb_ld(&bar[XB_XGEN(b.x)]) == gen, bar);
            __builtin_amdgcn_fence(__ATOMIC_ACQUIRE, "agent");
            asm volatile("s_waitcnt vmcnt(0)" ::: "memory");
        }
    }
    __syncthreads();
}
struct Frame {
    LAS unsigned char* lds;
    volatile LAS unsigned* MISC;
    gu32* ctl;
    int tid, lane, wave;
    int vcu, G;
    unsigned char* ws;
    __amdgpu_buffer_rsrc_t rsrc;
};

#define PHASE_FRAME(F0) Frame F = (F0); { int t_ = threadIdx.x; asm volatile("" : "+v"(t_)); F.tid = t_; F.lane = t_ & 63; F.wave = __builtin_amdgcn_readfirstlane(t_ >> 6); }

__device__ __forceinline__ void tr_item(const float* W, size_t ldw, int k0, int c0, bf16* WT, size_t ldt, int drow0, LAS float* scr, int lane) {
    const int kr = lane >> 4, cq = lane & 15;
    f32x4 v[16];
#pragma unroll
    for (int i = 0; i < 16; ++i) v[i] = *(const GAS f32x4*)(W + (size_t)(k0 + 4 * i + kr) * ldw + c0 + 4 * cq);
#pragma unroll
    for (int i = 0; i < 16; ++i)
#pragma unroll
        for (int j = 0; j < 4; ++j) scr[(4 * cq + j) * 65 + 4 * i + kr] = v[i][j];
    LDS_WAIT(); asm volatile("" ::: "memory");
    const int c = lane & 7;
#pragma unroll
    for (int jj = 0; jj < 8; ++jj) { const int n = (lane >> 3) + 8 * jj; const LAS float* s = scr + n * 65 + 8 * c;
        v4u o; o.x = pk2(s[0], s[1]); o.y = pk2(s[2], s[3]); o.z = pk2(s[4], s[5]); o.w = pk2(s[6], s[7]);
        *(GAS v4u*)(WT + (size_t)(drow0 + n) * ldt + k0 + 8 * c) = o; }
    LDS_WAIT(); asm volatile("" ::: "memory");
}

__device__ __forceinline__ void tr8_load(const float* W, size_t ldw, int k0, int c0, f32x4 (&v)[16], int lane) {
    const int kr = lane >> 4, cq = lane & 15;
#pragma unroll
    for (int i = 0; i < 16; ++i) v[i] = *(const GAS f32x4*)(W + (size_t)(k0 + 4 * i + kr) * ldw + c0 + 4 * cq);
}
__device__ __forceinline__ void tr8_finish(const f32x4 (&v)[16], int k0, unsigned char* WT, size_t ldt, int drow0, LAS float* scr, int lane, float sc) {
    const int kr = lane >> 4, cq = lane & 15;
#pragma unroll
    for (int i = 0; i < 16; ++i)
#pragma unroll
        for (int j = 0; j < 4; ++j) scr[(4 * cq + j) * 65 + 4 * i + kr] = v[i][j] * sc;
    LDS_WAIT(); asm volatile("" ::: "memory");
    const int c = lane & 3;
#pragma unroll
    for (int jj = 0; jj < 4; ++jj) { const int n = (lane >> 2) + 16 * jj; const LAS float* s = scr + n * 65 + 16 * c;
        int w[4];
#pragma unroll
        for (int q = 0; q < 4; ++q) { w[q] = __builtin_amdgcn_cvt_pk_fp8_f32(s[4 * q], s[4 * q + 1], 0, false); w[q] = __builtin_amdgcn_cvt_pk_fp8_f32(s[4 * q + 2], s[4 * q + 3], w[q], true); }
        *(GAS v4u*)(WT + (size_t)(drow0 + n) * ldt + k0 + 16 * c) = (v4u){(unsigned)w[0], (unsigned)w[1], (unsigned)w[2], (unsigned)w[3]}; }
    LDS_WAIT(); asm volatile("" ::: "memory");
}
constexpr int MOE_J4 = 32 * 32 * 64, MOE_J5 = 32 * 32 * 32, MOE_NITEMS = MOE_J4 + MOE_J5;
struct MoeItem { const float* W; size_t ldw; int k0, c0; unsigned char* WT; size_t ldt; int drow; };
__device__ __forceinline__ MoeItem moe_item(int r, const float* w_gu, const float* w_down, unsigned char* ws) {
    MoeItem m;
    if (r < MOE_J4) { const int e = r / 2048, q = r % 2048, kb = q / 64, cb = q % 64, c0 = cb * 64; const int cc = c0 & 2047;
        m.W = w_gu + (size_t)e * D * 2 * FF; m.ldw = 2 * FF; m.k0 = kb * 64; m.c0 = c0; m.WT = ws + WS_WGUT + (size_t)e * 2 * FF * D; m.ldt = D; m.drow = (cc >> 7) * 256 + (c0 >= 2048 ? 128 : 0) + (cc & 127); }
    else { r -= MOE_J4; const int e = r / 1024, q = r % 1024, kb = q / 32, cb = q % 32;
        m.W = w_down + (size_t)e * FF * D; m.ldw = D; m.k0 = kb * 64; m.c0 = cb * 64; m.WT = ws + WS_WDNT + (size_t)e * D * FF; m.ldt = FF; m.drow = cb * 64; }
    return m;
}

struct In {
    const float *x, *w_in, *rel_bias, *shift_mu, *w0, *w_up, *a0, *a_up, *g_up, *k_k, *k_a, *r_k, *lnx_w, *lnx_b, *proj_a, *proj_b, *w_out,
                *ln1_w, *ln1_b, *w_router, *b_router, *w_gu, *b_gu, *w_down, *b_down, *ln2_w, *ln2_b;
};

__device__ __forceinline__ void p0_prologue(Frame& F0, const In& I) {
    PHASE_FRAME(F0);
    LAS float* scr = (LAS float*)(F.lds + F.wave * 16640);
    const int gw = F.vcu * NWAVES + F.wave, NGW = F.G * NWAVES;
    unsigned char* ws = F.ws;
    constexpr int J0 = 32 * 167, J1 = 16 * 32, J2 = 16 * 32, J3 = 32 * 32;
    constexpr int NITEMS = J0 + J1 + J2 + J3;
    for (int it = gw; it < NITEMS; it += NGW) {
        int r = it;
        if (r < J0) { const int kb = r / 167, cb = r % 167, c0 = cb * 64; bf16* dst; int drow;
            if (c0 < 2048) { dst = (bf16*)(ws + WS_WINT); drow = c0; }
            else if (c0 < 3072) { dst = (bf16*)(ws + WS_WVT); drow = c0 - 2048; }
            else if (c0 < 6592) { dst = (bf16*)(ws + WS_WINT); drow = PJ_SEG + (c0 - 3072); }
            else { dst = (bf16*)(ws + WS_WINT); drow = PJ_GA + (c0 - 6592); }
            tr_item(I.w_in, D_IN, kb * 64, c0, dst, D, drow, scr, F.lane); continue; } r -= J0;
        if (r < J1) { const int kb = r / 32, cb = r % 32; tr_item(I.proj_a, D, kb * 64, cb * 64, (bf16*)(ws + WS_PAT), AW, cb * 64, scr, F.lane); continue; } r -= J1;
        if (r < J2) { const int kb = r / 32, cb = r % 32; tr_item(I.proj_b, D, kb * 64, cb * 64, (bf16*)(ws + WS_PBT), RW, cb * 64, scr, F.lane); continue; } r -= J2;
        { const int kb = r / 32, cb = r % 32; tr_item(I.w_out, D, kb * 64, cb * 64, (bf16*)(ws + WS_WOT), D, cb * 64, scr, F.lane); }
    }
    const int gt = F.vcu * (NWAVES * 64) + F.tid, NGT = F.G * NWAVES * 64;
    for (int i = gt; i < 2048 * 256; i += NGT) { const int n = i >> 8, k = i & 255; float v = 0.f;
        if (n < 1024) { if (k < DLORA) v = I.w_up[(size_t)k * RW + n]; }
        else { if (k >= 128 && k < 128 + ALORA) v = I.a_up[(size_t)(k - 128) * RW + (n - 1024)]; }
        ((bf16*)(ws + WS_WLA))[i] = (bf16)f2bf(v); }
    for (int i = gt; i < 1024 * 256; i += NGT) { const int n = i >> 8, k = i & 255; ((bf16*)(ws + WS_WLG))[i] = (bf16)f2bf(I.g_up[(size_t)k * RW + n]); }
    for (int i = gt; i < 64 * D / 8; i += NGT) ((GAS v4u*)((bf16*)(ws + WS_WINT) + (size_t)(PJ_SEG + SHIFT_W) * D))[i] = (v4u){0u, 0u, 0u, 0u};
    for (int i = gt; i < RROWS; i += NGT) ((int*)(ws + WS_ROWSLOT))[i] = -1;
    for (size_t i = gt; i < (size_t)T * D / 8; i += NGT) { const f32x4 a = ((const GAS f32x4*)I.x)[2 * i], b = ((const GAS f32x4*)I.x)[2 * i + 1];
        v4u o; o.x = pk2(a.x, a.y); o.y = pk2(a.z, a.w); o.z = pk2(b.x, b.y); o.w = pk2(b.z, b.w); ((GAS v4u*)(ws + WS_XB16))[i] = o; }
}

constexpr int P8_HS = 0, P8_PITCH = 2052, P8_PART = 131328, P8_LOG = 147712, P8_HIST = 149760;
template <bool SKIP_MIX>
__device__ __forceinline__ void p8_ln_router(Frame& F0, const In& I) {
    PHASE_FRAME(F0);
    LAS float* hs = (LAS float*)(F.lds + P8_HS); LAS float* part = (LAS float*)(F.lds + P8_PART); LAS float* lg = (LAS float*)(F.lds + P8_LOG); LAS int* hist = (LAS int*)(F.lds + P8_HIST);
    const int lane = F.lane, w = F.wave;
    if (F.tid < 32) hist[F.tid] = 0;
    const int kq = lane >> 4, col = lane & 15;
    float ln_w[32], ln_b[32];
#pragma unroll
    for (int j = 0; j < 8; ++j) { const f32x4 a = *(const GAS f32x4*)(I.ln1_w + 4 * lane + 256 * j), b = *(const GAS f32x4*)(I.ln1_b + 4 * lane + 256 * j);
#pragma unroll
        for (int e = 0; e < 4; ++e) { ln_w[4 * j + e] = a[e]; ln_b[4 * j + e] = b[e]; } }
    __syncthreads();
    const float* zsrc = SKIP_MIX ? I.x : (const float*)(F.ws + WS_Z);
    for (int g = F.vcu; g < T / 16; g += F.G) {
        const int tok0 = g * 16;
#pragma unroll 1
        for (int tt = 0; tt < 2; ++tt) {
            const int tl = 2 * w + tt; const size_t tok = (size_t)(tok0 + tl);
            const GAS f32x4* zr = (const GAS f32x4*)(zsrc + tok * D) + lane;
            f32x4 v[8]; float s = 0.f;
#pragma unroll
            for (int j = 0; j < 8; ++j) { v[j] = zr[64 * j]; if (SKIP_MIX) v[j] = v[j] * DN_ALPHA; s += (v[j].x + v[j].y) + (v[j].z + v[j].w); }
            const float mean = wave_sum(s) * (1.f / D); float s2 = 0.f;
#pragma unroll
            for (int j = 0; j < 8; ++j) { v[j] = v[j] - mean; s2 += (v[j].x * v[j].x + v[j].y * v[j].y) + (v[j].z * v[j].z + v[j].w * v[j].w); }
            const float rstd = 1.f / sqrtf(wave_sum(s2) * (1.f / D) + LN_EPS);
            GAS f32x4* h1 = (GAS f32x4*)((float*)(F.ws + WS_H1) + tok * D) + lane;
            GAS unsigned* h1b = (GAS unsigned*)((unsigned char*)(F.ws + WS_H1B) + tok * D) + lane;
#pragma unroll
            for (int j = 0; j < 8; ++j) { f32x4 h;
#pragma unroll
                for (int e = 0; e < 4; ++e) h[e] = v[j][e] * rstd * ln_w[4 * j + e] + ln_b[4 * j + e];
                h1[64 * j] = h; { int w8 = __builtin_amdgcn_cvt_pk_fp8_f32(h.x, h.y, 0, false); w8 = __builtin_amdgcn_cvt_pk_fp8_f32(h.z, h.w, w8, true); h1b[64 * j] = (unsigned)w8; }
                *(LAS f32x4*)(hs + tl * P8_PITCH + 4 * lane + 256 * j) = h; }
        }
        __syncthreads();
        f32x4 c0 = (f32x4){0.f, 0.f, 0.f, 0.f}, c1 = c0;
        const LAS float* ap = hs + col * P8_PITCH + 256 * w + 4 * kq;
        const float* bp = I.w_router + (size_t)(256 * w + 4 * kq) * NE + col;
#pragma unroll 4
        for (int kk = 0; kk < 16; ++kk) {
            const f32x4 a = *(const LAS f32x4*)(ap + 16 * kk);
#pragma unroll
            for (int e = 0; e < 4; ++e) {
                const float b0 = bp[(size_t)(16 * kk + e) * NE], b1 = bp[(size_t)(16 * kk + e) * NE + 16];
                c0 = __builtin_amdgcn_mfma_f32_16x16x4f32(a[e], b0, c0, 0, 0, 0);
                c1 = __builtin_amdgcn_mfma_f32_16x16x4f32(a[e], b1, c1, 0, 0, 0);
            }
        }
#pragma unroll
        for (int i = 0; i < 4; ++i) { part[(w * 16 + 4 * kq + i) * 32 + col] = c0[i]; part[(w * 16 + 4 * kq + i) * 32 + 16 + col] = c1[i]; }
        __syncthreads();
        { const int tl = F.tid >> 5, e = F.tid & 31; float s = I.b_router[e];
#pragma unroll
            for (int ww = 0; ww < 8; ++ww) s += part[(ww * 16 + tl) * 32 + e];
            lg[tl * 32 + e] = s; }
        __syncthreads();
        if (F.tid < 16) {
            const int tl = F.tid; float lv[32];
#pragma unroll
            for (int e = 0; e < 32; ++e) lv[e] = lg[tl * 32 + e];
            int ti[4]; float tv[4];
#pragma unroll
            for (int k = 0; k < 4; ++k) { float best = -3.4e38f; int bi = 0;
#pragma unroll
                for (int e = 0; e < 32; ++e) { const bool tk = lv[e] > best; best = tk ? lv[e] : best; bi = tk ? e : bi; }
                ti[k] = bi; tv[k] = best;
#pragma unroll
                for (int e = 0; e < 32; ++e) lv[e] = (e == bi) ? -3.4e38f : lv[e]; }
            float ex[4], sum = 0.f;
#pragma unroll
            for (int k = 0; k < 4; ++k) { ex[k] = __expf(tv[k] - tv[0]); sum += ex[k]; }
            const float inv = 1.f / sum;
            *(GAS v4u*)((int*)(F.ws + WS_TOPI) + (size_t)(tok0 + tl) * 4) = (v4u){(unsigned)ti[0], (unsigned)ti[1], (unsigned)ti[2], (unsigned)ti[3]};
            *(GAS f32x4*)((float*)(F.ws + WS_GATE) + (size_t)(tok0 + tl) * 4) = (f32x4){ex[0] * inv, ex[1] * inv, ex[2] * inv, ex[3] * inv};
#pragma unroll
            for (int k = 0; k < 4; ++k) __hip_atomic_fetch_add(&hist[ti[k]], 1, __ATOMIC_RELAXED, __HIP_MEMORY_SCOPE_WORKGROUP);
        }
        __syncthreads();
    }
    if (F.tid < 32) { const int c = hist[F.tid]; if (c) __hip_atomic_fetch_add(F.ctl + CW_CNT + F.tid, (unsigned)c, RLX_AGENT); }
}

template <bool SKIP_MOE>
__device__ __forceinline__ void p12_final(Frame& F0, const In& I, float* out) {
    PHASE_FRAME(F0);
    const int lane = F.lane; const int gw = F.vcu * NWAVES + F.wave, NGW = F.G * NWAVES;
    float ln_w[32], ln_b[32];
#pragma unroll
    for (int j = 0; j < 8; ++j) { const f32x4 a = *(const GAS f32x4*)(I.ln2_w + 4 * lane + 256 * j), b = *(const GAS f32x4*)(I.ln2_b + 4 * lane + 256 * j);
#pragma unroll
        for (int e = 0; e < 4; ++e) { ln_w[4 * j + e] = a[e]; ln_b[4 * j + e] = b[e]; } }
    for (int tok = gw; tok < T; tok += NGW) {
        const GAS f32x4* hr = (const GAS f32x4*)((const float*)(F.ws + WS_H1) + (size_t)tok * D) + lane;
        f32x4 v[8]; float s = 0.f;
#pragma unroll
        for (int j = 0; j < 8; ++j) v[j] = hr[64 * j] * DN_ALPHA;
        if (!SKIP_MOE) {
#pragma unroll
            for (int k = 0; k < 4; ++k) { const GAS v2u* yr = (const GAS v2u*)((const bf16*)(F.ws + WS_YSLOT) + ((size_t)tok * 4 + k) * D) + lane;
#pragma unroll
                for (int j = 0; j < 8; ++j) { const v2u y = yr[64 * j]; v[j].x += bflo(y.x); v[j].y += bfhi(y.x); v[j].z += bflo(y.y); v[j].w += bfhi(y.y); } }
        }
#pragma unroll
        for (int j = 0; j < 8; ++j) s += (v[j].x + v[j].y) + (v[j].z + v[j].w);
        const float mean = wave_sum(s) * (1.f / D); float s2 = 0.f;
#pragma unroll
        for (int j = 0; j < 8; ++j) { v[j] = v[j] - mean; s2 += (v[j].x * v[j].x + v[j].y * v[j].y) + (v[j].z * v[j].z + v[j].w * v[j].w); }
        const float rstd = 1.f / sqrtf(wave_sum(s2) * (1.f / D) + LN_EPS);
        GAS f32x4* o = (GAS f32x4*)(out + (size_t)tok * D) + lane;
#pragma unroll
        for (int j = 0; j < 8; ++j) { f32x4 h;
#pragma unroll
            for (int e = 0; e < 4; ++e) h[e] = v[j][e] * rstd * ln_w[4 * j + e] + ln_b[4 * j + e];
            o[64 * j] = h; }
    }
}
__device__ __forceinline__ void moe_tables(Frame& F) {
    LAS int* tab = (LAS int*)(F.lds + TAB_OFF);
    if (F.tid == 0) { int run = 0;
        for (int e = 0; e < NE; ++e) { const int c = (int)__hip_atomic_load(F.ctl + CW_CNT + e, RLX_AGENT); const int p = (c + 255) / 256 * 256; tab[32 + e] = run; run += p; tab[e] = run; }
        tab[64] = run / 256; }
    __syncthreads();
}

__device__ __forceinline__ void p9_scatter(Frame& F0, const In& I) {
    PHASE_FRAME(F0);
    moe_tables(F);
    LAS int* tab = (LAS int*)(F.lds + TAB_OFF);
    LAS int* lh = (LAS int*)(F.lds + 0);
    LAS int* lb = (LAS int*)(F.lds + 128);
    LAS int* dst = (LAS int*)(F.lds + 256);
    const int* topi = (const int*)(F.ws + WS_TOPI); const float* gate = (const float*)(F.ws + WS_GATE);
    for (int ch = F.vcu; ch < T / 128; ch += F.G) {
        if (F.tid < 32) lh[F.tid] = 0;
        __syncthreads();
        const int s = ch * 512 + F.tid; const int e = topi[s]; const float gv = gate[s];
        const int rank = __hip_atomic_fetch_add(&lh[e], 1, __ATOMIC_RELAXED, __HIP_MEMORY_SCOPE_WORKGROUP);
        __syncthreads();
        if (F.tid < 32) { const int c = lh[F.tid]; lb[F.tid] = c ? (int)__hip_atomic_fetch_add(F.ctl + CW_CUR + F.tid, (unsigned)c, RLX_AGENT) : 0; }
        __syncthreads();
        const int d = tab[32 + e] + lb[e] + rank;
        ((int*)(F.ws + WS_ROWSLOT))[d] = s; ((float*)(F.ws + WS_ROWW))[d] = gv; dst[F.tid] = d;
        __syncthreads();
        for (int i = F.wave; i < 512; i += NWAVES) {
            const int tok = ch * 128 + (i >> 2); const int dd = dst[i];
            const GAS v4u* src = (const GAS v4u*)((const unsigned char*)(F.ws + WS_H1B) + (size_t)tok * D) + F.lane;
            GAS v4u* o = (GAS v4u*)((unsigned char*)(F.ws + WS_XG) + (size_t)dd * D) + F.lane;
            v4u v[2];
#pragma unroll
            for (int j = 0; j < 2; ++j) v[j] = src[64 * j];
#pragma unroll
            for (int j = 0; j < 2; ++j) o[64 * j] = v[j];
        }
        __syncthreads();
    }
}

__device__ __forceinline__ void p10_moe_up(Frame& F0, const In& I) {
    PHASE_FRAME(F0);
    moe_tables(F);
    LAS int* tab = (LAS int*)(F.lds + TAB_OFF);
    pg8::SchedMoe S; S.t.init(tab[64], 16, F.G, (int)blockIdx.x);
    S.A = (unsigned)(WS_XG); S.B = (unsigned)(WS_WGUT); S.tsA = (unsigned)256 * D; S.tsB = (unsigned)256 * D; S.es = (unsigned)2 * FF * D; S.pad_end = tab;
    pg8::EpiSwiglu E{(unsigned char*)(F.ws + WS_ACT), I.b_gu};
    pg8::gemm_phase<pg8::EpiSwiglu, pg8::SchedMoe, true, true>(F.lds + RING_OFF, F.rsrc, D / 2, D / 2, D / 2, S, E);
}
__device__ __forceinline__ void p11_moe_down(Frame& F0, const In& I) {
    PHASE_FRAME(F0);
    moe_tables(F);
    LAS int* tab = (LAS int*)(F.lds + TAB_OFF);
    pg8::SchedMoe S; S.t.init(tab[64], 8, F.G, (int)blockIdx.x);
    S.A = (unsigned)(WS_ACT); S.B = (unsigned)(WS_WDNT); S.tsA = (unsigned)256 * FF; S.tsB = (unsigned)256 * FF; S.es = (unsigned)D * FF; S.pad_end = tab;
    pg8::EpiDown E{(bf16*)(F.ws + WS_YSLOT), I.b_down, (const int*)(F.ws + WS_ROWSLOT), (const float*)(F.ws + WS_ROWW)};
    pg8::gemm_phase<pg8::EpiDown, pg8::SchedMoe, true, true>(F.lds + RING_OFF, F.rsrc, FF / 2, FF / 2, FF / 2, S, E);
}

__device__ __forceinline__ void p1_proj(Frame& F0, const In& I) {
    PHASE_FRAME(F0);
    { pg8::SchedPlain S; S.t.init(T / 256, PROJ_LD / 256, F.G, (int)blockIdx.x);
      S.A = (unsigned)(WS_XB16); S.B = (unsigned)(WS_WINT); S.tsA = (unsigned)256 * D * 2; S.tsB = (unsigned)256 * D * 2;
      pg8::EpiProj E{(bf16*)(F.ws + WS_PROJ)};
      pg8::gemm_phase<pg8::EpiProj, pg8::SchedPlain, true>(F.lds + RING_OFF, F.rsrc, D, D, D, S, E); }
    { pg8::SchedPlain S; S.t.init(AW / 256, T / 256, F.G, (int)blockIdx.x);
      S.A = (unsigned)(WS_WVT); S.B = (unsigned)(WS_XB16); S.tsA = (unsigned)256 * D * 2; S.tsB = (unsigned)256 * D * 2;
      pg8::EpiBf16 E{(bf16*)(F.ws + WS_VT), T};
      pg8::gemm_phase<pg8::EpiBf16, pg8::SchedPlain, true>(F.lds + RING_OFF, F.rsrc, D, D, D, S, E); }
}

__device__ __forceinline__ float ftanh(float x) { return 2.0f * fsigmoid(2.0f * x) - 1.0f; }
__device__ __forceinline__ void p2_shift_attn(Frame& F0, const In& I) {
    PHASE_FRAME(F0);
    const int lane = F.lane; const int gw = F.vcu * NWAVES + F.wave, NGW = F.G * NWAVES;
    const bf16* PROJ = (const bf16*)(F.ws + WS_PROJ);
    for (int tok = gw; tok < T; tok += NGW) {
        const bool first = (tok % SEQ) == 0;
        const bf16* cur = PROJ + (size_t)tok * PROJ_LD + PJ_SEG; const bf16* prv = cur - PROJ_LD;
        bf16* rkv = (bf16*)(F.ws + WS_RKV) + (size_t)tok * (3 * RW); bf16* lin = (bf16*)(F.ws + WS_LORAIN) + (size_t)tok * LORA_LD;
#pragma unroll 1
        for (int it = 0; it < 7; ++it) { const int gi = it * 64 + lane; if (gi >= SHIFT_W / 8) break; const int c = gi * 8;
            const v4u cv = *(const GAS v4u*)(cur + c); v4u pv = (v4u){0u, 0u, 0u, 0u}; if (!first) pv = *(const GAS v4u*)(prv + c);
            const f32x4 m0 = *(const GAS f32x4*)(I.shift_mu + c), m1 = *(const GAS f32x4*)(I.shift_mu + c + 4);
            float v[8]; const unsigned cw[4] = {cv.x, cv.y, cv.z, cv.w}, pw[4] = {pv.x, pv.y, pv.z, pv.w};
#pragma unroll
            for (int j = 0; j < 4; ++j) { const float c0 = bflo(cw[j]), c1 = bfhi(cw[j]), p0 = bflo(pw[j]), p1 = bfhi(pw[j]); const float mu0 = (j < 2) ? m0[2 * j] : m1[2 * j - 4], mu1 = (j < 2) ? m0[2 * j + 1] : m1[2 * j - 3];
                v[2 * j] = c0 + (p0 - c0) * mu0; v[2 * j + 1] = c1 + (p1 - c1) * mu1; }
            bf16* dstp;
            if (c < 3 * RW) dstp = rkv + c;
            else if (c < 3 * RW + DLORA) { dstp = lin + (c - 3 * RW);
#pragma unroll
                for (int j = 0; j < 8; ++j) v[j] = ftanh(v[j]); }
            else if (c < 3 * RW + DLORA + ALORA) dstp = lin + 128 + (c - 3 * RW - DLORA);
            else { dstp = lin + 256 + (c - 3 * RW - DLORA - ALORA);
#pragma unroll
                for (int j = 0; j < 8; ++j) v[j] = fsigmoid(v[j]); }
            *(GAS v4u*)dstp = (v4u){pk2(v[0], v[1]), pk2(v[2], v[3]), pk2(v[4], v[5]), pk2(v[6], v[7])};
        }
        if (lane < 8) { const int c = (lane < 4) ? (DLORA + 8 * lane) : (128 + ALORA + 8 * (lane - 4)); *(GAS v4u*)(lin + c) = (v4u){0u, 0u, 0u, 0u}; }
    }
#if STAGE == 3
    { const int gt = F.vcu * (NWAVES * 64) + F.tid, NGT = F.G * NWAVES * 64;
      for (size_t i = gt; i < (size_t)T * RW / 8; i += NGT) ((GAS v4u*)(F.ws + WS_YB))[i] = (v4u){0u, 0u, 0u, 0u}; }
#endif
    LAS float* tbl = (LAS float*)(F.lds + 0);
    const bf16* VT = (const bf16*)(F.ws + WS_VT); bf16* YA = (bf16*)(F.ws + WS_YA);
    const int r = lane & 31, hh = lane >> 5;
    for (int grp = F.vcu; grp < BATCH * AH * 4; grp += F.G) {
        const int bh = grp >> 2, b = bh >> 4, h = bh & 15, qb0 = (grp & 3) * 64;
        __syncthreads();
        if (F.tid < REL_TABLE) tbl[F.tid] = I.rel_bias[h * REL_TABLE + F.tid];
        __syncthreads();
#pragma unroll 1
        for (int i8 = 0; i8 < 8; ++i8) {
            const int qb = qb0 + F.wave + 8 * i8, q0 = qb * 32, c = q0 >> 6;
            const size_t tokq = (size_t)b * SEQ + q0 + r;
            bf16x8 qf[4];
#pragma unroll
            for (int s = 0; s < 4; ++s) qf[s] = *(const GAS bf16x8*)(PROJ + tokq * PROJ_LD + PJ_Q + h * 64 + 16 * s + 8 * hh);
            f32x16 o0, o1;
#pragma unroll
            for (int i = 0; i < 16; ++i) { o0[i] = 0.f; o1[i] = 0.f; }
            float m_run = -1e30f, l_run = 0.f;
            const int kt0 = (c > LEFT ? c - LEFT : 0) * 2, kt1 = (c + 1) * 2;
            bf16x8 kf[4]; bf16x8 vf[2][2];
            const int rp = (r & 16) + 8 * ((r >> 2) & 1) + 4 * ((r >> 3) & 1) + (r & 3);
#define AT_LOAD(kt_) do { const int kp_ = (kt_) * 32; const size_t tk_ = (size_t)b * SEQ + kp_ + rp; \
                _Pragma("unroll") for (int s = 0; s < 4; ++s) kf[s] = *(const GAS bf16x8*)(PROJ + tk_ * PROJ_LD + PJ_K + h * 64 + 16 * s + 8 * hh); \
                _Pragma("unroll") for (int mt = 0; mt < 2; ++mt) _Pragma("unroll") for (int s2 = 0; s2 < 2; ++s2) \
                    vf[mt][s2] = *(const GAS bf16x8*)(VT + (size_t)(h * 64 + 32 * mt + r) * T + (size_t)b * SEQ + kp_ + 16 * s2 + 8 * hh); } while (0)
            AT_LOAD(kt0);
#pragma unroll 1
            for (int kt = kt0; kt < kt1; ++kt) {
                const int kpos0 = kt * 32;
                bf16x8 kc[4]; bf16x8 va[2], vb[2];
#pragma unroll
                for (int s = 0; s < 4; ++s) kc[s] = kf[s];
#pragma unroll
                for (int s2 = 0; s2 < 2; ++s2) { va[s2] = vf[0][s2]; vb[s2] = vf[1][s2]; }
                if (kt + 1 < kt1) AT_LOAD(kt + 1);
                f32x16 st;
#pragma unroll
                for (int i = 0; i < 16; ++i) st[i] = 0.f;
#pragma unroll
                for (int s = 0; s < 4; ++s) st = __builtin_amdgcn_mfma_f32_32x32x16_bf16(kc[s], qf[s], st, 0, 0, 0);
                const int dbase = (q0 + r) - (kpos0 + 8 * hh);
                float mx = -1e30f;
#pragma unroll
                for (int i = 0; i < 16; ++i) { int d = dbase - (16 * (i >> 3) + 4 * ((i >> 2) & 1) + (i & 3)); d = d < MAX_PAST ? d : MAX_PAST; st[i] += tbl[d + 63]; mx = fmaxf(mx, st[i]); }
                mx = fmaxf(mx, __shfl_xor(mx, 32));
                const float m_new = fmaxf(m_run, mx), alpha = __expf(m_run - m_new);
                float ls = 0.f;
#pragma unroll
                for (int i = 0; i < 16; ++i) { st[i] = __expf(st[i] - m_new); ls += st[i]; }
                l_run = l_run * alpha + ls; m_run = m_new;
#pragma unroll
                for (int i = 0; i < 16; ++i) { o0[i] *= alpha; o1[i] *= alpha; }
#pragma unroll
                for (int s2 = 0; s2 < 2; ++s2) {
                    v4u pw; pw.x = pg8::cvt_pk_bf16(st[8 * s2 + 0], st[8 * s2 + 1]); pw.y = pg8::cvt_pk_bf16(st[8 * s2 + 2], st[8 * s2 + 3]); pw.z = pg8::cvt_pk_bf16(st[8 * s2 + 4], st[8 * s2 + 5]); pw.w = pg8::cvt_pk_bf16(st[8 * s2 + 6], st[8 * s2 + 7]);
                    const bf16x8 pf = __builtin_bit_cast(bf16x8, pw);
                    o0 = __builtin_amdgcn_mfma_f32_32x32x16_bf16(va[s2], pf, o0, 0, 0, 0);
                    o1 = __builtin_amdgcn_mfma_f32_32x32x16_bf16(vb[s2], pf, o1, 0, 0, 0);
                }
            }
#undef AT_LOAD
            const float inv = 1.0f / (l_run + __shfl_xor(l_run, 32));
            bf16* yo = YA + tokq * AW + h * 64 + 4 * hh;
#pragma unroll
            for (int g4 = 0; g4 < 4; ++g4) {
                *(GAS v2u*)(yo + 8 * g4) = (v2u){pg8::cvt_pk_bf16(o0[4 * g4] * inv, o0[4 * g4 + 1] * inv), pg8::cvt_pk_bf16(o0[4 * g4 + 2] * inv, o0[4 * g4 + 3] * inv)};
                *(GAS v2u*)(yo + 32 + 8 * g4) = (v2u){pg8::cvt_pk_bf16(o1[4 * g4] * inv, o1[4 * g4 + 1] * inv), pg8::cvt_pk_bf16(o1[4 * g4 + 2] * inv, o1[4 * g4 + 3] * inv)};
            }
        }
    }
}

__device__ __forceinline__ void p6_merged(Frame& F0, const In& I) {
    PHASE_FRAME(F0);
    pg8::SchedTwo S; S.t.init(T / 256, D / 256, F.G, (int)blockIdx.x);
    S.A0 = (unsigned)(WS_YA); S.A1 = (unsigned)(WS_YB); S.B0 = (unsigned)(WS_PAT); S.B1 = (unsigned)(WS_PBT);
    S.tsA = (unsigned)256 * AW * 2; S.tsB = (unsigned)256 * AW * 2;
    pg8::EpiMerged E{(const bf16*)(F.ws + WS_PROJ), (bf16*)(F.ws + WS_MERGED)};
    pg8::gemm_phase<pg8::EpiMerged, pg8::SchedTwo, true>(F.lds + RING_OFF, F.rsrc, AW, AW, AW, S, E);
}
__device__ __forceinline__ void p7_mix(Frame& F0, const In& I) {
    PHASE_FRAME(F0);
    pg8::SchedPlain S; S.t.init(T / 256, D / 256, F.G, (int)blockIdx.x);
    S.A = (unsigned)(WS_MERGED); S.B = (unsigned)(WS_WOT); S.tsA = (unsigned)256 * D * 2; S.tsB = (unsigned)256 * D * 2;
    pg8::EpiZ E{I.x, (float*)(F.ws + WS_Z)};
    pg8::gemm_phase<pg8::EpiZ, pg8::SchedPlain, true>(F.lds + RING_OFF, F.rsrc, D, D, D, S, E);
}

__device__ __forceinline__ void p3_lora(Frame& F0, const In& I) {
    PHASE_FRAME(F0);
    { pg8::SchedPlain S; S.t.init(T / 256, 4, F.G, (int)blockIdx.x);
      S.A = (unsigned)(WS_LORAIN); S.B = (unsigned)(WS_WLA); S.tsA = (unsigned)256 * LORA_LD * 2; S.tsB = (unsigned)256 * 256 * 2;
      pg8::EpiLoraA<true> E{(float*)(F.ws + WS_DECAY), I.w0};
      pg8::gemm_phase<pg8::EpiLoraA<true>, pg8::SchedPlain, true>(F.lds + RING_OFF, F.rsrc, LORA_LD, 256, 256, S, E); }
    { pg8::SchedPlain S; S.t.init(T / 256, 4, F.G, (int)blockIdx.x);
      S.A = (unsigned)(WS_LORAIN); S.B = (unsigned)(WS_WLA + (size_t)1024 * 256 * 2); S.tsA = (unsigned)256 * LORA_LD * 2; S.tsB = (unsigned)256 * 256 * 2;
      pg8::EpiLoraA<false> E{(float*)(F.ws + WS_ICLR), I.a0};
      pg8::gemm_phase<pg8::EpiLoraA<false>, pg8::SchedPlain, true>(F.lds + RING_OFF, F.rsrc, LORA_LD, 256, 256, S, E); }
    { pg8::SchedPlain S; S.t.init(T / 256, 4, F.G, (int)blockIdx.x);
      S.A = (unsigned)(WS_LORAIN + 512); S.B = (unsigned)(WS_WLG); S.tsA = (unsigned)256 * LORA_LD * 2; S.tsB = (unsigned)256 * 256 * 2;
      pg8::EpiBf16 E{(bf16*)(F.ws + WS_G), RW};
      pg8::gemm_phase<pg8::EpiBf16, pg8::SchedPlain, true>(F.lds + RING_OFF, F.rsrc, LORA_LD, 256, 256, S, E); }
}

constexpr int CP = 144;
constexpr int CMAT = 64 * CP;
constexpr int C_RT = 0 * CMAT, C_ATT = 1 * CMAT, C_KHT = 2 * CMAT, C_VT = 3 * CMAT, C_AAK = 4 * CMAT, C_ARKT = 5 * CMAT, C_WA = 6 * CMAT, C_WB = 8 * CMAT,
              C_MA = 10 * CMAT, C_MTA = 11 * CMAT, C_MB = 12 * CMAT, C_MTB = 13 * CMAT, C_SEG = 14 * CMAT, C_GAM = C_SEG + 8 * 64 * 4;
constexpr int C_AT = C_WB, C_BT = C_WB + CMAT, C_KT = C_MB, C_QYT = C_MA, C_QST = C_MTA;
constexpr int CHK_UNIT_BYTES = 4 * 64 * 64 * 2;
#define CBAR() do { asm volatile("s_waitcnt lgkmcnt(0)" ::: "memory"); __builtin_amdgcn_s_barrier(); asm volatile("" ::: "memory"); } while (0)
template <int NT, class Epi>
__device__ __forceinline__ void cmm(const LAS unsigned char* X, const LAS unsigned char* Y, int mt0, int nt, int lane, const Epi& E) {
    const int lr = lane & 15, kq = lane >> 4;
    const bf16x8 b0 = *(const LAS bf16x8*)(Y + (nt * 16 + lr) * CP + kq * 16), b1 = *(const LAS bf16x8*)(Y + (nt * 16 + lr) * CP + kq * 16 + 64);
#pragma unroll
    for (int i = 0; i < NT; ++i) { const int mt = mt0 + i;
        const bf16x8 a0 = *(const LAS bf16x8*)(X + (mt * 16 + lr) * CP + kq * 16), a1 = *(const LAS bf16x8*)(X + (mt * 16 + lr) * CP + kq * 16 + 64);
        f32x4 acc = (f32x4){0.f, 0.f, 0.f, 0.f};
        acc = __builtin_amdgcn_mfma_f32_16x16x32_bf16(a0, b0, acc, 0, 0, 0);
        acc = __builtin_amdgcn_mfma_f32_16x16x32_bf16(a1, b1, acc, 0, 0, 0);
        E(mt, nt, acc); }
}
__device__ __forceinline__ v2u pack4(const f32x4& v) { return (v2u){pg8::cvt_pk_bf16(v[0], v[1]), pg8::cvt_pk_bf16(v[2], v[3])}; }
__device__ __forceinline__ f32x4 unpack4(const v2u w) { return (f32x4){bflo(w.x), bfhi(w.x), bflo(w.y), bfhi(w.y)}; }
__device__ __forceinline__ void p4a_chunk(Frame& F0, const In& I) {
    PHASE_FRAME(F0);
    LAS unsigned char* L = F.lds;
    const int lane = F.lane, w = F.wave, lr = lane & 15, kq = lane >> 4;
    const bf16* RKV = (const bf16*)(F.ws + WS_RKV); const float* LW = (const float*)(F.ws + WS_DECAY); const float* ICL = (const float*)(F.ws + WS_ICLR);
    unsigned char* CHK = F.ws + WS_CHK;
    for (int unit = F.vcu; unit < BATCH * RH * (SEQ / 64); unit += F.G) {
        const int bh = unit >> 7, ck = unit & 127, b = bh >> 4, h = bh & 15;
        const size_t tok0 = (size_t)b * SEQ + (size_t)ck * 64 + 8 * w;
        const int hc = h * 64 + lane;
        float lwv[8], ic[8], rr[8], kk[8], vv[8];
#pragma unroll
        for (int i = 0; i < 8; ++i) { const size_t tok = tok0 + i; lwv[i] = LW[tok * RW + hc]; ic[i] = ICL[tok * RW + hc];
            rr[i] = bf2f(RKV[tok * (3 * RW) + hc]); kk[i] = bf2f(RKV[tok * (3 * RW) + RW + hc]); vv[i] = bf2f(RKV[tok * (3 * RW) + 2 * RW + hc]); }
        const float kkp = I.k_k[hc], kap = I.k_a[hc];
        float cs[8]; { float run = 0.f;
#pragma unroll
            for (int i = 0; i < 8; ++i) { run += lwv[i]; cs[i] = run; } }
        __syncthreads();
        ((LAS float*)(L + C_SEG))[w * 64 + lane] = cs[7];
        CBAR();
        float pre = 0.f, tot = 0.f;
#pragma unroll
        for (int j = 0; j < 8; ++j) { const float sg = ((const LAS float*)(L + C_SEG))[j * 64 + lane]; tot += sg; pre += (j < w) ? sg : 0.f; }
        if (w == 0) ((LAS float*)(L + C_GAM))[lane] = __expf(tot);
        unsigned att[4], bht[4], kht[4], vtt[4];
        float at_[8], bh_[8], kh_[8];
#pragma unroll
        for (int i = 0; i < 8; ++i) { const int t = 8 * w + i; const float cum = pre + cs[i], cump = cum - lwv[i];
            const float kkv = kk[i] * kkp; const float n2 = wave_sum(kkv * kkv); const float kkn = kkv * __builtin_amdgcn_rsqf(fmaxf(n2, 1e-24f));
            const float a = -kkn, bb = kkn * ic[i], kp = kk[i] * (1.0f + (ic[i] - 1.0f) * kap);
            const float ep = __expf(cum), em = __expf(-cum), epp = __expf(cump), eL = __expf(tot - cum);
            const float Rv = rr[i] * ep, Av = a * epp, Bv = bb * em, Kv = kp * em;
            at_[i] = Av; bh_[i] = bb * eL; kh_[i] = kp * eL;
            *(LAS unsigned short*)(L + C_RT + t * CP + lane * 2) = (unsigned short)f2bf(Rv);
            *(LAS unsigned short*)(L + C_AT + t * CP + lane * 2) = (unsigned short)f2bf(Av);
            *(LAS unsigned short*)(L + C_BT + t * CP + lane * 2) = (unsigned short)f2bf(Bv);
            *(LAS unsigned short*)(L + C_KT + t * CP + lane * 2) = (unsigned short)f2bf(Kv); }
#pragma unroll
        for (int q = 0; q < 4; ++q) { att[q] = pk2(at_[2 * q], at_[2 * q + 1]); bht[q] = pk2(bh_[2 * q], bh_[2 * q + 1]); kht[q] = pk2(kh_[2 * q], kh_[2 * q + 1]); vtt[q] = pk2(vv[2 * q], vv[2 * q + 1]); }
        *(LAS v4u*)(L + C_ATT + lane * CP + 16 * w) = (v4u){att[0], att[1], att[2], att[3]};
        *(LAS v4u*)(L + C_WA + (64 + lane) * CP + 16 * w) = (v4u){bht[0], bht[1], bht[2], bht[3]};
        *(LAS v4u*)(L + C_KHT + lane * CP + 16 * w) = (v4u){kht[0], kht[1], kht[2], kht[3]};
        *(LAS v4u*)(L + C_VT + lane * CP + 16 * w) = (v4u){vtt[0], vtt[1], vtt[2], vtt[3]};
        CBAR();
        { const int nt = w & 3, mt0 = 2 * (w >> 2);
          cmm<2>(L + C_BT, L + C_AT, mt0, nt, lane, [&](int mt, int nt_, f32x4 acc) { const int n = nt_ * 16 + lr, m0 = mt * 16 + 4 * kq;
#pragma unroll
              for (int i = 0; i < 4; ++i) { acc[i] = (m0 + i < n) ? acc[i] : 0.f; *(LAS unsigned short*)(L + C_MA + (m0 + i) * CP + n * 2) = (unsigned short)f2bf(acc[i]); }
              *(LAS v2u*)(L + C_MTA + n * CP + m0 * 2) = pack4(acc); });
          cmm<2>(L + C_AT, L + C_KT, mt0, nt, lane, [&](int mt, int nt_, f32x4 acc) { const int n = nt_ * 16 + lr, m0 = mt * 16 + 4 * kq;
#pragma unroll
              for (int i = 0; i < 4; ++i) acc[i] = (n < m0 + i) ? acc[i] : 0.f;
              *(LAS v2u*)(L + C_AAK + n * CP + m0 * 2) = pack4(acc); });
          cmm<2>(L + C_BT, L + C_RT, mt0, nt, lane, [&](int mt, int nt_, f32x4 acc) { const int n = nt_ * 16 + lr, m0 = mt * 16 + 4 * kq;
#pragma unroll
              for (int i = 0; i < 4; ++i) acc[i] = (m0 + i <= n) ? acc[i] : 0.f;
              *(LAS v2u*)(L + C_WA + n * CP + m0 * 2) = pack4(acc); });
          cmm<2>(L + C_KT, L + C_RT, mt0, nt, lane, [&](int mt, int nt_, f32x4 acc) { const int n = nt_ * 16 + lr, m0 = mt * 16 + 4 * kq;
#pragma unroll
              for (int i = 0; i < 4; ++i) acc[i] = (m0 + i <= n) ? acc[i] : 0.f;
              *(LAS v2u*)(L + C_ARKT + n * CP + m0 * 2) = pack4(acc); }); }
        CBAR();
#pragma unroll
        for (int lvl = 0; lvl < 6; ++lvl) {
            const int Wsrc = (lvl & 1) ? C_WB : C_WA, Wdst = (lvl & 1) ? C_WA : C_WB, Ms = (lvl & 1) ? C_MB : C_MA, Mts = (lvl & 1) ? C_MTB : C_MTA, Md = (lvl & 1) ? C_MA : C_MB, Mtd = (lvl & 1) ? C_MTA : C_MTB;
            cmm<4>(L + Ms, L + Wsrc, 0, w, lane, [&](int mt, int nt_, f32x4 acc) { const int n = nt_ * 16 + lr, m0 = mt * 16 + 4 * kq;
                const f32x4 old = unpack4(*(const LAS v2u*)(L + Wsrc + n * CP + m0 * 2));
                *(LAS v2u*)(L + Wdst + n * CP + m0 * 2) = pack4(old + acc); });
            if (lvl < 5) {
                cmm<2>(L + Ms, L + Mts, 2 * (w >> 2), w & 3, lane, [&](int mt, int nt_, f32x4 acc) { const int n = nt_ * 16 + lr, m0 = mt * 16 + 4 * kq;
#pragma unroll
                    for (int i = 0; i < 4; ++i) *(LAS unsigned short*)(L + Md + (m0 + i) * CP + n * 2) = (unsigned short)f2bf(acc[i]);
                    *(LAS v2u*)(L + Mtd + n * CP + m0 * 2) = pack4(acc); });
            }
            CBAR();
        }
        unsigned char* og = CHK + (size_t)unit * CHK_UNIT_BYTES;
        { const int nt = w & 3, mt0 = 2 * (w >> 2);
          cmm<2>(L + C_ATT, L + C_WA, mt0, nt, lane, [&](int mt, int nt_, f32x4 acc) { const int n = nt_ * 16 + lr, m0 = mt * 16 + 4 * kq;
              const f32x4 rv = unpack4(*(const LAS v2u*)(L + C_RT + n * CP + m0 * 2));
              *(GAS v2u*)(og + 0 * 8192 + n * 128 + m0 * 2) = pack4(acc + rv); });
          cmm<2>(L + C_AAK, L + C_WA, mt0, nt, lane, [&](int mt, int nt_, f32x4 acc) { const int n = nt_ * 16 + lr, m0 = mt * 16 + 4 * kq;
              const f32x4 av = unpack4(*(const LAS v2u*)(L + C_ARKT + n * CP + m0 * 2));
              *(LAS v2u*)(L + C_QYT + n * CP + m0 * 2) = pack4(acc + av); });
          cmm<2>(L + C_ATT, L + C_WA + 64 * CP, mt0, nt, lane, [&](int mt, int nt_, f32x4 acc) { const int n = nt_ * 16 + lr, m0 = mt * 16 + 4 * kq;
              const float gm = ((const LAS float*)(L + C_GAM))[n];
#pragma unroll
              for (int i = 0; i < 4; ++i) acc[i] += (m0 + i == n) ? gm : 0.f;
              *(GAS v2u*)(og + 1 * 8192 + n * 128 + m0 * 2) = pack4(acc); });
          cmm<2>(L + C_AAK, L + C_WA + 64 * CP, mt0, nt, lane, [&](int mt, int nt_, f32x4 acc) { const int n = nt_ * 16 + lr, m0 = mt * 16 + 4 * kq;
              const f32x4 kv = unpack4(*(const LAS v2u*)(L + C_KHT + n * CP + m0 * 2));
              *(LAS v2u*)(L + C_QST + n * CP + m0 * 2) = pack4(acc + kv); }); }
        CBAR();
        { const int nt = w & 3, mt0 = 2 * (w >> 2);
          cmm<2>(L + C_VT, L + C_QYT, mt0, nt, lane, [&](int mt, int nt_, f32x4 acc) { const int n = nt_ * 16 + lr, m0 = mt * 16 + 4 * kq;
              *(GAS v2u*)(og + 2 * 8192 + n * 128 + m0 * 2) = pack4(acc); });
          cmm<2>(L + C_VT, L + C_QST, mt0, nt, lane, [&](int mt, int nt_, f32x4 acc) { const int n = nt_ * 16 + lr, m0 = mt * 16 + 4 * kq;
              *(GAS v2u*)(og + 3 * 8192 + n * 128 + m0 * 2) = pack4(acc); }); }
    }
}

__device__ __forceinline__ void p4b_scan(Frame& F0, const In& I) {
    PHASE_FRAME(F0);
    const int lane = F.lane, lr = lane & 15, kq = lane >> 4;
    const unsigned char* CHK = F.ws + WS_CHK; float* YS = (float*)(F.ws + WS_YSCAN);
    for (int unit = F.vcu; unit < BATCH * RH * 4; unit += F.G) {
        const int bh = unit >> 2, rq = unit & 3, b = bh >> 4, h = bh & 15;
        if (F.wave == 0) {
            LAS unsigned char* Sl = F.lds;
            f32x4 S[4]; bf16x8 sf[2];
#pragma unroll
            for (int nt = 0; nt < 4; ++nt) S[nt] = (f32x4){0.f, 0.f, 0.f, 0.f};
#pragma unroll
            for (int ks = 0; ks < 2; ++ks)
#pragma unroll
                for (int j = 0; j < 8; ++j) sf[ks][j] = 0;
            bf16x8 py[4][2], ps[4][2]; v2u yl[4], sl[4];
#define C2_LOAD(ck_) do { const unsigned char* ug = CHK + ((size_t)bh * 128 + (ck_)) * CHK_UNIT_BYTES; \
                _Pragma("unroll") for (int nt = 0; nt < 4; ++nt) { _Pragma("unroll") for (int ks = 0; ks < 2; ++ks) { \
                    py[nt][ks] = *(const GAS bf16x8*)(ug + 0 * 8192 + (16 * nt + lr) * 128 + kq * 16 + ks * 64); ps[nt][ks] = *(const GAS bf16x8*)(ug + 1 * 8192 + (16 * nt + lr) * 128 + kq * 16 + ks * 64); } \
                    yl[nt] = *(const GAS v2u*)(ug + 2 * 8192 + (16 * nt + lr) * 128 + (rq * 16 + 4 * kq) * 2); sl[nt] = *(const GAS v2u*)(ug + 3 * 8192 + (16 * nt + lr) * 128 + (rq * 16 + 4 * kq) * 2); } } while (0)
            C2_LOAD(0);
#pragma unroll 1
            for (int ck = 0; ck < SEQ / 64; ++ck) {
                bf16x8 cpy[4][2], cps[4][2]; f32x4 cyl[4], csl[4];
#pragma unroll
                for (int nt = 0; nt < 4; ++nt) { cpy[nt][0] = py[nt][0]; cpy[nt][1] = py[nt][1]; cps[nt][0] = ps[nt][0]; cps[nt][1] = ps[nt][1]; cyl[nt] = unpack4(yl[nt]); csl[nt] = unpack4(sl[nt]); }
                if (ck + 1 < SEQ / 64) C2_LOAD(ck + 1);
#pragma unroll
                for (int nt = 0; nt < 4; ++nt) {
                    f32x4 y = cyl[nt];
                    y = __builtin_amdgcn_mfma_f32_16x16x32_bf16(sf[0], cpy[nt][0], y, 0, 0, 0); y = __builtin_amdgcn_mfma_f32_16x16x32_bf16(sf[1], cpy[nt][1], y, 0, 0, 0);
                    *(GAS f32x4*)(YS + ((size_t)b * SEQ + (size_t)ck * 64 + 16 * nt + lr) * RW + h * 64 + rq * 16 + 4 * kq) = y;
                    f32x4 s2 = csl[nt];
                    s2 = __builtin_amdgcn_mfma_f32_16x16x32_bf16(sf[0], cps[nt][0], s2, 0, 0, 0); s2 = __builtin_amdgcn_mfma_f32_16x16x32_bf16(sf[1], cps[nt][1], s2, 0, 0, 0);
                    S[nt] = s2; }
#pragma unroll
                for (int nt = 0; nt < 4; ++nt)
#pragma unroll
                    for (int i = 0; i < 4; ++i) *(LAS unsigned short*)(Sl + (4 * kq + i) * CP + (16 * nt + lr) * 2) = (unsigned short)f2bf(S[nt][i]);
                LDS_WAIT(); asm volatile("" ::: "memory");
                sf[0] = *(const LAS bf16x8*)(Sl + lr * CP + kq * 16); sf[1] = *(const LAS bf16x8*)(Sl + lr * CP + kq * 16 + 64);
                LDS_WAIT(); asm volatile("" ::: "memory");
            }
#undef C2_LOAD
        } else {
            LAS float* tscr = (LAS float*)(F.lds + 4096 + (F.wave - 1) * 16640);
            f32x4 tv[16]; MoeItem mi = moe_item(unit * 7 + (F.wave - 1), I.w_gu, I.w_down, F.ws);
            tr8_load(mi.W, mi.ldw, mi.k0, mi.c0, tv, lane);
#pragma unroll 1
            for (int it = unit * 7 + (F.wave - 1); it < MOE_NITEMS; it += 256 * 7) {
                const MoeItem cur = mi; f32x4 cv[16];
#pragma unroll
                for (int i = 0; i < 16; ++i) cv[i] = tv[i];
                if (it + 256 * 7 < MOE_NITEMS) { mi = moe_item(it + 256 * 7, I.w_gu, I.w_down, F.ws); tr8_load(mi.W, mi.ldw, mi.k0, mi.c0, tv, lane); }
                tr8_finish(cv, cur.k0, cur.WT, cur.ldt, cur.drow, tscr, lane, 64.0f);
            }
        }
    }
}

__device__ __forceinline__ void p5_post(Frame& F0, const In& I) {
    PHASE_FRAME(F0);
    const int lane = F.lane; const int gw = F.vcu * NWAVES + F.wave, NGW = F.G * NWAVES;
    const bf16* RKV = (const bf16*)(F.ws + WS_RKV); const float* ICL = (const float*)(F.ws + WS_ICLR); const float* YS = (const float*)(F.ws + WS_YSCAN);
    const bf16* G = (const bf16*)(F.ws + WS_G); bf16* YB = (bf16*)(F.ws + WS_YB);
    const int c0 = lane * 16;
    for (int tok = gw; tok < T; tok += NGW) {
        float y[16], rr[16], kk[16], vv[16], ic[16], gg[16];
#pragma unroll
        for (int q = 0; q < 4; ++q) { const f32x4 a = *(const GAS f32x4*)(YS + (size_t)tok * RW + c0 + 4 * q), c = *(const GAS f32x4*)(ICL + (size_t)tok * RW + c0 + 4 * q);
#pragma unroll
            for (int e = 0; e < 4; ++e) { y[4 * q + e] = a[e]; ic[4 * q + e] = c[e]; } }
#pragma unroll
        for (int q = 0; q < 2; ++q) {
            const v4u a = *(const GAS v4u*)(RKV + (size_t)tok * (3 * RW) + c0 + 8 * q), bb = *(const GAS v4u*)(RKV + (size_t)tok * (3 * RW) + RW + c0 + 8 * q),
                      c = *(const GAS v4u*)(RKV + (size_t)tok * (3 * RW) + 2 * RW + c0 + 8 * q), d = *(const GAS v4u*)(G + (size_t)tok * RW + c0 + 8 * q);
            const unsigned aw[4] = {a.x, a.y, a.z, a.w}, bw[4] = {bb.x, bb.y, bb.z, bb.w}, cw[4] = {c.x, c.y, c.z, c.w}, dw[4] = {d.x, d.y, d.z, d.w};
#pragma unroll
            for (int e = 0; e < 4; ++e) { rr[8 * q + 2 * e] = bflo(aw[e]); rr[8 * q + 2 * e + 1] = bfhi(aw[e]); kk[8 * q + 2 * e] = bflo(bw[e]); kk[8 * q + 2 * e + 1] = bfhi(bw[e]);
                vv[8 * q + 2 * e] = bflo(cw[e]); vv[8 * q + 2 * e + 1] = bfhi(cw[e]); gg[8 * q + 2 * e] = bflo(dw[e]); gg[8 * q + 2 * e + 1] = bfhi(dw[e]); } }
        float s = 0.f, bs = 0.f;
#pragma unroll
        for (int e = 0; e < 16; ++e) { s += y[e]; const float kp = kk[e] * (1.0f + (ic[e] - 1.0f) * I.k_a[c0 + e]); bs += rr[e] * kp * I.r_k[c0 + e]; }
        s = quadsum(s); bs = quadsum(bs);
        const float mean = s * (1.f / 64.f); float s2 = 0.f;
#pragma unroll
        for (int e = 0; e < 16; ++e) { y[e] -= mean; s2 += y[e] * y[e]; }
        s2 = quadsum(s2);
        const float rstd = 1.f / sqrtf(s2 * (1.f / 64.f) + GN_EPS);
        float o[16];
#pragma unroll
        for (int e = 0; e < 16; ++e) o[e] = (y[e] * rstd * I.lnx_w[c0 + e] + I.lnx_b[c0 + e] + bs * vv[e]) * gg[e];
#pragma unroll
        for (int q = 0; q < 2; ++q) *(GAS v4u*)(YB + (size_t)tok * RW + c0 + 8 * q) = (v4u){pk2(o[8 * q], o[8 * q + 1]), pk2(o[8 * q + 2], o[8 * q + 3]), pk2(o[8 * q + 4], o[8 * q + 5]), pk2(o[8 * q + 6], o[8 * q + 7])};
    }
}
#ifndef STAGE
#define STAGE 4
#endif
struct Args { In in; float* out; unsigned char* ws; };
__global__ void __launch_bounds__(NWAVES * 64, 2) mk_fwd(Args args) {
    extern __shared__ __attribute__((aligned(16))) unsigned char lds[];
    Frame F;
    F.lds = (LAS unsigned char*)lds;
    F.MISC = (volatile LAS unsigned*)(F.lds + MISC_OFF);
    F.tid = threadIdx.x; F.lane = F.tid & 63; F.wave = __builtin_amdgcn_readfirstlane(F.tid >> 6);
    F.G = gridDim.x; { const int bx = blockIdx.x; F.vcu = (F.G % 8 == 0) ? (bx % 8) * (F.G / 8) + bx / 8 : bx; }
    F.ws = args.ws;
    F.rsrc = __builtin_amdgcn_make_buffer_rsrc(args.ws, 0, 0xffffffff, 0x00020000);
    F.ctl = (gu32*)(args.ws + WS_CTL);
    for (int u = F.tid; u < (LDS_BYTES - MISC_OFF) / 4; u += NWAVES * 64) ((LAS unsigned*)(F.lds + MISC_OFF))[u] = 0u;
    __syncthreads();
    XcdBarrier bar = xcd_barrier_post((unsigned*)(F.ctl + CW_BAR), F.MISC + 8);
    const In& I = args.in;
#define GRID_BAR() xcd_barrier(bar)
#ifndef DUP_PHASE
#define DUP_PHASE -1
#endif
#define RUN(n, call) do { call; if (DUP_PHASE == (n)) { GRID_BAR(); call; } } while (0)

#if STAGE >= 2
    RUN(0, p0_prologue(F, I));
    GRID_BAR();
#endif
#if STAGE >= 3
    RUN(1, p1_proj(F, I));
    GRID_BAR();
    RUN(2, p2_shift_attn(F, I));
    GRID_BAR();
#if STAGE >= 4
    RUN(3, p3_lora(F, I));
    GRID_BAR();
    RUN(4, p4a_chunk(F, I));
    GRID_BAR();
    RUN(44, p4b_scan(F, I));
    GRID_BAR();
    RUN(5, p5_post(F, I));
    GRID_BAR();
#endif
    RUN(6, p6_merged(F, I));
    GRID_BAR();
    RUN(7, p7_mix(F, I));
    GRID_BAR();
#endif
    p8_ln_router<(STAGE < 3)>(F, I);
    GRID_BAR();
#if STAGE >= 2
    p9_scatter(F, I);
    GRID_BAR();
    RUN(10, p10_moe_up(F, I));
    GRID_BAR();
    RUN(11, p11_moe_down(F, I));
    GRID_BAR();
#endif
    RUN(12, p12_final<(STAGE < 2)>(F, I, args.out));
}

extern "C" void kernel_launch(void* const* d_in, const int* in_sizes, int n_in, void* d_out, int out_size, void* d_ws, size_t ws_size, hipStream_t stream) {
    static int grid = 0;
    if (grid == 0) {
        if (n_in != 27 || in_sizes[0] != T * D || out_size != T * D || ws_size < WS_END) { fprintf(stderr, "kernel_launch: unexpected shapes (n_in %d, in0 %d, out %d, ws %zu)\n", n_in, n_in > 0 ? in_sizes[0] : -1, out_size, ws_size); grid = -1; return; }
        int dev = 0, cus = 0, per_cu = 0;
        if (hipGetDevice(&dev) != hipSuccess || hipDeviceGetAttribute(&cus, hipDeviceAttributeMultiprocessorCount, dev) != hipSuccess) { grid = -1; return; }
        if (hipFuncSetAttribute((const void*)mk_fwd, hipFuncAttributeMaxDynamicSharedMemorySize, LDS_BYTES) != hipSuccess) { fprintf(stderr, "kernel_launch: hipFuncSetAttribute failed\n"); grid = -1; return; }
        if (hipOccupancyMaxActiveBlocksPerMultiprocessor(&per_cu, (const void*)mk_fwd, NWAVES * 64, LDS_BYTES) != hipSuccess || per_cu < 1)
            fprintf(stderr, "kernel_launch: occupancy query reports %d\n", per_cu);
        (void)hipGetLastError();
        grid = cus;
    }
    if (grid < 0) return;
    if (hipMemsetAsync((char*)d_ws + WS_CTL, 0, CTL_ZERO_BYTES, stream) != hipSuccess) return;
    Args a{};
    const float** ip = (const float**)&a.in;
    for (int i = 0; i < 27; ++i) ip[i] = (const float*)d_in[i];
    a.out = (float*)d_out; a.ws = (unsigned char*)d_ws;
    hipLaunchKernelGGL(mk_fwd, dim3(grid), dim3(NWAVES * 64), LDS_BYTES, stream, a);
    const hipError_t le = hipPeekAtLastError();
    if (le != hipSuccess) fprintf(stderr, "kernel_launch: launch failed: %s\n", hipGetErrorName(le));
}
```

```cpp
#define STAGE 4
#include <hip/hip_runtime.h>
#include <cstdio>
#include <cstdint>

#define GAS __attribute__((address_space(1)))
#define LAS __attribute__((address_space(3)))
typedef unsigned short bf16;
typedef unsigned v4u __attribute__((ext_vector_type(4)));
typedef unsigned v2u __attribute__((ext_vector_type(2)));
typedef float f32x4 __attribute__((ext_vector_type(4)));
typedef float f32x2 __attribute__((ext_vector_type(2)));
typedef float f32x16 __attribute__((ext_vector_type(16)));
typedef short bf16x8 __attribute__((ext_vector_type(8)));
typedef short bf16x4 __attribute__((ext_vector_type(4)));
typedef GAS unsigned gu32;

constexpr int NWAVES = 8;
constexpr int BATCH = 4, SEQ = 8192, D = 2048, T = BATCH * SEQ;
constexpr int CHUNK = 64, LEFT = 8, AH = 16, AD = 64, AW = 1024;
constexpr int REL_TABLE = 320, MAX_PAST = 256;
constexpr int RH = 16, RN = 64, RW = 1024, DLORA = 96, ALORA = 96, GLORA = 256;
constexpr int SHIFT_W = 3 * RW + DLORA + ALORA + GLORA;
constexpr int D_IN = 3 * AW + SHIFT_W + 2 * D;
constexpr int NE = 32, TOPK = 4, FF = 2048;
constexpr int MSLOT = T * TOPK;
constexpr int NBLK_MAX = (MSLOT + NE * 255 + 255) / 256;
constexpr int RROWS = NBLK_MAX * 256;
constexpr float LN_EPS = 1e-5f, GN_EPS = 64e-5f;
constexpr float YS_SCALE = 16.0f, YS_INV = 1.0f / 16.0f;
constexpr float ACT8_SCALE = 16.0f;
constexpr float F8_CVT_SCALE = 0.015625f;
constexpr float DN_ALPHA = 1.189207115002721f;
constexpr int PROJ_LD = 9728, PJ_Q = 0, PJ_K = 1024, PJ_SEG = 2048, SEG_PAD = 3584, PJ_GA = 5632, PJ_GB = 7680;
constexpr int LORA_LD = 512;

constexpr size_t MiB = 1u << 20;
constexpr size_t WS_CTL = 0, CTL_ZERO_BYTES = 1 * MiB;
constexpr size_t WS_TOPI = 2 * MiB;
constexpr size_t WS_GATE = 3 * MiB;
constexpr size_t WS_ROWSLOT = 4 * MiB;
constexpr size_t WS_ROWW = 5 * MiB;
constexpr size_t WS_WLA = 6 * MiB;
constexpr size_t WS_WLG = 7 * MiB;
constexpr size_t WS_PAT = 8 * MiB;
constexpr size_t WS_PBT = 12 * MiB;
constexpr size_t WS_WOT = 16 * MiB;
constexpr size_t WS_WVT = 24 * MiB;
constexpr size_t WS_WINT = 28 * MiB;
constexpr size_t WS_WG8 = 72 * MiB;
constexpr size_t WS_WQK8 = 80 * MiB;
constexpr size_t WS_WV8 = 84 * MiB;
constexpr size_t WS_WGUT = 128 * MiB;
constexpr size_t WS_WDNT = 640 * MiB;
constexpr size_t WS_BASE0 = 1024 * MiB;
constexpr size_t WS_PROJ = WS_BASE0;
constexpr size_t WS_VT = WS_PROJ + 608 * MiB;
constexpr size_t WS_YA = WS_VT + 64 * MiB;
constexpr size_t WS_RKV = WS_YA + 64 * MiB;
constexpr size_t WS_LORAIN = WS_RKV + 192 * MiB;
constexpr size_t WS_DECAY = WS_LORAIN + 32 * MiB;
constexpr size_t WS_ICLR = WS_DECAY + 128 * MiB;
constexpr size_t WS_G = WS_ICLR + 128 * MiB;
constexpr size_t WS_YSCAN = WS_G + 64 * MiB;
constexpr size_t WS_YB = WS_YSCAN + 128 * MiB;
constexpr size_t WS_MERGED = WS_YB + 64 * MiB;
constexpr size_t WS_XB16 = WS_MERGED + 128 * MiB;
constexpr size_t WS_MIX_END = WS_XB16 + 128 * MiB;
constexpr size_t WS_Z = 2816 * MiB;
constexpr size_t WS_H1 = 3072 * MiB;
constexpr size_t WS_H1B = 3328 * MiB;
constexpr size_t WS_CHK = 3456 * MiB;
constexpr size_t WS_XB8 = 3712 * MiB;
constexpr size_t WS_END = 3776 * MiB;
constexpr size_t WS_XG = WS_BASE0;
constexpr size_t WS_ACT = WS_BASE0 + 544 * MiB;
constexpr size_t WS_YSLOT = WS_BASE0 + 1088 * MiB;
static_assert(WS_MIX_END <= WS_Z && WS_YSLOT + 512 * MiB <= WS_Z, "ws map");
static_assert(WS_WINT + (size_t)PROJ_LD * D * 2 <= WS_WGUT, "ws map");

constexpr int CW_CNT = 512;
constexpr int CW_CUR = 576;
constexpr int CW_BAR = 4096;

constexpr int RING_OFF = 0, RING_BYTES = 131072;
constexpr int LDS_BYTES = 160 * 1024;
constexpr int MISC_OFF = LDS_BYTES - 512;
constexpr int TAB_OFF = LDS_BYTES - 1024;

#define RLX_AGENT __ATOMIC_RELAXED, __HIP_MEMORY_SCOPE_AGENT
#define LDS_WAIT() asm volatile("s_waitcnt lgkmcnt(0)" ::: "memory")
#define VM_WAIT() asm volatile("s_waitcnt vmcnt(0)" ::: "memory")
__device__ __forceinline__ unsigned f2bf(float f) { unsigned u = __builtin_bit_cast(unsigned, f); return (u + 0x7fffu + ((u >> 16) & 1u)) >> 16; }
__device__ __forceinline__ unsigned pk2(float lo, float hi) { return f2bf(lo) | (f2bf(hi) << 16); }
__device__ __forceinline__ float bf2f(unsigned short h) { return __builtin_bit_cast(float, (unsigned)h << 16); }
__device__ __forceinline__ float bflo(unsigned w) { return __builtin_bit_cast(float, w << 16); }
__device__ __forceinline__ float bfhi(unsigned w) { return __builtin_bit_cast(float, w & 0xffff0000u); }
__device__ __forceinline__ float fsigmoid(float x) { return __builtin_amdgcn_rcpf(1.0f + __expf(-x)); }
__device__ __forceinline__ float dpp_f(float x, const int ctrl_sel) {
    const int xi = __builtin_bit_cast(int, x); int r;
    if (ctrl_sel == 0) r = __builtin_amdgcn_update_dpp(0, xi, 0xB1, 0xF, 0xF, false);
    else if (ctrl_sel == 1) r = __builtin_amdgcn_update_dpp(0, xi, 0x4E, 0xF, 0xF, false);
    else if (ctrl_sel == 2) r = __builtin_amdgcn_update_dpp(0, xi, 0x124, 0xF, 0xF, false);
    else r = __builtin_amdgcn_update_dpp(0, xi, 0x128, 0xF, 0xF, false);
    return __builtin_bit_cast(float, r);
}
__device__ __forceinline__ float rowsum16(float x) { x += dpp_f(x, 0); x += dpp_f(x, 1); x += dpp_f(x, 2); x += dpp_f(x, 3); return x; }
__device__ __forceinline__ float quadsum(float x) { x += dpp_f(x, 0); x += dpp_f(x, 1); return x; }
__device__ __forceinline__ float wave_sum(float v) {
    v = rowsum16(v);
    const int vi = __builtin_bit_cast(int, v);
    const float s0 = __builtin_bit_cast(float, __builtin_amdgcn_readlane(vi, 0)), s1 = __builtin_bit_cast(float, __builtin_amdgcn_readlane(vi, 16));
    const float s2 = __builtin_bit_cast(float, __builtin_amdgcn_readlane(vi, 32)), s3 = __builtin_bit_cast(float, __builtin_amdgcn_readlane(vi, 48));
    return (s0 + s1) + (s2 + s3);
}
namespace pg8 {
#define PG8_LAS __attribute__((address_space(3)))
typedef unsigned short bf16_t;
typedef unsigned u32x4 __attribute__((ext_vector_type(4)));
constexpr int BM = 256, BK = 64, HALF = 128, HTB = HALF * BK * 2, STAGE_BYTES = 8 * HTB, NXCD = 8, WGM = 8;

__host__ __device__ __forceinline__ int lds_byte(int r, int c) { const int st = (r >> 4) * 2 + (c >> 5), rr = r & 15, cc = c & 31, ob = rr * 64 + cc * 2; return st * 1024 + (ob ^ (((ob >> 9) & 1) << 5)); }
__host__ __device__ __forceinline__ void stage_rc(int b, int& R, int& C) { const int st = b / 1024, sb = b % 1024, swz = sb ^ (((sb >> 9) & 1) << 5); R = (st >> 1) * 16 + swz / 64; C = (st & 1) * 32 + (swz % 64) / 2; }
__host__ __device__ __forceinline__ int perm32(int rho) { const int n = rho >> 4, i = rho & 15; return 8 * (i >> 2) + 4 * n + (i & 3); }

struct Unit { int pm, pn, aux; };

struct Tiler {
    int nM, nN, nwg, G, c;
    __device__ __forceinline__ void init(int nM_, int nN_, int G_, int c_) { nM = nM_; nN = nN_; nwg = nM * nN; G = G_; c = c_; }
    __device__ __forceinline__ bool map(int i, int& pm, int& pn) const {
        const long L = (long)i * G + c; if (L >= nwg) return false;
        int wgid = (int)L; { const int q = nwg / NXCD, r = nwg % NXCD, xcd = wgid % NXCD, off = wgid / NXCD; wgid = (xcd < r ? xcd * (q + 1) : r * (q + 1) + (xcd - r) * q) + off; }
        const int nig = WGM * nN, gid = wgid / nig, fm = gid * WGM, gsz = (nM - fm) < WGM ? (nM - fm) : WGM;
        pm = fm + ((wgid % nig) % gsz); pn = (wgid % nig) / gsz; return true;
    }
};
struct SchedPlain {
    Tiler t; unsigned A, B, tsA, tsB;
    __device__ __forceinline__ bool next(int i, Unit& u) const { u.aux = 0; return t.map(i, u.pm, u.pn); }
    __device__ __forceinline__ void bases(const Unit& u, unsigned& a, unsigned& b) const { a = A + (unsigned)u.pm * tsA; b = B + (unsigned)u.pn * tsB; }
};
struct SchedTwo {
    Tiler t; unsigned A0, A1, B0, B1, tsA, tsB;
    __device__ __forceinline__ bool next(int i, Unit& u) const { u.aux = i & 1; return t.map(i >> 1, u.pm, u.pn); }
    __device__ __forceinline__ void bases(const Unit& u, unsigned& a, unsigned& b) const { a = (u.aux ? A1 : A0) + (unsigned)u.pm * tsA; b = (u.aux ? B1 : B0) + (unsigned)u.pn * tsB; }
};
struct SchedMoe {
    Tiler t; unsigned A, B, tsA, tsB, es; const PG8_LAS int* pad_end;
    __device__ __forceinline__ bool next(int i, Unit& u) const {
        if (!t.map(i, u.pm, u.pn)) return false;
        const int row0 = u.pm * BM; int e = 0;
#pragma unroll
        for (int j = 0; j < 32; ++j) e += (pad_end[j] <= row0) ? 1 : 0;
        u.aux = __builtin_amdgcn_readfirstlane(e < 31 ? e : 31); return true;
    }
    __device__ __forceinline__ void bases(const Unit& u, unsigned& a, unsigned& b) const { a = A + (unsigned)u.pm * tsA; b = B + (unsigned)u.aux * es + (unsigned)u.pn * tsB; }
};

typedef float f32x2_t_ __attribute__((ext_vector_type(2)));
typedef __bf16 bf16x2_t_ __attribute__((ext_vector_type(2)));
__device__ __forceinline__ unsigned cvt_pk_bf16(float lo, float hi) { const f32x2_t_ v = {lo, hi}; const bf16x2_t_ b = __builtin_convertvector(v, bf16x2_t_); return __builtin_bit_cast(unsigned, b); }
__device__ __forceinline__ u32x4 pack8(const f32x4& v0, const f32x4& v1) { u32x4 w; w.x = cvt_pk_bf16(v0[0], v0[1]); w.y = cvt_pk_bf16(v0[2], v0[3]); w.z = cvt_pk_bf16(v1[0], v1[1]); w.w = cvt_pk_bf16(v1[2], v1[3]); return w; }

typedef int i32x8 __attribute__((ext_vector_type(8)));
typedef int i32x4 __attribute__((ext_vector_type(4)));
__device__ __forceinline__ i32x8 cat8(const bf16x8& a, const bf16x8& b) { return __builtin_shufflevector(__builtin_bit_cast(i32x4, a), __builtin_bit_cast(i32x4, b), 0, 1, 2, 3, 4, 5, 6, 7); }
constexpr int F8_SCALES = 0x00007f79;
template <class Epi, class Sched, bool ALIGN_EPI, bool F8 = false, int F8SC = F8_SCALES>
__device__ __forceinline__ void gemm_phase(PG8_LAS unsigned char* lds, const __amdgpu_buffer_rsrc_t rsrc, const int lda, const int ldb, const int K, const Sched& S, const Epi& E) {
    int tid_ = threadIdx.x; asm volatile("" : "+v"(tid_));
    const int tid = tid_, wid = __builtin_amdgcn_readfirstlane(tid >> 6), lane = tid & 63, wr = wid >> 2, wc = wid & 3, fr = lane & 15, fq = lane >> 4;
    const int nt = K / BK;
    unsigned voffA, voffB;
    { int R, C; stage_rc(tid * 16, R, C); const int Rb = (R & ~31) + perm32(R & 31); voffA = (unsigned)(R * lda + C) * 2u; voffB = (unsigned)(Rb * ldb + C) * 2u; }
    const unsigned p1voffA = 64u * (unsigned)lda * 2u, p1voffB = 64u * (unsigned)ldb * 2u;
    const unsigned kstep = (unsigned)(BK * 2);
    const unsigned hsA = (unsigned)HALF * lda * 2, hsB = (unsigned)HALF * ldb * 2;
    const unsigned ldsw = (unsigned)wid * 1024u;
    const int aoff = lds_byte(wr * 64 + fr, fq * 8), boff = lds_byte(wc * 32 + fr, fq * 8);
#define PG8_SA(b, h) (((b) * 2 + (h)) * HTB)
#define PG8_SB(b, h) ((4 + (b) * 2 + (h)) * HTB)
#define PG8_STAGE(bufoff, goff, voff) do { _Pragma("unroll") for (int _i = 0; _i < 2; ++_i) \
        __builtin_amdgcn_raw_ptr_buffer_load_lds(rsrc, (PG8_LAS void*)(lds + (bufoff) + ldsw + _i * 8192), 16, (int)(voff), (int)((goff) + _i * p1##voff), 0, 0); } while (0)
#define PG8_LD8(addr) __builtin_shufflevector(*(const PG8_LAS i32x4*)(addr), *(const PG8_LAS i32x4*)((addr) + 1024), 0, 1, 2, 3, 4, 5, 6, 7)
#define PG8_LDA(dst, b, h) do { _Pragma("unroll") for (int m = 0; m < 4; ++m) dst[m] = PG8_LD8(lds + PG8_SA(b, h) + aoff + m * 2048); } while (0)
#define PG8_LDB(dst, b, h) do { _Pragma("unroll") for (int n = 0; n < 2; ++n) dst[n] = PG8_LD8(lds + PG8_SB(b, h) + boff + n * 2048); } while (0)
#define PG8_LO(v) __builtin_bit_cast(bf16x8, __builtin_shufflevector(v, v, 0, 1, 2, 3))
#define PG8_HI(v) __builtin_bit_cast(bf16x8, __builtin_shufflevector(v, v, 4, 5, 6, 7))
#define PG8_MMA(ai, bj, At, Bt) do { __builtin_amdgcn_s_setprio(1); \
        if constexpr (!F8) { _Pragma("unroll") for (int m = 0; m < 4; ++m) _Pragma("unroll") for (int n = 0; n < 2; ++n) { \
            acc[ai][bj][m][n] = __builtin_amdgcn_mfma_f32_16x16x32_bf16(PG8_LO(Bt[n]), PG8_LO(At[m]), acc[ai][bj][m][n], 0, 0, 0); \
            acc[ai][bj][m][n] = __builtin_amdgcn_mfma_f32_16x16x32_bf16(PG8_HI(Bt[n]), PG8_HI(At[m]), acc[ai][bj][m][n], 0, 0, 0); } } \
        else { _Pragma("unroll") for (int m = 0; m < 4; ++m) _Pragma("unroll") for (int n = 0; n < 2; ++n) \
            acc[ai][bj][m][n] = __builtin_amdgcn_mfma_scale_f32_16x16x128_f8f6f4(Bt[n], At[m], acc[ai][bj][m][n], 0, 0, 0, F8SC, 1, F8SC); } \
        __builtin_amdgcn_s_setprio(0); } while (0)
#define PG8_WAIT_V(n) asm volatile("s_waitcnt vmcnt(" #n ")" ::: "memory")
#define PG8_WAIT_L(n) asm volatile("s_waitcnt lgkmcnt(" #n ")" ::: "memory")
#define PG8_BAR __builtin_amdgcn_s_barrier()
#define PG8_SCHED __builtin_amdgcn_sched_barrier(0)
#define PG8_ZERO() do { _Pragma("unroll") for (int a = 0; a < 2; ++a) _Pragma("unroll") for (int b = 0; b < 2; ++b) _Pragma("unroll") for (int m = 0; m < 4; ++m) _Pragma("unroll") for (int n = 0; n < 2; ++n) acc[a][b][m][n] = (f32x4){0.f, 0.f, 0.f, 0.f}; } while (0)
    Unit cur, nxt; int ui = 0;
    if (!S.next(0, cur)) return;
    f32x4 acc[2][2][4][2];
    PG8_ZERO();
    i32x8 At[4], B0[2], B1[2];
    unsigned cA, cB; S.bases(cur, cA, cB); cA = __builtin_amdgcn_readfirstlane(cA); cB = __builtin_amdgcn_readfirstlane(cB);
    PG8_STAGE(PG8_SB(0, 0), cB, voffB); PG8_STAGE(PG8_SB(0, 1), cB + hsB, voffB); PG8_STAGE(PG8_SA(0, 0), cA, voffA); PG8_STAGE(PG8_SA(0, 1), cA + hsA, voffA);
    if (wr == 1) PG8_BAR;
    PG8_WAIT_V(2); PG8_BAR;
    PG8_STAGE(PG8_SB(1, 0), cB + kstep, voffB); PG8_STAGE(PG8_SA(1, 0), cA + kstep, voffA); PG8_STAGE(PG8_SB(1, 1), cB + hsB + kstep, voffB);
    PG8_WAIT_V(6); PG8_BAR;
    for (;;) {
        const bool has_next = S.next(ui + 1, nxt);
        unsigned nA = cA, nB = cB; if (has_next) { S.bases(nxt, nA, nB); nA = __builtin_amdgcn_readfirstlane(nA); nB = __builtin_amdgcn_readfirstlane(nB); }
#pragma unroll 1
        for (int t = 0; t < nt; t += 2) {
            const bool last = (t == nt - 2);
            const unsigned a1 = cA + (unsigned)(t + 1) * kstep;
            const unsigned a2 = last ? nA : cA + (unsigned)(t + 2) * kstep, b2 = last ? nB : cB + (unsigned)(t + 2) * kstep;
            const unsigned a3 = a2 + kstep, b3 = b2 + kstep;
            PG8_LDB(B0, 0, 0); PG8_LDB(B1, 0, 1); PG8_SCHED; PG8_LDA(At, 0, 0); PG8_STAGE(PG8_SA(1, 1), a1 + hsA, voffA);
            PG8_WAIT_V(8); PG8_WAIT_L(0); PG8_BAR; PG8_MMA(0, 0, At, B0); PG8_MMA(0, 1, At, B1); PG8_BAR; PG8_SCHED;
            PG8_LDA(At, 0, 1); PG8_STAGE(PG8_SB(0, 0), b2, voffB); PG8_STAGE(PG8_SB(0, 1), b2 + hsB, voffB); PG8_STAGE(PG8_SA(0, 0), a2, voffA);
            PG8_WAIT_V(8); PG8_WAIT_L(0); PG8_BAR; PG8_MMA(1, 0, At, B0); PG8_MMA(1, 1, At, B1); PG8_BAR; PG8_SCHED;
            PG8_LDB(B0, 1, 0); PG8_LDB(B1, 1, 1); PG8_SCHED; PG8_LDA(At, 1, 0); PG8_STAGE(PG8_SA(0, 1), a2 + hsA, voffA);
            PG8_WAIT_V(8); PG8_WAIT_L(0); PG8_BAR; PG8_MMA(0, 0, At, B0); PG8_MMA(0, 1, At, B1); PG8_BAR; PG8_SCHED;
            PG8_LDA(At, 1, 1); PG8_STAGE(PG8_SB(1, 0), b3, voffB); PG8_STAGE(PG8_SB(1, 1), b3 + hsB, voffB); PG8_STAGE(PG8_SA(1, 0), a3, voffA);
            PG8_WAIT_V(8); PG8_WAIT_L(0); PG8_BAR; PG8_MMA(1, 0, At, B0); PG8_MMA(1, 1, At, B1); PG8_BAR; PG8_SCHED;
        }
        if constexpr (ALIGN_EPI) { if (wr == 0) PG8_BAR; }
        bool keep; { int t2 = threadIdx.x; asm volatile("" : "+v"(t2)); const int w2 = __builtin_amdgcn_readfirstlane(t2 >> 6), l2 = t2 & 63; keep = E(acc, cur, w2 >> 2, w2 & 3, l2 & 15, l2 >> 4); }
        if (!has_next) break;
        if (!keep) PG8_ZERO();
        cur = nxt; cA = nA; cB = nB; ++ui;
        if constexpr (ALIGN_EPI) { if (wr == 1) PG8_BAR; }
    }
    PG8_WAIT_V(0);
    if constexpr (!ALIGN_EPI) { if (wr == 0) PG8_BAR; }
    PG8_BAR;
#undef PG8_SA
#undef PG8_SB
#undef PG8_STAGE
#undef PG8_LDA
#undef PG8_LDB
#undef PG8_LD8
#undef PG8_LO
#undef PG8_HI
#undef PG8_MMA
#undef PG8_WAIT_V
#undef PG8_WAIT_L
#undef PG8_BAR
#undef PG8_SCHED
#undef PG8_ZERO
}
}
namespace pg8 {
#define EPI_ROWLOOP _Pragma("unroll") for (int ai = 0; ai < 2; ++ai) _Pragma("unroll") for (int m = 0; m < 4; ++m)
struct EpiProj {
    bf16_t* O; int coloff, nq;
    __device__ __forceinline__ bool operator()(f32x4 (&acc)[2][2][4][2], const Unit& u, int wr, int wc, int fr, int fq) const {
        const int row0 = u.pm * BM + wr * 64 + fr, col0 = coloff + u.pn * BM + wc * 32 + 8 * fq;
        const float sc = (u.pn < nq) ? 0.125f : 1.0f;
        EPI_ROWLOOP { bf16_t* rowp = O + (size_t)(row0 + ai * HALF + m * 16) * PROJ_LD + col0;
#pragma unroll
            for (int bj = 0; bj < 2; ++bj) *(u32x4*)(rowp + bj * HALF) = pack8(acc[ai][bj][m][0] * sc, acc[ai][bj][m][1] * sc); }
        return false;
    }
};
struct EpiGate {
    bf16_t* O;
    __device__ __forceinline__ bool operator()(f32x4 (&acc)[2][2][4][2], const Unit& u, int wr, int wc, int fr, int fq) const {
        const int row0 = u.pm * BM + wr * 64 + fr, col0 = PJ_GA + u.pn * BM + wc * 32 + 8 * fq;
        EPI_ROWLOOP { bf16_t* rowp = O + (size_t)(row0 + ai * HALF + m * 16) * PROJ_LD + col0;
#pragma unroll
            for (int bj = 0; bj < 2; ++bj) { f32x4 v0 = acc[ai][bj][m][0], v1 = acc[ai][bj][m][1];
#pragma unroll
                for (int j = 0; j < 4; ++j) { v0[j] = fsigmoid(v0[j]); v1[j] = fsigmoid(v1[j]); }
                *(u32x4*)(rowp + bj * HALF) = pack8(v0, v1); } }
        return false;
    }
};
struct EpiBf16 {
    bf16_t* O; int ldc;
    __device__ __forceinline__ bool operator()(f32x4 (&acc)[2][2][4][2], const Unit& u, int wr, int wc, int fr, int fq) const {
        const int row0 = u.pm * BM + wr * 64 + fr, col0 = u.pn * BM + wc * 32 + 8 * fq;
        EPI_ROWLOOP { bf16_t* rowp = O + (size_t)(row0 + ai * HALF + m * 16) * ldc + col0;
#pragma unroll
            for (int bj = 0; bj < 2; ++bj) *(u32x4*)(rowp + bj * HALF) = pack8(acc[ai][bj][m][0], acc[ai][bj][m][1]); }
        return false;
    }
};
template <bool ISDEC> struct EpiLoraA {
    float* OUT; const float* par;
    __device__ __forceinline__ bool operator()(f32x4 (&acc)[2][2][4][2], const Unit& u, int wr, int wc, int fr, int fq) const {
        const int row0 = u.pm * BM + wr * 64 + fr, col0 = u.pn * BM + wc * 32 + 8 * fq;
        f32x4 pv[2][2];
#pragma unroll
        for (int bj = 0; bj < 2; ++bj)
#pragma unroll
            for (int n = 0; n < 2; ++n) pv[bj][n] = *(const f32x4*)(par + col0 + bj * HALF + 4 * n);
        EPI_ROWLOOP { float* rowp = OUT + (size_t)(row0 + ai * HALF + m * 16) * RW + col0;
#pragma unroll
            for (int bj = 0; bj < 2; ++bj)
#pragma unroll
                for (int n = 0; n < 2; ++n) { f32x4 v = acc[ai][bj][m][n] + pv[bj][n];
#pragma unroll
                    for (int j = 0; j < 4; ++j) {
                        if (ISDEC) v[j] = -0.60653065971263342f * fsigmoid(v[j]);
                        else v[j] = fsigmoid(v[j]); }
                    *(f32x4*)(rowp + bj * HALF + 4 * n) = v; } }
        return false;
    }
};
struct EpiIclr {
    bf16_t* OUT; const float* par;
    __device__ __forceinline__ bool operator()(f32x4 (&acc)[2][2][4][2], const Unit& u, int wr, int wc, int fr, int fq) const {
        const int row0 = u.pm * BM + wr * 64 + fr, col0 = u.pn * BM + wc * 32 + 8 * fq;
        f32x4 pv[2][2];
#pragma unroll
        for (int bj = 0; bj < 2; ++bj)
#pragma unroll
            for (int n = 0; n < 2; ++n) pv[bj][n] = *(const f32x4*)(par + col0 + bj * HALF + 4 * n);
        EPI_ROWLOOP { bf16_t* rowp = OUT + (size_t)(row0 + ai * HALF + m * 16) * RW + col0;
#pragma unroll
            for (int bj = 0; bj < 2; ++bj) { f32x4 v0 = acc[ai][bj][m][0] + pv[bj][0], v1 = acc[ai][bj][m][1] + pv[bj][1];
#pragma unroll
                for (int j = 0; j < 4; ++j) { v0[j] = fsigmoid(v0[j]); v1[j] = fsigmoid(v1[j]); }
                *(u32x4*)(rowp + bj * HALF) = pack8(v0, v1); } }
        return false;
    }
};
struct EpiMerged {
    const bf16_t* PROJ; bf16_t* O;
    __device__ __forceinline__ bool operator()(f32x4 (&acc)[2][2][4][2], const Unit& u, int wr, int wc, int fr, int fq) const {
        const int row0 = u.pm * BM + wr * 64 + fr, col0 = u.pn * BM + wc * 32 + 8 * fq;
        EPI_ROWLOOP { const int row = row0 + ai * HALF + m * 16; const bf16_t* gp = PROJ + (size_t)row * PROJ_LD + col0;
#pragma unroll
            for (int bj = 0; bj < 2; ++bj) {
                const u32x4 gb = *(const u32x4*)(gp + PJ_GB + bj * HALF);
                f32x4 b0 = (f32x4){bflo(gb.x), bfhi(gb.x), bflo(gb.y), bfhi(gb.y)}, b1 = (f32x4){bflo(gb.z), bfhi(gb.z), bflo(gb.w), bfhi(gb.w)};
                if (u.aux == 0) {
                    const u32x4 ga = *(const u32x4*)(gp + PJ_GA + bj * HALF);
                    f32x4 a0 = (f32x4){bflo(ga.x), bfhi(ga.x), bflo(ga.y), bfhi(ga.y)}, a1 = (f32x4){bflo(ga.z), bfhi(ga.z), bflo(ga.w), bfhi(ga.w)};
#pragma unroll
                    for (int j = 0; j < 4; ++j) { acc[ai][bj][m][0][j] *= a0[j] * __builtin_amdgcn_rcpf(fmaxf(b0[j], 1e-30f)); acc[ai][bj][m][1][j] *= a1[j] * __builtin_amdgcn_rcpf(fmaxf(b1[j], 1e-30f)); }
                } else {
                    { const f32x4 o0 = acc[ai][bj][m][0] * b0 * ACT8_SCALE, o1 = acc[ai][bj][m][1] * b1 * ACT8_SCALE;
                      int w0 = __builtin_amdgcn_cvt_pk_fp8_f32(o0[0], o0[1], 0, false); w0 = __builtin_amdgcn_cvt_pk_fp8_f32(o0[2], o0[3], w0, true);
                      int w1 = __builtin_amdgcn_cvt_pk_fp8_f32(o1[0], o1[1], 0, false); w1 = __builtin_amdgcn_cvt_pk_fp8_f32(o1[2], o1[3], w1, true);
                      *(v2u*)((unsigned char*)O + (size_t)row * D + col0 + bj * HALF) = (v2u){(unsigned)w0, (unsigned)w1}; }
                } } }
        return u.aux == 0;
    }
};
struct EpiZ {
    const float* X; float* Z;
    __device__ __forceinline__ bool operator()(f32x4 (&acc)[2][2][4][2], const Unit& u, int wr, int wc, int fr, int fq) const {
        const int row0 = u.pm * BM + wr * 64 + fr, col0 = u.pn * BM + wc * 32 + 8 * fq;
        EPI_ROWLOOP { const size_t off = (size_t)(row0 + ai * HALF + m * 16) * D + col0;
#pragma unroll
            for (int bj = 0; bj < 2; ++bj)
#pragma unroll
                for (int n = 0; n < 2; ++n) { const f32x4 xv = *(const f32x4*)(X + off + bj * HALF + 4 * n); *(f32x4*)(Z + off + bj * HALF + 4 * n) = xv * DN_ALPHA + acc[ai][bj][m][n]; } }
        return false;
    }
};
struct EpiSwiglu {
    unsigned char* ACT; const float* bgu;
    __device__ __forceinline__ bool operator()(f32x4 (&acc)[2][2][4][2], const Unit& u, int wr, int wc, int fr, int fq) const {
        const int row0 = u.pm * BM + wr * 64 + fr, col0 = u.pn * HALF + wc * 32 + 8 * fq;
        const float* bp = bgu + (size_t)u.aux * (2 * FF) + col0;
        f32x4 bg[2], bu[2];
#pragma unroll
        for (int n = 0; n < 2; ++n) { bg[n] = *(const f32x4*)(bp + 4 * n); bu[n] = *(const f32x4*)(bp + FF + 4 * n); }
        EPI_ROWLOOP { f32x4 o[2];
#pragma unroll
            for (int n = 0; n < 2; ++n) { const f32x4 g = acc[ai][0][m][n] + bg[n], uu = acc[ai][1][m][n] + bu[n];
#pragma unroll
                for (int j = 0; j < 4; ++j) { const float gc = fminf(g[j], 7.0f), uc = fminf(fmaxf(uu[j], -7.0f), 7.0f); o[n][j] = (uc + 1.0f) * (gc * fsigmoid(1.702f * gc)); } }
            int w0 = __builtin_amdgcn_cvt_pk_fp8_f32(o[0][0], o[0][1], 0, false); w0 = __builtin_amdgcn_cvt_pk_fp8_f32(o[0][2], o[0][3], w0, true);
            int w1 = __builtin_amdgcn_cvt_pk_fp8_f32(o[1][0], o[1][1], 0, false); w1 = __builtin_amdgcn_cvt_pk_fp8_f32(o[1][2], o[1][3], w1, true);
            *(v2u*)(ACT + (size_t)(row0 + ai * HALF + m * 16) * FF + col0) = (v2u){(unsigned)w0, (unsigned)w1}; }
        return false;
    }
};
struct EpiDown {
    unsigned char* YS; const float* bdn; const int* rowslot; const float* roww;
    __device__ __forceinline__ bool operator()(f32x4 (&acc)[2][2][4][2], const Unit& u, int wr, int wc, int fr, int fq) const {
        const int row0 = u.pm * BM + wr * 64 + fr, col0 = u.pn * BM + wc * 32 + 8 * fq;
        const float* bp = bdn + (size_t)u.aux * D + col0;
        f32x4 bv[2][2];
#pragma unroll
        for (int bj = 0; bj < 2; ++bj)
#pragma unroll
            for (int n = 0; n < 2; ++n) bv[bj][n] = *(const f32x4*)(bp + bj * HALF + 4 * n);
        EPI_ROWLOOP { const int row = row0 + ai * HALF + m * 16; const int slot = rowslot[row]; const float w = roww[row] * YS_SCALE;
            if (slot >= 0) { unsigned char* rowp = YS + (size_t)slot * D + col0;
#pragma unroll
                for (int bj = 0; bj < 2; ++bj) { const f32x4 o0 = (acc[ai][bj][m][0] + bv[bj][0]) * w, o1 = (acc[ai][bj][m][1] + bv[bj][1]) * w;
                    int w0 = __builtin_amdgcn_cvt_pk_fp8_f32(o0[0], o0[1], 0, false); w0 = __builtin_amdgcn_cvt_pk_fp8_f32(o0[2], o0[3], w0, true);
                    int w1 = __builtin_amdgcn_cvt_pk_fp8_f32(o1[0], o1[1], 0, false); w1 = __builtin_amdgcn_cvt_pk_fp8_f32(o1[2], o1[3], w1, true);
                    *(v2u*)(rowp + bj * HALF) = (v2u){(unsigned)w0, (unsigned)w1}; } } }
        return false;
    }
};
#undef EPI_ROWLOOP
}

#define XB_TMO      128
#define XB_XCNT(j)  (256  + 64 * (j))
#define XB_XSUB(j)  (1280 + 64 * (j))
#define XB_XGEN(j)  (2304 + 64 * (j))
#define XB_TOP      3328
#define XB_TOPGEN   3392
#define XCD_BAR_WORDS 3456
#define XB_SPIN_CAP (1u << 18)

__device__ __forceinline__ unsigned xb_ld(unsigned* p)              { return __hip_atomic_load(p, __ATOMIC_RELAXED, __HIP_MEMORY_SCOPE_AGENT); }
__device__ __forceinline__ unsigned xb_add(unsigned* p, unsigned v) { return __hip_atomic_fetch_add(p, v, __ATOMIC_RELAXED, __HIP_MEMORY_SCOPE_AGENT); }
__device__ __forceinline__ unsigned xb_xcc_id() { return (unsigned)__builtin_amdgcn_s_getreg((3 << 11) | 20) & 0xFu; }
#define XB_SPIN(cond, bar) do { unsigned _sp = 0; while (cond) { __builtin_amdgcn_s_sleep(1); \
    if ((++_sp & 255u) == 0u) { if (xb_ld(&(bar)[XB_TMO])) break; if (_sp > XB_SPIN_CAP) { atomicAdd(&(bar)[XB_TMO], 1u); break; } } } } while (0)

struct XcdBarrier {
    unsigned* bar; unsigned x;
    volatile LAS unsigned* st;
};

__device__ __forceinline__ XcdBarrier xcd_barrier_post(unsigned* bar, volatile LAS unsigned* st) {
    XcdBarrier b; b.bar = bar; b.x = xb_xcc_id(); b.st = st;
    if (threadIdx.x == 0) (void)xb_add(&bar[XB_XCNT(b.x)], 1u);
    return b;
}
__device__ __forceinline__ void xcd_barrier_complete(unsigned* bar, unsigned x, unsigned& nloc, unsigned& nx) {
    const unsigned G = gridDim.x * gridDim.y * gridDim.z;
    unsigned sum, cnt, mine, sp = 0u;
    for (;;) {
        sum = 0u; cnt = 0u; mine = 0u;
#pragma unroll
        for (unsigned j = 0; j < 16; ++j) { const unsigned c = xb_ld(&bar[XB_XCNT(j)]); sum += c; cnt += (c > 0u) ? 1u : 0u; mine = (j == x) ? c : mine; }
        if (sum == G) break;
        __builtin_amdgcn_s_sleep(1);
        if ((++sp & 255u) == 0u) { if (xb_ld(&bar[XB_TMO])) break; if (sp > XB_SPIN_CAP) { atomicAdd(&bar[XB_TMO], 1u); break; } }
    }
    nloc = mine > 0u ? mine : 1u; nx = cnt > 0u ? cnt : 1u;
}

__device__ __forceinline__ void xcd_barrier(const XcdBarrier& b) {
    asm volatile("s_waitcnt vmcnt(0)" ::: "memory");
    __syncthreads();
    if (threadIdx.x == 0) {
        unsigned* bar = b.bar;
        __builtin_amdgcn_s_waitcnt(0);
        unsigned nloc = b.st[0], nx = b.st[1];
        if (nloc == 0u) { xcd_barrier_complete(bar, b.x, nloc, nx); b.st[0] = nloc; b.st[1] = nx; }
        const unsigned old = xb_add(&bar[XB_XSUB(b.x)], 1u);
        const unsigned gen = old / nloc;
        if (old + 1u == (gen + 1u) * nloc) {
            __builtin_amdgcn_fence(__ATOMIC_RELEASE, "agent");
            asm volatile("s_waitcnt vmcnt(0)" ::: "memory");
            const unsigned og = xb_add(&bar[XB_TOP], 1u);
            const unsigned tg = og / nx;
            if (og + 1u == (tg + 1u) * nx) xb_add(&bar[XB_TOPGEN], 1u);
            else XB_SPIN(xb_ld(&bar[XB_TOPGEN]) == tg, bar);
            __builtin_amdgcn_fence(__ATOMIC_ACQUIRE, "agent");
            xb_add(&bar[XB_XGEN(b.x)], 1u);
            asm volatile("s_waitcnt vmcnt(0)" ::: "memory");
        } else {
            XB_SPIN(xb_ld(&bar[XB_XGEN(b.x)]) == gen, bar);
            __builtin_amdgcn_fence(__ATOMIC_ACQUIRE, "agent");
            asm volatile("s_waitcnt vmcnt(0)" ::: "memory");
        }
    }
    __syncthreads();
}
struct Frame {
    LAS unsigned char* lds;
    volatile LAS unsigned* MISC;
    gu32* ctl;
    int tid, lane, wave;
    int vcu, G;
    unsigned char* ws;
    __amdgpu_buffer_rsrc_t rsrc;
};

#define PHASE_FRAME(F0) Frame F = (F0); { int t_ = threadIdx.x; asm volatile("" : "+v"(t_)); F.tid = t_; F.lane = t_ & 63; F.wave = __builtin_amdgcn_readfirstlane(t_ >> 6); }

__device__ __forceinline__ void tr_item(const float* W, size_t ldw, int k0, int c0, bf16* WT, size_t ldt, int drow0, LAS float* scr, int lane) {
    const int kr = lane >> 4, cq = lane & 15;
    f32x4 v[16];
#pragma unroll
    for (int i = 0; i < 16; ++i) v[i] = *(const GAS f32x4*)(W + (size_t)(k0 + 4 * i + kr) * ldw + c0 + 4 * cq);
#pragma unroll
    for (int i = 0; i < 16; ++i)
#pragma unroll
        for (int j = 0; j < 4; ++j) scr[(4 * cq + j) * 65 + 4 * i + kr] = v[i][j];
    LDS_WAIT(); asm volatile("" ::: "memory");
    const int c = lane & 7;
#pragma unroll
    for (int jj = 0; jj < 8; ++jj) { const int n = (lane >> 3) + 8 * jj; const LAS float* s = scr + n * 65 + 8 * c;
        v4u o; o.x = pk2(s[0], s[1]); o.y = pk2(s[2], s[3]); o.z = pk2(s[4], s[5]); o.w = pk2(s[6], s[7]);
        *(GAS v4u*)(WT + (size_t)(drow0 + n) * ldt + k0 + 8 * c) = o; }
    LDS_WAIT(); asm volatile("" ::: "memory");
}

typedef short s16x2 __attribute__((ext_vector_type(2)));
struct MoeItem { __amdgpu_buffer_rsrc_t rs; unsigned soff, rstep; int ldw, k0; unsigned char* WT; size_t ldt; int drow; };
__device__ __forceinline__ void tr8_load(const MoeItem& m, f32x4 (&v)[16], int lane) {
    const int kr = lane >> 4, cq = lane & 15;
    const int voff = (kr * m.ldw + 4 * cq) * 4;
#pragma unroll
    for (int i = 0; i < 16; ++i) v[i] = __builtin_bit_cast(f32x4, __builtin_amdgcn_raw_buffer_load_b128(m.rs, voff, (int)(m.soff + (unsigned)i * m.rstep), 0));
}
__device__ __forceinline__ void tr8_finish(const f32x4 (&v)[16], const MoeItem& m, LAS float* scr_, int lane) {
    LAS unsigned char* scr = (LAS unsigned char*)scr_;
    const int kr = lane >> 4, cq = lane & 15;
#pragma unroll
    for (int j = 0; j < 4; ++j) { unsigned w[4];
#pragma unroll
        for (int q = 0; q < 4; ++q) { s16x2 t = {0, 0};
            t = __builtin_amdgcn_cvt_scalef32_pk_fp8_f32(t, v[4 * q][j], v[4 * q + 1][j], F8_CVT_SCALE, false);
            t = __builtin_amdgcn_cvt_scalef32_pk_fp8_f32(t, v[4 * q + 2][j], v[4 * q + 3][j], F8_CVT_SCALE, true);
            w[q] = __builtin_bit_cast(unsigned, t); }
        *(LAS v4u*)(scr + (4 * cq + j) * 80 + kr * 16) = (v4u){w[0], w[1], w[2], w[3]}; }
    LDS_WAIT(); asm volatile("" ::: "memory");
    const int qd = lane & 3;
#pragma unroll
    for (int ps = 0; ps < 4; ++ps) { const int n = (lane >> 2) + 16 * ps; const LAS unsigned char* s = scr + n * 80 + qd * 4;
        const unsigned d0 = *(const LAS unsigned*)(s), d1 = *(const LAS unsigned*)(s + 16), d2 = *(const LAS unsigned*)(s + 32), d3 = *(const LAS unsigned*)(s + 48);
        const unsigned t0 = __builtin_amdgcn_perm(d1, d0, 0x05010400u), t1 = __builtin_amdgcn_perm(d1, d0, 0x07030602u), t2 = __builtin_amdgcn_perm(d3, d2, 0x05010400u), t3 = __builtin_amdgcn_perm(d3, d2, 0x07030602u);
        const v4u o = (v4u){__builtin_amdgcn_perm(t2, t0, 0x05040100u), __builtin_amdgcn_perm(t2, t0, 0x07060302u), __builtin_amdgcn_perm(t3, t1, 0x05040100u), __builtin_amdgcn_perm(t3, t1, 0x07060302u)};
        *(GAS v4u*)(m.WT + (size_t)(m.drow + n) * m.ldt + m.k0 + 16 * qd) = o; }
    LDS_WAIT(); asm volatile("" ::: "memory");
}
constexpr int MOE_J4 = 32 * 32 * 64, MOE_J5 = 32 * 32 * 32, MOE_NITEMS = MOE_J4 + MOE_J5;
__device__ __forceinline__ MoeItem moe_item(int r, const float* w_gu, const float* w_down, unsigned char* ws) {
    MoeItem m;
    if (r < MOE_J4) { const int e = r / 2048, q = r % 2048, kb = q / 64, cb = q % 64, c0 = cb * 64; const int cc = c0 & 2047;
        m.rs = __builtin_amdgcn_make_buffer_rsrc((void*)w_gu, 0, 0xffffffff, 0x00020000); m.ldw = 2 * FF; m.k0 = kb * 64;
        m.soff = (unsigned)(((size_t)e * D * 2 * FF + (size_t)kb * 64 * (2 * FF) + c0) * 4); m.rstep = 4u * (2 * FF) * 4u;
        m.WT = ws + WS_WGUT + (size_t)e * 2 * FF * D; m.ldt = D; m.drow = (cc >> 7) * 256 + (c0 >= 2048 ? 128 : 0) + (cc & 127); }
    else { r -= MOE_J4; const int e = r / 1024, q = r % 1024, kb = q / 32, cb = q % 32;
        m.rs = __builtin_amdgcn_make_buffer_rsrc((void*)w_down, 0, 0xffffffff, 0x00020000); m.ldw = D; m.k0 = kb * 64;
        m.soff = (unsigned)(((size_t)e * FF * D + (size_t)kb * 64 * D + cb * 64) * 4); m.rstep = 4u * D * 4u;
        m.WT = ws + WS_WDNT + (size_t)e * D * FF; m.ldt = FF; m.drow = cb * 64; }
    return m;
}
__device__ __forceinline__ MoeItem f8_item(const float* W, int ldw, int k0, int c0, unsigned char* WT, size_t ldt, int drow) {
    MoeItem m; m.rs = __builtin_amdgcn_make_buffer_rsrc((void*)W, 0, 0xffffffff, 0x00020000); m.ldw = ldw; m.k0 = k0;
    m.soff = (unsigned)(((size_t)k0 * ldw + c0) * 4); m.rstep = 4u * (unsigned)ldw * 4u; m.WT = WT; m.ldt = ldt; m.drow = drow; return m;
}

struct In {
    const float *x, *w_in, *rel_bias, *shift_mu, *w0, *w_up, *a0, *a_up, *g_up, *k_k, *k_a, *r_k, *lnx_w, *lnx_b, *proj_a, *proj_b, *w_out,
                *ln1_w, *ln1_b, *w_router, *b_router, *w_gu, *b_gu, *w_down, *b_down, *ln2_w, *ln2_b;
};

__device__ __forceinline__ void p0_prologue(Frame& F0, const In& I) {
    PHASE_FRAME(F0);
    LAS float* scr = (LAS float*)(F.lds + F.wave * 16640);
    const int gw = F.vcu * NWAVES + F.wave, NGW = F.G * NWAVES;
    unsigned char* ws = F.ws;
    constexpr int J0 = 32 * 167, J1 = 16 * 32, J2 = 16 * 32, J3 = 32 * 32;
    constexpr int NITEMS = J0 + J1 + J2 + J3;
    for (int it = gw; it < NITEMS; it += NGW) {
        int r = it;
        if (r < J0) { const int kb = r / 167, cb = r % 167, c0 = cb * 64; bf16* dst; int drow;
            if (c0 < 3072) { f32x4 tv[16];
                   const MoeItem m = (c0 < 2048) ? f8_item(I.w_in, D_IN, kb * 64, c0, (unsigned char*)(ws + WS_WQK8), D, c0) : f8_item(I.w_in, D_IN, kb * 64, c0, (unsigned char*)(ws + WS_WV8), D, c0 - 2048);
                   tr8_load(m, tv, F.lane); tr8_finish(tv, m, scr, F.lane); continue; }
            else if (c0 < 6592) { dst = (bf16*)(ws + WS_WINT); drow = PJ_SEG + (c0 - 3072); }
            else { f32x4 tv[16]; const MoeItem m = f8_item(I.w_in, D_IN, kb * 64, c0, (unsigned char*)(ws + WS_WG8), D, c0 - 6592);
                   tr8_load(m, tv, F.lane); tr8_finish(tv, m, scr, F.lane); continue; }
            tr_item(I.w_in, D_IN, kb * 64, c0, dst, D, drow, scr, F.lane); continue; } r -= J0;
        if (r < J1) { const int kb = r / 32, cb = r % 32; f32x4 tv[16]; const MoeItem m = f8_item(I.proj_a, D, kb * 64, cb * 64, (unsigned char*)(ws + WS_PAT), AW, cb * 64); tr8_load(m, tv, F.lane); tr8_finish(tv, m, scr, F.lane); continue; } r -= J1;
        if (r < J2) { const int kb = r / 32, cb = r % 32; f32x4 tv[16]; const MoeItem m = f8_item(I.proj_b, D, kb * 64, cb * 64, (unsigned char*)(ws + WS_PBT), RW, cb * 64); tr8_load(m, tv, F.lane); tr8_finish(tv, m, scr, F.lane); continue; } r -= J2;
        { const int kb = r / 32, cb = r % 32; f32x4 tv[16]; const MoeItem m = f8_item(I.w_out, D, kb * 64, cb * 64, (unsigned char*)(ws + WS_WOT), D, cb * 64);
          tr8_load(m, tv, F.lane); tr8_finish(tv, m, scr, F.lane); }
    }
    const int gt = F.vcu * (NWAVES * 64) + F.tid, NGT = F.G * NWAVES * 64;
    for (int i = gt; i < 2048 * 256; i += NGT) { const int n = i >> 8, k = i & 255; float v = 0.f;
        if (n < 1024) { if (k < DLORA) v = I.w_up[(size_t)k * RW + n]; }
        else { if (k >= 128 && k < 128 + ALORA) v = I.a_up[(size_t)(k - 128) * RW + (n - 1024)]; }
        ((bf16*)(ws + WS_WLA))[i] = (bf16)f2bf(v); }
    for (int i = gt; i < 1024 * 256; i += NGT) { const int n = i >> 8, k = i & 255; ((bf16*)(ws + WS_WLG))[i] = (bf16)f2bf(I.g_up[(size_t)k * RW + n]); }
    for (int i = gt; i < 64 * D / 8; i += NGT) ((GAS v4u*)((bf16*)(ws + WS_WINT) + (size_t)(PJ_SEG + SHIFT_W) * D))[i] = (v4u){0u, 0u, 0u, 0u};
    for (int i = gt; i < RROWS; i += NGT) ((int*)(ws + WS_ROWSLOT))[i] = -1;
    for (size_t i = gt; i < (size_t)T * D / 8; i += NGT) { const f32x4 a = ((const GAS f32x4*)I.x)[2 * i], b = ((const GAS f32x4*)I.x)[2 * i + 1];
        v4u o; o.x = pk2(a.x, a.y); o.y = pk2(a.z, a.w); o.z = pk2(b.x, b.y); o.w = pk2(b.z, b.w); ((GAS v4u*)(ws + WS_XB16))[i] = o;
        int w0 = __builtin_amdgcn_cvt_pk_fp8_f32(a.x, a.y, 0, false); w0 = __builtin_amdgcn_cvt_pk_fp8_f32(a.z, a.w, w0, true);
        int w1 = __builtin_amdgcn_cvt_pk_fp8_f32(b.x, b.y, 0, false); w1 = __builtin_amdgcn_cvt_pk_fp8_f32(b.z, b.w, w1, true);
        ((GAS v2u*)(ws + WS_XB8))[i] = (v2u){(unsigned)w0, (unsigned)w1}; }
}

constexpr int P8_HS = 0, P8_PITCH = 2052, P8_PART = 131328, P8_LOG = 147712, P8_HIST = 149760;
template <bool SKIP_MIX>
__device__ __forceinline__ void p8_ln_router(Frame& F0, const In& I) {
    PHASE_FRAME(F0);
    LAS float* hs = (LAS float*)(F.lds + P8_HS); LAS float* part = (LAS float*)(F.lds + P8_PART); LAS float* lg = (LAS float*)(F.lds + P8_LOG); LAS int* hist = (LAS int*)(F.lds + P8_HIST);
    const int lane = F.lane, w = F.wave;
    if (F.tid < 32) hist[F.tid] = 0;
    const int kq = lane >> 4, col = lane & 15;
    float ln_w[32], ln_b[32];
#pragma unroll
    for (int j = 0; j < 8; ++j) { const f32x4 a = *(const GAS f32x4*)(I.ln1_w + 4 * lane + 256 * j), b = *(const GAS f32x4*)(I.ln1_b + 4 * lane + 256 * j);
#pragma unroll
        for (int e = 0; e < 4; ++e) { ln_w[4 * j + e] = a[e]; ln_b[4 * j + e] = b[e]; } }
    __syncthreads();
    const float* zsrc = I.x; const bf16* mixb = (const bf16*)(F.ws + WS_Z);
    for (int g = F.vcu; g < T / 16; g += F.G) {
        const int tok0 = g * 16;
        { f32x4 va[8], vb[8];
          const size_t tokA = (size_t)(tok0 + 2 * w), tokB = tokA + 1;
          const GAS f32x4* zra = (const GAS f32x4*)(zsrc + tokA * D) + lane; const GAS f32x4* zrb = (const GAS f32x4*)(zsrc + tokB * D) + lane;
          const GAS v2u* mra = (const GAS v2u*)(mixb + tokA * D) + lane; const GAS v2u* mrb = (const GAS v2u*)(mixb + tokB * D) + lane;
          v2u ma[8], mb[8];
#pragma unroll
          for (int j = 0; j < 8; ++j) { va[j] = zra[64 * j]; vb[j] = zrb[64 * j]; if (!SKIP_MIX) { ma[j] = mra[64 * j]; mb[j] = mrb[64 * j]; } }
#pragma unroll
          for (int j = 0; j < 8; ++j) { va[j] = va[j] * DN_ALPHA; vb[j] = vb[j] * DN_ALPHA;
              if (!SKIP_MIX) { va[j] += (f32x4){bflo(ma[j].x), bfhi(ma[j].x), bflo(ma[j].y), bfhi(ma[j].y)}; vb[j] += (f32x4){bflo(mb[j].x), bfhi(mb[j].x), bflo(mb[j].y), bfhi(mb[j].y)}; } }
#pragma unroll
          for (int tt = 0; tt < 2; ++tt) {
            const int tl = 2 * w + tt; const size_t tok = (size_t)(tok0 + tl);
            f32x4 v[8]; float s = 0.f;
#pragma unroll
            for (int j = 0; j < 8; ++j) { v[j] = tt ? vb[j] : va[j]; s += (v[j].x + v[j].y) + (v[j].z + v[j].w); }
            const float mean = wave_sum(s) * (1.f / D); float s2 = 0.f;
#pragma unroll
            for (int j = 0; j < 8; ++j) { v[j] = v[j] - mean; s2 += (v[j].x * v[j].x + v[j].y * v[j].y) + (v[j].z * v[j].z + v[j].w * v[j].w); }
            const float rstd = 1.f / sqrtf(wave_sum(s2) * (1.f / D) + LN_EPS);
            GAS v2u* h1 = (GAS v2u*)((bf16*)(F.ws + WS_H1) + tok * D) + lane;
            GAS unsigned* h1b = (GAS unsigned*)((unsigned char*)(F.ws + WS_H1B) + tok * D) + lane;
#pragma unroll
            for (int j = 0; j < 8; ++j) { f32x4 h;
#pragma unroll
                for (int e = 0; e < 4; ++e) h[e] = v[j][e] * rstd * ln_w[4 * j + e] + ln_b[4 * j + e];
                h1[64 * j] = (v2u){pg8::cvt_pk_bf16(h.x, h.y), pg8::cvt_pk_bf16(h.z, h.w)}; { int w8 = __builtin_amdgcn_cvt_pk_fp8_f32(h.x, h.y, 0, false); w8 = __builtin_amdgcn_cvt_pk_fp8_f32(h.z, h.w, w8, true); h1b[64 * j] = (unsigned)w8; }
                *(LAS f32x4*)(hs + tl * P8_PITCH + 4 * lane + 256 * j) = h; }
          } }
        __syncthreads();
        f32x4 c0 = (f32x4){0.f, 0.f, 0.f, 0.f}, c1 = c0;
        const LAS float* ap = hs + col * P8_PITCH + 256 * w + 4 * kq;
        const float* bp = I.w_router + (size_t)(256 * w + 4 * kq) * NE + col;
#pragma unroll 4
        for (int kk = 0; kk < 16; ++kk) {
            const f32x4 a = *(const LAS f32x4*)(ap + 16 * kk);
#pragma unroll
            for (int e = 0; e < 4; ++e) {
                const float b0 = bp[(size_t)(16 * kk + e) * NE], b1 = bp[(size_t)(16 * kk + e) * NE + 16];
                c0 = __builtin_amdgcn_mfma_f32_16x16x4f32(a[e], b0, c0, 0, 0, 0);
                c1 = __builtin_amdgcn_mfma_f32_16x16x4f32(a[e], b1, c1, 0, 0, 0);
            }
        }
#pragma unroll
        for (int i = 0; i < 4; ++i) { part[(w * 16 + 4 * kq + i) * 32 + col] = c0[i]; part[(w * 16 + 4 * kq + i) * 32 + 16 + col] = c1[i]; }
        __syncthreads();
        { const int tl = F.tid >> 5, e = F.tid & 31; float s = I.b_router[e];
#pragma unroll
            for (int ww = 0; ww < 8; ++ww) s += part[(ww * 16 + tl) * 32 + e];
            lg[tl * 32 + e] = s; }
        __syncthreads();
        if (F.tid < 16) {
            const int tl = F.tid; float lv[32];
#pragma unroll
            for (int e = 0; e < 32; ++e) lv[e] = lg[tl * 32 + e];
            int ti[4]; float tv[4];
#pragma unroll
            for (int k = 0; k < 4; ++k) { float best = -3.4e38f; int bi = 0;
#pragma unroll
                for (int e = 0; e < 32; ++e) { const bool tk = lv[e] > best; best = tk ? lv[e] : best; bi = tk ? e : bi; }
                ti[k] = bi; tv[k] = best;
#pragma unroll
                for (int e = 0; e < 32; ++e) lv[e] = (e == bi) ? -3.4e38f : lv[e]; }
            float ex[4], sum = 0.f;
#pragma unroll
            for (int k = 0; k < 4; ++k) { ex[k] = __expf(tv[k] - tv[0]); sum += ex[k]; }
            const float inv = 1.f / sum;
            *(GAS v4u*)((int*)(F.ws + WS_TOPI) + (size_t)(tok0 + tl) * 4) = (v4u){(unsigned)ti[0], (unsigned)ti[1], (unsigned)ti[2], (unsigned)ti[3]};
            *(GAS f32x4*)((float*)(F.ws + WS_GATE) + (size_t)(tok0 + tl) * 4) = (f32x4){ex[0] * inv, ex[1] * inv, ex[2] * inv, ex[3] * inv};
#pragma unroll
            for (int k = 0; k < 4; ++k) __hip_atomic_fetch_add(&hist[ti[k]], 1, __ATOMIC_RELAXED, __HIP_MEMORY_SCOPE_WORKGROUP);
        }
        __syncthreads();
    }
    if (F.tid < 32) { const int c = hist[F.tid]; if (c) __hip_atomic_fetch_add(F.ctl + CW_CNT + F.tid, (unsigned)c, RLX_AGENT); }
}

template <bool SKIP_MOE>
__device__ __forceinline__ void p12_final(Frame& F0, const In& I, float* out) {
    PHASE_FRAME(F0);
    const int lane = F.lane; const int gw = F.vcu * NWAVES + F.wave, NGW = F.G * NWAVES;
    float ln_w[32], ln_b[32];
#pragma unroll
    for (int j = 0; j < 8; ++j) { const f32x4 a = *(const GAS f32x4*)(I.ln2_w + 4 * lane + 256 * j), b = *(const GAS f32x4*)(I.ln2_b + 4 * lane + 256 * j);
#pragma unroll
        for (int e = 0; e < 4; ++e) { ln_w[4 * j + e] = a[e]; ln_b[4 * j + e] = b[e]; } }
    for (int tok = gw; tok < T; tok += NGW) {
        const GAS v2u* hr = (const GAS v2u*)((const bf16*)(F.ws + WS_H1) + (size_t)tok * D) + lane;
        f32x4 v[8]; float s = 0.f;
#pragma unroll
        for (int j = 0; j < 8; ++j) { const v2u hh = hr[64 * j]; v[j] = (f32x4){bflo(hh.x), bfhi(hh.x), bflo(hh.y), bfhi(hh.y)} * DN_ALPHA; }
        if (!SKIP_MOE) {
#pragma unroll
            for (int k = 0; k < 4; ++k) { const GAS unsigned* yr = (const GAS unsigned*)((const unsigned char*)(F.ws + WS_YSLOT) + ((size_t)tok * 4 + k) * D) + lane;
#pragma unroll
                for (int j = 0; j < 8; ++j) { const unsigned y = yr[64 * j]; const f32x2 lo = __builtin_amdgcn_cvt_pk_f32_fp8((int)y, false), hi = __builtin_amdgcn_cvt_pk_f32_fp8((int)y, true);
                    v[j].x += lo.x * YS_INV; v[j].y += lo.y * YS_INV; v[j].z += hi.x * YS_INV; v[j].w += hi.y * YS_INV; } }
        }
#pragma unroll
        for (int j = 0; j < 8; ++j) s += (v[j].x + v[j].y) + (v[j].z + v[j].w);
        const float mean = wave_sum(s) * (1.f / D); float s2 = 0.f;
#pragma unroll
        for (int j = 0; j < 8; ++j) { v[j] = v[j] - mean; s2 += (v[j].x * v[j].x + v[j].y * v[j].y) + (v[j].z * v[j].z + v[j].w * v[j].w); }
        const float rstd = 1.f / sqrtf(wave_sum(s2) * (1.f / D) + LN_EPS);
        GAS f32x4* o = (GAS f32x4*)(out + (size_t)tok * D) + lane;
#pragma unroll
        for (int j = 0; j < 8; ++j) { f32x4 h;
#pragma unroll
            for (int e = 0; e < 4; ++e) h[e] = v[j][e] * rstd * ln_w[4 * j + e] + ln_b[4 * j + e];
            o[64 * j] = h; }
    }
}
__device__ __forceinline__ void moe_tables(Frame& F) {
    LAS int* tab = (LAS int*)(F.lds + TAB_OFF);
    if (F.tid == 0) { int run = 0;
        for (int e = 0; e < NE; ++e) { const int c = (int)__hip_atomic_load(F.ctl + CW_CNT + e, RLX_AGENT); const int p = (c + 255) / 256 * 256; tab[32 + e] = run; run += p; tab[e] = run; }
        tab[64] = run / 256; }
    __syncthreads();
}

__device__ __forceinline__ void p9_scatter(Frame& F0, const In& I) {
    PHASE_FRAME(F0);
    moe_tables(F);
    LAS int* tab = (LAS int*)(F.lds + TAB_OFF);
    LAS int* lh = (LAS int*)(F.lds + 0);
    LAS int* lb = (LAS int*)(F.lds + 128);
    LAS int* dst = (LAS int*)(F.lds + 256);
    const int* topi = (const int*)(F.ws + WS_TOPI); const float* gate = (const float*)(F.ws + WS_GATE);
    for (int ch = F.vcu; ch < T / 128; ch += F.G) {
        if (F.tid < 32) lh[F.tid] = 0;
        __syncthreads();
        const int s = ch * 512 + F.tid; const int e = topi[s]; const float gv = gate[s];
        const int rank = __hip_atomic_fetch_add(&lh[e], 1, __ATOMIC_RELAXED, __HIP_MEMORY_SCOPE_WORKGROUP);
        __syncthreads();
        if (F.tid < 32) { const int c = lh[F.tid]; lb[F.tid] = c ? (int)__hip_atomic_fetch_add(F.ctl + CW_CUR + F.tid, (unsigned)c, RLX_AGENT) : 0; }
        __syncthreads();
        const int d = tab[32 + e] + lb[e] + rank;
        ((int*)(F.ws + WS_ROWSLOT))[d] = s; ((float*)(F.ws + WS_ROWW))[d] = gv; dst[F.tid] = d;
        __syncthreads();
#pragma unroll 1
        for (int i0 = F.wave * 64; i0 < F.wave * 64 + 64; i0 += 8) {
            v4u v[8][2]; int dd[8];
#pragma unroll
            for (int q = 0; q < 8; ++q) { const int i = i0 + q; const int tok = ch * 128 + (i >> 2); dd[q] = dst[i];
                const GAS v4u* src = (const GAS v4u*)((const unsigned char*)(F.ws + WS_H1B) + (size_t)tok * D) + F.lane;
                v[q][0] = src[0]; v[q][1] = src[64]; }
#pragma unroll
            for (int q = 0; q < 8; ++q) { GAS v4u* o = (GAS v4u*)((unsigned char*)(F.ws + WS_XG) + (size_t)dd[q] * D) + F.lane; o[0] = v[q][0]; o[64] = v[q][1]; }
        }
        __syncthreads();
    }
}

__device__ __forceinline__ void p10_moe_up(Frame& F0, const In& I) {
    PHASE_FRAME(F0);
    moe_tables(F);
    LAS int* tab = (LAS int*)(F.lds + TAB_OFF);
    pg8::SchedMoe S; S.t.init(tab[64], 16, F.G, (int)blockIdx.x);
    S.A = (unsigned)(WS_XG); S.B = (unsigned)(WS_WGUT); S.tsA = (unsigned)256 * D; S.tsB = (unsigned)256 * D; S.es = (unsigned)2 * FF * D; S.pad_end = tab;
    pg8::EpiSwiglu E{(unsigned char*)(F.ws + WS_ACT), I.b_gu};
    pg8::gemm_phase<pg8::EpiSwiglu, pg8::SchedMoe, true, true>(F.lds + RING_OFF, F.rsrc, D / 2, D / 2, D / 2, S, E);
}
__device__ __forceinline__ void p11_moe_down(Frame& F0, const In& I) {
    PHASE_FRAME(F0);
    moe_tables(F);
    LAS int* tab = (LAS int*)(F.lds + TAB_OFF);
    pg8::SchedMoe S; S.t.init(tab[64], 8, F.G, (int)blockIdx.x);
    S.A = (unsigned)(WS_ACT); S.B = (unsigned)(WS_WDNT); S.tsA = (unsigned)256 * FF; S.tsB = (unsigned)256 * FF; S.es = (unsigned)D * FF; S.pad_end = tab;
    pg8::EpiDown E{(unsigned char*)(F.ws + WS_YSLOT), I.b_down, (const int*)(F.ws + WS_ROWSLOT), (const float*)(F.ws + WS_ROWW)};
    pg8::gemm_phase<pg8::EpiDown, pg8::SchedMoe, true, true>(F.lds + RING_OFF, F.rsrc, FF / 2, FF / 2, FF / 2, S, E);
}

__device__ __forceinline__ void p1_proj(Frame& F0, const In& I) {
    PHASE_FRAME(F0);
    { pg8::SchedPlain S; S.t.init(T / 256, SEG_PAD / 256, F.G, (int)blockIdx.x);
      S.A = (unsigned)(WS_XB16); S.B = (unsigned)(WS_WINT + (size_t)PJ_SEG * D * 2); S.tsA = (unsigned)256 * D * 2; S.tsB = (unsigned)256 * D * 2;
      pg8::EpiProj E{(bf16*)(F.ws + WS_PROJ), PJ_SEG, 0};
      pg8::gemm_phase<pg8::EpiProj, pg8::SchedPlain, true>(F.lds + RING_OFF, F.rsrc, D, D, D, S, E); }
    { pg8::SchedPlain S; S.t.init(T / 256, (2 * AW) / 256, F.G, (int)blockIdx.x);
      S.A = (unsigned)(WS_XB8); S.B = (unsigned)(WS_WQK8); S.tsA = (unsigned)256 * D; S.tsB = (unsigned)256 * D;
      pg8::EpiProj E{(bf16*)(F.ws + WS_PROJ), 0, 4};
      pg8::gemm_phase<pg8::EpiProj, pg8::SchedPlain, true, true>(F.lds + RING_OFF, F.rsrc, D / 2, D / 2, D / 2, S, E); }
    { pg8::SchedPlain S; S.t.init(T / 256, (2 * D) / 256, F.G, (int)blockIdx.x);
      S.A = (unsigned)(WS_XB8); S.B = (unsigned)(WS_WG8); S.tsA = (unsigned)256 * D; S.tsB = (unsigned)256 * D;
      pg8::EpiGate E{(bf16*)(F.ws + WS_PROJ)};
      pg8::gemm_phase<pg8::EpiGate, pg8::SchedPlain, true, true>(F.lds + RING_OFF, F.rsrc, D / 2, D / 2, D / 2, S, E); }
    { pg8::SchedPlain S; S.t.init(AW / 256, T / 256, F.G, (int)blockIdx.x);
      S.A = (unsigned)(WS_WV8); S.B = (unsigned)(WS_XB8); S.tsA = (unsigned)256 * D; S.tsB = (unsigned)256 * D;
      pg8::EpiBf16 E{(bf16*)(F.ws + WS_VT), T};
      pg8::gemm_phase<pg8::EpiBf16, pg8::SchedPlain, true, true>(F.lds + RING_OFF, F.rsrc, D / 2, D / 2, D / 2, S, E); }
}

__device__ __forceinline__ float ftanh(float x) { return 2.0f * fsigmoid(2.0f * x) - 1.0f; }
__device__ __forceinline__ void p2_shift_attn(Frame& F0, const In& I) {
    PHASE_FRAME(F0);
    const int lane = F.lane; const int gw = F.vcu * NWAVES + F.wave, NGW = F.G * NWAVES;
    const bf16* PROJ = (const bf16*)(F.ws + WS_PROJ);
    for (int tok = gw; tok < T; tok += NGW) {
        const bool first = (tok % SEQ) == 0;
        const bf16* cur = PROJ + (size_t)tok * PROJ_LD + PJ_SEG; const bf16* prv = cur - PROJ_LD;
        bf16* rkv = (bf16*)(F.ws + WS_RKV) + (size_t)tok * (3 * RW); bf16* lin = (bf16*)(F.ws + WS_LORAIN) + (size_t)tok * LORA_LD;
#pragma unroll 1
        for (int it = 0; it < 7; ++it) { const int gi = it * 64 + lane; if (gi >= SHIFT_W / 8) break; const int c = gi * 8;
            const v4u cv = *(const GAS v4u*)(cur + c); v4u pv = (v4u){0u, 0u, 0u, 0u}; if (!first) pv = *(const GAS v4u*)(prv + c);
            const f32x4 m0 = *(const GAS f32x4*)(I.shift_mu + c), m1 = *(const GAS f32x4*)(I.shift_mu + c + 4);
            float v[8]; const unsigned cw[4] = {cv.x, cv.y, cv.z, cv.w}, pw[4] = {pv.x, pv.y, pv.z, pv.w};
#pragma unroll
            for (int j = 0; j < 4; ++j) { const float c0 = bflo(cw[j]), c1 = bfhi(cw[j]), p0 = bflo(pw[j]), p1 = bfhi(pw[j]); const float mu0 = (j < 2) ? m0[2 * j] : m1[2 * j - 4], mu1 = (j < 2) ? m0[2 * j + 1] : m1[2 * j - 3];
                v[2 * j] = c0 + (p0 - c0) * mu0; v[2 * j + 1] = c1 + (p1 - c1) * mu1; }
            bf16* dstp;
            if (c < 3 * RW) dstp = rkv + c;
            else if (c < 3 * RW + DLORA) { dstp = lin + (c - 3 * RW);
#pragma unroll
                for (int j = 0; j < 8; ++j) v[j] = ftanh(v[j]); }
            else if (c < 3 * RW + DLORA + ALORA) dstp = lin + 128 + (c - 3 * RW - DLORA);
            else { dstp = lin + 256 + (c - 3 * RW - DLORA - ALORA);
#pragma unroll
                for (int j = 0; j < 8; ++j) v[j] = fsigmoid(v[j]); }
            *(GAS v4u*)dstp = (v4u){pk2(v[0], v[1]), pk2(v[2], v[3]), pk2(v[4], v[5]), pk2(v[6], v[7])};
        }
        if (lane < 8) { const int c = (lane < 4) ? (DLORA + 8 * lane) : (128 + ALORA + 8 * (lane - 4)); *(GAS v4u*)(lin + c) = (v4u){0u, 0u, 0u, 0u}; }
    }
#if STAGE == 3
    { const int gt = F.vcu * (NWAVES * 64) + F.tid, NGT = F.G * NWAVES * 64;
      for (size_t i = gt; i < (size_t)T * RW / 8; i += NGT) ((GAS v4u*)(F.ws + WS_YB))[i] = (v4u){0u, 0u, 0u, 0u}; }
#endif
    LAS float* tbl = (LAS float*)(F.lds + 0);
    constexpr int AKV = 64 * 144, A_KOFF = 2048, A_VOFF = A_KOFF + 2 * AKV;
    const bf16* VT = (const bf16*)(F.ws + WS_VT); bf16* YA = (bf16*)(F.ws + WS_YA);
    const int r = lane & 31, hh = lane >> 5;
    const int rp = (r & 16) + 8 * ((r >> 2) & 1) + 4 * ((r >> 3) & 1) + (r & 3);
    const int srow = F.tid >> 3, spc = F.tid & 7;
    for (int task = F.vcu; task < BATCH * AH * (SEQ / 256); task += F.G) {
        const int bh = task >> 5, q256 = task & 31, b = bh >> 4, h = bh & 15, c0 = q256 * 4;
        const int q0 = q256 * 256 + F.wave * 32, cw = c0 + (F.wave >> 1);
        const int kc_lo = (c0 > LEFT) ? c0 - LEFT : 0, kc_hi = c0 + 3;
        __syncthreads();
        if (F.tid < REL_TABLE) tbl[F.tid] = I.rel_bias[h * REL_TABLE + F.tid];
        const size_t tokq = (size_t)b * SEQ + q0 + r;
        bf16x8 qf[4];
#pragma unroll
        for (int s = 0; s < 4; ++s) qf[s] = *(const GAS bf16x8*)(PROJ + tokq * PROJ_LD + PJ_Q + h * 64 + 16 * s + 8 * hh);
        f32x16 o0, o1;
#pragma unroll
        for (int i = 0; i < 16; ++i) { o0[i] = 0.f; o1[i] = 0.f; }
        float m_run = -1e30f, l_run = 0.f;
        v4u kreg, vreg;
#define AT_STAGE_LOAD(kc_) do { kreg = *(const GAS v4u*)(PROJ + ((size_t)b * SEQ + (size_t)(kc_) * 64 + srow) * PROJ_LD + PJ_K + h * 64 + spc * 8); \
                                vreg = *(const GAS v4u*)(VT + (size_t)(h * 64 + srow) * T + (size_t)b * SEQ + (size_t)(kc_) * 64 + spc * 8); } while (0)
#define AT_STAGE_WRITE(buf_) do { *(LAS v4u*)(F.lds + A_KOFF + (buf_) * AKV + srow * 144 + spc * 16) = kreg; *(LAS v4u*)(F.lds + A_VOFF + (buf_) * AKV + srow * 144 + spc * 16) = vreg; } while (0)
        AT_STAGE_LOAD(kc_lo); AT_STAGE_WRITE(0);
        __syncthreads();
#pragma unroll 1
        for (int kc = kc_lo; kc <= kc_hi; ++kc) {
            const int buf = (kc - kc_lo) & 1;
            if (kc < kc_hi) AT_STAGE_LOAD(kc + 1);
            if (kc >= cw - LEFT && kc <= cw) {
                const LAS unsigned char* Kb = F.lds + A_KOFF + buf * AKV; const LAS unsigned char* Vb = F.lds + A_VOFF + buf * AKV;
#pragma unroll
                for (int tt = 0; tt < 2; ++tt) {
                    const int kpos0 = kc * 64 + 32 * tt;
                    bf16x8 kf[4], va[2], vb[2];
#pragma unroll
                    for (int s = 0; s < 4; ++s) kf[s] = *(const LAS bf16x8*)(Kb + (32 * tt + rp) * 144 + 32 * s + 16 * hh);
#pragma unroll
                    for (int s2 = 0; s2 < 2; ++s2) { va[s2] = *(const LAS bf16x8*)(Vb + r * 144 + 64 * tt + 32 * s2 + 16 * hh); vb[s2] = *(const LAS bf16x8*)(Vb + (32 + r) * 144 + 64 * tt + 32 * s2 + 16 * hh); }
                    f32x16 st;
#pragma unroll
                    for (int i = 0; i < 16; ++i) st[i] = 0.f;
#pragma unroll
                    for (int s = 0; s < 4; ++s) st = __builtin_amdgcn_mfma_f32_32x32x16_bf16(kf[s], qf[s], st, 0, 0, 0);
                    const int dbase = (q0 + r) - (kpos0 + 8 * hh);
                    float mx = -1e30f;
                    if (q0 - (kpos0 + 31) >= MAX_PAST) {
                        const float bc = tbl[MAX_PAST + 63];
#pragma unroll
                        for (int i = 0; i < 16; ++i) { st[i] += bc; mx = fmaxf(mx, st[i]); }
                    } else {
#pragma unroll
                        for (int i = 0; i < 16; ++i) { int d = dbase - (16 * (i >> 3) + 4 * ((i >> 2) & 1) + (i & 3)); d = d < MAX_PAST ? d : MAX_PAST; st[i] += tbl[d + 63]; mx = fmaxf(mx, st[i]); }
                    }
                    mx = fmaxf(mx, __shfl_xor(mx, 32));
                    const float m_new = fmaxf(m_run, mx), alpha = __expf(m_run - m_new);
                    float ls = 0.f;
#pragma unroll
                    for (int i = 0; i < 16; ++i) { st[i] = __expf(st[i] - m_new); ls += st[i]; }
                    l_run = l_run * alpha + ls;
                    if (__builtin_amdgcn_ballot_w64(m_new != m_run)) {
#pragma unroll
                        for (int i = 0; i < 16; ++i) { o0[i] *= alpha; o1[i] *= alpha; } }
                    m_run = m_new;
#pragma unroll
                    for (int s2 = 0; s2 < 2; ++s2) {
                        v4u pw; pw.x = pg8::cvt_pk_bf16(st[8 * s2 + 0], st[8 * s2 + 1]); pw.y = pg8::cvt_pk_bf16(st[8 * s2 + 2], st[8 * s2 + 3]); pw.z = pg8::cvt_pk_bf16(st[8 * s2 + 4], st[8 * s2 + 5]); pw.w = pg8::cvt_pk_bf16(st[8 * s2 + 6], st[8 * s2 + 7]);
                        const bf16x8 pf = __builtin_bit_cast(bf16x8, pw);
                        o0 = __builtin_amdgcn_mfma_f32_32x32x16_bf16(va[s2], pf, o0, 0, 0, 0);
                        o1 = __builtin_amdgcn_mfma_f32_32x32x16_bf16(vb[s2], pf, o1, 0, 0, 0);
                    }
                }
            }
            if (kc < kc_hi) AT_STAGE_WRITE(buf ^ 1);
            __syncthreads();
        }
#undef AT_STAGE_LOAD
#undef AT_STAGE_WRITE
        const float inv = 1.0f / (l_run + __shfl_xor(l_run, 32));
        unsigned char* yo = (unsigned char*)YA + tokq * AW + h * 64 + 4 * hh;
        const float inv16 = inv * ACT8_SCALE;
#pragma unroll
        for (int g4 = 0; g4 < 4; ++g4) {
            int w0 = __builtin_amdgcn_cvt_pk_fp8_f32(o0[4 * g4] * inv16, o0[4 * g4 + 1] * inv16, 0, false); w0 = __builtin_amdgcn_cvt_pk_fp8_f32(o0[4 * g4 + 2] * inv16, o0[4 * g4 + 3] * inv16, w0, true);
            int w1 = __builtin_amdgcn_cvt_pk_fp8_f32(o1[4 * g4] * inv16, o1[4 * g4 + 1] * inv16, 0, false); w1 = __builtin_amdgcn_cvt_pk_fp8_f32(o1[4 * g4 + 2] * inv16, o1[4 * g4 + 3] * inv16, w1, true);
            *(GAS unsigned*)(yo + 8 * g4) = (unsigned)w0; *(GAS unsigned*)(yo + 32 + 8 * g4) = (unsigned)w1;
        }
    }
}

__device__ __forceinline__ void p6_merged(Frame& F0, const In& I) {
    PHASE_FRAME(F0);
    pg8::SchedTwo S; S.t.init(T / 256, D / 256, F.G, (int)blockIdx.x);
    S.A0 = (unsigned)(WS_YA); S.A1 = (unsigned)(WS_YB); S.B0 = (unsigned)(WS_PAT); S.B1 = (unsigned)(WS_PBT);
    S.tsA = (unsigned)256 * AW; S.tsB = (unsigned)256 * AW;
    pg8::EpiMerged E{(const bf16*)(F.ws + WS_PROJ), (bf16*)(F.ws + WS_MERGED)};
    pg8::gemm_phase<pg8::EpiMerged, pg8::SchedTwo, true, true, 0x00007b79>(F.lds + RING_OFF, F.rsrc, AW / 2, AW / 2, AW / 2, S, E);
}
__device__ __forceinline__ void p7_mix(Frame& F0, const In& I) {
    PHASE_FRAME(F0);
    pg8::SchedPlain S; S.t.init(T / 256, D / 256, F.G, (int)blockIdx.x);
    S.A = (unsigned)(WS_MERGED); S.B = (unsigned)(WS_WOT); S.tsA = (unsigned)256 * D; S.tsB = (unsigned)256 * D;
    pg8::EpiBf16 E{(bf16*)(F.ws + WS_Z), D};
    pg8::gemm_phase<pg8::EpiBf16, pg8::SchedPlain, true, true, 0x00007b79>(F.lds + RING_OFF, F.rsrc, D / 2, D / 2, D / 2, S, E);
}

__device__ __forceinline__ void p3_lora(Frame& F0, const In& I) {
    PHASE_FRAME(F0);
    { pg8::SchedPlain S; S.t.init(T / 256, 4, F.G, (int)blockIdx.x);
      S.A = (unsigned)(WS_LORAIN); S.B = (unsigned)(WS_WLA); S.tsA = (unsigned)256 * LORA_LD * 2; S.tsB = (unsigned)256 * 256 * 2;
      pg8::EpiLoraA<true> E{(float*)(F.ws + WS_DECAY), I.w0};
      pg8::gemm_phase<pg8::EpiLoraA<true>, pg8::SchedPlain, true>(F.lds + RING_OFF, F.rsrc, LORA_LD, 256, 256, S, E); }
    { pg8::SchedPlain S; S.t.init(T / 256, 4, F.G, (int)blockIdx.x);
      S.A = (unsigned)(WS_LORAIN); S.B = (unsigned)(WS_WLA + (size_t)1024 * 256 * 2); S.tsA = (unsigned)256 * LORA_LD * 2; S.tsB = (unsigned)256 * 256 * 2;
      pg8::EpiIclr E{(bf16*)(F.ws + WS_ICLR), I.a0};
      pg8::gemm_phase<pg8::EpiIclr, pg8::SchedPlain, true>(F.lds + RING_OFF, F.rsrc, LORA_LD, 256, 256, S, E); }
    { pg8::SchedPlain S; S.t.init(T / 256, 4, F.G, (int)blockIdx.x);
      S.A = (unsigned)(WS_LORAIN + 512); S.B = (unsigned)(WS_WLG); S.tsA = (unsigned)256 * LORA_LD * 2; S.tsB = (unsigned)256 * 256 * 2;
      pg8::EpiBf16 E{(bf16*)(F.ws + WS_G), RW};
      pg8::gemm_phase<pg8::EpiBf16, pg8::SchedPlain, true>(F.lds + RING_OFF, F.rsrc, LORA_LD, 256, 256, S, E); }
}

constexpr int CP = 144;
constexpr int CMAT = 64 * CP;
constexpr int C_RT = 0 * CMAT, C_ATT = 1 * CMAT, C_AAK = 2 * CMAT, C_ARKT = 3 * CMAT, C_WA = 4 * CMAT, C_WB = 6 * CMAT,
              C_MA = 8 * CMAT, C_MTA = 9 * CMAT, C_MB = 10 * CMAT, C_MTB = 11 * CMAT, C_SEG = 12 * CMAT, C_GAM = C_SEG + 8 * 64 * 4, C_TSCR = C_GAM + 256;
constexpr int C_AT = C_WB, C_BT = C_WB + CMAT, C_KT = C_MB, C_QYT = C_MA, C_QST = C_MTA, C_KHT = C_MTB, C_VT = C_WB;
static_assert(C_TSCR % 16 == 0 && C_TSCR + 8 * 5120 <= TAB_OFF, "P4a LDS map");
constexpr int CHK_UNIT_BYTES = 4 * 64 * 64 * 2;
#define CBAR() do { asm volatile("s_waitcnt lgkmcnt(0)" ::: "memory"); __builtin_amdgcn_s_barrier(); asm volatile("" ::: "memory"); } while (0)
template <int NT, class Epi>
__device__ __forceinline__ void cmm(const LAS unsigned char* X, const LAS unsigned char* Y, int mt0, int nt, int lane, const Epi& E) {
    const int lr = lane & 15, kq = lane >> 4;
    const bf16x8 b0 = *(const LAS bf16x8*)(Y + (nt * 16 + lr) * CP + kq * 16), b1 = *(const LAS bf16x8*)(Y + (nt * 16 + lr) * CP + kq * 16 + 64);
#pragma unroll
    for (int i = 0; i < NT; ++i) { const int mt = mt0 + i;
        const bf16x8 a0 = *(const LAS bf16x8*)(X + (mt * 16 + lr) * CP + kq * 16), a1 = *(const LAS bf16x8*)(X + (mt * 16 + lr) * CP + kq * 16 + 64);
        f32x4 acc = (f32x4){0.f, 0.f, 0.f, 0.f};
        acc = __builtin_amdgcn_mfma_f32_16x16x32_bf16(a0, b0, acc, 0, 0, 0);
        acc = __builtin_amdgcn_mfma_f32_16x16x32_bf16(a1, b1, acc, 0, 0, 0);
        E(mt, nt, acc); }
}
__device__ __forceinline__ v2u pack4(const f32x4& v) { return (v2u){pg8::cvt_pk_bf16(v[0], v[1]), pg8::cvt_pk_bf16(v[2], v[3])}; }
__device__ __forceinline__ f32x4 unpack4(const v2u w) { return (f32x4){bflo(w.x), bfhi(w.x), bflo(w.y), bfhi(w.y)}; }
__device__ __forceinline__ void p4a_chunk(Frame& F0, const In& I) {
    PHASE_FRAME(F0);
    LAS unsigned char* L = F.lds;
    const int lane = F.lane, w = F.wave, lr = lane & 15, kq = lane >> 4;
    const bf16* RKV = (const bf16*)(F.ws + WS_RKV); const float* LW = (const float*)(F.ws + WS_DECAY); const bf16* ICL = (const bf16*)(F.ws + WS_ICLR);
    unsigned char* CHK = F.ws + WS_CHK;
    int uit = 0;
    for (int unit = F.vcu; unit < BATCH * RH * (SEQ / 64); unit += F.G, ++uit) {
        const int bh = unit >> 7, ck = unit & 127, b = bh >> 4, h = bh & 15;
        const size_t tok0 = (size_t)b * SEQ + (size_t)ck * 64 + 8 * w;
        const int hc = h * 64 + lane;
        float lwv[8], ic[8], rr[8], kk[8], vv[8];
#pragma unroll
        for (int i = 0; i < 8; ++i) { const size_t tok = tok0 + i; lwv[i] = LW[tok * RW + hc]; ic[i] = bf2f(ICL[tok * RW + hc]);
            rr[i] = bf2f(RKV[tok * (3 * RW) + hc]); kk[i] = bf2f(RKV[tok * (3 * RW) + RW + hc]); vv[i] = bf2f(RKV[tok * (3 * RW) + 2 * RW + hc]); }
        const float kkp = I.k_k[hc], kap = I.k_a[hc];
        float cs[8]; { float run = 0.f;
#pragma unroll
            for (int i = 0; i < 8; ++i) { run += lwv[i]; cs[i] = run; } }
        __syncthreads();
        ((LAS float*)(L + C_SEG))[w * 64 + lane] = cs[7];
        CBAR();
        float pre = 0.f, tot = 0.f;
#pragma unroll
        for (int j = 0; j < 8; ++j) { const float sg = ((const LAS float*)(L + C_SEG))[j * 64 + lane]; tot += sg; pre += (j < w) ? sg : 0.f; }
        if (w == 0) ((LAS float*)(L + C_GAM))[lane] = __expf(tot);
        unsigned att[4], bht[4], kht[4], vtt[4];
        float at_[8], bh_[8], kh_[8]; const float gtot = __expf(tot); float ep_prev = 1.f;
#pragma unroll
        for (int i = 0; i < 8; ++i) { const int t = 8 * w + i; const float cum = pre + cs[i], cump = cum - lwv[i];
            const float kkv = kk[i] * kkp; const float n2 = wave_sum(kkv * kkv); const float kkn = kkv * __builtin_amdgcn_rsqf(fmaxf(n2, 1e-24f));
            const float a = -kkn, bb = kkn * ic[i], kp = kk[i] * (1.0f + (ic[i] - 1.0f) * kap);
            const float ep = __expf(cum), em = __builtin_amdgcn_rcpf(ep), epp = (i == 0) ? __expf(cump) : ep_prev, eL = gtot * em; ep_prev = ep;
            const float Rv = rr[i] * ep, Av = a * epp, Bv = bb * em, Kv = kp * em;
            at_[i] = Av; bh_[i] = bb * eL; kh_[i] = kp * eL;
            *(LAS unsigned short*)(L + C_RT + t * CP + lane * 2) = (unsigned short)f2bf(Rv);
            *(LAS unsigned short*)(L + C_AT + t * CP + lane * 2) = (unsigned short)f2bf(Av);
            *(LAS unsigned short*)(L + C_BT + t * CP + lane * 2) = (unsigned short)f2bf(Bv);
            *(LAS unsigned short*)(L + C_KT + t * CP + lane * 2) = (unsigned short)f2bf(Kv); }
#pragma unroll
        for (int q = 0; q < 4; ++q) { att[q] = pk2(at_[2 * q], at_[2 * q + 1]); bht[q] = pk2(bh_[2 * q], bh_[2 * q + 1]); kht[q] = pk2(kh_[2 * q], kh_[2 * q + 1]); vtt[q] = pk2(vv[2 * q], vv[2 * q + 1]); }
        *(LAS v4u*)(L + C_ATT + lane * CP + 16 * w) = (v4u){att[0], att[1], att[2], att[3]};
        *(LAS v4u*)(L + C_WA + (64 + lane) * CP + 16 * w) = (v4u){bht[0], bht[1], bht[2], bht[3]};
        CBAR();
        const int cit = (uit * F.G + F.vcu) * 16 + w * 2; const bool hx = cit < MOE_NITEMS, hy = cit + 1 < MOE_NITEMS;
        f32x4 tX[16]; MoeItem mX = moe_item(hx ? cit : 0, I.w_gu, I.w_down, F.ws);
        LAS float* tscr = (LAS float*)(L + C_TSCR + w * 5120);
        struct Fr { bf16x8 a, b; };
        auto LD = [&](int base, int tile) -> Fr { const LAS unsigned char* q = L + base + (tile * 16 + lr) * CP + kq * 16; Fr f; f.a = *(const LAS bf16x8*)q; f.b = *(const LAS bf16x8*)(q + 64); return f; };
        auto MM = [&](const Fr& x, const Fr& y) -> f32x4 { f32x4 acc = (f32x4){0.f, 0.f, 0.f, 0.f};
            acc = __builtin_amdgcn_mfma_f32_16x16x32_bf16(x.a, y.a, acc, 0, 0, 0); acc = __builtin_amdgcn_mfma_f32_16x16x32_bf16(x.b, y.b, acc, 0, 0, 0); return acc; };
        const int nt = w & 3, mt0 = 2 * (w >> 2), n = nt * 16 + lr;
        { const Fr yAT = LD(C_AT, nt), yKT = LD(C_KT, nt), yRT = LD(C_RT, nt);
          Fr xBT[2], xAT[2], xKT[2];
#pragma unroll
          for (int i = 0; i < 2; ++i) { xBT[i] = LD(C_BT, mt0 + i); xAT[i] = LD(C_AT, mt0 + i); xKT[i] = LD(C_KT, mt0 + i); }
          f32x4 a1[2], a2[2], a3[2], a4[2];
#pragma unroll
          for (int i = 0; i < 2; ++i) { a1[i] = MM(xBT[i], yAT); a2[i] = MM(xAT[i], yKT); a3[i] = MM(xBT[i], yRT); a4[i] = MM(xKT[i], yRT); }
#pragma unroll
          for (int i = 0; i < 2; ++i) { const int m0 = (mt0 + i) * 16 + 4 * kq;
              f32x4 v = a1[i];
#pragma unroll
              for (int e = 0; e < 4; ++e) { v[e] = (m0 + e < n) ? v[e] : 0.f; *(LAS unsigned short*)(L + C_MA + (m0 + e) * CP + n * 2) = (unsigned short)f2bf(v[e]); }
              *(LAS v2u*)(L + C_MTA + n * CP + m0 * 2) = pack4(v);
              v = a2[i];
#pragma unroll
              for (int e = 0; e < 4; ++e) v[e] = (n < m0 + e) ? v[e] : 0.f;
              *(LAS v2u*)(L + C_AAK + n * CP + m0 * 2) = pack4(v);
              v = a3[i];
#pragma unroll
              for (int e = 0; e < 4; ++e) v[e] = (m0 + e <= n) ? v[e] : 0.f;
              *(LAS v2u*)(L + C_WA + n * CP + m0 * 2) = pack4(v);
              v = a4[i];
#pragma unroll
              for (int e = 0; e < 4; ++e) v[e] = (m0 + e <= n) ? v[e] : 0.f;
              *(LAS v2u*)(L + C_ARKT + n * CP + m0 * 2) = pack4(v); } }
        CBAR();
        if (hx) tr8_load(mX, tX, lane);
#pragma unroll
        for (int lvl = 0; lvl < 6; ++lvl) {
            const int Wsrc = (lvl & 1) ? C_WB : C_WA, Wdst = (lvl & 1) ? C_WA : C_WB, Ms = (lvl & 1) ? C_MB : C_MA, Mts = (lvl & 1) ? C_MTB : C_MTA, Md = (lvl & 1) ? C_MA : C_MB, Mtd = (lvl & 1) ? C_MTA : C_MTB;
            const Fr yW = LD(Wsrc, w); Fr yMt; if (lvl < 5) yMt = LD(Mts, nt);
            Fr xM[4], xS[2];
#pragma unroll
            for (int i = 0; i < 4; ++i) xM[i] = LD(Ms, i);
            if (lvl < 5) { xS[0] = LD(Ms, mt0); xS[1] = LD(Ms, mt0 + 1); }
            const int nj = w * 16 + lr;
            f32x4 old[4], aw[4], as[2];
#pragma unroll
            for (int i = 0; i < 4; ++i) old[i] = unpack4(*(const LAS v2u*)(L + Wsrc + nj * CP + (i * 16 + 4 * kq) * 2));
#pragma unroll
            for (int i = 0; i < 4; ++i) aw[i] = MM(xM[i], yW);
            if (lvl < 5) {
#pragma unroll
                for (int i = 0; i < 2; ++i) as[i] = MM(xS[i], yMt); }
#pragma unroll
            for (int i = 0; i < 4; ++i) *(LAS v2u*)(L + Wdst + nj * CP + (i * 16 + 4 * kq) * 2) = pack4(old[i] + aw[i]);
            if (lvl < 5) {
#pragma unroll
                for (int i = 0; i < 2; ++i) { const int m0 = (mt0 + i) * 16 + 4 * kq;
#pragma unroll
                    for (int e = 0; e < 4; ++e) *(LAS unsigned short*)(L + Md + (m0 + e) * CP + n * 2) = (unsigned short)f2bf(as[i][e]);
                    if (lvl < 4) *(LAS v2u*)(L + Mtd + n * CP + m0 * 2) = pack4(as[i]); } }
            if (lvl == 4) *(LAS v4u*)(L + C_KHT + lane * CP + 16 * w) = (v4u){kht[0], kht[1], kht[2], kht[3]};
            if (lvl == 2) { if (hx) tr8_finish(tX, mX, tscr, lane);
                            if (hy) { mX = moe_item(cit + 1, I.w_gu, I.w_down, F.ws); tr8_load(mX, tX, lane); } }
            CBAR();
        }
        *(LAS v4u*)(L + C_VT + lane * CP + 16 * w) = (v4u){vtt[0], vtt[1], vtt[2], vtt[3]};
        unsigned char* og = CHK + (size_t)unit * CHK_UNIT_BYTES;
        { const Fr yW1 = LD(C_WA, nt), yW2 = LD(C_WA + 64 * CP, nt);
          Fr xA[2], xK[2];
#pragma unroll
          for (int i = 0; i < 2; ++i) { xA[i] = LD(C_ATT, mt0 + i); xK[i] = LD(C_AAK, mt0 + i); }
          f32x4 rv[2], av[2], kv[2];
          const float gm = ((const LAS float*)(L + C_GAM))[n];
#pragma unroll
          for (int i = 0; i < 2; ++i) { const int m0 = (mt0 + i) * 16 + 4 * kq;
              rv[i] = unpack4(*(const LAS v2u*)(L + C_RT + n * CP + m0 * 2)); av[i] = unpack4(*(const LAS v2u*)(L + C_ARKT + n * CP + m0 * 2)); kv[i] = unpack4(*(const LAS v2u*)(L + C_KHT + n * CP + m0 * 2)); }
          f32x4 p7[2], p8[2], p9[2], p10[2];
#pragma unroll
          for (int i = 0; i < 2; ++i) { p7[i] = MM(xA[i], yW1); p8[i] = MM(xK[i], yW1); p9[i] = MM(xA[i], yW2); p10[i] = MM(xK[i], yW2); }
#pragma unroll
          for (int i = 0; i < 2; ++i) { const int m0 = (mt0 + i) * 16 + 4 * kq;
              *(GAS v2u*)(og + 0 * 8192 + n * 128 + m0 * 2) = pack4(p7[i] + rv[i]);
              *(LAS v2u*)(L + C_QYT + n * CP + m0 * 2) = pack4(p8[i] + av[i]);
              f32x4 v = p9[i];
#pragma unroll
              for (int e = 0; e < 4; ++e) v[e] += (m0 + e == n) ? gm : 0.f;
              *(GAS v2u*)(og + 1 * 8192 + n * 128 + m0 * 2) = pack4(v);
              *(LAS v2u*)(L + C_QST + n * CP + m0 * 2) = pack4(p10[i] + kv[i]); } }
        CBAR();
        { const Fr yQy = LD(C_QYT, nt), yQs = LD(C_QST, nt);
          Fr xV[2];
#pragma unroll
          for (int i = 0; i < 2; ++i) xV[i] = LD(C_VT, mt0 + i);
          f32x4 p11[2], p12[2];
#pragma unroll
          for (int i = 0; i < 2; ++i) { p11[i] = MM(xV[i], yQy); p12[i] = MM(xV[i], yQs); }
#pragma unroll
          for (int i = 0; i < 2; ++i) { const int m0 = (mt0 + i) * 16 + 4 * kq;
              *(GAS v2u*)(og + 2 * 8192 + n * 128 + m0 * 2) = pack4(p11[i]);
              *(GAS v2u*)(og + 3 * 8192 + n * 128 + m0 * 2) = pack4(p12[i]); } }
        if (hy) tr8_finish(tX, mX, tscr, lane);
    }
}

constexpr int C2_SLOT = 20480;
__device__ __forceinline__ void p4b_scan(Frame& F0, const In& I) {
    PHASE_FRAME(F0);
    const int lane = F.lane, lr = lane & 15, kq = lane >> 4;
    const unsigned char* CHK = F.ws + WS_CHK; bf16* YS = (bf16*)(F.ws + WS_YSCAN);
    for (int unit = F.vcu; unit < BATCH * RH * 4; unit += F.G) {
        const int bh = unit >> 2, rq = unit & 3, b = bh >> 4, h = bh & 15;
        if (F.wave == 0) {
            LAS unsigned char* Sl = F.lds + 3 * C2_SLOT;
            f32x4 S[4]; bf16x8 sf[2];
#pragma unroll
            for (int nt = 0; nt < 4; ++nt) S[nt] = (f32x4){0.f, 0.f, 0.f, 0.f};
#pragma unroll
            for (int ks = 0; ks < 2; ++ks)
#pragma unroll
                for (int j = 0; j < 8; ++j) sf[ks][j] = 0;
#define C2_DMA(ck_) do { const int ckc_ = (ck_) < SEQ / 64 ? (ck_) : SEQ / 64 - 1; const unsigned char* ug = CHK + ((size_t)bh * 128 + ckc_) * CHK_UNIT_BYTES; \
                LAS unsigned char* sl_ = F.lds + ((ck_) % 3) * C2_SLOT; \
                _Pragma("unroll") for (int j = 0; j < 16; ++j) __builtin_amdgcn_global_load_lds((const unsigned*)(ug + j * 1024 + lane * 16), (LAS unsigned*)(sl_ + j * 1024), 16, 0, 0); \
                _Pragma("unroll") for (int j = 0; j < 2; ++j) { \
                    __builtin_amdgcn_global_load_lds((const unsigned*)(ug + 2 * 8192 + (j * 32 + (lane >> 1)) * 128 + rq * 32 + (lane & 1) * 16), (LAS unsigned*)(sl_ + 16384 + j * 1024), 16, 0, 0); \
                    __builtin_amdgcn_global_load_lds((const unsigned*)(ug + 3 * 8192 + (j * 32 + (lane >> 1)) * 128 + rq * 32 + (lane & 1) * 16), (LAS unsigned*)(sl_ + 18432 + j * 1024), 16, 0, 0); } } while (0)
            C2_DMA(0); C2_DMA(1);
#pragma unroll 1
            for (int ck = 0; ck < SEQ / 64; ++ck) {
                asm volatile("s_waitcnt lgkmcnt(0)" ::: "memory");
                C2_DMA(ck + 2);
                asm volatile("s_waitcnt vmcnt(40)" ::: "memory");
                const LAS unsigned char* sl_ = F.lds + (ck % 3) * C2_SLOT;
#pragma unroll
                for (int nt = 0; nt < 4; ++nt) {
                    const bf16x8 py0 = *(const LAS bf16x8*)(sl_ + (16 * nt + lr) * 128 + kq * 16), py1 = *(const LAS bf16x8*)(sl_ + (16 * nt + lr) * 128 + kq * 16 + 64);
                    const bf16x8 ps0 = *(const LAS bf16x8*)(sl_ + 8192 + (16 * nt + lr) * 128 + kq * 16), ps1 = *(const LAS bf16x8*)(sl_ + 8192 + (16 * nt + lr) * 128 + kq * 16 + 64);
                    f32x4 y = unpack4(*(const LAS v2u*)(sl_ + 16384 + (16 * nt + lr) * 32 + kq * 8));
                    f32x4 s2 = unpack4(*(const LAS v2u*)(sl_ + 18432 + (16 * nt + lr) * 32 + kq * 8));
                    y = __builtin_amdgcn_mfma_f32_16x16x32_bf16(sf[0], py0, y, 0, 0, 0); y = __builtin_amdgcn_mfma_f32_16x16x32_bf16(sf[1], py1, y, 0, 0, 0);
                    *(GAS v2u*)(YS + ((size_t)b * SEQ + (size_t)ck * 64 + 16 * nt + lr) * RW + h * 64 + rq * 16 + 4 * kq) = pack4(y);
                    s2 = __builtin_amdgcn_mfma_f32_16x16x32_bf16(sf[0], ps0, s2, 0, 0, 0); s2 = __builtin_amdgcn_mfma_f32_16x16x32_bf16(sf[1], ps1, s2, 0, 0, 0);
                    S[nt] = s2; }
#pragma unroll
                for (int nt = 0; nt < 4; ++nt)
#pragma unroll
                    for (int i = 0; i < 4; ++i) *(LAS unsigned short*)(Sl + (4 * kq + i) * CP + (16 * nt + lr) * 2) = (unsigned short)f2bf(S[nt][i]);
                LDS_WAIT(); asm volatile("" ::: "memory");
                sf[0] = *(const LAS bf16x8*)(Sl + lr * CP + kq * 16); sf[1] = *(const LAS bf16x8*)(Sl + lr * CP + kq * 16 + 64);
                LDS_WAIT(); asm volatile("" ::: "memory");
            }
            asm volatile("s_waitcnt vmcnt(0)" ::: "memory");
#undef C2_DMA
        }
    }
}
static_assert(3 * C2_SLOT + 4096 + 5 * 16640 <= TAB_OFF, "P4b LDS map");

__device__ __forceinline__ void p5_post(Frame& F0, const In& I) {
    PHASE_FRAME(F0);
    const int lane = F.lane; const int gw = F.vcu * NWAVES + F.wave, NGW = F.G * NWAVES;
    const bf16* RKV = (const bf16*)(F.ws + WS_RKV); const bf16* ICL = (const bf16*)(F.ws + WS_ICLR); const bf16* YS = (const bf16*)(F.ws + WS_YSCAN);
    const bf16* G = (const bf16*)(F.ws + WS_G); bf16* YB = (bf16*)(F.ws + WS_YB);
    const int c0 = lane * 16;
    for (int tok = gw; tok < T; tok += NGW) {
        float y[16], rr[16], kk[16], vv[16], ic[16], gg[16];
#pragma unroll
        for (int q = 0; q < 2; ++q) { const v4u a = *(const GAS v4u*)(YS + (size_t)tok * RW + c0 + 8 * q), c = *(const GAS v4u*)(ICL + (size_t)tok * RW + c0 + 8 * q);
            const unsigned aw[4] = {a.x, a.y, a.z, a.w}, cw[4] = {c.x, c.y, c.z, c.w};
#pragma unroll
            for (int e = 0; e < 4; ++e) { y[8 * q + 2 * e] = bflo(aw[e]); y[8 * q + 2 * e + 1] = bfhi(aw[e]); ic[8 * q + 2 * e] = bflo(cw[e]); ic[8 * q + 2 * e + 1] = bfhi(cw[e]); } }
#pragma unroll
        for (int q = 0; q < 2; ++q) {
            const v4u a = *(const GAS v4u*)(RKV + (size_t)tok * (3 * RW) + c0 + 8 * q), bb = *(const GAS v4u*)(RKV + (size_t)tok * (3 * RW) + RW + c0 + 8 * q),
                      c = *(const GAS v4u*)(RKV + (size_t)tok * (3 * RW) + 2 * RW + c0 + 8 * q), d = *(const GAS v4u*)(G + (size_t)tok * RW + c0 + 8 * q);
            const unsigned aw[4] = {a.x, a.y, a.z, a.w}, bw[4] = {bb.x, bb.y, bb.z, bb.w}, cw[4] = {c.x, c.y, c.z, c.w}, dw[4] = {d.x, d.y, d.z, d.w};
#pragma unroll
            for (int e = 0; e < 4; ++e) { rr[8 * q + 2 * e] = bflo(aw[e]); rr[8 * q + 2 * e + 1] = bfhi(aw[e]); kk[8 * q + 2 * e] = bflo(bw[e]); kk[8 * q + 2 * e + 1] = bfhi(bw[e]);
                vv[8 * q + 2 * e] = bflo(cw[e]); vv[8 * q + 2 * e + 1] = bfhi(cw[e]); gg[8 * q + 2 * e] = bflo(dw[e]); gg[8 * q + 2 * e + 1] = bfhi(dw[e]); } }
        float s = 0.f, bs = 0.f;
#pragma unroll
        for (int e = 0; e < 16; ++e) { s += y[e]; const float kp = kk[e] * (1.0f + (ic[e] - 1.0f) * I.k_a[c0 + e]); bs += rr[e] * kp * I.r_k[c0 + e]; }
        s = quadsum(s); bs = quadsum(bs);
        const float mean = s * (1.f / 64.f); float s2 = 0.f;
#pragma unroll
        for (int e = 0; e < 16; ++e) { y[e] -= mean; s2 += y[e] * y[e]; }
        s2 = quadsum(s2);
        const float rstd = 1.f / sqrtf(s2 * (1.f / 64.f) + GN_EPS);
        float o[16];
#pragma unroll
        for (int e = 0; e < 16; ++e) o[e] = (y[e] * rstd * I.lnx_w[c0 + e] + I.lnx_b[c0 + e] + bs * vv[e]) * gg[e];
        { unsigned w8[4];
#pragma unroll
          for (int q = 0; q < 4; ++q) { int t8 = __builtin_amdgcn_cvt_pk_fp8_f32(o[4 * q] * ACT8_SCALE, o[4 * q + 1] * ACT8_SCALE, 0, false); t8 = __builtin_amdgcn_cvt_pk_fp8_f32(o[4 * q + 2] * ACT8_SCALE, o[4 * q + 3] * ACT8_SCALE, t8, true); w8[q] = (unsigned)t8; }
          *(GAS v4u*)((unsigned char*)YB + (size_t)tok * RW + c0) = (v4u){w8[0], w8[1], w8[2], w8[3]}; }
    }
}
#ifndef STAGE
#define STAGE 4
#endif
struct Args { In in; float* out; unsigned char* ws; };
__global__ void __launch_bounds__(NWAVES * 64, 2) mk_fwd(Args args) {
    extern __shared__ __attribute__((aligned(16))) unsigned char lds[];
    Frame F;
    F.lds = (LAS unsigned char*)lds;
    F.MISC = (volatile LAS unsigned*)(F.lds + MISC_OFF);
    F.tid = threadIdx.x; F.lane = F.tid & 63; F.wave = __builtin_amdgcn_readfirstlane(F.tid >> 6);
    F.G = gridDim.x; { const int bx = blockIdx.x; F.vcu = (F.G % 8 == 0) ? (bx % 8) * (F.G / 8) + bx / 8 : bx; }
    F.ws = args.ws;
    F.rsrc = __builtin_amdgcn_make_buffer_rsrc(args.ws, 0, 0xffffffff, 0x00020000);
    F.ctl = (gu32*)(args.ws + WS_CTL);
    for (int u = F.tid; u < (LDS_BYTES - MISC_OFF) / 4; u += NWAVES * 64) ((LAS unsigned*)(F.lds + MISC_OFF))[u] = 0u;
    __syncthreads();
    XcdBarrier bar = xcd_barrier_post((unsigned*)(F.ctl + CW_BAR), F.MISC + 8);
    const In& I = args.in;
#define GRID_BAR() xcd_barrier(bar)
#ifndef DUP_PHASE
#define DUP_PHASE -1
#endif
#define RUN(n, call) do { call; if (DUP_PHASE == (n)) { GRID_BAR(); call; } } while (0)

#if STAGE >= 2
    RUN(0, p0_prologue(F, I));
    GRID_BAR();
#endif
#if STAGE >= 3
    RUN(1, p1_proj(F, I));
    GRID_BAR();
    RUN(2, p2_shift_attn(F, I));
    GRID_BAR();
#if STAGE >= 4
    RUN(3, p3_lora(F, I));
    GRID_BAR();
    RUN(4, p4a_chunk(F, I));
    GRID_BAR();
    RUN(44, p4b_scan(F, I));
    GRID_BAR();
    RUN(5, p5_post(F, I));
    GRID_BAR();
#endif
    RUN(6, p6_merged(F, I));
    GRID_BAR();
    RUN(7, p7_mix(F, I));
    GRID_BAR();
#endif
    p8_ln_router<(STAGE < 3)>(F, I);
    GRID_BAR();
#if STAGE >= 2
    p9_scatter(F, I);
    GRID_BAR();
    RUN(10, p10_moe_up(F, I));
    GRID_BAR();
    RUN(11, p11_moe_down(F, I));
    GRID_BAR();
#endif
    RUN(12, p12_final<(STAGE < 2)>(F, I, args.out));
}

extern "C" void kernel_launch(void* const* d_in, const int* in_sizes, int n_in, void* d_out, int out_size, void* d_ws, size_t ws_size, hipStream_t stream) {
    static int grid = 0;
    if (grid == 0) {
        if (n_in != 27 || in_sizes[0] != T * D || out_size != T * D || ws_size < WS_END) { fprintf(stderr, "kernel_launch: unexpected shapes (n_in %d, in0 %d, out %d, ws %zu)\n", n_in, n_in > 0 ? in_sizes[0] : -1, out_size, ws_size); grid = -1; return; }
        int dev = 0, cus = 0, per_cu = 0;
        if (hipGetDevice(&dev) != hipSuccess || hipDeviceGetAttribute(&cus, hipDeviceAttributeMultiprocessorCount, dev) != hipSuccess) { grid = -1; return; }
        if (hipFuncSetAttribute((const void*)mk_fwd, hipFuncAttributeMaxDynamicSharedMemorySize, LDS_BYTES) != hipSuccess) { fprintf(stderr, "kernel_launch: hipFuncSetAttribute failed\n"); grid = -1; return; }
        if (hipOccupancyMaxActiveBlocksPerMultiprocessor(&per_cu, (const void*)mk_fwd, NWAVES * 64, LDS_BYTES) != hipSuccess || per_cu < 1)
            fprintf(stderr, "kernel_launch: occupancy query reports %d\n", per_cu);
        (void)hipGetLastError();
        grid = cus;
    }
    if (grid < 0) return;
    if (hipMemsetAsync((char*)d_ws + WS_CTL, 0, CTL_ZERO_BYTES, stream) != hipSuccess) return;
    Args a{};
    const float** ip = (const float**)&a.in;
    for (int i = 0; i < 27; ++i) ip[i] = (const float*)d_in[i];
    a.out = (float*)d_out; a.ws = (unsigned char*)d_ws;
    hipLaunchKernelGGL(mk_fwd, dim3(grid), dim3(NWAVES * 64), LDS_BYTES, stream, a);
    const hipError_t le = hipPeekAtLastError();
    if (le != hipSuccess) fprintf(stderr, "kernel_launch: launch failed: %s\n", hipGetErrorName(le));
}
```

```cpp
#define STAGE 4
#include <hip/hip_runtime.h>
#include <cstdio>
#include <cstdint>

#define GAS __attribute__((address_space(1)))
#define LAS __attribute__((address_space(3)))
typedef unsigned short bf16;
typedef unsigned v4u __attribute__((ext_vector_type(4)));
typedef unsigned v2u __attribute__((ext_vector_type(2)));
typedef float f32x4 __attribute__((ext_vector_type(4)));
typedef float f32x2 __attribute__((ext_vector_type(2)));
typedef float f32x16 __attribute__((ext_vector_type(16)));
typedef short bf16x8 __attribute__((ext_vector_type(8)));
typedef short bf16x4 __attribute__((ext_vector_type(4)));
typedef GAS unsigned gu32;

constexpr int NWAVES = 8;
constexpr int BATCH = 4, SEQ = 8192, D = 2048, T = BATCH * SEQ;
constexpr int CHUNK = 64, LEFT = 8, AH = 16, AD = 64, AW = 1024;
constexpr int REL_TABLE = 320, MAX_PAST = 256;
constexpr int RH = 16, RN = 64, RW = 1024, DLORA = 96, ALORA = 96, GLORA = 256;
constexpr int SHIFT_W = 3 * RW + DLORA + ALORA + GLORA;
constexpr int D_IN = 3 * AW + SHIFT_W + 2 * D;
constexpr int NE = 32, TOPK = 4, FF = 2048;
constexpr int MSLOT = T * TOPK;
constexpr int NBLK_MAX = (MSLOT + NE * 255 + 255) / 256;
constexpr int RROWS = NBLK_MAX * 256;
constexpr float LN_EPS = 1e-5f, GN_EPS = 64e-5f;
constexpr float YS_SCALE = 16.0f, YS_INV = 1.0f / 16.0f;
constexpr float ACT8_SCALE = 16.0f;
constexpr float F8_CVT_SCALE = 0.015625f;
constexpr float DN_ALPHA = 1.189207115002721f;
constexpr int PROJ_LD = 9728, PJ_Q = 0, PJ_K = 1024, PJ_SEG = 2048, SEG_PAD = 3584, PJ_GA = 5632, PJ_GB = 7680;
constexpr int LORA_LD = 512;

constexpr size_t MiB = 1u << 20;
constexpr size_t WS_CTL = 0, CTL_ZERO_BYTES = 1 * MiB;
constexpr size_t WS_TOPI = 2 * MiB;
constexpr size_t WS_GATE = 3 * MiB;
constexpr size_t WS_ROWSLOT = 4 * MiB;
constexpr size_t WS_ROWW = 5 * MiB;
constexpr size_t WS_WLA = 6 * MiB;
constexpr size_t WS_WLG = 7 * MiB;
constexpr size_t WS_PAT = 8 * MiB;
constexpr size_t WS_PBT = 12 * MiB;
constexpr size_t WS_WOT = 16 * MiB;
constexpr size_t WS_WVT = 24 * MiB;
constexpr size_t WS_WINT = 28 * MiB;
constexpr size_t WS_WG8 = 72 * MiB;
constexpr size_t WS_WQK8 = 80 * MiB;
constexpr size_t WS_WV8 = 84 * MiB;
constexpr size_t WS_WGUT = 128 * MiB;
constexpr size_t WS_WDNT = 640 * MiB;
constexpr size_t WS_BASE0 = 1024 * MiB;
constexpr size_t WS_PROJ = WS_BASE0;
constexpr size_t WS_VT = WS_PROJ + 608 * MiB;
constexpr size_t WS_YA = WS_VT + 64 * MiB;
constexpr size_t WS_RKV = WS_YA + 64 * MiB;
constexpr size_t WS_LORAIN = WS_RKV + 192 * MiB;
constexpr size_t WS_DECAY = WS_LORAIN + 32 * MiB;
constexpr size_t WS_ICLR = WS_DECAY + 128 * MiB;
constexpr size_t WS_G = WS_ICLR + 128 * MiB;
constexpr size_t WS_YSCAN = WS_G + 64 * MiB;
constexpr size_t WS_YB = WS_YSCAN + 128 * MiB;
constexpr size_t WS_MERGED = WS_YB + 64 * MiB;
constexpr size_t WS_XB16 = WS_MERGED + 128 * MiB;
constexpr size_t WS_MIX_END = WS_XB16 + 128 * MiB;
constexpr size_t WS_Z = 2816 * MiB;
constexpr size_t WS_H1 = 3072 * MiB;
constexpr size_t WS_H1B = 3328 * MiB;
constexpr size_t WS_CHK = 3456 * MiB;
constexpr size_t WS_XB8 = 3712 * MiB;
constexpr size_t WS_END = 3776 * MiB;
constexpr size_t WS_XG = WS_BASE0;
constexpr size_t WS_ACT = WS_BASE0 + 544 * MiB;
constexpr size_t WS_YSLOT = WS_BASE0 + 1088 * MiB;
static_assert(WS_MIX_END <= WS_Z && WS_YSLOT + 512 * MiB <= WS_Z, "ws map");
static_assert(WS_WINT + (size_t)PROJ_LD * D * 2 <= WS_WGUT, "ws map");

constexpr int CW_CNT = 512;
constexpr int CW_CUR = 576;
constexpr int CW_BAR = 4096;

constexpr int RING_OFF = 0, RING_BYTES = 131072;
constexpr int LDS_BYTES = 160 * 1024;
constexpr int MISC_OFF = LDS_BYTES - 512;
constexpr int TAB_OFF = LDS_BYTES - 1024;

#define RLX_AGENT __ATOMIC_RELAXED, __HIP_MEMORY_SCOPE_AGENT
#define LDS_WAIT() asm volatile("s_waitcnt lgkmcnt(0)" ::: "memory")
#define VM_WAIT() asm volatile("s_waitcnt vmcnt(0)" ::: "memory")
__device__ __forceinline__ unsigned f2bf(float f) { unsigned u = __builtin_bit_cast(unsigned, f); return (u + 0x7fffu + ((u >> 16) & 1u)) >> 16; }
__device__ __forceinline__ unsigned pk2(float lo, float hi) { return f2bf(lo) | (f2bf(hi) << 16); }
__device__ __forceinline__ float bf2f(unsigned short h) { return __builtin_bit_cast(float, (unsigned)h << 16); }
__device__ __forceinline__ float bflo(unsigned w) { return __builtin_bit_cast(float, w << 16); }
__device__ __forceinline__ float bfhi(unsigned w) { return __builtin_bit_cast(float, w & 0xffff0000u); }
__device__ __forceinline__ float fsigmoid(float x) { return __builtin_amdgcn_rcpf(1.0f + __expf(-x)); }
__device__ __forceinline__ float dpp_f(float x, const int ctrl_sel) {
    const int xi = __builtin_bit_cast(int, x); int r;
    if (ctrl_sel == 0) r = __builtin_amdgcn_update_dpp(0, xi, 0xB1, 0xF, 0xF, false);
    else if (ctrl_sel == 1) r = __builtin_amdgcn_update_dpp(0, xi, 0x4E, 0xF, 0xF, false);
    else if (ctrl_sel == 2) r = __builtin_amdgcn_update_dpp(0, xi, 0x124, 0xF, 0xF, false);
    else r = __builtin_amdgcn_update_dpp(0, xi, 0x128, 0xF, 0xF, false);
    return __builtin_bit_cast(float, r);
}
__device__ __forceinline__ float rowsum16(float x) { x += dpp_f(x, 0); x += dpp_f(x, 1); x += dpp_f(x, 2); x += dpp_f(x, 3); return x; }
__device__ __forceinline__ float quadsum(float x) { x += dpp_f(x, 0); x += dpp_f(x, 1); return x; }
__device__ __forceinline__ float wave_sum(float v) {
    v = rowsum16(v);
    const int vi = __builtin_bit_cast(int, v);
    const float s0 = __builtin_bit_cast(float, __builtin_amdgcn_readlane(vi, 0)), s1 = __builtin_bit_cast(float, __builtin_amdgcn_readlane(vi, 16));
    const float s2 = __builtin_bit_cast(float, __builtin_amdgcn_readlane(vi, 32)), s3 = __builtin_bit_cast(float, __builtin_amdgcn_readlane(vi, 48));
    return (s0 + s1) + (s2 + s3);
}
namespace pg8 {
#define PG8_LAS __attribute__((address_space(3)))
typedef unsigned short bf16_t;
typedef unsigned u32x4 __attribute__((ext_vector_type(4)));
constexpr int BM = 256, BK = 64, HALF = 128, HTB = HALF * BK * 2, STAGE_BYTES = 8 * HTB, NXCD = 8, WGM = 8;

__host__ __device__ __forceinline__ int lds_byte(int r, int c) { const int st = (r >> 4) * 2 + (c >> 5), rr = r & 15, cc = c & 31, ob = rr * 64 + cc * 2; return st * 1024 + (ob ^ (((ob >> 9) & 1) << 5)); }
__host__ __device__ __forceinline__ void stage_rc(int b, int& R, int& C) { const int st = b / 1024, sb = b % 1024, swz = sb ^ (((sb >> 9) & 1) << 5); R = (st >> 1) * 16 + swz / 64; C = (st & 1) * 32 + (swz % 64) / 2; }
__host__ __device__ __forceinline__ int perm32(int rho) { const int n = rho >> 4, i = rho & 15; return 8 * (i >> 2) + 4 * n + (i & 3); }

struct Unit { int pm, pn, aux; };

struct Tiler {
    int nM, nN, nwg, G, c;
    __device__ __forceinline__ void init(int nM_, int nN_, int G_, int c_) { nM = nM_; nN = nN_; nwg = nM * nN; G = G_; c = c_; }
    __device__ __forceinline__ bool map(int i, int& pm, int& pn) const {
        const long L = (long)i * G + c; if (L >= nwg) return false;
        int wgid = (int)L; { const int q = nwg / NXCD, r = nwg % NXCD, xcd = wgid % NXCD, off = wgid / NXCD; wgid = (xcd < r ? xcd * (q + 1) : r * (q + 1) + (xcd - r) * q) + off; }
        const int nig = WGM * nN, gid = wgid / nig, fm = gid * WGM, gsz = (nM - fm) < WGM ? (nM - fm) : WGM;
        pm = fm + ((wgid % nig) % gsz); pn = (wgid % nig) / gsz; return true;
    }
};
struct SchedPlain {
    Tiler t; unsigned A, B, tsA, tsB;
    __device__ __forceinline__ bool next(int i, Unit& u) const { u.aux = 0; return t.map(i, u.pm, u.pn); }
    __device__ __forceinline__ void bases(const Unit& u, unsigned& a, unsigned& b) const { a = A + (unsigned)u.pm * tsA; b = B + (unsigned)u.pn * tsB; }
};
struct SchedTwo {
    Tiler t; unsigned A0, A1, B0, B1, tsA, tsB;
    __device__ __forceinline__ bool next(int i, Unit& u) const { u.aux = i & 1; return t.map(i >> 1, u.pm, u.pn); }
    __device__ __forceinline__ void bases(const Unit& u, unsigned& a, unsigned& b) const { a = (u.aux ? A1 : A0) + (unsigned)u.pm * tsA; b = (u.aux ? B1 : B0) + (unsigned)u.pn * tsB; }
};
struct SchedMoe {
    Tiler t; unsigned A, B, tsA, tsB, es; const PG8_LAS int* pad_end;
    __device__ __forceinline__ bool next(int i, Unit& u) const {
        if (!t.map(i, u.pm, u.pn)) return false;
        const int row0 = u.pm * BM; int e = 0;
#pragma unroll
        for (int j = 0; j < 32; ++j) e += (pad_end[j] <= row0) ? 1 : 0;
        u.aux = __builtin_amdgcn_readfirstlane(e < 31 ? e : 31); return true;
    }
    __device__ __forceinline__ void bases(const Unit& u, unsigned& a, unsigned& b) const { a = A + (unsigned)u.pm * tsA; b = B + (unsigned)u.aux * es + (unsigned)u.pn * tsB; }
};

typedef float f32x2_t_ __attribute__((ext_vector_type(2)));
typedef __bf16 bf16x2_t_ __attribute__((ext_vector_type(2)));
__device__ __forceinline__ unsigned cvt_pk_bf16(float lo, float hi) { const f32x2_t_ v = {lo, hi}; const bf16x2_t_ b = __builtin_convertvector(v, bf16x2_t_); return __builtin_bit_cast(unsigned, b); }
__device__ __forceinline__ u32x4 pack8(const f32x4& v0, const f32x4& v1) { u32x4 w; w.x = cvt_pk_bf16(v0[0], v0[1]); w.y = cvt_pk_bf16(v0[2], v0[3]); w.z = cvt_pk_bf16(v1[0], v1[1]); w.w = cvt_pk_bf16(v1[2], v1[3]); return w; }

typedef int i32x8 __attribute__((ext_vector_type(8)));
typedef int i32x4 __attribute__((ext_vector_type(4)));
__device__ __forceinline__ i32x8 cat8(const bf16x8& a, const bf16x8& b) { return __builtin_shufflevector(__builtin_bit_cast(i32x4, a), __builtin_bit_cast(i32x4, b), 0, 1, 2, 3, 4, 5, 6, 7); }
constexpr int F8_SCALES = 0x00007f79;
template <class Epi, class Sched, bool ALIGN_EPI, bool F8 = false, int F8SC = F8_SCALES>
__device__ __forceinline__ void gemm_phase(PG8_LAS unsigned char* lds, const __amdgpu_buffer_rsrc_t rsrc, const int lda, const int ldb, const int K, const Sched& S, const Epi& E) {
    int tid_ = threadIdx.x; asm volatile("" : "+v"(tid_));
    const int tid = tid_, wid = __builtin_amdgcn_readfirstlane(tid >> 6), lane = tid & 63, wr = wid >> 2, wc = wid & 3, fr = lane & 15, fq = lane >> 4;
    const int nt = K / BK;
    unsigned voffA, voffB;
    { int R, C; stage_rc(tid * 16, R, C); const int Rb = (R & ~31) + perm32(R & 31); voffA = (unsigned)(R * lda + C) * 2u; voffB = (unsigned)(Rb * ldb + C) * 2u; }
    const unsigned p1voffA = 64u * (unsigned)lda * 2u, p1voffB = 64u * (unsigned)ldb * 2u;
    const unsigned kstep = (unsigned)(BK * 2);
    const unsigned hsA = (unsigned)HALF * lda * 2, hsB = (unsigned)HALF * ldb * 2;
    const unsigned ldsw = (unsigned)wid * 1024u;
    const int aoff = lds_byte(wr * 64 + fr, fq * 8), boff = lds_byte(wc * 32 + fr, fq * 8);
#define PG8_SA(b, h) (((b) * 2 + (h)) * HTB)
#define PG8_SB(b, h) ((4 + (b) * 2 + (h)) * HTB)
#define PG8_STAGE(bufoff, goff, voff) do { _Pragma("unroll") for (int _i = 0; _i < 2; ++_i) \
        __builtin_amdgcn_raw_ptr_buffer_load_lds(rsrc, (PG8_LAS void*)(lds + (bufoff) + ldsw + _i * 8192), 16, (int)(voff), (int)((goff) + _i * p1##voff), 0, 0); } while (0)
#define PG8_LD8(addr) __builtin_shufflevector(*(const PG8_LAS i32x4*)(addr), *(const PG8_LAS i32x4*)((addr) + 1024), 0, 1, 2, 3, 4, 5, 6, 7)
#define PG8_LDA(dst, b, h) do { _Pragma("unroll") for (int m = 0; m < 4; ++m) dst[m] = PG8_LD8(lds + PG8_SA(b, h) + aoff + m * 2048); } while (0)
#define PG8_LDB(dst, b, h) do { _Pragma("unroll") for (int n = 0; n < 2; ++n) dst[n] = PG8_LD8(lds + PG8_SB(b, h) + boff + n * 2048); } while (0)
#define PG8_LO(v) __builtin_bit_cast(bf16x8, __builtin_shufflevector(v, v, 0, 1, 2, 3))
#define PG8_HI(v) __builtin_bit_cast(bf16x8, __builtin_shufflevector(v, v, 4, 5, 6, 7))
#define PG8_MMA(ai, bj, At, Bt) do { __builtin_amdgcn_s_setprio(1); \
        if constexpr (!F8) { _Pragma("unroll") for (int m = 0; m < 4; ++m) _Pragma("unroll") for (int n = 0; n < 2; ++n) { \
            acc[ai][bj][m][n] = __builtin_amdgcn_mfma_f32_16x16x32_bf16(PG8_LO(Bt[n]), PG8_LO(At[m]), acc[ai][bj][m][n], 0, 0, 0); \
            acc[ai][bj][m][n] = __builtin_amdgcn_mfma_f32_16x16x32_bf16(PG8_HI(Bt[n]), PG8_HI(At[m]), acc[ai][bj][m][n], 0, 0, 0); } } \
        else { _Pragma("unroll") for (int m = 0; m < 4; ++m) _Pragma("unroll") for (int n = 0; n < 2; ++n) \
            acc[ai][bj][m][n] = __builtin_amdgcn_mfma_scale_f32_16x16x128_f8f6f4(Bt[n], At[m], acc[ai][bj][m][n], 0, 0, 0, F8SC, 1, F8SC); } \
        __builtin_amdgcn_s_setprio(0); } while (0)
#define PG8_WAIT_V(n) asm volatile("s_waitcnt vmcnt(" #n ")" ::: "memory")
#define PG8_WAIT_L(n) asm volatile("s_waitcnt lgkmcnt(" #n ")" ::: "memory")
#define PG8_BAR __builtin_amdgcn_s_barrier()
#define PG8_SCHED __builtin_amdgcn_sched_barrier(0)
#define PG8_ZERO() do { _Pragma("unroll") for (int a = 0; a < 2; ++a) _Pragma("unroll") for (int b = 0; b < 2; ++b) _Pragma("unroll") for (int m = 0; m < 4; ++m) _Pragma("unroll") for (int n = 0; n < 2; ++n) acc[a][b][m][n] = (f32x4){0.f, 0.f, 0.f, 0.f}; } while (0)
    Unit cur, nxt; int ui = 0;
    if (!S.next(0, cur)) return;
    f32x4 acc[2][2][4][2];
    PG8_ZERO();
    i32x8 At[4], B0[2], B1[2];
    unsigned cA, cB; S.bases(cur, cA, cB); cA = __builtin_amdgcn_readfirstlane(cA); cB = __builtin_amdgcn_readfirstlane(cB);
    PG8_STAGE(PG8_SB(0, 0), cB, voffB); PG8_STAGE(PG8_SB(0, 1), cB + hsB, voffB); PG8_STAGE(PG8_SA(0, 0), cA, voffA); PG8_STAGE(PG8_SA(0, 1), cA + hsA, voffA);
    if (wr == 1) PG8_BAR;
    PG8_WAIT_V(2); PG8_BAR;
    PG8_STAGE(PG8_SB(1, 0), cB + kstep, voffB); PG8_STAGE(PG8_SA(1, 0), cA + kstep, voffA); PG8_STAGE(PG8_SB(1, 1), cB + hsB + kstep, voffB);
    PG8_WAIT_V(6); PG8_BAR;
    for (;;) {
        const bool has_next = S.next(ui + 1, nxt);
        unsigned nA = cA, nB = cB; if (has_next) { S.bases(nxt, nA, nB); nA = __builtin_amdgcn_readfirstlane(nA); nB = __builtin_amdgcn_readfirstlane(nB); }
#pragma unroll 1
        for (int t = 0; t < nt; t += 2) {
            const bool last = (t == nt - 2);
            const unsigned a1 = cA + (unsigned)(t + 1) * kstep;
            const unsigned a2 = last ? nA : cA + (unsigned)(t + 2) * kstep, b2 = last ? nB : cB + (unsigned)(t + 2) * kstep;
            const unsigned a3 = a2 + kstep, b3 = b2 + kstep;
            PG8_LDB(B0, 0, 0); PG8_LDB(B1, 0, 1); PG8_SCHED; PG8_LDA(At, 0, 0); PG8_STAGE(PG8_SA(1, 1), a1 + hsA, voffA);
            PG8_WAIT_V(8); PG8_WAIT_L(0); PG8_BAR; PG8_MMA(0, 0, At, B0); PG8_MMA(0, 1, At, B1); PG8_BAR; PG8_SCHED;
            PG8_LDA(At, 0, 1); PG8_STAGE(PG8_SB(0, 0), b2, voffB); PG8_STAGE(PG8_SB(0, 1), b2 + hsB, voffB); PG8_STAGE(PG8_SA(0, 0), a2, voffA);
            PG8_WAIT_V(8); PG8_WAIT_L(0); PG8_BAR; PG8_MMA(1, 0, At, B0); PG8_MMA(1, 1, At, B1); PG8_BAR; PG8_SCHED;
            PG8_LDB(B0, 1, 0); PG8_LDB(B1, 1, 1); PG8_SCHED; PG8_LDA(At, 1, 0); PG8_STAGE(PG8_SA(0, 1), a2 + hsA, voffA);
            PG8_WAIT_V(8); PG8_WAIT_L(0); PG8_BAR; PG8_MMA(0, 0, At, B0); PG8_MMA(0, 1, At, B1); PG8_BAR; PG8_SCHED;
            PG8_LDA(At, 1, 1); PG8_STAGE(PG8_SB(1, 0), b3, voffB); PG8_STAGE(PG8_SB(1, 1), b3 + hsB, voffB); PG8_STAGE(PG8_SA(1, 0), a3, voffA);
            PG8_WAIT_V(8); PG8_WAIT_L(0); PG8_BAR; PG8_MMA(1, 0, At, B0); PG8_MMA(1, 1, At, B1); PG8_BAR; PG8_SCHED;
        }
        if constexpr (ALIGN_EPI) { if (wr == 0) PG8_BAR; }
        bool keep; { int t2 = threadIdx.x; asm volatile("" : "+v"(t2)); const int w2 = __builtin_amdgcn_readfirstlane(t2 >> 6), l2 = t2 & 63; keep = E(acc, cur, w2 >> 2, w2 & 3, l2 & 15, l2 >> 4); }
        if (!has_next) break;
        if (!keep) PG8_ZERO();
        cur = nxt; cA = nA; cB = nB; ++ui;
        if constexpr (ALIGN_EPI) { if (wr == 1) PG8_BAR; }
    }
    PG8_WAIT_V(0);
    if constexpr (!ALIGN_EPI) { if (wr == 0) PG8_BAR; }
    PG8_BAR;
#undef PG8_SA
#undef PG8_SB
#undef PG8_STAGE
#undef PG8_LDA
#undef PG8_LDB
#undef PG8_LD8
#undef PG8_LO
#undef PG8_HI
#undef PG8_MMA
#undef PG8_WAIT_V
#undef PG8_WAIT_L
#undef PG8_BAR
#undef PG8_SCHED
#undef PG8_ZERO
}
}
namespace pg8 {
#define EPI_ROWLOOP _Pragma("unroll") for (int ai = 0; ai < 2; ++ai) _Pragma("unroll") for (int m = 0; m < 4; ++m)
struct EpiProj {
    bf16_t* O; int coloff, nq;
    __device__ __forceinline__ bool operator()(f32x4 (&acc)[2][2][4][2], const Unit& u, int wr, int wc, int fr, int fq) const {
        const int row0 = u.pm * BM + wr * 64 + fr, col0 = coloff + u.pn * BM + wc * 32 + 8 * fq;
        const float sc = (u.pn < nq) ? 0.125f : 1.0f;
        EPI_ROWLOOP { bf16_t* rowp = O + (size_t)(row0 + ai * HALF + m * 16) * PROJ_LD + col0;
#pragma unroll
            for (int bj = 0; bj < 2; ++bj) *(u32x4*)(rowp + bj * HALF) = pack8(acc[ai][bj][m][0] * sc, acc[ai][bj][m][1] * sc); }
        return false;
    }
};
struct EpiGate {
    bf16_t* O;
    __device__ __forceinline__ bool operator()(f32x4 (&acc)[2][2][4][2], const Unit& u, int wr, int wc, int fr, int fq) const {
        const int row0 = u.pm * BM + wr * 64 + fr, d0 = u.pn * HALF + wc * 32 + 8 * fq;
        EPI_ROWLOOP { bf16_t* rowp = O + (size_t)(row0 + ai * HALF + m * 16) * PROJ_LD + d0;
            f32x4 rt[2], gb[2];
#pragma unroll
            for (int n = 0; n < 2; ++n)
#pragma unroll
                for (int j = 0; j < 4; ++j) { const float ea = __expf(-acc[ai][0][m][n][j]), eb = fminf(__expf(-acc[ai][1][m][n][j]), 1e30f);
                    gb[n][j] = __builtin_amdgcn_rcpf(1.0f + eb); rt[n][j] = (1.0f + eb) * __builtin_amdgcn_rcpf(1.0f + ea); }
            *(u32x4*)(rowp + PJ_GA) = pack8(rt[0], rt[1]); *(u32x4*)(rowp + PJ_GB) = pack8(gb[0], gb[1]); }
        return false;
    }
};
struct EpiBf16 {
    bf16_t* O; int ldc;
    __device__ __forceinline__ bool operator()(f32x4 (&acc)[2][2][4][2], const Unit& u, int wr, int wc, int fr, int fq) const {
        const int row0 = u.pm * BM + wr * 64 + fr, col0 = u.pn * BM + wc * 32 + 8 * fq;
        EPI_ROWLOOP { bf16_t* rowp = O + (size_t)(row0 + ai * HALF + m * 16) * ldc + col0;
#pragma unroll
            for (int bj = 0; bj < 2; ++bj) *(u32x4*)(rowp + bj * HALF) = pack8(acc[ai][bj][m][0], acc[ai][bj][m][1]); }
        return false;
    }
};
template <bool ISDEC> struct EpiLoraA {
    float* OUT; const float* par;
    __device__ __forceinline__ bool operator()(f32x4 (&acc)[2][2][4][2], const Unit& u, int wr, int wc, int fr, int fq) const {
        const int row0 = u.pm * BM + wr * 64 + fr, col0 = u.pn * BM + wc * 32 + 8 * fq;
        f32x4 pv[2][2];
#pragma unroll
        for (int bj = 0; bj < 2; ++bj)
#pragma unroll
            for (int n = 0; n < 2; ++n) pv[bj][n] = *(const f32x4*)(par + col0 + bj * HALF + 4 * n);
        EPI_ROWLOOP { float* rowp = OUT + (size_t)(row0 + ai * HALF + m * 16) * RW + col0;
#pragma unroll
            for (int bj = 0; bj < 2; ++bj)
#pragma unroll
                for (int n = 0; n < 2; ++n) { f32x4 v = acc[ai][bj][m][n] + pv[bj][n];
#pragma unroll
                    for (int j = 0; j < 4; ++j) {
                        if (ISDEC) v[j] = -0.60653065971263342f * fsigmoid(v[j]);
                        else v[j] = fsigmoid(v[j]); }
                    *(f32x4*)(rowp + bj * HALF + 4 * n) = v; } }
        return false;
    }
};
struct EpiIclr {
    bf16_t* OUT; const float* par;
    __device__ __forceinline__ bool operator()(f32x4 (&acc)[2][2][4][2], const Unit& u, int wr, int wc, int fr, int fq) const {
        const int row0 = u.pm * BM + wr * 64 + fr, col0 = u.pn * BM + wc * 32 + 8 * fq;
        f32x4 pv[2][2];
#pragma unroll
        for (int bj = 0; bj < 2; ++bj)
#pragma unroll
            for (int n = 0; n < 2; ++n) pv[bj][n] = *(const f32x4*)(par + col0 + bj * HALF + 4 * n);
        EPI_ROWLOOP { bf16_t* rowp = OUT + (size_t)(row0 + ai * HALF + m * 16) * RW + col0;
#pragma unroll
            for (int bj = 0; bj < 2; ++bj) { f32x4 v0 = acc[ai][bj][m][0] + pv[bj][0], v1 = acc[ai][bj][m][1] + pv[bj][1];
#pragma unroll
                for (int j = 0; j < 4; ++j) { v0[j] = fsigmoid(v0[j]); v1[j] = fsigmoid(v1[j]); }
                *(u32x4*)(rowp + bj * HALF) = pack8(v0, v1); } }
        return false;
    }
};
struct EpiMerged {
    const bf16_t* PROJ; bf16_t* O;
    __device__ __forceinline__ bool operator()(f32x4 (&acc)[2][2][4][2], const Unit& u, int wr, int wc, int fr, int fq) const {
        const int row0 = u.pm * BM + wr * 64 + fr, col0 = u.pn * BM + wc * 32 + 8 * fq;
        EPI_ROWLOOP { const int row = row0 + ai * HALF + m * 16; const bf16_t* gp = PROJ + (size_t)row * PROJ_LD + col0;
#pragma unroll
            for (int bj = 0; bj < 2; ++bj) {
                if (u.aux == 0) {
                    const u32x4 ga = *(const u32x4*)(gp + PJ_GA + bj * HALF);
                    const f32x4 a0 = (f32x4){bflo(ga.x), bfhi(ga.x), bflo(ga.y), bfhi(ga.y)}, a1 = (f32x4){bflo(ga.z), bfhi(ga.z), bflo(ga.w), bfhi(ga.w)};
                    acc[ai][bj][m][0] = acc[ai][bj][m][0] * a0; acc[ai][bj][m][1] = acc[ai][bj][m][1] * a1;
                } else {
                    const u32x4 gb = *(const u32x4*)(gp + PJ_GB + bj * HALF);
                    const f32x4 b0 = (f32x4){bflo(gb.x), bfhi(gb.x), bflo(gb.y), bfhi(gb.y)}, b1 = (f32x4){bflo(gb.z), bfhi(gb.z), bflo(gb.w), bfhi(gb.w)};
                    { const f32x4 o0 = acc[ai][bj][m][0] * b0 * ACT8_SCALE, o1 = acc[ai][bj][m][1] * b1 * ACT8_SCALE;
                      int w0 = __builtin_amdgcn_cvt_pk_fp8_f32(o0[0], o0[1], 0, false); w0 = __builtin_amdgcn_cvt_pk_fp8_f32(o0[2], o0[3], w0, true);
                      int w1 = __builtin_amdgcn_cvt_pk_fp8_f32(o1[0], o1[1], 0, false); w1 = __builtin_amdgcn_cvt_pk_fp8_f32(o1[2], o1[3], w1, true);
                      *(v2u*)((unsigned char*)O + (size_t)row * D + col0 + bj * HALF) = (v2u){(unsigned)w0, (unsigned)w1}; }
                } } }
        return u.aux == 0;
    }
};
struct EpiZ {
    const float* X; float* Z;
    __device__ __forceinline__ bool operator()(f32x4 (&acc)[2][2][4][2], const Unit& u, int wr, int wc, int fr, int fq) const {
        const int row0 = u.pm * BM + wr * 64 + fr, col0 = u.pn * BM + wc * 32 + 8 * fq;
        EPI_ROWLOOP { const size_t off = (size_t)(row0 + ai * HALF + m * 16) * D + col0;
#pragma unroll
            for (int bj = 0; bj < 2; ++bj)
#pragma unroll
                for (int n = 0; n < 2; ++n) { const f32x4 xv = *(const f32x4*)(X + off + bj * HALF + 4 * n); *(f32x4*)(Z + off + bj * HALF + 4 * n) = xv * DN_ALPHA + acc[ai][bj][m][n]; } }
        return false;
    }
};
struct EpiSwiglu {
    unsigned char* ACT; const float* bgu;
    __device__ __forceinline__ bool operator()(f32x4 (&acc)[2][2][4][2], const Unit& u, int wr, int wc, int fr, int fq) const {
        const int row0 = u.pm * BM + wr * 64 + fr, col0 = u.pn * HALF + wc * 32 + 8 * fq;
        const float* bp = bgu + (size_t)u.aux * (2 * FF) + col0;
        f32x4 bg[2], bu[2];
#pragma unroll
        for (int n = 0; n < 2; ++n) { bg[n] = *(const f32x4*)(bp + 4 * n); bu[n] = *(const f32x4*)(bp + FF + 4 * n); }
        EPI_ROWLOOP { f32x4 o[2];
#pragma unroll
            for (int n = 0; n < 2; ++n) { const f32x4 g = acc[ai][0][m][n] + bg[n], uu = acc[ai][1][m][n] + bu[n];
#pragma unroll
                for (int j = 0; j < 4; ++j) { const float gc = fminf(g[j], 7.0f), uc = fminf(fmaxf(uu[j], -7.0f), 7.0f); o[n][j] = (uc + 1.0f) * (gc * fsigmoid(1.702f * gc)); } }
            int w0 = __builtin_amdgcn_cvt_pk_fp8_f32(o[0][0], o[0][1], 0, false); w0 = __builtin_amdgcn_cvt_pk_fp8_f32(o[0][2], o[0][3], w0, true);
            int w1 = __builtin_amdgcn_cvt_pk_fp8_f32(o[1][0], o[1][1], 0, false); w1 = __builtin_amdgcn_cvt_pk_fp8_f32(o[1][2], o[1][3], w1, true);
            *(v2u*)(ACT + (size_t)(row0 + ai * HALF + m * 16) * FF + col0) = (v2u){(unsigned)w0, (unsigned)w1}; }
        return false;
    }
};
struct EpiDown {
    unsigned char* YS; const float* bdn; const int* rowslot; const float* roww;
    __device__ __forceinline__ bool operator()(f32x4 (&acc)[2][2][4][2], const Unit& u, int wr, int wc, int fr, int fq) const {
        const int row0 = u.pm * BM + wr * 64 + fr, col0 = u.pn * BM + wc * 32 + 8 * fq;
        const float* bp = bdn + (size_t)u.aux * D + col0;
        f32x4 bv[2][2];
#pragma unroll
        for (int bj = 0; bj < 2; ++bj)
#pragma unroll
            for (int n = 0; n < 2; ++n) bv[bj][n] = *(const f32x4*)(bp + bj * HALF + 4 * n);
        EPI_ROWLOOP { const int row = row0 + ai * HALF + m * 16; const int slot = rowslot[row]; const float w = roww[row] * YS_SCALE;
            if (slot >= 0) { unsigned char* rowp = YS + (size_t)slot * D + col0;
#pragma unroll
                for (int bj = 0; bj < 2; ++bj) { const f32x4 o0 = (acc[ai][bj][m][0] + bv[bj][0]) * w, o1 = (acc[ai][bj][m][1] + bv[bj][1]) * w;
                    int w0 = __builtin_amdgcn_cvt_pk_fp8_f32(o0[0], o0[1], 0, false); w0 = __builtin_amdgcn_cvt_pk_fp8_f32(o0[2], o0[3], w0, true);
                    int w1 = __builtin_amdgcn_cvt_pk_fp8_f32(o1[0], o1[1], 0, false); w1 = __builtin_amdgcn_cvt_pk_fp8_f32(o1[2], o1[3], w1, true);
                    *(v2u*)(rowp + bj * HALF) = (v2u){(unsigned)w0, (unsigned)w1}; } } }
        return false;
    }
};
#undef EPI_ROWLOOP
}

#define XB_TMO      128
#define XB_XCNT(j)  (256  + 64 * (j))
#define XB_XSUB(j)  (1280 + 64 * (j))
#define XB_XGEN(j)  (2304 + 64 * (j))
#define XB_TOP      3328
#define XB_TOPGEN   3392
#define XCD_BAR_WORDS 3456
#define XB_SPIN_CAP (1u << 18)

__device__ __forceinline__ unsigned xb_ld(unsigned* p)              { return __hip_atomic_load(p, __ATOMIC_RELAXED, __HIP_MEMORY_SCOPE_AGENT); }
__device__ __forceinline__ unsigned xb_add(unsigned* p, unsigned v) { return __hip_atomic_fetch_add(p, v, __ATOMIC_RELAXED, __HIP_MEMORY_SCOPE_AGENT); }
__device__ __forceinline__ unsigned xb_xcc_id() { return (unsigned)__builtin_amdgcn_s_getreg((3 << 11) | 20) & 0xFu; }
#define XB_SPIN(cond, bar) do { unsigned _sp = 0; while (cond) { __builtin_amdgcn_s_sleep(1); \
    if ((++_sp & 255u) == 0u) { if (xb_ld(&(bar)[XB_TMO])) break; if (_sp > XB_SPIN_CAP) { atomicAdd(&(bar)[XB_TMO], 1u); break; } } } } while (0)

struct XcdBarrier {
    unsigned* bar; unsigned x;
    volatile LAS unsigned* st;
};

__device__ __forceinline__ XcdBarrier xcd_barrier_post(unsigned* bar, volatile LAS unsigned* st) {
    XcdBarrier b; b.bar = bar; b.x = xb_xcc_id(); b.st = st;
    if (threadIdx.x == 0) (void)xb_add(&bar[XB_XCNT(b.x)], 1u);
    return b;
}
__device__ __forceinline__ void xcd_barrier_complete(unsigned* bar, unsigned x, unsigned& nloc, unsigned& nx) {
    const unsigned G = gridDim.x * gridDim.y * gridDim.z;
    unsigned sum, cnt, mine, sp = 0u;
    for (;;) {
        sum = 0u; cnt = 0u; mine = 0u;
#pragma unroll
        for (unsigned j = 0; j < 16; ++j) { const unsigned c = xb_ld(&bar[XB_XCNT(j)]); sum += c; cnt += (c > 0u) ? 1u : 0u; mine = (j == x) ? c : mine; }
        if (sum == G) break;
        __builtin_amdgcn_s_sleep(1);
        if ((++sp & 255u) == 0u) { if (xb_ld(&bar[XB_TMO])) break; if (sp > XB_SPIN_CAP) { atomicAdd(&bar[XB_TMO], 1u); break; } }
    }
    nloc = mine > 0u ? mine : 1u; nx = cnt > 0u ? cnt : 1u;
}

__device__ __forceinline__ void xcd_barrier(const XcdBarrier& b) {
    asm volatile("s_waitcnt vmcnt(0)" ::: "memory");
    __syncthreads();
    if (threadIdx.x == 0) {
        unsigned* bar = b.bar;
        __builtin_amdgcn_s_waitcnt(0);
        unsigned nloc = b.st[0], nx = b.st[1];
        if (nloc == 0u) { xcd_barrier_complete(bar, b.x, nloc, nx); b.st[0] = nloc; b.st[1] = nx; }
        const unsigned old = xb_add(&bar[XB_XSUB(b.x)], 1u);
        const unsigned gen = old / nloc;
        if (old + 1u == (gen + 1u) * nloc) {
            __builtin_amdgcn_fence(__ATOMIC_RELEASE, "agent");
            asm volatile("s_waitcnt vmcnt(0)" ::: "memory");
            const unsigned og = xb_add(&bar[XB_TOP], 1u);
            const unsigned tg = og / nx;
            if (og + 1u == (tg + 1u) * nx) xb_add(&bar[XB_TOPGEN], 1u);
            else XB_SPIN(xb_ld(&bar[XB_TOPGEN]) == tg, bar);
            __builtin_amdgcn_fence(__ATOMIC_ACQUIRE, "agent");
            xb_add(&bar[XB_XGEN(b.x)], 1u);
            asm volatile("s_waitcnt vmcnt(0)" ::: "memory");
        } else {
            XB_SPIN(xb_ld(&bar[XB_XGEN(b.x)]) == gen, bar);
            __builtin_amdgcn_fence(__ATOMIC_ACQUIRE, "agent");
            asm volatile("s_waitcnt vmcnt(0)" ::: "memory");
        }
    }
    __syncthreads();
}
struct Frame {
    LAS unsigned char* lds;
    volatile LAS unsigned* MISC;
    gu32* ctl;
    int tid, lane, wave;
    int vcu, G;
    unsigned char* ws;
    __amdgpu_buffer_rsrc_t rsrc;
};

#define PHASE_FRAME(F0) Frame F = (F0); { int t_ = threadIdx.x; asm volatile("" : "+v"(t_)); F.tid = t_; F.lane = t_ & 63; F.wave = __builtin_amdgcn_readfirstlane(t_ >> 6); }

__device__ __forceinline__ void tr_item(const float* W, size_t ldw, int k0, int c0, bf16* WT, size_t ldt, int drow0, LAS float* scr, int lane) {
    const int kr = lane >> 4, cq = lane & 15;
    f32x4 v[16];
#pragma unroll
    for (int i = 0; i < 16; ++i) v[i] = *(const GAS f32x4*)(W + (size_t)(k0 + 4 * i + kr) * ldw + c0 + 4 * cq);
#pragma unroll
    for (int i = 0; i < 16; ++i)
#pragma unroll
        for (int j = 0; j < 4; ++j) scr[(4 * cq + j) * 65 + 4 * i + kr] = v[i][j];
    LDS_WAIT(); asm volatile("" ::: "memory");
    const int c = lane & 7;
#pragma unroll
    for (int jj = 0; jj < 8; ++jj) { const int n = (lane >> 3) + 8 * jj; const LAS float* s = scr + n * 65 + 8 * c;
        v4u o; o.x = pk2(s[0], s[1]); o.y = pk2(s[2], s[3]); o.z = pk2(s[4], s[5]); o.w = pk2(s[6], s[7]);
        *(GAS v4u*)(WT + (size_t)(drow0 + n) * ldt + k0 + 8 * c) = o; }
    LDS_WAIT(); asm volatile("" ::: "memory");
}

typedef short s16x2 __attribute__((ext_vector_type(2)));
struct MoeItem { __amdgpu_buffer_rsrc_t rs; unsigned soff, rstep; int ldw, k0; unsigned char* WT; size_t ldt; int drow; };
__device__ __forceinline__ void tr8_load(const MoeItem& m, f32x4 (&v)[16], int lane) {
    const int kr = lane >> 4, cq = lane & 15;
    const int voff = (kr * m.ldw + 4 * cq) * 4;
#pragma unroll
    for (int i = 0; i < 16; ++i) v[i] = __builtin_bit_cast(f32x4, __builtin_amdgcn_raw_buffer_load_b128(m.rs, voff, (int)(m.soff + (unsigned)i * m.rstep), 0));
}
__device__ __forceinline__ void tr8_finish(const f32x4 (&v)[16], const MoeItem& m, LAS float* scr_, int lane) {
    LAS unsigned char* scr = (LAS unsigned char*)scr_;
    const int kr = lane >> 4, cq = lane & 15;
#pragma unroll
    for (int j = 0; j < 4; ++j) { unsigned w[4];
#pragma unroll
        for (int q = 0; q < 4; ++q) { s16x2 t = {0, 0};
            t = __builtin_amdgcn_cvt_scalef32_pk_fp8_f32(t, v[4 * q][j], v[4 * q + 1][j], F8_CVT_SCALE, false);
            t = __builtin_amdgcn_cvt_scalef32_pk_fp8_f32(t, v[4 * q + 2][j], v[4 * q + 3][j], F8_CVT_SCALE, true);
            w[q] = __builtin_bit_cast(unsigned, t); }
        *(LAS v4u*)(scr + (4 * cq + j) * 80 + kr * 16) = (v4u){w[0], w[1], w[2], w[3]}; }
    LDS_WAIT(); asm volatile("" ::: "memory");
    const int qd = lane & 3;
#pragma unroll
    for (int ps = 0; ps < 4; ++ps) { const int n = (lane >> 2) + 16 * ps; const LAS unsigned char* s = scr + n * 80 + qd * 4;
        const unsigned d0 = *(const LAS unsigned*)(s), d1 = *(const LAS unsigned*)(s + 16), d2 = *(const LAS unsigned*)(s + 32), d3 = *(const LAS unsigned*)(s + 48);
        const unsigned t0 = __builtin_amdgcn_perm(d1, d0, 0x05010400u), t1 = __builtin_amdgcn_perm(d1, d0, 0x07030602u), t2 = __builtin_amdgcn_perm(d3, d2, 0x05010400u), t3 = __builtin_amdgcn_perm(d3, d2, 0x07030602u);
        const v4u o = (v4u){__builtin_amdgcn_perm(t2, t0, 0x05040100u), __builtin_amdgcn_perm(t2, t0, 0x07060302u), __builtin_amdgcn_perm(t3, t1, 0x05040100u), __builtin_amdgcn_perm(t3, t1, 0x07060302u)};
        *(GAS v4u*)(m.WT + (size_t)(m.drow + n) * m.ldt + m.k0 + 16 * qd) = o; }
    LDS_WAIT(); asm volatile("" ::: "memory");
}
constexpr int MOE_J4 = 32 * 32 * 64, MOE_J5 = 32 * 32 * 32, MOE_NITEMS = MOE_J4 + MOE_J5;
__device__ __forceinline__ MoeItem moe_item(int r, const float* w_gu, const float* w_down, unsigned char* ws) {
    MoeItem m;
    if (r < MOE_J4) { const int e = r / 2048, q = r % 2048, kb = q / 64, cb = q % 64, c0 = cb * 64; const int cc = c0 & 2047;
        m.rs = __builtin_amdgcn_make_buffer_rsrc((void*)w_gu, 0, 0xffffffff, 0x00020000); m.ldw = 2 * FF; m.k0 = kb * 64;
        m.soff = (unsigned)(((size_t)e * D * 2 * FF + (size_t)kb * 64 * (2 * FF) + c0) * 4); m.rstep = 4u * (2 * FF) * 4u;
        m.WT = ws + WS_WGUT + (size_t)e * 2 * FF * D; m.ldt = D; m.drow = (cc >> 7) * 256 + (c0 >= 2048 ? 128 : 0) + (cc & 127); }
    else { r -= MOE_J4; const int e = r / 1024, q = r % 1024, kb = q / 32, cb = q % 32;
        m.rs = __builtin_amdgcn_make_buffer_rsrc((void*)w_down, 0, 0xffffffff, 0x00020000); m.ldw = D; m.k0 = kb * 64;
        m.soff = (unsigned)(((size_t)e * FF * D + (size_t)kb * 64 * D + cb * 64) * 4); m.rstep = 4u * D * 4u;
        m.WT = ws + WS_WDNT + (size_t)e * D * FF; m.ldt = FF; m.drow = cb * 64; }
    return m;
}
__device__ __forceinline__ MoeItem f8_item(const float* W, int ldw, int k0, int c0, unsigned char* WT, size_t ldt, int drow) {
    MoeItem m; m.rs = __builtin_amdgcn_make_buffer_rsrc((void*)W, 0, 0xffffffff, 0x00020000); m.ldw = ldw; m.k0 = k0;
    m.soff = (unsigned)(((size_t)k0 * ldw + c0) * 4); m.rstep = 4u * (unsigned)ldw * 4u; m.WT = WT; m.ldt = ldt; m.drow = drow; return m;
}

struct In {
    const float *x, *w_in, *rel_bias, *shift_mu, *w0, *w_up, *a0, *a_up, *g_up, *k_k, *k_a, *r_k, *lnx_w, *lnx_b, *proj_a, *proj_b, *w_out,
                *ln1_w, *ln1_b, *w_router, *b_router, *w_gu, *b_gu, *w_down, *b_down, *ln2_w, *ln2_b;
};

__device__ __forceinline__ void p0_prologue(Frame& F0, const In& I) {
    PHASE_FRAME(F0);
    LAS float* scr = (LAS float*)(F.lds + F.wave * 16640);
    const int gw = F.vcu * NWAVES + F.wave, NGW = F.G * NWAVES;
    unsigned char* ws = F.ws;
    constexpr int J0 = 32 * 167, J1 = 16 * 32, J2 = 16 * 32, J3 = 32 * 32;
    constexpr int NITEMS = J0 + J1 + J2 + J3;
    for (int it = gw; it < NITEMS; it += NGW) {
        int r = it;
        if (r < J0) { const int kb = r / 167, cb = r % 167, c0 = cb * 64; bf16* dst; int drow;
            if (c0 < 3072) { f32x4 tv[16];
                   const MoeItem m = (c0 < 2048) ? f8_item(I.w_in, D_IN, kb * 64, c0, (unsigned char*)(ws + WS_WQK8), D, c0) : f8_item(I.w_in, D_IN, kb * 64, c0, (unsigned char*)(ws + WS_WV8), D, c0 - 2048);
                   tr8_load(m, tv, F.lane); tr8_finish(tv, m, scr, F.lane); continue; }
            else if (c0 < 6592) { dst = (bf16*)(ws + WS_WINT); drow = PJ_SEG + (c0 - 3072); }
            else { f32x4 tv[16]; const int cg = c0 - 6592, d0 = cg & 2047; const MoeItem m = f8_item(I.w_in, D_IN, kb * 64, c0, (unsigned char*)(ws + WS_WG8), D, (d0 >> 7) * 256 + (cg >= 2048 ? 128 : 0) + (d0 & 127));
                   tr8_load(m, tv, F.lane); tr8_finish(tv, m, scr, F.lane); continue; }
            tr_item(I.w_in, D_IN, kb * 64, c0, dst, D, drow, scr, F.lane); continue; } r -= J0;
        if (r < J1) { const int kb = r / 32, cb = r % 32; f32x4 tv[16]; const MoeItem m = f8_item(I.proj_a, D, kb * 64, cb * 64, (unsigned char*)(ws + WS_PAT), AW, cb * 64); tr8_load(m, tv, F.lane); tr8_finish(tv, m, scr, F.lane); continue; } r -= J1;
        if (r < J2) { const int kb = r / 32, cb = r % 32; f32x4 tv[16]; const MoeItem m = f8_item(I.proj_b, D, kb * 64, cb * 64, (unsigned char*)(ws + WS_PBT), RW, cb * 64); tr8_load(m, tv, F.lane); tr8_finish(tv, m, scr, F.lane); continue; } r -= J2;
        { const int kb = r / 32, cb = r % 32; f32x4 tv[16]; const MoeItem m = f8_item(I.w_out, D, kb * 64, cb * 64, (unsigned char*)(ws + WS_WOT), D, cb * 64);
          tr8_load(m, tv, F.lane); tr8_finish(tv, m, scr, F.lane); }
    }
    const int gt = F.vcu * (NWAVES * 64) + F.tid, NGT = F.G * NWAVES * 64;
    for (int i = gt; i < 2048 * 256; i += NGT) { const int n = i >> 8, k = i & 255; float v = 0.f;
        if (n < 1024) { if (k < DLORA) v = I.w_up[(size_t)k * RW + n]; }
        else { if (k >= 128 && k < 128 + ALORA) v = I.a_up[(size_t)(k - 128) * RW + (n - 1024)]; }
        ((bf16*)(ws + WS_WLA))[i] = (bf16)f2bf(v); }
    for (int i = gt; i < 1024 * 256; i += NGT) { const int n = i >> 8, k = i & 255; ((bf16*)(ws + WS_WLG))[i] = (bf16)f2bf(I.g_up[(size_t)k * RW + n]); }
    for (int i = gt; i < 64 * D / 8; i += NGT) ((GAS v4u*)((bf16*)(ws + WS_WINT) + (size_t)(PJ_SEG + SHIFT_W) * D))[i] = (v4u){0u, 0u, 0u, 0u};
    for (int i = gt; i < RROWS; i += NGT) ((int*)(ws + WS_ROWSLOT))[i] = -1;
    for (size_t i = gt; i < (size_t)T * D / 8; i += NGT) { const f32x4 a = ((const GAS f32x4*)I.x)[2 * i], b = ((const GAS f32x4*)I.x)[2 * i + 1];
        v4u o; o.x = pk2(a.x, a.y); o.y = pk2(a.z, a.w); o.z = pk2(b.x, b.y); o.w = pk2(b.z, b.w); ((GAS v4u*)(ws + WS_XB16))[i] = o;
        int w0 = __builtin_amdgcn_cvt_pk_fp8_f32(a.x, a.y, 0, false); w0 = __builtin_amdgcn_cvt_pk_fp8_f32(a.z, a.w, w0, true);
        int w1 = __builtin_amdgcn_cvt_pk_fp8_f32(b.x, b.y, 0, false); w1 = __builtin_amdgcn_cvt_pk_fp8_f32(b.z, b.w, w1, true);
        ((GAS v2u*)(ws + WS_XB8))[i] = (v2u){(unsigned)w0, (unsigned)w1}; }
}

constexpr int P8_HS = 0, P8_PITCH = 2052, P8_PART = 131328, P8_LOG = 147712, P8_HIST = 149760;
template <bool SKIP_MIX>
__device__ __forceinline__ void p8_ln_router(Frame& F0, const In& I) {
    PHASE_FRAME(F0);
    LAS float* hs = (LAS float*)(F.lds + P8_HS); LAS float* part = (LAS float*)(F.lds + P8_PART); LAS float* lg = (LAS float*)(F.lds + P8_LOG); LAS int* hist = (LAS int*)(F.lds + P8_HIST);
    const int lane = F.lane, w = F.wave;
    if (F.tid < 32) hist[F.tid] = 0;
    const int kq = lane >> 4, col = lane & 15;
    float ln_w[32], ln_b[32];
#pragma unroll
    for (int j = 0; j < 8; ++j) { const f32x4 a = *(const GAS f32x4*)(I.ln1_w + 4 * lane + 256 * j), b = *(const GAS f32x4*)(I.ln1_b + 4 * lane + 256 * j);
#pragma unroll
        for (int e = 0; e < 4; ++e) { ln_w[4 * j + e] = a[e]; ln_b[4 * j + e] = b[e]; } }
    __syncthreads();
    const float* zsrc = I.x; const bf16* mixb = (const bf16*)(F.ws + WS_Z);
    for (int g = F.vcu; g < T / 16; g += F.G) {
        const int tok0 = g * 16;
        { f32x4 va[8], vb[8];
          const size_t tokA = (size_t)(tok0 + 2 * w), tokB = tokA + 1;
          const GAS f32x4* zra = (const GAS f32x4*)(zsrc + tokA * D) + lane; const GAS f32x4* zrb = (const GAS f32x4*)(zsrc + tokB * D) + lane;
          const GAS v2u* mra = (const GAS v2u*)(mixb + tokA * D) + lane; const GAS v2u* mrb = (const GAS v2u*)(mixb + tokB * D) + lane;
          v2u ma[8], mb[8];
#pragma unroll
          for (int j = 0; j < 8; ++j) { va[j] = zra[64 * j]; vb[j] = zrb[64 * j]; if (!SKIP_MIX) { ma[j] = mra[64 * j]; mb[j] = mrb[64 * j]; } }
#pragma unroll
          for (int j = 0; j < 8; ++j) { va[j] = va[j] * DN_ALPHA; vb[j] = vb[j] * DN_ALPHA;
              if (!SKIP_MIX) { va[j] += (f32x4){bflo(ma[j].x), bfhi(ma[j].x), bflo(ma[j].y), bfhi(ma[j].y)}; vb[j] += (f32x4){bflo(mb[j].x), bfhi(mb[j].x), bflo(mb[j].y), bfhi(mb[j].y)}; } }
#pragma unroll
          for (int tt = 0; tt < 2; ++tt) {
            const int tl = 2 * w + tt; const size_t tok = (size_t)(tok0 + tl);
            f32x4 v[8]; float s = 0.f;
#pragma unroll
            for (int j = 0; j < 8; ++j) { v[j] = tt ? vb[j] : va[j]; s += (v[j].x + v[j].y) + (v[j].z + v[j].w); }
            const float mean = wave_sum(s) * (1.f / D); float s2 = 0.f;
#pragma unroll
            for (int j = 0; j < 8; ++j) { v[j] = v[j] - mean; s2 += (v[j].x * v[j].x + v[j].y * v[j].y) + (v[j].z * v[j].z + v[j].w * v[j].w); }
            const float rstd = 1.f / sqrtf(wave_sum(s2) * (1.f / D) + LN_EPS);
            GAS v2u* h1 = (GAS v2u*)((bf16*)(F.ws + WS_H1) + tok * D) + lane;
            GAS unsigned* h1b = (GAS unsigned*)((unsigned char*)(F.ws + WS_H1B) + tok * D) + lane;
#pragma unroll
            for (int j = 0; j < 8; ++j) { f32x4 h;
#pragma unroll
                for (int e = 0; e < 4; ++e) h[e] = v[j][e] * rstd * ln_w[4 * j + e] + ln_b[4 * j + e];
                h1[64 * j] = (v2u){pg8::cvt_pk_bf16(h.x, h.y), pg8::cvt_pk_bf16(h.z, h.w)}; { int w8 = __builtin_amdgcn_cvt_pk_fp8_f32(h.x, h.y, 0, false); w8 = __builtin_amdgcn_cvt_pk_fp8_f32(h.z, h.w, w8, true); h1b[64 * j] = (unsigned)w8; }
                *(LAS f32x4*)(hs + tl * P8_PITCH + 4 * lane + 256 * j) = h; }
          } }
        __syncthreads();
        f32x4 c0 = (f32x4){0.f, 0.f, 0.f, 0.f}, c1 = c0;
        const LAS float* ap = hs + col * P8_PITCH + 256 * w + 4 * kq;
        const float* bp = I.w_router + (size_t)(256 * w + 4 * kq) * NE + col;
#pragma unroll 4
        for (int kk = 0; kk < 16; ++kk) {
            const f32x4 a = *(const LAS f32x4*)(ap + 16 * kk);
#pragma unroll
            for (int e = 0; e < 4; ++e) {
                const float b0 = bp[(size_t)(16 * kk + e) * NE], b1 = bp[(size_t)(16 * kk + e) * NE + 16];
                c0 = __builtin_amdgcn_mfma_f32_16x16x4f32(a[e], b0, c0, 0, 0, 0);
                c1 = __builtin_amdgcn_mfma_f32_16x16x4f32(a[e], b1, c1, 0, 0, 0);
            }
        }
#pragma unroll
        for (int i = 0; i < 4; ++i) { part[(w * 16 + 4 * kq + i) * 32 + col] = c0[i]; part[(w * 16 + 4 * kq + i) * 32 + 16 + col] = c1[i]; }
        __syncthreads();
        { const int tl = F.tid >> 5, e = F.tid & 31; float s = I.b_router[e];
#pragma unroll
            for (int ww = 0; ww < 8; ++ww) s += part[(ww * 16 + tl) * 32 + e];
            lg[tl * 32 + e] = s; }
        __syncthreads();
        if (F.tid < 16) {
            const int tl = F.tid; float lv[32];
#pragma unroll
            for (int e = 0; e < 32; ++e) lv[e] = lg[tl * 32 + e];
            int ti[4]; float tv[4];
#pragma unroll
            for (int k = 0; k < 4; ++k) { float best = -3.4e38f; int bi = 0;
#pragma unroll
                for (int e = 0; e < 32; ++e) { const bool tk = lv[e] > best; best = tk ? lv[e] : best; bi = tk ? e : bi; }
                ti[k] = bi; tv[k] = best;
#pragma unroll
                for (int e = 0; e < 32; ++e) lv[e] = (e == bi) ? -3.4e38f : lv[e]; }
            float ex[4], sum = 0.f;
#pragma unroll
            for (int k = 0; k < 4; ++k) { ex[k] = __expf(tv[k] - tv[0]); sum += ex[k]; }
            const float inv = 1.f / sum;
            *(GAS v4u*)((int*)(F.ws + WS_TOPI) + (size_t)(tok0 + tl) * 4) = (v4u){(unsigned)ti[0], (unsigned)ti[1], (unsigned)ti[2], (unsigned)ti[3]};
            *(GAS f32x4*)((float*)(F.ws + WS_GATE) + (size_t)(tok0 + tl) * 4) = (f32x4){ex[0] * inv, ex[1] * inv, ex[2] * inv, ex[3] * inv};
#pragma unroll
            for (int k = 0; k < 4; ++k) __hip_atomic_fetch_add(&hist[ti[k]], 1, __ATOMIC_RELAXED, __HIP_MEMORY_SCOPE_WORKGROUP);
        }
        __syncthreads();
    }
    if (F.tid < 32) { const int c = hist[F.tid]; if (c) __hip_atomic_fetch_add(F.ctl + CW_CNT + F.tid, (unsigned)c, RLX_AGENT); }
}

template <bool SKIP_MOE>
__device__ __forceinline__ void p12_final(Frame& F0, const In& I, float* out) {
    PHASE_FRAME(F0);
    const int lane = F.lane; const int gw = F.vcu * NWAVES + F.wave, NGW = F.G * NWAVES;
    float ln_w[32], ln_b[32];
#pragma unroll
    for (int j = 0; j < 8; ++j) { const f32x4 a = *(const GAS f32x4*)(I.ln2_w + 4 * lane + 256 * j), b = *(const GAS f32x4*)(I.ln2_b + 4 * lane + 256 * j);
#pragma unroll
        for (int e = 0; e < 4; ++e) { ln_w[4 * j + e] = a[e]; ln_b[4 * j + e] = b[e]; } }
    for (int tok = gw; tok < T; tok += NGW) {
        const GAS v2u* hr = (const GAS v2u*)((const bf16*)(F.ws + WS_H1) + (size_t)tok * D) + lane;
        f32x4 v[8]; float s = 0.f;
#pragma unroll
        for (int j = 0; j < 8; ++j) { const v2u hh = hr[64 * j]; v[j] = (f32x4){bflo(hh.x), bfhi(hh.x), bflo(hh.y), bfhi(hh.y)} * DN_ALPHA; }
        if (!SKIP_MOE) {
#pragma unroll
            for (int k = 0; k < 4; ++k) { const GAS unsigned* yr = (const GAS unsigned*)((const unsigned char*)(F.ws + WS_YSLOT) + ((size_t)tok * 4 + k) * D) + lane;
#pragma unroll
                for (int j = 0; j < 8; ++j) { const unsigned y = yr[64 * j]; const f32x2 lo = __builtin_amdgcn_cvt_pk_f32_fp8((int)y, false), hi = __builtin_amdgcn_cvt_pk_f32_fp8((int)y, true);
                    v[j].x += lo.x * YS_INV; v[j].y += lo.y * YS_INV; v[j].z += hi.x * YS_INV; v[j].w += hi.y * YS_INV; } }
        }
#pragma unroll
        for (int j = 0; j < 8; ++j) s += (v[j].x + v[j].y) + (v[j].z + v[j].w);
        const float mean = wave_sum(s) * (1.f / D); float s2 = 0.f;
#pragma unroll
        for (int j = 0; j < 8; ++j) { v[j] = v[j] - mean; s2 += (v[j].x * v[j].x + v[j].y * v[j].y) + (v[j].z * v[j].z + v[j].w * v[j].w); }
        const float rstd = 1.f / sqrtf(wave_sum(s2) * (1.f / D) + LN_EPS);
        GAS f32x4* o = (GAS f32x4*)(out + (size_t)tok * D) + lane;
#pragma unroll
        for (int j = 0; j < 8; ++j) { f32x4 h;
#pragma unroll
            for (int e = 0; e < 4; ++e) h[e] = v[j][e] * rstd * ln_w[4 * j + e] + ln_b[4 * j + e];
            o[64 * j] = h; }
    }
}
__device__ __forceinline__ void moe_tables(Frame& F) {
    LAS int* tab = (LAS int*)(F.lds + TAB_OFF);
    if (F.tid == 0) { int run = 0;
        for (int e = 0; e < NE; ++e) { const int c = (int)__hip_atomic_load(F.ctl + CW_CNT + e, RLX_AGENT); const int p = (c + 255) / 256 * 256; tab[32 + e] = run; run += p; tab[e] = run; }
        tab[64] = run / 256; }
    __syncthreads();
}

__device__ __forceinline__ void p9_scatter(Frame& F0, const In& I) {
    PHASE_FRAME(F0);
    moe_tables(F);
    LAS int* tab = (LAS int*)(F.lds + TAB_OFF);
    LAS int* lh = (LAS int*)(F.lds + 0);
    LAS int* lb = (LAS int*)(F.lds + 128);
    LAS int* dst = (LAS int*)(F.lds + 256);
    const int* topi = (const int*)(F.ws + WS_TOPI); const float* gate = (const float*)(F.ws + WS_GATE);
    for (int ch = F.vcu; ch < T / 128; ch += F.G) {
        if (F.tid < 32) lh[F.tid] = 0;
        __syncthreads();
        const int s = ch * 512 + F.tid; const int e = topi[s]; const float gv = gate[s];
        const int rank = __hip_atomic_fetch_add(&lh[e], 1, __ATOMIC_RELAXED, __HIP_MEMORY_SCOPE_WORKGROUP);
        __syncthreads();
        if (F.tid < 32) { const int c = lh[F.tid]; lb[F.tid] = c ? (int)__hip_atomic_fetch_add(F.ctl + CW_CUR + F.tid, (unsigned)c, RLX_AGENT) : 0; }
        __syncthreads();
        const int d = tab[32 + e] + lb[e] + rank;
        ((int*)(F.ws + WS_ROWSLOT))[d] = s; ((float*)(F.ws + WS_ROWW))[d] = gv; dst[F.tid] = d;
        __syncthreads();
#pragma unroll 1
        for (int i0 = F.wave * 64; i0 < F.wave * 64 + 64; i0 += 8) {
            v4u v[8][2]; int dd[8];
#pragma unroll
            for (int q = 0; q < 8; ++q) { const int i = i0 + q; const int tok = ch * 128 + (i >> 2); dd[q] = dst[i];
                const GAS v4u* src = (const GAS v4u*)((const unsigned char*)(F.ws + WS_H1B) + (size_t)tok * D) + F.lane;
                v[q][0] = src[0]; v[q][1] = src[64]; }
#pragma unroll
            for (int q = 0; q < 8; ++q) { GAS v4u* o = (GAS v4u*)((unsigned char*)(F.ws + WS_XG) + (size_t)dd[q] * D) + F.lane; o[0] = v[q][0]; o[64] = v[q][1]; }
        }
        __syncthreads();
    }
}

__device__ __forceinline__ void p10_moe_up(Frame& F0, const In& I) {
    PHASE_FRAME(F0);
    moe_tables(F);
    LAS int* tab = (LAS int*)(F.lds + TAB_OFF);
    pg8::SchedMoe S; S.t.init(tab[64], 16, F.G, (int)blockIdx.x);
    S.A = (unsigned)(WS_XG); S.B = (unsigned)(WS_WGUT); S.tsA = (unsigned)256 * D; S.tsB = (unsigned)256 * D; S.es = (unsigned)2 * FF * D; S.pad_end = tab;
    pg8::EpiSwiglu E{(unsigned char*)(F.ws + WS_ACT), I.b_gu};
    pg8::gemm_phase<pg8::EpiSwiglu, pg8::SchedMoe, true, true>(F.lds + RING_OFF, F.rsrc, D / 2, D / 2, D / 2, S, E);
}
__device__ __forceinline__ void p11_moe_down(Frame& F0, const In& I) {
    PHASE_FRAME(F0);
    moe_tables(F);
    LAS int* tab = (LAS int*)(F.lds + TAB_OFF);
    pg8::SchedMoe S; S.t.init(tab[64], 8, F.G, (int)blockIdx.x);
    S.A = (unsigned)(WS_ACT); S.B = (unsigned)(WS_WDNT); S.tsA = (unsigned)256 * FF; S.tsB = (unsigned)256 * FF; S.es = (unsigned)D * FF; S.pad_end = tab;
    pg8::EpiDown E{(unsigned char*)(F.ws + WS_YSLOT), I.b_down, (const int*)(F.ws + WS_ROWSLOT), (const float*)(F.ws + WS_ROWW)};
    pg8::gemm_phase<pg8::EpiDown, pg8::SchedMoe, true, true>(F.lds + RING_OFF, F.rsrc, FF / 2, FF / 2, FF / 2, S, E);
}

__device__ __forceinline__ void p1_proj(Frame& F0, const In& I) {
    PHASE_FRAME(F0);
    { pg8::SchedPlain S; S.t.init(T / 256, SEG_PAD / 256, F.G, (int)blockIdx.x);
      S.A = (unsigned)(WS_XB16); S.B = (unsigned)(WS_WINT + (size_t)PJ_SEG * D * 2); S.tsA = (unsigned)256 * D * 2; S.tsB = (unsigned)256 * D * 2;
      pg8::EpiProj E{(bf16*)(F.ws + WS_PROJ), PJ_SEG, 0};
      pg8::gemm_phase<pg8::EpiProj, pg8::SchedPlain, true>(F.lds + RING_OFF, F.rsrc, D, D, D, S, E); }
    { pg8::SchedPlain S; S.t.init(T / 256, (2 * AW) / 256, F.G, (int)blockIdx.x);
      S.A = (unsigned)(WS_XB8); S.B = (unsigned)(WS_WQK8); S.tsA = (unsigned)256 * D; S.tsB = (unsigned)256 * D;
      pg8::EpiProj E{(bf16*)(F.ws + WS_PROJ), 0, 4};
      pg8::gemm_phase<pg8::EpiProj, pg8::SchedPlain, true, true>(F.lds + RING_OFF, F.rsrc, D / 2, D / 2, D / 2, S, E); }
    { pg8::SchedPlain S; S.t.init(T / 256, (2 * D) / 256, F.G, (int)blockIdx.x);
      S.A = (unsigned)(WS_XB8); S.B = (unsigned)(WS_WG8); S.tsA = (unsigned)256 * D; S.tsB = (unsigned)256 * D;
      pg8::EpiGate E{(bf16*)(F.ws + WS_PROJ)};
      pg8::gemm_phase<pg8::EpiGate, pg8::SchedPlain, true, true>(F.lds + RING_OFF, F.rsrc, D / 2, D / 2, D / 2, S, E); }
    { pg8::SchedPlain S; S.t.init(AW / 256, T / 256, F.G, (int)blockIdx.x);
      S.A = (unsigned)(WS_WV8); S.B = (unsigned)(WS_XB8); S.tsA = (unsigned)256 * D; S.tsB = (unsigned)256 * D;
      pg8::EpiBf16 E{(bf16*)(F.ws + WS_VT), T};
      pg8::gemm_phase<pg8::EpiBf16, pg8::SchedPlain, true, true>(F.lds + RING_OFF, F.rsrc, D / 2, D / 2, D / 2, S, E); }
}

__device__ __forceinline__ float ftanh(float x) { return 2.0f * fsigmoid(2.0f * x) - 1.0f; }
__device__ __forceinline__ void p2_shift_attn(Frame& F0, const In& I) {
    PHASE_FRAME(F0);
    const int lane = F.lane; const int gw = F.vcu * NWAVES + F.wave, NGW = F.G * NWAVES;
    const bf16* PROJ = (const bf16*)(F.ws + WS_PROJ);
    for (int tok = gw; tok < T; tok += NGW) {
        const bool first = (tok % SEQ) == 0;
        const bf16* cur = PROJ + (size_t)tok * PROJ_LD + PJ_SEG; const bf16* prv = cur - PROJ_LD;
        bf16* rkv = (bf16*)(F.ws + WS_RKV) + (size_t)tok * (3 * RW); bf16* lin = (bf16*)(F.ws + WS_LORAIN) + (size_t)tok * LORA_LD;
#pragma unroll 1
        for (int it = 0; it < 7; ++it) { const int gi = it * 64 + lane; if (gi >= SHIFT_W / 8) break; const int c = gi * 8;
            const v4u cv = *(const GAS v4u*)(cur + c); v4u pv = (v4u){0u, 0u, 0u, 0u}; if (!first) pv = *(const GAS v4u*)(prv + c);
            const f32x4 m0 = *(const GAS f32x4*)(I.shift_mu + c), m1 = *(const GAS f32x4*)(I.shift_mu + c + 4);
            float v[8]; const unsigned cw[4] = {cv.x, cv.y, cv.z, cv.w}, pw[4] = {pv.x, pv.y, pv.z, pv.w};
#pragma unroll
            for (int j = 0; j < 4; ++j) { const float c0 = bflo(cw[j]), c1 = bfhi(cw[j]), p0 = bflo(pw[j]), p1 = bfhi(pw[j]); const float mu0 = (j < 2) ? m0[2 * j] : m1[2 * j - 4], mu1 = (j < 2) ? m0[2 * j + 1] : m1[2 * j - 3];
                v[2 * j] = c0 + (p0 - c0) * mu0; v[2 * j + 1] = c1 + (p1 - c1) * mu1; }
            bf16* dstp;
            if (c < 3 * RW) dstp = rkv + c;
            else if (c < 3 * RW + DLORA) { dstp = lin + (c - 3 * RW);
#pragma unroll
                for (int j = 0; j < 8; ++j) v[j] = ftanh(v[j]); }
            else if (c < 3 * RW + DLORA + ALORA) dstp = lin + 128 + (c - 3 * RW - DLORA);
            else { dstp = lin + 256 + (c - 3 * RW - DLORA - ALORA);
#pragma unroll
                for (int j = 0; j < 8; ++j) v[j] = fsigmoid(v[j]); }
            *(GAS v4u*)dstp = (v4u){pk2(v[0], v[1]), pk2(v[2], v[3]), pk2(v[4], v[5]), pk2(v[6], v[7])};
        }
        if (lane < 8) { const int c = (lane < 4) ? (DLORA + 8 * lane) : (128 + ALORA + 8 * (lane - 4)); *(GAS v4u*)(lin + c) = (v4u){0u, 0u, 0u, 0u}; }
    }
#if STAGE == 3
    { const int gt = F.vcu * (NWAVES * 64) + F.tid, NGT = F.G * NWAVES * 64;
      for (size_t i = gt; i < (size_t)T * RW / 8; i += NGT) ((GAS v4u*)(F.ws + WS_YB))[i] = (v4u){0u, 0u, 0u, 0u}; }
#endif
    LAS float* tbl = (LAS float*)(F.lds + 0);
    constexpr int AKV = 64 * 144, A_KOFF = 2048, A_VOFF = A_KOFF + 2 * AKV;
    const bf16* VT = (const bf16*)(F.ws + WS_VT); bf16* YA = (bf16*)(F.ws + WS_YA);
    const int r = lane & 31, hh = lane >> 5;
    const int rp = (r & 16) + 8 * ((r >> 2) & 1) + 4 * ((r >> 3) & 1) + (r & 3);
    const int srow = F.tid >> 3, spc = F.tid & 7;
    for (int task = F.vcu; task < BATCH * AH * (SEQ / 256); task += F.G) {
        const int bh = task >> 5, q256 = task & 31, b = bh >> 4, h = bh & 15, c0 = q256 * 4;
        const int q0 = q256 * 256 + F.wave * 32, cw = c0 + (F.wave >> 1);
        const int kc_lo = (c0 > LEFT) ? c0 - LEFT : 0, kc_hi = c0 + 3;
        __syncthreads();
        if (F.tid < REL_TABLE) tbl[F.tid] = I.rel_bias[h * REL_TABLE + F.tid];
        const size_t tokq = (size_t)b * SEQ + q0 + r;
        bf16x8 qf[4];
#pragma unroll
        for (int s = 0; s < 4; ++s) qf[s] = *(const GAS bf16x8*)(PROJ + tokq * PROJ_LD + PJ_Q + h * 64 + 16 * s + 8 * hh);
        f32x16 o0, o1;
#pragma unroll
        for (int i = 0; i < 16; ++i) { o0[i] = 0.f; o1[i] = 0.f; }
        float m_run = -1e30f, l_run = 0.f;
        v4u kreg, vreg;
#define AT_STAGE_LOAD(kc_) do { kreg = *(const GAS v4u*)(PROJ + ((size_t)b * SEQ + (size_t)(kc_) * 64 + srow) * PROJ_LD + PJ_K + h * 64 + spc * 8); \
                                vreg = *(const GAS v4u*)(VT + (size_t)(h * 64 + srow) * T + (size_t)b * SEQ + (size_t)(kc_) * 64 + spc * 8); } while (0)
#define AT_STAGE_WRITE(buf_) do { *(LAS v4u*)(F.lds + A_KOFF + (buf_) * AKV + srow * 144 + spc * 16) = kreg; *(LAS v4u*)(F.lds + A_VOFF + (buf_) * AKV + srow * 144 + spc * 16) = vreg; } while (0)
        AT_STAGE_LOAD(kc_lo); AT_STAGE_WRITE(0);
        __syncthreads();
#pragma unroll 1
        for (int kc = kc_lo; kc <= kc_hi; ++kc) {
            const int buf = (kc - kc_lo) & 1;
            if (kc < kc_hi) AT_STAGE_LOAD(kc + 1);
            if (kc >= cw - LEFT && kc <= cw) {
                const LAS unsigned char* Kb = F.lds + A_KOFF + buf * AKV; const LAS unsigned char* Vb = F.lds + A_VOFF + buf * AKV;
#pragma unroll
                for (int tt = 0; tt < 2; ++tt) {
                    const int kpos0 = kc * 64 + 32 * tt;
                    bf16x8 kf[4], va[2], vb[2];
#pragma unroll
                    for (int s = 0; s < 4; ++s) kf[s] = *(const LAS bf16x8*)(Kb + (32 * tt + rp) * 144 + 32 * s + 16 * hh);
#pragma unroll
                    for (int s2 = 0; s2 < 2; ++s2) { va[s2] = *(const LAS bf16x8*)(Vb + r * 144 + 64 * tt + 32 * s2 + 16 * hh); vb[s2] = *(const LAS bf16x8*)(Vb + (32 + r) * 144 + 64 * tt + 32 * s2 + 16 * hh); }
                    f32x16 st;
#pragma unroll
                    for (int i = 0; i < 16; ++i) st[i] = 0.f;
#pragma unroll
                    for (int s = 0; s < 4; ++s) st = __builtin_amdgcn_mfma_f32_32x32x16_bf16(kf[s], qf[s], st, 0, 0, 0);
                    const int dbase = (q0 + r) - (kpos0 + 8 * hh);
                    float mx = -1e30f;
                    if (q0 - (kpos0 + 31) >= MAX_PAST) {
                        const float bc = tbl[MAX_PAST + 63];
#pragma unroll
                        for (int i = 0; i < 16; ++i) { st[i] += bc; mx = fmaxf(mx, st[i]); }
                    } else {
#pragma unroll
                        for (int i = 0; i < 16; ++i) { int d = dbase - (16 * (i >> 3) + 4 * ((i >> 2) & 1) + (i & 3)); d = d < MAX_PAST ? d : MAX_PAST; st[i] += tbl[d + 63]; mx = fmaxf(mx, st[i]); }
                    }
                    mx = fmaxf(mx, __shfl_xor(mx, 32));
                    const float m_new = fmaxf(m_run, mx), alpha = __expf(m_run - m_new);
                    float ls = 0.f;
#pragma unroll
                    for (int i = 0; i < 16; ++i) { st[i] = __expf(st[i] - m_new); ls += st[i]; }
                    l_run = l_run * alpha + ls;
                    if (__builtin_amdgcn_ballot_w64(m_new != m_run)) {
#pragma unroll
                        for (int i = 0; i < 16; ++i) { o0[i] *= alpha; o1[i] *= alpha; } }
                    m_run = m_new;
#pragma unroll
                    for (int s2 = 0; s2 < 2; ++s2) {
                        v4u pw; pw.x = pg8::cvt_pk_bf16(st[8 * s2 + 0], st[8 * s2 + 1]); pw.y = pg8::cvt_pk_bf16(st[8 * s2 + 2], st[8 * s2 + 3]); pw.z = pg8::cvt_pk_bf16(st[8 * s2 + 4], st[8 * s2 + 5]); pw.w = pg8::cvt_pk_bf16(st[8 * s2 + 6], st[8 * s2 + 7]);
                        const bf16x8 pf = __builtin_bit_cast(bf16x8, pw);
                        o0 = __builtin_amdgcn_mfma_f32_32x32x16_bf16(va[s2], pf, o0, 0, 0, 0);
                        o1 = __builtin_amdgcn_mfma_f32_32x32x16_bf16(vb[s2], pf, o1, 0, 0, 0);
                    }
                }
            }
            if (kc < kc_hi) AT_STAGE_WRITE(buf ^ 1);
            __syncthreads();
        }
#undef AT_STAGE_LOAD
#undef AT_STAGE_WRITE
        const float inv = 1.0f / (l_run + __shfl_xor(l_run, 32));
        unsigned char* yo = (unsigned char*)YA + tokq * AW + h * 64 + 4 * hh;
        const float inv16 = inv * ACT8_SCALE;
#pragma unroll
        for (int g4 = 0; g4 < 4; ++g4) {
            int w0 = __builtin_amdgcn_cvt_pk_fp8_f32(o0[4 * g4] * inv16, o0[4 * g4 + 1] * inv16, 0, false); w0 = __builtin_amdgcn_cvt_pk_fp8_f32(o0[4 * g4 + 2] * inv16, o0[4 * g4 + 3] * inv16, w0, true);
            int w1 = __builtin_amdgcn_cvt_pk_fp8_f32(o1[4 * g4] * inv16, o1[4 * g4 + 1] * inv16, 0, false); w1 = __builtin_amdgcn_cvt_pk_fp8_f32(o1[4 * g4 + 2] * inv16, o1[4 * g4 + 3] * inv16, w1, true);
            *(GAS unsigned*)(yo + 8 * g4) = (unsigned)w0; *(GAS unsigned*)(yo + 32 + 8 * g4) = (unsigned)w1;
        }
    }
}

__device__ __forceinline__ void p6_merged(Frame& F0, const In& I) {
    PHASE_FRAME(F0);
    pg8::SchedTwo S; S.t.init(T / 256, D / 256, F.G, (int)blockIdx.x);
    S.A0 = (unsigned)(WS_YA); S.A1 = (unsigned)(WS_YB); S.B0 = (unsigned)(WS_PAT); S.B1 = (unsigned)(WS_PBT);
    S.tsA = (unsigned)256 * AW; S.tsB = (unsigned)256 * AW;
    pg8::EpiMerged E{(const bf16*)(F.ws + WS_PROJ), (bf16*)(F.ws + WS_MERGED)};
    pg8::gemm_phase<pg8::EpiMerged, pg8::SchedTwo, true, true, 0x00007b79>(F.lds + RING_OFF, F.rsrc, AW / 2, AW / 2, AW / 2, S, E);
}
__device__ __forceinline__ void p7_mix(Frame& F0, const In& I) {
    PHASE_FRAME(F0);
    pg8::SchedPlain S; S.t.init(T / 256, D / 256, F.G, (int)blockIdx.x);
    S.A = (unsigned)(WS_MERGED); S.B = (unsigned)(WS_WOT); S.tsA = (unsigned)256 * D; S.tsB = (unsigned)256 * D;
    pg8::EpiBf16 E{(bf16*)(F.ws + WS_Z), D};
    pg8::gemm_phase<pg8::EpiBf16, pg8::SchedPlain, true, true, 0x00007b79>(F.lds + RING_OFF, F.rsrc, D / 2, D / 2, D / 2, S, E);
}

__device__ __forceinline__ void p3_lora(Frame& F0, const In& I) {
    PHASE_FRAME(F0);
    { pg8::SchedPlain S; S.t.init(T / 256, 4, F.G, (int)blockIdx.x);
      S.A = (unsigned)(WS_LORAIN); S.B = (unsigned)(WS_WLA); S.tsA = (unsigned)256 * LORA_LD * 2; S.tsB = (unsigned)256 * 256 * 2;
      pg8::EpiLoraA<true> E{(float*)(F.ws + WS_DECAY), I.w0};
      pg8::gemm_phase<pg8::EpiLoraA<true>, pg8::SchedPlain, true>(F.lds + RING_OFF, F.rsrc, LORA_LD, 256, 256, S, E); }
    { pg8::SchedPlain S; S.t.init(T / 256, 4, F.G, (int)blockIdx.x);
      S.A = (unsigned)(WS_LORAIN); S.B = (unsigned)(WS_WLA + (size_t)1024 * 256 * 2); S.tsA = (unsigned)256 * LORA_LD * 2; S.tsB = (unsigned)256 * 256 * 2;
      pg8::EpiIclr E{(bf16*)(F.ws + WS_ICLR), I.a0};
      pg8::gemm_phase<pg8::EpiIclr, pg8::SchedPlain, true>(F.lds + RING_OFF, F.rsrc, LORA_LD, 256, 256, S, E); }
    { pg8::SchedPlain S; S.t.init(T / 256, 4, F.G, (int)blockIdx.x);
      S.A = (unsigned)(WS_LORAIN + 512); S.B = (unsigned)(WS_WLG); S.tsA = (unsigned)256 * LORA_LD * 2; S.tsB = (unsigned)256 * 256 * 2;
      pg8::EpiBf16 E{(bf16*)(F.ws + WS_G), RW};
      pg8::gemm_phase<pg8::EpiBf16, pg8::SchedPlain, true>(F.lds + RING_OFF, F.rsrc, LORA_LD, 256, 256, S, E); }
}

constexpr int CP = 144;
constexpr int CMAT = 64 * CP;
constexpr int C_RT = 0 * CMAT, C_ATT = 1 * CMAT, C_AAK = 2 * CMAT, C_ARKT = 3 * CMAT, C_WA = 4 * CMAT, C_WB = 6 * CMAT,
              C_MA = 8 * CMAT, C_MTA = 9 * CMAT, C_MB = 10 * CMAT, C_MTB = 11 * CMAT, C_SEG = 12 * CMAT, C_GAM = C_SEG + 8 * 64 * 4, C_TSCR = C_GAM + 256;
constexpr int C_AT = C_WB, C_BT = C_WB + CMAT, C_KT = C_MB, C_QYT = C_MA, C_QST = C_MTA, C_KHT = C_MTB, C_VT = C_WB;
static_assert(C_TSCR % 16 == 0 && C_TSCR + 8 * 5120 <= TAB_OFF, "P4a LDS map");
constexpr int CHK_UNIT_BYTES = 4 * 64 * 64 * 2;
#define CBAR() do { asm volatile("s_waitcnt lgkmcnt(0)" ::: "memory"); __builtin_amdgcn_s_barrier(); asm volatile("" ::: "memory"); } while (0)
template <int NT, class Epi>
__device__ __forceinline__ void cmm(const LAS unsigned char* X, const LAS unsigned char* Y, int mt0, int nt, int lane, const Epi& E) {
    const int lr = lane & 15, kq = lane >> 4;
    const bf16x8 b0 = *(const LAS bf16x8*)(Y + (nt * 16 + lr) * CP + kq * 16), b1 = *(const LAS bf16x8*)(Y + (nt * 16 + lr) * CP + kq * 16 + 64);
#pragma unroll
    for (int i = 0; i < NT; ++i) { const int mt = mt0 + i;
        const bf16x8 a0 = *(const LAS bf16x8*)(X + (mt * 16 + lr) * CP + kq * 16), a1 = *(const LAS bf16x8*)(X + (mt * 16 + lr) * CP + kq * 16 + 64);
        f32x4 acc = (f32x4){0.f, 0.f, 0.f, 0.f};
        acc = __builtin_amdgcn_mfma_f32_16x16x32_bf16(a0, b0, acc, 0, 0, 0);
        acc = __builtin_amdgcn_mfma_f32_16x16x32_bf16(a1, b1, acc, 0, 0, 0);
        E(mt, nt, acc); }
}
__device__ __forceinline__ v2u pack4(const f32x4& v) { return (v2u){pg8::cvt_pk_bf16(v[0], v[1]), pg8::cvt_pk_bf16(v[2], v[3])}; }
__device__ __forceinline__ f32x4 unpack4(const v2u w) { return (f32x4){bflo(w.x), bfhi(w.x), bflo(w.y), bfhi(w.y)}; }
__device__ __forceinline__ void p4a_chunk(Frame& F0, const In& I) {
    PHASE_FRAME(F0);
    LAS unsigned char* L = F.lds;
    const int lane = F.lane, w = F.wave, lr = lane & 15, kq = lane >> 4;
    const bf16* RKV = (const bf16*)(F.ws + WS_RKV); const float* LW = (const float*)(F.ws + WS_DECAY); const bf16* ICL = (const bf16*)(F.ws + WS_ICLR);
    unsigned char* CHK = F.ws + WS_CHK;
    int uit = 0;
    for (int unit = F.vcu; unit < BATCH * RH * (SEQ / 64); unit += F.G, ++uit) {
        const int bh = unit >> 7, ck = unit & 127, b = bh >> 4, h = bh & 15;
        const size_t tok0 = (size_t)b * SEQ + (size_t)ck * 64 + 8 * w;
        const int hc = h * 64 + lane;
        float lwv[8], ic[8], rr[8], kk[8], vv[8];
#pragma unroll
        for (int i = 0; i < 8; ++i) { const size_t tok = tok0 + i; lwv[i] = LW[tok * RW + hc]; ic[i] = bf2f(ICL[tok * RW + hc]);
            rr[i] = bf2f(RKV[tok * (3 * RW) + hc]); kk[i] = bf2f(RKV[tok * (3 * RW) + RW + hc]); vv[i] = bf2f(RKV[tok * (3 * RW) + 2 * RW + hc]); }
        const float kkp = I.k_k[hc], kap = I.k_a[hc];
        float cs[8]; { float run = 0.f;
#pragma unroll
            for (int i = 0; i < 8; ++i) { run += lwv[i]; cs[i] = run; } }
        __syncthreads();
        ((LAS float*)(L + C_SEG))[w * 64 + lane] = cs[7];
        CBAR();
        float pre = 0.f, tot = 0.f;
#pragma unroll
        for (int j = 0; j < 8; ++j) { const float sg = ((const LAS float*)(L + C_SEG))[j * 64 + lane]; tot += sg; pre += (j < w) ? sg : 0.f; }
        if (w == 0) ((LAS float*)(L + C_GAM))[lane] = __expf(tot);
        unsigned att[4], bht[4], kht[4], vtt[4];
        float at_[8], bh_[8], kh_[8]; const float gtot = __expf(tot); float ep_prev = 1.f;
#pragma unroll
        for (int i = 0; i < 8; ++i) { const int t = 8 * w + i; const float cum = pre + cs[i], cump = cum - lwv[i];
            const float kkv = kk[i] * kkp; const float n2 = wave_sum(kkv * kkv); const float kkn = kkv * __builtin_amdgcn_rsqf(fmaxf(n2, 1e-24f));
            const float a = -kkn, bb = kkn * ic[i], kp = kk[i] * (1.0f + (ic[i] - 1.0f) * kap);
            const float ep = __expf(cum), em = __builtin_amdgcn_rcpf(ep), epp = (i == 0) ? __expf(cump) : ep_prev, eL = gtot * em; ep_prev = ep;
            const float Rv = rr[i] * ep, Av = a * epp, Bv = bb * em, Kv = kp * em;
            at_[i] = Av; bh_[i] = bb * eL; kh_[i] = kp * eL;
            *(LAS unsigned short*)(L + C_RT + t * CP + lane * 2) = (unsigned short)f2bf(Rv);
            *(LAS unsigned short*)(L + C_AT + t * CP + lane * 2) = (unsigned short)f2bf(Av);
            *(LAS unsigned short*)(L + C_BT + t * CP + lane * 2) = (unsigned short)f2bf(Bv);
            *(LAS unsigned short*)(L + C_KT + t * CP + lane * 2) = (unsigned short)f2bf(Kv); }
#pragma unroll
        for (int q = 0; q < 4; ++q) { att[q] = pk2(at_[2 * q], at_[2 * q + 1]); bht[q] = pk2(bh_[2 * q], bh_[2 * q + 1]); kht[q] = pk2(kh_[2 * q], kh_[2 * q + 1]); vtt[q] = pk2(vv[2 * q], vv[2 * q + 1]); }
        *(LAS v4u*)(L + C_ATT + lane * CP + 16 * w) = (v4u){att[0], att[1], att[2], att[3]};
        *(LAS v4u*)(L + C_WA + (64 + lane) * CP + 16 * w) = (v4u){bht[0], bht[1], bht[2], bht[3]};
        CBAR();
        const int cit = (uit * F.G + F.vcu) * 16 + w * 2; const bool hx = cit < MOE_NITEMS, hy = cit + 1 < MOE_NITEMS;
        f32x4 tX[16]; MoeItem mX = moe_item(hx ? cit : 0, I.w_gu, I.w_down, F.ws);
        LAS float* tscr = (LAS float*)(L + C_TSCR + w * 5120);
        struct Fr { bf16x8 a, b; };
        auto LD = [&](int base, int tile) -> Fr { const LAS unsigned char* q = L + base + (tile * 16 + lr) * CP + kq * 16; Fr f; f.a = *(const LAS bf16x8*)q; f.b = *(const LAS bf16x8*)(q + 64); return f; };
        auto MM = [&](const Fr& x, const Fr& y) -> f32x4 { f32x4 acc = (f32x4){0.f, 0.f, 0.f, 0.f};
            acc = __builtin_amdgcn_mfma_f32_16x16x32_bf16(x.a, y.a, acc, 0, 0, 0); acc = __builtin_amdgcn_mfma_f32_16x16x32_bf16(x.b, y.b, acc, 0, 0, 0); return acc; };
        const int nt = w & 3, mt0 = 2 * (w >> 2), n = nt * 16 + lr;
        { const Fr yAT = LD(C_AT, nt), yKT = LD(C_KT, nt), yRT = LD(C_RT, nt);
          Fr xBT[2], xAT[2], xKT[2];
#pragma unroll
          for (int i = 0; i < 2; ++i) { xBT[i] = LD(C_BT, mt0 + i); xAT[i] = LD(C_AT, mt0 + i); xKT[i] = LD(C_KT, mt0 + i); }
          f32x4 a1[2], a2[2], a3[2], a4[2];
#pragma unroll
          for (int i = 0; i < 2; ++i) { a1[i] = MM(xBT[i], yAT); a2[i] = MM(xAT[i], yKT); a3[i] = MM(xBT[i], yRT); a4[i] = MM(xKT[i], yRT); }
#pragma unroll
          for (int i = 0; i < 2; ++i) { const int m0 = (mt0 + i) * 16 + 4 * kq;
              f32x4 v = a1[i];
#pragma unroll
              for (int e = 0; e < 4; ++e) { v[e] = (m0 + e < n) ? v[e] : 0.f; *(LAS unsigned short*)(L + C_MA + (m0 + e) * CP + n * 2) = (unsigned short)f2bf(v[e]); }
              *(LAS v2u*)(L + C_MTA + n * CP + m0 * 2) = pack4(v);
              v = a2[i];
#pragma unroll
              for (int e = 0; e < 4; ++e) v[e] = (n < m0 + e) ? v[e] : 0.f;
              *(LAS v2u*)(L + C_AAK + n * CP + m0 * 2) = pack4(v);
              v = a3[i];
#pragma unroll
              for (int e = 0; e < 4; ++e) v[e] = (m0 + e <= n) ? v[e] : 0.f;
              *(LAS v2u*)(L + C_WA + n * CP + m0 * 2) = pack4(v);
              v = a4[i];
#pragma unroll
              for (int e = 0; e < 4; ++e) v[e] = (m0 + e <= n) ? v[e] : 0.f;
              *(LAS v2u*)(L + C_ARKT + n * CP + m0 * 2) = pack4(v); } }
        CBAR();
        if (hx) tr8_load(mX, tX, lane);
#pragma unroll
        for (int lvl = 0; lvl < 6; ++lvl) {
            const int Wsrc = (lvl & 1) ? C_WB : C_WA, Wdst = (lvl & 1) ? C_WA : C_WB, Ms = (lvl & 1) ? C_MB : C_MA, Mts = (lvl & 1) ? C_MTB : C_MTA, Md = (lvl & 1) ? C_MA : C_MB, Mtd = (lvl & 1) ? C_MTA : C_MTB;
            const Fr yW = LD(Wsrc, w); Fr yMt; if (lvl < 5) yMt = LD(Mts, nt);
            Fr xM[4], xS[2];
#pragma unroll
            for (int i = 0; i < 4; ++i) xM[i] = LD(Ms, i);
            if (lvl < 5) { xS[0] = LD(Ms, mt0); xS[1] = LD(Ms, mt0 + 1); }
            const int nj = w * 16 + lr;
            f32x4 old[4], aw[4], as[2];
#pragma unroll
            for (int i = 0; i < 4; ++i) old[i] = unpack4(*(const LAS v2u*)(L + Wsrc + nj * CP + (i * 16 + 4 * kq) * 2));
#pragma unroll
            for (int i = 0; i < 4; ++i) aw[i] = MM(xM[i], yW);
            if (lvl < 5) {
#pragma unroll
                for (int i = 0; i < 2; ++i) as[i] = MM(xS[i], yMt); }
#pragma unroll
            for (int i = 0; i < 4; ++i) *(LAS v2u*)(L + Wdst + nj * CP + (i * 16 + 4 * kq) * 2) = pack4(old[i] + aw[i]);
            if (lvl < 5) {
#pragma unroll
                for (int i = 0; i < 2; ++i) { const int m0 = (mt0 + i) * 16 + 4 * kq;
#pragma unroll
                    for (int e = 0; e < 4; ++e) *(LAS unsigned short*)(L + Md + (m0 + e) * CP + n * 2) = (unsigned short)f2bf(as[i][e]);
                    if (lvl < 4) *(LAS v2u*)(L + Mtd + n * CP + m0 * 2) = pack4(as[i]); } }
            if (lvl == 4) *(LAS v4u*)(L + C_KHT + lane * CP + 16 * w) = (v4u){kht[0], kht[1], kht[2], kht[3]};
            if (lvl == 2) { if (hx) tr8_finish(tX, mX, tscr, lane);
                            if (hy) { mX = moe_item(cit + 1, I.w_gu, I.w_down, F.ws); tr8_load(mX, tX, lane); } }
            CBAR();
        }
        *(LAS v4u*)(L + C_VT + lane * CP + 16 * w) = (v4u){vtt[0], vtt[1], vtt[2], vtt[3]};
        unsigned char* og = CHK + (size_t)unit * CHK_UNIT_BYTES;
        { const Fr yW1 = LD(C_WA, nt), yW2 = LD(C_WA + 64 * CP, nt);
          Fr xA[2], xK[2];
#pragma unroll
          for (int i = 0; i < 2; ++i) { xA[i] = LD(C_ATT, mt0 + i); xK[i] = LD(C_AAK, mt0 + i); }
          f32x4 rv[2], av[2], kv[2];
          const float gm = ((const LAS float*)(L + C_GAM))[n];
#pragma unroll
          for (int i = 0; i < 2; ++i) { const int m0 = (mt0 + i) * 16 + 4 * kq;
              rv[i] = unpack4(*(const LAS v2u*)(L + C_RT + n * CP + m0 * 2)); av[i] = unpack4(*(const LAS v2u*)(L + C_ARKT + n * CP + m0 * 2)); kv[i] = unpack4(*(const LAS v2u*)(L + C_KHT + n * CP + m0 * 2)); }
          f32x4 p7[2], p8[2], p9[2], p10[2];
#pragma unroll
          for (int i = 0; i < 2; ++i) { p7[i] = MM(xA[i], yW1); p8[i] = MM(xK[i], yW1); p9[i] = MM(xA[i], yW2); p10[i] = MM(xK[i], yW2); }
#pragma unroll
          for (int i = 0; i < 2; ++i) { const int m0 = (mt0 + i) * 16 + 4 * kq;
              *(GAS v2u*)(og + 0 * 8192 + n * 128 + m0 * 2) = pack4(p7[i] + rv[i]);
              *(LAS v2u*)(L + C_QYT + n * CP + m0 * 2) = pack4(p8[i] + av[i]);
              f32x4 v = p9[i];
#pragma unroll
              for (int e = 0; e < 4; ++e) v[e] += (m0 + e == n) ? gm : 0.f;
              *(GAS v2u*)(og + 1 * 8192 + n * 128 + m0 * 2) = pack4(v);
              *(LAS v2u*)(L + C_QST + n * CP + m0 * 2) = pack4(p10[i] + kv[i]); } }
        CBAR();
        { const Fr yQy = LD(C_QYT, nt), yQs = LD(C_QST, nt);
          Fr xV[2];
#pragma unroll
          for (int i = 0; i < 2; ++i) xV[i] = LD(C_VT, mt0 + i);
          f32x4 p11[2], p12[2];
#pragma unroll
          for (int i = 0; i < 2; ++i) { p11[i] = MM(xV[i], yQy); p12[i] = MM(xV[i], yQs); }
#pragma unroll
          for (int i = 0; i < 2; ++i) { const int m0 = (mt0 + i) * 16 + 4 * kq;
              *(GAS v2u*)(og + 2 * 8192 + n * 128 + m0 * 2) = pack4(p11[i]);
              *(GAS v2u*)(og + 3 * 8192 + n * 128 + m0 * 2) = pack4(p12[i]); } }
        if (hy) tr8_finish(tX, mX, tscr, lane);
    }
}

constexpr int C2_SLOT = 20480;
__device__ __forceinline__ void p4b_scan(Frame& F0, const In& I) {
    PHASE_FRAME(F0);
    const int lane = F.lane, lr = lane & 15, kq = lane >> 4;
    const unsigned char* CHK = F.ws + WS_CHK; bf16* YS = (bf16*)(F.ws + WS_YSCAN);
    for (int unit = F.vcu; unit < BATCH * RH * 4; unit += F.G) {
        const int bh = unit >> 2, rq = unit & 3, b = bh >> 4, h = bh & 15;
        if (F.wave == 0) {
            LAS unsigned char* Sl = F.lds + 3 * C2_SLOT;
            f32x4 S[4]; bf16x8 sf[2];
#pragma unroll
            for (int nt = 0; nt < 4; ++nt) S[nt] = (f32x4){0.f, 0.f, 0.f, 0.f};
#pragma unroll
            for (int ks = 0; ks < 2; ++ks)
#pragma unroll
                for (int j = 0; j < 8; ++j) sf[ks][j] = 0;
#define C2_DMA(ck_) do { const int ckc_ = (ck_) < SEQ / 64 ? (ck_) : SEQ / 64 - 1; const unsigned char* ug = CHK + ((size_t)bh * 128 + ckc_) * CHK_UNIT_BYTES; \
                LAS unsigned char* sl_ = F.lds + ((ck_) % 3) * C2_SLOT; \
                _Pragma("unroll") for (int j = 0; j < 16; ++j) __builtin_amdgcn_global_load_lds((const unsigned*)(ug + j * 1024 + lane * 16), (LAS unsigned*)(sl_ + j * 1024), 16, 0, 0); \
                _Pragma("unroll") for (int j = 0; j < 2; ++j) { \
                    __builtin_amdgcn_global_load_lds((const unsigned*)(ug + 2 * 8192 + (j * 32 + (lane >> 1)) * 128 + rq * 32 + (lane & 1) * 16), (LAS unsigned*)(sl_ + 16384 + j * 1024), 16, 0, 0); \
                    __builtin_amdgcn_global_load_lds((const unsigned*)(ug + 3 * 8192 + (j * 32 + (lane >> 1)) * 128 + rq * 32 + (lane & 1) * 16), (LAS unsigned*)(sl_ + 18432 + j * 1024), 16, 0, 0); } } while (0)
            C2_DMA(0); C2_DMA(1);
#pragma unroll 1
            for (int ck = 0; ck < SEQ / 64; ++ck) {
                asm volatile("s_waitcnt lgkmcnt(0)" ::: "memory");
                C2_DMA(ck + 2);
                asm volatile("s_waitcnt vmcnt(40)" ::: "memory");
                const LAS unsigned char* sl_ = F.lds + (ck % 3) * C2_SLOT;
#pragma unroll
                for (int nt = 0; nt < 4; ++nt) {
                    const bf16x8 py0 = *(const LAS bf16x8*)(sl_ + (16 * nt + lr) * 128 + kq * 16), py1 = *(const LAS bf16x8*)(sl_ + (16 * nt + lr) * 128 + kq * 16 + 64);
                    const bf16x8 ps0 = *(const LAS bf16x8*)(sl_ + 8192 + (16 * nt + lr) * 128 + kq * 16), ps1 = *(const LAS bf16x8*)(sl_ + 8192 + (16 * nt + lr) * 128 + kq * 16 + 64);
                    f32x4 y = unpack4(*(const LAS v2u*)(sl_ + 16384 + (16 * nt + lr) * 32 + kq * 8));
                    f32x4 s2 = unpack4(*(const LAS v2u*)(sl_ + 18432 + (16 * nt + lr) * 32 + kq * 8));
                    y = __builtin_amdgcn_mfma_f32_16x16x32_bf16(sf[0], py0, y, 0, 0, 0); y = __builtin_amdgcn_mfma_f32_16x16x32_bf16(sf[1], py1, y, 0, 0, 0);
                    *(GAS v2u*)(YS + ((size_t)b * SEQ + (size_t)ck * 64 + 16 * nt + lr) * RW + h * 64 + rq * 16 + 4 * kq) = pack4(y);
                    s2 = __builtin_amdgcn_mfma_f32_16x16x32_bf16(sf[0], ps0, s2, 0, 0, 0); s2 = __builtin_amdgcn_mfma_f32_16x16x32_bf16(sf[1], ps1, s2, 0, 0, 0);
                    S[nt] = s2; }
#pragma unroll
                for (int nt = 0; nt < 4; ++nt)
#pragma unroll
                    for (int i = 0; i < 4; ++i) *(LAS unsigned short*)(Sl + (4 * kq + i) * CP + (16 * nt + lr) * 2) = (unsigned short)f2bf(S[nt][i]);
                LDS_WAIT(); asm volatile("" ::: "memory");
                sf[0] = *(const LAS bf16x8*)(Sl + lr * CP + kq * 16); sf[1] = *(const LAS bf16x8*)(Sl + lr * CP + kq * 16 + 64);
                LDS_WAIT(); asm volatile("" ::: "memory");
            }
            asm volatile("s_waitcnt vmcnt(0)" ::: "memory");
#undef C2_DMA
        }
    }
}
static_assert(3 * C2_SLOT + 4096 + 5 * 16640 <= TAB_OFF, "P4b LDS map");

__device__ __forceinline__ void p5_post(Frame& F0, const In& I) {
    PHASE_FRAME(F0);
    const int lane = F.lane; const int gw = F.vcu * NWAVES + F.wave, NGW = F.G * NWAVES;
    const bf16* RKV = (const bf16*)(F.ws + WS_RKV); const bf16* ICL = (const bf16*)(F.ws + WS_ICLR); const bf16* YS = (const bf16*)(F.ws + WS_YSCAN);
    const bf16* G = (const bf16*)(F.ws + WS_G); bf16* YB = (bf16*)(F.ws + WS_YB);
    const int c0 = lane * 16;
    for (int tok = gw; tok < T; tok += NGW) {
        float y[16], rr[16], kk[16], vv[16], ic[16], gg[16];
#pragma unroll
        for (int q = 0; q < 2; ++q) { const v4u a = *(const GAS v4u*)(YS + (size_t)tok * RW + c0 + 8 * q), c = *(const GAS v4u*)(ICL + (size_t)tok * RW + c0 + 8 * q);
            const unsigned aw[4] = {a.x, a.y, a.z, a.w}, cw[4] = {c.x, c.y, c.z, c.w};
#pragma unroll
            for (int e = 0; e < 4; ++e) { y[8 * q + 2 * e] = bflo(aw[e]); y[8 * q + 2 * e + 1] = bfhi(aw[e]); ic[8 * q + 2 * e] = bflo(cw[e]); ic[8 * q + 2 * e + 1] = bfhi(cw[e]); } }
#pragma unroll
        for (int q = 0; q < 2; ++q) {
            const v4u a = *(const GAS v4u*)(RKV + (size_t)tok * (3 * RW) + c0 + 8 * q), bb = *(const GAS v4u*)(RKV + (size_t)tok * (3 * RW) + RW + c0 + 8 * q),
                      c = *(const GAS v4u*)(RKV + (size_t)tok * (3 * RW) + 2 * RW + c0 + 8 * q), d = *(const GAS v4u*)(G + (size_t)tok * RW + c0 + 8 * q);
            const unsigned aw[4] = {a.x, a.y, a.z, a.w}, bw[4] = {bb.x, bb.y, bb.z, bb.w}, cw[4] = {c.x, c.y, c.z, c.w}, dw[4] = {d.x, d.y, d.z, d.w};
#pragma unroll
            for (int e = 0; e < 4; ++e) { rr[8 * q + 2 * e] = bflo(aw[e]); rr[8 * q + 2 * e + 1] = bfhi(aw[e]); kk[8 * q + 2 * e] = bflo(bw[e]); kk[8 * q + 2 * e + 1] = bfhi(bw[e]);
                vv[8 * q + 2 * e] = bflo(cw[e]); vv[8 * q + 2 * e + 1] = bfhi(cw[e]); gg[8 * q + 2 * e] = bflo(dw[e]); gg[8 * q + 2 * e + 1] = bfhi(dw[e]); } }
        float s = 0.f, bs = 0.f;
#pragma unroll
        for (int e = 0; e < 16; ++e) { s += y[e]; const float kp = kk[e] * (1.0f + (ic[e] - 1.0f) * I.k_a[c0 + e]); bs += rr[e] * kp * I.r_k[c0 + e]; }
        s = quadsum(s); bs = quadsum(bs);
        const float mean = s * (1.f / 64.f); float s2 = 0.f;
#pragma unroll
        for (int e = 0; e < 16; ++e) { y[e] -= mean; s2 += y[e] * y[e]; }
        s2 = quadsum(s2);
        const float rstd = 1.f / sqrtf(s2 * (1.f / 64.f) + GN_EPS);
        float o[16];
#pragma unroll
        for (int e = 0; e < 16; ++e) o[e] = (y[e] * rstd * I.lnx_w[c0 + e] + I.lnx_b[c0 + e] + bs * vv[e]) * gg[e];
        { unsigned w8[4];
#pragma unroll
          for (int q = 0; q < 4; ++q) { int t8 = __builtin_amdgcn_cvt_pk_fp8_f32(o[4 * q] * ACT8_SCALE, o[4 * q + 1] * ACT8_SCALE, 0, false); t8 = __builtin_amdgcn_cvt_pk_fp8_f32(o[4 * q + 2] * ACT8_SCALE, o[4 * q + 3] * ACT8_SCALE, t8, true); w8[q] = (unsigned)t8; }
          *(GAS v4u*)((unsigned char*)YB + (size_t)tok * RW + c0) = (v4u){w8[0], w8[1], w8[2], w8[3]}; }
    }
}
#ifndef STAGE
#define STAGE 4
#endif
struct Args { In in; float* out; unsigned char* ws; };
__global__ void __launch_bounds__(NWAVES * 64, 2) mk_fwd(Args args) {
    extern __shared__ __attribute__((aligned(16))) unsigned char lds[];
    Frame F;
    F.lds = (LAS unsigned char*)lds;
    F.MISC = (volatile LAS unsigned*)(F.lds + MISC_OFF);
    F.tid = threadIdx.x; F.lane = F.tid & 63; F.wave = __builtin_amdgcn_readfirstlane(F.tid >> 6);
    F.G = gridDim.x; { const int bx = blockIdx.x; F.vcu = (F.G % 8 == 0) ? (bx % 8) * (F.G / 8) + bx / 8 : bx; }
    F.ws = args.ws;
    F.rsrc = __builtin_amdgcn_make_buffer_rsrc(args.ws, 0, 0xffffffff, 0x00020000);
    F.ctl = (gu32*)(args.ws + WS_CTL);
    for (int u = F.tid; u < (LDS_BYTES - MISC_OFF) / 4; u += NWAVES * 64) ((LAS unsigned*)(F.lds + MISC_OFF))[u] = 0u;
    __syncthreads();
    XcdBarrier bar = xcd_barrier_post((unsigned*)(F.ctl + CW_BAR), F.MISC + 8);
    const In& I = args.in;
#define GRID_BAR() xcd_barrier(bar)
#ifndef DUP_PHASE
#define DUP_PHASE -1
#endif
#define RUN(n, call) do { call; if (DUP_PHASE == (n)) { GRID_BAR(); call; } } while (0)

#if STAGE >= 2
    RUN(0, p0_prologue(F, I));
    GRID_BAR();
#endif
#if STAGE >= 3
    RUN(1, p1_proj(F, I));
    GRID_BAR();
    RUN(2, p2_shift_attn(F, I));
    GRID_BAR();
#if STAGE >= 4
    RUN(3, p3_lora(F, I));
    GRID_BAR();
    RUN(4, p4a_chunk(F, I));
    GRID_BAR();
    RUN(44, p4b_scan(F, I));
    GRID_BAR();
    RUN(5, p5_post(F, I));
    GRID_BAR();
#endif
    RUN(6, p6_merged(F, I));
    GRID_BAR();
    RUN(7, p7_mix(F, I));
    GRID_BAR();
#endif
    p8_ln_router<(STAGE < 3)>(F, I);
    GRID_BAR();
#if STAGE >= 2
    p9_scatter(F, I);
    GRID_BAR();
    RUN(10, p10_moe_up(F, I));
    GRID_BAR();
    RUN(11, p11_moe_down(F, I));
    GRID_BAR();
#endif
    RUN(12, p12_final<(STAGE < 2)>(F, I, args.out));
}

extern "C" void kernel_launch(void* const* d_in, const int* in_sizes, int n_in, void* d_out, int out_size, void* d_ws, size_t ws_size, hipStream_t stream) {
    static int grid = 0;
    if (grid == 0) {
        if (n_in != 27 || in_sizes[0] != T * D || out_size != T * D || ws_size < WS_END) { fprintf(stderr, "kernel_launch: unexpected shapes (n_in %d, in0 %d, out %d, ws %zu)\n", n_in, n_in > 0 ? in_sizes[0] : -1, out_size, ws_size); grid = -1; return; }
        int dev = 0, cus = 0, per_cu = 0;
        if (hipGetDevice(&dev) != hipSuccess || hipDeviceGetAttribute(&cus, hipDeviceAttributeMultiprocessorCount, dev) != hipSuccess) { grid = -1; return; }
        if (hipFuncSetAttribute((const void*)mk_fwd, hipFuncAttributeMaxDynamicSharedMemorySize, LDS_BYTES) != hipSuccess) { fprintf(stderr, "kernel_launch: hipFuncSetAttribute failed\n"); grid = -1; return; }
        if (hipOccupancyMaxActiveBlocksPerMultiprocessor(&per_cu, (const void*)mk_fwd, NWAVES * 64, LDS_BYTES) != hipSuccess || per_cu < 1)
            fprintf(stderr, "kernel_launch: occupancy query reports %d\n", per_cu);
        (void)hipGetLastError();
        grid = cus;
    }
    if (grid < 0) return;
    if (hipMemsetAsync((char*)d_ws + WS_CTL, 0, CTL_ZERO_BYTES, stream) != hipSuccess) return;
    Args a{};
    const float** ip = (const float**)&a.in;
    for (int i = 0; i < 27; ++i) ip[i] = (const float*)d_in[i];
    a.out = (float*)d_out; a.ws = (unsigned char*)d_ws;
    hipLaunchKernelGGL(mk_fwd, dim3(grid), dim3(NWAVES * 64), LDS_BYTES, stream, a);
    const hipError_t le = hipPeekAtLastError();
    if (le != hipSuccess) fprintf(stderr, "kernel_launch: launch failed: %s\n", hipGetErrorName(le));
}
```

```cpp
#define STAGE 4
#include <hip/hip_runtime.h>
#include <cstdio>
#include <cstdint>

#define GAS __attribute__((address_space(1)))
#define LAS __attribute__((address_space(3)))
typedef unsigned short bf16;
typedef unsigned v4u __attribute__((ext_vector_type(4)));
typedef unsigned v2u __attribute__((ext_vector_type(2)));
typedef float f32x4 __attribute__((ext_vector_type(4)));
typedef float f32x2 __attribute__((ext_vector_type(2)));
typedef float f32x16 __attribute__((ext_vector_type(16)));
typedef short bf16x8 __attribute__((ext_vector_type(8)));
typedef short bf16x4 __attribute__((ext_vector_type(4)));
typedef GAS unsigned gu32;

constexpr int NWAVES = 8;
constexpr int BATCH = 4, SEQ = 8192, D = 2048, T = BATCH * SEQ;
constexpr int CHUNK = 64, LEFT = 8, AH = 16, AD = 64, AW = 1024;
constexpr int REL_TABLE = 320, MAX_PAST = 256;
constexpr int RH = 16, RN = 64, RW = 1024, DLORA = 96, ALORA = 96, GLORA = 256;
constexpr int SHIFT_W = 3 * RW + DLORA + ALORA + GLORA;
constexpr int D_IN = 3 * AW + SHIFT_W + 2 * D;
constexpr int NE = 32, TOPK = 4, FF = 2048;
constexpr int MSLOT = T * TOPK;
constexpr int NBLK_MAX = (MSLOT + NE * 255 + 255) / 256;
constexpr int RROWS = NBLK_MAX * 256;
constexpr float LN_EPS = 1e-5f, GN_EPS = 64e-5f;
constexpr float YS_SCALE = 16.0f, YS_INV = 1.0f / 16.0f;
constexpr float ACT8_SCALE = 16.0f;
constexpr float F8_CVT_SCALE = 0.015625f;
constexpr float DN_ALPHA = 1.189207115002721f;
constexpr int PROJ_LD = 9728, PJ_Q = 0, PJ_K = 1024, PJ_SEG = 2048, SEG_PAD = 3584, PJ_GA = 5632, PJ_GB = 7680;
constexpr int LORA_LD = 512;

constexpr size_t MiB = 1u << 20;
constexpr size_t WS_CTL = 0, CTL_ZERO_BYTES = 1 * MiB;
constexpr size_t WS_TOPI = 2 * MiB;
constexpr size_t WS_GATE = 3 * MiB;
constexpr size_t WS_ROWSLOT = 4 * MiB;
constexpr size_t WS_ROWW = 5 * MiB;
constexpr size_t WS_WLA = 6 * MiB;
constexpr size_t WS_WLG = 7 * MiB;
constexpr size_t WS_PAT = 8 * MiB;
constexpr size_t WS_PBT = 12 * MiB;
constexpr size_t WS_WOT = 16 * MiB;
constexpr size_t WS_WVT = 24 * MiB;
constexpr size_t WS_WINT = 28 * MiB;
constexpr size_t WS_WG8 = 72 * MiB;
constexpr size_t WS_WQK8 = 80 * MiB;
constexpr size_t WS_WV8 = 84 * MiB;
constexpr size_t WS_WSV8 = 88 * MiB;
constexpr size_t WS_WGUT = 128 * MiB;
constexpr size_t WS_WDNT = 640 * MiB;
constexpr size_t WS_BASE0 = 1024 * MiB;
constexpr size_t WS_PROJ = WS_BASE0;
constexpr size_t WS_VT = WS_PROJ + 608 * MiB;
constexpr size_t WS_YA = WS_VT + 64 * MiB;
constexpr size_t WS_RKV = WS_YA + 64 * MiB;
constexpr size_t WS_LORAIN = WS_RKV + 192 * MiB;
constexpr size_t WS_DECAY = WS_LORAIN + 32 * MiB;
constexpr size_t WS_ICLR = WS_DECAY + 128 * MiB;
constexpr size_t WS_G = WS_ICLR + 128 * MiB;
constexpr size_t WS_YSCAN = WS_G + 64 * MiB;
constexpr size_t WS_YB = WS_YSCAN + 128 * MiB;
constexpr size_t WS_MERGED = WS_YB + 64 * MiB;
constexpr size_t WS_XB16 = WS_MERGED + 128 * MiB;
constexpr size_t WS_MIX_END = WS_XB16 + 128 * MiB;
constexpr size_t WS_Z = 2816 * MiB;
constexpr size_t WS_H1 = 3072 * MiB;
constexpr size_t WS_H1B = 3328 * MiB;
constexpr size_t WS_CHK = 3456 * MiB;
constexpr size_t WS_XB8 = 3712 * MiB;
constexpr size_t WS_END = 3776 * MiB;
constexpr size_t WS_XG = WS_BASE0;
constexpr size_t WS_ACT = WS_BASE0 + 544 * MiB;
constexpr size_t WS_YSLOT = WS_BASE0 + 1088 * MiB;
static_assert(WS_MIX_END <= WS_Z && WS_YSLOT + 512 * MiB <= WS_Z, "ws map");
static_assert(WS_WINT + (size_t)PROJ_LD * D * 2 <= WS_WGUT, "ws map");

constexpr int CW_CNT = 512;
constexpr int CW_CUR = 576;
constexpr int CW_BAR = 4096;

constexpr int RING_OFF = 0, RING_BYTES = 131072;
constexpr int LDS_BYTES = 160 * 1024;
constexpr int MISC_OFF = LDS_BYTES - 512;
constexpr int TAB_OFF = LDS_BYTES - 1024;

#define RLX_AGENT __ATOMIC_RELAXED, __HIP_MEMORY_SCOPE_AGENT
#define LDS_WAIT() asm volatile("s_waitcnt lgkmcnt(0)" ::: "memory")
#define VM_WAIT() asm volatile("s_waitcnt vmcnt(0)" ::: "memory")
__device__ __forceinline__ unsigned f2bf(float f) { unsigned u = __builtin_bit_cast(unsigned, f); return (u + 0x7fffu + ((u >> 16) & 1u)) >> 16; }
__device__ __forceinline__ unsigned pk2(float lo, float hi) { return f2bf(lo) | (f2bf(hi) << 16); }
__device__ __forceinline__ float bf2f(unsigned short h) { return __builtin_bit_cast(float, (unsigned)h << 16); }
__device__ __forceinline__ float bflo(unsigned w) { return __builtin_bit_cast(float, w << 16); }
__device__ __forceinline__ float bfhi(unsigned w) { return __builtin_bit_cast(float, w & 0xffff0000u); }
__device__ __forceinline__ float fsigmoid(float x) { return __builtin_amdgcn_rcpf(1.0f + __expf(-x)); }
__device__ __forceinline__ float dpp_f(float x, const int ctrl_sel) {
    const int xi = __builtin_bit_cast(int, x); int r;
    if (ctrl_sel == 0) r = __builtin_amdgcn_update_dpp(0, xi, 0xB1, 0xF, 0xF, false);
    else if (ctrl_sel == 1) r = __builtin_amdgcn_update_dpp(0, xi, 0x4E, 0xF, 0xF, false);
    else if (ctrl_sel == 2) r = __builtin_amdgcn_update_dpp(0, xi, 0x124, 0xF, 0xF, false);
    else r = __builtin_amdgcn_update_dpp(0, xi, 0x128, 0xF, 0xF, false);
    return __builtin_bit_cast(float, r);
}
__device__ __forceinline__ float rowsum16(float x) { x += dpp_f(x, 0); x += dpp_f(x, 1); x += dpp_f(x, 2); x += dpp_f(x, 3); return x; }
__device__ __forceinline__ float quadsum(float x) { x += dpp_f(x, 0); x += dpp_f(x, 1); return x; }
__device__ __forceinline__ float wave_sum(float v) {
    v = rowsum16(v);
    const int vi = __builtin_bit_cast(int, v);
    const float s0 = __builtin_bit_cast(float, __builtin_amdgcn_readlane(vi, 0)), s1 = __builtin_bit_cast(float, __builtin_amdgcn_readlane(vi, 16));
    const float s2 = __builtin_bit_cast(float, __builtin_amdgcn_readlane(vi, 32)), s3 = __builtin_bit_cast(float, __builtin_amdgcn_readlane(vi, 48));
    return (s0 + s1) + (s2 + s3);
}
namespace pg8 {
#define PG8_LAS __attribute__((address_space(3)))
typedef unsigned short bf16_t;
typedef unsigned u32x4 __attribute__((ext_vector_type(4)));
constexpr int BM = 256, BK = 64, HALF = 128, HTB = HALF * BK * 2, STAGE_BYTES = 8 * HTB, NXCD = 8, WGM = 8;

__host__ __device__ __forceinline__ int lds_byte(int r, int c) { const int st = (r >> 4) * 2 + (c >> 5), rr = r & 15, cc = c & 31, ob = rr * 64 + cc * 2; return st * 1024 + (ob ^ (((ob >> 9) & 1) << 5)); }
__host__ __device__ __forceinline__ void stage_rc(int b, int& R, int& C) { const int st = b / 1024, sb = b % 1024, swz = sb ^ (((sb >> 9) & 1) << 5); R = (st >> 1) * 16 + swz / 64; C = (st & 1) * 32 + (swz % 64) / 2; }
__host__ __device__ __forceinline__ int perm32(int rho) { const int n = rho >> 4, i = rho & 15; return 8 * (i >> 2) + 4 * n + (i & 3); }

struct Unit { int pm, pn, aux; };

struct Tiler {
    int nM, nN, nwg, G, c;
    __device__ __forceinline__ void init(int nM_, int nN_, int G_, int c_) { nM = nM_; nN = nN_; nwg = nM * nN; G = G_; c = c_; }
    __device__ __forceinline__ bool map(int i, int& pm, int& pn) const {
        const long L = (long)i * G + c; if (L >= nwg) return false;
        int wgid = (int)L; { const int q = nwg / NXCD, r = nwg % NXCD, xcd = wgid % NXCD, off = wgid / NXCD; wgid = (xcd < r ? xcd * (q + 1) : r * (q + 1) + (xcd - r) * q) + off; }
        const int nig = WGM * nN, gid = wgid / nig, fm = gid * WGM, gsz = (nM - fm) < WGM ? (nM - fm) : WGM;
        pm = fm + ((wgid % nig) % gsz); pn = (wgid % nig) / gsz; return true;
    }
};
struct SchedPlain {
    Tiler t; unsigned A, B, tsA, tsB;
    __device__ __forceinline__ bool next(int i, Unit& u) const { u.aux = 0; return t.map(i, u.pm, u.pn); }
    __device__ __forceinline__ void bases(const Unit& u, unsigned& a, unsigned& b) const { a = A + (unsigned)u.pm * tsA; b = B + (unsigned)u.pn * tsB; }
};
struct SchedTwo {
    Tiler t; unsigned A0, A1, B0, B1, tsA, tsB;
    __device__ __forceinline__ bool next(int i, Unit& u) const { u.aux = i & 1; return t.map(i >> 1, u.pm, u.pn); }
    __device__ __forceinline__ void bases(const Unit& u, unsigned& a, unsigned& b) const { a = (u.aux ? A1 : A0) + (unsigned)u.pm * tsA; b = (u.aux ? B1 : B0) + (unsigned)u.pn * tsB; }
};
struct SchedMoe {
    Tiler t; unsigned A, B, tsA, tsB, es; const PG8_LAS int* pad_end;
    __device__ __forceinline__ bool next(int i, Unit& u) const {
        if (!t.map(i, u.pm, u.pn)) return false;
        const int row0 = u.pm * BM; int e = 0;
#pragma unroll
        for (int j = 0; j < 32; ++j) e += (pad_end[j] <= row0) ? 1 : 0;
        u.aux = __builtin_amdgcn_readfirstlane(e < 31 ? e : 31); return true;
    }
    __device__ __forceinline__ void bases(const Unit& u, unsigned& a, unsigned& b) const { a = A + (unsigned)u.pm * tsA; b = B + (unsigned)u.aux * es + (unsigned)u.pn * tsB; }
};

typedef float f32x2_t_ __attribute__((ext_vector_type(2)));
typedef __bf16 bf16x2_t_ __attribute__((ext_vector_type(2)));
__device__ __forceinline__ unsigned cvt_pk_bf16(float lo, float hi) { const f32x2_t_ v = {lo, hi}; const bf16x2_t_ b = __builtin_convertvector(v, bf16x2_t_); return __builtin_bit_cast(unsigned, b); }
__device__ __forceinline__ u32x4 pack8(const f32x4& v0, const f32x4& v1) { u32x4 w; w.x = cvt_pk_bf16(v0[0], v0[1]); w.y = cvt_pk_bf16(v0[2], v0[3]); w.z = cvt_pk_bf16(v1[0], v1[1]); w.w = cvt_pk_bf16(v1[2], v1[3]); return w; }

typedef int i32x8 __attribute__((ext_vector_type(8)));
typedef int i32x4 __attribute__((ext_vector_type(4)));
__device__ __forceinline__ i32x8 cat8(const bf16x8& a, const bf16x8& b) { return __builtin_shufflevector(__builtin_bit_cast(i32x4, a), __builtin_bit_cast(i32x4, b), 0, 1, 2, 3, 4, 5, 6, 7); }
constexpr int F8_SCALES = 0x00007f79;
template <class Epi, class Sched, bool ALIGN_EPI, bool F8 = false, int F8SC = F8_SCALES>
__device__ __forceinline__ void gemm_phase(PG8_LAS unsigned char* lds, const __amdgpu_buffer_rsrc_t rsrc, const int lda, const int ldb, const int K, const Sched& S, const Epi& E) {
    int tid_ = threadIdx.x; asm volatile("" : "+v"(tid_));
    const int tid = tid_, wid = __builtin_amdgcn_readfirstlane(tid >> 6), lane = tid & 63, wr = wid >> 2, wc = wid & 3, fr = lane & 15, fq = lane >> 4;
    const int nt = K / BK;
    unsigned voffA, voffB;
    { int R, C; stage_rc(tid * 16, R, C); const int Rb = (R & ~31) + perm32(R & 31); voffA = (unsigned)(R * lda + C) * 2u; voffB = (unsigned)(Rb * ldb + C) * 2u; }
    const unsigned p1voffA = 64u * (unsigned)lda * 2u, p1voffB = 64u * (unsigned)ldb * 2u;
    const unsigned kstep = (unsigned)(BK * 2);
    const unsigned hsA = (unsigned)HALF * lda * 2, hsB = (unsigned)HALF * ldb * 2;
    const unsigned ldsw = (unsigned)wid * 1024u;
    const int aoff = lds_byte(wr * 64 + fr, fq * 8), boff = lds_byte(wc * 32 + fr, fq * 8);
#define PG8_SA(b, h) (((b) * 2 + (h)) * HTB)
#define PG8_SB(b, h) ((4 + (b) * 2 + (h)) * HTB)
#define PG8_STAGE(bufoff, goff, voff) do { _Pragma("unroll") for (int _i = 0; _i < 2; ++_i) \
        __builtin_amdgcn_raw_ptr_buffer_load_lds(rsrc, (PG8_LAS void*)(lds + (bufoff) + ldsw + _i * 8192), 16, (int)(voff), (int)((goff) + _i * p1##voff), 0, 0); } while (0)
#define PG8_LD8(addr) __builtin_shufflevector(*(const PG8_LAS i32x4*)(addr), *(const PG8_LAS i32x4*)((addr) + 1024), 0, 1, 2, 3, 4, 5, 6, 7)
#define PG8_LDA(dst, b, h) do { _Pragma("unroll") for (int m = 0; m < 4; ++m) dst[m] = PG8_LD8(lds + PG8_SA(b, h) + aoff + m * 2048); } while (0)
#define PG8_LDB(dst, b, h) do { _Pragma("unroll") for (int n = 0; n < 2; ++n) dst[n] = PG8_LD8(lds + PG8_SB(b, h) + boff + n * 2048); } while (0)
#define PG8_LO(v) __builtin_bit_cast(bf16x8, __builtin_shufflevector(v, v, 0, 1, 2, 3))
#define PG8_HI(v) __builtin_bit_cast(bf16x8, __builtin_shufflevector(v, v, 4, 5, 6, 7))
#define PG8_MMA(ai, bj, At, Bt) do { __builtin_amdgcn_s_setprio(1); \
        if constexpr (!F8) { _Pragma("unroll") for (int m = 0; m < 4; ++m) _Pragma("unroll") for (int n = 0; n < 2; ++n) { \
            acc[ai][bj][m][n] = __builtin_amdgcn_mfma_f32_16x16x32_bf16(PG8_LO(Bt[n]), PG8_LO(At[m]), acc[ai][bj][m][n], 0, 0, 0); \
            acc[ai][bj][m][n] = __builtin_amdgcn_mfma_f32_16x16x32_bf16(PG8_HI(Bt[n]), PG8_HI(At[m]), acc[ai][bj][m][n], 0, 0, 0); } } \
        else { _Pragma("unroll") for (int m = 0; m < 4; ++m) _Pragma("unroll") for (int n = 0; n < 2; ++n) \
            acc[ai][bj][m][n] = __builtin_amdgcn_mfma_scale_f32_16x16x128_f8f6f4(Bt[n], At[m], acc[ai][bj][m][n], 0, 0, 0, F8SC, 1, F8SC); } \
        __builtin_amdgcn_s_setprio(0); } while (0)
#define PG8_WAIT_V(n) asm volatile("s_waitcnt vmcnt(" #n ")" ::: "memory")
#define PG8_WAIT_L(n) asm volatile("s_waitcnt lgkmcnt(" #n ")" ::: "memory")
#define PG8_BAR __builtin_amdgcn_s_barrier()
#define PG8_SCHED __builtin_amdgcn_sched_barrier(0)
#define PG8_ZERO() do { _Pragma("unroll") for (int a = 0; a < 2; ++a) _Pragma("unroll") for (int b = 0; b < 2; ++b) _Pragma("unroll") for (int m = 0; m < 4; ++m) _Pragma("unroll") for (int n = 0; n < 2; ++n) acc[a][b][m][n] = (f32x4){0.f, 0.f, 0.f, 0.f}; } while (0)
    Unit cur, nxt; int ui = 0;
    if (!S.next(0, cur)) return;
    f32x4 acc[2][2][4][2];
    PG8_ZERO();
    i32x8 At[4], B0[2], B1[2];
    unsigned cA, cB; S.bases(cur, cA, cB); cA = __builtin_amdgcn_readfirstlane(cA); cB = __builtin_amdgcn_readfirstlane(cB);
    PG8_STAGE(PG8_SB(0, 0), cB, voffB); PG8_STAGE(PG8_SB(0, 1), cB + hsB, voffB); PG8_STAGE(PG8_SA(0, 0), cA, voffA); PG8_STAGE(PG8_SA(0, 1), cA + hsA, voffA);
    if (wr == 1) PG8_BAR;
    PG8_WAIT_V(2); PG8_BAR;
    PG8_STAGE(PG8_SB(1, 0), cB + kstep, voffB); PG8_STAGE(PG8_SA(1, 0), cA + kstep, voffA); PG8_STAGE(PG8_SB(1, 1), cB + hsB + kstep, voffB);
    PG8_WAIT_V(6); PG8_BAR;
    for (;;) {
        const bool has_next = S.next(ui + 1, nxt);
        unsigned nA = cA, nB = cB; if (has_next) { S.bases(nxt, nA, nB); nA = __builtin_amdgcn_readfirstlane(nA); nB = __builtin_amdgcn_readfirstlane(nB); }
#pragma unroll 1
        for (int t = 0; t < nt; t += 2) {
            const bool last = (t == nt - 2);
            const unsigned a1 = cA + (unsigned)(t + 1) * kstep;
            const unsigned a2 = last ? nA : cA + (unsigned)(t + 2) * kstep, b2 = last ? nB : cB + (unsigned)(t + 2) * kstep;
            const unsigned a3 = a2 + kstep, b3 = b2 + kstep;
            PG8_LDB(B0, 0, 0); PG8_LDB(B1, 0, 1); PG8_SCHED; PG8_LDA(At, 0, 0); PG8_STAGE(PG8_SA(1, 1), a1 + hsA, voffA);
            PG8_WAIT_V(8); PG8_WAIT_L(0); PG8_BAR; PG8_MMA(0, 0, At, B0); PG8_MMA(0, 1, At, B1); PG8_BAR; PG8_SCHED;
            PG8_LDA(At, 0, 1); PG8_STAGE(PG8_SB(0, 0), b2, voffB); PG8_STAGE(PG8_SB(0, 1), b2 + hsB, voffB); PG8_STAGE(PG8_SA(0, 0), a2, voffA);
            PG8_WAIT_V(8); PG8_WAIT_L(0); PG8_BAR; PG8_MMA(1, 0, At, B0); PG8_MMA(1, 1, At, B1); PG8_BAR; PG8_SCHED;
            PG8_LDB(B0, 1, 0); PG8_LDB(B1, 1, 1); PG8_SCHED; PG8_LDA(At, 1, 0); PG8_STAGE(PG8_SA(0, 1), a2 + hsA, voffA);
            PG8_WAIT_V(8); PG8_WAIT_L(0); PG8_BAR; PG8_MMA(0, 0, At, B0); PG8_MMA(0, 1, At, B1); PG8_BAR; PG8_SCHED;
            PG8_LDA(At, 1, 1); PG8_STAGE(PG8_SB(1, 0), b3, voffB); PG8_STAGE(PG8_SB(1, 1), b3 + hsB, voffB); PG8_STAGE(PG8_SA(1, 0), a3, voffA);
            PG8_WAIT_V(8); PG8_WAIT_L(0); PG8_BAR; PG8_MMA(1, 0, At, B0); PG8_MMA(1, 1, At, B1); PG8_BAR; PG8_SCHED;
        }
        if constexpr (ALIGN_EPI) { if (wr == 0) PG8_BAR; }
        bool keep; { int t2 = threadIdx.x; asm volatile("" : "+v"(t2)); const int w2 = __builtin_amdgcn_readfirstlane(t2 >> 6), l2 = t2 & 63; keep = E(acc, cur, w2 >> 2, w2 & 3, l2 & 15, l2 >> 4); }
        if (!has_next) break;
        if (!keep) PG8_ZERO();
        cur = nxt; cA = nA; cB = nB; ++ui;
        if constexpr (ALIGN_EPI) { if (wr == 1) PG8_BAR; }
    }
    PG8_WAIT_V(0);
    if constexpr (!ALIGN_EPI) { if (wr == 0) PG8_BAR; }
    PG8_BAR;
#undef PG8_SA
#undef PG8_SB
#undef PG8_STAGE
#undef PG8_LDA
#undef PG8_LDB
#undef PG8_LD8
#undef PG8_LO
#undef PG8_HI
#undef PG8_MMA
#undef PG8_WAIT_V
#undef PG8_WAIT_L
#undef PG8_BAR
#undef PG8_SCHED
#undef PG8_ZERO
}
}
namespace pg8 {
#define EPI_ROWLOOP _Pragma("unroll") for (int ai = 0; ai < 2; ++ai) _Pragma("unroll") for (int m = 0; m < 4; ++m)
struct EpiProj {
    bf16_t* O; int coloff, nq;
    __device__ __forceinline__ bool operator()(f32x4 (&acc)[2][2][4][2], const Unit& u, int wr, int wc, int fr, int fq) const {
        const int row0 = u.pm * BM + wr * 64 + fr, col0 = coloff + u.pn * BM + wc * 32 + 8 * fq;
        const float sc = (u.pn < nq) ? 0.125f : 1.0f;
        EPI_ROWLOOP { bf16_t* rowp = O + (size_t)(row0 + ai * HALF + m * 16) * PROJ_LD + col0;
#pragma unroll
            for (int bj = 0; bj < 2; ++bj) *(u32x4*)(rowp + bj * HALF) = pack8(acc[ai][bj][m][0] * sc, acc[ai][bj][m][1] * sc); }
        return false;
    }
};
struct EpiGate {
    bf16_t* O;
    __device__ __forceinline__ bool operator()(f32x4 (&acc)[2][2][4][2], const Unit& u, int wr, int wc, int fr, int fq) const {
        const int row0 = u.pm * BM + wr * 64 + fr, d0 = u.pn * HALF + wc * 32 + 8 * fq;
        EPI_ROWLOOP { bf16_t* rowp = O + (size_t)(row0 + ai * HALF + m * 16) * PROJ_LD + d0;
            f32x4 rt[2], gb[2];
#pragma unroll
            for (int n = 0; n < 2; ++n)
#pragma unroll
                for (int j = 0; j < 4; ++j) { const float ea = __expf(-acc[ai][0][m][n][j]), eb = fminf(__expf(-acc[ai][1][m][n][j]), 1e30f);
                    gb[n][j] = __builtin_amdgcn_rcpf(1.0f + eb); rt[n][j] = (1.0f + eb) * __builtin_amdgcn_rcpf(1.0f + ea); }
            *(u32x4*)(rowp + PJ_GA) = pack8(rt[0], rt[1]); *(u32x4*)(rowp + PJ_GB) = pack8(gb[0], gb[1]); }
        return false;
    }
};
struct EpiBf16 {
    bf16_t* O; int ldc;
    __device__ __forceinline__ bool operator()(f32x4 (&acc)[2][2][4][2], const Unit& u, int wr, int wc, int fr, int fq) const {
        const int row0 = u.pm * BM + wr * 64 + fr, col0 = u.pn * BM + wc * 32 + 8 * fq;
        EPI_ROWLOOP { bf16_t* rowp = O + (size_t)(row0 + ai * HALF + m * 16) * ldc + col0;
#pragma unroll
            for (int bj = 0; bj < 2; ++bj) *(u32x4*)(rowp + bj * HALF) = pack8(acc[ai][bj][m][0], acc[ai][bj][m][1]); }
        return false;
    }
};
template <bool ISDEC> struct EpiLoraA {
    float* OUT; const float* par;
    __device__ __forceinline__ bool operator()(f32x4 (&acc)[2][2][4][2], const Unit& u, int wr, int wc, int fr, int fq) const {
        const int row0 = u.pm * BM + wr * 64 + fr, col0 = u.pn * BM + wc * 32 + 8 * fq;
        f32x4 pv[2][2];
#pragma unroll
        for (int bj = 0; bj < 2; ++bj)
#pragma unroll
            for (int n = 0; n < 2; ++n) pv[bj][n] = *(const f32x4*)(par + col0 + bj * HALF + 4 * n);
        EPI_ROWLOOP { float* rowp = OUT + (size_t)(row0 + ai * HALF + m * 16) * RW + col0;
#pragma unroll
            for (int bj = 0; bj < 2; ++bj)
#pragma unroll
                for (int n = 0; n < 2; ++n) { f32x4 v = acc[ai][bj][m][n] + pv[bj][n];
#pragma unroll
                    for (int j = 0; j < 4; ++j) {
                        if (ISDEC) v[j] = -0.60653065971263342f * fsigmoid(v[j]);
                        else v[j] = fsigmoid(v[j]); }
                    *(f32x4*)(rowp + bj * HALF + 4 * n) = v; } }
        return false;
    }
};
struct EpiIclr {
    bf16_t* OUT; const float* par;
    __device__ __forceinline__ bool operator()(f32x4 (&acc)[2][2][4][2], const Unit& u, int wr, int wc, int fr, int fq) const {
        const int row0 = u.pm * BM + wr * 64 + fr, col0 = u.pn * BM + wc * 32 + 8 * fq;
        f32x4 pv[2][2];
#pragma unroll
        for (int bj = 0; bj < 2; ++bj)
#pragma unroll
            for (int n = 0; n < 2; ++n) pv[bj][n] = *(const f32x4*)(par + col0 + bj * HALF + 4 * n);
        EPI_ROWLOOP { bf16_t* rowp = OUT + (size_t)(row0 + ai * HALF + m * 16) * RW + col0;
#pragma unroll
            for (int bj = 0; bj < 2; ++bj) { f32x4 v0 = acc[ai][bj][m][0] + pv[bj][0], v1 = acc[ai][bj][m][1] + pv[bj][1];
#pragma unroll
                for (int j = 0; j < 4; ++j) { v0[j] = fsigmoid(v0[j]); v1[j] = fsigmoid(v1[j]); }
                *(u32x4*)(rowp + bj * HALF) = pack8(v0, v1); } }
        return false;
    }
};
struct EpiMerged {
    const bf16_t* PROJ; bf16_t* O;
    __device__ __forceinline__ bool operator()(f32x4 (&acc)[2][2][4][2], const Unit& u, int wr, int wc, int fr, int fq) const {
        const int row0 = u.pm * BM + wr * 64 + fr, col0 = u.pn * BM + wc * 32 + 8 * fq;
        EPI_ROWLOOP { const int row = row0 + ai * HALF + m * 16; const bf16_t* gp = PROJ + (size_t)row * PROJ_LD + col0;
#pragma unroll
            for (int bj = 0; bj < 2; ++bj) {
                if (u.aux == 0) {
                    const u32x4 ga = *(const u32x4*)(gp + PJ_GA + bj * HALF);
                    const f32x4 a0 = (f32x4){bflo(ga.x), bfhi(ga.x), bflo(ga.y), bfhi(ga.y)}, a1 = (f32x4){bflo(ga.z), bfhi(ga.z), bflo(ga.w), bfhi(ga.w)};
                    acc[ai][bj][m][0] = acc[ai][bj][m][0] * a0; acc[ai][bj][m][1] = acc[ai][bj][m][1] * a1;
                } else {
                    const u32x4 gb = *(const u32x4*)(gp + PJ_GB + bj * HALF);
                    const f32x4 b0 = (f32x4){bflo(gb.x), bfhi(gb.x), bflo(gb.y), bfhi(gb.y)}, b1 = (f32x4){bflo(gb.z), bfhi(gb.z), bflo(gb.w), bfhi(gb.w)};
                    { const f32x4 o0 = acc[ai][bj][m][0] * b0 * ACT8_SCALE, o1 = acc[ai][bj][m][1] * b1 * ACT8_SCALE;
                      int w0 = __builtin_amdgcn_cvt_pk_fp8_f32(o0[0], o0[1], 0, false); w0 = __builtin_amdgcn_cvt_pk_fp8_f32(o0[2], o0[3], w0, true);
                      int w1 = __builtin_amdgcn_cvt_pk_fp8_f32(o1[0], o1[1], 0, false); w1 = __builtin_amdgcn_cvt_pk_fp8_f32(o1[2], o1[3], w1, true);
                      *(v2u*)((unsigned char*)O + (size_t)row * D + col0 + bj * HALF) = (v2u){(unsigned)w0, (unsigned)w1}; }
                } } }
        return u.aux == 0;
    }
};
struct EpiZ {
    const float* X; float* Z;
    __device__ __forceinline__ bool operator()(f32x4 (&acc)[2][2][4][2], const Unit& u, int wr, int wc, int fr, int fq) const {
        const int row0 = u.pm * BM + wr * 64 + fr, col0 = u.pn * BM + wc * 32 + 8 * fq;
        EPI_ROWLOOP { const size_t off = (size_t)(row0 + ai * HALF + m * 16) * D + col0;
#pragma unroll
            for (int bj = 0; bj < 2; ++bj)
#pragma unroll
                for (int n = 0; n < 2; ++n) { const f32x4 xv = *(const f32x4*)(X + off + bj * HALF + 4 * n); *(f32x4*)(Z + off + bj * HALF + 4 * n) = xv * DN_ALPHA + acc[ai][bj][m][n]; } }
        return false;
    }
};
struct EpiSwiglu {
    unsigned char* ACT; const float* bgu;
    __device__ __forceinline__ bool operator()(f32x4 (&acc)[2][2][4][2], const Unit& u, int wr, int wc, int fr, int fq) const {
        const int row0 = u.pm * BM + wr * 64 + fr, col0 = u.pn * HALF + wc * 32 + 8 * fq;
        const float* bp = bgu + (size_t)u.aux * (2 * FF) + col0;
        f32x4 bg[2], bu[2];
#pragma unroll
        for (int n = 0; n < 2; ++n) { bg[n] = *(const f32x4*)(bp + 4 * n); bu[n] = *(const f32x4*)(bp + FF + 4 * n); }
        EPI_ROWLOOP { f32x4 o[2];
#pragma unroll
            for (int n = 0; n < 2; ++n) { const f32x4 g = acc[ai][0][m][n] + bg[n], uu = acc[ai][1][m][n] + bu[n];
#pragma unroll
                for (int j = 0; j < 4; ++j) { const float gc = fminf(g[j], 7.0f), uc = fminf(fmaxf(uu[j], -7.0f), 7.0f); o[n][j] = (uc + 1.0f) * (gc * fsigmoid(1.702f * gc)); } }
            int w0 = __builtin_amdgcn_cvt_pk_fp8_f32(o[0][0], o[0][1], 0, false); w0 = __builtin_amdgcn_cvt_pk_fp8_f32(o[0][2], o[0][3], w0, true);
            int w1 = __builtin_amdgcn_cvt_pk_fp8_f32(o[1][0], o[1][1], 0, false); w1 = __builtin_amdgcn_cvt_pk_fp8_f32(o[1][2], o[1][3], w1, true);
            *(v2u*)(ACT + (size_t)(row0 + ai * HALF + m * 16) * FF + col0) = (v2u){(unsigned)w0, (unsigned)w1}; }
        return false;
    }
};
struct EpiDown {
    unsigned char* YS; const float* bdn; const int* rowslot; const float* roww;
    __device__ __forceinline__ bool operator()(f32x4 (&acc)[2][2][4][2], const Unit& u, int wr, int wc, int fr, int fq) const {
        const int row0 = u.pm * BM + wr * 64 + fr, col0 = u.pn * BM + wc * 32 + 8 * fq;
        const float* bp = bdn + (size_t)u.aux * D + col0;
        f32x4 bv[2][2];
#pragma unroll
        for (int bj = 0; bj < 2; ++bj)
#pragma unroll
            for (int n = 0; n < 2; ++n) bv[bj][n] = *(const f32x4*)(bp + bj * HALF + 4 * n);
        EPI_ROWLOOP { const int row = row0 + ai * HALF + m * 16; const int slot = rowslot[row]; const float w = roww[row] * YS_SCALE;
            if (slot >= 0) { unsigned char* rowp = YS + (size_t)slot * D + col0;
#pragma unroll
                for (int bj = 0; bj < 2; ++bj) { const f32x4 o0 = (acc[ai][bj][m][0] + bv[bj][0]) * w, o1 = (acc[ai][bj][m][1] + bv[bj][1]) * w;
                    int w0 = __builtin_amdgcn_cvt_pk_fp8_f32(o0[0], o0[1], 0, false); w0 = __builtin_amdgcn_cvt_pk_fp8_f32(o0[2], o0[3], w0, true);
                    int w1 = __builtin_amdgcn_cvt_pk_fp8_f32(o1[0], o1[1], 0, false); w1 = __builtin_amdgcn_cvt_pk_fp8_f32(o1[2], o1[3], w1, true);
                    *(v2u*)(rowp + bj * HALF) = (v2u){(unsigned)w0, (unsigned)w1}; } } }
        return false;
    }
};
#undef EPI_ROWLOOP
}

#define XB_TMO      128
#define XB_XCNT(j)  (256  + 64 * (j))
#define XB_XSUB(j)  (1280 + 64 * (j))
#define XB_XGEN(j)  (2304 + 64 * (j))
#define XB_TOP      3328
#define XB_TOPGEN   3392
#define XCD_BAR_WORDS 3456
#define XB_SPIN_CAP (1u << 18)

__device__ __forceinline__ unsigned xb_ld(unsigned* p)              { return __hip_atomic_load(p, __ATOMIC_RELAXED, __HIP_MEMORY_SCOPE_AGENT); }
__device__ __forceinline__ unsigned xb_add(unsigned* p, unsigned v) { return __hip_atomic_fetch_add(p, v, __ATOMIC_RELAXED, __HIP_MEMORY_SCOPE_AGENT); }
__device__ __forceinline__ unsigned xb_xcc_id() { return (unsigned)__builtin_amdgcn_s_getreg((3 << 11) | 20) & 0xFu; }
#define XB_SPIN(cond, bar) do { unsigned _sp = 0; while (cond) { __builtin_amdgcn_s_sleep(1); \
    if ((++_sp & 255u) == 0u) { if (xb_ld(&(bar)[XB_TMO])) break; if (_sp > XB_SPIN_CAP) { atomicAdd(&(bar)[XB_TMO], 1u); break; } } } } while (0)

struct XcdBarrier {
    unsigned* bar; unsigned x;
    volatile LAS unsigned* st;
};

__device__ __forceinline__ XcdBarrier xcd_barrier_post(unsigned* bar, volatile LAS unsigned* st) {
    XcdBarrier b; b.bar = bar; b.x = xb_xcc_id(); b.st = st;
    if (threadIdx.x == 0) (void)xb_add(&bar[XB_XCNT(b.x)], 1u);
    return b;
}
__device__ __forceinline__ void xcd_barrier_complete(unsigned* bar, unsigned x, unsigned& nloc, unsigned& nx) {
    const unsigned G = gridDim.x * gridDim.y * gridDim.z;
    unsigned sum, cnt, mine, sp = 0u;
    for (;;) {
        sum = 0u; cnt = 0u; mine = 0u;
#pragma unroll
        for (unsigned j = 0; j < 16; ++j) { const unsigned c = xb_ld(&bar[XB_XCNT(j)]); sum += c; cnt += (c > 0u) ? 1u : 0u; mine = (j == x) ? c : mine; }
        if (sum == G) break;
        __builtin_amdgcn_s_sleep(1);
        if ((++sp & 255u) == 0u) { if (xb_ld(&bar[XB_TMO])) break; if (sp > XB_SPIN_CAP) { atomicAdd(&bar[XB_TMO], 1u); break; } }
    }
    nloc = mine > 0u ? mine : 1u; nx = cnt > 0u ? cnt : 1u;
}

__device__ __forceinline__ void xcd_barrier(const XcdBarrier& b) {
    asm volatile("s_waitcnt vmcnt(0)" ::: "memory");
    __syncthreads();
    if (threadIdx.x == 0) {
        unsigned* bar = b.bar;
        __builtin_amdgcn_s_waitcnt(0);
        unsigned nloc = b.st[0], nx = b.st[1];
        if (nloc == 0u) { xcd_barrier_complete(bar, b.x, nloc, nx); b.st[0] = nloc; b.st[1] = nx; }
        const unsigned old = xb_add(&bar[XB_XSUB(b.x)], 1u);
        const unsigned gen = old / nloc;
        if (old + 1u == (gen + 1u) * nloc) {
            __builtin_amdgcn_fence(__ATOMIC_RELEASE, "agent");
            asm volatile("s_waitcnt vmcnt(0)" ::: "memory");
            const unsigned og = xb_add(&bar[XB_TOP], 1u);
            const unsigned tg = og / nx;
            if (og + 1u == (tg + 1u) * nx) xb_add(&bar[XB_TOPGEN], 1u);
            else XB_SPIN(xb_ld(&bar[XB_TOPGEN]) == tg, bar);
            __builtin_amdgcn_fence(__ATOMIC_ACQUIRE, "agent");
            xb_add(&bar[XB_XGEN(b.x)], 1u);
            asm volatile("s_waitcnt vmcnt(0)" ::: "memory");
        } else {
            XB_SPIN(xb_ld(&bar[XB_XGEN(b.x)]) == gen, bar);
            __builtin_amdgcn_fence(__ATOMIC_ACQUIRE, "agent");
            asm volatile("s_waitcnt vmcnt(0)" ::: "memory");
        }
    }
    __syncthreads();
}
struct Frame {
    LAS unsigned char* lds;
    volatile LAS unsigned* MISC;
    gu32* ctl;
    int tid, lane, wave;
    int vcu, G;
    unsigned char* ws;
    __amdgpu_buffer_rsrc_t rsrc;
};

#define PHASE_FRAME(F0) Frame F = (F0); { int t_ = threadIdx.x; asm volatile("" : "+v"(t_)); F.tid = t_; F.lane = t_ & 63; F.wave = __builtin_amdgcn_readfirstlane(t_ >> 6); }

__device__ __forceinline__ void tr_item(const float* W, size_t ldw, int k0, int c0, bf16* WT, size_t ldt, int drow0, LAS float* scr, int lane) {
    const int kr = lane >> 4, cq = lane & 15;
    f32x4 v[16];
#pragma unroll
    for (int i = 0; i < 16; ++i) v[i] = *(const GAS f32x4*)(W + (size_t)(k0 + 4 * i + kr) * ldw + c0 + 4 * cq);
#pragma unroll
    for (int i = 0; i < 16; ++i)
#pragma unroll
        for (int j = 0; j < 4; ++j) scr[(4 * cq + j) * 65 + 4 * i + kr] = v[i][j];
    LDS_WAIT(); asm volatile("" ::: "memory");
    const int c = lane & 7;
#pragma unroll
    for (int jj = 0; jj < 8; ++jj) { const int n = (lane >> 3) + 8 * jj; const LAS float* s = scr + n * 65 + 8 * c;
        v4u o; o.x = pk2(s[0], s[1]); o.y = pk2(s[2], s[3]); o.z = pk2(s[4], s[5]); o.w = pk2(s[6], s[7]);
        *(GAS v4u*)(WT + (size_t)(drow0 + n) * ldt + k0 + 8 * c) = o; }
    LDS_WAIT(); asm volatile("" ::: "memory");
}

typedef short s16x2 __attribute__((ext_vector_type(2)));
struct MoeItem { __amdgpu_buffer_rsrc_t rs; unsigned soff, rstep; int ldw, k0; unsigned char* WT; size_t ldt; int drow; };
__device__ __forceinline__ void tr8_load(const MoeItem& m, f32x4 (&v)[16], int lane) {
    const int kr = lane >> 4, cq = lane & 15;
    const int voff = (kr * m.ldw + 4 * cq) * 4;
#pragma unroll
    for (int i = 0; i < 16; ++i) v[i] = __builtin_bit_cast(f32x4, __builtin_amdgcn_raw_buffer_load_b128(m.rs, voff, (int)(m.soff + (unsigned)i * m.rstep), 0));
}
__device__ __forceinline__ void tr8_finish(const f32x4 (&v)[16], const MoeItem& m, LAS float* scr_, int lane) {
    LAS unsigned char* scr = (LAS unsigned char*)scr_;
    const int kr = lane >> 4, cq = lane & 15;
#pragma unroll
    for (int j = 0; j < 4; ++j) { unsigned w[4];
#pragma unroll
        for (int q = 0; q < 4; ++q) { s16x2 t = {0, 0};
            t = __builtin_amdgcn_cvt_scalef32_pk_fp8_f32(t, v[4 * q][j], v[4 * q + 1][j], F8_CVT_SCALE, false);
            t = __builtin_amdgcn_cvt_scalef32_pk_fp8_f32(t, v[4 * q + 2][j], v[4 * q + 3][j], F8_CVT_SCALE, true);
            w[q] = __builtin_bit_cast(unsigned, t); }
        *(LAS v4u*)(scr + (4 * cq + j) * 80 + kr * 16) = (v4u){w[0], w[1], w[2], w[3]}; }
    LDS_WAIT(); asm volatile("" ::: "memory");
    const int qd = lane & 3;
#pragma unroll
    for (int ps = 0; ps < 4; ++ps) { const int n = (lane >> 2) + 16 * ps; const LAS unsigned char* s = scr + n * 80 + qd * 4;
        const unsigned d0 = *(const LAS unsigned*)(s), d1 = *(const LAS unsigned*)(s + 16), d2 = *(const LAS unsigned*)(s + 32), d3 = *(const LAS unsigned*)(s + 48);
        const unsigned t0 = __builtin_amdgcn_perm(d1, d0, 0x05010400u), t1 = __builtin_amdgcn_perm(d1, d0, 0x07030602u), t2 = __builtin_amdgcn_perm(d3, d2, 0x05010400u), t3 = __builtin_amdgcn_perm(d3, d2, 0x07030602u);
        const v4u o = (v4u){__builtin_amdgcn_perm(t2, t0, 0x05040100u), __builtin_amdgcn_perm(t2, t0, 0x07060302u), __builtin_amdgcn_perm(t3, t1, 0x05040100u), __builtin_amdgcn_perm(t3, t1, 0x07060302u)};
        *(GAS v4u*)(m.WT + (size_t)(m.drow + n) * m.ldt + m.k0 + 16 * qd) = o; }
    LDS_WAIT(); asm volatile("" ::: "memory");
}
constexpr int MOE_J4 = 32 * 32 * 64, MOE_J5 = 32 * 32 * 32, MOE_NITEMS = MOE_J4 + MOE_J5;
__device__ __forceinline__ MoeItem moe_item(int r, const float* w_gu, const float* w_down, unsigned char* ws) {
    MoeItem m;
    if (r < MOE_J4) { const int e = r / 2048, q = r % 2048, kb = q / 64, cb = q % 64, c0 = cb * 64; const int cc = c0 & 2047;
        m.rs = __builtin_amdgcn_make_buffer_rsrc((void*)w_gu, 0, 0xffffffff, 0x00020000); m.ldw = 2 * FF; m.k0 = kb * 64;
        m.soff = (unsigned)(((size_t)e * D * 2 * FF + (size_t)kb * 64 * (2 * FF) + c0) * 4); m.rstep = 4u * (2 * FF) * 4u;
        m.WT = ws + WS_WGUT + (size_t)e * 2 * FF * D; m.ldt = D; m.drow = (cc >> 7) * 256 + (c0 >= 2048 ? 128 : 0) + (cc & 127); }
    else { r -= MOE_J4; const int e = r / 1024, q = r % 1024, kb = q / 32, cb = q % 32;
        m.rs = __builtin_amdgcn_make_buffer_rsrc((void*)w_down, 0, 0xffffffff, 0x00020000); m.ldw = D; m.k0 = kb * 64;
        m.soff = (unsigned)(((size_t)e * FF * D + (size_t)kb * 64 * D + cb * 64) * 4); m.rstep = 4u * D * 4u;
        m.WT = ws + WS_WDNT + (size_t)e * D * FF; m.ldt = FF; m.drow = cb * 64; }
    return m;
}
__device__ __forceinline__ MoeItem f8_item(const float* W, int ldw, int k0, int c0, unsigned char* WT, size_t ldt, int drow) {
    MoeItem m; m.rs = __builtin_amdgcn_make_buffer_rsrc((void*)W, 0, 0xffffffff, 0x00020000); m.ldw = ldw; m.k0 = k0;
    m.soff = (unsigned)(((size_t)k0 * ldw + c0) * 4); m.rstep = 4u * (unsigned)ldw * 4u; m.WT = WT; m.ldt = ldt; m.drow = drow; return m;
}

struct In {
    const float *x, *w_in, *rel_bias, *shift_mu, *w0, *w_up, *a0, *a_up, *g_up, *k_k, *k_a, *r_k, *lnx_w, *lnx_b, *proj_a, *proj_b, *w_out,
                *ln1_w, *ln1_b, *w_router, *b_router, *w_gu, *b_gu, *w_down, *b_down, *ln2_w, *ln2_b;
};

__device__ __forceinline__ void p0_prologue(Frame& F0, const In& I) {
    PHASE_FRAME(F0);
    LAS float* scr = (LAS float*)(F.lds + F.wave * 16640);
    const int gw = F.vcu * NWAVES + F.wave, NGW = F.G * NWAVES;
    unsigned char* ws = F.ws;
    constexpr int J0 = 32 * 167, J1 = 16 * 32, J2 = 16 * 32, J3 = 32 * 32;
    constexpr int NITEMS = J0 + J1 + J2 + J3;
    for (int it = gw; it < NITEMS; it += NGW) {
        int r = it;
        if (r < J0) { const int kb = r / 167, cb = r % 167, c0 = cb * 64; bf16* dst; int drow;
            if (c0 < 3072) { f32x4 tv[16];
                   const MoeItem m = (c0 < 2048) ? f8_item(I.w_in, D_IN, kb * 64, c0, (unsigned char*)(ws + WS_WQK8), D, c0) : f8_item(I.w_in, D_IN, kb * 64, c0, (unsigned char*)(ws + WS_WV8), D, c0 - 2048);
                   tr8_load(m, tv, F.lane); tr8_finish(tv, m, scr, F.lane); continue; }
            else if (c0 < 3072 + 2048) { dst = (bf16*)(ws + WS_WINT); drow = PJ_SEG + (c0 - 3072); }
            else if (c0 < 6592) { f32x4 tv[16]; const MoeItem m = f8_item(I.w_in, D_IN, kb * 64, c0, (unsigned char*)(ws + WS_WSV8), D, c0 - (3072 + 2048));
                   tr8_load(m, tv, F.lane); tr8_finish(tv, m, scr, F.lane); continue; }
            else { f32x4 tv[16]; const int cg = c0 - 6592, d0 = cg & 2047; const MoeItem m = f8_item(I.w_in, D_IN, kb * 64, c0, (unsigned char*)(ws + WS_WG8), D, (d0 >> 7) * 256 + (cg >= 2048 ? 128 : 0) + (d0 & 127));
                   tr8_load(m, tv, F.lane); tr8_finish(tv, m, scr, F.lane); continue; }
            tr_item(I.w_in, D_IN, kb * 64, c0, dst, D, drow, scr, F.lane); continue; } r -= J0;
        if (r < J1) { const int kb = r / 32, cb = r % 32; f32x4 tv[16]; const MoeItem m = f8_item(I.proj_a, D, kb * 64, cb * 64, (unsigned char*)(ws + WS_PAT), AW, cb * 64); tr8_load(m, tv, F.lane); tr8_finish(tv, m, scr, F.lane); continue; } r -= J1;
        if (r < J2) { const int kb = r / 32, cb = r % 32; f32x4 tv[16]; const MoeItem m = f8_item(I.proj_b, D, kb * 64, cb * 64, (unsigned char*)(ws + WS_PBT), RW, cb * 64); tr8_load(m, tv, F.lane); tr8_finish(tv, m, scr, F.lane); continue; } r -= J2;
        { const int kb = r / 32, cb = r % 32; f32x4 tv[16]; const MoeItem m = f8_item(I.w_out, D, kb * 64, cb * 64, (unsigned char*)(ws + WS_WOT), D, cb * 64);
          tr8_load(m, tv, F.lane); tr8_finish(tv, m, scr, F.lane); }
    }
    const int gt = F.vcu * (NWAVES * 64) + F.tid, NGT = F.G * NWAVES * 64;
    for (int i = gt; i < 2048 * 256; i += NGT) { const int n = i >> 8, k = i & 255; float v = 0.f;
        if (n < 1024) { if (k < DLORA) v = I.w_up[(size_t)k * RW + n]; }
        else { if (k >= 128 && k < 128 + ALORA) v = I.a_up[(size_t)(k - 128) * RW + (n - 1024)]; }
        ((bf16*)(ws + WS_WLA))[i] = (bf16)f2bf(v); }
    for (int i = gt; i < 1024 * 256; i += NGT) { const int n = i >> 8, k = i & 255; ((bf16*)(ws + WS_WLG))[i] = (bf16)f2bf(I.g_up[(size_t)k * RW + n]); }
    for (int i = gt; i < 64 * D / 16; i += NGT) ((GAS v4u*)((unsigned char*)(ws + WS_WSV8) + (size_t)(SHIFT_W - 2048) * D))[i] = (v4u){0u, 0u, 0u, 0u};
    for (int i = gt; i < RROWS; i += NGT) ((int*)(ws + WS_ROWSLOT))[i] = -1;
    for (size_t i = gt; i < (size_t)T * D / 8; i += NGT) { const f32x4 a = ((const GAS f32x4*)I.x)[2 * i], b = ((const GAS f32x4*)I.x)[2 * i + 1];
        v4u o; o.x = pk2(a.x, a.y); o.y = pk2(a.z, a.w); o.z = pk2(b.x, b.y); o.w = pk2(b.z, b.w); ((GAS v4u*)(ws + WS_XB16))[i] = o;
        int w0 = __builtin_amdgcn_cvt_pk_fp8_f32(a.x, a.y, 0, false); w0 = __builtin_amdgcn_cvt_pk_fp8_f32(a.z, a.w, w0, true);
        int w1 = __builtin_amdgcn_cvt_pk_fp8_f32(b.x, b.y, 0, false); w1 = __builtin_amdgcn_cvt_pk_fp8_f32(b.z, b.w, w1, true);
        ((GAS v2u*)(ws + WS_XB8))[i] = (v2u){(unsigned)w0, (unsigned)w1}; }
}

constexpr int P8_HS = 0, P8_PITCH = 2052, P8_PART = 131328, P8_LOG = 147712, P8_HIST = 149760;
template <bool SKIP_MIX>
__device__ __forceinline__ void p8_ln_router(Frame& F0, const In& I) {
    PHASE_FRAME(F0);
    LAS float* hs = (LAS float*)(F.lds + P8_HS); LAS float* part = (LAS float*)(F.lds + P8_PART); LAS float* lg = (LAS float*)(F.lds + P8_LOG); LAS int* hist = (LAS int*)(F.lds + P8_HIST);
    const int lane = F.lane, w = F.wave;
    if (F.tid < 32) hist[F.tid] = 0;
    const int kq = lane >> 4, col = lane & 15;
    float ln_w[32], ln_b[32];
#pragma unroll
    for (int j = 0; j < 8; ++j) { const f32x4 a = *(const GAS f32x4*)(I.ln1_w + 4 * lane + 256 * j), b = *(const GAS f32x4*)(I.ln1_b + 4 * lane + 256 * j);
#pragma unroll
        for (int e = 0; e < 4; ++e) { ln_w[4 * j + e] = a[e]; ln_b[4 * j + e] = b[e]; } }
    __syncthreads();
    const float* zsrc = I.x; const bf16* mixb = (const bf16*)(F.ws + WS_Z);
    for (int g = F.vcu; g < T / 16; g += F.G) {
        const int tok0 = g * 16;
        { f32x4 va[8], vb[8];
          const size_t tokA = (size_t)(tok0 + 2 * w), tokB = tokA + 1;
          const GAS f32x4* zra = (const GAS f32x4*)(zsrc + tokA * D) + lane; const GAS f32x4* zrb = (const GAS f32x4*)(zsrc + tokB * D) + lane;
          const GAS v2u* mra = (const GAS v2u*)(mixb + tokA * D) + lane; const GAS v2u* mrb = (const GAS v2u*)(mixb + tokB * D) + lane;
          v2u ma[8], mb[8];
#pragma unroll
          for (int j = 0; j < 8; ++j) { va[j] = zra[64 * j]; vb[j] = zrb[64 * j]; if (!SKIP_MIX) { ma[j] = mra[64 * j]; mb[j] = mrb[64 * j]; } }
#pragma unroll
          for (int j = 0; j < 8; ++j) { va[j] = va[j] * DN_ALPHA; vb[j] = vb[j] * DN_ALPHA;
              if (!SKIP_MIX) { va[j] += (f32x4){bflo(ma[j].x), bfhi(ma[j].x), bflo(ma[j].y), bfhi(ma[j].y)}; vb[j] += (f32x4){bflo(mb[j].x), bfhi(mb[j].x), bflo(mb[j].y), bfhi(mb[j].y)}; } }
#pragma unroll
          for (int tt = 0; tt < 2; ++tt) {
            const int tl = 2 * w + tt; const size_t tok = (size_t)(tok0 + tl);
            f32x4 v[8]; float s = 0.f;
#pragma unroll
            for (int j = 0; j < 8; ++j) { v[j] = tt ? vb[j] : va[j]; s += (v[j].x + v[j].y) + (v[j].z + v[j].w); }
            const float mean = wave_sum(s) * (1.f / D); float s2 = 0.f;
#pragma unroll
            for (int j = 0; j < 8; ++j) { v[j] = v[j] - mean; s2 += (v[j].x * v[j].x + v[j].y * v[j].y) + (v[j].z * v[j].z + v[j].w * v[j].w); }
            const float rstd = 1.f / sqrtf(wave_sum(s2) * (1.f / D) + LN_EPS);
            GAS v2u* h1 = (GAS v2u*)((bf16*)(F.ws + WS_H1) + tok * D) + lane;
            GAS unsigned* h1b = (GAS unsigned*)((unsigned char*)(F.ws + WS_H1B) + tok * D) + lane;
#pragma unroll
            for (int j = 0; j < 8; ++j) { f32x4 h;
#pragma unroll
                for (int e = 0; e < 4; ++e) h[e] = v[j][e] * rstd * ln_w[4 * j + e] + ln_b[4 * j + e];
                h1[64 * j] = (v2u){pg8::cvt_pk_bf16(h.x, h.y), pg8::cvt_pk_bf16(h.z, h.w)}; { int w8 = __builtin_amdgcn_cvt_pk_fp8_f32(h.x, h.y, 0, false); w8 = __builtin_amdgcn_cvt_pk_fp8_f32(h.z, h.w, w8, true); h1b[64 * j] = (unsigned)w8; }
                *(LAS f32x4*)(hs + tl * P8_PITCH + 4 * lane + 256 * j) = h; }
          } }
        __syncthreads();
        f32x4 c0 = (f32x4){0.f, 0.f, 0.f, 0.f}, c1 = c0;
        const LAS float* ap = hs + col * P8_PITCH + 256 * w + 4 * kq;
        const float* bp = I.w_router + (size_t)(256 * w + 4 * kq) * NE + col;
#pragma unroll 4
        for (int kk = 0; kk < 16; ++kk) {
            const f32x4 a = *(const LAS f32x4*)(ap + 16 * kk);
#pragma unroll
            for (int e = 0; e < 4; ++e) {
                const float b0 = bp[(size_t)(16 * kk + e) * NE], b1 = bp[(size_t)(16 * kk + e) * NE + 16];
                c0 = __builtin_amdgcn_mfma_f32_16x16x4f32(a[e], b0, c0, 0, 0, 0);
                c1 = __builtin_amdgcn_mfma_f32_16x16x4f32(a[e], b1, c1, 0, 0, 0);
            }
        }
#pragma unroll
        for (int i = 0; i < 4; ++i) { part[(w * 16 + 4 * kq + i) * 32 + col] = c0[i]; part[(w * 16 + 4 * kq + i) * 32 + 16 + col] = c1[i]; }
        __syncthreads();
        { const int tl = F.tid >> 5, e = F.tid & 31; float s = I.b_router[e];
#pragma unroll
            for (int ww = 0; ww < 8; ++ww) s += part[(ww * 16 + tl) * 32 + e];
            lg[tl * 32 + e] = s; }
        __syncthreads();
        if (F.tid < 16) {
            const int tl = F.tid; float lv[32];
#pragma unroll
            for (int e = 0; e < 32; ++e) lv[e] = lg[tl * 32 + e];
            int ti[4]; float tv[4];
#pragma unroll
            for (int k = 0; k < 4; ++k) { float best = -3.4e38f; int bi = 0;
#pragma unroll
                for (int e = 0; e < 32; ++e) { const bool tk = lv[e] > best; best = tk ? lv[e] : best; bi = tk ? e : bi; }
                ti[k] = bi; tv[k] = best;
#pragma unroll
                for (int e = 0; e < 32; ++e) lv[e] = (e == bi) ? -3.4e38f : lv[e]; }
            float ex[4], sum = 0.f;
#pragma unroll
            for (int k = 0; k < 4; ++k) { ex[k] = __expf(tv[k] - tv[0]); sum += ex[k]; }
            const float inv = 1.f / sum;
            *(GAS v4u*)((int*)(F.ws + WS_TOPI) + (size_t)(tok0 + tl) * 4) = (v4u){(unsigned)ti[0], (unsigned)ti[1], (unsigned)ti[2], (unsigned)ti[3]};
            *(GAS f32x4*)((float*)(F.ws + WS_GATE) + (size_t)(tok0 + tl) * 4) = (f32x4){ex[0] * inv, ex[1] * inv, ex[2] * inv, ex[3] * inv};
#pragma unroll
            for (int k = 0; k < 4; ++k) __hip_atomic_fetch_add(&hist[ti[k]], 1, __ATOMIC_RELAXED, __HIP_MEMORY_SCOPE_WORKGROUP);
        }
        __syncthreads();
    }
    if (F.tid < 32) { const int c = hist[F.tid]; if (c) __hip_atomic_fetch_add(F.ctl + CW_CNT + F.tid, (unsigned)c, RLX_AGENT); }
}

template <bool SKIP_MOE>
__device__ __forceinline__ void p12_final(Frame& F0, const In& I, float* out) {
    PHASE_FRAME(F0);
    const int lane = F.lane; const int gw = F.vcu * NWAVES + F.wave, NGW = F.G * NWAVES;
    float ln_w[32], ln_b[32];
#pragma unroll
    for (int j = 0; j < 8; ++j) { const f32x4 a = *(const GAS f32x4*)(I.ln2_w + 4 * lane + 256 * j), b = *(const GAS f32x4*)(I.ln2_b + 4 * lane + 256 * j);
#pragma unroll
        for (int e = 0; e < 4; ++e) { ln_w[4 * j + e] = a[e]; ln_b[4 * j + e] = b[e]; } }
    for (int tok = gw; tok < T; tok += NGW) {
        const GAS v2u* hr = (const GAS v2u*)((const bf16*)(F.ws + WS_H1) + (size_t)tok * D) + lane;
        f32x4 v[8]; float s = 0.f;
#pragma unroll
        for (int j = 0; j < 8; ++j) { const v2u hh = hr[64 * j]; v[j] = (f32x4){bflo(hh.x), bfhi(hh.x), bflo(hh.y), bfhi(hh.y)} * DN_ALPHA; }
        if (!SKIP_MOE) {
#pragma unroll
            for (int k = 0; k < 4; ++k) { const GAS unsigned* yr = (const GAS unsigned*)((const unsigned char*)(F.ws + WS_YSLOT) + ((size_t)tok * 4 + k) * D) + lane;
#pragma unroll
                for (int j = 0; j < 8; ++j) { const unsigned y = yr[64 * j]; const f32x2 lo = __builtin_amdgcn_cvt_pk_f32_fp8((int)y, false), hi = __builtin_amdgcn_cvt_pk_f32_fp8((int)y, true);
                    v[j].x += lo.x * YS_INV; v[j].y += lo.y * YS_INV; v[j].z += hi.x * YS_INV; v[j].w += hi.y * YS_INV; } }
        }
#pragma unroll
        for (int j = 0; j < 8; ++j) s += (v[j].x + v[j].y) + (v[j].z + v[j].w);
        const float mean = wave_sum(s) * (1.f / D); float s2 = 0.f;
#pragma unroll
        for (int j = 0; j < 8; ++j) { v[j] = v[j] - mean; s2 += (v[j].x * v[j].x + v[j].y * v[j].y) + (v[j].z * v[j].z + v[j].w * v[j].w); }
        const float rstd = 1.f / sqrtf(wave_sum(s2) * (1.f / D) + LN_EPS);
        GAS f32x4* o = (GAS f32x4*)(out + (size_t)tok * D) + lane;
#pragma unroll
        for (int j = 0; j < 8; ++j) { f32x4 h;
#pragma unroll
            for (int e = 0; e < 4; ++e) h[e] = v[j][e] * rstd * ln_w[4 * j + e] + ln_b[4 * j + e];
            o[64 * j] = h; }
    }
}
__device__ __forceinline__ void moe_tables(Frame& F) {
    LAS int* tab = (LAS int*)(F.lds + TAB_OFF);
    if (F.tid == 0) { int run = 0;
        for (int e = 0; e < NE; ++e) { const int c = (int)__hip_atomic_load(F.ctl + CW_CNT + e, RLX_AGENT); const int p = (c + 255) / 256 * 256; tab[32 + e] = run; run += p; tab[e] = run; }
        tab[64] = run / 256; }
    __syncthreads();
}

__device__ __forceinline__ void p9_scatter(Frame& F0, const In& I) {
    PHASE_FRAME(F0);
    moe_tables(F);
    LAS int* tab = (LAS int*)(F.lds + TAB_OFF);
    LAS int* lh = (LAS int*)(F.lds + 0);
    LAS int* lb = (LAS int*)(F.lds + 128);
    LAS int* dst = (LAS int*)(F.lds + 256);
    const int* topi = (const int*)(F.ws + WS_TOPI); const float* gate = (const float*)(F.ws + WS_GATE);
    for (int ch = F.vcu; ch < T / 128; ch += F.G) {
        if (F.tid < 32) lh[F.tid] = 0;
        __syncthreads();
        const int s = ch * 512 + F.tid; const int e = topi[s]; const float gv = gate[s];
        const int rank = __hip_atomic_fetch_add(&lh[e], 1, __ATOMIC_RELAXED, __HIP_MEMORY_SCOPE_WORKGROUP);
        __syncthreads();
        if (F.tid < 32) { const int c = lh[F.tid]; lb[F.tid] = c ? (int)__hip_atomic_fetch_add(F.ctl + CW_CUR + F.tid, (unsigned)c, RLX_AGENT) : 0; }
        __syncthreads();
        const int d = tab[32 + e] + lb[e] + rank;
        ((int*)(F.ws + WS_ROWSLOT))[d] = s; ((float*)(F.ws + WS_ROWW))[d] = gv; dst[F.tid] = d;
        __syncthreads();
#pragma unroll 1
        for (int i0 = F.wave * 64; i0 < F.wave * 64 + 64; i0 += 8) {
            v4u v[8][2]; int dd[8];
#pragma unroll
            for (int q = 0; q < 8; ++q) { const int i = i0 + q; const int tok = ch * 128 + (i >> 2); dd[q] = dst[i];
                const GAS v4u* src = (const GAS v4u*)((const unsigned char*)(F.ws + WS_H1B) + (size_t)tok * D) + F.lane;
                v[q][0] = src[0]; v[q][1] = src[64]; }
#pragma unroll
            for (int q = 0; q < 8; ++q) { GAS v4u* o = (GAS v4u*)((unsigned char*)(F.ws + WS_XG) + (size_t)dd[q] * D) + F.lane; o[0] = v[q][0]; o[64] = v[q][1]; }
        }
        __syncthreads();
    }
}

__device__ __forceinline__ void p10_moe_up(Frame& F0, const In& I) {
    PHASE_FRAME(F0);
    moe_tables(F);
    LAS int* tab = (LAS int*)(F.lds + TAB_OFF);
    pg8::SchedMoe S; S.t.init(tab[64], 16, F.G, (int)blockIdx.x);
    S.A = (unsigned)(WS_XG); S.B = (unsigned)(WS_WGUT); S.tsA = (unsigned)256 * D; S.tsB = (unsigned)256 * D; S.es = (unsigned)2 * FF * D; S.pad_end = tab;
    pg8::EpiSwiglu E{(unsigned char*)(F.ws + WS_ACT), I.b_gu};
    pg8::gemm_phase<pg8::EpiSwiglu, pg8::SchedMoe, true, true>(F.lds + RING_OFF, F.rsrc, D / 2, D / 2, D / 2, S, E);
}
__device__ __forceinline__ void p11_moe_down(Frame& F0, const In& I) {
    PHASE_FRAME(F0);
    moe_tables(F);
    LAS int* tab = (LAS int*)(F.lds + TAB_OFF);
    pg8::SchedMoe S; S.t.init(tab[64], 8, F.G, (int)blockIdx.x);
    S.A = (unsigned)(WS_ACT); S.B = (unsigned)(WS_WDNT); S.tsA = (unsigned)256 * FF; S.tsB = (unsigned)256 * FF; S.es = (unsigned)D * FF; S.pad_end = tab;
    pg8::EpiDown E{(unsigned char*)(F.ws + WS_YSLOT), I.b_down, (const int*)(F.ws + WS_ROWSLOT), (const float*)(F.ws + WS_ROWW)};
    pg8::gemm_phase<pg8::EpiDown, pg8::SchedMoe, true, true>(F.lds + RING_OFF, F.rsrc, FF / 2, FF / 2, FF / 2, S, E);
}

__device__ __forceinline__ void p1_proj(Frame& F0, const In& I) {
    PHASE_FRAME(F0);
    { pg8::SchedPlain S; S.t.init(T / 256, 2048 / 256, F.G, (int)blockIdx.x);
      S.A = (unsigned)(WS_XB16); S.B = (unsigned)(WS_WINT + (size_t)PJ_SEG * D * 2); S.tsA = (unsigned)256 * D * 2; S.tsB = (unsigned)256 * D * 2;
      pg8::EpiProj E{(bf16*)(F.ws + WS_PROJ), PJ_SEG, 0};
      pg8::gemm_phase<pg8::EpiProj, pg8::SchedPlain, true>(F.lds + RING_OFF, F.rsrc, D, D, D, S, E); }
    { pg8::SchedPlain S; S.t.init(T / 256, (SEG_PAD - 2048) / 256, F.G, (int)blockIdx.x);
      S.A = (unsigned)(WS_XB8); S.B = (unsigned)(WS_WSV8); S.tsA = (unsigned)256 * D; S.tsB = (unsigned)256 * D;
      pg8::EpiProj E{(bf16*)(F.ws + WS_PROJ), PJ_SEG + 2048, 0};
      pg8::gemm_phase<pg8::EpiProj, pg8::SchedPlain, true, true>(F.lds + RING_OFF, F.rsrc, D / 2, D / 2, D / 2, S, E); }
    { pg8::SchedPlain S; S.t.init(T / 256, (2 * AW) / 256, F.G, (int)blockIdx.x);
      S.A = (unsigned)(WS_XB8); S.B = (unsigned)(WS_WQK8); S.tsA = (unsigned)256 * D; S.tsB = (unsigned)256 * D;
      pg8::EpiProj E{(bf16*)(F.ws + WS_PROJ), 0, 4};
      pg8::gemm_phase<pg8::EpiProj, pg8::SchedPlain, true, true>(F.lds + RING_OFF, F.rsrc, D / 2, D / 2, D / 2, S, E); }
    { pg8::SchedPlain S; S.t.init(T / 256, (2 * D) / 256, F.G, (int)blockIdx.x);
      S.A = (unsigned)(WS_XB8); S.B = (unsigned)(WS_WG8); S.tsA = (unsigned)256 * D; S.tsB = (unsigned)256 * D;
      pg8::EpiGate E{(bf16*)(F.ws + WS_PROJ)};
      pg8::gemm_phase<pg8::EpiGate, pg8::SchedPlain, true, true>(F.lds + RING_OFF, F.rsrc, D / 2, D / 2, D / 2, S, E); }
    { pg8::SchedPlain S; S.t.init(AW / 256, T / 256, F.G, (int)blockIdx.x);
      S.A = (unsigned)(WS_WV8); S.B = (unsigned)(WS_XB8); S.tsA = (unsigned)256 * D; S.tsB = (unsigned)256 * D;
      pg8::EpiBf16 E{(bf16*)(F.ws + WS_VT), T};
      pg8::gemm_phase<pg8::EpiBf16, pg8::SchedPlain, true, true>(F.lds + RING_OFF, F.rsrc, D / 2, D / 2, D / 2, S, E); }
}

__device__ __forceinline__ float ftanh(float x) { return 2.0f * fsigmoid(2.0f * x) - 1.0f; }
__device__ __forceinline__ void p2_shift_attn(Frame& F0, const In& I) {
    PHASE_FRAME(F0);
    const int lane = F.lane; const int gw = F.vcu * NWAVES + F.wave, NGW = F.G * NWAVES;
    const bf16* PROJ = (const bf16*)(F.ws + WS_PROJ);
    for (int tok = gw; tok < T; tok += NGW) {
        const bool first = (tok % SEQ) == 0;
        const bf16* cur = PROJ + (size_t)tok * PROJ_LD + PJ_SEG; const bf16* prv = cur - PROJ_LD;
        bf16* rkv = (bf16*)(F.ws + WS_RKV) + (size_t)tok * (3 * RW); bf16* lin = (bf16*)(F.ws + WS_LORAIN) + (size_t)tok * LORA_LD;
#pragma unroll 1
        for (int it = 0; it < 7; ++it) { const int gi = it * 64 + lane; if (gi >= SHIFT_W / 8) break; const int c = gi * 8;
            const v4u cv = *(const GAS v4u*)(cur + c); v4u pv = (v4u){0u, 0u, 0u, 0u}; if (!first) pv = *(const GAS v4u*)(prv + c);
            const f32x4 m0 = *(const GAS f32x4*)(I.shift_mu + c), m1 = *(const GAS f32x4*)(I.shift_mu + c + 4);
            float v[8]; const unsigned cw[4] = {cv.x, cv.y, cv.z, cv.w}, pw[4] = {pv.x, pv.y, pv.z, pv.w};
#pragma unroll
            for (int j = 0; j < 4; ++j) { const float c0 = bflo(cw[j]), c1 = bfhi(cw[j]), p0 = bflo(pw[j]), p1 = bfhi(pw[j]); const float mu0 = (j < 2) ? m0[2 * j] : m1[2 * j - 4], mu1 = (j < 2) ? m0[2 * j + 1] : m1[2 * j - 3];
                v[2 * j] = c0 + (p0 - c0) * mu0; v[2 * j + 1] = c1 + (p1 - c1) * mu1; }
            bf16* dstp;
            if (c < 3 * RW) dstp = rkv + c;
            else if (c < 3 * RW + DLORA) { dstp = lin + (c - 3 * RW);
#pragma unroll
                for (int j = 0; j < 8; ++j) v[j] = ftanh(v[j]); }
            else if (c < 3 * RW + DLORA + ALORA) dstp = lin + 128 + (c - 3 * RW - DLORA);
            else { dstp = lin + 256 + (c - 3 * RW - DLORA - ALORA);
#pragma unroll
                for (int j = 0; j < 8; ++j) v[j] = fsigmoid(v[j]); }
            *(GAS v4u*)dstp = (v4u){pk2(v[0], v[1]), pk2(v[2], v[3]), pk2(v[4], v[5]), pk2(v[6], v[7])};
        }
        if (lane < 8) { const int c = (lane < 4) ? (DLORA + 8 * lane) : (128 + ALORA + 8 * (lane - 4)); *(GAS v4u*)(lin + c) = (v4u){0u, 0u, 0u, 0u}; }
    }
#if STAGE == 3
    { const int gt = F.vcu * (NWAVES * 64) + F.tid, NGT = F.G * NWAVES * 64;
      for (size_t i = gt; i < (size_t)T * RW / 8; i += NGT) ((GAS v4u*)(F.ws + WS_YB))[i] = (v4u){0u, 0u, 0u, 0u}; }
#endif
    LAS float* tbl = (LAS float*)(F.lds + 0);
    constexpr int AKV = 64 * 144, A_KOFF = 2048, A_VOFF = A_KOFF + 2 * AKV;
    const bf16* VT = (const bf16*)(F.ws + WS_VT); bf16* YA = (bf16*)(F.ws + WS_YA);
    const int r = lane & 31, hh = lane >> 5;
    const int rp = (r & 16) + 8 * ((r >> 2) & 1) + 4 * ((r >> 3) & 1) + (r & 3);
    const int srow = F.tid >> 3, spc = F.tid & 7;
    for (int task = F.vcu; task < BATCH * AH * (SEQ / 256); task += F.G) {
        const int bh = task >> 5, q256 = task & 31, b = bh >> 4, h = bh & 15, c0 = q256 * 4;
        const int q0 = q256 * 256 + F.wave * 32, cw = c0 + (F.wave >> 1);
        const int kc_lo = (c0 > LEFT) ? c0 - LEFT : 0, kc_hi = c0 + 3;
        __syncthreads();
        if (F.tid < REL_TABLE) tbl[F.tid] = I.rel_bias[h * REL_TABLE + F.tid];
        const size_t tokq = (size_t)b * SEQ + q0 + r;
        bf16x8 qf[4];
#pragma unroll
        for (int s = 0; s < 4; ++s) qf[s] = *(const GAS bf16x8*)(PROJ + tokq * PROJ_LD + PJ_Q + h * 64 + 16 * s + 8 * hh);
        f32x16 o0, o1;
#pragma unroll
        for (int i = 0; i < 16; ++i) { o0[i] = 0.f; o1[i] = 0.f; }
        float m_run = -1e30f, l_run = 0.f;
        v4u kreg, vreg;
#define AT_STAGE_LOAD(kc_) do { kreg = *(const GAS v4u*)(PROJ + ((size_t)b * SEQ + (size_t)(kc_) * 64 + srow) * PROJ_LD + PJ_K + h * 64 + spc * 8); \
                                vreg = *(const GAS v4u*)(VT + (size_t)(h * 64 + srow) * T + (size_t)b * SEQ + (size_t)(kc_) * 64 + spc * 8); } while (0)
#define AT_STAGE_WRITE(buf_) do { *(LAS v4u*)(F.lds + A_KOFF + (buf_) * AKV + srow * 144 + spc * 16) = kreg; *(LAS v4u*)(F.lds + A_VOFF + (buf_) * AKV + srow * 144 + spc * 16) = vreg; } while (0)
        AT_STAGE_LOAD(kc_lo); AT_STAGE_WRITE(0);
        __syncthreads();
#pragma unroll 1
        for (int kc = kc_lo; kc <= kc_hi; ++kc) {
            const int buf = (kc - kc_lo) & 1;
            if (kc < kc_hi) AT_STAGE_LOAD(kc + 1);
            if (kc >= cw - LEFT && kc <= cw) {
                const LAS unsigned char* Kb = F.lds + A_KOFF + buf * AKV; const LAS unsigned char* Vb = F.lds + A_VOFF + buf * AKV;
#pragma unroll
                for (int tt = 0; tt < 2; ++tt) {
                    const int kpos0 = kc * 64 + 32 * tt;
                    bf16x8 kf[4], va[2], vb[2];
#pragma unroll
                    for (int s = 0; s < 4; ++s) kf[s] = *(const LAS bf16x8*)(Kb + (32 * tt + rp) * 144 + 32 * s + 16 * hh);
#pragma unroll
                    for (int s2 = 0; s2 < 2; ++s2) { va[s2] = *(const LAS bf16x8*)(Vb + r * 144 + 64 * tt + 32 * s2 + 16 * hh); vb[s2] = *(const LAS bf16x8*)(Vb + (32 + r) * 144 + 64 * tt + 32 * s2 + 16 * hh); }
                    f32x16 st;
#pragma unroll
                    for (int i = 0; i < 16; ++i) st[i] = 0.f;
#pragma unroll
                    for (int s = 0; s < 4; ++s) st = __builtin_amdgcn_mfma_f32_32x32x16_bf16(kf[s], qf[s], st, 0, 0, 0);
                    const int dbase = (q0 + r) - (kpos0 + 8 * hh);
                    float mx = -1e30f;
                    if (q0 - (kpos0 + 31) >= MAX_PAST) {
                        const float bc = tbl[MAX_PAST + 63];
#pragma unroll
                        for (int i = 0; i < 16; ++i) { st[i] += bc; mx = fmaxf(mx, st[i]); }
                    } else {
#pragma unroll
                        for (int i = 0; i < 16; ++i) { int d = dbase - (16 * (i >> 3) + 4 * ((i >> 2) & 1) + (i & 3)); d = d < MAX_PAST ? d : MAX_PAST; st[i] += tbl[d + 63]; mx = fmaxf(mx, st[i]); }
                    }
                    mx = fmaxf(mx, __shfl_xor(mx, 32));
                    const float m_new = fmaxf(m_run, mx), alpha = __expf(m_run - m_new);
                    float ls = 0.f;
#pragma unroll
                    for (int i = 0; i < 16; ++i) { st[i] = __expf(st[i] - m_new); ls += st[i]; }
                    l_run = l_run * alpha + ls;
                    if (__builtin_amdgcn_ballot_w64(m_new != m_run)) {
#pragma unroll
                        for (int i = 0; i < 16; ++i) { o0[i] *= alpha; o1[i] *= alpha; } }
                    m_run = m_new;
#pragma unroll
                    for (int s2 = 0; s2 < 2; ++s2) {
                        v4u pw; pw.x = pg8::cvt_pk_bf16(st[8 * s2 + 0], st[8 * s2 + 1]); pw.y = pg8::cvt_pk_bf16(st[8 * s2 + 2], st[8 * s2 + 3]); pw.z = pg8::cvt_pk_bf16(st[8 * s2 + 4], st[8 * s2 + 5]); pw.w = pg8::cvt_pk_bf16(st[8 * s2 + 6], st[8 * s2 + 7]);
                        const bf16x8 pf = __builtin_bit_cast(bf16x8, pw);
                        o0 = __builtin_amdgcn_mfma_f32_32x32x16_bf16(va[s2], pf, o0, 0, 0, 0);
                        o1 = __builtin_amdgcn_mfma_f32_32x32x16_bf16(vb[s2], pf, o1, 0, 0, 0);
                    }
                }
            }
            if (kc < kc_hi) AT_STAGE_WRITE(buf ^ 1);
            __syncthreads();
        }
#undef AT_STAGE_LOAD
#undef AT_STAGE_WRITE
        const float inv = 1.0f / (l_run + __shfl_xor(l_run, 32));
        unsigned char* yo = (unsigned char*)YA + tokq * AW + h * 64 + 4 * hh;
        const float inv16 = inv * ACT8_SCALE;
#pragma unroll
        for (int g4 = 0; g4 < 4; ++g4) {
            int w0 = __builtin_amdgcn_cvt_pk_fp8_f32(o0[4 * g4] * inv16, o0[4 * g4 + 1] * inv16, 0, false); w0 = __builtin_amdgcn_cvt_pk_fp8_f32(o0[4 * g4 + 2] * inv16, o0[4 * g4 + 3] * inv16, w0, true);
            int w1 = __builtin_amdgcn_cvt_pk_fp8_f32(o1[4 * g4] * inv16, o1[4 * g4 + 1] * inv16, 0, false); w1 = __builtin_amdgcn_cvt_pk_fp8_f32(o1[4 * g4 + 2] * inv16, o1[4 * g4 + 3] * inv16, w1, true);
            *(GAS unsigned*)(yo + 8 * g4) = (unsigned)w0; *(GAS unsigned*)(yo + 32 + 8 * g4) = (unsigned)w1;
        }
    }
}

__device__ __forceinline__ void p6_merged(Frame& F0, const In& I) {
    PHASE_FRAME(F0);
    pg8::SchedTwo S; S.t.init(T / 256, D / 256, F.G, (int)blockIdx.x);
    S.A0 = (unsigned)(WS_YA); S.A1 = (unsigned)(WS_YB); S.B0 = (unsigned)(WS_PAT); S.B1 = (unsigned)(WS_PBT);
    S.tsA = (unsigned)256 * AW; S.tsB = (unsigned)256 * AW;
    pg8::EpiMerged E{(const bf16*)(F.ws + WS_PROJ), (bf16*)(F.ws + WS_MERGED)};
    pg8::gemm_phase<pg8::EpiMerged, pg8::SchedTwo, true, true, 0x00007b79>(F.lds + RING_OFF, F.rsrc, AW / 2, AW / 2, AW / 2, S, E);
}
__device__ __forceinline__ void p7_mix(Frame& F0, const In& I) {
    PHASE_FRAME(F0);
    pg8::SchedPlain S; S.t.init(T / 256, D / 256, F.G, (int)blockIdx.x);
    S.A = (unsigned)(WS_MERGED); S.B = (unsigned)(WS_WOT); S.tsA = (unsigned)256 * D; S.tsB = (unsigned)256 * D;
    pg8::EpiBf16 E{(bf16*)(F.ws + WS_Z), D};
    pg8::gemm_phase<pg8::EpiBf16, pg8::SchedPlain, true, true, 0x00007b79>(F.lds + RING_OFF, F.rsrc, D / 2, D / 2, D / 2, S, E);
}

__device__ __forceinline__ void p3_lora(Frame& F0, const In& I) {
    PHASE_FRAME(F0);
    { pg8::SchedPlain S; S.t.init(T / 256, 4, F.G, (int)blockIdx.x);
      S.A = (unsigned)(WS_LORAIN); S.B = (unsigned)(WS_WLA); S.tsA = (unsigned)256 * LORA_LD * 2; S.tsB = (unsigned)256 * 256 * 2;
      pg8::EpiLoraA<true> E{(float*)(F.ws + WS_DECAY), I.w0};
      pg8::gemm_phase<pg8::EpiLoraA<true>, pg8::SchedPlain, true>(F.lds + RING_OFF, F.rsrc, LORA_LD, 256, 256, S, E); }
    { pg8::SchedPlain S; S.t.init(T / 256, 4, F.G, (int)blockIdx.x);
      S.A = (unsigned)(WS_LORAIN); S.B = (unsigned)(WS_WLA + (size_t)1024 * 256 * 2); S.tsA = (unsigned)256 * LORA_LD * 2; S.tsB = (unsigned)256 * 256 * 2;
      pg8::EpiIclr E{(bf16*)(F.ws + WS_ICLR), I.a0};
      pg8::gemm_phase<pg8::EpiIclr, pg8::SchedPlain, true>(F.lds + RING_OFF, F.rsrc, LORA_LD, 256, 256, S, E); }
    { pg8::SchedPlain S; S.t.init(T / 256, 4, F.G, (int)blockIdx.x);
      S.A = (unsigned)(WS_LORAIN + 512); S.B = (unsigned)(WS_WLG); S.tsA = (unsigned)256 * LORA_LD * 2; S.tsB = (unsigned)256 * 256 * 2;
      pg8::EpiBf16 E{(bf16*)(F.ws + WS_G), RW};
      pg8::gemm_phase<pg8::EpiBf16, pg8::SchedPlain, true>(F.lds + RING_OFF, F.rsrc, LORA_LD, 256, 256, S, E); }
}

constexpr int CP = 144;
constexpr int CMAT = 64 * CP;
constexpr int C_RT = 0 * CMAT, C_ATT = 1 * CMAT, C_AAK = 2 * CMAT, C_ARKT = 3 * CMAT, C_WA = 4 * CMAT, C_WB = 6 * CMAT,
              C_MA = 8 * CMAT, C_MTA = 9 * CMAT, C_MB = 10 * CMAT, C_MTB = 11 * CMAT, C_SEG = 12 * CMAT, C_GAM = C_SEG + 8 * 64 * 4, C_TSCR = C_GAM + 256;
constexpr int C_AT = C_WB, C_BT = C_WB + CMAT, C_KT = C_MB, C_QYT = C_MA, C_QST = C_MTA, C_KHT = C_MTB, C_VT = C_WB;
static_assert(C_TSCR % 16 == 0 && C_TSCR + 8 * 5120 <= TAB_OFF, "P4a LDS map");
constexpr int CHK_UNIT_BYTES = 4 * 64 * 64 * 2;
#define CBAR() do { asm volatile("s_waitcnt lgkmcnt(0)" ::: "memory"); __builtin_amdgcn_s_barrier(); asm volatile("" ::: "memory"); } while (0)
template <int NT, class Epi>
__device__ __forceinline__ void cmm(const LAS unsigned char* X, const LAS unsigned char* Y, int mt0, int nt, int lane, const Epi& E) {
    const int lr = lane & 15, kq = lane >> 4;
    const bf16x8 b0 = *(const LAS bf16x8*)(Y + (nt * 16 + lr) * CP + kq * 16), b1 = *(const LAS bf16x8*)(Y + (nt * 16 + lr) * CP + kq * 16 + 64);
#pragma unroll
    for (int i = 0; i < NT; ++i) { const int mt = mt0 + i;
        const bf16x8 a0 = *(const LAS bf16x8*)(X + (mt * 16 + lr) * CP + kq * 16), a1 = *(const LAS bf16x8*)(X + (mt * 16 + lr) * CP + kq * 16 + 64);
        f32x4 acc = (f32x4){0.f, 0.f, 0.f, 0.f};
        acc = __builtin_amdgcn_mfma_f32_16x16x32_bf16(a0, b0, acc, 0, 0, 0);
        acc = __builtin_amdgcn_mfma_f32_16x16x32_bf16(a1, b1, acc, 0, 0, 0);
        E(mt, nt, acc); }
}
__device__ __forceinline__ v2u pack4(const f32x4& v) { return (v2u){pg8::cvt_pk_bf16(v[0], v[1]), pg8::cvt_pk_bf16(v[2], v[3])}; }
__device__ __forceinline__ f32x4 unpack4(const v2u w) { return (f32x4){bflo(w.x), bfhi(w.x), bflo(w.y), bfhi(w.y)}; }
__device__ __forceinline__ void p4a_chunk(Frame& F0, const In& I) {
    PHASE_FRAME(F0);
    LAS unsigned char* L = F.lds;
    const int lane = F.lane, w = F.wave, lr = lane & 15, kq = lane >> 4;
    const bf16* RKV = (const bf16*)(F.ws + WS_RKV); const float* LW = (const float*)(F.ws + WS_DECAY); const bf16* ICL = (const bf16*)(F.ws + WS_ICLR);
    unsigned char* CHK = F.ws + WS_CHK;
    int uit = 0;
    for (int unit = F.vcu; unit < BATCH * RH * (SEQ / 64); unit += F.G, ++uit) {
        const int bh = unit >> 7, ck = unit & 127, b = bh >> 4, h = bh & 15;
        const size_t tok0 = (size_t)b * SEQ + (size_t)ck * 64 + 8 * w;
        const int hc = h * 64 + lane;
        float lwv[8], ic[8], rr[8], kk[8], vv[8];
#pragma unroll
        for (int i = 0; i < 8; ++i) { const size_t tok = tok0 + i; lwv[i] = LW[tok * RW + hc]; ic[i] = bf2f(ICL[tok * RW + hc]);
            rr[i] = bf2f(RKV[tok * (3 * RW) + hc]); kk[i] = bf2f(RKV[tok * (3 * RW) + RW + hc]); vv[i] = bf2f(RKV[tok * (3 * RW) + 2 * RW + hc]); }
        const float kkp = I.k_k[hc], kap = I.k_a[hc];
        float cs[8]; { float run = 0.f;
#pragma unroll
            for (int i = 0; i < 8; ++i) { run += lwv[i]; cs[i] = run; } }
        __syncthreads();
        ((LAS float*)(L + C_SEG))[w * 64 + lane] = cs[7];
        CBAR();
        float pre = 0.f, tot = 0.f;
#pragma unroll
        for (int j = 0; j < 8; ++j) { const float sg = ((const LAS float*)(L + C_SEG))[j * 64 + lane]; tot += sg; pre += (j < w) ? sg : 0.f; }
        if (w == 0) ((LAS float*)(L + C_GAM))[lane] = __expf(tot);
        unsigned att[4], bht[4], kht[4], vtt[4];
        float at_[8], bh_[8], kh_[8]; const float gtot = __expf(tot); float ep_prev = 1.f;
#pragma unroll
        for (int i = 0; i < 8; ++i) { const int t = 8 * w + i; const float cum = pre + cs[i], cump = cum - lwv[i];
            const float kkv = kk[i] * kkp; const float n2 = wave_sum(kkv * kkv); const float kkn = kkv * __builtin_amdgcn_rsqf(fmaxf(n2, 1e-24f));
            const float a = -kkn, bb = kkn * ic[i], kp = kk[i] * (1.0f + (ic[i] - 1.0f) * kap);
            const float ep = __expf(cum), em = __builtin_amdgcn_rcpf(ep), epp = (i == 0) ? __expf(cump) : ep_prev, eL = gtot * em; ep_prev = ep;
            const float Rv = rr[i] * ep, Av = a * epp, Bv = bb * em, Kv = kp * em;
            at_[i] = Av; bh_[i] = bb * eL; kh_[i] = kp * eL;
            *(LAS unsigned short*)(L + C_RT + t * CP + lane * 2) = (unsigned short)f2bf(Rv);
            *(LAS unsigned short*)(L + C_AT + t * CP + lane * 2) = (unsigned short)f2bf(Av);
            *(LAS unsigned short*)(L + C_BT + t * CP + lane * 2) = (unsigned short)f2bf(Bv);
            *(LAS unsigned short*)(L + C_KT + t * CP + lane * 2) = (unsigned short)f2bf(Kv); }
#pragma unroll
        for (int q = 0; q < 4; ++q) { att[q] = pk2(at_[2 * q], at_[2 * q + 1]); bht[q] = pk2(bh_[2 * q], bh_[2 * q + 1]); kht[q] = pk2(kh_[2 * q], kh_[2 * q + 1]); vtt[q] = pk2(vv[2 * q], vv[2 * q + 1]); }
        *(LAS v4u*)(L + C_ATT + lane * CP + 16 * w) = (v4u){att[0], att[1], att[2], att[3]};
        *(LAS v4u*)(L + C_WA + (64 + lane) * CP + 16 * w) = (v4u){bht[0], bht[1], bht[2], bht[3]};
        CBAR();
        const int cit = (uit * F.G + F.vcu) * 16 + w * 2; const bool hx = cit < MOE_NITEMS, hy = cit + 1 < MOE_NITEMS;
        f32x4 tX[16]; MoeItem mX = moe_item(hx ? cit : 0, I.w_gu, I.w_down, F.ws);
        LAS float* tscr = (LAS float*)(L + C_TSCR + w * 5120);
        struct Fr { bf16x8 a, b; };
        auto LD = [&](int base, int tile) -> Fr { const LAS unsigned char* q = L + base + (tile * 16 + lr) * CP + kq * 16; Fr f; f.a = *(const LAS bf16x8*)q; f.b = *(const LAS bf16x8*)(q + 64); return f; };
        auto MM = [&](const Fr& x, const Fr& y) -> f32x4 { f32x4 acc = (f32x4){0.f, 0.f, 0.f, 0.f};
            acc = __builtin_amdgcn_mfma_f32_16x16x32_bf16(x.a, y.a, acc, 0, 0, 0); acc = __builtin_amdgcn_mfma_f32_16x16x32_bf16(x.b, y.b, acc, 0, 0, 0); return acc; };
        const int nt = w & 3, mt0 = 2 * (w >> 2), n = nt * 16 + lr;
        { const Fr yAT = LD(C_AT, nt), yKT = LD(C_KT, nt), yRT = LD(C_RT, nt);
          Fr xBT[2], xAT[2], xKT[2];
#pragma unroll
          for (int i = 0; i < 2; ++i) { xBT[i] = LD(C_BT, mt0 + i); xAT[i] = LD(C_AT, mt0 + i); xKT[i] = LD(C_KT, mt0 + i); }
          f32x4 a1[2], a2[2], a3[2], a4[2];
#pragma unroll
          for (int i = 0; i < 2; ++i) { a1[i] = MM(xBT[i], yAT); a2[i] = MM(xAT[i], yKT); a3[i] = MM(xBT[i], yRT); a4[i] = MM(xKT[i], yRT); }
#pragma unroll
          for (int i = 0; i < 2; ++i) { const int m0 = (mt0 + i) * 16 + 4 * kq;
              f32x4 v = a1[i];
#pragma unroll
              for (int e = 0; e < 4; ++e) { v[e] = (m0 + e < n) ? v[e] : 0.f; *(LAS unsigned short*)(L + C_MA + (m0 + e) * CP + n * 2) = (unsigned short)f2bf(v[e]); }
              *(LAS v2u*)(L + C_MTA + n * CP + m0 * 2) = pack4(v);
              v = a2[i];
#pragma unroll
              for (int e = 0; e < 4; ++e) v[e] = (n < m0 + e) ? v[e] : 0.f;
              *(LAS v2u*)(L + C_AAK + n * CP + m0 * 2) = pack4(v);
              v = a3[i];
#pragma unroll
              for (int e = 0; e < 4; ++e) v[e] = (m0 + e <= n) ? v[e] : 0.f;
              *(LAS v2u*)(L + C_WA + n * CP + m0 * 2) = pack4(v);
              v = a4[i];
#pragma unroll
              for (int e = 0; e < 4; ++e) v[e] = (m0 + e <= n) ? v[e] : 0.f;
              *(LAS v2u*)(L + C_ARKT + n * CP + m0 * 2) = pack4(v); } }
        CBAR();
        if (hx) tr8_load(mX, tX, lane);
#pragma unroll
        for (int lvl = 0; lvl < 6; ++lvl) {
            const int Wsrc = (lvl & 1) ? C_WB : C_WA, Wdst = (lvl & 1) ? C_WA : C_WB, Ms = (lvl & 1) ? C_MB : C_MA, Mts = (lvl & 1) ? C_MTB : C_MTA, Md = (lvl & 1) ? C_MA : C_MB, Mtd = (lvl & 1) ? C_MTA : C_MTB;
            const Fr yW = LD(Wsrc, w); Fr yMt; if (lvl < 5) yMt = LD(Mts, nt);
            Fr xM[4], xS[2];
#pragma unroll
            for (int i = 0; i < 4; ++i) xM[i] = LD(Ms, i);
            if (lvl < 5) { xS[0] = LD(Ms, mt0); xS[1] = LD(Ms, mt0 + 1); }
            const int nj = w * 16 + lr;
            f32x4 old[4], aw[4], as[2];
#pragma unroll
            for (int i = 0; i < 4; ++i) old[i] = unpack4(*(const LAS v2u*)(L + Wsrc + nj * CP + (i * 16 + 4 * kq) * 2));
#pragma unroll
            for (int i = 0; i < 4; ++i) aw[i] = MM(xM[i], yW);
            if (lvl < 5) {
#pragma unroll
                for (int i = 0; i < 2; ++i) as[i] = MM(xS[i], yMt); }
#pragma unroll
            for (int i = 0; i < 4; ++i) *(LAS v2u*)(L + Wdst + nj * CP + (i * 16 + 4 * kq) * 2) = pack4(old[i] + aw[i]);
            if (lvl < 5) {
#pragma unroll
                for (int i = 0; i < 2; ++i) { const int m0 = (mt0 + i) * 16 + 4 * kq;
#pragma unroll
                    for (int e = 0; e < 4; ++e) *(LAS unsigned short*)(L + Md + (m0 + e) * CP + n * 2) = (unsigned short)f2bf(as[i][e]);
                    if (lvl < 4) *(LAS v2u*)(L + Mtd + n * CP + m0 * 2) = pack4(as[i]); } }
            if (lvl == 4) *(LAS v4u*)(L + C_KHT + lane * CP + 16 * w) = (v4u){kht[0], kht[1], kht[2], kht[3]};
            if (lvl == 2) { if (hx) tr8_finish(tX, mX, tscr, lane);
                            if (hy) { mX = moe_item(cit + 1, I.w_gu, I.w_down, F.ws); tr8_load(mX, tX, lane); } }
            CBAR();
        }
        *(LAS v4u*)(L + C_VT + lane * CP + 16 * w) = (v4u){vtt[0], vtt[1], vtt[2], vtt[3]};
        unsigned char* og = CHK + (size_t)unit * CHK_UNIT_BYTES;
        { const Fr yW1 = LD(C_WA, nt), yW2 = LD(C_WA + 64 * CP, nt);
          Fr xA[2], xK[2];
#pragma unroll
          for (int i = 0; i < 2; ++i) { xA[i] = LD(C_ATT, mt0 + i); xK[i] = LD(C_AAK, mt0 + i); }
          f32x4 rv[2], av[2], kv[2];
          const float gm = ((const LAS float*)(L + C_GAM))[n];
#pragma unroll
          for (int i = 0; i < 2; ++i) { const int m0 = (mt0 + i) * 16 + 4 * kq;
              rv[i] = unpack4(*(const LAS v2u*)(L + C_RT + n * CP + m0 * 2)); av[i] = unpack4(*(const LAS v2u*)(L + C_ARKT + n * CP + m0 * 2)); kv[i] = unpack4(*(const LAS v2u*)(L + C_KHT + n * CP + m0 * 2)); }
          f32x4 p7[2], p8[2], p9[2], p10[2];
#pragma unroll
          for (int i = 0; i < 2; ++i) { p7[i] = MM(xA[i], yW1); p8[i] = MM(xK[i], yW1); p9[i] = MM(xA[i], yW2); p10[i] = MM(xK[i], yW2); }
#pragma unroll
          for (int i = 0; i < 2; ++i) { const int m0 = (mt0 + i) * 16 + 4 * kq;
              *(GAS v2u*)(og + 0 * 8192 + n * 128 + m0 * 2) = pack4(p7[i] + rv[i]);
              *(LAS v2u*)(L + C_QYT + n * CP + m0 * 2) = pack4(p8[i] + av[i]);
              f32x4 v = p9[i];
#pragma unroll
              for (int e = 0; e < 4; ++e) v[e] += (m0 + e == n) ? gm : 0.f;
              *(GAS v2u*)(og + 1 * 8192 + n * 128 + m0 * 2) = pack4(v);
              *(LAS v2u*)(L + C_QST + n * CP + m0 * 2) = pack4(p10[i] + kv[i]); } }
        CBAR();
        { const Fr yQy = LD(C_QYT, nt), yQs = LD(C_QST, nt);
          Fr xV[2];
#pragma unroll
          for (int i = 0; i < 2; ++i) xV[i] = LD(C_VT, mt0 + i);
          f32x4 p11[2], p12[2];
#pragma unroll
          for (int i = 0; i < 2; ++i) { p11[i] = MM(xV[i], yQy); p12[i] = MM(xV[i], yQs); }
#pragma unroll
          for (int i = 0; i < 2; ++i) { const int m0 = (mt0 + i) * 16 + 4 * kq;
              *(GAS v2u*)(og + 2 * 8192 + n * 128 + m0 * 2) = pack4(p11[i]);
              *(GAS v2u*)(og + 3 * 8192 + n * 128 + m0 * 2) = pack4(p12[i]); } }
        if (hy) tr8_finish(tX, mX, tscr, lane);
    }
}

constexpr int C2_SLOT = 20480;
__device__ __forceinline__ void p4b_scan(Frame& F0, const In& I) {
    PHASE_FRAME(F0);
    const int lane = F.lane, lr = lane & 15, kq = lane >> 4;
    const unsigned char* CHK = F.ws + WS_CHK; bf16* YS = (bf16*)(F.ws + WS_YSCAN);
    for (int unit = F.vcu; unit < BATCH * RH * 4; unit += F.G) {
        const int bh = unit >> 2, rq = unit & 3, b = bh >> 4, h = bh & 15;
        if (F.wave == 0) {
            LAS unsigned char* Sl = F.lds + 3 * C2_SLOT;
            f32x4 S[4]; bf16x8 sf[2];
#pragma unroll
            for (int nt = 0; nt < 4; ++nt) S[nt] = (f32x4){0.f, 0.f, 0.f, 0.f};
#pragma unroll
            for (int ks = 0; ks < 2; ++ks)
#pragma unroll
                for (int j = 0; j < 8; ++j) sf[ks][j] = 0;
#define C2_DMA(ck_) do { const int ckc_ = (ck_) < SEQ / 64 ? (ck_) : SEQ / 64 - 1; const unsigned char* ug = CHK + ((size_t)bh * 128 + ckc_) * CHK_UNIT_BYTES; \
                LAS unsigned char* sl_ = F.lds + ((ck_) % 3) * C2_SLOT; \
                _Pragma("unroll") for (int j = 0; j < 16; ++j) __builtin_amdgcn_global_load_lds((const unsigned*)(ug + j * 1024 + lane * 16), (LAS unsigned*)(sl_ + j * 1024), 16, 0, 0); \
                _Pragma("unroll") for (int j = 0; j < 2; ++j) { \
                    __builtin_amdgcn_global_load_lds((const unsigned*)(ug + 2 * 8192 + (j * 32 + (lane >> 1)) * 128 + rq * 32 + (lane & 1) * 16), (LAS unsigned*)(sl_ + 16384 + j * 1024), 16, 0, 0); \
                    __builtin_amdgcn_global_load_lds((const unsigned*)(ug + 3 * 8192 + (j * 32 + (lane >> 1)) * 128 + rq * 32 + (lane & 1) * 16), (LAS unsigned*)(sl_ + 18432 + j * 1024), 16, 0, 0); } } while (0)
            C2_DMA(0); C2_DMA(1);
#pragma unroll 1
            for (int ck = 0; ck < SEQ / 64; ++ck) {
                asm volatile("s_waitcnt lgkmcnt(0)" ::: "memory");
                C2_DMA(ck + 2);
                asm volatile("s_waitcnt vmcnt(40)" ::: "memory");
                const LAS unsigned char* sl_ = F.lds + (ck % 3) * C2_SLOT;
#pragma unroll
                for (int nt = 0; nt < 4; ++nt) {
                    const bf16x8 py0 = *(const LAS bf16x8*)(sl_ + (16 * nt + lr) * 128 + kq * 16), py1 = *(const LAS bf16x8*)(sl_ + (16 * nt + lr) * 128 + kq * 16 + 64);
                    const bf16x8 ps0 = *(const LAS bf16x8*)(sl_ + 8192 + (16 * nt + lr) * 128 + kq * 16), ps1 = *(const LAS bf16x8*)(sl_ + 8192 + (16 * nt + lr) * 128 + kq * 16 + 64);
                    f32x4 y = unpack4(*(const LAS v2u*)(sl_ + 16384 + (16 * nt + lr) * 32 + kq * 8));
                    f32x4 s2 = unpack4(*(const LAS v2u*)(sl_ + 18432 + (16 * nt + lr) * 32 + kq * 8));
                    y = __builtin_amdgcn_mfma_f32_16x16x32_bf16(sf[0], py0, y, 0, 0, 0); y = __builtin_amdgcn_mfma_f32_16x16x32_bf16(sf[1], py1, y, 0, 0, 0);
                    *(GAS v2u*)(YS + ((size_t)b * SEQ + (size_t)ck * 64 + 16 * nt + lr) * RW + h * 64 + rq * 16 + 4 * kq) = pack4(y);
                    s2 = __builtin_amdgcn_mfma_f32_16x16x32_bf16(sf[0], ps0, s2, 0, 0, 0); s2 = __builtin_amdgcn_mfma_f32_16x16x32_bf16(sf[1], ps1, s2, 0, 0, 0);
                    S[nt] = s2; }
#pragma unroll
                for (int nt = 0; nt < 4; ++nt)
#pragma unroll
                    for (int i = 0; i < 4; ++i) *(LAS unsigned short*)(Sl + (4 * kq + i) * CP + (16 * nt + lr) * 2) = (unsigned short)f2bf(S[nt][i]);
                LDS_WAIT(); asm volatile("" ::: "memory");
                sf[0] = *(const LAS bf16x8*)(Sl + lr * CP + kq * 16); sf[1] = *(const LAS bf16x8*)(Sl + lr * CP + kq * 16 + 64);
                LDS_WAIT(); asm volatile("" ::: "memory");
            }
            asm volatile("s_waitcnt vmcnt(0)" ::: "memory");
#undef C2_DMA
        }
    }
}
static_assert(3 * C2_SLOT + 4096 + 5 * 16640 <= TAB_OFF, "P4b LDS map");

__device__ __forceinline__ void p5_post(Frame& F0, const In& I) {
    PHASE_FRAME(F0);
    const int lane = F.lane; const int gw = F.vcu * NWAVES + F.wave, NGW = F.G * NWAVES;
    const bf16* RKV = (const bf16*)(F.ws + WS_RKV); const bf16* ICL = (const bf16*)(F.ws + WS_ICLR); const bf16* YS = (const bf16*)(F.ws + WS_YSCAN);
    const bf16* G = (const bf16*)(F.ws + WS_G); bf16* YB = (bf16*)(F.ws + WS_YB);
    const int c0 = lane * 16;
    for (int tok = gw; tok < T; tok += NGW) {
        float y[16], rr[16], kk[16], vv[16], ic[16], gg[16];
#pragma unroll
        for (int q = 0; q < 2; ++q) { const v4u a = *(const GAS v4u*)(YS + (size_t)tok * RW + c0 + 8 * q), c = *(const GAS v4u*)(ICL + (size_t)tok * RW + c0 + 8 * q);
            const unsigned aw[4] = {a.x, a.y, a.z, a.w}, cw[4] = {c.x, c.y, c.z, c.w};
#pragma unroll
            for (int e = 0; e < 4; ++e) { y[8 * q + 2 * e] = bflo(aw[e]); y[8 * q + 2 * e + 1] = bfhi(aw[e]); ic[8 * q + 2 * e] = bflo(cw[e]); ic[8 * q + 2 * e + 1] = bfhi(cw[e]); } }
#pragma unroll
        for (int q = 0; q < 2; ++q) {
            const v4u a = *(const GAS v4u*)(RKV + (size_t)tok * (3 * RW) + c0 + 8 * q), bb = *(const GAS v4u*)(RKV + (size_t)tok * (3 * RW) + RW + c0 + 8 * q),
                      c = *(const GAS v4u*)(RKV + (size_t)tok * (3 * RW) + 2 * RW + c0 + 8 * q), d = *(const GAS v4u*)(G + (size_t)tok * RW + c0 + 8 * q);
            const unsigned aw[4] = {a.x, a.y, a.z, a.w}, bw[4] = {bb.x, bb.y, bb.z, bb.w}, cw[4] = {c.x, c.y, c.z, c.w}, dw[4] = {d.x, d.y, d.z, d.w};
#pragma unroll
            for (int e = 0; e < 4; ++e) { rr[8 * q + 2 * e] = bflo(aw[e]); rr[8 * q + 2 * e + 1] = bfhi(aw[e]); kk[8 * q + 2 * e] = bflo(bw[e]); kk[8 * q + 2 * e + 1] = bfhi(bw[e]);
                vv[8 * q + 2 * e] = bflo(cw[e]); vv[8 * q + 2 * e + 1] = bfhi(cw[e]); gg[8 * q + 2 * e] = bflo(dw[e]); gg[8 * q + 2 * e + 1] = bfhi(dw[e]); } }
        float s = 0.f, bs = 0.f;
#pragma unroll
        for (int e = 0; e < 16; ++e) { s += y[e]; const float kp = kk[e] * (1.0f + (ic[e] - 1.0f) * I.k_a[c0 + e]); bs += rr[e] * kp * I.r_k[c0 + e]; }
        s = quadsum(s); bs = quadsum(bs);
        const float mean = s * (1.f / 64.f); float s2 = 0.f;
#pragma unroll
        for (int e = 0; e < 16; ++e) { y[e] -= mean; s2 += y[e] * y[e]; }
        s2 = quadsum(s2);
        const float rstd = 1.f / sqrtf(s2 * (1.f / 64.f) + GN_EPS);
        float o[16];
#pragma unroll
        for (int e = 0; e < 16; ++e) o[e] = (y[e] * rstd * I.lnx_w[c0 + e] + I.lnx_b[c0 + e] + bs * vv[e]) * gg[e];
        { unsigned w8[4];
#pragma unroll
          for (int q = 0; q < 4; ++q) { int t8 = __builtin_amdgcn_cvt_pk_fp8_f32(o[4 * q] * ACT8_SCALE, o[4 * q + 1] * ACT8_SCALE, 0, false); t8 = __builtin_amdgcn_cvt_pk_fp8_f32(o[4 * q + 2] * ACT8_SCALE, o[4 * q + 3] * ACT8_SCALE, t8, true); w8[q] = (unsigned)t8; }
          *(GAS v4u*)((unsigned char*)YB + (size_t)tok * RW + c0) = (v4u){w8[0], w8[1], w8[2], w8[3]}; }
    }
}
#ifndef STAGE
#define STAGE 4
#endif
struct Args { In in; float* out; unsigned char* ws; };
__global__ void __launch_bounds__(NWAVES * 64, 2) mk_fwd(Args args) {
    extern __shared__ __attribute__((aligned(16))) unsigned char lds[];
    Frame F;
    F.lds = (LAS unsigned char*)lds;
    F.MISC = (volatile LAS unsigned*)(F.lds + MISC_OFF);
    F.tid = threadIdx.x; F.lane = F.tid & 63; F.wave = __builtin_amdgcn_readfirstlane(F.tid >> 6);
    F.G = gridDim.x; { const int bx = blockIdx.x; F.vcu = (F.G % 8 == 0) ? (bx % 8) * (F.G / 8) + bx / 8 : bx; }
    F.ws = args.ws;
    F.rsrc = __builtin_amdgcn_make_buffer_rsrc(args.ws, 0, 0xffffffff, 0x00020000);
    F.ctl = (gu32*)(args.ws + WS_CTL);
    for (int u = F.tid; u < (LDS_BYTES - MISC_OFF) / 4; u += NWAVES * 64) ((LAS unsigned*)(F.lds + MISC_OFF))[u] = 0u;
    __syncthreads();
    XcdBarrier bar = xcd_barrier_post((unsigned*)(F.ctl + CW_BAR), F.MISC + 8);
    const In& I = args.in;
#define GRID_BAR() xcd_barrier(bar)
#ifndef DUP_PHASE
#define DUP_PHASE -1
#endif
#define RUN(n, call) do { call; if (DUP_PHASE == (n)) { GRID_BAR(); call; } } while (0)

#if STAGE >= 2
    RUN(0, p0_prologue(F, I));
    GRID_BAR();
#endif
#if STAGE >= 3
    RUN(1, p1_proj(F, I));
    GRID_BAR();
    RUN(2, p2_shift_attn(F, I));
    GRID_BAR();
#if STAGE >= 4
    RUN(3, p3_lora(F, I));
    GRID_BAR();
    RUN(4, p4a_chunk(F, I));
    GRID_BAR();
    RUN(44, p4b_scan(F, I));
    GRID_BAR();
    RUN(5, p5_post(F, I));
    GRID_BAR();
#endif
    RUN(6, p6_merged(F, I));
    GRID_BAR();
    RUN(7, p7_mix(F, I));
    GRID_BAR();
#endif
    p8_ln_router<(STAGE < 3)>(F, I);
    GRID_BAR();
#if STAGE >= 2
    p9_scatter(F, I);
    GRID_BAR();
    RUN(10, p10_moe_up(F, I));
    GRID_BAR();
    RUN(11, p11_moe_down(F, I));
    GRID_BAR();
#endif
    RUN(12, p12_final<(STAGE < 2)>(F, I, args.out));
}

extern "C" void kernel_launch(void* const* d_in, const int* in_sizes, int n_in, void* d_out, int out_size, void* d_ws, size_t ws_size, hipStream_t stream) {
    static int grid = 0;
    if (grid == 0) {
        if (n_in != 27 || in_sizes[0] != T * D || out_size != T * D || ws_size < WS_END) { fprintf(stderr, "kernel_launch: unexpected shapes (n_in %d, in0 %d, out %d, ws %zu)\n", n_in, n_in > 0 ? in_sizes[0] : -1, out_size, ws_size); grid = -1; return; }
        int dev = 0, cus = 0, per_cu = 0;
        if (hipGetDevice(&dev) != hipSuccess || hipDeviceGetAttribute(&cus, hipDeviceAttributeMultiprocessorCount, dev) != hipSuccess) { grid = -1; return; }
        if (hipFuncSetAttribute((const void*)mk_fwd, hipFuncAttributeMaxDynamicSharedMemorySize, LDS_BYTES) != hipSuccess) { fprintf(stderr, "kernel_launch: hipFuncSetAttribute failed\n"); grid = -1; return; }
        if (hipOccupancyMaxActiveBlocksPerMultiprocessor(&per_cu, (const void*)mk_fwd, NWAVES * 64, LDS_BYTES) != hipSuccess || per_cu < 1)
            fprintf(stderr, "kernel_launch: occupancy query reports %d\n", per_cu);
        (void)hipGetLastError();
        grid = cus;
    }
    if (grid < 0) return;
    if (hipMemsetAsync((char*)d_ws + WS_CTL, 0, CTL_ZERO_BYTES, stream) != hipSuccess) return;
    Args a{};
    const float** ip = (const float**)&a.in;
    for (int i = 0; i < 27; ++i) ip[i] = (const float*)d_in[i];
    a.out = (float*)d_out; a.ws = (unsigned char*)d_ws;
    hipLaunchKernelGGL(mk_fwd, dim3(grid), dim3(NWAVES * 64), LDS_BYTES, stream, a);
    const hipError_t le = hipPeekAtLastError();
    if (le != hipSuccess) fprintf(stderr, "kernel_launch: launch failed: %s\n", hipGetErrorName(le));
}
```

```cpp
#define STAGE 4
#include <hip/hip_runtime.h>
#include <cstdio>
#include <cstdint>

#define GAS __attribute__((address_space(1)))
#define LAS __attribute__((address_space(3)))
typedef unsigned short bf16;
typedef unsigned v4u __attribute__((ext_vector_type(4)));
typedef unsigned v2u __attribute__((ext_vector_type(2)));
typedef float f32x4 __attribute__((ext_vector_type(4)));
typedef float f32x2 __attribute__((ext_vector_type(2)));
typedef float f32x16 __attribute__((ext_vector_type(16)));
typedef short bf16x8 __attribute__((ext_vector_type(8)));
typedef short bf16x4 __attribute__((ext_vector_type(4)));
typedef GAS unsigned gu32;

constexpr int NWAVES = 8;
constexpr int BATCH = 4, SEQ = 8192, D = 2048, T = BATCH * SEQ;
constexpr int CHUNK = 64, LEFT = 8, AH = 16, AD = 64, AW = 1024;
constexpr int REL_TABLE = 320, MAX_PAST = 256;
constexpr int RH = 16, RN = 64, RW = 1024, DLORA = 96, ALORA = 96, GLORA = 256;
constexpr int SHIFT_W = 3 * RW + DLORA + ALORA + GLORA;
constexpr int D_IN = 3 * AW + SHIFT_W + 2 * D;
constexpr int NE = 32, TOPK = 4, FF = 2048;
constexpr int MSLOT = T * TOPK;
constexpr int NBLK_MAX = (MSLOT + NE * 255 + 255) / 256;
constexpr int RROWS = NBLK_MAX * 256;
constexpr float LN_EPS = 1e-5f, GN_EPS = 64e-5f;
constexpr float YS_SCALE = 16.0f, YS_INV = 1.0f / 16.0f;
constexpr float ACT8_SCALE = 16.0f;
constexpr float F8_CVT_SCALE = 0.015625f;
constexpr float DN_ALPHA = 1.189207115002721f;
constexpr int PROJ_LD = 9728, PJ_Q = 0, PJ_K = 1024, PJ_SEG = 2048, SEG_PAD = 3584, PJ_GA = 5632, PJ_GB = 7680;
constexpr int LORA_LD = 512;

constexpr size_t MiB = 1u << 20;
constexpr size_t WS_CTL = 0, CTL_ZERO_BYTES = 1 * MiB;
constexpr size_t WS_TOPI = 2 * MiB;
constexpr size_t WS_GATE = 3 * MiB;
constexpr size_t WS_ROWSLOT = 4 * MiB;
constexpr size_t WS_ROWW = 5 * MiB;
constexpr size_t WS_WLA = 6 * MiB;
constexpr size_t WS_WLG = 7 * MiB;
constexpr size_t WS_PAT = 8 * MiB;
constexpr size_t WS_PBT = 12 * MiB;
constexpr size_t WS_WOT = 16 * MiB;
constexpr size_t WS_WVT = 24 * MiB;
constexpr size_t WS_WINT = 28 * MiB;
constexpr size_t WS_WG8 = 72 * MiB;
constexpr size_t WS_WQK8 = 80 * MiB;
constexpr size_t WS_WV8 = 84 * MiB;
constexpr size_t WS_WSV8 = 88 * MiB;
constexpr size_t WS_WGUT = 128 * MiB;
constexpr size_t WS_WDNT = 640 * MiB;
constexpr size_t WS_BASE0 = 1024 * MiB;
constexpr size_t WS_PROJ = WS_BASE0;
constexpr size_t WS_VT = WS_PROJ + 608 * MiB;
constexpr size_t WS_YA = WS_VT + 64 * MiB;
constexpr size_t WS_RKV = WS_YA + 64 * MiB;
constexpr size_t WS_LORAIN = WS_RKV + 192 * MiB;
constexpr size_t WS_DECAY = WS_LORAIN + 32 * MiB;
constexpr size_t WS_ICLR = WS_DECAY + 128 * MiB;
constexpr size_t WS_G = WS_ICLR + 128 * MiB;
constexpr size_t WS_YSCAN = WS_G + 64 * MiB;
constexpr size_t WS_YB = WS_YSCAN + 128 * MiB;
constexpr size_t WS_MERGED = WS_YB + 64 * MiB;
constexpr size_t WS_XB16 = WS_MERGED + 128 * MiB;
constexpr size_t WS_MIX_END = WS_XB16 + 128 * MiB;
constexpr size_t WS_Z = 2816 * MiB;
constexpr size_t WS_H1 = 3072 * MiB;
constexpr size_t WS_H1B = 3328 * MiB;
constexpr size_t WS_CHK = 3456 * MiB;
constexpr size_t WS_XB8 = 3712 * MiB;
constexpr size_t WS_END = 3776 * MiB;
constexpr size_t WS_XG = WS_BASE0;
constexpr size_t WS_ACT = WS_BASE0 + 544 * MiB;
constexpr size_t WS_YSLOT = WS_BASE0 + 1088 * MiB;
static_assert(WS_MIX_END <= WS_Z && WS_YSLOT + 512 * MiB <= WS_Z, "ws map");
static_assert(WS_WINT + (size_t)PROJ_LD * D * 2 <= WS_WGUT, "ws map");

constexpr int CW_CNT = 512;
constexpr int CW_CUR = 576;
constexpr int CW_BAR = 4096;

constexpr int RING_OFF = 0, RING_BYTES = 131072;
constexpr int LDS_BYTES = 160 * 1024;
constexpr int MISC_OFF = LDS_BYTES - 512;
constexpr int TAB_OFF = LDS_BYTES - 1024;

#define RLX_AGENT __ATOMIC_RELAXED, __HIP_MEMORY_SCOPE_AGENT
#define LDS_WAIT() asm volatile("s_waitcnt lgkmcnt(0)" ::: "memory")
#define VM_WAIT() asm volatile("s_waitcnt vmcnt(0)" ::: "memory")
__device__ __forceinline__ unsigned f2bf(float f) { unsigned u = __builtin_bit_cast(unsigned, f); return (u + 0x7fffu + ((u >> 16) & 1u)) >> 16; }
__device__ __forceinline__ unsigned pk2(float lo, float hi) { return f2bf(lo) | (f2bf(hi) << 16); }
__device__ __forceinline__ float bf2f(unsigned short h) { return __builtin_bit_cast(float, (unsigned)h << 16); }
__device__ __forceinline__ float bflo(unsigned w) { return __builtin_bit_cast(float, w << 16); }
__device__ __forceinline__ float bfhi(unsigned w) { return __builtin_bit_cast(float, w & 0xffff0000u); }
__device__ __forceinline__ float fsigmoid(float x) { return __builtin_amdgcn_rcpf(1.0f + __expf(-x)); }
__device__ __forceinline__ float dpp_f(float x, const int ctrl_sel) {
    const int xi = __builtin_bit_cast(int, x); int r;
    if (ctrl_sel == 0) r = __builtin_amdgcn_update_dpp(0, xi, 0xB1, 0xF, 0xF, false);
    else if (ctrl_sel == 1) r = __builtin_amdgcn_update_dpp(0, xi, 0x4E, 0xF, 0xF, false);
    else if (ctrl_sel == 2) r = __builtin_amdgcn_update_dpp(0, xi, 0x124, 0xF, 0xF, false);
    else r = __builtin_amdgcn_update_dpp(0, xi, 0x128, 0xF, 0xF, false);
    return __builtin_bit_cast(float, r);
}
__device__ __forceinline__ float rowsum16(float x) { x += dpp_f(x, 0); x += dpp_f(x, 1); x += dpp_f(x, 2); x += dpp_f(x, 3); return x; }
__device__ __forceinline__ float quadsum(float x) { x += dpp_f(x, 0); x += dpp_f(x, 1); return x; }
__device__ __forceinline__ float wave_sum(float v) {
    v = rowsum16(v);
    const int vi = __builtin_bit_cast(int, v);
    const float s0 = __builtin_bit_cast(float, __builtin_amdgcn_readlane(vi, 0)), s1 = __builtin_bit_cast(float, __builtin_amdgcn_readlane(vi, 16));
    const float s2 = __builtin_bit_cast(float, __builtin_amdgcn_readlane(vi, 32)), s3 = __builtin_bit_cast(float, __builtin_amdgcn_readlane(vi, 48));
    return (s0 + s1) + (s2 + s3);
}
namespace pg8 {
#define PG8_LAS __attribute__((address_space(3)))
typedef unsigned short bf16_t;
typedef unsigned u32x4 __attribute__((ext_vector_type(4)));
constexpr int BM = 256, BK = 64, HALF = 128, HTB = HALF * BK * 2, STAGE_BYTES = 8 * HTB, NXCD = 8, WGM = 8;

__host__ __device__ __forceinline__ int lds_byte(int r, int c) { const int st = (r >> 4) * 2 + (c >> 5), rr = r & 15, cc = c & 31, ob = rr * 64 + cc * 2; return st * 1024 + (ob ^ (((ob >> 9) & 1) << 5)); }
__host__ __device__ __forceinline__ void stage_rc(int b, int& R, int& C) { const int st = b / 1024, sb = b % 1024, swz = sb ^ (((sb >> 9) & 1) << 5); R = (st >> 1) * 16 + swz / 64; C = (st & 1) * 32 + (swz % 64) / 2; }
__host__ __device__ __forceinline__ int perm32(int rho) { const int n = rho >> 4, i = rho & 15; return 8 * (i >> 2) + 4 * n + (i & 3); }

struct Unit { int pm, pn, aux; };

struct Tiler {
    int nM, nN, nwg, G, c;
    __device__ __forceinline__ void init(int nM_, int nN_, int G_, int c_) { nM = nM_; nN = nN_; nwg = nM * nN; G = G_; c = c_; }
    __device__ __forceinline__ bool map(int i, int& pm, int& pn) const {
        const long L = (long)i * G + c; if (L >= nwg) return false;
        int wgid = (int)L; { const int q = nwg / NXCD, r = nwg % NXCD, xcd = wgid % NXCD, off = wgid / NXCD; wgid = (xcd < r ? xcd * (q + 1) : r * (q + 1) + (xcd - r) * q) + off; }
        const int nig = WGM * nN, gid = wgid / nig, fm = gid * WGM, gsz = (nM - fm) < WGM ? (nM - fm) : WGM;
        pm = fm + ((wgid % nig) % gsz); pn = (wgid % nig) / gsz; return true;
    }
};
struct SchedPlain {
    Tiler t; unsigned A, B, tsA, tsB;
    __device__ __forceinline__ bool next(int i, Unit& u) const { u.aux = 0; return t.map(i, u.pm, u.pn); }
    __device__ __forceinline__ void bases(const Unit& u, unsigned& a, unsigned& b) const { a = A + (unsigned)u.pm * tsA; b = B + (unsigned)u.pn * tsB; }
};
struct SchedTwo {
    Tiler t; unsigned A0, A1, B0, B1, tsA, tsB;
    __device__ __forceinline__ bool next(int i, Unit& u) const { u.aux = i & 1; return t.map(i >> 1, u.pm, u.pn); }
    __device__ __forceinline__ void bases(const Unit& u, unsigned& a, unsigned& b) const { a = (u.aux ? A1 : A0) + (unsigned)u.pm * tsA; b = (u.aux ? B1 : B0) + (unsigned)u.pn * tsB; }
};
struct SchedMoe {
    Tiler t; unsigned A, B, tsA, tsB, es; const PG8_LAS int* pad_end;
    __device__ __forceinline__ bool next(int i, Unit& u) const {
        if (!t.map(i, u.pm, u.pn)) return false;
        const int row0 = u.pm * BM; int e = 0;
#pragma unroll
        for (int j = 0; j < 32; ++j) e += (pad_end[j] <= row0) ? 1 : 0;
        u.aux = __builtin_amdgcn_readfirstlane(e < 31 ? e : 31); return true;
    }
    __device__ __forceinline__ void bases(const Unit& u, unsigned& a, unsigned& b) const { a = A + (unsigned)u.pm * tsA; b = B + (unsigned)u.aux * es + (unsigned)u.pn * tsB; }
};

typedef float f32x2_t_ __attribute__((ext_vector_type(2)));
typedef __bf16 bf16x2_t_ __attribute__((ext_vector_type(2)));
__device__ __forceinline__ unsigned cvt_pk_bf16(float lo, float hi) { const f32x2_t_ v = {lo, hi}; const bf16x2_t_ b = __builtin_convertvector(v, bf16x2_t_); return __builtin_bit_cast(unsigned, b); }
__device__ __forceinline__ u32x4 pack8(const f32x4& v0, const f32x4& v1) { u32x4 w; w.x = cvt_pk_bf16(v0[0], v0[1]); w.y = cvt_pk_bf16(v0[2], v0[3]); w.z = cvt_pk_bf16(v1[0], v1[1]); w.w = cvt_pk_bf16(v1[2], v1[3]); return w; }

typedef int i32x8 __attribute__((ext_vector_type(8)));
typedef int i32x4 __attribute__((ext_vector_type(4)));
__device__ __forceinline__ i32x8 cat8(const bf16x8& a, const bf16x8& b) { return __builtin_shufflevector(__builtin_bit_cast(i32x4, a), __builtin_bit_cast(i32x4, b), 0, 1, 2, 3, 4, 5, 6, 7); }
constexpr int F8_SCALES = 0x00007f79;
template <class Epi, class Sched, bool ALIGN_EPI, bool F8 = false, int F8SC = F8_SCALES>
__device__ __forceinline__ void gemm_phase(PG8_LAS unsigned char* lds, const __amdgpu_buffer_rsrc_t rsrc, const int lda, const int ldb, const int K, const Sched& S, const Epi& E) {
    int tid_ = threadIdx.x; asm volatile("" : "+v"(tid_));
    const int tid = tid_, wid = __builtin_amdgcn_readfirstlane(tid >> 6), lane = tid & 63, wr = wid >> 2, wc = wid & 3, fr = lane & 15, fq = lane >> 4;
    const int nt = K / BK;
    unsigned voffA, voffB;
    { int R, C; stage_rc(tid * 16, R, C); const int Rb = (R & ~31) + perm32(R & 31); voffA = (unsigned)(R * lda + C) * 2u; voffB = (unsigned)(Rb * ldb + C) * 2u; }
    const unsigned p1voffA = 64u * (unsigned)lda * 2u, p1voffB = 64u * (unsigned)ldb * 2u;
    const unsigned kstep = (unsigned)(BK * 2);
    const unsigned hsA = (unsigned)HALF * lda * 2, hsB = (unsigned)HALF * ldb * 2;
    const unsigned ldsw = (unsigned)wid * 1024u;
    const int aoff = lds_byte(wr * 64 + fr, fq * 8), boff = lds_byte(wc * 32 + fr, fq * 8);
#define PG8_SA(b, h) (((b) * 2 + (h)) * HTB)
#define PG8_SB(b, h) ((4 + (b) * 2 + (h)) * HTB)
#define PG8_STAGE(bufoff, goff, voff) do { _Pragma("unroll") for (int _i = 0; _i < 2; ++_i) \
        __builtin_amdgcn_raw_ptr_buffer_load_lds(rsrc, (PG8_LAS void*)(lds + (bufoff) + ldsw + _i * 8192), 16, (int)(voff), (int)((goff) + _i * p1##voff), 0, 0); } while (0)
#define PG8_LD8(addr) __builtin_shufflevector(*(const PG8_LAS i32x4*)(addr), *(const PG8_LAS i32x4*)((addr) + 1024), 0, 1, 2, 3, 4, 5, 6, 7)
#define PG8_LDA(dst, b, h) do { _Pragma("unroll") for (int m = 0; m < 4; ++m) dst[m] = PG8_LD8(lds + PG8_SA(b, h) + aoff + m * 2048); } while (0)
#define PG8_LDB(dst, b, h) do { _Pragma("unroll") for (int n = 0; n < 2; ++n) dst[n] = PG8_LD8(lds + PG8_SB(b, h) + boff + n * 2048); } while (0)
#define PG8_LO(v) __builtin_bit_cast(bf16x8, __builtin_shufflevector(v, v, 0, 1, 2, 3))
#define PG8_HI(v) __builtin_bit_cast(bf16x8, __builtin_shufflevector(v, v, 4, 5, 6, 7))
#define PG8_MMA(ai, bj, At, Bt) do { __builtin_amdgcn_s_setprio(1); \
        if constexpr (!F8) { _Pragma("unroll") for (int m = 0; m < 4; ++m) _Pragma("unroll") for (int n = 0; n < 2; ++n) { \
            acc[ai][bj][m][n] = __builtin_amdgcn_mfma_f32_16x16x32_bf16(PG8_LO(Bt[n]), PG8_LO(At[m]), acc[ai][bj][m][n], 0, 0, 0); \
            acc[ai][bj][m][n] = __builtin_amdgcn_mfma_f32_16x16x32_bf16(PG8_HI(Bt[n]), PG8_HI(At[m]), acc[ai][bj][m][n], 0, 0, 0); } } \
        else { _Pragma("unroll") for (int m = 0; m < 4; ++m) _Pragma("unroll") for (int n = 0; n < 2; ++n) \
            acc[ai][bj][m][n] = __builtin_amdgcn_mfma_scale_f32_16x16x128_f8f6f4(Bt[n], At[m], acc[ai][bj][m][n], 0, 0, 0, F8SC, 1, F8SC); } \
        __builtin_amdgcn_s_setprio(0); } while (0)
#define PG8_WAIT_V(n) asm volatile("s_waitcnt vmcnt(" #n ")" ::: "memory")
#define PG8_WAIT_L(n) asm volatile("s_waitcnt lgkmcnt(" #n ")" ::: "memory")
#define PG8_BAR __builtin_amdgcn_s_barrier()
#define PG8_SCHED __builtin_amdgcn_sched_barrier(0)
#define PG8_ZERO() do { _Pragma("unroll") for (int a = 0; a < 2; ++a) _Pragma("unroll") for (int b = 0; b < 2; ++b) _Pragma("unroll") for (int m = 0; m < 4; ++m) _Pragma("unroll") for (int n = 0; n < 2; ++n) acc[a][b][m][n] = (f32x4){0.f, 0.f, 0.f, 0.f}; } while (0)
    Unit cur, nxt; int ui = 0;
    if (!S.next(0, cur)) return;
    f32x4 acc[2][2][4][2];
    PG8_ZERO();
    i32x8 At[4], B0[2], B1[2];
    unsigned cA, cB; S.bases(cur, cA, cB); cA = __builtin_amdgcn_readfirstlane(cA); cB = __builtin_amdgcn_readfirstlane(cB);
    PG8_STAGE(PG8_SB(0, 0), cB, voffB); PG8_STAGE(PG8_SB(0, 1), cB + hsB, voffB); PG8_STAGE(PG8_SA(0, 0), cA, voffA); PG8_STAGE(PG8_SA(0, 1), cA + hsA, voffA);
    if (wr == 1) PG8_BAR;
    PG8_WAIT_V(2); PG8_BAR;
    PG8_STAGE(PG8_SB(1, 0), cB + kstep, voffB); PG8_STAGE(PG8_SA(1, 0), cA + kstep, voffA); PG8_STAGE(PG8_SB(1, 1), cB + hsB + kstep, voffB);
    PG8_WAIT_V(6); PG8_BAR;
    for (;;) {
        const bool has_next = S.next(ui + 1, nxt);
        unsigned nA = cA, nB = cB; if (has_next) { S.bases(nxt, nA, nB); nA = __builtin_amdgcn_readfirstlane(nA); nB = __builtin_amdgcn_readfirstlane(nB); }
#pragma unroll 1
        for (int t = 0; t < nt; t += 2) {
            const bool last = (t == nt - 2);
            const unsigned a1 = cA + (unsigned)(t + 1) * kstep;
            const unsigned a2 = last ? nA : cA + (unsigned)(t + 2) * kstep, b2 = last ? nB : cB + (unsigned)(t + 2) * kstep;
            const unsigned a3 = a2 + kstep, b3 = b2 + kstep;
            PG8_LDB(B0, 0, 0); PG8_LDB(B1, 0, 1); PG8_SCHED; PG8_LDA(At, 0, 0); PG8_STAGE(PG8_SA(1, 1), a1 + hsA, voffA);
            PG8_WAIT_V(8); PG8_WAIT_L(0); PG8_BAR; PG8_MMA(0, 0, At, B0); PG8_MMA(0, 1, At, B1); PG8_BAR; PG8_SCHED;
            PG8_LDA(At, 0, 1); PG8_STAGE(PG8_SB(0, 0), b2, voffB); PG8_STAGE(PG8_SB(0, 1), b2 + hsB, voffB); PG8_STAGE(PG8_SA(0, 0), a2, voffA);
            PG8_WAIT_V(8); PG8_WAIT_L(0); PG8_BAR; PG8_MMA(1, 0, At, B0); PG8_MMA(1, 1, At, B1); PG8_BAR; PG8_SCHED;
            PG8_LDB(B0, 1, 0); PG8_LDB(B1, 1, 1); PG8_SCHED; PG8_LDA(At, 1, 0); PG8_STAGE(PG8_SA(0, 1), a2 + hsA, voffA);
            PG8_WAIT_V(8); PG8_WAIT_L(0); PG8_BAR; PG8_MMA(0, 0, At, B0); PG8_MMA(0, 1, At, B1); PG8_BAR; PG8_SCHED;
            PG8_LDA(At, 1, 1); PG8_STAGE(PG8_SB(1, 0), b3, voffB); PG8_STAGE(PG8_SB(1, 1), b3 + hsB, voffB); PG8_STAGE(PG8_SA(1, 0), a3, voffA);
            PG8_WAIT_V(8); PG8_WAIT_L(0); PG8_BAR; PG8_MMA(1, 0, At, B0); PG8_MMA(1, 1, At, B1); PG8_BAR; PG8_SCHED;
        }
        if constexpr (ALIGN_EPI) { if (wr == 0) PG8_BAR; }
        bool keep; { int t2 = threadIdx.x; asm volatile("" : "+v"(t2)); const int w2 = __builtin_amdgcn_readfirstlane(t2 >> 6), l2 = t2 & 63; keep = E(acc, cur, w2 >> 2, w2 & 3, l2 & 15, l2 >> 4); }
        if (!has_next) break;
        if (!keep) PG8_ZERO();
        cur = nxt; cA = nA; cB = nB; ++ui;
        if constexpr (ALIGN_EPI) { if (wr == 1) PG8_BAR; }
    }
    PG8_WAIT_V(0);
    if constexpr (!ALIGN_EPI) { if (wr == 0) PG8_BAR; }
    PG8_BAR;
#undef PG8_SA
#undef PG8_SB
#undef PG8_STAGE
#undef PG8_LDA
#undef PG8_LDB
#undef PG8_LD8
#undef PG8_LO
#undef PG8_HI
#undef PG8_MMA
#undef PG8_WAIT_V
#undef PG8_WAIT_L
#undef PG8_BAR
#undef PG8_SCHED
#undef PG8_ZERO
}
}
namespace pg8 {
#define EPI_ROWLOOP _Pragma("unroll") for (int ai = 0; ai < 2; ++ai) _Pragma("unroll") for (int m = 0; m < 4; ++m)
struct EpiProj {
    bf16_t* O; int coloff, nq;
    __device__ __forceinline__ bool operator()(f32x4 (&acc)[2][2][4][2], const Unit& u, int wr, int wc, int fr, int fq) const {
        const int row0 = u.pm * BM + wr * 64 + fr, col0 = coloff + u.pn * BM + wc * 32 + 8 * fq;
        const float sc = (u.pn < nq) ? 0.125f : 1.0f;
        EPI_ROWLOOP { bf16_t* rowp = O + (size_t)(row0 + ai * HALF + m * 16) * PROJ_LD + col0;
#pragma unroll
            for (int bj = 0; bj < 2; ++bj) *(u32x4*)(rowp + bj * HALF) = pack8(acc[ai][bj][m][0] * sc, acc[ai][bj][m][1] * sc); }
        return false;
    }
};
struct EpiGate {
    bf16_t* O;
    __device__ __forceinline__ bool operator()(f32x4 (&acc)[2][2][4][2], const Unit& u, int wr, int wc, int fr, int fq) const {
        const int row0 = u.pm * BM + wr * 64 + fr, d0 = u.pn * HALF + wc * 32 + 8 * fq;
        EPI_ROWLOOP { bf16_t* rowp = O + (size_t)(row0 + ai * HALF + m * 16) * PROJ_LD + d0;
            f32x4 rt[2], gb[2];
#pragma unroll
            for (int n = 0; n < 2; ++n)
#pragma unroll
                for (int j = 0; j < 4; ++j) { const float ea = __expf(-acc[ai][0][m][n][j]), eb = fminf(__expf(-acc[ai][1][m][n][j]), 1e30f);
                    gb[n][j] = __builtin_amdgcn_rcpf(1.0f + eb); rt[n][j] = (1.0f + eb) * __builtin_amdgcn_rcpf(1.0f + ea); }
            *(u32x4*)(rowp + PJ_GA) = pack8(rt[0], rt[1]); *(u32x4*)(rowp + PJ_GB) = pack8(gb[0], gb[1]); }
        return false;
    }
};
struct EpiBf16 {
    bf16_t* O; int ldc;
    __device__ __forceinline__ bool operator()(f32x4 (&acc)[2][2][4][2], const Unit& u, int wr, int wc, int fr, int fq) const {
        const int row0 = u.pm * BM + wr * 64 + fr, col0 = u.pn * BM + wc * 32 + 8 * fq;
        EPI_ROWLOOP { bf16_t* rowp = O + (size_t)(row0 + ai * HALF + m * 16) * ldc + col0;
#pragma unroll
            for (int bj = 0; bj < 2; ++bj) *(u32x4*)(rowp + bj * HALF) = pack8(acc[ai][bj][m][0], acc[ai][bj][m][1]); }
        return false;
    }
};
template <bool ISDEC> struct EpiLoraA {
    float* OUT; const float* par;
    __device__ __forceinline__ bool operator()(f32x4 (&acc)[2][2][4][2], const Unit& u, int wr, int wc, int fr, int fq) const {
        const int row0 = u.pm * BM + wr * 64 + fr, col0 = u.pn * BM + wc * 32 + 8 * fq;
        f32x4 pv[2][2];
#pragma unroll
        for (int bj = 0; bj < 2; ++bj)
#pragma unroll
            for (int n = 0; n < 2; ++n) pv[bj][n] = *(const f32x4*)(par + col0 + bj * HALF + 4 * n);
        EPI_ROWLOOP { float* rowp = OUT + (size_t)(row0 + ai * HALF + m * 16) * RW + col0;
#pragma unroll
            for (int bj = 0; bj < 2; ++bj)
#pragma unroll
                for (int n = 0; n < 2; ++n) { f32x4 v = acc[ai][bj][m][n] + pv[bj][n];
#pragma unroll
                    for (int j = 0; j < 4; ++j) {
                        if (ISDEC) v[j] = -0.60653065971263342f * fsigmoid(v[j]);
                        else v[j] = fsigmoid(v[j]); }
                    *(f32x4*)(rowp + bj * HALF + 4 * n) = v; } }
        return false;
    }
};
struct EpiIclr {
    bf16_t* OUT; const float* par;
    __device__ __forceinline__ bool operator()(f32x4 (&acc)[2][2][4][2], const Unit& u, int wr, int wc, int fr, int fq) const {
        const int row0 = u.pm * BM + wr * 64 + fr, col0 = u.pn * BM + wc * 32 + 8 * fq;
        f32x4 pv[2][2];
#pragma unroll
        for (int bj = 0; bj < 2; ++bj)
#pragma unroll
            for (int n = 0; n < 2; ++n) pv[bj][n] = *(const f32x4*)(par + col0 + bj * HALF + 4 * n);
        EPI_ROWLOOP { bf16_t* rowp = OUT + (size_t)(row0 + ai * HALF + m * 16) * RW + col0;
#pragma unroll
            for (int bj = 0; bj < 2; ++bj) { f32x4 v0 = acc[ai][bj][m][0] + pv[bj][0], v1 = acc[ai][bj][m][1] + pv[bj][1];
#pragma unroll
                for (int j = 0; j < 4; ++j) { v0[j] = fsigmoid(v0[j]); v1[j] = fsigmoid(v1[j]); }
                *(u32x4*)(rowp + bj * HALF) = pack8(v0, v1); } }
        return false;
    }
};
struct EpiMerged {
    const bf16_t* PROJ; bf16_t* O;
    __device__ __forceinline__ bool operator()(f32x4 (&acc)[2][2][4][2], const Unit& u, int wr, int wc, int fr, int fq) const {
        const int row0 = u.pm * BM + wr * 64 + fr, col0 = u.pn * BM + wc * 32 + 8 * fq;
        EPI_ROWLOOP { const int row = row0 + ai * HALF + m * 16; const bf16_t* gp = PROJ + (size_t)row * PROJ_LD + col0;
#pragma unroll
            for (int bj = 0; bj < 2; ++bj) {
                if (u.aux == 0) {
                    const u32x4 ga = *(const u32x4*)(gp + PJ_GA + bj * HALF);
                    const f32x4 a0 = (f32x4){bflo(ga.x), bfhi(ga.x), bflo(ga.y), bfhi(ga.y)}, a1 = (f32x4){bflo(ga.z), bfhi(ga.z), bflo(ga.w), bfhi(ga.w)};
                    acc[ai][bj][m][0] = acc[ai][bj][m][0] * a0; acc[ai][bj][m][1] = acc[ai][bj][m][1] * a1;
                } else {
                    const u32x4 gb = *(const u32x4*)(gp + PJ_GB + bj * HALF);
                    const f32x4 b0 = (f32x4){bflo(gb.x), bfhi(gb.x), bflo(gb.y), bfhi(gb.y)}, b1 = (f32x4){bflo(gb.z), bfhi(gb.z), bflo(gb.w), bfhi(gb.w)};
                    { const f32x4 o0 = acc[ai][bj][m][0] * b0 * ACT8_SCALE, o1 = acc[ai][bj][m][1] * b1 * ACT8_SCALE;
                      int w0 = __builtin_amdgcn_cvt_pk_fp8_f32(o0[0], o0[1], 0, false); w0 = __builtin_amdgcn_cvt_pk_fp8_f32(o0[2], o0[3], w0, true);
                      int w1 = __builtin_amdgcn_cvt_pk_fp8_f32(o1[0], o1[1], 0, false); w1 = __builtin_amdgcn_cvt_pk_fp8_f32(o1[2], o1[3], w1, true);
                      *(v2u*)((unsigned char*)O + (size_t)row * D + col0 + bj * HALF) = (v2u){(unsigned)w0, (unsigned)w1}; }
                } } }
        return u.aux == 0;
    }
};
struct EpiZ {
    const float* X; float* Z;
    __device__ __forceinline__ bool operator()(f32x4 (&acc)[2][2][4][2], const Unit& u, int wr, int wc, int fr, int fq) const {
        const int row0 = u.pm * BM + wr * 64 + fr, col0 = u.pn * BM + wc * 32 + 8 * fq;
        EPI_ROWLOOP { const size_t off = (size_t)(row0 + ai * HALF + m * 16) * D + col0;
#pragma unroll
            for (int bj = 0; bj < 2; ++bj)
#pragma unroll
                for (int n = 0; n < 2; ++n) { const f32x4 xv = *(const f32x4*)(X + off + bj * HALF + 4 * n); *(f32x4*)(Z + off + bj * HALF + 4 * n) = xv * DN_ALPHA + acc[ai][bj][m][n]; } }
        return false;
    }
};
struct EpiSwiglu {
    unsigned char* ACT; const float* bgu;
    __device__ __forceinline__ bool operator()(f32x4 (&acc)[2][2][4][2], const Unit& u, int wr, int wc, int fr, int fq) const {
        const int row0 = u.pm * BM + wr * 64 + fr, col0 = u.pn * HALF + wc * 32 + 8 * fq;
        const float* bp = bgu + (size_t)u.aux * (2 * FF) + col0;
        f32x4 bg[2], bu[2];
#pragma unroll
        for (int n = 0; n < 2; ++n) { bg[n] = *(const f32x4*)(bp + 4 * n); bu[n] = *(const f32x4*)(bp + FF + 4 * n); }
        EPI_ROWLOOP { f32x4 o[2];
#pragma unroll
            for (int n = 0; n < 2; ++n) { const f32x4 g = acc[ai][0][m][n] + bg[n], uu = acc[ai][1][m][n] + bu[n];
#pragma unroll
                for (int j = 0; j < 4; ++j) { const float gc = fminf(g[j], 7.0f), uc = fminf(fmaxf(uu[j], -7.0f), 7.0f); o[n][j] = (uc + 1.0f) * (gc * fsigmoid(1.702f * gc)); } }
            int w0 = __builtin_amdgcn_cvt_pk_fp8_f32(o[0][0], o[0][1], 0, false); w0 = __builtin_amdgcn_cvt_pk_fp8_f32(o[0][2], o[0][3], w0, true);
            int w1 = __builtin_amdgcn_cvt_pk_fp8_f32(o[1][0], o[1][1], 0, false); w1 = __builtin_amdgcn_cvt_pk_fp8_f32(o[1][2], o[1][3], w1, true);
            *(v2u*)(ACT + (size_t)(row0 + ai * HALF + m * 16) * FF + col0) = (v2u){(unsigned)w0, (unsigned)w1}; }
        return false;
    }
};
struct EpiDown {
    unsigned char* YS; const float* bdn; const int* rowslot; const float* roww;
    __device__ __forceinline__ bool operator()(f32x4 (&acc)[2][2][4][2], const Unit& u, int wr, int wc, int fr, int fq) const {
        const int row0 = u.pm * BM + wr * 64 + fr, col0 = u.pn * BM + wc * 32 + 8 * fq;
        const float* bp = bdn + (size_t)u.aux * D + col0;
        f32x4 bv[2][2];
#pragma unroll
        for (int bj = 0; bj < 2; ++bj)
#pragma unroll
            for (int n = 0; n < 2; ++n) bv[bj][n] = *(const f32x4*)(bp + bj * HALF + 4 * n);
        int slots[8]; float ws_[8];
#pragma unroll
        for (int q = 0; q < 8; ++q) { const int row = row0 + (q >> 2) * HALF + (q & 3) * 16; slots[q] = rowslot[row]; ws_[q] = roww[row]; }
        EPI_ROWLOOP { const int slot = slots[ai * 4 + m]; const float w = ws_[ai * 4 + m] * YS_SCALE;
            if (slot >= 0) { unsigned char* rowp = YS + (size_t)slot * D + col0;
#pragma unroll
                for (int bj = 0; bj < 2; ++bj) { const f32x4 o0 = (acc[ai][bj][m][0] + bv[bj][0]) * w, o1 = (acc[ai][bj][m][1] + bv[bj][1]) * w;
                    int w0 = __builtin_amdgcn_cvt_pk_fp8_f32(o0[0], o0[1], 0, false); w0 = __builtin_amdgcn_cvt_pk_fp8_f32(o0[2], o0[3], w0, true);
                    int w1 = __builtin_amdgcn_cvt_pk_fp8_f32(o1[0], o1[1], 0, false); w1 = __builtin_amdgcn_cvt_pk_fp8_f32(o1[2], o1[3], w1, true);
                    *(v2u*)(rowp + bj * HALF) = (v2u){(unsigned)w0, (unsigned)w1}; } } }
        return false;
    }
};
#undef EPI_ROWLOOP
}

#define XB_TMO      128
#define XB_XCNT(j)  (256  + 64 * (j))
#define XB_XSUB(j)  (1280 + 64 * (j))
#define XB_XGEN(j)  (2304 + 64 * (j))
#define XB_TOP      3328
#define XB_TOPGEN   3392
#define XCD_BAR_WORDS 3456
#define XB_SPIN_CAP (1u << 18)

__device__ __forceinline__ unsigned xb_ld(unsigned* p)              { return __hip_atomic_load(p, __ATOMIC_RELAXED, __HIP_MEMORY_SCOPE_AGENT); }
__device__ __forceinline__ unsigned xb_add(unsigned* p, unsigned v) { return __hip_atomic_fetch_add(p, v, __ATOMIC_RELAXED, __HIP_MEMORY_SCOPE_AGENT); }
__device__ __forceinline__ unsigned xb_xcc_id() { return (unsigned)__builtin_amdgcn_s_getreg((3 << 11) | 20) & 0xFu; }
#define XB_SPIN(cond, bar) do { unsigned _sp = 0; while (cond) { __builtin_amdgcn_s_sleep(1); \
    if ((++_sp & 255u) == 0u) { if (xb_ld(&(bar)[XB_TMO])) break; if (_sp > XB_SPIN_CAP) { atomicAdd(&(bar)[XB_TMO], 1u); break; } } } } while (0)

struct XcdBarrier {
    unsigned* bar; unsigned x;
    volatile LAS unsigned* st;
};

__device__ __forceinline__ XcdBarrier xcd_barrier_post(unsigned* bar, volatile LAS unsigned* st) {
    XcdBarrier b; b.bar = bar; b.x = xb_xcc_id(); b.st = st;
    if (threadIdx.x == 0) (void)xb_add(&bar[XB_XCNT(b.x)], 1u);
    return b;
}
__device__ __forceinline__ void xcd_barrier_complete(unsigned* bar, unsigned x, unsigned& nloc, unsigned& nx) {
    const unsigned G = gridDim.x * gridDim.y * gridDim.z;
    unsigned sum, cnt, mine, sp = 0u;
    for (;;) {
        sum = 0u; cnt = 0u; mine = 0u;
#pragma unroll
        for (unsigned j = 0; j < 16; ++j) { const unsigned c = xb_ld(&bar[XB_XCNT(j)]); sum += c; cnt += (c > 0u) ? 1u : 0u; mine = (j == x) ? c : mine; }
        if (sum == G) break;
        __builtin_amdgcn_s_sleep(1);
        if ((++sp & 255u) == 0u) { if (xb_ld(&bar[XB_TMO])) break; if (sp > XB_SPIN_CAP) { atomicAdd(&bar[XB_TMO], 1u); break; } }
    }
    nloc = mine > 0u ? mine : 1u; nx = cnt > 0u ? cnt : 1u;
}

__device__ __forceinline__ void xcd_barrier(const XcdBarrier& b) {
    asm volatile("s_waitcnt vmcnt(0)" ::: "memory");
    __syncthreads();
    if (threadIdx.x == 0) {
        unsigned* bar = b.bar;
        __builtin_amdgcn_s_waitcnt(0);
        unsigned nloc = b.st[0], nx = b.st[1];
        if (nloc == 0u) { xcd_barrier_complete(bar, b.x, nloc, nx); b.st[0] = nloc; b.st[1] = nx; }
        const unsigned old = xb_add(&bar[XB_XSUB(b.x)], 1u);
        const unsigned gen = old / nloc;
        if (old + 1u == (gen + 1u) * nloc) {
            __builtin_amdgcn_fence(__ATOMIC_RELEASE, "agent");
            asm volatile("s_waitcnt vmcnt(0)" ::: "memory");
            const unsigned og = xb_add(&bar[XB_TOP], 1u);
            const unsigned tg = og / nx;
            if (og + 1u == (tg + 1u) * nx) xb_add(&bar[XB_TOPGEN], 1u);
            else XB_SPIN(xb_ld(&bar[XB_TOPGEN]) == tg, bar);
            __builtin_amdgcn_fence(__ATOMIC_ACQUIRE, "agent");
            xb_add(&bar[XB_XGEN(b.x)], 1u);
            asm volatile("s_waitcnt vmcnt(0)" ::: "memory");
        } else {
            XB_SPIN(xb_ld(&bar[XB_XGEN(b.x)]) == gen, bar);
            __builtin_amdgcn_fence(__ATOMIC_ACQUIRE, "agent");
            asm volatile("s_waitcnt vmcnt(0)" ::: "memory");
        }
    }
    __syncthreads();
}
struct Frame {
    LAS unsigned char* lds;
    volatile LAS unsigned* MISC;
    gu32* ctl;
    int tid, lane, wave;
    int vcu, G;
    unsigned char* ws;
    __amdgpu_buffer_rsrc_t rsrc;
};

#define PHASE_FRAME(F0) Frame F = (F0); { int t_ = threadIdx.x; asm volatile("" : "+v"(t_)); F.tid = t_; F.lane = t_ & 63; F.wave = __builtin_amdgcn_readfirstlane(t_ >> 6); }

__device__ __forceinline__ void tr_item(const float* W, size_t ldw, int k0, int c0, bf16* WT, size_t ldt, int drow0, LAS float* scr, int lane) {
    const int kr = lane >> 4, cq = lane & 15;
    f32x4 v[16];
#pragma unroll
    for (int i = 0; i < 16; ++i) v[i] = *(const GAS f32x4*)(W + (size_t)(k0 + 4 * i + kr) * ldw + c0 + 4 * cq);
#pragma unroll
    for (int i = 0; i < 16; ++i)
#pragma unroll
        for (int j = 0; j < 4; ++j) scr[(4 * cq + j) * 65 + 4 * i + kr] = v[i][j];
    LDS_WAIT(); asm volatile("" ::: "memory");
    const int c = lane & 7;
#pragma unroll
    for (int jj = 0; jj < 8; ++jj) { const int n = (lane >> 3) + 8 * jj; const LAS float* s = scr + n * 65 + 8 * c;
        v4u o; o.x = pk2(s[0], s[1]); o.y = pk2(s[2], s[3]); o.z = pk2(s[4], s[5]); o.w = pk2(s[6], s[7]);
        *(GAS v4u*)(WT + (size_t)(drow0 + n) * ldt + k0 + 8 * c) = o; }
    LDS_WAIT(); asm volatile("" ::: "memory");
}

typedef short s16x2 __attribute__((ext_vector_type(2)));
struct MoeItem { __amdgpu_buffer_rsrc_t rs; unsigned soff, rstep; int ldw, k0; unsigned char* WT; size_t ldt; int drow; };
__device__ __forceinline__ void tr8_load(const MoeItem& m, f32x4 (&v)[16], int lane) {
    const int kr = lane >> 4, cq = lane & 15;
    const int voff = (kr * m.ldw + 4 * cq) * 4;
#pragma unroll
    for (int i = 0; i < 16; ++i) v[i] = __builtin_bit_cast(f32x4, __builtin_amdgcn_raw_buffer_load_b128(m.rs, voff, (int)(m.soff + (unsigned)i * m.rstep), 0));
}
__device__ __forceinline__ void tr8_finish(const f32x4 (&v)[16], const MoeItem& m, LAS float* scr_, int lane) {
    LAS unsigned char* scr = (LAS unsigned char*)scr_;
    const int kr = lane >> 4, cq = lane & 15;
#pragma unroll
    for (int j = 0; j < 4; ++j) { unsigned w[4];
#pragma unroll
        for (int q = 0; q < 4; ++q) { s16x2 t = {0, 0};
            t = __builtin_amdgcn_cvt_scalef32_pk_fp8_f32(t, v[4 * q][j], v[4 * q + 1][j], F8_CVT_SCALE, false);
            t = __builtin_amdgcn_cvt_scalef32_pk_fp8_f32(t, v[4 * q + 2][j], v[4 * q + 3][j], F8_CVT_SCALE, true);
            w[q] = __builtin_bit_cast(unsigned, t); }
        *(LAS v4u*)(scr + (4 * cq + j) * 80 + kr * 16) = (v4u){w[0], w[1], w[2], w[3]}; }
    LDS_WAIT(); asm volatile("" ::: "memory");
    const int qd = lane & 3;
#pragma unroll
    for (int ps = 0; ps < 4; ++ps) { const int n = (lane >> 2) + 16 * ps; const LAS unsigned char* s = scr + n * 80 + qd * 4;
        const unsigned d0 = *(const LAS unsigned*)(s), d1 = *(const LAS unsigned*)(s + 16), d2 = *(const LAS unsigned*)(s + 32), d3 = *(const LAS unsigned*)(s + 48);
        const unsigned t0 = __builtin_amdgcn_perm(d1, d0, 0x05010400u), t1 = __builtin_amdgcn_perm(d1, d0, 0x07030602u), t2 = __builtin_amdgcn_perm(d3, d2, 0x05010400u), t3 = __builtin_amdgcn_perm(d3, d2, 0x07030602u);
        const v4u o = (v4u){__builtin_amdgcn_perm(t2, t0, 0x05040100u), __builtin_amdgcn_perm(t2, t0, 0x07060302u), __builtin_amdgcn_perm(t3, t1, 0x05040100u), __builtin_amdgcn_perm(t3, t1, 0x07060302u)};
        *(GAS v4u*)(m.WT + (size_t)(m.drow + n) * m.ldt + m.k0 + 16 * qd) = o; }
    LDS_WAIT(); asm volatile("" ::: "memory");
}
constexpr int MOE_J4 = 32 * 32 * 64, MOE_J5 = 32 * 32 * 32, MOE_NITEMS = MOE_J4 + MOE_J5;
__device__ __forceinline__ MoeItem moe_item(int r, const float* w_gu, const float* w_down, unsigned char* ws) {
    MoeItem m;
    if (r < MOE_J4) { const int e = r / 2048, q = r % 2048, kb = q / 64, cb = q % 64, c0 = cb * 64; const int cc = c0 & 2047;
        m.rs = __builtin_amdgcn_make_buffer_rsrc((void*)w_gu, 0, 0xffffffff, 0x00020000); m.ldw = 2 * FF; m.k0 = kb * 64;
        m.soff = (unsigned)(((size_t)e * D * 2 * FF + (size_t)kb * 64 * (2 * FF) + c0) * 4); m.rstep = 4u * (2 * FF) * 4u;
        m.WT = ws + WS_WGUT + (size_t)e * 2 * FF * D; m.ldt = D; m.drow = (cc >> 7) * 256 + (c0 >= 2048 ? 128 : 0) + (cc & 127); }
    else { r -= MOE_J4; const int e = r / 1024, q = r % 1024, kb = q / 32, cb = q % 32;
        m.rs = __builtin_amdgcn_make_buffer_rsrc((void*)w_down, 0, 0xffffffff, 0x00020000); m.ldw = D; m.k0 = kb * 64;
        m.soff = (unsigned)(((size_t)e * FF * D + (size_t)kb * 64 * D + cb * 64) * 4); m.rstep = 4u * D * 4u;
        m.WT = ws + WS_WDNT + (size_t)e * D * FF; m.ldt = FF; m.drow = cb * 64; }
    return m;
}
__device__ __forceinline__ MoeItem f8_item(const float* W, int ldw, int k0, int c0, unsigned char* WT, size_t ldt, int drow) {
    MoeItem m; m.rs = __builtin_amdgcn_make_buffer_rsrc((void*)W, 0, 0xffffffff, 0x00020000); m.ldw = ldw; m.k0 = k0;
    m.soff = (unsigned)(((size_t)k0 * ldw + c0) * 4); m.rstep = 4u * (unsigned)ldw * 4u; m.WT = WT; m.ldt = ldt; m.drow = drow; return m;
}

struct In {
    const float *x, *w_in, *rel_bias, *shift_mu, *w0, *w_up, *a0, *a_up, *g_up, *k_k, *k_a, *r_k, *lnx_w, *lnx_b, *proj_a, *proj_b, *w_out,
                *ln1_w, *ln1_b, *w_router, *b_router, *w_gu, *b_gu, *w_down, *b_down, *ln2_w, *ln2_b;
};

__device__ __forceinline__ void p0_prologue(Frame& F0, const In& I) {
    PHASE_FRAME(F0);
    LAS float* scr = (LAS float*)(F.lds + F.wave * 16640);
    const int gw = F.vcu * NWAVES + F.wave, NGW = F.G * NWAVES;
    unsigned char* ws = F.ws;
    constexpr int J0 = 32 * 167, J1 = 16 * 32, J2 = 16 * 32, J3 = 32 * 32;
    constexpr int NITEMS = J0 + J1 + J2 + J3;
    for (int it = gw; it < NITEMS; it += NGW) {
        int r = it;
        if (r < J0) { const int kb = r / 167, cb = r % 167, c0 = cb * 64; bf16* dst; int drow;
            if (c0 < 3072) { f32x4 tv[16];
                   const MoeItem m = (c0 < 2048) ? f8_item(I.w_in, D_IN, kb * 64, c0, (unsigned char*)(ws + WS_WQK8), D, c0) : f8_item(I.w_in, D_IN, kb * 64, c0, (unsigned char*)(ws + WS_WV8), D, c0 - 2048);
                   tr8_load(m, tv, F.lane); tr8_finish(tv, m, scr, F.lane); continue; }
            else if (c0 < 3072 + 2048) { dst = (bf16*)(ws + WS_WINT); drow = PJ_SEG + (c0 - 3072); }
            else if (c0 < 6592) { f32x4 tv[16]; const MoeItem m = f8_item(I.w_in, D_IN, kb * 64, c0, (unsigned char*)(ws + WS_WSV8), D, c0 - (3072 + 2048));
                   tr8_load(m, tv, F.lane); tr8_finish(tv, m, scr, F.lane); continue; }
            else { f32x4 tv[16]; const int cg = c0 - 6592, d0 = cg & 2047; const MoeItem m = f8_item(I.w_in, D_IN, kb * 64, c0, (unsigned char*)(ws + WS_WG8), D, (d0 >> 7) * 256 + (cg >= 2048 ? 128 : 0) + (d0 & 127));
                   tr8_load(m, tv, F.lane); tr8_finish(tv, m, scr, F.lane); continue; }
            tr_item(I.w_in, D_IN, kb * 64, c0, dst, D, drow, scr, F.lane); continue; } r -= J0;
        if (r < J1) { const int kb = r / 32, cb = r % 32; f32x4 tv[16]; const MoeItem m = f8_item(I.proj_a, D, kb * 64, cb * 64, (unsigned char*)(ws + WS_PAT), AW, cb * 64); tr8_load(m, tv, F.lane); tr8_finish(tv, m, scr, F.lane); continue; } r -= J1;
        if (r < J2) { const int kb = r / 32, cb = r % 32; f32x4 tv[16]; const MoeItem m = f8_item(I.proj_b, D, kb * 64, cb * 64, (unsigned char*)(ws + WS_PBT), RW, cb * 64); tr8_load(m, tv, F.lane); tr8_finish(tv, m, scr, F.lane); continue; } r -= J2;
        { const int kb = r / 32, cb = r % 32; f32x4 tv[16]; const MoeItem m = f8_item(I.w_out, D, kb * 64, cb * 64, (unsigned char*)(ws + WS_WOT), D, cb * 64);
          tr8_load(m, tv, F.lane); tr8_finish(tv, m, scr, F.lane); }
    }
    const int gt = F.vcu * (NWAVES * 64) + F.tid, NGT = F.G * NWAVES * 64;
    for (int i = gt; i < 2048 * 256; i += NGT) { const int n = i >> 8, k = i & 255; float v = 0.f;
        if (n < 1024) { if (k < DLORA) v = I.w_up[(size_t)k * RW + n]; }
        else { if (k >= 128 && k < 128 + ALORA) v = I.a_up[(size_t)(k - 128) * RW + (n - 1024)]; }
        ((bf16*)(ws + WS_WLA))[i] = (bf16)f2bf(v); }
    for (int i = gt; i < 1024 * 256; i += NGT) { const int n = i >> 8, k = i & 255; ((bf16*)(ws + WS_WLG))[i] = (bf16)f2bf(I.g_up[(size_t)k * RW + n]); }
    for (int i = gt; i < 64 * D / 16; i += NGT) ((GAS v4u*)((unsigned char*)(ws + WS_WSV8) + (size_t)(SHIFT_W - 2048) * D))[i] = (v4u){0u, 0u, 0u, 0u};
    for (int i = gt; i < RROWS; i += NGT) ((int*)(ws + WS_ROWSLOT))[i] = -1;
    for (size_t i = gt; i < (size_t)T * D / 8; i += NGT) { const f32x4 a = ((const GAS f32x4*)I.x)[2 * i], b = ((const GAS f32x4*)I.x)[2 * i + 1];
        v4u o; o.x = pk2(a.x, a.y); o.y = pk2(a.z, a.w); o.z = pk2(b.x, b.y); o.w = pk2(b.z, b.w); ((GAS v4u*)(ws + WS_XB16))[i] = o;
        int w0 = __builtin_amdgcn_cvt_pk_fp8_f32(a.x, a.y, 0, false); w0 = __builtin_amdgcn_cvt_pk_fp8_f32(a.z, a.w, w0, true);
        int w1 = __builtin_amdgcn_cvt_pk_fp8_f32(b.x, b.y, 0, false); w1 = __builtin_amdgcn_cvt_pk_fp8_f32(b.z, b.w, w1, true);
        ((GAS v2u*)(ws + WS_XB8))[i] = (v2u){(unsigned)w0, (unsigned)w1}; }
}

constexpr int P8_HS = 0, P8_PITCH = 2052, P8_PART = 131328, P8_LOG = 147712, P8_HIST = 149760;
template <bool SKIP_MIX>
__device__ __forceinline__ void p8_ln_router(Frame& F0, const In& I) {
    PHASE_FRAME(F0);
    LAS float* hs = (LAS float*)(F.lds + P8_HS); LAS float* part = (LAS float*)(F.lds + P8_PART); LAS float* lg = (LAS float*)(F.lds + P8_LOG); LAS int* hist = (LAS int*)(F.lds + P8_HIST);
    const int lane = F.lane, w = F.wave;
    if (F.tid < 32) hist[F.tid] = 0;
    const int kq = lane >> 4, col = lane & 15;
    float ln_w[32], ln_b[32];
#pragma unroll
    for (int j = 0; j < 8; ++j) { const f32x4 a = *(const GAS f32x4*)(I.ln1_w + 4 * lane + 256 * j), b = *(const GAS f32x4*)(I.ln1_b + 4 * lane + 256 * j);
#pragma unroll
        for (int e = 0; e < 4; ++e) { ln_w[4 * j + e] = a[e]; ln_b[4 * j + e] = b[e]; } }
    __syncthreads();
    const float* zsrc = I.x; const bf16* mixb = (const bf16*)(F.ws + WS_Z);
    for (int g = F.vcu; g < T / 16; g += F.G) {
        const int tok0 = g * 16;
        { f32x4 va[8], vb[8];
          const size_t tokA = (size_t)(tok0 + 2 * w), tokB = tokA + 1;
          const GAS f32x4* zra = (const GAS f32x4*)(zsrc + tokA * D) + lane; const GAS f32x4* zrb = (const GAS f32x4*)(zsrc + tokB * D) + lane;
          const GAS v2u* mra = (const GAS v2u*)(mixb + tokA * D) + lane; const GAS v2u* mrb = (const GAS v2u*)(mixb + tokB * D) + lane;
          v2u ma[8], mb[8];
#pragma unroll
          for (int j = 0; j < 8; ++j) { va[j] = zra[64 * j]; vb[j] = zrb[64 * j]; if (!SKIP_MIX) { ma[j] = mra[64 * j]; mb[j] = mrb[64 * j]; } }
#pragma unroll
          for (int j = 0; j < 8; ++j) { va[j] = va[j] * DN_ALPHA; vb[j] = vb[j] * DN_ALPHA;
              if (!SKIP_MIX) { va[j] += (f32x4){bflo(ma[j].x), bfhi(ma[j].x), bflo(ma[j].y), bfhi(ma[j].y)}; vb[j] += (f32x4){bflo(mb[j].x), bfhi(mb[j].x), bflo(mb[j].y), bfhi(mb[j].y)}; } }
#pragma unroll
          for (int tt = 0; tt < 2; ++tt) {
            const int tl = 2 * w + tt; const size_t tok = (size_t)(tok0 + tl);
            f32x4 v[8]; float s = 0.f;
#pragma unroll
            for (int j = 0; j < 8; ++j) { v[j] = tt ? vb[j] : va[j]; s += (v[j].x + v[j].y) + (v[j].z + v[j].w); }
            const float mean = wave_sum(s) * (1.f / D); float s2 = 0.f;
#pragma unroll
            for (int j = 0; j < 8; ++j) { v[j] = v[j] - mean; s2 += (v[j].x * v[j].x + v[j].y * v[j].y) + (v[j].z * v[j].z + v[j].w * v[j].w); }
            const float rstd = 1.f / sqrtf(wave_sum(s2) * (1.f / D) + LN_EPS);
            GAS v2u* h1 = (GAS v2u*)((bf16*)(F.ws + WS_H1) + tok * D) + lane;
            GAS unsigned* h1b = (GAS unsigned*)((unsigned char*)(F.ws + WS_H1B) + tok * D) + lane;
#pragma unroll
            for (int j = 0; j < 8; ++j) { f32x4 h;
#pragma unroll
                for (int e = 0; e < 4; ++e) h[e] = v[j][e] * rstd * ln_w[4 * j + e] + ln_b[4 * j + e];
                h1[64 * j] = (v2u){pg8::cvt_pk_bf16(h.x, h.y), pg8::cvt_pk_bf16(h.z, h.w)}; { int w8 = __builtin_amdgcn_cvt_pk_fp8_f32(h.x, h.y, 0, false); w8 = __builtin_amdgcn_cvt_pk_fp8_f32(h.z, h.w, w8, true); h1b[64 * j] = (unsigned)w8; }
                *(LAS f32x4*)(hs + tl * P8_PITCH + 4 * lane + 256 * j) = h; }
          } }
        __syncthreads();
        f32x4 c0 = (f32x4){0.f, 0.f, 0.f, 0.f}, c1 = c0;
        const LAS float* ap = hs + col * P8_PITCH + 256 * w + 4 * kq;
        const float* bp = I.w_router + (size_t)(256 * w + 4 * kq) * NE + col;
#pragma unroll 4
        for (int kk = 0; kk < 16; ++kk) {
            const f32x4 a = *(const LAS f32x4*)(ap + 16 * kk);
#pragma unroll
            for (int e = 0; e < 4; ++e) {
                const float b0 = bp[(size_t)(16 * kk + e) * NE], b1 = bp[(size_t)(16 * kk + e) * NE + 16];
                c0 = __builtin_amdgcn_mfma_f32_16x16x4f32(a[e], b0, c0, 0, 0, 0);
                c1 = __builtin_amdgcn_mfma_f32_16x16x4f32(a[e], b1, c1, 0, 0, 0);
            }
        }
#pragma unroll
        for (int i = 0; i < 4; ++i) { part[(w * 16 + 4 * kq + i) * 32 + col] = c0[i]; part[(w * 16 + 4 * kq + i) * 32 + 16 + col] = c1[i]; }
        __syncthreads();
        { const int tl = F.tid >> 5, e = F.tid & 31; float s = I.b_router[e];
#pragma unroll
            for (int ww = 0; ww < 8; ++ww) s += part[(ww * 16 + tl) * 32 + e];
            lg[tl * 32 + e] = s; }
        __syncthreads();
        if (F.tid < 16) {
            const int tl = F.tid; float lv[32];
#pragma unroll
            for (int e = 0; e < 32; ++e) lv[e] = lg[tl * 32 + e];
            int ti[4]; float tv[4];
#pragma unroll
            for (int k = 0; k < 4; ++k) { float best = -3.4e38f; int bi = 0;
#pragma unroll
                for (int e = 0; e < 32; ++e) { const bool tk = lv[e] > best; best = tk ? lv[e] : best; bi = tk ? e : bi; }
                ti[k] = bi; tv[k] = best;
#pragma unroll
                for (int e = 0; e < 32; ++e) lv[e] = (e == bi) ? -3.4e38f : lv[e]; }
            float ex[4], sum = 0.f;
#pragma unroll
            for (int k = 0; k < 4; ++k) { ex[k] = __expf(tv[k] - tv[0]); sum += ex[k]; }
            const float inv = 1.f / sum;
            *(GAS v4u*)((int*)(F.ws + WS_TOPI) + (size_t)(tok0 + tl) * 4) = (v4u){(unsigned)ti[0], (unsigned)ti[1], (unsigned)ti[2], (unsigned)ti[3]};
            *(GAS f32x4*)((float*)(F.ws + WS_GATE) + (size_t)(tok0 + tl) * 4) = (f32x4){ex[0] * inv, ex[1] * inv, ex[2] * inv, ex[3] * inv};
#pragma unroll
            for (int k = 0; k < 4; ++k) __hip_atomic_fetch_add(&hist[ti[k]], 1, __ATOMIC_RELAXED, __HIP_MEMORY_SCOPE_WORKGROUP);
        }
        __syncthreads();
    }
    if (F.tid < 32) { const int c = hist[F.tid]; if (c) __hip_atomic_fetch_add(F.ctl + CW_CNT + F.tid, (unsigned)c, RLX_AGENT); }
}

template <bool SKIP_MOE>
__device__ __forceinline__ void p12_final(Frame& F0, const In& I, float* out) {
    PHASE_FRAME(F0);
    const int lane = F.lane; const int gw = F.vcu * NWAVES + F.wave, NGW = F.G * NWAVES;
    float ln_w[32], ln_b[32];
#pragma unroll
    for (int j = 0; j < 8; ++j) { const f32x4 a = *(const GAS f32x4*)(I.ln2_w + 4 * lane + 256 * j), b = *(const GAS f32x4*)(I.ln2_b + 4 * lane + 256 * j);
#pragma unroll
        for (int e = 0; e < 4; ++e) { ln_w[4 * j + e] = a[e]; ln_b[4 * j + e] = b[e]; } }
    for (int tok = gw; tok < T; tok += NGW) {
        const GAS v2u* hr = (const GAS v2u*)((const bf16*)(F.ws + WS_H1) + (size_t)tok * D) + lane;
        f32x4 v[8]; float s = 0.f;
#pragma unroll
        for (int j = 0; j < 8; ++j) { const v2u hh = hr[64 * j]; v[j] = (f32x4){bflo(hh.x), bfhi(hh.x), bflo(hh.y), bfhi(hh.y)} * DN_ALPHA; }
        if (!SKIP_MOE) {
#pragma unroll
            for (int k = 0; k < 4; ++k) { const GAS unsigned* yr = (const GAS unsigned*)((const unsigned char*)(F.ws + WS_YSLOT) + ((size_t)tok * 4 + k) * D) + lane;
#pragma unroll
                for (int j = 0; j < 8; ++j) { const unsigned y = yr[64 * j]; const f32x2 lo = __builtin_amdgcn_cvt_pk_f32_fp8((int)y, false), hi = __builtin_amdgcn_cvt_pk_f32_fp8((int)y, true);
                    v[j].x += lo.x * YS_INV; v[j].y += lo.y * YS_INV; v[j].z += hi.x * YS_INV; v[j].w += hi.y * YS_INV; } }
        }
#pragma unroll
        for (int j = 0; j < 8; ++j) s += (v[j].x + v[j].y) + (v[j].z + v[j].w);
        const float mean = wave_sum(s) * (1.f / D); float s2 = 0.f;
#pragma unroll
        for (int j = 0; j < 8; ++j) { v[j] = v[j] - mean; s2 += (v[j].x * v[j].x + v[j].y * v[j].y) + (v[j].z * v[j].z + v[j].w * v[j].w); }
        const float rstd = 1.f / sqrtf(wave_sum(s2) * (1.f / D) + LN_EPS);
        GAS f32x4* o = (GAS f32x4*)(out + (size_t)tok * D) + lane;
#pragma unroll
        for (int j = 0; j < 8; ++j) { f32x4 h;
#pragma unroll
            for (int e = 0; e < 4; ++e) h[e] = v[j][e] * rstd * ln_w[4 * j + e] + ln_b[4 * j + e];
            o[64 * j] = h; }
    }
}
__device__ __forceinline__ void moe_tables(Frame& F) {
    LAS int* tab = (LAS int*)(F.lds + TAB_OFF);
    if (F.tid == 0) { int run = 0;
        for (int e = 0; e < NE; ++e) { const int c = (int)__hip_atomic_load(F.ctl + CW_CNT + e, RLX_AGENT); const int p = (c + 255) / 256 * 256; tab[32 + e] = run; run += p; tab[e] = run; }
        tab[64] = run / 256; }
    __syncthreads();
}

__device__ __forceinline__ void p9_scatter(Frame& F0, const In& I) {
    PHASE_FRAME(F0);
    moe_tables(F);
    LAS int* tab = (LAS int*)(F.lds + TAB_OFF);
    LAS int* lh = (LAS int*)(F.lds + 0);
    LAS int* lb = (LAS int*)(F.lds + 128);
    LAS int* dst = (LAS int*)(F.lds + 256);
    const int* topi = (const int*)(F.ws + WS_TOPI); const float* gate = (const float*)(F.ws + WS_GATE);
    for (int ch = F.vcu; ch < T / 128; ch += F.G) {
        if (F.tid < 32) lh[F.tid] = 0;
        __syncthreads();
        const int s = ch * 512 + F.tid; const int e = topi[s]; const float gv = gate[s];
        const int rank = __hip_atomic_fetch_add(&lh[e], 1, __ATOMIC_RELAXED, __HIP_MEMORY_SCOPE_WORKGROUP);
        __syncthreads();
        if (F.tid < 32) { const int c = lh[F.tid]; lb[F.tid] = c ? (int)__hip_atomic_fetch_add(F.ctl + CW_CUR + F.tid, (unsigned)c, RLX_AGENT) : 0; }
        __syncthreads();
        const int d = tab[32 + e] + lb[e] + rank;
        ((int*)(F.ws + WS_ROWSLOT))[d] = s; ((float*)(F.ws + WS_ROWW))[d] = gv; dst[F.tid] = d;
        __syncthreads();
#pragma unroll 1
        for (int i0 = F.wave * 64; i0 < F.wave * 64 + 64; i0 += 8) {
            v4u v[8][2]; int dd[8];
#pragma unroll
            for (int q = 0; q < 8; ++q) { const int i = i0 + q; const int tok = ch * 128 + (i >> 2); dd[q] = dst[i];
                const GAS v4u* src = (const GAS v4u*)((const unsigned char*)(F.ws + WS_H1B) + (size_t)tok * D) + F.lane;
                v[q][0] = src[0]; v[q][1] = src[64]; }
#pragma unroll
            for (int q = 0; q < 8; ++q) { GAS v4u* o = (GAS v4u*)((unsigned char*)(F.ws + WS_XG) + (size_t)dd[q] * D) + F.lane; o[0] = v[q][0]; o[64] = v[q][1]; }
        }
        __syncthreads();
    }
}

__device__ __forceinline__ void p10_moe_up(Frame& F0, const In& I) {
    PHASE_FRAME(F0);
    moe_tables(F);
    LAS int* tab = (LAS int*)(F.lds + TAB_OFF);
    pg8::SchedMoe S; S.t.init(tab[64], 16, F.G, (int)blockIdx.x);
    S.A = (unsigned)(WS_XG); S.B = (unsigned)(WS_WGUT); S.tsA = (unsigned)256 * D; S.tsB = (unsigned)256 * D; S.es = (unsigned)2 * FF * D; S.pad_end = tab;
    pg8::EpiSwiglu E{(unsigned char*)(F.ws + WS_ACT), I.b_gu};
    pg8::gemm_phase<pg8::EpiSwiglu, pg8::SchedMoe, true, true>(F.lds + RING_OFF, F.rsrc, D / 2, D / 2, D / 2, S, E);
}
__device__ __forceinline__ void p11_moe_down(Frame& F0, const In& I) {
    PHASE_FRAME(F0);
    moe_tables(F);
    LAS int* tab = (LAS int*)(F.lds + TAB_OFF);
    pg8::SchedMoe S; S.t.init(tab[64], 8, F.G, (int)blockIdx.x);
    S.A = (unsigned)(WS_ACT); S.B = (unsigned)(WS_WDNT); S.tsA = (unsigned)256 * FF; S.tsB = (unsigned)256 * FF; S.es = (unsigned)D * FF; S.pad_end = tab;
    pg8::EpiDown E{(unsigned char*)(F.ws + WS_YSLOT), I.b_down, (const int*)(F.ws + WS_ROWSLOT), (const float*)(F.ws + WS_ROWW)};
    pg8::gemm_phase<pg8::EpiDown, pg8::SchedMoe, true, true>(F.lds + RING_OFF, F.rsrc, FF / 2, FF / 2, FF / 2, S, E);
}

__device__ __forceinline__ void p1_proj(Frame& F0, const In& I) {
    PHASE_FRAME(F0);
    { pg8::SchedPlain S; S.t.init(T / 256, 2048 / 256, F.G, (int)blockIdx.x);
      S.A = (unsigned)(WS_XB16); S.B = (unsigned)(WS_WINT + (size_t)PJ_SEG * D * 2); S.tsA = (unsigned)256 * D * 2; S.tsB = (unsigned)256 * D * 2;
      pg8::EpiProj E{(bf16*)(F.ws + WS_PROJ), PJ_SEG, 0};
      pg8::gemm_phase<pg8::EpiProj, pg8::SchedPlain, true>(F.lds + RING_OFF, F.rsrc, D, D, D, S, E); }
    { pg8::SchedPlain S; S.t.init(T / 256, (SEG_PAD - 2048) / 256, F.G, (int)blockIdx.x);
      S.A = (unsigned)(WS_XB8); S.B = (unsigned)(WS_WSV8); S.tsA = (unsigned)256 * D; S.tsB = (unsigned)256 * D;
      pg8::EpiProj E{(bf16*)(F.ws + WS_PROJ), PJ_SEG + 2048, 0};
      pg8::gemm_phase<pg8::EpiProj, pg8::SchedPlain, true, true>(F.lds + RING_OFF, F.rsrc, D / 2, D / 2, D / 2, S, E); }
    { pg8::SchedPlain S; S.t.init(T / 256, (2 * AW) / 256, F.G, (int)blockIdx.x);
      S.A = (unsigned)(WS_XB8); S.B = (unsigned)(WS_WQK8); S.tsA = (unsigned)256 * D; S.tsB = (unsigned)256 * D;
      pg8::EpiProj E{(bf16*)(F.ws + WS_PROJ), 0, 4};
      pg8::gemm_phase<pg8::EpiProj, pg8::SchedPlain, true, true>(F.lds + RING_OFF, F.rsrc, D / 2, D / 2, D / 2, S, E); }
    { pg8::SchedPlain S; S.t.init(T / 256, (2 * D) / 256, F.G, (int)blockIdx.x);
      S.A = (unsigned)(WS_XB8); S.B = (unsigned)(WS_WG8); S.tsA = (unsigned)256 * D; S.tsB = (unsigned)256 * D;
      pg8::EpiGate E{(bf16*)(F.ws + WS_PROJ)};
      pg8::gemm_phase<pg8::EpiGate, pg8::SchedPlain, true, true>(F.lds + RING_OFF, F.rsrc, D / 2, D / 2, D / 2, S, E); }
    { pg8::SchedPlain S; S.t.init(AW / 256, T / 256, F.G, (int)blockIdx.x);
      S.A = (unsigned)(WS_WV8); S.B = (unsigned)(WS_XB8); S.tsA = (unsigned)256 * D; S.tsB = (unsigned)256 * D;
      pg8::EpiBf16 E{(bf16*)(F.ws + WS_VT), T};
      pg8::gemm_phase<pg8::EpiBf16, pg8::SchedPlain, true, true>(F.lds + RING_OFF, F.rsrc, D / 2, D / 2, D / 2, S, E); }
}

__device__ __forceinline__ float ftanh(float x) { return 2.0f * fsigmoid(2.0f * x) - 1.0f; }
__device__ __forceinline__ void p2_shift_attn(Frame& F0, const In& I) {
    PHASE_FRAME(F0);
    const int lane = F.lane; const int gw = F.vcu * NWAVES + F.wave, NGW = F.G * NWAVES;
    const bf16* PROJ = (const bf16*)(F.ws + WS_PROJ);
    for (int tok = gw; tok < T; tok += NGW) {
        const bool first = (tok % SEQ) == 0;
        const bf16* cur = PROJ + (size_t)tok * PROJ_LD + PJ_SEG; const bf16* prv = cur - PROJ_LD;
        bf16* rkv = (bf16*)(F.ws + WS_RKV) + (size_t)tok * (3 * RW); bf16* lin = (bf16*)(F.ws + WS_LORAIN) + (size_t)tok * LORA_LD;
#pragma unroll 1
        for (int it = 0; it < 7; ++it) { const int gi = it * 64 + lane; if (gi >= SHIFT_W / 8) break; const int c = gi * 8;
            const v4u cv = *(const GAS v4u*)(cur + c); v4u pv = (v4u){0u, 0u, 0u, 0u}; if (!first) pv = *(const GAS v4u*)(prv + c);
            const f32x4 m0 = *(const GAS f32x4*)(I.shift_mu + c), m1 = *(const GAS f32x4*)(I.shift_mu + c + 4);
            float v[8]; const unsigned cw[4] = {cv.x, cv.y, cv.z, cv.w}, pw[4] = {pv.x, pv.y, pv.z, pv.w};
#pragma unroll
            for (int j = 0; j < 4; ++j) { const float c0 = bflo(cw[j]), c1 = bfhi(cw[j]), p0 = bflo(pw[j]), p1 = bfhi(pw[j]); const float mu0 = (j < 2) ? m0[2 * j] : m1[2 * j - 4], mu1 = (j < 2) ? m0[2 * j + 1] : m1[2 * j - 3];
                v[2 * j] = c0 + (p0 - c0) * mu0; v[2 * j + 1] = c1 + (p1 - c1) * mu1; }
            bf16* dstp;
            if (c < 3 * RW) dstp = rkv + c;
            else if (c < 3 * RW + DLORA) { dstp = lin + (c - 3 * RW);
#pragma unroll
                for (int j = 0; j < 8; ++j) v[j] = ftanh(v[j]); }
            else if (c < 3 * RW + DLORA + ALORA) dstp = lin + 128 + (c - 3 * RW - DLORA);
            else { dstp = lin + 256 + (c - 3 * RW - DLORA - ALORA);
#pragma unroll
                for (int j = 0; j < 8; ++j) v[j] = fsigmoid(v[j]); }
            *(GAS v4u*)dstp = (v4u){pk2(v[0], v[1]), pk2(v[2], v[3]), pk2(v[4], v[5]), pk2(v[6], v[7])};
        }
        if (lane < 8) { const int c = (lane < 4) ? (DLORA + 8 * lane) : (128 + ALORA + 8 * (lane - 4)); *(GAS v4u*)(lin + c) = (v4u){0u, 0u, 0u, 0u}; }
    }
#if STAGE == 3
    { const int gt = F.vcu * (NWAVES * 64) + F.tid, NGT = F.G * NWAVES * 64;
      for (size_t i = gt; i < (size_t)T * RW / 8; i += NGT) ((GAS v4u*)(F.ws + WS_YB))[i] = (v4u){0u, 0u, 0u, 0u}; }
#endif
    LAS float* tbl = (LAS float*)(F.lds + 0);
    constexpr int AKV = 64 * 144, A_KOFF = 2048, A_VOFF = A_KOFF + 2 * AKV;
    const bf16* VT = (const bf16*)(F.ws + WS_VT); bf16* YA = (bf16*)(F.ws + WS_YA);
    const int r = lane & 31, hh = lane >> 5;
    const int rp = (r & 16) + 8 * ((r >> 2) & 1) + 4 * ((r >> 3) & 1) + (r & 3);
    const int srow = F.tid >> 3, spc = F.tid & 7;
    for (int task = F.vcu; task < BATCH * AH * (SEQ / 256); task += F.G) {
        const int bh = task >> 5, q256 = task & 31, b = bh >> 4, h = bh & 15, c0 = q256 * 4;
        const int q0 = q256 * 256 + F.wave * 32, cw = c0 + (F.wave >> 1);
        const int kc_lo = (c0 > LEFT) ? c0 - LEFT : 0, kc_hi = c0 + 3;
        __syncthreads();
        if (F.tid < REL_TABLE) tbl[F.tid] = I.rel_bias[h * REL_TABLE + F.tid];
        const size_t tokq = (size_t)b * SEQ + q0 + r;
        bf16x8 qf[4];
#pragma unroll
        for (int s = 0; s < 4; ++s) qf[s] = *(const GAS bf16x8*)(PROJ + tokq * PROJ_LD + PJ_Q + h * 64 + 16 * s + 8 * hh);
        f32x16 o0, o1;
#pragma unroll
        for (int i = 0; i < 16; ++i) { o0[i] = 0.f; o1[i] = 0.f; }
        float m_run = -1e30f, l_run = 0.f;
        v4u kreg, vreg;
#define AT_STAGE_LOAD(kc_) do { kreg = *(const GAS v4u*)(PROJ + ((size_t)b * SEQ + (size_t)(kc_) * 64 + srow) * PROJ_LD + PJ_K + h * 64 + spc * 8); \
                                vreg = *(const GAS v4u*)(VT + (size_t)(h * 64 + srow) * T + (size_t)b * SEQ + (size_t)(kc_) * 64 + spc * 8); } while (0)
#define AT_STAGE_WRITE(buf_) do { *(LAS v4u*)(F.lds + A_KOFF + (buf_) * AKV + srow * 144 + spc * 16) = kreg; *(LAS v4u*)(F.lds + A_VOFF + (buf_) * AKV + srow * 144 + spc * 16) = vreg; } while (0)
        AT_STAGE_LOAD(kc_lo); AT_STAGE_WRITE(0);
        __syncthreads();
#pragma unroll 1
        for (int kc = kc_lo; kc <= kc_hi; ++kc) {
            const int buf = (kc - kc_lo) & 1;
            if (kc < kc_hi) AT_STAGE_LOAD(kc + 1);
            if (kc >= cw - LEFT && kc <= cw) {
                const LAS unsigned char* Kb = F.lds + A_KOFF + buf * AKV; const LAS unsigned char* Vb = F.lds + A_VOFF + buf * AKV;
#pragma unroll
                for (int tt = 0; tt < 2; ++tt) {
                    const int kpos0 = kc * 64 + 32 * tt;
                    bf16x8 kf[4], va[2], vb[2];
#pragma unroll
                    for (int s = 0; s < 4; ++s) kf[s] = *(const LAS bf16x8*)(Kb + (32 * tt + rp) * 144 + 32 * s + 16 * hh);
#pragma unroll
                    for (int s2 = 0; s2 < 2; ++s2) { va[s2] = *(const LAS bf16x8*)(Vb + r * 144 + 64 * tt + 32 * s2 + 16 * hh); vb[s2] = *(const LAS bf16x8*)(Vb + (32 + r) * 144 + 64 * tt + 32 * s2 + 16 * hh); }
                    f32x16 st;
#pragma unroll
                    for (int i = 0; i < 16; ++i) st[i] = 0.f;
#pragma unroll
                    for (int s = 0; s < 4; ++s) st = __builtin_amdgcn_mfma_f32_32x32x16_bf16(kf[s], qf[s], st, 0, 0, 0);
                    const int dbase = (q0 + r) - (kpos0 + 8 * hh);
                    float mx = -1e30f;
                    if (q0 - (kpos0 + 31) >= MAX_PAST) {
                        const float bc = tbl[MAX_PAST + 63];
#pragma unroll
                        for (int i = 0; i < 16; ++i) { st[i] += bc; mx = fmaxf(mx, st[i]); }
                    } else {
#pragma unroll
                        for (int i = 0; i < 16; ++i) { int d = dbase - (16 * (i >> 3) + 4 * ((i >> 2) & 1) + (i & 3)); d = d < MAX_PAST ? d : MAX_PAST; st[i] += tbl[d + 63]; mx = fmaxf(mx, st[i]); }
                    }
                    mx = fmaxf(mx, __shfl_xor(mx, 32));
                    const float m_new = fmaxf(m_run, mx), alpha = __expf(m_run - m_new);
                    float ls = 0.f;
#pragma unroll
                    for (int i = 0; i < 16; ++i) { st[i] = __expf(st[i] - m_new); ls += st[i]; }
                    l_run = l_run * alpha + ls;
                    if (__builtin_amdgcn_ballot_w64(m_new != m_run)) {
#pragma unroll
                        for (int i = 0; i < 16; ++i) { o0[i] *= alpha; o1[i] *= alpha; } }
                    m_run = m_new;
#pragma unroll
                    for (int s2 = 0; s2 < 2; ++s2) {
                        v4u pw; pw.x = pg8::cvt_pk_bf16(st[8 * s2 + 0], st[8 * s2 + 1]); pw.y = pg8::cvt_pk_bf16(st[8 * s2 + 2], st[8 * s2 + 3]); pw.z = pg8::cvt_pk_bf16(st[8 * s2 + 4], st[8 * s2 + 5]); pw.w = pg8::cvt_pk_bf16(st[8 * s2 + 6], st[8 * s2 + 7]);
                        const bf16x8 pf = __builtin_bit_cast(bf16x8, pw);
                        o0 = __builtin_amdgcn_mfma_f32_32x32x16_bf16(va[s2], pf, o0, 0, 0, 0);
                        o1 = __builtin_amdgcn_mfma_f32_32x32x16_bf16(vb[s2], pf, o1, 0, 0, 0);
                    }
                }
            }
            if (kc < kc_hi) AT_STAGE_WRITE(buf ^ 1);
            __syncthreads();
        }
#undef AT_STAGE_LOAD
#undef AT_STAGE_WRITE
        const float inv = 1.0f / (l_run + __shfl_xor(l_run, 32));
        unsigned char* yo = (unsigned char*)YA + tokq * AW + h * 64 + 4 * hh;
        const float inv16 = inv * ACT8_SCALE;
#pragma unroll
        for (int g4 = 0; g4 < 4; ++g4) {
            int w0 = __builtin_amdgcn_cvt_pk_fp8_f32(o0[4 * g4] * inv16, o0[4 * g4 + 1] * inv16, 0, false); w0 = __builtin_amdgcn_cvt_pk_fp8_f32(o0[4 * g4 + 2] * inv16, o0[4 * g4 + 3] * inv16, w0, true);
            int w1 = __builtin_amdgcn_cvt_pk_fp8_f32(o1[4 * g4] * inv16, o1[4 * g4 + 1] * inv16, 0, false); w1 = __builtin_amdgcn_cvt_pk_fp8_f32(o1[4 * g4 + 2] * inv16, o1[4 * g4 + 3] * inv16, w1, true);
            *(GAS unsigned*)(yo + 8 * g4) = (unsigned)w0; *(GAS unsigned*)(yo + 32 + 8 * g4) = (unsigned)w1;
        }
    }
}

__device__ __forceinline__ void p6_merged(Frame& F0, const In& I) {
    PHASE_FRAME(F0);
    pg8::SchedTwo S; S.t.init(T / 256, D / 256, F.G, (int)blockIdx.x);
    S.A0 = (unsigned)(WS_YA); S.A1 = (unsigned)(WS_YB); S.B0 = (unsigned)(WS_PAT); S.B1 = (unsigned)(WS_PBT);
    S.tsA = (unsigned)256 * AW; S.tsB = (unsigned)256 * AW;
    pg8::EpiMerged E{(const bf16*)(F.ws + WS_PROJ), (bf16*)(F.ws + WS_MERGED)};
    pg8::gemm_phase<pg8::EpiMerged, pg8::SchedTwo, true, true, 0x00007b79>(F.lds + RING_OFF, F.rsrc, AW / 2, AW / 2, AW / 2, S, E);
}
__device__ __forceinline__ void p7_mix(Frame& F0, const In& I) {
    PHASE_FRAME(F0);
    pg8::SchedPlain S; S.t.init(T / 256, D / 256, F.G, (int)blockIdx.x);
    S.A = (unsigned)(WS_MERGED); S.B = (unsigned)(WS_WOT); S.tsA = (unsigned)256 * D; S.tsB = (unsigned)256 * D;
    pg8::EpiBf16 E{(bf16*)(F.ws + WS_Z), D};
    pg8::gemm_phase<pg8::EpiBf16, pg8::SchedPlain, true, true, 0x00007b79>(F.lds + RING_OFF, F.rsrc, D / 2, D / 2, D / 2, S, E);
}

__device__ __forceinline__ void p3_lora(Frame& F0, const In& I) {
    PHASE_FRAME(F0);
    { pg8::SchedPlain S; S.t.init(T / 256, 4, F.G, (int)blockIdx.x);
      S.A = (unsigned)(WS_LORAIN); S.B = (unsigned)(WS_WLA); S.tsA = (unsigned)256 * LORA_LD * 2; S.tsB = (unsigned)256 * 256 * 2;
      pg8::EpiLoraA<true> E{(float*)(F.ws + WS_DECAY), I.w0};
      pg8::gemm_phase<pg8::EpiLoraA<true>, pg8::SchedPlain, true>(F.lds + RING_OFF, F.rsrc, LORA_LD, 256, 256, S, E); }
    { pg8::SchedPlain S; S.t.init(T / 256, 4, F.G, (int)blockIdx.x);
      S.A = (unsigned)(WS_LORAIN); S.B = (unsigned)(WS_WLA + (size_t)1024 * 256 * 2); S.tsA = (unsigned)256 * LORA_LD * 2; S.tsB = (unsigned)256 * 256 * 2;
      pg8::EpiIclr E{(bf16*)(F.ws + WS_ICLR), I.a0};
      pg8::gemm_phase<pg8::EpiIclr, pg8::SchedPlain, true>(F.lds + RING_OFF, F.rsrc, LORA_LD, 256, 256, S, E); }
    { pg8::SchedPlain S; S.t.init(T / 256, 4, F.G, (int)blockIdx.x);
      S.A = (unsigned)(WS_LORAIN + 512); S.B = (unsigned)(WS_WLG); S.tsA = (unsigned)256 * LORA_LD * 2; S.tsB = (unsigned)256 * 256 * 2;
      pg8::EpiBf16 E{(bf16*)(F.ws + WS_G), RW};
      pg8::gemm_phase<pg8::EpiBf16, pg8::SchedPlain, true>(F.lds + RING_OFF, F.rsrc, LORA_LD, 256, 256, S, E); }
}

constexpr int CP = 144;
constexpr int CMAT = 64 * CP;
constexpr int C_RT = 0 * CMAT, C_ATT = 1 * CMAT, C_AAK = 2 * CMAT, C_ARKT = 3 * CMAT, C_WA = 4 * CMAT, C_WB = 6 * CMAT,
              C_MA = 8 * CMAT, C_MTA = 9 * CMAT, C_MB = 10 * CMAT, C_MTB = 11 * CMAT, C_SEG = 12 * CMAT, C_GAM = C_SEG + 8 * 64 * 4, C_TSCR = C_GAM + 256;
constexpr int C_AT = C_WB, C_BT = C_WB + CMAT, C_KT = C_MB, C_QYT = C_MA, C_QST = C_MTA, C_KHT = C_MTB, C_VT = C_WB;
static_assert(C_TSCR % 16 == 0 && C_TSCR + 8 * 5120 <= TAB_OFF, "P4a LDS map");
constexpr int CHK_UNIT_BYTES = 4 * 64 * 64 * 2;
#define CBAR() do { asm volatile("s_waitcnt lgkmcnt(0)" ::: "memory"); __builtin_amdgcn_s_barrier(); asm volatile("" ::: "memory"); } while (0)
template <int NT, class Epi>
__device__ __forceinline__ void cmm(const LAS unsigned char* X, const LAS unsigned char* Y, int mt0, int nt, int lane, const Epi& E) {
    const int lr = lane & 15, kq = lane >> 4;
    const bf16x8 b0 = *(const LAS bf16x8*)(Y + (nt * 16 + lr) * CP + kq * 16), b1 = *(const LAS bf16x8*)(Y + (nt * 16 + lr) * CP + kq * 16 + 64);
#pragma unroll
    for (int i = 0; i < NT; ++i) { const int mt = mt0 + i;
        const bf16x8 a0 = *(const LAS bf16x8*)(X + (mt * 16 + lr) * CP + kq * 16), a1 = *(const LAS bf16x8*)(X + (mt * 16 + lr) * CP + kq * 16 + 64);
        f32x4 acc = (f32x4){0.f, 0.f, 0.f, 0.f};
        acc = __builtin_amdgcn_mfma_f32_16x16x32_bf16(a0, b0, acc, 0, 0, 0);
        acc = __builtin_amdgcn_mfma_f32_16x16x32_bf16(a1, b1, acc, 0, 0, 0);
        E(mt, nt, acc); }
}
__device__ __forceinline__ v2u pack4(const f32x4& v) { return (v2u){pg8::cvt_pk_bf16(v[0], v[1]), pg8::cvt_pk_bf16(v[2], v[3])}; }
__device__ __forceinline__ f32x4 unpack4(const v2u w) { return (f32x4){bflo(w.x), bfhi(w.x), bflo(w.y), bfhi(w.y)}; }
__device__ __forceinline__ void p4a_chunk(Frame& F0, const In& I) {
    PHASE_FRAME(F0);
    LAS unsigned char* L = F.lds;
    const int lane = F.lane, w = F.wave, lr = lane & 15, kq = lane >> 4;
    const bf16* RKV = (const bf16*)(F.ws + WS_RKV); const float* LW = (const float*)(F.ws + WS_DECAY); const bf16* ICL = (const bf16*)(F.ws + WS_ICLR);
    unsigned char* CHK = F.ws + WS_CHK;
    int uit = 0;
    for (int unit = F.vcu; unit < BATCH * RH * (SEQ / 64); unit += F.G, ++uit) {
        const int bh = unit >> 7, ck = unit & 127, b = bh >> 4, h = bh & 15;
        const size_t tok0 = (size_t)b * SEQ + (size_t)ck * 64 + 8 * w;
        const int hc = h * 64 + lane;
        float lwv[8], ic[8], rr[8], kk[8], vv[8];
#pragma unroll
        for (int i = 0; i < 8; ++i) { const size_t tok = tok0 + i; lwv[i] = LW[tok * RW + hc]; ic[i] = bf2f(ICL[tok * RW + hc]);
            rr[i] = bf2f(RKV[tok * (3 * RW) + hc]); kk[i] = bf2f(RKV[tok * (3 * RW) + RW + hc]); vv[i] = bf2f(RKV[tok * (3 * RW) + 2 * RW + hc]); }
        const float kkp = I.k_k[hc], kap = I.k_a[hc];
        float cs[8]; { float run = 0.f;
#pragma unroll
            for (int i = 0; i < 8; ++i) { run += lwv[i]; cs[i] = run; } }
        __syncthreads();
        ((LAS float*)(L + C_SEG))[w * 64 + lane] = cs[7];
        CBAR();
        float pre = 0.f, tot = 0.f;
#pragma unroll
        for (int j = 0; j < 8; ++j) { const float sg = ((const LAS float*)(L + C_SEG))[j * 64 + lane]; tot += sg; pre += (j < w) ? sg : 0.f; }
        if (w == 0) ((LAS float*)(L + C_GAM))[lane] = __expf(tot);
        unsigned att[4], bht[4], kht[4], vtt[4];
        float at_[8], bh_[8], kh_[8]; const float gtot = __expf(tot); float ep_prev = 1.f;
#pragma unroll
        for (int i = 0; i < 8; ++i) { const int t = 8 * w + i; const float cum = pre + cs[i], cump = cum - lwv[i];
            const float kkv = kk[i] * kkp; const float n2 = wave_sum(kkv * kkv); const float kkn = kkv * __builtin_amdgcn_rsqf(fmaxf(n2, 1e-24f));
            const float a = -kkn, bb = kkn * ic[i], kp = kk[i] * (1.0f + (ic[i] - 1.0f) * kap);
            const float ep = __expf(cum), em = __builtin_amdgcn_rcpf(ep), epp = (i == 0) ? __expf(cump) : ep_prev, eL = gtot * em; ep_prev = ep;
            const float Rv = rr[i] * ep, Av = a * epp, Bv = bb * em, Kv = kp * em;
            at_[i] = Av; bh_[i] = bb * eL; kh_[i] = kp * eL;
            *(LAS unsigned short*)(L + C_RT + t * CP + lane * 2) = (unsigned short)f2bf(Rv);
            *(LAS unsigned short*)(L + C_AT + t * CP + lane * 2) = (unsigned short)f2bf(Av);
            *(LAS unsigned short*)(L + C_BT + t * CP + lane * 2) = (unsigned short)f2bf(Bv);
            *(LAS unsigned short*)(L + C_KT + t * CP + lane * 2) = (unsigned short)f2bf(Kv); }
#pragma unroll
        for (int q = 0; q < 4; ++q) { att[q] = pk2(at_[2 * q], at_[2 * q + 1]); bht[q] = pk2(bh_[2 * q], bh_[2 * q + 1]); kht[q] = pk2(kh_[2 * q], kh_[2 * q + 1]); vtt[q] = pk2(vv[2 * q], vv[2 * q + 1]); }
        *(LAS v4u*)(L + C_ATT + lane * CP + 16 * w) = (v4u){att[0], att[1], att[2], att[3]};
        *(LAS v4u*)(L + C_WA + (64 + lane) * CP + 16 * w) = (v4u){bht[0], bht[1], bht[2], bht[3]};
        CBAR();
        const int cit = (uit * F.G + F.vcu) * 16 + w * 2; const bool hx = cit < MOE_NITEMS, hy = cit + 1 < MOE_NITEMS;
        f32x4 tX[16]; MoeItem mX = moe_item(hx ? cit : 0, I.w_gu, I.w_down, F.ws);
        LAS float* tscr = (LAS float*)(L + C_TSCR + w * 5120);
        struct Fr { bf16x8 a, b; };
        auto LD = [&](int base, int tile) -> Fr { const LAS unsigned char* q = L + base + (tile * 16 + lr) * CP + kq * 16; Fr f; f.a = *(const LAS bf16x8*)q; f.b = *(const LAS bf16x8*)(q + 64); return f; };
        auto MM = [&](const Fr& x, const Fr& y) -> f32x4 { f32x4 acc = (f32x4){0.f, 0.f, 0.f, 0.f};
            acc = __builtin_amdgcn_mfma_f32_16x16x32_bf16(x.a, y.a, acc, 0, 0, 0); acc = __builtin_amdgcn_mfma_f32_16x16x32_bf16(x.b, y.b, acc, 0, 0, 0); return acc; };
        const int nt = w & 3, mt0 = 2 * (w >> 2), n = nt * 16 + lr;
        { const Fr yAT = LD(C_AT, nt), yKT = LD(C_KT, nt), yRT = LD(C_RT, nt);
          Fr xBT[2], xAT[2], xKT[2];
#pragma unroll
          for (int i = 0; i < 2; ++i) { xBT[i] = LD(C_BT, mt0 + i); xAT[i] = LD(C_AT, mt0 + i); xKT[i] = LD(C_KT, mt0 + i); }
          f32x4 a1[2], a2[2], a3[2], a4[2];
#pragma unroll
          for (int i = 0; i < 2; ++i) { a1[i] = MM(xBT[i], yAT); a2[i] = MM(xAT[i], yKT); a3[i] = MM(xBT[i], yRT); a4[i] = MM(xKT[i], yRT); }
#pragma unroll
          for (int i = 0; i < 2; ++i) { const int m0 = (mt0 + i) * 16 + 4 * kq;
              f32x4 v = a1[i];
#pragma unroll
              for (int e = 0; e < 4; ++e) { v[e] = (m0 + e < n) ? v[e] : 0.f; *(LAS unsigned short*)(L + C_MA + (m0 + e) * CP + n * 2) = (unsigned short)f2bf(v[e]); }
              *(LAS v2u*)(L + C_MTA + n * CP + m0 * 2) = pack4(v);
              v = a2[i];
#pragma unroll
              for (int e = 0; e < 4; ++e) v[e] = (n < m0 + e) ? v[e] : 0.f;
              *(LAS v2u*)(L + C_AAK + n * CP + m0 * 2) = pack4(v);
              v = a3[i];
#pragma unroll
              for (int e = 0; e < 4; ++e) v[e] = (m0 + e <= n) ? v[e] : 0.f;
              *(LAS v2u*)(L + C_WA + n * CP + m0 * 2) = pack4(v);
              v = a4[i];
#pragma unroll
              for (int e = 0; e < 4; ++e) v[e] = (m0 + e <= n) ? v[e] : 0.f;
              *(LAS v2u*)(L + C_ARKT + n * CP + m0 * 2) = pack4(v); } }
        CBAR();
        if (hx) tr8_load(mX, tX, lane);
#pragma unroll
        for (int lvl = 0; lvl < 6; ++lvl) {
            const int Wsrc = (lvl & 1) ? C_WB : C_WA, Wdst = (lvl & 1) ? C_WA : C_WB, Ms = (lvl & 1) ? C_MB : C_MA, Mts = (lvl & 1) ? C_MTB : C_MTA, Md = (lvl & 1) ? C_MA : C_MB, Mtd = (lvl & 1) ? C_MTA : C_MTB;
            const Fr yW = LD(Wsrc, w); Fr yMt; if (lvl < 5) yMt = LD(Mts, nt);
            Fr xM[4], xS[2];
#pragma unroll
            for (int i = 0; i < 4; ++i) xM[i] = LD(Ms, i);
            if (lvl < 5) { xS[0] = LD(Ms, mt0); xS[1] = LD(Ms, mt0 + 1); }
            const int nj = w * 16 + lr;
            f32x4 old[4], aw[4], as[2];
#pragma unroll
            for (int i = 0; i < 4; ++i) old[i] = unpack4(*(const LAS v2u*)(L + Wsrc + nj * CP + (i * 16 + 4 * kq) * 2));
#pragma unroll
            for (int i = 0; i < 4; ++i) aw[i] = MM(xM[i], yW);
            if (lvl < 5) {
#pragma unroll
                for (int i = 0; i < 2; ++i) as[i] = MM(xS[i], yMt); }
#pragma unroll
            for (int i = 0; i < 4; ++i) *(LAS v2u*)(L + Wdst + nj * CP + (i * 16 + 4 * kq) * 2) = pack4(old[i] + aw[i]);
            if (lvl < 5) {
#pragma unroll
                for (int i = 0; i < 2; ++i) { const int m0 = (mt0 + i) * 16 + 4 * kq;
#pragma unroll
                    for (int e = 0; e < 4; ++e) *(LAS unsigned short*)(L + Md + (m0 + e) * CP + n * 2) = (unsigned short)f2bf(as[i][e]);
                    if (lvl < 4) *(LAS v2u*)(L + Mtd + n * CP + m0 * 2) = pack4(as[i]); } }
            if (lvl == 4) *(LAS v4u*)(L + C_KHT + lane * CP + 16 * w) = (v4u){kht[0], kht[1], kht[2], kht[3]};
            if (lvl == 2) { if (hx) tr8_finish(tX, mX, tscr, lane);
                            if (hy) { mX = moe_item(cit + 1, I.w_gu, I.w_down, F.ws); tr8_load(mX, tX, lane); } }
            CBAR();
        }
        *(LAS v4u*)(L + C_VT + lane * CP + 16 * w) = (v4u){vtt[0], vtt[1], vtt[2], vtt[3]};
        unsigned char* og = CHK + (size_t)unit * CHK_UNIT_BYTES;
        { const Fr yW1 = LD(C_WA, nt), yW2 = LD(C_WA + 64 * CP, nt);
          Fr xA[2], xK[2];
#pragma unroll
          for (int i = 0; i < 2; ++i) { xA[i] = LD(C_ATT, mt0 + i); xK[i] = LD(C_AAK, mt0 + i); }
          f32x4 rv[2], av[2], kv[2];
          const float gm = ((const LAS float*)(L + C_GAM))[n];
#pragma unroll
          for (int i = 0; i < 2; ++i) { const int m0 = (mt0 + i) * 16 + 4 * kq;
              rv[i] = unpack4(*(const LAS v2u*)(L + C_RT + n * CP + m0 * 2)); av[i] = unpack4(*(const LAS v2u*)(L + C_ARKT + n * CP + m0 * 2)); kv[i] = unpack4(*(const LAS v2u*)(L + C_KHT + n * CP + m0 * 2)); }
          f32x4 p7[2], p8[2], p9[2], p10[2];
#pragma unroll
          for (int i = 0; i < 2; ++i) { p7[i] = MM(xA[i], yW1); p8[i] = MM(xK[i], yW1); p9[i] = MM(xA[i], yW2); p10[i] = MM(xK[i], yW2); }
#pragma unroll
          for (int i = 0; i < 2; ++i) { const int m0 = (mt0 + i) * 16 + 4 * kq;
              *(GAS v2u*)(og + 0 * 8192 + n * 128 + m0 * 2) = pack4(p7[i] + rv[i]);
              *(LAS v2u*)(L + C_QYT + n * CP + m0 * 2) = pack4(p8[i] + av[i]);
              f32x4 v = p9[i];
#pragma unroll
              for (int e = 0; e < 4; ++e) v[e] += (m0 + e == n) ? gm : 0.f;
              *(GAS v2u*)(og + 1 * 8192 + n * 128 + m0 * 2) = pack4(v);
              *(LAS v2u*)(L + C_QST + n * CP + m0 * 2) = pack4(p10[i] + kv[i]); } }
        CBAR();
        { const Fr yQy = LD(C_QYT, nt), yQs = LD(C_QST, nt);
          Fr xV[2];
#pragma unroll
          for (int i = 0; i < 2; ++i) xV[i] = LD(C_VT, mt0 + i);
          f32x4 p11[2], p12[2];
#pragma unroll
          for (int i = 0; i < 2; ++i) { p11[i] = MM(xV[i], yQy); p12[i] = MM(xV[i], yQs); }
#pragma unroll
          for (int i = 0; i < 2; ++i) { const int m0 = (mt0 + i) * 16 + 4 * kq;
              *(GAS v2u*)(og + 2 * 8192 + n * 128 + m0 * 2) = pack4(p11[i]);
              *(GAS v2u*)(og + 3 * 8192 + n * 128 + m0 * 2) = pack4(p12[i]); } }
        if (hy) tr8_finish(tX, mX, tscr, lane);
    }
}

constexpr int C2_SLOT = 20480;
__device__ __forceinline__ void p4b_scan(Frame& F0, const In& I) {
    PHASE_FRAME(F0);
    const int lane = F.lane, lr = lane & 15, kq = lane >> 4;
    const unsigned char* CHK = F.ws + WS_CHK; bf16* YS = (bf16*)(F.ws + WS_YSCAN);
    for (int unit = F.vcu; unit < BATCH * RH * 4; unit += F.G) {
        const int bh = unit >> 2, rq = unit & 3, b = bh >> 4, h = bh & 15;
        if (F.wave == 0) {
            LAS unsigned char* Sl = F.lds + 3 * C2_SLOT;
            f32x4 S[4]; bf16x8 sf[2];
#pragma unroll
            for (int nt = 0; nt < 4; ++nt) S[nt] = (f32x4){0.f, 0.f, 0.f, 0.f};
#pragma unroll
            for (int ks = 0; ks < 2; ++ks)
#pragma unroll
                for (int j = 0; j < 8; ++j) sf[ks][j] = 0;
#define C2_DMA(ck_) do { const int ckc_ = (ck_) < SEQ / 64 ? (ck_) : SEQ / 64 - 1; const unsigned char* ug = CHK + ((size_t)bh * 128 + ckc_) * CHK_UNIT_BYTES; \
                LAS unsigned char* sl_ = F.lds + ((ck_) % 3) * C2_SLOT; \
                _Pragma("unroll") for (int j = 0; j < 16; ++j) __builtin_amdgcn_global_load_lds((const unsigned*)(ug + j * 1024 + lane * 16), (LAS unsigned*)(sl_ + j * 1024), 16, 0, 0); \
                _Pragma("unroll") for (int j = 0; j < 2; ++j) { \
                    __builtin_amdgcn_global_load_lds((const unsigned*)(ug + 2 * 8192 + (j * 32 + (lane >> 1)) * 128 + rq * 32 + (lane & 1) * 16), (LAS unsigned*)(sl_ + 16384 + j * 1024), 16, 0, 0); \
                    __builtin_amdgcn_global_load_lds((const unsigned*)(ug + 3 * 8192 + (j * 32 + (lane >> 1)) * 128 + rq * 32 + (lane & 1) * 16), (LAS unsigned*)(sl_ + 18432 + j * 1024), 16, 0, 0); } } while (0)
            C2_DMA(0); C2_DMA(1);
#pragma unroll 1
            for (int ck = 0; ck < SEQ / 64; ++ck) {
                asm volatile("s_waitcnt lgkmcnt(0)" ::: "memory");
                C2_DMA(ck + 2);
                asm volatile("s_waitcnt vmcnt(40)" ::: "memory");
                const LAS unsigned char* sl_ = F.lds + (ck % 3) * C2_SLOT;
#pragma unroll
                for (int nt = 0; nt < 4; ++nt) {
                    const bf16x8 py0 = *(const LAS bf16x8*)(sl_ + (16 * nt + lr) * 128 + kq * 16), py1 = *(const LAS bf16x8*)(sl_ + (16 * nt + lr) * 128 + kq * 16 + 64);
                    const bf16x8 ps0 = *(const LAS bf16x8*)(sl_ + 8192 + (16 * nt + lr) * 128 + kq * 16), ps1 = *(const LAS bf16x8*)(sl_ + 8192 + (16 * nt + lr) * 128 + kq * 16 + 64);
                    f32x4 y = unpack4(*(const LAS v2u*)(sl_ + 16384 + (16 * nt + lr) * 32 + kq * 8));
                    f32x4 s2 = unpack4(*(const LAS v2u*)(sl_ + 18432 + (16 * nt + lr) * 32 + kq * 8));
                    y = __builtin_amdgcn_mfma_f32_16x16x32_bf16(sf[0], py0, y, 0, 0, 0); y = __builtin_amdgcn_mfma_f32_16x16x32_bf16(sf[1], py1, y, 0, 0, 0);
                    *(GAS v2u*)(YS + ((size_t)b * SEQ + (size_t)ck * 64 + 16 * nt + lr) * RW + h * 64 + rq * 16 + 4 * kq) = pack4(y);
                    s2 = __builtin_amdgcn_mfma_f32_16x16x32_bf16(sf[0], ps0, s2, 0, 0, 0); s2 = __builtin_amdgcn_mfma_f32_16x16x32_bf16(sf[1], ps1, s2, 0, 0, 0);
                    S[nt] = s2; }
#pragma unroll
                for (int nt = 0; nt < 4; ++nt)
#pragma unroll
                    for (int i = 0; i < 4; ++i) *(LAS unsigned short*)(Sl + (4 * kq + i) * CP + (16 * nt + lr) * 2) = (unsigned short)f2bf(S[nt][i]);
                LDS_WAIT(); asm volatile("" ::: "memory");
                sf[0] = *(const LAS bf16x8*)(Sl + lr * CP + kq * 16); sf[1] = *(const LAS bf16x8*)(Sl + lr * CP + kq * 16 + 64);
                LDS_WAIT(); asm volatile("" ::: "memory");
            }
            asm volatile("s_waitcnt vmcnt(0)" ::: "memory");
#undef C2_DMA
        }
    }
}
static_assert(3 * C2_SLOT + 4096 + 5 * 16640 <= TAB_OFF, "P4b LDS map");

__device__ __forceinline__ void p5_post(Frame& F0, const In& I) {
    PHASE_FRAME(F0);
    const int lane = F.lane; const int gw = F.vcu * NWAVES + F.wave, NGW = F.G * NWAVES;
    const bf16* RKV = (const bf16*)(F.ws + WS_RKV); const bf16* ICL = (const bf16*)(F.ws + WS_ICLR); const bf16* YS = (const bf16*)(F.ws + WS_YSCAN);
    const bf16* G = (const bf16*)(F.ws + WS_G); bf16* YB = (bf16*)(F.ws + WS_YB);
    const int c0 = lane * 16;
    for (int tok = gw; tok < T; tok += NGW) {
        float y[16], rr[16], kk[16], vv[16], ic[16], gg[16];
#pragma unroll
        for (int q = 0; q < 2; ++q) { const v4u a = *(const GAS v4u*)(YS + (size_t)tok * RW + c0 + 8 * q), c = *(const GAS v4u*)(ICL + (size_t)tok * RW + c0 + 8 * q);
            const unsigned aw[4] = {a.x, a.y, a.z, a.w}, cw[4] = {c.x, c.y, c.z, c.w};
#pragma unroll
            for (int e = 0; e < 4; ++e) { y[8 * q + 2 * e] = bflo(aw[e]); y[8 * q + 2 * e + 1] = bfhi(aw[e]); ic[8 * q + 2 * e] = bflo(cw[e]); ic[8 * q + 2 * e + 1] = bfhi(cw[e]); } }
#pragma unroll
        for (int q = 0; q < 2; ++q) {
            const v4u a = *(const GAS v4u*)(RKV + (size_t)tok * (3 * RW) + c0 + 8 * q), bb = *(const GAS v4u*)(RKV + (size_t)tok * (3 * RW) + RW + c0 + 8 * q),
                      c = *(const GAS v4u*)(RKV + (size_t)tok * (3 * RW) + 2 * RW + c0 + 8 * q), d = *(const GAS v4u*)(G + (size_t)tok * RW + c0 + 8 * q);
            const unsigned aw[4] = {a.x, a.y, a.z, a.w}, bw[4] = {bb.x, bb.y, bb.z, bb.w}, cw[4] = {c.x, c.y, c.z, c.w}, dw[4] = {d.x, d.y, d.z, d.w};
#pragma unroll
            for (int e = 0; e < 4; ++e) { rr[8 * q + 2 * e] = bflo(aw[e]); rr[8 * q + 2 * e + 1] = bfhi(aw[e]); kk[8 * q + 2 * e] = bflo(bw[e]); kk[8 * q + 2 * e + 1] = bfhi(bw[e]);
                vv[8 * q + 2 * e] = bflo(cw[e]); vv[8 * q + 2 * e + 1] = bfhi(cw[e]); gg[8 * q + 2 * e] = bflo(dw[e]); gg[8 * q + 2 * e + 1] = bfhi(dw[e]); } }
        float s = 0.f, bs = 0.f;
#pragma unroll
        for (int e = 0; e < 16; ++e) { s += y[e]; const float kp = kk[e] * (1.0f + (ic[e] - 1.0f) * I.k_a[c0 + e]); bs += rr[e] * kp * I.r_k[c0 + e]; }
        s = quadsum(s); bs = quadsum(bs);
        const float mean = s * (1.f / 64.f); float s2 = 0.f;
#pragma unroll
        for (int e = 0; e < 16; ++e) { y[e] -= mean; s2 += y[e] * y[e]; }
        s2 = quadsum(s2);
        const float rstd = 1.f / sqrtf(s2 * (1.f / 64.f) + GN_EPS);
        float o[16];
#pragma unroll
        for (int e = 0; e < 16; ++e) o[e] = (y[e] * rstd * I.lnx_w[c0 + e] + I.lnx_b[c0 + e] + bs * vv[e]) * gg[e];
        { unsigned w8[4];
#pragma unroll
          for (int q = 0; q < 4; ++q) { int t8 = __builtin_amdgcn_cvt_pk_fp8_f32(o[4 * q] * ACT8_SCALE, o[4 * q + 1] * ACT8_SCALE, 0, false); t8 = __builtin_amdgcn_cvt_pk_fp8_f32(o[4 * q + 2] * ACT8_SCALE, o[4 * q + 3] * ACT8_SCALE, t8, true); w8[q] = (unsigned)t8; }
          *(GAS v4u*)((unsigned char*)YB + (size_t)tok * RW + c0) = (v4u){w8[0], w8[1], w8[2], w8[3]}; }
    }
}
#ifndef STAGE
#define STAGE 4
#endif
struct Args { In in; float* out; unsigned char* ws; };
__global__ void __launch_bounds__(NWAVES * 64, 2) mk_fwd(Args args) {
    extern __shared__ __attribute__((aligned(16))) unsigned char lds[];
    Frame F;
    F.lds = (LAS unsigned char*)lds;
    F.MISC = (volatile LAS unsigned*)(F.lds + MISC_OFF);
    F.tid = threadIdx.x; F.lane = F.tid & 63; F.wave = __builtin_amdgcn_readfirstlane(F.tid >> 6);
    F.G = gridDim.x; { const int bx = blockIdx.x; F.vcu = (F.G % 8 == 0) ? (bx % 8) * (F.G / 8) + bx / 8 : bx; }
    F.ws = args.ws;
    F.rsrc = __builtin_amdgcn_make_buffer_rsrc(args.ws, 0, 0xffffffff, 0x00020000);
    F.ctl = (gu32*)(args.ws + WS_CTL);
    for (int u = F.tid; u < (LDS_BYTES - MISC_OFF) / 4; u += NWAVES * 64) ((LAS unsigned*)(F.lds + MISC_OFF))[u] = 0u;
    __syncthreads();
    XcdBarrier bar = xcd_barrier_post((unsigned*)(F.ctl + CW_BAR), F.MISC + 8);
    const In& I = args.in;
#define GRID_BAR() xcd_barrier(bar)
#ifndef DUP_PHASE
#define DUP_PHASE -1
#endif
#define RUN(n, call) do { call; if (DUP_PHASE == (n)) { GRID_BAR(); call; } } while (0)

#if STAGE >= 2
    RUN(0, p0_prologue(F, I));
    GRID_BAR();
#endif
#if STAGE >= 3
    RUN(1, p1_proj(F, I));
    GRID_BAR();
    RUN(2, p2_shift_attn(F, I));
    GRID_BAR();
#if STAGE >= 4
    RUN(3, p3_lora(F, I));
    GRID_BAR();
    RUN(4, p4a_chunk(F, I));
    GRID_BAR();
    RUN(44, p4b_scan(F, I));
    GRID_BAR();
    RUN(5, p5_post(F, I));
    GRID_BAR();
#endif
    RUN(6, p6_merged(F, I));
    GRID_BAR();
    RUN(7, p7_mix(F, I));
    GRID_BAR();
#endif
    p8_ln_router<(STAGE < 3)>(F, I);
    GRID_BAR();
#if STAGE >= 2
    p9_scatter(F, I);
    GRID_BAR();
    RUN(10, p10_moe_up(F, I));
    GRID_BAR();
    RUN(11, p11_moe_down(F, I));
    GRID_BAR();
#endif
    RUN(12, p12_final<(STAGE < 2)>(F, I, args.out));
}

extern "C" void kernel_launch(void* const* d_in, const int* in_sizes, int n_in, void* d_out, int out_size, void* d_ws, size_t ws_size, hipStream_t stream) {
    static int grid = 0;
    if (grid == 0) {
        if (n_in != 27 || in_sizes[0] != T * D || out_size != T * D || ws_size < WS_END) { fprintf(stderr, "kernel_launch: unexpected shapes (n_in %d, in0 %d, out %d, ws %zu)\n", n_in, n_in > 0 ? in_sizes[0] : -1, out_size, ws_size); grid = -1; return; }
        int dev = 0, cus = 0, per_cu = 0;
        if (hipGetDevice(&dev) != hipSuccess || hipDeviceGetAttribute(&cus, hipDeviceAttributeMultiprocessorCount, dev) != hipSuccess) { grid = -1; return; }
        if (hipFuncSetAttribute((const void*)mk_fwd, hipFuncAttributeMaxDynamicSharedMemorySize, LDS_BYTES) != hipSuccess) { fprintf(stderr, "kernel_launch: hipFuncSetAttribute failed\n"); grid = -1; return; }
        if (hipOccupancyMaxActiveBlocksPerMultiprocessor(&per_cu, (const void*)mk_fwd, NWAVES * 64, LDS_BYTES) != hipSuccess || per_cu < 1)
            fprintf(stderr, "kernel_launch: occupancy query reports %d\n", per_cu);
        (void)hipGetLastError();
        grid = cus;
    }
    if (grid < 0) return;
    if (hipMemsetAsync((char*)d_ws + WS_CTL, 0, CTL_ZERO_BYTES, stream) != hipSuccess) return;
    Args a{};
    const float** ip = (const float**)&a.in;
    for (int i = 0; i < 27; ++i) ip[i] = (const float*)d_in[i];
    a.out = (float*)d_out; a.ws = (unsigned char*)d_ws;
    hipLaunchKernelGGL(mk_fwd, dim3(grid), dim3(NWAVES * 64), LDS_BYTES, stream, a);
    const hipError_t le = hipPeekAtLastError();
    if (le != hipSuccess) fprintf(stderr, "kernel_launch: launch failed: %s\n", hipGetErrorName(le));
}
```

```cpp
#define STAGE 4
#include <hip/hip_runtime.h>
#include <cstdio>
#include <cstdint>

#define GAS __attribute__((address_space(1)))
#define LAS __attribute__((address_space(3)))
typedef unsigned short bf16;
typedef unsigned v4u __attribute__((ext_vector_type(4)));
typedef unsigned v2u __attribute__((ext_vector_type(2)));
typedef float f32x4 __attribute__((ext_vector_type(4)));
typedef float f32x2 __attribute__((ext_vector_type(2)));
typedef float f32x16 __attribute__((ext_vector_type(16)));
typedef short bf16x8 __attribute__((ext_vector_type(8)));
typedef short bf16x4 __attribute__((ext_vector_type(4)));
typedef GAS unsigned gu32;

constexpr int NWAVES = 8;
constexpr int BATCH = 4, SEQ = 8192, D = 2048, T = BATCH * SEQ;
constexpr int CHUNK = 64, LEFT = 8, AH = 16, AD = 64, AW = 1024;
constexpr int REL_TABLE = 320, MAX_PAST = 256;
constexpr int RH = 16, RN = 64, RW = 1024, DLORA = 96, ALORA = 96, GLORA = 256;
constexpr int SHIFT_W = 3 * RW + DLORA + ALORA + GLORA;
constexpr int D_IN = 3 * AW + SHIFT_W + 2 * D;
constexpr int NE = 32, TOPK = 4, FF = 2048;
constexpr int MSLOT = T * TOPK;
constexpr int NBLK_MAX = (MSLOT + NE * 255 + 255) / 256;
constexpr int RROWS = NBLK_MAX * 256;
constexpr float LN_EPS = 1e-5f, GN_EPS = 64e-5f;
constexpr float YS_SCALE = 16.0f, YS_INV = 1.0f / 16.0f;
constexpr float ACT8_SCALE = 16.0f;
constexpr float F8_CVT_SCALE = 0.015625f;
constexpr float DN_ALPHA = 1.189207115002721f;
constexpr int PROJ_LD = 9728, PJ_Q = 0, PJ_K = 1024, PJ_SEG = 2048, SEG_PAD = 3584, PJ_GA = 5632, PJ_GB = 7680;
constexpr int LORA_LD = 512;

constexpr size_t MiB = 1u << 20;
constexpr size_t WS_CTL = 0, CTL_ZERO_BYTES = 1 * MiB;
constexpr size_t WS_TOPI = 2 * MiB;
constexpr size_t WS_GATE = 3 * MiB;
constexpr size_t WS_ROWSLOT = 4 * MiB;
constexpr size_t WS_ROWW = 5 * MiB;
constexpr size_t WS_WLA = 6 * MiB;
constexpr size_t WS_WLG = 7 * MiB;
constexpr size_t WS_PAT = 8 * MiB;
constexpr size_t WS_PBT = 12 * MiB;
constexpr size_t WS_WOT = 16 * MiB;
constexpr size_t WS_WVT = 24 * MiB;
constexpr size_t WS_WINT = 28 * MiB;
constexpr size_t WS_WG8 = 72 * MiB;
constexpr size_t WS_WQK8 = 80 * MiB;
constexpr size_t WS_WV8 = 84 * MiB;
constexpr size_t WS_WSV8 = 88 * MiB;
constexpr size_t WS_WGUT = 128 * MiB;
constexpr size_t WS_WDNT = 640 * MiB;
constexpr size_t WS_BASE0 = 1024 * MiB;
constexpr size_t WS_PROJ = WS_BASE0;
constexpr size_t WS_VT = WS_PROJ + 608 * MiB;
constexpr size_t WS_YA = WS_VT + 64 * MiB;
constexpr size_t WS_RKV = WS_YA + 64 * MiB;
constexpr size_t WS_LORAIN = WS_RKV + 192 * MiB;
constexpr size_t WS_DECAY = WS_LORAIN + 32 * MiB;
constexpr size_t WS_ICLR = WS_DECAY + 128 * MiB;
constexpr size_t WS_G = WS_ICLR + 128 * MiB;
constexpr size_t WS_YSCAN = WS_G + 64 * MiB;
constexpr size_t WS_YB = WS_YSCAN + 128 * MiB;
constexpr size_t WS_MERGED = WS_YB + 64 * MiB;
constexpr size_t WS_XB16 = WS_MERGED + 128 * MiB;
constexpr size_t WS_MIX_END = WS_XB16 + 128 * MiB;
constexpr size_t WS_Z = 2816 * MiB;
constexpr size_t WS_H1 = 3072 * MiB;
constexpr size_t WS_H1B = 3328 * MiB;
constexpr size_t WS_CHK = 3456 * MiB;
constexpr size_t WS_XB8 = 3712 * MiB;
constexpr size_t WS_END = 3776 * MiB;
constexpr size_t WS_XG = WS_BASE0;
constexpr size_t WS_ACT = WS_BASE0 + 544 * MiB;
constexpr size_t WS_YSLOT = WS_BASE0 + 1088 * MiB;
static_assert(WS_MIX_END <= WS_Z && WS_YSLOT + 512 * MiB <= WS_Z, "ws map");
static_assert(WS_WINT + (size_t)PROJ_LD * D * 2 <= WS_WGUT, "ws map");

constexpr int CW_CNT = 512;
constexpr int CW_CUR = 576;
constexpr int CW_BAR = 4096;

constexpr int RING_OFF = 0, RING_BYTES = 131072;
constexpr int LDS_BYTES = 160 * 1024;
constexpr int MISC_OFF = LDS_BYTES - 512;
constexpr int TAB_OFF = LDS_BYTES - 1024;

#define RLX_AGENT __ATOMIC_RELAXED, __HIP_MEMORY_SCOPE_AGENT
#define LDS_WAIT() asm volatile("s_waitcnt lgkmcnt(0)" ::: "memory")
#define VM_WAIT() asm volatile("s_waitcnt vmcnt(0)" ::: "memory")
__device__ __forceinline__ unsigned f2bf(float f) { unsigned u = __builtin_bit_cast(unsigned, f); return (u + 0x7fffu + ((u >> 16) & 1u)) >> 16; }
__device__ __forceinline__ unsigned pk2(float lo, float hi) { return f2bf(lo) | (f2bf(hi) << 16); }
__device__ __forceinline__ float bf2f(unsigned short h) { return __builtin_bit_cast(float, (unsigned)h << 16); }
__device__ __forceinline__ float bflo(unsigned w) { return __builtin_bit_cast(float, w << 16); }
__device__ __forceinline__ float bfhi(unsigned w) { return __builtin_bit_cast(float, w & 0xffff0000u); }
__device__ __forceinline__ float fsigmoid(float x) { return __builtin_amdgcn_rcpf(1.0f + __expf(-x)); }
__device__ __forceinline__ float dpp_f(float x, const int ctrl_sel) {
    const int xi = __builtin_bit_cast(int, x); int r;
    if (ctrl_sel == 0) r = __builtin_amdgcn_update_dpp(0, xi, 0xB1, 0xF, 0xF, false);
    else if (ctrl_sel == 1) r = __builtin_amdgcn_update_dpp(0, xi, 0x4E, 0xF, 0xF, false);
    else if (ctrl_sel == 2) r = __builtin_amdgcn_update_dpp(0, xi, 0x124, 0xF, 0xF, false);
    else r = __builtin_amdgcn_update_dpp(0, xi, 0x128, 0xF, 0xF, false);
    return __builtin_bit_cast(float, r);
}
__device__ __forceinline__ float rowsum16(float x) { x += dpp_f(x, 0); x += dpp_f(x, 1); x += dpp_f(x, 2); x += dpp_f(x, 3); return x; }
__device__ __forceinline__ float quadsum(float x) { x += dpp_f(x, 0); x += dpp_f(x, 1); return x; }
__device__ __forceinline__ float wave_sum(float v) {
    v = rowsum16(v);
    const int vi = __builtin_bit_cast(int, v);
    const float s0 = __builtin_bit_cast(float, __builtin_amdgcn_readlane(vi, 0)), s1 = __builtin_bit_cast(float, __builtin_amdgcn_readlane(vi, 16));
    const float s2 = __builtin_bit_cast(float, __builtin_amdgcn_readlane(vi, 32)), s3 = __builtin_bit_cast(float, __builtin_amdgcn_readlane(vi, 48));
    return (s0 + s1) + (s2 + s3);
}
namespace pg8 {
#define PG8_LAS __attribute__((address_space(3)))
typedef unsigned short bf16_t;
typedef unsigned u32x4 __attribute__((ext_vector_type(4)));
constexpr int BM = 256, BK = 64, HALF = 128, HTB = HALF * BK * 2, STAGE_BYTES = 8 * HTB, NXCD = 8, WGM = 8;

__host__ __device__ __forceinline__ int lds_byte(int r, int c) { const int st = (r >> 4) * 2 + (c >> 5), rr = r & 15, cc = c & 31, ob = rr * 64 + cc * 2; return st * 1024 + (ob ^ (((ob >> 9) & 1) << 5)); }
__host__ __device__ __forceinline__ void stage_rc(int b, int& R, int& C) { const int st = b / 1024, sb = b % 1024, swz = sb ^ (((sb >> 9) & 1) << 5); R = (st >> 1) * 16 + swz / 64; C = (st & 1) * 32 + (swz % 64) / 2; }
__host__ __device__ __forceinline__ int perm32(int rho) { const int n = rho >> 4, i = rho & 15; return 8 * (i >> 2) + 4 * n + (i & 3); }

struct Unit { int pm, pn, aux; };

struct Tiler {
    int nM, nN, nwg, G, c;
    __device__ __forceinline__ void init(int nM_, int nN_, int G_, int c_) { nM = nM_; nN = nN_; nwg = nM * nN; G = G_; c = c_; }
    __device__ __forceinline__ bool map(int i, int& pm, int& pn) const {
        const long L = (long)i * G + c; if (L >= nwg) return false;
        int wgid = (int)L; { const int q = nwg / NXCD, r = nwg % NXCD, xcd = wgid % NXCD, off = wgid / NXCD; wgid = (xcd < r ? xcd * (q + 1) : r * (q + 1) + (xcd - r) * q) + off; }
        const int nig = WGM * nN, gid = wgid / nig, fm = gid * WGM, gsz = (nM - fm) < WGM ? (nM - fm) : WGM;
        pm = fm + ((wgid % nig) % gsz); pn = (wgid % nig) / gsz; return true;
    }
};
struct SchedPlain {
    Tiler t; unsigned A, B, tsA, tsB;
    __device__ __forceinline__ bool next(int i, Unit& u) const { u.aux = 0; return t.map(i, u.pm, u.pn); }
    __device__ __forceinline__ void bases(const Unit& u, unsigned& a, unsigned& b) const { a = A + (unsigned)u.pm * tsA; b = B + (unsigned)u.pn * tsB; }
};
struct SchedTwo {
    Tiler t; unsigned A0, A1, B0, B1, tsA, tsB;
    __device__ __forceinline__ bool next(int i, Unit& u) const { u.aux = i & 1; return t.map(i >> 1, u.pm, u.pn); }
    __device__ __forceinline__ void bases(const Unit& u, unsigned& a, unsigned& b) const { a = (u.aux ? A1 : A0) + (unsigned)u.pm * tsA; b = (u.aux ? B1 : B0) + (unsigned)u.pn * tsB; }
};
struct SchedMoe {
    Tiler t; unsigned A, B, tsA, tsB, es; const PG8_LAS int* pad_end;
    __device__ __forceinline__ bool next(int i, Unit& u) const {
        if (!t.map(i, u.pm, u.pn)) return false;
        const int row0 = u.pm * BM; int e = 0;
#pragma unroll
        for (int j = 0; j < 32; ++j) e += (pad_end[j] <= row0) ? 1 : 0;
        u.aux = __builtin_amdgcn_readfirstlane(e < 31 ? e : 31); return true;
    }
    __device__ __forceinline__ void bases(const Unit& u, unsigned& a, unsigned& b) const { a = A + (unsigned)u.pm * tsA; b = B + (unsigned)u.aux * es + (unsigned)u.pn * tsB; }
};

typedef float f32x2_t_ __attribute__((ext_vector_type(2)));
typedef __bf16 bf16x2_t_ __attribute__((ext_vector_type(2)));
__device__ __forceinline__ unsigned cvt_pk_bf16(float lo, float hi) { const f32x2_t_ v = {lo, hi}; const bf16x2_t_ b = __builtin_convertvector(v, bf16x2_t_); return __builtin_bit_cast(unsigned, b); }
__device__ __forceinline__ u32x4 pack8(const f32x4& v0, const f32x4& v1) { u32x4 w; w.x = cvt_pk_bf16(v0[0], v0[1]); w.y = cvt_pk_bf16(v0[2], v0[3]); w.z = cvt_pk_bf16(v1[0], v1[1]); w.w = cvt_pk_bf16(v1[2], v1[3]); return w; }

typedef int i32x8 __attribute__((ext_vector_type(8)));
typedef int i32x4 __attribute__((ext_vector_type(4)));
__device__ __forceinline__ i32x8 cat8(const bf16x8& a, const bf16x8& b) { return __builtin_shufflevector(__builtin_bit_cast(i32x4, a), __builtin_bit_cast(i32x4, b), 0, 1, 2, 3, 4, 5, 6, 7); }
constexpr int F8_SCALES = 0x00007f79;
template <class Epi, class Sched, bool ALIGN_EPI, bool F8 = false, int F8SC = F8_SCALES>
__device__ __forceinline__ void gemm_phase(PG8_LAS unsigned char* lds, const __amdgpu_buffer_rsrc_t rsrc, const int lda, const int ldb, const int K, const Sched& S, const Epi& E) {
    int tid_ = threadIdx.x; asm volatile("" : "+v"(tid_));
    const int tid = tid_, wid = __builtin_amdgcn_readfirstlane(tid >> 6), lane = tid & 63, wr = wid >> 2, wc = wid & 3, fr = lane & 15, fq = lane >> 4;
    const int nt = K / BK;
    unsigned voffA, voffB;
    { int R, C; stage_rc(tid * 16, R, C); const int Rb = (R & ~31) + perm32(R & 31); voffA = (unsigned)(R * lda + C) * 2u; voffB = (unsigned)(Rb * ldb + C) * 2u; }
    const unsigned p1voffA = 64u * (unsigned)lda * 2u, p1voffB = 64u * (unsigned)ldb * 2u;
    const unsigned kstep = (unsigned)(BK * 2);
    const unsigned hsA = (unsigned)HALF * lda * 2, hsB = (unsigned)HALF * ldb * 2;
    const unsigned ldsw = (unsigned)wid * 1024u;
    const int aoff = lds_byte(wr * 64 + fr, fq * 8), boff = lds_byte(wc * 32 + fr, fq * 8);
#define PG8_SA(b, h) (((b) * 2 + (h)) * HTB)
#define PG8_SB(b, h) ((4 + (b) * 2 + (h)) * HTB)
#define PG8_STAGE(bufoff, goff, voff) do { _Pragma("unroll") for (int _i = 0; _i < 2; ++_i) \
        __builtin_amdgcn_raw_ptr_buffer_load_lds(rsrc, (PG8_LAS void*)(lds + (bufoff) + ldsw + _i * 8192), 16, (int)(voff), (int)((goff) + _i * p1##voff), 0, 0); } while (0)
#define PG8_LD8(addr) __builtin_shufflevector(*(const PG8_LAS i32x4*)(addr), *(const PG8_LAS i32x4*)((addr) + 1024), 0, 1, 2, 3, 4, 5, 6, 7)
#define PG8_LDA(dst, b, h) do { _Pragma("unroll") for (int m = 0; m < 4; ++m) dst[m] = PG8_LD8(lds + PG8_SA(b, h) + aoff + m * 2048); } while (0)
#define PG8_LDB(dst, b, h) do { _Pragma("unroll") for (int n = 0; n < 2; ++n) dst[n] = PG8_LD8(lds + PG8_SB(b, h) + boff + n * 2048); } while (0)
#define PG8_LO(v) __builtin_bit_cast(bf16x8, __builtin_shufflevector(v, v, 0, 1, 2, 3))
#define PG8_HI(v) __builtin_bit_cast(bf16x8, __builtin_shufflevector(v, v, 4, 5, 6, 7))
#define PG8_MMA(ai, bj, At, Bt) do { __builtin_amdgcn_s_setprio(1); \
        if constexpr (!F8) { _Pragma("unroll") for (int m = 0; m < 4; ++m) _Pragma("unroll") for (int n = 0; n < 2; ++n) { \
            acc[ai][bj][m][n] = __builtin_amdgcn_mfma_f32_16x16x32_bf16(PG8_LO(Bt[n]), PG8_LO(At[m]), acc[ai][bj][m][n], 0, 0, 0); \
            acc[ai][bj][m][n] = __builtin_amdgcn_mfma_f32_16x16x32_bf16(PG8_HI(Bt[n]), PG8_HI(At[m]), acc[ai][bj][m][n], 0, 0, 0); } } \
        else { _Pragma("unroll") for (int m = 0; m < 4; ++m) _Pragma("unroll") for (int n = 0; n < 2; ++n) \
            acc[ai][bj][m][n] = __builtin_amdgcn_mfma_scale_f32_16x16x128_f8f6f4(Bt[n], At[m], acc[ai][bj][m][n], 0, 0, 0, F8SC, 1, F8SC); } \
        __builtin_amdgcn_s_setprio(0); } while (0)
#define PG8_WAIT_V(n) asm volatile("s_waitcnt vmcnt(" #n ")" ::: "memory")
#define PG8_WAIT_L(n) asm volatile("s_waitcnt lgkmcnt(" #n ")" ::: "memory")
#define PG8_BAR __builtin_amdgcn_s_barrier()
#define PG8_SCHED __builtin_amdgcn_sched_barrier(0)
#define PG8_ZERO() do { _Pragma("unroll") for (int a = 0; a < 2; ++a) _Pragma("unroll") for (int b = 0; b < 2; ++b) _Pragma("unroll") for (int m = 0; m < 4; ++m) _Pragma("unroll") for (int n = 0; n < 2; ++n) acc[a][b][m][n] = (f32x4){0.f, 0.f, 0.f, 0.f}; } while (0)
    Unit cur, nxt; int ui = 0;
    if (!S.next(0, cur)) return;
    f32x4 acc[2][2][4][2];
    PG8_ZERO();
    i32x8 At[4], B0[2], B1[2];
    unsigned cA, cB; S.bases(cur, cA, cB); cA = __builtin_amdgcn_readfirstlane(cA); cB = __builtin_amdgcn_readfirstlane(cB);
    PG8_STAGE(PG8_SB(0, 0), cB, voffB); PG8_STAGE(PG8_SB(0, 1), cB + hsB, voffB); PG8_STAGE(PG8_SA(0, 0), cA, voffA); PG8_STAGE(PG8_SA(0, 1), cA + hsA, voffA);
    if (wr == 1) PG8_BAR;
    PG8_WAIT_V(2); PG8_BAR;
    PG8_STAGE(PG8_SB(1, 0), cB + kstep, voffB); PG8_STAGE(PG8_SA(1, 0), cA + kstep, voffA); PG8_STAGE(PG8_SB(1, 1), cB + hsB + kstep, voffB);
    PG8_WAIT_V(6); PG8_BAR;
    for (;;) {
        const bool has_next = S.next(ui + 1, nxt);
        unsigned nA = cA, nB = cB; if (has_next) { S.bases(nxt, nA, nB); nA = __builtin_amdgcn_readfirstlane(nA); nB = __builtin_amdgcn_readfirstlane(nB); }
#pragma unroll 1
        for (int t = 0; t < nt; t += 2) {
            const bool last = (t == nt - 2);
            const unsigned a1 = cA + (unsigned)(t + 1) * kstep;
            const unsigned a2 = last ? nA : cA + (unsigned)(t + 2) * kstep, b2 = last ? nB : cB + (unsigned)(t + 2) * kstep;
            const unsigned a3 = a2 + kstep, b3 = b2 + kstep;
            PG8_LDB(B0, 0, 0); PG8_LDB(B1, 0, 1); PG8_SCHED; PG8_LDA(At, 0, 0); PG8_STAGE(PG8_SA(1, 1), a1 + hsA, voffA);
            PG8_WAIT_V(8); PG8_WAIT_L(0); PG8_BAR; PG8_MMA(0, 0, At, B0); PG8_MMA(0, 1, At, B1); PG8_BAR; PG8_SCHED;
            PG8_LDA(At, 0, 1); PG8_STAGE(PG8_SB(0, 0), b2, voffB); PG8_STAGE(PG8_SB(0, 1), b2 + hsB, voffB); PG8_STAGE(PG8_SA(0, 0), a2, voffA);
            PG8_WAIT_V(8); PG8_WAIT_L(0); PG8_BAR; PG8_MMA(1, 0, At, B0); PG8_MMA(1, 1, At, B1); PG8_BAR; PG8_SCHED;
            PG8_LDB(B0, 1, 0); PG8_LDB(B1, 1, 1); PG8_SCHED; PG8_LDA(At, 1, 0); PG8_STAGE(PG8_SA(0, 1), a2 + hsA, voffA);
            PG8_WAIT_V(8); PG8_WAIT_L(0); PG8_BAR; PG8_MMA(0, 0, At, B0); PG8_MMA(0, 1, At, B1); PG8_BAR; PG8_SCHED;
            PG8_LDA(At, 1, 1); PG8_STAGE(PG8_SB(1, 0), b3, voffB); PG8_STAGE(PG8_SB(1, 1), b3 + hsB, voffB); PG8_STAGE(PG8_SA(1, 0), a3, voffA);
            PG8_WAIT_V(8); PG8_WAIT_L(0); PG8_BAR; PG8_MMA(1, 0, At, B0); PG8_MMA(1, 1, At, B1); PG8_BAR; PG8_SCHED;
        }
        if constexpr (ALIGN_EPI) { if (wr == 0) PG8_BAR; }
        bool keep; { int t2 = threadIdx.x; asm volatile("" : "+v"(t2)); const int w2 = __builtin_amdgcn_readfirstlane(t2 >> 6), l2 = t2 & 63; keep = E(acc, cur, w2 >> 2, w2 & 3, l2 & 15, l2 >> 4); }
        if (!has_next) break;
        if (!keep) PG8_ZERO();
        cur = nxt; cA = nA; cB = nB; ++ui;
        if constexpr (ALIGN_EPI) { if (wr == 1) PG8_BAR; }
    }
    PG8_WAIT_V(0);
    if constexpr (!ALIGN_EPI) { if (wr == 0) PG8_BAR; }
    PG8_BAR;
#undef PG8_SA
#undef PG8_SB
#undef PG8_STAGE
#undef PG8_LDA
#undef PG8_LDB
#undef PG8_LD8
#undef PG8_LO
#undef PG8_HI
#undef PG8_MMA
#undef PG8_WAIT_V
#undef PG8_WAIT_L
#undef PG8_BAR
#undef PG8_SCHED
#undef PG8_ZERO
}
}
namespace pg8 {
#define EPI_ROWLOOP _Pragma("unroll") for (int ai = 0; ai < 2; ++ai) _Pragma("unroll") for (int m = 0; m < 4; ++m)
struct EpiProj {
    bf16_t* O; int coloff, nq;
    __device__ __forceinline__ bool operator()(f32x4 (&acc)[2][2][4][2], const Unit& u, int wr, int wc, int fr, int fq) const {
        const int row0 = u.pm * BM + wr * 64 + fr, col0 = coloff + u.pn * BM + wc * 32 + 8 * fq;
        const float sc = (u.pn < nq) ? 0.125f : 1.0f;
        EPI_ROWLOOP { bf16_t* rowp = O + (size_t)(row0 + ai * HALF + m * 16) * PROJ_LD + col0;
#pragma unroll
            for (int bj = 0; bj < 2; ++bj) *(u32x4*)(rowp + bj * HALF) = pack8(acc[ai][bj][m][0] * sc, acc[ai][bj][m][1] * sc); }
        return false;
    }
};
struct EpiGate {
    bf16_t* O;
    __device__ __forceinline__ bool operator()(f32x4 (&acc)[2][2][4][2], const Unit& u, int wr, int wc, int fr, int fq) const {
        const int row0 = u.pm * BM + wr * 64 + fr, d0 = u.pn * HALF + wc * 32 + 8 * fq;
        EPI_ROWLOOP { bf16_t* rowp = O + (size_t)(row0 + ai * HALF + m * 16) * PROJ_LD + d0;
            f32x4 rt[2], gb[2];
#pragma unroll
            for (int n = 0; n < 2; ++n)
#pragma unroll
                for (int j = 0; j < 4; ++j) { const float ea = __expf(-acc[ai][0][m][n][j]), eb = fminf(__expf(-acc[ai][1][m][n][j]), 1e30f);
                    gb[n][j] = __builtin_amdgcn_rcpf(1.0f + eb); rt[n][j] = (1.0f + eb) * __builtin_amdgcn_rcpf(1.0f + ea); }
            *(u32x4*)(rowp + PJ_GA) = pack8(rt[0], rt[1]); *(u32x4*)(rowp + PJ_GB) = pack8(gb[0], gb[1]); }
        return false;
    }
};
struct EpiBf16 {
    bf16_t* O; int ldc;
    __device__ __forceinline__ bool operator()(f32x4 (&acc)[2][2][4][2], const Unit& u, int wr, int wc, int fr, int fq) const {
        const int row0 = u.pm * BM + wr * 64 + fr, col0 = u.pn * BM + wc * 32 + 8 * fq;
        EPI_ROWLOOP { bf16_t* rowp = O + (size_t)(row0 + ai * HALF + m * 16) * ldc + col0;
#pragma unroll
            for (int bj = 0; bj < 2; ++bj) *(u32x4*)(rowp + bj * HALF) = pack8(acc[ai][bj][m][0], acc[ai][bj][m][1]); }
        return false;
    }
};
template <bool ISDEC> struct EpiLoraA {
    float* OUT; const float* par;
    __device__ __forceinline__ bool operator()(f32x4 (&acc)[2][2][4][2], const Unit& u, int wr, int wc, int fr, int fq) const {
        const int row0 = u.pm * BM + wr * 64 + fr, col0 = u.pn * BM + wc * 32 + 8 * fq;
        f32x4 pv[2][2];
#pragma unroll
        for (int bj = 0; bj < 2; ++bj)
#pragma unroll
            for (int n = 0; n < 2; ++n) pv[bj][n] = *(const f32x4*)(par + col0 + bj * HALF + 4 * n);
        EPI_ROWLOOP { float* rowp = OUT + (size_t)(row0 + ai * HALF + m * 16) * RW + col0;
#pragma unroll
            for (int bj = 0; bj < 2; ++bj)
#pragma unroll
                for (int n = 0; n < 2; ++n) { f32x4 v = acc[ai][bj][m][n] + pv[bj][n];
#pragma unroll
                    for (int j = 0; j < 4; ++j) {
                        if (ISDEC) v[j] = -0.60653065971263342f * fsigmoid(v[j]);
                        else v[j] = fsigmoid(v[j]); }
                    *(f32x4*)(rowp + bj * HALF + 4 * n) = v; } }
        return false;
    }
};
struct EpiIclr {
    bf16_t* OUT; const float* par;
    __device__ __forceinline__ bool operator()(f32x4 (&acc)[2][2][4][2], const Unit& u, int wr, int wc, int fr, int fq) const {
        const int row0 = u.pm * BM + wr * 64 + fr, col0 = u.pn * BM + wc * 32 + 8 * fq;
        f32x4 pv[2][2];
#pragma unroll
        for (int bj = 0; bj < 2; ++bj)
#pragma unroll
            for (int n = 0; n < 2; ++n) pv[bj][n] = *(const f32x4*)(par + col0 + bj * HALF + 4 * n);
        EPI_ROWLOOP { bf16_t* rowp = OUT + (size_t)(row0 + ai * HALF + m * 16) * RW + col0;
#pragma unroll
            for (int bj = 0; bj < 2; ++bj) { f32x4 v0 = acc[ai][bj][m][0] + pv[bj][0], v1 = acc[ai][bj][m][1] + pv[bj][1];
#pragma unroll
                for (int j = 0; j < 4; ++j) { v0[j] = fsigmoid(v0[j]); v1[j] = fsigmoid(v1[j]); }
                *(u32x4*)(rowp + bj * HALF) = pack8(v0, v1); } }
        return false;
    }
};
struct EpiMerged {
    const bf16_t* PROJ; bf16_t* O;
    __device__ __forceinline__ bool operator()(f32x4 (&acc)[2][2][4][2], const Unit& u, int wr, int wc, int fr, int fq) const {
        const int row0 = u.pm * BM + wr * 64 + fr, col0 = u.pn * BM + wc * 32 + 8 * fq;
        EPI_ROWLOOP { const int row = row0 + ai * HALF + m * 16; const bf16_t* gp = PROJ + (size_t)row * PROJ_LD + col0;
#pragma unroll
            for (int bj = 0; bj < 2; ++bj) {
                if (u.aux == 0) {
                    const u32x4 ga = *(const u32x4*)(gp + PJ_GA + bj * HALF);
                    const f32x4 a0 = (f32x4){bflo(ga.x), bfhi(ga.x), bflo(ga.y), bfhi(ga.y)}, a1 = (f32x4){bflo(ga.z), bfhi(ga.z), bflo(ga.w), bfhi(ga.w)};
                    acc[ai][bj][m][0] = acc[ai][bj][m][0] * a0; acc[ai][bj][m][1] = acc[ai][bj][m][1] * a1;
                } else {
                    const u32x4 gb = *(const u32x4*)(gp + PJ_GB + bj * HALF);
                    const f32x4 b0 = (f32x4){bflo(gb.x), bfhi(gb.x), bflo(gb.y), bfhi(gb.y)}, b1 = (f32x4){bflo(gb.z), bfhi(gb.z), bflo(gb.w), bfhi(gb.w)};
                    { const f32x4 o0 = acc[ai][bj][m][0] * b0 * ACT8_SCALE, o1 = acc[ai][bj][m][1] * b1 * ACT8_SCALE;
                      int w0 = __builtin_amdgcn_cvt_pk_fp8_f32(o0[0], o0[1], 0, false); w0 = __builtin_amdgcn_cvt_pk_fp8_f32(o0[2], o0[3], w0, true);
                      int w1 = __builtin_amdgcn_cvt_pk_fp8_f32(o1[0], o1[1], 0, false); w1 = __builtin_amdgcn_cvt_pk_fp8_f32(o1[2], o1[3], w1, true);
                      *(v2u*)((unsigned char*)O + (size_t)row * D + col0 + bj * HALF) = (v2u){(unsigned)w0, (unsigned)w1}; }
                } } }
        return u.aux == 0;
    }
};
struct EpiZ {
    const float* X; float* Z;
    __device__ __forceinline__ bool operator()(f32x4 (&acc)[2][2][4][2], const Unit& u, int wr, int wc, int fr, int fq) const {
        const int row0 = u.pm * BM + wr * 64 + fr, col0 = u.pn * BM + wc * 32 + 8 * fq;
        EPI_ROWLOOP { const size_t off = (size_t)(row0 + ai * HALF + m * 16) * D + col0;
#pragma unroll
            for (int bj = 0; bj < 2; ++bj)
#pragma unroll
                for (int n = 0; n < 2; ++n) { const f32x4 xv = *(const f32x4*)(X + off + bj * HALF + 4 * n); *(f32x4*)(Z + off + bj * HALF + 4 * n) = xv * DN_ALPHA + acc[ai][bj][m][n]; } }
        return false;
    }
};
struct EpiSwiglu {
    unsigned char* ACT; const float* bgu;
    __device__ __forceinline__ bool operator()(f32x4 (&acc)[2][2][4][2], const Unit& u, int wr, int wc, int fr, int fq) const {
        const int row0 = u.pm * BM + wr * 64 + fr, col0 = u.pn * HALF + wc * 32 + 8 * fq;
        const float* bp = bgu + (size_t)u.aux * (2 * FF) + col0;
        f32x4 bg[2], bu[2];
#pragma unroll
        for (int n = 0; n < 2; ++n) { bg[n] = *(const f32x4*)(bp + 4 * n); bu[n] = *(const f32x4*)(bp + FF + 4 * n); }
        EPI_ROWLOOP { f32x4 o[2];
#pragma unroll
            for (int n = 0; n < 2; ++n) { const f32x4 g = acc[ai][0][m][n] + bg[n], uu = acc[ai][1][m][n] + bu[n];
#pragma unroll
                for (int j = 0; j < 4; j += 2) {
                    f32x2 gc, uc; gc[0] = fminf(g[j], 7.0f); gc[1] = fminf(g[j + 1], 7.0f);
                    uc[0] = __builtin_amdgcn_fmed3f(uu[j], -7.0f, 7.0f); uc[1] = __builtin_amdgcn_fmed3f(uu[j + 1], -7.0f, 7.0f);
                    const f32x2 t = gc * (f32x2){-2.4554669595930156f, -2.4554669595930156f};
                    f32x2 d; d[0] = __builtin_amdgcn_exp2f(t[0]); d[1] = __builtin_amdgcn_exp2f(t[1]);
                    d = d + (f32x2){1.0f, 1.0f};
                    f32x2 r; r[0] = __builtin_amdgcn_rcpf(d[0]); r[1] = __builtin_amdgcn_rcpf(d[1]);
                    const f32x2 s = gc * r, oo = __builtin_elementwise_fma(uc, s, s);
                    o[n][j] = oo[0]; o[n][j + 1] = oo[1]; } }
            int w0 = __builtin_amdgcn_cvt_pk_fp8_f32(o[0][0], o[0][1], 0, false); w0 = __builtin_amdgcn_cvt_pk_fp8_f32(o[0][2], o[0][3], w0, true);
            int w1 = __builtin_amdgcn_cvt_pk_fp8_f32(o[1][0], o[1][1], 0, false); w1 = __builtin_amdgcn_cvt_pk_fp8_f32(o[1][2], o[1][3], w1, true);
            *(v2u*)(ACT + (size_t)(row0 + ai * HALF + m * 16) * FF + col0) = (v2u){(unsigned)w0, (unsigned)w1}; }
        return false;
    }
};
struct EpiDown {
    unsigned char* YS; const float* bdn; const int* rowslot; const float* roww;
    __device__ __forceinline__ bool operator()(f32x4 (&acc)[2][2][4][2], const Unit& u, int wr, int wc, int fr, int fq) const {
        const int row0 = u.pm * BM + wr * 64 + fr, col0 = u.pn * BM + wc * 32 + 8 * fq;
        const float* bp = bdn + (size_t)u.aux * D + col0;
        f32x4 bv[2][2];
#pragma unroll
        for (int bj = 0; bj < 2; ++bj)
#pragma unroll
            for (int n = 0; n < 2; ++n) bv[bj][n] = *(const f32x4*)(bp + bj * HALF + 4 * n);
        int slots[8]; float ws_[8];
#pragma unroll
        for (int q = 0; q < 8; ++q) { const int row = row0 + (q >> 2) * HALF + (q & 3) * 16; slots[q] = rowslot[row]; ws_[q] = roww[row]; }
        EPI_ROWLOOP { const int slot = slots[ai * 4 + m]; const float w = ws_[ai * 4 + m] * YS_SCALE;
            if (slot >= 0) { unsigned char* rowp = YS + (size_t)slot * D + col0;
#pragma unroll
                for (int bj = 0; bj < 2; ++bj) { const f32x4 o0 = (acc[ai][bj][m][0] + bv[bj][0]) * w, o1 = (acc[ai][bj][m][1] + bv[bj][1]) * w;
                    int w0 = __builtin_amdgcn_cvt_pk_fp8_f32(o0[0], o0[1], 0, false); w0 = __builtin_amdgcn_cvt_pk_fp8_f32(o0[2], o0[3], w0, true);
                    int w1 = __builtin_amdgcn_cvt_pk_fp8_f32(o1[0], o1[1], 0, false); w1 = __builtin_amdgcn_cvt_pk_fp8_f32(o1[2], o1[3], w1, true);
                    *(v2u*)(rowp + bj * HALF) = (v2u){(unsigned)w0, (unsigned)w1}; } } }
        return false;
    }
};
#undef EPI_ROWLOOP
}

#define XB_TMO      128
#define XB_XCNT(j)  (256  + 64 * (j))
#define XB_XSUB(j)  (1280 + 64 * (j))
#define XB_XGEN(j)  (2304 + 64 * (j))
#define XB_TOP      3328
#define XB_TOPGEN   3392
#define XCD_BAR_WORDS 3456
#define XB_SPIN_CAP (1u << 18)

__device__ __forceinline__ unsigned xb_ld(unsigned* p)              { return __hip_atomic_load(p, __ATOMIC_RELAXED, __HIP_MEMORY_SCOPE_AGENT); }
__device__ __forceinline__ unsigned xb_add(unsigned* p, unsigned v) { return __hip_atomic_fetch_add(p, v, __ATOMIC_RELAXED, __HIP_MEMORY_SCOPE_AGENT); }
__device__ __forceinline__ unsigned xb_xcc_id() { return (unsigned)__builtin_amdgcn_s_getreg((3 << 11) | 20) & 0xFu; }
#define XB_SPIN(cond, bar) do { unsigned _sp = 0; while (cond) { __builtin_amdgcn_s_sleep(1); \
    if ((++_sp & 255u) == 0u) { if (xb_ld(&(bar)[XB_TMO])) break; if (_sp > XB_SPIN_CAP) { atomicAdd(&(bar)[XB_TMO], 1u); break; } } } } while (0)

struct XcdBarrier {
    unsigned* bar; unsigned x;
    volatile LAS unsigned* st;
};

__device__ __forceinline__ XcdBarrier xcd_barrier_post(unsigned* bar, volatile LAS unsigned* st) {
    XcdBarrier b; b.bar = bar; b.x = xb_xcc_id(); b.st = st;
    if (threadIdx.x == 0) (void)xb_add(&bar[XB_XCNT(b.x)], 1u);
    return b;
}
__device__ __forceinline__ void xcd_barrier_complete(unsigned* bar, unsigned x, unsigned& nloc, unsigned& nx) {
    const unsigned G = gridDim.x * gridDim.y * gridDim.z;
    unsigned sum, cnt, mine, sp = 0u;
    for (;;) {
        sum = 0u; cnt = 0u; mine = 0u;
#pragma unroll
        for (unsigned j = 0; j < 16; ++j) { const unsigned c = xb_ld(&bar[XB_XCNT(j)]); sum += c; cnt += (c > 0u) ? 1u : 0u; mine = (j == x) ? c : mine; }
        if (sum == G) break;
        __builtin_amdgcn_s_sleep(1);
        if ((++sp & 255u) == 0u) { if (xb_ld(&bar[XB_TMO])) break; if (sp > XB_SPIN_CAP) { atomicAdd(&bar[XB_TMO], 1u); break; } }
    }
    nloc = mine > 0u ? mine : 1u; nx = cnt > 0u ? cnt : 1u;
}

__device__ __forceinline__ void xcd_barrier(const XcdBarrier& b) {
    asm volatile("s_waitcnt vmcnt(0)" ::: "memory");
    __syncthreads();
    if (threadIdx.x == 0) {
        unsigned* bar = b.bar;
        __builtin_amdgcn_s_waitcnt(0);
        unsigned nloc = b.st[0], nx = b.st[1];
        if (nloc == 0u) { xcd_barrier_complete(bar, b.x, nloc, nx); b.st[0] = nloc; b.st[1] = nx; }
        const unsigned old = xb_add(&bar[XB_XSUB(b.x)], 1u);
        const unsigned gen = old / nloc;
        if (old + 1u == (gen + 1u) * nloc) {
            __builtin_amdgcn_fence(__ATOMIC_RELEASE, "agent");
            asm volatile("s_waitcnt vmcnt(0)" ::: "memory");
            const unsigned og = xb_add(&bar[XB_TOP], 1u);
            const unsigned tg = og / nx;
            if (og + 1u == (tg + 1u) * nx) xb_add(&bar[XB_TOPGEN], 1u);
            else XB_SPIN(xb_ld(&bar[XB_TOPGEN]) == tg, bar);
            __builtin_amdgcn_fence(__ATOMIC_ACQUIRE, "agent");
            xb_add(&bar[XB_XGEN(b.x)], 1u);
            asm volatile("s_waitcnt vmcnt(0)" ::: "memory");
        } else {
            XB_SPIN(xb_ld(&bar[XB_XGEN(b.x)]) == gen, bar);
            __builtin_amdgcn_fence(__ATOMIC_ACQUIRE, "agent");
            asm volatile("s_waitcnt vmcnt(0)" ::: "memory");
        }
    }
    __syncthreads();
}
struct Frame {
    LAS unsigned char* lds;
    volatile LAS unsigned* MISC;
    gu32* ctl;
    int tid, lane, wave;
    int vcu, G;
    unsigned char* ws;
    __amdgpu_buffer_rsrc_t rsrc;
};

#define PHASE_FRAME(F0) Frame F = (F0); { int t_ = threadIdx.x; asm volatile("" : "+v"(t_)); F.tid = t_; F.lane = t_ & 63; F.wave = __builtin_amdgcn_readfirstlane(t_ >> 6); }

__device__ __forceinline__ void tr_item(const float* W, size_t ldw, int k0, int c0, bf16* WT, size_t ldt, int drow0, LAS float* scr, int lane) {
    const int kr = lane >> 4, cq = lane & 15;
    f32x4 v[16];
#pragma unroll
    for (int i = 0; i < 16; ++i) v[i] = *(const GAS f32x4*)(W + (size_t)(k0 + 4 * i + kr) * ldw + c0 + 4 * cq);
#pragma unroll
    for (int i = 0; i < 16; ++i)
#pragma unroll
        for (int j = 0; j < 4; ++j) scr[(4 * cq + j) * 65 + 4 * i + kr] = v[i][j];
    LDS_WAIT(); asm volatile("" ::: "memory");
    const int c = lane & 7;
#pragma unroll
    for (int jj = 0; jj < 8; ++jj) { const int n = (lane >> 3) + 8 * jj; const LAS float* s = scr + n * 65 + 8 * c;
        v4u o; o.x = pk2(s[0], s[1]); o.y = pk2(s[2], s[3]); o.z = pk2(s[4], s[5]); o.w = pk2(s[6], s[7]);
        *(GAS v4u*)(WT + (size_t)(drow0 + n) * ldt + k0 + 8 * c) = o; }
    LDS_WAIT(); asm volatile("" ::: "memory");
}

typedef short s16x2 __attribute__((ext_vector_type(2)));
struct MoeItem { __amdgpu_buffer_rsrc_t rs; unsigned soff, rstep; int ldw, k0; unsigned char* WT; size_t ldt; int drow; };
__device__ __forceinline__ void tr8_load(const MoeItem& m, f32x4 (&v)[16], int lane) {
    const int kr = lane >> 4, cq = lane & 15;
    const int voff = (kr * m.ldw + 4 * cq) * 4;
#pragma unroll
    for (int i = 0; i < 16; ++i) v[i] = __builtin_bit_cast(f32x4, __builtin_amdgcn_raw_buffer_load_b128(m.rs, voff, (int)(m.soff + (unsigned)i * m.rstep), 0));
}
__device__ __forceinline__ void tr8_finish(const f32x4 (&v)[16], const MoeItem& m, LAS float* scr_, int lane) {
    LAS unsigned char* scr = (LAS unsigned char*)scr_;
    const int kr = lane >> 4, cq = lane & 15;
#pragma unroll
    for (int j = 0; j < 4; ++j) { unsigned w[4];
#pragma unroll
        for (int q = 0; q < 4; ++q) { s16x2 t = {0, 0};
            t = __builtin_amdgcn_cvt_scalef32_pk_fp8_f32(t, v[4 * q][j], v[4 * q + 1][j], F8_CVT_SCALE, false);
            t = __builtin_amdgcn_cvt_scalef32_pk_fp8_f32(t, v[4 * q + 2][j], v[4 * q + 3][j], F8_CVT_SCALE, true);
            w[q] = __builtin_bit_cast(unsigned, t); }
        *(LAS v4u*)(scr + (4 * cq + j) * 80 + kr * 16) = (v4u){w[0], w[1], w[2], w[3]}; }
    LDS_WAIT(); asm volatile("" ::: "memory");
    const int qd = lane & 3;
#pragma unroll
    for (int ps = 0; ps < 4; ++ps) { const int n = (lane >> 2) + 16 * ps; const LAS unsigned char* s = scr + n * 80 + qd * 4;
        const unsigned d0 = *(const LAS unsigned*)(s), d1 = *(const LAS unsigned*)(s + 16), d2 = *(const LAS unsigned*)(s + 32), d3 = *(const LAS unsigned*)(s + 48);
        const unsigned t0 = __builtin_amdgcn_perm(d1, d0, 0x05010400u), t1 = __builtin_amdgcn_perm(d1, d0, 0x07030602u), t2 = __builtin_amdgcn_perm(d3, d2, 0x05010400u), t3 = __builtin_amdgcn_perm(d3, d2, 0x07030602u);
        const v4u o = (v4u){__builtin_amdgcn_perm(t2, t0, 0x05040100u), __builtin_amdgcn_perm(t2, t0, 0x07060302u), __builtin_amdgcn_perm(t3, t1, 0x05040100u), __builtin_amdgcn_perm(t3, t1, 0x07060302u)};
        *(GAS v4u*)(m.WT + (size_t)(m.drow + n) * m.ldt + m.k0 + 16 * qd) = o; }
    LDS_WAIT(); asm volatile("" ::: "memory");
}
constexpr int MOE_J4 = 32 * 32 * 64, MOE_J5 = 32 * 32 * 32, MOE_NITEMS = MOE_J4 + MOE_J5;
__device__ __forceinline__ MoeItem moe_item(int r, const float* w_gu, const float* w_down, unsigned char* ws) {
    MoeItem m;
    if (r < MOE_J4) { const int e = r / 2048, q = r % 2048, kb = q / 64, cb = q % 64, c0 = cb * 64; const int cc = c0 & 2047;
        m.rs = __builtin_amdgcn_make_buffer_rsrc((void*)w_gu, 0, 0xffffffff, 0x00020000); m.ldw = 2 * FF; m.k0 = kb * 64;
        m.soff = (unsigned)(((size_t)e * D * 2 * FF + (size_t)kb * 64 * (2 * FF) + c0) * 4); m.rstep = 4u * (2 * FF) * 4u;
        m.WT = ws + WS_WGUT + (size_t)e * 2 * FF * D; m.ldt = D; m.drow = (cc >> 7) * 256 + (c0 >= 2048 ? 128 : 0) + (cc & 127); }
    else { r -= MOE_J4; const int e = r / 1024, q = r % 1024, kb = q / 32, cb = q % 32;
        m.rs = __builtin_amdgcn_make_buffer_rsrc((void*)w_down, 0, 0xffffffff, 0x00020000); m.ldw = D; m.k0 = kb * 64;
        m.soff = (unsigned)(((size_t)e * FF * D + (size_t)kb * 64 * D + cb * 64) * 4); m.rstep = 4u * D * 4u;
        m.WT = ws + WS_WDNT + (size_t)e * D * FF; m.ldt = FF; m.drow = cb * 64; }
    return m;
}
__device__ __forceinline__ MoeItem f8_item(const float* W, int ldw, int k0, int c0, unsigned char* WT, size_t ldt, int drow) {
    MoeItem m; m.rs = __builtin_amdgcn_make_buffer_rsrc((void*)W, 0, 0xffffffff, 0x00020000); m.ldw = ldw; m.k0 = k0;
    m.soff = (unsigned)(((size_t)k0 * ldw + c0) * 4); m.rstep = 4u * (unsigned)ldw * 4u; m.WT = WT; m.ldt = ldt; m.drow = drow; return m;
}

struct In {
    const float *x, *w_in, *rel_bias, *shift_mu, *w0, *w_up, *a0, *a_up, *g_up, *k_k, *k_a, *r_k, *lnx_w, *lnx_b, *proj_a, *proj_b, *w_out,
                *ln1_w, *ln1_b, *w_router, *b_router, *w_gu, *b_gu, *w_down, *b_down, *ln2_w, *ln2_b;
};

__device__ __forceinline__ void p0_prologue(Frame& F0, const In& I) {
    PHASE_FRAME(F0);
    LAS float* scr = (LAS float*)(F.lds + F.wave * 16640);
    const int gw = F.vcu * NWAVES + F.wave, NGW = F.G * NWAVES;
    unsigned char* ws = F.ws;
    constexpr int J0 = 32 * 167, J1 = 16 * 32, J2 = 16 * 32, J3 = 32 * 32;
    constexpr int NITEMS = J0 + J1 + J2 + J3;
    for (int it = gw; it < NITEMS; it += NGW) {
        int r = it;
        if (r < J0) { const int kb = r / 167, cb = r % 167, c0 = cb * 64; bf16* dst; int drow;
            if (c0 < 3072) { f32x4 tv[16];
                   const MoeItem m = (c0 < 2048) ? f8_item(I.w_in, D_IN, kb * 64, c0, (unsigned char*)(ws + WS_WQK8), D, c0) : f8_item(I.w_in, D_IN, kb * 64, c0, (unsigned char*)(ws + WS_WV8), D, c0 - 2048);
                   tr8_load(m, tv, F.lane); tr8_finish(tv, m, scr, F.lane); continue; }
            else if (c0 < 3072 + 2048) { dst = (bf16*)(ws + WS_WINT); drow = PJ_SEG + (c0 - 3072); }
            else if (c0 < 6592) { f32x4 tv[16]; const MoeItem m = f8_item(I.w_in, D_IN, kb * 64, c0, (unsigned char*)(ws + WS_WSV8), D, c0 - (3072 + 2048));
                   tr8_load(m, tv, F.lane); tr8_finish(tv, m, scr, F.lane); continue; }
            else { f32x4 tv[16]; const int cg = c0 - 6592, d0 = cg & 2047; const MoeItem m = f8_item(I.w_in, D_IN, kb * 64, c0, (unsigned char*)(ws + WS_WG8), D, (d0 >> 7) * 256 + (cg >= 2048 ? 128 : 0) + (d0 & 127));
                   tr8_load(m, tv, F.lane); tr8_finish(tv, m, scr, F.lane); continue; }
            tr_item(I.w_in, D_IN, kb * 64, c0, dst, D, drow, scr, F.lane); continue; } r -= J0;
        if (r < J1) { const int kb = r / 32, cb = r % 32; f32x4 tv[16]; const MoeItem m = f8_item(I.proj_a, D, kb * 64, cb * 64, (unsigned char*)(ws + WS_PAT), AW, cb * 64); tr8_load(m, tv, F.lane); tr8_finish(tv, m, scr, F.lane); continue; } r -= J1;
        if (r < J2) { const int kb = r / 32, cb = r % 32; f32x4 tv[16]; const MoeItem m = f8_item(I.proj_b, D, kb * 64, cb * 64, (unsigned char*)(ws + WS_PBT), RW, cb * 64); tr8_load(m, tv, F.lane); tr8_finish(tv, m, scr, F.lane); continue; } r -= J2;
        { const int kb = r / 32, cb = r % 32; f32x4 tv[16]; const MoeItem m = f8_item(I.w_out, D, kb * 64, cb * 64, (unsigned char*)(ws + WS_WOT), D, cb * 64);
          tr8_load(m, tv, F.lane); tr8_finish(tv, m, scr, F.lane); }
    }
    const int gt = F.vcu * (NWAVES * 64) + F.tid, NGT = F.G * NWAVES * 64;
    for (int i = gt; i < 2048 * 256; i += NGT) { const int n = i >> 8, k = i & 255; float v = 0.f;
        if (n < 1024) { if (k < DLORA) v = I.w_up[(size_t)k * RW + n]; }
        else { if (k >= 128 && k < 128 + ALORA) v = I.a_up[(size_t)(k - 128) * RW + (n - 1024)]; }
        ((bf16*)(ws + WS_WLA))[i] = (bf16)f2bf(v); }
    for (int i = gt; i < 1024 * 256; i += NGT) { const int n = i >> 8, k = i & 255; ((bf16*)(ws + WS_WLG))[i] = (bf16)f2bf(I.g_up[(size_t)k * RW + n]); }
    for (int i = gt; i < 64 * D / 16; i += NGT) ((GAS v4u*)((unsigned char*)(ws + WS_WSV8) + (size_t)(SHIFT_W - 2048) * D))[i] = (v4u){0u, 0u, 0u, 0u};
    for (int i = gt; i < RROWS; i += NGT) ((int*)(ws + WS_ROWSLOT))[i] = -1;
    for (size_t i = gt; i < (size_t)T * D / 8; i += NGT) { const f32x4 a = ((const GAS f32x4*)I.x)[2 * i], b = ((const GAS f32x4*)I.x)[2 * i + 1];
        v4u o; o.x = pk2(a.x, a.y); o.y = pk2(a.z, a.w); o.z = pk2(b.x, b.y); o.w = pk2(b.z, b.w); ((GAS v4u*)(ws + WS_XB16))[i] = o;
        int w0 = __builtin_amdgcn_cvt_pk_fp8_f32(a.x, a.y, 0, false); w0 = __builtin_amdgcn_cvt_pk_fp8_f32(a.z, a.w, w0, true);
        int w1 = __builtin_amdgcn_cvt_pk_fp8_f32(b.x, b.y, 0, false); w1 = __builtin_amdgcn_cvt_pk_fp8_f32(b.z, b.w, w1, true);
        ((GAS v2u*)(ws + WS_XB8))[i] = (v2u){(unsigned)w0, (unsigned)w1}; }
}

constexpr int P8_HS = 0, P8_PITCH = 2052, P8_PART = 131328, P8_LOG = 147712, P8_HIST = 149760;
template <bool SKIP_MIX>
__device__ __forceinline__ void p8_ln_router(Frame& F0, const In& I) {
    PHASE_FRAME(F0);
    LAS float* hs = (LAS float*)(F.lds + P8_HS); LAS float* part = (LAS float*)(F.lds + P8_PART); LAS float* lg = (LAS float*)(F.lds + P8_LOG); LAS int* hist = (LAS int*)(F.lds + P8_HIST);
    const int lane = F.lane, w = F.wave;
    if (F.tid < 32) hist[F.tid] = 0;
    const int kq = lane >> 4, col = lane & 15;
    float ln_w[32], ln_b[32];
#pragma unroll
    for (int j = 0; j < 8; ++j) { const f32x4 a = *(const GAS f32x4*)(I.ln1_w + 4 * lane + 256 * j), b = *(const GAS f32x4*)(I.ln1_b + 4 * lane + 256 * j);
#pragma unroll
        for (int e = 0; e < 4; ++e) { ln_w[4 * j + e] = a[e]; ln_b[4 * j + e] = b[e]; } }
    __syncthreads();
    const float* zsrc = I.x; const bf16* mixb = (const bf16*)(F.ws + WS_Z);
    for (int g = F.vcu; g < T / 16; g += F.G) {
        const int tok0 = g * 16;
        { f32x4 va[8], vb[8];
          const size_t tokA = (size_t)(tok0 + 2 * w), tokB = tokA + 1;
          const GAS f32x4* zra = (const GAS f32x4*)(zsrc + tokA * D) + lane; const GAS f32x4* zrb = (const GAS f32x4*)(zsrc + tokB * D) + lane;
          const GAS v2u* mra = (const GAS v2u*)(mixb + tokA * D) + lane; const GAS v2u* mrb = (const GAS v2u*)(mixb + tokB * D) + lane;
          v2u ma[8], mb[8];
#pragma unroll
          for (int j = 0; j < 8; ++j) { va[j] = zra[64 * j]; vb[j] = zrb[64 * j]; if (!SKIP_MIX) { ma[j] = mra[64 * j]; mb[j] = mrb[64 * j]; } }
#pragma unroll
          for (int j = 0; j < 8; ++j) { va[j] = va[j] * DN_ALPHA; vb[j] = vb[j] * DN_ALPHA;
              if (!SKIP_MIX) { va[j] += (f32x4){bflo(ma[j].x), bfhi(ma[j].x), bflo(ma[j].y), bfhi(ma[j].y)}; vb[j] += (f32x4){bflo(mb[j].x), bfhi(mb[j].x), bflo(mb[j].y), bfhi(mb[j].y)}; } }
#pragma unroll
          for (int tt = 0; tt < 2; ++tt) {
            const int tl = 2 * w + tt; const size_t tok = (size_t)(tok0 + tl);
            f32x4 v[8]; float s = 0.f;
#pragma unroll
            for (int j = 0; j < 8; ++j) { v[j] = tt ? vb[j] : va[j]; s += (v[j].x + v[j].y) + (v[j].z + v[j].w); }
            const float mean = wave_sum(s) * (1.f / D); float s2 = 0.f;
#pragma unroll
            for (int j = 0; j < 8; ++j) { v[j] = v[j] - mean; s2 += (v[j].x * v[j].x + v[j].y * v[j].y) + (v[j].z * v[j].z + v[j].w * v[j].w); }
            const float rstd = 1.f / sqrtf(wave_sum(s2) * (1.f / D) + LN_EPS);
            GAS v2u* h1 = (GAS v2u*)((bf16*)(F.ws + WS_H1) + tok * D) + lane;
            GAS unsigned* h1b = (GAS unsigned*)((unsigned char*)(F.ws + WS_H1B) + tok * D) + lane;
#pragma unroll
            for (int j = 0; j < 8; ++j) { f32x4 h;
#pragma unroll
                for (int e = 0; e < 4; ++e) h[e] = v[j][e] * rstd * ln_w[4 * j + e] + ln_b[4 * j + e];
                h1[64 * j] = (v2u){pg8::cvt_pk_bf16(h.x, h.y), pg8::cvt_pk_bf16(h.z, h.w)}; { int w8 = __builtin_amdgcn_cvt_pk_fp8_f32(h.x, h.y, 0, false); w8 = __builtin_amdgcn_cvt_pk_fp8_f32(h.z, h.w, w8, true); h1b[64 * j] = (unsigned)w8; }
                *(LAS f32x4*)(hs + tl * P8_PITCH + 4 * lane + 256 * j) = h; }
          } }
        __syncthreads();
        f32x4 c0 = (f32x4){0.f, 0.f, 0.f, 0.f}, c1 = c0;
        const LAS float* ap = hs + col * P8_PITCH + 256 * w + 4 * kq;
        const float* bp = I.w_router + (size_t)(256 * w + 4 * kq) * NE + col;
#pragma unroll 4
        for (int kk = 0; kk < 16; ++kk) {
            const f32x4 a = *(const LAS f32x4*)(ap + 16 * kk);
#pragma unroll
            for (int e = 0; e < 4; ++e) {
                const float b0 = bp[(size_t)(16 * kk + e) * NE], b1 = bp[(size_t)(16 * kk + e) * NE + 16];
                c0 = __builtin_amdgcn_mfma_f32_16x16x4f32(a[e], b0, c0, 0, 0, 0);
                c1 = __builtin_amdgcn_mfma_f32_16x16x4f32(a[e], b1, c1, 0, 0, 0);
            }
        }
#pragma unroll
        for (int i = 0; i < 4; ++i) { part[(w * 16 + 4 * kq + i) * 32 + col] = c0[i]; part[(w * 16 + 4 * kq + i) * 32 + 16 + col] = c1[i]; }
        __syncthreads();
        { const int tl = F.tid >> 5, e = F.tid & 31; float s = I.b_router[e];
#pragma unroll
            for (int ww = 0; ww < 8; ++ww) s += part[(ww * 16 + tl) * 32 + e];
            lg[tl * 32 + e] = s; }
        __syncthreads();
        if (F.tid < 16) {
            const int tl = F.tid; float lv[32];
#pragma unroll
            for (int e = 0; e < 32; ++e) lv[e] = lg[tl * 32 + e];
            int ti[4]; float tv[4];
#pragma unroll
            for (int k = 0; k < 4; ++k) { float best = -3.4e38f; int bi = 0;
#pragma unroll
                for (int e = 0; e < 32; ++e) { const bool tk = lv[e] > best; best = tk ? lv[e] : best; bi = tk ? e : bi; }
                ti[k] = bi; tv[k] = best;
#pragma unroll
                for (int e = 0; e < 32; ++e) lv[e] = (e == bi) ? -3.4e38f : lv[e]; }
            float ex[4], sum = 0.f;
#pragma unroll
            for (int k = 0; k < 4; ++k) { ex[k] = __expf(tv[k] - tv[0]); sum += ex[k]; }
            const float inv = 1.f / sum;
            *(GAS v4u*)((int*)(F.ws + WS_TOPI) + (size_t)(tok0 + tl) * 4) = (v4u){(unsigned)ti[0], (unsigned)ti[1], (unsigned)ti[2], (unsigned)ti[3]};
            *(GAS f32x4*)((float*)(F.ws + WS_GATE) + (size_t)(tok0 + tl) * 4) = (f32x4){ex[0] * inv, ex[1] * inv, ex[2] * inv, ex[3] * inv};
#pragma unroll
            for (int k = 0; k < 4; ++k) __hip_atomic_fetch_add(&hist[ti[k]], 1, __ATOMIC_RELAXED, __HIP_MEMORY_SCOPE_WORKGROUP);
        }
        __syncthreads();
    }
    if (F.tid < 32) { const int c = hist[F.tid]; if (c) __hip_atomic_fetch_add(F.ctl + CW_CNT + F.tid, (unsigned)c, RLX_AGENT); }
}

template <bool SKIP_MOE>
__device__ __forceinline__ void p12_final(Frame& F0, const In& I, float* out) {
    PHASE_FRAME(F0);
    const int lane = F.lane; const int gw = F.vcu * NWAVES + F.wave, NGW = F.G * NWAVES;
    float ln_w[32], ln_b[32];
#pragma unroll
    for (int j = 0; j < 8; ++j) { const f32x4 a = *(const GAS f32x4*)(I.ln2_w + 4 * lane + 256 * j), b = *(const GAS f32x4*)(I.ln2_b + 4 * lane + 256 * j);
#pragma unroll
        for (int e = 0; e < 4; ++e) { ln_w[4 * j + e] = a[e]; ln_b[4 * j + e] = b[e]; } }
    for (int tok = gw; tok < T; tok += NGW) {
        const GAS v2u* hr = (const GAS v2u*)((const bf16*)(F.ws + WS_H1) + (size_t)tok * D) + lane;
        f32x4 v[8]; float s = 0.f;
#pragma unroll
        for (int j = 0; j < 8; ++j) { const v2u hh = hr[64 * j]; v[j] = (f32x4){bflo(hh.x), bfhi(hh.x), bflo(hh.y), bfhi(hh.y)} * DN_ALPHA; }
        if (!SKIP_MOE) {
#pragma unroll
            for (int k = 0; k < 4; ++k) { const GAS unsigned* yr = (const GAS unsigned*)((const unsigned char*)(F.ws + WS_YSLOT) + ((size_t)tok * 4 + k) * D) + lane;
#pragma unroll
                for (int j = 0; j < 8; ++j) { const unsigned y = yr[64 * j]; const f32x2 lo = __builtin_amdgcn_cvt_pk_f32_fp8((int)y, false), hi = __builtin_amdgcn_cvt_pk_f32_fp8((int)y, true);
                    v[j].x += lo.x * YS_INV; v[j].y += lo.y * YS_INV; v[j].z += hi.x * YS_INV; v[j].w += hi.y * YS_INV; } }
        }
#pragma unroll
        for (int j = 0; j < 8; ++j) s += (v[j].x + v[j].y) + (v[j].z + v[j].w);
        const float mean = wave_sum(s) * (1.f / D); float s2 = 0.f;
#pragma unroll
        for (int j = 0; j < 8; ++j) { v[j] = v[j] - mean; s2 += (v[j].x * v[j].x + v[j].y * v[j].y) + (v[j].z * v[j].z + v[j].w * v[j].w); }
        const float rstd = 1.f / sqrtf(wave_sum(s2) * (1.f / D) + LN_EPS);
        GAS f32x4* o = (GAS f32x4*)(out + (size_t)tok * D) + lane;
#pragma unroll
        for (int j = 0; j < 8; ++j) { f32x4 h;
#pragma unroll
            for (int e = 0; e < 4; ++e) h[e] = v[j][e] * rstd * ln_w[4 * j + e] + ln_b[4 * j + e];
            o[64 * j] = h; }
    }
}
__device__ __forceinline__ void moe_tables(Frame& F) {
    LAS int* tab = (LAS int*)(F.lds + TAB_OFF);
    if (F.tid == 0) { int run = 0;
        for (int e = 0; e < NE; ++e) { const int c = (int)__hip_atomic_load(F.ctl + CW_CNT + e, RLX_AGENT); const int p = (c + 255) / 256 * 256; tab[32 + e] = run; run += p; tab[e] = run; }
        tab[64] = run / 256; }
    __syncthreads();
}

__device__ __forceinline__ void p9_scatter(Frame& F0, const In& I) {
    PHASE_FRAME(F0);
    moe_tables(F);
    LAS int* tab = (LAS int*)(F.lds + TAB_OFF);
    LAS int* lh = (LAS int*)(F.lds + 0);
    LAS int* lb = (LAS int*)(F.lds + 128);
    LAS int* dst = (LAS int*)(F.lds + 256);
    const int* topi = (const int*)(F.ws + WS_TOPI); const float* gate = (const float*)(F.ws + WS_GATE);
    for (int ch = F.vcu; ch < T / 128; ch += F.G) {
        if (F.tid < 32) lh[F.tid] = 0;
        __syncthreads();
        const int s = ch * 512 + F.tid; const int e = topi[s]; const float gv = gate[s];
        const int rank = __hip_atomic_fetch_add(&lh[e], 1, __ATOMIC_RELAXED, __HIP_MEMORY_SCOPE_WORKGROUP);
        __syncthreads();
        if (F.tid < 32) { const int c = lh[F.tid]; lb[F.tid] = c ? (int)__hip_atomic_fetch_add(F.ctl + CW_CUR + F.tid, (unsigned)c, RLX_AGENT) : 0; }
        __syncthreads();
        const int d = tab[32 + e] + lb[e] + rank;
        ((int*)(F.ws + WS_ROWSLOT))[d] = s; ((float*)(F.ws + WS_ROWW))[d] = gv; dst[F.tid] = d;
        __syncthreads();
#pragma unroll 1
        for (int i0 = F.wave * 64; i0 < F.wave * 64 + 64; i0 += 8) {
            v4u v[8][2]; int dd[8];
#pragma unroll
            for (int q = 0; q < 8; ++q) { const int i = i0 + q; const int tok = ch * 128 + (i >> 2); dd[q] = dst[i];
                const GAS v4u* src = (const GAS v4u*)((const unsigned char*)(F.ws + WS_H1B) + (size_t)tok * D) + F.lane;
                v[q][0] = src[0]; v[q][1] = src[64]; }
#pragma unroll
            for (int q = 0; q < 8; ++q) { GAS v4u* o = (GAS v4u*)((unsigned char*)(F.ws + WS_XG) + (size_t)dd[q] * D) + F.lane; o[0] = v[q][0]; o[64] = v[q][1]; }
        }
        __syncthreads();
    }
}

__device__ __forceinline__ void p10_moe_up(Frame& F0, const In& I) {
    PHASE_FRAME(F0);
    moe_tables(F);
    LAS int* tab = (LAS int*)(F.lds + TAB_OFF);
    pg8::SchedMoe S; S.t.init(tab[64], 16, F.G, (int)blockIdx.x);
    S.A = (unsigned)(WS_XG); S.B = (unsigned)(WS_WGUT); S.tsA = (unsigned)256 * D; S.tsB = (unsigned)256 * D; S.es = (unsigned)2 * FF * D; S.pad_end = tab;
    pg8::EpiSwiglu E{(unsigned char*)(F.ws + WS_ACT), I.b_gu};
    pg8::gemm_phase<pg8::EpiSwiglu, pg8::SchedMoe, true, true>(F.lds + RING_OFF, F.rsrc, D / 2, D / 2, D / 2, S, E);
}
__device__ __forceinline__ void p11_moe_down(Frame& F0, const In& I) {
    PHASE_FRAME(F0);
    moe_tables(F);
    LAS int* tab = (LAS int*)(F.lds + TAB_OFF);
    pg8::SchedMoe S; S.t.init(tab[64], 8, F.G, (int)blockIdx.x);
    S.A = (unsigned)(WS_ACT); S.B = (unsigned)(WS_WDNT); S.tsA = (unsigned)256 * FF; S.tsB = (unsigned)256 * FF; S.es = (unsigned)D * FF; S.pad_end = tab;
    pg8::EpiDown E{(unsigned char*)(F.ws + WS_YSLOT), I.b_down, (const int*)(F.ws + WS_ROWSLOT), (const float*)(F.ws + WS_ROWW)};
    pg8::gemm_phase<pg8::EpiDown, pg8::SchedMoe, true, true>(F.lds + RING_OFF, F.rsrc, FF / 2, FF / 2, FF / 2, S, E);
}

__device__ __forceinline__ void p1_proj(Frame& F0, const In& I) {
    PHASE_FRAME(F0);
    { pg8::SchedPlain S; S.t.init(T / 256, 2048 / 256, F.G, (int)blockIdx.x);
      S.A = (unsigned)(WS_XB16); S.B = (unsigned)(WS_WINT + (size_t)PJ_SEG * D * 2); S.tsA = (unsigned)256 * D * 2; S.tsB = (unsigned)256 * D * 2;
      pg8::EpiProj E{(bf16*)(F.ws + WS_PROJ), PJ_SEG, 0};
      pg8::gemm_phase<pg8::EpiProj, pg8::SchedPlain, true>(F.lds + RING_OFF, F.rsrc, D, D, D, S, E); }
    { pg8::SchedPlain S; S.t.init(T / 256, (SEG_PAD - 2048) / 256, F.G, (int)blockIdx.x);
      S.A = (unsigned)(WS_XB8); S.B = (unsigned)(WS_WSV8); S.tsA = (unsigned)256 * D; S.tsB = (unsigned)256 * D;
      pg8::EpiProj E{(bf16*)(F.ws + WS_PROJ), PJ_SEG + 2048, 0};
      pg8::gemm_phase<pg8::EpiProj, pg8::SchedPlain, true, true>(F.lds + RING_OFF, F.rsrc, D / 2, D / 2, D / 2, S, E); }
    { pg8::SchedPlain S; S.t.init(T / 256, (2 * AW) / 256, F.G, (int)blockIdx.x);
      S.A = (unsigned)(WS_XB8); S.B = (unsigned)(WS_WQK8); S.tsA = (unsigned)256 * D; S.tsB = (unsigned)256 * D;
      pg8::EpiProj E{(bf16*)(F.ws + WS_PROJ), 0, 4};
      pg8::gemm_phase<pg8::EpiProj, pg8::SchedPlain, true, true>(F.lds + RING_OFF, F.rsrc, D / 2, D / 2, D / 2, S, E); }
    { pg8::SchedPlain S; S.t.init(T / 256, (2 * D) / 256, F.G, (int)blockIdx.x);
      S.A = (unsigned)(WS_XB8); S.B = (unsigned)(WS_WG8); S.tsA = (unsigned)256 * D; S.tsB = (unsigned)256 * D;
      pg8::EpiGate E{(bf16*)(F.ws + WS_PROJ)};
      pg8::gemm_phase<pg8::EpiGate, pg8::SchedPlain, true, true>(F.lds + RING_OFF, F.rsrc, D / 2, D / 2, D / 2, S, E); }
    { pg8::SchedPlain S; S.t.init(AW / 256, T / 256, F.G, (int)blockIdx.x);
      S.A = (unsigned)(WS_WV8); S.B = (unsigned)(WS_XB8); S.tsA = (unsigned)256 * D; S.tsB = (unsigned)256 * D;
      pg8::EpiBf16 E{(bf16*)(F.ws + WS_VT), T};
      pg8::gemm_phase<pg8::EpiBf16, pg8::SchedPlain, true, true>(F.lds + RING_OFF, F.rsrc, D / 2, D / 2, D / 2, S, E); }
}

__device__ __forceinline__ float ftanh(float x) { return 2.0f * fsigmoid(2.0f * x) - 1.0f; }
__device__ __forceinline__ void p2_shift_attn(Frame& F0, const In& I) {
    PHASE_FRAME(F0);
    const int lane = F.lane; const int gw = F.vcu * NWAVES + F.wave, NGW = F.G * NWAVES;
    const bf16* PROJ = (const bf16*)(F.ws + WS_PROJ);
    for (int tok = gw; tok < T; tok += NGW) {
        const bool first = (tok % SEQ) == 0;
        const bf16* cur = PROJ + (size_t)tok * PROJ_LD + PJ_SEG; const bf16* prv = cur - PROJ_LD;
        bf16* rkv = (bf16*)(F.ws + WS_RKV) + (size_t)tok * (3 * RW); bf16* lin = (bf16*)(F.ws + WS_LORAIN) + (size_t)tok * LORA_LD;
#pragma unroll 1
        for (int it = 0; it < 7; ++it) { const int gi = it * 64 + lane; if (gi >= SHIFT_W / 8) break; const int c = gi * 8;
            const v4u cv = *(const GAS v4u*)(cur + c); v4u pv = (v4u){0u, 0u, 0u, 0u}; if (!first) pv = *(const GAS v4u*)(prv + c);
            const f32x4 m0 = *(const GAS f32x4*)(I.shift_mu + c), m1 = *(const GAS f32x4*)(I.shift_mu + c + 4);
            float v[8]; const unsigned cw[4] = {cv.x, cv.y, cv.z, cv.w}, pw[4] = {pv.x, pv.y, pv.z, pv.w};
#pragma unroll
            for (int j = 0; j < 4; ++j) { const float c0 = bflo(cw[j]), c1 = bfhi(cw[j]), p0 = bflo(pw[j]), p1 = bfhi(pw[j]); const float mu0 = (j < 2) ? m0[2 * j] : m1[2 * j - 4], mu1 = (j < 2) ? m0[2 * j + 1] : m1[2 * j - 3];
                v[2 * j] = c0 + (p0 - c0) * mu0; v[2 * j + 1] = c1 + (p1 - c1) * mu1; }
            bf16* dstp;
            if (c < 3 * RW) dstp = rkv + c;
            else if (c < 3 * RW + DLORA) { dstp = lin + (c - 3 * RW);
#pragma unroll
                for (int j = 0; j < 8; ++j) v[j] = ftanh(v[j]); }
            else if (c < 3 * RW + DLORA + ALORA) dstp = lin + 128 + (c - 3 * RW - DLORA);
            else { dstp = lin + 256 + (c - 3 * RW - DLORA - ALORA);
#pragma unroll
                for (int j = 0; j < 8; ++j) v[j] = fsigmoid(v[j]); }
            *(GAS v4u*)dstp = (v4u){pk2(v[0], v[1]), pk2(v[2], v[3]), pk2(v[4], v[5]), pk2(v[6], v[7])};
        }
        if (lane < 8) { const int c = (lane < 4) ? (DLORA + 8 * lane) : (128 + ALORA + 8 * (lane - 4)); *(GAS v4u*)(lin + c) = (v4u){0u, 0u, 0u, 0u}; }
    }
#if STAGE == 3
    { const int gt = F.vcu * (NWAVES * 64) + F.tid, NGT = F.G * NWAVES * 64;
      for (size_t i = gt; i < (size_t)T * RW / 8; i += NGT) ((GAS v4u*)(F.ws + WS_YB))[i] = (v4u){0u, 0u, 0u, 0u}; }
#endif
    LAS float* tbl = (LAS float*)(F.lds + 0);
    constexpr int AKV = 64 * 144, A_KOFF = 2048, A_VOFF = A_KOFF + 2 * AKV;
    const bf16* VT = (const bf16*)(F.ws + WS_VT); bf16* YA = (bf16*)(F.ws + WS_YA);
    const int r = lane & 31, hh = lane >> 5;
    const int rp = (r & 16) + 8 * ((r >> 2) & 1) + 4 * ((r >> 3) & 1) + (r & 3);
    const int srow = F.tid >> 3, spc = F.tid & 7;
    for (int task = F.vcu; task < BATCH * AH * (SEQ / 256); task += F.G) {
        const int bh = task >> 5, q256 = task & 31, b = bh >> 4, h = bh & 15, c0 = q256 * 4;
        const int q0 = q256 * 256 + F.wave * 32, cw = c0 + (F.wave >> 1);
        const int kc_lo = (c0 > LEFT) ? c0 - LEFT : 0, kc_hi = c0 + 3;
        __syncthreads();
        if (F.tid < REL_TABLE) tbl[F.tid] = I.rel_bias[h * REL_TABLE + F.tid];
        const size_t tokq = (size_t)b * SEQ + q0 + r;
        bf16x8 qf[4];
#pragma unroll
        for (int s = 0; s < 4; ++s) qf[s] = *(const GAS bf16x8*)(PROJ + tokq * PROJ_LD + PJ_Q + h * 64 + 16 * s + 8 * hh);
        f32x16 o0, o1;
#pragma unroll
        for (int i = 0; i < 16; ++i) { o0[i] = 0.f; o1[i] = 0.f; }
        float m_run = -1e30f, l_run = 0.f;
        v4u kreg, vreg;
#define AT_STAGE_LOAD(kc_) do { kreg = *(const GAS v4u*)(PROJ + ((size_t)b * SEQ + (size_t)(kc_) * 64 + srow) * PROJ_LD + PJ_K + h * 64 + spc * 8); \
                                vreg = *(const GAS v4u*)(VT + (size_t)(h * 64 + srow) * T + (size_t)b * SEQ + (size_t)(kc_) * 64 + spc * 8); } while (0)
#define AT_STAGE_WRITE(buf_) do { *(LAS v4u*)(F.lds + A_KOFF + (buf_) * AKV + srow * 144 + spc * 16) = kreg; *(LAS v4u*)(F.lds + A_VOFF + (buf_) * AKV + srow * 144 + spc * 16) = vreg; } while (0)
        AT_STAGE_LOAD(kc_lo); AT_STAGE_WRITE(0);
        __syncthreads();
#pragma unroll 1
        for (int kc = kc_lo; kc <= kc_hi; ++kc) {
            const int buf = (kc - kc_lo) & 1;
            if (kc < kc_hi) AT_STAGE_LOAD(kc + 1);
            if (kc >= cw - LEFT && kc <= cw) {
                const LAS unsigned char* Kb = F.lds + A_KOFF + buf * AKV; const LAS unsigned char* Vb = F.lds + A_VOFF + buf * AKV;
#pragma unroll
                for (int tt = 0; tt < 2; ++tt) {
                    const int kpos0 = kc * 64 + 32 * tt;
                    bf16x8 kf[4], va[2], vb[2];
#pragma unroll
                    for (int s = 0; s < 4; ++s) kf[s] = *(const LAS bf16x8*)(Kb + (32 * tt + rp) * 144 + 32 * s + 16 * hh);
#pragma unroll
                    for (int s2 = 0; s2 < 2; ++s2) { va[s2] = *(const LAS bf16x8*)(Vb + r * 144 + 64 * tt + 32 * s2 + 16 * hh); vb[s2] = *(const LAS bf16x8*)(Vb + (32 + r) * 144 + 64 * tt + 32 * s2 + 16 * hh); }
                    f32x16 st;
#pragma unroll
                    for (int i = 0; i < 16; ++i) st[i] = 0.f;
#pragma unroll
                    for (int s = 0; s < 4; ++s) st = __builtin_amdgcn_mfma_f32_32x32x16_bf16(kf[s], qf[s], st, 0, 0, 0);
                    const int dbase = (q0 + r) - (kpos0 + 8 * hh);
                    float mx = -1e30f;
                    if (q0 - (kpos0 + 31) >= MAX_PAST) {
                        const float bc = tbl[MAX_PAST + 63];
#pragma unroll
                        for (int i = 0; i < 16; ++i) { st[i] += bc; mx = fmaxf(mx, st[i]); }
                    } else {
#pragma unroll
                        for (int i = 0; i < 16; ++i) { int d = dbase - (16 * (i >> 3) + 4 * ((i >> 2) & 1) + (i & 3)); d = d < MAX_PAST ? d : MAX_PAST; st[i] += tbl[d + 63]; mx = fmaxf(mx, st[i]); }
                    }
                    mx = fmaxf(mx, __shfl_xor(mx, 32));
                    const float m_new = fmaxf(m_run, mx), alpha = __expf(m_run - m_new);
                    float ls = 0.f;
#pragma unroll
                    for (int i = 0; i < 16; ++i) { st[i] = __expf(st[i] - m_new); ls += st[i]; }
                    l_run = l_run * alpha + ls;
                    if (__builtin_amdgcn_ballot_w64(m_new != m_run)) {
#pragma unroll
                        for (int i = 0; i < 16; ++i) { o0[i] *= alpha; o1[i] *= alpha; } }
                    m_run = m_new;
#pragma unroll
                    for (int s2 = 0; s2 < 2; ++s2) {
                        v4u pw; pw.x = pg8::cvt_pk_bf16(st[8 * s2 + 0], st[8 * s2 + 1]); pw.y = pg8::cvt_pk_bf16(st[8 * s2 + 2], st[8 * s2 + 3]); pw.z = pg8::cvt_pk_bf16(st[8 * s2 + 4], st[8 * s2 + 5]); pw.w = pg8::cvt_pk_bf16(st[8 * s2 + 6], st[8 * s2 + 7]);
                        const bf16x8 pf = __builtin_bit_cast(bf16x8, pw);
                        o0 = __builtin_amdgcn_mfma_f32_32x32x16_bf16(va[s2], pf, o0, 0, 0, 0);
                        o1 = __builtin_amdgcn_mfma_f32_32x32x16_bf16(vb[s2], pf, o1, 0, 0, 0);
                    }
                }
            }
            if (kc < kc_hi) AT_STAGE_WRITE(buf ^ 1);
            __syncthreads();
        }
#undef AT_STAGE_LOAD
#undef AT_STAGE_WRITE
        const float inv = 1.0f / (l_run + __shfl_xor(l_run, 32));
        unsigned char* yo = (unsigned char*)YA + tokq * AW + h * 64 + 4 * hh;
        const float inv16 = inv * ACT8_SCALE;
#pragma unroll
        for (int g4 = 0; g4 < 4; ++g4) {
            int w0 = __builtin_amdgcn_cvt_pk_fp8_f32(o0[4 * g4] * inv16, o0[4 * g4 + 1] * inv16, 0, false); w0 = __builtin_amdgcn_cvt_pk_fp8_f32(o0[4 * g4 + 2] * inv16, o0[4 * g4 + 3] * inv16, w0, true);
            int w1 = __builtin_amdgcn_cvt_pk_fp8_f32(o1[4 * g4] * inv16, o1[4 * g4 + 1] * inv16, 0, false); w1 = __builtin_amdgcn_cvt_pk_fp8_f32(o1[4 * g4 + 2] * inv16, o1[4 * g4 + 3] * inv16, w1, true);
            *(GAS unsigned*)(yo + 8 * g4) = (unsigned)w0; *(GAS unsigned*)(yo + 32 + 8 * g4) = (unsigned)w1;
        }
    }
}

__device__ __forceinline__ void p6_merged(Frame& F0, const In& I) {
    PHASE_FRAME(F0);
    pg8::SchedTwo S; S.t.init(T / 256, D / 256, F.G, (int)blockIdx.x);
    S.A0 = (unsigned)(WS_YA); S.A1 = (unsigned)(WS_YB); S.B0 = (unsigned)(WS_PAT); S.B1 = (unsigned)(WS_PBT);
    S.tsA = (unsigned)256 * AW; S.tsB = (unsigned)256 * AW;
    pg8::EpiMerged E{(const bf16*)(F.ws + WS_PROJ), (bf16*)(F.ws + WS_MERGED)};
    pg8::gemm_phase<pg8::EpiMerged, pg8::SchedTwo, true, true, 0x00007b79>(F.lds + RING_OFF, F.rsrc, AW / 2, AW / 2, AW / 2, S, E);
}
__device__ __forceinline__ void p7_mix(Frame& F0, const In& I) {
    PHASE_FRAME(F0);
    pg8::SchedPlain S; S.t.init(T / 256, D / 256, F.G, (int)blockIdx.x);
    S.A = (unsigned)(WS_MERGED); S.B = (unsigned)(WS_WOT); S.tsA = (unsigned)256 * D; S.tsB = (unsigned)256 * D;
    pg8::EpiBf16 E{(bf16*)(F.ws + WS_Z), D};
    pg8::gemm_phase<pg8::EpiBf16, pg8::SchedPlain, true, true, 0x00007b79>(F.lds + RING_OFF, F.rsrc, D / 2, D / 2, D / 2, S, E);
}

__device__ __forceinline__ void p3_lora(Frame& F0, const In& I) {
    PHASE_FRAME(F0);
    { pg8::SchedPlain S; S.t.init(T / 256, 4, F.G, (int)blockIdx.x);
      S.A = (unsigned)(WS_LORAIN); S.B = (unsigned)(WS_WLA); S.tsA = (unsigned)256 * LORA_LD * 2; S.tsB = (unsigned)256 * 256 * 2;
      pg8::EpiLoraA<true> E{(float*)(F.ws + WS_DECAY), I.w0};
      pg8::gemm_phase<pg8::EpiLoraA<true>, pg8::SchedPlain, true>(F.lds + RING_OFF, F.rsrc, LORA_LD, 256, 256, S, E); }
    { pg8::SchedPlain S; S.t.init(T / 256, 4, F.G, (int)blockIdx.x);
      S.A = (unsigned)(WS_LORAIN); S.B = (unsigned)(WS_WLA + (size_t)1024 * 256 * 2); S.tsA = (unsigned)256 * LORA_LD * 2; S.tsB = (unsigned)256 * 256 * 2;
      pg8::EpiIclr E{(bf16*)(F.ws + WS_ICLR), I.a0};
      pg8::gemm_phase<pg8::EpiIclr, pg8::SchedPlain, true>(F.lds + RING_OFF, F.rsrc, LORA_LD, 256, 256, S, E); }
    { pg8::SchedPlain S; S.t.init(T / 256, 4, F.G, (int)blockIdx.x);
      S.A = (unsigned)(WS_LORAIN + 512); S.B = (unsigned)(WS_WLG); S.tsA = (unsigned)256 * LORA_LD * 2; S.tsB = (unsigned)256 * 256 * 2;
      pg8::EpiBf16 E{(bf16*)(F.ws + WS_G), RW};
      pg8::gemm_phase<pg8::EpiBf16, pg8::SchedPlain, true>(F.lds + RING_OFF, F.rsrc, LORA_LD, 256, 256, S, E); }
}

constexpr int CP = 144;
constexpr int CMAT = 64 * CP;
constexpr int C_RT = 0 * CMAT, C_ATT = 1 * CMAT, C_AAK = 2 * CMAT, C_ARKT = 3 * CMAT, C_WA = 4 * CMAT, C_WB = 6 * CMAT,
              C_MA = 8 * CMAT, C_MTA = 9 * CMAT, C_MB = 10 * CMAT, C_MTB = 11 * CMAT, C_SEG = 12 * CMAT, C_GAM = C_SEG + 8 * 64 * 4, C_TSCR = C_GAM + 256;
constexpr int C_AT = C_WB, C_BT = C_WB + CMAT, C_KT = C_MB, C_QYT = C_MA, C_QST = C_MTA, C_KHT = C_MTB, C_VT = C_WB;
static_assert(C_TSCR % 16 == 0 && C_TSCR + 8 * 5120 <= TAB_OFF, "P4a LDS map");
constexpr int CHK_UNIT_BYTES = 4 * 64 * 64 * 2;
#define CBAR() do { asm volatile("s_waitcnt lgkmcnt(0)" ::: "memory"); __builtin_amdgcn_s_barrier(); asm volatile("" ::: "memory"); } while (0)
template <int NT, class Epi>
__device__ __forceinline__ void cmm(const LAS unsigned char* X, const LAS unsigned char* Y, int mt0, int nt, int lane, const Epi& E) {
    const int lr = lane & 15, kq = lane >> 4;
    const bf16x8 b0 = *(const LAS bf16x8*)(Y + (nt * 16 + lr) * CP + kq * 16), b1 = *(const LAS bf16x8*)(Y + (nt * 16 + lr) * CP + kq * 16 + 64);
#pragma unroll
    for (int i = 0; i < NT; ++i) { const int mt = mt0 + i;
        const bf16x8 a0 = *(const LAS bf16x8*)(X + (mt * 16 + lr) * CP + kq * 16), a1 = *(const LAS bf16x8*)(X + (mt * 16 + lr) * CP + kq * 16 + 64);
        f32x4 acc = (f32x4){0.f, 0.f, 0.f, 0.f};
        acc = __builtin_amdgcn_mfma_f32_16x16x32_bf16(a0, b0, acc, 0, 0, 0);
        acc = __builtin_amdgcn_mfma_f32_16x16x32_bf16(a1, b1, acc, 0, 0, 0);
        E(mt, nt, acc); }
}
__device__ __forceinline__ v2u pack4(const f32x4& v) { return (v2u){pg8::cvt_pk_bf16(v[0], v[1]), pg8::cvt_pk_bf16(v[2], v[3])}; }
__device__ __forceinline__ f32x4 unpack4(const v2u w) { return (f32x4){bflo(w.x), bfhi(w.x), bflo(w.y), bfhi(w.y)}; }
__device__ __forceinline__ void p4a_chunk(Frame& F0, const In& I) {
    PHASE_FRAME(F0);
    LAS unsigned char* L = F.lds;
    const int lane = F.lane, w = F.wave, lr = lane & 15, kq = lane >> 4;
    const bf16* RKV = (const bf16*)(F.ws + WS_RKV); const float* LW = (const float*)(F.ws + WS_DECAY); const bf16* ICL = (const bf16*)(F.ws + WS_ICLR);
    unsigned char* CHK = F.ws + WS_CHK;
    int uit = 0;
    for (int unit = F.vcu; unit < BATCH * RH * (SEQ / 64); unit += F.G, ++uit) {
        const int bh = unit >> 7, ck = unit & 127, b = bh >> 4, h = bh & 15;
        const size_t tok0 = (size_t)b * SEQ + (size_t)ck * 64 + 8 * w;
        const int hc = h * 64 + lane;
        float lwv[8], ic[8], rr[8], kk[8], vv[8];
#pragma unroll
        for (int i = 0; i < 8; ++i) { const size_t tok = tok0 + i; lwv[i] = LW[tok * RW + hc]; ic[i] = bf2f(ICL[tok * RW + hc]);
            rr[i] = bf2f(RKV[tok * (3 * RW) + hc]); kk[i] = bf2f(RKV[tok * (3 * RW) + RW + hc]); vv[i] = bf2f(RKV[tok * (3 * RW) + 2 * RW + hc]); }
        const float kkp = I.k_k[hc], kap = I.k_a[hc];
        float cs[8]; { float run = 0.f;
#pragma unroll
            for (int i = 0; i < 8; ++i) { run += lwv[i]; cs[i] = run; } }
        __syncthreads();
        ((LAS float*)(L + C_SEG))[w * 64 + lane] = cs[7];
        CBAR();
        float pre = 0.f, tot = 0.f;
#pragma unroll
        for (int j = 0; j < 8; ++j) { const float sg = ((const LAS float*)(L + C_SEG))[j * 64 + lane]; tot += sg; pre += (j < w) ? sg : 0.f; }
        if (w == 0) ((LAS float*)(L + C_GAM))[lane] = __expf(tot);
        unsigned att[4], bht[4], kht[4], vtt[4];
        float at_[8], bh_[8], kh_[8]; const float gtot = __expf(tot); float ep_prev = 1.f;
#pragma unroll
        for (int i = 0; i < 8; ++i) { const int t = 8 * w + i; const float cum = pre + cs[i], cump = cum - lwv[i];
            const float kkv = kk[i] * kkp; const float n2 = wave_sum(kkv * kkv); const float kkn = kkv * __builtin_amdgcn_rsqf(fmaxf(n2, 1e-24f));
            const float a = -kkn, bb = kkn * ic[i], kp = kk[i] * (1.0f + (ic[i] - 1.0f) * kap);
            const float ep = __expf(cum), em = __builtin_amdgcn_rcpf(ep), epp = (i == 0) ? __expf(cump) : ep_prev, eL = gtot * em; ep_prev = ep;
            const float Rv = rr[i] * ep, Av = a * epp, Bv = bb * em, Kv = kp * em;
            at_[i] = Av; bh_[i] = bb * eL; kh_[i] = kp * eL;
            *(LAS unsigned short*)(L + C_RT + t * CP + lane * 2) = (unsigned short)f2bf(Rv);
            *(LAS unsigned short*)(L + C_AT + t * CP + lane * 2) = (unsigned short)f2bf(Av);
            *(LAS unsigned short*)(L + C_BT + t * CP + lane * 2) = (unsigned short)f2bf(Bv);
            *(LAS unsigned short*)(L + C_KT + t * CP + lane * 2) = (unsigned short)f2bf(Kv); }
#pragma unroll
        for (int q = 0; q < 4; ++q) { att[q] = pk2(at_[2 * q], at_[2 * q + 1]); bht[q] = pk2(bh_[2 * q], bh_[2 * q + 1]); kht[q] = pk2(kh_[2 * q], kh_[2 * q + 1]); vtt[q] = pk2(vv[2 * q], vv[2 * q + 1]); }
        *(LAS v4u*)(L + C_ATT + lane * CP + 16 * w) = (v4u){att[0], att[1], att[2], att[3]};
        *(LAS v4u*)(L + C_WA + (64 + lane) * CP + 16 * w) = (v4u){bht[0], bht[1], bht[2], bht[3]};
        CBAR();
        const int cit = (uit * F.G + F.vcu) * 16 + w * 2; const bool hx = cit < MOE_NITEMS, hy = cit + 1 < MOE_NITEMS;
        f32x4 tX[16]; MoeItem mX = moe_item(hx ? cit : 0, I.w_gu, I.w_down, F.ws);
        LAS float* tscr = (LAS float*)(L + C_TSCR + w * 5120);
        struct Fr { bf16x8 a, b; };
        auto LD = [&](int base, int tile) -> Fr { const LAS unsigned char* q = L + base + (tile * 16 + lr) * CP + kq * 16; Fr f; f.a = *(const LAS bf16x8*)q; f.b = *(const LAS bf16x8*)(q + 64); return f; };
        auto MM = [&](const Fr& x, const Fr& y) -> f32x4 { f32x4 acc = (f32x4){0.f, 0.f, 0.f, 0.f};
            acc = __builtin_amdgcn_mfma_f32_16x16x32_bf16(x.a, y.a, acc, 0, 0, 0); acc = __builtin_amdgcn_mfma_f32_16x16x32_bf16(x.b, y.b, acc, 0, 0, 0); return acc; };
        const int nt = w & 3, mt0 = 2 * (w >> 2), n = nt * 16 + lr;
        { const Fr yAT = LD(C_AT, nt), yKT = LD(C_KT, nt), yRT = LD(C_RT, nt);
          Fr xBT[2], xAT[2], xKT[2];
#pragma unroll
          for (int i = 0; i < 2; ++i) { xBT[i] = LD(C_BT, mt0 + i); xAT[i] = LD(C_AT, mt0 + i); xKT[i] = LD(C_KT, mt0 + i); }
          f32x4 a1[2], a2[2], a3[2], a4[2];
#pragma unroll
          for (int i = 0; i < 2; ++i) { a1[i] = MM(xBT[i], yAT); a2[i] = MM(xAT[i], yKT); a3[i] = MM(xBT[i], yRT); a4[i] = MM(xKT[i], yRT); }
#pragma unroll
          for (int i = 0; i < 2; ++i) { const int m0 = (mt0 + i) * 16 + 4 * kq;
              f32x4 v = a1[i];
#pragma unroll
              for (int e = 0; e < 4; ++e) { v[e] = (m0 + e < n) ? v[e] : 0.f; *(LAS unsigned short*)(L + C_MA + (m0 + e) * CP + n * 2) = (unsigned short)f2bf(v[e]); }
              *(LAS v2u*)(L + C_MTA + n * CP + m0 * 2) = pack4(v);
              v = a2[i];
#pragma unroll
              for (int e = 0; e < 4; ++e) v[e] = (n < m0 + e) ? v[e] : 0.f;
              *(LAS v2u*)(L + C_AAK + n * CP + m0 * 2) = pack4(v);
              v = a3[i];
#pragma unroll
              for (int e = 0; e < 4; ++e) v[e] = (m0 + e <= n) ? v[e] : 0.f;
              *(LAS v2u*)(L + C_WA + n * CP + m0 * 2) = pack4(v);
              v = a4[i];
#pragma unroll
              for (int e = 0; e < 4; ++e) v[e] = (m0 + e <= n) ? v[e] : 0.f;
              *(LAS v2u*)(L + C_ARKT + n * CP + m0 * 2) = pack4(v); } }
        CBAR();
        if (hx) tr8_load(mX, tX, lane);
#pragma unroll
        for (int lvl = 0; lvl < 6; ++lvl) {
            const int Wsrc = (lvl & 1) ? C_WB : C_WA, Wdst = (lvl & 1) ? C_WA : C_WB, Ms = (lvl & 1) ? C_MB : C_MA, Mts = (lvl & 1) ? C_MTB : C_MTA, Md = (lvl & 1) ? C_MA : C_MB, Mtd = (lvl & 1) ? C_MTA : C_MTB;
            const Fr yW = LD(Wsrc, w); Fr yMt; if (lvl < 5) yMt = LD(Mts, nt);
            Fr xM[4], xS[2];
#pragma unroll
            for (int i = 0; i < 4; ++i) xM[i] = LD(Ms, i);
            if (lvl < 5) { xS[0] = LD(Ms, mt0); xS[1] = LD(Ms, mt0 + 1); }
            const int nj = w * 16 + lr;
            f32x4 old[4], aw[4], as[2];
#pragma unroll
            for (int i = 0; i < 4; ++i) old[i] = unpack4(*(const LAS v2u*)(L + Wsrc + nj * CP + (i * 16 + 4 * kq) * 2));
#pragma unroll
            for (int i = 0; i < 4; ++i) aw[i] = MM(xM[i], yW);
            if (lvl < 5) {
#pragma unroll
                for (int i = 0; i < 2; ++i) as[i] = MM(xS[i], yMt); }
#pragma unroll
            for (int i = 0; i < 4; ++i) *(LAS v2u*)(L + Wdst + nj * CP + (i * 16 + 4 * kq) * 2) = pack4(old[i] + aw[i]);
            if (lvl < 5) {
#pragma unroll
                for (int i = 0; i < 2; ++i) { const int m0 = (mt0 + i) * 16 + 4 * kq;
#pragma unroll
                    for (int e = 0; e < 4; ++e) *(LAS unsigned short*)(L + Md + (m0 + e) * CP + n * 2) = (unsigned short)f2bf(as[i][e]);
                    if (lvl < 4) *(LAS v2u*)(L + Mtd + n * CP + m0 * 2) = pack4(as[i]); } }
            if (lvl == 4) *(LAS v4u*)(L + C_KHT + lane * CP + 16 * w) = (v4u){kht[0], kht[1], kht[2], kht[3]};
            if (lvl == 2) { if (hx) tr8_finish(tX, mX, tscr, lane);
                            if (hy) { mX = moe_item(cit + 1, I.w_gu, I.w_down, F.ws); tr8_load(mX, tX, lane); } }
            CBAR();
        }
        *(LAS v4u*)(L + C_VT + lane * CP + 16 * w) = (v4u){vtt[0], vtt[1], vtt[2], vtt[3]};
        unsigned char* og = CHK + (size_t)unit * CHK_UNIT_BYTES;
        { const Fr yW1 = LD(C_WA, nt), yW2 = LD(C_WA + 64 * CP, nt);
          Fr xA[2], xK[2];
#pragma unroll
          for (int i = 0; i < 2; ++i) { xA[i] = LD(C_ATT, mt0 + i); xK[i] = LD(C_AAK, mt0 + i); }
          f32x4 rv[2], av[2], kv[2];
          const float gm = ((const LAS float*)(L + C_GAM))[n];
#pragma unroll
          for (int i = 0; i < 2; ++i) { const int m0 = (mt0 + i) * 16 + 4 * kq;
              rv[i] = unpack4(*(const LAS v2u*)(L + C_RT + n * CP + m0 * 2)); av[i] = unpack4(*(const LAS v2u*)(L + C_ARKT + n * CP + m0 * 2)); kv[i] = unpack4(*(const LAS v2u*)(L + C_KHT + n * CP + m0 * 2)); }
          f32x4 p7[2], p8[2], p9[2], p10[2];
#pragma unroll
          for (int i = 0; i < 2; ++i) { p7[i] = MM(xA[i], yW1); p8[i] = MM(xK[i], yW1); p9[i] = MM(xA[i], yW2); p10[i] = MM(xK[i], yW2); }
#pragma unroll
          for (int i = 0; i < 2; ++i) { const int m0 = (mt0 + i) * 16 + 4 * kq;
              *(GAS v2u*)(og + 0 * 8192 + n * 128 + m0 * 2) = pack4(p7[i] + rv[i]);
              *(LAS v2u*)(L + C_QYT + n * CP + m0 * 2) = pack4(p8[i] + av[i]);
              f32x4 v = p9[i];
#pragma unroll
              for (int e = 0; e < 4; ++e) v[e] += (m0 + e == n) ? gm : 0.f;
              *(GAS v2u*)(og + 1 * 8192 + n * 128 + m0 * 2) = pack4(v);
              *(LAS v2u*)(L + C_QST + n * CP + m0 * 2) = pack4(p10[i] + kv[i]); } }
        CBAR();
        { const Fr yQy = LD(C_QYT, nt), yQs = LD(C_QST, nt);
          Fr xV[2];
#pragma unroll
          for (int i = 0; i < 2; ++i) xV[i] = LD(C_VT, mt0 + i);
          f32x4 p11[2], p12[2];
#pragma unroll
          for (int i = 0; i < 2; ++i) { p11[i] = MM(xV[i], yQy); p12[i] = MM(xV[i], yQs); }
#pragma unroll
          for (int i = 0; i < 2; ++i) { const int m0 = (mt0 + i) * 16 + 4 * kq;
              *(GAS v2u*)(og + 2 * 8192 + n * 128 + m0 * 2) = pack4(p11[i]);
              *(GAS v2u*)(og + 3 * 8192 + n * 128 + m0 * 2) = pack4(p12[i]); } }
        if (hy) tr8_finish(tX, mX, tscr, lane);
    }
}

constexpr int C2_SLOT = 20480;
__device__ __forceinline__ void p4b_scan(Frame& F0, const In& I) {
    PHASE_FRAME(F0);
    const int lane = F.lane, lr = lane & 15, kq = lane >> 4;
    const unsigned char* CHK = F.ws + WS_CHK; bf16* YS = (bf16*)(F.ws + WS_YSCAN);
    for (int unit = F.vcu; unit < BATCH * RH * 4; unit += F.G) {
        const int bh = unit >> 2, rq = unit & 3, b = bh >> 4, h = bh & 15;
        if (F.wave == 0) {
            LAS unsigned char* Sl = F.lds + 3 * C2_SLOT;
            f32x4 S[4]; bf16x8 sf[2];
#pragma unroll
            for (int nt = 0; nt < 4; ++nt) S[nt] = (f32x4){0.f, 0.f, 0.f, 0.f};
#pragma unroll
            for (int ks = 0; ks < 2; ++ks)
#pragma unroll
                for (int j = 0; j < 8; ++j) sf[ks][j] = 0;
#define C2_DMA(ck_) do { const int ckc_ = (ck_) < SEQ / 64 ? (ck_) : SEQ / 64 - 1; const unsigned char* ug = CHK + ((size_t)bh * 128 + ckc_) * CHK_UNIT_BYTES; \
                LAS unsigned char* sl_ = F.lds + ((ck_) % 3) * C2_SLOT; \
                _Pragma("unroll") for (int j = 0; j < 16; ++j) __builtin_amdgcn_global_load_lds((const unsigned*)(ug + j * 1024 + lane * 16), (LAS unsigned*)(sl_ + j * 1024), 16, 0, 0); \
                _Pragma("unroll") for (int j = 0; j < 2; ++j) { \
                    __builtin_amdgcn_global_load_lds((const unsigned*)(ug + 2 * 8192 + (j * 32 + (lane >> 1)) * 128 + rq * 32 + (lane & 1) * 16), (LAS unsigned*)(sl_ + 16384 + j * 1024), 16, 0, 0); \
                    __builtin_amdgcn_global_load_lds((const unsigned*)(ug + 3 * 8192 + (j * 32 + (lane >> 1)) * 128 + rq * 32 + (lane & 1) * 16), (LAS unsigned*)(sl_ + 18432 + j * 1024), 16, 0, 0); } } while (0)
            C2_DMA(0); C2_DMA(1);
#pragma unroll 1
            for (int ck = 0; ck < SEQ / 64; ++ck) {
                asm volatile("s_waitcnt lgkmcnt(0)" ::: "memory");
                C2_DMA(ck + 2);
                asm volatile("s_waitcnt vmcnt(40)" ::: "memory");
                const LAS unsigned char* sl_ = F.lds + (ck % 3) * C2_SLOT;
#pragma unroll
                for (int nt = 0; nt < 4; ++nt) {
                    const bf16x8 py0 = *(const LAS bf16x8*)(sl_ + (16 * nt + lr) * 128 + kq * 16), py1 = *(const LAS bf16x8*)(sl_ + (16 * nt + lr) * 128 + kq * 16 + 64);
                    const bf16x8 ps0 = *(const LAS bf16x8*)(sl_ + 8192 + (16 * nt + lr) * 128 + kq * 16), ps1 = *(const LAS bf16x8*)(sl_ + 8192 + (16 * nt + lr) * 128 + kq * 16 + 64);
                    f32x4 y = unpack4(*(const LAS v2u*)(sl_ + 16384 + (16 * nt + lr) * 32 + kq * 8));
                    f32x4 s2 = unpack4(*(const LAS v2u*)(sl_ + 18432 + (16 * nt + lr) * 32 + kq * 8));
                    y = __builtin_amdgcn_mfma_f32_16x16x32_bf16(sf[0], py0, y, 0, 0, 0); y = __builtin_amdgcn_mfma_f32_16x16x32_bf16(sf[1], py1, y, 0, 0, 0);
                    *(GAS v2u*)(YS + ((size_t)b * SEQ + (size_t)ck * 64 + 16 * nt + lr) * RW + h * 64 + rq * 16 + 4 * kq) = pack4(y);
                    s2 = __builtin_amdgcn_mfma_f32_16x16x32_bf16(sf[0], ps0, s2, 0, 0, 0); s2 = __builtin_amdgcn_mfma_f32_16x16x32_bf16(sf[1], ps1, s2, 0, 0, 0);
                    S[nt] = s2; }
#pragma unroll
                for (int nt = 0; nt < 4; ++nt)
#pragma unroll
                    for (int i = 0; i < 4; ++i) *(LAS unsigned short*)(Sl + (4 * kq + i) * CP + (16 * nt + lr) * 2) = (unsigned short)f2bf(S[nt][i]);
                LDS_WAIT(); asm volatile("" ::: "memory");
                sf[0] = *(const LAS bf16x8*)(Sl + lr * CP + kq * 16); sf[1] = *(const LAS bf16x8*)(Sl + lr * CP + kq * 16 + 64);
                LDS_WAIT(); asm volatile("" ::: "memory");
            }
            asm volatile("s_waitcnt vmcnt(0)" ::: "memory");
#undef C2_DMA
        }
    }
}
static_assert(3 * C2_SLOT + 4096 + 5 * 16640 <= TAB_OFF, "P4b LDS map");

__device__ __forceinline__ void p5_post(Frame& F0, const In& I) {
    PHASE_FRAME(F0);
    const int lane = F.lane; const int gw = F.vcu * NWAVES + F.wave, NGW = F.G * NWAVES;
    const bf16* RKV = (const bf16*)(F.ws + WS_RKV); const bf16* ICL = (const bf16*)(F.ws + WS_ICLR); const bf16* YS = (const bf16*)(F.ws + WS_YSCAN);
    const bf16* G = (const bf16*)(F.ws + WS_G); bf16* YB = (bf16*)(F.ws + WS_YB);
    const int c0 = lane * 16;
    for (int tok = gw; tok < T; tok += NGW) {
        float y[16], rr[16], kk[16], vv[16], ic[16], gg[16];
#pragma unroll
        for (int q = 0; q < 2; ++q) { const v4u a = *(const GAS v4u*)(YS + (size_t)tok * RW + c0 + 8 * q), c = *(const GAS v4u*)(ICL + (size_t)tok * RW + c0 + 8 * q);
            const unsigned aw[4] = {a.x, a.y, a.z, a.w}, cw[4] = {c.x, c.y, c.z, c.w};
#pragma unroll
            for (int e = 0; e < 4; ++e) { y[8 * q + 2 * e] = bflo(aw[e]); y[8 * q + 2 * e + 1] = bfhi(aw[e]); ic[8 * q + 2 * e] = bflo(cw[e]); ic[8 * q + 2 * e + 1] = bfhi(cw[e]); } }
#pragma unroll
        for (int q = 0; q < 2; ++q) {
            const v4u a = *(const GAS v4u*)(RKV + (size_t)tok * (3 * RW) + c0 + 8 * q), bb = *(const GAS v4u*)(RKV + (size_t)tok * (3 * RW) + RW + c0 + 8 * q),
                      c = *(const GAS v4u*)(RKV + (size_t)tok * (3 * RW) + 2 * RW + c0 + 8 * q), d = *(const GAS v4u*)(G + (size_t)tok * RW + c0 + 8 * q);
            const unsigned aw[4] = {a.x, a.y, a.z, a.w}, bw[4] = {bb.x, bb.y, bb.z, bb.w}, cw[4] = {c.x, c.y, c.z, c.w}, dw[4] = {d.x, d.y, d.z, d.w};
#pragma unroll
            for (int e = 0; e < 4; ++e) { rr[8 * q + 2 * e] = bflo(aw[e]); rr[8 * q + 2 * e + 1] = bfhi(aw[e]); kk[8 * q + 2 * e] = bflo(bw[e]); kk[8 * q + 2 * e + 1] = bfhi(bw[e]);
                vv[8 * q + 2 * e] = bflo(cw[e]); vv[8 * q + 2 * e + 1] = bfhi(cw[e]); gg[8 * q + 2 * e] = bflo(dw[e]); gg[8 * q + 2 * e + 1] = bfhi(dw[e]); } }
        float s = 0.f, bs = 0.f;
#pragma unroll
        for (int e = 0; e < 16; ++e) { s += y[e]; const float kp = kk[e] * (1.0f + (ic[e] - 1.0f) * I.k_a[c0 + e]); bs += rr[e] * kp * I.r_k[c0 + e]; }
        s = quadsum(s); bs = quadsum(bs);
        const float mean = s * (1.f / 64.f); float s2 = 0.f;
#pragma unroll
        for (int e = 0; e < 16; ++e) { y[e] -= mean; s2 += y[e] * y[e]; }
        s2 = quadsum(s2);
        const float rstd = 1.f / sqrtf(s2 * (1.f / 64.f) + GN_EPS);
        float o[16];
#pragma unroll
        for (int e = 0; e < 16; ++e) o[e] = (y[e] * rstd * I.lnx_w[c0 + e] + I.lnx_b[c0 + e] + bs * vv[e]) * gg[e];
        { unsigned w8[4];
#pragma unroll
          for (int q = 0; q < 4; ++q) { int t8 = __builtin_amdgcn_cvt_pk_fp8_f32(o[4 * q] * ACT8_SCALE, o[4 * q + 1] * ACT8_SCALE, 0, false); t8 = __builtin_amdgcn_cvt_pk_fp8_f32(o[4 * q + 2] * ACT8_SCALE, o[4 * q + 3] * ACT8_SCALE, t8, true); w8[q] = (unsigned)t8; }
          *(GAS v4u*)((unsigned char*)YB + (size_t)tok * RW + c0) = (v4u){w8[0], w8[1], w8[2], w8[3]}; }
    }
}
#ifndef STAGE
#define STAGE 4
#endif
struct Args { In in; float* out; unsigned char* ws; };
__global__ void __launch_bounds__(NWAVES * 64, 2) mk_fwd(Args args) {
    extern __shared__ __attribute__((aligned(16))) unsigned char lds[];
    Frame F;
    F.lds = (LAS unsigned char*)lds;
    F.MISC = (volatile LAS unsigned*)(F.lds + MISC_OFF);
    F.tid = threadIdx.x; F.lane = F.tid & 63; F.wave = __builtin_amdgcn_readfirstlane(F.tid >> 6);
    F.G = gridDim.x; { const int bx = blockIdx.x; F.vcu = (F.G % 8 == 0) ? (bx % 8) * (F.G / 8) + bx / 8 : bx; }
    F.ws = args.ws;
    F.rsrc = __builtin_amdgcn_make_buffer_rsrc(args.ws, 0, 0xffffffff, 0x00020000);
    F.ctl = (gu32*)(args.ws + WS_CTL);
    for (int u = F.tid; u < (LDS_BYTES - MISC_OFF) / 4; u += NWAVES * 64) ((LAS unsigned*)(F.lds + MISC_OFF))[u] = 0u;
    __syncthreads();
    XcdBarrier bar = xcd_barrier_post((unsigned*)(F.ctl + CW_BAR), F.MISC + 8);
    const In& I = args.in;
#define GRID_BAR() xcd_barrier(bar)
#ifndef DUP_PHASE
#define DUP_PHASE -1
#endif
#define RUN(n, call) do { call; if (DUP_PHASE == (n)) { GRID_BAR(); call; } } while (0)

#if STAGE >= 2
    RUN(0, p0_prologue(F, I));
    GRID_BAR();
#endif
#if STAGE >= 3
    RUN(1, p1_proj(F, I));
    GRID_BAR();
    RUN(2, p2_shift_attn(F, I));
    GRID_BAR();
#if STAGE >= 4
    RUN(3, p3_lora(F, I));
    GRID_BAR();
    RUN(4, p4a_chunk(F, I));
    GRID_BAR();
    RUN(44, p4b_scan(F, I));
    GRID_BAR();
    RUN(5, p5_post(F, I));
    GRID_BAR();
#endif
    RUN(6, p6_merged(F, I));
    GRID_BAR();
    RUN(7, p7_mix(F, I));
    GRID_BAR();
#endif
    p8_ln_router<(STAGE < 3)>(F, I);
    GRID_BAR();
#if STAGE >= 2
    p9_scatter(F, I);
    GRID_BAR();
    RUN(10, p10_moe_up(F, I));
    GRID_BAR();
    RUN(11, p11_moe_down(F, I));
    GRID_BAR();
#endif
    RUN(12, p12_final<(STAGE < 2)>(F, I, args.out));
}

extern "C" void kernel_launch(void* const* d_in, const int* in_sizes, int n_in, void* d_out, int out_size, void* d_ws, size_t ws_size, hipStream_t stream) {
    static int grid = 0;
    if (grid == 0) {
        if (n_in != 27 || in_sizes[0] != T * D || out_size != T * D || ws_size < WS_END) { fprintf(stderr, "kernel_launch: unexpected shapes (n_in %d, in0 %d, out %d, ws %zu)\n", n_in, n_in > 0 ? in_sizes[0] : -1, out_size, ws_size); grid = -1; return; }
        int dev = 0, cus = 0, per_cu = 0;
        if (hipGetDevice(&dev) != hipSuccess || hipDeviceGetAttribute(&cus, hipDeviceAttributeMultiprocessorCount, dev) != hipSuccess) { grid = -1; return; }
        if (hipFuncSetAttribute((const void*)mk_fwd, hipFuncAttributeMaxDynamicSharedMemorySize, LDS_BYTES) != hipSuccess) { fprintf(stderr, "kernel_launch: hipFuncSetAttribute failed\n"); grid = -1; return; }
        if (hipOccupancyMaxActiveBlocksPerMultiprocessor(&per_cu, (const void*)mk_fwd, NWAVES * 64, LDS_BYTES) != hipSuccess || per_cu < 1)
            fprintf(stderr, "kernel_launch: occupancy query reports %d\n", per_cu);
        (void)hipGetLastError();
        grid = cus;
    }
    if (grid < 0) return;
    if (hipMemsetAsync((char*)d_ws + WS_CTL, 0, CTL_ZERO_BYTES, stream) != hipSuccess) return;
    Args a{};
    const float** ip = (const float**)&a.in;
    for (int i = 0; i < 27; ++i) ip[i] = (const float*)d_in[i];
    a.out = (float*)d_out; a.ws = (unsigned char*)d_ws;
    hipLaunchKernelGGL(mk_fwd, dim3(grid), dim3(NWAVES * 64), LDS_BYTES, stream, a);
    const hipError_t le = hipPeekAtLastError();
    if (le != hipSuccess) fprintf(stderr, "kernel_launch: launch failed: %s\n", hipGetErrorName(le));
}
```

```cpp
#define STAGE 4
#include <hip/hip_runtime.h>
#include <cstdio>
#include <cstdint>

#define GAS __attribute__((address_space(1)))
#define LAS __attribute__((address_space(3)))
typedef unsigned short bf16;
typedef unsigned v4u __attribute__((ext_vector_type(4)));
typedef unsigned v2u __attribute__((ext_vector_type(2)));
typedef float f32x4 __attribute__((ext_vector_type(4)));
typedef float f32x2 __attribute__((ext_vector_type(2)));
typedef float f32x16 __attribute__((ext_vector_type(16)));
typedef short bf16x8 __attribute__((ext_vector_type(8)));
typedef short bf16x4 __attribute__((ext_vector_type(4)));
typedef GAS unsigned gu32;

constexpr int NWAVES = 8;
constexpr int BATCH = 4, SEQ = 8192, D = 2048, T = BATCH * SEQ;
constexpr int CHUNK = 64, LEFT = 8, AH = 16, AD = 64, AW = 1024;
constexpr int REL_TABLE = 320, MAX_PAST = 256;
constexpr int RH = 16, RN = 64, RW = 1024, DLORA = 96, ALORA = 96, GLORA = 256;
constexpr int SHIFT_W = 3 * RW + DLORA + ALORA + GLORA;
constexpr int D_IN = 3 * AW + SHIFT_W + 2 * D;
constexpr int NE = 32, TOPK = 4, FF = 2048;
constexpr int MSLOT = T * TOPK;
constexpr int NBLK_MAX = (MSLOT + NE * 255 + 255) / 256;
constexpr int RROWS = NBLK_MAX * 256;
constexpr float LN_EPS = 1e-5f, GN_EPS = 64e-5f;
constexpr float YS_SCALE = 16.0f, YS_INV = 1.0f / 16.0f;
constexpr float ACT8_SCALE = 16.0f;
constexpr float F8_CVT_SCALE = 0.015625f;
constexpr float DN_ALPHA = 1.189207115002721f;
constexpr int PROJ_LD = 9728, PJ_Q = 0, PJ_K = 1024, PJ_SEG = 2048, SEG_PAD = 3584, PJ_GA = 5632, PJ_GB = 7680;
constexpr int LORA_LD = 512;

constexpr size_t MiB = 1u << 20;
constexpr size_t WS_CTL = 0, CTL_ZERO_BYTES = 1 * MiB;
constexpr size_t WS_TOPI = 2 * MiB;
constexpr size_t WS_GATE = 3 * MiB;
constexpr size_t WS_ROWSLOT = 4 * MiB;
constexpr size_t WS_ROWW = 5 * MiB;
constexpr size_t WS_WLA = 6 * MiB;
constexpr size_t WS_WLG = 7 * MiB;
constexpr size_t WS_PAT = 8 * MiB;
constexpr size_t WS_PBT = 12 * MiB;
constexpr size_t WS_WOT = 16 * MiB;
constexpr size_t WS_WVT = 24 * MiB;
constexpr size_t WS_WINT = 28 * MiB;
constexpr size_t WS_WG8 = 72 * MiB;
constexpr size_t WS_WQK8 = 80 * MiB;
constexpr size_t WS_WV8 = 84 * MiB;
constexpr size_t WS_WSV8 = 88 * MiB;
constexpr size_t WS_WGUT = 128 * MiB;
constexpr size_t WS_WDNT = 640 * MiB;
constexpr size_t WS_BASE0 = 1024 * MiB;
constexpr size_t WS_PROJ = WS_BASE0;
constexpr size_t WS_VT = WS_PROJ + 608 * MiB;
constexpr size_t WS_YA = WS_VT + 64 * MiB;
constexpr size_t WS_RKV = WS_YA + 64 * MiB;
constexpr size_t WS_LORAIN = WS_RKV + 192 * MiB;
constexpr size_t WS_DECAY = WS_LORAIN + 32 * MiB;
constexpr size_t WS_ICLR = WS_DECAY + 128 * MiB;
constexpr size_t WS_G = WS_ICLR + 128 * MiB;
constexpr size_t WS_YSCAN = WS_G + 64 * MiB;
constexpr size_t WS_YB = WS_YSCAN + 128 * MiB;
constexpr size_t WS_MERGED = WS_YB + 64 * MiB;
constexpr size_t WS_XB16 = WS_MERGED + 128 * MiB;
constexpr size_t WS_MIX_END = WS_XB16 + 128 * MiB;
constexpr size_t WS_Z = 2816 * MiB;
constexpr size_t WS_H1 = 3072 * MiB;
constexpr size_t WS_H1B = 3328 * MiB;
constexpr size_t WS_CHK = 3456 * MiB;
constexpr size_t WS_XB8 = 3712 * MiB;
constexpr size_t WS_END = 3776 * MiB;
constexpr size_t WS_XG = WS_BASE0;
constexpr size_t WS_ACT = WS_BASE0 + 544 * MiB;
constexpr size_t WS_YSLOT = WS_BASE0 + 1088 * MiB;
static_assert(WS_MIX_END <= WS_Z && WS_YSLOT + 512 * MiB <= WS_Z, "ws map");
static_assert(WS_WINT + (size_t)PROJ_LD * D * 2 <= WS_WGUT, "ws map");

constexpr int CW_CNT = 512;
constexpr int CW_CUR = 576;
constexpr int CW_BAR = 4096;

constexpr int RING_OFF = 0, RING_BYTES = 131072;
constexpr int LDS_BYTES = 160 * 1024;
constexpr int MISC_OFF = LDS_BYTES - 512;
constexpr int TAB_OFF = LDS_BYTES - 1024;

#define RLX_AGENT __ATOMIC_RELAXED, __HIP_MEMORY_SCOPE_AGENT
#define LDS_WAIT() asm volatile("s_waitcnt lgkmcnt(0)" ::: "memory")
#define VM_WAIT() asm volatile("s_waitcnt vmcnt(0)" ::: "memory")
__device__ __forceinline__ unsigned f2bf(float f) { unsigned u = __builtin_bit_cast(unsigned, f); return (u + 0x7fffu + ((u >> 16) & 1u)) >> 16; }
__device__ __forceinline__ unsigned pk2(float lo, float hi) { return f2bf(lo) | (f2bf(hi) << 16); }
__device__ __forceinline__ float bf2f(unsigned short h) { return __builtin_bit_cast(float, (unsigned)h << 16); }
__device__ __forceinline__ float bflo(unsigned w) { return __builtin_bit_cast(float, w << 16); }
__device__ __forceinline__ float bfhi(unsigned w) { return __builtin_bit_cast(float, w & 0xffff0000u); }
__device__ __forceinline__ float fsigmoid(float x) { return __builtin_amdgcn_rcpf(1.0f + __expf(-x)); }
__device__ __forceinline__ float dpp_f(float x, const int ctrl_sel) {
    const int xi = __builtin_bit_cast(int, x); int r;
    if (ctrl_sel == 0) r = __builtin_amdgcn_update_dpp(0, xi, 0xB1, 0xF, 0xF, false);
    else if (ctrl_sel == 1) r = __builtin_amdgcn_update_dpp(0, xi, 0x4E, 0xF, 0xF, false);
    else if (ctrl_sel == 2) r = __builtin_amdgcn_update_dpp(0, xi, 0x124, 0xF, 0xF, false);
    else r = __builtin_amdgcn_update_dpp(0, xi, 0x128, 0xF, 0xF, false);
    return __builtin_bit_cast(float, r);
}
__device__ __forceinline__ float rowsum16(float x) { x += dpp_f(x, 0); x += dpp_f(x, 1); x += dpp_f(x, 2); x += dpp_f(x, 3); return x; }
__device__ __forceinline__ float quadsum(float x) { x += dpp_f(x, 0); x += dpp_f(x, 1); return x; }
__device__ __forceinline__ float wave_sum(float v) {
    v = rowsum16(v);
    const int vi = __builtin_bit_cast(int, v);
    const float s0 = __builtin_bit_cast(float, __builtin_amdgcn_readlane(vi, 0)), s1 = __builtin_bit_cast(float, __builtin_amdgcn_readlane(vi, 16));
    const float s2 = __builtin_bit_cast(float, __builtin_amdgcn_readlane(vi, 32)), s3 = __builtin_bit_cast(float, __builtin_amdgcn_readlane(vi, 48));
    return (s0 + s1) + (s2 + s3);
}
namespace pg8 {
#define PG8_LAS __attribute__((address_space(3)))
typedef unsigned short bf16_t;
typedef unsigned u32x4 __attribute__((ext_vector_type(4)));
constexpr int BM = 256, BK = 64, HALF = 128, HTB = HALF * BK * 2, STAGE_BYTES = 8 * HTB, NXCD = 8, WGM = 8;

__host__ __device__ __forceinline__ int lds_byte(int r, int c) { const int st = (r >> 4) * 2 + (c >> 5), rr = r & 15, cc = c & 31, ob = rr * 64 + cc * 2; return st * 1024 + (ob ^ (((ob >> 9) & 1) << 5)); }
__host__ __device__ __forceinline__ void stage_rc(int b, int& R, int& C) { const int st = b / 1024, sb = b % 1024, swz = sb ^ (((sb >> 9) & 1) << 5); R = (st >> 1) * 16 + swz / 64; C = (st & 1) * 32 + (swz % 64) / 2; }
__host__ __device__ __forceinline__ int perm32(int rho) { const int n = rho >> 4, i = rho & 15; return 8 * (i >> 2) + 4 * n + (i & 3); }

struct Unit { int pm, pn, aux; };

struct Tiler {
    int nM, nN, nwg, G, c;
    __device__ __forceinline__ void init(int nM_, int nN_, int G_, int c_) { nM = nM_; nN = nN_; nwg = nM * nN; G = G_; c = c_; }
    __device__ __forceinline__ bool map(int i, int& pm, int& pn) const {
        const long L = (long)i * G + c; if (L >= nwg) return false;
        int wgid = (int)L; { const int q = nwg / NXCD, r = nwg % NXCD, xcd = wgid % NXCD, off = wgid / NXCD; wgid = (xcd < r ? xcd * (q + 1) : r * (q + 1) + (xcd - r) * q) + off; }
        const int nig = WGM * nN, gid = wgid / nig, fm = gid * WGM, gsz = (nM - fm) < WGM ? (nM - fm) : WGM;
        pm = fm + ((wgid % nig) % gsz); pn = (wgid % nig) / gsz; return true;
    }
};
struct SchedPlain {
    Tiler t; unsigned A, B, tsA, tsB;
    __device__ __forceinline__ bool next(int i, Unit& u) const { u.aux = 0; return t.map(i, u.pm, u.pn); }
    __device__ __forceinline__ void bases(const Unit& u, unsigned& a, unsigned& b) const { a = A + (unsigned)u.pm * tsA; b = B + (unsigned)u.pn * tsB; }
};
struct SchedTwo {
    Tiler t; unsigned A0, A1, B0, B1, tsA, tsB;
    __device__ __forceinline__ bool next(int i, Unit& u) const { u.aux = i & 1; return t.map(i >> 1, u.pm, u.pn); }
    __device__ __forceinline__ void bases(const Unit& u, unsigned& a, unsigned& b) const { a = (u.aux ? A1 : A0) + (unsigned)u.pm * tsA; b = (u.aux ? B1 : B0) + (unsigned)u.pn * tsB; }
};
struct SchedMoe {
    Tiler t; unsigned A, B, tsA, tsB, es; const PG8_LAS int* pad_end;
    __device__ __forceinline__ bool next(int i, Unit& u) const {
        if (!t.map(i, u.pm, u.pn)) return false;
        const int row0 = u.pm * BM; int e = 0;
#pragma unroll
        for (int j = 0; j < 32; ++j) e += (pad_end[j] <= row0) ? 1 : 0;
        u.aux = __builtin_amdgcn_readfirstlane(e < 31 ? e : 31); return true;
    }
    __device__ __forceinline__ void bases(const Unit& u, unsigned& a, unsigned& b) const { a = A + (unsigned)u.pm * tsA; b = B + (unsigned)u.aux * es + (unsigned)u.pn * tsB; }
};

typedef float f32x2_t_ __attribute__((ext_vector_type(2)));
typedef __bf16 bf16x2_t_ __attribute__((ext_vector_type(2)));
__device__ __forceinline__ unsigned cvt_pk_bf16(float lo, float hi) { const f32x2_t_ v = {lo, hi}; const bf16x2_t_ b = __builtin_convertvector(v, bf16x2_t_); return __builtin_bit_cast(unsigned, b); }
__device__ __forceinline__ u32x4 pack8(const f32x4& v0, const f32x4& v1) { u32x4 w; w.x = cvt_pk_bf16(v0[0], v0[1]); w.y = cvt_pk_bf16(v0[2], v0[3]); w.z = cvt_pk_bf16(v1[0], v1[1]); w.w = cvt_pk_bf16(v1[2], v1[3]); return w; }

typedef int i32x8 __attribute__((ext_vector_type(8)));
typedef int i32x4 __attribute__((ext_vector_type(4)));
__device__ __forceinline__ i32x8 cat8(const bf16x8& a, const bf16x8& b) { return __builtin_shufflevector(__builtin_bit_cast(i32x4, a), __builtin_bit_cast(i32x4, b), 0, 1, 2, 3, 4, 5, 6, 7); }
constexpr int F8_SCALES = 0x00007f79;
template <class Epi, class Sched, bool ALIGN_EPI, bool F8 = false, int F8SC = F8_SCALES>
__device__ __forceinline__ void gemm_phase(PG8_LAS unsigned char* lds, const __amdgpu_buffer_rsrc_t rsrc, const int lda, const int ldb, const int K, const Sched& S, const Epi& E) {
    int tid_ = threadIdx.x; asm volatile("" : "+v"(tid_));
    const int tid = tid_, wid = __builtin_amdgcn_readfirstlane(tid >> 6), lane = tid & 63, wr = wid >> 2, wc = wid & 3, fr = lane & 15, fq = lane >> 4;
    const int nt = K / BK;
    unsigned voffA, voffB;
    { int R, C; stage_rc(tid * 16, R, C); const int Rb = (R & ~31) + perm32(R & 31); voffA = (unsigned)(R * lda + C) * 2u; voffB = (unsigned)(Rb * ldb + C) * 2u; }
    const unsigned p1voffA = 64u * (unsigned)lda * 2u, p1voffB = 64u * (unsigned)ldb * 2u;
    const unsigned kstep = (unsigned)(BK * 2);
    const unsigned hsA = (unsigned)HALF * lda * 2, hsB = (unsigned)HALF * ldb * 2;
    const unsigned ldsw = (unsigned)wid * 1024u;
    const int aoff = lds_byte(wr * 64 + fr, fq * 8), boff = lds_byte(wc * 32 + fr, fq * 8);
#define PG8_SA(b, h) (((b) * 2 + (h)) * HTB)
#define PG8_SB(b, h) ((4 + (b) * 2 + (h)) * HTB)
#define PG8_STAGE(bufoff, goff, voff) do { _Pragma("unroll") for (int _i = 0; _i < 2; ++_i) \
        __builtin_amdgcn_raw_ptr_buffer_load_lds(rsrc, (PG8_LAS void*)(lds + (bufoff) + ldsw + _i * 8192), 16, (int)(voff), (int)((goff) + _i * p1##voff), 0, 0); } while (0)
#define PG8_LD8(addr) __builtin_shufflevector(*(const PG8_LAS i32x4*)(addr), *(const PG8_LAS i32x4*)((addr) + 1024), 0, 1, 2, 3, 4, 5, 6, 7)
#define PG8_LDA(dst, b, h) do { _Pragma("unroll") for (int m = 0; m < 4; ++m) dst[m] = PG8_LD8(lds + PG8_SA(b, h) + aoff + m * 2048); } while (0)
#define PG8_LDB(dst, b, h) do { _Pragma("unroll") for (int n = 0; n < 2; ++n) dst[n] = PG8_LD8(lds + PG8_SB(b, h) + boff + n * 2048); } while (0)
#define PG8_LO(v) __builtin_bit_cast(bf16x8, __builtin_shufflevector(v, v, 0, 1, 2, 3))
#define PG8_HI(v) __builtin_bit_cast(bf16x8, __builtin_shufflevector(v, v, 4, 5, 6, 7))
#define PG8_MMA(ai, bj, At, Bt) do { __builtin_amdgcn_s_setprio(1); \
        if constexpr (!F8) { _Pragma("unroll") for (int m = 0; m < 4; ++m) _Pragma("unroll") for (int n = 0; n < 2; ++n) { \
            acc[ai][bj][m][n] = __builtin_amdgcn_mfma_f32_16x16x32_bf16(PG8_LO(Bt[n]), PG8_LO(At[m]), acc[ai][bj][m][n], 0, 0, 0); \
            acc[ai][bj][m][n] = __builtin_amdgcn_mfma_f32_16x16x32_bf16(PG8_HI(Bt[n]), PG8_HI(At[m]), acc[ai][bj][m][n], 0, 0, 0); } } \
        else { _Pragma("unroll") for (int m = 0; m < 4; ++m) _Pragma("unroll") for (int n = 0; n < 2; ++n) \
            acc[ai][bj][m][n] = __builtin_amdgcn_mfma_scale_f32_16x16x128_f8f6f4(Bt[n], At[m], acc[ai][bj][m][n], 0, 0, 0, F8SC, 1, F8SC); } \
        __builtin_amdgcn_s_setprio(0); } while (0)
#define PG8_WAIT_V(n) asm volatile("s_waitcnt vmcnt(" #n ")" ::: "memory")
#define PG8_WAIT_L(n) asm volatile("s_waitcnt lgkmcnt(" #n ")" ::: "memory")
#define PG8_BAR __builtin_amdgcn_s_barrier()
#define PG8_SCHED __builtin_amdgcn_sched_barrier(0)
#define PG8_ZERO() do { _Pragma("unroll") for (int a = 0; a < 2; ++a) _Pragma("unroll") for (int b = 0; b < 2; ++b) _Pragma("unroll") for (int m = 0; m < 4; ++m) _Pragma("unroll") for (int n = 0; n < 2; ++n) acc[a][b][m][n] = (f32x4){0.f, 0.f, 0.f, 0.f}; } while (0)
    Unit cur, nxt; int ui = 0;
    if (!S.next(0, cur)) return;
    f32x4 acc[2][2][4][2];
    PG8_ZERO();
    i32x8 At[4], B0[2], B1[2];
    unsigned cA, cB; S.bases(cur, cA, cB); cA = __builtin_amdgcn_readfirstlane(cA); cB = __builtin_amdgcn_readfirstlane(cB);
    PG8_STAGE(PG8_SB(0, 0), cB, voffB); PG8_STAGE(PG8_SB(0, 1), cB + hsB, voffB); PG8_STAGE(PG8_SA(0, 0), cA, voffA); PG8_STAGE(PG8_SA(0, 1), cA + hsA, voffA);
    if (wr == 1) PG8_BAR;
    PG8_WAIT_V(2); PG8_BAR;
    PG8_STAGE(PG8_SB(1, 0), cB + kstep, voffB); PG8_STAGE(PG8_SA(1, 0), cA + kstep, voffA); PG8_STAGE(PG8_SB(1, 1), cB + hsB + kstep, voffB);
    PG8_WAIT_V(6); PG8_BAR;
    for (;;) {
        const bool has_next = S.next(ui + 1, nxt);
        unsigned nA = cA, nB = cB; if (has_next) { S.bases(nxt, nA, nB); nA = __builtin_amdgcn_readfirstlane(nA); nB = __builtin_amdgcn_readfirstlane(nB); }
#pragma unroll 1
        for (int t = 0; t < nt; t += 2) {
            const bool last = (t == nt - 2);
            const unsigned a1 = cA + (unsigned)(t + 1) * kstep;
            const unsigned a2 = last ? nA : cA + (unsigned)(t + 2) * kstep, b2 = last ? nB : cB + (unsigned)(t + 2) * kstep;
            const unsigned a3 = a2 + kstep, b3 = b2 + kstep;
            PG8_LDB(B0, 0, 0); PG8_LDB(B1, 0, 1); PG8_SCHED; PG8_LDA(At, 0, 0); PG8_STAGE(PG8_SA(1, 1), a1 + hsA, voffA);
            PG8_WAIT_V(8); PG8_WAIT_L(0); PG8_BAR; PG8_MMA(0, 0, At, B0); PG8_MMA(0, 1, At, B1); PG8_BAR; PG8_SCHED;
            PG8_LDA(At, 0, 1); PG8_STAGE(PG8_SB(0, 0), b2, voffB); PG8_STAGE(PG8_SB(0, 1), b2 + hsB, voffB); PG8_STAGE(PG8_SA(0, 0), a2, voffA);
            PG8_WAIT_V(8); PG8_WAIT_L(0); PG8_BAR; PG8_MMA(1, 0, At, B0); PG8_MMA(1, 1, At, B1); PG8_BAR; PG8_SCHED;
            PG8_LDB(B0, 1, 0); PG8_LDB(B1, 1, 1); PG8_SCHED; PG8_LDA(At, 1, 0); PG8_STAGE(PG8_SA(0, 1), a2 + hsA, voffA);
            PG8_WAIT_V(8); PG8_WAIT_L(0); PG8_BAR; PG8_MMA(0, 0, At, B0); PG8_MMA(0, 1, At, B1); PG8_BAR; PG8_SCHED;
            PG8_LDA(At, 1, 1); PG8_STAGE(PG8_SB(1, 0), b3, voffB); PG8_STAGE(PG8_SB(1, 1), b3 + hsB, voffB); PG8_STAGE(PG8_SA(1, 0), a3, voffA);
            PG8_WAIT_V(8); PG8_WAIT_L(0); PG8_BAR; PG8_MMA(1, 0, At, B0); PG8_MMA(1, 1, At, B1); PG8_BAR; PG8_SCHED;
        }
        if constexpr (ALIGN_EPI) { if (wr == 0) PG8_BAR; }
        bool keep; { int t2 = threadIdx.x; asm volatile("" : "+v"(t2)); const int w2 = __builtin_amdgcn_readfirstlane(t2 >> 6), l2 = t2 & 63; keep = E(acc, cur, w2 >> 2, w2 & 3, l2 & 15, l2 >> 4); }
        if (!has_next) break;
        if (!keep) PG8_ZERO();
        cur = nxt; cA = nA; cB = nB; ++ui;
        if constexpr (ALIGN_EPI) { if (wr == 1) PG8_BAR; }
    }
    PG8_WAIT_V(0);
    if constexpr (!ALIGN_EPI) { if (wr == 0) PG8_BAR; }
    PG8_BAR;
#undef PG8_SA
#undef PG8_SB
#undef PG8_STAGE
#undef PG8_LDA
#undef PG8_LDB
#undef PG8_LD8
#undef PG8_LO
#undef PG8_HI
#undef PG8_MMA
#undef PG8_WAIT_V
#undef PG8_WAIT_L
#undef PG8_BAR
#undef PG8_SCHED
#undef PG8_ZERO
}
}
namespace pg8 {
#define EPI_ROWLOOP _Pragma("unroll") for (int ai = 0; ai < 2; ++ai) _Pragma("unroll") for (int m = 0; m < 4; ++m)
struct EpiProj {
    bf16_t* O; int coloff, nq;
    __device__ __forceinline__ bool operator()(f32x4 (&acc)[2][2][4][2], const Unit& u, int wr, int wc, int fr, int fq) const {
        const int row0 = u.pm * BM + wr * 64 + fr, col0 = coloff + u.pn * BM + wc * 32 + 8 * fq;
        const float sc = (u.pn < nq) ? 0.125f : 1.0f;
        EPI_ROWLOOP { bf16_t* rowp = O + (size_t)(row0 + ai * HALF + m * 16) * PROJ_LD + col0;
#pragma unroll
            for (int bj = 0; bj < 2; ++bj) *(u32x4*)(rowp + bj * HALF) = pack8(acc[ai][bj][m][0] * sc, acc[ai][bj][m][1] * sc); }
        return false;
    }
};
struct EpiGate {
    bf16_t* O;
    __device__ __forceinline__ bool operator()(f32x4 (&acc)[2][2][4][2], const Unit& u, int wr, int wc, int fr, int fq) const {
        const int row0 = u.pm * BM + wr * 64 + fr, d0 = u.pn * HALF + wc * 32 + 8 * fq;
        EPI_ROWLOOP { bf16_t* rowp = O + (size_t)(row0 + ai * HALF + m * 16) * PROJ_LD + d0;
            f32x4 rt[2], gb[2];
#pragma unroll
            for (int n = 0; n < 2; ++n)
#pragma unroll
                for (int j = 0; j < 4; ++j) { const float ea = __expf(-acc[ai][0][m][n][j]), eb = fminf(__expf(-acc[ai][1][m][n][j]), 1e30f);
                    gb[n][j] = __builtin_amdgcn_rcpf(1.0f + eb); rt[n][j] = (1.0f + eb) * __builtin_amdgcn_rcpf(1.0f + ea); }
            *(u32x4*)(rowp + PJ_GA) = pack8(rt[0], rt[1]); *(u32x4*)(rowp + PJ_GB) = pack8(gb[0], gb[1]); }
        return false;
    }
};
struct EpiBf16 {
    bf16_t* O; int ldc;
    __device__ __forceinline__ bool operator()(f32x4 (&acc)[2][2][4][2], const Unit& u, int wr, int wc, int fr, int fq) const {
        const int row0 = u.pm * BM + wr * 64 + fr, col0 = u.pn * BM + wc * 32 + 8 * fq;
        EPI_ROWLOOP { bf16_t* rowp = O + (size_t)(row0 + ai * HALF + m * 16) * ldc + col0;
#pragma unroll
            for (int bj = 0; bj < 2; ++bj) *(u32x4*)(rowp + bj * HALF) = pack8(acc[ai][bj][m][0], acc[ai][bj][m][1]); }
        return false;
    }
};
template <bool ISDEC> struct EpiLoraA {
    float* OUT; const float* par;
    __device__ __forceinline__ bool operator()(f32x4 (&acc)[2][2][4][2], const Unit& u, int wr, int wc, int fr, int fq) const {
        const int row0 = u.pm * BM + wr * 64 + fr, col0 = u.pn * BM + wc * 32 + 8 * fq;
        f32x4 pv[2][2];
#pragma unroll
        for (int bj = 0; bj < 2; ++bj)
#pragma unroll
            for (int n = 0; n < 2; ++n) pv[bj][n] = *(const f32x4*)(par + col0 + bj * HALF + 4 * n);
        EPI_ROWLOOP { float* rowp = OUT + (size_t)(row0 + ai * HALF + m * 16) * RW + col0;
#pragma unroll
            for (int bj = 0; bj < 2; ++bj)
#pragma unroll
                for (int n = 0; n < 2; ++n) { f32x4 v = acc[ai][bj][m][n] + pv[bj][n];
#pragma unroll
                    for (int j = 0; j < 4; ++j) {
                        if (ISDEC) v[j] = -0.60653065971263342f * fsigmoid(v[j]);
                        else v[j] = fsigmoid(v[j]); }
                    *(f32x4*)(rowp + bj * HALF + 4 * n) = v; } }
        return false;
    }
};
struct EpiIclr {
    bf16_t* OUT; const float* par;
    __device__ __forceinline__ bool operator()(f32x4 (&acc)[2][2][4][2], const Unit& u, int wr, int wc, int fr, int fq) const {
        const int row0 = u.pm * BM + wr * 64 + fr, col0 = u.pn * BM + wc * 32 + 8 * fq;
        f32x4 pv[2][2];
#pragma unroll
        for (int bj = 0; bj < 2; ++bj)
#pragma unroll
            for (int n = 0; n < 2; ++n) pv[bj][n] = *(const f32x4*)(par + col0 + bj * HALF + 4 * n);
        EPI_ROWLOOP { bf16_t* rowp = OUT + (size_t)(row0 + ai * HALF + m * 16) * RW + col0;
#pragma unroll
            for (int bj = 0; bj < 2; ++bj) { f32x4 v0 = acc[ai][bj][m][0] + pv[bj][0], v1 = acc[ai][bj][m][1] + pv[bj][1];
#pragma unroll
                for (int j = 0; j < 4; ++j) { v0[j] = fsigmoid(v0[j]); v1[j] = fsigmoid(v1[j]); }
                *(u32x4*)(rowp + bj * HALF) = pack8(v0, v1); } }
        return false;
    }
};
struct EpiMerged {
    const bf16_t* PROJ; bf16_t* O;
    __device__ __forceinline__ bool operator()(f32x4 (&acc)[2][2][4][2], const Unit& u, int wr, int wc, int fr, int fq) const {
        const int row0 = u.pm * BM + wr * 64 + fr, col0 = u.pn * BM + wc * 32 + 8 * fq;
        EPI_ROWLOOP { const int row = row0 + ai * HALF + m * 16; const bf16_t* gp = PROJ + (size_t)row * PROJ_LD + col0;
#pragma unroll
            for (int bj = 0; bj < 2; ++bj) {
                if (u.aux == 0) {
                    const u32x4 ga = *(const u32x4*)(gp + PJ_GA + bj * HALF);
                    const f32x4 a0 = (f32x4){bflo(ga.x), bfhi(ga.x), bflo(ga.y), bfhi(ga.y)}, a1 = (f32x4){bflo(ga.z), bfhi(ga.z), bflo(ga.w), bfhi(ga.w)};
                    acc[ai][bj][m][0] = acc[ai][bj][m][0] * a0; acc[ai][bj][m][1] = acc[ai][bj][m][1] * a1;
                } else {
                    const u32x4 gb = *(const u32x4*)(gp + PJ_GB + bj * HALF);
                    const f32x4 b0 = (f32x4){bflo(gb.x), bfhi(gb.x), bflo(gb.y), bfhi(gb.y)}, b1 = (f32x4){bflo(gb.z), bfhi(gb.z), bflo(gb.w), bfhi(gb.w)};
                    { const f32x4 o0 = acc[ai][bj][m][0] * b0 * ACT8_SCALE, o1 = acc[ai][bj][m][1] * b1 * ACT8_SCALE;
                      int w0 = __builtin_amdgcn_cvt_pk_fp8_f32(o0[0], o0[1], 0, false); w0 = __builtin_amdgcn_cvt_pk_fp8_f32(o0[2], o0[3], w0, true);
                      int w1 = __builtin_amdgcn_cvt_pk_fp8_f32(o1[0], o1[1], 0, false); w1 = __builtin_amdgcn_cvt_pk_fp8_f32(o1[2], o1[3], w1, true);
                      *(v2u*)((unsigned char*)O + (size_t)row * D + col0 + bj * HALF) = (v2u){(unsigned)w0, (unsigned)w1}; }
                } } }
        return u.aux == 0;
    }
};
struct EpiZ {
    const float* X; float* Z;
    __device__ __forceinline__ bool operator()(f32x4 (&acc)[2][2][4][2], const Unit& u, int wr, int wc, int fr, int fq) const {
        const int row0 = u.pm * BM + wr * 64 + fr, col0 = u.pn * BM + wc * 32 + 8 * fq;
        EPI_ROWLOOP { const size_t off = (size_t)(row0 + ai * HALF + m * 16) * D + col0;
#pragma unroll
            for (int bj = 0; bj < 2; ++bj)
#pragma unroll
                for (int n = 0; n < 2; ++n) { const f32x4 xv = *(const f32x4*)(X + off + bj * HALF + 4 * n); *(f32x4*)(Z + off + bj * HALF + 4 * n) = xv * DN_ALPHA + acc[ai][bj][m][n]; } }
        return false;
    }
};
struct EpiSwiglu {
    unsigned char* ACT; const float* bgu;
    __device__ __forceinline__ bool operator()(f32x4 (&acc)[2][2][4][2], const Unit& u, int wr, int wc, int fr, int fq) const {
        const int row0 = u.pm * BM + wr * 64 + fr, col0 = u.pn * HALF + wc * 32 + 8 * fq;
        const float* bp = bgu + (size_t)u.aux * (2 * FF) + col0;
        f32x4 bg[2], bu[2];
#pragma unroll
        for (int n = 0; n < 2; ++n) { bg[n] = *(const f32x4*)(bp + 4 * n); bu[n] = *(const f32x4*)(bp + FF + 4 * n); }
        EPI_ROWLOOP { f32x4 o[2];
#pragma unroll
            for (int n = 0; n < 2; ++n) { const f32x4 g = acc[ai][0][m][n] + bg[n], uu = acc[ai][1][m][n] + bu[n];
#pragma unroll
                for (int j = 0; j < 4; j += 2) {
                    f32x2 gc, uc; gc[0] = fminf(g[j], 7.0f); gc[1] = fminf(g[j + 1], 7.0f);
                    uc[0] = __builtin_amdgcn_fmed3f(uu[j], -7.0f, 7.0f); uc[1] = __builtin_amdgcn_fmed3f(uu[j + 1], -7.0f, 7.0f);
                    const f32x2 t = gc * (f32x2){-2.4554669595930156f, -2.4554669595930156f};
                    f32x2 d; d[0] = __builtin_amdgcn_exp2f(t[0]); d[1] = __builtin_amdgcn_exp2f(t[1]);
                    d = d + (f32x2){1.0f, 1.0f};
                    f32x2 r; r[0] = __builtin_amdgcn_rcpf(d[0]); r[1] = __builtin_amdgcn_rcpf(d[1]);
                    const f32x2 s = gc * r, oo = __builtin_elementwise_fma(uc, s, s);
                    o[n][j] = oo[0]; o[n][j + 1] = oo[1]; } }
            int w0 = __builtin_amdgcn_cvt_pk_fp8_f32(o[0][0], o[0][1], 0, false); w0 = __builtin_amdgcn_cvt_pk_fp8_f32(o[0][2], o[0][3], w0, true);
            int w1 = __builtin_amdgcn_cvt_pk_fp8_f32(o[1][0], o[1][1], 0, false); w1 = __builtin_amdgcn_cvt_pk_fp8_f32(o[1][2], o[1][3], w1, true);
            *(v2u*)(ACT + (size_t)(row0 + ai * HALF + m * 16) * FF + col0) = (v2u){(unsigned)w0, (unsigned)w1}; }
        return false;
    }
};
struct EpiDown {
    unsigned char* YS; const float* bdn; const int* rowslot; const float* roww;
    __device__ __forceinline__ bool operator()(f32x4 (&acc)[2][2][4][2], const Unit& u, int wr, int wc, int fr, int fq) const {
        const int row0 = u.pm * BM + wr * 64 + fr, col0 = u.pn * BM + wc * 32 + 8 * fq;
        const float* bp = bdn + (size_t)u.aux * D + col0;
        f32x4 bv[2][2];
#pragma unroll
        for (int bj = 0; bj < 2; ++bj)
#pragma unroll
            for (int n = 0; n < 2; ++n) bv[bj][n] = *(const f32x4*)(bp + bj * HALF + 4 * n);
        int slots[8]; float ws_[8];
#pragma unroll
        for (int q = 0; q < 8; ++q) { const int row = row0 + (q >> 2) * HALF + (q & 3) * 16; slots[q] = rowslot[row]; ws_[q] = roww[row]; }
        EPI_ROWLOOP { const int slot = slots[ai * 4 + m]; const float w = ws_[ai * 4 + m] * YS_SCALE;
            if (slot >= 0) { unsigned char* rowp = YS + (size_t)slot * D + col0;
#pragma unroll
                for (int bj = 0; bj < 2; ++bj) { const f32x4 o0 = (acc[ai][bj][m][0] + bv[bj][0]) * w, o1 = (acc[ai][bj][m][1] + bv[bj][1]) * w;
                    int w0 = __builtin_amdgcn_cvt_pk_fp8_f32(o0[0], o0[1], 0, false); w0 = __builtin_amdgcn_cvt_pk_fp8_f32(o0[2], o0[3], w0, true);
                    int w1 = __builtin_amdgcn_cvt_pk_fp8_f32(o1[0], o1[1], 0, false); w1 = __builtin_amdgcn_cvt_pk_fp8_f32(o1[2], o1[3], w1, true);
                    *(v2u*)(rowp + bj * HALF) = (v2u){(unsigned)w0, (unsigned)w1}; } } }
        return false;
    }
};
#undef EPI_ROWLOOP
}

#define XB_TMO      128
#define XB_XCNT(j)  (256  + 64 * (j))
#define XB_XSUB(j)  (1280 + 64 * (j))
#define XB_XGEN(j)  (2304 + 64 * (j))
#define XB_TOP      3328
#define XB_TOPGEN   3392
#define XCD_BAR_WORDS 3456
#define XB_SPIN_CAP (1u << 18)

__device__ __forceinline__ unsigned xb_ld(unsigned* p)              { return __hip_atomic_load(p, __ATOMIC_RELAXED, __HIP_MEMORY_SCOPE_AGENT); }
__device__ __forceinline__ unsigned xb_add(unsigned* p, unsigned v) { return __hip_atomic_fetch_add(p, v, __ATOMIC_RELAXED, __HIP_MEMORY_SCOPE_AGENT); }
__device__ __forceinline__ unsigned xb_xcc_id() { return (unsigned)__builtin_amdgcn_s_getreg((3 << 11) | 20) & 0xFu; }
#define XB_SPIN(cond, bar) do { unsigned _sp = 0; while (cond) { __builtin_amdgcn_s_sleep(1); \
    if ((++_sp & 255u) == 0u) { if (xb_ld(&(bar)[XB_TMO])) break; if (_sp > XB_SPIN_CAP) { atomicAdd(&(bar)[XB_TMO], 1u); break; } } } } while (0)

struct XcdBarrier {
    unsigned* bar; unsigned x;
    volatile LAS unsigned* st;
};

__device__ __forceinline__ XcdBarrier xcd_barrier_post(unsigned* bar, volatile LAS unsigned* st) {
    XcdBarrier b; b.bar = bar; b.x = xb_xcc_id(); b.st = st;
    if (threadIdx.x == 0) (void)xb_add(&bar[XB_XCNT(b.x)], 1u);
    return b;
}
__device__ __forceinline__ void xcd_barrier_complete(unsigned* bar, unsigned x, unsigned& nloc, unsigned& nx) {
    const unsigned G = gridDim.x * gridDim.y * gridDim.z;
    unsigned sum, cnt, mine, sp = 0u;
    for (;;) {
        sum = 0u; cnt = 0u; mine = 0u;
#pragma unroll
        for (unsigned j = 0; j < 16; ++j) { const unsigned c = xb_ld(&bar[XB_XCNT(j)]); sum += c; cnt += (c > 0u) ? 1u : 0u; mine = (j == x) ? c : mine; }
        if (sum == G) break;
        __builtin_amdgcn_s_sleep(1);
        if ((++sp & 255u) == 0u) { if (xb_ld(&bar[XB_TMO])) break; if (sp > XB_SPIN_CAP) { atomicAdd(&bar[XB_TMO], 1u); break; } }
    }
    nloc = mine > 0u ? mine : 1u; nx = cnt > 0u ? cnt : 1u;
}

__device__ __forceinline__ void xcd_barrier(const XcdBarrier& b) {
    asm volatile("s_waitcnt vmcnt(0)" ::: "memory");
    __syncthreads();
    if (threadIdx.x == 0) {
        unsigned* bar = b.bar;
        __builtin_amdgcn_s_waitcnt(0);
        unsigned nloc = b.st[0], nx = b.st[1];
        if (nloc == 0u) { xcd_barrier_complete(bar, b.x, nloc, nx); b.st[0] = nloc; b.st[1] = nx; }
        const unsigned old = xb_add(&bar[XB_XSUB(b.x)], 1u);
        const unsigned gen = old / nloc;
        if (old + 1u == (gen + 1u) * nloc) {
            __builtin_amdgcn_fence(__ATOMIC_RELEASE, "agent");
            asm volatile("s_waitcnt vmcnt(0)" ::: "memory");
            const unsigned og = xb_add(&bar[XB_TOP], 1u);
            const unsigned tg = og / nx;
            if (og + 1u == (tg + 1u) * nx) xb_add(&bar[XB_TOPGEN], 1u);
            else XB_SPIN(xb_ld(&bar[XB_TOPGEN]) == tg, bar);
            __builtin_amdgcn_fence(__ATOMIC_ACQUIRE, "agent");
            xb_add(&bar[XB_XGEN(b.x)], 1u);
            asm volatile("s_waitcnt vmcnt(0)" ::: "memory");
        } else {
            XB_SPIN(xb_ld(&bar[XB_XGEN(b.x)]) == gen, bar);
            __builtin_amdgcn_fence(__ATOMIC_ACQUIRE, "agent");
            asm volatile("s_waitcnt vmcnt(0)" ::: "memory");
        }
    }
    __syncthreads();
}
struct Frame {
    LAS unsigned char* lds;
    volatile LAS unsigned* MISC;
    gu32* ctl;
    int tid, lane, wave;
    int vcu, G;
    unsigned char* ws;
    __amdgpu_buffer_rsrc_t rsrc;
};

#define PHASE_FRAME(F0) Frame F = (F0); { int t_ = threadIdx.x; asm volatile("" : "+v"(t_)); F.tid = t_; F.lane = t_ & 63; F.wave = __builtin_amdgcn_readfirstlane(t_ >> 6); }

__device__ __forceinline__ void tr_item(const float* W, size_t ldw, int k0, int c0, bf16* WT, size_t ldt, int drow0, LAS float* scr, int lane) {
    const int kr = lane >> 4, cq = lane & 15;
    f32x4 v[16];
#pragma unroll
    for (int i = 0; i < 16; ++i) v[i] = *(const GAS f32x4*)(W + (size_t)(k0 + 4 * i + kr) * ldw + c0 + 4 * cq);
#pragma unroll
    for (int i = 0; i < 16; ++i)
#pragma unroll
        for (int j = 0; j < 4; ++j) scr[(4 * cq + j) * 65 + 4 * i + kr] = v[i][j];
    LDS_WAIT(); asm volatile("" ::: "memory");
    const int c = lane & 7;
#pragma unroll
    for (int jj = 0; jj < 8; ++jj) { const int n = (lane >> 3) + 8 * jj; const LAS float* s = scr + n * 65 + 8 * c;
        v4u o; o.x = pk2(s[0], s[1]); o.y = pk2(s[2], s[3]); o.z = pk2(s[4], s[5]); o.w = pk2(s[6], s[7]);
        *(GAS v4u*)(WT + (size_t)(drow0 + n) * ldt + k0 + 8 * c) = o; }
    LDS_WAIT(); asm volatile("" ::: "memory");
}

typedef short s16x2 __attribute__((ext_vector_type(2)));
struct MoeItem { __amdgpu_buffer_rsrc_t rs; unsigned soff, rstep; int ldw, k0; unsigned char* WT; size_t ldt; int drow; };
__device__ __forceinline__ void tr8_load(const MoeItem& m, f32x4 (&v)[16], int lane) {
    const int kr = lane >> 4, cq = lane & 15;
    const int voff = (kr * m.ldw + 4 * cq) * 4;
#pragma unroll
    for (int i = 0; i < 16; ++i) v[i] = __builtin_bit_cast(f32x4, __builtin_amdgcn_raw_buffer_load_b128(m.rs, voff, (int)(m.soff + (unsigned)i * m.rstep), 0));
}
__device__ __forceinline__ void tr8_finish(const f32x4 (&v)[16], const MoeItem& m, LAS float* scr_, int lane) {
    LAS unsigned char* scr = (LAS unsigned char*)scr_;
    const int kr = lane >> 4, cq = lane & 15;
#pragma unroll
    for (int j = 0; j < 4; ++j) { unsigned w[4];
#pragma unroll
        for (int q = 0; q < 4; ++q) { s16x2 t = {0, 0};
            t = __builtin_amdgcn_cvt_scalef32_pk_fp8_f32(t, v[4 * q][j], v[4 * q + 1][j], F8_CVT_SCALE, false);
            t = __builtin_amdgcn_cvt_scalef32_pk_fp8_f32(t, v[4 * q + 2][j], v[4 * q + 3][j], F8_CVT_SCALE, true);
            w[q] = __builtin_bit_cast(unsigned, t); }
        *(LAS v4u*)(scr + (4 * cq + j) * 80 + kr * 16) = (v4u){w[0], w[1], w[2], w[3]}; }
    LDS_WAIT(); asm volatile("" ::: "memory");
    const int qd = lane & 3;
#pragma unroll
    for (int ps = 0; ps < 4; ++ps) { const int n = (lane >> 2) + 16 * ps; const LAS unsigned char* s = scr + n * 80 + qd * 4;
        const unsigned d0 = *(const LAS unsigned*)(s), d1 = *(const LAS unsigned*)(s + 16), d2 = *(const LAS unsigned*)(s + 32), d3 = *(const LAS unsigned*)(s + 48);
        const unsigned t0 = __builtin_amdgcn_perm(d1, d0, 0x05010400u), t1 = __builtin_amdgcn_perm(d1, d0, 0x07030602u), t2 = __builtin_amdgcn_perm(d3, d2, 0x05010400u), t3 = __builtin_amdgcn_perm(d3, d2, 0x07030602u);
        const v4u o = (v4u){__builtin_amdgcn_perm(t2, t0, 0x05040100u), __builtin_amdgcn_perm(t2, t0, 0x07060302u), __builtin_amdgcn_perm(t3, t1, 0x05040100u), __builtin_amdgcn_perm(t3, t1, 0x07060302u)};
        *(GAS v4u*)(m.WT + (size_t)(m.drow + n) * m.ldt + m.k0 + 16 * qd) = o; }
    LDS_WAIT(); asm volatile("" ::: "memory");
}
constexpr int MOE_J4 = 32 * 32 * 64, MOE_J5 = 32 * 32 * 32, MOE_NITEMS = MOE_J4 + MOE_J5;
__device__ __forceinline__ MoeItem moe_item(int r, const float* w_gu, const float* w_down, unsigned char* ws) {
    MoeItem m;
    if (r < MOE_J4) { const int e = r / 2048, q = r % 2048, kb = q / 64, cb = q % 64, c0 = cb * 64; const int cc = c0 & 2047;
        m.rs = __builtin_amdgcn_make_buffer_rsrc((void*)w_gu, 0, 0xffffffff, 0x00020000); m.ldw = 2 * FF; m.k0 = kb * 64;
        m.soff = (unsigned)(((size_t)e * D * 2 * FF + (size_t)kb * 64 * (2 * FF) + c0) * 4); m.rstep = 4u * (2 * FF) * 4u;
        m.WT = ws + WS_WGUT + (size_t)e * 2 * FF * D; m.ldt = D; m.drow = (cc >> 7) * 256 + (c0 >= 2048 ? 128 : 0) + (cc & 127); }
    else { r -= MOE_J4; const int e = r / 1024, q = r % 1024, kb = q / 32, cb = q % 32;
        m.rs = __builtin_amdgcn_make_buffer_rsrc((void*)w_down, 0, 0xffffffff, 0x00020000); m.ldw = D; m.k0 = kb * 64;
        m.soff = (unsigned)(((size_t)e * FF * D + (size_t)kb * 64 * D + cb * 64) * 4); m.rstep = 4u * D * 4u;
        m.WT = ws + WS_WDNT + (size_t)e * D * FF; m.ldt = FF; m.drow = cb * 64; }
    return m;
}
__device__ __forceinline__ MoeItem f8_item(const float* W, int ldw, int k0, int c0, unsigned char* WT, size_t ldt, int drow) {
    MoeItem m; m.rs = __builtin_amdgcn_make_buffer_rsrc((void*)W, 0, 0xffffffff, 0x00020000); m.ldw = ldw; m.k0 = k0;
    m.soff = (unsigned)(((size_t)k0 * ldw + c0) * 4); m.rstep = 4u * (unsigned)ldw * 4u; m.WT = WT; m.ldt = ldt; m.drow = drow; return m;
}

struct In {
    const float *x, *w_in, *rel_bias, *shift_mu, *w0, *w_up, *a0, *a_up, *g_up, *k_k, *k_a, *r_k, *lnx_w, *lnx_b, *proj_a, *proj_b, *w_out,
                *ln1_w, *ln1_b, *w_router, *b_router, *w_gu, *b_gu, *w_down, *b_down, *ln2_w, *ln2_b;
};

__device__ __forceinline__ void p0_prologue(Frame& F0, const In& I) {
    PHASE_FRAME(F0);
    LAS float* scr = (LAS float*)(F.lds + F.wave * 16640);
    const int gw = F.vcu * NWAVES + F.wave, NGW = F.G * NWAVES;
    unsigned char* ws = F.ws;
    constexpr int J0 = 32 * 167, J1 = 16 * 32, J2 = 16 * 32, J3 = 32 * 32;
    constexpr int NITEMS = J0 + J1 + J2 + J3;
    for (int it = gw; it < NITEMS; it += NGW) {
        int r = it;
        if (r < J0) { const int kb = r / 167, cb = r % 167, c0 = cb * 64; bf16* dst; int drow;
            if (c0 < 3072) { f32x4 tv[16];
                   const MoeItem m = (c0 < 2048) ? f8_item(I.w_in, D_IN, kb * 64, c0, (unsigned char*)(ws + WS_WQK8), D, c0) : f8_item(I.w_in, D_IN, kb * 64, c0, (unsigned char*)(ws + WS_WV8), D, c0 - 2048);
                   tr8_load(m, tv, F.lane); tr8_finish(tv, m, scr, F.lane); continue; }
            else if (c0 < 6592) { f32x4 tv[16]; const MoeItem m = f8_item(I.w_in, D_IN, kb * 64, c0, (unsigned char*)(ws + WS_WSV8), D, c0 - 3072);
                   tr8_load(m, tv, F.lane); tr8_finish(tv, m, scr, F.lane); continue; }
            else { f32x4 tv[16]; const int cg = c0 - 6592, d0 = cg & 2047; const MoeItem m = f8_item(I.w_in, D_IN, kb * 64, c0, (unsigned char*)(ws + WS_WG8), D, (d0 >> 7) * 256 + (cg >= 2048 ? 128 : 0) + (d0 & 127));
                   tr8_load(m, tv, F.lane); tr8_finish(tv, m, scr, F.lane); continue; }
            (void)dst; (void)drow; continue; } r -= J0;
        if (r < J1) { const int kb = r / 32, cb = r % 32; f32x4 tv[16]; const MoeItem m = f8_item(I.proj_a, D, kb * 64, cb * 64, (unsigned char*)(ws + WS_PAT), AW, cb * 64); tr8_load(m, tv, F.lane); tr8_finish(tv, m, scr, F.lane); continue; } r -= J1;
        if (r < J2) { const int kb = r / 32, cb = r % 32; f32x4 tv[16]; const MoeItem m = f8_item(I.proj_b, D, kb * 64, cb * 64, (unsigned char*)(ws + WS_PBT), RW, cb * 64); tr8_load(m, tv, F.lane); tr8_finish(tv, m, scr, F.lane); continue; } r -= J2;
        { const int kb = r / 32, cb = r % 32; f32x4 tv[16]; const MoeItem m = f8_item(I.w_out, D, kb * 64, cb * 64, (unsigned char*)(ws + WS_WOT), D, cb * 64);
          tr8_load(m, tv, F.lane); tr8_finish(tv, m, scr, F.lane); }
    }
    const int gt = F.vcu * (NWAVES * 64) + F.tid, NGT = F.G * NWAVES * 64;
    for (int i = gt; i < 2048 * 256; i += NGT) { const int n = i >> 8, k = i & 255; float v = 0.f;
        if (n < 1024) { if (k < DLORA) v = I.w_up[(size_t)k * RW + n]; }
        else { if (k >= 128 && k < 128 + ALORA) v = I.a_up[(size_t)(k - 128) * RW + (n - 1024)]; }
        ((bf16*)(ws + WS_WLA))[i] = (bf16)f2bf(v); }
    for (int i = gt; i < 1024 * 256; i += NGT) { const int n = i >> 8, k = i & 255; ((bf16*)(ws + WS_WLG))[i] = (bf16)f2bf(I.g_up[(size_t)k * RW + n]); }
    for (int i = gt; i < 64 * D / 16; i += NGT) ((GAS v4u*)((unsigned char*)(ws + WS_WSV8) + (size_t)SHIFT_W * D))[i] = (v4u){0u, 0u, 0u, 0u};
    for (int i = gt; i < RROWS; i += NGT) ((int*)(ws + WS_ROWSLOT))[i] = -1;
    for (size_t i = gt; i < (size_t)T * D / 8; i += NGT) { const f32x4 a = ((const GAS f32x4*)I.x)[2 * i], b = ((const GAS f32x4*)I.x)[2 * i + 1];
        int w0 = __builtin_amdgcn_cvt_pk_fp8_f32(a.x, a.y, 0, false); w0 = __builtin_amdgcn_cvt_pk_fp8_f32(a.z, a.w, w0, true);
        int w1 = __builtin_amdgcn_cvt_pk_fp8_f32(b.x, b.y, 0, false); w1 = __builtin_amdgcn_cvt_pk_fp8_f32(b.z, b.w, w1, true);
        ((GAS v2u*)(ws + WS_XB8))[i] = (v2u){(unsigned)w0, (unsigned)w1}; }
}

constexpr int P8_HS = 0, P8_PITCH = 2052, P8_PART = 131328, P8_LOG = 147712, P8_HIST = 149760;
template <bool SKIP_MIX>
__device__ __forceinline__ void p8_ln_router(Frame& F0, const In& I) {
    PHASE_FRAME(F0);
    LAS float* hs = (LAS float*)(F.lds + P8_HS); LAS float* part = (LAS float*)(F.lds + P8_PART); LAS float* lg = (LAS float*)(F.lds + P8_LOG); LAS int* hist = (LAS int*)(F.lds + P8_HIST);
    const int lane = F.lane, w = F.wave;
    if (F.tid < 32) hist[F.tid] = 0;
    const int kq = lane >> 4, col = lane & 15;
    float ln_w[32], ln_b[32];
#pragma unroll
    for (int j = 0; j < 8; ++j) { const f32x4 a = *(const GAS f32x4*)(I.ln1_w + 4 * lane + 256 * j), b = *(const GAS f32x4*)(I.ln1_b + 4 * lane + 256 * j);
#pragma unroll
        for (int e = 0; e < 4; ++e) { ln_w[4 * j + e] = a[e]; ln_b[4 * j + e] = b[e]; } }
    __syncthreads();
    const float* zsrc = I.x; const bf16* mixb = (const bf16*)(F.ws + WS_Z);
    for (int g = F.vcu; g < T / 16; g += F.G) {
        const int tok0 = g * 16;
        { f32x4 va[8], vb[8];
          const size_t tokA = (size_t)(tok0 + 2 * w), tokB = tokA + 1;
          const GAS f32x4* zra = (const GAS f32x4*)(zsrc + tokA * D) + lane; const GAS f32x4* zrb = (const GAS f32x4*)(zsrc + tokB * D) + lane;
          const GAS v2u* mra = (const GAS v2u*)(mixb + tokA * D) + lane; const GAS v2u* mrb = (const GAS v2u*)(mixb + tokB * D) + lane;
          v2u ma[8], mb[8];
#pragma unroll
          for (int j = 0; j < 8; ++j) { va[j] = zra[64 * j]; vb[j] = zrb[64 * j]; if (!SKIP_MIX) { ma[j] = mra[64 * j]; mb[j] = mrb[64 * j]; } }
#pragma unroll
          for (int j = 0; j < 8; ++j) { va[j] = va[j] * DN_ALPHA; vb[j] = vb[j] * DN_ALPHA;
              if (!SKIP_MIX) { va[j] += (f32x4){bflo(ma[j].x), bfhi(ma[j].x), bflo(ma[j].y), bfhi(ma[j].y)}; vb[j] += (f32x4){bflo(mb[j].x), bfhi(mb[j].x), bflo(mb[j].y), bfhi(mb[j].y)}; } }
#pragma unroll
          for (int tt = 0; tt < 2; ++tt) {
            const int tl = 2 * w + tt; const size_t tok = (size_t)(tok0 + tl);
            f32x4 v[8]; float s = 0.f;
#pragma unroll
            for (int j = 0; j < 8; ++j) { v[j] = tt ? vb[j] : va[j]; s += (v[j].x + v[j].y) + (v[j].z + v[j].w); }
            const float mean = wave_sum(s) * (1.f / D); float s2 = 0.f;
#pragma unroll
            for (int j = 0; j < 8; ++j) { v[j] = v[j] - mean; s2 += (v[j].x * v[j].x + v[j].y * v[j].y) + (v[j].z * v[j].z + v[j].w * v[j].w); }
            const float rstd = 1.f / sqrtf(wave_sum(s2) * (1.f / D) + LN_EPS);
            GAS v2u* h1 = (GAS v2u*)((bf16*)(F.ws + WS_H1) + tok * D) + lane;
            GAS unsigned* h1b = (GAS unsigned*)((unsigned char*)(F.ws + WS_H1B) + tok * D) + lane;
#pragma unroll
            for (int j = 0; j < 8; ++j) { f32x4 h;
#pragma unroll
                for (int e = 0; e < 4; ++e) h[e] = v[j][e] * rstd * ln_w[4 * j + e] + ln_b[4 * j + e];
                h1[64 * j] = (v2u){pg8::cvt_pk_bf16(h.x, h.y), pg8::cvt_pk_bf16(h.z, h.w)}; { int w8 = __builtin_amdgcn_cvt_pk_fp8_f32(h.x, h.y, 0, false); w8 = __builtin_amdgcn_cvt_pk_fp8_f32(h.z, h.w, w8, true); h1b[64 * j] = (unsigned)w8; }
                *(LAS f32x4*)(hs + tl * P8_PITCH + 4 * lane + 256 * j) = h; }
          } }
        __syncthreads();
        f32x4 c0 = (f32x4){0.f, 0.f, 0.f, 0.f}, c1 = c0;
        const LAS float* ap = hs + col * P8_PITCH + 256 * w + 4 * kq;
        const float* bp = I.w_router + (size_t)(256 * w + 4 * kq) * NE + col;
#pragma unroll 4
        for (int kk = 0; kk < 16; ++kk) {
            const f32x4 a = *(const LAS f32x4*)(ap + 16 * kk);
#pragma unroll
            for (int e = 0; e < 4; ++e) {
                const float b0 = bp[(size_t)(16 * kk + e) * NE], b1 = bp[(size_t)(16 * kk + e) * NE + 16];
                c0 = __builtin_amdgcn_mfma_f32_16x16x4f32(a[e], b0, c0, 0, 0, 0);
                c1 = __builtin_amdgcn_mfma_f32_16x16x4f32(a[e], b1, c1, 0, 0, 0);
            }
        }
#pragma unroll
        for (int i = 0; i < 4; ++i) { part[(w * 16 + 4 * kq + i) * 32 + col] = c0[i]; part[(w * 16 + 4 * kq + i) * 32 + 16 + col] = c1[i]; }
        __syncthreads();
        { const int tl = F.tid >> 5, e = F.tid & 31; float s = I.b_router[e];
#pragma unroll
            for (int ww = 0; ww < 8; ++ww) s += part[(ww * 16 + tl) * 32 + e];
            lg[tl * 32 + e] = s; }
        __syncthreads();
        if (F.tid < 16) {
            const int tl = F.tid; float lv[32];
#pragma unroll
            for (int e = 0; e < 32; ++e) lv[e] = lg[tl * 32 + e];
            int ti[4]; float tv[4];
#pragma unroll
            for (int k = 0; k < 4; ++k) { float best = -3.4e38f; int bi = 0;
#pragma unroll
                for (int e = 0; e < 32; ++e) { const bool tk = lv[e] > best; best = tk ? lv[e] : best; bi = tk ? e : bi; }
                ti[k] = bi; tv[k] = best;
#pragma unroll
                for (int e = 0; e < 32; ++e) lv[e] = (e == bi) ? -3.4e38f : lv[e]; }
            float ex[4], sum = 0.f;
#pragma unroll
            for (int k = 0; k < 4; ++k) { ex[k] = __expf(tv[k] - tv[0]); sum += ex[k]; }
            const float inv = 1.f / sum;
            *(GAS v4u*)((int*)(F.ws + WS_TOPI) + (size_t)(tok0 + tl) * 4) = (v4u){(unsigned)ti[0], (unsigned)ti[1], (unsigned)ti[2], (unsigned)ti[3]};
            *(GAS f32x4*)((float*)(F.ws + WS_GATE) + (size_t)(tok0 + tl) * 4) = (f32x4){ex[0] * inv, ex[1] * inv, ex[2] * inv, ex[3] * inv};
#pragma unroll
            for (int k = 0; k < 4; ++k) __hip_atomic_fetch_add(&hist[ti[k]], 1, __ATOMIC_RELAXED, __HIP_MEMORY_SCOPE_WORKGROUP);
        }
        __syncthreads();
    }
    if (F.tid < 32) { const int c = hist[F.tid]; if (c) __hip_atomic_fetch_add(F.ctl + CW_CNT + F.tid, (unsigned)c, RLX_AGENT); }
}

template <bool SKIP_MOE>
__device__ __forceinline__ void p12_final(Frame& F0, const In& I, float* out) {
    PHASE_FRAME(F0);
    const int lane = F.lane; const int gw = F.vcu * NWAVES + F.wave, NGW = F.G * NWAVES;
    float ln_w[32], ln_b[32];
#pragma unroll
    for (int j = 0; j < 8; ++j) { const f32x4 a = *(const GAS f32x4*)(I.ln2_w + 4 * lane + 256 * j), b = *(const GAS f32x4*)(I.ln2_b + 4 * lane + 256 * j);
#pragma unroll
        for (int e = 0; e < 4; ++e) { ln_w[4 * j + e] = a[e]; ln_b[4 * j + e] = b[e]; } }
    for (int tok = gw; tok < T; tok += NGW) {
        const GAS v2u* hr = (const GAS v2u*)((const bf16*)(F.ws + WS_H1) + (size_t)tok * D) + lane;
        f32x4 v[8]; float s = 0.f;
#pragma unroll
        for (int j = 0; j < 8; ++j) { const v2u hh = hr[64 * j]; v[j] = (f32x4){bflo(hh.x), bfhi(hh.x), bflo(hh.y), bfhi(hh.y)} * DN_ALPHA; }
        if (!SKIP_MOE) {
#pragma unroll
            for (int k = 0; k < 4; ++k) { const GAS unsigned* yr = (const GAS unsigned*)((const unsigned char*)(F.ws + WS_YSLOT) + ((size_t)tok * 4 + k) * D) + lane;
#pragma unroll
                for (int j = 0; j < 8; ++j) { const unsigned y = yr[64 * j]; const f32x2 lo = __builtin_amdgcn_cvt_pk_f32_fp8((int)y, false), hi = __builtin_amdgcn_cvt_pk_f32_fp8((int)y, true);
                    v[j].x += lo.x * YS_INV; v[j].y += lo.y * YS_INV; v[j].z += hi.x * YS_INV; v[j].w += hi.y * YS_INV; } }
        }
#pragma unroll
        for (int j = 0; j < 8; ++j) s += (v[j].x + v[j].y) + (v[j].z + v[j].w);
        const float mean = wave_sum(s) * (1.f / D); float s2 = 0.f;
#pragma unroll
        for (int j = 0; j < 8; ++j) { v[j] = v[j] - mean; s2 += (v[j].x * v[j].x + v[j].y * v[j].y) + (v[j].z * v[j].z + v[j].w * v[j].w); }
        const float rstd = 1.f / sqrtf(wave_sum(s2) * (1.f / D) + LN_EPS);
        GAS f32x4* o = (GAS f32x4*)(out + (size_t)tok * D) + lane;
#pragma unroll
        for (int j = 0; j < 8; ++j) { f32x4 h;
#pragma unroll
            for (int e = 0; e < 4; ++e) h[e] = v[j][e] * rstd * ln_w[4 * j + e] + ln_b[4 * j + e];
            o[64 * j] = h; }
    }
}
__device__ __forceinline__ void moe_tables(Frame& F) {
    LAS int* tab = (LAS int*)(F.lds + TAB_OFF);
    if (F.tid == 0) { int run = 0;
        for (int e = 0; e < NE; ++e) { const int c = (int)__hip_atomic_load(F.ctl + CW_CNT + e, RLX_AGENT); const int p = (c + 255) / 256 * 256; tab[32 + e] = run; run += p; tab[e] = run; }
        tab[64] = run / 256; }
    __syncthreads();
}

__device__ __forceinline__ void p9_scatter(Frame& F0, const In& I) {
    PHASE_FRAME(F0);
    moe_tables(F);
    LAS int* tab = (LAS int*)(F.lds + TAB_OFF);
    LAS int* lh = (LAS int*)(F.lds + 0);
    LAS int* lb = (LAS int*)(F.lds + 128);
    LAS int* dst = (LAS int*)(F.lds + 256);
    const int* topi = (const int*)(F.ws + WS_TOPI); const float* gate = (const float*)(F.ws + WS_GATE);
    for (int ch = F.vcu; ch < T / 128; ch += F.G) {
        if (F.tid < 32) lh[F.tid] = 0;
        __syncthreads();
        const int s = ch * 512 + F.tid; const int e = topi[s]; const float gv = gate[s];
        const int rank = __hip_atomic_fetch_add(&lh[e], 1, __ATOMIC_RELAXED, __HIP_MEMORY_SCOPE_WORKGROUP);
        __syncthreads();
        if (F.tid < 32) { const int c = lh[F.tid]; lb[F.tid] = c ? (int)__hip_atomic_fetch_add(F.ctl + CW_CUR + F.tid, (unsigned)c, RLX_AGENT) : 0; }
        __syncthreads();
        const int d = tab[32 + e] + lb[e] + rank;
        ((int*)(F.ws + WS_ROWSLOT))[d] = s; ((float*)(F.ws + WS_ROWW))[d] = gv; dst[F.tid] = d;
        __syncthreads();
#pragma unroll 1
        for (int i0 = F.wave * 64; i0 < F.wave * 64 + 64; i0 += 8) {
            v4u v[8][2]; int dd[8];
#pragma unroll
            for (int q = 0; q < 8; ++q) { const int i = i0 + q; const int tok = ch * 128 + (i >> 2); dd[q] = dst[i];
                const GAS v4u* src = (const GAS v4u*)((const unsigned char*)(F.ws + WS_H1B) + (size_t)tok * D) + F.lane;
                v[q][0] = src[0]; v[q][1] = src[64]; }
#pragma unroll
            for (int q = 0; q < 8; ++q) { GAS v4u* o = (GAS v4u*)((unsigned char*)(F.ws + WS_XG) + (size_t)dd[q] * D) + F.lane; o[0] = v[q][0]; o[64] = v[q][1]; }
        }
        __syncthreads();
    }
}

__device__ __forceinline__ void p10_moe_up(Frame& F0, const In& I) {
    PHASE_FRAME(F0);
    moe_tables(F);
    LAS int* tab = (LAS int*)(F.lds + TAB_OFF);
    pg8::SchedMoe S; S.t.init(tab[64], 16, F.G, (int)blockIdx.x);
    S.A = (unsigned)(WS_XG); S.B = (unsigned)(WS_WGUT); S.tsA = (unsigned)256 * D; S.tsB = (unsigned)256 * D; S.es = (unsigned)2 * FF * D; S.pad_end = tab;
    pg8::EpiSwiglu E{(unsigned char*)(F.ws + WS_ACT), I.b_gu};
    pg8::gemm_phase<pg8::EpiSwiglu, pg8::SchedMoe, true, true>(F.lds + RING_OFF, F.rsrc, D / 2, D / 2, D / 2, S, E);
}
__device__ __forceinline__ void p11_moe_down(Frame& F0, const In& I) {
    PHASE_FRAME(F0);
    moe_tables(F);
    LAS int* tab = (LAS int*)(F.lds + TAB_OFF);
    pg8::SchedMoe S; S.t.init(tab[64], 8, F.G, (int)blockIdx.x);
    S.A = (unsigned)(WS_ACT); S.B = (unsigned)(WS_WDNT); S.tsA = (unsigned)256 * FF; S.tsB = (unsigned)256 * FF; S.es = (unsigned)D * FF; S.pad_end = tab;
    pg8::EpiDown E{(unsigned char*)(F.ws + WS_YSLOT), I.b_down, (const int*)(F.ws + WS_ROWSLOT), (const float*)(F.ws + WS_ROWW)};
    pg8::gemm_phase<pg8::EpiDown, pg8::SchedMoe, true, true>(F.lds + RING_OFF, F.rsrc, FF / 2, FF / 2, FF / 2, S, E);
}

__device__ __forceinline__ void p1_proj(Frame& F0, const In& I) {
    PHASE_FRAME(F0);
    { pg8::SchedPlain S; S.t.init(T / 256, SEG_PAD / 256, F.G, (int)blockIdx.x);
      S.A = (unsigned)(WS_XB8); S.B = (unsigned)(WS_WSV8); S.tsA = (unsigned)256 * D; S.tsB = (unsigned)256 * D;
      pg8::EpiProj E{(bf16*)(F.ws + WS_PROJ), PJ_SEG, 0};
      pg8::gemm_phase<pg8::EpiProj, pg8::SchedPlain, true, true>(F.lds + RING_OFF, F.rsrc, D / 2, D / 2, D / 2, S, E); }
    { pg8::SchedPlain S; S.t.init(T / 256, (2 * AW) / 256, F.G, (int)blockIdx.x);
      S.A = (unsigned)(WS_XB8); S.B = (unsigned)(WS_WQK8); S.tsA = (unsigned)256 * D; S.tsB = (unsigned)256 * D;
      pg8::EpiProj E{(bf16*)(F.ws + WS_PROJ), 0, 4};
      pg8::gemm_phase<pg8::EpiProj, pg8::SchedPlain, true, true>(F.lds + RING_OFF, F.rsrc, D / 2, D / 2, D / 2, S, E); }
    { pg8::SchedPlain S; S.t.init(T / 256, (2 * D) / 256, F.G, (int)blockIdx.x);
      S.A = (unsigned)(WS_XB8); S.B = (unsigned)(WS_WG8); S.tsA = (unsigned)256 * D; S.tsB = (unsigned)256 * D;
      pg8::EpiGate E{(bf16*)(F.ws + WS_PROJ)};
      pg8::gemm_phase<pg8::EpiGate, pg8::SchedPlain, true, true>(F.lds + RING_OFF, F.rsrc, D / 2, D / 2, D / 2, S, E); }
    { pg8::SchedPlain S; S.t.init(AW / 256, T / 256, F.G, (int)blockIdx.x);
      S.A = (unsigned)(WS_WV8); S.B = (unsigned)(WS_XB8); S.tsA = (unsigned)256 * D; S.tsB = (unsigned)256 * D;
      pg8::EpiBf16 E{(bf16*)(F.ws + WS_VT), T};
      pg8::gemm_phase<pg8::EpiBf16, pg8::SchedPlain, true, true>(F.lds + RING_OFF, F.rsrc, D / 2, D / 2, D / 2, S, E); }
}

__device__ __forceinline__ float ftanh(float x) { return 2.0f * fsigmoid(2.0f * x) - 1.0f; }
__device__ __forceinline__ void p2_shift_attn(Frame& F0, const In& I) {
    PHASE_FRAME(F0);
    const int lane = F.lane; const int gw = F.vcu * NWAVES + F.wave, NGW = F.G * NWAVES;
    const bf16* PROJ = (const bf16*)(F.ws + WS_PROJ);
    for (int tok = gw; tok < T; tok += NGW) {
        const bool first = (tok % SEQ) == 0;
        const bf16* cur = PROJ + (size_t)tok * PROJ_LD + PJ_SEG; const bf16* prv = cur - PROJ_LD;
        bf16* rkv = (bf16*)(F.ws + WS_RKV) + (size_t)tok * (3 * RW); bf16* lin = (bf16*)(F.ws + WS_LORAIN) + (size_t)tok * LORA_LD;
#pragma unroll 1
        for (int it = 0; it < 7; ++it) { const int gi = it * 64 + lane; if (gi >= SHIFT_W / 8) break; const int c = gi * 8;
            const v4u cv = *(const GAS v4u*)(cur + c); v4u pv = (v4u){0u, 0u, 0u, 0u}; if (!first) pv = *(const GAS v4u*)(prv + c);
            const f32x4 m0 = *(const GAS f32x4*)(I.shift_mu + c), m1 = *(const GAS f32x4*)(I.shift_mu + c + 4);
            float v[8]; const unsigned cw[4] = {cv.x, cv.y, cv.z, cv.w}, pw[4] = {pv.x, pv.y, pv.z, pv.w};
#pragma unroll
            for (int j = 0; j < 4; ++j) { const float c0 = bflo(cw[j]), c1 = bfhi(cw[j]), p0 = bflo(pw[j]), p1 = bfhi(pw[j]); const float mu0 = (j < 2) ? m0[2 * j] : m1[2 * j - 4], mu1 = (j < 2) ? m0[2 * j + 1] : m1[2 * j - 3];
                v[2 * j] = c0 + (p0 - c0) * mu0; v[2 * j + 1] = c1 + (p1 - c1) * mu1; }
            bf16* dstp;
            if (c < 3 * RW) dstp = rkv + c;
            else if (c < 3 * RW + DLORA) { dstp = lin + (c - 3 * RW);
#pragma unroll
                for (int j = 0; j < 8; ++j) v[j] = ftanh(v[j]); }
            else if (c < 3 * RW + DLORA + ALORA) dstp = lin + 128 + (c - 3 * RW - DLORA);
            else { dstp = lin + 256 + (c - 3 * RW - DLORA - ALORA);
#pragma unroll
                for (int j = 0; j < 8; ++j) v[j] = fsigmoid(v[j]); }
            *(GAS v4u*)dstp = (v4u){pk2(v[0], v[1]), pk2(v[2], v[3]), pk2(v[4], v[5]), pk2(v[6], v[7])};
        }
        if (lane < 8) { const int c = (lane < 4) ? (DLORA + 8 * lane) : (128 + ALORA + 8 * (lane - 4)); *(GAS v4u*)(lin + c) = (v4u){0u, 0u, 0u, 0u}; }
    }
#if STAGE == 3
    { const int gt = F.vcu * (NWAVES * 64) + F.tid, NGT = F.G * NWAVES * 64;
      for (size_t i = gt; i < (size_t)T * RW / 8; i += NGT) ((GAS v4u*)(F.ws + WS_YB))[i] = (v4u){0u, 0u, 0u, 0u}; }
#endif
    LAS float* tbl = (LAS float*)(F.lds + 0);
    constexpr int AKV = 64 * 144, A_KOFF = 2048, A_VOFF = A_KOFF + 2 * AKV;
    const bf16* VT = (const bf16*)(F.ws + WS_VT); bf16* YA = (bf16*)(F.ws + WS_YA);
    const int r = lane & 31, hh = lane >> 5;
    const int rp = (r & 16) + 8 * ((r >> 2) & 1) + 4 * ((r >> 3) & 1) + (r & 3);
    const int srow = F.tid >> 3, spc = F.tid & 7;
    for (int task = F.vcu; task < BATCH * AH * (SEQ / 256); task += F.G) {
        const int bh = task >> 5, q256 = task & 31, b = bh >> 4, h = bh & 15, c0 = q256 * 4;
        const int q0 = q256 * 256 + F.wave * 32, cw = c0 + (F.wave >> 1);
        const int kc_lo = (c0 > LEFT) ? c0 - LEFT : 0, kc_hi = c0 + 3;
        __syncthreads();
        if (F.tid < REL_TABLE) tbl[F.tid] = I.rel_bias[h * REL_TABLE + F.tid];
        const size_t tokq = (size_t)b * SEQ + q0 + r;
        bf16x8 qf[4];
#pragma unroll
        for (int s = 0; s < 4; ++s) qf[s] = *(const GAS bf16x8*)(PROJ + tokq * PROJ_LD + PJ_Q + h * 64 + 16 * s + 8 * hh);
        f32x16 o0, o1;
#pragma unroll
        for (int i = 0; i < 16; ++i) { o0[i] = 0.f; o1[i] = 0.f; }
        float m_run = -1e30f, l_run = 0.f;
        v4u kreg, vreg;
#define AT_STAGE_LOAD(kc_) do { kreg = *(const GAS v4u*)(PROJ + ((size_t)b * SEQ + (size_t)(kc_) * 64 + srow) * PROJ_LD + PJ_K + h * 64 + spc * 8); \
                                vreg = *(const GAS v4u*)(VT + (size_t)(h * 64 + srow) * T + (size_t)b * SEQ + (size_t)(kc_) * 64 + spc * 8); } while (0)
#define AT_STAGE_WRITE(buf_) do { *(LAS v4u*)(F.lds + A_KOFF + (buf_) * AKV + srow * 144 + spc * 16) = kreg; *(LAS v4u*)(F.lds + A_VOFF + (buf_) * AKV + srow * 144 + spc * 16) = vreg; } while (0)
        AT_STAGE_LOAD(kc_lo); AT_STAGE_WRITE(0);
        __syncthreads();
#pragma unroll 1
        for (int kc = kc_lo; kc <= kc_hi; ++kc) {
            const int buf = (kc - kc_lo) & 1;
            if (kc < kc_hi) AT_STAGE_LOAD(kc + 1);
            if (kc >= cw - LEFT && kc <= cw) {
                const LAS unsigned char* Kb = F.lds + A_KOFF + buf * AKV; const LAS unsigned char* Vb = F.lds + A_VOFF + buf * AKV;
#pragma unroll
                for (int tt = 0; tt < 2; ++tt) {
                    const int kpos0 = kc * 64 + 32 * tt;
                    bf16x8 kf[4], va[2], vb[2];
#pragma unroll
                    for (int s = 0; s < 4; ++s) kf[s] = *(const LAS bf16x8*)(Kb + (32 * tt + rp) * 144 + 32 * s + 16 * hh);
#pragma unroll
                    for (int s2 = 0; s2 < 2; ++s2) { va[s2] = *(const LAS bf16x8*)(Vb + r * 144 + 64 * tt + 32 * s2 + 16 * hh); vb[s2] = *(const LAS bf16x8*)(Vb + (32 + r) * 144 + 64 * tt + 32 * s2 + 16 * hh); }
                    f32x16 st;
#pragma unroll
                    for (int i = 0; i < 16; ++i) st[i] = 0.f;
#pragma unroll
                    for (int s = 0; s < 4; ++s) st = __builtin_amdgcn_mfma_f32_32x32x16_bf16(kf[s], qf[s], st, 0, 0, 0);
                    const int dbase = (q0 + r) - (kpos0 + 8 * hh);
                    float mx = -1e30f;
                    if (q0 - (kpos0 + 31) >= MAX_PAST) {
                        const float bc = tbl[MAX_PAST + 63];
#pragma unroll
                        for (int i = 0; i < 16; ++i) { st[i] += bc; mx = fmaxf(mx, st[i]); }
                    } else {
#pragma unroll
                        for (int i = 0; i < 16; ++i) { int d = dbase - (16 * (i >> 3) + 4 * ((i >> 2) & 1) + (i & 3)); d = d < MAX_PAST ? d : MAX_PAST; st[i] += tbl[d + 63]; mx = fmaxf(mx, st[i]); }
                    }
                    mx = fmaxf(mx, __shfl_xor(mx, 32));
                    const float m_new = fmaxf(m_run, mx), alpha = __expf(m_run - m_new);
                    float ls = 0.f;
#pragma unroll
                    for (int i = 0; i < 16; ++i) { st[i] = __expf(st[i] - m_new); ls += st[i]; }
                    l_run = l_run * alpha + ls;
                    if (__builtin_amdgcn_ballot_w64(m_new != m_run)) {
#pragma unroll
                        for (int i = 0; i < 16; ++i) { o0[i] *= alpha; o1[i] *= alpha; } }
                    m_run = m_new;
#pragma unroll
                    for (int s2 = 0; s2 < 2; ++s2) {
                        v4u pw; pw.x = pg8::cvt_pk_bf16(st[8 * s2 + 0], st[8 * s2 + 1]); pw.y = pg8::cvt_pk_bf16(st[8 * s2 + 2], st[8 * s2 + 3]); pw.z = pg8::cvt_pk_bf16(st[8 * s2 + 4], st[8 * s2 + 5]); pw.w = pg8::cvt_pk_bf16(st[8 * s2 + 6], st[8 * s2 + 7]);
                        const bf16x8 pf = __builtin_bit_cast(bf16x8, pw);
                        o0 = __builtin_amdgcn_mfma_f32_32x32x16_bf16(va[s2], pf, o0, 0, 0, 0);
                        o1 = __builtin_amdgcn_mfma_f32_32x32x16_bf16(vb[s2], pf, o1, 0, 0, 0);
                    }
                }
            }
            if (kc < kc_hi) AT_STAGE_WRITE(buf ^ 1);
            __syncthreads();
        }
#undef AT_STAGE_LOAD
#undef AT_STAGE_WRITE
        const float inv = 1.0f / (l_run + __shfl_xor(l_run, 32));
        unsigned char* yo = (unsigned char*)YA + tokq * AW + h * 64 + 4 * hh;
        const float inv16 = inv * ACT8_SCALE;
#pragma unroll
        for (int g4 = 0; g4 < 4; ++g4) {
            int w0 = __builtin_amdgcn_cvt_pk_fp8_f32(o0[4 * g4] * inv16, o0[4 * g4 + 1] * inv16, 0, false); w0 = __builtin_amdgcn_cvt_pk_fp8_f32(o0[4 * g4 + 2] * inv16, o0[4 * g4 + 3] * inv16, w0, true);
            int w1 = __builtin_amdgcn_cvt_pk_fp8_f32(o1[4 * g4] * inv16, o1[4 * g4 + 1] * inv16, 0, false); w1 = __builtin_amdgcn_cvt_pk_fp8_f32(o1[4 * g4 + 2] * inv16, o1[4 * g4 + 3] * inv16, w1, true);
            *(GAS unsigned*)(yo + 8 * g4) = (unsigned)w0; *(GAS unsigned*)(yo + 32 + 8 * g4) = (unsigned)w1;
        }
    }
}

__device__ __forceinline__ void p6_merged(Frame& F0, const In& I) {
    PHASE_FRAME(F0);
    pg8::SchedTwo S; S.t.init(T / 256, D / 256, F.G, (int)blockIdx.x);
    S.A0 = (unsigned)(WS_YA); S.A1 = (unsigned)(WS_YB); S.B0 = (unsigned)(WS_PAT); S.B1 = (unsigned)(WS_PBT);
    S.tsA = (unsigned)256 * AW; S.tsB = (unsigned)256 * AW;
    pg8::EpiMerged E{(const bf16*)(F.ws + WS_PROJ), (bf16*)(F.ws + WS_MERGED)};
    pg8::gemm_phase<pg8::EpiMerged, pg8::SchedTwo, true, true, 0x00007b79>(F.lds + RING_OFF, F.rsrc, AW / 2, AW / 2, AW / 2, S, E);
}
__device__ __forceinline__ void p7_mix(Frame& F0, const In& I) {
    PHASE_FRAME(F0);
    pg8::SchedPlain S; S.t.init(T / 256, D / 256, F.G, (int)blockIdx.x);
    S.A = (unsigned)(WS_MERGED); S.B = (unsigned)(WS_WOT); S.tsA = (unsigned)256 * D; S.tsB = (unsigned)256 * D;
    pg8::EpiBf16 E{(bf16*)(F.ws + WS_Z), D};
    pg8::gemm_phase<pg8::EpiBf16, pg8::SchedPlain, true, true, 0x00007b79>(F.lds + RING_OFF, F.rsrc, D / 2, D / 2, D / 2, S, E);
}

__device__ __forceinline__ void p3_lora(Frame& F0, const In& I) {
    PHASE_FRAME(F0);
    { pg8::SchedPlain S; S.t.init(T / 256, 4, F.G, (int)blockIdx.x);
      S.A = (unsigned)(WS_LORAIN); S.B = (unsigned)(WS_WLA); S.tsA = (unsigned)256 * LORA_LD * 2; S.tsB = (unsigned)256 * 256 * 2;
      pg8::EpiLoraA<true> E{(float*)(F.ws + WS_DECAY), I.w0};
      pg8::gemm_phase<pg8::EpiLoraA<true>, pg8::SchedPlain, true>(F.lds + RING_OFF, F.rsrc, LORA_LD, 256, 256, S, E); }
    { pg8::SchedPlain S; S.t.init(T / 256, 4, F.G, (int)blockIdx.x);
      S.A = (unsigned)(WS_LORAIN); S.B = (unsigned)(WS_WLA + (size_t)1024 * 256 * 2); S.tsA = (unsigned)256 * LORA_LD * 2; S.tsB = (unsigned)256 * 256 * 2;
      pg8::EpiIclr E{(bf16*)(F.ws + WS_ICLR), I.a0};
      pg8::gemm_phase<pg8::EpiIclr, pg8::SchedPlain, true>(F.lds + RING_OFF, F.rsrc, LORA_LD, 256, 256, S, E); }
    { pg8::SchedPlain S; S.t.init(T / 256, 4, F.G, (int)blockIdx.x);
      S.A = (unsigned)(WS_LORAIN + 512); S.B = (unsigned)(WS_WLG); S.tsA = (unsigned)256 * LORA_LD * 2; S.tsB = (unsigned)256 * 256 * 2;
      pg8::EpiBf16 E{(bf16*)(F.ws + WS_G), RW};
      pg8::gemm_phase<pg8::EpiBf16, pg8::SchedPlain, true>(F.lds + RING_OFF, F.rsrc, LORA_LD, 256, 256, S, E); }
}

constexpr int CP = 144;
constexpr int CMAT = 64 * CP;
constexpr int C_RT = 0 * CMAT, C_ATT = 1 * CMAT, C_AAK = 2 * CMAT, C_ARKT = 3 * CMAT, C_WA = 4 * CMAT, C_WB = 6 * CMAT,
              C_MA = 8 * CMAT, C_MTA = 9 * CMAT, C_MB = 10 * CMAT, C_MTB = 11 * CMAT, C_SEG = 12 * CMAT, C_GAM = C_SEG + 8 * 64 * 4, C_TSCR = C_GAM + 256;
constexpr int C_AT = C_WB, C_BT = C_WB + CMAT, C_KT = C_MB, C_QYT = C_MA, C_QST = C_MTA, C_KHT = C_MTB, C_VT = C_WB;
static_assert(C_TSCR % 16 == 0 && C_TSCR + 8 * 5120 <= TAB_OFF, "P4a LDS map");
constexpr int CHK_UNIT_BYTES = 4 * 64 * 64 * 2;
#define CBAR() do { asm volatile("s_waitcnt lgkmcnt(0)" ::: "memory"); __builtin_amdgcn_s_barrier(); asm volatile("" ::: "memory"); } while (0)
template <int NT, class Epi>
__device__ __forceinline__ void cmm(const LAS unsigned char* X, const LAS unsigned char* Y, int mt0, int nt, int lane, const Epi& E) {
    const int lr = lane & 15, kq = lane >> 4;
    const bf16x8 b0 = *(const LAS bf16x8*)(Y + (nt * 16 + lr) * CP + kq * 16), b1 = *(const LAS bf16x8*)(Y + (nt * 16 + lr) * CP + kq * 16 + 64);
#pragma unroll
    for (int i = 0; i < NT; ++i) { const int mt = mt0 + i;
        const bf16x8 a0 = *(const LAS bf16x8*)(X + (mt * 16 + lr) * CP + kq * 16), a1 = *(const LAS bf16x8*)(X + (mt * 16 + lr) * CP + kq * 16 + 64);
        f32x4 acc = (f32x4){0.f, 0.f, 0.f, 0.f};
        acc = __builtin_amdgcn_mfma_f32_16x16x32_bf16(a0, b0, acc, 0, 0, 0);
        acc = __builtin_amdgcn_mfma_f32_16x16x32_bf16(a1, b1, acc, 0, 0, 0);
        E(mt, nt, acc); }
}
__device__ __forceinline__ v2u pack4(const f32x4& v) { return (v2u){pg8::cvt_pk_bf16(v[0], v[1]), pg8::cvt_pk_bf16(v[2], v[3])}; }
__device__ __forceinline__ f32x4 unpack4(const v2u w) { return (f32x4){bflo(w.x), bfhi(w.x), bflo(w.y), bfhi(w.y)}; }
__device__ __forceinline__ void p4a_chunk(Frame& F0, const In& I) {
    PHASE_FRAME(F0);
    LAS unsigned char* L = F.lds;
    const int lane = F.lane, w = F.wave, lr = lane & 15, kq = lane >> 4;
    const bf16* RKV = (const bf16*)(F.ws + WS_RKV); const float* LW = (const float*)(F.ws + WS_DECAY); const bf16* ICL = (const bf16*)(F.ws + WS_ICLR);
    unsigned char* CHK = F.ws + WS_CHK;
    int uit = 0;
    for (int unit = F.vcu; unit < BATCH * RH * (SEQ / 64); unit += F.G, ++uit) {
        const int bh = unit >> 7, ck = unit & 127, b = bh >> 4, h = bh & 15;
        const size_t tok0 = (size_t)b * SEQ + (size_t)ck * 64 + 8 * w;
        const int hc = h * 64 + lane;
        float lwv[8], ic[8], rr[8], kk[8], vv[8];
#pragma unroll
        for (int i = 0; i < 8; ++i) { const size_t tok = tok0 + i; lwv[i] = LW[tok * RW + hc]; ic[i] = bf2f(ICL[tok * RW + hc]);
            rr[i] = bf2f(RKV[tok * (3 * RW) + hc]); kk[i] = bf2f(RKV[tok * (3 * RW) + RW + hc]); vv[i] = bf2f(RKV[tok * (3 * RW) + 2 * RW + hc]); }
        const float kkp = I.k_k[hc], kap = I.k_a[hc];
        float cs[8]; { float run = 0.f;
#pragma unroll
            for (int i = 0; i < 8; ++i) { run += lwv[i]; cs[i] = run; } }
        __syncthreads();
        ((LAS float*)(L + C_SEG))[w * 64 + lane] = cs[7];
        CBAR();
        float pre = 0.f, tot = 0.f;
#pragma unroll
        for (int j = 0; j < 8; ++j) { const float sg = ((const LAS float*)(L + C_SEG))[j * 64 + lane]; tot += sg; pre += (j < w) ? sg : 0.f; }
        if (w == 0) ((LAS float*)(L + C_GAM))[lane] = __expf(tot);
        unsigned att[4], bht[4], kht[4], vtt[4];
        float at_[8], bh_[8], kh_[8]; const float gtot = __expf(tot); float ep_prev = 1.f;
#pragma unroll
        for (int i = 0; i < 8; ++i) { const int t = 8 * w + i; const float cum = pre + cs[i], cump = cum - lwv[i];
            const float kkv = kk[i] * kkp; const float n2 = wave_sum(kkv * kkv); const float kkn = kkv * __builtin_amdgcn_rsqf(fmaxf(n2, 1e-24f));
            const float a = -kkn, bb = kkn * ic[i], kp = kk[i] * (1.0f + (ic[i] - 1.0f) * kap);
            const float ep = __expf(cum), em = __builtin_amdgcn_rcpf(ep), epp = (i == 0) ? __expf(cump) : ep_prev, eL = gtot * em; ep_prev = ep;
            const float Rv = rr[i] * ep, Av = a * epp, Bv = bb * em, Kv = kp * em;
            at_[i] = Av; bh_[i] = bb * eL; kh_[i] = kp * eL;
            *(LAS unsigned short*)(L + C_RT + t * CP + lane * 2) = (unsigned short)f2bf(Rv);
            *(LAS unsigned short*)(L + C_AT + t * CP + lane * 2) = (unsigned short)f2bf(Av);
            *(LAS unsigned short*)(L + C_BT + t * CP + lane * 2) = (unsigned short)f2bf(Bv);
            *(LAS unsigned short*)(L + C_KT + t * CP + lane * 2) = (unsigned short)f2bf(Kv); }
#pragma unroll
        for (int q = 0; q < 4; ++q) { att[q] = pk2(at_[2 * q], at_[2 * q + 1]); bht[q] = pk2(bh_[2 * q], bh_[2 * q + 1]); kht[q] = pk2(kh_[2 * q], kh_[2 * q + 1]); vtt[q] = pk2(vv[2 * q], vv[2 * q + 1]); }
        *(LAS v4u*)(L + C_ATT + lane * CP + 16 * w) = (v4u){att[0], att[1], att[2], att[3]};
        *(LAS v4u*)(L + C_WA + (64 + lane) * CP + 16 * w) = (v4u){bht[0], bht[1], bht[2], bht[3]};
        CBAR();
        const int cit = (uit * F.G + F.vcu) * 16 + w * 2; const bool hx = cit < MOE_NITEMS, hy = cit + 1 < MOE_NITEMS;
        f32x4 tX[16]; MoeItem mX = moe_item(hx ? cit : 0, I.w_gu, I.w_down, F.ws);
        LAS float* tscr = (LAS float*)(L + C_TSCR + w * 5120);
        struct Fr { bf16x8 a, b; };
        auto LD = [&](int base, int tile) -> Fr { const LAS unsigned char* q = L + base + (tile * 16 + lr) * CP + kq * 16; Fr f; f.a = *(const LAS bf16x8*)q; f.b = *(const LAS bf16x8*)(q + 64); return f; };
        auto MM = [&](const Fr& x, const Fr& y) -> f32x4 { f32x4 acc = (f32x4){0.f, 0.f, 0.f, 0.f};
            acc = __builtin_amdgcn_mfma_f32_16x16x32_bf16(x.a, y.a, acc, 0, 0, 0); acc = __builtin_amdgcn_mfma_f32_16x16x32_bf16(x.b, y.b, acc, 0, 0, 0); return acc; };
        const int nt = w & 3, mt0 = 2 * (w >> 2), n = nt * 16 + lr;
        { const Fr yAT = LD(C_AT, nt), yKT = LD(C_KT, nt), yRT = LD(C_RT, nt);
          Fr xBT[2], xAT[2], xKT[2];
#pragma unroll
          for (int i = 0; i < 2; ++i) { xBT[i] = LD(C_BT, mt0 + i); xAT[i] = LD(C_AT, mt0 + i); xKT[i] = LD(C_KT, mt0 + i); }
          f32x4 a1[2], a2[2], a3[2], a4[2];
#pragma unroll
          for (int i = 0; i < 2; ++i) { a1[i] = MM(xBT[i], yAT); a2[i] = MM(xAT[i], yKT); a3[i] = MM(xBT[i], yRT); a4[i] = MM(xKT[i], yRT); }
#pragma unroll
          for (int i = 0; i < 2; ++i) { const int m0 = (mt0 + i) * 16 + 4 * kq;
              f32x4 v = a1[i];
#pragma unroll
              for (int e = 0; e < 4; ++e) { v[e] = (m0 + e < n) ? v[e] : 0.f; *(LAS unsigned short*)(L + C_MA + (m0 + e) * CP + n * 2) = (unsigned short)f2bf(v[e]); }
              *(LAS v2u*)(L + C_MTA + n * CP + m0 * 2) = pack4(v);
              v = a2[i];
#pragma unroll
              for (int e = 0; e < 4; ++e) v[e] = (n < m0 + e) ? v[e] : 0.f;
              *(LAS v2u*)(L + C_AAK + n * CP + m0 * 2) = pack4(v);
              v = a3[i];
#pragma unroll
              for (int e = 0; e < 4; ++e) v[e] = (m0 + e <= n) ? v[e] : 0.f;
              *(LAS v2u*)(L + C_WA + n * CP + m0 * 2) = pack4(v);
              v = a4[i];
#pragma unroll
              for (int e = 0; e < 4; ++e) v[e] = (m0 + e <= n) ? v[e] : 0.f;
              *(LAS v2u*)(L + C_ARKT + n * CP + m0 * 2) = pack4(v); } }
        CBAR();
        if (hx) tr8_load(mX, tX, lane);
#pragma unroll
        for (int lvl = 0; lvl < 6; ++lvl) {
            const int Wsrc = (lvl & 1) ? C_WB : C_WA, Wdst = (lvl & 1) ? C_WA : C_WB, Ms = (lvl & 1) ? C_MB : C_MA, Mts = (lvl & 1) ? C_MTB : C_MTA, Md = (lvl & 1) ? C_MA : C_MB, Mtd = (lvl & 1) ? C_MTA : C_MTB;
            const Fr yW = LD(Wsrc, w); Fr yMt; if (lvl < 5) yMt = LD(Mts, nt);
            Fr xM[4], xS[2];
#pragma unroll
            for (int i = 0; i < 4; ++i) xM[i] = LD(Ms, i);
            if (lvl < 5) { xS[0] = LD(Ms, mt0); xS[1] = LD(Ms, mt0 + 1); }
            const int nj = w * 16 + lr;
            f32x4 old[4], aw[4], as[2];
#pragma unroll
            for (int i = 0; i < 4; ++i) old[i] = unpack4(*(const LAS v2u*)(L + Wsrc + nj * CP + (i * 16 + 4 * kq) * 2));
#pragma unroll
            for (int i = 0; i < 4; ++i) aw[i] = MM(xM[i], yW);
            if (lvl < 5) {
#pragma unroll
                for (int i = 0; i < 2; ++i) as[i] = MM(xS[i], yMt); }
#pragma unroll
            for (int i = 0; i < 4; ++i) *(LAS v2u*)(L + Wdst + nj * CP + (i * 16 + 4 * kq) * 2) = pack4(old[i] + aw[i]);
            if (lvl < 5) {
#pragma unroll
                for (int i = 0; i < 2; ++i) { const int m0 = (mt0 + i) * 16 + 4 * kq;
#pragma unroll
                    for (int e = 0; e < 4; ++e) *(LAS unsigned short*)(L + Md + (m0 + e) * CP + n * 2) = (unsigned short)f2bf(as[i][e]);
                    if (lvl < 4) *(LAS v2u*)(L + Mtd + n * CP + m0 * 2) = pack4(as[i]); } }
            if (lvl == 4) *(LAS v4u*)(L + C_KHT + lane * CP + 16 * w) = (v4u){kht[0], kht[1], kht[2], kht[3]};
            if (lvl == 2) { if (hx) tr8_finish(tX, mX, tscr, lane);
                            if (hy) { mX = moe_item(cit + 1, I.w_gu, I.w_down, F.ws); tr8_load(mX, tX, lane); } }
            CBAR();
        }
        *(LAS v4u*)(L + C_VT + lane * CP + 16 * w) = (v4u){vtt[0], vtt[1], vtt[2], vtt[3]};
        unsigned char* og = CHK + (size_t)unit * CHK_UNIT_BYTES;
        { const Fr yW1 = LD(C_WA, nt), yW2 = LD(C_WA + 64 * CP, nt);
          Fr xA[2], xK[2];
#pragma unroll
          for (int i = 0; i < 2; ++i) { xA[i] = LD(C_ATT, mt0 + i); xK[i] = LD(C_AAK, mt0 + i); }
          f32x4 rv[2], av[2], kv[2];
          const float gm = ((const LAS float*)(L + C_GAM))[n];
#pragma unroll
          for (int i = 0; i < 2; ++i) { const int m0 = (mt0 + i) * 16 + 4 * kq;
              rv[i] = unpack4(*(const LAS v2u*)(L + C_RT + n * CP + m0 * 2)); av[i] = unpack4(*(const LAS v2u*)(L + C_ARKT + n * CP + m0 * 2)); kv[i] = unpack4(*(const LAS v2u*)(L + C_KHT + n * CP + m0 * 2)); }
          f32x4 p7[2], p8[2], p9[2], p10[2];
#pragma unroll
          for (int i = 0; i < 2; ++i) { p7[i] = MM(xA[i], yW1); p8[i] = MM(xK[i], yW1); p9[i] = MM(xA[i], yW2); p10[i] = MM(xK[i], yW2); }
#pragma unroll
          for (int i = 0; i < 2; ++i) { const int m0 = (mt0 + i) * 16 + 4 * kq;
              *(GAS v2u*)(og + 0 * 8192 + n * 128 + m0 * 2) = pack4(p7[i] + rv[i]);
              *(LAS v2u*)(L + C_QYT + n * CP + m0 * 2) = pack4(p8[i] + av[i]);
              f32x4 v = p9[i];
#pragma unroll
              for (int e = 0; e < 4; ++e) v[e] += (m0 + e == n) ? gm : 0.f;
              *(GAS v2u*)(og + 1 * 8192 + n * 128 + m0 * 2) = pack4(v);
              *(LAS v2u*)(L + C_QST + n * CP + m0 * 2) = pack4(p10[i] + kv[i]); } }
        CBAR();
        { const Fr yQy = LD(C_QYT, nt), yQs = LD(C_QST, nt);
          Fr xV[2];
#pragma unroll
          for (int i = 0; i < 2; ++i) xV[i] = LD(C_VT, mt0 + i);
          f32x4 p11[2], p12[2];
#pragma unroll
          for (int i = 0; i < 2; ++i) { p11[i] = MM(xV[i], yQy); p12[i] = MM(xV[i], yQs); }
#pragma unroll
          for (int i = 0; i < 2; ++i) { const int m0 = (mt0 + i) * 16 + 4 * kq;
              *(GAS v2u*)(og + 2 * 8192 + n * 128 + m0 * 2) = pack4(p11[i]);
              *(GAS v2u*)(og + 3 * 8192 + n * 128 + m0 * 2) = pack4(p12[i]); } }
        if (hy) tr8_finish(tX, mX, tscr, lane);
    }
}

constexpr int C2_SLOT = 20480;
__device__ __forceinline__ void p4b_scan(Frame& F0, const In& I) {
    PHASE_FRAME(F0);
    const int lane = F.lane, lr = lane & 15, kq = lane >> 4;
    const unsigned char* CHK = F.ws + WS_CHK; bf16* YS = (bf16*)(F.ws + WS_YSCAN);
    for (int unit = F.vcu; unit < BATCH * RH * 4; unit += F.G) {
        const int bh = unit >> 2, rq = unit & 3, b = bh >> 4, h = bh & 15;
        if (F.wave == 0) {
            LAS unsigned char* Sl = F.lds + 3 * C2_SLOT;
            f32x4 S[4]; bf16x8 sf[2];
#pragma unroll
            for (int nt = 0; nt < 4; ++nt) S[nt] = (f32x4){0.f, 0.f, 0.f, 0.f};
#pragma unroll
            for (int ks = 0; ks < 2; ++ks)
#pragma unroll
                for (int j = 0; j < 8; ++j) sf[ks][j] = 0;
#define C2_DMA(ck_) do { const int ckc_ = (ck_) < SEQ / 64 ? (ck_) : SEQ / 64 - 1; const unsigned char* ug = CHK + ((size_t)bh * 128 + ckc_) * CHK_UNIT_BYTES; \
                LAS unsigned char* sl_ = F.lds + ((ck_) % 3) * C2_SLOT; \
                _Pragma("unroll") for (int j = 0; j < 16; ++j) __builtin_amdgcn_global_load_lds((const unsigned*)(ug + j * 1024 + lane * 16), (LAS unsigned*)(sl_ + j * 1024), 16, 0, 0); \
                _Pragma("unroll") for (int j = 0; j < 2; ++j) { \
                    __builtin_amdgcn_global_load_lds((const unsigned*)(ug + 2 * 8192 + (j * 32 + (lane >> 1)) * 128 + rq * 32 + (lane & 1) * 16), (LAS unsigned*)(sl_ + 16384 + j * 1024), 16, 0, 0); \
                    __builtin_amdgcn_global_load_lds((const unsigned*)(ug + 3 * 8192 + (j * 32 + (lane >> 1)) * 128 + rq * 32 + (lane & 1) * 16), (LAS unsigned*)(sl_ + 18432 + j * 1024), 16, 0, 0); } } while (0)
            C2_DMA(0); C2_DMA(1);
#pragma unroll 1
            for (int ck = 0; ck < SEQ / 64; ++ck) {
                asm volatile("s_waitcnt lgkmcnt(0)" ::: "memory");
                C2_DMA(ck + 2);
                asm volatile("s_waitcnt vmcnt(40)" ::: "memory");
                const LAS unsigned char* sl_ = F.lds + (ck % 3) * C2_SLOT;
#pragma unroll
                for (int nt = 0; nt < 4; ++nt) {
                    const bf16x8 py0 = *(const LAS bf16x8*)(sl_ + (16 * nt + lr) * 128 + kq * 16), py1 = *(const LAS bf16x8*)(sl_ + (16 * nt + lr) * 128 + kq * 16 + 64);
                    const bf16x8 ps0 = *(const LAS bf16x8*)(sl_ + 8192 + (16 * nt + lr) * 128 + kq * 16), ps1 = *(const LAS bf16x8*)(sl_ + 8192 + (16 * nt + lr) * 128 + kq * 16 + 64);
                    f32x4 y = unpack4(*(const LAS v2u*)(sl_ + 16384 + (16 * nt + lr) * 32 + kq * 8));
                    f32x4 s2 = unpack4(*(const LAS v2u*)(sl_ + 18432 + (16 * nt + lr) * 32 + kq * 8));
                    y = __builtin_amdgcn_mfma_f32_16x16x32_bf16(sf[0], py0, y, 0, 0, 0); y = __builtin_amdgcn_mfma_f32_16x16x32_bf16(sf[1], py1, y, 0, 0, 0);
                    *(GAS v2u*)(YS + ((size_t)b * SEQ + (size_t)ck * 64 + 16 * nt + lr) * RW + h * 64 + rq * 16 + 4 * kq) = pack4(y);
                    s2 = __builtin_amdgcn_mfma_f32_16x16x32_bf16(sf[0], ps0, s2, 0, 0, 0); s2 = __builtin_amdgcn_mfma_f32_16x16x32_bf16(sf[1], ps1, s2, 0, 0, 0);
                    S[nt] = s2; }
#pragma unroll
                for (int nt = 0; nt < 4; ++nt)
#pragma unroll
                    for (int i = 0; i < 4; ++i) *(LAS unsigned short*)(Sl + (4 * kq + i) * CP + (16 * nt + lr) * 2) = (unsigned short)f2bf(S[nt][i]);
                LDS_WAIT(); asm volatile("" ::: "memory");
                sf[0] = *(const LAS bf16x8*)(Sl + lr * CP + kq * 16); sf[1] = *(const LAS bf16x8*)(Sl + lr * CP + kq * 16 + 64);
                LDS_WAIT(); asm volatile("" ::: "memory");
            }
            asm volatile("s_waitcnt vmcnt(0)" ::: "memory");
#undef C2_DMA
        }
    }
}
static_assert(3 * C2_SLOT + 4096 + 5 * 16640 <= TAB_OFF, "P4b LDS map");

__device__ __forceinline__ void p5_post(Frame& F0, const In& I) {
    PHASE_FRAME(F0);
    const int lane = F.lane; const int gw = F.vcu * NWAVES + F.wave, NGW = F.G * NWAVES;
    const bf16* RKV = (const bf16*)(F.ws + WS_RKV); const bf16* ICL = (const bf16*)(F.ws + WS_ICLR); const bf16* YS = (const bf16*)(F.ws + WS_YSCAN);
    const bf16* G = (const bf16*)(F.ws + WS_G); bf16* YB = (bf16*)(F.ws + WS_YB);
    const int c0 = lane * 16;
    for (int tok = gw; tok < T; tok += NGW) {
        float y[16], rr[16], kk[16], vv[16], ic[16], gg[16];
#pragma unroll
        for (int q = 0; q < 2; ++q) { const v4u a = *(const GAS v4u*)(YS + (size_t)tok * RW + c0 + 8 * q), c = *(const GAS v4u*)(ICL + (size_t)tok * RW + c0 + 8 * q);
            const unsigned aw[4] = {a.x, a.y, a.z, a.w}, cw[4] = {c.x, c.y, c.z, c.w};
#pragma unroll
            for (int e = 0; e < 4; ++e) { y[8 * q + 2 * e] = bflo(aw[e]); y[8 * q + 2 * e + 1] = bfhi(aw[e]); ic[8 * q + 2 * e] = bflo(cw[e]); ic[8 * q + 2 * e + 1] = bfhi(cw[e]); } }
#pragma unroll
        for (int q = 0; q < 2; ++q) {
            const v4u a = *(const GAS v4u*)(RKV + (size_t)tok * (3 * RW) + c0 + 8 * q), bb = *(const GAS v4u*)(RKV + (size_t)tok * (3 * RW) + RW + c0 + 8 * q),
                      c = *(const GAS v4u*)(RKV + (size_t)tok * (3 * RW) + 2 * RW + c0 + 8 * q), d = *(const GAS v4u*)(G + (size_t)tok * RW + c0 + 8 * q);
            const unsigned aw[4] = {a.x, a.y, a.z, a.w}, bw[4] = {bb.x, bb.y, bb.z, bb.w}, cw[4] = {c.x, c.y, c.z, c.w}, dw[4] = {d.x, d.y, d.z, d.w};
#pragma unroll
            for (int e = 0; e < 4; ++e) { rr[8 * q + 2 * e] = bflo(aw[e]); rr[8 * q + 2 * e + 1] = bfhi(aw[e]); kk[8 * q + 2 * e] = bflo(bw[e]); kk[8 * q + 2 * e + 1] = bfhi(bw[e]);
                vv[8 * q + 2 * e] = bflo(cw[e]); vv[8 * q + 2 * e + 1] = bfhi(cw[e]); gg[8 * q + 2 * e] = bflo(dw[e]); gg[8 * q + 2 * e + 1] = bfhi(dw[e]); } }
        float s = 0.f, bs = 0.f;
#pragma unroll
        for (int e = 0; e < 16; ++e) { s += y[e]; const float kp = kk[e] * (1.0f + (ic[e] - 1.0f) * I.k_a[c0 + e]); bs += rr[e] * kp * I.r_k[c0 + e]; }
        s = quadsum(s); bs = quadsum(bs);
        const float mean = s * (1.f / 64.f); float s2 = 0.f;
#pragma unroll
        for (int e = 0; e < 16; ++e) { y[e] -= mean; s2 += y[e] * y[e]; }
        s2 = quadsum(s2);
        const float rstd = 1.f / sqrtf(s2 * (1.f / 64.f) + GN_EPS);
        float o[16];
#pragma unroll
        for (int e = 0; e < 16; ++e) o[e] = (y[e] * rstd * I.lnx_w[c0 + e] + I.lnx_b[c0 + e] + bs * vv[e]) * gg[e];
        { unsigned w8[4];
#pragma unroll
          for (int q = 0; q < 4; ++q) { int t8 = __builtin_amdgcn_cvt_pk_fp8_f32(o[4 * q] * ACT8_SCALE, o[4 * q + 1] * ACT8_SCALE, 0, false); t8 = __builtin_amdgcn_cvt_pk_fp8_f32(o[4 * q + 2] * ACT8_SCALE, o[4 * q + 3] * ACT8_SCALE, t8, true); w8[q] = (unsigned)t8; }
          *(GAS v4u*)((unsigned char*)YB + (size_t)tok * RW + c0) = (v4u){w8[0], w8[1], w8[2], w8[3]}; }
    }
}
#ifndef STAGE
#define STAGE 4
#endif
struct Args { In in; float* out; unsigned char* ws; };
__global__ void __launch_bounds__(NWAVES * 64, 2) mk_fwd(Args args) {
    extern __shared__ __attribute__((aligned(16))) unsigned char lds[];
    Frame F;
    F.lds = (LAS unsigned char*)lds;
    F.MISC = (volatile LAS unsigned*)(F.lds + MISC_OFF);
    F.tid = threadIdx.x; F.lane = F.tid & 63; F.wave = __builtin_amdgcn_readfirstlane(F.tid >> 6);
    F.G = gridDim.x; { const int bx = blockIdx.x; F.vcu = (F.G % 8 == 0) ? (bx % 8) * (F.G / 8) + bx / 8 : bx; }
    F.ws = args.ws;
    F.rsrc = __builtin_amdgcn_make_buffer_rsrc(args.ws, 0, 0xffffffff, 0x00020000);
    F.ctl = (gu32*)(args.ws + WS_CTL);
    for (int u = F.tid; u < (LDS_BYTES - MISC_OFF) / 4; u += NWAVES * 64) ((LAS unsigned*)(F.lds + MISC_OFF))[u] = 0u;
    __syncthreads();
    XcdBarrier bar = xcd_barrier_post((unsigned*)(F.ctl + CW_BAR), F.MISC + 8);
    const In& I = args.in;
#define GRID_BAR() xcd_barrier(bar)
#ifndef DUP_PHASE
#define DUP_PHASE -1
#endif
#define RUN(n, call) do { call; if (DUP_PHASE == (n)) { GRID_BAR(); call; } } while (0)

#if STAGE >= 2
    RUN(0, p0_prologue(F, I));
    GRID_BAR();
#endif
#if STAGE >= 3
    RUN(1, p1_proj(F, I));
    GRID_BAR();
    RUN(2, p2_shift_attn(F, I));
    GRID_BAR();
#if STAGE >= 4
    RUN(3, p3_lora(F, I));
    GRID_BAR();
    RUN(4, p4a_chunk(F, I));
    GRID_BAR();
    RUN(44, p4b_scan(F, I));
    GRID_BAR();
    RUN(5, p5_post(F, I));
    GRID_BAR();
#endif
    RUN(6, p6_merged(F, I));
    GRID_BAR();
    RUN(7, p7_mix(F, I));
    GRID_BAR();
#endif
    p8_ln_router<(STAGE < 3)>(F, I);
    GRID_BAR();
#if STAGE >= 2
    p9_scatter(F, I);
    GRID_BAR();
    RUN(10, p10_moe_up(F, I));
    GRID_BAR();
    RUN(11, p11_moe_down(F, I));
    GRID_BAR();
#endif
    RUN(12, p12_final<(STAGE < 2)>(F, I, args.out));
}

extern "C" void kernel_launch(void* const* d_in, const int* in_sizes, int n_in, void* d_out, int out_size, void* d_ws, size_t ws_size, hipStream_t stream) {
    static int grid = 0;
    if (grid == 0) {
        if (n_in != 27 || in_sizes[0] != T * D || out_size != T * D || ws_size < WS_END) { fprintf(stderr, "kernel_launch: unexpected shapes (n_in %d, in0 %d, out %d, ws %zu)\n", n_in, n_in > 0 ? in_sizes[0] : -1, out_size, ws_size); grid = -1; return; }
        int dev = 0, cus = 0, per_cu = 0;
        if (hipGetDevice(&dev) != hipSuccess || hipDeviceGetAttribute(&cus, hipDeviceAttributeMultiprocessorCount, dev) != hipSuccess) { grid = -1; return; }
        if (hipFuncSetAttribute((const void*)mk_fwd, hipFuncAttributeMaxDynamicSharedMemorySize, LDS_BYTES) != hipSuccess) { fprintf(stderr, "kernel_launch: hipFuncSetAttribute failed\n"); grid = -1; return; }
        if (hipOccupancyMaxActiveBlocksPerMultiprocessor(&per_cu, (const void*)mk_fwd, NWAVES * 64, LDS_BYTES) != hipSuccess || per_cu < 1)
            fprintf(stderr, "kernel_launch: occupancy query reports %d\n", per_cu);
        (void)hipGetLastError();
        grid = cus;
    }
    if (grid < 0) return;
    if (hipMemsetAsync((char*)d_ws + WS_CTL, 0, CTL_ZERO_BYTES, stream) != hipSuccess) return;
    Args a{};
    const float** ip = (const float**)&a.in;
    for (int i = 0; i < 27; ++i) ip[i] = (const float*)d_in[i];
    a.out = (float*)d_out; a.ws = (unsigned char*)d_ws;
    hipLaunchKernelGGL(mk_fwd, dim3(grid), dim3(NWAVES * 64), LDS_BYTES, stream, a);
    const hipError_t le = hipPeekAtLastError();
    if (le != hipSuccess) fprintf(stderr, "kernel_launch: launch failed: %s\n", hipGetErrorName(le));
}
```

```cpp
#define STAGE 4
#include <hip/hip_runtime.h>
#include <cstdio>
#include <cstdint>

#define GAS __attribute__((address_space(1)))
#define LAS __attribute__((address_space(3)))
typedef unsigned short bf16;
typedef unsigned v4u __attribute__((ext_vector_type(4)));
typedef unsigned v2u __attribute__((ext_vector_type(2)));
typedef float f32x4 __attribute__((ext_vector_type(4)));
typedef float f32x2 __attribute__((ext_vector_type(2)));
typedef float f32x16 __attribute__((ext_vector_type(16)));
typedef short bf16x8 __attribute__((ext_vector_type(8)));
typedef short bf16x4 __attribute__((ext_vector_type(4)));
typedef GAS unsigned gu32;

constexpr int NWAVES = 8;
constexpr int BATCH = 4, SEQ = 8192, D = 2048, T = BATCH * SEQ;
constexpr int CHUNK = 64, LEFT = 8, AH = 16, AD = 64, AW = 1024;
constexpr int REL_TABLE = 320, MAX_PAST = 256;
constexpr int RH = 16, RN = 64, RW = 1024, DLORA = 96, ALORA = 96, GLORA = 256;
constexpr int SHIFT_W = 3 * RW + DLORA + ALORA + GLORA;
constexpr int D_IN = 3 * AW + SHIFT_W + 2 * D;
constexpr int NE = 32, TOPK = 4, FF = 2048;
constexpr int MSLOT = T * TOPK;
constexpr int NBLK_MAX = (MSLOT + NE * 255 + 255) / 256;
constexpr int RROWS = NBLK_MAX * 256;
constexpr float LN_EPS = 1e-5f, GN_EPS = 64e-5f;
constexpr float YS_SCALE = 16.0f, YS_INV = 1.0f / 16.0f;
constexpr float ACT8_SCALE = 16.0f;
constexpr float F8_CVT_SCALE = 0.015625f;
constexpr float DN_ALPHA = 1.189207115002721f;
constexpr int PROJ_LD = 9728, PJ_Q = 0, PJ_K = 1024, PJ_SEG = 2048, SEG_PAD = 3584, PJ_GA = 5632, PJ_GB = 7680;
constexpr int LORA_LD = 512;

constexpr size_t MiB = 1u << 20;
constexpr size_t WS_CTL = 0, CTL_ZERO_BYTES = 1 * MiB;
constexpr size_t WS_TOPI = 2 * MiB;
constexpr size_t WS_GATE = 3 * MiB;
constexpr size_t WS_ROWSLOT = 4 * MiB;
constexpr size_t WS_ROWW = 5 * MiB;
constexpr size_t WS_WLA = 6 * MiB;
constexpr size_t WS_WLG = 7 * MiB;
constexpr size_t WS_PAT = 8 * MiB;
constexpr size_t WS_PBT = 12 * MiB;
constexpr size_t WS_WOT = 16 * MiB;
constexpr size_t WS_WVT = 24 * MiB;
constexpr size_t WS_SIDE0 = 28 * MiB, WS_SIDEL = 36 * MiB;
constexpr size_t WS_WINT = 28 * MiB;
constexpr size_t WS_WG8 = 72 * MiB;
constexpr size_t WS_WQK8 = 80 * MiB;
constexpr size_t WS_WV8 = 84 * MiB;
constexpr size_t WS_WSV8 = 88 * MiB;
constexpr size_t WS_WGUT = 128 * MiB;
constexpr size_t WS_WDNT = 640 * MiB;
constexpr size_t WS_BASE0 = 1024 * MiB;
constexpr size_t WS_PROJ = WS_BASE0;
constexpr size_t WS_VT = WS_PROJ + 608 * MiB;
constexpr size_t WS_YA = WS_VT + 64 * MiB;
constexpr size_t WS_RKV = WS_YA + 64 * MiB;
constexpr size_t WS_LORAIN = WS_RKV + 192 * MiB;
constexpr size_t WS_DECAY = WS_LORAIN + 32 * MiB;
constexpr size_t WS_ICLR = WS_DECAY + 128 * MiB;
constexpr size_t WS_G = WS_ICLR + 128 * MiB;
constexpr size_t WS_YSCAN = WS_G + 64 * MiB;
constexpr size_t WS_YB = WS_YSCAN + 128 * MiB;
constexpr size_t WS_MERGED = WS_YB + 64 * MiB;
constexpr size_t WS_XB16 = WS_MERGED + 128 * MiB;
constexpr size_t WS_MIX_END = WS_XB16 + 128 * MiB;
constexpr size_t WS_Z = 2816 * MiB;
constexpr size_t WS_H1 = 3072 * MiB;
constexpr size_t WS_H1B = 3328 * MiB;
constexpr size_t WS_CHK = 3456 * MiB;
constexpr size_t WS_XB8 = 3712 * MiB;
constexpr size_t WS_END = 3776 * MiB;
constexpr size_t WS_XG = WS_BASE0;
constexpr size_t WS_ACT = WS_BASE0 + 544 * MiB;
constexpr size_t WS_YSLOT = WS_BASE0 + 1088 * MiB;
static_assert(WS_MIX_END <= WS_Z && WS_YSLOT + 512 * MiB <= WS_Z, "ws map");
static_assert(WS_WINT + (size_t)PROJ_LD * D * 2 <= WS_WGUT, "ws map");

constexpr int CW_CNT = 512;
constexpr int CW_CUR = 576;
constexpr int CW_BAR = 4096;

constexpr int RING_OFF = 0, RING_BYTES = 131072;
constexpr int LDS_BYTES = 160 * 1024;
constexpr int MISC_OFF = LDS_BYTES - 512;
constexpr int TAB_OFF = LDS_BYTES - 1024;

#define RLX_AGENT __ATOMIC_RELAXED, __HIP_MEMORY_SCOPE_AGENT
#define LDS_WAIT() asm volatile("s_waitcnt lgkmcnt(0)" ::: "memory")
#define VM_WAIT() asm volatile("s_waitcnt vmcnt(0)" ::: "memory")
__device__ __forceinline__ unsigned f2bf(float f) { unsigned u = __builtin_bit_cast(unsigned, f); return (u + 0x7fffu + ((u >> 16) & 1u)) >> 16; }
__device__ __forceinline__ unsigned pk2(float lo, float hi) { return f2bf(lo) | (f2bf(hi) << 16); }
__device__ __forceinline__ float bf2f(unsigned short h) { return __builtin_bit_cast(float, (unsigned)h << 16); }
__device__ __forceinline__ float bflo(unsigned w) { return __builtin_bit_cast(float, w << 16); }
__device__ __forceinline__ float bfhi(unsigned w) { return __builtin_bit_cast(float, w & 0xffff0000u); }
__device__ __forceinline__ float fsigmoid(float x) { return __builtin_amdgcn_rcpf(1.0f + __expf(-x)); }
__device__ __forceinline__ float dpp_f(float x, const int ctrl_sel) {
    const int xi = __builtin_bit_cast(int, x); int r;
    if (ctrl_sel == 0) r = __builtin_amdgcn_update_dpp(0, xi, 0xB1, 0xF, 0xF, false);
    else if (ctrl_sel == 1) r = __builtin_amdgcn_update_dpp(0, xi, 0x4E, 0xF, 0xF, false);
    else if (ctrl_sel == 2) r = __builtin_amdgcn_update_dpp(0, xi, 0x124, 0xF, 0xF, false);
    else r = __builtin_amdgcn_update_dpp(0, xi, 0x128, 0xF, 0xF, false);
    return __builtin_bit_cast(float, r);
}
__device__ __forceinline__ float rowsum16(float x) { x += dpp_f(x, 0); x += dpp_f(x, 1); x += dpp_f(x, 2); x += dpp_f(x, 3); return x; }
__device__ __forceinline__ float quadsum(float x) { x += dpp_f(x, 0); x += dpp_f(x, 1); return x; }
__device__ __forceinline__ float wave_sum(float v) {
    v = rowsum16(v);
    const int vi = __builtin_bit_cast(int, v);
    const float s0 = __builtin_bit_cast(float, __builtin_amdgcn_readlane(vi, 0)), s1 = __builtin_bit_cast(float, __builtin_amdgcn_readlane(vi, 16));
    const float s2 = __builtin_bit_cast(float, __builtin_amdgcn_readlane(vi, 32)), s3 = __builtin_bit_cast(float, __builtin_amdgcn_readlane(vi, 48));
    return (s0 + s1) + (s2 + s3);
}
namespace pg8 {
#define PG8_LAS __attribute__((address_space(3)))
typedef unsigned short bf16_t;
typedef unsigned u32x4 __attribute__((ext_vector_type(4)));
constexpr int BM = 256, BK = 64, HALF = 128, HTB = HALF * BK * 2, STAGE_BYTES = 8 * HTB, NXCD = 8, WGM = 8;

__host__ __device__ __forceinline__ int lds_byte(int r, int c) { const int st = (r >> 4) * 2 + (c >> 5), rr = r & 15, cc = c & 31, ob = rr * 64 + cc * 2; return st * 1024 + (ob ^ (((ob >> 9) & 1) << 5)); }
__host__ __device__ __forceinline__ void stage_rc(int b, int& R, int& C) { const int st = b / 1024, sb = b % 1024, swz = sb ^ (((sb >> 9) & 1) << 5); R = (st >> 1) * 16 + swz / 64; C = (st & 1) * 32 + (swz % 64) / 2; }
__host__ __device__ __forceinline__ int perm32(int rho) { const int n = rho >> 4, i = rho & 15; return 8 * (i >> 2) + 4 * n + (i & 3); }

struct Unit { int pm, pn, aux; };

struct Tiler {
    int nM, nN, nwg, G, c;
    __device__ __forceinline__ void init(int nM_, int nN_, int G_, int c_) { nM = nM_; nN = nN_; nwg = nM * nN; G = G_; c = c_; }
    __device__ __forceinline__ bool map(int i, int& pm, int& pn) const {
        const long L = (long)i * G + c; if (L >= nwg) return false;
        int wgid = (int)L; { const int q = nwg / NXCD, r = nwg % NXCD, xcd = wgid % NXCD, off = wgid / NXCD; wgid = (xcd < r ? xcd * (q + 1) : r * (q + 1) + (xcd - r) * q) + off; }
        const int nig = WGM * nN, gid = wgid / nig, fm = gid * WGM, gsz = (nM - fm) < WGM ? (nM - fm) : WGM;
        pm = fm + ((wgid % nig) % gsz); pn = (wgid % nig) / gsz; return true;
    }
};
struct SchedPlain {
    Tiler t; unsigned A, B, tsA, tsB;
    __device__ __forceinline__ bool next(int i, Unit& u) const { u.aux = 0; return t.map(i, u.pm, u.pn); }
    __device__ __forceinline__ void bases(const Unit& u, unsigned& a, unsigned& b) const { a = A + (unsigned)u.pm * tsA; b = B + (unsigned)u.pn * tsB; }
};
struct SchedTwo {
    Tiler t; unsigned A0, A1, B0, B1, tsA, tsB;
    __device__ __forceinline__ bool next(int i, Unit& u) const { u.aux = i & 1; return t.map(i >> 1, u.pm, u.pn); }
    __device__ __forceinline__ void bases(const Unit& u, unsigned& a, unsigned& b) const { a = (u.aux ? A1 : A0) + (unsigned)u.pm * tsA; b = (u.aux ? B1 : B0) + (unsigned)u.pn * tsB; }
};
struct SchedMoe {
    Tiler t; unsigned A, B, tsA, tsB, es; const PG8_LAS int* pad_end;
    __device__ __forceinline__ bool next(int i, Unit& u) const {
        if (!t.map(i, u.pm, u.pn)) return false;
        const int row0 = u.pm * BM; int e = 0;
#pragma unroll
        for (int j = 0; j < 32; ++j) e += (pad_end[j] <= row0) ? 1 : 0;
        u.aux = __builtin_amdgcn_readfirstlane(e < 31 ? e : 31); return true;
    }
    __device__ __forceinline__ void bases(const Unit& u, unsigned& a, unsigned& b) const { a = A + (unsigned)u.pm * tsA; b = B + (unsigned)u.aux * es + (unsigned)u.pn * tsB; }
};

typedef float f32x2_t_ __attribute__((ext_vector_type(2)));
typedef __bf16 bf16x2_t_ __attribute__((ext_vector_type(2)));
__device__ __forceinline__ unsigned cvt_pk_bf16(float lo, float hi) { const f32x2_t_ v = {lo, hi}; const bf16x2_t_ b = __builtin_convertvector(v, bf16x2_t_); return __builtin_bit_cast(unsigned, b); }
__device__ __forceinline__ u32x4 pack8(const f32x4& v0, const f32x4& v1) { u32x4 w; w.x = cvt_pk_bf16(v0[0], v0[1]); w.y = cvt_pk_bf16(v0[2], v0[3]); w.z = cvt_pk_bf16(v1[0], v1[1]); w.w = cvt_pk_bf16(v1[2], v1[3]); return w; }

typedef int i32x8 __attribute__((ext_vector_type(8)));
typedef int i32x4 __attribute__((ext_vector_type(4)));
__device__ __forceinline__ i32x8 cat8(const bf16x8& a, const bf16x8& b) { return __builtin_shufflevector(__builtin_bit_cast(i32x4, a), __builtin_bit_cast(i32x4, b), 0, 1, 2, 3, 4, 5, 6, 7); }
constexpr int F8_SCALES = 0x00007f79;
template <class Epi, class Sched, bool ALIGN_EPI, bool F8 = false, int F8SC = F8_SCALES>
__device__ __forceinline__ void gemm_phase(PG8_LAS unsigned char* lds, const __amdgpu_buffer_rsrc_t rsrc, const int lda, const int ldb, const int K, const Sched& S, const Epi& E) {
    int tid_ = threadIdx.x; asm volatile("" : "+v"(tid_));
    const int tid = tid_, wid = __builtin_amdgcn_readfirstlane(tid >> 6), lane = tid & 63, wr = wid >> 2, wc = wid & 3, fr = lane & 15, fq = lane >> 4;
    const int nt = K / BK;
    unsigned voffA, voffB;
    { int R, C; stage_rc(tid * 16, R, C); const int Rb = (R & ~31) + perm32(R & 31); voffA = (unsigned)(R * lda + C) * 2u; voffB = (unsigned)(Rb * ldb + C) * 2u; }
    const unsigned p1voffA = 64u * (unsigned)lda * 2u, p1voffB = 64u * (unsigned)ldb * 2u;
    const unsigned kstep = (unsigned)(BK * 2);
    const unsigned hsA = (unsigned)HALF * lda * 2, hsB = (unsigned)HALF * ldb * 2;
    const unsigned ldsw = (unsigned)wid * 1024u;
    const int aoff = lds_byte(wr * 64 + fr, fq * 8), boff = lds_byte(wc * 32 + fr, fq * 8);
#define PG8_SA(b, h) (((b) * 2 + (h)) * HTB)
#define PG8_SB(b, h) ((4 + (b) * 2 + (h)) * HTB)
#define PG8_STAGE(bufoff, goff, voff) do { _Pragma("unroll") for (int _i = 0; _i < 2; ++_i) \
        __builtin_amdgcn_raw_ptr_buffer_load_lds(rsrc, (PG8_LAS void*)(lds + (bufoff) + ldsw + _i * 8192), 16, (int)(voff), (int)((goff) + _i * p1##voff), 0, 0); } while (0)
#define PG8_LD8(addr) __builtin_shufflevector(*(const PG8_LAS i32x4*)(addr), *(const PG8_LAS i32x4*)((addr) + 1024), 0, 1, 2, 3, 4, 5, 6, 7)
#define PG8_LDA(dst, b, h) do { _Pragma("unroll") for (int m = 0; m < 4; ++m) dst[m] = PG8_LD8(lds + PG8_SA(b, h) + aoff + m * 2048); } while (0)
#define PG8_LDB(dst, b, h) do { _Pragma("unroll") for (int n = 0; n < 2; ++n) dst[n] = PG8_LD8(lds + PG8_SB(b, h) + boff + n * 2048); } while (0)
#define PG8_LO(v) __builtin_bit_cast(bf16x8, __builtin_shufflevector(v, v, 0, 1, 2, 3))
#define PG8_HI(v) __builtin_bit_cast(bf16x8, __builtin_shufflevector(v, v, 4, 5, 6, 7))
#define PG8_MMA(ai, bj, At, Bt) do { __builtin_amdgcn_s_setprio(1); \
        if constexpr (!F8) { _Pragma("unroll") for (int m = 0; m < 4; ++m) _Pragma("unroll") for (int n = 0; n < 2; ++n) { \
            acc[ai][bj][m][n] = __builtin_amdgcn_mfma_f32_16x16x32_bf16(PG8_LO(Bt[n]), PG8_LO(At[m]), acc[ai][bj][m][n], 0, 0, 0); \
            acc[ai][bj][m][n] = __builtin_amdgcn_mfma_f32_16x16x32_bf16(PG8_HI(Bt[n]), PG8_HI(At[m]), acc[ai][bj][m][n], 0, 0, 0); } } \
        else { _Pragma("unroll") for (int m = 0; m < 4; ++m) _Pragma("unroll") for (int n = 0; n < 2; ++n) \
            acc[ai][bj][m][n] = __builtin_amdgcn_mfma_scale_f32_16x16x128_f8f6f4(Bt[n], At[m], acc[ai][bj][m][n], 0, 0, 0, F8SC, 1, F8SC); } \
        __builtin_amdgcn_s_setprio(0); } while (0)
#define PG8_WAIT_V(n) asm volatile("s_waitcnt vmcnt(" #n ")" ::: "memory")
#define PG8_WAIT_L(n) asm volatile("s_waitcnt lgkmcnt(" #n ")" ::: "memory")
#define PG8_BAR __builtin_amdgcn_s_barrier()
#define PG8_SCHED __builtin_amdgcn_sched_barrier(0)
#define PG8_ZERO() do { _Pragma("unroll") for (int a = 0; a < 2; ++a) _Pragma("unroll") for (int b = 0; b < 2; ++b) _Pragma("unroll") for (int m = 0; m < 4; ++m) _Pragma("unroll") for (int n = 0; n < 2; ++n) acc[a][b][m][n] = (f32x4){0.f, 0.f, 0.f, 0.f}; } while (0)
    Unit cur, nxt; int ui = 0;
    if (!S.next(0, cur)) return;
    f32x4 acc[2][2][4][2];
    PG8_ZERO();
    i32x8 At[4], B0[2], B1[2];
    unsigned cA, cB; S.bases(cur, cA, cB); cA = __builtin_amdgcn_readfirstlane(cA); cB = __builtin_amdgcn_readfirstlane(cB);
    PG8_STAGE(PG8_SB(0, 0), cB, voffB); PG8_STAGE(PG8_SB(0, 1), cB + hsB, voffB); PG8_STAGE(PG8_SA(0, 0), cA, voffA); PG8_STAGE(PG8_SA(0, 1), cA + hsA, voffA);
    if (wr == 1) PG8_BAR;
    PG8_WAIT_V(2); PG8_BAR;
    PG8_STAGE(PG8_SB(1, 0), cB + kstep, voffB); PG8_STAGE(PG8_SA(1, 0), cA + kstep, voffA); PG8_STAGE(PG8_SB(1, 1), cB + hsB + kstep, voffB);
    PG8_WAIT_V(6); PG8_BAR;
    for (;;) {
        const bool has_next = S.next(ui + 1, nxt);
        unsigned nA = cA, nB = cB; if (has_next) { S.bases(nxt, nA, nB); nA = __builtin_amdgcn_readfirstlane(nA); nB = __builtin_amdgcn_readfirstlane(nB); }
#pragma unroll 1
        for (int t = 0; t < nt; t += 2) {
            const bool last = (t == nt - 2);
            const unsigned a1 = cA + (unsigned)(t + 1) * kstep;
            const unsigned a2 = last ? nA : cA + (unsigned)(t + 2) * kstep, b2 = last ? nB : cB + (unsigned)(t + 2) * kstep;
            const unsigned a3 = a2 + kstep, b3 = b2 + kstep;
            PG8_LDB(B0, 0, 0); PG8_LDB(B1, 0, 1); PG8_SCHED; PG8_LDA(At, 0, 0); PG8_STAGE(PG8_SA(1, 1), a1 + hsA, voffA);
            PG8_WAIT_V(8); PG8_WAIT_L(0); PG8_BAR; PG8_MMA(0, 0, At, B0); PG8_MMA(0, 1, At, B1); PG8_BAR; PG8_SCHED;
            PG8_LDA(At, 0, 1); PG8_STAGE(PG8_SB(0, 0), b2, voffB); PG8_STAGE(PG8_SB(0, 1), b2 + hsB, voffB); PG8_STAGE(PG8_SA(0, 0), a2, voffA);
            PG8_WAIT_V(8); PG8_WAIT_L(0); PG8_BAR; PG8_MMA(1, 0, At, B0); PG8_MMA(1, 1, At, B1); PG8_BAR; PG8_SCHED;
            PG8_LDB(B0, 1, 0); PG8_LDB(B1, 1, 1); PG8_SCHED; PG8_LDA(At, 1, 0); PG8_STAGE(PG8_SA(0, 1), a2 + hsA, voffA);
            PG8_WAIT_V(8); PG8_WAIT_L(0); PG8_BAR; PG8_MMA(0, 0, At, B0); PG8_MMA(0, 1, At, B1); PG8_BAR; PG8_SCHED;
            PG8_LDA(At, 1, 1); PG8_STAGE(PG8_SB(1, 0), b3, voffB); PG8_STAGE(PG8_SB(1, 1), b3 + hsB, voffB); PG8_STAGE(PG8_SA(1, 0), a3, voffA);
            PG8_WAIT_V(8); PG8_WAIT_L(0); PG8_BAR; PG8_MMA(1, 0, At, B0); PG8_MMA(1, 1, At, B1); PG8_BAR; PG8_SCHED;
        }
        if constexpr (ALIGN_EPI) { if (wr == 0) PG8_BAR; }
        bool keep; { int t2 = threadIdx.x; asm volatile("" : "+v"(t2)); const int w2 = __builtin_amdgcn_readfirstlane(t2 >> 6), l2 = t2 & 63; keep = E(acc, cur, w2 >> 2, w2 & 3, l2 & 15, l2 >> 4); }
        if (!has_next) break;
        if (!keep) PG8_ZERO();
        cur = nxt; cA = nA; cB = nB; ++ui;
        if constexpr (ALIGN_EPI) { if (wr == 1) PG8_BAR; }
    }
    PG8_WAIT_V(0);
    if constexpr (!ALIGN_EPI) { if (wr == 0) PG8_BAR; }
    PG8_BAR;
#undef PG8_SA
#undef PG8_SB
#undef PG8_STAGE
#undef PG8_LDA
#undef PG8_LDB
#undef PG8_LD8
#undef PG8_LO
#undef PG8_HI
#undef PG8_MMA
#undef PG8_WAIT_V
#undef PG8_WAIT_L
#undef PG8_BAR
#undef PG8_SCHED
#undef PG8_ZERO
}
}
namespace pg8 {
#define EPI_ROWLOOP _Pragma("unroll") for (int ai = 0; ai < 2; ++ai) _Pragma("unroll") for (int m = 0; m < 4; ++m)
struct EpiProj {
    bf16_t* O; int coloff, nq;
    __device__ __forceinline__ bool operator()(f32x4 (&acc)[2][2][4][2], const Unit& u, int wr, int wc, int fr, int fq) const {
        const int row0 = u.pm * BM + wr * 64 + fr, col0 = coloff + u.pn * BM + wc * 32 + 8 * fq;
        const float sc = (u.pn < nq) ? 0.125f : 1.0f;
        EPI_ROWLOOP { bf16_t* rowp = O + (size_t)(row0 + ai * HALF + m * 16) * PROJ_LD + col0;
#pragma unroll
            for (int bj = 0; bj < 2; ++bj) *(u32x4*)(rowp + bj * HALF) = pack8(acc[ai][bj][m][0] * sc, acc[ai][bj][m][1] * sc); }
        return false;
    }
};
__device__ __forceinline__ float dpp_prev_row(float lo15, float cur) {
    const int o = __builtin_amdgcn_update_dpp(0, __builtin_bit_cast(int, lo15), 0x121, 0xF, 0xF, false);
    return __builtin_bit_cast(float, __builtin_amdgcn_update_dpp(o, __builtin_bit_cast(int, cur), 0x111, 0xF, 0xF, false));
}
struct EpiShift {
    bf16_t* RKVp; bf16_t* LIN; float* SIDE0; float* SIDEL; const float* mu;
    __device__ __forceinline__ bool operator()(f32x4 (&acc)[2][2][4][2], const Unit& u, int wr, int wc, int fr, int fq) const {
        static_assert(DLORA % 32 == 0 && ALORA % 32 == 0 && GLORA % 32 == 0 && RW % 32 == 0, "segment boundaries are wave-uniform");
        const int row0 = u.pm * BM + wr * 64 + fr;
#pragma unroll
        for (int bj = 0; bj < 2; ++bj) {
            const int cgrp = u.pn * BM + bj * HALF + wc * 32;
            if (cgrp >= SHIFT_W) continue;
            const int c = cgrp + 8 * fq;
            const f32x4 mu0 = *(const f32x4*)(mu + c), mu1 = *(const f32x4*)(mu + c + 4);
            bf16_t* dbase; int ld, act = 0;
            if (cgrp < 3 * RW) { dbase = RKVp + c; ld = 3 * RW; }
            else if (cgrp < 3 * RW + DLORA) { dbase = LIN + (c - 3 * RW); ld = LORA_LD; act = 1; }
            else if (cgrp < 3 * RW + DLORA + ALORA) { dbase = LIN + 128 + (c - 3 * RW - DLORA); ld = LORA_LD; }
            else { dbase = LIN + 256 + (c - 3 * RW - DLORA - ALORA); ld = LORA_LD; act = 2; }
            const bool zpad = (cgrp == 3 * RW + DLORA - 32) || (cgrp == 3 * RW + DLORA + ALORA - 32);
#pragma unroll
            for (int ai = 0; ai < 2; ++ai) {
                const int g = u.pm * 4 + ai * 2 + wr;
#pragma unroll
                for (int m = 0; m < 4; ++m) {
                    f32x4 o[2];
#pragma unroll
                    for (int n = 0; n < 2; ++n) { const f32x4 cur = acc[ai][bj][m][n]; const f32x4 mm = n ? mu1 : mu0;
#pragma unroll
                        for (int j = 0; j < 4; ++j) { const float prv = dpp_prev_row(m > 0 ? acc[ai][bj][m > 0 ? m - 1 : 0][n][j] : 0.0f, cur[j]);
                            float v = cur[j] + (prv - cur[j]) * mm[j];
                            if (act == 1) v = 2.0f * fsigmoid(2.0f * v) - 1.0f; else if (act == 2) v = fsigmoid(v);
                            o[n][j] = v; } }
                    bf16_t* dp = dbase + (size_t)(row0 + ai * HALF + m * 16) * ld;
                    *(u32x4*)dp = pack8(o[0], o[1]);
                    if (zpad) { unsigned zz = 0u; asm volatile("" : "+v"(zz)); *(u32x4*)(dp + 32) = (u32x4){zz, zz, zz, zz}; }
                    if (m == 0 && fr == 0) { float* sp = SIDE0 + (size_t)g * SEG_PAD + c; *(f32x4*)sp = acc[ai][bj][0][0]; *(f32x4*)(sp + 4) = acc[ai][bj][0][1]; }
                    if (m == 3 && fr == 15) { float* sp = SIDEL + (size_t)g * SEG_PAD + c; *(f32x4*)sp = acc[ai][bj][3][0]; *(f32x4*)(sp + 4) = acc[ai][bj][3][1]; }
                } }
        }
        return false;
    }
};
struct EpiGate {
    bf16_t* O;
    __device__ __forceinline__ bool operator()(f32x4 (&acc)[2][2][4][2], const Unit& u, int wr, int wc, int fr, int fq) const {
        const int row0 = u.pm * BM + wr * 64 + fr, d0 = u.pn * HALF + wc * 32 + 8 * fq;
        EPI_ROWLOOP { bf16_t* rowp = O + (size_t)(row0 + ai * HALF + m * 16) * PROJ_LD + d0;
            f32x4 rt[2], gb[2];
#pragma unroll
            for (int n = 0; n < 2; ++n)
#pragma unroll
                for (int j = 0; j < 4; ++j) { const float ea = __expf(-acc[ai][0][m][n][j]), eb = fminf(__expf(-acc[ai][1][m][n][j]), 1e30f);
                    gb[n][j] = __builtin_amdgcn_rcpf(1.0f + eb); rt[n][j] = (1.0f + eb) * __builtin_amdgcn_rcpf(1.0f + ea); }
            *(u32x4*)(rowp + PJ_GA) = pack8(rt[0], rt[1]); *(u32x4*)(rowp + PJ_GB) = pack8(gb[0], gb[1]); }
        return false;
    }
};
struct EpiBf16 {
    bf16_t* O; int ldc;
    __device__ __forceinline__ bool operator()(f32x4 (&acc)[2][2][4][2], const Unit& u, int wr, int wc, int fr, int fq) const {
        const int row0 = u.pm * BM + wr * 64 + fr, col0 = u.pn * BM + wc * 32 + 8 * fq;
        EPI_ROWLOOP { bf16_t* rowp = O + (size_t)(row0 + ai * HALF + m * 16) * ldc + col0;
#pragma unroll
            for (int bj = 0; bj < 2; ++bj) *(u32x4*)(rowp + bj * HALF) = pack8(acc[ai][bj][m][0], acc[ai][bj][m][1]); }
        return false;
    }
};
template <bool ISDEC> struct EpiLoraA {
    float* OUT; const float* par;
    __device__ __forceinline__ bool operator()(f32x4 (&acc)[2][2][4][2], const Unit& u, int wr, int wc, int fr, int fq) const {
        const int row0 = u.pm * BM + wr * 64 + fr, col0 = u.pn * BM + wc * 32 + 8 * fq;
        f32x4 pv[2][2];
#pragma unroll
        for (int bj = 0; bj < 2; ++bj)
#pragma unroll
            for (int n = 0; n < 2; ++n) pv[bj][n] = *(const f32x4*)(par + col0 + bj * HALF + 4 * n);
        EPI_ROWLOOP { float* rowp = OUT + (size_t)(row0 + ai * HALF + m * 16) * RW + col0;
#pragma unroll
            for (int bj = 0; bj < 2; ++bj)
#pragma unroll
                for (int n = 0; n < 2; ++n) { f32x4 v = acc[ai][bj][m][n] + pv[bj][n];
#pragma unroll
                    for (int j = 0; j < 4; ++j) {
                        if (ISDEC) v[j] = -0.60653065971263342f * fsigmoid(v[j]);
                        else v[j] = fsigmoid(v[j]); }
                    *(f32x4*)(rowp + bj * HALF + 4 * n) = v; } }
        return false;
    }
};
struct EpiIclr {
    bf16_t* OUT; const float* par;
    __device__ __forceinline__ bool operator()(f32x4 (&acc)[2][2][4][2], const Unit& u, int wr, int wc, int fr, int fq) const {
        const int row0 = u.pm * BM + wr * 64 + fr, col0 = u.pn * BM + wc * 32 + 8 * fq;
        f32x4 pv[2][2];
#pragma unroll
        for (int bj = 0; bj < 2; ++bj)
#pragma unroll
            for (int n = 0; n < 2; ++n) pv[bj][n] = *(const f32x4*)(par + col0 + bj * HALF + 4 * n);
        EPI_ROWLOOP { bf16_t* rowp = OUT + (size_t)(row0 + ai * HALF + m * 16) * RW + col0;
#pragma unroll
            for (int bj = 0; bj < 2; ++bj) { f32x4 v0 = acc[ai][bj][m][0] + pv[bj][0], v1 = acc[ai][bj][m][1] + pv[bj][1];
#pragma unroll
                for (int j = 0; j < 4; ++j) { v0[j] = fsigmoid(v0[j]); v1[j] = fsigmoid(v1[j]); }
                *(u32x4*)(rowp + bj * HALF) = pack8(v0, v1); } }
        return false;
    }
};
struct EpiMerged {
    const bf16_t* PROJ; bf16_t* O;
    __device__ __forceinline__ bool operator()(f32x4 (&acc)[2][2][4][2], const Unit& u, int wr, int wc, int fr, int fq) const {
        const int row0 = u.pm * BM + wr * 64 + fr, col0 = u.pn * BM + wc * 32 + 8 * fq;
        EPI_ROWLOOP { const int row = row0 + ai * HALF + m * 16; const bf16_t* gp = PROJ + (size_t)row * PROJ_LD + col0;
#pragma unroll
            for (int bj = 0; bj < 2; ++bj) {
                if (u.aux == 0) {
                    const u32x4 ga = *(const u32x4*)(gp + PJ_GA + bj * HALF);
                    const f32x4 a0 = (f32x4){bflo(ga.x), bfhi(ga.x), bflo(ga.y), bfhi(ga.y)}, a1 = (f32x4){bflo(ga.z), bfhi(ga.z), bflo(ga.w), bfhi(ga.w)};
                    acc[ai][bj][m][0] = acc[ai][bj][m][0] * a0; acc[ai][bj][m][1] = acc[ai][bj][m][1] * a1;
                } else {
                    const u32x4 gb = *(const u32x4*)(gp + PJ_GB + bj * HALF);
                    const f32x4 b0 = (f32x4){bflo(gb.x), bfhi(gb.x), bflo(gb.y), bfhi(gb.y)}, b1 = (f32x4){bflo(gb.z), bfhi(gb.z), bflo(gb.w), bfhi(gb.w)};
                    { const f32x4 o0 = acc[ai][bj][m][0] * b0 * ACT8_SCALE, o1 = acc[ai][bj][m][1] * b1 * ACT8_SCALE;
                      int w0 = __builtin_amdgcn_cvt_pk_fp8_f32(o0[0], o0[1], 0, false); w0 = __builtin_amdgcn_cvt_pk_fp8_f32(o0[2], o0[3], w0, true);
                      int w1 = __builtin_amdgcn_cvt_pk_fp8_f32(o1[0], o1[1], 0, false); w1 = __builtin_amdgcn_cvt_pk_fp8_f32(o1[2], o1[3], w1, true);
                      *(v2u*)((unsigned char*)O + (size_t)row * D + col0 + bj * HALF) = (v2u){(unsigned)w0, (unsigned)w1}; }
                } } }
        return u.aux == 0;
    }
};
struct EpiZ {
    const float* X; float* Z;
    __device__ __forceinline__ bool operator()(f32x4 (&acc)[2][2][4][2], const Unit& u, int wr, int wc, int fr, int fq) const {
        const int row0 = u.pm * BM + wr * 64 + fr, col0 = u.pn * BM + wc * 32 + 8 * fq;
        EPI_ROWLOOP { const size_t off = (size_t)(row0 + ai * HALF + m * 16) * D + col0;
#pragma unroll
            for (int bj = 0; bj < 2; ++bj)
#pragma unroll
                for (int n = 0; n < 2; ++n) { const f32x4 xv = *(const f32x4*)(X + off + bj * HALF + 4 * n); *(f32x4*)(Z + off + bj * HALF + 4 * n) = xv * DN_ALPHA + acc[ai][bj][m][n]; } }
        return false;
    }
};
struct EpiSwiglu {
    unsigned char* ACT; const float* bgu;
    __device__ __forceinline__ bool operator()(f32x4 (&acc)[2][2][4][2], const Unit& u, int wr, int wc, int fr, int fq) const {
        const int row0 = u.pm * BM + wr * 64 + fr, col0 = u.pn * HALF + wc * 32 + 8 * fq;
        const float* bp = bgu + (size_t)u.aux * (2 * FF) + col0;
        f32x4 bg[2], bu[2];
#pragma unroll
        for (int n = 0; n < 2; ++n) { bg[n] = *(const f32x4*)(bp + 4 * n); bu[n] = *(const f32x4*)(bp + FF + 4 * n); }
        EPI_ROWLOOP { f32x4 o[2];
#pragma unroll
            for (int n = 0; n < 2; ++n) { const f32x4 g = acc[ai][0][m][n] + bg[n], uu = acc[ai][1][m][n] + bu[n];
#pragma unroll
                for (int j = 0; j < 4; j += 2) {
                    f32x2 gc, uc; gc[0] = fminf(g[j], 7.0f); gc[1] = fminf(g[j + 1], 7.0f);
                    uc[0] = __builtin_amdgcn_fmed3f(uu[j], -7.0f, 7.0f); uc[1] = __builtin_amdgcn_fmed3f(uu[j + 1], -7.0f, 7.0f);
                    const f32x2 t = gc * (f32x2){-2.4554669595930156f, -2.4554669595930156f};
                    f32x2 d; d[0] = __builtin_amdgcn_exp2f(t[0]); d[1] = __builtin_amdgcn_exp2f(t[1]);
                    d = d + (f32x2){1.0f, 1.0f};
                    f32x2 r; r[0] = __builtin_amdgcn_rcpf(d[0]); r[1] = __builtin_amdgcn_rcpf(d[1]);
                    const f32x2 s = gc * r, oo = __builtin_elementwise_fma(uc, s, s);
                    o[n][j] = oo[0]; o[n][j + 1] = oo[1]; } }
            int w0 = __builtin_amdgcn_cvt_pk_fp8_f32(o[0][0], o[0][1], 0, false); w0 = __builtin_amdgcn_cvt_pk_fp8_f32(o[0][2], o[0][3], w0, true);
            int w1 = __builtin_amdgcn_cvt_pk_fp8_f32(o[1][0], o[1][1], 0, false); w1 = __builtin_amdgcn_cvt_pk_fp8_f32(o[1][2], o[1][3], w1, true);
            *(v2u*)(ACT + (size_t)(row0 + ai * HALF + m * 16) * FF + col0) = (v2u){(unsigned)w0, (unsigned)w1}; }
        return false;
    }
};
struct EpiDown {
    unsigned char* YS; const float* bdn; const int* rowslot; const float* roww;
    __device__ __forceinline__ bool operator()(f32x4 (&acc)[2][2][4][2], const Unit& u, int wr, int wc, int fr, int fq) const {
        const int row0 = u.pm * BM + wr * 64 + fr, col0 = u.pn * BM + wc * 32 + 8 * fq;
        const float* bp = bdn + (size_t)u.aux * D + col0;
        f32x4 bv[2][2];
#pragma unroll
        for (int bj = 0; bj < 2; ++bj)
#pragma unroll
            for (int n = 0; n < 2; ++n) bv[bj][n] = *(const f32x4*)(bp + bj * HALF + 4 * n);
        int slots[8]; float ws_[8];
#pragma unroll
        for (int q = 0; q < 8; ++q) { const int row = row0 + (q >> 2) * HALF + (q & 3) * 16; slots[q] = rowslot[row]; ws_[q] = roww[row]; }
        EPI_ROWLOOP { const int slot = slots[ai * 4 + m]; const float w = ws_[ai * 4 + m] * YS_SCALE;
            if (slot >= 0) { unsigned char* rowp = YS + (size_t)slot * D + col0;
#pragma unroll
                for (int bj = 0; bj < 2; ++bj) { const f32x4 o0 = (acc[ai][bj][m][0] + bv[bj][0]) * w, o1 = (acc[ai][bj][m][1] + bv[bj][1]) * w;
                    int w0 = __builtin_amdgcn_cvt_pk_fp8_f32(o0[0], o0[1], 0, false); w0 = __builtin_amdgcn_cvt_pk_fp8_f32(o0[2], o0[3], w0, true);
                    int w1 = __builtin_amdgcn_cvt_pk_fp8_f32(o1[0], o1[1], 0, false); w1 = __builtin_amdgcn_cvt_pk_fp8_f32(o1[2], o1[3], w1, true);
                    *(v2u*)(rowp + bj * HALF) = (v2u){(unsigned)w0, (unsigned)w1}; } } }
        return false;
    }
};
#undef EPI_ROWLOOP
}

#define XB_TMO      128
#define XB_XCNT(j)  (256  + 64 * (j))
#define XB_XSUB(j)  (1280 + 64 * (j))
#define XB_XGEN(j)  (2304 + 64 * (j))
#define XB_TOP      3328
#define XB_TOPGEN   3392
#define XCD_BAR_WORDS 3456
#define XB_SPIN_CAP (1u << 18)

__device__ __forceinline__ unsigned xb_ld(unsigned* p)              { return __hip_atomic_load(p, __ATOMIC_RELAXED, __HIP_MEMORY_SCOPE_AGENT); }
__device__ __forceinline__ unsigned xb_add(unsigned* p, unsigned v) { return __hip_atomic_fetch_add(p, v, __ATOMIC_RELAXED, __HIP_MEMORY_SCOPE_AGENT); }
__device__ __forceinline__ unsigned xb_xcc_id() { return (unsigned)__builtin_amdgcn_s_getreg((3 << 11) | 20) & 0xFu; }
#define XB_SPIN(cond, bar) do { unsigned _sp = 0; while (cond) { __builtin_amdgcn_s_sleep(1); \
    if ((++_sp & 255u) == 0u) { if (xb_ld(&(bar)[XB_TMO])) break; if (_sp > XB_SPIN_CAP) { atomicAdd(&(bar)[XB_TMO], 1u); break; } } } } while (0)

struct XcdBarrier {
    unsigned* bar; unsigned x;
    volatile LAS unsigned* st;
};

__device__ __forceinline__ XcdBarrier xcd_barrier_post(unsigned* bar, volatile LAS unsigned* st) {
    XcdBarrier b; b.bar = bar; b.x = xb_xcc_id(); b.st = st;
    if (threadIdx.x == 0) (void)xb_add(&bar[XB_XCNT(b.x)], 1u);
    return b;
}
__device__ __forceinline__ void xcd_barrier_complete(unsigned* bar, unsigned x, unsigned& nloc, unsigned& nx) {
    const unsigned G = gridDim.x * gridDim.y * gridDim.z;
    unsigned sum, cnt, mine, sp = 0u;
    for (;;) {
        sum = 0u; cnt = 0u; mine = 0u;
#pragma unroll
        for (unsigned j = 0; j < 16; ++j) { const unsigned c = xb_ld(&bar[XB_XCNT(j)]); sum += c; cnt += (c > 0u) ? 1u : 0u; mine = (j == x) ? c : mine; }
        if (sum == G) break;
        __builtin_amdgcn_s_sleep(1);
        if ((++sp & 255u) == 0u) { if (xb_ld(&bar[XB_TMO])) break; if (sp > XB_SPIN_CAP) { atomicAdd(&bar[XB_TMO], 1u); break; } }
    }
    nloc = mine > 0u ? mine : 1u; nx = cnt > 0u ? cnt : 1u;
}

__device__ __forceinline__ void xcd_barrier(const XcdBarrier& b) {
    asm volatile("s_waitcnt vmcnt(0)" ::: "memory");
    __syncthreads();
    if (threadIdx.x == 0) {
        unsigned* bar = b.bar;
        __builtin_amdgcn_s_waitcnt(0);
        unsigned nloc = b.st[0], nx = b.st[1];
        if (nloc == 0u) { xcd_barrier_complete(bar, b.x, nloc, nx); b.st[0] = nloc; b.st[1] = nx; }
        const unsigned old = xb_add(&bar[XB_XSUB(b.x)], 1u);
        const unsigned gen = old / nloc;
        if (old + 1u == (gen + 1u) * nloc) {
            __builtin_amdgcn_fence(__ATOMIC_RELEASE, "agent");
            asm volatile("s_waitcnt vmcnt(0)" ::: "memory");
            const unsigned og = xb_add(&bar[XB_TOP], 1u);
            const unsigned tg = og / nx;
            if (og + 1u == (tg + 1u) * nx) xb_add(&bar[XB_TOPGEN], 1u);
            else XB_SPIN(xb_ld(&bar[XB_TOPGEN]) == tg, bar);
            __builtin_amdgcn_fence(__ATOMIC_ACQUIRE, "agent");
            xb_add(&bar[XB_XGEN(b.x)], 1u);
            asm volatile("s_waitcnt vmcnt(0)" ::: "memory");
        } else {
            XB_SPIN(xb_ld(&bar[XB_XGEN(b.x)]) == gen, bar);
            __builtin_amdgcn_fence(__ATOMIC_ACQUIRE, "agent");
            asm volatile("s_waitcnt vmcnt(0)" ::: "memory");
        }
    }
    __syncthreads();
}
struct Frame {
    LAS unsigned char* lds;
    volatile LAS unsigned* MISC;
    gu32* ctl;
    int tid, lane, wave;
    int vcu, G;
    unsigned char* ws;
    __amdgpu_buffer_rsrc_t rsrc;
};

#define PHASE_FRAME(F0) Frame F = (F0); { int t_ = threadIdx.x; asm volatile("" : "+v"(t_)); F.tid = t_; F.lane = t_ & 63; F.wave = __builtin_amdgcn_readfirstlane(t_ >> 6); }

__device__ __forceinline__ void tr_item(const float* W, size_t ldw, int k0, int c0, bf16* WT, size_t ldt, int drow0, LAS float* scr, int lane) {
    const int kr = lane >> 4, cq = lane & 15;
    f32x4 v[16];
#pragma unroll
    for (int i = 0; i < 16; ++i) v[i] = *(const GAS f32x4*)(W + (size_t)(k0 + 4 * i + kr) * ldw + c0 + 4 * cq);
#pragma unroll
    for (int i = 0; i < 16; ++i)
#pragma unroll
        for (int j = 0; j < 4; ++j) scr[(4 * cq + j) * 65 + 4 * i + kr] = v[i][j];
    LDS_WAIT(); asm volatile("" ::: "memory");
    const int c = lane & 7;
#pragma unroll
    for (int jj = 0; jj < 8; ++jj) { const int n = (lane >> 3) + 8 * jj; const LAS float* s = scr + n * 65 + 8 * c;
        v4u o; o.x = pk2(s[0], s[1]); o.y = pk2(s[2], s[3]); o.z = pk2(s[4], s[5]); o.w = pk2(s[6], s[7]);
        *(GAS v4u*)(WT + (size_t)(drow0 + n) * ldt + k0 + 8 * c) = o; }
    LDS_WAIT(); asm volatile("" ::: "memory");
}

typedef short s16x2 __attribute__((ext_vector_type(2)));
struct MoeItem { __amdgpu_buffer_rsrc_t rs; unsigned soff, rstep; int ldw, k0; unsigned char* WT; size_t ldt; int drow; };
__device__ __forceinline__ void tr8_load(const MoeItem& m, f32x4 (&v)[16], int lane) {
    const int kr = lane >> 4, cq = lane & 15;
    const int voff = (kr * m.ldw + 4 * cq) * 4;
#pragma unroll
    for (int i = 0; i < 16; ++i) v[i] = __builtin_bit_cast(f32x4, __builtin_amdgcn_raw_buffer_load_b128(m.rs, voff, (int)(m.soff + (unsigned)i * m.rstep), 0));
}
__device__ __forceinline__ void tr8_finish(const f32x4 (&v)[16], const MoeItem& m, LAS float* scr_, int lane) {
    LAS unsigned char* scr = (LAS unsigned char*)scr_;
    const int kr = lane >> 4, cq = lane & 15;
#pragma unroll
    for (int j = 0; j < 4; ++j) { unsigned w[4];
#pragma unroll
        for (int q = 0; q < 4; ++q) { s16x2 t = {0, 0};
            t = __builtin_amdgcn_cvt_scalef32_pk_fp8_f32(t, v[4 * q][j], v[4 * q + 1][j], F8_CVT_SCALE, false);
            t = __builtin_amdgcn_cvt_scalef32_pk_fp8_f32(t, v[4 * q + 2][j], v[4 * q + 3][j], F8_CVT_SCALE, true);
            w[q] = __builtin_bit_cast(unsigned, t); }
        *(LAS v4u*)(scr + (4 * cq + j) * 80 + kr * 16) = (v4u){w[0], w[1], w[2], w[3]}; }
    LDS_WAIT(); asm volatile("" ::: "memory");
    const int qd = lane & 3;
#pragma unroll
    for (int ps = 0; ps < 4; ++ps) { const int n = (lane >> 2) + 16 * ps; const LAS unsigned char* s = scr + n * 80 + qd * 4;
        const unsigned d0 = *(const LAS unsigned*)(s), d1 = *(const LAS unsigned*)(s + 16), d2 = *(const LAS unsigned*)(s + 32), d3 = *(const LAS unsigned*)(s + 48);
        const unsigned t0 = __builtin_amdgcn_perm(d1, d0, 0x05010400u), t1 = __builtin_amdgcn_perm(d1, d0, 0x07030602u), t2 = __builtin_amdgcn_perm(d3, d2, 0x05010400u), t3 = __builtin_amdgcn_perm(d3, d2, 0x07030602u);
        const v4u o = (v4u){__builtin_amdgcn_perm(t2, t0, 0x05040100u), __builtin_amdgcn_perm(t2, t0, 0x07060302u), __builtin_amdgcn_perm(t3, t1, 0x05040100u), __builtin_amdgcn_perm(t3, t1, 0x07060302u)};
        *(GAS v4u*)(m.WT + (size_t)(m.drow + n) * m.ldt + m.k0 + 16 * qd) = o; }
    LDS_WAIT(); asm volatile("" ::: "memory");
}
constexpr int MOE_J4 = 32 * 32 * 64, MOE_J5 = 32 * 32 * 32, MOE_NITEMS = MOE_J4 + MOE_J5;
__device__ __forceinline__ MoeItem moe_item(int r, const float* w_gu, const float* w_down, unsigned char* ws) {
    MoeItem m;
    if (r < MOE_J4) { const int e = r / 2048, q = r % 2048, kb = q / 64, cb = q % 64, c0 = cb * 64; const int cc = c0 & 2047;
        m.rs = __builtin_amdgcn_make_buffer_rsrc((void*)w_gu, 0, 0xffffffff, 0x00020000); m.ldw = 2 * FF; m.k0 = kb * 64;
        m.soff = (unsigned)(((size_t)e * D * 2 * FF + (size_t)kb * 64 * (2 * FF) + c0) * 4); m.rstep = 4u * (2 * FF) * 4u;
        m.WT = ws + WS_WGUT + (size_t)e * 2 * FF * D; m.ldt = D; m.drow = (cc >> 7) * 256 + (c0 >= 2048 ? 128 : 0) + (cc & 127); }
    else { r -= MOE_J4; const int e = r / 1024, q = r % 1024, kb = q / 32, cb = q % 32;
        m.rs = __builtin_amdgcn_make_buffer_rsrc((void*)w_down, 0, 0xffffffff, 0x00020000); m.ldw = D; m.k0 = kb * 64;
        m.soff = (unsigned)(((size_t)e * FF * D + (size_t)kb * 64 * D + cb * 64) * 4); m.rstep = 4u * D * 4u;
        m.WT = ws + WS_WDNT + (size_t)e * D * FF; m.ldt = FF; m.drow = cb * 64; }
    return m;
}
__device__ __forceinline__ MoeItem f8_item(const float* W, int ldw, int k0, int c0, unsigned char* WT, size_t ldt, int drow) {
    MoeItem m; m.rs = __builtin_amdgcn_make_buffer_rsrc((void*)W, 0, 0xffffffff, 0x00020000); m.ldw = ldw; m.k0 = k0;
    m.soff = (unsigned)(((size_t)k0 * ldw + c0) * 4); m.rstep = 4u * (unsigned)ldw * 4u; m.WT = WT; m.ldt = ldt; m.drow = drow; return m;
}

struct In {
    const float *x, *w_in, *rel_bias, *shift_mu, *w0, *w_up, *a0, *a_up, *g_up, *k_k, *k_a, *r_k, *lnx_w, *lnx_b, *proj_a, *proj_b, *w_out,
                *ln1_w, *ln1_b, *w_router, *b_router, *w_gu, *b_gu, *w_down, *b_down, *ln2_w, *ln2_b;
};

__device__ __forceinline__ void p0_prologue(Frame& F0, const In& I) {
    PHASE_FRAME(F0);
    LAS float* scr = (LAS float*)(F.lds + F.wave * 16640);
    const int gw = F.vcu * NWAVES + F.wave, NGW = F.G * NWAVES;
    unsigned char* ws = F.ws;
    constexpr int J0 = 32 * 167, J1 = 16 * 32, J2 = 16 * 32, J3 = 32 * 32;
    constexpr int NITEMS = J0 + J1 + J2 + J3;
    for (int it = gw; it < NITEMS; it += NGW) {
        int r = it;
        if (r < J0) { const int kb = r / 167, cb = r % 167, c0 = cb * 64; bf16* dst; int drow;
            if (c0 < 3072) { f32x4 tv[16];
                   const MoeItem m = (c0 < 2048) ? f8_item(I.w_in, D_IN, kb * 64, c0, (unsigned char*)(ws + WS_WQK8), D, c0) : f8_item(I.w_in, D_IN, kb * 64, c0, (unsigned char*)(ws + WS_WV8), D, c0 - 2048);
                   tr8_load(m, tv, F.lane); tr8_finish(tv, m, scr, F.lane); continue; }
            else if (c0 < 6592) { f32x4 tv[16]; const MoeItem m = f8_item(I.w_in, D_IN, kb * 64, c0, (unsigned char*)(ws + WS_WSV8), D, c0 - 3072);
                   tr8_load(m, tv, F.lane); tr8_finish(tv, m, scr, F.lane); continue; }
            else { f32x4 tv[16]; const int cg = c0 - 6592, d0 = cg & 2047; const MoeItem m = f8_item(I.w_in, D_IN, kb * 64, c0, (unsigned char*)(ws + WS_WG8), D, (d0 >> 7) * 256 + (cg >= 2048 ? 128 : 0) + (d0 & 127));
                   tr8_load(m, tv, F.lane); tr8_finish(tv, m, scr, F.lane); continue; }
            (void)dst; (void)drow; continue; } r -= J0;
        if (r < J1) { const int kb = r / 32, cb = r % 32; f32x4 tv[16]; const MoeItem m = f8_item(I.proj_a, D, kb * 64, cb * 64, (unsigned char*)(ws + WS_PAT), AW, cb * 64); tr8_load(m, tv, F.lane); tr8_finish(tv, m, scr, F.lane); continue; } r -= J1;
        if (r < J2) { const int kb = r / 32, cb = r % 32; f32x4 tv[16]; const MoeItem m = f8_item(I.proj_b, D, kb * 64, cb * 64, (unsigned char*)(ws + WS_PBT), RW, cb * 64); tr8_load(m, tv, F.lane); tr8_finish(tv, m, scr, F.lane); continue; } r -= J2;
        { const int kb = r / 32, cb = r % 32; f32x4 tv[16]; const MoeItem m = f8_item(I.w_out, D, kb * 64, cb * 64, (unsigned char*)(ws + WS_WOT), D, cb * 64);
          tr8_load(m, tv, F.lane); tr8_finish(tv, m, scr, F.lane); }
    }
    const int gt = F.vcu * (NWAVES * 64) + F.tid, NGT = F.G * NWAVES * 64;
    for (int i = gt; i < 2048 * 256; i += NGT) { const int n = i >> 8, k = i & 255; float v = 0.f;
        if (n < 1024) { if (k < DLORA) v = I.w_up[(size_t)k * RW + n]; }
        else { if (k >= 128 && k < 128 + ALORA) v = I.a_up[(size_t)(k - 128) * RW + (n - 1024)]; }
        ((bf16*)(ws + WS_WLA))[i] = (bf16)f2bf(v); }
    for (int i = gt; i < 1024 * 256; i += NGT) { const int n = i >> 8, k = i & 255; ((bf16*)(ws + WS_WLG))[i] = (bf16)f2bf(I.g_up[(size_t)k * RW + n]); }
    for (int i = gt; i < 64 * D / 16; i += NGT) ((GAS v4u*)((unsigned char*)(ws + WS_WSV8) + (size_t)SHIFT_W * D))[i] = (v4u){0u, 0u, 0u, 0u};
    for (int i = gt; i < RROWS; i += NGT) ((int*)(ws + WS_ROWSLOT))[i] = -1;
    for (size_t i = gt; i < (size_t)T * D / 8; i += NGT) { const f32x4 a = ((const GAS f32x4*)I.x)[2 * i], b = ((const GAS f32x4*)I.x)[2 * i + 1];
        int w0 = __builtin_amdgcn_cvt_pk_fp8_f32(a.x, a.y, 0, false); w0 = __builtin_amdgcn_cvt_pk_fp8_f32(a.z, a.w, w0, true);
        int w1 = __builtin_amdgcn_cvt_pk_fp8_f32(b.x, b.y, 0, false); w1 = __builtin_amdgcn_cvt_pk_fp8_f32(b.z, b.w, w1, true);
        ((GAS v2u*)(ws + WS_XB8))[i] = (v2u){(unsigned)w0, (unsigned)w1}; }
}

constexpr int P8_HS = 0, P8_PITCH = 2052, P8_PART = 131328, P8_LOG = 147712, P8_HIST = 149760;
template <bool SKIP_MIX>
__device__ __forceinline__ void p8_ln_router(Frame& F0, const In& I) {
    PHASE_FRAME(F0);
    LAS float* hs = (LAS float*)(F.lds + P8_HS); LAS float* part = (LAS float*)(F.lds + P8_PART); LAS float* lg = (LAS float*)(F.lds + P8_LOG); LAS int* hist = (LAS int*)(F.lds + P8_HIST);
    const int lane = F.lane, w = F.wave;
    if (F.tid < 32) hist[F.tid] = 0;
    const int kq = lane >> 4, col = lane & 15;
    float ln_w[32], ln_b[32];
#pragma unroll
    for (int j = 0; j < 8; ++j) { const f32x4 a = *(const GAS f32x4*)(I.ln1_w + 4 * lane + 256 * j), b = *(const GAS f32x4*)(I.ln1_b + 4 * lane + 256 * j);
#pragma unroll
        for (int e = 0; e < 4; ++e) { ln_w[4 * j + e] = a[e]; ln_b[4 * j + e] = b[e]; } }
    __syncthreads();
    const float* zsrc = I.x; const bf16* mixb = (const bf16*)(F.ws + WS_Z);
    for (int g = F.vcu; g < T / 16; g += F.G) {
        const int tok0 = g * 16;
        { f32x4 va[8], vb[8];
          const size_t tokA = (size_t)(tok0 + 2 * w), tokB = tokA + 1;
          const GAS f32x4* zra = (const GAS f32x4*)(zsrc + tokA * D) + lane; const GAS f32x4* zrb = (const GAS f32x4*)(zsrc + tokB * D) + lane;
          const GAS v2u* mra = (const GAS v2u*)(mixb + tokA * D) + lane; const GAS v2u* mrb = (const GAS v2u*)(mixb + tokB * D) + lane;
          v2u ma[8], mb[8];
#pragma unroll
          for (int j = 0; j < 8; ++j) { va[j] = zra[64 * j]; vb[j] = zrb[64 * j]; if (!SKIP_MIX) { ma[j] = mra[64 * j]; mb[j] = mrb[64 * j]; } }
#pragma unroll
          for (int j = 0; j < 8; ++j) { va[j] = va[j] * DN_ALPHA; vb[j] = vb[j] * DN_ALPHA;
              if (!SKIP_MIX) { va[j] += (f32x4){bflo(ma[j].x), bfhi(ma[j].x), bflo(ma[j].y), bfhi(ma[j].y)}; vb[j] += (f32x4){bflo(mb[j].x), bfhi(mb[j].x), bflo(mb[j].y), bfhi(mb[j].y)}; } }
#pragma unroll
          for (int tt = 0; tt < 2; ++tt) {
            const int tl = 2 * w + tt; const size_t tok = (size_t)(tok0 + tl);
            f32x4 v[8]; float s = 0.f;
#pragma unroll
            for (int j = 0; j < 8; ++j) { v[j] = tt ? vb[j] : va[j]; s += (v[j].x + v[j].y) + (v[j].z + v[j].w); }
            const float mean = wave_sum(s) * (1.f / D); float s2 = 0.f;
#pragma unroll
            for (int j = 0; j < 8; ++j) { v[j] = v[j] - mean; s2 += (v[j].x * v[j].x + v[j].y * v[j].y) + (v[j].z * v[j].z + v[j].w * v[j].w); }
            const float rstd = 1.f / sqrtf(wave_sum(s2) * (1.f / D) + LN_EPS);
            GAS v2u* h1 = (GAS v2u*)((bf16*)(F.ws + WS_H1) + tok * D) + lane;
            GAS unsigned* h1b = (GAS unsigned*)((unsigned char*)(F.ws + WS_H1B) + tok * D) + lane;
#pragma unroll
            for (int j = 0; j < 8; ++j) { f32x4 h;
#pragma unroll
                for (int e = 0; e < 4; ++e) h[e] = v[j][e] * rstd * ln_w[4 * j + e] + ln_b[4 * j + e];
                h1[64 * j] = (v2u){pg8::cvt_pk_bf16(h.x, h.y), pg8::cvt_pk_bf16(h.z, h.w)}; { int w8 = __builtin_amdgcn_cvt_pk_fp8_f32(h.x, h.y, 0, false); w8 = __builtin_amdgcn_cvt_pk_fp8_f32(h.z, h.w, w8, true); h1b[64 * j] = (unsigned)w8; }
                *(LAS f32x4*)(hs + tl * P8_PITCH + 4 * lane + 256 * j) = h; }
          } }
        __syncthreads();
        f32x4 c0 = (f32x4){0.f, 0.f, 0.f, 0.f}, c1 = c0;
        const LAS float* ap = hs + col * P8_PITCH + 256 * w + 4 * kq;
        const float* bp = I.w_router + (size_t)(256 * w + 4 * kq) * NE + col;
#pragma unroll 4
        for (int kk = 0; kk < 16; ++kk) {
            const f32x4 a = *(const LAS f32x4*)(ap + 16 * kk);
#pragma unroll
            for (int e = 0; e < 4; ++e) {
                const float b0 = bp[(size_t)(16 * kk + e) * NE], b1 = bp[(size_t)(16 * kk + e) * NE + 16];
                c0 = __builtin_amdgcn_mfma_f32_16x16x4f32(a[e], b0, c0, 0, 0, 0);
                c1 = __builtin_amdgcn_mfma_f32_16x16x4f32(a[e], b1, c1, 0, 0, 0);
            }
        }
#pragma unroll
        for (int i = 0; i < 4; ++i) { part[(w * 16 + 4 * kq + i) * 32 + col] = c0[i]; part[(w * 16 + 4 * kq + i) * 32 + 16 + col] = c1[i]; }
        __syncthreads();
        { const int tl = F.tid >> 5, e = F.tid & 31; float s = I.b_router[e];
#pragma unroll
            for (int ww = 0; ww < 8; ++ww) s += part[(ww * 16 + tl) * 32 + e];
            lg[tl * 32 + e] = s; }
        __syncthreads();
        if (F.tid < 16) {
            const int tl = F.tid; float lv[32];
#pragma unroll
            for (int e = 0; e < 32; ++e) lv[e] = lg[tl * 32 + e];
            int ti[4]; float tv[4];
#pragma unroll
            for (int k = 0; k < 4; ++k) { float best = -3.4e38f; int bi = 0;
#pragma unroll
                for (int e = 0; e < 32; ++e) { const bool tk = lv[e] > best; best = tk ? lv[e] : best; bi = tk ? e : bi; }
                ti[k] = bi; tv[k] = best;
#pragma unroll
                for (int e = 0; e < 32; ++e) lv[e] = (e == bi) ? -3.4e38f : lv[e]; }
            float ex[4], sum = 0.f;
#pragma unroll
            for (int k = 0; k < 4; ++k) { ex[k] = __expf(tv[k] - tv[0]); sum += ex[k]; }
            const float inv = 1.f / sum;
            *(GAS v4u*)((int*)(F.ws + WS_TOPI) + (size_t)(tok0 + tl) * 4) = (v4u){(unsigned)ti[0], (unsigned)ti[1], (unsigned)ti[2], (unsigned)ti[3]};
            *(GAS f32x4*)((float*)(F.ws + WS_GATE) + (size_t)(tok0 + tl) * 4) = (f32x4){ex[0] * inv, ex[1] * inv, ex[2] * inv, ex[3] * inv};
#pragma unroll
            for (int k = 0; k < 4; ++k) __hip_atomic_fetch_add(&hist[ti[k]], 1, __ATOMIC_RELAXED, __HIP_MEMORY_SCOPE_WORKGROUP);
        }
        __syncthreads();
    }
    if (F.tid < 32) { const int c = hist[F.tid]; if (c) __hip_atomic_fetch_add(F.ctl + CW_CNT + F.tid, (unsigned)c, RLX_AGENT); }
}

template <bool SKIP_MOE>
__device__ __forceinline__ void p12_final(Frame& F0, const In& I, float* out) {
    PHASE_FRAME(F0);
    const int lane = F.lane; const int gw = F.vcu * NWAVES + F.wave, NGW = F.G * NWAVES;
    float ln_w[32], ln_b[32];
#pragma unroll
    for (int j = 0; j < 8; ++j) { const f32x4 a = *(const GAS f32x4*)(I.ln2_w + 4 * lane + 256 * j), b = *(const GAS f32x4*)(I.ln2_b + 4 * lane + 256 * j);
#pragma unroll
        for (int e = 0; e < 4; ++e) { ln_w[4 * j + e] = a[e]; ln_b[4 * j + e] = b[e]; } }
    for (int tok = gw; tok < T; tok += NGW) {
        const GAS v2u* hr = (const GAS v2u*)((const bf16*)(F.ws + WS_H1) + (size_t)tok * D) + lane;
        f32x4 v[8]; float s = 0.f;
#pragma unroll
        for (int j = 0; j < 8; ++j) { const v2u hh = hr[64 * j]; v[j] = (f32x4){bflo(hh.x), bfhi(hh.x), bflo(hh.y), bfhi(hh.y)} * DN_ALPHA; }
        if (!SKIP_MOE) {
#pragma unroll
            for (int k = 0; k < 4; ++k) { const GAS unsigned* yr = (const GAS unsigned*)((const unsigned char*)(F.ws + WS_YSLOT) + ((size_t)tok * 4 + k) * D) + lane;
#pragma unroll
                for (int j = 0; j < 8; ++j) { const unsigned y = yr[64 * j]; const f32x2 lo = __builtin_amdgcn_cvt_pk_f32_fp8((int)y, false), hi = __builtin_amdgcn_cvt_pk_f32_fp8((int)y, true);
                    v[j].x += lo.x * YS_INV; v[j].y += lo.y * YS_INV; v[j].z += hi.x * YS_INV; v[j].w += hi.y * YS_INV; } }
        }
#pragma unroll
        for (int j = 0; j < 8; ++j) s += (v[j].x + v[j].y) + (v[j].z + v[j].w);
        const float mean = wave_sum(s) * (1.f / D); float s2 = 0.f;
#pragma unroll
        for (int j = 0; j < 8; ++j) { v[j] = v[j] - mean; s2 += (v[j].x * v[j].x + v[j].y * v[j].y) + (v[j].z * v[j].z + v[j].w * v[j].w); }
        const float rstd = 1.f / sqrtf(wave_sum(s2) * (1.f / D) + LN_EPS);
        GAS f32x4* o = (GAS f32x4*)(out + (size_t)tok * D) + lane;
#pragma unroll
        for (int j = 0; j < 8; ++j) { f32x4 h;
#pragma unroll
            for (int e = 0; e < 4; ++e) h[e] = v[j][e] * rstd * ln_w[4 * j + e] + ln_b[4 * j + e];
            o[64 * j] = h; }
    }
}
__device__ __forceinline__ void moe_tables(Frame& F) {
    LAS int* tab = (LAS int*)(F.lds + TAB_OFF);
    if (F.tid == 0) { int run = 0;
        for (int e = 0; e < NE; ++e) { const int c = (int)__hip_atomic_load(F.ctl + CW_CNT + e, RLX_AGENT); const int p = (c + 255) / 256 * 256; tab[32 + e] = run; run += p; tab[e] = run; }
        tab[64] = run / 256; }
    __syncthreads();
}

__device__ __forceinline__ void p9_scatter(Frame& F0, const In& I) {
    PHASE_FRAME(F0);
    moe_tables(F);
    LAS int* tab = (LAS int*)(F.lds + TAB_OFF);
    LAS int* lh = (LAS int*)(F.lds + 0);
    LAS int* lb = (LAS int*)(F.lds + 128);
    LAS int* dst = (LAS int*)(F.lds + 256);
    const int* topi = (const int*)(F.ws + WS_TOPI); const float* gate = (const float*)(F.ws + WS_GATE);
    for (int ch = F.vcu; ch < T / 128; ch += F.G) {
        if (F.tid < 32) lh[F.tid] = 0;
        __syncthreads();
        const int s = ch * 512 + F.tid; const int e = topi[s]; const float gv = gate[s];
        const int rank = __hip_atomic_fetch_add(&lh[e], 1, __ATOMIC_RELAXED, __HIP_MEMORY_SCOPE_WORKGROUP);
        __syncthreads();
        if (F.tid < 32) { const int c = lh[F.tid]; lb[F.tid] = c ? (int)__hip_atomic_fetch_add(F.ctl + CW_CUR + F.tid, (unsigned)c, RLX_AGENT) : 0; }
        __syncthreads();
        const int d = tab[32 + e] + lb[e] + rank;
        ((int*)(F.ws + WS_ROWSLOT))[d] = s; ((float*)(F.ws + WS_ROWW))[d] = gv; dst[F.tid] = d;
        __syncthreads();
#pragma unroll 1
        for (int i0 = F.wave * 64; i0 < F.wave * 64 + 64; i0 += 8) {
            v4u v[8][2]; int dd[8];
#pragma unroll
            for (int q = 0; q < 8; ++q) { const int i = i0 + q; const int tok = ch * 128 + (i >> 2); dd[q] = dst[i];
                const GAS v4u* src = (const GAS v4u*)((const unsigned char*)(F.ws + WS_H1B) + (size_t)tok * D) + F.lane;
                v[q][0] = src[0]; v[q][1] = src[64]; }
#pragma unroll
            for (int q = 0; q < 8; ++q) { GAS v4u* o = (GAS v4u*)((unsigned char*)(F.ws + WS_XG) + (size_t)dd[q] * D) + F.lane; o[0] = v[q][0]; o[64] = v[q][1]; }
        }
        __syncthreads();
    }
}

__device__ __forceinline__ void p10_moe_up(Frame& F0, const In& I) {
    PHASE_FRAME(F0);
    moe_tables(F);
    LAS int* tab = (LAS int*)(F.lds + TAB_OFF);
    pg8::SchedMoe S; S.t.init(tab[64], 16, F.G, (int)blockIdx.x);
    S.A = (unsigned)(WS_XG); S.B = (unsigned)(WS_WGUT); S.tsA = (unsigned)256 * D; S.tsB = (unsigned)256 * D; S.es = (unsigned)2 * FF * D; S.pad_end = tab;
    pg8::EpiSwiglu E{(unsigned char*)(F.ws + WS_ACT), I.b_gu};
    pg8::gemm_phase<pg8::EpiSwiglu, pg8::SchedMoe, true, true>(F.lds + RING_OFF, F.rsrc, D / 2, D / 2, D / 2, S, E);
}
__device__ __forceinline__ void p11_moe_down(Frame& F0, const In& I) {
    PHASE_FRAME(F0);
    moe_tables(F);
    LAS int* tab = (LAS int*)(F.lds + TAB_OFF);
    pg8::SchedMoe S; S.t.init(tab[64], 8, F.G, (int)blockIdx.x);
    S.A = (unsigned)(WS_ACT); S.B = (unsigned)(WS_WDNT); S.tsA = (unsigned)256 * FF; S.tsB = (unsigned)256 * FF; S.es = (unsigned)D * FF; S.pad_end = tab;
    pg8::EpiDown E{(unsigned char*)(F.ws + WS_YSLOT), I.b_down, (const int*)(F.ws + WS_ROWSLOT), (const float*)(F.ws + WS_ROWW)};
    pg8::gemm_phase<pg8::EpiDown, pg8::SchedMoe, true, true>(F.lds + RING_OFF, F.rsrc, FF / 2, FF / 2, FF / 2, S, E);
}

__device__ __forceinline__ void p1_proj(Frame& F0, const In& I) {
    PHASE_FRAME(F0);
    { pg8::SchedPlain S; S.t.init(T / 256, SEG_PAD / 256, F.G, (int)blockIdx.x);
      S.A = (unsigned)(WS_XB8); S.B = (unsigned)(WS_WSV8); S.tsA = (unsigned)256 * D; S.tsB = (unsigned)256 * D;
      pg8::EpiShift E{(bf16*)(F.ws + WS_RKV), (bf16*)(F.ws + WS_LORAIN), (float*)(F.ws + WS_SIDE0), (float*)(F.ws + WS_SIDEL), I.shift_mu};
      pg8::gemm_phase<pg8::EpiShift, pg8::SchedPlain, true, true>(F.lds + RING_OFF, F.rsrc, D / 2, D / 2, D / 2, S, E); }
    { pg8::SchedPlain S; S.t.init(T / 256, (2 * AW) / 256, F.G, (int)blockIdx.x);
      S.A = (unsigned)(WS_XB8); S.B = (unsigned)(WS_WQK8); S.tsA = (unsigned)256 * D; S.tsB = (unsigned)256 * D;
      pg8::EpiProj E{(bf16*)(F.ws + WS_PROJ), 0, 4};
      pg8::gemm_phase<pg8::EpiProj, pg8::SchedPlain, true, true>(F.lds + RING_OFF, F.rsrc, D / 2, D / 2, D / 2, S, E); }
    { pg8::SchedPlain S; S.t.init(T / 256, (2 * D) / 256, F.G, (int)blockIdx.x);
      S.A = (unsigned)(WS_XB8); S.B = (unsigned)(WS_WG8); S.tsA = (unsigned)256 * D; S.tsB = (unsigned)256 * D;
      pg8::EpiGate E{(bf16*)(F.ws + WS_PROJ)};
      pg8::gemm_phase<pg8::EpiGate, pg8::SchedPlain, true, true>(F.lds + RING_OFF, F.rsrc, D / 2, D / 2, D / 2, S, E); }
    { pg8::SchedPlain S; S.t.init(AW / 256, T / 256, F.G, (int)blockIdx.x);
      S.A = (unsigned)(WS_WV8); S.B = (unsigned)(WS_XB8); S.tsA = (unsigned)256 * D; S.tsB = (unsigned)256 * D;
      pg8::EpiBf16 E{(bf16*)(F.ws + WS_VT), T};
      pg8::gemm_phase<pg8::EpiBf16, pg8::SchedPlain, true, true>(F.lds + RING_OFF, F.rsrc, D / 2, D / 2, D / 2, S, E); }
}

__device__ __forceinline__ float ftanh(float x) { return 2.0f * fsigmoid(2.0f * x) - 1.0f; }
__device__ __forceinline__ void p2_shift_attn(Frame& F0, const In& I) {
    PHASE_FRAME(F0);
    const int lane = F.lane; const int gw = F.vcu * NWAVES + F.wave, NGW = F.G * NWAVES;
    const bf16* PROJ = (const bf16*)(F.ws + WS_PROJ);
    for (int g = gw; g < T / 64; g += NGW) {
        const int tok = g * 64; const bool first = (tok % SEQ) == 0;
        const float* cur = (const float*)(F.ws + WS_SIDE0) + (size_t)g * SEG_PAD; const float* prv = (const float*)(F.ws + WS_SIDEL) + (size_t)(g - 1) * SEG_PAD;
        bf16* rkv = (bf16*)(F.ws + WS_RKV) + (size_t)tok * (3 * RW); bf16* lin = (bf16*)(F.ws + WS_LORAIN) + (size_t)tok * LORA_LD;
#pragma unroll 1
        for (int it = 0; it < 7; ++it) { const int gi = it * 64 + lane; if (gi >= SHIFT_W / 8) break; const int c = gi * 8;
            const f32x4 c0 = *(const GAS f32x4*)(cur + c), c1 = *(const GAS f32x4*)(cur + c + 4);
            f32x4 p0 = (f32x4){0.f, 0.f, 0.f, 0.f}, p1 = p0; if (!first) { p0 = *(const GAS f32x4*)(prv + c); p1 = *(const GAS f32x4*)(prv + c + 4); }
            const f32x4 m0 = *(const GAS f32x4*)(I.shift_mu + c), m1 = *(const GAS f32x4*)(I.shift_mu + c + 4);
            float v[8];
#pragma unroll
            for (int j = 0; j < 4; ++j) { v[j] = c0[j] + (p0[j] - c0[j]) * m0[j]; v[4 + j] = c1[j] + (p1[j] - c1[j]) * m1[j]; }
            bf16* dstp;
            if (c < 3 * RW) dstp = rkv + c;
            else if (c < 3 * RW + DLORA) { dstp = lin + (c - 3 * RW);
#pragma unroll
                for (int j = 0; j < 8; ++j) v[j] = ftanh(v[j]); }
            else if (c < 3 * RW + DLORA + ALORA) dstp = lin + 128 + (c - 3 * RW - DLORA);
            else { dstp = lin + 256 + (c - 3 * RW - DLORA - ALORA);
#pragma unroll
                for (int j = 0; j < 8; ++j) v[j] = fsigmoid(v[j]); }
            *(GAS v4u*)dstp = (v4u){pk2(v[0], v[1]), pk2(v[2], v[3]), pk2(v[4], v[5]), pk2(v[6], v[7])};
        }
    }
#if STAGE == 3
    { const int gt = F.vcu * (NWAVES * 64) + F.tid, NGT = F.G * NWAVES * 64;
      for (size_t i = gt; i < (size_t)T * RW / 8; i += NGT) ((GAS v4u*)(F.ws + WS_YB))[i] = (v4u){0u, 0u, 0u, 0u}; }
#endif
    LAS float* tbl = (LAS float*)(F.lds + 0);
    constexpr int AKV = 64 * 144, A_KOFF = 2048, A_VOFF = A_KOFF + 2 * AKV;
    const bf16* VT = (const bf16*)(F.ws + WS_VT); bf16* YA = (bf16*)(F.ws + WS_YA);
    const int r = lane & 31, hh = lane >> 5;
    const int rp = (r & 16) + 8 * ((r >> 2) & 1) + 4 * ((r >> 3) & 1) + (r & 3);
    const int srow = F.tid >> 3, spc = F.tid & 7;
    for (int task = F.vcu; task < BATCH * AH * (SEQ / 256); task += F.G) {
        const int bh = task >> 5, q256 = task & 31, b = bh >> 4, h = bh & 15, c0 = q256 * 4;
        const int q0 = q256 * 256 + F.wave * 32, cw = c0 + (F.wave >> 1);
        const int kc_lo = (c0 > LEFT) ? c0 - LEFT : 0, kc_hi = c0 + 3;
        __syncthreads();
        if (F.tid < REL_TABLE) tbl[F.tid] = I.rel_bias[h * REL_TABLE + F.tid];
        const size_t tokq = (size_t)b * SEQ + q0 + r;
        bf16x8 qf[4];
#pragma unroll
        for (int s = 0; s < 4; ++s) qf[s] = *(const GAS bf16x8*)(PROJ + tokq * PROJ_LD + PJ_Q + h * 64 + 16 * s + 8 * hh);
        f32x16 o0, o1;
#pragma unroll
        for (int i = 0; i < 16; ++i) { o0[i] = 0.f; o1[i] = 0.f; }
        float m_run = -1e30f, l_run = 0.f;
        v4u kreg, vreg;
#define AT_STAGE_LOAD(kc_) do { kreg = *(const GAS v4u*)(PROJ + ((size_t)b * SEQ + (size_t)(kc_) * 64 + srow) * PROJ_LD + PJ_K + h * 64 + spc * 8); \
                                vreg = *(const GAS v4u*)(VT + (size_t)(h * 64 + srow) * T + (size_t)b * SEQ + (size_t)(kc_) * 64 + spc * 8); } while (0)
#define AT_STAGE_WRITE(buf_) do { *(LAS v4u*)(F.lds + A_KOFF + (buf_) * AKV + srow * 144 + spc * 16) = kreg; *(LAS v4u*)(F.lds + A_VOFF + (buf_) * AKV + srow * 144 + spc * 16) = vreg; } while (0)
        AT_STAGE_LOAD(kc_lo); AT_STAGE_WRITE(0);
        __syncthreads();
#pragma unroll 1
        for (int kc = kc_lo; kc <= kc_hi; ++kc) {
            const int buf = (kc - kc_lo) & 1;
            if (kc < kc_hi) AT_STAGE_LOAD(kc + 1);
            if (kc >= cw - LEFT && kc <= cw) {
                const LAS unsigned char* Kb = F.lds + A_KOFF + buf * AKV; const LAS unsigned char* Vb = F.lds + A_VOFF + buf * AKV;
#pragma unroll
                for (int tt = 0; tt < 2; ++tt) {
                    const int kpos0 = kc * 64 + 32 * tt;
                    bf16x8 kf[4], va[2], vb[2];
#pragma unroll
                    for (int s = 0; s < 4; ++s) kf[s] = *(const LAS bf16x8*)(Kb + (32 * tt + rp) * 144 + 32 * s + 16 * hh);
#pragma unroll
                    for (int s2 = 0; s2 < 2; ++s2) { va[s2] = *(const LAS bf16x8*)(Vb + r * 144 + 64 * tt + 32 * s2 + 16 * hh); vb[s2] = *(const LAS bf16x8*)(Vb + (32 + r) * 144 + 64 * tt + 32 * s2 + 16 * hh); }
                    f32x16 st;
#pragma unroll
                    for (int i = 0; i < 16; ++i) st[i] = 0.f;
#pragma unroll
                    for (int s = 0; s < 4; ++s) st = __builtin_amdgcn_mfma_f32_32x32x16_bf16(kf[s], qf[s], st, 0, 0, 0);
                    const int dbase = (q0 + r) - (kpos0 + 8 * hh);
                    float mx = -1e30f;
                    if (q0 - (kpos0 + 31) >= MAX_PAST) {
                        const float bc = tbl[MAX_PAST + 63];
#pragma unroll
                        for (int i = 0; i < 16; ++i) { st[i] += bc; mx = fmaxf(mx, st[i]); }
                    } else {
#pragma unroll
                        for (int i = 0; i < 16; ++i) { int d = dbase - (16 * (i >> 3) + 4 * ((i >> 2) & 1) + (i & 3)); d = d < MAX_PAST ? d : MAX_PAST; st[i] += tbl[d + 63]; mx = fmaxf(mx, st[i]); }
                    }
                    mx = fmaxf(mx, __shfl_xor(mx, 32));
                    const float m_new = fmaxf(m_run, mx), alpha = __expf(m_run - m_new);
                    float ls = 0.f;
#pragma unroll
                    for (int i = 0; i < 16; ++i) { st[i] = __expf(st[i] - m_new); ls += st[i]; }
                    l_run = l_run * alpha + ls;
                    if (__builtin_amdgcn_ballot_w64(m_new != m_run)) {
#pragma unroll
                        for (int i = 0; i < 16; ++i) { o0[i] *= alpha; o1[i] *= alpha; } }
                    m_run = m_new;
#pragma unroll
                    for (int s2 = 0; s2 < 2; ++s2) {
                        v4u pw; pw.x = pg8::cvt_pk_bf16(st[8 * s2 + 0], st[8 * s2 + 1]); pw.y = pg8::cvt_pk_bf16(st[8 * s2 + 2], st[8 * s2 + 3]); pw.z = pg8::cvt_pk_bf16(st[8 * s2 + 4], st[8 * s2 + 5]); pw.w = pg8::cvt_pk_bf16(st[8 * s2 + 6], st[8 * s2 + 7]);
                        const bf16x8 pf = __builtin_bit_cast(bf16x8, pw);
                        o0 = __builtin_amdgcn_mfma_f32_32x32x16_bf16(va[s2], pf, o0, 0, 0, 0);
                        o1 = __builtin_amdgcn_mfma_f32_32x32x16_bf16(vb[s2], pf, o1, 0, 0, 0);
                    }
                }
            }
            if (kc < kc_hi) AT_STAGE_WRITE(buf ^ 1);
            __syncthreads();
        }
#undef AT_STAGE_LOAD
#undef AT_STAGE_WRITE
        const float inv = 1.0f / (l_run + __shfl_xor(l_run, 32));
        unsigned char* yo = (unsigned char*)YA + tokq * AW + h * 64 + 4 * hh;
        const float inv16 = inv * ACT8_SCALE;
#pragma unroll
        for (int g4 = 0; g4 < 4; ++g4) {
            int w0 = __builtin_amdgcn_cvt_pk_fp8_f32(o0[4 * g4] * inv16, o0[4 * g4 + 1] * inv16, 0, false); w0 = __builtin_amdgcn_cvt_pk_fp8_f32(o0[4 * g4 + 2] * inv16, o0[4 * g4 + 3] * inv16, w0, true);
            int w1 = __builtin_amdgcn_cvt_pk_fp8_f32(o1[4 * g4] * inv16, o1[4 * g4 + 1] * inv16, 0, false); w1 = __builtin_amdgcn_cvt_pk_fp8_f32(o1[4 * g4 + 2] * inv16, o1[4 * g4 + 3] * inv16, w1, true);
            *(GAS unsigned*)(yo + 8 * g4) = (unsigned)w0; *(GAS unsigned*)(yo + 32 + 8 * g4) = (unsigned)w1;
        }
    }
}

__device__ __forceinline__ void p6_merged(Frame& F0, const In& I) {
    PHASE_FRAME(F0);
    pg8::SchedTwo S; S.t.init(T / 256, D / 256, F.G, (int)blockIdx.x);
    S.A0 = (unsigned)(WS_YA); S.A1 = (unsigned)(WS_YB); S.B0 = (unsigned)(WS_PAT); S.B1 = (unsigned)(WS_PBT);
    S.tsA = (unsigned)256 * AW; S.tsB = (unsigned)256 * AW;
    pg8::EpiMerged E{(const bf16*)(F.ws + WS_PROJ), (bf16*)(F.ws + WS_MERGED)};
    pg8::gemm_phase<pg8::EpiMerged, pg8::SchedTwo, true, true, 0x00007b79>(F.lds + RING_OFF, F.rsrc, AW / 2, AW / 2, AW / 2, S, E);
}
__device__ __forceinline__ void p7_mix(Frame& F0, const In& I) {
    PHASE_FRAME(F0);
    pg8::SchedPlain S; S.t.init(T / 256, D / 256, F.G, (int)blockIdx.x);
    S.A = (unsigned)(WS_MERGED); S.B = (unsigned)(WS_WOT); S.tsA = (unsigned)256 * D; S.tsB = (unsigned)256 * D;
    pg8::EpiBf16 E{(bf16*)(F.ws + WS_Z), D};
    pg8::gemm_phase<pg8::EpiBf16, pg8::SchedPlain, true, true, 0x00007b79>(F.lds + RING_OFF, F.rsrc, D / 2, D / 2, D / 2, S, E);
}

__device__ __forceinline__ void p3_lora(Frame& F0, const In& I) {
    PHASE_FRAME(F0);
    { pg8::SchedPlain S; S.t.init(T / 256, 4, F.G, (int)blockIdx.x);
      S.A = (unsigned)(WS_LORAIN); S.B = (unsigned)(WS_WLA); S.tsA = (unsigned)256 * LORA_LD * 2; S.tsB = (unsigned)256 * 256 * 2;
      pg8::EpiLoraA<true> E{(float*)(F.ws + WS_DECAY), I.w0};
      pg8::gemm_phase<pg8::EpiLoraA<true>, pg8::SchedPlain, true>(F.lds + RING_OFF, F.rsrc, LORA_LD, 256, 256, S, E); }
    { pg8::SchedPlain S; S.t.init(T / 256, 4, F.G, (int)blockIdx.x);
      S.A = (unsigned)(WS_LORAIN); S.B = (unsigned)(WS_WLA + (size_t)1024 * 256 * 2); S.tsA = (unsigned)256 * LORA_LD * 2; S.tsB = (unsigned)256 * 256 * 2;
      pg8::EpiIclr E{(bf16*)(F.ws + WS_ICLR), I.a0};
      pg8::gemm_phase<pg8::EpiIclr, pg8::SchedPlain, true>(F.lds + RING_OFF, F.rsrc, LORA_LD, 256, 256, S, E); }
    { pg8::SchedPlain S; S.t.init(T / 256, 4, F.G, (int)blockIdx.x);
      S.A = (unsigned)(WS_LORAIN + 512); S.B = (unsigned)(WS_WLG); S.tsA = (unsigned)256 * LORA_LD * 2; S.tsB = (unsigned)256 * 256 * 2;
      pg8::EpiBf16 E{(bf16*)(F.ws + WS_G), RW};
      pg8::gemm_phase<pg8::EpiBf16, pg8::SchedPlain, true>(F.lds + RING_OFF, F.rsrc, LORA_LD, 256, 256, S, E); }
}

constexpr int CP = 144;
constexpr int CMAT = 64 * CP;
constexpr int C_RT = 0 * CMAT, C_ATT = 1 * CMAT, C_AAK = 2 * CMAT, C_ARKT = 3 * CMAT, C_WA = 4 * CMAT, C_WB = 6 * CMAT,
              C_MA = 8 * CMAT, C_MTA = 9 * CMAT, C_MB = 10 * CMAT, C_MTB = 11 * CMAT, C_SEG = 12 * CMAT, C_GAM = C_SEG + 8 * 64 * 4, C_TSCR = C_GAM + 256;
constexpr int C_AT = C_WB, C_BT = C_WB + CMAT, C_KT = C_MB, C_QYT = C_MA, C_QST = C_MTA, C_KHT = C_MTB, C_VT = C_WB;
static_assert(C_TSCR % 16 == 0 && C_TSCR + 8 * 5120 <= TAB_OFF, "P4a LDS map");
constexpr int CHK_UNIT_BYTES = 4 * 64 * 64 * 2;
#define CBAR() do { asm volatile("s_waitcnt lgkmcnt(0)" ::: "memory"); __builtin_amdgcn_s_barrier(); asm volatile("" ::: "memory"); } while (0)
template <int NT, class Epi>
__device__ __forceinline__ void cmm(const LAS unsigned char* X, const LAS unsigned char* Y, int mt0, int nt, int lane, const Epi& E) {
    const int lr = lane & 15, kq = lane >> 4;
    const bf16x8 b0 = *(const LAS bf16x8*)(Y + (nt * 16 + lr) * CP + kq * 16), b1 = *(const LAS bf16x8*)(Y + (nt * 16 + lr) * CP + kq * 16 + 64);
#pragma unroll
    for (int i = 0; i < NT; ++i) { const int mt = mt0 + i;
        const bf16x8 a0 = *(const LAS bf16x8*)(X + (mt * 16 + lr) * CP + kq * 16), a1 = *(const LAS bf16x8*)(X + (mt * 16 + lr) * CP + kq * 16 + 64);
        f32x4 acc = (f32x4){0.f, 0.f, 0.f, 0.f};
        acc = __builtin_amdgcn_mfma_f32_16x16x32_bf16(a0, b0, acc, 0, 0, 0);
        acc = __builtin_amdgcn_mfma_f32_16x16x32_bf16(a1, b1, acc, 0, 0, 0);
        E(mt, nt, acc); }
}
__device__ __forceinline__ v2u pack4(const f32x4& v) { return (v2u){pg8::cvt_pk_bf16(v[0], v[1]), pg8::cvt_pk_bf16(v[2], v[3])}; }
__device__ __forceinline__ f32x4 unpack4(const v2u w) { return (f32x4){bflo(w.x), bfhi(w.x), bflo(w.y), bfhi(w.y)}; }
__device__ __forceinline__ void p4a_chunk(Frame& F0, const In& I) {
    PHASE_FRAME(F0);
    LAS unsigned char* L = F.lds;
    const int lane = F.lane, w = F.wave, lr = lane & 15, kq = lane >> 4;
    const bf16* RKV = (const bf16*)(F.ws + WS_RKV); const float* LW = (const float*)(F.ws + WS_DECAY); const bf16* ICL = (const bf16*)(F.ws + WS_ICLR);
    unsigned char* CHK = F.ws + WS_CHK;
    int uit = 0;
    for (int unit = F.vcu; unit < BATCH * RH * (SEQ / 64); unit += F.G, ++uit) {
        const int bh = unit >> 7, ck = unit & 127, b = bh >> 4, h = bh & 15;
        const size_t tok0 = (size_t)b * SEQ + (size_t)ck * 64 + 8 * w;
        const int hc = h * 64 + lane;
        float lwv[8], ic[8], rr[8], kk[8], vv[8];
#pragma unroll
        for (int i = 0; i < 8; ++i) { const size_t tok = tok0 + i; lwv[i] = LW[tok * RW + hc]; ic[i] = bf2f(ICL[tok * RW + hc]);
            rr[i] = bf2f(RKV[tok * (3 * RW) + hc]); kk[i] = bf2f(RKV[tok * (3 * RW) + RW + hc]); vv[i] = bf2f(RKV[tok * (3 * RW) + 2 * RW + hc]); }
        const float kkp = I.k_k[hc], kap = I.k_a[hc];
        float cs[8]; { float run = 0.f;
#pragma unroll
            for (int i = 0; i < 8; ++i) { run += lwv[i]; cs[i] = run; } }
        __syncthreads();
        ((LAS float*)(L + C_SEG))[w * 64 + lane] = cs[7];
        CBAR();
        float pre = 0.f, tot = 0.f;
#pragma unroll
        for (int j = 0; j < 8; ++j) { const float sg = ((const LAS float*)(L + C_SEG))[j * 64 + lane]; tot += sg; pre += (j < w) ? sg : 0.f; }
        if (w == 0) ((LAS float*)(L + C_GAM))[lane] = __expf(tot);
        unsigned att[4], bht[4], kht[4], vtt[4];
        float at_[8], bh_[8], kh_[8]; const float gtot = __expf(tot); float ep_prev = 1.f;
#pragma unroll
        for (int i = 0; i < 8; ++i) { const int t = 8 * w + i; const float cum = pre + cs[i], cump = cum - lwv[i];
            const float kkv = kk[i] * kkp; const float n2 = wave_sum(kkv * kkv); const float kkn = kkv * __builtin_amdgcn_rsqf(fmaxf(n2, 1e-24f));
            const float a = -kkn, bb = kkn * ic[i], kp = kk[i] * (1.0f + (ic[i] - 1.0f) * kap);
            const float ep = __expf(cum), em = __builtin_amdgcn_rcpf(ep), epp = (i == 0) ? __expf(cump) : ep_prev, eL = gtot * em; ep_prev = ep;
            const float Rv = rr[i] * ep, Av = a * epp, Bv = bb * em, Kv = kp * em;
            at_[i] = Av; bh_[i] = bb * eL; kh_[i] = kp * eL;
            *(LAS unsigned short*)(L + C_RT + t * CP + lane * 2) = (unsigned short)f2bf(Rv);
            *(LAS unsigned short*)(L + C_AT + t * CP + lane * 2) = (unsigned short)f2bf(Av);
            *(LAS unsigned short*)(L + C_BT + t * CP + lane * 2) = (unsigned short)f2bf(Bv);
            *(LAS unsigned short*)(L + C_KT + t * CP + lane * 2) = (unsigned short)f2bf(Kv); }
#pragma unroll
        for (int q = 0; q < 4; ++q) { att[q] = pk2(at_[2 * q], at_[2 * q + 1]); bht[q] = pk2(bh_[2 * q], bh_[2 * q + 1]); kht[q] = pk2(kh_[2 * q], kh_[2 * q + 1]); vtt[q] = pk2(vv[2 * q], vv[2 * q + 1]); }
        *(LAS v4u*)(L + C_ATT + lane * CP + 16 * w) = (v4u){att[0], att[1], att[2], att[3]};
        *(LAS v4u*)(L + C_WA + (64 + lane) * CP + 16 * w) = (v4u){bht[0], bht[1], bht[2], bht[3]};
        CBAR();
        const int cit = (uit * F.G + F.vcu) * 16 + w * 2; const bool hx = cit < MOE_NITEMS, hy = cit + 1 < MOE_NITEMS;
        f32x4 tX[16]; MoeItem mX = moe_item(hx ? cit : 0, I.w_gu, I.w_down, F.ws);
        LAS float* tscr = (LAS float*)(L + C_TSCR + w * 5120);
        struct Fr { bf16x8 a, b; };
        auto LD = [&](int base, int tile) -> Fr { const LAS unsigned char* q = L + base + (tile * 16 + lr) * CP + kq * 16; Fr f; f.a = *(const LAS bf16x8*)q; f.b = *(const LAS bf16x8*)(q + 64); return f; };
        auto MM = [&](const Fr& x, const Fr& y) -> f32x4 { f32x4 acc = (f32x4){0.f, 0.f, 0.f, 0.f};
            acc = __builtin_amdgcn_mfma_f32_16x16x32_bf16(x.a, y.a, acc, 0, 0, 0); acc = __builtin_amdgcn_mfma_f32_16x16x32_bf16(x.b, y.b, acc, 0, 0, 0); return acc; };
        const int nt = w & 3, mt0 = 2 * (w >> 2), n = nt * 16 + lr;
        { const Fr yAT = LD(C_AT, nt), yKT = LD(C_KT, nt), yRT = LD(C_RT, nt);
          Fr xBT[2], xAT[2], xKT[2];
#pragma unroll
          for (int i = 0; i < 2; ++i) { xBT[i] = LD(C_BT, mt0 + i); xAT[i] = LD(C_AT, mt0 + i); xKT[i] = LD(C_KT, mt0 + i); }
          f32x4 a1[2], a2[2], a3[2], a4[2];
#pragma unroll
          for (int i = 0; i < 2; ++i) { a1[i] = MM(xBT[i], yAT); a2[i] = MM(xAT[i], yKT); a3[i] = MM(xBT[i], yRT); a4[i] = MM(xKT[i], yRT); }
#pragma unroll
          for (int i = 0; i < 2; ++i) { const int m0 = (mt0 + i) * 16 + 4 * kq;
              f32x4 v = a1[i];
#pragma unroll
              for (int e = 0; e < 4; ++e) { v[e] = (m0 + e < n) ? v[e] : 0.f; *(LAS unsigned short*)(L + C_MA + (m0 + e) * CP + n * 2) = (unsigned short)f2bf(v[e]); }
              *(LAS v2u*)(L + C_MTA + n * CP + m0 * 2) = pack4(v);
              v = a2[i];
#pragma unroll
              for (int e = 0; e < 4; ++e) v[e] = (n < m0 + e) ? v[e] : 0.f;
              *(LAS v2u*)(L + C_AAK + n * CP + m0 * 2) = pack4(v);
              v = a3[i];
#pragma unroll
              for (int e = 0; e < 4; ++e) v[e] = (m0 + e <= n) ? v[e] : 0.f;
              *(LAS v2u*)(L + C_WA + n * CP + m0 * 2) = pack4(v);
              v = a4[i];
#pragma unroll
              for (int e = 0; e < 4; ++e) v[e] = (m0 + e <= n) ? v[e] : 0.f;
              *(LAS v2u*)(L + C_ARKT + n * CP + m0 * 2) = pack4(v); } }
        CBAR();
        if (hx) tr8_load(mX, tX, lane);
#pragma unroll
        for (int lvl = 0; lvl < 6; ++lvl) {
            const int Wsrc = (lvl & 1) ? C_WB : C_WA, Wdst = (lvl & 1) ? C_WA : C_WB, Ms = (lvl & 1) ? C_MB : C_MA, Mts = (lvl & 1) ? C_MTB : C_MTA, Md = (lvl & 1) ? C_MA : C_MB, Mtd = (lvl & 1) ? C_MTA : C_MTB;
            const Fr yW = LD(Wsrc, w); Fr yMt; if (lvl < 5) yMt = LD(Mts, nt);
            Fr xM[4], xS[2];
#pragma unroll
            for (int i = 0; i < 4; ++i) xM[i] = LD(Ms, i);
            if (lvl < 5) { xS[0] = LD(Ms, mt0); xS[1] = LD(Ms, mt0 + 1); }
            const int nj = w * 16 + lr;
            f32x4 old[4], aw[4], as[2];
#pragma unroll
            for (int i = 0; i < 4; ++i) old[i] = unpack4(*(const LAS v2u*)(L + Wsrc + nj * CP + (i * 16 + 4 * kq) * 2));
#pragma unroll
            for (int i = 0; i < 4; ++i) aw[i] = MM(xM[i], yW);
            if (lvl < 5) {
#pragma unroll
                for (int i = 0; i < 2; ++i) as[i] = MM(xS[i], yMt); }
#pragma unroll
            for (int i = 0; i < 4; ++i) *(LAS v2u*)(L + Wdst + nj * CP + (i * 16 + 4 * kq) * 2) = pack4(old[i] + aw[i]);
            if (lvl < 5) {
#pragma unroll
                for (int i = 0; i < 2; ++i) { const int m0 = (mt0 + i) * 16 + 4 * kq;
#pragma unroll
                    for (int e = 0; e < 4; ++e) *(LAS unsigned short*)(L + Md + (m0 + e) * CP + n * 2) = (unsigned short)f2bf(as[i][e]);
                    if (lvl < 4) *(LAS v2u*)(L + Mtd + n * CP + m0 * 2) = pack4(as[i]); } }
            if (lvl == 4) *(LAS v4u*)(L + C_KHT + lane * CP + 16 * w) = (v4u){kht[0], kht[1], kht[2], kht[3]};
            if (lvl == 2) { if (hx) tr8_finish(tX, mX, tscr, lane);
                            if (hy) { mX = moe_item(cit + 1, I.w_gu, I.w_down, F.ws); tr8_load(mX, tX, lane); } }
            CBAR();
        }
        *(LAS v4u*)(L + C_VT + lane * CP + 16 * w) = (v4u){vtt[0], vtt[1], vtt[2], vtt[3]};
        unsigned char* og = CHK + (size_t)unit * CHK_UNIT_BYTES;
        { const Fr yW1 = LD(C_WA, nt), yW2 = LD(C_WA + 64 * CP, nt);
          Fr xA[2], xK[2];
#pragma unroll
          for (int i = 0; i < 2; ++i) { xA[i] = LD(C_ATT, mt0 + i); xK[i] = LD(C_AAK, mt0 + i); }
          f32x4 rv[2], av[2], kv[2];
          const float gm = ((const LAS float*)(L + C_GAM))[n];
#pragma unroll
          for (int i = 0; i < 2; ++i) { const int m0 = (mt0 + i) * 16 + 4 * kq;
              rv[i] = unpack4(*(const LAS v2u*)(L + C_RT + n * CP + m0 * 2)); av[i] = unpack4(*(const LAS v2u*)(L + C_ARKT + n * CP + m0 * 2)); kv[i] = unpack4(*(const LAS v2u*)(L + C_KHT + n * CP + m0 * 2)); }
          f32x4 p7[2], p8[2], p9[2], p10[2];
#pragma unroll
          for (int i = 0; i < 2; ++i) { p7[i] = MM(xA[i], yW1); p8[i] = MM(xK[i], yW1); p9[i] = MM(xA[i], yW2); p10[i] = MM(xK[i], yW2); }
#pragma unroll
          for (int i = 0; i < 2; ++i) { const int m0 = (mt0 + i) * 16 + 4 * kq;
              *(GAS v2u*)(og + 0 * 8192 + n * 128 + m0 * 2) = pack4(p7[i] + rv[i]);
              *(LAS v2u*)(L + C_QYT + n * CP + m0 * 2) = pack4(p8[i] + av[i]);
              f32x4 v = p9[i];
#pragma unroll
              for (int e = 0; e < 4; ++e) v[e] += (m0 + e == n) ? gm : 0.f;
              *(GAS v2u*)(og + 1 * 8192 + n * 128 + m0 * 2) = pack4(v);
              *(LAS v2u*)(L + C_QST + n * CP + m0 * 2) = pack4(p10[i] + kv[i]); } }
        CBAR();
        { const Fr yQy = LD(C_QYT, nt), yQs = LD(C_QST, nt);
          Fr xV[2];
#pragma unroll
          for (int i = 0; i < 2; ++i) xV[i] = LD(C_VT, mt0 + i);
          f32x4 p11[2], p12[2];
#pragma unroll
          for (int i = 0; i < 2; ++i) { p11[i] = MM(xV[i], yQy); p12[i] = MM(xV[i], yQs); }
#pragma unroll
          for (int i = 0; i < 2; ++i) { const int m0 = (mt0 + i) * 16 + 4 * kq;
              *(GAS v2u*)(og + 2 * 8192 + n * 128 + m0 * 2) = pack4(p11[i]);
              *(GAS v2u*)(og + 3 * 8192 + n * 128 + m0 * 2) = pack4(p12[i]); } }
        if (hy) tr8_finish(tX, mX, tscr, lane);
    }
}

constexpr int C2_SLOT = 20480;
__device__ __forceinline__ void p4b_scan(Frame& F0, const In& I) {
    PHASE_FRAME(F0);
    const int lane = F.lane, lr = lane & 15, kq = lane >> 4;
    const unsigned char* CHK = F.ws + WS_CHK; bf16* YS = (bf16*)(F.ws + WS_YSCAN);
    for (int unit = F.vcu; unit < BATCH * RH * 4; unit += F.G) {
        const int bh = unit >> 2, rq = unit & 3, b = bh >> 4, h = bh & 15;
        if (F.wave == 0) {
            LAS unsigned char* Sl = F.lds + 3 * C2_SLOT;
            f32x4 S[4]; bf16x8 sf[2];
#pragma unroll
            for (int nt = 0; nt < 4; ++nt) S[nt] = (f32x4){0.f, 0.f, 0.f, 0.f};
#pragma unroll
            for (int ks = 0; ks < 2; ++ks)
#pragma unroll
                for (int j = 0; j < 8; ++j) sf[ks][j] = 0;
#define C2_DMA(ck_) do { const int ckc_ = (ck_) < SEQ / 64 ? (ck_) : SEQ / 64 - 1; const unsigned char* ug = CHK + ((size_t)bh * 128 + ckc_) * CHK_UNIT_BYTES; \
                LAS unsigned char* sl_ = F.lds + ((ck_) % 3) * C2_SLOT; \
                _Pragma("unroll") for (int j = 0; j < 16; ++j) __builtin_amdgcn_global_load_lds((const unsigned*)(ug + j * 1024 + lane * 16), (LAS unsigned*)(sl_ + j * 1024), 16, 0, 0); \
                _Pragma("unroll") for (int j = 0; j < 2; ++j) { \
                    __builtin_amdgcn_global_load_lds((const unsigned*)(ug + 2 * 8192 + (j * 32 + (lane >> 1)) * 128 + rq * 32 + (lane & 1) * 16), (LAS unsigned*)(sl_ + 16384 + j * 1024), 16, 0, 0); \
                    __builtin_amdgcn_global_load_lds((const unsigned*)(ug + 3 * 8192 + (j * 32 + (lane >> 1)) * 128 + rq * 32 + (lane & 1) * 16), (LAS unsigned*)(sl_ + 18432 + j * 1024), 16, 0, 0); } } while (0)
            C2_DMA(0); C2_DMA(1);
#pragma unroll 1
            for (int ck = 0; ck < SEQ / 64; ++ck) {
                asm volatile("s_waitcnt lgkmcnt(0)" ::: "memory");
                C2_DMA(ck + 2);
                asm volatile("s_waitcnt vmcnt(40)" ::: "memory");
                const LAS unsigned char* sl_ = F.lds + (ck % 3) * C2_SLOT;
#pragma unroll
                for (int nt = 0; nt < 4; ++nt) {
                    const bf16x8 py0 = *(const LAS bf16x8*)(sl_ + (16 * nt + lr) * 128 + kq * 16), py1 = *(const LAS bf16x8*)(sl_ + (16 * nt + lr) * 128 + kq * 16 + 64);
                    const bf16x8 ps0 = *(const LAS bf16x8*)(sl_ + 8192 + (16 * nt + lr) * 128 + kq * 16), ps1 = *(const LAS bf16x8*)(sl_ + 8192 + (16 * nt + lr) * 128 + kq * 16 + 64);
                    f32x4 y = unpack4(*(const LAS v2u*)(sl_ + 16384 + (16 * nt + lr) * 32 + kq * 8));
                    f32x4 s2 = unpack4(*(const LAS v2u*)(sl_ + 18432 + (16 * nt + lr) * 32 + kq * 8));
                    y = __builtin_amdgcn_mfma_f32_16x16x32_bf16(sf[0], py0, y, 0, 0, 0); y = __builtin_amdgcn_mfma_f32_16x16x32_bf16(sf[1], py1, y, 0, 0, 0);
                    *(GAS v2u*)(YS + ((size_t)b * SEQ + (size_t)ck * 64 + 16 * nt + lr) * RW + h * 64 + rq * 16 + 4 * kq) = pack4(y);
                    s2 = __builtin_amdgcn_mfma_f32_16x16x32_bf16(sf[0], ps0, s2, 0, 0, 0); s2 = __builtin_amdgcn_mfma_f32_16x16x32_bf16(sf[1], ps1, s2, 0, 0, 0);
                    S[nt] = s2; }
#pragma unroll
                for (int nt = 0; nt < 4; ++nt)
#pragma unroll
                    for (int i = 0; i < 4; ++i) *(LAS unsigned short*)(Sl + (4 * kq + i) * CP + (16 * nt + lr) * 2) = (unsigned short)f2bf(S[nt][i]);
                LDS_WAIT(); asm volatile("" ::: "memory");
                sf[0] = *(const LAS bf16x8*)(Sl + lr * CP + kq * 16); sf[1] = *(const LAS bf16x8*)(Sl + lr * CP + kq * 16 + 64);
                LDS_WAIT(); asm volatile("" ::: "memory");
            }
            asm volatile("s_waitcnt vmcnt(0)" ::: "memory");
#undef C2_DMA
        }
    }
}
static_assert(3 * C2_SLOT + 4096 + 5 * 16640 <= TAB_OFF, "P4b LDS map");

__device__ __forceinline__ void p5_post(Frame& F0, const In& I) {
    PHASE_FRAME(F0);
    const int lane = F.lane; const int gw = F.vcu * NWAVES + F.wave, NGW = F.G * NWAVES;
    const bf16* RKV = (const bf16*)(F.ws + WS_RKV); const bf16* ICL = (const bf16*)(F.ws + WS_ICLR); const bf16* YS = (const bf16*)(F.ws + WS_YSCAN);
    const bf16* G = (const bf16*)(F.ws + WS_G); bf16* YB = (bf16*)(F.ws + WS_YB);
    const int c0 = lane * 16;
    for (int tok = gw; tok < T; tok += NGW) {
        float y[16], rr[16], kk[16], vv[16], ic[16], gg[16];
#pragma unroll
        for (int q = 0; q < 2; ++q) { const v4u a = *(const GAS v4u*)(YS + (size_t)tok * RW + c0 + 8 * q), c = *(const GAS v4u*)(ICL + (size_t)tok * RW + c0 + 8 * q);
            const unsigned aw[4] = {a.x, a.y, a.z, a.w}, cw[4] = {c.x, c.y, c.z, c.w};
#pragma unroll
            for (int e = 0; e < 4; ++e) { y[8 * q + 2 * e] = bflo(aw[e]); y[8 * q + 2 * e + 1] = bfhi(aw[e]); ic[8 * q + 2 * e] = bflo(cw[e]); ic[8 * q + 2 * e + 1] = bfhi(cw[e]); } }
#pragma unroll
        for (int q = 0; q < 2; ++q) {
            const v4u a = *(const GAS v4u*)(RKV + (size_t)tok * (3 * RW) + c0 + 8 * q), bb = *(const GAS v4u*)(RKV + (size_t)tok * (3 * RW) + RW + c0 + 8 * q),
                      c = *(const GAS v4u*)(RKV + (size_t)tok * (3 * RW) + 2 * RW + c0 + 8 * q), d = *(const GAS v4u*)(G + (size_t)tok * RW + c0 + 8 * q);
            const unsigned aw[4] = {a.x, a.y, a.z, a.w}, bw[4] = {bb.x, bb.y, bb.z, bb.w}, cw[4] = {c.x, c.y, c.z, c.w}, dw[4] = {d.x, d.y, d.z, d.w};
#pragma unroll
            for (int e = 0; e < 4; ++e) { rr[8 * q + 2 * e] = bflo(aw[e]); rr[8 * q + 2 * e + 1] = bfhi(aw[e]); kk[8 * q + 2 * e] = bflo(bw[e]); kk[8 * q + 2 * e + 1] = bfhi(bw[e]);
                vv[8 * q + 2 * e] = bflo(cw[e]); vv[8 * q + 2 * e + 1] = bfhi(cw[e]); gg[8 * q + 2 * e] = bflo(dw[e]); gg[8 * q + 2 * e + 1] = bfhi(dw[e]); } }
        float s = 0.f, bs = 0.f;
#pragma unroll
        for (int e = 0; e < 16; ++e) { s += y[e]; const float kp = kk[e] * (1.0f + (ic[e] - 1.0f) * I.k_a[c0 + e]); bs += rr[e] * kp * I.r_k[c0 + e]; }
        s = quadsum(s); bs = quadsum(bs);
        const float mean = s * (1.f / 64.f); float s2 = 0.f;
#pragma unroll
        for (int e = 0; e < 16; ++e) { y[e] -= mean; s2 += y[e] * y[e]; }
        s2 = quadsum(s2);
        const float rstd = 1.f / sqrtf(s2 * (1.f / 64.f) + GN_EPS);
        float o[16];
#pragma unroll
        for (int e = 0; e < 16; ++e) o[e] = (y[e] * rstd * I.lnx_w[c0 + e] + I.lnx_b[c0 + e] + bs * vv[e]) * gg[e];
        { unsigned w8[4];
#pragma unroll
          for (int q = 0; q < 4; ++q) { int t8 = __builtin_amdgcn_cvt_pk_fp8_f32(o[4 * q] * ACT8_SCALE, o[4 * q + 1] * ACT8_SCALE, 0, false); t8 = __builtin_amdgcn_cvt_pk_fp8_f32(o[4 * q + 2] * ACT8_SCALE, o[4 * q + 3] * ACT8_SCALE, t8, true); w8[q] = (unsigned)t8; }
          *(GAS v4u*)((unsigned char*)YB + (size_t)tok * RW + c0) = (v4u){w8[0], w8[1], w8[2], w8[3]}; }
    }
}
#ifndef STAGE
#define STAGE 4
#endif
struct Args { In in; float* out; unsigned char* ws; };
__global__ void __launch_bounds__(NWAVES * 64, 2) mk_fwd(Args args) {
    extern __shared__ __attribute__((aligned(16))) unsigned char lds[];
    Frame F;
    F.lds = (LAS unsigned char*)lds;
    F.MISC = (volatile LAS unsigned*)(F.lds + MISC_OFF);
    F.tid = threadIdx.x; F.lane = F.tid & 63; F.wave = __builtin_amdgcn_readfirstlane(F.tid >> 6);
    F.G = gridDim.x; { const int bx = blockIdx.x; F.vcu = (F.G % 8 == 0) ? (bx % 8) * (F.G / 8) + bx / 8 : bx; }
    F.ws = args.ws;
    F.rsrc = __builtin_amdgcn_make_buffer_rsrc(args.ws, 0, 0xffffffff, 0x00020000);
    F.ctl = (gu32*)(args.ws + WS_CTL);
    for (int u = F.tid; u < (LDS_BYTES - MISC_OFF) / 4; u += NWAVES * 64) ((LAS unsigned*)(F.lds + MISC_OFF))[u] = 0u;
    __syncthreads();
    XcdBarrier bar = xcd_barrier_post((unsigned*)(F.ctl + CW_BAR), F.MISC + 8);
    const In& I = args.in;
#define GRID_BAR() xcd_barrier(bar)
#ifndef DUP_PHASE
#define DUP_PHASE -1
#endif
#define RUN(n, call) do { call; if (DUP_PHASE == (n)) { GRID_BAR(); call; } } while (0)

#if STAGE >= 2
    RUN(0, p0_prologue(F, I));
    GRID_BAR();
#endif
#if STAGE >= 3
    RUN(1, p1_proj(F, I));
    GRID_BAR();
    RUN(2, p2_shift_attn(F, I));
    GRID_BAR();
#if STAGE >= 4
    RUN(3, p3_lora(F, I));
    GRID_BAR();
    RUN(4, p4a_chunk(F, I));
    GRID_BAR();
    RUN(44, p4b_scan(F, I));
    GRID_BAR();
    RUN(5, p5_post(F, I));
    GRID_BAR();
#endif
    RUN(6, p6_merged(F, I));
    GRID_BAR();
    RUN(7, p7_mix(F, I));
    GRID_BAR();
#endif
    p8_ln_router<(STAGE < 3)>(F, I);
    GRID_BAR();
#if STAGE >= 2
    p9_scatter(F, I);
    GRID_BAR();
    RUN(10, p10_moe_up(F, I));
    GRID_BAR();
    RUN(11, p11_moe_down(F, I));
    GRID_BAR();
#endif
    RUN(12, p12_final<(STAGE < 2)>(F, I, args.out));
}

extern "C" void kernel_launch(void* const* d_in, const int* in_sizes, int n_in, void* d_out, int out_size, void* d_ws, size_t ws_size, hipStream_t stream) {
    static int grid = 0;
    if (grid == 0) {
        if (n_in != 27 || in_sizes[0] != T * D || out_size != T * D || ws_size < WS_END) { fprintf(stderr, "kernel_launch: unexpected shapes (n_in %d, in0 %d, out %d, ws %zu)\n", n_in, n_in > 0 ? in_sizes[0] : -1, out_size, ws_size); grid = -1; return; }
        int dev = 0, cus = 0, per_cu = 0;
        if (hipGetDevice(&dev) != hipSuccess || hipDeviceGetAttribute(&cus, hipDeviceAttributeMultiprocessorCount, dev) != hipSuccess) { grid = -1; return; }
        if (hipFuncSetAttribute((const void*)mk_fwd, hipFuncAttributeMaxDynamicSharedMemorySize, LDS_BYTES) != hipSuccess) { fprintf(stderr, "kernel_launch: hipFuncSetAttribute failed\n"); grid = -1; return; }
        if (hipOccupancyMaxActiveBlocksPerMultiprocessor(&per_cu, (const void*)mk_fwd, NWAVES * 64, LDS_BYTES) != hipSuccess || per_cu < 1)
            fprintf(stderr, "kernel_launch: occupancy query reports %d\n", per_cu);
        (void)hipGetLastError();
        grid = cus;
    }
    if (grid < 0) return;
    if (hipMemsetAsync((char*)d_ws + WS_CTL, 0, CTL_ZERO_BYTES, stream) != hipSuccess) return;
    Args a{};
    const float** ip = (const float**)&a.in;
    for (int i = 0; i < 27; ++i) ip[i] = (const float*)d_in[i];
    a.out = (float*)d_out; a.ws = (unsigned char*)d_ws;
    hipLaunchKernelGGL(mk_fwd, dim3(grid), dim3(NWAVES * 64), LDS_BYTES, stream, a);
    const hipError_t le = hipPeekAtLastError();
    if (le != hipSuccess) fprintf(stderr, "kernel_launch: launch failed: %s\n", hipGetErrorName(le));
}
```

```cpp
#define STAGE 4
#include <hip/hip_runtime.h>
#include <cstdio>
#include <cstdint>

#define GAS __attribute__((address_space(1)))
#define LAS __attribute__((address_space(3)))
typedef unsigned short bf16;
typedef unsigned v4u __attribute__((ext_vector_type(4)));
typedef unsigned v2u __attribute__((ext_vector_type(2)));
typedef float f32x4 __attribute__((ext_vector_type(4)));
typedef float f32x2 __attribute__((ext_vector_type(2)));
typedef float f32x16 __attribute__((ext_vector_type(16)));
typedef short bf16x8 __attribute__((ext_vector_type(8)));
typedef short bf16x4 __attribute__((ext_vector_type(4)));
typedef GAS unsigned gu32;

constexpr int NWAVES = 8;
constexpr int BATCH = 4, SEQ = 8192, D = 2048, T = BATCH * SEQ;
constexpr int CHUNK = 64, LEFT = 8, AH = 16, AD = 64, AW = 1024;
constexpr int REL_TABLE = 320, MAX_PAST = 256;
constexpr int RH = 16, RN = 64, RW = 1024, DLORA = 96, ALORA = 96, GLORA = 256;
constexpr int SHIFT_W = 3 * RW + DLORA + ALORA + GLORA;
constexpr int D_IN = 3 * AW + SHIFT_W + 2 * D;
constexpr int NE = 32, TOPK = 4, FF = 2048;
constexpr int MSLOT = T * TOPK;
constexpr int NBLK_MAX = (MSLOT + NE * 255 + 255) / 256;
constexpr int RROWS = NBLK_MAX * 256;
constexpr float LN_EPS = 1e-5f, GN_EPS = 64e-5f;
constexpr float YS_SCALE = 16.0f, YS_INV = 1.0f / 16.0f;
constexpr float ACT8_SCALE = 16.0f;
constexpr float F8_CVT_SCALE = 0.015625f;
constexpr float DN_ALPHA = 1.189207115002721f;
constexpr int PROJ_LD = 9728, PJ_Q = 0, PJ_K = 1024, PJ_SEG = 2048, SEG_PAD = 3584, PJ_GA = 5632, PJ_GB = 7680;
constexpr int LORA_LD = 512;

constexpr size_t MiB = 1u << 20;
constexpr size_t WS_CTL = 0, CTL_ZERO_BYTES = 1 * MiB;
constexpr size_t WS_TOPI = 2 * MiB;
constexpr size_t WS_GATE = 3 * MiB;
constexpr size_t WS_ROWSLOT = 4 * MiB;
constexpr size_t WS_ROWW = 5 * MiB;
constexpr size_t WS_WLA = 6 * MiB;
constexpr size_t WS_WLG = 7 * MiB;
constexpr size_t WS_PAT = 8 * MiB;
constexpr size_t WS_PBT = 12 * MiB;
constexpr size_t WS_WOT = 16 * MiB;
constexpr size_t WS_WVT = 24 * MiB;
constexpr size_t WS_SIDE0 = 28 * MiB, WS_SIDEL = 36 * MiB;
constexpr size_t WS_WINT = 28 * MiB;
constexpr size_t WS_WG8 = 72 * MiB;
constexpr size_t WS_WQK8 = 80 * MiB;
constexpr size_t WS_WV8 = 84 * MiB;
constexpr size_t WS_WSV8 = 88 * MiB;
constexpr size_t WS_WGUT = 128 * MiB;
constexpr size_t WS_WDNT = 640 * MiB;
constexpr size_t WS_BASE0 = 1024 * MiB;
constexpr size_t WS_PROJ = WS_BASE0;
constexpr size_t WS_VT = WS_PROJ + 608 * MiB;
constexpr size_t WS_YA = WS_VT + 64 * MiB;
constexpr size_t WS_RKV = WS_YA + 64 * MiB;
constexpr size_t WS_LORAIN = WS_RKV + 192 * MiB;
constexpr size_t WS_DECAY = WS_LORAIN + 32 * MiB;
constexpr size_t WS_ICLR = WS_DECAY + 128 * MiB;
constexpr size_t WS_G = WS_ICLR + 128 * MiB;
constexpr size_t WS_YSCAN = WS_G + 64 * MiB;
constexpr size_t WS_YB = WS_YSCAN + 128 * MiB;
constexpr size_t WS_MERGED = WS_YB + 64 * MiB;
constexpr size_t WS_XB16 = WS_MERGED + 128 * MiB;
constexpr size_t WS_MIX_END = WS_XB16 + 128 * MiB;
constexpr size_t WS_Z = 2816 * MiB;
constexpr size_t WS_GATEF = WS_Z;
constexpr size_t WS_H1 = 3072 * MiB;
constexpr size_t WS_H1B = 3328 * MiB;
constexpr size_t WS_CHK = 3456 * MiB;
constexpr size_t WS_XB8 = 3712 * MiB;
constexpr size_t WS_END = 3776 * MiB;
constexpr size_t WS_XG = WS_BASE0;
constexpr size_t WS_ACT = WS_BASE0 + 544 * MiB;
constexpr size_t WS_YSLOT = WS_BASE0 + 1088 * MiB;
static_assert(WS_MIX_END <= WS_Z && WS_YSLOT + 512 * MiB <= WS_Z, "ws map");
static_assert(WS_WINT + (size_t)PROJ_LD * D * 2 <= WS_WGUT, "ws map");

constexpr int CW_CNT = 512;
constexpr int CW_CUR = 576;
constexpr int CW_BAR = 4096;

constexpr int RING_OFF = 0, RING_BYTES = 131072;
constexpr int LDS_BYTES = 160 * 1024;
constexpr int MISC_OFF = LDS_BYTES - 512;
constexpr int TAB_OFF = LDS_BYTES - 1024;

#define RLX_AGENT __ATOMIC_RELAXED, __HIP_MEMORY_SCOPE_AGENT
#define LDS_WAIT() asm volatile("s_waitcnt lgkmcnt(0)" ::: "memory")
#define VM_WAIT() asm volatile("s_waitcnt vmcnt(0)" ::: "memory")
__device__ __forceinline__ unsigned f2bf(float f) { unsigned u = __builtin_bit_cast(unsigned, f); return (u + 0x7fffu + ((u >> 16) & 1u)) >> 16; }
__device__ __forceinline__ unsigned pk2(float lo, float hi) { return f2bf(lo) | (f2bf(hi) << 16); }
__device__ __forceinline__ float bf2f(unsigned short h) { return __builtin_bit_cast(float, (unsigned)h << 16); }
__device__ __forceinline__ float bflo(unsigned w) { return __builtin_bit_cast(float, w << 16); }
__device__ __forceinline__ float bfhi(unsigned w) { return __builtin_bit_cast(float, w & 0xffff0000u); }
__device__ __forceinline__ float fsigmoid(float x) { return __builtin_amdgcn_rcpf(1.0f + __expf(-x)); }
__device__ __forceinline__ float dpp_f(float x, const int ctrl_sel) {
    const int xi = __builtin_bit_cast(int, x); int r;
    if (ctrl_sel == 0) r = __builtin_amdgcn_update_dpp(0, xi, 0xB1, 0xF, 0xF, false);
    else if (ctrl_sel == 1) r = __builtin_amdgcn_update_dpp(0, xi, 0x4E, 0xF, 0xF, false);
    else if (ctrl_sel == 2) r = __builtin_amdgcn_update_dpp(0, xi, 0x124, 0xF, 0xF, false);
    else r = __builtin_amdgcn_update_dpp(0, xi, 0x128, 0xF, 0xF, false);
    return __builtin_bit_cast(float, r);
}
__device__ __forceinline__ float rowsum16(float x) { x += dpp_f(x, 0); x += dpp_f(x, 1); x += dpp_f(x, 2); x += dpp_f(x, 3); return x; }
__device__ __forceinline__ float quadsum(float x) { x += dpp_f(x, 0); x += dpp_f(x, 1); return x; }
__device__ __forceinline__ float wave_sum(float v) {
    v = rowsum16(v);
    const int vi = __builtin_bit_cast(int, v);
    const float s0 = __builtin_bit_cast(float, __builtin_amdgcn_readlane(vi, 0)), s1 = __builtin_bit_cast(float, __builtin_amdgcn_readlane(vi, 16));
    const float s2 = __builtin_bit_cast(float, __builtin_amdgcn_readlane(vi, 32)), s3 = __builtin_bit_cast(float, __builtin_amdgcn_readlane(vi, 48));
    return (s0 + s1) + (s2 + s3);
}
namespace pg8 {
#define PG8_LAS __attribute__((address_space(3)))
typedef unsigned short bf16_t;
typedef unsigned u32x4 __attribute__((ext_vector_type(4)));
constexpr int BM = 256, BK = 64, HALF = 128, HTB = HALF * BK * 2, STAGE_BYTES = 8 * HTB, NXCD = 8, WGM = 8;

__host__ __device__ __forceinline__ int lds_byte(int r, int c) { const int st = (r >> 4) * 2 + (c >> 5), rr = r & 15, cc = c & 31, ob = rr * 64 + cc * 2; return st * 1024 + (ob ^ (((ob >> 9) & 1) << 5)); }
__host__ __device__ __forceinline__ void stage_rc(int b, int& R, int& C) { const int st = b / 1024, sb = b % 1024, swz = sb ^ (((sb >> 9) & 1) << 5); R = (st >> 1) * 16 + swz / 64; C = (st & 1) * 32 + (swz % 64) / 2; }
__host__ __device__ __forceinline__ int perm32(int rho) { const int n = rho >> 4, i = rho & 15; return 8 * (i >> 2) + 4 * n + (i & 3); }

struct Unit { int pm, pn, aux; };

struct Tiler {
    int nM, nN, nwg, G, c;
    __device__ __forceinline__ void init(int nM_, int nN_, int G_, int c_) { nM = nM_; nN = nN_; nwg = nM * nN; G = G_; c = c_; }
    __device__ __forceinline__ bool map(int i, int& pm, int& pn) const {
        const long L = (long)i * G + c; if (L >= nwg) return false;
        int wgid = (int)L; { const int q = nwg / NXCD, r = nwg % NXCD, xcd = wgid % NXCD, off = wgid / NXCD; wgid = (xcd < r ? xcd * (q + 1) : r * (q + 1) + (xcd - r) * q) + off; }
        const int nig = WGM * nN, gid = wgid / nig, fm = gid * WGM, gsz = (nM - fm) < WGM ? (nM - fm) : WGM;
        pm = fm + ((wgid % nig) % gsz); pn = (wgid % nig) / gsz; return true;
    }
};
struct SchedPlain {
    Tiler t; unsigned A, B, tsA, tsB;
    __device__ __forceinline__ bool next(int i, Unit& u) const { u.aux = 0; return t.map(i, u.pm, u.pn); }
    __device__ __forceinline__ void bases(const Unit& u, unsigned& a, unsigned& b) const { a = A + (unsigned)u.pm * tsA; b = B + (unsigned)u.pn * tsB; }
};
struct SchedTwo {
    Tiler t; unsigned A0, A1, B0, B1, tsA, tsB;
    __device__ __forceinline__ bool next(int i, Unit& u) const { u.aux = i & 1; return t.map(i >> 1, u.pm, u.pn); }
    __device__ __forceinline__ void bases(const Unit& u, unsigned& a, unsigned& b) const { a = (u.aux ? A1 : A0) + (unsigned)u.pm * tsA; b = (u.aux ? B1 : B0) + (unsigned)u.pn * tsB; }
};
struct SchedMoe {
    Tiler t; unsigned A, B, tsA, tsB, es; const PG8_LAS int* pad_end;
    __device__ __forceinline__ bool next(int i, Unit& u) const {
        if (!t.map(i, u.pm, u.pn)) return false;
        const int row0 = u.pm * BM; int e = 0;
#pragma unroll
        for (int j = 0; j < 32; ++j) e += (pad_end[j] <= row0) ? 1 : 0;
        u.aux = __builtin_amdgcn_readfirstlane(e < 31 ? e : 31); return true;
    }
    __device__ __forceinline__ void bases(const Unit& u, unsigned& a, unsigned& b) const { a = A + (unsigned)u.pm * tsA; b = B + (unsigned)u.aux * es + (unsigned)u.pn * tsB; }
};

typedef float f32x2_t_ __attribute__((ext_vector_type(2)));
typedef __bf16 bf16x2_t_ __attribute__((ext_vector_type(2)));
__device__ __forceinline__ unsigned cvt_pk_bf16(float lo, float hi) { const f32x2_t_ v = {lo, hi}; const bf16x2_t_ b = __builtin_convertvector(v, bf16x2_t_); return __builtin_bit_cast(unsigned, b); }
__device__ __forceinline__ u32x4 pack8(const f32x4& v0, const f32x4& v1) { u32x4 w; w.x = cvt_pk_bf16(v0[0], v0[1]); w.y = cvt_pk_bf16(v0[2], v0[3]); w.z = cvt_pk_bf16(v1[0], v1[1]); w.w = cvt_pk_bf16(v1[2], v1[3]); return w; }

typedef int i32x8 __attribute__((ext_vector_type(8)));
typedef int i32x4 __attribute__((ext_vector_type(4)));
__device__ __forceinline__ i32x8 cat8(const bf16x8& a, const bf16x8& b) { return __builtin_shufflevector(__builtin_bit_cast(i32x4, a), __builtin_bit_cast(i32x4, b), 0, 1, 2, 3, 4, 5, 6, 7); }
constexpr int F8_SCALES = 0x00007f79;
template <class Epi, class Sched, bool ALIGN_EPI, bool F8 = false, int F8SC = F8_SCALES>
__device__ __forceinline__ void gemm_phase(PG8_LAS unsigned char* lds, const __amdgpu_buffer_rsrc_t rsrc, const int lda, const int ldb, const int K, const Sched& S, const Epi& E) {
    int tid_ = threadIdx.x; asm volatile("" : "+v"(tid_));
    const int tid = tid_, wid = __builtin_amdgcn_readfirstlane(tid >> 6), lane = tid & 63, wr = wid >> 2, wc = wid & 3, fr = lane & 15, fq = lane >> 4;
    const int nt = K / BK;
    unsigned voffA, voffB;
    { int R, C; stage_rc(tid * 16, R, C); const int Rb = (R & ~31) + perm32(R & 31); voffA = (unsigned)(R * lda + C) * 2u; voffB = (unsigned)(Rb * ldb + C) * 2u; }
    const unsigned p1voffA = 64u * (unsigned)lda * 2u, p1voffB = 64u * (unsigned)ldb * 2u;
    const unsigned kstep = (unsigned)(BK * 2);
    const unsigned hsA = (unsigned)HALF * lda * 2, hsB = (unsigned)HALF * ldb * 2;
    const unsigned ldsw = (unsigned)wid * 1024u;
    const int aoff = lds_byte(wr * 64 + fr, fq * 8), boff = lds_byte(wc * 32 + fr, fq * 8);
#define PG8_SA(b, h) (((b) * 2 + (h)) * HTB)
#define PG8_SB(b, h) ((4 + (b) * 2 + (h)) * HTB)
#define PG8_STAGE(bufoff, goff, voff) do { _Pragma("unroll") for (int _i = 0; _i < 2; ++_i) \
        __builtin_amdgcn_raw_ptr_buffer_load_lds(rsrc, (PG8_LAS void*)(lds + (bufoff) + ldsw + _i * 8192), 16, (int)(voff), (int)((goff) + _i * p1##voff), 0, 0); } while (0)
#define PG8_LD8(addr) __builtin_shufflevector(*(const PG8_LAS i32x4*)(addr), *(const PG8_LAS i32x4*)((addr) + 1024), 0, 1, 2, 3, 4, 5, 6, 7)
#define PG8_LDA(dst, b, h) do { _Pragma("unroll") for (int m = 0; m < 4; ++m) dst[m] = PG8_LD8(lds + PG8_SA(b, h) + aoff + m * 2048); } while (0)
#define PG8_LDB(dst, b, h) do { _Pragma("unroll") for (int n = 0; n < 2; ++n) dst[n] = PG8_LD8(lds + PG8_SB(b, h) + boff + n * 2048); } while (0)
#define PG8_LO(v) __builtin_bit_cast(bf16x8, __builtin_shufflevector(v, v, 0, 1, 2, 3))
#define PG8_HI(v) __builtin_bit_cast(bf16x8, __builtin_shufflevector(v, v, 4, 5, 6, 7))
#define PG8_MMA(ai, bj, At, Bt) do { __builtin_amdgcn_s_setprio(1); \
        if constexpr (!F8) { _Pragma("unroll") for (int m = 0; m < 4; ++m) _Pragma("unroll") for (int n = 0; n < 2; ++n) { \
            acc[ai][bj][m][n] = __builtin_amdgcn_mfma_f32_16x16x32_bf16(PG8_LO(Bt[n]), PG8_LO(At[m]), acc[ai][bj][m][n], 0, 0, 0); \
            acc[ai][bj][m][n] = __builtin_amdgcn_mfma_f32_16x16x32_bf16(PG8_HI(Bt[n]), PG8_HI(At[m]), acc[ai][bj][m][n], 0, 0, 0); } } \
        else { _Pragma("unroll") for (int m = 0; m < 4; ++m) _Pragma("unroll") for (int n = 0; n < 2; ++n) \
            acc[ai][bj][m][n] = __builtin_amdgcn_mfma_scale_f32_16x16x128_f8f6f4(Bt[n], At[m], acc[ai][bj][m][n], 0, 0, 0, F8SC, 1, F8SC); } \
        __builtin_amdgcn_s_setprio(0); } while (0)
#define PG8_WAIT_V(n) asm volatile("s_waitcnt vmcnt(" #n ")" ::: "memory")
#define PG8_WAIT_L(n) asm volatile("s_waitcnt lgkmcnt(" #n ")" ::: "memory")
#define PG8_BAR __builtin_amdgcn_s_barrier()
#define PG8_SCHED __builtin_amdgcn_sched_barrier(0)
#define PG8_ZERO() do { _Pragma("unroll") for (int a = 0; a < 2; ++a) _Pragma("unroll") for (int b = 0; b < 2; ++b) _Pragma("unroll") for (int m = 0; m < 4; ++m) _Pragma("unroll") for (int n = 0; n < 2; ++n) acc[a][b][m][n] = (f32x4){0.f, 0.f, 0.f, 0.f}; } while (0)
    Unit cur, nxt; int ui = 0;
    if (!S.next(0, cur)) return;
    f32x4 acc[2][2][4][2];
    PG8_ZERO();
    i32x8 At[4], B0[2], B1[2];
    unsigned cA, cB; S.bases(cur, cA, cB); cA = __builtin_amdgcn_readfirstlane(cA); cB = __builtin_amdgcn_readfirstlane(cB);
    PG8_STAGE(PG8_SB(0, 0), cB, voffB); PG8_STAGE(PG8_SB(0, 1), cB + hsB, voffB); PG8_STAGE(PG8_SA(0, 0), cA, voffA); PG8_STAGE(PG8_SA(0, 1), cA + hsA, voffA);
    if (wr == 1) PG8_BAR;
    PG8_WAIT_V(2); PG8_BAR;
    PG8_STAGE(PG8_SB(1, 0), cB + kstep, voffB); PG8_STAGE(PG8_SA(1, 0), cA + kstep, voffA); PG8_STAGE(PG8_SB(1, 1), cB + hsB + kstep, voffB);
    PG8_WAIT_V(6); PG8_BAR;
    for (;;) {
        const bool has_next = S.next(ui + 1, nxt);
        unsigned nA = cA, nB = cB; if (has_next) { S.bases(nxt, nA, nB); nA = __builtin_amdgcn_readfirstlane(nA); nB = __builtin_amdgcn_readfirstlane(nB); }
#pragma unroll 1
        for (int t = 0; t < nt; t += 2) {
            const bool last = (t == nt - 2);
            const unsigned a1 = cA + (unsigned)(t + 1) * kstep;
            const unsigned a2 = last ? nA : cA + (unsigned)(t + 2) * kstep, b2 = last ? nB : cB + (unsigned)(t + 2) * kstep;
            const unsigned a3 = a2 + kstep, b3 = b2 + kstep;
            PG8_LDB(B0, 0, 0); PG8_LDB(B1, 0, 1); PG8_SCHED; PG8_LDA(At, 0, 0); PG8_STAGE(PG8_SA(1, 1), a1 + hsA, voffA);
            PG8_WAIT_V(8); PG8_WAIT_L(0); PG8_BAR; PG8_MMA(0, 0, At, B0); PG8_MMA(0, 1, At, B1); PG8_BAR; PG8_SCHED;
            PG8_LDA(At, 0, 1); PG8_STAGE(PG8_SB(0, 0), b2, voffB); PG8_STAGE(PG8_SB(0, 1), b2 + hsB, voffB); PG8_STAGE(PG8_SA(0, 0), a2, voffA);
            PG8_WAIT_V(8); PG8_WAIT_L(0); PG8_BAR; PG8_MMA(1, 0, At, B0); PG8_MMA(1, 1, At, B1); PG8_BAR; PG8_SCHED;
            PG8_LDB(B0, 1, 0); PG8_LDB(B1, 1, 1); PG8_SCHED; PG8_LDA(At, 1, 0); PG8_STAGE(PG8_SA(0, 1), a2 + hsA, voffA);
            PG8_WAIT_V(8); PG8_WAIT_L(0); PG8_BAR; PG8_MMA(0, 0, At, B0); PG8_MMA(0, 1, At, B1); PG8_BAR; PG8_SCHED;
            PG8_LDA(At, 1, 1); PG8_STAGE(PG8_SB(1, 0), b3, voffB); PG8_STAGE(PG8_SB(1, 1), b3 + hsB, voffB); PG8_STAGE(PG8_SA(1, 0), a3, voffA);
            PG8_WAIT_V(8); PG8_WAIT_L(0); PG8_BAR; PG8_MMA(1, 0, At, B0); PG8_MMA(1, 1, At, B1); PG8_BAR; PG8_SCHED;
        }
        if constexpr (ALIGN_EPI) { if (wr == 0) PG8_BAR; }
        bool keep; { int t2 = threadIdx.x; asm volatile("" : "+v"(t2)); const int w2 = __builtin_amdgcn_readfirstlane(t2 >> 6), l2 = t2 & 63; keep = E(acc, cur, w2 >> 2, w2 & 3, l2 & 15, l2 >> 4); }
        if (!has_next) break;
        if (!keep) PG8_ZERO();
        cur = nxt; cA = nA; cB = nB; ++ui;
        if constexpr (ALIGN_EPI) { if (wr == 1) PG8_BAR; }
    }
    PG8_WAIT_V(0);
    if constexpr (!ALIGN_EPI) { if (wr == 0) PG8_BAR; }
    PG8_BAR;
#undef PG8_SA
#undef PG8_SB
#undef PG8_STAGE
#undef PG8_LDA
#undef PG8_LDB
#undef PG8_LD8
#undef PG8_LO
#undef PG8_HI
#undef PG8_MMA
#undef PG8_WAIT_V
#undef PG8_WAIT_L
#undef PG8_BAR
#undef PG8_SCHED
#undef PG8_ZERO
}
}
namespace pg8 {
#define EPI_ROWLOOP _Pragma("unroll") for (int ai = 0; ai < 2; ++ai) _Pragma("unroll") for (int m = 0; m < 4; ++m)
struct EpiProj {
    bf16_t* O; int coloff, nq;
    __device__ __forceinline__ bool operator()(f32x4 (&acc)[2][2][4][2], const Unit& u, int wr, int wc, int fr, int fq) const {
        const int row0 = u.pm * BM + wr * 64 + fr, col0 = coloff + u.pn * BM + wc * 32 + 8 * fq;
        const float sc = (u.pn < nq) ? 0.125f : 1.0f;
        EPI_ROWLOOP { bf16_t* rowp = O + (size_t)(row0 + ai * HALF + m * 16) * PROJ_LD + col0;
#pragma unroll
            for (int bj = 0; bj < 2; ++bj) *(u32x4*)(rowp + bj * HALF) = pack8(acc[ai][bj][m][0] * sc, acc[ai][bj][m][1] * sc); }
        return false;
    }
};
__device__ __forceinline__ float dpp_prev_row(float lo15, float cur) {
    const int o = __builtin_amdgcn_update_dpp(0, __builtin_bit_cast(int, lo15), 0x121, 0xF, 0xF, false);
    return __builtin_bit_cast(float, __builtin_amdgcn_update_dpp(o, __builtin_bit_cast(int, cur), 0x111, 0xF, 0xF, false));
}
struct EpiShift {
    bf16_t* RKVp; bf16_t* LIN; float* SIDE0; float* SIDEL; const float* mu;
    __device__ __forceinline__ bool operator()(f32x4 (&acc)[2][2][4][2], const Unit& u, int wr, int wc, int fr, int fq) const {
        static_assert(DLORA % 32 == 0 && ALORA % 32 == 0 && GLORA % 32 == 0 && RW % 32 == 0, "segment boundaries are wave-uniform");
        const int row0 = u.pm * BM + wr * 64 + fr;
#pragma unroll
        for (int bj = 0; bj < 2; ++bj) {
            const int cgrp = u.pn * BM + bj * HALF + wc * 32;
            if (cgrp >= SHIFT_W) continue;
            const int c = cgrp + 8 * fq;
            const f32x4 mu0 = *(const f32x4*)(mu + c), mu1 = *(const f32x4*)(mu + c + 4);
            bf16_t* dbase; int ld, act = 0;
            if (cgrp < 3 * RW) { dbase = RKVp + c; ld = 3 * RW; }
            else if (cgrp < 3 * RW + DLORA) { dbase = LIN + (c - 3 * RW); ld = LORA_LD; act = 1; }
            else if (cgrp < 3 * RW + DLORA + ALORA) { dbase = LIN + 128 + (c - 3 * RW - DLORA); ld = LORA_LD; }
            else { dbase = LIN + 256 + (c - 3 * RW - DLORA - ALORA); ld = LORA_LD; act = 2; }
            const bool zpad = (cgrp == 3 * RW + DLORA - 32) || (cgrp == 3 * RW + DLORA + ALORA - 32);
#pragma unroll
            for (int ai = 0; ai < 2; ++ai) {
                const int g = u.pm * 4 + ai * 2 + wr;
#pragma unroll
                for (int m = 0; m < 4; ++m) {
                    f32x4 o[2];
#pragma unroll
                    for (int n = 0; n < 2; ++n) { const f32x4 cur = acc[ai][bj][m][n]; const f32x4 mm = n ? mu1 : mu0;
#pragma unroll
                        for (int j = 0; j < 4; ++j) { const float prv = dpp_prev_row(m > 0 ? acc[ai][bj][m > 0 ? m - 1 : 0][n][j] : 0.0f, cur[j]);
                            float v = cur[j] + (prv - cur[j]) * mm[j];
                            if (act == 1) v = 2.0f * fsigmoid(2.0f * v) - 1.0f; else if (act == 2) v = fsigmoid(v);
                            o[n][j] = v; } }
                    bf16_t* dp = dbase + (size_t)(row0 + ai * HALF + m * 16) * ld;
                    *(u32x4*)dp = pack8(o[0], o[1]);
                    if (zpad) { unsigned zz = 0u; asm volatile("" : "+v"(zz)); *(u32x4*)(dp + 32) = (u32x4){zz, zz, zz, zz}; }
                    if (m == 0 && fr == 0) { float* sp = SIDE0 + (size_t)g * SEG_PAD + c; *(f32x4*)sp = acc[ai][bj][0][0]; *(f32x4*)(sp + 4) = acc[ai][bj][0][1]; }
                    if (m == 3 && fr == 15) { float* sp = SIDEL + (size_t)g * SEG_PAD + c; *(f32x4*)sp = acc[ai][bj][3][0]; *(f32x4*)(sp + 4) = acc[ai][bj][3][1]; }
                } }
        }
        return false;
    }
};
struct EpiGate {
    bf16_t* O;
    __device__ __forceinline__ bool operator()(f32x4 (&acc)[2][2][4][2], const Unit& u, int wr, int wc, int fr, int fq) const {
        u32x4* gf = (u32x4*)O + ((size_t)(u.pm * 16 + u.pn) * 2 * 8 + (wr * 4 + wc)) * 512 + (fq * 16 + fr);
        EPI_ROWLOOP {
            f32x4 rt[2], gb[2];
#pragma unroll
            for (int n = 0; n < 2; ++n)
#pragma unroll
                for (int j = 0; j < 4; ++j) { const float ea = __expf(-acc[ai][0][m][n][j]), eb = fminf(__expf(-acc[ai][1][m][n][j]), 1e30f);
                    gb[n][j] = __builtin_amdgcn_rcpf(1.0f + eb); rt[n][j] = (1.0f + eb) * __builtin_amdgcn_rcpf(1.0f + ea); }
            gf[(ai * 4 + m) * 64] = pack8(rt[0], rt[1]); gf[8 * 512 + (ai * 4 + m) * 64] = pack8(gb[0], gb[1]); }
        return false;
    }
};
struct EpiBf16 {
    bf16_t* O; int ldc;
    __device__ __forceinline__ bool operator()(f32x4 (&acc)[2][2][4][2], const Unit& u, int wr, int wc, int fr, int fq) const {
        const int row0 = u.pm * BM + wr * 64 + fr, col0 = u.pn * BM + wc * 32 + 8 * fq;
        EPI_ROWLOOP { bf16_t* rowp = O + (size_t)(row0 + ai * HALF + m * 16) * ldc + col0;
#pragma unroll
            for (int bj = 0; bj < 2; ++bj) *(u32x4*)(rowp + bj * HALF) = pack8(acc[ai][bj][m][0], acc[ai][bj][m][1]); }
        return false;
    }
};
template <bool ISDEC> struct EpiLoraA {
    float* OUT; const float* par;
    __device__ __forceinline__ bool operator()(f32x4 (&acc)[2][2][4][2], const Unit& u, int wr, int wc, int fr, int fq) const {
        const int row0 = u.pm * BM + wr * 64 + fr, col0 = u.pn * BM + wc * 32 + 8 * fq;
        f32x4 pv[2][2];
#pragma unroll
        for (int bj = 0; bj < 2; ++bj)
#pragma unroll
            for (int n = 0; n < 2; ++n) pv[bj][n] = *(const f32x4*)(par + col0 + bj * HALF + 4 * n);
        EPI_ROWLOOP { float* rowp = OUT + (size_t)(row0 + ai * HALF + m * 16) * RW + col0;
#pragma unroll
            for (int bj = 0; bj < 2; ++bj)
#pragma unroll
                for (int n = 0; n < 2; ++n) { f32x4 v = acc[ai][bj][m][n] + pv[bj][n];
#pragma unroll
                    for (int j = 0; j < 4; ++j) {
                        if (ISDEC) v[j] = -0.60653065971263342f * fsigmoid(v[j]);
                        else v[j] = fsigmoid(v[j]); }
                    *(f32x4*)(rowp + bj * HALF + 4 * n) = v; } }
        return false;
    }
};
struct EpiIclr {
    bf16_t* OUT; const float* par;
    __device__ __forceinline__ bool operator()(f32x4 (&acc)[2][2][4][2], const Unit& u, int wr, int wc, int fr, int fq) const {
        const int row0 = u.pm * BM + wr * 64 + fr, col0 = u.pn * BM + wc * 32 + 8 * fq;
        f32x4 pv[2][2];
#pragma unroll
        for (int bj = 0; bj < 2; ++bj)
#pragma unroll
            for (int n = 0; n < 2; ++n) pv[bj][n] = *(const f32x4*)(par + col0 + bj * HALF + 4 * n);
        EPI_ROWLOOP { bf16_t* rowp = OUT + (size_t)(row0 + ai * HALF + m * 16) * RW + col0;
#pragma unroll
            for (int bj = 0; bj < 2; ++bj) { f32x4 v0 = acc[ai][bj][m][0] + pv[bj][0], v1 = acc[ai][bj][m][1] + pv[bj][1];
#pragma unroll
                for (int j = 0; j < 4; ++j) { v0[j] = fsigmoid(v0[j]); v1[j] = fsigmoid(v1[j]); }
                *(u32x4*)(rowp + bj * HALF) = pack8(v0, v1); } }
        return false;
    }
};
struct EpiMerged {
    const bf16_t* PROJ; bf16_t* O;
    __device__ __forceinline__ bool operator()(f32x4 (&acc)[2][2][4][2], const Unit& u, int wr, int wc, int fr, int fq) const {
        const int row0 = u.pm * BM + wr * 64 + fr, col0 = u.pn * BM + wc * 32 + 8 * fq;
        const u32x4* gf = (const u32x4*)PROJ + ((size_t)(u.pm * 16 + u.pn * 2) * 2 * 8 + (u.aux == 0 ? 0 : 8) + (wr * 4 + wc)) * 512 + (fq * 16 + fr);
#pragma unroll
        for (int ai = 0; ai < 2; ++ai) {
            u32x4 gv[4][2];
#pragma unroll
            for (int m = 0; m < 4; ++m)
#pragma unroll
                for (int bj = 0; bj < 2; ++bj) gv[m][bj] = gf[(size_t)bj * (2 * 8 * 512) + (ai * 4 + m) * 64];
#pragma unroll
            for (int m = 0; m < 4; ++m) { const int row = row0 + ai * HALF + m * 16;
#pragma unroll
                for (int bj = 0; bj < 2; ++bj) { const u32x4 g = gv[m][bj];
                    const f32x4 g0 = (f32x4){bflo(g.x), bfhi(g.x), bflo(g.y), bfhi(g.y)}, g1 = (f32x4){bflo(g.z), bfhi(g.z), bflo(g.w), bfhi(g.w)};
                    if (u.aux == 0) { acc[ai][bj][m][0] = acc[ai][bj][m][0] * g0; acc[ai][bj][m][1] = acc[ai][bj][m][1] * g1; }
                    else { const f32x4 o0 = acc[ai][bj][m][0] * g0 * ACT8_SCALE, o1 = acc[ai][bj][m][1] * g1 * ACT8_SCALE;
                        int w0 = __builtin_amdgcn_cvt_pk_fp8_f32(o0[0], o0[1], 0, false); w0 = __builtin_amdgcn_cvt_pk_fp8_f32(o0[2], o0[3], w0, true);
                        int w1 = __builtin_amdgcn_cvt_pk_fp8_f32(o1[0], o1[1], 0, false); w1 = __builtin_amdgcn_cvt_pk_fp8_f32(o1[2], o1[3], w1, true);
                        *(v2u*)((unsigned char*)O + (size_t)row * D + col0 + bj * HALF) = (v2u){(unsigned)w0, (unsigned)w1}; } } }
        }
        return u.aux == 0;
    }
};
struct EpiZ {
    const float* X; float* Z;
    __device__ __forceinline__ bool operator()(f32x4 (&acc)[2][2][4][2], const Unit& u, int wr, int wc, int fr, int fq) const {
        const int row0 = u.pm * BM + wr * 64 + fr, col0 = u.pn * BM + wc * 32 + 8 * fq;
        EPI_ROWLOOP { const size_t off = (size_t)(row0 + ai * HALF + m * 16) * D + col0;
#pragma unroll
            for (int bj = 0; bj < 2; ++bj)
#pragma unroll
                for (int n = 0; n < 2; ++n) { const f32x4 xv = *(const f32x4*)(X + off + bj * HALF + 4 * n); *(f32x4*)(Z + off + bj * HALF + 4 * n) = xv * DN_ALPHA + acc[ai][bj][m][n]; } }
        return false;
    }
};
struct EpiSwiglu {
    unsigned char* ACT; const float* bgu;
    __device__ __forceinline__ bool operator()(f32x4 (&acc)[2][2][4][2], const Unit& u, int wr, int wc, int fr, int fq) const {
        const int row0 = u.pm * BM + wr * 64 + fr, col0 = u.pn * HALF + wc * 32 + 8 * fq;
        const float* bp = bgu + (size_t)u.aux * (2 * FF) + col0;
        f32x4 bg[2], bu[2];
#pragma unroll
        for (int n = 0; n < 2; ++n) { bg[n] = *(const f32x4*)(bp + 4 * n); bu[n] = *(const f32x4*)(bp + FF + 4 * n); }
        EPI_ROWLOOP { f32x4 o[2];
#pragma unroll
            for (int n = 0; n < 2; ++n) { const f32x4 g = acc[ai][0][m][n] + bg[n], uu = acc[ai][1][m][n] + bu[n];
#pragma unroll
                for (int j = 0; j < 4; j += 2) {
                    f32x2 gc, uc; gc[0] = fminf(g[j], 7.0f); gc[1] = fminf(g[j + 1], 7.0f);
                    uc[0] = __builtin_amdgcn_fmed3f(uu[j], -7.0f, 7.0f); uc[1] = __builtin_amdgcn_fmed3f(uu[j + 1], -7.0f, 7.0f);
                    const f32x2 t = gc * (f32x2){-2.4554669595930156f, -2.4554669595930156f};
                    f32x2 d; d[0] = __builtin_amdgcn_exp2f(t[0]); d[1] = __builtin_amdgcn_exp2f(t[1]);
                    d = d + (f32x2){1.0f, 1.0f};
                    f32x2 r; r[0] = __builtin_amdgcn_rcpf(d[0]); r[1] = __builtin_amdgcn_rcpf(d[1]);
                    const f32x2 s = gc * r, oo = __builtin_elementwise_fma(uc, s, s);
                    o[n][j] = oo[0]; o[n][j + 1] = oo[1]; } }
            int w0 = __builtin_amdgcn_cvt_pk_fp8_f32(o[0][0], o[0][1], 0, false); w0 = __builtin_amdgcn_cvt_pk_fp8_f32(o[0][2], o[0][3], w0, true);
            int w1 = __builtin_amdgcn_cvt_pk_fp8_f32(o[1][0], o[1][1], 0, false); w1 = __builtin_amdgcn_cvt_pk_fp8_f32(o[1][2], o[1][3], w1, true);
            *(v2u*)(ACT + (size_t)(row0 + ai * HALF + m * 16) * FF + col0) = (v2u){(unsigned)w0, (unsigned)w1}; }
        return false;
    }
};
struct EpiDown {
    unsigned char* YS; const float* bdn; const int* rowslot; const float* roww;
    __device__ __forceinline__ bool operator()(f32x4 (&acc)[2][2][4][2], const Unit& u, int wr, int wc, int fr, int fq) const {
        const int row0 = u.pm * BM + wr * 64 + fr, col0 = u.pn * BM + wc * 32 + 8 * fq;
        const float* bp = bdn + (size_t)u.aux * D + col0;
        f32x4 bv[2][2];
#pragma unroll
        for (int bj = 0; bj < 2; ++bj)
#pragma unroll
            for (int n = 0; n < 2; ++n) bv[bj][n] = *(const f32x4*)(bp + bj * HALF + 4 * n);
        int slots[8]; float ws_[8];
#pragma unroll
        for (int q = 0; q < 8; ++q) { const int row = row0 + (q >> 2) * HALF + (q & 3) * 16; slots[q] = rowslot[row]; ws_[q] = roww[row]; }
        EPI_ROWLOOP { const int slot = slots[ai * 4 + m]; const float w = ws_[ai * 4 + m] * YS_SCALE;
            if (slot >= 0) { unsigned char* rowp = YS + (size_t)slot * D + col0;
#pragma unroll
                for (int bj = 0; bj < 2; ++bj) { const f32x4 o0 = (acc[ai][bj][m][0] + bv[bj][0]) * w, o1 = (acc[ai][bj][m][1] + bv[bj][1]) * w;
                    int w0 = __builtin_amdgcn_cvt_pk_fp8_f32(o0[0], o0[1], 0, false); w0 = __builtin_amdgcn_cvt_pk_fp8_f32(o0[2], o0[3], w0, true);
                    int w1 = __builtin_amdgcn_cvt_pk_fp8_f32(o1[0], o1[1], 0, false); w1 = __builtin_amdgcn_cvt_pk_fp8_f32(o1[2], o1[3], w1, true);
                    *(v2u*)(rowp + bj * HALF) = (v2u){(unsigned)w0, (unsigned)w1}; } } }
        return false;
    }
};
#undef EPI_ROWLOOP
}

#define XB_TMO      128
#define XB_XCNT(j)  (256  + 64 * (j))
#define XB_XSUB(j)  (1280 + 64 * (j))
#define XB_XGEN(j)  (2304 + 64 * (j))
#define XB_TOP      3328
#define XB_TOPGEN   3392
#define XCD_BAR_WORDS 3456
#define XB_SPIN_CAP (1u << 18)

__device__ __forceinline__ unsigned xb_ld(unsigned* p)              { return __hip_atomic_load(p, __ATOMIC_RELAXED, __HIP_MEMORY_SCOPE_AGENT); }
__device__ __forceinline__ unsigned xb_add(unsigned* p, unsigned v) { return __hip_atomic_fetch_add(p, v, __ATOMIC_RELAXED, __HIP_MEMORY_SCOPE_AGENT); }
__device__ __forceinline__ unsigned xb_xcc_id() { return (unsigned)__builtin_amdgcn_s_getreg((3 << 11) | 20) & 0xFu; }
#define XB_SPIN(cond, bar) do { unsigned _sp = 0; while (cond) { __builtin_amdgcn_s_sleep(1); \
    if ((++_sp & 255u) == 0u) { if (xb_ld(&(bar)[XB_TMO])) break; if (_sp > XB_SPIN_CAP) { atomicAdd(&(bar)[XB_TMO], 1u); break; } } } } while (0)

struct XcdBarrier {
    unsigned* bar; unsigned x;
    volatile LAS unsigned* st;
};

__device__ __forceinline__ XcdBarrier xcd_barrier_post(unsigned* bar, volatile LAS unsigned* st) {
    XcdBarrier b; b.bar = bar; b.x = xb_xcc_id(); b.st = st;
    if (threadIdx.x == 0) (void)xb_add(&bar[XB_XCNT(b.x)], 1u);
    return b;
}
__device__ __forceinline__ void xcd_barrier_complete(unsigned* bar, unsigned x, unsigned& nloc, unsigned& nx) {
    const unsigned G = gridDim.x * gridDim.y * gridDim.z;
    unsigned sum, cnt, mine, sp = 0u;
    for (;;) {
        sum = 0u; cnt = 0u; mine = 0u;
#pragma unroll
        for (unsigned j = 0; j < 16; ++j) { const unsigned c = xb_ld(&bar[XB_XCNT(j)]); sum += c; cnt += (c > 0u) ? 1u : 0u; mine = (j == x) ? c : mine; }
        if (sum == G) break;
        __builtin_amdgcn_s_sleep(1);
        if ((++sp & 255u) == 0u) { if (xb_ld(&bar[XB_TMO])) break; if (sp > XB_SPIN_CAP) { atomicAdd(&bar[XB_TMO], 1u); break; } }
    }
    nloc = mine > 0u ? mine : 1u; nx = cnt > 0u ? cnt : 1u;
}

__device__ __forceinline__ void xcd_barrier(const XcdBarrier& b) {
    asm volatile("s_waitcnt vmcnt(0)" ::: "memory");
    __syncthreads();
    if (threadIdx.x == 0) {
        unsigned* bar = b.bar;
        __builtin_amdgcn_s_waitcnt(0);
        unsigned nloc = b.st[0], nx = b.st[1];
        if (nloc == 0u) { xcd_barrier_complete(bar, b.x, nloc, nx); b.st[0] = nloc; b.st[1] = nx; }
        const unsigned old = xb_add(&bar[XB_XSUB(b.x)], 1u);
        const unsigned gen = old / nloc;
        if (old + 1u == (gen + 1u) * nloc) {
            __builtin_amdgcn_fence(__ATOMIC_RELEASE, "agent");
            asm volatile("s_waitcnt vmcnt(0)" ::: "memory");
            const unsigned og = xb_add(&bar[XB_TOP], 1u);
            const unsigned tg = og / nx;
            if (og + 1u == (tg + 1u) * nx) xb_add(&bar[XB_TOPGEN], 1u);
            else XB_SPIN(xb_ld(&bar[XB_TOPGEN]) == tg, bar);
            __builtin_amdgcn_fence(__ATOMIC_ACQUIRE, "agent");
            xb_add(&bar[XB_XGEN(b.x)], 1u);
            asm volatile("s_waitcnt vmcnt(0)" ::: "memory");
        } else {
            XB_SPIN(xb_ld(&bar[XB_XGEN(b.x)]) == gen, bar);
            __builtin_amdgcn_fence(__ATOMIC_ACQUIRE, "agent");
            asm volatile("s_waitcnt vmcnt(0)" ::: "memory");
        }
    }
    __syncthreads();
}
struct Frame {
    LAS unsigned char* lds;
    volatile LAS unsigned* MISC;
    gu32* ctl;
    int tid, lane, wave;
    int vcu, G;
    unsigned char* ws;
    __amdgpu_buffer_rsrc_t rsrc;
};

#define PHASE_FRAME(F0) Frame F = (F0); { int t_ = threadIdx.x; asm volatile("" : "+v"(t_)); F.tid = t_; F.lane = t_ & 63; F.wave = __builtin_amdgcn_readfirstlane(t_ >> 6); }

__device__ __forceinline__ void tr_item(const float* W, size_t ldw, int k0, int c0, bf16* WT, size_t ldt, int drow0, LAS float* scr, int lane) {
    const int kr = lane >> 4, cq = lane & 15;
    f32x4 v[16];
#pragma unroll
    for (int i = 0; i < 16; ++i) v[i] = *(const GAS f32x4*)(W + (size_t)(k0 + 4 * i + kr) * ldw + c0 + 4 * cq);
#pragma unroll
    for (int i = 0; i < 16; ++i)
#pragma unroll
        for (int j = 0; j < 4; ++j) scr[(4 * cq + j) * 65 + 4 * i + kr] = v[i][j];
    LDS_WAIT(); asm volatile("" ::: "memory");
    const int c = lane & 7;
#pragma unroll
    for (int jj = 0; jj < 8; ++jj) { const int n = (lane >> 3) + 8 * jj; const LAS float* s = scr + n * 65 + 8 * c;
        v4u o; o.x = pk2(s[0], s[1]); o.y = pk2(s[2], s[3]); o.z = pk2(s[4], s[5]); o.w = pk2(s[6], s[7]);
        *(GAS v4u*)(WT + (size_t)(drow0 + n) * ldt + k0 + 8 * c) = o; }
    LDS_WAIT(); asm volatile("" ::: "memory");
}

typedef short s16x2 __attribute__((ext_vector_type(2)));
struct MoeItem { __amdgpu_buffer_rsrc_t rs; unsigned soff, rstep; int ldw, k0; unsigned char* WT; size_t ldt; int drow; };
__device__ __forceinline__ void tr8_load(const MoeItem& m, f32x4 (&v)[16], int lane) {
    const int kr = lane >> 4, cq = lane & 15;
    const int voff = (kr * m.ldw + 4 * cq) * 4;
#pragma unroll
    for (int i = 0; i < 16; ++i) v[i] = __builtin_bit_cast(f32x4, __builtin_amdgcn_raw_buffer_load_b128(m.rs, voff, (int)(m.soff + (unsigned)i * m.rstep), 0));
}
__device__ __forceinline__ void tr8_finish(const f32x4 (&v)[16], const MoeItem& m, LAS float* scr_, int lane) {
    LAS unsigned char* scr = (LAS unsigned char*)scr_;
    const int kr = lane >> 4, cq = lane & 15;
#pragma unroll
    for (int j = 0; j < 4; ++j) { unsigned w[4];
#pragma unroll
        for (int q = 0; q < 4; ++q) { s16x2 t = {0, 0};
            t = __builtin_amdgcn_cvt_scalef32_pk_fp8_f32(t, v[4 * q][j], v[4 * q + 1][j], F8_CVT_SCALE, false);
            t = __builtin_amdgcn_cvt_scalef32_pk_fp8_f32(t, v[4 * q + 2][j], v[4 * q + 3][j], F8_CVT_SCALE, true);
            w[q] = __builtin_bit_cast(unsigned, t); }
        *(LAS v4u*)(scr + (4 * cq + j) * 80 + kr * 16) = (v4u){w[0], w[1], w[2], w[3]}; }
    LDS_WAIT(); asm volatile("" ::: "memory");
    const int qd = lane & 3;
#pragma unroll
    for (int ps = 0; ps < 4; ++ps) { const int n = (lane >> 2) + 16 * ps; const LAS unsigned char* s = scr + n * 80 + qd * 4;
        const unsigned d0 = *(const LAS unsigned*)(s), d1 = *(const LAS unsigned*)(s + 16), d2 = *(const LAS unsigned*)(s + 32), d3 = *(const LAS unsigned*)(s + 48);
        const unsigned t0 = __builtin_amdgcn_perm(d1, d0, 0x05010400u), t1 = __builtin_amdgcn_perm(d1, d0, 0x07030602u), t2 = __builtin_amdgcn_perm(d3, d2, 0x05010400u), t3 = __builtin_amdgcn_perm(d3, d2, 0x07030602u);
        const v4u o = (v4u){__builtin_amdgcn_perm(t2, t0, 0x05040100u), __builtin_amdgcn_perm(t2, t0, 0x07060302u), __builtin_amdgcn_perm(t3, t1, 0x05040100u), __builtin_amdgcn_perm(t3, t1, 0x07060302u)};
        *(GAS v4u*)(m.WT + (size_t)(m.drow + n) * m.ldt + m.k0 + 16 * qd) = o; }
    LDS_WAIT(); asm volatile("" ::: "memory");
}
constexpr int MOE_J4 = 32 * 32 * 64, MOE_J5 = 32 * 32 * 32, MOE_NITEMS = MOE_J4 + MOE_J5;
__device__ __forceinline__ MoeItem moe_item(int r, const float* w_gu, const float* w_down, unsigned char* ws) {
    MoeItem m;
    if (r < MOE_J4) { const int e = r / 2048, q = r % 2048, kb = q / 64, cb = q % 64, c0 = cb * 64; const int cc = c0 & 2047;
        m.rs = __builtin_amdgcn_make_buffer_rsrc((void*)w_gu, 0, 0xffffffff, 0x00020000); m.ldw = 2 * FF; m.k0 = kb * 64;
        m.soff = (unsigned)(((size_t)e * D * 2 * FF + (size_t)kb * 64 * (2 * FF) + c0) * 4); m.rstep = 4u * (2 * FF) * 4u;
        m.WT = ws + WS_WGUT + (size_t)e * 2 * FF * D; m.ldt = D; m.drow = (cc >> 7) * 256 + (c0 >= 2048 ? 128 : 0) + (cc & 127); }
    else { r -= MOE_J4; const int e = r / 1024, q = r % 1024, kb = q / 32, cb = q % 32;
        m.rs = __builtin_amdgcn_make_buffer_rsrc((void*)w_down, 0, 0xffffffff, 0x00020000); m.ldw = D; m.k0 = kb * 64;
        m.soff = (unsigned)(((size_t)e * FF * D + (size_t)kb * 64 * D + cb * 64) * 4); m.rstep = 4u * D * 4u;
        m.WT = ws + WS_WDNT + (size_t)e * D * FF; m.ldt = FF; m.drow = cb * 64; }
    return m;
}
__device__ __forceinline__ MoeItem f8_item(const float* W, int ldw, int k0, int c0, unsigned char* WT, size_t ldt, int drow) {
    MoeItem m; m.rs = __builtin_amdgcn_make_buffer_rsrc((void*)W, 0, 0xffffffff, 0x00020000); m.ldw = ldw; m.k0 = k0;
    m.soff = (unsigned)(((size_t)k0 * ldw + c0) * 4); m.rstep = 4u * (unsigned)ldw * 4u; m.WT = WT; m.ldt = ldt; m.drow = drow; return m;
}

struct In {
    const float *x, *w_in, *rel_bias, *shift_mu, *w0, *w_up, *a0, *a_up, *g_up, *k_k, *k_a, *r_k, *lnx_w, *lnx_b, *proj_a, *proj_b, *w_out,
                *ln1_w, *ln1_b, *w_router, *b_router, *w_gu, *b_gu, *w_down, *b_down, *ln2_w, *ln2_b;
};

__device__ __forceinline__ void p0_prologue(Frame& F0, const In& I) {
    PHASE_FRAME(F0);
    LAS float* scr = (LAS float*)(F.lds + F.wave * 16640);
    const int gw = F.vcu * NWAVES + F.wave, NGW = F.G * NWAVES;
    unsigned char* ws = F.ws;
    constexpr int J0 = 32 * 167, J1 = 16 * 32, J2 = 16 * 32, J3 = 32 * 32;
    constexpr int NITEMS = J0 + J1 + J2 + J3;
    for (int it = gw; it < NITEMS; it += NGW) {
        int r = it;
        if (r < J0) { const int kb = r / 167, cb = r % 167, c0 = cb * 64; bf16* dst; int drow;
            if (c0 < 3072) { f32x4 tv[16];
                   const MoeItem m = (c0 < 2048) ? f8_item(I.w_in, D_IN, kb * 64, c0, (unsigned char*)(ws + WS_WQK8), D, c0) : f8_item(I.w_in, D_IN, kb * 64, c0, (unsigned char*)(ws + WS_WV8), D, c0 - 2048);
                   tr8_load(m, tv, F.lane); tr8_finish(tv, m, scr, F.lane); continue; }
            else if (c0 < 6592) { f32x4 tv[16]; const MoeItem m = f8_item(I.w_in, D_IN, kb * 64, c0, (unsigned char*)(ws + WS_WSV8), D, c0 - 3072);
                   tr8_load(m, tv, F.lane); tr8_finish(tv, m, scr, F.lane); continue; }
            else { f32x4 tv[16]; const int cg = c0 - 6592, d0 = cg & 2047; const MoeItem m = f8_item(I.w_in, D_IN, kb * 64, c0, (unsigned char*)(ws + WS_WG8), D, (d0 >> 7) * 256 + (cg >= 2048 ? 128 : 0) + (d0 & 127));
                   tr8_load(m, tv, F.lane); tr8_finish(tv, m, scr, F.lane); continue; }
            (void)dst; (void)drow; continue; } r -= J0;
        if (r < J1) { const int kb = r / 32, cb = r % 32; f32x4 tv[16]; const MoeItem m = f8_item(I.proj_a, D, kb * 64, cb * 64, (unsigned char*)(ws + WS_PAT), AW, cb * 64); tr8_load(m, tv, F.lane); tr8_finish(tv, m, scr, F.lane); continue; } r -= J1;
        if (r < J2) { const int kb = r / 32, cb = r % 32; f32x4 tv[16]; const MoeItem m = f8_item(I.proj_b, D, kb * 64, cb * 64, (unsigned char*)(ws + WS_PBT), RW, cb * 64); tr8_load(m, tv, F.lane); tr8_finish(tv, m, scr, F.lane); continue; } r -= J2;
        { const int kb = r / 32, cb = r % 32; f32x4 tv[16]; const MoeItem m = f8_item(I.w_out, D, kb * 64, cb * 64, (unsigned char*)(ws + WS_WOT), D, cb * 64);
          tr8_load(m, tv, F.lane); tr8_finish(tv, m, scr, F.lane); }
    }
    const int gt = F.vcu * (NWAVES * 64) + F.tid, NGT = F.G * NWAVES * 64;
    for (int i = gt; i < 2048 * 256; i += NGT) { const int n = i >> 8, k = i & 255; float v = 0.f;
        if (n < 1024) { if (k < DLORA) v = I.w_up[(size_t)k * RW + n]; }
        else { if (k >= 128 && k < 128 + ALORA) v = I.a_up[(size_t)(k - 128) * RW + (n - 1024)]; }
        ((bf16*)(ws + WS_WLA))[i] = (bf16)f2bf(v); }
    for (int i = gt; i < 1024 * 256; i += NGT) { const int n = i >> 8, k = i & 255; ((bf16*)(ws + WS_WLG))[i] = (bf16)f2bf(I.g_up[(size_t)k * RW + n]); }
    for (int i = gt; i < 64 * D / 16; i += NGT) ((GAS v4u*)((unsigned char*)(ws + WS_WSV8) + (size_t)SHIFT_W * D))[i] = (v4u){0u, 0u, 0u, 0u};
    for (int i = gt; i < RROWS; i += NGT) ((int*)(ws + WS_ROWSLOT))[i] = -1;
    for (size_t i = gt; i < (size_t)T * D / 8; i += NGT) { const f32x4 a = ((const GAS f32x4*)I.x)[2 * i], b = ((const GAS f32x4*)I.x)[2 * i + 1];
        int w0 = __builtin_amdgcn_cvt_pk_fp8_f32(a.x, a.y, 0, false); w0 = __builtin_amdgcn_cvt_pk_fp8_f32(a.z, a.w, w0, true);
        int w1 = __builtin_amdgcn_cvt_pk_fp8_f32(b.x, b.y, 0, false); w1 = __builtin_amdgcn_cvt_pk_fp8_f32(b.z, b.w, w1, true);
        ((GAS v2u*)(ws + WS_XB8))[i] = (v2u){(unsigned)w0, (unsigned)w1}; }
}

constexpr int P8_HS = 0, P8_PITCH = 2052, P8_PART = 131328, P8_LOG = 147712, P8_HIST = 149760;
template <bool SKIP_MIX>
__device__ __forceinline__ void p8_ln_router(Frame& F0, const In& I) {
    PHASE_FRAME(F0);
    LAS float* hs = (LAS float*)(F.lds + P8_HS); LAS float* part = (LAS float*)(F.lds + P8_PART); LAS float* lg = (LAS float*)(F.lds + P8_LOG); LAS int* hist = (LAS int*)(F.lds + P8_HIST);
    const int lane = F.lane, w = F.wave;
    if (F.tid < 32) hist[F.tid] = 0;
    const int kq = lane >> 4, col = lane & 15;
    float ln_w[32], ln_b[32];
#pragma unroll
    for (int j = 0; j < 8; ++j) { const f32x4 a = *(const GAS f32x4*)(I.ln1_w + 4 * lane + 256 * j), b = *(const GAS f32x4*)(I.ln1_b + 4 * lane + 256 * j);
#pragma unroll
        for (int e = 0; e < 4; ++e) { ln_w[4 * j + e] = a[e]; ln_b[4 * j + e] = b[e]; } }
    __syncthreads();
    const float* zsrc = I.x; const bf16* mixb = (const bf16*)(F.ws + WS_Z);
    for (int g = F.vcu; g < T / 16; g += F.G) {
        const int tok0 = g * 16;
        { f32x4 va[8], vb[8];
          const size_t tokA = (size_t)(tok0 + 2 * w), tokB = tokA + 1;
          const GAS f32x4* zra = (const GAS f32x4*)(zsrc + tokA * D) + lane; const GAS f32x4* zrb = (const GAS f32x4*)(zsrc + tokB * D) + lane;
          const GAS v2u* mra = (const GAS v2u*)(mixb + tokA * D) + lane; const GAS v2u* mrb = (const GAS v2u*)(mixb + tokB * D) + lane;
          v2u ma[8], mb[8];
#pragma unroll
          for (int j = 0; j < 8; ++j) { va[j] = zra[64 * j]; vb[j] = zrb[64 * j]; if (!SKIP_MIX) { ma[j] = mra[64 * j]; mb[j] = mrb[64 * j]; } }
#pragma unroll
          for (int j = 0; j < 8; ++j) { va[j] = va[j] * DN_ALPHA; vb[j] = vb[j] * DN_ALPHA;
              if (!SKIP_MIX) { va[j] += (f32x4){bflo(ma[j].x), bfhi(ma[j].x), bflo(ma[j].y), bfhi(ma[j].y)}; vb[j] += (f32x4){bflo(mb[j].x), bfhi(mb[j].x), bflo(mb[j].y), bfhi(mb[j].y)}; } }
#pragma unroll
          for (int tt = 0; tt < 2; ++tt) {
            const int tl = 2 * w + tt; const size_t tok = (size_t)(tok0 + tl);
            f32x4 v[8]; float s = 0.f;
#pragma unroll
            for (int j = 0; j < 8; ++j) { v[j] = tt ? vb[j] : va[j]; s += (v[j].x + v[j].y) + (v[j].z + v[j].w); }
            const float mean = wave_sum(s) * (1.f / D); float s2 = 0.f;
#pragma unroll
            for (int j = 0; j < 8; ++j) { v[j] = v[j] - mean; s2 += (v[j].x * v[j].x + v[j].y * v[j].y) + (v[j].z * v[j].z + v[j].w * v[j].w); }
            const float rstd = 1.f / sqrtf(wave_sum(s2) * (1.f / D) + LN_EPS);
            GAS v2u* h1 = (GAS v2u*)((bf16*)(F.ws + WS_H1) + tok * D) + lane;
            GAS unsigned* h1b = (GAS unsigned*)((unsigned char*)(F.ws + WS_H1B) + tok * D) + lane;
#pragma unroll
            for (int j = 0; j < 8; ++j) { f32x4 h;
#pragma unroll
                for (int e = 0; e < 4; ++e) h[e] = v[j][e] * rstd * ln_w[4 * j + e] + ln_b[4 * j + e];
                h1[64 * j] = (v2u){pg8::cvt_pk_bf16(h.x, h.y), pg8::cvt_pk_bf16(h.z, h.w)}; { int w8 = __builtin_amdgcn_cvt_pk_fp8_f32(h.x, h.y, 0, false); w8 = __builtin_amdgcn_cvt_pk_fp8_f32(h.z, h.w, w8, true); h1b[64 * j] = (unsigned)w8; }
                *(LAS f32x4*)(hs + tl * P8_PITCH + 4 * lane + 256 * j) = h; }
          } }
        __syncthreads();
        f32x4 c0 = (f32x4){0.f, 0.f, 0.f, 0.f}, c1 = c0;
        const LAS float* ap = hs + col * P8_PITCH + 256 * w + 4 * kq;
        const float* bp = I.w_router + (size_t)(256 * w + 4 * kq) * NE + col;
#pragma unroll 4
        for (int kk = 0; kk < 16; ++kk) {
            const f32x4 a = *(const LAS f32x4*)(ap + 16 * kk);
#pragma unroll
            for (int e = 0; e < 4; ++e) {
                const float b0 = bp[(size_t)(16 * kk + e) * NE], b1 = bp[(size_t)(16 * kk + e) * NE + 16];
                c0 = __builtin_amdgcn_mfma_f32_16x16x4f32(a[e], b0, c0, 0, 0, 0);
                c1 = __builtin_amdgcn_mfma_f32_16x16x4f32(a[e], b1, c1, 0, 0, 0);
            }
        }
#pragma unroll
        for (int i = 0; i < 4; ++i) { part[(w * 16 + 4 * kq + i) * 32 + col] = c0[i]; part[(w * 16 + 4 * kq + i) * 32 + 16 + col] = c1[i]; }
        __syncthreads();
        { const int tl = F.tid >> 5, e = F.tid & 31; float s = I.b_router[e];
#pragma unroll
            for (int ww = 0; ww < 8; ++ww) s += part[(ww * 16 + tl) * 32 + e];
            lg[tl * 32 + e] = s; }
        __syncthreads();
        if (F.tid < 16) {
            const int tl = F.tid; float lv[32];
#pragma unroll
            for (int e = 0; e < 32; ++e) lv[e] = lg[tl * 32 + e];
            int ti[4]; float tv[4];
#pragma unroll
            for (int k = 0; k < 4; ++k) { float best = -3.4e38f; int bi = 0;
#pragma unroll
                for (int e = 0; e < 32; ++e) { const bool tk = lv[e] > best; best = tk ? lv[e] : best; bi = tk ? e : bi; }
                ti[k] = bi; tv[k] = best;
#pragma unroll
                for (int e = 0; e < 32; ++e) lv[e] = (e == bi) ? -3.4e38f : lv[e]; }
            float ex[4], sum = 0.f;
#pragma unroll
            for (int k = 0; k < 4; ++k) { ex[k] = __expf(tv[k] - tv[0]); sum += ex[k]; }
            const float inv = 1.f / sum;
            *(GAS v4u*)((int*)(F.ws + WS_TOPI) + (size_t)(tok0 + tl) * 4) = (v4u){(unsigned)ti[0], (unsigned)ti[1], (unsigned)ti[2], (unsigned)ti[3]};
            *(GAS f32x4*)((float*)(F.ws + WS_GATE) + (size_t)(tok0 + tl) * 4) = (f32x4){ex[0] * inv, ex[1] * inv, ex[2] * inv, ex[3] * inv};
#pragma unroll
            for (int k = 0; k < 4; ++k) __hip_atomic_fetch_add(&hist[ti[k]], 1, __ATOMIC_RELAXED, __HIP_MEMORY_SCOPE_WORKGROUP);
        }
        __syncthreads();
    }
    if (F.tid < 32) { const int c = hist[F.tid]; if (c) __hip_atomic_fetch_add(F.ctl + CW_CNT + F.tid, (unsigned)c, RLX_AGENT); }
}

template <bool SKIP_MOE>
__device__ __forceinline__ void p12_final(Frame& F0, const In& I, float* out) {
    PHASE_FRAME(F0);
    const int lane = F.lane; const int gw = F.vcu * NWAVES + F.wave, NGW = F.G * NWAVES;
    float ln_w[32], ln_b[32];
#pragma unroll
    for (int j = 0; j < 8; ++j) { const f32x4 a = *(const GAS f32x4*)(I.ln2_w + 4 * lane + 256 * j), b = *(const GAS f32x4*)(I.ln2_b + 4 * lane + 256 * j);
#pragma unroll
        for (int e = 0; e < 4; ++e) { ln_w[4 * j + e] = a[e]; ln_b[4 * j + e] = b[e]; } }
    for (int tok = gw; tok < T; tok += NGW) {
        const GAS v2u* hr = (const GAS v2u*)((const bf16*)(F.ws + WS_H1) + (size_t)tok * D) + lane;
        f32x4 v[8]; float s = 0.f;
#pragma unroll
        for (int j = 0; j < 8; ++j) { const v2u hh = hr[64 * j]; v[j] = (f32x4){bflo(hh.x), bfhi(hh.x), bflo(hh.y), bfhi(hh.y)} * DN_ALPHA; }
        if (!SKIP_MOE) {
#pragma unroll
            for (int k = 0; k < 4; ++k) { const GAS unsigned* yr = (const GAS unsigned*)((const unsigned char*)(F.ws + WS_YSLOT) + ((size_t)tok * 4 + k) * D) + lane;
#pragma unroll
                for (int j = 0; j < 8; ++j) { const unsigned y = yr[64 * j]; const f32x2 lo = __builtin_amdgcn_cvt_pk_f32_fp8((int)y, false), hi = __builtin_amdgcn_cvt_pk_f32_fp8((int)y, true);
                    v[j].x += lo.x * YS_INV; v[j].y += lo.y * YS_INV; v[j].z += hi.x * YS_INV; v[j].w += hi.y * YS_INV; } }
        }
#pragma unroll
        for (int j = 0; j < 8; ++j) s += (v[j].x + v[j].y) + (v[j].z + v[j].w);
        const float mean = wave_sum(s) * (1.f / D); float s2 = 0.f;
#pragma unroll
        for (int j = 0; j < 8; ++j) { v[j] = v[j] - mean; s2 += (v[j].x * v[j].x + v[j].y * v[j].y) + (v[j].z * v[j].z + v[j].w * v[j].w); }
        const float rstd = 1.f / sqrtf(wave_sum(s2) * (1.f / D) + LN_EPS);
        GAS f32x4* o = (GAS f32x4*)(out + (size_t)tok * D) + lane;
#pragma unroll
        for (int j = 0; j < 8; ++j) { f32x4 h;
#pragma unroll
            for (int e = 0; e < 4; ++e) h[e] = v[j][e] * rstd * ln_w[4 * j + e] + ln_b[4 * j + e];
            o[64 * j] = h; }
    }
}
__device__ __forceinline__ void moe_tables(Frame& F) {
    LAS int* tab = (LAS int*)(F.lds + TAB_OFF);
    if (F.tid == 0) { int run = 0;
        for (int e = 0; e < NE; ++e) { const int c = (int)__hip_atomic_load(F.ctl + CW_CNT + e, RLX_AGENT); const int p = (c + 255) / 256 * 256; tab[32 + e] = run; run += p; tab[e] = run; }
        tab[64] = run / 256; }
    __syncthreads();
}

__device__ __forceinline__ void p9_scatter(Frame& F0, const In& I) {
    PHASE_FRAME(F0);
    moe_tables(F);
    LAS int* tab = (LAS int*)(F.lds + TAB_OFF);
    LAS int* lh = (LAS int*)(F.lds + 0);
    LAS int* lb = (LAS int*)(F.lds + 128);
    LAS int* dst = (LAS int*)(F.lds + 256);
    const int* topi = (const int*)(F.ws + WS_TOPI); const float* gate = (const float*)(F.ws + WS_GATE);
    for (int ch = F.vcu; ch < T / 128; ch += F.G) {
        if (F.tid < 32) lh[F.tid] = 0;
        __syncthreads();
        const int s = ch * 512 + F.tid; const int e = topi[s]; const float gv = gate[s];
        const int rank = __hip_atomic_fetch_add(&lh[e], 1, __ATOMIC_RELAXED, __HIP_MEMORY_SCOPE_WORKGROUP);
        __syncthreads();
        if (F.tid < 32) { const int c = lh[F.tid]; lb[F.tid] = c ? (int)__hip_atomic_fetch_add(F.ctl + CW_CUR + F.tid, (unsigned)c, RLX_AGENT) : 0; }
        __syncthreads();
        const int d = tab[32 + e] + lb[e] + rank;
        ((int*)(F.ws + WS_ROWSLOT))[d] = s; ((float*)(F.ws + WS_ROWW))[d] = gv; dst[F.tid] = d;
        __syncthreads();
#pragma unroll 1
        for (int i0 = F.wave * 64; i0 < F.wave * 64 + 64; i0 += 8) {
            v4u v[8][2]; int dd[8];
#pragma unroll
            for (int q = 0; q < 8; ++q) { const int i = i0 + q; const int tok = ch * 128 + (i >> 2); dd[q] = dst[i];
                const GAS v4u* src = (const GAS v4u*)((const unsigned char*)(F.ws + WS_H1B) + (size_t)tok * D) + F.lane;
                v[q][0] = src[0]; v[q][1] = src[64]; }
#pragma unroll
            for (int q = 0; q < 8; ++q) { GAS v4u* o = (GAS v4u*)((unsigned char*)(F.ws + WS_XG) + (size_t)dd[q] * D) + F.lane; o[0] = v[q][0]; o[64] = v[q][1]; }
        }
        __syncthreads();
    }
}

__device__ __forceinline__ void p10_moe_up(Frame& F0, const In& I) {
    PHASE_FRAME(F0);
    moe_tables(F);
    LAS int* tab = (LAS int*)(F.lds + TAB_OFF);
    pg8::SchedMoe S; S.t.init(tab[64], 16, F.G, (int)blockIdx.x);
    S.A = (unsigned)(WS_XG); S.B = (unsigned)(WS_WGUT); S.tsA = (unsigned)256 * D; S.tsB = (unsigned)256 * D; S.es = (unsigned)2 * FF * D; S.pad_end = tab;
    pg8::EpiSwiglu E{(unsigned char*)(F.ws + WS_ACT), I.b_gu};
    pg8::gemm_phase<pg8::EpiSwiglu, pg8::SchedMoe, true, true>(F.lds + RING_OFF, F.rsrc, D / 2, D / 2, D / 2, S, E);
}
__device__ __forceinline__ void p11_moe_down(Frame& F0, const In& I) {
    PHASE_FRAME(F0);
    moe_tables(F);
    LAS int* tab = (LAS int*)(F.lds + TAB_OFF);
    pg8::SchedMoe S; S.t.init(tab[64], 8, F.G, (int)blockIdx.x);
    S.A = (unsigned)(WS_ACT); S.B = (unsigned)(WS_WDNT); S.tsA = (unsigned)256 * FF; S.tsB = (unsigned)256 * FF; S.es = (unsigned)D * FF; S.pad_end = tab;
    pg8::EpiDown E{(unsigned char*)(F.ws + WS_YSLOT), I.b_down, (const int*)(F.ws + WS_ROWSLOT), (const float*)(F.ws + WS_ROWW)};
    pg8::gemm_phase<pg8::EpiDown, pg8::SchedMoe, true, true>(F.lds + RING_OFF, F.rsrc, FF / 2, FF / 2, FF / 2, S, E);
}

__device__ __forceinline__ void p1_proj(Frame& F0, const In& I) {
    PHASE_FRAME(F0);
    { pg8::SchedPlain S; S.t.init(T / 256, SEG_PAD / 256, F.G, (int)blockIdx.x);
      S.A = (unsigned)(WS_XB8); S.B = (unsigned)(WS_WSV8); S.tsA = (unsigned)256 * D; S.tsB = (unsigned)256 * D;
      pg8::EpiShift E{(bf16*)(F.ws + WS_RKV), (bf16*)(F.ws + WS_LORAIN), (float*)(F.ws + WS_SIDE0), (float*)(F.ws + WS_SIDEL), I.shift_mu};
      pg8::gemm_phase<pg8::EpiShift, pg8::SchedPlain, true, true>(F.lds + RING_OFF, F.rsrc, D / 2, D / 2, D / 2, S, E); }
    { pg8::SchedPlain S; S.t.init(T / 256, (2 * AW) / 256, F.G, (int)blockIdx.x);
      S.A = (unsigned)(WS_XB8); S.B = (unsigned)(WS_WQK8); S.tsA = (unsigned)256 * D; S.tsB = (unsigned)256 * D;
      pg8::EpiProj E{(bf16*)(F.ws + WS_PROJ), 0, 4};
      pg8::gemm_phase<pg8::EpiProj, pg8::SchedPlain, true, true>(F.lds + RING_OFF, F.rsrc, D / 2, D / 2, D / 2, S, E); }
    { pg8::SchedPlain S; S.t.init(T / 256, (2 * D) / 256, F.G, (int)blockIdx.x);
      S.A = (unsigned)(WS_XB8); S.B = (unsigned)(WS_WG8); S.tsA = (unsigned)256 * D; S.tsB = (unsigned)256 * D;
      pg8::EpiGate E{(bf16*)(F.ws + WS_GATEF)};
      pg8::gemm_phase<pg8::EpiGate, pg8::SchedPlain, true, true>(F.lds + RING_OFF, F.rsrc, D / 2, D / 2, D / 2, S, E); }
    { pg8::SchedPlain S; S.t.init(AW / 256, T / 256, F.G, (int)blockIdx.x);
      S.A = (unsigned)(WS_WV8); S.B = (unsigned)(WS_XB8); S.tsA = (unsigned)256 * D; S.tsB = (unsigned)256 * D;
      pg8::EpiBf16 E{(bf16*)(F.ws + WS_VT), T};
      pg8::gemm_phase<pg8::EpiBf16, pg8::SchedPlain, true, true>(F.lds + RING_OFF, F.rsrc, D / 2, D / 2, D / 2, S, E); }
}

__device__ __forceinline__ float ftanh(float x) { return 2.0f * fsigmoid(2.0f * x) - 1.0f; }
__device__ __forceinline__ void p2_shift_attn(Frame& F0, const In& I) {
    PHASE_FRAME(F0);
    const int lane = F.lane; const int gw = F.vcu * NWAVES + F.wave, NGW = F.G * NWAVES;
    const bf16* PROJ = (const bf16*)(F.ws + WS_PROJ);
    for (int g = gw; g < T / 64; g += NGW) {
        const int tok = g * 64; const bool first = (tok % SEQ) == 0;
        const float* cur = (const float*)(F.ws + WS_SIDE0) + (size_t)g * SEG_PAD; const float* prv = (const float*)(F.ws + WS_SIDEL) + (size_t)(g - 1) * SEG_PAD;
        bf16* rkv = (bf16*)(F.ws + WS_RKV) + (size_t)tok * (3 * RW); bf16* lin = (bf16*)(F.ws + WS_LORAIN) + (size_t)tok * LORA_LD;
#pragma unroll 1
        for (int it = 0; it < 7; ++it) { const int gi = it * 64 + lane; if (gi >= SHIFT_W / 8) break; const int c = gi * 8;
            const f32x4 c0 = *(const GAS f32x4*)(cur + c), c1 = *(const GAS f32x4*)(cur + c + 4);
            f32x4 p0 = (f32x4){0.f, 0.f, 0.f, 0.f}, p1 = p0; if (!first) { p0 = *(const GAS f32x4*)(prv + c); p1 = *(const GAS f32x4*)(prv + c + 4); }
            const f32x4 m0 = *(const GAS f32x4*)(I.shift_mu + c), m1 = *(const GAS f32x4*)(I.shift_mu + c + 4);
            float v[8];
#pragma unroll
            for (int j = 0; j < 4; ++j) { v[j] = c0[j] + (p0[j] - c0[j]) * m0[j]; v[4 + j] = c1[j] + (p1[j] - c1[j]) * m1[j]; }
            bf16* dstp;
            if (c < 3 * RW) dstp = rkv + c;
            else if (c < 3 * RW + DLORA) { dstp = lin + (c - 3 * RW);
#pragma unroll
                for (int j = 0; j < 8; ++j) v[j] = ftanh(v[j]); }
            else if (c < 3 * RW + DLORA + ALORA) dstp = lin + 128 + (c - 3 * RW - DLORA);
            else { dstp = lin + 256 + (c - 3 * RW - DLORA - ALORA);
#pragma unroll
                for (int j = 0; j < 8; ++j) v[j] = fsigmoid(v[j]); }
            *(GAS v4u*)dstp = (v4u){pk2(v[0], v[1]), pk2(v[2], v[3]), pk2(v[4], v[5]), pk2(v[6], v[7])};
        }
    }
#if STAGE == 3
    { const int gt = F.vcu * (NWAVES * 64) + F.tid, NGT = F.G * NWAVES * 64;
      for (size_t i = gt; i < (size_t)T * RW / 8; i += NGT) ((GAS v4u*)(F.ws + WS_YB))[i] = (v4u){0u, 0u, 0u, 0u}; }
#endif
    LAS float* tbl = (LAS float*)(F.lds + 0);
    constexpr int AKV = 64 * 144, A_KOFF = 2048, A_VOFF = A_KOFF + 2 * AKV;
    const bf16* VT = (const bf16*)(F.ws + WS_VT); bf16* YA = (bf16*)(F.ws + WS_YA);
    const int r = lane & 31, hh = lane >> 5;
    const int rp = (r & 16) + 8 * ((r >> 2) & 1) + 4 * ((r >> 3) & 1) + (r & 3);
    const int srow = F.tid >> 3, spc = F.tid & 7;
    for (int task = F.vcu; task < BATCH * AH * (SEQ / 256); task += F.G) {
        const int bh = task >> 5, q256 = task & 31, b = bh >> 4, h = bh & 15, c0 = q256 * 4;
        const int q0 = q256 * 256 + F.wave * 32, cw = c0 + (F.wave >> 1);
        const int kc_lo = (c0 > LEFT) ? c0 - LEFT : 0, kc_hi = c0 + 3;
        __syncthreads();
        if (F.tid < REL_TABLE) tbl[F.tid] = I.rel_bias[h * REL_TABLE + F.tid];
        const size_t tokq = (size_t)b * SEQ + q0 + r;
        bf16x8 qf[4];
#pragma unroll
        for (int s = 0; s < 4; ++s) qf[s] = *(const GAS bf16x8*)(PROJ + tokq * PROJ_LD + PJ_Q + h * 64 + 16 * s + 8 * hh);
        f32x16 o0, o1;
#pragma unroll
        for (int i = 0; i < 16; ++i) { o0[i] = 0.f; o1[i] = 0.f; }
        float m_run = -1e30f, l_run = 0.f;
        v4u kreg, vreg;
#define AT_STAGE_LOAD(kc_) do { kreg = *(const GAS v4u*)(PROJ + ((size_t)b * SEQ + (size_t)(kc_) * 64 + srow) * PROJ_LD + PJ_K + h * 64 + spc * 8); \
                                vreg = *(const GAS v4u*)(VT + (size_t)(h * 64 + srow) * T + (size_t)b * SEQ + (size_t)(kc_) * 64 + spc * 8); } while (0)
#define AT_STAGE_WRITE(buf_) do { *(LAS v4u*)(F.lds + A_KOFF + (buf_) * AKV + srow * 144 + spc * 16) = kreg; *(LAS v4u*)(F.lds + A_VOFF + (buf_) * AKV + srow * 144 + spc * 16) = vreg; } while (0)
        AT_STAGE_LOAD(kc_lo); AT_STAGE_WRITE(0);
        __syncthreads();
#pragma unroll 1
        for (int kc = kc_lo; kc <= kc_hi; ++kc) {
            const int buf = (kc - kc_lo) & 1;
            if (kc < kc_hi) AT_STAGE_LOAD(kc + 1);
            if (kc >= cw - LEFT && kc <= cw) {
                const LAS unsigned char* Kb = F.lds + A_KOFF + buf * AKV; const LAS unsigned char* Vb = F.lds + A_VOFF + buf * AKV;
#pragma unroll
                for (int tt = 0; tt < 2; ++tt) {
                    const int kpos0 = kc * 64 + 32 * tt;
                    bf16x8 kf[4], va[2], vb[2];
#pragma unroll
                    for (int s = 0; s < 4; ++s) kf[s] = *(const LAS bf16x8*)(Kb + (32 * tt + rp) * 144 + 32 * s + 16 * hh);
#pragma unroll
                    for (int s2 = 0; s2 < 2; ++s2) { va[s2] = *(const LAS bf16x8*)(Vb + r * 144 + 64 * tt + 32 * s2 + 16 * hh); vb[s2] = *(const LAS bf16x8*)(Vb + (32 + r) * 144 + 64 * tt + 32 * s2 + 16 * hh); }
                    f32x16 st;
#pragma unroll
                    for (int i = 0; i < 16; ++i) st[i] = 0.f;
#pragma unroll
                    for (int s = 0; s < 4; ++s) st = __builtin_amdgcn_mfma_f32_32x32x16_bf16(kf[s], qf[s], st, 0, 0, 0);
                    const int dbase = (q0 + r) - (kpos0 + 8 * hh);
                    float mx = -1e30f;
                    if (q0 - (kpos0 + 31) >= MAX_PAST) {
                        const float bc = tbl[MAX_PAST + 63];
#pragma unroll
                        for (int i = 0; i < 16; ++i) { st[i] += bc; mx = fmaxf(mx, st[i]); }
                    } else {
#pragma unroll
                        for (int i = 0; i < 16; ++i) { int d = dbase - (16 * (i >> 3) + 4 * ((i >> 2) & 1) + (i & 3)); d = d < MAX_PAST ? d : MAX_PAST; st[i] += tbl[d + 63]; mx = fmaxf(mx, st[i]); }
                    }
                    mx = fmaxf(mx, __shfl_xor(mx, 32));
                    const float m_new = fmaxf(m_run, mx), alpha = __expf(m_run - m_new);
                    float ls = 0.f;
#pragma unroll
                    for (int i = 0; i < 16; ++i) { st[i] = __expf(st[i] - m_new); ls += st[i]; }
                    l_run = l_run * alpha + ls;
                    if (__builtin_amdgcn_ballot_w64(m_new != m_run)) {
#pragma unroll
                        for (int i = 0; i < 16; ++i) { o0[i] *= alpha; o1[i] *= alpha; } }
                    m_run = m_new;
#pragma unroll
                    for (int s2 = 0; s2 < 2; ++s2) {
                        v4u pw; pw.x = pg8::cvt_pk_bf16(st[8 * s2 + 0], st[8 * s2 + 1]); pw.y = pg8::cvt_pk_bf16(st[8 * s2 + 2], st[8 * s2 + 3]); pw.z = pg8::cvt_pk_bf16(st[8 * s2 + 4], st[8 * s2 + 5]); pw.w = pg8::cvt_pk_bf16(st[8 * s2 + 6], st[8 * s2 + 7]);
                        const bf16x8 pf = __builtin_bit_cast(bf16x8, pw);
                        o0 = __builtin_amdgcn_mfma_f32_32x32x16_bf16(va[s2], pf, o0, 0, 0, 0);
                        o1 = __builtin_amdgcn_mfma_f32_32x32x16_bf16(vb[s2], pf, o1, 0, 0, 0);
                    }
                }
            }
            if (kc < kc_hi) AT_STAGE_WRITE(buf ^ 1);
            __syncthreads();
        }
#undef AT_STAGE_LOAD
#undef AT_STAGE_WRITE
        const float inv = 1.0f / (l_run + __shfl_xor(l_run, 32));
        unsigned char* yo = (unsigned char*)YA + tokq * AW + h * 64 + 4 * hh;
        const float inv16 = inv * ACT8_SCALE;
#pragma unroll
        for (int g4 = 0; g4 < 4; ++g4) {
            int w0 = __builtin_amdgcn_cvt_pk_fp8_f32(o0[4 * g4] * inv16, o0[4 * g4 + 1] * inv16, 0, false); w0 = __builtin_amdgcn_cvt_pk_fp8_f32(o0[4 * g4 + 2] * inv16, o0[4 * g4 + 3] * inv16, w0, true);
            int w1 = __builtin_amdgcn_cvt_pk_fp8_f32(o1[4 * g4] * inv16, o1[4 * g4 + 1] * inv16, 0, false); w1 = __builtin_amdgcn_cvt_pk_fp8_f32(o1[4 * g4 + 2] * inv16, o1[4 * g4 + 3] * inv16, w1, true);
            *(GAS unsigned*)(yo + 8 * g4) = (unsigned)w0; *(GAS unsigned*)(yo + 32 + 8 * g4) = (unsigned)w1;
        }
    }
}

__device__ __forceinline__ void p6_merged(Frame& F0, const In& I) {
    PHASE_FRAME(F0);
    pg8::SchedTwo S; S.t.init(T / 256, D / 256, F.G, (int)blockIdx.x);
    S.A0 = (unsigned)(WS_YA); S.A1 = (unsigned)(WS_YB); S.B0 = (unsigned)(WS_PAT); S.B1 = (unsigned)(WS_PBT);
    S.tsA = (unsigned)256 * AW; S.tsB = (unsigned)256 * AW;
    pg8::EpiMerged E{(const bf16*)(F.ws + WS_GATEF), (bf16*)(F.ws + WS_MERGED)};
    pg8::gemm_phase<pg8::EpiMerged, pg8::SchedTwo, true, true, 0x00007b79>(F.lds + RING_OFF, F.rsrc, AW / 2, AW / 2, AW / 2, S, E);
}
__device__ __forceinline__ void p7_mix(Frame& F0, const In& I) {
    PHASE_FRAME(F0);
    pg8::SchedPlain S; S.t.init(T / 256, D / 256, F.G, (int)blockIdx.x);
    S.A = (unsigned)(WS_MERGED); S.B = (unsigned)(WS_WOT); S.tsA = (unsigned)256 * D; S.tsB = (unsigned)256 * D;
    pg8::EpiBf16 E{(bf16*)(F.ws + WS_Z), D};
    pg8::gemm_phase<pg8::EpiBf16, pg8::SchedPlain, true, true, 0x00007b79>(F.lds + RING_OFF, F.rsrc, D / 2, D / 2, D / 2, S, E);
}

__device__ __forceinline__ void p3_lora(Frame& F0, const In& I) {
    PHASE_FRAME(F0);
    { pg8::SchedPlain S; S.t.init(T / 256, 4, F.G, (int)blockIdx.x);
      S.A = (unsigned)(WS_LORAIN); S.B = (unsigned)(WS_WLA); S.tsA = (unsigned)256 * LORA_LD * 2; S.tsB = (unsigned)256 * 256 * 2;
      pg8::EpiLoraA<true> E{(float*)(F.ws + WS_DECAY), I.w0};
      pg8::gemm_phase<pg8::EpiLoraA<true>, pg8::SchedPlain, true>(F.lds + RING_OFF, F.rsrc, LORA_LD, 256, 256, S, E); }
    { pg8::SchedPlain S; S.t.init(T / 256, 4, F.G, (int)blockIdx.x);
      S.A = (unsigned)(WS_LORAIN); S.B = (unsigned)(WS_WLA + (size_t)1024 * 256 * 2); S.tsA = (unsigned)256 * LORA_LD * 2; S.tsB = (unsigned)256 * 256 * 2;
      pg8::EpiIclr E{(bf16*)(F.ws + WS_ICLR), I.a0};
      pg8::gemm_phase<pg8::EpiIclr, pg8::SchedPlain, true>(F.lds + RING_OFF, F.rsrc, LORA_LD, 256, 256, S, E); }
    { pg8::SchedPlain S; S.t.init(T / 256, 4, F.G, (int)blockIdx.x);
      S.A = (unsigned)(WS_LORAIN + 512); S.B = (unsigned)(WS_WLG); S.tsA = (unsigned)256 * LORA_LD * 2; S.tsB = (unsigned)256 * 256 * 2;
      pg8::EpiBf16 E{(bf16*)(F.ws + WS_G), RW};
      pg8::gemm_phase<pg8::EpiBf16, pg8::SchedPlain, true>(F.lds + RING_OFF, F.rsrc, LORA_LD, 256, 256, S, E); }
}

constexpr int CP = 144;
constexpr int CMAT = 64 * CP;
constexpr int C_RT = 0 * CMAT, C_ATT = 1 * CMAT, C_AAK = 2 * CMAT, C_ARKT = 3 * CMAT, C_WA = 4 * CMAT, C_WB = 6 * CMAT,
              C_MA = 8 * CMAT, C_MTA = 9 * CMAT, C_MB = 10 * CMAT, C_MTB = 11 * CMAT, C_SEG = 12 * CMAT, C_GAM = C_SEG + 8 * 64 * 4, C_TSCR = C_GAM + 256;
constexpr int C_AT = C_WB, C_BT = C_WB + CMAT, C_KT = C_MB, C_QYT = C_MA, C_QST = C_MTA, C_KHT = C_MTB, C_VT = C_WB;
static_assert(C_TSCR % 16 == 0 && C_TSCR + 8 * 5120 <= TAB_OFF, "P4a LDS map");
constexpr int CHK_UNIT_BYTES = 4 * 64 * 64 * 2;
#define CBAR() do { asm volatile("s_waitcnt lgkmcnt(0)" ::: "memory"); __builtin_amdgcn_s_barrier(); asm volatile("" ::: "memory"); } while (0)
template <int NT, class Epi>
__device__ __forceinline__ void cmm(const LAS unsigned char* X, const LAS unsigned char* Y, int mt0, int nt, int lane, const Epi& E) {
    const int lr = lane & 15, kq = lane >> 4;
    const bf16x8 b0 = *(const LAS bf16x8*)(Y + (nt * 16 + lr) * CP + kq * 16), b1 = *(const LAS bf16x8*)(Y + (nt * 16 + lr) * CP + kq * 16 + 64);
#pragma unroll
    for (int i = 0; i < NT; ++i) { const int mt = mt0 + i;
        const bf16x8 a0 = *(const LAS bf16x8*)(X + (mt * 16 + lr) * CP + kq * 16), a1 = *(const LAS bf16x8*)(X + (mt * 16 + lr) * CP + kq * 16 + 64);
        f32x4 acc = (f32x4){0.f, 0.f, 0.f, 0.f};
        acc = __builtin_amdgcn_mfma_f32_16x16x32_bf16(a0, b0, acc, 0, 0, 0);
        acc = __builtin_amdgcn_mfma_f32_16x16x32_bf16(a1, b1, acc, 0, 0, 0);
        E(mt, nt, acc); }
}
__device__ __forceinline__ v2u pack4(const f32x4& v) { return (v2u){pg8::cvt_pk_bf16(v[0], v[1]), pg8::cvt_pk_bf16(v[2], v[3])}; }
__device__ __forceinline__ f32x4 unpack4(const v2u w) { return (f32x4){bflo(w.x), bfhi(w.x), bflo(w.y), bfhi(w.y)}; }
__device__ __forceinline__ void p4a_chunk(Frame& F0, const In& I) {
    PHASE_FRAME(F0);
    LAS unsigned char* L = F.lds;
    const int lane = F.lane, w = F.wave, lr = lane & 15, kq = lane >> 4;
    const bf16* RKV = (const bf16*)(F.ws + WS_RKV); const float* LW = (const float*)(F.ws + WS_DECAY); const bf16* ICL = (const bf16*)(F.ws + WS_ICLR);
    unsigned char* CHK = F.ws + WS_CHK;
    int uit = 0;
    for (int unit = F.vcu; unit < BATCH * RH * (SEQ / 64); unit += F.G, ++uit) {
        const int bh = unit >> 7, ck = unit & 127, b = bh >> 4, h = bh & 15;
        const size_t tok0 = (size_t)b * SEQ + (size_t)ck * 64 + 8 * w;
        const int hc = h * 64 + lane;
        float lwv[8], ic[8], rr[8], kk[8], vv[8];
#pragma unroll
        for (int i = 0; i < 8; ++i) { const size_t tok = tok0 + i; lwv[i] = LW[tok * RW + hc]; ic[i] = bf2f(ICL[tok * RW + hc]);
            rr[i] = bf2f(RKV[tok * (3 * RW) + hc]); kk[i] = bf2f(RKV[tok * (3 * RW) + RW + hc]); vv[i] = bf2f(RKV[tok * (3 * RW) + 2 * RW + hc]); }
        const float kkp = I.k_k[hc], kap = I.k_a[hc];
        float cs[8]; { float run = 0.f;
#pragma unroll
            for (int i = 0; i < 8; ++i) { run += lwv[i]; cs[i] = run; } }
        __syncthreads();
        ((LAS float*)(L + C_SEG))[w * 64 + lane] = cs[7];
        CBAR();
        float pre = 0.f, tot = 0.f;
#pragma unroll
        for (int j = 0; j < 8; ++j) { const float sg = ((const LAS float*)(L + C_SEG))[j * 64 + lane]; tot += sg; pre += (j < w) ? sg : 0.f; }
        if (w == 0) ((LAS float*)(L + C_GAM))[lane] = __expf(tot);
        unsigned att[4], bht[4], kht[4], vtt[4];
        float at_[8], bh_[8], kh_[8]; const float gtot = __expf(tot); float ep_prev = 1.f;
#pragma unroll
        for (int i = 0; i < 8; ++i) { const int t = 8 * w + i; const float cum = pre + cs[i], cump = cum - lwv[i];
            const float kkv = kk[i] * kkp; const float n2 = wave_sum(kkv * kkv); const float kkn = kkv * __builtin_amdgcn_rsqf(fmaxf(n2, 1e-24f));
            const float a = -kkn, bb = kkn * ic[i], kp = kk[i] * (1.0f + (ic[i] - 1.0f) * kap);
            const float ep = __expf(cum), em = __builtin_amdgcn_rcpf(ep), epp = (i == 0) ? __expf(cump) : ep_prev, eL = gtot * em; ep_prev = ep;
            const float Rv = rr[i] * ep, Av = a * epp, Bv = bb * em, Kv = kp * em;
            at_[i] = Av; bh_[i] = bb * eL; kh_[i] = kp * eL;
            *(LAS unsigned short*)(L + C_RT + t * CP + lane * 2) = (unsigned short)f2bf(Rv);
            *(LAS unsigned short*)(L + C_AT + t * CP + lane * 2) = (unsigned short)f2bf(Av);
            *(LAS unsigned short*)(L + C_BT + t * CP + lane * 2) = (unsigned short)f2bf(Bv);
            *(LAS unsigned short*)(L + C_KT + t * CP + lane * 2) = (unsigned short)f2bf(Kv); }
#pragma unroll
        for (int q = 0; q < 4; ++q) { att[q] = pk2(at_[2 * q], at_[2 * q + 1]); bht[q] = pk2(bh_[2 * q], bh_[2 * q + 1]); kht[q] = pk2(kh_[2 * q], kh_[2 * q + 1]); vtt[q] = pk2(vv[2 * q], vv[2 * q + 1]); }
        *(LAS v4u*)(L + C_ATT + lane * CP + 16 * w) = (v4u){att[0], att[1], att[2], att[3]};
        *(LAS v4u*)(L + C_WA + (64 + lane) * CP + 16 * w) = (v4u){bht[0], bht[1], bht[2], bht[3]};
        CBAR();
        const int cit = (uit * F.G + F.vcu) * 16 + w * 2; const bool hx = cit < MOE_NITEMS, hy = cit + 1 < MOE_NITEMS;
        f32x4 tX[16]; MoeItem mX = moe_item(hx ? cit : 0, I.w_gu, I.w_down, F.ws);
        LAS float* tscr = (LAS float*)(L + C_TSCR + w * 5120);
        struct Fr { bf16x8 a, b; };
        auto LD = [&](int base, int tile) -> Fr { const LAS unsigned char* q = L + base + (tile * 16 + lr) * CP + kq * 16; Fr f; f.a = *(const LAS bf16x8*)q; f.b = *(const LAS bf16x8*)(q + 64); return f; };
        auto MM = [&](const Fr& x, const Fr& y) -> f32x4 { f32x4 acc = (f32x4){0.f, 0.f, 0.f, 0.f};
            acc = __builtin_amdgcn_mfma_f32_16x16x32_bf16(x.a, y.a, acc, 0, 0, 0); acc = __builtin_amdgcn_mfma_f32_16x16x32_bf16(x.b, y.b, acc, 0, 0, 0); return acc; };
        const int nt = w & 3, mt0 = 2 * (w >> 2), n = nt * 16 + lr;
        { const Fr yAT = LD(C_AT, nt), yKT = LD(C_KT, nt), yRT = LD(C_RT, nt);
          Fr xBT[2], xAT[2], xKT[2];
#pragma unroll
          for (int i = 0; i < 2; ++i) { xBT[i] = LD(C_BT, mt0 + i); xAT[i] = LD(C_AT, mt0 + i); xKT[i] = LD(C_KT, mt0 + i); }
          f32x4 a1[2], a2[2], a3[2], a4[2];
#pragma unroll
          for (int i = 0; i < 2; ++i) { a1[i] = MM(xBT[i], yAT); a2[i] = MM(xAT[i], yKT); a3[i] = MM(xBT[i], yRT); a4[i] = MM(xKT[i], yRT); }
#pragma unroll
          for (int i = 0; i < 2; ++i) { const int m0 = (mt0 + i) * 16 + 4 * kq;
              f32x4 v = a1[i];
#pragma unroll
              for (int e = 0; e < 4; ++e) { v[e] = (m0 + e < n) ? v[e] : 0.f; *(LAS unsigned short*)(L + C_MA + (m0 + e) * CP + n * 2) = (unsigned short)f2bf(v[e]); }
              *(LAS v2u*)(L + C_MTA + n * CP + m0 * 2) = pack4(v);
              v = a2[i];
#pragma unroll
              for (int e = 0; e < 4; ++e) v[e] = (n < m0 + e) ? v[e] : 0.f;
              *(LAS v2u*)(L + C_AAK + n * CP + m0 * 2) = pack4(v);
              v = a3[i];
#pragma unroll
              for (int e = 0; e < 4; ++e) v[e] = (m0 + e <= n) ? v[e] : 0.f;
              *(LAS v2u*)(L + C_WA + n * CP + m0 * 2) = pack4(v);
              v = a4[i];
#pragma unroll
              for (int e = 0; e < 4; ++e) v[e] = (m0 + e <= n) ? v[e] : 0.f;
              *(LAS v2u*)(L + C_ARKT + n * CP + m0 * 2) = pack4(v); } }
        CBAR();
        if (hx) tr8_load(mX, tX, lane);
#pragma unroll
        for (int lvl = 0; lvl < 6; ++lvl) {
            const int Wsrc = (lvl & 1) ? C_WB : C_WA, Wdst = (lvl & 1) ? C_WA : C_WB, Ms = (lvl & 1) ? C_MB : C_MA, Mts = (lvl & 1) ? C_MTB : C_MTA, Md = (lvl & 1) ? C_MA : C_MB, Mtd = (lvl & 1) ? C_MTA : C_MTB;
            const Fr yW = LD(Wsrc, w); Fr yMt; if (lvl < 5) yMt = LD(Mts, nt);
            Fr xM[4], xS[2];
#pragma unroll
            for (int i = 0; i < 4; ++i) xM[i] = LD(Ms, i);
            if (lvl < 5) { xS[0] = LD(Ms, mt0); xS[1] = LD(Ms, mt0 + 1); }
            const int nj = w * 16 + lr;
            f32x4 old[4], aw[4], as[2];
#pragma unroll
            for (int i = 0; i < 4; ++i) old[i] = unpack4(*(const LAS v2u*)(L + Wsrc + nj * CP + (i * 16 + 4 * kq) * 2));
#pragma unroll
            for (int i = 0; i < 4; ++i) aw[i] = MM(xM[i], yW);
            if (lvl < 5) {
#pragma unroll
                for (int i = 0; i < 2; ++i) as[i] = MM(xS[i], yMt); }
#pragma unroll
            for (int i = 0; i < 4; ++i) *(LAS v2u*)(L + Wdst + nj * CP + (i * 16 + 4 * kq) * 2) = pack4(old[i] + aw[i]);
            if (lvl < 5) {
#pragma unroll
                for (int i = 0; i < 2; ++i) { const int m0 = (mt0 + i) * 16 + 4 * kq;
#pragma unroll
                    for (int e = 0; e < 4; ++e) *(LAS unsigned short*)(L + Md + (m0 + e) * CP + n * 2) = (unsigned short)f2bf(as[i][e]);
                    if (lvl < 4) *(LAS v2u*)(L + Mtd + n * CP + m0 * 2) = pack4(as[i]); } }
            if (lvl == 4) *(LAS v4u*)(L + C_KHT + lane * CP + 16 * w) = (v4u){kht[0], kht[1], kht[2], kht[3]};
            if (lvl == 2) { if (hx) tr8_finish(tX, mX, tscr, lane);
                            if (hy) { mX = moe_item(cit + 1, I.w_gu, I.w_down, F.ws); tr8_load(mX, tX, lane); } }
            CBAR();
        }
        *(LAS v4u*)(L + C_VT + lane * CP + 16 * w) = (v4u){vtt[0], vtt[1], vtt[2], vtt[3]};
        unsigned char* og = CHK + (size_t)unit * CHK_UNIT_BYTES;
        { const Fr yW1 = LD(C_WA, nt), yW2 = LD(C_WA + 64 * CP, nt);
          Fr xA[2], xK[2];
#pragma unroll
          for (int i = 0; i < 2; ++i) { xA[i] = LD(C_ATT, mt0 + i); xK[i] = LD(C_AAK, mt0 + i); }
          f32x4 rv[2], av[2], kv[2];
          const float gm = ((const LAS float*)(L + C_GAM))[n];
#pragma unroll
          for (int i = 0; i < 2; ++i) { const int m0 = (mt0 + i) * 16 + 4 * kq;
              rv[i] = unpack4(*(const LAS v2u*)(L + C_RT + n * CP + m0 * 2)); av[i] = unpack4(*(const LAS v2u*)(L + C_ARKT + n * CP + m0 * 2)); kv[i] = unpack4(*(const LAS v2u*)(L + C_KHT + n * CP + m0 * 2)); }
          f32x4 p7[2], p8[2], p9[2], p10[2];
#pragma unroll
          for (int i = 0; i < 2; ++i) { p7[i] = MM(xA[i], yW1); p8[i] = MM(xK[i], yW1); p9[i] = MM(xA[i], yW2); p10[i] = MM(xK[i], yW2); }
#pragma unroll
          for (int i = 0; i < 2; ++i) { const int m0 = (mt0 + i) * 16 + 4 * kq;
              *(GAS v2u*)(og + 0 * 8192 + n * 128 + m0 * 2) = pack4(p7[i] + rv[i]);
              *(LAS v2u*)(L + C_QYT + n * CP + m0 * 2) = pack4(p8[i] + av[i]);
              f32x4 v = p9[i];
#pragma unroll
              for (int e = 0; e < 4; ++e) v[e] += (m0 + e == n) ? gm : 0.f;
              *(GAS v2u*)(og + 1 * 8192 + n * 128 + m0 * 2) = pack4(v);
              *(LAS v2u*)(L + C_QST + n * CP + m0 * 2) = pack4(p10[i] + kv[i]); } }
        CBAR();
        { const Fr yQy = LD(C_QYT, nt), yQs = LD(C_QST, nt);
          Fr xV[2];
#pragma unroll
          for (int i = 0; i < 2; ++i) xV[i] = LD(C_VT, mt0 + i);
          f32x4 p11[2], p12[2];
#pragma unroll
          for (int i = 0; i < 2; ++i) { p11[i] = MM(xV[i], yQy); p12[i] = MM(xV[i], yQs); }
#pragma unroll
          for (int i = 0; i < 2; ++i) { const int m0 = (mt0 + i) * 16 + 4 * kq;
              *(GAS v2u*)(og + 2 * 8192 + n * 128 + m0 * 2) = pack4(p11[i]);
              *(GAS v2u*)(og + 3 * 8192 + n * 128 + m0 * 2) = pack4(p12[i]); } }
        if (hy) tr8_finish(tX, mX, tscr, lane);
    }
}

constexpr int C2_SLOT = 20480;
__device__ __forceinline__ void p4b_scan(Frame& F0, const In& I) {
    PHASE_FRAME(F0);
    const int lane = F.lane, lr = lane & 15, kq = lane >> 4;
    const unsigned char* CHK = F.ws + WS_CHK; bf16* YS = (bf16*)(F.ws + WS_YSCAN);
    for (int unit = F.vcu; unit < BATCH * RH * 4; unit += F.G) {
        const int bh = unit >> 2, rq = unit & 3, b = bh >> 4, h = bh & 15;
        if (F.wave == 0) {
            LAS unsigned char* Sl = F.lds + 3 * C2_SLOT;
            f32x4 S[4]; bf16x8 sf[2];
#pragma unroll
            for (int nt = 0; nt < 4; ++nt) S[nt] = (f32x4){0.f, 0.f, 0.f, 0.f};
#pragma unroll
            for (int ks = 0; ks < 2; ++ks)
#pragma unroll
                for (int j = 0; j < 8; ++j) sf[ks][j] = 0;
#define C2_DMA(ck_) do { const int ckc_ = (ck_) < SEQ / 64 ? (ck_) : SEQ / 64 - 1; const unsigned char* ug = CHK + ((size_t)bh * 128 + ckc_) * CHK_UNIT_BYTES; \
                LAS unsigned char* sl_ = F.lds + ((ck_) % 3) * C2_SLOT; \
                _Pragma("unroll") for (int j = 0; j < 16; ++j) __builtin_amdgcn_global_load_lds((const unsigned*)(ug + j * 1024 + lane * 16), (LAS unsigned*)(sl_ + j * 1024), 16, 0, 0); \
                _Pragma("unroll") for (int j = 0; j < 2; ++j) { \
                    __builtin_amdgcn_global_load_lds((const unsigned*)(ug + 2 * 8192 + (j * 32 + (lane >> 1)) * 128 + rq * 32 + (lane & 1) * 16), (LAS unsigned*)(sl_ + 16384 + j * 1024), 16, 0, 0); \
                    __builtin_amdgcn_global_load_lds((const unsigned*)(ug + 3 * 8192 + (j * 32 + (lane >> 1)) * 128 + rq * 32 + (lane & 1) * 16), (LAS unsigned*)(sl_ + 18432 + j * 1024), 16, 0, 0); } } while (0)
            C2_DMA(0); C2_DMA(1);
#pragma unroll 1
            for (int ck = 0; ck < SEQ / 64; ++ck) {
                asm volatile("s_waitcnt lgkmcnt(0)" ::: "memory");
                C2_DMA(ck + 2);
                asm volatile("s_waitcnt vmcnt(40)" ::: "memory");
                const LAS unsigned char* sl_ = F.lds + (ck % 3) * C2_SLOT;
#pragma unroll
                for (int nt = 0; nt < 4; ++nt) {
                    const bf16x8 py0 = *(const LAS bf16x8*)(sl_ + (16 * nt + lr) * 128 + kq * 16), py1 = *(const LAS bf16x8*)(sl_ + (16 * nt + lr) * 128 + kq * 16 + 64);
                    const bf16x8 ps0 = *(const LAS bf16x8*)(sl_ + 8192 + (16 * nt + lr) * 128 + kq * 16), ps1 = *(const LAS bf16x8*)(sl_ + 8192 + (16 * nt + lr) * 128 + kq * 16 + 64);
                    f32x4 y = unpack4(*(const LAS v2u*)(sl_ + 16384 + (16 * nt + lr) * 32 + kq * 8));
                    f32x4 s2 = unpack4(*(const LAS v2u*)(sl_ + 18432 + (16 * nt + lr) * 32 + kq * 8));
                    y = __builtin_amdgcn_mfma_f32_16x16x32_bf16(sf[0], py0, y, 0, 0, 0); y = __builtin_amdgcn_mfma_f32_16x16x32_bf16(sf[1], py1, y, 0, 0, 0);
                    *(GAS v2u*)(YS + ((size_t)b * SEQ + (size_t)ck * 64 + 16 * nt + lr) * RW + h * 64 + rq * 16 + 4 * kq) = pack4(y);
                    s2 = __builtin_amdgcn_mfma_f32_16x16x32_bf16(sf[0], ps0, s2, 0, 0, 0); s2 = __builtin_amdgcn_mfma_f32_16x16x32_bf16(sf[1], ps1, s2, 0, 0, 0);
                    S[nt] = s2; }
#pragma unroll
                for (int nt = 0; nt < 4; ++nt)
#pragma unroll
                    for (int i = 0; i < 4; ++i) *(LAS unsigned short*)(Sl + (4 * kq + i) * CP + (16 * nt + lr) * 2) = (unsigned short)f2bf(S[nt][i]);
                LDS_WAIT(); asm volatile("" ::: "memory");
                sf[0] = *(const LAS bf16x8*)(Sl + lr * CP + kq * 16); sf[1] = *(const LAS bf16x8*)(Sl + lr * CP + kq * 16 + 64);
                LDS_WAIT(); asm volatile("" ::: "memory");
            }
            asm volatile("s_waitcnt vmcnt(0)" ::: "memory");
#undef C2_DMA
        }
    }
}
static_assert(3 * C2_SLOT + 4096 + 5 * 16640 <= TAB_OFF, "P4b LDS map");

__device__ __forceinline__ void p5_post(Frame& F0, const In& I) {
    PHASE_FRAME(F0);
    const int lane = F.lane; const int gw = F.vcu * NWAVES + F.wave, NGW = F.G * NWAVES;
    const bf16* RKV = (const bf16*)(F.ws + WS_RKV); const bf16* ICL = (const bf16*)(F.ws + WS_ICLR); const bf16* YS = (const bf16*)(F.ws + WS_YSCAN);
    const bf16* G = (const bf16*)(F.ws + WS_G); bf16* YB = (bf16*)(F.ws + WS_YB);
    const int c0 = lane * 16;
    for (int tok = gw; tok < T; tok += NGW) {
        float y[16], rr[16], kk[16], vv[16], ic[16], gg[16];
#pragma unroll
        for (int q = 0; q < 2; ++q) { const v4u a = *(const GAS v4u*)(YS + (size_t)tok * RW + c0 + 8 * q), c = *(const GAS v4u*)(ICL + (size_t)tok * RW + c0 + 8 * q);
            const unsigned aw[4] = {a.x, a.y, a.z, a.w}, cw[4] = {c.x, c.y, c.z, c.w};
#pragma unroll
            for (int e = 0; e < 4; ++e) { y[8 * q + 2 * e] = bflo(aw[e]); y[8 * q + 2 * e + 1] = bfhi(aw[e]); ic[8 * q + 2 * e] = bflo(cw[e]); ic[8 * q + 2 * e + 1] = bfhi(cw[e]); } }
#pragma unroll
        for (int q = 0; q < 2; ++q) {
            const v4u a = *(const GAS v4u*)(RKV + (size_t)tok * (3 * RW) + c0 + 8 * q), bb = *(const GAS v4u*)(RKV + (size_t)tok * (3 * RW) + RW + c0 + 8 * q),
                      c = *(const GAS v4u*)(RKV + (size_t)tok * (3 * RW) + 2 * RW + c0 + 8 * q), d = *(const GAS v4u*)(G + (size_t)tok * RW + c0 + 8 * q);
            const unsigned aw[4] = {a.x, a.y, a.z, a.w}, bw[4] = {bb.x, bb.y, bb.z, bb.w}, cw[4] = {c.x, c.y, c.z, c.w}, dw[4] = {d.x, d.y, d.z, d.w};
#pragma unroll
            for (int e = 0; e < 4; ++e) { rr[8 * q + 2 * e] = bflo(aw[e]); rr[8 * q + 2 * e + 1] = bfhi(aw[e]); kk[8 * q + 2 * e] = bflo(bw[e]); kk[8 * q + 2 * e + 1] = bfhi(bw[e]);
                vv[8 * q + 2 * e] = bflo(cw[e]); vv[8 * q + 2 * e + 1] = bfhi(cw[e]); gg[8 * q + 2 * e] = bflo(dw[e]); gg[8 * q + 2 * e + 1] = bfhi(dw[e]); } }
        float s = 0.f, bs = 0.f;
#pragma unroll
        for (int e = 0; e < 16; ++e) { s += y[e]; const float kp = kk[e] * (1.0f + (ic[e] - 1.0f) * I.k_a[c0 + e]); bs += rr[e] * kp * I.r_k[c0 + e]; }
        s = quadsum(s); bs = quadsum(bs);
        const float mean = s * (1.f / 64.f); float s2 = 0.f;
#pragma unroll
        for (int e = 0; e < 16; ++e) { y[e] -= mean; s2 += y[e] * y[e]; }
        s2 = quadsum(s2);
        const float rstd = 1.f / sqrtf(s2 * (1.f / 64.f) + GN_EPS);
        float o[16];
#pragma unroll
        for (int e = 0; e < 16; ++e) o[e] = (y[e] * rstd * I.lnx_w[c0 + e] + I.lnx_b[c0 + e] + bs * vv[e]) * gg[e];
        { unsigned w8[4];
#pragma unroll
          for (int q = 0; q < 4; ++q) { int t8 = __builtin_amdgcn_cvt_pk_fp8_f32(o[4 * q] * ACT8_SCALE, o[4 * q + 1] * ACT8_SCALE, 0, false); t8 = __builtin_amdgcn_cvt_pk_fp8_f32(o[4 * q + 2] * ACT8_SCALE, o[4 * q + 3] * ACT8_SCALE, t8, true); w8[q] = (unsigned)t8; }
          *(GAS v4u*)((unsigned char*)YB + (size_t)tok * RW + c0) = (v4u){w8[0], w8[1], w8[2], w8[3]}; }
    }
}
#ifndef STAGE
#define STAGE 4
#endif
struct Args { In in; float* out; unsigned char* ws; };
__global__ void __launch_bounds__(NWAVES * 64, 2) mk_fwd(Args args) {
    extern __shared__ __attribute__((aligned(16))) unsigned char lds[];
    Frame F;
    F.lds = (LAS unsigned char*)lds;
    F.MISC = (volatile LAS unsigned*)(F.lds + MISC_OFF);
    F.tid = threadIdx.x; F.lane = F.tid & 63; F.wave = __builtin_amdgcn_readfirstlane(F.tid >> 6);
    F.G = gridDim.x; { const int bx = blockIdx.x; F.vcu = (F.G % 8 == 0) ? (bx % 8) * (F.G / 8) + bx / 8 : bx; }
    F.ws = args.ws;
    F.rsrc = __builtin_amdgcn_make_buffer_rsrc(args.ws, 0, 0xffffffff, 0x00020000);
    F.ctl = (gu32*)(args.ws + WS_CTL);
    for (int u = F.tid; u < (LDS_BYTES - MISC_OFF) / 4; u += NWAVES * 64) ((LAS unsigned*)(F.lds + MISC_OFF))[u] = 0u;
    __syncthreads();
    XcdBarrier bar = xcd_barrier_post((unsigned*)(F.ctl + CW_BAR), F.MISC + 8);
    const In& I = args.in;
#define GRID_BAR() xcd_barrier(bar)
#ifndef DUP_PHASE
#define DUP_PHASE -1
#endif
#define RUN(n, call) do { call; if (DUP_PHASE == (n)) { GRID_BAR(); call; } } while (0)

#if STAGE >= 2
    RUN(0, p0_prologue(F, I));
    GRID_BAR();
#endif
#if STAGE >= 3
    RUN(1, p1_proj(F, I));
    GRID_BAR();
    RUN(2, p2_shift_attn(F, I));
    GRID_BAR();
#if STAGE >= 4
    RUN(3, p3_lora(F, I));
    GRID_BAR();
    RUN(4, p4a_chunk(F, I));
    GRID_BAR();
    RUN(44, p4b_scan(F, I));
    GRID_BAR();
    RUN(5, p5_post(F, I));
    GRID_BAR();
#endif
    RUN(6, p6_merged(F, I));
    GRID_BAR();
    RUN(7, p7_mix(F, I));
    GRID_BAR();
#endif
    p8_ln_router<(STAGE < 3)>(F, I);
    GRID_BAR();
#if STAGE >= 2
    p9_scatter(F, I);
    GRID_BAR();
    RUN(10, p10_moe_up(F, I));
    GRID_BAR();
    RUN(11, p11_moe_down(F, I));
    GRID_BAR();
#endif
    RUN(12, p12_final<(STAGE < 2)>(F, I, args.out));
}

extern "C" void kernel_launch(void* const* d_in, const int* in_sizes, int n_in, void* d_out, int out_size, void* d_ws, size_t ws_size, hipStream_t stream) {
    static int grid = 0;
    if (grid == 0) {
        if (n_in != 27 || in_sizes[0] != T * D || out_size != T * D || ws_size < WS_END) { fprintf(stderr, "kernel_launch: unexpected shapes (n_in %d, in0 %d, out %d, ws %zu)\n", n_in, n_in > 0 ? in_sizes[0] : -1, out_size, ws_size); grid = -1; return; }
        int dev = 0, cus = 0, per_cu = 0;
        if (hipGetDevice(&dev) != hipSuccess || hipDeviceGetAttribute(&cus, hipDeviceAttributeMultiprocessorCount, dev) != hipSuccess) { grid = -1; return; }
        if (hipFuncSetAttribute((const void*)mk_fwd, hipFuncAttributeMaxDynamicSharedMemorySize, LDS_BYTES) != hipSuccess) { fprintf(stderr, "kernel_launch: hipFuncSetAttribute failed\n"); grid = -1; return; }
        if (hipOccupancyMaxActiveBlocksPerMultiprocessor(&per_cu, (const void*)mk_fwd, NWAVES * 64, LDS_BYTES) != hipSuccess || per_cu < 1)
            fprintf(stderr, "kernel_launch: occupancy query reports %d\n", per_cu);
        (void)hipGetLastError();
        grid = cus;
    }
    if (grid < 0) return;
    if (hipMemsetAsync((char*)d_ws + WS_CTL, 0, CTL_ZERO_BYTES, stream) != hipSuccess) return;
    Args a{};
    const float** ip = (const float**)&a.in;
    for (int i = 0; i < 27; ++i) ip[i] = (const float*)d_in[i];
    a.out = (float*)d_out; a.ws = (unsigned char*)d_ws;
    hipLaunchKernelGGL(mk_fwd, dim3(grid), dim3(NWAVES * 64), LDS_BYTES, stream, a);
    const hipError_t le = hipPeekAtLastError();
    if (le != hipSuccess) fprintf(stderr, "kernel_launch: launch failed: %s\n", hipGetErrorName(le));
}
```

```cpp
#define STAGE 4
#include <hip/hip_runtime.h>
#include <cstdio>
#include <cstdint>

#define GAS __attribute__((address_space(1)))
#define LAS __attribute__((address_space(3)))
typedef unsigned short bf16;
typedef unsigned v4u __attribute__((ext_vector_type(4)));
typedef unsigned v2u __attribute__((ext_vector_type(2)));
typedef float f32x4 __attribute__((ext_vector_type(4)));
typedef float f32x2 __attribute__((ext_vector_type(2)));
typedef float f32x16 __attribute__((ext_vector_type(16)));
typedef short bf16x8 __attribute__((ext_vector_type(8)));
typedef short bf16x4 __attribute__((ext_vector_type(4)));
typedef GAS unsigned gu32;

constexpr int NWAVES = 8;
constexpr int BATCH = 4, SEQ = 8192, D = 2048, T = BATCH * SEQ;
constexpr int CHUNK = 64, LEFT = 8, AH = 16, AD = 64, AW = 1024;
constexpr int REL_TABLE = 320, MAX_PAST = 256;
constexpr int RH = 16, RN = 64, RW = 1024, DLORA = 96, ALORA = 96, GLORA = 256;
constexpr int SHIFT_W = 3 * RW + DLORA + ALORA + GLORA;
constexpr int D_IN = 3 * AW + SHIFT_W + 2 * D;
constexpr int NE = 32, TOPK = 4, FF = 2048;
constexpr int MSLOT = T * TOPK;
constexpr int NBLK_MAX = (MSLOT + NE * 255 + 255) / 256;
constexpr int RROWS = NBLK_MAX * 256;
constexpr float LN_EPS = 1e-5f, GN_EPS = 64e-5f;
constexpr float YS_SCALE = 16.0f, YS_INV = 1.0f / 16.0f;
constexpr float ACT8_SCALE = 16.0f;
constexpr float F8_CVT_SCALE = 0.015625f;
constexpr float DN_ALPHA = 1.189207115002721f;
constexpr int PROJ_LD = 9728, PJ_Q = 0, PJ_K = 1024, PJ_SEG = 2048, SEG_PAD = 3584, PJ_GA = 5632, PJ_GB = 7680;
constexpr int LORA_LD = 512;

constexpr size_t MiB = 1u << 20;
constexpr size_t WS_CTL = 0, CTL_ZERO_BYTES = 1 * MiB;
constexpr size_t WS_TOPI = 2 * MiB;
constexpr size_t WS_GATE = 3 * MiB;
constexpr size_t WS_ROWSLOT = 4 * MiB;
constexpr size_t WS_ROWW = 5 * MiB;
constexpr size_t WS_WLA = 6 * MiB;
constexpr size_t WS_WLG = 7 * MiB;
constexpr size_t WS_PAT = 8 * MiB;
constexpr size_t WS_PBT = 12 * MiB;
constexpr size_t WS_WOT = 16 * MiB;
constexpr size_t WS_WVT = 24 * MiB;
constexpr size_t WS_SIDE0 = 28 * MiB, WS_SIDEL = 36 * MiB;
constexpr size_t WS_WINT = 28 * MiB;
constexpr size_t WS_WG8 = 72 * MiB;
constexpr size_t WS_WQK8 = 80 * MiB;
constexpr size_t WS_WV8 = 84 * MiB;
constexpr size_t WS_WSV8 = 88 * MiB;
constexpr size_t WS_WGUT = 128 * MiB;
constexpr size_t WS_WDNT = 640 * MiB;
constexpr size_t WS_BASE0 = 1024 * MiB;
constexpr size_t WS_PROJ = WS_BASE0;
constexpr size_t WS_VT = WS_PROJ + 608 * MiB;
constexpr size_t WS_YA = WS_VT + 64 * MiB;
constexpr size_t WS_RKV = WS_YA + 64 * MiB;
constexpr size_t WS_LORAIN = WS_RKV + 192 * MiB;
constexpr size_t WS_DECAY = WS_LORAIN + 32 * MiB;
constexpr size_t WS_ICLR = WS_DECAY + 128 * MiB;
constexpr size_t WS_G = WS_ICLR + 128 * MiB;
constexpr size_t WS_YSCAN = WS_G + 64 * MiB;
constexpr size_t WS_YB = WS_YSCAN + 128 * MiB;
constexpr size_t WS_MERGED = WS_YB + 64 * MiB;
constexpr size_t WS_XB16 = WS_MERGED + 128 * MiB;
constexpr size_t WS_MIX_END = WS_XB16 + 128 * MiB;
constexpr size_t WS_Z = 2816 * MiB;
constexpr size_t WS_GATEF = WS_Z;
constexpr size_t WS_H1 = 3072 * MiB;
constexpr size_t WS_H1B = 3328 * MiB;
constexpr size_t WS_CHK = 3456 * MiB;
constexpr size_t WS_XB8 = 3712 * MiB;
constexpr size_t WS_END = 3776 * MiB;
constexpr size_t WS_XG = WS_BASE0;
constexpr size_t WS_ACT = WS_BASE0 + 544 * MiB;
constexpr size_t WS_YSLOT = WS_BASE0 + 1088 * MiB;
static_assert(WS_MIX_END <= WS_Z && WS_YSLOT + 512 * MiB <= WS_Z, "ws map");
static_assert(WS_WINT + (size_t)PROJ_LD * D * 2 <= WS_WGUT, "ws map");

constexpr int CW_CNT = 512;
constexpr int CW_CUR = 576;
constexpr int CW_BAR = 4096;

constexpr int RING_OFF = 0, RING_BYTES = 131072;
constexpr int LDS_BYTES = 160 * 1024;
constexpr int MISC_OFF = LDS_BYTES - 512;
constexpr int TAB_OFF = LDS_BYTES - 1024;

#define RLX_AGENT __ATOMIC_RELAXED, __HIP_MEMORY_SCOPE_AGENT
#define LDS_WAIT() asm volatile("s_waitcnt lgkmcnt(0)" ::: "memory")
#define VM_WAIT() asm volatile("s_waitcnt vmcnt(0)" ::: "memory")
__device__ __forceinline__ unsigned f2bf(float f) { unsigned u = __builtin_bit_cast(unsigned, f); return (u + 0x7fffu + ((u >> 16) & 1u)) >> 16; }
__device__ __forceinline__ unsigned pk2(float lo, float hi) { return f2bf(lo) | (f2bf(hi) << 16); }
__device__ __forceinline__ float bf2f(unsigned short h) { return __builtin_bit_cast(float, (unsigned)h << 16); }
__device__ __forceinline__ float bflo(unsigned w) { return __builtin_bit_cast(float, w << 16); }
__device__ __forceinline__ float bfhi(unsigned w) { return __builtin_bit_cast(float, w & 0xffff0000u); }
__device__ __forceinline__ float fsigmoid(float x) { return __builtin_amdgcn_rcpf(1.0f + __expf(-x)); }
__device__ __forceinline__ float dpp_f(float x, const int ctrl_sel) {
    const int xi = __builtin_bit_cast(int, x); int r;
    if (ctrl_sel == 0) r = __builtin_amdgcn_update_dpp(0, xi, 0xB1, 0xF, 0xF, false);
    else if (ctrl_sel == 1) r = __builtin_amdgcn_update_dpp(0, xi, 0x4E, 0xF, 0xF, false);
    else if (ctrl_sel == 2) r = __builtin_amdgcn_update_dpp(0, xi, 0x124, 0xF, 0xF, false);
    else r = __builtin_amdgcn_update_dpp(0, xi, 0x128, 0xF, 0xF, false);
    return __builtin_bit_cast(float, r);
}
__device__ __forceinline__ float rowsum16(float x) { x += dpp_f(x, 0); x += dpp_f(x, 1); x += dpp_f(x, 2); x += dpp_f(x, 3); return x; }
__device__ __forceinline__ float quadsum(float x) { x += dpp_f(x, 0); x += dpp_f(x, 1); return x; }
__device__ __forceinline__ float wave_sum(float v) {
    v = rowsum16(v);
    const int vi = __builtin_bit_cast(int, v);
    const float s0 = __builtin_bit_cast(float, __builtin_amdgcn_readlane(vi, 0)), s1 = __builtin_bit_cast(float, __builtin_amdgcn_readlane(vi, 16));
    const float s2 = __builtin_bit_cast(float, __builtin_amdgcn_readlane(vi, 32)), s3 = __builtin_bit_cast(float, __builtin_amdgcn_readlane(vi, 48));
    return (s0 + s1) + (s2 + s3);
}
namespace pg8 {
#define PG8_LAS __attribute__((address_space(3)))
typedef unsigned short bf16_t;
typedef unsigned u32x4 __attribute__((ext_vector_type(4)));
constexpr int BM = 256, BK = 64, HALF = 128, HTB = HALF * BK * 2, STAGE_BYTES = 8 * HTB, NXCD = 8, WGM = 8;

__host__ __device__ __forceinline__ int lds_byte(int r, int c) { const int st = (r >> 4) * 2 + (c >> 5), rr = r & 15, cc = c & 31, ob = rr * 64 + cc * 2; return st * 1024 + (ob ^ (((ob >> 9) & 1) << 5)); }
__host__ __device__ __forceinline__ void stage_rc(int b, int& R, int& C) { const int st = b / 1024, sb = b % 1024, swz = sb ^ (((sb >> 9) & 1) << 5); R = (st >> 1) * 16 + swz / 64; C = (st & 1) * 32 + (swz % 64) / 2; }
__host__ __device__ __forceinline__ int perm32(int rho) { const int n = rho >> 4, i = rho & 15; return 8 * (i >> 2) + 4 * n + (i & 3); }

struct Unit { int pm, pn, aux; };

struct Tiler {
    int nM, nN, nwg, G, c;
    __device__ __forceinline__ void init(int nM_, int nN_, int G_, int c_) { nM = nM_; nN = nN_; nwg = nM * nN; G = G_; c = c_; }
    __device__ __forceinline__ bool map(int i, int& pm, int& pn) const {
        const long L = (long)i * G + c; if (L >= nwg) return false;
        int wgid = (int)L; { const int q = nwg / NXCD, r = nwg % NXCD, xcd = wgid % NXCD, off = wgid / NXCD; wgid = (xcd < r ? xcd * (q + 1) : r * (q + 1) + (xcd - r) * q) + off; }
        const int nig = WGM * nN, gid = wgid / nig, fm = gid * WGM, gsz = (nM - fm) < WGM ? (nM - fm) : WGM;
        pm = fm + ((wgid % nig) % gsz); pn = (wgid % nig) / gsz; return true;
    }
};
struct SchedPlain {
    Tiler t; unsigned A, B, tsA, tsB;
    __device__ __forceinline__ bool next(int i, Unit& u) const { u.aux = 0; return t.map(i, u.pm, u.pn); }
    __device__ __forceinline__ void bases(const Unit& u, unsigned& a, unsigned& b) const { a = A + (unsigned)u.pm * tsA; b = B + (unsigned)u.pn * tsB; }
};
struct SchedTwo {
    Tiler t; unsigned A0, A1, B0, B1, tsA, tsB;
    __device__ __forceinline__ bool next(int i, Unit& u) const { u.aux = i & 1; return t.map(i >> 1, u.pm, u.pn); }
    __device__ __forceinline__ void bases(const Unit& u, unsigned& a, unsigned& b) const { a = (u.aux ? A1 : A0) + (unsigned)u.pm * tsA; b = (u.aux ? B1 : B0) + (unsigned)u.pn * tsB; }
};
struct SchedMoe {
    Tiler t; unsigned A, B, tsA, tsB, es; const PG8_LAS int* pad_end;
    __device__ __forceinline__ bool next(int i, Unit& u) const {
        if (!t.map(i, u.pm, u.pn)) return false;
        const int row0 = u.pm * BM; int e = 0;
#pragma unroll
        for (int j = 0; j < 32; ++j) e += (pad_end[j] <= row0) ? 1 : 0;
        u.aux = __builtin_amdgcn_readfirstlane(e < 31 ? e : 31); return true;
    }
    __device__ __forceinline__ void bases(const Unit& u, unsigned& a, unsigned& b) const { a = A + (unsigned)u.pm * tsA; b = B + (unsigned)u.aux * es + (unsigned)u.pn * tsB; }
};

typedef float f32x2_t_ __attribute__((ext_vector_type(2)));
typedef __bf16 bf16x2_t_ __attribute__((ext_vector_type(2)));
__device__ __forceinline__ unsigned cvt_pk_bf16(float lo, float hi) { const f32x2_t_ v = {lo, hi}; const bf16x2_t_ b = __builtin_convertvector(v, bf16x2_t_); return __builtin_bit_cast(unsigned, b); }
__device__ __forceinline__ u32x4 pack8(const f32x4& v0, const f32x4& v1) { u32x4 w; w.x = cvt_pk_bf16(v0[0], v0[1]); w.y = cvt_pk_bf16(v0[2], v0[3]); w.z = cvt_pk_bf16(v1[0], v1[1]); w.w = cvt_pk_bf16(v1[2], v1[3]); return w; }

typedef int i32x8 __attribute__((ext_vector_type(8)));
typedef int i32x4 __attribute__((ext_vector_type(4)));
__device__ __forceinline__ i32x8 cat8(const bf16x8& a, const bf16x8& b) { return __builtin_shufflevector(__builtin_bit_cast(i32x4, a), __builtin_bit_cast(i32x4, b), 0, 1, 2, 3, 4, 5, 6, 7); }
constexpr int F8_SCALES = 0x00007f79;
template <class Epi, class Sched, bool ALIGN_EPI, bool F8 = false, int F8SC = F8_SCALES>
__device__ __forceinline__ void gemm_phase(PG8_LAS unsigned char* lds, const __amdgpu_buffer_rsrc_t rsrc, const int lda, const int ldb, const int K, const Sched& S, const Epi& E) {
    int tid_ = threadIdx.x; asm volatile("" : "+v"(tid_));
    const int tid = tid_, wid = __builtin_amdgcn_readfirstlane(tid >> 6), lane = tid & 63, wr = wid >> 2, wc = wid & 3, fr = lane & 15, fq = lane >> 4;
    const int nt = K / BK;
    unsigned voffA, voffB;
    { int R, C; stage_rc(tid * 16, R, C); const int Rb = (R & ~31) + perm32(R & 31); voffA = (unsigned)(R * lda + C) * 2u; voffB = (unsigned)(Rb * ldb + C) * 2u; }
    const unsigned p1voffA = 64u * (unsigned)lda * 2u, p1voffB = 64u * (unsigned)ldb * 2u;
    const unsigned kstep = (unsigned)(BK * 2);
    const unsigned hsA = (unsigned)HALF * lda * 2, hsB = (unsigned)HALF * ldb * 2;
    const unsigned ldsw = (unsigned)wid * 1024u;
    const int aoff = lds_byte(wr * 64 + fr, fq * 8), boff = lds_byte(wc * 32 + fr, fq * 8);
#define PG8_SA(b, h) (((b) * 2 + (h)) * HTB)
#define PG8_SB(b, h) ((4 + (b) * 2 + (h)) * HTB)
#define PG8_STAGE(bufoff, goff, voff) do { _Pragma("unroll") for (int _i = 0; _i < 2; ++_i) \
        __builtin_amdgcn_raw_ptr_buffer_load_lds(rsrc, (PG8_LAS void*)(lds + (bufoff) + ldsw + _i * 8192), 16, (int)(voff), (int)((goff) + _i * p1##voff), 0, 0); } while (0)
#define PG8_LD8(addr) __builtin_shufflevector(*(const PG8_LAS i32x4*)(addr), *(const PG8_LAS i32x4*)((addr) + 1024), 0, 1, 2, 3, 4, 5, 6, 7)
#define PG8_LDA(dst, b, h) do { _Pragma("unroll") for (int m = 0; m < 4; ++m) dst[m] = PG8_LD8(lds + PG8_SA(b, h) + aoff + m * 2048); } while (0)
#define PG8_LDB(dst, b, h) do { _Pragma("unroll") for (int n = 0; n < 2; ++n) dst[n] = PG8_LD8(lds + PG8_SB(b, h) + boff + n * 2048); } while (0)
#define PG8_LO(v) __builtin_bit_cast(bf16x8, __builtin_shufflevector(v, v, 0, 1, 2, 3))
#define PG8_HI(v) __builtin_bit_cast(bf16x8, __builtin_shufflevector(v, v, 4, 5, 6, 7))
#define PG8_MMA(ai, bj, At, Bt) do { __builtin_amdgcn_s_setprio(1); \
        if constexpr (!F8) { _Pragma("unroll") for (int m = 0; m < 4; ++m) _Pragma("unroll") for (int n = 0; n < 2; ++n) { \
            acc[ai][bj][m][n] = __builtin_amdgcn_mfma_f32_16x16x32_bf16(PG8_LO(Bt[n]), PG8_LO(At[m]), acc[ai][bj][m][n], 0, 0, 0); \
            acc[ai][bj][m][n] = __builtin_amdgcn_mfma_f32_16x16x32_bf16(PG8_HI(Bt[n]), PG8_HI(At[m]), acc[ai][bj][m][n], 0, 0, 0); } } \
        else { _Pragma("unroll") for (int m = 0; m < 4; ++m) _Pragma("unroll") for (int n = 0; n < 2; ++n) \
            acc[ai][bj][m][n] = __builtin_amdgcn_mfma_scale_f32_16x16x128_f8f6f4(Bt[n], At[m], acc[ai][bj][m][n], 0, 0, 0, F8SC, 1, F8SC); } \
        __builtin_amdgcn_s_setprio(0); } while (0)
#define PG8_WAIT_V(n) asm volatile("s_waitcnt vmcnt(" #n ")" ::: "memory")
#define PG8_WAIT_L(n) asm volatile("s_waitcnt lgkmcnt(" #n ")" ::: "memory")
#define PG8_BAR __builtin_amdgcn_s_barrier()
#define PG8_SCHED __builtin_amdgcn_sched_barrier(0)
#define PG8_ZERO() do { _Pragma("unroll") for (int a = 0; a < 2; ++a) _Pragma("unroll") for (int b = 0; b < 2; ++b) _Pragma("unroll") for (int m = 0; m < 4; ++m) _Pragma("unroll") for (int n = 0; n < 2; ++n) acc[a][b][m][n] = (f32x4){0.f, 0.f, 0.f, 0.f}; } while (0)
    Unit cur, nxt; int ui = 0;
    if (!S.next(0, cur)) return;
    f32x4 acc[2][2][4][2];
    PG8_ZERO();
    i32x8 At[4], B0[2], B1[2];
    unsigned cA, cB; S.bases(cur, cA, cB); cA = __builtin_amdgcn_readfirstlane(cA); cB = __builtin_amdgcn_readfirstlane(cB);
    PG8_STAGE(PG8_SB(0, 0), cB, voffB); PG8_STAGE(PG8_SB(0, 1), cB + hsB, voffB); PG8_STAGE(PG8_SA(0, 0), cA, voffA); PG8_STAGE(PG8_SA(0, 1), cA + hsA, voffA);
    if (wr == 1) PG8_BAR;
    PG8_WAIT_V(2); PG8_BAR;
    PG8_STAGE(PG8_SB(1, 0), cB + kstep, voffB); PG8_STAGE(PG8_SA(1, 0), cA + kstep, voffA); PG8_STAGE(PG8_SB(1, 1), cB + hsB + kstep, voffB);
    PG8_WAIT_V(6); PG8_BAR;
    for (;;) {
        const bool has_next = S.next(ui + 1, nxt);
        unsigned nA = cA, nB = cB; if (has_next) { S.bases(nxt, nA, nB); nA = __builtin_amdgcn_readfirstlane(nA); nB = __builtin_amdgcn_readfirstlane(nB); }
#pragma unroll 1
        for (int t = 0; t < nt; t += 2) {
            const bool last = (t == nt - 2);
            const unsigned a1 = cA + (unsigned)(t + 1) * kstep;
            const unsigned a2 = last ? nA : cA + (unsigned)(t + 2) * kstep, b2 = last ? nB : cB + (unsigned)(t + 2) * kstep;
            const unsigned a3 = a2 + kstep, b3 = b2 + kstep;
            PG8_LDB(B0, 0, 0); PG8_LDB(B1, 0, 1); PG8_SCHED; PG8_LDA(At, 0, 0); PG8_STAGE(PG8_SA(1, 1), a1 + hsA, voffA);
            PG8_WAIT_V(8); PG8_WAIT_L(0); PG8_BAR; PG8_MMA(0, 0, At, B0); PG8_MMA(0, 1, At, B1); PG8_BAR; PG8_SCHED;
            PG8_LDA(At, 0, 1); PG8_STAGE(PG8_SB(0, 0), b2, voffB); PG8_STAGE(PG8_SB(0, 1), b2 + hsB, voffB); PG8_STAGE(PG8_SA(0, 0), a2, voffA);
            PG8_WAIT_V(8); PG8_WAIT_L(0); PG8_BAR; PG8_MMA(1, 0, At, B0); PG8_MMA(1, 1, At, B1); PG8_BAR; PG8_SCHED;
            PG8_LDB(B0, 1, 0); PG8_LDB(B1, 1, 1); PG8_SCHED; PG8_LDA(At, 1, 0); PG8_STAGE(PG8_SA(0, 1), a2 + hsA, voffA);
            PG8_WAIT_V(8); PG8_WAIT_L(0); PG8_BAR; PG8_MMA(0, 0, At, B0); PG8_MMA(0, 1, At, B1); PG8_BAR; PG8_SCHED;
            PG8_LDA(At, 1, 1); PG8_STAGE(PG8_SB(1, 0), b3, voffB); PG8_STAGE(PG8_SB(1, 1), b3 + hsB, voffB); PG8_STAGE(PG8_SA(1, 0), a3, voffA);
            PG8_WAIT_V(8); PG8_WAIT_L(0); PG8_BAR; PG8_MMA(1, 0, At, B0); PG8_MMA(1, 1, At, B1); PG8_BAR; PG8_SCHED;
        }
        if constexpr (ALIGN_EPI) { if (wr == 0) PG8_BAR; }
        bool keep; { int t2 = threadIdx.x; asm volatile("" : "+v"(t2)); const int w2 = __builtin_amdgcn_readfirstlane(t2 >> 6), l2 = t2 & 63; keep = E(acc, cur, w2 >> 2, w2 & 3, l2 & 15, l2 >> 4); }
        if (!has_next) break;
        if (!keep) PG8_ZERO();
        cur = nxt; cA = nA; cB = nB; ++ui;
        if constexpr (ALIGN_EPI) { if (wr == 1) PG8_BAR; }
    }
    PG8_WAIT_V(0);
    if constexpr (!ALIGN_EPI) { if (wr == 0) PG8_BAR; }
    PG8_BAR;
#undef PG8_SA
#undef PG8_SB
#undef PG8_STAGE
#undef PG8_LDA
#undef PG8_LDB
#undef PG8_LD8
#undef PG8_LO
#undef PG8_HI
#undef PG8_MMA
#undef PG8_WAIT_V
#undef PG8_WAIT_L
#undef PG8_BAR
#undef PG8_SCHED
#undef PG8_ZERO
}
}
namespace pg8 {
#define EPI_ROWLOOP _Pragma("unroll") for (int ai = 0; ai < 2; ++ai) _Pragma("unroll") for (int m = 0; m < 4; ++m)
struct EpiProj {
    bf16_t* O; int coloff, nq;
    __device__ __forceinline__ bool operator()(f32x4 (&acc)[2][2][4][2], const Unit& u, int wr, int wc, int fr, int fq) const {
        const int row0 = u.pm * BM + wr * 64 + fr, col0 = coloff + u.pn * BM + wc * 32 + 8 * fq;
        const float sc = (u.pn < nq) ? 0.125f : 1.0f;
        EPI_ROWLOOP { bf16_t* rowp = O + (size_t)(row0 + ai * HALF + m * 16) * PROJ_LD + col0;
#pragma unroll
            for (int bj = 0; bj < 2; ++bj) *(u32x4*)(rowp + bj * HALF) = pack8(acc[ai][bj][m][0] * sc, acc[ai][bj][m][1] * sc); }
        return false;
    }
};
__device__ __forceinline__ float dpp_prev_row(float lo15, float cur) {
    const int o = __builtin_amdgcn_update_dpp(0, __builtin_bit_cast(int, lo15), 0x121, 0xF, 0xF, false);
    return __builtin_bit_cast(float, __builtin_amdgcn_update_dpp(o, __builtin_bit_cast(int, cur), 0x111, 0xF, 0xF, false));
}
struct EpiShift {
    bf16_t* RKVp; bf16_t* LIN; float* SIDE0; float* SIDEL; const float* mu;
    __device__ __forceinline__ bool operator()(f32x4 (&acc)[2][2][4][2], const Unit& u, int wr, int wc, int fr, int fq) const {
        static_assert(DLORA % 32 == 0 && ALORA % 32 == 0 && GLORA % 32 == 0 && RW % 32 == 0, "segment boundaries are wave-uniform");
        const int row0 = u.pm * BM + wr * 64 + fr;
#pragma unroll
        for (int bj = 0; bj < 2; ++bj) {
            const int cgrp = u.pn * BM + bj * HALF + wc * 32;
            if (cgrp >= SHIFT_W) continue;
            const int c = cgrp + 8 * fq;
            const f32x4 mu0 = *(const f32x4*)(mu + c), mu1 = *(const f32x4*)(mu + c + 4);
            bf16_t* dbase; int ld, act = 0;
            if (cgrp < 3 * RW) { dbase = RKVp + c; ld = 3 * RW; }
            else if (cgrp < 3 * RW + DLORA) { dbase = LIN + (c - 3 * RW); ld = LORA_LD; act = 1; }
            else if (cgrp < 3 * RW + DLORA + ALORA) { dbase = LIN + 128 + (c - 3 * RW - DLORA); ld = LORA_LD; }
            else { dbase = LIN + 256 + (c - 3 * RW - DLORA - ALORA); ld = LORA_LD; act = 2; }
            const bool zpad = (cgrp == 3 * RW + DLORA - 32) || (cgrp == 3 * RW + DLORA + ALORA - 32);
#pragma unroll
            for (int ai = 0; ai < 2; ++ai) {
                const int g = u.pm * 4 + ai * 2 + wr;
#pragma unroll
                for (int m = 0; m < 4; ++m) {
                    f32x4 o[2];
#pragma unroll
                    for (int n = 0; n < 2; ++n) { const f32x4 cur = acc[ai][bj][m][n]; const f32x4 mm = n ? mu1 : mu0;
#pragma unroll
                        for (int j = 0; j < 4; ++j) { const float prv = dpp_prev_row(m > 0 ? acc[ai][bj][m > 0 ? m - 1 : 0][n][j] : 0.0f, cur[j]);
                            float v = cur[j] + (prv - cur[j]) * mm[j];
                            if (act == 1) v = 2.0f * fsigmoid(2.0f * v) - 1.0f; else if (act == 2) v = fsigmoid(v);
                            o[n][j] = v; } }
                    bf16_t* dp = dbase + (size_t)(row0 + ai * HALF + m * 16) * ld;
                    *(u32x4*)dp = pack8(o[0], o[1]);
                    if (zpad) { unsigned zz = 0u; asm volatile("" : "+v"(zz)); *(u32x4*)(dp + 32) = (u32x4){zz, zz, zz, zz}; }
                    if (m == 0 && fr == 0) { float* sp = SIDE0 + (size_t)g * SEG_PAD + c; *(f32x4*)sp = acc[ai][bj][0][0]; *(f32x4*)(sp + 4) = acc[ai][bj][0][1]; }
                    if (m == 3 && fr == 15) { float* sp = SIDEL + (size_t)g * SEG_PAD + c; *(f32x4*)sp = acc[ai][bj][3][0]; *(f32x4*)(sp + 4) = acc[ai][bj][3][1]; }
                } }
        }
        return false;
    }
};
struct EpiGate {
    bf16_t* O;
    __device__ __forceinline__ bool operator()(f32x4 (&acc)[2][2][4][2], const Unit& u, int wr, int wc, int fr, int fq) const {
        u32x4* gf = (u32x4*)O + ((size_t)(u.pm * 16 + u.pn) * 2 * 8 + (wr * 4 + wc)) * 512 + (fq * 16 + fr);
        EPI_ROWLOOP {
            f32x4 rt[2], gb[2];
#pragma unroll
            for (int n = 0; n < 2; ++n)
#pragma unroll
                for (int j = 0; j < 4; ++j) { const float ea = __expf(-acc[ai][0][m][n][j]), eb = fminf(__expf(-acc[ai][1][m][n][j]), 1e30f);
                    gb[n][j] = __builtin_amdgcn_rcpf(1.0f + eb); rt[n][j] = (1.0f + eb) * __builtin_amdgcn_rcpf(1.0f + ea); }
            gf[(ai * 4 + m) * 64] = pack8(rt[0], rt[1]); gf[8 * 512 + (ai * 4 + m) * 64] = pack8(gb[0], gb[1]); }
        return false;
    }
};
struct EpiBf16 {
    bf16_t* O; int ldc;
    __device__ __forceinline__ bool operator()(f32x4 (&acc)[2][2][4][2], const Unit& u, int wr, int wc, int fr, int fq) const {
        const int row0 = u.pm * BM + wr * 64 + fr, col0 = u.pn * BM + wc * 32 + 8 * fq;
        EPI_ROWLOOP { bf16_t* rowp = O + (size_t)(row0 + ai * HALF + m * 16) * ldc + col0;
#pragma unroll
            for (int bj = 0; bj < 2; ++bj) *(u32x4*)(rowp + bj * HALF) = pack8(acc[ai][bj][m][0], acc[ai][bj][m][1]); }
        return false;
    }
};
template <bool ISDEC> struct EpiLoraA {
    float* OUT; const float* par;
    __device__ __forceinline__ bool operator()(f32x4 (&acc)[2][2][4][2], const Unit& u, int wr, int wc, int fr, int fq) const {
        const int row0 = u.pm * BM + wr * 64 + fr, col0 = u.pn * BM + wc * 32 + 8 * fq;
        f32x4 pv[2][2];
#pragma unroll
        for (int bj = 0; bj < 2; ++bj)
#pragma unroll
            for (int n = 0; n < 2; ++n) pv[bj][n] = *(const f32x4*)(par + col0 + bj * HALF + 4 * n);
        EPI_ROWLOOP { float* rowp = OUT + (size_t)(row0 + ai * HALF + m * 16) * RW + col0;
#pragma unroll
            for (int bj = 0; bj < 2; ++bj)
#pragma unroll
                for (int n = 0; n < 2; ++n) { f32x4 v = acc[ai][bj][m][n] + pv[bj][n];
#pragma unroll
                    for (int j = 0; j < 4; ++j) {
                        if (ISDEC) v[j] = -0.60653065971263342f * fsigmoid(v[j]);
                        else v[j] = fsigmoid(v[j]); }
                    *(f32x4*)(rowp + bj * HALF + 4 * n) = v; } }
        return false;
    }
};
struct EpiIclr {
    bf16_t* OUT; const float* par;
    __device__ __forceinline__ bool operator()(f32x4 (&acc)[2][2][4][2], const Unit& u, int wr, int wc, int fr, int fq) const {
        const int row0 = u.pm * BM + wr * 64 + fr, col0 = u.pn * BM + wc * 32 + 8 * fq;
        f32x4 pv[2][2];
#pragma unroll
        for (int bj = 0; bj < 2; ++bj)
#pragma unroll
            for (int n = 0; n < 2; ++n) pv[bj][n] = *(const f32x4*)(par + col0 + bj * HALF + 4 * n);
        EPI_ROWLOOP { bf16_t* rowp = OUT + (size_t)(row0 + ai * HALF + m * 16) * RW + col0;
#pragma unroll
            for (int bj = 0; bj < 2; ++bj) { f32x4 v0 = acc[ai][bj][m][0] + pv[bj][0], v1 = acc[ai][bj][m][1] + pv[bj][1];
#pragma unroll
                for (int j = 0; j < 4; ++j) { v0[j] = fsigmoid(v0[j]); v1[j] = fsigmoid(v1[j]); }
                *(u32x4*)(rowp + bj * HALF) = pack8(v0, v1); } }
        return false;
    }
};
struct EpiMerged {
    const bf16_t* PROJ; bf16_t* O;
    __device__ __forceinline__ bool operator()(f32x4 (&acc)[2][2][4][2], const Unit& u, int wr, int wc, int fr, int fq) const {
        const int row0 = u.pm * BM + wr * 64 + fr, col0 = u.pn * BM + wc * 32 + 8 * fq;
        const u32x4* gf = (const u32x4*)PROJ + ((size_t)(u.pm * 16 + u.pn * 2) * 2 * 8 + (u.aux == 0 ? 0 : 8) + (wr * 4 + wc)) * 512 + (fq * 16 + fr);
#pragma unroll
        for (int ai = 0; ai < 2; ++ai) {
            u32x4 gv[4][2];
#pragma unroll
            for (int m = 0; m < 4; ++m)
#pragma unroll
                for (int bj = 0; bj < 2; ++bj) gv[m][bj] = gf[(size_t)bj * (2 * 8 * 512) + (ai * 4 + m) * 64];
#pragma unroll
            for (int m = 0; m < 4; ++m) { const int row = row0 + ai * HALF + m * 16;
#pragma unroll
                for (int bj = 0; bj < 2; ++bj) { const u32x4 g = gv[m][bj];
                    const f32x4 g0 = (f32x4){bflo(g.x), bfhi(g.x), bflo(g.y), bfhi(g.y)}, g1 = (f32x4){bflo(g.z), bfhi(g.z), bflo(g.w), bfhi(g.w)};
                    if (u.aux == 0) { acc[ai][bj][m][0] = acc[ai][bj][m][0] * g0; acc[ai][bj][m][1] = acc[ai][bj][m][1] * g1; }
                    else { const f32x4 o0 = acc[ai][bj][m][0] * g0 * ACT8_SCALE, o1 = acc[ai][bj][m][1] * g1 * ACT8_SCALE;
                        int w0 = __builtin_amdgcn_cvt_pk_fp8_f32(o0[0], o0[1], 0, false); w0 = __builtin_amdgcn_cvt_pk_fp8_f32(o0[2], o0[3], w0, true);
                        int w1 = __builtin_amdgcn_cvt_pk_fp8_f32(o1[0], o1[1], 0, false); w1 = __builtin_amdgcn_cvt_pk_fp8_f32(o1[2], o1[3], w1, true);
                        *(v2u*)((unsigned char*)O + (size_t)row * D + col0 + bj * HALF) = (v2u){(unsigned)w0, (unsigned)w1}; } } }
        }
        return u.aux == 0;
    }
};
struct EpiZ {
    const float* X; float* Z;
    __device__ __forceinline__ bool operator()(f32x4 (&acc)[2][2][4][2], const Unit& u, int wr, int wc, int fr, int fq) const {
        const int row0 = u.pm * BM + wr * 64 + fr, col0 = u.pn * BM + wc * 32 + 8 * fq;
        EPI_ROWLOOP { const size_t off = (size_t)(row0 + ai * HALF + m * 16) * D + col0;
#pragma unroll
            for (int bj = 0; bj < 2; ++bj)
#pragma unroll
                for (int n = 0; n < 2; ++n) { const f32x4 xv = *(const f32x4*)(X + off + bj * HALF + 4 * n); *(f32x4*)(Z + off + bj * HALF + 4 * n) = xv * DN_ALPHA + acc[ai][bj][m][n]; } }
        return false;
    }
};
struct EpiSwiglu {
    unsigned char* ACT; const float* bgu;
    __device__ __forceinline__ bool operator()(f32x4 (&acc)[2][2][4][2], const Unit& u, int wr, int wc, int fr, int fq) const {
        const int row0 = u.pm * BM + wr * 64 + fr, col0 = u.pn * HALF + wc * 32 + 8 * fq;
        const float* bp = bgu + (size_t)u.aux * (2 * FF) + col0;
        f32x4 bg[2], bu[2];
#pragma unroll
        for (int n = 0; n < 2; ++n) { bg[n] = *(const f32x4*)(bp + 4 * n); bu[n] = *(const f32x4*)(bp + FF + 4 * n); }
        EPI_ROWLOOP { f32x4 o[2];
#pragma unroll
            for (int n = 0; n < 2; ++n) { const f32x4 g = acc[ai][0][m][n] + bg[n], uu = acc[ai][1][m][n] + bu[n];
#pragma unroll
                for (int j = 0; j < 4; j += 2) {
                    f32x2 gc, uc; gc[0] = fminf(g[j], 7.0f); gc[1] = fminf(g[j + 1], 7.0f);
                    uc[0] = __builtin_amdgcn_fmed3f(uu[j], -7.0f, 7.0f); uc[1] = __builtin_amdgcn_fmed3f(uu[j + 1], -7.0f, 7.0f);
                    const f32x2 t = gc * (f32x2){-2.4554669595930156f, -2.4554669595930156f};
                    f32x2 d; d[0] = __builtin_amdgcn_exp2f(t[0]); d[1] = __builtin_amdgcn_exp2f(t[1]);
                    d = d + (f32x2){1.0f, 1.0f};
                    f32x2 r; r[0] = __builtin_amdgcn_rcpf(d[0]); r[1] = __builtin_amdgcn_rcpf(d[1]);
                    const f32x2 s = gc * r, oo = __builtin_elementwise_fma(uc, s, s);
                    o[n][j] = oo[0]; o[n][j + 1] = oo[1]; } }
            int w0 = __builtin_amdgcn_cvt_pk_fp8_f32(o[0][0], o[0][1], 0, false); w0 = __builtin_amdgcn_cvt_pk_fp8_f32(o[0][2], o[0][3], w0, true);
            int w1 = __builtin_amdgcn_cvt_pk_fp8_f32(o[1][0], o[1][1], 0, false); w1 = __builtin_amdgcn_cvt_pk_fp8_f32(o[1][2], o[1][3], w1, true);
            *(v2u*)(ACT + (size_t)(row0 + ai * HALF + m * 16) * FF + col0) = (v2u){(unsigned)w0, (unsigned)w1}; }
        return false;
    }
};
struct EpiDown {
    unsigned char* YS; const float* bdn; const int* rowslot; const float* roww;
    __device__ __forceinline__ bool operator()(f32x4 (&acc)[2][2][4][2], const Unit& u, int wr, int wc, int fr, int fq) const {
        const int row0 = u.pm * BM + wr * 64 + fr, col0 = u.pn * BM + wc * 32 + 8 * fq;
        const float* bp = bdn + (size_t)u.aux * D + col0;
        f32x4 bv[2][2];
#pragma unroll
        for (int bj = 0; bj < 2; ++bj)
#pragma unroll
            for (int n = 0; n < 2; ++n) bv[bj][n] = *(const f32x4*)(bp + bj * HALF + 4 * n);
        int slots[8]; float ws_[8];
#pragma unroll
        for (int q = 0; q < 8; ++q) { const int row = row0 + (q >> 2) * HALF + (q & 3) * 16; slots[q] = rowslot[row]; ws_[q] = roww[row]; }
        EPI_ROWLOOP { const int slot = slots[ai * 4 + m]; const float w = ws_[ai * 4 + m] * YS_SCALE;
            if (slot >= 0) { unsigned char* rowp = YS + (size_t)slot * D + col0;
#pragma unroll
                for (int bj = 0; bj < 2; ++bj) { const f32x4 o0 = (acc[ai][bj][m][0] + bv[bj][0]) * w, o1 = (acc[ai][bj][m][1] + bv[bj][1]) * w;
                    int w0 = __builtin_amdgcn_cvt_pk_fp8_f32(o0[0], o0[1], 0, false); w0 = __builtin_amdgcn_cvt_pk_fp8_f32(o0[2], o0[3], w0, true);
                    int w1 = __builtin_amdgcn_cvt_pk_fp8_f32(o1[0], o1[1], 0, false); w1 = __builtin_amdgcn_cvt_pk_fp8_f32(o1[2], o1[3], w1, true);
                    *(v2u*)(rowp + bj * HALF) = (v2u){(unsigned)w0, (unsigned)w1}; } } }
        return false;
    }
};
#undef EPI_ROWLOOP
}

#define XB_TMO      128
#define XB_XCNT(j)  (256  + 64 * (j))
#define XB_XSUB(j)  (1280 + 64 * (j))
#define XB_XGEN(j)  (2304 + 64 * (j))
#define XB_TOP      3328
#define XB_TOPGEN   3392
#define XCD_BAR_WORDS 3456
#define XB_SPIN_CAP (1u << 18)

__device__ __forceinline__ unsigned xb_ld(unsigned* p)              { return __hip_atomic_load(p, __ATOMIC_RELAXED, __HIP_MEMORY_SCOPE_AGENT); }
__device__ __forceinline__ unsigned xb_add(unsigned* p, unsigned v) { return __hip_atomic_fetch_add(p, v, __ATOMIC_RELAXED, __HIP_MEMORY_SCOPE_AGENT); }
__device__ __forceinline__ unsigned xb_xcc_id() { return (unsigned)__builtin_amdgcn_s_getreg((3 << 11) | 20) & 0xFu; }
#define XB_SPIN(cond, bar) do { unsigned _sp = 0; while (cond) { __builtin_amdgcn_s_sleep(1); \
    if ((++_sp & 255u) == 0u) { if (xb_ld(&(bar)[XB_TMO])) break; if (_sp > XB_SPIN_CAP) { atomicAdd(&(bar)[XB_TMO], 1u); break; } } } } while (0)

struct XcdBarrier {
    unsigned* bar; unsigned x;
    volatile LAS unsigned* st;
};

__device__ __forceinline__ XcdBarrier xcd_barrier_post(unsigned* bar, volatile LAS unsigned* st) {
    XcdBarrier b; b.bar = bar; b.x = xb_xcc_id(); b.st = st;
    if (threadIdx.x == 0) (void)xb_add(&bar[XB_XCNT(b.x)], 1u);
    return b;
}
__device__ __forceinline__ void xcd_barrier_complete(unsigned* bar, unsigned x, unsigned& nloc, unsigned& nx) {
    const unsigned G = gridDim.x * gridDim.y * gridDim.z;
    unsigned sum, cnt, mine, sp = 0u;
    for (;;) {
        sum = 0u; cnt = 0u; mine = 0u;
#pragma unroll
        for (unsigned j = 0; j < 16; ++j) { const unsigned c = xb_ld(&bar[XB_XCNT(j)]); sum += c; cnt += (c > 0u) ? 1u : 0u; mine = (j == x) ? c : mine; }
        if (sum == G) break;
        __builtin_amdgcn_s_sleep(1);
        if ((++sp & 255u) == 0u) { if (xb_ld(&bar[XB_TMO])) break; if (sp > XB_SPIN_CAP) { atomicAdd(&bar[XB_TMO], 1u); break; } }
    }
    nloc = mine > 0u ? mine : 1u; nx = cnt > 0u ? cnt : 1u;
}

__device__ __forceinline__ void xcd_barrier(const XcdBarrier& b) {
    asm volatile("s_waitcnt vmcnt(0)" ::: "memory");
    __syncthreads();
    if (threadIdx.x == 0) {
        unsigned* bar = b.bar;
        __builtin_amdgcn_s_waitcnt(0);
        unsigned nloc = b.st[0], nx = b.st[1];
        if (nloc == 0u) { xcd_barrier_complete(bar, b.x, nloc, nx); b.st[0] = nloc; b.st[1] = nx; }
        const unsigned old = xb_add(&bar[XB_XSUB(b.x)], 1u);
        const unsigned gen = old / nloc;
        if (old + 1u == (gen + 1u) * nloc) {
            __builtin_amdgcn_fence(__ATOMIC_RELEASE, "agent");
            asm volatile("s_waitcnt vmcnt(0)" ::: "memory");
            const unsigned og = xb_add(&bar[XB_TOP], 1u);
            const unsigned tg = og / nx;
            if (og + 1u == (tg + 1u) * nx) xb_add(&bar[XB_TOPGEN], 1u);
            else XB_SPIN(xb_ld(&bar[XB_TOPGEN]) == tg, bar);
            __builtin_amdgcn_fence(__ATOMIC_ACQUIRE, "agent");
            xb_add(&bar[XB_XGEN(b.x)], 1u);
            asm volatile("s_waitcnt vmcnt(0)" ::: "memory");
        } else {
            XB_SPIN(xb_ld(&bar[XB_XGEN(b.x)]) == gen, bar);
            __builtin_amdgcn_fence(__ATOMIC_ACQUIRE, "agent");
            asm volatile("s_waitcnt vmcnt(0)" ::: "memory");
        }
    }
    __syncthreads();
}
struct Frame {
    LAS unsigned char* lds;
    volatile LAS unsigned* MISC;
    gu32* ctl;
    int tid, lane, wave;
    int vcu, G;
    unsigned char* ws;
    __amdgpu_buffer_rsrc_t rsrc;
};

#define PHASE_FRAME(F0) Frame F = (F0); { int t_ = threadIdx.x; asm volatile("" : "+v"(t_)); F.tid = t_; F.lane = t_ & 63; F.wave = __builtin_amdgcn_readfirstlane(t_ >> 6); }

__device__ __forceinline__ void tr_item(const float* W, size_t ldw, int k0, int c0, bf16* WT, size_t ldt, int drow0, LAS float* scr, int lane) {
    const int kr = lane >> 4, cq = lane & 15;
    f32x4 v[16];
#pragma unroll
    for (int i = 0; i < 16; ++i) v[i] = *(const GAS f32x4*)(W + (size_t)(k0 + 4 * i + kr) * ldw + c0 + 4 * cq);
#pragma unroll
    for (int i = 0; i < 16; ++i)
#pragma unroll
        for (int j = 0; j < 4; ++j) scr[(4 * cq + j) * 65 + 4 * i + kr] = v[i][j];
    LDS_WAIT(); asm volatile("" ::: "memory");
    const int c = lane & 7;
#pragma unroll
    for (int jj = 0; jj < 8; ++jj) { const int n = (lane >> 3) + 8 * jj; const LAS float* s = scr + n * 65 + 8 * c;
        v4u o; o.x = pk2(s[0], s[1]); o.y = pk2(s[2], s[3]); o.z = pk2(s[4], s[5]); o.w = pk2(s[6], s[7]);
        *(GAS v4u*)(WT + (size_t)(drow0 + n) * ldt + k0 + 8 * c) = o; }
    LDS_WAIT(); asm volatile("" ::: "memory");
}

typedef short s16x2 __attribute__((ext_vector_type(2)));
struct MoeItem { __amdgpu_buffer_rsrc_t rs; unsigned soff, rstep; int ldw, k0; unsigned char* WT; size_t ldt; int drow; };
__device__ __forceinline__ void tr8_load(const MoeItem& m, f32x4 (&v)[16], int lane) {
    const int kr = lane >> 4, cq = lane & 15;
    const int voff = (kr * m.ldw + 4 * cq) * 4;
#pragma unroll
    for (int i = 0; i < 16; ++i) v[i] = __builtin_bit_cast(f32x4, __builtin_amdgcn_raw_buffer_load_b128(m.rs, voff, (int)(m.soff + (unsigned)i * m.rstep), 0));
}
__device__ __forceinline__ void tr8_finish(const f32x4 (&v)[16], const MoeItem& m, LAS float* scr_, int lane) {
    LAS unsigned char* scr = (LAS unsigned char*)scr_;
    const int kr = lane >> 4, cq = lane & 15;
#pragma unroll
    for (int j = 0; j < 4; ++j) { unsigned w[4];
#pragma unroll
        for (int q = 0; q < 4; ++q) { s16x2 t = {0, 0};
            t = __builtin_amdgcn_cvt_scalef32_pk_fp8_f32(t, v[4 * q][j], v[4 * q + 1][j], F8_CVT_SCALE, false);
            t = __builtin_amdgcn_cvt_scalef32_pk_fp8_f32(t, v[4 * q + 2][j], v[4 * q + 3][j], F8_CVT_SCALE, true);
            w[q] = __builtin_bit_cast(unsigned, t); }
        *(LAS v4u*)(scr + (4 * cq + j) * 80 + kr * 16) = (v4u){w[0], w[1], w[2], w[3]}; }
    LDS_WAIT(); asm volatile("" ::: "memory");
    const int qd = lane & 3;
#pragma unroll
    for (int ps = 0; ps < 4; ++ps) { const int n = (lane >> 2) + 16 * ps; const LAS unsigned char* s = scr + n * 80 + qd * 4;
        const unsigned d0 = *(const LAS unsigned*)(s), d1 = *(const LAS unsigned*)(s + 16), d2 = *(const LAS unsigned*)(s + 32), d3 = *(const LAS unsigned*)(s + 48);
        const unsigned t0 = __builtin_amdgcn_perm(d1, d0, 0x05010400u), t1 = __builtin_amdgcn_perm(d1, d0, 0x07030602u), t2 = __builtin_amdgcn_perm(d3, d2, 0x05010400u), t3 = __builtin_amdgcn_perm(d3, d2, 0x07030602u);
        const v4u o = (v4u){__builtin_amdgcn_perm(t2, t0, 0x05040100u), __builtin_amdgcn_perm(t2, t0, 0x07060302u), __builtin_amdgcn_perm(t3, t1, 0x05040100u), __builtin_amdgcn_perm(t3, t1, 0x07060302u)};
        *(GAS v4u*)(m.WT + (size_t)(m.drow + n) * m.ldt + m.k0 + 16 * qd) = o; }
    LDS_WAIT(); asm volatile("" ::: "memory");
}
constexpr int MOE_J4 = 32 * 32 * 64, MOE_J5 = 32 * 32 * 32, MOE_NITEMS = MOE_J4 + MOE_J5;
__device__ __forceinline__ MoeItem moe_item(int r, const float* w_gu, const float* w_down, unsigned char* ws) {
    MoeItem m;
    if (r < MOE_J4) { const int e = r / 2048, q = r % 2048, kb = q / 64, cb = q % 64, c0 = cb * 64; const int cc = c0 & 2047;
        m.rs = __builtin_amdgcn_make_buffer_rsrc((void*)w_gu, 0, 0xffffffff, 0x00020000); m.ldw = 2 * FF; m.k0 = kb * 64;
        m.soff = (unsigned)(((size_t)e * D * 2 * FF + (size_t)kb * 64 * (2 * FF) + c0) * 4); m.rstep = 4u * (2 * FF) * 4u;
        m.WT = ws + WS_WGUT + (size_t)e * 2 * FF * D; m.ldt = D; m.drow = (cc >> 7) * 256 + (c0 >= 2048 ? 128 : 0) + (cc & 127); }
    else { r -= MOE_J4; const int e = r / 1024, q = r % 1024, kb = q / 32, cb = q % 32;
        m.rs = __builtin_amdgcn_make_buffer_rsrc((void*)w_down, 0, 0xffffffff, 0x00020000); m.ldw = D; m.k0 = kb * 64;
        m.soff = (unsigned)(((size_t)e * FF * D + (size_t)kb * 64 * D + cb * 64) * 4); m.rstep = 4u * D * 4u;
        m.WT = ws + WS_WDNT + (size_t)e * D * FF; m.ldt = FF; m.drow = cb * 64; }
    return m;
}
__device__ __forceinline__ MoeItem f8_item(const float* W, int ldw, int k0, int c0, unsigned char* WT, size_t ldt, int drow) {
    MoeItem m; m.rs = __builtin_amdgcn_make_buffer_rsrc((void*)W, 0, 0xffffffff, 0x00020000); m.ldw = ldw; m.k0 = k0;
    m.soff = (unsigned)(((size_t)k0 * ldw + c0) * 4); m.rstep = 4u * (unsigned)ldw * 4u; m.WT = WT; m.ldt = ldt; m.drow = drow; return m;
}

struct In {
    const float *x, *w_in, *rel_bias, *shift_mu, *w0, *w_up, *a0, *a_up, *g_up, *k_k, *k_a, *r_k, *lnx_w, *lnx_b, *proj_a, *proj_b, *w_out,
                *ln1_w, *ln1_b, *w_router, *b_router, *w_gu, *b_gu, *w_down, *b_down, *ln2_w, *ln2_b;
};

__device__ __forceinline__ void p0_prologue(Frame& F0, const In& I) {
    PHASE_FRAME(F0);
    LAS float* scr = (LAS float*)(F.lds + F.wave * 16640);
    const int gw = F.vcu * NWAVES + F.wave, NGW = F.G * NWAVES;
    unsigned char* ws = F.ws;
    constexpr int J0 = 32 * 167, J1 = 16 * 32, J2 = 16 * 32, J3 = 32 * 32;
    constexpr int NITEMS = J0 + J1 + J2 + J3;
    for (int it = gw; it < NITEMS; it += NGW) {
        int r = it;
        if (r < J0) { const int kb = r / 167, cb = r % 167, c0 = cb * 64; bf16* dst; int drow;
            if (c0 < 3072) { f32x4 tv[16];
                   const MoeItem m = (c0 < 2048) ? f8_item(I.w_in, D_IN, kb * 64, c0, (unsigned char*)(ws + WS_WQK8), D, c0) : f8_item(I.w_in, D_IN, kb * 64, c0, (unsigned char*)(ws + WS_WV8), D, c0 - 2048);
                   tr8_load(m, tv, F.lane); tr8_finish(tv, m, scr, F.lane); continue; }
            else if (c0 < 6592) { f32x4 tv[16]; const MoeItem m = f8_item(I.w_in, D_IN, kb * 64, c0, (unsigned char*)(ws + WS_WSV8), D, c0 - 3072);
                   tr8_load(m, tv, F.lane); tr8_finish(tv, m, scr, F.lane); continue; }
            else { f32x4 tv[16]; const int cg = c0 - 6592, d0 = cg & 2047; const MoeItem m = f8_item(I.w_in, D_IN, kb * 64, c0, (unsigned char*)(ws + WS_WG8), D, (d0 >> 7) * 256 + (cg >= 2048 ? 128 : 0) + (d0 & 127));
                   tr8_load(m, tv, F.lane); tr8_finish(tv, m, scr, F.lane); continue; }
            (void)dst; (void)drow; continue; } r -= J0;
        if (r < J1) { const int kb = r / 32, cb = r % 32; f32x4 tv[16]; const MoeItem m = f8_item(I.proj_a, D, kb * 64, cb * 64, (unsigned char*)(ws + WS_PAT), AW, cb * 64); tr8_load(m, tv, F.lane); tr8_finish(tv, m, scr, F.lane); continue; } r -= J1;
        if (r < J2) { const int kb = r / 32, cb = r % 32; f32x4 tv[16]; const MoeItem m = f8_item(I.proj_b, D, kb * 64, cb * 64, (unsigned char*)(ws + WS_PBT), RW, cb * 64); tr8_load(m, tv, F.lane); tr8_finish(tv, m, scr, F.lane); continue; } r -= J2;
        { const int kb = r / 32, cb = r % 32; f32x4 tv[16]; const MoeItem m = f8_item(I.w_out, D, kb * 64, cb * 64, (unsigned char*)(ws + WS_WOT), D, cb * 64);
          tr8_load(m, tv, F.lane); tr8_finish(tv, m, scr, F.lane); }
    }
    const int gt = F.vcu * (NWAVES * 64) + F.tid, NGT = F.G * NWAVES * 64;
    for (int i = gt; i < 2048 * 256; i += NGT) { const int n = i >> 8, k = i & 255; float v = 0.f;
        if (n < 1024) { if (k < DLORA) v = I.w_up[(size_t)k * RW + n]; }
        else { if (k >= 128 && k < 128 + ALORA) v = I.a_up[(size_t)(k - 128) * RW + (n - 1024)]; }
        ((bf16*)(ws + WS_WLA))[i] = (bf16)f2bf(v); }
    for (int i = gt; i < 1024 * 256; i += NGT) { const int n = i >> 8, k = i & 255; ((bf16*)(ws + WS_WLG))[i] = (bf16)f2bf(I.g_up[(size_t)k * RW + n]); }
    for (int i = gt; i < 64 * D / 16; i += NGT) ((GAS v4u*)((unsigned char*)(ws + WS_WSV8) + (size_t)SHIFT_W * D))[i] = (v4u){0u, 0u, 0u, 0u};
    for (int i = gt; i < RROWS; i += NGT) ((int*)(ws + WS_ROWSLOT))[i] = -1;
    for (size_t i = gt; i < (size_t)T * D / 8; i += NGT) { const f32x4 a = ((const GAS f32x4*)I.x)[2 * i], b = ((const GAS f32x4*)I.x)[2 * i + 1];
        int w0 = __builtin_amdgcn_cvt_pk_fp8_f32(a.x, a.y, 0, false); w0 = __builtin_amdgcn_cvt_pk_fp8_f32(a.z, a.w, w0, true);
        int w1 = __builtin_amdgcn_cvt_pk_fp8_f32(b.x, b.y, 0, false); w1 = __builtin_amdgcn_cvt_pk_fp8_f32(b.z, b.w, w1, true);
        ((GAS v2u*)(ws + WS_XB8))[i] = (v2u){(unsigned)w0, (unsigned)w1}; }
}

constexpr int P8_HS = 0, P8_PITCH = 2052, P8_PART = 131328, P8_LOG = 147712, P8_HIST = 149760;
template <bool SKIP_MIX>
__device__ __forceinline__ void p8_ln_router(Frame& F0, const In& I) {
    PHASE_FRAME(F0);
    LAS float* hs = (LAS float*)(F.lds + P8_HS); LAS float* part = (LAS float*)(F.lds + P8_PART); LAS float* lg = (LAS float*)(F.lds + P8_LOG); LAS int* hist = (LAS int*)(F.lds + P8_HIST);
    const int lane = F.lane, w = F.wave;
    if (F.tid < 32) hist[F.tid] = 0;
    const int kq = lane >> 4, col = lane & 15;
    float ln_w[32], ln_b[32];
#pragma unroll
    for (int j = 0; j < 8; ++j) { const f32x4 a = *(const GAS f32x4*)(I.ln1_w + 4 * lane + 256 * j), b = *(const GAS f32x4*)(I.ln1_b + 4 * lane + 256 * j);
#pragma unroll
        for (int e = 0; e < 4; ++e) { ln_w[4 * j + e] = a[e]; ln_b[4 * j + e] = b[e]; } }
    __syncthreads();
    const float* zsrc = I.x; const bf16* mixb = (const bf16*)(F.ws + WS_Z);
    for (int g = F.vcu; g < T / 16; g += F.G) {
        const int tok0 = g * 16;
        { f32x4 va[8], vb[8];
          const size_t tokA = (size_t)(tok0 + 2 * w), tokB = tokA + 1;
          const GAS f32x4* zra = (const GAS f32x4*)(zsrc + tokA * D) + lane; const GAS f32x4* zrb = (const GAS f32x4*)(zsrc + tokB * D) + lane;
          const GAS v2u* mra = (const GAS v2u*)(mixb + tokA * D) + lane; const GAS v2u* mrb = (const GAS v2u*)(mixb + tokB * D) + lane;
          v2u ma[8], mb[8];
#pragma unroll
          for (int j = 0; j < 8; ++j) { va[j] = zra[64 * j]; vb[j] = zrb[64 * j]; if (!SKIP_MIX) { ma[j] = mra[64 * j]; mb[j] = mrb[64 * j]; } }
#pragma unroll
          for (int j = 0; j < 8; ++j) { va[j] = va[j] * DN_ALPHA; vb[j] = vb[j] * DN_ALPHA;
              if (!SKIP_MIX) { va[j] += (f32x4){bflo(ma[j].x), bfhi(ma[j].x), bflo(ma[j].y), bfhi(ma[j].y)}; vb[j] += (f32x4){bflo(mb[j].x), bfhi(mb[j].x), bflo(mb[j].y), bfhi(mb[j].y)}; } }
#pragma unroll
          for (int tt = 0; tt < 2; ++tt) {
            const int tl = 2 * w + tt; const size_t tok = (size_t)(tok0 + tl);
            f32x4 v[8]; float s = 0.f;
#pragma unroll
            for (int j = 0; j < 8; ++j) { v[j] = tt ? vb[j] : va[j]; s += (v[j].x + v[j].y) + (v[j].z + v[j].w); }
            const float mean = wave_sum(s) * (1.f / D); float s2 = 0.f;
#pragma unroll
            for (int j = 0; j < 8; ++j) { v[j] = v[j] - mean; s2 += (v[j].x * v[j].x + v[j].y * v[j].y) + (v[j].z * v[j].z + v[j].w * v[j].w); }
            const float rstd = 1.f / sqrtf(wave_sum(s2) * (1.f / D) + LN_EPS);
            GAS v2u* h1 = (GAS v2u*)((bf16*)(F.ws + WS_H1) + tok * D) + lane;
            GAS unsigned* h1b = (GAS unsigned*)((unsigned char*)(F.ws + WS_H1B) + tok * D) + lane;
#pragma unroll
            for (int j = 0; j < 8; ++j) { f32x4 h;
#pragma unroll
                for (int e = 0; e < 4; ++e) h[e] = v[j][e] * rstd * ln_w[4 * j + e] + ln_b[4 * j + e];
                h1[64 * j] = (v2u){pg8::cvt_pk_bf16(h.x, h.y), pg8::cvt_pk_bf16(h.z, h.w)}; { int w8 = __builtin_amdgcn_cvt_pk_fp8_f32(h.x, h.y, 0, false); w8 = __builtin_amdgcn_cvt_pk_fp8_f32(h.z, h.w, w8, true); h1b[64 * j] = (unsigned)w8; }
                *(LAS f32x4*)(hs + tl * P8_PITCH + 4 * lane + 256 * j) = h; }
          } }
        __syncthreads();
        f32x4 c0 = (f32x4){0.f, 0.f, 0.f, 0.f}, c1 = c0;
        const LAS float* ap = hs + col * P8_PITCH + 256 * w + 4 * kq;
        const float* bp = I.w_router + (size_t)(256 * w + 4 * kq) * NE + col;
#pragma unroll 4
        for (int kk = 0; kk < 16; ++kk) {
            const f32x4 a = *(const LAS f32x4*)(ap + 16 * kk);
#pragma unroll
            for (int e = 0; e < 4; ++e) {
                const float b0 = bp[(size_t)(16 * kk + e) * NE], b1 = bp[(size_t)(16 * kk + e) * NE + 16];
                c0 = __builtin_amdgcn_mfma_f32_16x16x4f32(a[e], b0, c0, 0, 0, 0);
                c1 = __builtin_amdgcn_mfma_f32_16x16x4f32(a[e], b1, c1, 0, 0, 0);
            }
        }
#pragma unroll
        for (int i = 0; i < 4; ++i) { part[(w * 16 + 4 * kq + i) * 32 + col] = c0[i]; part[(w * 16 + 4 * kq + i) * 32 + 16 + col] = c1[i]; }
        __syncthreads();
        { const int tl = F.tid >> 5, e = F.tid & 31; float s = I.b_router[e];
#pragma unroll
            for (int ww = 0; ww < 8; ++ww) s += part[(ww * 16 + tl) * 32 + e];
            lg[tl * 32 + e] = s; }
        __syncthreads();
        if (F.tid < 16) {
            const int tl = F.tid; float lv[32];
#pragma unroll
            for (int e = 0; e < 32; ++e) lv[e] = lg[tl * 32 + e];
            int ti[4]; float tv[4];
#pragma unroll
            for (int k = 0; k < 4; ++k) { float best = -3.4e38f; int bi = 0;
#pragma unroll
                for (int e = 0; e < 32; ++e) { const bool tk = lv[e] > best; best = tk ? lv[e] : best; bi = tk ? e : bi; }
                ti[k] = bi; tv[k] = best;
#pragma unroll
                for (int e = 0; e < 32; ++e) lv[e] = (e == bi) ? -3.4e38f : lv[e]; }
            float ex[4], sum = 0.f;
#pragma unroll
            for (int k = 0; k < 4; ++k) { ex[k] = __expf(tv[k] - tv[0]); sum += ex[k]; }
            const float inv = 1.f / sum;
            *(GAS v4u*)((int*)(F.ws + WS_TOPI) + (size_t)(tok0 + tl) * 4) = (v4u){(unsigned)ti[0], (unsigned)ti[1], (unsigned)ti[2], (unsigned)ti[3]};
            *(GAS f32x4*)((float*)(F.ws + WS_GATE) + (size_t)(tok0 + tl) * 4) = (f32x4){ex[0] * inv, ex[1] * inv, ex[2] * inv, ex[3] * inv};
#pragma unroll
            for (int k = 0; k < 4; ++k) __hip_atomic_fetch_add(&hist[ti[k]], 1, __ATOMIC_RELAXED, __HIP_MEMORY_SCOPE_WORKGROUP);
        }
        __syncthreads();
    }
    if (F.tid < 32) { const int c = hist[F.tid]; if (c) __hip_atomic_fetch_add(F.ctl + CW_CNT + F.tid, (unsigned)c, RLX_AGENT); }
}

template <bool SKIP_MOE>
__device__ __forceinline__ void p12_final(Frame& F0, const In& I, float* out) {
    PHASE_FRAME(F0);
    const int lane = F.lane; const int gw = F.vcu * NWAVES + F.wave, NGW = F.G * NWAVES;
    LAS f32x4* lnp = (LAS f32x4*)(F.lds);
    for (int u = F.tid; u < D / 4; u += NWAVES * 64) { lnp[u] = *(const GAS f32x4*)(I.ln2_w + 4 * u); lnp[D / 4 + u] = *(const GAS f32x4*)(I.ln2_b + 4 * u); }
    __syncthreads();
    v2u hraw[8]; unsigned yraw[4][8];
#define P12_LOAD(tok_) do { const unsigned hoff = (unsigned)(WS_H1 + (size_t)(tok_) * D * 2) + (unsigned)lane * 8u;        \
        _Pragma("unroll") for (int j = 0; j < 8; ++j) hraw[j] = *(const GAS v2u*)(F.ws + (size_t)(hoff + 512u * j)); \
        if (!SKIP_MOE) { const unsigned yoff = (unsigned)(WS_YSLOT + (size_t)(tok_) * 4 * D) + (unsigned)lane * 4u; \
            _Pragma("unroll") for (int k = 0; k < 4; ++k) { _Pragma("unroll") for (int j = 0; j < 8; ++j) yraw[k][j] = *(const GAS unsigned*)(F.ws + (size_t)(yoff + 2048u * k + 256u * j)); } } } while (0)
    if (gw < T) P12_LOAD(gw);
    for (int tok = gw; tok < T; tok += NGW) {
        f32x4 v[8]; float s = 0.f;
#pragma unroll
        for (int j = 0; j < 8; ++j) { const v2u hh = hraw[j]; v[j] = (f32x4){bflo(hh.x), bfhi(hh.x), bflo(hh.y), bfhi(hh.y)} * DN_ALPHA; }
        if (!SKIP_MOE) {
#pragma unroll
            for (int k = 0; k < 4; ++k) {
#pragma unroll
                for (int j = 0; j < 8; ++j) { const unsigned y = yraw[k][j]; const f32x2 lo = __builtin_amdgcn_cvt_pk_f32_fp8((int)y, false), hi = __builtin_amdgcn_cvt_pk_f32_fp8((int)y, true);
                    v[j].x += lo.x * YS_INV; v[j].y += lo.y * YS_INV; v[j].z += hi.x * YS_INV; v[j].w += hi.y * YS_INV; } }
        }
        __builtin_amdgcn_sched_barrier(0);
        if (tok + NGW < T) P12_LOAD(tok + NGW);
        __builtin_amdgcn_sched_barrier(0);
#pragma unroll
        for (int j = 0; j < 8; ++j) s += (v[j].x + v[j].y) + (v[j].z + v[j].w);
        const float mean = wave_sum(s) * (1.f / D); float s2 = 0.f;
#pragma unroll
        for (int j = 0; j < 8; ++j) { v[j] = v[j] - mean; s2 += (v[j].x * v[j].x + v[j].y * v[j].y) + (v[j].z * v[j].z + v[j].w * v[j].w); }
        const float rstd = 1.f / sqrtf(wave_sum(s2) * (1.f / D) + LN_EPS);
        GAS f32x4* o = (GAS f32x4*)(out + (size_t)tok * D) + lane;
#pragma unroll
        for (int j = 0; j < 8; ++j) { f32x4 h;
            const f32x4 lw = lnp[lane + 64 * j], lb = lnp[D / 4 + lane + 64 * j];
#pragma unroll
            for (int e = 0; e < 4; ++e) h[e] = v[j][e] * rstd * lw[e] + lb[e];
            o[64 * j] = h; }
    }
#undef P12_LOAD
}
__device__ __forceinline__ void moe_tables(Frame& F) {
    LAS int* tab = (LAS int*)(F.lds + TAB_OFF);
    if (F.tid == 0) { int run = 0;
        for (int e = 0; e < NE; ++e) { const int c = (int)__hip_atomic_load(F.ctl + CW_CNT + e, RLX_AGENT); const int p = (c + 255) / 256 * 256; tab[32 + e] = run; run += p; tab[e] = run; }
        tab[64] = run / 256; }
    __syncthreads();
}

__device__ __forceinline__ void p9_scatter(Frame& F0, const In& I) {
    PHASE_FRAME(F0);
    moe_tables(F);
    LAS int* tab = (LAS int*)(F.lds + TAB_OFF);
    LAS int* lh = (LAS int*)(F.lds + 0);
    LAS int* lb = (LAS int*)(F.lds + 128);
    LAS int* dst = (LAS int*)(F.lds + 256);
    const int* topi = (const int*)(F.ws + WS_TOPI); const float* gate = (const float*)(F.ws + WS_GATE);
    for (int ch = F.vcu; ch < T / 128; ch += F.G) {
        if (F.tid < 32) lh[F.tid] = 0;
        __syncthreads();
        const int s = ch * 512 + F.tid; const int e = topi[s]; const float gv = gate[s];
        const int rank = __hip_atomic_fetch_add(&lh[e], 1, __ATOMIC_RELAXED, __HIP_MEMORY_SCOPE_WORKGROUP);
        __syncthreads();
        if (F.tid < 32) { const int c = lh[F.tid]; lb[F.tid] = c ? (int)__hip_atomic_fetch_add(F.ctl + CW_CUR + F.tid, (unsigned)c, RLX_AGENT) : 0; }
        __syncthreads();
        const int d = tab[32 + e] + lb[e] + rank;
        ((int*)(F.ws + WS_ROWSLOT))[d] = s; ((float*)(F.ws + WS_ROWW))[d] = gv; dst[F.tid] = d;
        __syncthreads();
#pragma unroll 1
        for (int i0 = F.wave * 64; i0 < F.wave * 64 + 64; i0 += 8) {
            v4u v[8][2]; int dd[8];
#pragma unroll
            for (int q = 0; q < 8; ++q) { const int i = i0 + q; const int tok = ch * 128 + (i >> 2); dd[q] = dst[i];
                const GAS v4u* src = (const GAS v4u*)((const unsigned char*)(F.ws + WS_H1B) + (size_t)tok * D) + F.lane;
                v[q][0] = src[0]; v[q][1] = src[64]; }
#pragma unroll
            for (int q = 0; q < 8; ++q) { GAS v4u* o = (GAS v4u*)((unsigned char*)(F.ws + WS_XG) + (size_t)dd[q] * D) + F.lane; o[0] = v[q][0]; o[64] = v[q][1]; }
        }
        __syncthreads();
    }
}

__device__ __forceinline__ void p10_moe_up(Frame& F0, const In& I) {
    PHASE_FRAME(F0);
    moe_tables(F);
    LAS int* tab = (LAS int*)(F.lds + TAB_OFF);
    pg8::SchedMoe S; S.t.init(tab[64], 16, F.G, (int)blockIdx.x);
    S.A = (unsigned)(WS_XG); S.B = (unsigned)(WS_WGUT); S.tsA = (unsigned)256 * D; S.tsB = (unsigned)256 * D; S.es = (unsigned)2 * FF * D; S.pad_end = tab;
    pg8::EpiSwiglu E{(unsigned char*)(F.ws + WS_ACT), I.b_gu};
    pg8::gemm_phase<pg8::EpiSwiglu, pg8::SchedMoe, true, true>(F.lds + RING_OFF, F.rsrc, D / 2, D / 2, D / 2, S, E);
}
__device__ __forceinline__ void p11_moe_down(Frame& F0, const In& I) {
    PHASE_FRAME(F0);
    moe_tables(F);
    LAS int* tab = (LAS int*)(F.lds + TAB_OFF);
    pg8::SchedMoe S; S.t.init(tab[64], 8, F.G, (int)blockIdx.x);
    S.A = (unsigned)(WS_ACT); S.B = (unsigned)(WS_WDNT); S.tsA = (unsigned)256 * FF; S.tsB = (unsigned)256 * FF; S.es = (unsigned)D * FF; S.pad_end = tab;
    pg8::EpiDown E{(unsigned char*)(F.ws + WS_YSLOT), I.b_down, (const int*)(F.ws + WS_ROWSLOT), (const float*)(F.ws + WS_ROWW)};
    pg8::gemm_phase<pg8::EpiDown, pg8::SchedMoe, true, true>(F.lds + RING_OFF, F.rsrc, FF / 2, FF / 2, FF / 2, S, E);
}

__device__ __forceinline__ void p1_proj(Frame& F0, const In& I) {
    PHASE_FRAME(F0);
    { pg8::SchedPlain S; S.t.init(T / 256, SEG_PAD / 256, F.G, (int)blockIdx.x);
      S.A = (unsigned)(WS_XB8); S.B = (unsigned)(WS_WSV8); S.tsA = (unsigned)256 * D; S.tsB = (unsigned)256 * D;
      pg8::EpiShift E{(bf16*)(F.ws + WS_RKV), (bf16*)(F.ws + WS_LORAIN), (float*)(F.ws + WS_SIDE0), (float*)(F.ws + WS_SIDEL), I.shift_mu};
      pg8::gemm_phase<pg8::EpiShift, pg8::SchedPlain, true, true>(F.lds + RING_OFF, F.rsrc, D / 2, D / 2, D / 2, S, E); }
    { pg8::SchedPlain S; S.t.init(T / 256, (2 * AW) / 256, F.G, (int)blockIdx.x);
      S.A = (unsigned)(WS_XB8); S.B = (unsigned)(WS_WQK8); S.tsA = (unsigned)256 * D; S.tsB = (unsigned)256 * D;
      pg8::EpiProj E{(bf16*)(F.ws + WS_PROJ), 0, 4};
      pg8::gemm_phase<pg8::EpiProj, pg8::SchedPlain, true, true>(F.lds + RING_OFF, F.rsrc, D / 2, D / 2, D / 2, S, E); }
    { pg8::SchedPlain S; S.t.init(T / 256, (2 * D) / 256, F.G, (int)blockIdx.x);
      S.A = (unsigned)(WS_XB8); S.B = (unsigned)(WS_WG8); S.tsA = (unsigned)256 * D; S.tsB = (unsigned)256 * D;
      pg8::EpiGate E{(bf16*)(F.ws + WS_GATEF)};
      pg8::gemm_phase<pg8::EpiGate, pg8::SchedPlain, true, true>(F.lds + RING_OFF, F.rsrc, D / 2, D / 2, D / 2, S, E); }
    { pg8::SchedPlain S; S.t.init(AW / 256, T / 256, F.G, (int)blockIdx.x);
      S.A = (unsigned)(WS_WV8); S.B = (unsigned)(WS_XB8); S.tsA = (unsigned)256 * D; S.tsB = (unsigned)256 * D;
      pg8::EpiBf16 E{(bf16*)(F.ws + WS_VT), T};
      pg8::gemm_phase<pg8::EpiBf16, pg8::SchedPlain, true, true>(F.lds + RING_OFF, F.rsrc, D / 2, D / 2, D / 2, S, E); }
}

__device__ __forceinline__ float ftanh(float x) { return 2.0f * fsigmoid(2.0f * x) - 1.0f; }
__device__ __forceinline__ void p2_shift_attn(Frame& F0, const In& I) {
    PHASE_FRAME(F0);
    const int lane = F.lane; const int gw = F.vcu * NWAVES + F.wave, NGW = F.G * NWAVES;
    const bf16* PROJ = (const bf16*)(F.ws + WS_PROJ);
    for (int g = gw; g < T / 64; g += NGW) {
        const int tok = g * 64; const bool first = (tok % SEQ) == 0;
        const float* cur = (const float*)(F.ws + WS_SIDE0) + (size_t)g * SEG_PAD; const float* prv = (const float*)(F.ws + WS_SIDEL) + (size_t)(g - 1) * SEG_PAD;
        bf16* rkv = (bf16*)(F.ws + WS_RKV) + (size_t)tok * (3 * RW); bf16* lin = (bf16*)(F.ws + WS_LORAIN) + (size_t)tok * LORA_LD;
#pragma unroll 1
        for (int it = 0; it < 7; ++it) { const int gi = it * 64 + lane; if (gi >= SHIFT_W / 8) break; const int c = gi * 8;
            const f32x4 c0 = *(const GAS f32x4*)(cur + c), c1 = *(const GAS f32x4*)(cur + c + 4);
            f32x4 p0 = (f32x4){0.f, 0.f, 0.f, 0.f}, p1 = p0; if (!first) { p0 = *(const GAS f32x4*)(prv + c); p1 = *(const GAS f32x4*)(prv + c + 4); }
            const f32x4 m0 = *(const GAS f32x4*)(I.shift_mu + c), m1 = *(const GAS f32x4*)(I.shift_mu + c + 4);
            float v[8];
#pragma unroll
            for (int j = 0; j < 4; ++j) { v[j] = c0[j] + (p0[j] - c0[j]) * m0[j]; v[4 + j] = c1[j] + (p1[j] - c1[j]) * m1[j]; }
            bf16* dstp;
            if (c < 3 * RW) dstp = rkv + c;
            else if (c < 3 * RW + DLORA) { dstp = lin + (c - 3 * RW);
#pragma unroll
                for (int j = 0; j < 8; ++j) v[j] = ftanh(v[j]); }
            else if (c < 3 * RW + DLORA + ALORA) dstp = lin + 128 + (c - 3 * RW - DLORA);
            else { dstp = lin + 256 + (c - 3 * RW - DLORA - ALORA);
#pragma unroll
                for (int j = 0; j < 8; ++j) v[j] = fsigmoid(v[j]); }
            *(GAS v4u*)dstp = (v4u){pk2(v[0], v[1]), pk2(v[2], v[3]), pk2(v[4], v[5]), pk2(v[6], v[7])};
        }
    }
#if STAGE == 3
    { const int gt = F.vcu * (NWAVES * 64) + F.tid, NGT = F.G * NWAVES * 64;
      for (size_t i = gt; i < (size_t)T * RW / 8; i += NGT) ((GAS v4u*)(F.ws + WS_YB))[i] = (v4u){0u, 0u, 0u, 0u}; }
#endif
    LAS float* tbl = (LAS float*)(F.lds + 0);
    constexpr int AKV = 64 * 144, A_KOFF = 2048, A_VOFF = A_KOFF + 2 * AKV;
    const bf16* VT = (const bf16*)(F.ws + WS_VT); bf16* YA = (bf16*)(F.ws + WS_YA);
    const int r = lane & 31, hh = lane >> 5;
    const int rp = (r & 16) + 8 * ((r >> 2) & 1) + 4 * ((r >> 3) & 1) + (r & 3);
    const int srow = F.tid >> 3, spc = F.tid & 7;
    for (int task = F.vcu; task < BATCH * AH * (SEQ / 256); task += F.G) {
        const int bh = task >> 5, q256 = task & 31, b = bh >> 4, h = bh & 15, c0 = q256 * 4;
        const int q0 = q256 * 256 + F.wave * 32, cw = c0 + (F.wave >> 1);
        const int kc_lo = (c0 > LEFT) ? c0 - LEFT : 0, kc_hi = c0 + 3;
        __syncthreads();
        if (F.tid < REL_TABLE) tbl[F.tid] = I.rel_bias[h * REL_TABLE + F.tid];
        const size_t tokq = (size_t)b * SEQ + q0 + r;
        bf16x8 qf[4];
#pragma unroll
        for (int s = 0; s < 4; ++s) qf[s] = *(const GAS bf16x8*)(PROJ + tokq * PROJ_LD + PJ_Q + h * 64 + 16 * s + 8 * hh);
        f32x16 o0, o1;
#pragma unroll
        for (int i = 0; i < 16; ++i) { o0[i] = 0.f; o1[i] = 0.f; }
        float m_run = -1e30f, l_run = 0.f;
        v4u kreg, vreg;
#define AT_STAGE_LOAD(kc_) do { kreg = *(const GAS v4u*)(PROJ + ((size_t)b * SEQ + (size_t)(kc_) * 64 + srow) * PROJ_LD + PJ_K + h * 64 + spc * 8); \
                                vreg = *(const GAS v4u*)(VT + (size_t)(h * 64 + srow) * T + (size_t)b * SEQ + (size_t)(kc_) * 64 + spc * 8); } while (0)
#define AT_STAGE_WRITE(buf_) do { *(LAS v4u*)(F.lds + A_KOFF + (buf_) * AKV + srow * 144 + spc * 16) = kreg; *(LAS v4u*)(F.lds + A_VOFF + (buf_) * AKV + srow * 144 + spc * 16) = vreg; } while (0)
        AT_STAGE_LOAD(kc_lo); AT_STAGE_WRITE(0);
        __syncthreads();
#pragma unroll 1
        for (int kc = kc_lo; kc <= kc_hi; ++kc) {
            const int buf = (kc - kc_lo) & 1;
            if (kc < kc_hi) AT_STAGE_LOAD(kc + 1);
            if (kc >= cw - LEFT && kc <= cw) {
                const LAS unsigned char* Kb = F.lds + A_KOFF + buf * AKV; const LAS unsigned char* Vb = F.lds + A_VOFF + buf * AKV;
#pragma unroll
                for (int tt = 0; tt < 2; ++tt) {
                    const int kpos0 = kc * 64 + 32 * tt;
                    bf16x8 kf[4], va[2], vb[2];
#pragma unroll
                    for (int s = 0; s < 4; ++s) kf[s] = *(const LAS bf16x8*)(Kb + (32 * tt + rp) * 144 + 32 * s + 16 * hh);
#pragma unroll
                    for (int s2 = 0; s2 < 2; ++s2) { va[s2] = *(const LAS bf16x8*)(Vb + r * 144 + 64 * tt + 32 * s2 + 16 * hh); vb[s2] = *(const LAS bf16x8*)(Vb + (32 + r) * 144 + 64 * tt + 32 * s2 + 16 * hh); }
                    f32x16 st;
#pragma unroll
                    for (int i = 0; i < 16; ++i) st[i] = 0.f;
#pragma unroll
                    for (int s = 0; s < 4; ++s) st = __builtin_amdgcn_mfma_f32_32x32x16_bf16(kf[s], qf[s], st, 0, 0, 0);
                    const int dbase = (q0 + r) - (kpos0 + 8 * hh);
                    float mx = -1e30f;
                    if (q0 - (kpos0 + 31) >= MAX_PAST) {
                        const float bc = tbl[MAX_PAST + 63];
#pragma unroll
                        for (int i = 0; i < 16; ++i) { st[i] += bc; mx = fmaxf(mx, st[i]); }
                    } else {
#pragma unroll
                        for (int i = 0; i < 16; ++i) { int d = dbase - (16 * (i >> 3) + 4 * ((i >> 2) & 1) + (i & 3)); d = d < MAX_PAST ? d : MAX_PAST; st[i] += tbl[d + 63]; mx = fmaxf(mx, st[i]); }
                    }
                    mx = fmaxf(mx, __shfl_xor(mx, 32));
                    const float m_new = fmaxf(m_run, mx), alpha = __expf(m_run - m_new);
                    float ls = 0.f;
#pragma unroll
                    for (int i = 0; i < 16; ++i) { st[i] = __expf(st[i] - m_new); ls += st[i]; }
                    l_run = l_run * alpha + ls;
                    if (__builtin_amdgcn_ballot_w64(m_new != m_run)) {
#pragma unroll
                        for (int i = 0; i < 16; ++i) { o0[i] *= alpha; o1[i] *= alpha; } }
                    m_run = m_new;
#pragma unroll
                    for (int s2 = 0; s2 < 2; ++s2) {
                        v4u pw; pw.x = pg8::cvt_pk_bf16(st[8 * s2 + 0], st[8 * s2 + 1]); pw.y = pg8::cvt_pk_bf16(st[8 * s2 + 2], st[8 * s2 + 3]); pw.z = pg8::cvt_pk_bf16(st[8 * s2 + 4], st[8 * s2 + 5]); pw.w = pg8::cvt_pk_bf16(st[8 * s2 + 6], st[8 * s2 + 7]);
                        const bf16x8 pf = __builtin_bit_cast(bf16x8, pw);
                        o0 = __builtin_amdgcn_mfma_f32_32x32x16_bf16(va[s2], pf, o0, 0, 0, 0);
                        o1 = __builtin_amdgcn_mfma_f32_32x32x16_bf16(vb[s2], pf, o1, 0, 0, 0);
                    }
                }
            }
            if (kc < kc_hi) AT_STAGE_WRITE(buf ^ 1);
            __syncthreads();
        }
#undef AT_STAGE_LOAD
#undef AT_STAGE_WRITE
        const float inv = 1.0f / (l_run + __shfl_xor(l_run, 32));
        unsigned char* yo = (unsigned char*)YA + tokq * AW + h * 64 + 4 * hh;
        const float inv16 = inv * ACT8_SCALE;
#pragma unroll
        for (int g4 = 0; g4 < 4; ++g4) {
            int w0 = __builtin_amdgcn_cvt_pk_fp8_f32(o0[4 * g4] * inv16, o0[4 * g4 + 1] * inv16, 0, false); w0 = __builtin_amdgcn_cvt_pk_fp8_f32(o0[4 * g4 + 2] * inv16, o0[4 * g4 + 3] * inv16, w0, true);
            int w1 = __builtin_amdgcn_cvt_pk_fp8_f32(o1[4 * g4] * inv16, o1[4 * g4 + 1] * inv16, 0, false); w1 = __builtin_amdgcn_cvt_pk_fp8_f32(o1[4 * g4 + 2] * inv16, o1[4 * g4 + 3] * inv16, w1, true);
            *(GAS unsigned*)(yo + 8 * g4) = (unsigned)w0; *(GAS unsigned*)(yo + 32 + 8 * g4) = (unsigned)w1;
        }
    }
}

__device__ __forceinline__ void p6_merged(Frame& F0, const In& I) {
    PHASE_FRAME(F0);
    pg8::SchedTwo S; S.t.init(T / 256, D / 256, F.G, (int)blockIdx.x);
    S.A0 = (unsigned)(WS_YA); S.A1 = (unsigned)(WS_YB); S.B0 = (unsigned)(WS_PAT); S.B1 = (unsigned)(WS_PBT);
    S.tsA = (unsigned)256 * AW; S.tsB = (unsigned)256 * AW;
    pg8::EpiMerged E{(const bf16*)(F.ws + WS_GATEF), (bf16*)(F.ws + WS_MERGED)};
    pg8::gemm_phase<pg8::EpiMerged, pg8::SchedTwo, true, true, 0x00007b79>(F.lds + RING_OFF, F.rsrc, AW / 2, AW / 2, AW / 2, S, E);
}
__device__ __forceinline__ void p7_mix(Frame& F0, const In& I) {
    PHASE_FRAME(F0);
    pg8::SchedPlain S; S.t.init(T / 256, D / 256, F.G, (int)blockIdx.x);
    S.A = (unsigned)(WS_MERGED); S.B = (unsigned)(WS_WOT); S.tsA = (unsigned)256 * D; S.tsB = (unsigned)256 * D;
    pg8::EpiBf16 E{(bf16*)(F.ws + WS_Z), D};
    pg8::gemm_phase<pg8::EpiBf16, pg8::SchedPlain, true, true, 0x00007b79>(F.lds + RING_OFF, F.rsrc, D / 2, D / 2, D / 2, S, E);
}

__device__ __forceinline__ void p3_lora(Frame& F0, const In& I) {
    PHASE_FRAME(F0);
    { pg8::SchedPlain S; S.t.init(T / 256, 4, F.G, (int)blockIdx.x);
      S.A = (unsigned)(WS_LORAIN); S.B = (unsigned)(WS_WLA); S.tsA = (unsigned)256 * LORA_LD * 2; S.tsB = (unsigned)256 * 256 * 2;
      pg8::EpiLoraA<true> E{(float*)(F.ws + WS_DECAY), I.w0};
      pg8::gemm_phase<pg8::EpiLoraA<true>, pg8::SchedPlain, true>(F.lds + RING_OFF, F.rsrc, LORA_LD, 256, 256, S, E); }
    { pg8::SchedPlain S; S.t.init(T / 256, 4, F.G, (int)blockIdx.x);
      S.A = (unsigned)(WS_LORAIN); S.B = (unsigned)(WS_WLA + (size_t)1024 * 256 * 2); S.tsA = (unsigned)256 * LORA_LD * 2; S.tsB = (unsigned)256 * 256 * 2;
      pg8::EpiIclr E{(bf16*)(F.ws + WS_ICLR), I.a0};
      pg8::gemm_phase<pg8::EpiIclr, pg8::SchedPlain, true>(F.lds + RING_OFF, F.rsrc, LORA_LD, 256, 256, S, E); }
    { pg8::SchedPlain S; S.t.init(T / 256, 4, F.G, (int)blockIdx.x);
      S.A = (unsigned)(WS_LORAIN + 512); S.B = (unsigned)(WS_WLG); S.tsA = (unsigned)256 * LORA_LD * 2; S.tsB = (unsigned)256 * 256 * 2;
      pg8::EpiBf16 E{(bf16*)(F.ws + WS_G), RW};
      pg8::gemm_phase<pg8::EpiBf16, pg8::SchedPlain, true>(F.lds + RING_OFF, F.rsrc, LORA_LD, 256, 256, S, E); }
}

constexpr int CP = 144;
constexpr int CMAT = 64 * CP;
constexpr int C_RT = 0 * CMAT, C_ATT = 1 * CMAT, C_AAK = 2 * CMAT, C_ARKT = 3 * CMAT, C_WA = 4 * CMAT, C_WB = 6 * CMAT,
              C_MA = 8 * CMAT, C_MTA = 9 * CMAT, C_MB = 10 * CMAT, C_MTB = 11 * CMAT, C_SEG = 12 * CMAT, C_GAM = C_SEG + 8 * 64 * 4, C_TSCR = C_GAM + 256;
constexpr int C_AT = C_WB, C_BT = C_WB + CMAT, C_KT = C_MB, C_QYT = C_MA, C_QST = C_MTA, C_KHT = C_MTB, C_VT = C_WB;
static_assert(C_TSCR % 16 == 0 && C_TSCR + 8 * 5120 <= TAB_OFF, "P4a LDS map");
constexpr int CHK_UNIT_BYTES = 4 * 64 * 64 * 2;
#define CBAR() do { asm volatile("s_waitcnt lgkmcnt(0)" ::: "memory"); __builtin_amdgcn_s_barrier(); asm volatile("" ::: "memory"); } while (0)
template <int NT, class Epi>
__device__ __forceinline__ void cmm(const LAS unsigned char* X, const LAS unsigned char* Y, int mt0, int nt, int lane, const Epi& E) {
    const int lr = lane & 15, kq = lane >> 4;
    const bf16x8 b0 = *(const LAS bf16x8*)(Y + (nt * 16 + lr) * CP + kq * 16), b1 = *(const LAS bf16x8*)(Y + (nt * 16 + lr) * CP + kq * 16 + 64);
#pragma unroll
    for (int i = 0; i < NT; ++i) { const int mt = mt0 + i;
        const bf16x8 a0 = *(const LAS bf16x8*)(X + (mt * 16 + lr) * CP + kq * 16), a1 = *(const LAS bf16x8*)(X + (mt * 16 + lr) * CP + kq * 16 + 64);
        f32x4 acc = (f32x4){0.f, 0.f, 0.f, 0.f};
        acc = __builtin_amdgcn_mfma_f32_16x16x32_bf16(a0, b0, acc, 0, 0, 0);
        acc = __builtin_amdgcn_mfma_f32_16x16x32_bf16(a1, b1, acc, 0, 0, 0);
        E(mt, nt, acc); }
}
__device__ __forceinline__ v2u pack4(const f32x4& v) { return (v2u){pg8::cvt_pk_bf16(v[0], v[1]), pg8::cvt_pk_bf16(v[2], v[3])}; }
__device__ __forceinline__ f32x4 unpack4(const v2u w) { return (f32x4){bflo(w.x), bfhi(w.x), bflo(w.y), bfhi(w.y)}; }
__device__ __forceinline__ void p4a_chunk(Frame& F0, const In& I) {
    PHASE_FRAME(F0);
    LAS unsigned char* L = F.lds;
    const int lane = F.lane, w = F.wave, lr = lane & 15, kq = lane >> 4;
    const bf16* RKV = (const bf16*)(F.ws + WS_RKV); const float* LW = (const float*)(F.ws + WS_DECAY); const bf16* ICL = (const bf16*)(F.ws + WS_ICLR);
    unsigned char* CHK = F.ws + WS_CHK;
    int uit = 0;
    for (int unit = F.vcu; unit < BATCH * RH * (SEQ / 64); unit += F.G, ++uit) {
        const int bh = unit >> 7, ck = unit & 127, b = bh >> 4, h = bh & 15;
        const size_t tok0 = (size_t)b * SEQ + (size_t)ck * 64 + 8 * w;
        const int hc = h * 64 + lane;
        float lwv[8], ic[8], rr[8], kk[8], vv[8];
#pragma unroll
        for (int i = 0; i < 8; ++i) { const size_t tok = tok0 + i; lwv[i] = LW[tok * RW + hc]; ic[i] = bf2f(ICL[tok * RW + hc]);
            rr[i] = bf2f(RKV[tok * (3 * RW) + hc]); kk[i] = bf2f(RKV[tok * (3 * RW) + RW + hc]); vv[i] = bf2f(RKV[tok * (3 * RW) + 2 * RW + hc]); }
        const float kkp = I.k_k[hc], kap = I.k_a[hc];
        float cs[8]; { float run = 0.f;
#pragma unroll
            for (int i = 0; i < 8; ++i) { run += lwv[i]; cs[i] = run; } }
        __syncthreads();
        ((LAS float*)(L + C_SEG))[w * 64 + lane] = cs[7];
        CBAR();
        float pre = 0.f, tot = 0.f;
#pragma unroll
        for (int j = 0; j < 8; ++j) { const float sg = ((const LAS float*)(L + C_SEG))[j * 64 + lane]; tot += sg; pre += (j < w) ? sg : 0.f; }
        if (w == 0) ((LAS float*)(L + C_GAM))[lane] = __expf(tot);
        unsigned att[4], bht[4], kht[4], vtt[4];
        float at_[8], bh_[8], kh_[8]; const float gtot = __expf(tot); float ep_prev = 1.f;
#pragma unroll
        for (int i = 0; i < 8; ++i) { const int t = 8 * w + i; const float cum = pre + cs[i], cump = cum - lwv[i];
            const float kkv = kk[i] * kkp; const float n2 = wave_sum(kkv * kkv); const float kkn = kkv * __builtin_amdgcn_rsqf(fmaxf(n2, 1e-24f));
            const float a = -kkn, bb = kkn * ic[i], kp = kk[i] * (1.0f + (ic[i] - 1.0f) * kap);
            const float ep = __expf(cum), em = __builtin_amdgcn_rcpf(ep), epp = (i == 0) ? __expf(cump) : ep_prev, eL = gtot * em; ep_prev = ep;
            const float Rv = rr[i] * ep, Av = a * epp, Bv = bb * em, Kv = kp * em;
            at_[i] = Av; bh_[i] = bb * eL; kh_[i] = kp * eL;
            *(LAS unsigned short*)(L + C_RT + t * CP + lane * 2) = (unsigned short)f2bf(Rv);
            *(LAS unsigned short*)(L + C_AT + t * CP + lane * 2) = (unsigned short)f2bf(Av);
            *(LAS unsigned short*)(L + C_BT + t * CP + lane * 2) = (unsigned short)f2bf(Bv);
            *(LAS unsigned short*)(L + C_KT + t * CP + lane * 2) = (unsigned short)f2bf(Kv); }
#pragma unroll
        for (int q = 0; q < 4; ++q) { att[q] = pk2(at_[2 * q], at_[2 * q + 1]); bht[q] = pk2(bh_[2 * q], bh_[2 * q + 1]); kht[q] = pk2(kh_[2 * q], kh_[2 * q + 1]); vtt[q] = pk2(vv[2 * q], vv[2 * q + 1]); }
        *(LAS v4u*)(L + C_ATT + lane * CP + 16 * w) = (v4u){att[0], att[1], att[2], att[3]};
        *(LAS v4u*)(L + C_WA + (64 + lane) * CP + 16 * w) = (v4u){bht[0], bht[1], bht[2], bht[3]};
        CBAR();
        const int cit = (uit * F.G + F.vcu) * 16 + w * 2; const bool hx = cit < MOE_NITEMS, hy = cit + 1 < MOE_NITEMS;
        f32x4 tX[16]; MoeItem mX = moe_item(hx ? cit : 0, I.w_gu, I.w_down, F.ws);
        LAS float* tscr = (LAS float*)(L + C_TSCR + w * 5120);
        struct Fr { bf16x8 a, b; };
        auto LD = [&](int base, int tile) -> Fr { const LAS unsigned char* q = L + base + (tile * 16 + lr) * CP + kq * 16; Fr f; f.a = *(const LAS bf16x8*)q; f.b = *(const LAS bf16x8*)(q + 64); return f; };
        auto MM = [&](const Fr& x, const Fr& y) -> f32x4 { f32x4 acc = (f32x4){0.f, 0.f, 0.f, 0.f};
            acc = __builtin_amdgcn_mfma_f32_16x16x32_bf16(x.a, y.a, acc, 0, 0, 0); acc = __builtin_amdgcn_mfma_f32_16x16x32_bf16(x.b, y.b, acc, 0, 0, 0); return acc; };
        const int nt = w & 3, mt0 = 2 * (w >> 2), n = nt * 16 + lr;
        { const Fr yAT = LD(C_AT, nt), yKT = LD(C_KT, nt), yRT = LD(C_RT, nt);
          Fr xBT[2], xAT[2], xKT[2];
#pragma unroll
          for (int i = 0; i < 2; ++i) { xBT[i] = LD(C_BT, mt0 + i); xAT[i] = LD(C_AT, mt0 + i); xKT[i] = LD(C_KT, mt0 + i); }
          f32x4 a1[2], a2[2], a3[2], a4[2];
#pragma unroll
          for (int i = 0; i < 2; ++i) { a1[i] = MM(xBT[i], yAT); a2[i] = MM(xAT[i], yKT); a3[i] = MM(xBT[i], yRT); a4[i] = MM(xKT[i], yRT); }
#pragma unroll
          for (int i = 0; i < 2; ++i) { const int m0 = (mt0 + i) * 16 + 4 * kq;
              f32x4 v = a1[i];
#pragma unroll
              for (int e = 0; e < 4; ++e) { v[e] = (m0 + e < n) ? v[e] : 0.f; *(LAS unsigned short*)(L + C_MA + (m0 + e) * CP + n * 2) = (unsigned short)f2bf(v[e]); }
              *(LAS v2u*)(L + C_MTA + n * CP + m0 * 2) = pack4(v);
              v = a2[i];
#pragma unroll
              for (int e = 0; e < 4; ++e) v[e] = (n < m0 + e) ? v[e] : 0.f;
              *(LAS v2u*)(L + C_AAK + n * CP + m0 * 2) = pack4(v);
              v = a3[i];
#pragma unroll
              for (int e = 0; e < 4; ++e) v[e] = (m0 + e <= n) ? v[e] : 0.f;
              *(LAS v2u*)(L + C_WA + n * CP + m0 * 2) = pack4(v);
              v = a4[i];
#pragma unroll
              for (int e = 0; e < 4; ++e) v[e] = (m0 + e <= n) ? v[e] : 0.f;
              *(LAS v2u*)(L + C_ARKT + n * CP + m0 * 2) = pack4(v); } }
        CBAR();
        if (hx) tr8_load(mX, tX, lane);
#pragma unroll
        for (int lvl = 0; lvl < 6; ++lvl) {
            const int Wsrc = (lvl & 1) ? C_WB : C_WA, Wdst = (lvl & 1) ? C_WA : C_WB, Ms = (lvl & 1) ? C_MB : C_MA, Mts = (lvl & 1) ? C_MTB : C_MTA, Md = (lvl & 1) ? C_MA : C_MB, Mtd = (lvl & 1) ? C_MTA : C_MTB;
            const Fr yW = LD(Wsrc, w); Fr yMt; if (lvl < 5) yMt = LD(Mts, nt);
            Fr xM[4], xS[2];
#pragma unroll
            for (int i = 0; i < 4; ++i) xM[i] = LD(Ms, i);
            if (lvl < 5) { xS[0] = LD(Ms, mt0); xS[1] = LD(Ms, mt0 + 1); }
            const int nj = w * 16 + lr;
            f32x4 old[4], aw[4], as[2];
#pragma unroll
            for (int i = 0; i < 4; ++i) old[i] = unpack4(*(const LAS v2u*)(L + Wsrc + nj * CP + (i * 16 + 4 * kq) * 2));
#pragma unroll
            for (int i = 0; i < 4; ++i) aw[i] = MM(xM[i], yW);
            if (lvl < 5) {
#pragma unroll
                for (int i = 0; i < 2; ++i) as[i] = MM(xS[i], yMt); }
#pragma unroll
            for (int i = 0; i < 4; ++i) *(LAS v2u*)(L + Wdst + nj * CP + (i * 16 + 4 * kq) * 2) = pack4(old[i] + aw[i]);
            if (lvl < 5) {
#pragma unroll
                for (int i = 0; i < 2; ++i) { const int m0 = (mt0 + i) * 16 + 4 * kq;
#pragma unroll
                    for (int e = 0; e < 4; ++e) *(LAS unsigned short*)(L + Md + (m0 + e) * CP + n * 2) = (unsigned short)f2bf(as[i][e]);
                    if (lvl < 4) *(LAS v2u*)(L + Mtd + n * CP + m0 * 2) = pack4(as[i]); } }
            if (lvl == 4) *(LAS v4u*)(L + C_KHT + lane * CP + 16 * w) = (v4u){kht[0], kht[1], kht[2], kht[3]};
            if (lvl == 2) { if (hx) tr8_finish(tX, mX, tscr, lane);
                            if (hy) { mX = moe_item(cit + 1, I.w_gu, I.w_down, F.ws); tr8_load(mX, tX, lane); } }
            CBAR();
        }
        *(LAS v4u*)(L + C_VT + lane * CP + 16 * w) = (v4u){vtt[0], vtt[1], vtt[2], vtt[3]};
        unsigned char* og = CHK + (size_t)unit * CHK_UNIT_BYTES;
        { const Fr yW1 = LD(C_WA, nt), yW2 = LD(C_WA + 64 * CP, nt);
          Fr xA[2], xK[2];
#pragma unroll
          for (int i = 0; i < 2; ++i) { xA[i] = LD(C_ATT, mt0 + i); xK[i] = LD(C_AAK, mt0 + i); }
          f32x4 rv[2], av[2], kv[2];
          const float gm = ((const LAS float*)(L + C_GAM))[n];
#pragma unroll
          for (int i = 0; i < 2; ++i) { const int m0 = (mt0 + i) * 16 + 4 * kq;
              rv[i] = unpack4(*(const LAS v2u*)(L + C_RT + n * CP + m0 * 2)); av[i] = unpack4(*(const LAS v2u*)(L + C_ARKT + n * CP + m0 * 2)); kv[i] = unpack4(*(const LAS v2u*)(L + C_KHT + n * CP + m0 * 2)); }
          f32x4 p7[2], p8[2], p9[2], p10[2];
#pragma unroll
          for (int i = 0; i < 2; ++i) { p7[i] = MM(xA[i], yW1); p8[i] = MM(xK[i], yW1); p9[i] = MM(xA[i], yW2); p10[i] = MM(xK[i], yW2); }
#pragma unroll
          for (int i = 0; i < 2; ++i) { const int m0 = (mt0 + i) * 16 + 4 * kq;
              *(GAS v2u*)(og + 0 * 8192 + n * 128 + m0 * 2) = pack4(p7[i] + rv[i]);
              *(LAS v2u*)(L + C_QYT + n * CP + m0 * 2) = pack4(p8[i] + av[i]);
              f32x4 v = p9[i];
#pragma unroll
              for (int e = 0; e < 4; ++e) v[e] += (m0 + e == n) ? gm : 0.f;
              *(GAS v2u*)(og + 1 * 8192 + n * 128 + m0 * 2) = pack4(v);
              *(LAS v2u*)(L + C_QST + n * CP + m0 * 2) = pack4(p10[i] + kv[i]); } }
        CBAR();
        { const Fr yQy = LD(C_QYT, nt), yQs = LD(C_QST, nt);
          Fr xV[2];
#pragma unroll
          for (int i = 0; i < 2; ++i) xV[i] = LD(C_VT, mt0 + i);
          f32x4 p11[2], p12[2];
#pragma unroll
          for (int i = 0; i < 2; ++i) { p11[i] = MM(xV[i], yQy); p12[i] = MM(xV[i], yQs); }
#pragma unroll
          for (int i = 0; i < 2; ++i) { const int m0 = (mt0 + i) * 16 + 4 * kq;
              *(GAS v2u*)(og + 2 * 8192 + n * 128 + m0 * 2) = pack4(p11[i]);
              *(GAS v2u*)(og + 3 * 8192 + n * 128 + m0 * 2) = pack4(p12[i]); } }
        if (hy) tr8_finish(tX, mX, tscr, lane);
    }
}

constexpr int C2_SLOT = 20480;
__device__ __forceinline__ void p4b_scan(Frame& F0, const In& I) {
    PHASE_FRAME(F0);
    const int lane = F.lane, lr = lane & 15, kq = lane >> 4;
    const unsigned char* CHK = F.ws + WS_CHK; bf16* YS = (bf16*)(F.ws + WS_YSCAN);
    for (int unit = F.vcu; unit < BATCH * RH * 4; unit += F.G) {
        const int bh = unit >> 2, rq = unit & 3, b = bh >> 4, h = bh & 15;
        if (F.wave == 0) {
            LAS unsigned char* Sl = F.lds + 3 * C2_SLOT;
            f32x4 S[4]; bf16x8 sf[2];
#pragma unroll
            for (int nt = 0; nt < 4; ++nt) S[nt] = (f32x4){0.f, 0.f, 0.f, 0.f};
#pragma unroll
            for (int ks = 0; ks < 2; ++ks)
#pragma unroll
                for (int j = 0; j < 8; ++j) sf[ks][j] = 0;
#define C2_DMA(ck_) do { const int ckc_ = (ck_) < SEQ / 64 ? (ck_) : SEQ / 64 - 1; const unsigned char* ug = CHK + ((size_t)bh * 128 + ckc_) * CHK_UNIT_BYTES; \
                LAS unsigned char* sl_ = F.lds + ((ck_) % 3) * C2_SLOT; \
                _Pragma("unroll") for (int j = 0; j < 16; ++j) __builtin_amdgcn_global_load_lds((const unsigned*)(ug + j * 1024 + lane * 16), (LAS unsigned*)(sl_ + j * 1024), 16, 0, 0); \
                _Pragma("unroll") for (int j = 0; j < 2; ++j) { \
                    __builtin_amdgcn_global_load_lds((const unsigned*)(ug + 2 * 8192 + (j * 32 + (lane >> 1)) * 128 + rq * 32 + (lane & 1) * 16), (LAS unsigned*)(sl_ + 16384 + j * 1024), 16, 0, 0); \
                    __builtin_amdgcn_global_load_lds((const unsigned*)(ug + 3 * 8192 + (j * 32 + (lane >> 1)) * 128 + rq * 32 + (lane & 1) * 16), (LAS unsigned*)(sl_ + 18432 + j * 1024), 16, 0, 0); } } while (0)
            C2_DMA(0); C2_DMA(1);
#pragma unroll 1
            for (int ck = 0; ck < SEQ / 64; ++ck) {
                asm volatile("s_waitcnt lgkmcnt(0)" ::: "memory");
                C2_DMA(ck + 2);
                asm volatile("s_waitcnt vmcnt(40)" ::: "memory");
                const LAS unsigned char* sl_ = F.lds + (ck % 3) * C2_SLOT;
#pragma unroll
                for (int nt = 0; nt < 4; ++nt) {
                    const bf16x8 py0 = *(const LAS bf16x8*)(sl_ + (16 * nt + lr) * 128 + kq * 16), py1 = *(const LAS bf16x8*)(sl_ + (16 * nt + lr) * 128 + kq * 16 + 64);
                    const bf16x8 ps0 = *(const LAS bf16x8*)(sl_ + 8192 + (16 * nt + lr) * 128 + kq * 16), ps1 = *(const LAS bf16x8*)(sl_ + 8192 + (16 * nt + lr) * 128 + kq * 16 + 64);
                    f32x4 y = unpack4(*(const LAS v2u*)(sl_ + 16384 + (16 * nt + lr) * 32 + kq * 8));
                    f32x4 s2 = unpack4(*(const LAS v2u*)(sl_ + 18432 + (16 * nt + lr) * 32 + kq * 8));
                    y = __builtin_amdgcn_mfma_f32_16x16x32_bf16(sf[0], py0, y, 0, 0, 0); y = __builtin_amdgcn_mfma_f32_16x16x32_bf16(sf[1], py1, y, 0, 0, 0);
                    *(GAS v2u*)(YS + ((size_t)b * SEQ + (size_t)ck * 64 + 16 * nt + lr) * RW + h * 64 + rq * 16 + 4 * kq) = pack4(y);
                    s2 = __builtin_amdgcn_mfma_f32_16x16x32_bf16(sf[0], ps0, s2, 0, 0, 0); s2 = __builtin_amdgcn_mfma_f32_16x16x32_bf16(sf[1], ps1, s2, 0, 0, 0);
                    S[nt] = s2; }
#pragma unroll
                for (int nt = 0; nt < 4; ++nt)
#pragma unroll
                    for (int i = 0; i < 4; ++i) *(LAS unsigned short*)(Sl + (4 * kq + i) * CP + (16 * nt + lr) * 2) = (unsigned short)f2bf(S[nt][i]);
                LDS_WAIT(); asm volatile("" ::: "memory");
                sf[0] = *(const LAS bf16x8*)(Sl + lr * CP + kq * 16); sf[1] = *(const LAS bf16x8*)(Sl + lr * CP + kq * 16 + 64);
                LDS_WAIT(); asm volatile("" ::: "memory");
            }
            asm volatile("s_waitcnt vmcnt(0)" ::: "memory");
#undef C2_DMA
        }
    }
}
static_assert(3 * C2_SLOT + 4096 + 5 * 16640 <= TAB_OFF, "P4b LDS map");

__device__ __forceinline__ void p5_post(Frame& F0, const In& I) {
    PHASE_FRAME(F0);
    const int lane = F.lane; const int gw = F.vcu * NWAVES + F.wave, NGW = F.G * NWAVES;
    const bf16* RKV = (const bf16*)(F.ws + WS_RKV); const bf16* ICL = (const bf16*)(F.ws + WS_ICLR); const bf16* YS = (const bf16*)(F.ws + WS_YSCAN);
    const bf16* G = (const bf16*)(F.ws + WS_G); bf16* YB = (bf16*)(F.ws + WS_YB);
    const int c0 = lane * 16;
    float p_ka[16], p_rk[16], p_lw[16], p_lb[16];
#pragma unroll
    for (int q = 0; q < 4; ++q) { const f32x4 a = *(const GAS f32x4*)(I.k_a + c0 + 4 * q), bq = *(const GAS f32x4*)(I.r_k + c0 + 4 * q), c = *(const GAS f32x4*)(I.lnx_w + c0 + 4 * q), d = *(const GAS f32x4*)(I.lnx_b + c0 + 4 * q);
#pragma unroll
        for (int e = 0; e < 4; ++e) { p_ka[4 * q + e] = a[e]; p_rk[4 * q + e] = bq[e]; p_lw[4 * q + e] = c[e]; p_lb[4 * q + e] = d[e]; } }
    v4u raw[12];
#define P5_LOAD(tok_) do { _Pragma("unroll") for (int q = 0; q < 2; ++q) { \
        raw[q] = *(const GAS v4u*)(YS + (size_t)(tok_) * RW + c0 + 8 * q); raw[2 + q] = *(const GAS v4u*)(ICL + (size_t)(tok_) * RW + c0 + 8 * q); \
        raw[4 + q] = *(const GAS v4u*)(RKV + (size_t)(tok_) * (3 * RW) + c0 + 8 * q); raw[6 + q] = *(const GAS v4u*)(RKV + (size_t)(tok_) * (3 * RW) + RW + c0 + 8 * q); \
        raw[8 + q] = *(const GAS v4u*)(RKV + (size_t)(tok_) * (3 * RW) + 2 * RW + c0 + 8 * q); raw[10 + q] = *(const GAS v4u*)(G + (size_t)(tok_) * RW + c0 + 8 * q); } } while (0)
    if (gw < T) P5_LOAD(gw);
    for (int tok = gw; tok < T; tok += NGW) {
        float y[16], rr[16], kk[16], vv[16], ic[16], gg[16];
#pragma unroll
        for (int q = 0; q < 2; ++q) {
            const unsigned yw[4] = {raw[q].x, raw[q].y, raw[q].z, raw[q].w}, iw[4] = {raw[2 + q].x, raw[2 + q].y, raw[2 + q].z, raw[2 + q].w};
            const unsigned aw[4] = {raw[4 + q].x, raw[4 + q].y, raw[4 + q].z, raw[4 + q].w}, bw[4] = {raw[6 + q].x, raw[6 + q].y, raw[6 + q].z, raw[6 + q].w};
            const unsigned cw[4] = {raw[8 + q].x, raw[8 + q].y, raw[8 + q].z, raw[8 + q].w}, dw[4] = {raw[10 + q].x, raw[10 + q].y, raw[10 + q].z, raw[10 + q].w};
#pragma unroll
            for (int e = 0; e < 4; ++e) { y[8 * q + 2 * e] = bflo(yw[e]); y[8 * q + 2 * e + 1] = bfhi(yw[e]); ic[8 * q + 2 * e] = bflo(iw[e]); ic[8 * q + 2 * e + 1] = bfhi(iw[e]);
                rr[8 * q + 2 * e] = bflo(aw[e]); rr[8 * q + 2 * e + 1] = bfhi(aw[e]); kk[8 * q + 2 * e] = bflo(bw[e]); kk[8 * q + 2 * e + 1] = bfhi(bw[e]);
                vv[8 * q + 2 * e] = bflo(cw[e]); vv[8 * q + 2 * e + 1] = bfhi(cw[e]); gg[8 * q + 2 * e] = bflo(dw[e]); gg[8 * q + 2 * e + 1] = bfhi(dw[e]); } }
        __builtin_amdgcn_sched_barrier(0);
        if (tok + NGW < T) P5_LOAD(tok + NGW);
        __builtin_amdgcn_sched_barrier(0);
        float s = 0.f, bs = 0.f;
#pragma unroll
        for (int e = 0; e < 16; ++e) { s += y[e]; const float kp = kk[e] * (1.0f + (ic[e] - 1.0f) * p_ka[e]); bs += rr[e] * kp * p_rk[e]; }
        s = quadsum(s); bs = quadsum(bs);
        const float mean = s * (1.f / 64.f); float s2 = 0.f;
#pragma unroll
        for (int e = 0; e < 16; ++e) { y[e] -= mean; s2 += y[e] * y[e]; }
        s2 = quadsum(s2);
        const float rstd = 1.f / sqrtf(s2 * (1.f / 64.f) + GN_EPS);
        float o[16];
#pragma unroll
        for (int e = 0; e < 16; ++e) o[e] = (y[e] * rstd * p_lw[e] + p_lb[e] + bs * vv[e]) * gg[e];
        { unsigned w8[4];
#pragma unroll
          for (int q = 0; q < 4; ++q) { int t8 = __builtin_amdgcn_cvt_pk_fp8_f32(o[4 * q] * ACT8_SCALE, o[4 * q + 1] * ACT8_SCALE, 0, false); t8 = __builtin_amdgcn_cvt_pk_fp8_f32(o[4 * q + 2] * ACT8_SCALE, o[4 * q + 3] * ACT8_SCALE, t8, true); w8[q] = (unsigned)t8; }
          *(GAS v4u*)((unsigned char*)YB + (size_t)tok * RW + c0) = (v4u){w8[0], w8[1], w8[2], w8[3]}; }
    }
#undef P5_LOAD
}
#ifndef STAGE
#define STAGE 4
#endif
struct Args { In in; float* out; unsigned char* ws; };
__global__ void __launch_bounds__(NWAVES * 64, 2) mk_fwd(Args args) {
    extern __shared__ __attribute__((aligned(16))) unsigned char lds[];
    Frame F;
    F.lds = (LAS unsigned char*)lds;
    F.MISC = (volatile LAS unsigned*)(F.lds + MISC_OFF);
    F.tid = threadIdx.x; F.lane = F.tid & 63; F.wave = __builtin_amdgcn_readfirstlane(F.tid >> 6);
    F.G = gridDim.x; { const int bx = blockIdx.x; F.vcu = (F.G % 8 == 0) ? (bx % 8) * (F.G / 8) + bx / 8 : bx; }
    F.ws = args.ws;
    F.rsrc = __builtin_amdgcn_make_buffer_rsrc(args.ws, 0, 0xffffffff, 0x00020000);
    F.ctl = (gu32*)(args.ws + WS_CTL);
    for (int u = F.tid; u < (LDS_BYTES - MISC_OFF) / 4; u += NWAVES * 64) ((LAS unsigned*)(F.lds + MISC_OFF))[u] = 0u;
    __syncthreads();
    XcdBarrier bar = xcd_barrier_post((unsigned*)(F.ctl + CW_BAR), F.MISC + 8);
    const In& I = args.in;
#define GRID_BAR() xcd_barrier(bar)
#ifndef DUP_PHASE
#define DUP_PHASE -1
#endif
#define RUN(n, call) do { call; if (DUP_PHASE == (n)) { GRID_BAR(); call; } } while (0)

#if STAGE >= 2
    RUN(0, p0_prologue(F, I));
    GRID_BAR();
#endif
#if STAGE >= 3
    RUN(1, p1_proj(F, I));
    GRID_BAR();
    RUN(2, p2_shift_attn(F, I));
    GRID_BAR();
#if STAGE >= 4
    RUN(3, p3_lora(F, I));
    GRID_BAR();
    RUN(4, p4a_chunk(F, I));
    GRID_BAR();
    RUN(44, p4b_scan(F, I));
    GRID_BAR();
    RUN(5, p5_post(F, I));
    GRID_BAR();
#endif
    RUN(6, p6_merged(F, I));
    GRID_BAR();
    RUN(7, p7_mix(F, I));
    GRID_BAR();
#endif
    p8_ln_router<(STAGE < 3)>(F, I);
    GRID_BAR();
#if STAGE >= 2
    p9_scatter(F, I);
    GRID_BAR();
    RUN(10, p10_moe_up(F, I));
    GRID_BAR();
    RUN(11, p11_moe_down(F, I));
    GRID_BAR();
#endif
    RUN(12, p12_final<(STAGE < 2)>(F, I, args.out));
}

extern "C" void kernel_launch(void* const* d_in, const int* in_sizes, int n_in, void* d_out, int out_size, void* d_ws, size_t ws_size, hipStream_t stream) {
    static int grid = 0;
    if (grid == 0) {
        if (n_in != 27 || in_sizes[0] != T * D || out_size != T * D || ws_size < WS_END) { fprintf(stderr, "kernel_launch: unexpected shapes (n_in %d, in0 %d, out %d, ws %zu)\n", n_in, n_in > 0 ? in_sizes[0] : -1, out_size, ws_size); grid = -1; return; }
        int dev = 0, cus = 0, per_cu = 0;
        if (hipGetDevice(&dev) != hipSuccess || hipDeviceGetAttribute(&cus, hipDeviceAttributeMultiprocessorCount, dev) != hipSuccess) { grid = -1; return; }
        if (hipFuncSetAttribute((const void*)mk_fwd, hipFuncAttributeMaxDynamicSharedMemorySize, LDS_BYTES) != hipSuccess) { fprintf(stderr, "kernel_launch: hipFuncSetAttribute failed\n"); grid = -1; return; }
        if (hipOccupancyMaxActiveBlocksPerMultiprocessor(&per_cu, (const void*)mk_fwd, NWAVES * 64, LDS_BYTES) != hipSuccess || per_cu < 1)
            fprintf(stderr, "kernel_launch: occupancy query reports %d\n", per_cu);
        (void)hipGetLastError();
        grid = cus;
    }
    if (grid < 0) return;
    if (hipMemsetAsync((char*)d_ws + WS_CTL, 0, CTL_ZERO_BYTES, stream) != hipSuccess) return;
    Args a{};
    const float** ip = (const float**)&a.in;
    for (int i = 0; i < 27; ++i) ip[i] = (const float*)d_in[i];
    a.out = (float*)d_out; a.ws = (unsigned char*)d_ws;
    hipLaunchKernelGGL(mk_fwd, dim3(grid), dim3(NWAVES * 64), LDS_BYTES, stream, a);
    const hipError_t le = hipPeekAtLastError();
    if (le != hipSuccess) fprintf(stderr, "kernel_launch: launch failed: %s\n", hipGetErrorName(le));
}
```

```cpp
#define STAGE 4
#include <hip/hip_runtime.h>
#include <cstdio>
#include <cstdint>

#define GAS __attribute__((address_space(1)))
#define LAS __attribute__((address_space(3)))
typedef unsigned short bf16;
typedef unsigned v4u __attribute__((ext_vector_type(4)));
typedef unsigned v2u __attribute__((ext_vector_type(2)));
typedef float f32x4 __attribute__((ext_vector_type(4)));
typedef float f32x2 __attribute__((ext_vector_type(2)));
typedef float f32x16 __attribute__((ext_vector_type(16)));
typedef short bf16x8 __attribute__((ext_vector_type(8)));
typedef short bf16x4 __attribute__((ext_vector_type(4)));
typedef GAS unsigned gu32;

constexpr int NWAVES = 8;
constexpr int BATCH = 4, SEQ = 8192, D = 2048, T = BATCH * SEQ;
constexpr int CHUNK = 64, LEFT = 8, AH = 16, AD = 64, AW = 1024;
constexpr int REL_TABLE = 320, MAX_PAST = 256;
constexpr int RH = 16, RN = 64, RW = 1024, DLORA = 96, ALORA = 96, GLORA = 256;
constexpr int SHIFT_W = 3 * RW + DLORA + ALORA + GLORA;
constexpr int D_IN = 3 * AW + SHIFT_W + 2 * D;
constexpr int NE = 32, TOPK = 4, FF = 2048;
constexpr int MSLOT = T * TOPK;
constexpr int NBLK_MAX = (MSLOT + NE * 255 + 255) / 256;
constexpr int RROWS = NBLK_MAX * 256;
constexpr float LN_EPS = 1e-5f, GN_EPS = 64e-5f;
constexpr float YS_SCALE = 16.0f, YS_INV = 1.0f / 16.0f;
constexpr float ACT8_SCALE = 16.0f;
constexpr float F8_CVT_SCALE = 0.015625f;
constexpr float DN_ALPHA = 1.189207115002721f;
constexpr int PROJ_LD = 9728, PJ_Q = 0, PJ_K = 1024, PJ_SEG = 2048, SEG_PAD = 3584, PJ_GA = 5632, PJ_GB = 7680;
constexpr int LORA_LD = 512;

constexpr size_t MiB = 1u << 20;
constexpr size_t WS_CTL = 0, CTL_ZERO_BYTES = 1 * MiB;
constexpr size_t WS_TOPI = 2 * MiB;
constexpr size_t WS_GATE = 3 * MiB;
constexpr size_t WS_ROWSLOT = 4 * MiB;
constexpr size_t WS_ROWW = 5 * MiB;
constexpr size_t WS_WLA = 6 * MiB;
constexpr size_t WS_WLG = 7 * MiB;
constexpr size_t WS_PAT = 8 * MiB;
constexpr size_t WS_PBT = 12 * MiB;
constexpr size_t WS_WOT = 16 * MiB;
constexpr size_t WS_WVT = 24 * MiB;
constexpr size_t WS_SIDE0 = 28 * MiB, WS_SIDEL = 36 * MiB;
constexpr size_t WS_WINT = 28 * MiB;
constexpr size_t WS_WG8 = 72 * MiB;
constexpr size_t WS_WQK8 = 80 * MiB;
constexpr size_t WS_WV8 = 84 * MiB;
constexpr size_t WS_WSV8 = 88 * MiB;
constexpr size_t WS_WGUT = 128 * MiB;
constexpr size_t WS_WDNT = 640 * MiB;
constexpr size_t WS_BASE0 = 1024 * MiB;
constexpr size_t WS_PROJ = WS_BASE0;
constexpr size_t WS_VT = WS_PROJ + 608 * MiB;
constexpr size_t WS_YA = WS_VT + 64 * MiB;
constexpr size_t WS_RKV = WS_YA + 64 * MiB;
constexpr size_t WS_LORAIN = WS_RKV + 192 * MiB;
constexpr size_t WS_DECAY = WS_LORAIN + 32 * MiB;
constexpr size_t WS_ICLR = WS_DECAY + 128 * MiB;
constexpr size_t WS_G = WS_ICLR + 128 * MiB;
constexpr size_t WS_YSCAN = WS_G + 64 * MiB;
constexpr size_t WS_YB = WS_YSCAN + 128 * MiB;
constexpr size_t WS_MERGED = WS_YB + 64 * MiB;
constexpr size_t WS_XB16 = WS_MERGED + 128 * MiB;
constexpr size_t WS_MIX_END = WS_XB16 + 128 * MiB;
constexpr size_t WS_Z = 2816 * MiB;
constexpr size_t WS_GATEF = WS_Z;
constexpr size_t WS_H1 = 3072 * MiB;
constexpr size_t WS_H1B = 3328 * MiB;
constexpr size_t WS_CHK = 3456 * MiB;
constexpr size_t WS_XB8 = 3712 * MiB;
constexpr size_t WS_END = 3776 * MiB;
constexpr size_t WS_XG = WS_BASE0;
constexpr size_t WS_ACT = WS_BASE0 + 544 * MiB;
constexpr size_t WS_YSLOT = WS_BASE0 + 1088 * MiB;
static_assert(WS_MIX_END <= WS_Z && WS_YSLOT + 512 * MiB <= WS_Z, "ws map");
static_assert(WS_WINT + (size_t)PROJ_LD * D * 2 <= WS_WGUT, "ws map");

constexpr int CW_CNT = 512;
constexpr int CW_CUR = 576;
constexpr int CW_BAR = 4096;

constexpr int RING_OFF = 0, RING_BYTES = 131072;
constexpr int LDS_BYTES = 160 * 1024;
constexpr int MISC_OFF = LDS_BYTES - 512;
constexpr int TAB_OFF = LDS_BYTES - 1024;

#define RLX_AGENT __ATOMIC_RELAXED, __HIP_MEMORY_SCOPE_AGENT
#define LDS_WAIT() asm volatile("s_waitcnt lgkmcnt(0)" ::: "memory")
#define VM_WAIT() asm volatile("s_waitcnt vmcnt(0)" ::: "memory")
__device__ __forceinline__ unsigned f2bf(float f) { unsigned u = __builtin_bit_cast(unsigned, f); return (u + 0x7fffu + ((u >> 16) & 1u)) >> 16; }
__device__ __forceinline__ unsigned pk2(float lo, float hi) { return f2bf(lo) | (f2bf(hi) << 16); }
__device__ __forceinline__ float bf2f(unsigned short h) { return __builtin_bit_cast(float, (unsigned)h << 16); }
__device__ __forceinline__ float bflo(unsigned w) { return __builtin_bit_cast(float, w << 16); }
__device__ __forceinline__ float bfhi(unsigned w) { return __builtin_bit_cast(float, w & 0xffff0000u); }
__device__ __forceinline__ float fsigmoid(float x) { return __builtin_amdgcn_rcpf(1.0f + __expf(-x)); }
__device__ __forceinline__ float dpp_f(float x, const int ctrl_sel) {
    const int xi = __builtin_bit_cast(int, x); int r;
    if (ctrl_sel == 0) r = __builtin_amdgcn_update_dpp(0, xi, 0xB1, 0xF, 0xF, false);
    else if (ctrl_sel == 1) r = __builtin_amdgcn_update_dpp(0, xi, 0x4E, 0xF, 0xF, false);
    else if (ctrl_sel == 2) r = __builtin_amdgcn_update_dpp(0, xi, 0x124, 0xF, 0xF, false);
    else r = __builtin_amdgcn_update_dpp(0, xi, 0x128, 0xF, 0xF, false);
    return __builtin_bit_cast(float, r);
}
__device__ __forceinline__ float rowsum16(float x) { x += dpp_f(x, 0); x += dpp_f(x, 1); x += dpp_f(x, 2); x += dpp_f(x, 3); return x; }
__device__ __forceinline__ float quadsum(float x) { x += dpp_f(x, 0); x += dpp_f(x, 1); return x; }
__device__ __forceinline__ float wave_sum(float v) {
    v = rowsum16(v);
    const int vi = __builtin_bit_cast(int, v);
    const float s0 = __builtin_bit_cast(float, __builtin_amdgcn_readlane(vi, 0)), s1 = __builtin_bit_cast(float, __builtin_amdgcn_readlane(vi, 16));
    const float s2 = __builtin_bit_cast(float, __builtin_amdgcn_readlane(vi, 32)), s3 = __builtin_bit_cast(float, __builtin_amdgcn_readlane(vi, 48));
    return (s0 + s1) + (s2 + s3);
}
namespace pg8 {
#define PG8_LAS __attribute__((address_space(3)))
typedef unsigned short bf16_t;
typedef unsigned u32x4 __attribute__((ext_vector_type(4)));
constexpr int BM = 256, BK = 64, HALF = 128, HTB = HALF * BK * 2, STAGE_BYTES = 8 * HTB, NXCD = 8, WGM = 8;

__host__ __device__ __forceinline__ int lds_byte(int r, int c) { const int st = (r >> 4) * 2 + (c >> 5), rr = r & 15, cc = c & 31, ob = rr * 64 + cc * 2; return st * 1024 + (ob ^ (((ob >> 9) & 1) << 5)); }
__host__ __device__ __forceinline__ void stage_rc(int b, int& R, int& C) { const int st = b / 1024, sb = b % 1024, swz = sb ^ (((sb >> 9) & 1) << 5); R = (st >> 1) * 16 + swz / 64; C = (st & 1) * 32 + (swz % 64) / 2; }
__host__ __device__ __forceinline__ int perm32(int rho) { const int n = rho >> 4, i = rho & 15; return 8 * (i >> 2) + 4 * n + (i & 3); }

struct Unit { int pm, pn, aux; };

struct Tiler {
    int nM, nN, nwg, G, c;
    __device__ __forceinline__ void init(int nM_, int nN_, int G_, int c_) { nM = nM_; nN = nN_; nwg = nM * nN; G = G_; c = c_; }
    __device__ __forceinline__ bool map(int i, int& pm, int& pn) const {
        const long L = (long)i * G + c; if (L >= nwg) return false;
        int wgid = (int)L; { const int q = nwg / NXCD, r = nwg % NXCD, xcd = wgid % NXCD, off = wgid / NXCD; wgid = (xcd < r ? xcd * (q + 1) : r * (q + 1) + (xcd - r) * q) + off; }
        const int nig = WGM * nN, gid = wgid / nig, fm = gid * WGM, gsz = (nM - fm) < WGM ? (nM - fm) : WGM;
        pm = fm + ((wgid % nig) % gsz); pn = (wgid % nig) / gsz; return true;
    }
};
struct SchedPlain {
    Tiler t; unsigned A, B, tsA, tsB;
    __device__ __forceinline__ bool next(int i, Unit& u) const { u.aux = 0; return t.map(i, u.pm, u.pn); }
    __device__ __forceinline__ void bases(const Unit& u, unsigned& a, unsigned& b) const { a = A + (unsigned)u.pm * tsA; b = B + (unsigned)u.pn * tsB; }
};
struct SchedTwo {
    Tiler t; unsigned A0, A1, B0, B1, tsA, tsB;
    __device__ __forceinline__ bool next(int i, Unit& u) const { u.aux = i & 1; return t.map(i >> 1, u.pm, u.pn); }
    __device__ __forceinline__ void bases(const Unit& u, unsigned& a, unsigned& b) const { a = (u.aux ? A1 : A0) + (unsigned)u.pm * tsA; b = (u.aux ? B1 : B0) + (unsigned)u.pn * tsB; }
};
struct SchedMoe {
    Tiler t; unsigned A, B, tsA, tsB, es; const PG8_LAS int* pad_end;
    __device__ __forceinline__ bool next(int i, Unit& u) const {
        if (!t.map(i, u.pm, u.pn)) return false;
        const int row0 = u.pm * BM; int e = 0;
#pragma unroll
        for (int j = 0; j < 32; ++j) e += (pad_end[j] <= row0) ? 1 : 0;
        u.aux = __builtin_amdgcn_readfirstlane(e < 31 ? e : 31); return true;
    }
    __device__ __forceinline__ void bases(const Unit& u, unsigned& a, unsigned& b) const { a = A + (unsigned)u.pm * tsA; b = B + (unsigned)u.aux * es + (unsigned)u.pn * tsB; }
};

typedef float f32x2_t_ __attribute__((ext_vector_type(2)));
typedef __bf16 bf16x2_t_ __attribute__((ext_vector_type(2)));
__device__ __forceinline__ unsigned cvt_pk_bf16(float lo, float hi) { const f32x2_t_ v = {lo, hi}; const bf16x2_t_ b = __builtin_convertvector(v, bf16x2_t_); return __builtin_bit_cast(unsigned, b); }
__device__ __forceinline__ u32x4 pack8(const f32x4& v0, const f32x4& v1) { u32x4 w; w.x = cvt_pk_bf16(v0[0], v0[1]); w.y = cvt_pk_bf16(v0[2], v0[3]); w.z = cvt_pk_bf16(v1[0], v1[1]); w.w = cvt_pk_bf16(v1[2], v1[3]); return w; }

typedef int i32x8 __attribute__((ext_vector_type(8)));
typedef int i32x4 __attribute__((ext_vector_type(4)));
__device__ __forceinline__ i32x8 cat8(const bf16x8& a, const bf16x8& b) { return __builtin_shufflevector(__builtin_bit_cast(i32x4, a), __builtin_bit_cast(i32x4, b), 0, 1, 2, 3, 4, 5, 6, 7); }
constexpr int F8_SCALES = 0x00007f79;
template <class Epi, class Sched, bool ALIGN_EPI, bool F8 = false, int F8SC = F8_SCALES>
__device__ __forceinline__ void gemm_phase(PG8_LAS unsigned char* lds, const __amdgpu_buffer_rsrc_t rsrc, const int lda, const int ldb, const int K, const Sched& S, const Epi& E) {
    int tid_ = threadIdx.x; asm volatile("" : "+v"(tid_));
    const int tid = tid_, wid = __builtin_amdgcn_readfirstlane(tid >> 6), lane = tid & 63, wr = wid >> 2, wc = wid & 3, fr = lane & 15, fq = lane >> 4;
    const int nt = K / BK;
    unsigned voffA, voffB;
    { int R, C; stage_rc(tid * 16, R, C); const int Rb = (R & ~31) + perm32(R & 31); voffA = (unsigned)(R * lda + C) * 2u; voffB = (unsigned)(Rb * ldb + C) * 2u; }
    const unsigned p1voffA = 64u * (unsigned)lda * 2u, p1voffB = 64u * (unsigned)ldb * 2u;
    const unsigned kstep = (unsigned)(BK * 2);
    const unsigned hsA = (unsigned)HALF * lda * 2, hsB = (unsigned)HALF * ldb * 2;
    const unsigned ldsw = (unsigned)wid * 1024u;
    const int aoff = lds_byte(wr * 64 + fr, fq * 8), boff = lds_byte(wc * 32 + fr, fq * 8);
#define PG8_SA(b, h) (((b) * 2 + (h)) * HTB)
#define PG8_SB(b, h) ((4 + (b) * 2 + (h)) * HTB)
#define PG8_STAGE(bufoff, goff, voff) do { _Pragma("unroll") for (int _i = 0; _i < 2; ++_i) \
        __builtin_amdgcn_raw_ptr_buffer_load_lds(rsrc, (PG8_LAS void*)(lds + (bufoff) + ldsw + _i * 8192), 16, (int)(voff), (int)((goff) + _i * p1##voff), 0, 0); } while (0)
#define PG8_LD8(addr) __builtin_shufflevector(*(const PG8_LAS i32x4*)(addr), *(const PG8_LAS i32x4*)((addr) + 1024), 0, 1, 2, 3, 4, 5, 6, 7)
#define PG8_LDA(dst, b, h) do { _Pragma("unroll") for (int m = 0; m < 4; ++m) dst[m] = PG8_LD8(lds + PG8_SA(b, h) + aoff + m * 2048); } while (0)
#define PG8_LDB(dst, b, h) do { _Pragma("unroll") for (int n = 0; n < 2; ++n) dst[n] = PG8_LD8(lds + PG8_SB(b, h) + boff + n * 2048); } while (0)
#define PG8_LO(v) __builtin_bit_cast(bf16x8, __builtin_shufflevector(v, v, 0, 1, 2, 3))
#define PG8_HI(v) __builtin_bit_cast(bf16x8, __builtin_shufflevector(v, v, 4, 5, 6, 7))
#define PG8_MMA(ai, bj, At, Bt) do { __builtin_amdgcn_s_setprio(1); \
        if constexpr (!F8) { _Pragma("unroll") for (int m = 0; m < 4; ++m) _Pragma("unroll") for (int n = 0; n < 2; ++n) { \
            acc[ai][bj][m][n] = __builtin_amdgcn_mfma_f32_16x16x32_bf16(PG8_LO(Bt[n]), PG8_LO(At[m]), acc[ai][bj][m][n], 0, 0, 0); \
            acc[ai][bj][m][n] = __builtin_amdgcn_mfma_f32_16x16x32_bf16(PG8_HI(Bt[n]), PG8_HI(At[m]), acc[ai][bj][m][n], 0, 0, 0); } } \
        else { _Pragma("unroll") for (int m = 0; m < 4; ++m) _Pragma("unroll") for (int n = 0; n < 2; ++n) \
            acc[ai][bj][m][n] = __builtin_amdgcn_mfma_scale_f32_16x16x128_f8f6f4(Bt[n], At[m], acc[ai][bj][m][n], 0, 0, 0, F8SC, 1, F8SC); } \
        __builtin_amdgcn_s_setprio(0); } while (0)
#define PG8_WAIT_V(n) asm volatile("s_waitcnt vmcnt(" #n ")" ::: "memory")
#define PG8_WAIT_L(n) asm volatile("s_waitcnt lgkmcnt(" #n ")" ::: "memory")
#define PG8_BAR __builtin_amdgcn_s_barrier()
#define PG8_SCHED __builtin_amdgcn_sched_barrier(0)
#define PG8_ZERO() do { _Pragma("unroll") for (int a = 0; a < 2; ++a) _Pragma("unroll") for (int b = 0; b < 2; ++b) _Pragma("unroll") for (int m = 0; m < 4; ++m) _Pragma("unroll") for (int n = 0; n < 2; ++n) acc[a][b][m][n] = (f32x4){0.f, 0.f, 0.f, 0.f}; } while (0)
    Unit cur, nxt; int ui = 0;
    if (!S.next(0, cur)) return;
    f32x4 acc[2][2][4][2];
    PG8_ZERO();
    i32x8 At[4], B0[2], B1[2];
    unsigned cA, cB; S.bases(cur, cA, cB); cA = __builtin_amdgcn_readfirstlane(cA); cB = __builtin_amdgcn_readfirstlane(cB);
    PG8_STAGE(PG8_SB(0, 0), cB, voffB); PG8_STAGE(PG8_SB(0, 1), cB + hsB, voffB); PG8_STAGE(PG8_SA(0, 0), cA, voffA); PG8_STAGE(PG8_SA(0, 1), cA + hsA, voffA);
    if (wr == 1) PG8_BAR;
    PG8_WAIT_V(2); PG8_BAR;
    PG8_STAGE(PG8_SB(1, 0), cB + kstep, voffB); PG8_STAGE(PG8_SA(1, 0), cA + kstep, voffA); PG8_STAGE(PG8_SB(1, 1), cB + hsB + kstep, voffB);
    PG8_WAIT_V(6); PG8_BAR;
    for (;;) {
        const bool has_next = S.next(ui + 1, nxt);
        unsigned nA = cA, nB = cB; if (has_next) { S.bases(nxt, nA, nB); nA = __builtin_amdgcn_readfirstlane(nA); nB = __builtin_amdgcn_readfirstlane(nB); }
#pragma unroll 1
        for (int t = 0; t < nt; t += 2) {
            const bool last = (t == nt - 2);
            const unsigned a1 = cA + (unsigned)(t + 1) * kstep;
            const unsigned a2 = last ? nA : cA + (unsigned)(t + 2) * kstep, b2 = last ? nB : cB + (unsigned)(t + 2) * kstep;
            const unsigned a3 = a2 + kstep, b3 = b2 + kstep;
            PG8_LDB(B0, 0, 0); PG8_LDB(B1, 0, 1); PG8_SCHED; PG8_LDA(At, 0, 0); PG8_STAGE(PG8_SA(1, 1), a1 + hsA, voffA);
            PG8_WAIT_V(8); PG8_WAIT_L(0); PG8_BAR; PG8_MMA(0, 0, At, B0); PG8_MMA(0, 1, At, B1); PG8_BAR; PG8_SCHED;
            PG8_LDA(At, 0, 1); PG8_STAGE(PG8_SB(0, 0), b2, voffB); PG8_STAGE(PG8_SB(0, 1), b2 + hsB, voffB); PG8_STAGE(PG8_SA(0, 0), a2, voffA);
            PG8_WAIT_V(8); PG8_WAIT_L(0); PG8_BAR; PG8_MMA(1, 0, At, B0); PG8_MMA(1, 1, At, B1); PG8_BAR; PG8_SCHED;
            PG8_LDB(B0, 1, 0); PG8_LDB(B1, 1, 1); PG8_SCHED; PG8_LDA(At, 1, 0); PG8_STAGE(PG8_SA(0, 1), a2 + hsA, voffA);
            PG8_WAIT_V(8); PG8_WAIT_L(0); PG8_BAR; PG8_MMA(0, 0, At, B0); PG8_MMA(0, 1, At, B1); PG8_BAR; PG8_SCHED;
            PG8_LDA(At, 1, 1); PG8_STAGE(PG8_SB(1, 0), b3, voffB); PG8_STAGE(PG8_SB(1, 1), b3 + hsB, voffB); PG8_STAGE(PG8_SA(1, 0), a3, voffA);
            PG8_WAIT_V(8); PG8_WAIT_L(0); PG8_BAR; PG8_MMA(1, 0, At, B0); PG8_MMA(1, 1, At, B1); PG8_BAR; PG8_SCHED;
        }
        if constexpr (ALIGN_EPI) { if (wr == 0) PG8_BAR; }
        bool keep; { int t2 = threadIdx.x; asm volatile("" : "+v"(t2)); const int w2 = __builtin_amdgcn_readfirstlane(t2 >> 6), l2 = t2 & 63; keep = E(acc, cur, w2 >> 2, w2 & 3, l2 & 15, l2 >> 4); }
        if (!has_next) break;
        if (!keep) PG8_ZERO();
        cur = nxt; cA = nA; cB = nB; ++ui;
        if constexpr (ALIGN_EPI) { if (wr == 1) PG8_BAR; }
    }
    PG8_WAIT_V(0);
    if constexpr (!ALIGN_EPI) { if (wr == 0) PG8_BAR; }
    PG8_BAR;
#undef PG8_SA
#undef PG8_SB
#undef PG8_STAGE
#undef PG8_LDA
#undef PG8_LDB
#undef PG8_LD8
#undef PG8_LO
#undef PG8_HI
#undef PG8_MMA
#undef PG8_WAIT_V
#undef PG8_WAIT_L
#undef PG8_BAR
#undef PG8_SCHED
#undef PG8_ZERO
}
}
namespace pg8 {
#define EPI_ROWLOOP _Pragma("unroll") for (int ai = 0; ai < 2; ++ai) _Pragma("unroll") for (int m = 0; m < 4; ++m)
struct EpiProj {
    bf16_t* O; int coloff, nq;
    __device__ __forceinline__ bool operator()(f32x4 (&acc)[2][2][4][2], const Unit& u, int wr, int wc, int fr, int fq) const {
        const int row0 = u.pm * BM + wr * 64 + fr, col0 = coloff + u.pn * BM + wc * 32 + 8 * fq;
        const float sc = (u.pn < nq) ? 0.125f : 1.0f;
        EPI_ROWLOOP { bf16_t* rowp = O + (size_t)(row0 + ai * HALF + m * 16) * PROJ_LD + col0;
#pragma unroll
            for (int bj = 0; bj < 2; ++bj) *(u32x4*)(rowp + bj * HALF) = pack8(acc[ai][bj][m][0] * sc, acc[ai][bj][m][1] * sc); }
        return false;
    }
};
__device__ __forceinline__ float dpp_prev_row(float lo15, float cur) {
    const int o = __builtin_amdgcn_update_dpp(0, __builtin_bit_cast(int, lo15), 0x121, 0xF, 0xF, false);
    return __builtin_bit_cast(float, __builtin_amdgcn_update_dpp(o, __builtin_bit_cast(int, cur), 0x111, 0xF, 0xF, false));
}
struct EpiShift {
    bf16_t* RKVp; bf16_t* LIN; float* SIDE0; float* SIDEL; const float* mu;
    __device__ __forceinline__ bool operator()(f32x4 (&acc)[2][2][4][2], const Unit& u, int wr, int wc, int fr, int fq) const {
        static_assert(DLORA % 32 == 0 && ALORA % 32 == 0 && GLORA % 32 == 0 && RW % 32 == 0, "segment boundaries are wave-uniform");
        const int row0 = u.pm * BM + wr * 64 + fr;
#pragma unroll
        for (int bj = 0; bj < 2; ++bj) {
            const int cgrp = u.pn * BM + bj * HALF + wc * 32;
            if (cgrp >= SHIFT_W) continue;
            const int c = cgrp + 8 * fq;
            const f32x4 mu0 = *(const f32x4*)(mu + c), mu1 = *(const f32x4*)(mu + c + 4);
            bf16_t* dbase; int ld, act = 0;
            if (cgrp < 3 * RW) { dbase = RKVp + c; ld = 3 * RW; }
            else if (cgrp < 3 * RW + DLORA) { dbase = LIN + (c - 3 * RW); ld = LORA_LD; act = 1; }
            else if (cgrp < 3 * RW + DLORA + ALORA) { dbase = LIN + 128 + (c - 3 * RW - DLORA); ld = LORA_LD; }
            else { dbase = LIN + 256 + (c - 3 * RW - DLORA - ALORA); ld = LORA_LD; act = 2; }
            const bool zpad = (cgrp == 3 * RW + DLORA - 32) || (cgrp == 3 * RW + DLORA + ALORA - 32);
#pragma unroll
            for (int ai = 0; ai < 2; ++ai) {
                const int g = u.pm * 4 + ai * 2 + wr;
#pragma unroll
                for (int m = 0; m < 4; ++m) {
                    f32x4 o[2];
#pragma unroll
                    for (int n = 0; n < 2; ++n) { const f32x4 cur = acc[ai][bj][m][n]; const f32x4 mm = n ? mu1 : mu0;
#pragma unroll
                        for (int j = 0; j < 4; ++j) { const float prv = dpp_prev_row(m > 0 ? acc[ai][bj][m > 0 ? m - 1 : 0][n][j] : 0.0f, cur[j]);
                            float v = cur[j] + (prv - cur[j]) * mm[j];
                            if (act == 1) v = 2.0f * fsigmoid(2.0f * v) - 1.0f; else if (act == 2) v = fsigmoid(v);
                            o[n][j] = v; } }
                    bf16_t* dp = dbase + (size_t)(row0 + ai * HALF + m * 16) * ld;
                    *(u32x4*)dp = pack8(o[0], o[1]);
                    if (zpad) { unsigned zz = 0u; asm volatile("" : "+v"(zz)); *(u32x4*)(dp + 32) = (u32x4){zz, zz, zz, zz}; }
                    if (m == 0 && fr == 0) { float* sp = SIDE0 + (size_t)g * SEG_PAD + c; *(f32x4*)sp = acc[ai][bj][0][0]; *(f32x4*)(sp + 4) = acc[ai][bj][0][1]; }
                    if (m == 3 && fr == 15) { float* sp = SIDEL + (size_t)g * SEG_PAD + c; *(f32x4*)sp = acc[ai][bj][3][0]; *(f32x4*)(sp + 4) = acc[ai][bj][3][1]; }
                } }
        }
        return false;
    }
};
struct EpiGate {
    bf16_t* O;
    __device__ __forceinline__ bool operator()(f32x4 (&acc)[2][2][4][2], const Unit& u, int wr, int wc, int fr, int fq) const {
        u32x4* gf = (u32x4*)O + ((size_t)(u.pm * 16 + u.pn) * 2 * 8 + (wr * 4 + wc)) * 512 + (fq * 16 + fr);
        EPI_ROWLOOP {
            f32x4 rt[2], gb[2];
#pragma unroll
            for (int n = 0; n < 2; ++n)
#pragma unroll
                for (int j = 0; j < 4; ++j) { const float ea = __expf(-acc[ai][0][m][n][j]), eb = fminf(__expf(-acc[ai][1][m][n][j]), 1e30f);
                    gb[n][j] = __builtin_amdgcn_rcpf(1.0f + eb); rt[n][j] = (1.0f + eb) * __builtin_amdgcn_rcpf(1.0f + ea); }
            gf[(ai * 4 + m) * 64] = pack8(rt[0], rt[1]); gf[8 * 512 + (ai * 4 + m) * 64] = pack8(gb[0], gb[1]); }
        return false;
    }
};
struct EpiBf16 {
    bf16_t* O; int ldc;
    __device__ __forceinline__ bool operator()(f32x4 (&acc)[2][2][4][2], const Unit& u, int wr, int wc, int fr, int fq) const {
        const int row0 = u.pm * BM + wr * 64 + fr, col0 = u.pn * BM + wc * 32 + 8 * fq;
        EPI_ROWLOOP { bf16_t* rowp = O + (size_t)(row0 + ai * HALF + m * 16) * ldc + col0;
#pragma unroll
            for (int bj = 0; bj < 2; ++bj) *(u32x4*)(rowp + bj * HALF) = pack8(acc[ai][bj][m][0], acc[ai][bj][m][1]); }
        return false;
    }
};
template <bool ISDEC> struct EpiLoraA {
    float* OUT; const float* par;
    __device__ __forceinline__ bool operator()(f32x4 (&acc)[2][2][4][2], const Unit& u, int wr, int wc, int fr, int fq) const {
        const int row0 = u.pm * BM + wr * 64 + fr, col0 = u.pn * BM + wc * 32 + 8 * fq;
        f32x4 pv[2][2];
#pragma unroll
        for (int bj = 0; bj < 2; ++bj)
#pragma unroll
            for (int n = 0; n < 2; ++n) pv[bj][n] = *(const f32x4*)(par + col0 + bj * HALF + 4 * n);
        EPI_ROWLOOP { float* rowp = OUT + (size_t)(row0 + ai * HALF + m * 16) * RW + col0;
#pragma unroll
            for (int bj = 0; bj < 2; ++bj)
#pragma unroll
                for (int n = 0; n < 2; ++n) { f32x4 v = acc[ai][bj][m][n] + pv[bj][n];
#pragma unroll
                    for (int j = 0; j < 4; ++j) {
                        if (ISDEC) v[j] = -0.60653065971263342f * fsigmoid(v[j]);
                        else v[j] = fsigmoid(v[j]); }
                    *(f32x4*)(rowp + bj * HALF + 4 * n) = v; } }
        return false;
    }
};
struct EpiIclr {
    bf16_t* OUT; const float* par;
    __device__ __forceinline__ bool operator()(f32x4 (&acc)[2][2][4][2], const Unit& u, int wr, int wc, int fr, int fq) const {
        const int row0 = u.pm * BM + wr * 64 + fr, col0 = u.pn * BM + wc * 32 + 8 * fq;
        f32x4 pv[2][2];
#pragma unroll
        for (int bj = 0; bj < 2; ++bj)
#pragma unroll
            for (int n = 0; n < 2; ++n) pv[bj][n] = *(const f32x4*)(par + col0 + bj * HALF + 4 * n);
        EPI_ROWLOOP { bf16_t* rowp = OUT + (size_t)(row0 + ai * HALF + m * 16) * RW + col0;
#pragma unroll
            for (int bj = 0; bj < 2; ++bj) { f32x4 v0 = acc[ai][bj][m][0] + pv[bj][0], v1 = acc[ai][bj][m][1] + pv[bj][1];
#pragma unroll
                for (int j = 0; j < 4; ++j) { v0[j] = fsigmoid(v0[j]); v1[j] = fsigmoid(v1[j]); }
                *(u32x4*)(rowp + bj * HALF) = pack8(v0, v1); } }
        return false;
    }
};
struct EpiMerged {
    const bf16_t* PROJ; bf16_t* O;
    __device__ __forceinline__ bool operator()(f32x4 (&acc)[2][2][4][2], const Unit& u, int wr, int wc, int fr, int fq) const {
        const int row0 = u.pm * BM + wr * 64 + fr, col0 = u.pn * BM + wc * 32 + 8 * fq;
        const u32x4* gf = (const u32x4*)PROJ + ((size_t)(u.pm * 16 + u.pn * 2) * 2 * 8 + (u.aux == 0 ? 0 : 8) + (wr * 4 + wc)) * 512 + (fq * 16 + fr);
#pragma unroll
        for (int ai = 0; ai < 2; ++ai) {
            u32x4 gv[4][2];
#pragma unroll
            for (int m = 0; m < 4; ++m)
#pragma unroll
                for (int bj = 0; bj < 2; ++bj) gv[m][bj] = gf[(size_t)bj * (2 * 8 * 512) + (ai * 4 + m) * 64];
#pragma unroll
            for (int m = 0; m < 4; ++m) { const int row = row0 + ai * HALF + m * 16;
#pragma unroll
                for (int bj = 0; bj < 2; ++bj) { const u32x4 g = gv[m][bj];
                    const f32x4 g0 = (f32x4){bflo(g.x), bfhi(g.x), bflo(g.y), bfhi(g.y)}, g1 = (f32x4){bflo(g.z), bfhi(g.z), bflo(g.w), bfhi(g.w)};
                    if (u.aux == 0) { acc[ai][bj][m][0] = acc[ai][bj][m][0] * g0; acc[ai][bj][m][1] = acc[ai][bj][m][1] * g1; }
                    else { const f32x4 o0 = acc[ai][bj][m][0] * g0 * ACT8_SCALE, o1 = acc[ai][bj][m][1] * g1 * ACT8_SCALE;
                        int w0 = __builtin_amdgcn_cvt_pk_fp8_f32(o0[0], o0[1], 0, false); w0 = __builtin_amdgcn_cvt_pk_fp8_f32(o0[2], o0[3], w0, true);
                        int w1 = __builtin_amdgcn_cvt_pk_fp8_f32(o1[0], o1[1], 0, false); w1 = __builtin_amdgcn_cvt_pk_fp8_f32(o1[2], o1[3], w1, true);
                        *(v2u*)((unsigned char*)O + (size_t)row * D + col0 + bj * HALF) = (v2u){(unsigned)w0, (unsigned)w1}; } } }
        }
        return u.aux == 0;
    }
};
struct EpiZ {
    const float* X; float* Z;
    __device__ __forceinline__ bool operator()(f32x4 (&acc)[2][2][4][2], const Unit& u, int wr, int wc, int fr, int fq) const {
        const int row0 = u.pm * BM + wr * 64 + fr, col0 = u.pn * BM + wc * 32 + 8 * fq;
        EPI_ROWLOOP { const size_t off = (size_t)(row0 + ai * HALF + m * 16) * D + col0;
#pragma unroll
            for (int bj = 0; bj < 2; ++bj)
#pragma unroll
                for (int n = 0; n < 2; ++n) { const f32x4 xv = *(const f32x4*)(X + off + bj * HALF + 4 * n); *(f32x4*)(Z + off + bj * HALF + 4 * n) = xv * DN_ALPHA + acc[ai][bj][m][n]; } }
        return false;
    }
};
struct EpiSwiglu {
    unsigned char* ACT; const float* bgu;
    __device__ __forceinline__ bool operator()(f32x4 (&acc)[2][2][4][2], const Unit& u, int wr, int wc, int fr, int fq) const {
        const int row0 = u.pm * BM + wr * 64 + fr, col0 = u.pn * HALF + wc * 32 + 8 * fq;
        const float* bp = bgu + (size_t)u.aux * (2 * FF) + col0;
        f32x4 bg[2], bu[2];
#pragma unroll
        for (int n = 0; n < 2; ++n) { bg[n] = *(const f32x4*)(bp + 4 * n); bu[n] = *(const f32x4*)(bp + FF + 4 * n); }
        EPI_ROWLOOP { f32x4 o[2];
#pragma unroll
            for (int n = 0; n < 2; ++n) { const f32x4 g = acc[ai][0][m][n] + bg[n], uu = acc[ai][1][m][n] + bu[n];
#pragma unroll
                for (int j = 0; j < 4; j += 2) {
                    f32x2 gc, uc; gc[0] = fminf(g[j], 7.0f); gc[1] = fminf(g[j + 1], 7.0f);
                    uc[0] = __builtin_amdgcn_fmed3f(uu[j], -7.0f, 7.0f); uc[1] = __builtin_amdgcn_fmed3f(uu[j + 1], -7.0f, 7.0f);
                    const f32x2 t = gc * (f32x2){-2.4554669595930156f, -2.4554669595930156f};
                    f32x2 d; d[0] = __builtin_amdgcn_exp2f(t[0]); d[1] = __builtin_amdgcn_exp2f(t[1]);
                    d = d + (f32x2){1.0f, 1.0f};
                    f32x2 r; r[0] = __builtin_amdgcn_rcpf(d[0]); r[1] = __builtin_amdgcn_rcpf(d[1]);
                    const f32x2 s = gc * r, oo = __builtin_elementwise_fma(uc, s, s);
                    o[n][j] = oo[0]; o[n][j + 1] = oo[1]; } }
            int w0 = __builtin_amdgcn_cvt_pk_fp8_f32(o[0][0], o[0][1], 0, false); w0 = __builtin_amdgcn_cvt_pk_fp8_f32(o[0][2], o[0][3], w0, true);
            int w1 = __builtin_amdgcn_cvt_pk_fp8_f32(o[1][0], o[1][1], 0, false); w1 = __builtin_amdgcn_cvt_pk_fp8_f32(o[1][2], o[1][3], w1, true);
            *(v2u*)(ACT + (size_t)(row0 + ai * HALF + m * 16) * FF + col0) = (v2u){(unsigned)w0, (unsigned)w1}; }
        return false;
    }
};
struct EpiDown {
    unsigned char* YS; const float* bdn; const int* rowslot; const float* roww;
    __device__ __forceinline__ bool operator()(f32x4 (&acc)[2][2][4][2], const Unit& u, int wr, int wc, int fr, int fq) const {
        const int row0 = u.pm * BM + wr * 64 + fr, col0 = u.pn * BM + wc * 32 + 8 * fq;
        const float* bp = bdn + (size_t)u.aux * D + col0;
        f32x4 bv[2][2];
#pragma unroll
        for (int bj = 0; bj < 2; ++bj)
#pragma unroll
            for (int n = 0; n < 2; ++n) bv[bj][n] = *(const f32x4*)(bp + bj * HALF + 4 * n);
        int slots[8]; float ws_[8];
#pragma unroll
        for (int q = 0; q < 8; ++q) { const int row = row0 + (q >> 2) * HALF + (q & 3) * 16; slots[q] = rowslot[row]; ws_[q] = roww[row]; }
        EPI_ROWLOOP { const int slot = slots[ai * 4 + m]; const float w = ws_[ai * 4 + m] * YS_SCALE;
            if (slot >= 0) { unsigned char* rowp = YS + (size_t)slot * D + col0;
#pragma unroll
                for (int bj = 0; bj < 2; ++bj) { const f32x4 o0 = (acc[ai][bj][m][0] + bv[bj][0]) * w, o1 = (acc[ai][bj][m][1] + bv[bj][1]) * w;
                    int w0 = __builtin_amdgcn_cvt_pk_fp8_f32(o0[0], o0[1], 0, false); w0 = __builtin_amdgcn_cvt_pk_fp8_f32(o0[2], o0[3], w0, true);
                    int w1 = __builtin_amdgcn_cvt_pk_fp8_f32(o1[0], o1[1], 0, false); w1 = __builtin_amdgcn_cvt_pk_fp8_f32(o1[2], o1[3], w1, true);
                    *(v2u*)(rowp + bj * HALF) = (v2u){(unsigned)w0, (unsigned)w1}; } } }
        return false;
    }
};
#undef EPI_ROWLOOP
}

#define XB_TMO      128
#define XB_XCNT(j)  (256  + 64 * (j))
#define XB_XSUB(j)  (1280 + 64 * (j))
#define XB_XGEN(j)  (2304 + 64 * (j))
#define XB_TOP      3328
#define XB_TOPGEN   3392
#define XCD_BAR_WORDS 3456
#define XB_SPIN_CAP (1u << 18)

__device__ __forceinline__ unsigned xb_ld(unsigned* p)              { return __hip_atomic_load(p, __ATOMIC_RELAXED, __HIP_MEMORY_SCOPE_AGENT); }
__device__ __forceinline__ unsigned xb_add(unsigned* p, unsigned v) { return __hip_atomic_fetch_add(p, v, __ATOMIC_RELAXED, __HIP_MEMORY_SCOPE_AGENT); }
__device__ __forceinline__ unsigned xb_xcc_id() { return (unsigned)__builtin_amdgcn_s_getreg((3 << 11) | 20) & 0xFu; }
#define XB_SPIN(cond, bar) do { unsigned _sp = 0; while (cond) { __builtin_amdgcn_s_sleep(1); \
    if ((++_sp & 255u) == 0u) { if (xb_ld(&(bar)[XB_TMO])) break; if (_sp > XB_SPIN_CAP) { atomicAdd(&(bar)[XB_TMO], 1u); break; } } } } while (0)

struct XcdBarrier {
    unsigned* bar; unsigned x;
    volatile LAS unsigned* st;
};

__device__ __forceinline__ XcdBarrier xcd_barrier_post(unsigned* bar, volatile LAS unsigned* st) {
    XcdBarrier b; b.bar = bar; b.x = xb_xcc_id(); b.st = st;
    if (threadIdx.x == 0) (void)xb_add(&bar[XB_XCNT(b.x)], 1u);
    return b;
}
__device__ __forceinline__ void xcd_barrier_complete(unsigned* bar, unsigned x, unsigned& nloc, unsigned& nx) {
    const unsigned G = gridDim.x * gridDim.y * gridDim.z;
    unsigned sum, cnt, mine, sp = 0u;
    for (;;) {
        sum = 0u; cnt = 0u; mine = 0u;
#pragma unroll
        for (unsigned j = 0; j < 16; ++j) { const unsigned c = xb_ld(&bar[XB_XCNT(j)]); sum += c; cnt += (c > 0u) ? 1u : 0u; mine = (j == x) ? c : mine; }
        if (sum == G) break;
        __builtin_amdgcn_s_sleep(1);
        if ((++sp & 255u) == 0u) { if (xb_ld(&bar[XB_TMO])) break; if (sp > XB_SPIN_CAP) { atomicAdd(&bar[XB_TMO], 1u); break; } }
    }
    nloc = mine > 0u ? mine : 1u; nx = cnt > 0u ? cnt : 1u;
}

__device__ __forceinline__ void xcd_barrier(const XcdBarrier& b) {
    asm volatile("s_waitcnt vmcnt(0)" ::: "memory");
    __syncthreads();
    if (threadIdx.x == 0) {
        unsigned* bar = b.bar;
        __builtin_amdgcn_s_waitcnt(0);
        unsigned nloc = b.st[0], nx = b.st[1];
        if (nloc == 0u) { xcd_barrier_complete(bar, b.x, nloc, nx); b.st[0] = nloc; b.st[1] = nx; }
        const unsigned old = xb_add(&bar[XB_XSUB(b.x)], 1u);
        const unsigned gen = old / nloc;
        if (old + 1u == (gen + 1u) * nloc) {
            __builtin_amdgcn_fence(__ATOMIC_RELEASE, "agent");
            asm volatile("s_waitcnt vmcnt(0)" ::: "memory");
            const unsigned og = xb_add(&bar[XB_TOP], 1u);
            const unsigned tg = og / nx;
            if (og + 1u == (tg + 1u) * nx) xb_add(&bar[XB_TOPGEN], 1u);
            else XB_SPIN(xb_ld(&bar[XB_TOPGEN]) == tg, bar);
            __builtin_amdgcn_fence(__ATOMIC_ACQUIRE, "agent");
            xb_add(&bar[XB_XGEN(b.x)], 1u);
            asm volatile("s_waitcnt vmcnt(0)" ::: "memory");
        } else {
            XB_SPIN(xb_ld(&bar[XB_XGEN(b.x)]) == gen, bar);
            __builtin_amdgcn_fence(__ATOMIC_ACQUIRE, "agent");
            asm volatile("s_waitcnt vmcnt(0)" ::: "memory");
        }
    }
    __syncthreads();
}
struct Frame {
    LAS unsigned char* lds;
    volatile LAS unsigned* MISC;
    gu32* ctl;
    int tid, lane, wave;
    int vcu, G;
    unsigned char* ws;
    __amdgpu_buffer_rsrc_t rsrc;
};

#define PHASE_FRAME(F0) Frame F = (F0); { int t_ = threadIdx.x; asm volatile("" : "+v"(t_)); F.tid = t_; F.lane = t_ & 63; F.wave = __builtin_amdgcn_readfirstlane(t_ >> 6); }

__device__ __forceinline__ void tr_item(const float* W, size_t ldw, int k0, int c0, bf16* WT, size_t ldt, int drow0, LAS float* scr, int lane) {
    const int kr = lane >> 4, cq = lane & 15;
    f32x4 v[16];
#pragma unroll
    for (int i = 0; i < 16; ++i) v[i] = *(const GAS f32x4*)(W + (size_t)(k0 + 4 * i + kr) * ldw + c0 + 4 * cq);
#pragma unroll
    for (int i = 0; i < 16; ++i)
#pragma unroll
        for (int j = 0; j < 4; ++j) scr[(4 * cq + j) * 65 + 4 * i + kr] = v[i][j];
    LDS_WAIT(); asm volatile("" ::: "memory");
    const int c = lane & 7;
#pragma unroll
    for (int jj = 0; jj < 8; ++jj) { const int n = (lane >> 3) + 8 * jj; const LAS float* s = scr + n * 65 + 8 * c;
        v4u o; o.x = pk2(s[0], s[1]); o.y = pk2(s[2], s[3]); o.z = pk2(s[4], s[5]); o.w = pk2(s[6], s[7]);
        *(GAS v4u*)(WT + (size_t)(drow0 + n) * ldt + k0 + 8 * c) = o; }
    LDS_WAIT(); asm volatile("" ::: "memory");
}

typedef short s16x2 __attribute__((ext_vector_type(2)));
struct MoeItem { __amdgpu_buffer_rsrc_t rs; unsigned soff, rstep; int ldw, k0; unsigned char* WT; size_t ldt; int drow; };
__device__ __forceinline__ void tr8_load(const MoeItem& m, f32x4 (&v)[16], int lane) {
    const int kr = lane >> 4, cq = lane & 15;
    const int voff = (kr * m.ldw + 4 * cq) * 4;
#pragma unroll
    for (int i = 0; i < 16; ++i) v[i] = __builtin_bit_cast(f32x4, __builtin_amdgcn_raw_buffer_load_b128(m.rs, voff, (int)(m.soff + (unsigned)i * m.rstep), 0));
}
__device__ __forceinline__ void tr8_finish(const f32x4 (&v)[16], const MoeItem& m, LAS float* scr_, int lane) {
    LAS unsigned char* scr = (LAS unsigned char*)scr_;
    const int kr = lane >> 4, cq = lane & 15;
#pragma unroll
    for (int j = 0; j < 4; ++j) { unsigned w[4];
#pragma unroll
        for (int q = 0; q < 4; ++q) { s16x2 t = {0, 0};
            t = __builtin_amdgcn_cvt_scalef32_pk_fp8_f32(t, v[4 * q][j], v[4 * q + 1][j], F8_CVT_SCALE, false);
            t = __builtin_amdgcn_cvt_scalef32_pk_fp8_f32(t, v[4 * q + 2][j], v[4 * q + 3][j], F8_CVT_SCALE, true);
            w[q] = __builtin_bit_cast(unsigned, t); }
        *(LAS v4u*)(scr + (4 * cq + j) * 80 + kr * 16) = (v4u){w[0], w[1], w[2], w[3]}; }
    LDS_WAIT(); asm volatile("" ::: "memory");
    const int qd = lane & 3;
#pragma unroll
    for (int ps = 0; ps < 4; ++ps) { const int n = (lane >> 2) + 16 * ps; const LAS unsigned char* s = scr + n * 80 + qd * 4;
        const unsigned d0 = *(const LAS unsigned*)(s), d1 = *(const LAS unsigned*)(s + 16), d2 = *(const LAS unsigned*)(s + 32), d3 = *(const LAS unsigned*)(s + 48);
        const unsigned t0 = __builtin_amdgcn_perm(d1, d0, 0x05010400u), t1 = __builtin_amdgcn_perm(d1, d0, 0x07030602u), t2 = __builtin_amdgcn_perm(d3, d2, 0x05010400u), t3 = __builtin_amdgcn_perm(d3, d2, 0x07030602u);
        const v4u o = (v4u){__builtin_amdgcn_perm(t2, t0, 0x05040100u), __builtin_amdgcn_perm(t2, t0, 0x07060302u), __builtin_amdgcn_perm(t3, t1, 0x05040100u), __builtin_amdgcn_perm(t3, t1, 0x07060302u)};
        *(GAS v4u*)(m.WT + (size_t)(m.drow + n) * m.ldt + m.k0 + 16 * qd) = o; }
    LDS_WAIT(); asm volatile("" ::: "memory");
}
constexpr int MOE_J4 = 32 * 32 * 64, MOE_J5 = 32 * 32 * 32, MOE_NITEMS = MOE_J4 + MOE_J5;
__device__ __forceinline__ MoeItem moe_item(int r, const float* w_gu, const float* w_down, unsigned char* ws) {
    MoeItem m;
    if (r < MOE_J4) { const int e = r / 2048, q = r % 2048, kb = q / 64, cb = q % 64, c0 = cb * 64; const int cc = c0 & 2047;
        m.rs = __builtin_amdgcn_make_buffer_rsrc((void*)w_gu, 0, 0xffffffff, 0x00020000); m.ldw = 2 * FF; m.k0 = kb * 64;
        m.soff = (unsigned)(((size_t)e * D * 2 * FF + (size_t)kb * 64 * (2 * FF) + c0) * 4); m.rstep = 4u * (2 * FF) * 4u;
        m.WT = ws + WS_WGUT + (size_t)e * 2 * FF * D; m.ldt = D; m.drow = (cc >> 7) * 256 + (c0 >= 2048 ? 128 : 0) + (cc & 127); }
    else { r -= MOE_J4; const int e = r / 1024, q = r % 1024, kb = q / 32, cb = q % 32;
        m.rs = __builtin_amdgcn_make_buffer_rsrc((void*)w_down, 0, 0xffffffff, 0x00020000); m.ldw = D; m.k0 = kb * 64;
        m.soff = (unsigned)(((size_t)e * FF * D + (size_t)kb * 64 * D + cb * 64) * 4); m.rstep = 4u * D * 4u;
        m.WT = ws + WS_WDNT + (size_t)e * D * FF; m.ldt = FF; m.drow = cb * 64; }
    return m;
}
__device__ __forceinline__ MoeItem f8_item(const float* W, int ldw, int k0, int c0, unsigned char* WT, size_t ldt, int drow) {
    MoeItem m; m.rs = __builtin_amdgcn_make_buffer_rsrc((void*)W, 0, 0xffffffff, 0x00020000); m.ldw = ldw; m.k0 = k0;
    m.soff = (unsigned)(((size_t)k0 * ldw + c0) * 4); m.rstep = 4u * (unsigned)ldw * 4u; m.WT = WT; m.ldt = ldt; m.drow = drow; return m;
}

struct In {
    const float *x, *w_in, *rel_bias, *shift_mu, *w0, *w_up, *a0, *a_up, *g_up, *k_k, *k_a, *r_k, *lnx_w, *lnx_b, *proj_a, *proj_b, *w_out,
                *ln1_w, *ln1_b, *w_router, *b_router, *w_gu, *b_gu, *w_down, *b_down, *ln2_w, *ln2_b;
};

__device__ __forceinline__ void p0_prologue(Frame& F0, const In& I) {
    PHASE_FRAME(F0);
    LAS float* scr = (LAS float*)(F.lds + F.wave * 16640);
    const int gw = F.vcu * NWAVES + F.wave, NGW = F.G * NWAVES;
    unsigned char* ws = F.ws;
    constexpr int J0 = 32 * 167, J1 = 16 * 32, J2 = 16 * 32, J3 = 32 * 32;
    constexpr int NITEMS = J0 + J1 + J2 + J3;
    for (int it = gw; it < NITEMS; it += NGW) {
        int r = it;
        if (r < J0) { const int kb = r / 167, cb = r % 167, c0 = cb * 64; bf16* dst; int drow;
            if (c0 < 3072) { f32x4 tv[16];
                   const MoeItem m = (c0 < 2048) ? f8_item(I.w_in, D_IN, kb * 64, c0, (unsigned char*)(ws + WS_WQK8), D, c0) : f8_item(I.w_in, D_IN, kb * 64, c0, (unsigned char*)(ws + WS_WV8), D, c0 - 2048);
                   tr8_load(m, tv, F.lane); tr8_finish(tv, m, scr, F.lane); continue; }
            else if (c0 < 6592) { f32x4 tv[16]; const MoeItem m = f8_item(I.w_in, D_IN, kb * 64, c0, (unsigned char*)(ws + WS_WSV8), D, c0 - 3072);
                   tr8_load(m, tv, F.lane); tr8_finish(tv, m, scr, F.lane); continue; }
            else { f32x4 tv[16]; const int cg = c0 - 6592, d0 = cg & 2047; const MoeItem m = f8_item(I.w_in, D_IN, kb * 64, c0, (unsigned char*)(ws + WS_WG8), D, (d0 >> 7) * 256 + (cg >= 2048 ? 128 : 0) + (d0 & 127));
                   tr8_load(m, tv, F.lane); tr8_finish(tv, m, scr, F.lane); continue; }
            (void)dst; (void)drow; continue; } r -= J0;
        if (r < J1) { const int kb = r / 32, cb = r % 32; f32x4 tv[16]; const MoeItem m = f8_item(I.proj_a, D, kb * 64, cb * 64, (unsigned char*)(ws + WS_PAT), AW, cb * 64); tr8_load(m, tv, F.lane); tr8_finish(tv, m, scr, F.lane); continue; } r -= J1;
        if (r < J2) { const int kb = r / 32, cb = r % 32; f32x4 tv[16]; const MoeItem m = f8_item(I.proj_b, D, kb * 64, cb * 64, (unsigned char*)(ws + WS_PBT), RW, cb * 64); tr8_load(m, tv, F.lane); tr8_finish(tv, m, scr, F.lane); continue; } r -= J2;
        { const int kb = r / 32, cb = r % 32; f32x4 tv[16]; const MoeItem m = f8_item(I.w_out, D, kb * 64, cb * 64, (unsigned char*)(ws + WS_WOT), D, cb * 64);
          tr8_load(m, tv, F.lane); tr8_finish(tv, m, scr, F.lane); }
    }
    const int gt = F.vcu * (NWAVES * 64) + F.tid, NGT = F.G * NWAVES * 64;
    for (int i = gt; i < 2048 * 256; i += NGT) { const int n = i >> 8, k = i & 255; float v = 0.f;
        if (n < 1024) { if (k < DLORA) v = I.w_up[(size_t)k * RW + n]; }
        else { if (k >= 128 && k < 128 + ALORA) v = I.a_up[(size_t)(k - 128) * RW + (n - 1024)]; }
        ((bf16*)(ws + WS_WLA))[i] = (bf16)f2bf(v); }
    for (int i = gt; i < 1024 * 256; i += NGT) { const int n = i >> 8, k = i & 255; ((bf16*)(ws + WS_WLG))[i] = (bf16)f2bf(I.g_up[(size_t)k * RW + n]); }
    for (int i = gt; i < 64 * D / 16; i += NGT) ((GAS v4u*)((unsigned char*)(ws + WS_WSV8) + (size_t)SHIFT_W * D))[i] = (v4u){0u, 0u, 0u, 0u};
    for (int i = gt; i < RROWS; i += NGT) ((int*)(ws + WS_ROWSLOT))[i] = -1;
    for (size_t i = gt; i < (size_t)T * D / 8; i += NGT) { const f32x4 a = ((const GAS f32x4*)I.x)[2 * i], b = ((const GAS f32x4*)I.x)[2 * i + 1];
        int w0 = __builtin_amdgcn_cvt_pk_fp8_f32(a.x, a.y, 0, false); w0 = __builtin_amdgcn_cvt_pk_fp8_f32(a.z, a.w, w0, true);
        int w1 = __builtin_amdgcn_cvt_pk_fp8_f32(b.x, b.y, 0, false); w1 = __builtin_amdgcn_cvt_pk_fp8_f32(b.z, b.w, w1, true);
        ((GAS v2u*)(ws + WS_XB8))[i] = (v2u){(unsigned)w0, (unsigned)w1}; }
}

constexpr int P8_HS = 0, P8_PITCH = 2052, P8_PART = 131328, P8_LOG = 147712, P8_HIST = 149760;
template <bool SKIP_MIX>
__device__ __forceinline__ void p8_ln_router(Frame& F0, const In& I) {
    PHASE_FRAME(F0);
    LAS float* hs = (LAS float*)(F.lds + P8_HS); LAS float* part = (LAS float*)(F.lds + P8_PART); LAS float* lg = (LAS float*)(F.lds + P8_LOG); LAS int* hist = (LAS int*)(F.lds + P8_HIST);
    const int lane = F.lane, w = F.wave;
    if (F.tid < 32) hist[F.tid] = 0;
    const int kq = lane >> 4, col = lane & 15;
    float ln_w[32], ln_b[32];
#pragma unroll
    for (int j = 0; j < 8; ++j) { const f32x4 a = *(const GAS f32x4*)(I.ln1_w + 4 * lane + 256 * j), b = *(const GAS f32x4*)(I.ln1_b + 4 * lane + 256 * j);
#pragma unroll
        for (int e = 0; e < 4; ++e) { ln_w[4 * j + e] = a[e]; ln_b[4 * j + e] = b[e]; } }
    __syncthreads();
    const float* zsrc = I.x; const bf16* mixb = (const bf16*)(F.ws + WS_Z);
    for (int g = F.vcu; g < T / 16; g += F.G) {
        const int tok0 = g * 16;
        { f32x4 va[8], vb[8];
          const size_t tokA = (size_t)(tok0 + 2 * w), tokB = tokA + 1;
          const GAS f32x4* zra = (const GAS f32x4*)(zsrc + tokA * D) + lane; const GAS f32x4* zrb = (const GAS f32x4*)(zsrc + tokB * D) + lane;
          const GAS v2u* mra = (const GAS v2u*)(mixb + tokA * D) + lane; const GAS v2u* mrb = (const GAS v2u*)(mixb + tokB * D) + lane;
          v2u ma[8], mb[8];
#pragma unroll
          for (int j = 0; j < 8; ++j) { va[j] = zra[64 * j]; vb[j] = zrb[64 * j]; if (!SKIP_MIX) { ma[j] = mra[64 * j]; mb[j] = mrb[64 * j]; } }
#pragma unroll
          for (int j = 0; j < 8; ++j) { va[j] = va[j] * DN_ALPHA; vb[j] = vb[j] * DN_ALPHA;
              if (!SKIP_MIX) { va[j] += (f32x4){bflo(ma[j].x), bfhi(ma[j].x), bflo(ma[j].y), bfhi(ma[j].y)}; vb[j] += (f32x4){bflo(mb[j].x), bfhi(mb[j].x), bflo(mb[j].y), bfhi(mb[j].y)}; } }
#pragma unroll
          for (int tt = 0; tt < 2; ++tt) {
            const int tl = 2 * w + tt; const size_t tok = (size_t)(tok0 + tl);
            f32x4 v[8]; float s = 0.f;
#pragma unroll
            for (int j = 0; j < 8; ++j) { v[j] = tt ? vb[j] : va[j]; s += (v[j].x + v[j].y) + (v[j].z + v[j].w); }
            const float mean = wave_sum(s) * (1.f / D); float s2 = 0.f;
#pragma unroll
            for (int j = 0; j < 8; ++j) { v[j] = v[j] - mean; s2 += (v[j].x * v[j].x + v[j].y * v[j].y) + (v[j].z * v[j].z + v[j].w * v[j].w); }
            const float rstd = 1.f / sqrtf(wave_sum(s2) * (1.f / D) + LN_EPS);
            GAS v2u* h1 = (GAS v2u*)((bf16*)(F.ws + WS_H1) + tok * D) + lane;
            GAS unsigned* h1b = (GAS unsigned*)((unsigned char*)(F.ws + WS_H1B) + tok * D) + lane;
#pragma unroll
            for (int j = 0; j < 8; ++j) { f32x4 h;
#pragma unroll
                for (int e = 0; e < 4; ++e) h[e] = v[j][e] * rstd * ln_w[4 * j + e] + ln_b[4 * j + e];
                h1[64 * j] = (v2u){pg8::cvt_pk_bf16(h.x, h.y), pg8::cvt_pk_bf16(h.z, h.w)}; { int w8 = __builtin_amdgcn_cvt_pk_fp8_f32(h.x, h.y, 0, false); w8 = __builtin_amdgcn_cvt_pk_fp8_f32(h.z, h.w, w8, true); h1b[64 * j] = (unsigned)w8; }
                *(LAS f32x4*)(hs + tl * P8_PITCH + 4 * lane + 256 * j) = h; }
          } }
        __syncthreads();
        f32x4 c0 = (f32x4){0.f, 0.f, 0.f, 0.f}, c1 = c0;
        const LAS float* ap = hs + col * P8_PITCH + 256 * w + 4 * kq;
        const float* bp = I.w_router + (size_t)(256 * w + 4 * kq) * NE + col;
#pragma unroll 4
        for (int kk = 0; kk < 16; ++kk) {
            const f32x4 a = *(const LAS f32x4*)(ap + 16 * kk);
#pragma unroll
            for (int e = 0; e < 4; ++e) {
                const float b0 = bp[(size_t)(16 * kk + e) * NE], b1 = bp[(size_t)(16 * kk + e) * NE + 16];
                c0 = __builtin_amdgcn_mfma_f32_16x16x4f32(a[e], b0, c0, 0, 0, 0);
                c1 = __builtin_amdgcn_mfma_f32_16x16x4f32(a[e], b1, c1, 0, 0, 0);
            }
        }
#pragma unroll
        for (int i = 0; i < 4; ++i) { part[(w * 16 + 4 * kq + i) * 32 + col] = c0[i]; part[(w * 16 + 4 * kq + i) * 32 + 16 + col] = c1[i]; }
        __syncthreads();
        { const int tl = F.tid >> 5, e = F.tid & 31; float s = I.b_router[e];
#pragma unroll
            for (int ww = 0; ww < 8; ++ww) s += part[(ww * 16 + tl) * 32 + e];
            lg[tl * 32 + e] = s; }
        __syncthreads();
        if (F.tid < 16) {
            const int tl = F.tid; float lv[32];
#pragma unroll
            for (int e = 0; e < 32; ++e) lv[e] = lg[tl * 32 + e];
            int ti[4]; float tv[4];
#pragma unroll
            for (int k = 0; k < 4; ++k) { float best = -3.4e38f; int bi = 0;
#pragma unroll
                for (int e = 0; e < 32; ++e) { const bool tk = lv[e] > best; best = tk ? lv[e] : best; bi = tk ? e : bi; }
                ti[k] = bi; tv[k] = best;
#pragma unroll
                for (int e = 0; e < 32; ++e) lv[e] = (e == bi) ? -3.4e38f : lv[e]; }
            float ex[4], sum = 0.f;
#pragma unroll
            for (int k = 0; k < 4; ++k) { ex[k] = __expf(tv[k] - tv[0]); sum += ex[k]; }
            const float inv = 1.f / sum;
            *(GAS v4u*)((int*)(F.ws + WS_TOPI) + (size_t)(tok0 + tl) * 4) = (v4u){(unsigned)ti[0], (unsigned)ti[1], (unsigned)ti[2], (unsigned)ti[3]};
            *(GAS f32x4*)((float*)(F.ws + WS_GATE) + (size_t)(tok0 + tl) * 4) = (f32x4){ex[0] * inv, ex[1] * inv, ex[2] * inv, ex[3] * inv};
#pragma unroll
            for (int k = 0; k < 4; ++k) __hip_atomic_fetch_add(&hist[ti[k]], 1, __ATOMIC_RELAXED, __HIP_MEMORY_SCOPE_WORKGROUP);
        }
        __syncthreads();
    }
    if (F.tid < 32) { const int c = hist[F.tid]; if (c) __hip_atomic_fetch_add(F.ctl + CW_CNT + F.tid, (unsigned)c, RLX_AGENT); }
}

template <bool SKIP_MOE>
__device__ __forceinline__ void p12_final(Frame& F0, const In& I, float* out) {
    PHASE_FRAME(F0);
    const int lane = F.lane; const int gw = F.vcu * NWAVES + F.wave, NGW = F.G * NWAVES;
    LAS f32x4* lnp = (LAS f32x4*)(F.lds);
    for (int u = F.tid; u < D / 4; u += NWAVES * 64) { lnp[u] = *(const GAS f32x4*)(I.ln2_w + 4 * u); lnp[D / 4 + u] = *(const GAS f32x4*)(I.ln2_b + 4 * u); }
    __syncthreads();
    v2u hraw[8]; unsigned yraw[4][8];
#define P12_LOAD(tok_) do { const unsigned hoff = (unsigned)(WS_H1 + (size_t)(tok_) * D * 2) + (unsigned)lane * 8u;        \
        _Pragma("unroll") for (int j = 0; j < 8; ++j) hraw[j] = *(const GAS v2u*)(F.ws + (size_t)(hoff + 512u * j)); \
        if (!SKIP_MOE) { const unsigned yoff = (unsigned)(WS_YSLOT + (size_t)(tok_) * 4 * D) + (unsigned)lane * 4u; \
            _Pragma("unroll") for (int k = 0; k < 4; ++k) { _Pragma("unroll") for (int j = 0; j < 8; ++j) yraw[k][j] = *(const GAS unsigned*)(F.ws + (size_t)(yoff + 2048u * k + 256u * j)); } } } while (0)
    if (gw < T) P12_LOAD(gw);
    for (int tok = gw; tok < T; tok += NGW) {
        f32x4 v[8]; float s = 0.f;
#pragma unroll
        for (int j = 0; j < 8; ++j) { const v2u hh = hraw[j]; v[j] = (f32x4){bflo(hh.x), bfhi(hh.x), bflo(hh.y), bfhi(hh.y)} * DN_ALPHA; }
        if (!SKIP_MOE) {
#pragma unroll
            for (int k = 0; k < 4; ++k) {
#pragma unroll
                for (int j = 0; j < 8; ++j) { const unsigned y = yraw[k][j]; const f32x2 lo = __builtin_amdgcn_cvt_pk_f32_fp8((int)y, false), hi = __builtin_amdgcn_cvt_pk_f32_fp8((int)y, true);
                    v[j].x += lo.x * YS_INV; v[j].y += lo.y * YS_INV; v[j].z += hi.x * YS_INV; v[j].w += hi.y * YS_INV; } }
        }
        __builtin_amdgcn_sched_barrier(0);
        if (tok + NGW < T) P12_LOAD(tok + NGW);
        __builtin_amdgcn_sched_barrier(0);
#pragma unroll
        for (int j = 0; j < 8; ++j) s += (v[j].x + v[j].y) + (v[j].z + v[j].w);
        const float mean = wave_sum(s) * (1.f / D); float s2 = 0.f;
#pragma unroll
        for (int j = 0; j < 8; ++j) { v[j] = v[j] - mean; s2 += (v[j].x * v[j].x + v[j].y * v[j].y) + (v[j].z * v[j].z + v[j].w * v[j].w); }
        const float rstd = 1.f / sqrtf(wave_sum(s2) * (1.f / D) + LN_EPS);
        GAS f32x4* o = (GAS f32x4*)(out + (size_t)tok * D) + lane;
#pragma unroll
        for (int j = 0; j < 8; ++j) { f32x4 h;
            const f32x4 lw = lnp[lane + 64 * j], lb = lnp[D / 4 + lane + 64 * j];
#pragma unroll
            for (int e = 0; e < 4; ++e) h[e] = v[j][e] * rstd * lw[e] + lb[e];
            o[64 * j] = h; }
    }
#undef P12_LOAD
}
__device__ __forceinline__ void moe_tables(Frame& F) {
    LAS int* tab = (LAS int*)(F.lds + TAB_OFF);
    if (F.tid == 0) { int run = 0;
        for (int e = 0; e < NE; ++e) { const int c = (int)__hip_atomic_load(F.ctl + CW_CNT + e, RLX_AGENT); const int p = (c + 255) / 256 * 256; tab[32 + e] = run; run += p; tab[e] = run; }
        tab[64] = run / 256; }
    __syncthreads();
}

__device__ __forceinline__ void p9_scatter(Frame& F0, const In& I) {
    PHASE_FRAME(F0);
    moe_tables(F);
    LAS int* tab = (LAS int*)(F.lds + TAB_OFF);
    LAS int* lh = (LAS int*)(F.lds + 0);
    LAS int* lb = (LAS int*)(F.lds + 128);
    LAS int* dst = (LAS int*)(F.lds + 256);
    const int* topi = (const int*)(F.ws + WS_TOPI); const float* gate = (const float*)(F.ws + WS_GATE);
    for (int ch = F.vcu; ch < T / 128; ch += F.G) {
        if (F.tid < 32) lh[F.tid] = 0;
        __syncthreads();
        const int s = ch * 512 + F.tid; const int e = topi[s]; const float gv = gate[s];
        const int rank = __hip_atomic_fetch_add(&lh[e], 1, __ATOMIC_RELAXED, __HIP_MEMORY_SCOPE_WORKGROUP);
        __syncthreads();
        if (F.tid < 32) { const int c = lh[F.tid]; lb[F.tid] = c ? (int)__hip_atomic_fetch_add(F.ctl + CW_CUR + F.tid, (unsigned)c, RLX_AGENT) : 0; }
        __syncthreads();
        const int d = tab[32 + e] + lb[e] + rank;
        ((int*)(F.ws + WS_ROWSLOT))[d] = s; ((float*)(F.ws + WS_ROWW))[d] = gv; dst[F.tid] = d;
        __syncthreads();
#pragma unroll 1
        for (int i0 = F.wave * 64; i0 < F.wave * 64 + 64; i0 += 8) {
            v4u v[8][2]; int dd[8];
#pragma unroll
            for (int q = 0; q < 8; ++q) { const int i = i0 + q; const int tok = ch * 128 + (i >> 2); dd[q] = dst[i];
                const GAS v4u* src = (const GAS v4u*)((const unsigned char*)(F.ws + WS_H1B) + (size_t)tok * D) + F.lane;
                v[q][0] = src[0]; v[q][1] = src[64]; }
#pragma unroll
            for (int q = 0; q < 8; ++q) { GAS v4u* o = (GAS v4u*)((unsigned char*)(F.ws + WS_XG) + (size_t)dd[q] * D) + F.lane; o[0] = v[q][0]; o[64] = v[q][1]; }
        }
        __syncthreads();
    }
}

__device__ __forceinline__ void p10_moe_up(Frame& F0, const In& I) {
    PHASE_FRAME(F0);
    moe_tables(F);
    LAS int* tab = (LAS int*)(F.lds + TAB_OFF);
    pg8::SchedMoe S; S.t.init(tab[64], 16, F.G, (int)blockIdx.x);
    S.A = (unsigned)(WS_XG); S.B = (unsigned)(WS_WGUT); S.tsA = (unsigned)256 * D; S.tsB = (unsigned)256 * D; S.es = (unsigned)2 * FF * D; S.pad_end = tab;
    pg8::EpiSwiglu E{(unsigned char*)(F.ws + WS_ACT), I.b_gu};
    pg8::gemm_phase<pg8::EpiSwiglu, pg8::SchedMoe, true, true>(F.lds + RING_OFF, F.rsrc, D / 2, D / 2, D / 2, S, E);
}
__device__ __forceinline__ void p11_moe_down(Frame& F0, const In& I) {
    PHASE_FRAME(F0);
    moe_tables(F);
    LAS int* tab = (LAS int*)(F.lds + TAB_OFF);
    pg8::SchedMoe S; S.t.init(tab[64], 8, F.G, (int)blockIdx.x);
    S.A = (unsigned)(WS_ACT); S.B = (unsigned)(WS_WDNT); S.tsA = (unsigned)256 * FF; S.tsB = (unsigned)256 * FF; S.es = (unsigned)D * FF; S.pad_end = tab;
    pg8::EpiDown E{(unsigned char*)(F.ws + WS_YSLOT), I.b_down, (const int*)(F.ws + WS_ROWSLOT), (const float*)(F.ws + WS_ROWW)};
    pg8::gemm_phase<pg8::EpiDown, pg8::SchedMoe, true, true>(F.lds + RING_OFF, F.rsrc, FF / 2, FF / 2, FF / 2, S, E);
}

__device__ __forceinline__ void p1_proj(Frame& F0, const In& I) {
    PHASE_FRAME(F0);
    { pg8::SchedPlain S; S.t.init(T / 256, SEG_PAD / 256, F.G, (int)blockIdx.x);
      S.A = (unsigned)(WS_XB8); S.B = (unsigned)(WS_WSV8); S.tsA = (unsigned)256 * D; S.tsB = (unsigned)256 * D;
      pg8::EpiShift E{(bf16*)(F.ws + WS_RKV), (bf16*)(F.ws + WS_LORAIN), (float*)(F.ws + WS_SIDE0), (float*)(F.ws + WS_SIDEL), I.shift_mu};
      pg8::gemm_phase<pg8::EpiShift, pg8::SchedPlain, true, true>(F.lds + RING_OFF, F.rsrc, D / 2, D / 2, D / 2, S, E); }
    { pg8::SchedPlain S; S.t.init(T / 256, (2 * AW) / 256, F.G, (int)blockIdx.x);
      S.A = (unsigned)(WS_XB8); S.B = (unsigned)(WS_WQK8); S.tsA = (unsigned)256 * D; S.tsB = (unsigned)256 * D;
      pg8::EpiProj E{(bf16*)(F.ws + WS_PROJ), 0, 4};
      pg8::gemm_phase<pg8::EpiProj, pg8::SchedPlain, true, true>(F.lds + RING_OFF, F.rsrc, D / 2, D / 2, D / 2, S, E); }
    { pg8::SchedPlain S; S.t.init(T / 256, (2 * D) / 256, F.G, (int)blockIdx.x);
      S.A = (unsigned)(WS_XB8); S.B = (unsigned)(WS_WG8); S.tsA = (unsigned)256 * D; S.tsB = (unsigned)256 * D;
      pg8::EpiGate E{(bf16*)(F.ws + WS_GATEF)};
      pg8::gemm_phase<pg8::EpiGate, pg8::SchedPlain, true, true>(F.lds + RING_OFF, F.rsrc, D / 2, D / 2, D / 2, S, E); }
    { pg8::SchedPlain S; S.t.init(AW / 256, T / 256, F.G, (int)blockIdx.x);
      S.A = (unsigned)(WS_WV8); S.B = (unsigned)(WS_XB8); S.tsA = (unsigned)256 * D; S.tsB = (unsigned)256 * D;
      pg8::EpiBf16 E{(bf16*)(F.ws + WS_VT), T};
      pg8::gemm_phase<pg8::EpiBf16, pg8::SchedPlain, true, true>(F.lds + RING_OFF, F.rsrc, D / 2, D / 2, D / 2, S, E); }
}

__device__ __forceinline__ float ftanh(float x) { return 2.0f * fsigmoid(2.0f * x) - 1.0f; }
__device__ __forceinline__ void p2_shift_attn(Frame& F0, const In& I) {
    PHASE_FRAME(F0);
    const int lane = F.lane; const int gw = F.vcu * NWAVES + F.wave, NGW = F.G * NWAVES;
    const bf16* PROJ = (const bf16*)(F.ws + WS_PROJ);
    for (int g = gw; g < T / 64; g += NGW) {
        const int tok = g * 64; const bool first = (tok % SEQ) == 0;
        const float* cur = (const float*)(F.ws + WS_SIDE0) + (size_t)g * SEG_PAD; const float* prv = (const float*)(F.ws + WS_SIDEL) + (size_t)(g - 1) * SEG_PAD;
        bf16* rkv = (bf16*)(F.ws + WS_RKV) + (size_t)tok * (3 * RW); bf16* lin = (bf16*)(F.ws + WS_LORAIN) + (size_t)tok * LORA_LD;
#pragma unroll 1
        for (int it = 0; it < 7; ++it) { const int gi = it * 64 + lane; if (gi >= SHIFT_W / 8) break; const int c = gi * 8;
            const f32x4 c0 = *(const GAS f32x4*)(cur + c), c1 = *(const GAS f32x4*)(cur + c + 4);
            f32x4 p0 = (f32x4){0.f, 0.f, 0.f, 0.f}, p1 = p0; if (!first) { p0 = *(const GAS f32x4*)(prv + c); p1 = *(const GAS f32x4*)(prv + c + 4); }
            const f32x4 m0 = *(const GAS f32x4*)(I.shift_mu + c), m1 = *(const GAS f32x4*)(I.shift_mu + c + 4);
            float v[8];
#pragma unroll
            for (int j = 0; j < 4; ++j) { v[j] = c0[j] + (p0[j] - c0[j]) * m0[j]; v[4 + j] = c1[j] + (p1[j] - c1[j]) * m1[j]; }
            bf16* dstp;
            if (c < 3 * RW) dstp = rkv + c;
            else if (c < 3 * RW + DLORA) { dstp = lin + (c - 3 * RW);
#pragma unroll
                for (int j = 0; j < 8; ++j) v[j] = ftanh(v[j]); }
            else if (c < 3 * RW + DLORA + ALORA) dstp = lin + 128 + (c - 3 * RW - DLORA);
            else { dstp = lin + 256 + (c - 3 * RW - DLORA - ALORA);
#pragma unroll
                for (int j = 0; j < 8; ++j) v[j] = fsigmoid(v[j]); }
            *(GAS v4u*)dstp = (v4u){pk2(v[0], v[1]), pk2(v[2], v[3]), pk2(v[4], v[5]), pk2(v[6], v[7])};
        }
    }
#if STAGE == 3
    { const int gt = F.vcu * (NWAVES * 64) + F.tid, NGT = F.G * NWAVES * 64;
      for (size_t i = gt; i < (size_t)T * RW / 8; i += NGT) ((GAS v4u*)(F.ws + WS_YB))[i] = (v4u){0u, 0u, 0u, 0u}; }
#endif
    LAS float* tbl = (LAS float*)(F.lds + 0);
    constexpr int AKV = 64 * 144, A_KOFF = 2048, A_VOFF = A_KOFF + 2 * AKV;
    const bf16* VT = (const bf16*)(F.ws + WS_VT); bf16* YA = (bf16*)(F.ws + WS_YA);
    const int r = lane & 31, hh = lane >> 5;
    const int rp = (r & 16) + 8 * ((r >> 2) & 1) + 4 * ((r >> 3) & 1) + (r & 3);
    const int srow = F.tid >> 3, spc = F.tid & 7;
    for (int task = F.vcu; task < BATCH * AH * (SEQ / 256); task += F.G) {
        const int bh = task >> 5, q256 = task & 31, b = bh >> 4, h = bh & 15, c0 = q256 * 4;
        const int q0 = q256 * 256 + F.wave * 32, cw = c0 + (F.wave >> 1);
        const int kc_lo = (c0 > LEFT) ? c0 - LEFT : 0, kc_hi = c0 + 3;
        __syncthreads();
        if (F.tid < REL_TABLE) tbl[F.tid] = I.rel_bias[h * REL_TABLE + F.tid];
        const size_t tokq = (size_t)b * SEQ + q0 + r;
        bf16x8 qf[4];
#pragma unroll
        for (int s = 0; s < 4; ++s) qf[s] = *(const GAS bf16x8*)(PROJ + tokq * PROJ_LD + PJ_Q + h * 64 + 16 * s + 8 * hh);
        f32x16 o0, o1;
#pragma unroll
        for (int i = 0; i < 16; ++i) { o0[i] = 0.f; o1[i] = 0.f; }
        float m_run = -1e30f, l_run = 0.f;
        v4u kreg, vreg;
#define AT_STAGE_LOAD(kc_) do { kreg = *(const GAS v4u*)(PROJ + ((size_t)b * SEQ + (size_t)(kc_) * 64 + srow) * PROJ_LD + PJ_K + h * 64 + spc * 8); \
                                vreg = *(const GAS v4u*)(VT + (size_t)(h * 64 + srow) * T + (size_t)b * SEQ + (size_t)(kc_) * 64 + spc * 8); } while (0)
#define AT_STAGE_WRITE(buf_) do { *(LAS v4u*)(F.lds + A_KOFF + (buf_) * AKV + srow * 144 + spc * 16) = kreg; *(LAS v4u*)(F.lds + A_VOFF + (buf_) * AKV + srow * 144 + spc * 16) = vreg; } while (0)
        AT_STAGE_LOAD(kc_lo); AT_STAGE_WRITE(0);
        __syncthreads();
#pragma unroll 1
        for (int kc = kc_lo; kc <= kc_hi; ++kc) {
            const int buf = (kc - kc_lo) & 1;
            if (kc < kc_hi) AT_STAGE_LOAD(kc + 1);
            if (kc >= cw - LEFT && kc <= cw) {
                const LAS unsigned char* Kb = F.lds + A_KOFF + buf * AKV; const LAS unsigned char* Vb = F.lds + A_VOFF + buf * AKV;
#pragma unroll
                for (int tt = 0; tt < 2; ++tt) {
                    const int kpos0 = kc * 64 + 32 * tt;
                    bf16x8 kf[4], va[2], vb[2];
#pragma unroll
                    for (int s = 0; s < 4; ++s) kf[s] = *(const LAS bf16x8*)(Kb + (32 * tt + rp) * 144 + 32 * s + 16 * hh);
#pragma unroll
                    for (int s2 = 0; s2 < 2; ++s2) { va[s2] = *(const LAS bf16x8*)(Vb + r * 144 + 64 * tt + 32 * s2 + 16 * hh); vb[s2] = *(const LAS bf16x8*)(Vb + (32 + r) * 144 + 64 * tt + 32 * s2 + 16 * hh); }
                    f32x16 st;
#pragma unroll
                    for (int i = 0; i < 16; ++i) st[i] = 0.f;
#pragma unroll
                    for (int s = 0; s < 4; ++s) st = __builtin_amdgcn_mfma_f32_32x32x16_bf16(kf[s], qf[s], st, 0, 0, 0);
                    const int dbase = (q0 + r) - (kpos0 + 8 * hh);
                    float mx = -1e30f;
                    if (q0 - (kpos0 + 31) >= MAX_PAST) {
                        const float bc = tbl[MAX_PAST + 63];
#pragma unroll
                        for (int i = 0; i < 16; ++i) { st[i] += bc; mx = fmaxf(mx, st[i]); }
                    } else {
#pragma unroll
                        for (int i = 0; i < 16; ++i) { int d = dbase - (16 * (i >> 3) + 4 * ((i >> 2) & 1) + (i & 3)); d = d < MAX_PAST ? d : MAX_PAST; st[i] += tbl[d + 63]; mx = fmaxf(mx, st[i]); }
                    }
                    mx = fmaxf(mx, __shfl_xor(mx, 32));
                    const float m_new = fmaxf(m_run, mx), alpha = __expf(m_run - m_new);
                    float ls = 0.f;
#pragma unroll
                    for (int i = 0; i < 16; ++i) { st[i] = __expf(st[i] - m_new); ls += st[i]; }
                    l_run = l_run * alpha + ls;
                    if (__builtin_amdgcn_ballot_w64(m_new != m_run)) {
#pragma unroll
                        for (int i = 0; i < 16; ++i) { o0[i] *= alpha; o1[i] *= alpha; } }
                    m_run = m_new;
#pragma unroll
                    for (int s2 = 0; s2 < 2; ++s2) {
                        v4u pw; pw.x = pg8::cvt_pk_bf16(st[8 * s2 + 0], st[8 * s2 + 1]); pw.y = pg8::cvt_pk_bf16(st[8 * s2 + 2], st[8 * s2 + 3]); pw.z = pg8::cvt_pk_bf16(st[8 * s2 + 4], st[8 * s2 + 5]); pw.w = pg8::cvt_pk_bf16(st[8 * s2 + 6], st[8 * s2 + 7]);
                        const bf16x8 pf = __builtin_bit_cast(bf16x8, pw);
                        o0 = __builtin_amdgcn_mfma_f32_32x32x16_bf16(va[s2], pf, o0, 0, 0, 0);
                        o1 = __builtin_amdgcn_mfma_f32_32x32x16_bf16(vb[s2], pf, o1, 0, 0, 0);
                    }
                }
            }
            if (kc < kc_hi) AT_STAGE_WRITE(buf ^ 1);
            __syncthreads();
        }
#undef AT_STAGE_LOAD
#undef AT_STAGE_WRITE
        const float inv = 1.0f / (l_run + __shfl_xor(l_run, 32));
        unsigned char* yo = (unsigned char*)YA + tokq * AW + h * 64 + 4 * hh;
        const float inv16 = inv * ACT8_SCALE;
#pragma unroll
        for (int g4 = 0; g4 < 4; ++g4) {
            int w0 = __builtin_amdgcn_cvt_pk_fp8_f32(o0[4 * g4] * inv16, o0[4 * g4 + 1] * inv16, 0, false); w0 = __builtin_amdgcn_cvt_pk_fp8_f32(o0[4 * g4 + 2] * inv16, o0[4 * g4 + 3] * inv16, w0, true);
            int w1 = __builtin_amdgcn_cvt_pk_fp8_f32(o1[4 * g4] * inv16, o1[4 * g4 + 1] * inv16, 0, false); w1 = __builtin_amdgcn_cvt_pk_fp8_f32(o1[4 * g4 + 2] * inv16, o1[4 * g4 + 3] * inv16, w1, true);
            *(GAS unsigned*)(yo + 8 * g4) = (unsigned)w0; *(GAS unsigned*)(yo + 32 + 8 * g4) = (unsigned)w1;
        }
    }
}

__device__ __forceinline__ void p6_merged(Frame& F0, const In& I) {
    PHASE_FRAME(F0);
    pg8::SchedTwo S; S.t.init(T / 256, D / 256, F.G, (int)blockIdx.x);
    S.A0 = (unsigned)(WS_YA); S.A1 = (unsigned)(WS_YB); S.B0 = (unsigned)(WS_PAT); S.B1 = (unsigned)(WS_PBT);
    S.tsA = (unsigned)256 * AW; S.tsB = (unsigned)256 * AW;
    pg8::EpiMerged E{(const bf16*)(F.ws + WS_GATEF), (bf16*)(F.ws + WS_MERGED)};
    pg8::gemm_phase<pg8::EpiMerged, pg8::SchedTwo, true, true, 0x00007b79>(F.lds + RING_OFF, F.rsrc, AW / 2, AW / 2, AW / 2, S, E);
}
__device__ __forceinline__ void p7_mix(Frame& F0, const In& I) {
    PHASE_FRAME(F0);
    pg8::SchedPlain S; S.t.init(T / 256, D / 256, F.G, (int)blockIdx.x);
    S.A = (unsigned)(WS_MERGED); S.B = (unsigned)(WS_WOT); S.tsA = (unsigned)256 * D; S.tsB = (unsigned)256 * D;
    pg8::EpiBf16 E{(bf16*)(F.ws + WS_Z), D};
    pg8::gemm_phase<pg8::EpiBf16, pg8::SchedPlain, true, true, 0x00007b79>(F.lds + RING_OFF, F.rsrc, D / 2, D / 2, D / 2, S, E);
}

__device__ __forceinline__ void p3_lora(Frame& F0, const In& I) {
    PHASE_FRAME(F0);
    { pg8::SchedPlain S; S.t.init(T / 256, 4, F.G, (int)blockIdx.x);
      S.A = (unsigned)(WS_LORAIN); S.B = (unsigned)(WS_WLA); S.tsA = (unsigned)256 * LORA_LD * 2; S.tsB = (unsigned)256 * 256 * 2;
      pg8::EpiLoraA<true> E{(float*)(F.ws + WS_DECAY), I.w0};
      pg8::gemm_phase<pg8::EpiLoraA<true>, pg8::SchedPlain, true>(F.lds + RING_OFF, F.rsrc, LORA_LD, 256, 256, S, E); }
    { pg8::SchedPlain S; S.t.init(T / 256, 4, F.G, (int)blockIdx.x);
      S.A = (unsigned)(WS_LORAIN); S.B = (unsigned)(WS_WLA + (size_t)1024 * 256 * 2); S.tsA = (unsigned)256 * LORA_LD * 2; S.tsB = (unsigned)256 * 256 * 2;
      pg8::EpiIclr E{(bf16*)(F.ws + WS_ICLR), I.a0};
      pg8::gemm_phase<pg8::EpiIclr, pg8::SchedPlain, true>(F.lds + RING_OFF, F.rsrc, LORA_LD, 256, 256, S, E); }
    { pg8::SchedPlain S; S.t.init(T / 256, 4, F.G, (int)blockIdx.x);
      S.A = (unsigned)(WS_LORAIN + 512); S.B = (unsigned)(WS_WLG); S.tsA = (unsigned)256 * LORA_LD * 2; S.tsB = (unsigned)256 * 256 * 2;
      pg8::EpiBf16 E{(bf16*)(F.ws + WS_G), RW};
      pg8::gemm_phase<pg8::EpiBf16, pg8::SchedPlain, true>(F.lds + RING_OFF, F.rsrc, LORA_LD, 256, 256, S, E); }
}

constexpr int CP = 144;
constexpr int CMAT = 64 * CP;
constexpr int C_RT = 0 * CMAT, C_ATT = 1 * CMAT, C_AAK = 2 * CMAT, C_ARKT = 3 * CMAT, C_WA = 4 * CMAT, C_WB = 6 * CMAT,
              C_MA = 8 * CMAT, C_MTA = 9 * CMAT, C_MB = 10 * CMAT, C_MTB = 11 * CMAT, C_SEG = 12 * CMAT, C_GAM = C_SEG + 8 * 64 * 4, C_TSCR = C_GAM + 256;
constexpr int C_AT = C_WB, C_BT = C_WB + CMAT, C_KT = C_MB, C_QYT = C_MA, C_QST = C_MTA, C_KHT = C_MTB, C_VT = C_WB;
static_assert(C_TSCR % 16 == 0 && C_TSCR + 8 * 5120 <= TAB_OFF, "P4a LDS map");
static_assert(BATCH * RH * (SEQ / 64) * 12 == MOE_NITEMS, "P4a converts exactly 12 expert-weight tiles per chunk unit");
constexpr int CHK_UNIT_BYTES = 4 * 64 * 64 * 2;
#define CBAR() do { asm volatile("s_waitcnt lgkmcnt(0)" ::: "memory"); __builtin_amdgcn_s_barrier(); asm volatile("" ::: "memory"); } while (0)
template <int NT, class Epi>
__device__ __forceinline__ void cmm(const LAS unsigned char* X, const LAS unsigned char* Y, int mt0, int nt, int lane, const Epi& E) {
    const int lr = lane & 15, kq = lane >> 4;
    const bf16x8 b0 = *(const LAS bf16x8*)(Y + (nt * 16 + lr) * CP + kq * 16), b1 = *(const LAS bf16x8*)(Y + (nt * 16 + lr) * CP + kq * 16 + 64);
#pragma unroll
    for (int i = 0; i < NT; ++i) { const int mt = mt0 + i;
        const bf16x8 a0 = *(const LAS bf16x8*)(X + (mt * 16 + lr) * CP + kq * 16), a1 = *(const LAS bf16x8*)(X + (mt * 16 + lr) * CP + kq * 16 + 64);
        f32x4 acc = (f32x4){0.f, 0.f, 0.f, 0.f};
        acc = __builtin_amdgcn_mfma_f32_16x16x32_bf16(a0, b0, acc, 0, 0, 0);
        acc = __builtin_amdgcn_mfma_f32_16x16x32_bf16(a1, b1, acc, 0, 0, 0);
        E(mt, nt, acc); }
}
__device__ __forceinline__ v2u pack4(const f32x4& v) { return (v2u){pg8::cvt_pk_bf16(v[0], v[1]), pg8::cvt_pk_bf16(v[2], v[3])}; }
__device__ __forceinline__ f32x4 unpack4(const v2u w) { return (f32x4){bflo(w.x), bfhi(w.x), bflo(w.y), bfhi(w.y)}; }
__device__ __forceinline__ void p4a_chunk(Frame& F0, const In& I) {
    PHASE_FRAME(F0);
    LAS unsigned char* L = F.lds;
    const int lane = F.lane, w = F.wave, lr = lane & 15, kq = lane >> 4;
    const bf16* RKV = (const bf16*)(F.ws + WS_RKV); const float* LW = (const float*)(F.ws + WS_DECAY); const bf16* ICL = (const bf16*)(F.ws + WS_ICLR);
    unsigned char* CHK = F.ws + WS_CHK;
    int uit = 0;
    for (int unit = F.vcu; unit < BATCH * RH * (SEQ / 64); unit += F.G, ++uit) {
        const int bh = unit >> 7, ck = unit & 127, b = bh >> 4, h = bh & 15;
        const size_t tok0 = (size_t)b * SEQ + (size_t)ck * 64 + 8 * w;
        const int hc = h * 64 + lane;
        float lwv[8], ic[8], rr[8], kk[8], vv[8];
#pragma unroll
        for (int i = 0; i < 8; ++i) { const size_t tok = tok0 + i; lwv[i] = LW[tok * RW + hc]; ic[i] = bf2f(ICL[tok * RW + hc]);
            rr[i] = bf2f(RKV[tok * (3 * RW) + hc]); kk[i] = bf2f(RKV[tok * (3 * RW) + RW + hc]); vv[i] = bf2f(RKV[tok * (3 * RW) + 2 * RW + hc]); }
        const float kkp = I.k_k[hc], kap = I.k_a[hc];
        float cs[8]; { float run = 0.f;
#pragma unroll
            for (int i = 0; i < 8; ++i) { run += lwv[i]; cs[i] = run; } }
        __syncthreads();
        ((LAS float*)(L + C_SEG))[w * 64 + lane] = cs[7];
        CBAR();
        float pre = 0.f, tot = 0.f;
#pragma unroll
        for (int j = 0; j < 8; ++j) { const float sg = ((const LAS float*)(L + C_SEG))[j * 64 + lane]; tot += sg; pre += (j < w) ? sg : 0.f; }
        if (w == 0) ((LAS float*)(L + C_GAM))[lane] = __expf(tot);
        unsigned att[4], bht[4], kht[4], vtt[4];
        float at_[8], bh_[8], kh_[8]; const float gtot = __expf(tot); float ep_prev = 1.f;
#pragma unroll
        for (int i = 0; i < 8; ++i) { const int t = 8 * w + i; const float cum = pre + cs[i], cump = cum - lwv[i];
            const float kkv = kk[i] * kkp; const float n2 = wave_sum(kkv * kkv); const float kkn = kkv * __builtin_amdgcn_rsqf(fmaxf(n2, 1e-24f));
            const float a = -kkn, bb = kkn * ic[i], kp = kk[i] * (1.0f + (ic[i] - 1.0f) * kap);
            const float ep = __expf(cum), em = __builtin_amdgcn_rcpf(ep), epp = (i == 0) ? __expf(cump) : ep_prev, eL = gtot * em; ep_prev = ep;
            const float Rv = rr[i] * ep, Av = a * epp, Bv = bb * em, Kv = kp * em;
            at_[i] = Av; bh_[i] = bb * eL; kh_[i] = kp * eL;
            *(LAS unsigned short*)(L + C_RT + t * CP + lane * 2) = (unsigned short)f2bf(Rv);
            *(LAS unsigned short*)(L + C_AT + t * CP + lane * 2) = (unsigned short)f2bf(Av);
            *(LAS unsigned short*)(L + C_BT + t * CP + lane * 2) = (unsigned short)f2bf(Bv);
            *(LAS unsigned short*)(L + C_KT + t * CP + lane * 2) = (unsigned short)f2bf(Kv); }
#pragma unroll
        for (int q = 0; q < 4; ++q) { att[q] = pk2(at_[2 * q], at_[2 * q + 1]); bht[q] = pk2(bh_[2 * q], bh_[2 * q + 1]); kht[q] = pk2(kh_[2 * q], kh_[2 * q + 1]); vtt[q] = pk2(vv[2 * q], vv[2 * q + 1]); }
        *(LAS v4u*)(L + C_ATT + lane * CP + 16 * w) = (v4u){att[0], att[1], att[2], att[3]};
        *(LAS v4u*)(L + C_WA + (64 + lane) * CP + 16 * w) = (v4u){bht[0], bht[1], bht[2], bht[3]};
        CBAR();
        const int cit = unit * 12 + w; const bool hx = cit < MOE_NITEMS, hy = (w < 4) && (cit + 8 < MOE_NITEMS);
        f32x4 tX[16]; MoeItem mX = moe_item(hx ? cit : 0, I.w_gu, I.w_down, F.ws);
        LAS float* tscr = (LAS float*)(L + C_TSCR + w * 5120);
        struct Fr { bf16x8 a, b; };
        auto LD = [&](int base, int tile) -> Fr { const LAS unsigned char* q = L + base + (tile * 16 + lr) * CP + kq * 16; Fr f; f.a = *(const LAS bf16x8*)q; f.b = *(const LAS bf16x8*)(q + 64); return f; };
        auto MM = [&](const Fr& x, const Fr& y) -> f32x4 { f32x4 acc = (f32x4){0.f, 0.f, 0.f, 0.f};
            acc = __builtin_amdgcn_mfma_f32_16x16x32_bf16(x.a, y.a, acc, 0, 0, 0); acc = __builtin_amdgcn_mfma_f32_16x16x32_bf16(x.b, y.b, acc, 0, 0, 0); return acc; };
        const int nt = w & 3, mt0 = 2 * (w >> 2), n = nt * 16 + lr;
        { const Fr yAT = LD(C_AT, nt), yKT = LD(C_KT, nt), yRT = LD(C_RT, nt);
          Fr xBT[2], xAT[2], xKT[2];
#pragma unroll
          for (int i = 0; i < 2; ++i) { xBT[i] = LD(C_BT, mt0 + i); xAT[i] = LD(C_AT, mt0 + i); xKT[i] = LD(C_KT, mt0 + i); }
          f32x4 a1[2], a2[2], a3[2], a4[2];
#pragma unroll
          for (int i = 0; i < 2; ++i) { a1[i] = MM(xBT[i], yAT); a2[i] = MM(xAT[i], yKT); a3[i] = MM(xBT[i], yRT); a4[i] = MM(xKT[i], yRT); }
#pragma unroll
          for (int i = 0; i < 2; ++i) { const int m0 = (mt0 + i) * 16 + 4 * kq;
              f32x4 v = a1[i];
#pragma unroll
              for (int e = 0; e < 4; ++e) { v[e] = (m0 + e < n) ? v[e] : 0.f; *(LAS unsigned short*)(L + C_MA + (m0 + e) * CP + n * 2) = (unsigned short)f2bf(v[e]); }
              *(LAS v2u*)(L + C_MTA + n * CP + m0 * 2) = pack4(v);
              v = a2[i];
#pragma unroll
              for (int e = 0; e < 4; ++e) v[e] = (n < m0 + e) ? v[e] : 0.f;
              *(LAS v2u*)(L + C_AAK + n * CP + m0 * 2) = pack4(v);
              v = a3[i];
#pragma unroll
              for (int e = 0; e < 4; ++e) v[e] = (m0 + e <= n) ? v[e] : 0.f;
              *(LAS v2u*)(L + C_WA + n * CP + m0 * 2) = pack4(v);
              v = a4[i];
#pragma unroll
              for (int e = 0; e < 4; ++e) v[e] = (m0 + e <= n) ? v[e] : 0.f;
              *(LAS v2u*)(L + C_ARKT + n * CP + m0 * 2) = pack4(v); } }
        CBAR();
        if (hx) tr8_load(mX, tX, lane);
#pragma unroll
        for (int lvl = 0; lvl < 6; ++lvl) {
            const int Wsrc = (lvl & 1) ? C_WB : C_WA, Wdst = (lvl & 1) ? C_WA : C_WB, Ms = (lvl & 1) ? C_MB : C_MA, Mts = (lvl & 1) ? C_MTB : C_MTA, Md = (lvl & 1) ? C_MA : C_MB, Mtd = (lvl & 1) ? C_MTA : C_MTB;
            const Fr yW = LD(Wsrc, w); Fr yMt; if (lvl < 5) yMt = LD(Mts, nt);
            Fr xM[4], xS[2];
#pragma unroll
            for (int i = 0; i < 4; ++i) xM[i] = LD(Ms, i);
            if (lvl < 5) { xS[0] = LD(Ms, mt0); xS[1] = LD(Ms, mt0 + 1); }
            const int nj = w * 16 + lr;
            f32x4 old[4], aw[4], as[2];
#pragma unroll
            for (int i = 0; i < 4; ++i) old[i] = unpack4(*(const LAS v2u*)(L + Wsrc + nj * CP + (i * 16 + 4 * kq) * 2));
#pragma unroll
            for (int i = 0; i < 4; ++i) aw[i] = MM(xM[i], yW);
            if (lvl < 5) {
#pragma unroll
                for (int i = 0; i < 2; ++i) as[i] = MM(xS[i], yMt); }
#pragma unroll
            for (int i = 0; i < 4; ++i) *(LAS v2u*)(L + Wdst + nj * CP + (i * 16 + 4 * kq) * 2) = pack4(old[i] + aw[i]);
            if (lvl < 5) {
#pragma unroll
                for (int i = 0; i < 2; ++i) { const int m0 = (mt0 + i) * 16 + 4 * kq;
#pragma unroll
                    for (int e = 0; e < 4; ++e) *(LAS unsigned short*)(L + Md + (m0 + e) * CP + n * 2) = (unsigned short)f2bf(as[i][e]);
                    if (lvl < 4) *(LAS v2u*)(L + Mtd + n * CP + m0 * 2) = pack4(as[i]); } }
            if (lvl == 4) *(LAS v4u*)(L + C_KHT + lane * CP + 16 * w) = (v4u){kht[0], kht[1], kht[2], kht[3]};
            if (lvl == 2) { if (hx) tr8_finish(tX, mX, tscr, lane);
                            if (hy) { mX = moe_item(cit + 8, I.w_gu, I.w_down, F.ws); tr8_load(mX, tX, lane); } }
            CBAR();
        }
        *(LAS v4u*)(L + C_VT + lane * CP + 16 * w) = (v4u){vtt[0], vtt[1], vtt[2], vtt[3]};
        unsigned char* og = CHK + (size_t)unit * CHK_UNIT_BYTES;
        { const Fr yW1 = LD(C_WA, nt), yW2 = LD(C_WA + 64 * CP, nt);
          Fr xA[2], xK[2];
#pragma unroll
          for (int i = 0; i < 2; ++i) { xA[i] = LD(C_ATT, mt0 + i); xK[i] = LD(C_AAK, mt0 + i); }
          f32x4 rv[2], av[2], kv[2];
          const float gm = ((const LAS float*)(L + C_GAM))[n];
#pragma unroll
          for (int i = 0; i < 2; ++i) { const int m0 = (mt0 + i) * 16 + 4 * kq;
              rv[i] = unpack4(*(const LAS v2u*)(L + C_RT + n * CP + m0 * 2)); av[i] = unpack4(*(const LAS v2u*)(L + C_ARKT + n * CP + m0 * 2)); kv[i] = unpack4(*(const LAS v2u*)(L + C_KHT + n * CP + m0 * 2)); }
          f32x4 p7[2], p8[2], p9[2], p10[2];
#pragma unroll
          for (int i = 0; i < 2; ++i) { p7[i] = MM(xA[i], yW1); p8[i] = MM(xK[i], yW1); p9[i] = MM(xA[i], yW2); p10[i] = MM(xK[i], yW2); }
#pragma unroll
          for (int i = 0; i < 2; ++i) { const int m0 = (mt0 + i) * 16 + 4 * kq;
              *(GAS v2u*)(og + 0 * 8192 + n * 128 + m0 * 2) = pack4(p7[i] + rv[i]);
              *(LAS v2u*)(L + C_QYT + n * CP + m0 * 2) = pack4(p8[i] + av[i]);
              f32x4 v = p9[i];
#pragma unroll
              for (int e = 0; e < 4; ++e) v[e] += (m0 + e == n) ? gm : 0.f;
              *(GAS v2u*)(og + 1 * 8192 + n * 128 + m0 * 2) = pack4(v);
              *(LAS v2u*)(L + C_QST + n * CP + m0 * 2) = pack4(p10[i] + kv[i]); } }
        CBAR();
        { const Fr yQy = LD(C_QYT, nt), yQs = LD(C_QST, nt);
          Fr xV[2];
#pragma unroll
          for (int i = 0; i < 2; ++i) xV[i] = LD(C_VT, mt0 + i);
          f32x4 p11[2], p12[2];
#pragma unroll
          for (int i = 0; i < 2; ++i) { p11[i] = MM(xV[i], yQy); p12[i] = MM(xV[i], yQs); }
#pragma unroll
          for (int i = 0; i < 2; ++i) { const int m0 = (mt0 + i) * 16 + 4 * kq;
              *(GAS v2u*)(og + 2 * 8192 + n * 128 + m0 * 2) = pack4(p11[i]);
              *(GAS v2u*)(og + 3 * 8192 + n * 128 + m0 * 2) = pack4(p12[i]); } }
        if (hy) tr8_finish(tX, mX, tscr, lane);
    }
}

constexpr int C2_SLOT = 20480;
__device__ __forceinline__ void p4b_scan(Frame& F0, const In& I) {
    PHASE_FRAME(F0);
    const int lane = F.lane, lr = lane & 15, kq = lane >> 4;
    const unsigned char* CHK = F.ws + WS_CHK; bf16* YS = (bf16*)(F.ws + WS_YSCAN);
    for (int unit = F.vcu; unit < BATCH * RH * 4; unit += F.G) {
        const int bh = unit >> 2, rq = unit & 3, b = bh >> 4, h = bh & 15;
        if (F.wave == 0) {
            LAS unsigned char* Sl = F.lds + 3 * C2_SLOT;
            f32x4 S[4]; bf16x8 sf[2];
#pragma unroll
            for (int nt = 0; nt < 4; ++nt) S[nt] = (f32x4){0.f, 0.f, 0.f, 0.f};
#pragma unroll
            for (int ks = 0; ks < 2; ++ks)
#pragma unroll
                for (int j = 0; j < 8; ++j) sf[ks][j] = 0;
#define C2_DMA(ck_) do { const int ckc_ = (ck_) < SEQ / 64 ? (ck_) : SEQ / 64 - 1; const unsigned char* ug = CHK + ((size_t)bh * 128 + ckc_) * CHK_UNIT_BYTES; \
                LAS unsigned char* sl_ = F.lds + ((ck_) % 3) * C2_SLOT; \
                _Pragma("unroll") for (int j = 0; j < 16; ++j) __builtin_amdgcn_global_load_lds((const unsigned*)(ug + j * 1024 + lane * 16), (LAS unsigned*)(sl_ + j * 1024), 16, 0, 0); \
                _Pragma("unroll") for (int j = 0; j < 2; ++j) { \
                    __builtin_amdgcn_global_load_lds((const unsigned*)(ug + 2 * 8192 + (j * 32 + (lane >> 1)) * 128 + rq * 32 + (lane & 1) * 16), (LAS unsigned*)(sl_ + 16384 + j * 1024), 16, 0, 0); \
                    __builtin_amdgcn_global_load_lds((const unsigned*)(ug + 3 * 8192 + (j * 32 + (lane >> 1)) * 128 + rq * 32 + (lane & 1) * 16), (LAS unsigned*)(sl_ + 18432 + j * 1024), 16, 0, 0); } } while (0)
            C2_DMA(0); C2_DMA(1);
#pragma unroll 1
            for (int ck = 0; ck < SEQ / 64; ++ck) {
                asm volatile("s_waitcnt lgkmcnt(0)" ::: "memory");
                C2_DMA(ck + 2);
                asm volatile("s_waitcnt vmcnt(40)" ::: "memory");
                const LAS unsigned char* sl_ = F.lds + (ck % 3) * C2_SLOT;
#pragma unroll
                for (int nt = 0; nt < 4; ++nt) {
                    const bf16x8 py0 = *(const LAS bf16x8*)(sl_ + (16 * nt + lr) * 128 + kq * 16), py1 = *(const LAS bf16x8*)(sl_ + (16 * nt + lr) * 128 + kq * 16 + 64);
                    const bf16x8 ps0 = *(const LAS bf16x8*)(sl_ + 8192 + (16 * nt + lr) * 128 + kq * 16), ps1 = *(const LAS bf16x8*)(sl_ + 8192 + (16 * nt + lr) * 128 + kq * 16 + 64);
                    f32x4 y = unpack4(*(const LAS v2u*)(sl_ + 16384 + (16 * nt + lr) * 32 + kq * 8));
                    f32x4 s2 = unpack4(*(const LAS v2u*)(sl_ + 18432 + (16 * nt + lr) * 32 + kq * 8));
                    y = __builtin_amdgcn_mfma_f32_16x16x32_bf16(sf[0], py0, y, 0, 0, 0); y = __builtin_amdgcn_mfma_f32_16x16x32_bf16(sf[1], py1, y, 0, 0, 0);
                    *(GAS v2u*)(YS + ((size_t)b * SEQ + (size_t)ck * 64 + 16 * nt + lr) * RW + h * 64 + rq * 16 + 4 * kq) = pack4(y);
                    s2 = __builtin_amdgcn_mfma_f32_16x16x32_bf16(sf[0], ps0, s2, 0, 0, 0); s2 = __builtin_amdgcn_mfma_f32_16x16x32_bf16(sf[1], ps1, s2, 0, 0, 0);
                    S[nt] = s2; }
#pragma unroll
                for (int nt = 0; nt < 4; ++nt)
#pragma unroll
                    for (int i = 0; i < 4; ++i) *(LAS unsigned short*)(Sl + (4 * kq + i) * CP + (16 * nt + lr) * 2) = (unsigned short)f2bf(S[nt][i]);
                LDS_WAIT(); asm volatile("" ::: "memory");
                sf[0] = *(const LAS bf16x8*)(Sl + lr * CP + kq * 16); sf[1] = *(const LAS bf16x8*)(Sl + lr * CP + kq * 16 + 64);
                LDS_WAIT(); asm volatile("" ::: "memory");
            }
            asm volatile("s_waitcnt vmcnt(0)" ::: "memory");
#undef C2_DMA
        }
    }
}
static_assert(3 * C2_SLOT + 4096 + 5 * 16640 <= TAB_OFF, "P4b LDS map");

__device__ __forceinline__ void p5_post(Frame& F0, const In& I) {
    PHASE_FRAME(F0);
    const int lane = F.lane; const int gw = F.vcu * NWAVES + F.wave, NGW = F.G * NWAVES;
    const bf16* RKV = (const bf16*)(F.ws + WS_RKV); const bf16* ICL = (const bf16*)(F.ws + WS_ICLR); const bf16* YS = (const bf16*)(F.ws + WS_YSCAN);
    const bf16* G = (const bf16*)(F.ws + WS_G); bf16* YB = (bf16*)(F.ws + WS_YB);
    const int c0 = lane * 16;
    float p_ka[16], p_rk[16], p_lw[16], p_lb[16];
#pragma unroll
    for (int q = 0; q < 4; ++q) { const f32x4 a = *(const GAS f32x4*)(I.k_a + c0 + 4 * q), bq = *(const GAS f32x4*)(I.r_k + c0 + 4 * q), c = *(const GAS f32x4*)(I.lnx_w + c0 + 4 * q), d = *(const GAS f32x4*)(I.lnx_b + c0 + 4 * q);
#pragma unroll
        for (int e = 0; e < 4; ++e) { p_ka[4 * q + e] = a[e]; p_rk[4 * q + e] = bq[e]; p_lw[4 * q + e] = c[e]; p_lb[4 * q + e] = d[e]; } }
    v4u raw[12];
#define P5_LOAD(tok_) do { _Pragma("unroll") for (int q = 0; q < 2; ++q) { \
        raw[q] = *(const GAS v4u*)(YS + (size_t)(tok_) * RW + c0 + 8 * q); raw[2 + q] = *(const GAS v4u*)(ICL + (size_t)(tok_) * RW + c0 + 8 * q); \
        raw[4 + q] = *(const GAS v4u*)(RKV + (size_t)(tok_) * (3 * RW) + c0 + 8 * q); raw[6 + q] = *(const GAS v4u*)(RKV + (size_t)(tok_) * (3 * RW) + RW + c0 + 8 * q); \
        raw[8 + q] = *(const GAS v4u*)(RKV + (size_t)(tok_) * (3 * RW) + 2 * RW + c0 + 8 * q); raw[10 + q] = *(const GAS v4u*)(G + (size_t)(tok_) * RW + c0 + 8 * q); } } while (0)
    if (gw < T) P5_LOAD(gw);
    for (int tok = gw; tok < T; tok += NGW) {
        float y[16], rr[16], kk[16], vv[16], ic[16], gg[16];
#pragma unroll
        for (int q = 0; q < 2; ++q) {
            const unsigned yw[4] = {raw[q].x, raw[q].y, raw[q].z, raw[q].w}, iw[4] = {raw[2 + q].x, raw[2 + q].y, raw[2 + q].z, raw[2 + q].w};
            const unsigned aw[4] = {raw[4 + q].x, raw[4 + q].y, raw[4 + q].z, raw[4 + q].w}, bw[4] = {raw[6 + q].x, raw[6 + q].y, raw[6 + q].z, raw[6 + q].w};
            const unsigned cw[4] = {raw[8 + q].x, raw[8 + q].y, raw[8 + q].z, raw[8 + q].w}, dw[4] = {raw[10 + q].x, raw[10 + q].y, raw[10 + q].z, raw[10 + q].w};
#pragma unroll
            for (int e = 0; e < 4; ++e) { y[8 * q + 2 * e] = bflo(yw[e]); y[8 * q + 2 * e + 1] = bfhi(yw[e]); ic[8 * q + 2 * e] = bflo(iw[e]); ic[8 * q + 2 * e + 1] = bfhi(iw[e]);
                rr[8 * q + 2 * e] = bflo(aw[e]); rr[8 * q + 2 * e + 1] = bfhi(aw[e]); kk[8 * q + 2 * e] = bflo(bw[e]); kk[8 * q + 2 * e + 1] = bfhi(bw[e]);
                vv[8 * q + 2 * e] = bflo(cw[e]); vv[8 * q + 2 * e + 1] = bfhi(cw[e]); gg[8 * q + 2 * e] = bflo(dw[e]); gg[8 * q + 2 * e + 1] = bfhi(dw[e]); } }
        __builtin_amdgcn_sched_barrier(0);
        if (tok + NGW < T) P5_LOAD(tok + NGW);
        __builtin_amdgcn_sched_barrier(0);
        float s = 0.f, bs = 0.f;
#pragma unroll
        for (int e = 0; e < 16; ++e) { s += y[e]; const float kp = kk[e] * (1.0f + (ic[e] - 1.0f) * p_ka[e]); bs += rr[e] * kp * p_rk[e]; }
        s = quadsum(s); bs = quadsum(bs);
        const float mean = s * (1.f / 64.f); float s2 = 0.f;
#pragma unroll
        for (int e = 0; e < 16; ++e) { y[e] -= mean; s2 += y[e] * y[e]; }
        s2 = quadsum(s2);
        const float rstd = 1.f / sqrtf(s2 * (1.f / 64.f) + GN_EPS);
        float o[16];
#pragma unroll
        for (int e = 0; e < 16; ++e) o[e] = (y[e] * rstd * p_lw[e] + p_lb[e] + bs * vv[e]) * gg[e];
        { unsigned w8[4];
#pragma unroll
          for (int q = 0; q < 4; ++q) { int t8 = __builtin_amdgcn_cvt_pk_fp8_f32(o[4 * q] * ACT8_SCALE, o[4 * q + 1] * ACT8_SCALE, 0, false); t8 = __builtin_amdgcn_cvt_pk_fp8_f32(o[4 * q + 2] * ACT8_SCALE, o[4 * q + 3] * ACT8_SCALE, t8, true); w8[q] = (unsigned)t8; }
          *(GAS v4u*)((unsigned char*)YB + (size_t)tok * RW + c0) = (v4u){w8[0], w8[1], w8[2], w8[3]}; }
    }
#undef P5_LOAD
}
#ifndef STAGE
#define STAGE 4
#endif
struct Args { In in; float* out; unsigned char* ws; };
__global__ void __launch_bounds__(NWAVES * 64, 2) mk_fwd(Args args) {
    extern __shared__ __attribute__((aligned(16))) unsigned char lds[];
    Frame F;
    F.lds = (LAS unsigned char*)lds;
    F.MISC = (volatile LAS unsigned*)(F.lds + MISC_OFF);
    F.tid = threadIdx.x; F.lane = F.tid & 63; F.wave = __builtin_amdgcn_readfirstlane(F.tid >> 6);
    F.G = gridDim.x; { const int bx = blockIdx.x; F.vcu = (F.G % 8 == 0) ? (bx % 8) * (F.G / 8) + bx / 8 : bx; }
    F.ws = args.ws;
    F.rsrc = __builtin_amdgcn_make_buffer_rsrc(args.ws, 0, 0xffffffff, 0x00020000);
    F.ctl = (gu32*)(args.ws + WS_CTL);
    for (int u = F.tid; u < (LDS_BYTES - MISC_OFF) / 4; u += NWAVES * 64) ((LAS unsigned*)(F.lds + MISC_OFF))[u] = 0u;
    __syncthreads();
    XcdBarrier bar = xcd_barrier_post((unsigned*)(F.ctl + CW_BAR), F.MISC + 8);
    const In& I = args.in;
#define GRID_BAR() xcd_barrier(bar)
#ifndef DUP_PHASE
#define DUP_PHASE -1
#endif
#define RUN(n, call) do { call; if (DUP_PHASE == (n)) { GRID_BAR(); call; } } while (0)

#if STAGE >= 2
    RUN(0, p0_prologue(F, I));
    GRID_BAR();
#endif
#if STAGE >= 3
    RUN(1, p1_proj(F, I));
    GRID_BAR();
    RUN(2, p2_shift_attn(F, I));
    GRID_BAR();
#if STAGE >= 4
    RUN(3, p3_lora(F, I));
    GRID_BAR();
    RUN(4, p4a_chunk(F, I));
    GRID_BAR();
    RUN(44, p4b_scan(F, I));
    GRID_BAR();
    RUN(5, p5_post(F, I));
    GRID_BAR();
#endif
    RUN(6, p6_merged(F, I));
    GRID_BAR();
    RUN(7, p7_mix(F, I));
    GRID_BAR();
#endif
    p8_ln_router<(STAGE < 3)>(F, I);
    GRID_BAR();
#if STAGE >= 2
    p9_scatter(F, I);
    GRID_BAR();
    RUN(10, p10_moe_up(F, I));
    GRID_BAR();
    RUN(11, p11_moe_down(F, I));
    GRID_BAR();
#endif
    RUN(12, p12_final<(STAGE < 2)>(F, I, args.out));
}

extern "C" void kernel_launch(void* const* d_in, const int* in_sizes, int n_in, void* d_out, int out_size, void* d_ws, size_t ws_size, hipStream_t stream) {
    static int grid = 0;
    if (grid == 0) {
        if (n_in != 27 || in_sizes[0] != T * D || out_size != T * D || ws_size < WS_END) { fprintf(stderr, "kernel_launch: unexpected shapes (n_in %d, in0 %d, out %d, ws %zu)\n", n_in, n_in > 0 ? in_sizes[0] : -1, out_size, ws_size); grid = -1; return; }
        int dev = 0, cus = 0, per_cu = 0;
        if (hipGetDevice(&dev) != hipSuccess || hipDeviceGetAttribute(&cus, hipDeviceAttributeMultiprocessorCount, dev) != hipSuccess) { grid = -1; return; }
        if (hipFuncSetAttribute((const void*)mk_fwd, hipFuncAttributeMaxDynamicSharedMemorySize, LDS_BYTES) != hipSuccess) { fprintf(stderr, "kernel_launch: hipFuncSetAttribute failed\n"); grid = -1; return; }
        if (hipOccupancyMaxActiveBlocksPerMultiprocessor(&per_cu, (const void*)mk_fwd, NWAVES * 64, LDS_BYTES) != hipSuccess || per_cu < 1)
            fprintf(stderr, "kernel_launch: occupancy query reports %d\n", per_cu);
        (void)hipGetLastError();
        grid = cus;
    }
    if (grid < 0) return;
    if (hipMemsetAsync((char*)d_ws + WS_CTL, 0, CTL_ZERO_BYTES, stream) != hipSuccess) return;
    Args a{};
    const float** ip = (const float**)&a.in;
    for (int i = 0; i < 27; ++i) ip[i] = (const float*)d_in[i];
    a.out = (float*)d_out; a.ws = (unsigned char*)d_ws;
    hipLaunchKernelGGL(mk_fwd, dim3(grid), dim3(NWAVES * 64), LDS_BYTES, stream, a);
    const hipError_t le = hipPeekAtLastError();
    if (le != hipSuccess) fprintf(stderr, "kernel_launch: launch failed: %s\n", hipGetErrorName(le));
}
```

```cpp
#define STAGE 4
#include <hip/hip_runtime.h>
#include <cstdio>
#include <cstdint>

#define GAS __attribute__((address_space(1)))
#define LAS __attribute__((address_space(3)))
typedef unsigned short bf16;
typedef unsigned v4u __attribute__((ext_vector_type(4)));
typedef unsigned v2u __attribute__((ext_vector_type(2)));
typedef float f32x4 __attribute__((ext_vector_type(4)));
typedef float f32x2 __attribute__((ext_vector_type(2)));
typedef float f32x16 __attribute__((ext_vector_type(16)));
typedef short bf16x8 __attribute__((ext_vector_type(8)));
typedef short bf16x4 __attribute__((ext_vector_type(4)));
typedef GAS unsigned gu32;

constexpr int NWAVES = 8;
constexpr int BATCH = 4, SEQ = 8192, D = 2048, T = BATCH * SEQ;
constexpr int CHUNK = 64, LEFT = 8, AH = 16, AD = 64, AW = 1024;
constexpr int REL_TABLE = 320, MAX_PAST = 256;
constexpr int RH = 16, RN = 64, RW = 1024, DLORA = 96, ALORA = 96, GLORA = 256;
constexpr int SHIFT_W = 3 * RW + DLORA + ALORA + GLORA;
constexpr int D_IN = 3 * AW + SHIFT_W + 2 * D;
constexpr int NE = 32, TOPK = 4, FF = 2048;
constexpr int MSLOT = T * TOPK;
constexpr int NBLK_MAX = (MSLOT + NE * 255 + 255) / 256;
constexpr int RROWS = NBLK_MAX * 256;
constexpr float LN_EPS = 1e-5f, GN_EPS = 64e-5f;
constexpr float YS_SCALE = 16.0f, YS_INV = 1.0f / 16.0f;
constexpr float ACT8_SCALE = 16.0f;
constexpr float F8_CVT_SCALE = 0.015625f;
constexpr float DN_ALPHA = 1.189207115002721f;
constexpr int PROJ_LD = 9728, PJ_Q = 0, PJ_K = 1024, PJ_SEG = 2048, SEG_PAD = 3584, PJ_GA = 5632, PJ_GB = 7680;
constexpr int LORA_LD = 512;

constexpr size_t MiB = 1u << 20;
constexpr size_t WS_CTL = 0, CTL_ZERO_BYTES = 1 * MiB;
constexpr size_t WS_TOPI = 2 * MiB;
constexpr size_t WS_GATE = 3 * MiB;
constexpr size_t WS_ROWSLOT = 4 * MiB;
constexpr size_t WS_ROWW = 5 * MiB;
constexpr size_t WS_WLA = 6 * MiB;
constexpr size_t WS_WLG = 7 * MiB;
constexpr size_t WS_PAT = 8 * MiB;
constexpr size_t WS_PBT = 12 * MiB;
constexpr size_t WS_WOT = 16 * MiB;
constexpr size_t WS_WVT = 24 * MiB;
constexpr size_t WS_SIDE0 = 28 * MiB, WS_SIDEL = 36 * MiB;
constexpr size_t WS_WINT = 28 * MiB;
constexpr size_t WS_WG8 = 72 * MiB;
constexpr size_t WS_WQK8 = 80 * MiB;
constexpr size_t WS_WV8 = 84 * MiB;
constexpr size_t WS_WSV8 = 88 * MiB;
constexpr size_t WS_WGUT = 128 * MiB;
constexpr size_t WS_WDNT = 640 * MiB;
constexpr size_t WS_BASE0 = 1024 * MiB;
constexpr size_t WS_PROJ = WS_BASE0;
constexpr size_t WS_VT = WS_PROJ + 608 * MiB;
constexpr size_t WS_YA = WS_VT + 64 * MiB;
constexpr size_t WS_RKV = WS_YA + 64 * MiB;
constexpr size_t WS_LORAIN = WS_RKV + 192 * MiB;
constexpr size_t WS_DECAY = WS_LORAIN + 32 * MiB;
constexpr size_t WS_ICLR = WS_DECAY + 128 * MiB;
constexpr size_t WS_G = WS_ICLR + 128 * MiB;
constexpr size_t WS_YSCAN = WS_G + 64 * MiB;
constexpr size_t WS_YB = WS_YSCAN + 128 * MiB;
constexpr size_t WS_MERGED = WS_YB + 64 * MiB;
constexpr size_t WS_XB16 = WS_MERGED + 128 * MiB;
constexpr size_t WS_MIX_END = WS_XB16 + 128 * MiB;
constexpr size_t WS_Z = 2816 * MiB;
constexpr size_t WS_GATEF = WS_Z;
constexpr size_t WS_H1 = 3072 * MiB;
constexpr size_t WS_H1B = 3328 * MiB;
constexpr size_t WS_CHK = 3456 * MiB;
constexpr size_t WS_XB8 = 3712 * MiB;
constexpr size_t WS_END = 3776 * MiB;
constexpr size_t WS_XG = WS_BASE0;
constexpr size_t WS_ACT = WS_BASE0 + 544 * MiB;
constexpr size_t WS_YSLOT = WS_BASE0 + 1088 * MiB;
static_assert(WS_MIX_END <= WS_Z && WS_YSLOT + 512 * MiB <= WS_Z, "ws map");
static_assert(WS_WINT + (size_t)PROJ_LD * D * 2 <= WS_WGUT, "ws map");

constexpr int CW_CNT = 512;
constexpr int CW_CUR = 576;
constexpr int CW_BAR = 4096;

constexpr int RING_OFF = 0, RING_BYTES = 131072;
constexpr int LDS_BYTES = 160 * 1024;
constexpr int MISC_OFF = LDS_BYTES - 512;
constexpr int TAB_OFF = LDS_BYTES - 1024;

#define RLX_AGENT __ATOMIC_RELAXED, __HIP_MEMORY_SCOPE_AGENT
#define LDS_WAIT() asm volatile("s_waitcnt lgkmcnt(0)" ::: "memory")
#define VM_WAIT() asm volatile("s_waitcnt vmcnt(0)" ::: "memory")
__device__ __forceinline__ unsigned f2bf(float f) { unsigned u = __builtin_bit_cast(unsigned, f); return (u + 0x7fffu + ((u >> 16) & 1u)) >> 16; }
__device__ __forceinline__ unsigned pk2(float lo, float hi) { return f2bf(lo) | (f2bf(hi) << 16); }
__device__ __forceinline__ float bf2f(unsigned short h) { return __builtin_bit_cast(float, (unsigned)h << 16); }
__device__ __forceinline__ float bflo(unsigned w) { return __builtin_bit_cast(float, w << 16); }
__device__ __forceinline__ float bfhi(unsigned w) { return __builtin_bit_cast(float, w & 0xffff0000u); }
__device__ __forceinline__ float fsigmoid(float x) { return __builtin_amdgcn_rcpf(1.0f + __expf(-x)); }
__device__ __forceinline__ float dpp_f(float x, const int ctrl_sel) {
    const int xi = __builtin_bit_cast(int, x); int r;
    if (ctrl_sel == 0) r = __builtin_amdgcn_update_dpp(0, xi, 0xB1, 0xF, 0xF, false);
    else if (ctrl_sel == 1) r = __builtin_amdgcn_update_dpp(0, xi, 0x4E, 0xF, 0xF, false);
    else if (ctrl_sel == 2) r = __builtin_amdgcn_update_dpp(0, xi, 0x124, 0xF, 0xF, false);
    else r = __builtin_amdgcn_update_dpp(0, xi, 0x128, 0xF, 0xF, false);
    return __builtin_bit_cast(float, r);
}
__device__ __forceinline__ float rowsum16(float x) { x += dpp_f(x, 0); x += dpp_f(x, 1); x += dpp_f(x, 2); x += dpp_f(x, 3); return x; }
__device__ __forceinline__ float quadsum(float x) { x += dpp_f(x, 0); x += dpp_f(x, 1); return x; }
__device__ __forceinline__ float wave_sum(float v) {
    v = rowsum16(v);
    const int vi = __builtin_bit_cast(int, v);
    const float s0 = __builtin_bit_cast(float, __builtin_amdgcn_readlane(vi, 0)), s1 = __builtin_bit_cast(float, __builtin_amdgcn_readlane(vi, 16));
    const float s2 = __builtin_bit_cast(float, __builtin_amdgcn_readlane(vi, 32)), s3 = __builtin_bit_cast(float, __builtin_amdgcn_readlane(vi, 48));
    return (s0 + s1) + (s2 + s3);
}
namespace pg8 {
#define PG8_LAS __attribute__((address_space(3)))
typedef unsigned short bf16_t;
typedef unsigned u32x4 __attribute__((ext_vector_type(4)));
constexpr int BM = 256, BK = 64, HALF = 128, HTB = HALF * BK * 2, STAGE_BYTES = 8 * HTB, NXCD = 8, WGM = 8;

__host__ __device__ __forceinline__ int lds_byte(int r, int c) { const int st = (r >> 4) * 2 + (c >> 5), rr = r & 15, cc = c & 31, ob = rr * 64 + cc * 2; return st * 1024 + (ob ^ (((ob >> 9) & 1) << 5)); }
__host__ __device__ __forceinline__ void stage_rc(int b, int& R, int& C) { const int st = b / 1024, sb = b % 1024, swz = sb ^ (((sb >> 9) & 1) << 5); R = (st >> 1) * 16 + swz / 64; C = (st & 1) * 32 + (swz % 64) / 2; }
__host__ __device__ __forceinline__ int perm32(int rho) { const int n = rho >> 4, i = rho & 15; return 8 * (i >> 2) + 4 * n + (i & 3); }

struct Unit { int pm, pn, aux; };

struct Tiler {
    int nM, nN, nwg, G, c;
    __device__ __forceinline__ void init(int nM_, int nN_, int G_, int c_) { nM = nM_; nN = nN_; nwg = nM * nN; G = G_; c = c_; }
    __device__ __forceinline__ bool map(int i, int& pm, int& pn) const {
        const long L = (long)i * G + c; if (L >= nwg) return false;
        int wgid = (int)L; { const int q = nwg / NXCD, r = nwg % NXCD, xcd = wgid % NXCD, off = wgid / NXCD; wgid = (xcd < r ? xcd * (q + 1) : r * (q + 1) + (xcd - r) * q) + off; }
        const int nig = WGM * nN, gid = wgid / nig, fm = gid * WGM, gsz = (nM - fm) < WGM ? (nM - fm) : WGM;
        pm = fm + ((wgid % nig) % gsz); pn = (wgid % nig) / gsz; return true;
    }
};
struct SchedPlain {
    Tiler t; unsigned A, B, tsA, tsB;
    __device__ __forceinline__ bool next(int i, Unit& u) const { u.aux = 0; return t.map(i, u.pm, u.pn); }
    __device__ __forceinline__ void bases(const Unit& u, unsigned& a, unsigned& b) const { a = A + (unsigned)u.pm * tsA; b = B + (unsigned)u.pn * tsB; }
};
struct SchedTwo {
    Tiler t; unsigned A0, A1, B0, B1, tsA, tsB;
    __device__ __forceinline__ bool next(int i, Unit& u) const { u.aux = i & 1; return t.map(i >> 1, u.pm, u.pn); }
    __device__ __forceinline__ void bases(const Unit& u, unsigned& a, unsigned& b) const { a = (u.aux ? A1 : A0) + (unsigned)u.pm * tsA; b = (u.aux ? B1 : B0) + (unsigned)u.pn * tsB; }
};
struct SchedMoe {
    Tiler t; unsigned A, B, tsA, tsB, es; const PG8_LAS int* pad_end;
    __device__ __forceinline__ bool next(int i, Unit& u) const {
        if (!t.map(i, u.pm, u.pn)) return false;
        const int row0 = u.pm * BM; int e = 0;
#pragma unroll
        for (int j = 0; j < 32; ++j) e += (pad_end[j] <= row0) ? 1 : 0;
        u.aux = __builtin_amdgcn_readfirstlane(e < 31 ? e : 31); return true;
    }
    __device__ __forceinline__ void bases(const Unit& u, unsigned& a, unsigned& b) const { a = A + (unsigned)u.pm * tsA; b = B + (unsigned)u.aux * es + (unsigned)u.pn * tsB; }
};

typedef float f32x2_t_ __attribute__((ext_vector_type(2)));
typedef __bf16 bf16x2_t_ __attribute__((ext_vector_type(2)));
__device__ __forceinline__ unsigned cvt_pk_bf16(float lo, float hi) { const f32x2_t_ v = {lo, hi}; const bf16x2_t_ b = __builtin_convertvector(v, bf16x2_t_); return __builtin_bit_cast(unsigned, b); }
__device__ __forceinline__ u32x4 pack8(const f32x4& v0, const f32x4& v1) { u32x4 w; w.x = cvt_pk_bf16(v0[0], v0[1]); w.y = cvt_pk_bf16(v0[2], v0[3]); w.z = cvt_pk_bf16(v1[0], v1[1]); w.w = cvt_pk_bf16(v1[2], v1[3]); return w; }

typedef int i32x8 __attribute__((ext_vector_type(8)));
typedef int i32x4 __attribute__((ext_vector_type(4)));
__device__ __forceinline__ i32x8 cat8(const bf16x8& a, const bf16x8& b) { return __builtin_shufflevector(__builtin_bit_cast(i32x4, a), __builtin_bit_cast(i32x4, b), 0, 1, 2, 3, 4, 5, 6, 7); }
constexpr int F8_SCALES = 0x00007f79;
template <class Epi, class Sched, bool ALIGN_EPI, bool F8 = false, int F8SC = F8_SCALES>
__device__ __forceinline__ void gemm_phase(PG8_LAS unsigned char* lds, const __amdgpu_buffer_rsrc_t rsrc, const int lda, const int ldb, const int K, const Sched& S, const Epi& E) {
    int tid_ = threadIdx.x; asm volatile("" : "+v"(tid_));
    const int tid = tid_, wid = __builtin_amdgcn_readfirstlane(tid >> 6), lane = tid & 63, wr = wid >> 2, wc = wid & 3, fr = lane & 15, fq = lane >> 4;
    const int nt = K / BK;
    unsigned voffA, voffB;
    { int R, C; stage_rc(tid * 16, R, C); const int Rb = (R & ~31) + perm32(R & 31); voffA = (unsigned)(R * lda + C) * 2u; voffB = (unsigned)(Rb * ldb + C) * 2u; }
    const unsigned p1voffA = 64u * (unsigned)lda * 2u, p1voffB = 64u * (unsigned)ldb * 2u;
    const unsigned kstep = (unsigned)(BK * 2);
    const unsigned hsA = (unsigned)HALF * lda * 2, hsB = (unsigned)HALF * ldb * 2;
    const unsigned ldsw = (unsigned)wid * 1024u;
    const int aoff = lds_byte(wr * 64 + fr, fq * 8), boff = lds_byte(wc * 32 + fr, fq * 8);
#define PG8_SA(b, h) (((b) * 2 + (h)) * HTB)
#define PG8_SB(b, h) ((4 + (b) * 2 + (h)) * HTB)
#define PG8_STAGE(bufoff, goff, voff) do { _Pragma("unroll") for (int _i = 0; _i < 2; ++_i) \
        __builtin_amdgcn_raw_ptr_buffer_load_lds(rsrc, (PG8_LAS void*)(lds + (bufoff) + ldsw + _i * 8192), 16, (int)(voff), (int)((goff) + _i * p1##voff), 0, 0); } while (0)
#define PG8_LD8(addr) __builtin_shufflevector(*(const PG8_LAS i32x4*)(addr), *(const PG8_LAS i32x4*)((addr) + 1024), 0, 1, 2, 3, 4, 5, 6, 7)
#define PG8_LDA(dst, b, h) do { _Pragma("unroll") for (int m = 0; m < 4; ++m) dst[m] = PG8_LD8(lds + PG8_SA(b, h) + aoff + m * 2048); } while (0)
#define PG8_LDB(dst, b, h) do { _Pragma("unroll") for (int n = 0; n < 2; ++n) dst[n] = PG8_LD8(lds + PG8_SB(b, h) + boff + n * 2048); } while (0)
#define PG8_LO(v) __builtin_bit_cast(bf16x8, __builtin_shufflevector(v, v, 0, 1, 2, 3))
#define PG8_HI(v) __builtin_bit_cast(bf16x8, __builtin_shufflevector(v, v, 4, 5, 6, 7))
#define PG8_MMA(ai, bj, At, Bt) do { __builtin_amdgcn_s_setprio(1); \
        if constexpr (!F8) { _Pragma("unroll") for (int m = 0; m < 4; ++m) _Pragma("unroll") for (int n = 0; n < 2; ++n) { \
            acc[ai][bj][m][n] = __builtin_amdgcn_mfma_f32_16x16x32_bf16(PG8_LO(Bt[n]), PG8_LO(At[m]), acc[ai][bj][m][n], 0, 0, 0); \
            acc[ai][bj][m][n] = __builtin_amdgcn_mfma_f32_16x16x32_bf16(PG8_HI(Bt[n]), PG8_HI(At[m]), acc[ai][bj][m][n], 0, 0, 0); } } \
        else { _Pragma("unroll") for (int m = 0; m < 4; ++m) _Pragma("unroll") for (int n = 0; n < 2; ++n) \
            acc[ai][bj][m][n] = __builtin_amdgcn_mfma_scale_f32_16x16x128_f8f6f4(Bt[n], At[m], acc[ai][bj][m][n], 0, 0, 0, F8SC, 1, F8SC); } \
        __builtin_amdgcn_s_setprio(0); } while (0)
#define PG8_WAIT_V(n) asm volatile("s_waitcnt vmcnt(" #n ")" ::: "memory")
#define PG8_WAIT_L(n) asm volatile("s_waitcnt lgkmcnt(" #n ")" ::: "memory")
#define PG8_BAR __builtin_amdgcn_s_barrier()
#define PG8_SCHED __builtin_amdgcn_sched_barrier(0)
#define PG8_ZERO() do { _Pragma("unroll") for (int a = 0; a < 2; ++a) _Pragma("unroll") for (int b = 0; b < 2; ++b) _Pragma("unroll") for (int m = 0; m < 4; ++m) _Pragma("unroll") for (int n = 0; n < 2; ++n) acc[a][b][m][n] = (f32x4){0.f, 0.f, 0.f, 0.f}; } while (0)
    Unit cur, nxt; int ui = 0;
    if (!S.next(0, cur)) return;
    f32x4 acc[2][2][4][2];
    PG8_ZERO();
    i32x8 At[4], B0[2], B1[2];
    unsigned cA, cB; S.bases(cur, cA, cB); cA = __builtin_amdgcn_readfirstlane(cA); cB = __builtin_amdgcn_readfirstlane(cB);
    PG8_STAGE(PG8_SB(0, 0), cB, voffB); PG8_STAGE(PG8_SB(0, 1), cB + hsB, voffB); PG8_STAGE(PG8_SA(0, 0), cA, voffA); PG8_STAGE(PG8_SA(0, 1), cA + hsA, voffA);
    if (wr == 1) PG8_BAR;
    PG8_WAIT_V(2); PG8_BAR;
    PG8_STAGE(PG8_SB(1, 0), cB + kstep, voffB); PG8_STAGE(PG8_SA(1, 0), cA + kstep, voffA); PG8_STAGE(PG8_SB(1, 1), cB + hsB + kstep, voffB);
    PG8_WAIT_V(6); PG8_BAR;
    for (;;) {
        const bool has_next = S.next(ui + 1, nxt);
        unsigned nA = cA, nB = cB; if (has_next) { S.bases(nxt, nA, nB); nA = __builtin_amdgcn_readfirstlane(nA); nB = __builtin_amdgcn_readfirstlane(nB); }
#pragma unroll 1
        for (int t = 0; t < nt; t += 2) {
            const bool last = (t == nt - 2);
            const unsigned a1 = cA + (unsigned)(t + 1) * kstep;
            const unsigned a2 = last ? nA : cA + (unsigned)(t + 2) * kstep, b2 = last ? nB : cB + (unsigned)(t + 2) * kstep;
            const unsigned a3 = a2 + kstep, b3 = b2 + kstep;
            PG8_LDB(B0, 0, 0); PG8_LDB(B1, 0, 1); PG8_SCHED; PG8_LDA(At, 0, 0); PG8_STAGE(PG8_SA(1, 1), a1 + hsA, voffA);
            PG8_WAIT_V(8); PG8_WAIT_L(0); PG8_BAR; PG8_MMA(0, 0, At, B0); PG8_MMA(0, 1, At, B1); PG8_BAR; PG8_SCHED;
            PG8_LDA(At, 0, 1); PG8_STAGE(PG8_SB(0, 0), b2, voffB); PG8_STAGE(PG8_SB(0, 1), b2 + hsB, voffB); PG8_STAGE(PG8_SA(0, 0), a2, voffA);
            PG8_WAIT_V(8); PG8_WAIT_L(0); PG8_BAR; PG8_MMA(1, 0, At, B0); PG8_MMA(1, 1, At, B1); PG8_BAR; PG8_SCHED;
            PG8_LDB(B0, 1, 0); PG8_LDB(B1, 1, 1); PG8_SCHED; PG8_LDA(At, 1, 0); PG8_STAGE(PG8_SA(0, 1), a2 + hsA, voffA);
            PG8_WAIT_V(8); PG8_WAIT_L(0); PG8_BAR; PG8_MMA(0, 0, At, B0); PG8_MMA(0, 1, At, B1); PG8_BAR; PG8_SCHED;
            PG8_LDA(At, 1, 1); PG8_STAGE(PG8_SB(1, 0), b3, voffB); PG8_STAGE(PG8_SB(1, 1), b3 + hsB, voffB); PG8_STAGE(PG8_SA(1, 0), a3, voffA);
            PG8_WAIT_V(8); PG8_WAIT_L(0); PG8_BAR; PG8_MMA(1, 0, At, B0); PG8_MMA(1, 1, At, B1); PG8_BAR; PG8_SCHED;
        }
        if constexpr (ALIGN_EPI) { if (wr == 0) PG8_BAR; }
        bool keep; { int t2 = threadIdx.x; asm volatile("" : "+v"(t2)); const int w2 = __builtin_amdgcn_readfirstlane(t2 >> 6), l2 = t2 & 63; keep = E(acc, cur, w2 >> 2, w2 & 3, l2 & 15, l2 >> 4); }
        if (!has_next) break;
        if (!keep) PG8_ZERO();
        cur = nxt; cA = nA; cB = nB; ++ui;
        if constexpr (ALIGN_EPI) { if (wr == 1) PG8_BAR; }
    }
    PG8_WAIT_V(0);
    if constexpr (!ALIGN_EPI) { if (wr == 0) PG8_BAR; }
    PG8_BAR;
#undef PG8_SA
#undef PG8_SB
#undef PG8_STAGE
#undef PG8_LDA
#undef PG8_LDB
#undef PG8_LD8
#undef PG8_LO
#undef PG8_HI
#undef PG8_MMA
#undef PG8_WAIT_V
#undef PG8_WAIT_L
#undef PG8_BAR
#undef PG8_SCHED
#undef PG8_ZERO
}
}
namespace pg8 {
#define EPI_ROWLOOP _Pragma("unroll") for (int ai = 0; ai < 2; ++ai) _Pragma("unroll") for (int m = 0; m < 4; ++m)
struct EpiProj {
    bf16_t* O; int coloff, nq;
    __device__ __forceinline__ bool operator()(f32x4 (&acc)[2][2][4][2], const Unit& u, int wr, int wc, int fr, int fq) const {
        const int row0 = u.pm * BM + wr * 64 + fr, col0 = coloff + u.pn * BM + wc * 32 + 8 * fq;
        const float sc = (u.pn < nq) ? 0.125f : 1.0f;
        EPI_ROWLOOP { bf16_t* rowp = O + (size_t)(row0 + ai * HALF + m * 16) * PROJ_LD + col0;
#pragma unroll
            for (int bj = 0; bj < 2; ++bj) *(u32x4*)(rowp + bj * HALF) = pack8(acc[ai][bj][m][0] * sc, acc[ai][bj][m][1] * sc); }
        return false;
    }
};
__device__ __forceinline__ float dpp_prev_row(float lo15, float cur) {
    const int o = __builtin_amdgcn_update_dpp(0, __builtin_bit_cast(int, lo15), 0x121, 0xF, 0xF, false);
    return __builtin_bit_cast(float, __builtin_amdgcn_update_dpp(o, __builtin_bit_cast(int, cur), 0x111, 0xF, 0xF, false));
}
struct EpiShift {
    bf16_t* RKVp; bf16_t* LIN; float* SIDE0; float* SIDEL; const float* mu;
    __device__ __forceinline__ bool operator()(f32x4 (&acc)[2][2][4][2], const Unit& u, int wr, int wc, int fr, int fq) const {
        static_assert(DLORA % 32 == 0 && ALORA % 32 == 0 && GLORA % 32 == 0 && RW % 32 == 0, "segment boundaries are wave-uniform");
        const int row0 = u.pm * BM + wr * 64 + fr;
#pragma unroll
        for (int bj = 0; bj < 2; ++bj) {
            const int cgrp = u.pn * BM + bj * HALF + wc * 32;
            if (cgrp >= SHIFT_W) continue;
            const int c = cgrp + 8 * fq;
            const f32x4 mu0 = *(const f32x4*)(mu + c), mu1 = *(const f32x4*)(mu + c + 4);
            bf16_t* dbase; int ld, act = 0;
            if (cgrp < 3 * RW) { dbase = RKVp + c; ld = 3 * RW; }
            else if (cgrp < 3 * RW + DLORA) { dbase = LIN + (c - 3 * RW); ld = LORA_LD; act = 1; }
            else if (cgrp < 3 * RW + DLORA + ALORA) { dbase = LIN + 128 + (c - 3 * RW - DLORA); ld = LORA_LD; }
            else { dbase = LIN + 256 + (c - 3 * RW - DLORA - ALORA); ld = LORA_LD; act = 2; }
            const bool zpad = (cgrp == 3 * RW + DLORA - 32) || (cgrp == 3 * RW + DLORA + ALORA - 32);
#pragma unroll
            for (int ai = 0; ai < 2; ++ai) {
                const int g = u.pm * 4 + ai * 2 + wr;
#pragma unroll
                for (int m = 0; m < 4; ++m) {
                    f32x4 o[2];
#pragma unroll
                    for (int n = 0; n < 2; ++n) { const f32x4 cur = acc[ai][bj][m][n]; const f32x4 mm = n ? mu1 : mu0;
#pragma unroll
                        for (int j = 0; j < 4; ++j) { const float prv = dpp_prev_row(m > 0 ? acc[ai][bj][m > 0 ? m - 1 : 0][n][j] : 0.0f, cur[j]);
                            float v = cur[j] + (prv - cur[j]) * mm[j];
                            if (act == 1) v = 2.0f * fsigmoid(2.0f * v) - 1.0f; else if (act == 2) v = fsigmoid(v);
                            o[n][j] = v; } }
                    bf16_t* dp = dbase + (size_t)(row0 + ai * HALF + m * 16) * ld;
                    *(u32x4*)dp = pack8(o[0], o[1]);
                    if (zpad) { unsigned zz = 0u; asm volatile("" : "+v"(zz)); *(u32x4*)(dp + 32) = (u32x4){zz, zz, zz, zz}; }
                    if (m == 0 && fr == 0) { float* sp = SIDE0 + (size_t)g * SEG_PAD + c; *(f32x4*)sp = acc[ai][bj][0][0]; *(f32x4*)(sp + 4) = acc[ai][bj][0][1]; }
                    if (m == 3 && fr == 15) { float* sp = SIDEL + (size_t)g * SEG_PAD + c; *(f32x4*)sp = acc[ai][bj][3][0]; *(f32x4*)(sp + 4) = acc[ai][bj][3][1]; }
                } }
        }
        return false;
    }
};
struct EpiGate {
    bf16_t* O;
    __device__ __forceinline__ bool operator()(f32x4 (&acc)[2][2][4][2], const Unit& u, int wr, int wc, int fr, int fq) const {
        u32x4* gf = (u32x4*)O + ((size_t)(u.pm * 16 + u.pn) * 2 * 8 + (wr * 4 + wc)) * 512 + (fq * 16 + fr);
        EPI_ROWLOOP {
            f32x4 rt[2], gb[2];
#pragma unroll
            for (int n = 0; n < 2; ++n)
#pragma unroll
                for (int j = 0; j < 4; ++j) { const float ea = __expf(-acc[ai][0][m][n][j]), eb = fminf(__expf(-acc[ai][1][m][n][j]), 1e30f);
                    gb[n][j] = __builtin_amdgcn_rcpf(1.0f + eb); rt[n][j] = (1.0f + eb) * __builtin_amdgcn_rcpf(1.0f + ea); }
            gf[(ai * 4 + m) * 64] = pack8(rt[0], rt[1]); gf[8 * 512 + (ai * 4 + m) * 64] = pack8(gb[0], gb[1]); }
        return false;
    }
};
struct EpiBf16 {
    bf16_t* O; int ldc;
    __device__ __forceinline__ bool operator()(f32x4 (&acc)[2][2][4][2], const Unit& u, int wr, int wc, int fr, int fq) const {
        const int row0 = u.pm * BM + wr * 64 + fr, col0 = u.pn * BM + wc * 32 + 8 * fq;
        EPI_ROWLOOP { bf16_t* rowp = O + (size_t)(row0 + ai * HALF + m * 16) * ldc + col0;
#pragma unroll
            for (int bj = 0; bj < 2; ++bj) *(u32x4*)(rowp + bj * HALF) = pack8(acc[ai][bj][m][0], acc[ai][bj][m][1]); }
        return false;
    }
};
template <bool ISDEC> struct EpiLoraA {
    float* OUT; const float* par;
    __device__ __forceinline__ bool operator()(f32x4 (&acc)[2][2][4][2], const Unit& u, int wr, int wc, int fr, int fq) const {
        const int row0 = u.pm * BM + wr * 64 + fr, col0 = u.pn * BM + wc * 32 + 8 * fq;
        f32x4 pv[2][2];
#pragma unroll
        for (int bj = 0; bj < 2; ++bj)
#pragma unroll
            for (int n = 0; n < 2; ++n) pv[bj][n] = *(const f32x4*)(par + col0 + bj * HALF + 4 * n);
        EPI_ROWLOOP { float* rowp = OUT + (size_t)(row0 + ai * HALF + m * 16) * RW + col0;
#pragma unroll
            for (int bj = 0; bj < 2; ++bj)
#pragma unroll
                for (int n = 0; n < 2; ++n) { f32x4 v = acc[ai][bj][m][n] + pv[bj][n];
#pragma unroll
                    for (int j = 0; j < 4; ++j) {
                        if (ISDEC) v[j] = -0.60653065971263342f * fsigmoid(v[j]);
                        else v[j] = fsigmoid(v[j]); }
                    *(f32x4*)(rowp + bj * HALF + 4 * n) = v; } }
        return false;
    }
};
struct EpiIclr {
    bf16_t* OUT; const float* par;
    __device__ __forceinline__ bool operator()(f32x4 (&acc)[2][2][4][2], const Unit& u, int wr, int wc, int fr, int fq) const {
        const int row0 = u.pm * BM + wr * 64 + fr, col0 = u.pn * BM + wc * 32 + 8 * fq;
        f32x4 pv[2][2];
#pragma unroll
        for (int bj = 0; bj < 2; ++bj)
#pragma unroll
            for (int n = 0; n < 2; ++n) pv[bj][n] = *(const f32x4*)(par + col0 + bj * HALF + 4 * n);
        EPI_ROWLOOP { bf16_t* rowp = OUT + (size_t)(row0 + ai * HALF + m * 16) * RW + col0;
#pragma unroll
            for (int bj = 0; bj < 2; ++bj) { f32x4 v0 = acc[ai][bj][m][0] + pv[bj][0], v1 = acc[ai][bj][m][1] + pv[bj][1];
#pragma unroll
                for (int j = 0; j < 4; ++j) { v0[j] = fsigmoid(v0[j]); v1[j] = fsigmoid(v1[j]); }
                *(u32x4*)(rowp + bj * HALF) = pack8(v0, v1); } }
        return false;
    }
};
struct EpiMerged {
    const bf16_t* PROJ; bf16_t* O;
    __device__ __forceinline__ bool operator()(f32x4 (&acc)[2][2][4][2], const Unit& u, int wr, int wc, int fr, int fq) const {
        const int row0 = u.pm * BM + wr * 64 + fr, col0 = u.pn * BM + wc * 32 + 8 * fq;
        const u32x4* gf = (const u32x4*)PROJ + ((size_t)(u.pm * 16 + u.pn * 2) * 2 * 8 + (u.aux == 0 ? 0 : 8) + (wr * 4 + wc)) * 512 + (fq * 16 + fr);
#pragma unroll
        for (int ai = 0; ai < 2; ++ai) {
            u32x4 gv[4][2];
#pragma unroll
            for (int m = 0; m < 4; ++m)
#pragma unroll
                for (int bj = 0; bj < 2; ++bj) gv[m][bj] = gf[(size_t)bj * (2 * 8 * 512) + (ai * 4 + m) * 64];
#pragma unroll
            for (int m = 0; m < 4; ++m) { const int row = row0 + ai * HALF + m * 16;
#pragma unroll
                for (int bj = 0; bj < 2; ++bj) { const u32x4 g = gv[m][bj];
                    const f32x4 g0 = (f32x4){bflo(g.x), bfhi(g.x), bflo(g.y), bfhi(g.y)}, g1 = (f32x4){bflo(g.z), bfhi(g.z), bflo(g.w), bfhi(g.w)};
                    if (u.aux == 0) { acc[ai][bj][m][0] = acc[ai][bj][m][0] * g0; acc[ai][bj][m][1] = acc[ai][bj][m][1] * g1; }
                    else { const f32x4 o0 = acc[ai][bj][m][0] * g0 * ACT8_SCALE, o1 = acc[ai][bj][m][1] * g1 * ACT8_SCALE;
                        int w0 = __builtin_amdgcn_cvt_pk_fp8_f32(o0[0], o0[1], 0, false); w0 = __builtin_amdgcn_cvt_pk_fp8_f32(o0[2], o0[3], w0, true);
                        int w1 = __builtin_amdgcn_cvt_pk_fp8_f32(o1[0], o1[1], 0, false); w1 = __builtin_amdgcn_cvt_pk_fp8_f32(o1[2], o1[3], w1, true);
                        *(v2u*)((unsigned char*)O + (size_t)row * D + col0 + bj * HALF) = (v2u){(unsigned)w0, (unsigned)w1}; } } }
        }
        return u.aux == 0;
    }
};
struct EpiZ {
    const float* X; float* Z;
    __device__ __forceinline__ bool operator()(f32x4 (&acc)[2][2][4][2], const Unit& u, int wr, int wc, int fr, int fq) const {
        const int row0 = u.pm * BM + wr * 64 + fr, col0 = u.pn * BM + wc * 32 + 8 * fq;
        EPI_ROWLOOP { const size_t off = (size_t)(row0 + ai * HALF + m * 16) * D + col0;
#pragma unroll
            for (int bj = 0; bj < 2; ++bj)
#pragma unroll
                for (int n = 0; n < 2; ++n) { const f32x4 xv = *(const f32x4*)(X + off + bj * HALF + 4 * n); *(f32x4*)(Z + off + bj * HALF + 4 * n) = xv * DN_ALPHA + acc[ai][bj][m][n]; } }
        return false;
    }
};
struct EpiSwiglu {
    unsigned char* ACT; const float* bgu;
    __device__ __forceinline__ bool operator()(f32x4 (&acc)[2][2][4][2], const Unit& u, int wr, int wc, int fr, int fq) const {
        const int row0 = u.pm * BM + wr * 64 + fr, col0 = u.pn * HALF + wc * 32 + 8 * fq;
        const float* bp = bgu + (size_t)u.aux * (2 * FF) + col0;
        f32x4 bg[2], bu[2];
#pragma unroll
        for (int n = 0; n < 2; ++n) { bg[n] = *(const f32x4*)(bp + 4 * n); bu[n] = *(const f32x4*)(bp + FF + 4 * n); }
        EPI_ROWLOOP { f32x4 o[2];
#pragma unroll
            for (int n = 0; n < 2; ++n) { const f32x4 g = acc[ai][0][m][n] + bg[n], uu = acc[ai][1][m][n] + bu[n];
#pragma unroll
                for (int j = 0; j < 4; j += 2) {
                    f32x2 gc, uc; gc[0] = fminf(g[j], 7.0f); gc[1] = fminf(g[j + 1], 7.0f);
                    uc[0] = __builtin_amdgcn_fmed3f(uu[j], -7.0f, 7.0f); uc[1] = __builtin_amdgcn_fmed3f(uu[j + 1], -7.0f, 7.0f);
                    const f32x2 t = gc * (f32x2){-2.4554669595930156f, -2.4554669595930156f};
                    f32x2 d; d[0] = __builtin_amdgcn_exp2f(t[0]); d[1] = __builtin_amdgcn_exp2f(t[1]);
                    d = d + (f32x2){1.0f, 1.0f};
                    f32x2 r; r[0] = __builtin_amdgcn_rcpf(d[0]); r[1] = __builtin_amdgcn_rcpf(d[1]);
                    const f32x2 s = gc * r, oo = __builtin_elementwise_fma(uc, s, s);
                    o[n][j] = oo[0]; o[n][j + 1] = oo[1]; } }
            int w0 = __builtin_amdgcn_cvt_pk_fp8_f32(o[0][0], o[0][1], 0, false); w0 = __builtin_amdgcn_cvt_pk_fp8_f32(o[0][2], o[0][3], w0, true);
            int w1 = __builtin_amdgcn_cvt_pk_fp8_f32(o[1][0], o[1][1], 0, false); w1 = __builtin_amdgcn_cvt_pk_fp8_f32(o[1][2], o[1][3], w1, true);
            *(v2u*)(ACT + (size_t)(row0 + ai * HALF + m * 16) * FF + col0) = (v2u){(unsigned)w0, (unsigned)w1}; }
        return false;
    }
};
struct EpiDown {
    unsigned char* YS; const float* bdn; const int* rowslot; const float* roww;
    __device__ __forceinline__ bool operator()(f32x4 (&acc)[2][2][4][2], const Unit& u, int wr, int wc, int fr, int fq) const {
        const int row0 = u.pm * BM + wr * 64 + fr, col0 = u.pn * BM + wc * 32 + 8 * fq;
        const float* bp = bdn + (size_t)u.aux * D + col0;
        f32x4 bv[2][2];
#pragma unroll
        for (int bj = 0; bj < 2; ++bj)
#pragma unroll
            for (int n = 0; n < 2; ++n) bv[bj][n] = *(const f32x4*)(bp + bj * HALF + 4 * n);
        int slots[8]; float ws_[8];
#pragma unroll
        for (int q = 0; q < 8; ++q) { const int row = row0 + (q >> 2) * HALF + (q & 3) * 16; slots[q] = rowslot[row]; ws_[q] = roww[row]; }
        EPI_ROWLOOP { const int slot = slots[ai * 4 + m]; const float w = ws_[ai * 4 + m] * YS_SCALE;
            if (slot >= 0) { unsigned char* rowp = YS + (size_t)slot * D + col0;
#pragma unroll
                for (int bj = 0; bj < 2; ++bj) { const f32x4 o0 = (acc[ai][bj][m][0] + bv[bj][0]) * w, o1 = (acc[ai][bj][m][1] + bv[bj][1]) * w;
                    int w0 = __builtin_amdgcn_cvt_pk_fp8_f32(o0[0], o0[1], 0, false); w0 = __builtin_amdgcn_cvt_pk_fp8_f32(o0[2], o0[3], w0, true);
                    int w1 = __builtin_amdgcn_cvt_pk_fp8_f32(o1[0], o1[1], 0, false); w1 = __builtin_amdgcn_cvt_pk_fp8_f32(o1[2], o1[3], w1, true);
                    *(v2u*)(rowp + bj * HALF) = (v2u){(unsigned)w0, (unsigned)w1}; } } }
        return false;
    }
};
#undef EPI_ROWLOOP
}

#define XB_TMO      128
#define XB_XCNT(j)  (256  + 64 * (j))
#define XB_XSUB(j)  (1280 + 64 * (j))
#define XB_XGEN(j)  (2304 + 64 * (j))
#define XB_TOP      3328
#define XB_TOPGEN   3392
#define XCD_BAR_WORDS 3456
#define XB_SPIN_CAP (1u << 18)

__device__ __forceinline__ unsigned xb_ld(unsigned* p)              { return __hip_atomic_load(p, __ATOMIC_RELAXED, __HIP_MEMORY_SCOPE_AGENT); }
__device__ __forceinline__ unsigned xb_add(unsigned* p, unsigned v) { return __hip_atomic_fetch_add(p, v, __ATOMIC_RELAXED, __HIP_MEMORY_SCOPE_AGENT); }
__device__ __forceinline__ unsigned xb_xcc_id() { return (unsigned)__builtin_amdgcn_s_getreg((3 << 11) | 20) & 0xFu; }
#define XB_SPIN(cond, bar) do { unsigned _sp = 0; while (cond) { __builtin_amdgcn_s_sleep(1); \
    if ((++_sp & 255u) == 0u) { if (xb_ld(&(bar)[XB_TMO])) break; if (_sp > XB_SPIN_CAP) { atomicAdd(&(bar)[XB_TMO], 1u); break; } } } } while (0)

struct XcdBarrier {
    unsigned* bar; unsigned x;
    volatile LAS unsigned* st;
};

__device__ __forceinline__ XcdBarrier xcd_barrier_post(unsigned* bar, volatile LAS unsigned* st) {
    XcdBarrier b; b.bar = bar; b.x = xb_xcc_id(); b.st = st;
    if (threadIdx.x == 0) (void)xb_add(&bar[XB_XCNT(b.x)], 1u);
    return b;
}
__device__ __forceinline__ void xcd_barrier_complete(unsigned* bar, unsigned x, unsigned& nloc, unsigned& nx) {
    const unsigned G = gridDim.x * gridDim.y * gridDim.z;
    unsigned sum, cnt, mine, sp = 0u;
    for (;;) {
        sum = 0u; cnt = 0u; mine = 0u;
#pragma unroll
        for (unsigned j = 0; j < 16; ++j) { const unsigned c = xb_ld(&bar[XB_XCNT(j)]); sum += c; cnt += (c > 0u) ? 1u : 0u; mine = (j == x) ? c : mine; }
        if (sum == G) break;
        __builtin_amdgcn_s_sleep(1);
        if ((++sp & 255u) == 0u) { if (xb_ld(&bar[XB_TMO])) break; if (sp > XB_SPIN_CAP) { atomicAdd(&bar[XB_TMO], 1u); break; } }
    }
    nloc = mine > 0u ? mine : 1u; nx = cnt > 0u ? cnt : 1u;
}

__device__ __forceinline__ void xcd_barrier(const XcdBarrier& b) {
    asm volatile("s_waitcnt vmcnt(0)" ::: "memory");
    __syncthreads();
    if (threadIdx.x == 0) {
        unsigned* bar = b.bar;
        __builtin_amdgcn_s_waitcnt(0);
        unsigned nloc = b.st[0], nx = b.st[1];
        if (nloc == 0u) { xcd_barrier_complete(bar, b.x, nloc, nx); b.st[0] = nloc; b.st[1] = nx; }
        const unsigned old = xb_add(&bar[XB_XSUB(b.x)], 1u);
        const unsigned gen = old / nloc;
        if (old + 1u == (gen + 1u) * nloc) {
            __builtin_amdgcn_fence(__ATOMIC_RELEASE, "agent");
            asm volatile("s_waitcnt vmcnt(0)" ::: "memory");
            const unsigned og = xb_add(&bar[XB_TOP], 1u);
            const unsigned tg = og / nx;
            if (og + 1u == (tg + 1u) * nx) xb_add(&bar[XB_TOPGEN], 1u);
            else XB_SPIN(xb_ld(&bar[XB_TOPGEN]) == tg, bar);
            __builtin_amdgcn_fence(__ATOMIC_ACQUIRE, "agent");
            xb_add(&bar[XB_XGEN(b.x)], 1u);
            asm volatile("s_waitcnt vmcnt(0)" ::: "memory");
        } else {
            XB_SPIN(xb_ld(&bar[XB_XGEN(b.x)]) == gen, bar);
            __builtin_amdgcn_fence(__ATOMIC_ACQUIRE, "agent");
            asm volatile("s_waitcnt vmcnt(0)" ::: "memory");
        }
    }
    __syncthreads();
}
struct Frame {
    LAS unsigned char* lds;
    volatile LAS unsigned* MISC;
    gu32* ctl;
    int tid, lane, wave;
    int vcu, G;
    unsigned char* ws;
    __amdgpu_buffer_rsrc_t rsrc;
};

#define PHASE_FRAME(F0) Frame F = (F0); { int t_ = threadIdx.x; asm volatile("" : "+v"(t_)); F.tid = t_; F.lane = t_ & 63; F.wave = __builtin_amdgcn_readfirstlane(t_ >> 6); }

__device__ __forceinline__ void tr_item(const float* W, size_t ldw, int k0, int c0, bf16* WT, size_t ldt, int drow0, LAS float* scr, int lane) {
    const int kr = lane >> 4, cq = lane & 15;
    f32x4 v[16];
#pragma unroll
    for (int i = 0; i < 16; ++i) v[i] = *(const GAS f32x4*)(W + (size_t)(k0 + 4 * i + kr) * ldw + c0 + 4 * cq);
#pragma unroll
    for (int i = 0; i < 16; ++i)
#pragma unroll
        for (int j = 0; j < 4; ++j) scr[(4 * cq + j) * 65 + 4 * i + kr] = v[i][j];
    LDS_WAIT(); asm volatile("" ::: "memory");
    const int c = lane & 7;
#pragma unroll
    for (int jj = 0; jj < 8; ++jj) { const int n = (lane >> 3) + 8 * jj; const LAS float* s = scr + n * 65 + 8 * c;
        v4u o; o.x = pk2(s[0], s[1]); o.y = pk2(s[2], s[3]); o.z = pk2(s[4], s[5]); o.w = pk2(s[6], s[7]);
        *(GAS v4u*)(WT + (size_t)(drow0 + n) * ldt + k0 + 8 * c) = o; }
    LDS_WAIT(); asm volatile("" ::: "memory");
}

typedef short s16x2 __attribute__((ext_vector_type(2)));
struct MoeItem { __amdgpu_buffer_rsrc_t rs; unsigned soff, rstep; int ldw, k0; unsigned char* WT; size_t ldt; int drow; };
__device__ __forceinline__ void tr8_load(const MoeItem& m, f32x4 (&v)[16], int lane) {
    const int kr = lane >> 4, cq = lane & 15;
    const int voff = (kr * m.ldw + 4 * cq) * 4;
#pragma unroll
    for (int i = 0; i < 16; ++i) v[i] = __builtin_bit_cast(f32x4, __builtin_amdgcn_raw_buffer_load_b128(m.rs, voff, (int)(m.soff + (unsigned)i * m.rstep), 0));
}
__device__ __forceinline__ void tr8_finish(const f32x4 (&v)[16], const MoeItem& m, LAS float* scr_, int lane) {
    LAS unsigned char* scr = (LAS unsigned char*)scr_;
    const int kr = lane >> 4, cq = lane & 15;
#pragma unroll
    for (int j = 0; j < 4; ++j) { unsigned w[4];
#pragma unroll
        for (int q = 0; q < 4; ++q) { s16x2 t = {0, 0};
            t = __builtin_amdgcn_cvt_scalef32_pk_fp8_f32(t, v[4 * q][j], v[4 * q + 1][j], F8_CVT_SCALE, false);
            t = __builtin_amdgcn_cvt_scalef32_pk_fp8_f32(t, v[4 * q + 2][j], v[4 * q + 3][j], F8_CVT_SCALE, true);
            w[q] = __builtin_bit_cast(unsigned, t); }
        *(LAS v4u*)(scr + (4 * cq + j) * 80 + kr * 16) = (v4u){w[0], w[1], w[2], w[3]}; }
    LDS_WAIT(); asm volatile("" ::: "memory");
    const int qd = lane & 3;
#pragma unroll
    for (int ps = 0; ps < 4; ++ps) { const int n = (lane >> 2) + 16 * ps; const LAS unsigned char* s = scr + n * 80 + qd * 4;
        const unsigned d0 = *(const LAS unsigned*)(s), d1 = *(const LAS unsigned*)(s + 16), d2 = *(const LAS unsigned*)(s + 32), d3 = *(const LAS unsigned*)(s + 48);
        const unsigned t0 = __builtin_amdgcn_perm(d1, d0, 0x05010400u), t1 = __builtin_amdgcn_perm(d1, d0, 0x07030602u), t2 = __builtin_amdgcn_perm(d3, d2, 0x05010400u), t3 = __builtin_amdgcn_perm(d3, d2, 0x07030602u);
        const v4u o = (v4u){__builtin_amdgcn_perm(t2, t0, 0x05040100u), __builtin_amdgcn_perm(t2, t0, 0x07060302u), __builtin_amdgcn_perm(t3, t1, 0x05040100u), __builtin_amdgcn_perm(t3, t1, 0x07060302u)};
        *(GAS v4u*)(m.WT + (size_t)(m.drow + n) * m.ldt + m.k0 + 16 * qd) = o; }
    LDS_WAIT(); asm volatile("" ::: "memory");
}
constexpr int MOE_J4 = 32 * 32 * 64, MOE_J5 = 32 * 32 * 32, MOE_NITEMS = MOE_J4 + MOE_J5;
__device__ __forceinline__ MoeItem moe_item(int r, const float* w_gu, const float* w_down, unsigned char* ws) {
    MoeItem m;
    if (r < MOE_J4) { const int e = r / 2048, q = r % 2048, kb = q / 64, cb = q % 64, c0 = cb * 64; const int cc = c0 & 2047;
        m.rs = __builtin_amdgcn_make_buffer_rsrc((void*)w_gu, 0, 0xffffffff, 0x00020000); m.ldw = 2 * FF; m.k0 = kb * 64;
        m.soff = (unsigned)(((size_t)e * D * 2 * FF + (size_t)kb * 64 * (2 * FF) + c0) * 4); m.rstep = 4u * (2 * FF) * 4u;
        m.WT = ws + WS_WGUT + (size_t)e * 2 * FF * D; m.ldt = D; m.drow = (cc >> 7) * 256 + (c0 >= 2048 ? 128 : 0) + (cc & 127); }
    else { r -= MOE_J4; const int e = r / 1024, q = r % 1024, kb = q / 32, cb = q % 32;
        m.rs = __builtin_amdgcn_make_buffer_rsrc((void*)w_down, 0, 0xffffffff, 0x00020000); m.ldw = D; m.k0 = kb * 64;
        m.soff = (unsigned)(((size_t)e * FF * D + (size_t)kb * 64 * D + cb * 64) * 4); m.rstep = 4u * D * 4u;
        m.WT = ws + WS_WDNT + (size_t)e * D * FF; m.ldt = FF; m.drow = cb * 64; }
    return m;
}
__device__ __forceinline__ MoeItem f8_item(const float* W, int ldw, int k0, int c0, unsigned char* WT, size_t ldt, int drow) {
    MoeItem m; m.rs = __builtin_amdgcn_make_buffer_rsrc((void*)W, 0, 0xffffffff, 0x00020000); m.ldw = ldw; m.k0 = k0;
    m.soff = (unsigned)(((size_t)k0 * ldw + c0) * 4); m.rstep = 4u * (unsigned)ldw * 4u; m.WT = WT; m.ldt = ldt; m.drow = drow; return m;
}

struct In {
    const float *x, *w_in, *rel_bias, *shift_mu, *w0, *w_up, *a0, *a_up, *g_up, *k_k, *k_a, *r_k, *lnx_w, *lnx_b, *proj_a, *proj_b, *w_out,
                *ln1_w, *ln1_b, *w_router, *b_router, *w_gu, *b_gu, *w_down, *b_down, *ln2_w, *ln2_b;
};

__device__ __forceinline__ void p0_prologue(Frame& F0, const In& I) {
    PHASE_FRAME(F0);
    LAS float* scr = (LAS float*)(F.lds + F.wave * 16640);
    const int gw = F.vcu * NWAVES + F.wave, NGW = F.G * NWAVES;
    unsigned char* ws = F.ws;
    constexpr int J0 = 32 * 167, J1 = 16 * 32, J2 = 16 * 32, J3 = 32 * 32;
    constexpr int NITEMS = J0 + J1 + J2 + J3;
    for (int it = gw; it < NITEMS; it += NGW) {
        int r = it;
        if (r < J0) { const int kb = r / 167, cb = r % 167, c0 = cb * 64; bf16* dst; int drow;
            if (c0 < 3072) { f32x4 tv[16];
                   const MoeItem m = (c0 < 2048) ? f8_item(I.w_in, D_IN, kb * 64, c0, (unsigned char*)(ws + WS_WQK8), D, c0) : f8_item(I.w_in, D_IN, kb * 64, c0, (unsigned char*)(ws + WS_WV8), D, c0 - 2048);
                   tr8_load(m, tv, F.lane); tr8_finish(tv, m, scr, F.lane); continue; }
            else if (c0 < 6592) { f32x4 tv[16]; const MoeItem m = f8_item(I.w_in, D_IN, kb * 64, c0, (unsigned char*)(ws + WS_WSV8), D, c0 - 3072);
                   tr8_load(m, tv, F.lane); tr8_finish(tv, m, scr, F.lane); continue; }
            else { f32x4 tv[16]; const int cg = c0 - 6592, d0 = cg & 2047; const MoeItem m = f8_item(I.w_in, D_IN, kb * 64, c0, (unsigned char*)(ws + WS_WG8), D, (d0 >> 7) * 256 + (cg >= 2048 ? 128 : 0) + (d0 & 127));
                   tr8_load(m, tv, F.lane); tr8_finish(tv, m, scr, F.lane); continue; }
            (void)dst; (void)drow; continue; } r -= J0;
        if (r < J1) { const int kb = r / 32, cb = r % 32; f32x4 tv[16]; const MoeItem m = f8_item(I.proj_a, D, kb * 64, cb * 64, (unsigned char*)(ws + WS_PAT), AW, cb * 64); tr8_load(m, tv, F.lane); tr8_finish(tv, m, scr, F.lane); continue; } r -= J1;
        if (r < J2) { const int kb = r / 32, cb = r % 32; f32x4 tv[16]; const MoeItem m = f8_item(I.proj_b, D, kb * 64, cb * 64, (unsigned char*)(ws + WS_PBT), RW, cb * 64); tr8_load(m, tv, F.lane); tr8_finish(tv, m, scr, F.lane); continue; } r -= J2;
        { const int kb = r / 32, cb = r % 32; f32x4 tv[16]; const MoeItem m = f8_item(I.w_out, D, kb * 64, cb * 64, (unsigned char*)(ws + WS_WOT), D, cb * 64);
          tr8_load(m, tv, F.lane); tr8_finish(tv, m, scr, F.lane); }
    }
    const int gt = F.vcu * (NWAVES * 64) + F.tid, NGT = F.G * NWAVES * 64;
    for (int i = gt; i < 2048 * 256; i += NGT) { const int n = i >> 8, k = i & 255; float v = 0.f;
        if (n < 1024) { if (k < DLORA) v = I.w_up[(size_t)k * RW + n]; }
        else { if (k >= 128 && k < 128 + ALORA) v = I.a_up[(size_t)(k - 128) * RW + (n - 1024)]; }
        ((bf16*)(ws + WS_WLA))[i] = (bf16)f2bf(v); }
    for (int i = gt; i < 1024 * 256; i += NGT) { const int n = i >> 8, k = i & 255; ((bf16*)(ws + WS_WLG))[i] = (bf16)f2bf(I.g_up[(size_t)k * RW + n]); }
    for (int i = gt; i < 64 * D / 16; i += NGT) ((GAS v4u*)((unsigned char*)(ws + WS_WSV8) + (size_t)SHIFT_W * D))[i] = (v4u){0u, 0u, 0u, 0u};
    for (int i = gt; i < RROWS; i += NGT) ((int*)(ws + WS_ROWSLOT))[i] = -1;
    for (size_t i = gt; i < (size_t)T * D / 8; i += NGT) { const f32x4 a = ((const GAS f32x4*)I.x)[2 * i], b = ((const GAS f32x4*)I.x)[2 * i + 1];
        int w0 = __builtin_amdgcn_cvt_pk_fp8_f32(a.x, a.y, 0, false); w0 = __builtin_amdgcn_cvt_pk_fp8_f32(a.z, a.w, w0, true);
        int w1 = __builtin_amdgcn_cvt_pk_fp8_f32(b.x, b.y, 0, false); w1 = __builtin_amdgcn_cvt_pk_fp8_f32(b.z, b.w, w1, true);
        ((GAS v2u*)(ws + WS_XB8))[i] = (v2u){(unsigned)w0, (unsigned)w1}; }
}

constexpr int P8_HS = 0, P8_PITCH = 2052, P8_PART = 131328, P8_LOG = 147712, P8_HIST = 149760;
template <bool SKIP_MIX>
__device__ __forceinline__ void p8_ln_router(Frame& F0, const In& I) {
    PHASE_FRAME(F0);
    LAS float* hs = (LAS float*)(F.lds + P8_HS); LAS float* part = (LAS float*)(F.lds + P8_PART); LAS float* lg = (LAS float*)(F.lds + P8_LOG); LAS int* hist = (LAS int*)(F.lds + P8_HIST);
    const int lane = F.lane, w = F.wave;
    if (F.tid < 32) hist[F.tid] = 0;
    const int kq = lane >> 4, col = lane & 15;
    float ln_w[32], ln_b[32];
#pragma unroll
    for (int j = 0; j < 8; ++j) { const f32x4 a = *(const GAS f32x4*)(I.ln1_w + 4 * lane + 256 * j), b = *(const GAS f32x4*)(I.ln1_b + 4 * lane + 256 * j);
#pragma unroll
        for (int e = 0; e < 4; ++e) { ln_w[4 * j + e] = a[e]; ln_b[4 * j + e] = b[e]; } }
    __syncthreads();
    const float* zsrc = I.x; const bf16* mixb = (const bf16*)(F.ws + WS_Z);
    for (int g = F.vcu; g < T / 16; g += F.G) {
        const int tok0 = g * 16;
        { f32x4 va[8], vb[8];
          const size_t tokA = (size_t)(tok0 + 2 * w), tokB = tokA + 1;
          const GAS f32x4* zra = (const GAS f32x4*)(zsrc + tokA * D) + lane; const GAS f32x4* zrb = (const GAS f32x4*)(zsrc + tokB * D) + lane;
          const GAS v2u* mra = (const GAS v2u*)(mixb + tokA * D) + lane; const GAS v2u* mrb = (const GAS v2u*)(mixb + tokB * D) + lane;
          v2u ma[8], mb[8];
#pragma unroll
          for (int j = 0; j < 8; ++j) { va[j] = zra[64 * j]; vb[j] = zrb[64 * j]; if (!SKIP_MIX) { ma[j] = mra[64 * j]; mb[j] = mrb[64 * j]; } }
#pragma unroll
          for (int j = 0; j < 8; ++j) { va[j] = va[j] * DN_ALPHA; vb[j] = vb[j] * DN_ALPHA;
              if (!SKIP_MIX) { va[j] += (f32x4){bflo(ma[j].x), bfhi(ma[j].x), bflo(ma[j].y), bfhi(ma[j].y)}; vb[j] += (f32x4){bflo(mb[j].x), bfhi(mb[j].x), bflo(mb[j].y), bfhi(mb[j].y)}; } }
#pragma unroll
          for (int tt = 0; tt < 2; ++tt) {
            const int tl = 2 * w + tt; const size_t tok = (size_t)(tok0 + tl);
            f32x4 v[8]; float s = 0.f;
#pragma unroll
            for (int j = 0; j < 8; ++j) { v[j] = tt ? vb[j] : va[j]; s += (v[j].x + v[j].y) + (v[j].z + v[j].w); }
            const float mean = wave_sum(s) * (1.f / D); float s2 = 0.f;
#pragma unroll
            for (int j = 0; j < 8; ++j) { v[j] = v[j] - mean; s2 += (v[j].x * v[j].x + v[j].y * v[j].y) + (v[j].z * v[j].z + v[j].w * v[j].w); }
            const float rstd = 1.f / sqrtf(wave_sum(s2) * (1.f / D) + LN_EPS);
            GAS v2u* h1 = (GAS v2u*)((bf16*)(F.ws + WS_H1) + tok * D) + lane;
            GAS unsigned* h1b = (GAS unsigned*)((unsigned char*)(F.ws + WS_H1B) + tok * D) + lane;
#pragma unroll
            for (int j = 0; j < 8; ++j) { f32x4 h;
#pragma unroll
                for (int e = 0; e < 4; ++e) h[e] = v[j][e] * rstd * ln_w[4 * j + e] + ln_b[4 * j + e];
                h1[64 * j] = (v2u){pg8::cvt_pk_bf16(h.x, h.y), pg8::cvt_pk_bf16(h.z, h.w)}; { int w8 = __builtin_amdgcn_cvt_pk_fp8_f32(h.x, h.y, 0, false); w8 = __builtin_amdgcn_cvt_pk_fp8_f32(h.z, h.w, w8, true); h1b[64 * j] = (unsigned)w8; }
                *(LAS f32x4*)(hs + tl * P8_PITCH + 4 * lane + 256 * j) = h; }
          } }
        __syncthreads();
        f32x4 c0 = (f32x4){0.f, 0.f, 0.f, 0.f}, c1 = c0;
        const LAS float* ap = hs + col * P8_PITCH + 256 * w + 4 * kq;
        const float* bp = I.w_router + (size_t)(256 * w + 4 * kq) * NE + col;
#pragma unroll 4
        for (int kk = 0; kk < 16; ++kk) {
            const f32x4 a = *(const LAS f32x4*)(ap + 16 * kk);
#pragma unroll
            for (int e = 0; e < 4; ++e) {
                const float b0 = bp[(size_t)(16 * kk + e) * NE], b1 = bp[(size_t)(16 * kk + e) * NE + 16];
                c0 = __builtin_amdgcn_mfma_f32_16x16x4f32(a[e], b0, c0, 0, 0, 0);
                c1 = __builtin_amdgcn_mfma_f32_16x16x4f32(a[e], b1, c1, 0, 0, 0);
            }
        }
#pragma unroll
        for (int i = 0; i < 4; ++i) { part[(w * 16 + 4 * kq + i) * 32 + col] = c0[i]; part[(w * 16 + 4 * kq + i) * 32 + 16 + col] = c1[i]; }
        __syncthreads();
        { const int tl = F.tid >> 5, e = F.tid & 31; float s = I.b_router[e];
#pragma unroll
            for (int ww = 0; ww < 8; ++ww) s += part[(ww * 16 + tl) * 32 + e];
            lg[tl * 32 + e] = s; }
        __syncthreads();
        if (F.tid < 16) {
            const int tl = F.tid; float lv[32];
#pragma unroll
            for (int e = 0; e < 32; ++e) lv[e] = lg[tl * 32 + e];
            int ti[4]; float tv[4];
#pragma unroll
            for (int k = 0; k < 4; ++k) { float best = -3.4e38f; int bi = 0;
#pragma unroll
                for (int e = 0; e < 32; ++e) { const bool tk = lv[e] > best; best = tk ? lv[e] : best; bi = tk ? e : bi; }
                ti[k] = bi; tv[k] = best;
#pragma unroll
                for (int e = 0; e < 32; ++e) lv[e] = (e == bi) ? -3.4e38f : lv[e]; }
            float ex[4], sum = 0.f;
#pragma unroll
            for (int k = 0; k < 4; ++k) { ex[k] = __expf(tv[k] - tv[0]); sum += ex[k]; }
            const float inv = 1.f / sum;
            *(GAS v4u*)((int*)(F.ws + WS_TOPI) + (size_t)(tok0 + tl) * 4) = (v4u){(unsigned)ti[0], (unsigned)ti[1], (unsigned)ti[2], (unsigned)ti[3]};
            *(GAS f32x4*)((float*)(F.ws + WS_GATE) + (size_t)(tok0 + tl) * 4) = (f32x4){ex[0] * inv, ex[1] * inv, ex[2] * inv, ex[3] * inv};
#pragma unroll
            for (int k = 0; k < 4; ++k) __hip_atomic_fetch_add(&hist[ti[k]], 1, __ATOMIC_RELAXED, __HIP_MEMORY_SCOPE_WORKGROUP);
        }
        __syncthreads();
    }
    if (F.tid < 32) { const int c = hist[F.tid]; if (c) __hip_atomic_fetch_add(F.ctl + CW_CNT + F.tid, (unsigned)c, RLX_AGENT); }
}

template <bool SKIP_MOE>
__device__ __forceinline__ void p12_final(Frame& F0, const In& I, float* out) {
    PHASE_FRAME(F0);
    const int lane = F.lane; const int gw = F.vcu * NWAVES + F.wave, NGW = F.G * NWAVES;
    LAS f32x4* lnp = (LAS f32x4*)(F.lds);
    for (int u = F.tid; u < D / 4; u += NWAVES * 64) { lnp[u] = *(const GAS f32x4*)(I.ln2_w + 4 * u); lnp[D / 4 + u] = *(const GAS f32x4*)(I.ln2_b + 4 * u); }
    __syncthreads();
    v2u hraw[8]; unsigned yraw[4][8];
#define P12_LOAD(tok_) do { const unsigned hoff = (unsigned)(WS_H1 + (size_t)(tok_) * D * 2) + (unsigned)lane * 8u;        \
        _Pragma("unroll") for (int j = 0; j < 8; ++j) hraw[j] = *(const GAS v2u*)(F.ws + (size_t)(hoff + 512u * j)); \
        if (!SKIP_MOE) { const unsigned yoff = (unsigned)(WS_YSLOT + (size_t)(tok_) * 4 * D) + (unsigned)lane * 4u; \
            _Pragma("unroll") for (int k = 0; k < 4; ++k) { _Pragma("unroll") for (int j = 0; j < 8; ++j) yraw[k][j] = *(const GAS unsigned*)(F.ws + (size_t)(yoff + 2048u * k + 256u * j)); } } } while (0)
    if (gw < T) P12_LOAD(gw);
    for (int tok = gw; tok < T; tok += NGW) {
        f32x4 v[8]; float s = 0.f;
#pragma unroll
        for (int j = 0; j < 8; ++j) { const v2u hh = hraw[j]; v[j] = (f32x4){bflo(hh.x), bfhi(hh.x), bflo(hh.y), bfhi(hh.y)} * DN_ALPHA; }
        if (!SKIP_MOE) {
#pragma unroll
            for (int k = 0; k < 4; ++k) {
#pragma unroll
                for (int j = 0; j < 8; ++j) { const unsigned y = yraw[k][j]; const f32x2 lo = __builtin_amdgcn_cvt_pk_f32_fp8((int)y, false), hi = __builtin_amdgcn_cvt_pk_f32_fp8((int)y, true);
                    v[j].x += lo.x * YS_INV; v[j].y += lo.y * YS_INV; v[j].z += hi.x * YS_INV; v[j].w += hi.y * YS_INV; } }
        }
        __builtin_amdgcn_sched_barrier(0);
        if (tok + NGW < T) P12_LOAD(tok + NGW);
        __builtin_amdgcn_sched_barrier(0);
#pragma unroll
        for (int j = 0; j < 8; ++j) s += (v[j].x + v[j].y) + (v[j].z + v[j].w);
        const float mean = wave_sum(s) * (1.f / D); float s2 = 0.f;
#pragma unroll
        for (int j = 0; j < 8; ++j) { v[j] = v[j] - mean; s2 += (v[j].x * v[j].x + v[j].y * v[j].y) + (v[j].z * v[j].z + v[j].w * v[j].w); }
        const float rstd = 1.f / sqrtf(wave_sum(s2) * (1.f / D) + LN_EPS);
        GAS f32x4* o = (GAS f32x4*)(out + (size_t)tok * D) + lane;
#pragma unroll
        for (int j = 0; j < 8; ++j) { f32x4 h;
            const f32x4 lw = lnp[lane + 64 * j], lb = lnp[D / 4 + lane + 64 * j];
#pragma unroll
            for (int e = 0; e < 4; ++e) h[e] = v[j][e] * rstd * lw[e] + lb[e];
            o[64 * j] = h; }
    }
#undef P12_LOAD
}
__device__ __forceinline__ void moe_tables(Frame& F) {
    LAS int* tab = (LAS int*)(F.lds + TAB_OFF);
    if (F.tid == 0) { int run = 0;
        for (int e = 0; e < NE; ++e) { const int c = (int)__hip_atomic_load(F.ctl + CW_CNT + e, RLX_AGENT); const int p = (c + 255) / 256 * 256; tab[32 + e] = run; run += p; tab[e] = run; }
        tab[64] = run / 256; }
    __syncthreads();
}

__device__ __forceinline__ void p9_scatter(Frame& F0, const In& I) {
    PHASE_FRAME(F0);
    moe_tables(F);
    LAS int* tab = (LAS int*)(F.lds + TAB_OFF);
    LAS int* lh = (LAS int*)(F.lds + 0);
    LAS int* lb = (LAS int*)(F.lds + 128);
    LAS int* dst = (LAS int*)(F.lds + 256);
    const int* topi = (const int*)(F.ws + WS_TOPI); const float* gate = (const float*)(F.ws + WS_GATE);
    for (int ch = F.vcu; ch < T / 128; ch += F.G) {
        if (F.tid < 32) lh[F.tid] = 0;
        __syncthreads();
        const int s = ch * 512 + F.tid; const int e = topi[s]; const float gv = gate[s];
        const int rank = __hip_atomic_fetch_add(&lh[e], 1, __ATOMIC_RELAXED, __HIP_MEMORY_SCOPE_WORKGROUP);
        __syncthreads();
        if (F.tid < 32) { const int c = lh[F.tid]; lb[F.tid] = c ? (int)__hip_atomic_fetch_add(F.ctl + CW_CUR + F.tid, (unsigned)c, RLX_AGENT) : 0; }
        __syncthreads();
        const int d = tab[32 + e] + lb[e] + rank;
        ((int*)(F.ws + WS_ROWSLOT))[d] = s; ((float*)(F.ws + WS_ROWW))[d] = gv; dst[F.tid] = d;
        __syncthreads();
#pragma unroll 1
        for (int i0 = F.wave * 64; i0 < F.wave * 64 + 64; i0 += 8) {
            v4u v[8][2]; int dd[8];
#pragma unroll
            for (int q = 0; q < 8; ++q) { const int i = i0 + q; const int tok = ch * 128 + (i >> 2); dd[q] = dst[i];
                const GAS v4u* src = (const GAS v4u*)((const unsigned char*)(F.ws + WS_H1B) + (size_t)tok * D) + F.lane;
                v[q][0] = src[0]; v[q][1] = src[64]; }
#pragma unroll
            for (int q = 0; q < 8; ++q) { GAS v4u* o = (GAS v4u*)((unsigned char*)(F.ws + WS_XG) + (size_t)dd[q] * D) + F.lane; o[0] = v[q][0]; o[64] = v[q][1]; }
        }
        __syncthreads();
    }
}

__device__ __forceinline__ void p10_moe_up(Frame& F0, const In& I) {
    PHASE_FRAME(F0);
    moe_tables(F);
    LAS int* tab = (LAS int*)(F.lds + TAB_OFF);
    pg8::SchedMoe S; S.t.init(tab[64], 16, F.G, (int)blockIdx.x);
    S.A = (unsigned)(WS_XG); S.B = (unsigned)(WS_WGUT); S.tsA = (unsigned)256 * D; S.tsB = (unsigned)256 * D; S.es = (unsigned)2 * FF * D; S.pad_end = tab;
    pg8::EpiSwiglu E{(unsigned char*)(F.ws + WS_ACT), I.b_gu};
    pg8::gemm_phase<pg8::EpiSwiglu, pg8::SchedMoe, true, true>(F.lds + RING_OFF, F.rsrc, D / 2, D / 2, D / 2, S, E);
}
__device__ __forceinline__ void p11_moe_down(Frame& F0, const In& I) {
    PHASE_FRAME(F0);
    moe_tables(F);
    LAS int* tab = (LAS int*)(F.lds + TAB_OFF);
    pg8::SchedMoe S; S.t.init(tab[64], 8, F.G, (int)blockIdx.x);
    S.A = (unsigned)(WS_ACT); S.B = (unsigned)(WS_WDNT); S.tsA = (unsigned)256 * FF; S.tsB = (unsigned)256 * FF; S.es = (unsigned)D * FF; S.pad_end = tab;
    pg8::EpiDown E{(unsigned char*)(F.ws + WS_YSLOT), I.b_down, (const int*)(F.ws + WS_ROWSLOT), (const float*)(F.ws + WS_ROWW)};
    pg8::gemm_phase<pg8::EpiDown, pg8::SchedMoe, true, true>(F.lds + RING_OFF, F.rsrc, FF / 2, FF / 2, FF / 2, S, E);
}

__device__ __forceinline__ void p1_proj(Frame& F0, const In& I) {
    PHASE_FRAME(F0);
    { pg8::SchedPlain S; S.t.init(T / 256, SEG_PAD / 256, F.G, (int)blockIdx.x);
      S.A = (unsigned)(WS_XB8); S.B = (unsigned)(WS_WSV8); S.tsA = (unsigned)256 * D; S.tsB = (unsigned)256 * D;
      pg8::EpiShift E{(bf16*)(F.ws + WS_RKV), (bf16*)(F.ws + WS_LORAIN), (float*)(F.ws + WS_SIDE0), (float*)(F.ws + WS_SIDEL), I.shift_mu};
      pg8::gemm_phase<pg8::EpiShift, pg8::SchedPlain, true, true>(F.lds + RING_OFF, F.rsrc, D / 2, D / 2, D / 2, S, E); }
    { pg8::SchedPlain S; S.t.init(T / 256, (2 * AW) / 256, F.G, (int)blockIdx.x);
      S.A = (unsigned)(WS_XB8); S.B = (unsigned)(WS_WQK8); S.tsA = (unsigned)256 * D; S.tsB = (unsigned)256 * D;
      pg8::EpiProj E{(bf16*)(F.ws + WS_PROJ), 0, 4};
      pg8::gemm_phase<pg8::EpiProj, pg8::SchedPlain, true, true>(F.lds + RING_OFF, F.rsrc, D / 2, D / 2, D / 2, S, E); }
    { pg8::SchedPlain S; S.t.init(T / 256, (2 * D) / 256, F.G, (int)blockIdx.x);
      S.A = (unsigned)(WS_XB8); S.B = (unsigned)(WS_WG8); S.tsA = (unsigned)256 * D; S.tsB = (unsigned)256 * D;
      pg8::EpiGate E{(bf16*)(F.ws + WS_GATEF)};
      pg8::gemm_phase<pg8::EpiGate, pg8::SchedPlain, true, true>(F.lds + RING_OFF, F.rsrc, D / 2, D / 2, D / 2, S, E); }
    { pg8::SchedPlain S; S.t.init(AW / 256, T / 256, F.G, (int)blockIdx.x);
      S.A = (unsigned)(WS_WV8); S.B = (unsigned)(WS_XB8); S.tsA = (unsigned)256 * D; S.tsB = (unsigned)256 * D;
      pg8::EpiBf16 E{(bf16*)(F.ws + WS_VT), T};
      pg8::gemm_phase<pg8::EpiBf16, pg8::SchedPlain, true, true>(F.lds + RING_OFF, F.rsrc, D / 2, D / 2, D / 2, S, E); }
}

__device__ __forceinline__ float ftanh(float x) { return 2.0f * fsigmoid(2.0f * x) - 1.0f; }
__device__ __forceinline__ void p2_shift_attn(Frame& F0, const In& I) {
    PHASE_FRAME(F0);
    const int lane = F.lane; const int gw = F.vcu * NWAVES + F.wave, NGW = F.G * NWAVES;
    const bf16* PROJ = (const bf16*)(F.ws + WS_PROJ);
    for (int g = gw; g < T / 64; g += NGW) {
        const int tok = g * 64; const bool first = (tok % SEQ) == 0;
        const float* cur = (const float*)(F.ws + WS_SIDE0) + (size_t)g * SEG_PAD; const float* prv = (const float*)(F.ws + WS_SIDEL) + (size_t)(g - 1) * SEG_PAD;
        bf16* rkv = (bf16*)(F.ws + WS_RKV) + (size_t)tok * (3 * RW); bf16* lin = (bf16*)(F.ws + WS_LORAIN) + (size_t)tok * LORA_LD;
#pragma unroll 1
        for (int it = 0; it < 7; ++it) { const int gi = it * 64 + lane; if (gi >= SHIFT_W / 8) break; const int c = gi * 8;
            const f32x4 c0 = *(const GAS f32x4*)(cur + c), c1 = *(const GAS f32x4*)(cur + c + 4);
            f32x4 p0 = (f32x4){0.f, 0.f, 0.f, 0.f}, p1 = p0; if (!first) { p0 = *(const GAS f32x4*)(prv + c); p1 = *(const GAS f32x4*)(prv + c + 4); }
            const f32x4 m0 = *(const GAS f32x4*)(I.shift_mu + c), m1 = *(const GAS f32x4*)(I.shift_mu + c + 4);
            float v[8];
#pragma unroll
            for (int j = 0; j < 4; ++j) { v[j] = c0[j] + (p0[j] - c0[j]) * m0[j]; v[4 + j] = c1[j] + (p1[j] - c1[j]) * m1[j]; }
            bf16* dstp;
            if (c < 3 * RW) dstp = rkv + c;
            else if (c < 3 * RW + DLORA) { dstp = lin + (c - 3 * RW);
#pragma unroll
                for (int j = 0; j < 8; ++j) v[j] = ftanh(v[j]); }
            else if (c < 3 * RW + DLORA + ALORA) dstp = lin + 128 + (c - 3 * RW - DLORA);
            else { dstp = lin + 256 + (c - 3 * RW - DLORA - ALORA);
#pragma unroll
                for (int j = 0; j < 8; ++j) v[j] = fsigmoid(v[j]); }
            *(GAS v4u*)dstp = (v4u){pk2(v[0], v[1]), pk2(v[2], v[3]), pk2(v[4], v[5]), pk2(v[6], v[7])};
        }
    }
#if STAGE == 3
    { const int gt = F.vcu * (NWAVES * 64) + F.tid, NGT = F.G * NWAVES * 64;
      for (size_t i = gt; i < (size_t)T * RW / 8; i += NGT) ((GAS v4u*)(F.ws + WS_YB))[i] = (v4u){0u, 0u, 0u, 0u}; }
#endif
    LAS float* tbl = (LAS float*)(F.lds + 0);
    constexpr int AKV = 64 * 144, A_KOFF = 2048, A_VOFF = A_KOFF + 2 * AKV;
    const bf16* VT = (const bf16*)(F.ws + WS_VT); bf16* YA = (bf16*)(F.ws + WS_YA);
    const int r = lane & 31, hh = lane >> 5;
    const int rp = (r & 16) + 8 * ((r >> 2) & 1) + 4 * ((r >> 3) & 1) + (r & 3);
    const int srow = F.tid >> 3, spc = F.tid & 7;
    for (int task = F.vcu; task < BATCH * AH * (SEQ / 256); task += F.G) {
        const int bh = task >> 5, q256 = task & 31, b = bh >> 4, h = bh & 15, c0 = q256 * 4;
        const int q0 = q256 * 256 + F.wave * 32, cw = c0 + (F.wave >> 1);
        const int kc_lo = (c0 > LEFT) ? c0 - LEFT : 0, kc_hi = c0 + 3;
        __syncthreads();
        if (F.tid < REL_TABLE) tbl[F.tid] = I.rel_bias[h * REL_TABLE + F.tid];
        const size_t tokq = (size_t)b * SEQ + q0 + r;
        bf16x8 qf[4];
#pragma unroll
        for (int s = 0; s < 4; ++s) qf[s] = *(const GAS bf16x8*)(PROJ + tokq * PROJ_LD + PJ_Q + h * 64 + 16 * s + 8 * hh);
        f32x16 o0, o1;
#pragma unroll
        for (int i = 0; i < 16; ++i) { o0[i] = 0.f; o1[i] = 0.f; }
        float m_run = -1e30f, l_run = 0.f;
        v4u kreg, vreg;
#define AT_STAGE_LOAD(kc_) do { kreg = *(const GAS v4u*)(PROJ + ((size_t)b * SEQ + (size_t)(kc_) * 64 + srow) * PROJ_LD + PJ_K + h * 64 + spc * 8); \
                                vreg = *(const GAS v4u*)(VT + (size_t)(h * 64 + srow) * T + (size_t)b * SEQ + (size_t)(kc_) * 64 + spc * 8); } while (0)
#define AT_STAGE_WRITE(buf_) do { *(LAS v4u*)(F.lds + A_KOFF + (buf_) * AKV + srow * 144 + spc * 16) = kreg; *(LAS v4u*)(F.lds + A_VOFF + (buf_) * AKV + srow * 144 + spc * 16) = vreg; } while (0)
        AT_STAGE_LOAD(kc_lo); AT_STAGE_WRITE(0);
        __syncthreads();
#pragma unroll 1
        for (int kc = kc_lo; kc <= kc_hi; ++kc) {
            const int buf = (kc - kc_lo) & 1;
            if (kc < kc_hi) AT_STAGE_LOAD(kc + 1);
            if (kc >= cw - LEFT && kc <= cw) {
                const LAS unsigned char* Kb = F.lds + A_KOFF + buf * AKV; const LAS unsigned char* Vb = F.lds + A_VOFF + buf * AKV;
                bf16x8 kf[2][4];
#pragma unroll
                for (int tt = 0; tt < 2; ++tt)
#pragma unroll
                    for (int s = 0; s < 4; ++s) kf[tt][s] = *(const LAS bf16x8*)(Kb + (32 * tt + rp) * 144 + 32 * s + 16 * hh);
                f32x16 st[2];
#pragma unroll
                for (int tt = 0; tt < 2; ++tt)
#pragma unroll
                    for (int i = 0; i < 16; ++i) st[tt][i] = 0.f;
#pragma unroll
                for (int s = 0; s < 4; ++s) { st[0] = __builtin_amdgcn_mfma_f32_32x32x16_bf16(kf[0][s], qf[s], st[0], 0, 0, 0); st[1] = __builtin_amdgcn_mfma_f32_32x32x16_bf16(kf[1][s], qf[s], st[1], 0, 0, 0); }
                bf16x8 va[2][2], vb[2][2];
#pragma unroll
                for (int tt = 0; tt < 2; ++tt)
#pragma unroll
                    for (int s2 = 0; s2 < 2; ++s2) { va[tt][s2] = *(const LAS bf16x8*)(Vb + r * 144 + 64 * tt + 32 * s2 + 16 * hh); vb[tt][s2] = *(const LAS bf16x8*)(Vb + (32 + r) * 144 + 64 * tt + 32 * s2 + 16 * hh); }
                float mx = -1e30f;
#pragma unroll
                for (int tt = 0; tt < 2; ++tt) {
                    const int kpos0 = kc * 64 + 32 * tt;
                    const int dbase = (q0 + r) - (kpos0 + 8 * hh);
                    if (q0 - (kpos0 + 31) >= MAX_PAST) {
                        const float bc = tbl[MAX_PAST + 63];
#pragma unroll
                        for (int i = 0; i < 16; ++i) { st[tt][i] += bc; mx = fmaxf(mx, st[tt][i]); }
                    } else {
#pragma unroll
                        for (int i = 0; i < 16; ++i) { int d = dbase - (16 * (i >> 3) + 4 * ((i >> 2) & 1) + (i & 3)); d = d < MAX_PAST ? d : MAX_PAST; st[tt][i] += tbl[d + 63]; mx = fmaxf(mx, st[tt][i]); }
                    }
                }
                { const unsigned mu_ = __builtin_bit_cast(unsigned, mx);
                  const auto sw_ = __builtin_amdgcn_permlane32_swap(mu_, mu_, false, false);
                  mx = fmaxf(__builtin_bit_cast(float, sw_[0]), __builtin_bit_cast(float, sw_[1])); }
                const float m_new = fmaxf(m_run, mx), alpha = __expf(m_run - m_new);
                float ls = 0.f;
#pragma unroll
                for (int tt = 0; tt < 2; ++tt)
#pragma unroll
                    for (int i = 0; i < 16; ++i) { st[tt][i] = __expf(st[tt][i] - m_new); ls += st[tt][i]; }
                l_run = l_run * alpha + ls;
                if (__builtin_amdgcn_ballot_w64(m_new != m_run)) {
#pragma unroll
                    for (int i = 0; i < 16; ++i) { o0[i] *= alpha; o1[i] *= alpha; } }
                m_run = m_new;
#pragma unroll
                for (int tt = 0; tt < 2; ++tt)
#pragma unroll
                    for (int s2 = 0; s2 < 2; ++s2) {
                        v4u pw; pw.x = pg8::cvt_pk_bf16(st[tt][8 * s2 + 0], st[tt][8 * s2 + 1]); pw.y = pg8::cvt_pk_bf16(st[tt][8 * s2 + 2], st[tt][8 * s2 + 3]); pw.z = pg8::cvt_pk_bf16(st[tt][8 * s2 + 4], st[tt][8 * s2 + 5]); pw.w = pg8::cvt_pk_bf16(st[tt][8 * s2 + 6], st[tt][8 * s2 + 7]);
                        const bf16x8 pf = __builtin_bit_cast(bf16x8, pw);
                        o0 = __builtin_amdgcn_mfma_f32_32x32x16_bf16(va[tt][s2], pf, o0, 0, 0, 0);
                        o1 = __builtin_amdgcn_mfma_f32_32x32x16_bf16(vb[tt][s2], pf, o1, 0, 0, 0);
                    }
            }
            if (kc < kc_hi) AT_STAGE_WRITE(buf ^ 1);
            __syncthreads();
        }
#undef AT_STAGE_LOAD
#undef AT_STAGE_WRITE
        const float inv = 1.0f / (l_run + __shfl_xor(l_run, 32));
        unsigned char* yo = (unsigned char*)YA + tokq * AW + h * 64 + 4 * hh;
        const float inv16 = inv * ACT8_SCALE;
#pragma unroll
        for (int g4 = 0; g4 < 4; ++g4) {
            int w0 = __builtin_amdgcn_cvt_pk_fp8_f32(o0[4 * g4] * inv16, o0[4 * g4 + 1] * inv16, 0, false); w0 = __builtin_amdgcn_cvt_pk_fp8_f32(o0[4 * g4 + 2] * inv16, o0[4 * g4 + 3] * inv16, w0, true);
            int w1 = __builtin_amdgcn_cvt_pk_fp8_f32(o1[4 * g4] * inv16, o1[4 * g4 + 1] * inv16, 0, false); w1 = __builtin_amdgcn_cvt_pk_fp8_f32(o1[4 * g4 + 2] * inv16, o1[4 * g4 + 3] * inv16, w1, true);
            *(GAS unsigned*)(yo + 8 * g4) = (unsigned)w0; *(GAS unsigned*)(yo + 32 + 8 * g4) = (unsigned)w1;
        }
    }
}

__device__ __forceinline__ void p6_merged(Frame& F0, const In& I) {
    PHASE_FRAME(F0);
    pg8::SchedTwo S; S.t.init(T / 256, D / 256, F.G, (int)blockIdx.x);
    S.A0 = (unsigned)(WS_YA); S.A1 = (unsigned)(WS_YB); S.B0 = (unsigned)(WS_PAT); S.B1 = (unsigned)(WS_PBT);
    S.tsA = (unsigned)256 * AW; S.tsB = (unsigned)256 * AW;
    pg8::EpiMerged E{(const bf16*)(F.ws + WS_GATEF), (bf16*)(F.ws + WS_MERGED)};
    pg8::gemm_phase<pg8::EpiMerged, pg8::SchedTwo, true, true, 0x00007b79>(F.lds + RING_OFF, F.rsrc, AW / 2, AW / 2, AW / 2, S, E);
}
__device__ __forceinline__ void p7_mix(Frame& F0, const In& I) {
    PHASE_FRAME(F0);
    pg8::SchedPlain S; S.t.init(T / 256, D / 256, F.G, (int)blockIdx.x);
    S.A = (unsigned)(WS_MERGED); S.B = (unsigned)(WS_WOT); S.tsA = (unsigned)256 * D; S.tsB = (unsigned)256 * D;
    pg8::EpiBf16 E{(bf16*)(F.ws + WS_Z), D};
    pg8::gemm_phase<pg8::EpiBf16, pg8::SchedPlain, true, true, 0x00007b79>(F.lds + RING_OFF, F.rsrc, D / 2, D / 2, D / 2, S, E);
}

__device__ __forceinline__ void p3_lora(Frame& F0, const In& I) {
    PHASE_FRAME(F0);
    { pg8::SchedPlain S; S.t.init(T / 256, 4, F.G, (int)blockIdx.x);
      S.A = (unsigned)(WS_LORAIN); S.B = (unsigned)(WS_WLA); S.tsA = (unsigned)256 * LORA_LD * 2; S.tsB = (unsigned)256 * 256 * 2;
      pg8::EpiLoraA<true> E{(float*)(F.ws + WS_DECAY), I.w0};
      pg8::gemm_phase<pg8::EpiLoraA<true>, pg8::SchedPlain, true>(F.lds + RING_OFF, F.rsrc, LORA_LD, 256, 256, S, E); }
    { pg8::SchedPlain S; S.t.init(T / 256, 4, F.G, (int)blockIdx.x);
      S.A = (unsigned)(WS_LORAIN); S.B = (unsigned)(WS_WLA + (size_t)1024 * 256 * 2); S.tsA = (unsigned)256 * LORA_LD * 2; S.tsB = (unsigned)256 * 256 * 2;
      pg8::EpiIclr E{(bf16*)(F.ws + WS_ICLR), I.a0};
      pg8::gemm_phase<pg8::EpiIclr, pg8::SchedPlain, true>(F.lds + RING_OFF, F.rsrc, LORA_LD, 256, 256, S, E); }
    { pg8::SchedPlain S; S.t.init(T / 256, 4, F.G, (int)blockIdx.x);
      S.A = (unsigned)(WS_LORAIN + 512); S.B = (unsigned)(WS_WLG); S.tsA = (unsigned)256 * LORA_LD * 2; S.tsB = (unsigned)256 * 256 * 2;
      pg8::EpiBf16 E{(bf16*)(F.ws + WS_G), RW};
      pg8::gemm_phase<pg8::EpiBf16, pg8::SchedPlain, true>(F.lds + RING_OFF, F.rsrc, LORA_LD, 256, 256, S, E); }
}

constexpr int CP = 144;
constexpr int CMAT = 64 * CP;
constexpr int C_RT = 0 * CMAT, C_ATT = 1 * CMAT, C_AAK = 2 * CMAT, C_ARKT = 3 * CMAT, C_WA = 4 * CMAT, C_WB = 6 * CMAT,
              C_MA = 8 * CMAT, C_MTA = 9 * CMAT, C_MB = 10 * CMAT, C_MTB = 11 * CMAT, C_SEG = 12 * CMAT, C_GAM = C_SEG + 8 * 64 * 4, C_TSCR = C_GAM + 256;
constexpr int C_AT = C_WB, C_BT = C_WB + CMAT, C_KT = C_MB, C_QYT = C_MA, C_QST = C_MTA, C_KHT = C_MTB, C_VT = C_WB;
static_assert(C_TSCR % 16 == 0 && C_TSCR + 8 * 5120 <= TAB_OFF, "P4a LDS map");
static_assert(BATCH * RH * (SEQ / 64) * 12 == MOE_NITEMS, "P4a converts exactly 12 expert-weight tiles per chunk unit");
constexpr int CHK_UNIT_BYTES = 4 * 64 * 64 * 2;
#define CBAR() do { asm volatile("s_waitcnt lgkmcnt(0)" ::: "memory"); __builtin_amdgcn_s_barrier(); asm volatile("" ::: "memory"); } while (0)
template <int NT, class Epi>
__device__ __forceinline__ void cmm(const LAS unsigned char* X, const LAS unsigned char* Y, int mt0, int nt, int lane, const Epi& E) {
    const int lr = lane & 15, kq = lane >> 4;
    const bf16x8 b0 = *(const LAS bf16x8*)(Y + (nt * 16 + lr) * CP + kq * 16), b1 = *(const LAS bf16x8*)(Y + (nt * 16 + lr) * CP + kq * 16 + 64);
#pragma unroll
    for (int i = 0; i < NT; ++i) { const int mt = mt0 + i;
        const bf16x8 a0 = *(const LAS bf16x8*)(X + (mt * 16 + lr) * CP + kq * 16), a1 = *(const LAS bf16x8*)(X + (mt * 16 + lr) * CP + kq * 16 + 64);
        f32x4 acc = (f32x4){0.f, 0.f, 0.f, 0.f};
        acc = __builtin_amdgcn_mfma_f32_16x16x32_bf16(a0, b0, acc, 0, 0, 0);
        acc = __builtin_amdgcn_mfma_f32_16x16x32_bf16(a1, b1, acc, 0, 0, 0);
        E(mt, nt, acc); }
}
__device__ __forceinline__ v2u pack4(const f32x4& v) { return (v2u){pg8::cvt_pk_bf16(v[0], v[1]), pg8::cvt_pk_bf16(v[2], v[3])}; }
__device__ __forceinline__ f32x4 unpack4(const v2u w) { return (f32x4){bflo(w.x), bfhi(w.x), bflo(w.y), bfhi(w.y)}; }
__device__ __forceinline__ void p4a_chunk(Frame& F0, const In& I) {
    PHASE_FRAME(F0);
    LAS unsigned char* L = F.lds;
    const int lane = F.lane, w = F.wave, lr = lane & 15, kq = lane >> 4;
    const bf16* RKV = (const bf16*)(F.ws + WS_RKV); const float* LW = (const float*)(F.ws + WS_DECAY); const bf16* ICL = (const bf16*)(F.ws + WS_ICLR);
    unsigned char* CHK = F.ws + WS_CHK;
    int uit = 0;
    for (int unit = F.vcu; unit < BATCH * RH * (SEQ / 64); unit += F.G, ++uit) {
        const int bh = unit >> 7, ck = unit & 127, b = bh >> 4, h = bh & 15;
        const size_t tok0 = (size_t)b * SEQ + (size_t)ck * 64 + 8 * w;
        const int hc = h * 64 + lane;
        float lwv[8], ic[8], rr[8], kk[8], vv[8];
#pragma unroll
        for (int i = 0; i < 8; ++i) { const size_t tok = tok0 + i; lwv[i] = LW[tok * RW + hc]; ic[i] = bf2f(ICL[tok * RW + hc]);
            rr[i] = bf2f(RKV[tok * (3 * RW) + hc]); kk[i] = bf2f(RKV[tok * (3 * RW) + RW + hc]); vv[i] = bf2f(RKV[tok * (3 * RW) + 2 * RW + hc]); }
        const float kkp = I.k_k[hc], kap = I.k_a[hc];
        float cs[8]; { float run = 0.f;
#pragma unroll
            for (int i = 0; i < 8; ++i) { run += lwv[i]; cs[i] = run; } }
        __syncthreads();
        ((LAS float*)(L + C_SEG))[w * 64 + lane] = cs[7];
        CBAR();
        float pre = 0.f, tot = 0.f;
#pragma unroll
        for (int j = 0; j < 8; ++j) { const float sg = ((const LAS float*)(L + C_SEG))[j * 64 + lane]; tot += sg; pre += (j < w) ? sg : 0.f; }
        if (w == 0) ((LAS float*)(L + C_GAM))[lane] = __expf(tot);
        unsigned att[4], bht[4], kht[4], vtt[4];
        float at_[8], bh_[8], kh_[8]; const float gtot = __expf(tot); float ep_prev = 1.f;
#pragma unroll
        for (int i = 0; i < 8; ++i) { const int t = 8 * w + i; const float cum = pre + cs[i], cump = cum - lwv[i];
            const float kkv = kk[i] * kkp; const float n2 = wave_sum(kkv * kkv); const float kkn = kkv * __builtin_amdgcn_rsqf(fmaxf(n2, 1e-24f));
            const float a = -kkn, bb = kkn * ic[i], kp = kk[i] * (1.0f + (ic[i] - 1.0f) * kap);
            const float ep = __expf(cum), em = __builtin_amdgcn_rcpf(ep), epp = (i == 0) ? __expf(cump) : ep_prev, eL = gtot * em; ep_prev = ep;
            const float Rv = rr[i] * ep, Av = a * epp, Bv = bb * em, Kv = kp * em;
            at_[i] = Av; bh_[i] = bb * eL; kh_[i] = kp * eL;
            *(LAS unsigned short*)(L + C_RT + t * CP + lane * 2) = (unsigned short)f2bf(Rv);
            *(LAS unsigned short*)(L + C_AT + t * CP + lane * 2) = (unsigned short)f2bf(Av);
            *(LAS unsigned short*)(L + C_BT + t * CP + lane * 2) = (unsigned short)f2bf(Bv);
            *(LAS unsigned short*)(L + C_KT + t * CP + lane * 2) = (unsigned short)f2bf(Kv); }
#pragma unroll
        for (int q = 0; q < 4; ++q) { att[q] = pk2(at_[2 * q], at_[2 * q + 1]); bht[q] = pk2(bh_[2 * q], bh_[2 * q + 1]); kht[q] = pk2(kh_[2 * q], kh_[2 * q + 1]); vtt[q] = pk2(vv[2 * q], vv[2 * q + 1]); }
        *(LAS v4u*)(L + C_ATT + lane * CP + 16 * w) = (v4u){att[0], att[1], att[2], att[3]};
        *(LAS v4u*)(L + C_WA + (64 + lane) * CP + 16 * w) = (v4u){bht[0], bht[1], bht[2], bht[3]};
        CBAR();
        const int cit = unit * 12 + w; const bool hx = cit < MOE_NITEMS, hy = (w < 4) && (cit + 8 < MOE_NITEMS);
        f32x4 tX[16]; MoeItem mX = moe_item(hx ? cit : 0, I.w_gu, I.w_down, F.ws);
        LAS float* tscr = (LAS float*)(L + C_TSCR + w * 5120);
        struct Fr { bf16x8 a, b; };
        auto LD = [&](int base, int tile) -> Fr { const LAS unsigned char* q = L + base + (tile * 16 + lr) * CP + kq * 16; Fr f; f.a = *(const LAS bf16x8*)q; f.b = *(const LAS bf16x8*)(q + 64); return f; };
        auto MM = [&](const Fr& x, const Fr& y) -> f32x4 { f32x4 acc = (f32x4){0.f, 0.f, 0.f, 0.f};
            acc = __builtin_amdgcn_mfma_f32_16x16x32_bf16(x.a, y.a, acc, 0, 0, 0); acc = __builtin_amdgcn_mfma_f32_16x16x32_bf16(x.b, y.b, acc, 0, 0, 0); return acc; };
        const int nt = w & 3, mt0 = 2 * (w >> 2), n = nt * 16 + lr;
        { const Fr yAT = LD(C_AT, nt), yKT = LD(C_KT, nt), yRT = LD(C_RT, nt);
          Fr xBT[2], xAT[2], xKT[2];
#pragma unroll
          for (int i = 0; i < 2; ++i) { xBT[i] = LD(C_BT, mt0 + i); xAT[i] = LD(C_AT, mt0 + i); xKT[i] = LD(C_KT, mt0 + i); }
          f32x4 a1[2], a2[2], a3[2], a4[2];
#pragma unroll
          for (int i = 0; i < 2; ++i) { a1[i] = MM(xBT[i], yAT); a2[i] = MM(xAT[i], yKT); a3[i] = MM(xBT[i], yRT); a4[i] = MM(xKT[i], yRT); }
#pragma unroll
          for (int i = 0; i < 2; ++i) { const int m0 = (mt0 + i) * 16 + 4 * kq;
              f32x4 v = a1[i];
#pragma unroll
              for (int e = 0; e < 4; ++e) { v[e] = (m0 + e < n) ? v[e] : 0.f; *(LAS unsigned short*)(L + C_MA + (m0 + e) * CP + n * 2) = (unsigned short)f2bf(v[e]); }
              *(LAS v2u*)(L + C_MTA + n * CP + m0 * 2) = pack4(v);
              v = a2[i];
#pragma unroll
              for (int e = 0; e < 4; ++e) v[e] = (n < m0 + e) ? v[e] : 0.f;
              *(LAS v2u*)(L + C_AAK + n * CP + m0 * 2) = pack4(v);
              v = a3[i];
#pragma unroll
              for (int e = 0; e < 4; ++e) v[e] = (m0 + e <= n) ? v[e] : 0.f;
              *(LAS v2u*)(L + C_WA + n * CP + m0 * 2) = pack4(v);
              v = a4[i];
#pragma unroll
              for (int e = 0; e < 4; ++e) v[e] = (m0 + e <= n) ? v[e] : 0.f;
              *(LAS v2u*)(L + C_ARKT + n * CP + m0 * 2) = pack4(v); } }
        CBAR();
        if (hx) tr8_load(mX, tX, lane);
#pragma unroll
        for (int lvl = 0; lvl < 6; ++lvl) {
            const int Wsrc = (lvl & 1) ? C_WB : C_WA, Wdst = (lvl & 1) ? C_WA : C_WB, Ms = (lvl & 1) ? C_MB : C_MA, Mts = (lvl & 1) ? C_MTB : C_MTA, Md = (lvl & 1) ? C_MA : C_MB, Mtd = (lvl & 1) ? C_MTA : C_MTB;
            const Fr yW = LD(Wsrc, w); Fr yMt; if (lvl < 5) yMt = LD(Mts, nt);
            Fr xM[4], xS[2];
#pragma unroll
            for (int i = 0; i < 4; ++i) xM[i] = LD(Ms, i);
            if (lvl < 5) { xS[0] = LD(Ms, mt0); xS[1] = LD(Ms, mt0 + 1); }
            const int nj = w * 16 + lr;
            f32x4 old[4], aw[4], as[2];
#pragma unroll
            for (int i = 0; i < 4; ++i) old[i] = unpack4(*(const LAS v2u*)(L + Wsrc + nj * CP + (i * 16 + 4 * kq) * 2));
#pragma unroll
            for (int i = 0; i < 4; ++i) aw[i] = MM(xM[i], yW);
            if (lvl < 5) {
#pragma unroll
                for (int i = 0; i < 2; ++i) as[i] = MM(xS[i], yMt); }
#pragma unroll
            for (int i = 0; i < 4; ++i) *(LAS v2u*)(L + Wdst + nj * CP + (i * 16 + 4 * kq) * 2) = pack4(old[i] + aw[i]);
            if (lvl < 5) {
#pragma unroll
                for (int i = 0; i < 2; ++i) { const int m0 = (mt0 + i) * 16 + 4 * kq;
#pragma unroll
                    for (int e = 0; e < 4; ++e) *(LAS unsigned short*)(L + Md + (m0 + e) * CP + n * 2) = (unsigned short)f2bf(as[i][e]);
                    if (lvl < 4) *(LAS v2u*)(L + Mtd + n * CP + m0 * 2) = pack4(as[i]); } }
            if (lvl == 4) *(LAS v4u*)(L + C_KHT + lane * CP + 16 * w) = (v4u){kht[0], kht[1], kht[2], kht[3]};
            if (lvl == 2) { if (hx) tr8_finish(tX, mX, tscr, lane);
                            if (hy) { mX = moe_item(cit + 8, I.w_gu, I.w_down, F.ws); tr8_load(mX, tX, lane); } }
            CBAR();
        }
        *(LAS v4u*)(L + C_VT + lane * CP + 16 * w) = (v4u){vtt[0], vtt[1], vtt[2], vtt[3]};
        unsigned char* og = CHK + (size_t)unit * CHK_UNIT_BYTES;
        { const Fr yW1 = LD(C_WA, nt), yW2 = LD(C_WA + 64 * CP, nt);
          Fr xA[2], xK[2];
#pragma unroll
          for (int i = 0; i < 2; ++i) { xA[i] = LD(C_ATT, mt0 + i); xK[i] = LD(C_AAK, mt0 + i); }
          f32x4 rv[2], av[2], kv[2];
          const float gm = ((const LAS float*)(L + C_GAM))[n];
#pragma unroll
          for (int i = 0; i < 2; ++i) { const int m0 = (mt0 + i) * 16 + 4 * kq;
              rv[i] = unpack4(*(const LAS v2u*)(L + C_RT + n * CP + m0 * 2)); av[i] = unpack4(*(const LAS v2u*)(L + C_ARKT + n * CP + m0 * 2)); kv[i] = unpack4(*(const LAS v2u*)(L + C_KHT + n * CP + m0 * 2)); }
          f32x4 p7[2], p8[2], p9[2], p10[2];
#pragma unroll
          for (int i = 0; i < 2; ++i) { p7[i] = MM(xA[i], yW1); p8[i] = MM(xK[i], yW1); p9[i] = MM(xA[i], yW2); p10[i] = MM(xK[i], yW2); }
#pragma unroll
          for (int i = 0; i < 2; ++i) { const int m0 = (mt0 + i) * 16 + 4 * kq;
              *(GAS v2u*)(og + 0 * 8192 + n * 128 + m0 * 2) = pack4(p7[i] + rv[i]);
              *(LAS v2u*)(L + C_QYT + n * CP + m0 * 2) = pack4(p8[i] + av[i]);
              f32x4 v = p9[i];
#pragma unroll
              for (int e = 0; e < 4; ++e) v[e] += (m0 + e == n) ? gm : 0.f;
              *(GAS v2u*)(og + 1 * 8192 + n * 128 + m0 * 2) = pack4(v);
              *(LAS v2u*)(L + C_QST + n * CP + m0 * 2) = pack4(p10[i] + kv[i]); } }
        CBAR();
        { const Fr yQy = LD(C_QYT, nt), yQs = LD(C_QST, nt);
          Fr xV[2];
#pragma unroll
          for (int i = 0; i < 2; ++i) xV[i] = LD(C_VT, mt0 + i);
          f32x4 p11[2], p12[2];
#pragma unroll
          for (int i = 0; i < 2; ++i) { p11[i] = MM(xV[i], yQy); p12[i] = MM(xV[i], yQs); }
#pragma unroll
          for (int i = 0; i < 2; ++i) { const int m0 = (mt0 + i) * 16 + 4 * kq;
              *(GAS v2u*)(og + 2 * 8192 + n * 128 + m0 * 2) = pack4(p11[i]);
              *(GAS v2u*)(og + 3 * 8192 + n * 128 + m0 * 2) = pack4(p12[i]); } }
        if (hy) tr8_finish(tX, mX, tscr, lane);
    }
}

constexpr int C2_SLOT = 20480;
__device__ __forceinline__ void p4b_scan(Frame& F0, const In& I) {
    PHASE_FRAME(F0);
    const int lane = F.lane, lr = lane & 15, kq = lane >> 4;
    const unsigned char* CHK = F.ws + WS_CHK; bf16* YS = (bf16*)(F.ws + WS_YSCAN);
    for (int unit = F.vcu; unit < BATCH * RH * 4; unit += F.G) {
        const int bh = unit >> 2, rq = unit & 3, b = bh >> 4, h = bh & 15;
        if (F.wave == 0) {
            LAS unsigned char* Sl = F.lds + 3 * C2_SLOT;
            f32x4 S[4]; bf16x8 sf[2];
#pragma unroll
            for (int nt = 0; nt < 4; ++nt) S[nt] = (f32x4){0.f, 0.f, 0.f, 0.f};
#pragma unroll
            for (int ks = 0; ks < 2; ++ks)
#pragma unroll
                for (int j = 0; j < 8; ++j) sf[ks][j] = 0;
#define C2_DMA(ck_) do { const int ckc_ = (ck_) < SEQ / 64 ? (ck_) : SEQ / 64 - 1; const unsigned char* ug = CHK + ((size_t)bh * 128 + ckc_) * CHK_UNIT_BYTES; \
                LAS unsigned char* sl_ = F.lds + ((ck_) % 3) * C2_SLOT; \
                _Pragma("unroll") for (int j = 0; j < 16; ++j) __builtin_amdgcn_global_load_lds((const unsigned*)(ug + j * 1024 + lane * 16), (LAS unsigned*)(sl_ + j * 1024), 16, 0, 0); \
                _Pragma("unroll") for (int j = 0; j < 2; ++j) { \
                    __builtin_amdgcn_global_load_lds((const unsigned*)(ug + 2 * 8192 + (j * 32 + (lane >> 1)) * 128 + rq * 32 + (lane & 1) * 16), (LAS unsigned*)(sl_ + 16384 + j * 1024), 16, 0, 0); \
                    __builtin_amdgcn_global_load_lds((const unsigned*)(ug + 3 * 8192 + (j * 32 + (lane >> 1)) * 128 + rq * 32 + (lane & 1) * 16), (LAS unsigned*)(sl_ + 18432 + j * 1024), 16, 0, 0); } } while (0)
            C2_DMA(0); C2_DMA(1);
#pragma unroll 1
            for (int ck = 0; ck < SEQ / 64; ++ck) {
                asm volatile("s_waitcnt lgkmcnt(0)" ::: "memory");
                C2_DMA(ck + 2);
                asm volatile("s_waitcnt vmcnt(40)" ::: "memory");
                const LAS unsigned char* sl_ = F.lds + (ck % 3) * C2_SLOT;
#pragma unroll
                for (int nt = 0; nt < 4; ++nt) {
                    const bf16x8 py0 = *(const LAS bf16x8*)(sl_ + (16 * nt + lr) * 128 + kq * 16), py1 = *(const LAS bf16x8*)(sl_ + (16 * nt + lr) * 128 + kq * 16 + 64);
                    const bf16x8 ps0 = *(const LAS bf16x8*)(sl_ + 8192 + (16 * nt + lr) * 128 + kq * 16), ps1 = *(const LAS bf16x8*)(sl_ + 8192 + (16 * nt + lr) * 128 + kq * 16 + 64);
                    f32x4 y = unpack4(*(const LAS v2u*)(sl_ + 16384 + (16 * nt + lr) * 32 + kq * 8));
                    f32x4 s2 = unpack4(*(const LAS v2u*)(sl_ + 18432 + (16 * nt + lr) * 32 + kq * 8));
                    y = __builtin_amdgcn_mfma_f32_16x16x32_bf16(sf[0], py0, y, 0, 0, 0); y = __builtin_amdgcn_mfma_f32_16x16x32_bf16(sf[1], py1, y, 0, 0, 0);
                    *(GAS v2u*)(YS + ((size_t)b * SEQ + (size_t)ck * 64 + 16 * nt + lr) * RW + h * 64 + rq * 16 + 4 * kq) = pack4(y);
                    s2 = __builtin_amdgcn_mfma_f32_16x16x32_bf16(sf[0], ps0, s2, 0, 0, 0); s2 = __builtin_amdgcn_mfma_f32_16x16x32_bf16(sf[1], ps1, s2, 0, 0, 0);
                    S[nt] = s2; }
#pragma unroll
                for (int nt = 0; nt < 4; ++nt)
#pragma unroll
                    for (int i = 0; i < 4; ++i) *(LAS unsigned short*)(Sl + (4 * kq + i) * CP + (16 * nt + lr) * 2) = (unsigned short)f2bf(S[nt][i]);
                LDS_WAIT(); asm volatile("" ::: "memory");
                sf[0] = *(const LAS bf16x8*)(Sl + lr * CP + kq * 16); sf[1] = *(const LAS bf16x8*)(Sl + lr * CP + kq * 16 + 64);
                LDS_WAIT(); asm volatile("" ::: "memory");
            }
            asm volatile("s_waitcnt vmcnt(0)" ::: "memory");
#undef C2_DMA
        }
    }
}
static_assert(3 * C2_SLOT + 4096 + 5 * 16640 <= TAB_OFF, "P4b LDS map");

__device__ __forceinline__ void p5_post(Frame& F0, const In& I) {
    PHASE_FRAME(F0);
    const int lane = F.lane; const int gw = F.vcu * NWAVES + F.wave, NGW = F.G * NWAVES;
    const bf16* RKV = (const bf16*)(F.ws + WS_RKV); const bf16* ICL = (const bf16*)(F.ws + WS_ICLR); const bf16* YS = (const bf16*)(F.ws + WS_YSCAN);
    const bf16* G = (const bf16*)(F.ws + WS_G); bf16* YB = (bf16*)(F.ws + WS_YB);
    const int c0 = lane * 16;
    float p_ka[16], p_rk[16], p_lw[16], p_lb[16];
#pragma unroll
    for (int q = 0; q < 4; ++q) { const f32x4 a = *(const GAS f32x4*)(I.k_a + c0 + 4 * q), bq = *(const GAS f32x4*)(I.r_k + c0 + 4 * q), c = *(const GAS f32x4*)(I.lnx_w + c0 + 4 * q), d = *(const GAS f32x4*)(I.lnx_b + c0 + 4 * q);
#pragma unroll
        for (int e = 0; e < 4; ++e) { p_ka[4 * q + e] = a[e]; p_rk[4 * q + e] = bq[e]; p_lw[4 * q + e] = c[e]; p_lb[4 * q + e] = d[e]; } }
    v4u raw[12];
#define P5_LOAD(tok_) do { _Pragma("unroll") for (int q = 0; q < 2; ++q) { \
        raw[q] = *(const GAS v4u*)(YS + (size_t)(tok_) * RW + c0 + 8 * q); raw[2 + q] = *(const GAS v4u*)(ICL + (size_t)(tok_) * RW + c0 + 8 * q); \
        raw[4 + q] = *(const GAS v4u*)(RKV + (size_t)(tok_) * (3 * RW) + c0 + 8 * q); raw[6 + q] = *(const GAS v4u*)(RKV + (size_t)(tok_) * (3 * RW) + RW + c0 + 8 * q); \
        raw[8 + q] = *(const GAS v4u*)(RKV + (size_t)(tok_) * (3 * RW) + 2 * RW + c0 + 8 * q); raw[10 + q] = *(const GAS v4u*)(G + (size_t)(tok_) * RW + c0 + 8 * q); } } while (0)
    if (gw < T) P5_LOAD(gw);
    for (int tok = gw; tok < T; tok += NGW) {
        float y[16], rr[16], kk[16], vv[16], ic[16], gg[16];
#pragma unroll
        for (int q = 0; q < 2; ++q) {
            const unsigned yw[4] = {raw[q].x, raw[q].y, raw[q].z, raw[q].w}, iw[4] = {raw[2 + q].x, raw[2 + q].y, raw[2 + q].z, raw[2 + q].w};
            const unsigned aw[4] = {raw[4 + q].x, raw[4 + q].y, raw[4 + q].z, raw[4 + q].w}, bw[4] = {raw[6 + q].x, raw[6 + q].y, raw[6 + q].z, raw[6 + q].w};
            const unsigned cw[4] = {raw[8 + q].x, raw[8 + q].y, raw[8 + q].z, raw[8 + q].w}, dw[4] = {raw[10 + q].x, raw[10 + q].y, raw[10 + q].z, raw[10 + q].w};
#pragma unroll
            for (int e = 0; e < 4; ++e) { y[8 * q + 2 * e] = bflo(yw[e]); y[8 * q + 2 * e + 1] = bfhi(yw[e]); ic[8 * q + 2 * e] = bflo(iw[e]); ic[8 * q + 2 * e + 1] = bfhi(iw[e]);
                rr[8 * q + 2 * e] = bflo(aw[e]); rr[8 * q + 2 * e + 1] = bfhi(aw[e]); kk[8 * q + 2 * e] = bflo(bw[e]); kk[8 * q + 2 * e + 1] = bfhi(bw[e]);
                vv[8 * q + 2 * e] = bflo(cw[e]); vv[8 * q + 2 * e + 1] = bfhi(cw[e]); gg[8 * q + 2 * e] = bflo(dw[e]); gg[8 * q + 2 * e + 1] = bfhi(dw[e]); } }
        __builtin_amdgcn_sched_barrier(0);
        if (tok + NGW < T) P5_LOAD(tok + NGW);
        __builtin_amdgcn_sched_barrier(0);
        float s = 0.f, bs = 0.f;
#pragma unroll
        for (int e = 0; e < 16; ++e) { s += y[e]; const float kp = kk[e] * (1.0f + (ic[e] - 1.0f) * p_ka[e]); bs += rr[e] * kp * p_rk[e]; }
        s = quadsum(s); bs = quadsum(bs);
        const float mean = s * (1.f / 64.f); float s2 = 0.f;
#pragma unroll
        for (int e = 0; e < 16; ++e) { y[e] -= mean; s2 += y[e] * y[e]; }
        s2 = quadsum(s2);
        const float rstd = 1.f / sqrtf(s2 * (1.f / 64.f) + GN_EPS);
        float o[16];
#pragma unroll
        for (int e = 0; e < 16; ++e) o[e] = (y[e] * rstd * p_lw[e] + p_lb[e] + bs * vv[e]) * gg[e];
        { unsigned w8[4];
#pragma unroll
          for (int q = 0; q < 4; ++q) { int t8 = __builtin_amdgcn_cvt_pk_fp8_f32(o[4 * q] * ACT8_SCALE, o[4 * q + 1] * ACT8_SCALE, 0, false); t8 = __builtin_amdgcn_cvt_pk_fp8_f32(o[4 * q + 2] * ACT8_SCALE, o[4 * q + 3] * ACT8_SCALE, t8, true); w8[q] = (unsigned)t8; }
          *(GAS v4u*)((unsigned char*)YB + (size_t)tok * RW + c0) = (v4u){w8[0], w8[1], w8[2], w8[3]}; }
    }
#undef P5_LOAD
}
#ifndef STAGE
#define STAGE 4
#endif
struct Args { In in; float* out; unsigned char* ws; };
__global__ void __launch_bounds__(NWAVES * 64, 2) mk_fwd(Args args) {
    extern __shared__ __attribute__((aligned(16))) unsigned char lds[];
    Frame F;
    F.lds = (LAS unsigned char*)lds;
    F.MISC = (volatile LAS unsigned*)(F.lds + MISC_OFF);
    F.tid = threadIdx.x; F.lane = F.tid & 63; F.wave = __builtin_amdgcn_readfirstlane(F.tid >> 6);
    F.G = gridDim.x; { const int bx = blockIdx.x; F.vcu = (F.G % 8 == 0) ? (bx % 8) * (F.G / 8) + bx / 8 : bx; }
    F.ws = args.ws;
    F.rsrc = __builtin_amdgcn_make_buffer_rsrc(args.ws, 0, 0xffffffff, 0x00020000);
    F.ctl = (gu32*)(args.ws + WS_CTL);
    for (int u = F.tid; u < (LDS_BYTES - MISC_OFF) / 4; u += NWAVES * 64) ((LAS unsigned*)(F.lds + MISC_OFF))[u] = 0u;
    __syncthreads();
    XcdBarrier bar = xcd_barrier_post((unsigned*)(F.ctl + CW_BAR), F.MISC + 8);
    const In& I = args.in;
#define GRID_BAR() xcd_barrier(bar)
#ifndef DUP_PHASE
#define DUP_PHASE -1
#endif
#define RUN(n, call) do { call; if (DUP_PHASE == (n)) { GRID_BAR(); call; } } while (0)

#if STAGE >= 2
    RUN(0, p0_prologue(F, I));
    GRID_BAR();
#endif
#if STAGE >= 3
    RUN(1, p1_proj(F, I));
    GRID_BAR();
    RUN(2, p2_shift_attn(F, I));
    GRID_BAR();
#if STAGE >= 4
    RUN(3, p3_lora(F, I));
    GRID_BAR();
    RUN(4, p4a_chunk(F, I));
    GRID_BAR();
    RUN(44, p4b_scan(F, I));
    GRID_BAR();
    RUN(5, p5_post(F, I));
    GRID_BAR();
#endif
    RUN(6, p6_merged(F, I));
    GRID_BAR();
    RUN(7, p7_mix(F, I));
    GRID_BAR();
#endif
    p8_ln_router<(STAGE < 3)>(F, I);
    GRID_BAR();
#if STAGE >= 2
    p9_scatter(F, I);
    GRID_BAR();
    RUN(10, p10_moe_up(F, I));
    GRID_BAR();
    RUN(11, p11_moe_down(F, I));
    GRID_BAR();
#endif
    RUN(12, p12_final<(STAGE < 2)>(F, I, args.out));
}

extern "C" void kernel_launch(void* const* d_in, const int* in_sizes, int n_in, void* d_out, int out_size, void* d_ws, size_t ws_size, hipStream_t stream) {
    static int grid = 0;
    if (grid == 0) {
        if (n_in != 27 || in_sizes[0] != T * D || out_size != T * D || ws_size < WS_END) { fprintf(stderr, "kernel_launch: unexpected shapes (n_in %d, in0 %d, out %d, ws %zu)\n", n_in, n_in > 0 ? in_sizes[0] : -1, out_size, ws_size); grid = -1; return; }
        int dev = 0, cus = 0, per_cu = 0;
        if (hipGetDevice(&dev) != hipSuccess || hipDeviceGetAttribute(&cus, hipDeviceAttributeMultiprocessorCount, dev) != hipSuccess) { grid = -1; return; }
        if (hipFuncSetAttribute((const void*)mk_fwd, hipFuncAttributeMaxDynamicSharedMemorySize, LDS_BYTES) != hipSuccess) { fprintf(stderr, "kernel_launch: hipFuncSetAttribute failed\n"); grid = -1; return; }
        if (hipOccupancyMaxActiveBlocksPerMultiprocessor(&per_cu, (const void*)mk_fwd, NWAVES * 64, LDS_BYTES) != hipSuccess || per_cu < 1)
            fprintf(stderr, "kernel_launch: occupancy query reports %d\n", per_cu);
        (void)hipGetLastError();
        grid = cus;
    }
    if (grid < 0) return;
    if (hipMemsetAsync((char*)d_ws + WS_CTL, 0, CTL_ZERO_BYTES, stream) != hipSuccess) return;
    Args a{};
    const float** ip = (const float**)&a.in;
    for (int i = 0; i < 27; ++i) ip[i] = (const float*)d_in[i];
    a.out = (float*)d_out; a.ws = (unsigned char*)d_ws;
    hipLaunchKernelGGL(mk_fwd, dim3(grid), dim3(NWAVES * 64), LDS_BYTES, stream, a);
    const hipError_t le = hipPeekAtLastError();
    if (le != hipSuccess) fprintf(stderr, "kernel_launch: launch failed: %s\n", hipGetErrorName(le));
}
```

```cpp
#define STAGE 4
#include <hip/hip_runtime.h>
#include <cstdio>
#include <cstdint>

#define GAS __attribute__((address_space(1)))
#define LAS __attribute__((address_space(3)))
typedef unsigned short bf16;
typedef unsigned v4u __attribute__((ext_vector_type(4)));
typedef unsigned v2u __attribute__((ext_vector_type(2)));
typedef float f32x4 __attribute__((ext_vector_type(4)));
typedef float f32x2 __attribute__((ext_vector_type(2)));
typedef float f32x16 __attribute__((ext_vector_type(16)));
typedef short bf16x8 __attribute__((ext_vector_type(8)));
typedef short bf16x4 __attribute__((ext_vector_type(4)));
typedef GAS unsigned gu32;

constexpr int NWAVES = 8;
constexpr int BATCH = 4, SEQ = 8192, D = 2048, T = BATCH * SEQ;
constexpr int CHUNK = 64, LEFT = 8, AH = 16, AD = 64, AW = 1024;
constexpr int REL_TABLE = 320, MAX_PAST = 256;
constexpr int RH = 16, RN = 64, RW = 1024, DLORA = 96, ALORA = 96, GLORA = 256;
constexpr int SHIFT_W = 3 * RW + DLORA + ALORA + GLORA;
constexpr int D_IN = 3 * AW + SHIFT_W + 2 * D;
constexpr int NE = 32, TOPK = 4, FF = 2048;
constexpr int MSLOT = T * TOPK;
constexpr int NBLK_MAX = (MSLOT + NE * 255 + 255) / 256;
constexpr int RROWS = NBLK_MAX * 256;
constexpr float LN_EPS = 1e-5f, GN_EPS = 64e-5f;
constexpr float YS_SCALE = 16.0f, YS_INV = 1.0f / 16.0f;
constexpr float ACT8_SCALE = 16.0f;
constexpr float F8_CVT_SCALE = 0.015625f;
constexpr float DN_ALPHA = 1.189207115002721f;
constexpr int PROJ_LD = 9728, PJ_Q = 0, PJ_K = 1024, PJ_SEG = 2048, SEG_PAD = 3584, PJ_GA = 5632, PJ_GB = 7680;
constexpr int LORA_LD = 512;

constexpr size_t MiB = 1u << 20;
constexpr size_t WS_CTL = 0, CTL_ZERO_BYTES = 1 * MiB;
constexpr size_t WS_TOPI = 2 * MiB;
constexpr size_t WS_GATE = 3 * MiB;
constexpr size_t WS_ROWSLOT = 4 * MiB;
constexpr size_t WS_ROWW = 5 * MiB;
constexpr size_t WS_WLA = 6 * MiB;
constexpr size_t WS_WLG = 7 * MiB;
constexpr size_t WS_PAT = 8 * MiB;
constexpr size_t WS_PBT = 12 * MiB;
constexpr size_t WS_WOT = 16 * MiB;
constexpr size_t WS_WVT = 24 * MiB;
constexpr size_t WS_SIDE0 = 28 * MiB, WS_SIDEL = 36 * MiB;
constexpr size_t WS_WINT = 28 * MiB;
constexpr size_t WS_WG8 = 72 * MiB;
constexpr size_t WS_WQK8 = 80 * MiB;
constexpr size_t WS_WV8 = 84 * MiB;
constexpr size_t WS_WSV8 = 88 * MiB;
constexpr size_t WS_WGUT = 128 * MiB;
constexpr size_t WS_WDNT = 640 * MiB;
constexpr size_t WS_BASE0 = 1024 * MiB;
constexpr size_t WS_PROJ = WS_BASE0;
constexpr size_t WS_VT = WS_PROJ + 608 * MiB;
constexpr size_t WS_YA = WS_VT + 64 * MiB;
constexpr size_t WS_RKV = WS_YA + 64 * MiB;
constexpr size_t WS_LORAIN = WS_RKV + 192 * MiB;
constexpr size_t WS_DECAY = WS_LORAIN + 32 * MiB;
constexpr size_t WS_ICLR = WS_DECAY + 128 * MiB;
constexpr size_t WS_G = WS_ICLR + 128 * MiB;
constexpr size_t WS_YSCAN = WS_G + 64 * MiB;
constexpr size_t WS_YB = WS_YSCAN + 128 * MiB;
constexpr size_t WS_MERGED = WS_YB + 64 * MiB;
constexpr size_t WS_XB16 = WS_MERGED + 128 * MiB;
constexpr size_t WS_MIX_END = WS_XB16 + 128 * MiB;
constexpr size_t WS_Z = 2816 * MiB;
constexpr size_t WS_GATEF = WS_Z;
constexpr size_t WS_H1 = 3072 * MiB;
constexpr size_t WS_H1B = 3328 * MiB;
constexpr size_t WS_CHK = 3456 * MiB;
constexpr size_t WS_XB8 = 3712 * MiB;
constexpr size_t WS_END = 3776 * MiB;
constexpr size_t WS_XG = WS_BASE0;
constexpr size_t WS_ACT = WS_BASE0 + 544 * MiB;
constexpr size_t WS_YSLOT = WS_BASE0 + 1088 * MiB;
static_assert(WS_MIX_END <= WS_Z && WS_YSLOT + 512 * MiB <= WS_Z, "ws map");
static_assert(WS_WINT + (size_t)PROJ_LD * D * 2 <= WS_WGUT, "ws map");

constexpr int CW_CNT = 512;
constexpr int CW_CUR = 576;
constexpr int CW_BAR = 4096;

constexpr int RING_OFF = 0, RING_BYTES = 131072;
constexpr int LDS_BYTES = 160 * 1024;
constexpr int MISC_OFF = LDS_BYTES - 512;
constexpr int TAB_OFF = LDS_BYTES - 1024;

#define RLX_AGENT __ATOMIC_RELAXED, __HIP_MEMORY_SCOPE_AGENT
#define LDS_WAIT() asm volatile("s_waitcnt lgkmcnt(0)" ::: "memory")
#define VM_WAIT() asm volatile("s_waitcnt vmcnt(0)" ::: "memory")
__device__ __forceinline__ unsigned f2bf(float f) { unsigned u = __builtin_bit_cast(unsigned, f); return (u + 0x7fffu + ((u >> 16) & 1u)) >> 16; }
__device__ __forceinline__ unsigned pk2(float lo, float hi) { return f2bf(lo) | (f2bf(hi) << 16); }
__device__ __forceinline__ float bf2f(unsigned short h) { return __builtin_bit_cast(float, (unsigned)h << 16); }
__device__ __forceinline__ float bflo(unsigned w) { return __builtin_bit_cast(float, w << 16); }
__device__ __forceinline__ float bfhi(unsigned w) { return __builtin_bit_cast(float, w & 0xffff0000u); }
__device__ __forceinline__ float fsigmoid(float x) { return __builtin_amdgcn_rcpf(1.0f + __expf(-x)); }
__device__ __forceinline__ float dpp_f(float x, const int ctrl_sel) {
    const int xi = __builtin_bit_cast(int, x); int r;
    if (ctrl_sel == 0) r = __builtin_amdgcn_update_dpp(0, xi, 0xB1, 0xF, 0xF, false);
    else if (ctrl_sel == 1) r = __builtin_amdgcn_update_dpp(0, xi, 0x4E, 0xF, 0xF, false);
    else if (ctrl_sel == 2) r = __builtin_amdgcn_update_dpp(0, xi, 0x124, 0xF, 0xF, false);
    else r = __builtin_amdgcn_update_dpp(0, xi, 0x128, 0xF, 0xF, false);
    return __builtin_bit_cast(float, r);
}
__device__ __forceinline__ float rowsum16(float x) { x += dpp_f(x, 0); x += dpp_f(x, 1); x += dpp_f(x, 2); x += dpp_f(x, 3); return x; }
__device__ __forceinline__ float quadsum(float x) { x += dpp_f(x, 0); x += dpp_f(x, 1); return x; }
__device__ __forceinline__ float wave_sum(float v) {
    v = rowsum16(v);
    const int vi = __builtin_bit_cast(int, v);
    const float s0 = __builtin_bit_cast(float, __builtin_amdgcn_readlane(vi, 0)), s1 = __builtin_bit_cast(float, __builtin_amdgcn_readlane(vi, 16));
    const float s2 = __builtin_bit_cast(float, __builtin_amdgcn_readlane(vi, 32)), s3 = __builtin_bit_cast(float, __builtin_amdgcn_readlane(vi, 48));
    return (s0 + s1) + (s2 + s3);
}
namespace pg8 {
#define PG8_LAS __attribute__((address_space(3)))
typedef unsigned short bf16_t;
typedef unsigned u32x4 __attribute__((ext_vector_type(4)));
constexpr int BM = 256, BK = 64, HALF = 128, HTB = HALF * BK * 2, STAGE_BYTES = 8 * HTB, NXCD = 8, WGM = 8;

__host__ __device__ __forceinline__ int lds_byte(int r, int c) { const int st = (r >> 4) * 2 + (c >> 5), rr = r & 15, cc = c & 31, ob = rr * 64 + cc * 2; return st * 1024 + (ob ^ (((ob >> 9) & 1) << 5)); }
__host__ __device__ __forceinline__ void stage_rc(int b, int& R, int& C) { const int st = b / 1024, sb = b % 1024, swz = sb ^ (((sb >> 9) & 1) << 5); R = (st >> 1) * 16 + swz / 64; C = (st & 1) * 32 + (swz % 64) / 2; }
__host__ __device__ __forceinline__ int perm32(int rho) { const int n = rho >> 4, i = rho & 15; return 8 * (i >> 2) + 4 * n + (i & 3); }

struct Unit { int pm, pn, aux; };

struct Tiler {
    int nM, nN, nwg, G, c;
    __device__ __forceinline__ void init(int nM_, int nN_, int G_, int c_) { nM = nM_; nN = nN_; nwg = nM * nN; G = G_; c = c_; }
    __device__ __forceinline__ bool map(int i, int& pm, int& pn) const {
        const long L = (long)i * G + c; if (L >= nwg) return false;
        int wgid = (int)L; { const int q = nwg / NXCD, r = nwg % NXCD, xcd = wgid % NXCD, off = wgid / NXCD; wgid = (xcd < r ? xcd * (q + 1) : r * (q + 1) + (xcd - r) * q) + off; }
        const int nig = WGM * nN, gid = wgid / nig, fm = gid * WGM, gsz = (nM - fm) < WGM ? (nM - fm) : WGM;
        pm = fm + ((wgid % nig) % gsz); pn = (wgid % nig) / gsz; return true;
    }
};
struct SchedPlain {
    Tiler t; unsigned A, B, tsA, tsB;
    __device__ __forceinline__ bool next(int i, Unit& u) const { u.aux = 0; return t.map(i, u.pm, u.pn); }
    __device__ __forceinline__ void bases(const Unit& u, unsigned& a, unsigned& b) const { a = A + (unsigned)u.pm * tsA; b = B + (unsigned)u.pn * tsB; }
};
struct SchedTwo {
    Tiler t; unsigned A0, A1, B0, B1, tsA, tsB;
    __device__ __forceinline__ bool next(int i, Unit& u) const { u.aux = i & 1; return t.map(i >> 1, u.pm, u.pn); }
    __device__ __forceinline__ void bases(const Unit& u, unsigned& a, unsigned& b) const { a = (u.aux ? A1 : A0) + (unsigned)u.pm * tsA; b = (u.aux ? B1 : B0) + (unsigned)u.pn * tsB; }
};
struct SchedMoe {
    Tiler t; unsigned A, B, tsA, tsB, es; const PG8_LAS int* pad_end;
    __device__ __forceinline__ bool next(int i, Unit& u) const {
        if (!t.map(i, u.pm, u.pn)) return false;
        const int row0 = u.pm * BM; int e = 0;
#pragma unroll
        for (int j = 0; j < 32; ++j) e += (pad_end[j] <= row0) ? 1 : 0;
        u.aux = __builtin_amdgcn_readfirstlane(e < 31 ? e : 31); return true;
    }
    __device__ __forceinline__ void bases(const Unit& u, unsigned& a, unsigned& b) const { a = A + (unsigned)u.pm * tsA; b = B + (unsigned)u.aux * es + (unsigned)u.pn * tsB; }
};

typedef float f32x2_t_ __attribute__((ext_vector_type(2)));
typedef __bf16 bf16x2_t_ __attribute__((ext_vector_type(2)));
__device__ __forceinline__ unsigned cvt_pk_bf16(float lo, float hi) { const f32x2_t_ v = {lo, hi}; const bf16x2_t_ b = __builtin_convertvector(v, bf16x2_t_); return __builtin_bit_cast(unsigned, b); }
__device__ __forceinline__ u32x4 pack8(const f32x4& v0, const f32x4& v1) { u32x4 w; w.x = cvt_pk_bf16(v0[0], v0[1]); w.y = cvt_pk_bf16(v0[2], v0[3]); w.z = cvt_pk_bf16(v1[0], v1[1]); w.w = cvt_pk_bf16(v1[2], v1[3]); return w; }

typedef int i32x8 __attribute__((ext_vector_type(8)));
typedef int i32x4 __attribute__((ext_vector_type(4)));
__device__ __forceinline__ i32x8 cat8(const bf16x8& a, const bf16x8& b) { return __builtin_shufflevector(__builtin_bit_cast(i32x4, a), __builtin_bit_cast(i32x4, b), 0, 1, 2, 3, 4, 5, 6, 7); }
constexpr int F8_SCALES = 0x00007f79;
template <class Epi, class Sched, bool ALIGN_EPI, bool F8 = false, int F8SC = F8_SCALES>
__device__ __forceinline__ void gemm_phase(PG8_LAS unsigned char* lds, const __amdgpu_buffer_rsrc_t rsrc, const int lda, const int ldb, const int K, const Sched& S, const Epi& E) {
    int tid_ = threadIdx.x; asm volatile("" : "+v"(tid_));
    const int tid = tid_, wid = __builtin_amdgcn_readfirstlane(tid >> 6), lane = tid & 63, wr = wid >> 2, wc = wid & 3, fr = lane & 15, fq = lane >> 4;
    const int nt = K / BK;
    unsigned voffA, voffB;
    { int R, C; stage_rc(tid * 16, R, C); const int Rb = (R & ~31) + perm32(R & 31); voffA = (unsigned)(R * lda + C) * 2u; voffB = (unsigned)(Rb * ldb + C) * 2u; }
    const unsigned p1voffA = 64u * (unsigned)lda * 2u, p1voffB = 64u * (unsigned)ldb * 2u;
    const unsigned kstep = (unsigned)(BK * 2);
    const unsigned hsA = (unsigned)HALF * lda * 2, hsB = (unsigned)HALF * ldb * 2;
    const unsigned ldsw = (unsigned)wid * 1024u;
    const int aoff = lds_byte(wr * 64 + fr, fq * 8), boff = lds_byte(wc * 32 + fr, fq * 8);
#define PG8_SA(b, h) (((b) * 2 + (h)) * HTB)
#define PG8_SB(b, h) ((4 + (b) * 2 + (h)) * HTB)
#define PG8_STAGE(bufoff, goff, voff) do { _Pragma("unroll") for (int _i = 0; _i < 2; ++_i) \
        __builtin_amdgcn_raw_ptr_buffer_load_lds(rsrc, (PG8_LAS void*)(lds + (bufoff) + ldsw + _i * 8192), 16, (int)(voff), (int)((goff) + _i * p1##voff), 0, 0); } while (0)
#define PG8_LD8(addr) __builtin_shufflevector(*(const PG8_LAS i32x4*)(addr), *(const PG8_LAS i32x4*)((addr) + 1024), 0, 1, 2, 3, 4, 5, 6, 7)
#define PG8_LDA(dst, b, h) do { _Pragma("unroll") for (int m = 0; m < 4; ++m) dst[m] = PG8_LD8(lds + PG8_SA(b, h) + aoff + m * 2048); } while (0)
#define PG8_LDB(dst, b, h) do { _Pragma("unroll") for (int n = 0; n < 2; ++n) dst[n] = PG8_LD8(lds + PG8_SB(b, h) + boff + n * 2048); } while (0)
#define PG8_LO(v) __builtin_bit_cast(bf16x8, __builtin_shufflevector(v, v, 0, 1, 2, 3))
#define PG8_HI(v) __builtin_bit_cast(bf16x8, __builtin_shufflevector(v, v, 4, 5, 6, 7))
#define PG8_MMA(ai, bj, At, Bt) do { __builtin_amdgcn_s_setprio(1); \
        if constexpr (!F8) { _Pragma("unroll") for (int m = 0; m < 4; ++m) _Pragma("unroll") for (int n = 0; n < 2; ++n) { \
            acc[ai][bj][m][n] = __builtin_amdgcn_mfma_f32_16x16x32_bf16(PG8_LO(Bt[n]), PG8_LO(At[m]), acc[ai][bj][m][n], 0, 0, 0); \
            acc[ai][bj][m][n] = __builtin_amdgcn_mfma_f32_16x16x32_bf16(PG8_HI(Bt[n]), PG8_HI(At[m]), acc[ai][bj][m][n], 0, 0, 0); } } \
        else { _Pragma("unroll") for (int m = 0; m < 4; ++m) _Pragma("unroll") for (int n = 0; n < 2; ++n) \
            acc[ai][bj][m][n] = __builtin_amdgcn_mfma_scale_f32_16x16x128_f8f6f4(Bt[n], At[m], acc[ai][bj][m][n], 0, 0, 0, F8SC, 1, F8SC); } \
        __builtin_amdgcn_s_setprio(0); } while (0)
#define PG8_WAIT_V(n) asm volatile("s_waitcnt vmcnt(" #n ")" ::: "memory")
#define PG8_WAIT_L(n) asm volatile("s_waitcnt lgkmcnt(" #n ")" ::: "memory")
#define PG8_BAR __builtin_amdgcn_s_barrier()
#define PG8_SCHED __builtin_amdgcn_sched_barrier(0)
#define PG8_ZERO() do { _Pragma("unroll") for (int a = 0; a < 2; ++a) _Pragma("unroll") for (int b = 0; b < 2; ++b) _Pragma("unroll") for (int m = 0; m < 4; ++m) _Pragma("unroll") for (int n = 0; n < 2; ++n) acc[a][b][m][n] = (f32x4){0.f, 0.f, 0.f, 0.f}; } while (0)
    Unit cur, nxt; int ui = 0;
    if (!S.next(0, cur)) return;
    f32x4 acc[2][2][4][2];
    PG8_ZERO();
    i32x8 At[4], B0[2], B1[2];
    unsigned cA, cB; S.bases(cur, cA, cB); cA = __builtin_amdgcn_readfirstlane(cA); cB = __builtin_amdgcn_readfirstlane(cB);
    PG8_STAGE(PG8_SB(0, 0), cB, voffB); PG8_STAGE(PG8_SB(0, 1), cB + hsB, voffB); PG8_STAGE(PG8_SA(0, 0), cA, voffA); PG8_STAGE(PG8_SA(0, 1), cA + hsA, voffA);
    if (wr == 1) PG8_BAR;
    PG8_WAIT_V(2); PG8_BAR;
    PG8_STAGE(PG8_SB(1, 0), cB + kstep, voffB); PG8_STAGE(PG8_SA(1, 0), cA + kstep, voffA); PG8_STAGE(PG8_SB(1, 1), cB + hsB + kstep, voffB);
    PG8_WAIT_V(6); PG8_BAR;
    for (;;) {
        const bool has_next = S.next(ui + 1, nxt);
        unsigned nA = cA, nB = cB; if (has_next) { S.bases(nxt, nA, nB); nA = __builtin_amdgcn_readfirstlane(nA); nB = __builtin_amdgcn_readfirstlane(nB); }
#pragma unroll 1
        for (int t = 0; t < nt; t += 2) {
            const bool last = (t == nt - 2);
            const unsigned a1 = cA + (unsigned)(t + 1) * kstep;
            const unsigned a2 = last ? nA : cA + (unsigned)(t + 2) * kstep, b2 = last ? nB : cB + (unsigned)(t + 2) * kstep;
            const unsigned a3 = a2 + kstep, b3 = b2 + kstep;
            PG8_LDB(B0, 0, 0); PG8_LDB(B1, 0, 1); PG8_SCHED; PG8_LDA(At, 0, 0); PG8_STAGE(PG8_SA(1, 1), a1 + hsA, voffA);
            PG8_WAIT_V(8); PG8_WAIT_L(0); PG8_BAR; PG8_MMA(0, 0, At, B0); PG8_MMA(0, 1, At, B1); PG8_BAR; PG8_SCHED;
            PG8_LDA(At, 0, 1); PG8_STAGE(PG8_SB(0, 0), b2, voffB); PG8_STAGE(PG8_SB(0, 1), b2 + hsB, voffB); PG8_STAGE(PG8_SA(0, 0), a2, voffA);
            PG8_WAIT_V(8); PG8_WAIT_L(0); PG8_BAR; PG8_MMA(1, 0, At, B0); PG8_MMA(1, 1, At, B1); PG8_BAR; PG8_SCHED;
            PG8_LDB(B0, 1, 0); PG8_LDB(B1, 1, 1); PG8_SCHED; PG8_LDA(At, 1, 0); PG8_STAGE(PG8_SA(0, 1), a2 + hsA, voffA);
            PG8_WAIT_V(8); PG8_WAIT_L(0); PG8_BAR; PG8_MMA(0, 0, At, B0); PG8_MMA(0, 1, At, B1); PG8_BAR; PG8_SCHED;
            PG8_LDA(At, 1, 1); PG8_STAGE(PG8_SB(1, 0), b3, voffB); PG8_STAGE(PG8_SB(1, 1), b3 + hsB, voffB); PG8_STAGE(PG8_SA(1, 0), a3, voffA);
            PG8_WAIT_V(8); PG8_WAIT_L(0); PG8_BAR; PG8_MMA(1, 0, At, B0); PG8_MMA(1, 1, At, B1); PG8_BAR; PG8_SCHED;
        }
        if constexpr (ALIGN_EPI) { if (wr == 0) PG8_BAR; }
        bool keep; { int t2 = threadIdx.x; asm volatile("" : "+v"(t2)); const int w2 = __builtin_amdgcn_readfirstlane(t2 >> 6), l2 = t2 & 63; keep = E(acc, cur, w2 >> 2, w2 & 3, l2 & 15, l2 >> 4); }
        if (!has_next) break;
        if (!keep) PG8_ZERO();
        cur = nxt; cA = nA; cB = nB; ++ui;
        if constexpr (ALIGN_EPI) { if (wr == 1) PG8_BAR; }
    }
    PG8_WAIT_V(0);
    if constexpr (!ALIGN_EPI) { if (wr == 0) PG8_BAR; }
    PG8_BAR;
#undef PG8_SA
#undef PG8_SB
#undef PG8_STAGE
#undef PG8_LDA
#undef PG8_LDB
#undef PG8_LD8
#undef PG8_LO
#undef PG8_HI
#undef PG8_MMA
#undef PG8_WAIT_V
#undef PG8_WAIT_L
#undef PG8_BAR
#undef PG8_SCHED
#undef PG8_ZERO
}
}
namespace pg8 {
#define EPI_ROWLOOP _Pragma("unroll") for (int ai = 0; ai < 2; ++ai) _Pragma("unroll") for (int m = 0; m < 4; ++m)
struct EpiProj {
    bf16_t* O; int coloff, nq;
    __device__ __forceinline__ bool operator()(f32x4 (&acc)[2][2][4][2], const Unit& u, int wr, int wc, int fr, int fq) const {
        const int row0 = u.pm * BM + wr * 64 + fr, col0 = coloff + u.pn * BM + wc * 32 + 8 * fq;
        const float sc = (u.pn < nq) ? 0.125f : 1.0f;
        EPI_ROWLOOP { bf16_t* rowp = O + (size_t)(row0 + ai * HALF + m * 16) * PROJ_LD + col0;
#pragma unroll
            for (int bj = 0; bj < 2; ++bj) *(u32x4*)(rowp + bj * HALF) = pack8(acc[ai][bj][m][0] * sc, acc[ai][bj][m][1] * sc); }
        return false;
    }
};
__device__ __forceinline__ float dpp_prev_row(float lo15, float cur) {
    const int o = __builtin_amdgcn_update_dpp(0, __builtin_bit_cast(int, lo15), 0x121, 0xF, 0xF, false);
    return __builtin_bit_cast(float, __builtin_amdgcn_update_dpp(o, __builtin_bit_cast(int, cur), 0x111, 0xF, 0xF, false));
}
struct EpiShift {
    bf16_t* RKVp; bf16_t* LIN; float* SIDE0; float* SIDEL; const float* mu;
    __device__ __forceinline__ bool operator()(f32x4 (&acc)[2][2][4][2], const Unit& u, int wr, int wc, int fr, int fq) const {
        static_assert(DLORA % 32 == 0 && ALORA % 32 == 0 && GLORA % 32 == 0 && RW % 32 == 0, "segment boundaries are wave-uniform");
        const int row0 = u.pm * BM + wr * 64 + fr;
#pragma unroll
        for (int bj = 0; bj < 2; ++bj) {
            const int cgrp = u.pn * BM + bj * HALF + wc * 32;
            if (cgrp >= SHIFT_W) continue;
            const int c = cgrp + 8 * fq;
            const f32x4 mu0 = *(const f32x4*)(mu + c), mu1 = *(const f32x4*)(mu + c + 4);
            bf16_t* dbase; int ld, act = 0;
            if (cgrp < 3 * RW) { dbase = RKVp + c; ld = 3 * RW; }
            else if (cgrp < 3 * RW + DLORA) { dbase = LIN + (c - 3 * RW); ld = LORA_LD; act = 1; }
            else if (cgrp < 3 * RW + DLORA + ALORA) { dbase = LIN + 128 + (c - 3 * RW - DLORA); ld = LORA_LD; }
            else { dbase = LIN + 256 + (c - 3 * RW - DLORA - ALORA); ld = LORA_LD; act = 2; }
            const bool zpad = (cgrp == 3 * RW + DLORA - 32) || (cgrp == 3 * RW + DLORA + ALORA - 32);
#pragma unroll
            for (int ai = 0; ai < 2; ++ai) {
                const int g = u.pm * 4 + ai * 2 + wr;
#pragma unroll
                for (int m = 0; m < 4; ++m) {
                    f32x4 o[2];
#pragma unroll
                    for (int n = 0; n < 2; ++n) { const f32x4 cur = acc[ai][bj][m][n]; const f32x4 mm = n ? mu1 : mu0;
#pragma unroll
                        for (int j = 0; j < 4; ++j) { const float prv = dpp_prev_row(m > 0 ? acc[ai][bj][m > 0 ? m - 1 : 0][n][j] : 0.0f, cur[j]);
                            float v = cur[j] + (prv - cur[j]) * mm[j];
                            if (act == 1) v = 2.0f * fsigmoid(2.0f * v) - 1.0f; else if (act == 2) v = fsigmoid(v);
                            o[n][j] = v; } }
                    bf16_t* dp = dbase + (size_t)(row0 + ai * HALF + m * 16) * ld;
                    *(u32x4*)dp = pack8(o[0], o[1]);
                    if (zpad) { unsigned zz = 0u; asm volatile("" : "+v"(zz)); *(u32x4*)(dp + 32) = (u32x4){zz, zz, zz, zz}; }
                    if (m == 0 && fr == 0) { float* sp = SIDE0 + (size_t)g * SEG_PAD + c; *(f32x4*)sp = acc[ai][bj][0][0]; *(f32x4*)(sp + 4) = acc[ai][bj][0][1]; }
                    if (m == 3 && fr == 15) { float* sp = SIDEL + (size_t)g * SEG_PAD + c; *(f32x4*)sp = acc[ai][bj][3][0]; *(f32x4*)(sp + 4) = acc[ai][bj][3][1]; }
                } }
        }
        return false;
    }
};
struct EpiGate {
    bf16_t* O;
    __device__ __forceinline__ bool operator()(f32x4 (&acc)[2][2][4][2], const Unit& u, int wr, int wc, int fr, int fq) const {
        u32x4* gf = (u32x4*)O + ((size_t)(u.pm * 16 + u.pn) * 2 * 8 + (wr * 4 + wc)) * 512 + (fq * 16 + fr);
        EPI_ROWLOOP {
            f32x4 rt[2], gb[2];
#pragma unroll
            for (int n = 0; n < 2; ++n)
#pragma unroll
                for (int j = 0; j < 4; ++j) { const float ea = __expf(-acc[ai][0][m][n][j]), eb = fminf(__expf(-acc[ai][1][m][n][j]), 1e30f);
                    gb[n][j] = __builtin_amdgcn_rcpf(1.0f + eb); rt[n][j] = (1.0f + eb) * __builtin_amdgcn_rcpf(1.0f + ea); }
            gf[(ai * 4 + m) * 64] = pack8(rt[0], rt[1]); gf[8 * 512 + (ai * 4 + m) * 64] = pack8(gb[0], gb[1]); }
        return false;
    }
};
struct EpiBf16 {
    bf16_t* O; int ldc;
    __device__ __forceinline__ bool operator()(f32x4 (&acc)[2][2][4][2], const Unit& u, int wr, int wc, int fr, int fq) const {
        const int row0 = u.pm * BM + wr * 64 + fr, col0 = u.pn * BM + wc * 32 + 8 * fq;
        EPI_ROWLOOP { bf16_t* rowp = O + (size_t)(row0 + ai * HALF + m * 16) * ldc + col0;
#pragma unroll
            for (int bj = 0; bj < 2; ++bj) *(u32x4*)(rowp + bj * HALF) = pack8(acc[ai][bj][m][0], acc[ai][bj][m][1]); }
        return false;
    }
};
template <bool ISDEC> struct EpiLoraA {
    float* OUT; const float* par;
    __device__ __forceinline__ bool operator()(f32x4 (&acc)[2][2][4][2], const Unit& u, int wr, int wc, int fr, int fq) const {
        const int row0 = u.pm * BM + wr * 64 + fr, col0 = u.pn * BM + wc * 32 + 8 * fq;
        f32x4 pv[2][2];
#pragma unroll
        for (int bj = 0; bj < 2; ++bj)
#pragma unroll
            for (int n = 0; n < 2; ++n) pv[bj][n] = *(const f32x4*)(par + col0 + bj * HALF + 4 * n);
        EPI_ROWLOOP { float* rowp = OUT + (size_t)(row0 + ai * HALF + m * 16) * RW + col0;
#pragma unroll
            for (int bj = 0; bj < 2; ++bj)
#pragma unroll
                for (int n = 0; n < 2; ++n) { f32x4 v = acc[ai][bj][m][n] + pv[bj][n];
#pragma unroll
                    for (int j = 0; j < 4; ++j) {
                        if (ISDEC) v[j] = -0.60653065971263342f * fsigmoid(v[j]);
                        else v[j] = fsigmoid(v[j]); }
                    *(f32x4*)(rowp + bj * HALF + 4 * n) = v; } }
        return false;
    }
};
struct EpiIclr {
    bf16_t* OUT; const float* par;
    __device__ __forceinline__ bool operator()(f32x4 (&acc)[2][2][4][2], const Unit& u, int wr, int wc, int fr, int fq) const {
        const int row0 = u.pm * BM + wr * 64 + fr, col0 = u.pn * BM + wc * 32 + 8 * fq;
        f32x4 pv[2][2];
#pragma unroll
        for (int bj = 0; bj < 2; ++bj)
#pragma unroll
            for (int n = 0; n < 2; ++n) pv[bj][n] = *(const f32x4*)(par + col0 + bj * HALF + 4 * n);
        EPI_ROWLOOP { bf16_t* rowp = OUT + (size_t)(row0 + ai * HALF + m * 16) * RW + col0;
#pragma unroll
            for (int bj = 0; bj < 2; ++bj) { f32x4 v0 = acc[ai][bj][m][0] + pv[bj][0], v1 = acc[ai][bj][m][1] + pv[bj][1];
#pragma unroll
                for (int j = 0; j < 4; ++j) { v0[j] = fsigmoid(v0[j]); v1[j] = fsigmoid(v1[j]); }
                *(u32x4*)(rowp + bj * HALF) = pack8(v0, v1); } }
        return false;
    }
};
struct EpiMerged {
    const bf16_t* PROJ; bf16_t* O;
    __device__ __forceinline__ bool operator()(f32x4 (&acc)[2][2][4][2], const Unit& u, int wr, int wc, int fr, int fq) const {
        const int row0 = u.pm * BM + wr * 64 + fr, col0 = u.pn * BM + wc * 32 + 8 * fq;
        const u32x4* gf = (const u32x4*)PROJ + ((size_t)(u.pm * 16 + u.pn * 2) * 2 * 8 + (u.aux == 0 ? 0 : 8) + (wr * 4 + wc)) * 512 + (fq * 16 + fr);
#pragma unroll
        for (int ai = 0; ai < 2; ++ai) {
            u32x4 gv[4][2];
#pragma unroll
            for (int m = 0; m < 4; ++m)
#pragma unroll
                for (int bj = 0; bj < 2; ++bj) gv[m][bj] = gf[(size_t)bj * (2 * 8 * 512) + (ai * 4 + m) * 64];
#pragma unroll
            for (int m = 0; m < 4; ++m) { const int row = row0 + ai * HALF + m * 16;
#pragma unroll
                for (int bj = 0; bj < 2; ++bj) { const u32x4 g = gv[m][bj];
                    const f32x4 g0 = (f32x4){bflo(g.x), bfhi(g.x), bflo(g.y), bfhi(g.y)}, g1 = (f32x4){bflo(g.z), bfhi(g.z), bflo(g.w), bfhi(g.w)};
                    if (u.aux == 0) { acc[ai][bj][m][0] = acc[ai][bj][m][0] * g0; acc[ai][bj][m][1] = acc[ai][bj][m][1] * g1; }
                    else { const f32x4 o0 = acc[ai][bj][m][0] * g0 * ACT8_SCALE, o1 = acc[ai][bj][m][1] * g1 * ACT8_SCALE;
                        int w0 = __builtin_amdgcn_cvt_pk_fp8_f32(o0[0], o0[1], 0, false); w0 = __builtin_amdgcn_cvt_pk_fp8_f32(o0[2], o0[3], w0, true);
                        int w1 = __builtin_amdgcn_cvt_pk_fp8_f32(o1[0], o1[1], 0, false); w1 = __builtin_amdgcn_cvt_pk_fp8_f32(o1[2], o1[3], w1, true);
                        *(v2u*)((unsigned char*)O + (size_t)row * D + col0 + bj * HALF) = (v2u){(unsigned)w0, (unsigned)w1}; } } }
        }
        return u.aux == 0;
    }
};
struct EpiZ {
    const float* X; float* Z;
    __device__ __forceinline__ bool operator()(f32x4 (&acc)[2][2][4][2], const Unit& u, int wr, int wc, int fr, int fq) const {
        const int row0 = u.pm * BM + wr * 64 + fr, col0 = u.pn * BM + wc * 32 + 8 * fq;
        EPI_ROWLOOP { const size_t off = (size_t)(row0 + ai * HALF + m * 16) * D + col0;
#pragma unroll
            for (int bj = 0; bj < 2; ++bj)
#pragma unroll
                for (int n = 0; n < 2; ++n) { const f32x4 xv = *(const f32x4*)(X + off + bj * HALF + 4 * n); *(f32x4*)(Z + off + bj * HALF + 4 * n) = xv * DN_ALPHA + acc[ai][bj][m][n]; } }
        return false;
    }
};
struct EpiSwiglu {
    unsigned char* ACT; const float* bgu;
    __device__ __forceinline__ bool operator()(f32x4 (&acc)[2][2][4][2], const Unit& u, int wr, int wc, int fr, int fq) const {
        const int row0 = u.pm * BM + wr * 64 + fr, col0 = u.pn * HALF + wc * 32 + 8 * fq;
        const float* bp = bgu + (size_t)u.aux * (2 * FF) + col0;
        f32x4 bg[2], bu[2];
#pragma unroll
        for (int n = 0; n < 2; ++n) { bg[n] = *(const f32x4*)(bp + 4 * n); bu[n] = *(const f32x4*)(bp + FF + 4 * n); }
        EPI_ROWLOOP { f32x4 o[2];
#pragma unroll
            for (int n = 0; n < 2; ++n) { const f32x4 g = acc[ai][0][m][n] + bg[n], uu = acc[ai][1][m][n] + bu[n];
#pragma unroll
                for (int j = 0; j < 4; j += 2) {
                    f32x2 gc, uc; gc[0] = fminf(g[j], 7.0f); gc[1] = fminf(g[j + 1], 7.0f);
                    uc[0] = __builtin_amdgcn_fmed3f(uu[j], -7.0f, 7.0f); uc[1] = __builtin_amdgcn_fmed3f(uu[j + 1], -7.0f, 7.0f);
                    const f32x2 t = gc * (f32x2){-2.4554669595930156f, -2.4554669595930156f};
                    f32x2 d; d[0] = __builtin_amdgcn_exp2f(t[0]); d[1] = __builtin_amdgcn_exp2f(t[1]);
                    d = d + (f32x2){1.0f, 1.0f};
                    f32x2 r; r[0] = __builtin_amdgcn_rcpf(d[0]); r[1] = __builtin_amdgcn_rcpf(d[1]);
                    const f32x2 s = gc * r, oo = __builtin_elementwise_fma(uc, s, s);
                    o[n][j] = oo[0]; o[n][j + 1] = oo[1]; } }
            int w0 = __builtin_amdgcn_cvt_pk_fp8_f32(o[0][0], o[0][1], 0, false); w0 = __builtin_amdgcn_cvt_pk_fp8_f32(o[0][2], o[0][3], w0, true);
            int w1 = __builtin_amdgcn_cvt_pk_fp8_f32(o[1][0], o[1][1], 0, false); w1 = __builtin_amdgcn_cvt_pk_fp8_f32(o[1][2], o[1][3], w1, true);
            *(v2u*)(ACT + (size_t)(row0 + ai * HALF + m * 16) * FF + col0) = (v2u){(unsigned)w0, (unsigned)w1}; }
        return false;
    }
};
struct EpiDown {
    unsigned char* YS; const float* bdn; const int* rowslot; const float* roww;
    __device__ __forceinline__ bool operator()(f32x4 (&acc)[2][2][4][2], const Unit& u, int wr, int wc, int fr, int fq) const {
        const int row0 = u.pm * BM + wr * 64 + fr, col0 = u.pn * BM + wc * 32 + 8 * fq;
        const float* bp = bdn + (size_t)u.aux * D + col0;
        f32x4 bv[2][2];
#pragma unroll
        for (int bj = 0; bj < 2; ++bj)
#pragma unroll
            for (int n = 0; n < 2; ++n) bv[bj][n] = *(const f32x4*)(bp + bj * HALF + 4 * n);
        int slots[8]; float ws_[8];
#pragma unroll
        for (int q = 0; q < 8; ++q) { const int row = row0 + (q >> 2) * HALF + (q & 3) * 16; slots[q] = rowslot[row]; ws_[q] = roww[row]; }
        EPI_ROWLOOP { const int slot = slots[ai * 4 + m]; const float w = ws_[ai * 4 + m] * YS_SCALE;
            if (slot >= 0) { unsigned char* rowp = YS + (size_t)slot * D + col0;
#pragma unroll
                for (int bj = 0; bj < 2; ++bj) { const f32x4 o0 = (acc[ai][bj][m][0] + bv[bj][0]) * w, o1 = (acc[ai][bj][m][1] + bv[bj][1]) * w;
                    int w0 = __builtin_amdgcn_cvt_pk_fp8_f32(o0[0], o0[1], 0, false); w0 = __builtin_amdgcn_cvt_pk_fp8_f32(o0[2], o0[3], w0, true);
                    int w1 = __builtin_amdgcn_cvt_pk_fp8_f32(o1[0], o1[1], 0, false); w1 = __builtin_amdgcn_cvt_pk_fp8_f32(o1[2], o1[3], w1, true);
                    *(v2u*)(rowp + bj * HALF) = (v2u){(unsigned)w0, (unsigned)w1}; } } }
        return false;
    }
};
#undef EPI_ROWLOOP
}

#define XB_TMO      128
#define XB_XCNT(j)  (256  + 64 * (j))
#define XB_XSUB(j)  (1280 + 64 * (j))
#define XB_XGEN(j)  (2304 + 64 * (j))
#define XB_TOP      3328
#define XB_TOPGEN   3392
#define XCD_BAR_WORDS 3456
#define XB_SPIN_CAP (1u << 18)

__device__ __forceinline__ unsigned xb_ld(unsigned* p)              { return __hip_atomic_load(p, __ATOMIC_RELAXED, __HIP_MEMORY_SCOPE_AGENT); }
__device__ __forceinline__ unsigned xb_add(unsigned* p, unsigned v) { return __hip_atomic_fetch_add(p, v, __ATOMIC_RELAXED, __HIP_MEMORY_SCOPE_AGENT); }
__device__ __forceinline__ unsigned xb_xcc_id() { return (unsigned)__builtin_amdgcn_s_getreg((3 << 11) | 20) & 0xFu; }
#define XB_SPIN(cond, bar) do { unsigned _sp = 0; while (cond) { __builtin_amdgcn_s_sleep(1); \
    if ((++_sp & 255u) == 0u) { if (xb_ld(&(bar)[XB_TMO])) break; if (_sp > XB_SPIN_CAP) { atomicAdd(&(bar)[XB_TMO], 1u); break; } } } } while (0)

struct XcdBarrier {
    unsigned* bar; unsigned x;
    volatile LAS unsigned* st;
};

__device__ __forceinline__ XcdBarrier xcd_barrier_post(unsigned* bar, volatile LAS unsigned* st) {
    XcdBarrier b; b.bar = bar; b.x = xb_xcc_id(); b.st = st;
    if (threadIdx.x == 0) (void)xb_add(&bar[XB_XCNT(b.x)], 1u);
    return b;
}
__device__ __forceinline__ void xcd_barrier_complete(unsigned* bar, unsigned x, unsigned& nloc, unsigned& nx) {
    const unsigned G = gridDim.x * gridDim.y * gridDim.z;
    unsigned sum, cnt, mine, sp = 0u;
    for (;;) {
        sum = 0u; cnt = 0u; mine = 0u;
#pragma unroll
        for (unsigned j = 0; j < 16; ++j) { const unsigned c = xb_ld(&bar[XB_XCNT(j)]); sum += c; cnt += (c > 0u) ? 1u : 0u; mine = (j == x) ? c : mine; }
        if (sum == G) break;
        __builtin_amdgcn_s_sleep(1);
        if ((++sp & 255u) == 0u) { if (xb_ld(&bar[XB_TMO])) break; if (sp > XB_SPIN_CAP) { atomicAdd(&bar[XB_TMO], 1u); break; } }
    }
    nloc = mine > 0u ? mine : 1u; nx = cnt > 0u ? cnt : 1u;
}

__device__ __forceinline__ void xcd_barrier(const XcdBarrier& b) {
    asm volatile("s_waitcnt vmcnt(0)" ::: "memory");
    __syncthreads();
    if (threadIdx.x == 0) {
        unsigned* bar = b.bar;
        __builtin_amdgcn_s_waitcnt(0);
        unsigned nloc = b.st[0], nx = b.st[1];
        if (nloc == 0u) { xcd_barrier_complete(bar, b.x, nloc, nx); b.st[0] = nloc; b.st[1] = nx; }
        const unsigned old = xb_add(&bar[XB_XSUB(b.x)], 1u);
        const unsigned gen = old / nloc;
        if (old + 1u == (gen + 1u) * nloc) {
            __builtin_amdgcn_fence(__ATOMIC_RELEASE, "agent");
            asm volatile("s_waitcnt vmcnt(0)" ::: "memory");
            const unsigned og = xb_add(&bar[XB_TOP], 1u);
            const unsigned tg = og / nx;
            if (og + 1u == (tg + 1u) * nx) xb_add(&bar[XB_TOPGEN], 1u);
            else XB_SPIN(xb_ld(&bar[XB_TOPGEN]) == tg, bar);
            __builtin_amdgcn_fence(__ATOMIC_ACQUIRE, "agent");
            xb_add(&bar[XB_XGEN(b.x)], 1u);
            asm volatile("s_waitcnt vmcnt(0)" ::: "memory");
        } else {
            XB_SPIN(xb_ld(&bar[XB_XGEN(b.x)]) == gen, bar);
            __builtin_amdgcn_fence(__ATOMIC_ACQUIRE, "agent");
            asm volatile("s_waitcnt vmcnt(0)" ::: "memory");
        }
    }
    __syncthreads();
}
struct Frame {
    LAS unsigned char* lds;
    volatile LAS unsigned* MISC;
    gu32* ctl;
    int tid, lane, wave;
    int vcu, G;
    unsigned char* ws;
    __amdgpu_buffer_rsrc_t rsrc;
};

#define PHASE_FRAME(F0) Frame F = (F0); { int t_ = threadIdx.x; asm volatile("" : "+v"(t_)); F.tid = t_; F.lane = t_ & 63; F.wave = __builtin_amdgcn_readfirstlane(t_ >> 6); }

__device__ __forceinline__ void tr_item(const float* W, size_t ldw, int k0, int c0, bf16* WT, size_t ldt, int drow0, LAS float* scr, int lane) {
    const int kr = lane >> 4, cq = lane & 15;
    f32x4 v[16];
#pragma unroll
    for (int i = 0; i < 16; ++i) v[i] = *(const GAS f32x4*)(W + (size_t)(k0 + 4 * i + kr) * ldw + c0 + 4 * cq);
#pragma unroll
    for (int i = 0; i < 16; ++i)
#pragma unroll
        for (int j = 0; j < 4; ++j) scr[(4 * cq + j) * 65 + 4 * i + kr] = v[i][j];
    LDS_WAIT(); asm volatile("" ::: "memory");
    const int c = lane & 7;
#pragma unroll
    for (int jj = 0; jj < 8; ++jj) { const int n = (lane >> 3) + 8 * jj; const LAS float* s = scr + n * 65 + 8 * c;
        v4u o; o.x = pk2(s[0], s[1]); o.y = pk2(s[2], s[3]); o.z = pk2(s[4], s[5]); o.w = pk2(s[6], s[7]);
        *(GAS v4u*)(WT + (size_t)(drow0 + n) * ldt + k0 + 8 * c) = o; }
    LDS_WAIT(); asm volatile("" ::: "memory");
}

typedef short s16x2 __attribute__((ext_vector_type(2)));
struct MoeItem { __amdgpu_buffer_rsrc_t rs; unsigned soff, rstep; int ldw, k0; unsigned char* WT; size_t ldt; int drow; };
__device__ __forceinline__ void tr8_load(const MoeItem& m, f32x4 (&v)[16], int lane) {
    const int kr = lane >> 4, cq = lane & 15;
    const int voff = (kr * m.ldw + 4 * cq) * 4;
#pragma unroll
    for (int i = 0; i < 16; ++i) v[i] = __builtin_bit_cast(f32x4, __builtin_amdgcn_raw_buffer_load_b128(m.rs, voff, (int)(m.soff + (unsigned)i * m.rstep), 0));
}
__device__ __forceinline__ void tr8_finish(const f32x4 (&v)[16], const MoeItem& m, LAS float* scr_, int lane) {
    LAS unsigned char* scr = (LAS unsigned char*)scr_;
    const int kr = lane >> 4, cq = lane & 15;
#pragma unroll
    for (int j = 0; j < 4; ++j) { unsigned w[4];
#pragma unroll
        for (int q = 0; q < 4; ++q) { s16x2 t = {0, 0};
            t = __builtin_amdgcn_cvt_scalef32_pk_fp8_f32(t, v[4 * q][j], v[4 * q + 1][j], F8_CVT_SCALE, false);
            t = __builtin_amdgcn_cvt_scalef32_pk_fp8_f32(t, v[4 * q + 2][j], v[4 * q + 3][j], F8_CVT_SCALE, true);
            w[q] = __builtin_bit_cast(unsigned, t); }
        *(LAS v4u*)(scr + (4 * cq + j) * 80 + kr * 16) = (v4u){w[0], w[1], w[2], w[3]}; }
    LDS_WAIT(); asm volatile("" ::: "memory");
    const int qd = lane & 3;
#pragma unroll
    for (int ps = 0; ps < 4; ++ps) { const int n = (lane >> 2) + 16 * ps; const LAS unsigned char* s = scr + n * 80 + qd * 4;
        const unsigned d0 = *(const LAS unsigned*)(s), d1 = *(const LAS unsigned*)(s + 16), d2 = *(const LAS unsigned*)(s + 32), d3 = *(const LAS unsigned*)(s + 48);
        const unsigned t0 = __builtin_amdgcn_perm(d1, d0, 0x05010400u), t1 = __builtin_amdgcn_perm(d1, d0, 0x07030602u), t2 = __builtin_amdgcn_perm(d3, d2, 0x05010400u), t3 = __builtin_amdgcn_perm(d3, d2, 0x07030602u);
        const v4u o = (v4u){__builtin_amdgcn_perm(t2, t0, 0x05040100u), __builtin_amdgcn_perm(t2, t0, 0x07060302u), __builtin_amdgcn_perm(t3, t1, 0x05040100u), __builtin_amdgcn_perm(t3, t1, 0x07060302u)};
        *(GAS v4u*)(m.WT + (size_t)(m.drow + n) * m.ldt + m.k0 + 16 * qd) = o; }
    LDS_WAIT(); asm volatile("" ::: "memory");
}
constexpr int MOE_J4 = 32 * 32 * 64, MOE_J5 = 32 * 32 * 32, MOE_NITEMS = MOE_J4 + MOE_J5;
__device__ __forceinline__ MoeItem moe_item(int r, const float* w_gu, const float* w_down, unsigned char* ws) {
    MoeItem m;
    if (r < MOE_J4) { const int e = r / 2048, q = r % 2048, kb = q / 64, cb = q % 64, c0 = cb * 64; const int cc = c0 & 2047;
        m.rs = __builtin_amdgcn_make_buffer_rsrc((void*)w_gu, 0, 0xffffffff, 0x00020000); m.ldw = 2 * FF; m.k0 = kb * 64;
        m.soff = (unsigned)(((size_t)e * D * 2 * FF + (size_t)kb * 64 * (2 * FF) + c0) * 4); m.rstep = 4u * (2 * FF) * 4u;
        m.WT = ws + WS_WGUT + (size_t)e * 2 * FF * D; m.ldt = D; m.drow = (cc >> 7) * 256 + (c0 >= 2048 ? 128 : 0) + (cc & 127); }
    else { r -= MOE_J4; const int e = r / 1024, q = r % 1024, kb = q / 32, cb = q % 32;
        m.rs = __builtin_amdgcn_make_buffer_rsrc((void*)w_down, 0, 0xffffffff, 0x00020000); m.ldw = D; m.k0 = kb * 64;
        m.soff = (unsigned)(((size_t)e * FF * D + (size_t)kb * 64 * D + cb * 64) * 4); m.rstep = 4u * D * 4u;
        m.WT = ws + WS_WDNT + (size_t)e * D * FF; m.ldt = FF; m.drow = cb * 64; }
    return m;
}
__device__ __forceinline__ MoeItem f8_item(const float* W, int ldw, int k0, int c0, unsigned char* WT, size_t ldt, int drow) {
    MoeItem m; m.rs = __builtin_amdgcn_make_buffer_rsrc((void*)W, 0, 0xffffffff, 0x00020000); m.ldw = ldw; m.k0 = k0;
    m.soff = (unsigned)(((size_t)k0 * ldw + c0) * 4); m.rstep = 4u * (unsigned)ldw * 4u; m.WT = WT; m.ldt = ldt; m.drow = drow; return m;
}

struct In {
    const float *x, *w_in, *rel_bias, *shift_mu, *w0, *w_up, *a0, *a_up, *g_up, *k_k, *k_a, *r_k, *lnx_w, *lnx_b, *proj_a, *proj_b, *w_out,
                *ln1_w, *ln1_b, *w_router, *b_router, *w_gu, *b_gu, *w_down, *b_down, *ln2_w, *ln2_b;
};

__device__ __forceinline__ void p0_prologue(Frame& F0, const In& I) {
    PHASE_FRAME(F0);
    LAS float* scr = (LAS float*)(F.lds + F.wave * 16640);
    const int gw = F.vcu * NWAVES + F.wave, NGW = F.G * NWAVES;
    unsigned char* ws = F.ws;
    constexpr int J0 = 32 * 167, J1 = 16 * 32, J2 = 16 * 32, J3 = 32 * 32;
    constexpr int NITEMS = J0 + J1 + J2 + J3;
    for (int it = gw; it < NITEMS; it += NGW) {
        int r = it;
        if (r < J0) { const int kb = r / 167, cb = r % 167, c0 = cb * 64; bf16* dst; int drow;
            if (c0 < 3072) { f32x4 tv[16];
                   const MoeItem m = (c0 < 2048) ? f8_item(I.w_in, D_IN, kb * 64, c0, (unsigned char*)(ws + WS_WQK8), D, c0) : f8_item(I.w_in, D_IN, kb * 64, c0, (unsigned char*)(ws + WS_WV8), D, c0 - 2048);
                   tr8_load(m, tv, F.lane); tr8_finish(tv, m, scr, F.lane); continue; }
            else if (c0 < 6592) { f32x4 tv[16]; const MoeItem m = f8_item(I.w_in, D_IN, kb * 64, c0, (unsigned char*)(ws + WS_WSV8), D, c0 - 3072);
                   tr8_load(m, tv, F.lane); tr8_finish(tv, m, scr, F.lane); continue; }
            else { f32x4 tv[16]; const int cg = c0 - 6592, d0 = cg & 2047; const MoeItem m = f8_item(I.w_in, D_IN, kb * 64, c0, (unsigned char*)(ws + WS_WG8), D, (d0 >> 7) * 256 + (cg >= 2048 ? 128 : 0) + (d0 & 127));
                   tr8_load(m, tv, F.lane); tr8_finish(tv, m, scr, F.lane); continue; }
            (void)dst; (void)drow; continue; } r -= J0;
        if (r < J1) { const int kb = r / 32, cb = r % 32; f32x4 tv[16]; const MoeItem m = f8_item(I.proj_a, D, kb * 64, cb * 64, (unsigned char*)(ws + WS_PAT), AW, cb * 64); tr8_load(m, tv, F.lane); tr8_finish(tv, m, scr, F.lane); continue; } r -= J1;
        if (r < J2) { const int kb = r / 32, cb = r % 32; f32x4 tv[16]; const MoeItem m = f8_item(I.proj_b, D, kb * 64, cb * 64, (unsigned char*)(ws + WS_PBT), RW, cb * 64); tr8_load(m, tv, F.lane); tr8_finish(tv, m, scr, F.lane); continue; } r -= J2;
        { const int kb = r / 32, cb = r % 32; f32x4 tv[16]; const MoeItem m = f8_item(I.w_out, D, kb * 64, cb * 64, (unsigned char*)(ws + WS_WOT), D, cb * 64);
          tr8_load(m, tv, F.lane); tr8_finish(tv, m, scr, F.lane); }
    }
    const int gt = F.vcu * (NWAVES * 64) + F.tid, NGT = F.G * NWAVES * 64;
    for (int i = gt; i < 2048 * 256; i += NGT) { const int n = i >> 8, k = i & 255; float v = 0.f;
        if (n < 1024) { if (k < DLORA) v = I.w_up[(size_t)k * RW + n]; }
        else { if (k >= 128 && k < 128 + ALORA) v = I.a_up[(size_t)(k - 128) * RW + (n - 1024)]; }
        ((bf16*)(ws + WS_WLA))[i] = (bf16)f2bf(v); }
    for (int i = gt; i < 1024 * 256; i += NGT) { const int n = i >> 8, k = i & 255; ((bf16*)(ws + WS_WLG))[i] = (bf16)f2bf(I.g_up[(size_t)k * RW + n]); }
    for (int i = gt; i < 64 * D / 16; i += NGT) ((GAS v4u*)((unsigned char*)(ws + WS_WSV8) + (size_t)SHIFT_W * D))[i] = (v4u){0u, 0u, 0u, 0u};
    for (int i = gt; i < RROWS; i += NGT) ((int*)(ws + WS_ROWSLOT))[i] = -1;
    for (size_t i = gt; i < (size_t)T * D / 8; i += NGT) { const f32x4 a = ((const GAS f32x4*)I.x)[2 * i], b = ((const GAS f32x4*)I.x)[2 * i + 1];
        int w0 = __builtin_amdgcn_cvt_pk_fp8_f32(a.x, a.y, 0, false); w0 = __builtin_amdgcn_cvt_pk_fp8_f32(a.z, a.w, w0, true);
        int w1 = __builtin_amdgcn_cvt_pk_fp8_f32(b.x, b.y, 0, false); w1 = __builtin_amdgcn_cvt_pk_fp8_f32(b.z, b.w, w1, true);
        ((GAS v2u*)(ws + WS_XB8))[i] = (v2u){(unsigned)w0, (unsigned)w1}; }
}

constexpr int P8_HS = 0, P8_PITCH = 2052, P8_PART = 131328, P8_LOG = 147712, P8_HIST = 149760;
template <bool SKIP_MIX>
__device__ __forceinline__ void p8_ln_router(Frame& F0, const In& I) {
    PHASE_FRAME(F0);
    LAS float* hs = (LAS float*)(F.lds + P8_HS); LAS float* part = (LAS float*)(F.lds + P8_PART); LAS float* lg = (LAS float*)(F.lds + P8_LOG); LAS int* hist = (LAS int*)(F.lds + P8_HIST);
    const int lane = F.lane, w = F.wave;
    if (F.tid < 32) hist[F.tid] = 0;
    const int kq = lane >> 4, col = lane & 15;
    float ln_w[32], ln_b[32];
#pragma unroll
    for (int j = 0; j < 8; ++j) { const f32x4 a = *(const GAS f32x4*)(I.ln1_w + 4 * lane + 256 * j), b = *(const GAS f32x4*)(I.ln1_b + 4 * lane + 256 * j);
#pragma unroll
        for (int e = 0; e < 4; ++e) { ln_w[4 * j + e] = a[e]; ln_b[4 * j + e] = b[e]; } }
    __syncthreads();
    if (F.vcu & 1) { __builtin_amdgcn_s_sleep(127); __builtin_amdgcn_s_sleep(127); }
    const float* zsrc = I.x; const bf16* mixb = (const bf16*)(F.ws + WS_Z);
    for (int g = F.vcu; g < T / 16; g += F.G) {
        const int tok0 = g * 16;
        { f32x4 va[8], vb[8];
          const size_t tokA = (size_t)(tok0 + 2 * w), tokB = tokA + 1;
          const GAS f32x4* zra = (const GAS f32x4*)(zsrc + tokA * D) + lane; const GAS f32x4* zrb = (const GAS f32x4*)(zsrc + tokB * D) + lane;
          const GAS v2u* mra = (const GAS v2u*)(mixb + tokA * D) + lane; const GAS v2u* mrb = (const GAS v2u*)(mixb + tokB * D) + lane;
          v2u ma[8], mb[8];
#pragma unroll
          for (int j = 0; j < 8; ++j) { va[j] = zra[64 * j]; vb[j] = zrb[64 * j]; if (!SKIP_MIX) { ma[j] = mra[64 * j]; mb[j] = mrb[64 * j]; } }
#pragma unroll
          for (int j = 0; j < 8; ++j) { va[j] = va[j] * DN_ALPHA; vb[j] = vb[j] * DN_ALPHA;
              if (!SKIP_MIX) { va[j] += (f32x4){bflo(ma[j].x), bfhi(ma[j].x), bflo(ma[j].y), bfhi(ma[j].y)}; vb[j] += (f32x4){bflo(mb[j].x), bfhi(mb[j].x), bflo(mb[j].y), bfhi(mb[j].y)}; } }
#pragma unroll
          for (int tt = 0; tt < 2; ++tt) {
            const int tl = 2 * w + tt; const size_t tok = (size_t)(tok0 + tl);
            f32x4 v[8]; float s = 0.f;
#pragma unroll
            for (int j = 0; j < 8; ++j) { v[j] = tt ? vb[j] : va[j]; s += (v[j].x + v[j].y) + (v[j].z + v[j].w); }
            const float mean = wave_sum(s) * (1.f / D); float s2 = 0.f;
#pragma unroll
            for (int j = 0; j < 8; ++j) { v[j] = v[j] - mean; s2 += (v[j].x * v[j].x + v[j].y * v[j].y) + (v[j].z * v[j].z + v[j].w * v[j].w); }
            const float rstd = 1.f / sqrtf(wave_sum(s2) * (1.f / D) + LN_EPS);
            GAS v2u* h1 = (GAS v2u*)((bf16*)(F.ws + WS_H1) + tok * D) + lane;
            GAS unsigned* h1b = (GAS unsigned*)((unsigned char*)(F.ws + WS_H1B) + tok * D) + lane;
#pragma unroll
            for (int j = 0; j < 8; ++j) { f32x4 h;
#pragma unroll
                for (int e = 0; e < 4; ++e) h[e] = v[j][e] * rstd * ln_w[4 * j + e] + ln_b[4 * j + e];
                h1[64 * j] = (v2u){pg8::cvt_pk_bf16(h.x, h.y), pg8::cvt_pk_bf16(h.z, h.w)}; { int w8 = __builtin_amdgcn_cvt_pk_fp8_f32(h.x, h.y, 0, false); w8 = __builtin_amdgcn_cvt_pk_fp8_f32(h.z, h.w, w8, true); h1b[64 * j] = (unsigned)w8; }
                *(LAS f32x4*)(hs + tl * P8_PITCH + 4 * lane + 256 * j) = h; }
          } }
        __syncthreads();
        f32x4 c0 = (f32x4){0.f, 0.f, 0.f, 0.f}, c1 = c0;
        const LAS float* ap = hs + col * P8_PITCH + 256 * w + 4 * kq;
        const float* bp = I.w_router + (size_t)(256 * w + 4 * kq) * NE + col;
#pragma unroll 4
        for (int kk = 0; kk < 16; ++kk) {
            const f32x4 a = *(const LAS f32x4*)(ap + 16 * kk);
#pragma unroll
            for (int e = 0; e < 4; ++e) {
                const float b0 = bp[(size_t)(16 * kk + e) * NE], b1 = bp[(size_t)(16 * kk + e) * NE + 16];
                c0 = __builtin_amdgcn_mfma_f32_16x16x4f32(a[e], b0, c0, 0, 0, 0);
                c1 = __builtin_amdgcn_mfma_f32_16x16x4f32(a[e], b1, c1, 0, 0, 0);
            }
        }
#pragma unroll
        for (int i = 0; i < 4; ++i) { part[(w * 16 + 4 * kq + i) * 32 + col] = c0[i]; part[(w * 16 + 4 * kq + i) * 32 + 16 + col] = c1[i]; }
        __syncthreads();
        { const int tl = F.tid >> 5, e = F.tid & 31; float s = I.b_router[e];
#pragma unroll
            for (int ww = 0; ww < 8; ++ww) s += part[(ww * 16 + tl) * 32 + e];
            lg[tl * 32 + e] = s; }
        __syncthreads();
        if (F.tid < 16) {
            const int tl = F.tid; float lv[32];
#pragma unroll
            for (int e = 0; e < 32; ++e) lv[e] = lg[tl * 32 + e];
            int ti[4]; float tv[4];
#pragma unroll
            for (int k = 0; k < 4; ++k) { float best = -3.4e38f; int bi = 0;
#pragma unroll
                for (int e = 0; e < 32; ++e) { const bool tk = lv[e] > best; best = tk ? lv[e] : best; bi = tk ? e : bi; }
                ti[k] = bi; tv[k] = best;
#pragma unroll
                for (int e = 0; e < 32; ++e) lv[e] = (e == bi) ? -3.4e38f : lv[e]; }
            float ex[4], sum = 0.f;
#pragma unroll
            for (int k = 0; k < 4; ++k) { ex[k] = __expf(tv[k] - tv[0]); sum += ex[k]; }
            const float inv = 1.f / sum;
            *(GAS v4u*)((int*)(F.ws + WS_TOPI) + (size_t)(tok0 + tl) * 4) = (v4u){(unsigned)ti[0], (unsigned)ti[1], (unsigned)ti[2], (unsigned)ti[3]};
            *(GAS f32x4*)((float*)(F.ws + WS_GATE) + (size_t)(tok0 + tl) * 4) = (f32x4){ex[0] * inv, ex[1] * inv, ex[2] * inv, ex[3] * inv};
#pragma unroll
            for (int k = 0; k < 4; ++k) __hip_atomic_fetch_add(&hist[ti[k]], 1, __ATOMIC_RELAXED, __HIP_MEMORY_SCOPE_WORKGROUP);
        }
        __syncthreads();
    }
    if (F.tid < 32) { const int c = hist[F.tid]; if (c) __hip_atomic_fetch_add(F.ctl + CW_CNT + F.tid, (unsigned)c, RLX_AGENT); }
}

template <bool SKIP_MOE>
__device__ __forceinline__ void p12_final(Frame& F0, const In& I, float* out) {
    PHASE_FRAME(F0);
    const int lane = F.lane; const int gw = F.vcu * NWAVES + F.wave, NGW = F.G * NWAVES;
    LAS f32x4* lnp = (LAS f32x4*)(F.lds);
    for (int u = F.tid; u < D / 4; u += NWAVES * 64) { lnp[u] = *(const GAS f32x4*)(I.ln2_w + 4 * u); lnp[D / 4 + u] = *(const GAS f32x4*)(I.ln2_b + 4 * u); }
    __syncthreads();
    v2u hraw[8]; unsigned yraw[4][8];
#define P12_LOAD(tok_) do { const unsigned hoff = (unsigned)(WS_H1 + (size_t)(tok_) * D * 2) + (unsigned)lane * 8u;        \
        _Pragma("unroll") for (int j = 0; j < 8; ++j) hraw[j] = *(const GAS v2u*)(F.ws + (size_t)(hoff + 512u * j)); \
        if (!SKIP_MOE) { const unsigned yoff = (unsigned)(WS_YSLOT + (size_t)(tok_) * 4 * D) + (unsigned)lane * 4u; \
            _Pragma("unroll") for (int k = 0; k < 4; ++k) { _Pragma("unroll") for (int j = 0; j < 8; ++j) yraw[k][j] = *(const GAS unsigned*)(F.ws + (size_t)(yoff + 2048u * k + 256u * j)); } } } while (0)
    if (gw < T) P12_LOAD(gw);
    for (int tok = gw; tok < T; tok += NGW) {
        f32x4 v[8]; float s = 0.f;
#pragma unroll
        for (int j = 0; j < 8; ++j) { const v2u hh = hraw[j]; v[j] = (f32x4){bflo(hh.x), bfhi(hh.x), bflo(hh.y), bfhi(hh.y)} * DN_ALPHA; }
        if (!SKIP_MOE) {
#pragma unroll
            for (int k = 0; k < 4; ++k) {
#pragma unroll
                for (int j = 0; j < 8; ++j) { const unsigned y = yraw[k][j]; const f32x2 lo = __builtin_amdgcn_cvt_pk_f32_fp8((int)y, false), hi = __builtin_amdgcn_cvt_pk_f32_fp8((int)y, true);
                    v[j].x += lo.x * YS_INV; v[j].y += lo.y * YS_INV; v[j].z += hi.x * YS_INV; v[j].w += hi.y * YS_INV; } }
        }
        __builtin_amdgcn_sched_barrier(0);
        if (tok + NGW < T) P12_LOAD(tok + NGW);
        __builtin_amdgcn_sched_barrier(0);
#pragma unroll
        for (int j = 0; j < 8; ++j) s += (v[j].x + v[j].y) + (v[j].z + v[j].w);
        const float mean = wave_sum(s) * (1.f / D); float s2 = 0.f;
#pragma unroll
        for (int j = 0; j < 8; ++j) { v[j] = v[j] - mean; s2 += (v[j].x * v[j].x + v[j].y * v[j].y) + (v[j].z * v[j].z + v[j].w * v[j].w); }
        const float rstd = 1.f / sqrtf(wave_sum(s2) * (1.f / D) + LN_EPS);
        GAS f32x4* o = (GAS f32x4*)(out + (size_t)tok * D) + lane;
#pragma unroll
        for (int j = 0; j < 8; ++j) { f32x4 h;
            const f32x4 lw = lnp[lane + 64 * j], lb = lnp[D / 4 + lane + 64 * j];
#pragma unroll
            for (int e = 0; e < 4; ++e) h[e] = v[j][e] * rstd * lw[e] + lb[e];
            o[64 * j] = h; }
    }
#undef P12_LOAD
}
__device__ __forceinline__ void moe_tables(Frame& F) {
    LAS int* tab = (LAS int*)(F.lds + TAB_OFF);
    if (F.tid == 0) { int run = 0;
        for (int e = 0; e < NE; ++e) { const int c = (int)__hip_atomic_load(F.ctl + CW_CNT + e, RLX_AGENT); const int p = (c + 255) / 256 * 256; tab[32 + e] = run; run += p; tab[e] = run; }
        tab[64] = run / 256; }
    __syncthreads();
}

__device__ __forceinline__ void p9_scatter(Frame& F0, const In& I) {
    PHASE_FRAME(F0);
    moe_tables(F);
    LAS int* tab = (LAS int*)(F.lds + TAB_OFF);
    LAS int* lh = (LAS int*)(F.lds + 0);
    LAS int* lb = (LAS int*)(F.lds + 128);
    LAS int* dst = (LAS int*)(F.lds + 256);
    const int* topi = (const int*)(F.ws + WS_TOPI); const float* gate = (const float*)(F.ws + WS_GATE);
    for (int ch = F.vcu; ch < T / 128; ch += F.G) {
        if (F.tid < 32) lh[F.tid] = 0;
        __syncthreads();
        const int s = ch * 512 + F.tid; const int e = topi[s]; const float gv = gate[s];
        const int rank = __hip_atomic_fetch_add(&lh[e], 1, __ATOMIC_RELAXED, __HIP_MEMORY_SCOPE_WORKGROUP);
        __syncthreads();
        if (F.tid < 32) { const int c = lh[F.tid]; lb[F.tid] = c ? (int)__hip_atomic_fetch_add(F.ctl + CW_CUR + F.tid, (unsigned)c, RLX_AGENT) : 0; }
        __syncthreads();
        const int d = tab[32 + e] + lb[e] + rank;
        ((int*)(F.ws + WS_ROWSLOT))[d] = s; ((float*)(F.ws + WS_ROWW))[d] = gv; dst[F.tid] = d;
        __syncthreads();
#pragma unroll 1
        for (int i0 = F.wave * 64; i0 < F.wave * 64 + 64; i0 += 8) {
            v4u v[8][2]; int dd[8];
#pragma unroll
            for (int q = 0; q < 8; ++q) { const int i = i0 + q; const int tok = ch * 128 + (i >> 2); dd[q] = dst[i];
                const GAS v4u* src = (const GAS v4u*)((const unsigned char*)(F.ws + WS_H1B) + (size_t)tok * D) + F.lane;
                v[q][0] = src[0]; v[q][1] = src[64]; }
#pragma unroll
            for (int q = 0; q < 8; ++q) { GAS v4u* o = (GAS v4u*)((unsigned char*)(F.ws + WS_XG) + (size_t)dd[q] * D) + F.lane; o[0] = v[q][0]; o[64] = v[q][1]; }
        }
        __syncthreads();
    }
}

__device__ __forceinline__ void p10_moe_up(Frame& F0, const In& I) {
    PHASE_FRAME(F0);
    moe_tables(F);
    LAS int* tab = (LAS int*)(F.lds + TAB_OFF);
    pg8::SchedMoe S; S.t.init(tab[64], 16, F.G, (int)blockIdx.x);
    S.A = (unsigned)(WS_XG); S.B = (unsigned)(WS_WGUT); S.tsA = (unsigned)256 * D; S.tsB = (unsigned)256 * D; S.es = (unsigned)2 * FF * D; S.pad_end = tab;
    pg8::EpiSwiglu E{(unsigned char*)(F.ws + WS_ACT), I.b_gu};
    pg8::gemm_phase<pg8::EpiSwiglu, pg8::SchedMoe, true, true>(F.lds + RING_OFF, F.rsrc, D / 2, D / 2, D / 2, S, E);
}
__device__ __forceinline__ void p11_moe_down(Frame& F0, const In& I) {
    PHASE_FRAME(F0);
    moe_tables(F);
    LAS int* tab = (LAS int*)(F.lds + TAB_OFF);
    pg8::SchedMoe S; S.t.init(tab[64], 8, F.G, (int)blockIdx.x);
    S.A = (unsigned)(WS_ACT); S.B = (unsigned)(WS_WDNT); S.tsA = (unsigned)256 * FF; S.tsB = (unsigned)256 * FF; S.es = (unsigned)D * FF; S.pad_end = tab;
    pg8::EpiDown E{(unsigned char*)(F.ws + WS_YSLOT), I.b_down, (const int*)(F.ws + WS_ROWSLOT), (const float*)(F.ws + WS_ROWW)};
    pg8::gemm_phase<pg8::EpiDown, pg8::SchedMoe, true, true>(F.lds + RING_OFF, F.rsrc, FF / 2, FF / 2, FF / 2, S, E);
}

__device__ __forceinline__ void p1_proj(Frame& F0, const In& I) {
    PHASE_FRAME(F0);
    { pg8::SchedPlain S; S.t.init(T / 256, SEG_PAD / 256, F.G, (int)blockIdx.x);
      S.A = (unsigned)(WS_XB8); S.B = (unsigned)(WS_WSV8); S.tsA = (unsigned)256 * D; S.tsB = (unsigned)256 * D;
      pg8::EpiShift E{(bf16*)(F.ws + WS_RKV), (bf16*)(F.ws + WS_LORAIN), (float*)(F.ws + WS_SIDE0), (float*)(F.ws + WS_SIDEL), I.shift_mu};
      pg8::gemm_phase<pg8::EpiShift, pg8::SchedPlain, true, true>(F.lds + RING_OFF, F.rsrc, D / 2, D / 2, D / 2, S, E); }
    { pg8::SchedPlain S; S.t.init(T / 256, (2 * AW) / 256, F.G, (int)blockIdx.x);
      S.A = (unsigned)(WS_XB8); S.B = (unsigned)(WS_WQK8); S.tsA = (unsigned)256 * D; S.tsB = (unsigned)256 * D;
      pg8::EpiProj E{(bf16*)(F.ws + WS_PROJ), 0, 4};
      pg8::gemm_phase<pg8::EpiProj, pg8::SchedPlain, true, true>(F.lds + RING_OFF, F.rsrc, D / 2, D / 2, D / 2, S, E); }
    { pg8::SchedPlain S; S.t.init(T / 256, (2 * D) / 256, F.G, (int)blockIdx.x);
      S.A = (unsigned)(WS_XB8); S.B = (unsigned)(WS_WG8); S.tsA = (unsigned)256 * D; S.tsB = (unsigned)256 * D;
      pg8::EpiGate E{(bf16*)(F.ws + WS_GATEF)};
      pg8::gemm_phase<pg8::EpiGate, pg8::SchedPlain, true, true>(F.lds + RING_OFF, F.rsrc, D / 2, D / 2, D / 2, S, E); }
    { pg8::SchedPlain S; S.t.init(AW / 256, T / 256, F.G, (int)blockIdx.x);
      S.A = (unsigned)(WS_WV8); S.B = (unsigned)(WS_XB8); S.tsA = (unsigned)256 * D; S.tsB = (unsigned)256 * D;
      pg8::EpiBf16 E{(bf16*)(F.ws + WS_VT), T};
      pg8::gemm_phase<pg8::EpiBf16, pg8::SchedPlain, true, true>(F.lds + RING_OFF, F.rsrc, D / 2, D / 2, D / 2, S, E); }
}

__device__ __forceinline__ float ftanh(float x) { return 2.0f * fsigmoid(2.0f * x) - 1.0f; }
__device__ __forceinline__ void p2_shift_attn(Frame& F0, const In& I) {
    PHASE_FRAME(F0);
    const int lane = F.lane; const int gw = F.vcu * NWAVES + F.wave, NGW = F.G * NWAVES;
    const bf16* PROJ = (const bf16*)(F.ws + WS_PROJ);
    for (int g = gw; g < T / 64; g += NGW) {
        const int tok = g * 64; const bool first = (tok % SEQ) == 0;
        const float* cur = (const float*)(F.ws + WS_SIDE0) + (size_t)g * SEG_PAD; const float* prv = (const float*)(F.ws + WS_SIDEL) + (size_t)(g - 1) * SEG_PAD;
        bf16* rkv = (bf16*)(F.ws + WS_RKV) + (size_t)tok * (3 * RW); bf16* lin = (bf16*)(F.ws + WS_LORAIN) + (size_t)tok * LORA_LD;
#pragma unroll 1
        for (int it = 0; it < 7; ++it) { const int gi = it * 64 + lane; if (gi >= SHIFT_W / 8) break; const int c = gi * 8;
            const f32x4 c0 = *(const GAS f32x4*)(cur + c), c1 = *(const GAS f32x4*)(cur + c + 4);
            f32x4 p0 = (f32x4){0.f, 0.f, 0.f, 0.f}, p1 = p0; if (!first) { p0 = *(const GAS f32x4*)(prv + c); p1 = *(const GAS f32x4*)(prv + c + 4); }
            const f32x4 m0 = *(const GAS f32x4*)(I.shift_mu + c), m1 = *(const GAS f32x4*)(I.shift_mu + c + 4);
            float v[8];
#pragma unroll
            for (int j = 0; j < 4; ++j) { v[j] = c0[j] + (p0[j] - c0[j]) * m0[j]; v[4 + j] = c1[j] + (p1[j] - c1[j]) * m1[j]; }
            bf16* dstp;
            if (c < 3 * RW) dstp = rkv + c;
            else if (c < 3 * RW + DLORA) { dstp = lin + (c - 3 * RW);
#pragma unroll
                for (int j = 0; j < 8; ++j) v[j] = ftanh(v[j]); }
            else if (c < 3 * RW + DLORA + ALORA) dstp = lin + 128 + (c - 3 * RW - DLORA);
            else { dstp = lin + 256 + (c - 3 * RW - DLORA - ALORA);
#pragma unroll
                for (int j = 0; j < 8; ++j) v[j] = fsigmoid(v[j]); }
            *(GAS v4u*)dstp = (v4u){pk2(v[0], v[1]), pk2(v[2], v[3]), pk2(v[4], v[5]), pk2(v[6], v[7])};
        }
    }
#if STAGE == 3
    { const int gt = F.vcu * (NWAVES * 64) + F.tid, NGT = F.G * NWAVES * 64;
      for (size_t i = gt; i < (size_t)T * RW / 8; i += NGT) ((GAS v4u*)(F.ws + WS_YB))[i] = (v4u){0u, 0u, 0u, 0u}; }
#endif
    LAS float* tbl = (LAS float*)(F.lds + 0);
    constexpr int AKV = 64 * 144, A_KOFF = 2048, A_VOFF = A_KOFF + 2 * AKV;
    const bf16* VT = (const bf16*)(F.ws + WS_VT); bf16* YA = (bf16*)(F.ws + WS_YA);
    const int r = lane & 31, hh = lane >> 5;
    const int rp = (r & 16) + 8 * ((r >> 2) & 1) + 4 * ((r >> 3) & 1) + (r & 3);
    const int srow = F.tid >> 3, spc = F.tid & 7;
    for (int task = F.vcu; task < BATCH * AH * (SEQ / 256); task += F.G) {
        const int bh = task >> 5, q256 = task & 31, b = bh >> 4, h = bh & 15, c0 = q256 * 4;
        const int q0 = q256 * 256 + F.wave * 32, cw = c0 + (F.wave >> 1);
        const int kc_lo = (c0 > LEFT) ? c0 - LEFT : 0, kc_hi = c0 + 3;
        __syncthreads();
        if (F.tid < REL_TABLE) tbl[F.tid] = I.rel_bias[h * REL_TABLE + F.tid];
        const size_t tokq = (size_t)b * SEQ + q0 + r;
        bf16x8 qf[4];
#pragma unroll
        for (int s = 0; s < 4; ++s) qf[s] = *(const GAS bf16x8*)(PROJ + tokq * PROJ_LD + PJ_Q + h * 64 + 16 * s + 8 * hh);
        f32x16 o0, o1;
#pragma unroll
        for (int i = 0; i < 16; ++i) { o0[i] = 0.f; o1[i] = 0.f; }
        float m_run = -1e30f, l_run = 0.f;
        v4u kreg, vreg;
#define AT_STAGE_LOAD(kc_) do { kreg = *(const GAS v4u*)(PROJ + ((size_t)b * SEQ + (size_t)(kc_) * 64 + srow) * PROJ_LD + PJ_K + h * 64 + spc * 8); \
                                vreg = *(const GAS v4u*)(VT + (size_t)(h * 64 + srow) * T + (size_t)b * SEQ + (size_t)(kc_) * 64 + spc * 8); } while (0)
#define AT_STAGE_WRITE(buf_) do { *(LAS v4u*)(F.lds + A_KOFF + (buf_) * AKV + srow * 144 + spc * 16) = kreg; *(LAS v4u*)(F.lds + A_VOFF + (buf_) * AKV + srow * 144 + spc * 16) = vreg; } while (0)
        AT_STAGE_LOAD(kc_lo); AT_STAGE_WRITE(0);
        __syncthreads();
#pragma unroll 1
        for (int kc = kc_lo; kc <= kc_hi; ++kc) {
            const int buf = (kc - kc_lo) & 1;
            if (kc < kc_hi) AT_STAGE_LOAD(kc + 1);
            if (kc >= cw - LEFT && kc <= cw) {
                const LAS unsigned char* Kb = F.lds + A_KOFF + buf * AKV; const LAS unsigned char* Vb = F.lds + A_VOFF + buf * AKV;
                bf16x8 kf[2][4];
#pragma unroll
                for (int tt = 0; tt < 2; ++tt)
#pragma unroll
                    for (int s = 0; s < 4; ++s) kf[tt][s] = *(const LAS bf16x8*)(Kb + (32 * tt + rp) * 144 + 32 * s + 16 * hh);
                f32x16 st[2];
#pragma unroll
                for (int tt = 0; tt < 2; ++tt)
#pragma unroll
                    for (int i = 0; i < 16; ++i) st[tt][i] = 0.f;
#pragma unroll
                for (int s = 0; s < 4; ++s) { st[0] = __builtin_amdgcn_mfma_f32_32x32x16_bf16(kf[0][s], qf[s], st[0], 0, 0, 0); st[1] = __builtin_amdgcn_mfma_f32_32x32x16_bf16(kf[1][s], qf[s], st[1], 0, 0, 0); }
                bf16x8 va[2][2], vb[2][2];
#pragma unroll
                for (int tt = 0; tt < 2; ++tt)
#pragma unroll
                    for (int s2 = 0; s2 < 2; ++s2) { va[tt][s2] = *(const LAS bf16x8*)(Vb + r * 144 + 64 * tt + 32 * s2 + 16 * hh); vb[tt][s2] = *(const LAS bf16x8*)(Vb + (32 + r) * 144 + 64 * tt + 32 * s2 + 16 * hh); }
                float mx = -1e30f;
#pragma unroll
                for (int tt = 0; tt < 2; ++tt) {
                    const int kpos0 = kc * 64 + 32 * tt;
                    const int dbase = (q0 + r) - (kpos0 + 8 * hh);
                    if (q0 - (kpos0 + 31) >= MAX_PAST) {
                        const float bc = tbl[MAX_PAST + 63];
#pragma unroll
                        for (int i = 0; i < 16; ++i) { st[tt][i] += bc; mx = fmaxf(mx, st[tt][i]); }
                    } else {
#pragma unroll
                        for (int i = 0; i < 16; ++i) { int d = dbase - (16 * (i >> 3) + 4 * ((i >> 2) & 1) + (i & 3)); d = d < MAX_PAST ? d : MAX_PAST; st[tt][i] += tbl[d + 63]; mx = fmaxf(mx, st[tt][i]); }
                    }
                }
                { const unsigned mu_ = __builtin_bit_cast(unsigned, mx);
                  const auto sw_ = __builtin_amdgcn_permlane32_swap(mu_, mu_, false, false);
                  mx = fmaxf(__builtin_bit_cast(float, sw_[0]), __builtin_bit_cast(float, sw_[1])); }
                const float m_new = fmaxf(m_run, mx), alpha = __expf(m_run - m_new);
                float ls = 0.f;
#pragma unroll
                for (int tt = 0; tt < 2; ++tt)
#pragma unroll
                    for (int i = 0; i < 16; ++i) { st[tt][i] = __expf(st[tt][i] - m_new); ls += st[tt][i]; }
                l_run = l_run * alpha + ls;
                if (__builtin_amdgcn_ballot_w64(m_new != m_run)) {
#pragma unroll
                    for (int i = 0; i < 16; ++i) { o0[i] *= alpha; o1[i] *= alpha; } }
                m_run = m_new;
#pragma unroll
                for (int tt = 0; tt < 2; ++tt)
#pragma unroll
                    for (int s2 = 0; s2 < 2; ++s2) {
                        v4u pw; pw.x = pg8::cvt_pk_bf16(st[tt][8 * s2 + 0], st[tt][8 * s2 + 1]); pw.y = pg8::cvt_pk_bf16(st[tt][8 * s2 + 2], st[tt][8 * s2 + 3]); pw.z = pg8::cvt_pk_bf16(st[tt][8 * s2 + 4], st[tt][8 * s2 + 5]); pw.w = pg8::cvt_pk_bf16(st[tt][8 * s2 + 6], st[tt][8 * s2 + 7]);
                        const bf16x8 pf = __builtin_bit_cast(bf16x8, pw);
                        o0 = __builtin_amdgcn_mfma_f32_32x32x16_bf16(va[tt][s2], pf, o0, 0, 0, 0);
                        o1 = __builtin_amdgcn_mfma_f32_32x32x16_bf16(vb[tt][s2], pf, o1, 0, 0, 0);
                    }
            }
            if (kc < kc_hi) AT_STAGE_WRITE(buf ^ 1);
            __syncthreads();
        }
#undef AT_STAGE_LOAD
#undef AT_STAGE_WRITE
        const float inv = 1.0f / (l_run + __shfl_xor(l_run, 32));
        unsigned char* yo = (unsigned char*)YA + tokq * AW + h * 64 + 4 * hh;
        const float inv16 = inv * ACT8_SCALE;
#pragma unroll
        for (int g4 = 0; g4 < 4; ++g4) {
            int w0 = __builtin_amdgcn_cvt_pk_fp8_f32(o0[4 * g4] * inv16, o0[4 * g4 + 1] * inv16, 0, false); w0 = __builtin_amdgcn_cvt_pk_fp8_f32(o0[4 * g4 + 2] * inv16, o0[4 * g4 + 3] * inv16, w0, true);
            int w1 = __builtin_amdgcn_cvt_pk_fp8_f32(o1[4 * g4] * inv16, o1[4 * g4 + 1] * inv16, 0, false); w1 = __builtin_amdgcn_cvt_pk_fp8_f32(o1[4 * g4 + 2] * inv16, o1[4 * g4 + 3] * inv16, w1, true);
            *(GAS unsigned*)(yo + 8 * g4) = (unsigned)w0; *(GAS unsigned*)(yo + 32 + 8 * g4) = (unsigned)w1;
        }
    }
}

__device__ __forceinline__ void p6_merged(Frame& F0, const In& I) {
    PHASE_FRAME(F0);
    pg8::SchedTwo S; S.t.init(T / 256, D / 256, F.G, (int)blockIdx.x);
    S.A0 = (unsigned)(WS_YA); S.A1 = (unsigned)(WS_YB); S.B0 = (unsigned)(WS_PAT); S.B1 = (unsigned)(WS_PBT);
    S.tsA = (unsigned)256 * AW; S.tsB = (unsigned)256 * AW;
    pg8::EpiMerged E{(const bf16*)(F.ws + WS_GATEF), (bf16*)(F.ws + WS_MERGED)};
    pg8::gemm_phase<pg8::EpiMerged, pg8::SchedTwo, true, true, 0x00007b79>(F.lds + RING_OFF, F.rsrc, AW / 2, AW / 2, AW / 2, S, E);
}
__device__ __forceinline__ void p7_mix(Frame& F0, const In& I) {
    PHASE_FRAME(F0);
    pg8::SchedPlain S; S.t.init(T / 256, D / 256, F.G, (int)blockIdx.x);
    S.A = (unsigned)(WS_MERGED); S.B = (unsigned)(WS_WOT); S.tsA = (unsigned)256 * D; S.tsB = (unsigned)256 * D;
    pg8::EpiBf16 E{(bf16*)(F.ws + WS_Z), D};
    pg8::gemm_phase<pg8::EpiBf16, pg8::SchedPlain, true, true, 0x00007b79>(F.lds + RING_OFF, F.rsrc, D / 2, D / 2, D / 2, S, E);
}

__device__ __forceinline__ void p3_lora(Frame& F0, const In& I) {
    PHASE_FRAME(F0);
    { pg8::SchedPlain S; S.t.init(T / 256, 4, F.G, (int)blockIdx.x);
      S.A = (unsigned)(WS_LORAIN); S.B = (unsigned)(WS_WLA); S.tsA = (unsigned)256 * LORA_LD * 2; S.tsB = (unsigned)256 * 256 * 2;
      pg8::EpiLoraA<true> E{(float*)(F.ws + WS_DECAY), I.w0};
      pg8::gemm_phase<pg8::EpiLoraA<true>, pg8::SchedPlain, true>(F.lds + RING_OFF, F.rsrc, LORA_LD, 256, 256, S, E); }
    { pg8::SchedPlain S; S.t.init(T / 256, 4, F.G, (int)blockIdx.x);
      S.A = (unsigned)(WS_LORAIN); S.B = (unsigned)(WS_WLA + (size_t)1024 * 256 * 2); S.tsA = (unsigned)256 * LORA_LD * 2; S.tsB = (unsigned)256 * 256 * 2;
      pg8::EpiIclr E{(bf16*)(F.ws + WS_ICLR), I.a0};
      pg8::gemm_phase<pg8::EpiIclr, pg8::SchedPlain, true>(F.lds + RING_OFF, F.rsrc, LORA_LD, 256, 256, S, E); }
    { pg8::SchedPlain S; S.t.init(T / 256, 4, F.G, (int)blockIdx.x);
      S.A = (unsigned)(WS_LORAIN + 512); S.B = (unsigned)(WS_WLG); S.tsA = (unsigned)256 * LORA_LD * 2; S.tsB = (unsigned)256 * 256 * 2;
      pg8::EpiBf16 E{(bf16*)(F.ws + WS_G), RW};
      pg8::gemm_phase<pg8::EpiBf16, pg8::SchedPlain, true>(F.lds + RING_OFF, F.rsrc, LORA_LD, 256, 256, S, E); }
}

constexpr int CP = 144;
constexpr int CMAT = 64 * CP;
constexpr int C_RT = 0 * CMAT, C_ATT = 1 * CMAT, C_AAK = 2 * CMAT, C_ARKT = 3 * CMAT, C_WA = 4 * CMAT, C_WB = 6 * CMAT,
              C_MA = 8 * CMAT, C_MTA = 9 * CMAT, C_MB = 10 * CMAT, C_MTB = 11 * CMAT, C_SEG = 12 * CMAT, C_GAM = C_SEG + 8 * 64 * 4, C_TSCR = C_GAM + 256;
constexpr int C_AT = C_WB, C_BT = C_WB + CMAT, C_KT = C_MB, C_QYT = C_MA, C_QST = C_MTA, C_KHT = C_MTB, C_VT = C_WB;
static_assert(C_TSCR % 16 == 0 && C_TSCR + 8 * 5120 <= TAB_OFF, "P4a LDS map");
static_assert(BATCH * RH * (SEQ / 64) * 12 == MOE_NITEMS, "P4a converts exactly 12 expert-weight tiles per chunk unit");
constexpr int CHK_UNIT_BYTES = 4 * 64 * 64 * 2;
#define CBAR() do { asm volatile("s_waitcnt lgkmcnt(0)" ::: "memory"); __builtin_amdgcn_s_barrier(); asm volatile("" ::: "memory"); } while (0)
template <int NT, class Epi>
__device__ __forceinline__ void cmm(const LAS unsigned char* X, const LAS unsigned char* Y, int mt0, int nt, int lane, const Epi& E) {
    const int lr = lane & 15, kq = lane >> 4;
    const bf16x8 b0 = *(const LAS bf16x8*)(Y + (nt * 16 + lr) * CP + kq * 16), b1 = *(const LAS bf16x8*)(Y + (nt * 16 + lr) * CP + kq * 16 + 64);
#pragma unroll
    for (int i = 0; i < NT; ++i) { const int mt = mt0 + i;
        const bf16x8 a0 = *(const LAS bf16x8*)(X + (mt * 16 + lr) * CP + kq * 16), a1 = *(const LAS bf16x8*)(X + (mt * 16 + lr) * CP + kq * 16 + 64);
        f32x4 acc = (f32x4){0.f, 0.f, 0.f, 0.f};
        acc = __builtin_amdgcn_mfma_f32_16x16x32_bf16(a0, b0, acc, 0, 0, 0);
        acc = __builtin_amdgcn_mfma_f32_16x16x32_bf16(a1, b1, acc, 0, 0, 0);
        E(mt, nt, acc); }
}
__device__ __forceinline__ v2u pack4(const f32x4& v) { return (v2u){pg8::cvt_pk_bf16(v[0], v[1]), pg8::cvt_pk_bf16(v[2], v[3])}; }
__device__ __forceinline__ f32x4 unpack4(const v2u w) { return (f32x4){bflo(w.x), bfhi(w.x), bflo(w.y), bfhi(w.y)}; }
__device__ __forceinline__ void p4a_chunk(Frame& F0, const In& I) {
    PHASE_FRAME(F0);
    LAS unsigned char* L = F.lds;
    const int lane = F.lane, w = F.wave, lr = lane & 15, kq = lane >> 4;
    const bf16* RKV = (const bf16*)(F.ws + WS_RKV); const float* LW = (const float*)(F.ws + WS_DECAY); const bf16* ICL = (const bf16*)(F.ws + WS_ICLR);
    unsigned char* CHK = F.ws + WS_CHK;
    int uit = 0;
    for (int unit = F.vcu; unit < BATCH * RH * (SEQ / 64); unit += F.G, ++uit) {
        const int bh = unit >> 7, ck = unit & 127, b = bh >> 4, h = bh & 15;
        const size_t tok0 = (size_t)b * SEQ + (size_t)ck * 64 + 8 * w;
        const int hc = h * 64 + lane;
        float lwv[8], ic[8], rr[8], kk[8], vv[8];
#pragma unroll
        for (int i = 0; i < 8; ++i) { const size_t tok = tok0 + i; lwv[i] = LW[tok * RW + hc]; ic[i] = bf2f(ICL[tok * RW + hc]);
            rr[i] = bf2f(RKV[tok * (3 * RW) + hc]); kk[i] = bf2f(RKV[tok * (3 * RW) + RW + hc]); vv[i] = bf2f(RKV[tok * (3 * RW) + 2 * RW + hc]); }
        const float kkp = I.k_k[hc], kap = I.k_a[hc];
        float cs[8]; { float run = 0.f;
#pragma unroll
            for (int i = 0; i < 8; ++i) { run += lwv[i]; cs[i] = run; } }
        __syncthreads();
        ((LAS float*)(L + C_SEG))[w * 64 + lane] = cs[7];
        CBAR();
        float pre = 0.f, tot = 0.f;
#pragma unroll
        for (int j = 0; j < 8; ++j) { const float sg = ((const LAS float*)(L + C_SEG))[j * 64 + lane]; tot += sg; pre += (j < w) ? sg : 0.f; }
        if (w == 0) ((LAS float*)(L + C_GAM))[lane] = __expf(tot);
        unsigned att[4], bht[4], kht[4], vtt[4];
        float at_[8], bh_[8], kh_[8]; const float gtot = __expf(tot); float ep_prev = 1.f;
#pragma unroll
        for (int i = 0; i < 8; ++i) { const int t = 8 * w + i; const float cum = pre + cs[i], cump = cum - lwv[i];
            const float kkv = kk[i] * kkp; const float n2 = wave_sum(kkv * kkv); const float kkn = kkv * __builtin_amdgcn_rsqf(fmaxf(n2, 1e-24f));
            const float a = -kkn, bb = kkn * ic[i], kp = kk[i] * (1.0f + (ic[i] - 1.0f) * kap);
            const float ep = __expf(cum), em = __builtin_amdgcn_rcpf(ep), epp = (i == 0) ? __expf(cump) : ep_prev, eL = gtot * em; ep_prev = ep;
            const float Rv = rr[i] * ep, Av = a * epp, Bv = bb * em, Kv = kp * em;
            at_[i] = Av; bh_[i] = bb * eL; kh_[i] = kp * eL;
            *(LAS unsigned short*)(L + C_RT + t * CP + lane * 2) = (unsigned short)f2bf(Rv);
            *(LAS unsigned short*)(L + C_AT + t * CP + lane * 2) = (unsigned short)f2bf(Av);
            *(LAS unsigned short*)(L + C_BT + t * CP + lane * 2) = (unsigned short)f2bf(Bv);
            *(LAS unsigned short*)(L + C_KT + t * CP + lane * 2) = (unsigned short)f2bf(Kv); }
#pragma unroll
        for (int q = 0; q < 4; ++q) { att[q] = pk2(at_[2 * q], at_[2 * q + 1]); bht[q] = pk2(bh_[2 * q], bh_[2 * q + 1]); kht[q] = pk2(kh_[2 * q], kh_[2 * q + 1]); vtt[q] = pk2(vv[2 * q], vv[2 * q + 1]); }
        *(LAS v4u*)(L + C_ATT + lane * CP + 16 * w) = (v4u){att[0], att[1], att[2], att[3]};
        *(LAS v4u*)(L + C_WA + (64 + lane) * CP + 16 * w) = (v4u){bht[0], bht[1], bht[2], bht[3]};
        CBAR();
        const int cit = unit * 12 + w; const bool hx = cit < MOE_NITEMS, hy = (w < 4) && (cit + 8 < MOE_NITEMS);
        f32x4 tX[16]; MoeItem mX = moe_item(hx ? cit : 0, I.w_gu, I.w_down, F.ws);
        LAS float* tscr = (LAS float*)(L + C_TSCR + w * 5120);
        struct Fr { bf16x8 a, b; };
        auto LD = [&](int base, int tile) -> Fr { const LAS unsigned char* q = L + base + (tile * 16 + lr) * CP + kq * 16; Fr f; f.a = *(const LAS bf16x8*)q; f.b = *(const LAS bf16x8*)(q + 64); return f; };
        auto MM = [&](const Fr& x, const Fr& y) -> f32x4 { f32x4 acc = (f32x4){0.f, 0.f, 0.f, 0.f};
            acc = __builtin_amdgcn_mfma_f32_16x16x32_bf16(x.a, y.a, acc, 0, 0, 0); acc = __builtin_amdgcn_mfma_f32_16x16x32_bf16(x.b, y.b, acc, 0, 0, 0); return acc; };
        const int nt = w & 3, mt0 = 2 * (w >> 2), n = nt * 16 + lr;
        { const Fr yAT = LD(C_AT, nt), yKT = LD(C_KT, nt), yRT = LD(C_RT, nt);
          Fr xBT[2], xAT[2], xKT[2];
#pragma unroll
          for (int i = 0; i < 2; ++i) { xBT[i] = LD(C_BT, mt0 + i); xAT[i] = LD(C_AT, mt0 + i); xKT[i] = LD(C_KT, mt0 + i); }
          f32x4 a1[2], a2[2], a3[2], a4[2];
#pragma unroll
          for (int i = 0; i < 2; ++i) { a1[i] = MM(xBT[i], yAT); a2[i] = MM(xAT[i], yKT); a3[i] = MM(xBT[i], yRT); a4[i] = MM(xKT[i], yRT); }
#pragma unroll
          for (int i = 0; i < 2; ++i) { const int m0 = (mt0 + i) * 16 + 4 * kq;
              f32x4 v = a1[i];
#pragma unroll
              for (int e = 0; e < 4; ++e) { v[e] = (m0 + e < n) ? v[e] : 0.f; *(LAS unsigned short*)(L + C_MA + (m0 + e) * CP + n * 2) = (unsigned short)f2bf(v[e]); }
              *(LAS v2u*)(L + C_MTA + n * CP + m0 * 2) = pack4(v);
              v = a2[i];
#pragma unroll
              for (int e = 0; e < 4; ++e) v[e] = (n < m0 + e) ? v[e] : 0.f;
              *(LAS v2u*)(L + C_AAK + n * CP + m0 * 2) = pack4(v);
              v = a3[i];
#pragma unroll
              for (int e = 0; e < 4; ++e) v[e] = (m0 + e <= n) ? v[e] : 0.f;
              *(LAS v2u*)(L + C_WA + n * CP + m0 * 2) = pack4(v);
              v = a4[i];
#pragma unroll
              for (int e = 0; e < 4; ++e) v[e] = (m0 + e <= n) ? v[e] : 0.f;
              *(LAS v2u*)(L + C_ARKT + n * CP + m0 * 2) = pack4(v); } }
        CBAR();
        if (hx) tr8_load(mX, tX, lane);
#pragma unroll
        for (int lvl = 0; lvl < 6; ++lvl) {
            const int Wsrc = (lvl & 1) ? C_WB : C_WA, Wdst = (lvl & 1) ? C_WA : C_WB, Ms = (lvl & 1) ? C_MB : C_MA, Mts = (lvl & 1) ? C_MTB : C_MTA, Md = (lvl & 1) ? C_MA : C_MB, Mtd = (lvl & 1) ? C_MTA : C_MTB;
            const Fr yW = LD(Wsrc, w); Fr yMt; if (lvl < 5) yMt = LD(Mts, nt);
            Fr xM[4], xS[2];
#pragma unroll
            for (int i = 0; i < 4; ++i) xM[i] = LD(Ms, i);
            if (lvl < 5) { xS[0] = LD(Ms, mt0); xS[1] = LD(Ms, mt0 + 1); }
            const int nj = w * 16 + lr;
            f32x4 old[4], aw[4], as[2];
#pragma unroll
            for (int i = 0; i < 4; ++i) old[i] = unpack4(*(const LAS v2u*)(L + Wsrc + nj * CP + (i * 16 + 4 * kq) * 2));
#pragma unroll
            for (int i = 0; i < 4; ++i) aw[i] = MM(xM[i], yW);
            if (lvl < 5) {
#pragma unroll
                for (int i = 0; i < 2; ++i) as[i] = MM(xS[i], yMt); }
#pragma unroll
            for (int i = 0; i < 4; ++i) *(LAS v2u*)(L + Wdst + nj * CP + (i * 16 + 4 * kq) * 2) = pack4(old[i] + aw[i]);
            if (lvl < 5) {
#pragma unroll
                for (int i = 0; i < 2; ++i) { const int m0 = (mt0 + i) * 16 + 4 * kq;
#pragma unroll
                    for (int e = 0; e < 4; ++e) *(LAS unsigned short*)(L + Md + (m0 + e) * CP + n * 2) = (unsigned short)f2bf(as[i][e]);
                    if (lvl < 4) *(LAS v2u*)(L + Mtd + n * CP + m0 * 2) = pack4(as[i]); } }
            if (lvl == 4) *(LAS v4u*)(L + C_KHT + lane * CP + 16 * w) = (v4u){kht[0], kht[1], kht[2], kht[3]};
            if (lvl == 2) { if (hx) tr8_finish(tX, mX, tscr, lane);
                            if (hy) { mX = moe_item(cit + 8, I.w_gu, I.w_down, F.ws); tr8_load(mX, tX, lane); } }
            CBAR();
        }
        *(LAS v4u*)(L + C_VT + lane * CP + 16 * w) = (v4u){vtt[0], vtt[1], vtt[2], vtt[3]};
        unsigned char* og = CHK + (size_t)unit * CHK_UNIT_BYTES;
        { const Fr yW1 = LD(C_WA, nt), yW2 = LD(C_WA + 64 * CP, nt);
          Fr xA[2], xK[2];
#pragma unroll
          for (int i = 0; i < 2; ++i) { xA[i] = LD(C_ATT, mt0 + i); xK[i] = LD(C_AAK, mt0 + i); }
          f32x4 rv[2], av[2], kv[2];
          const float gm = ((const LAS float*)(L + C_GAM))[n];
#pragma unroll
          for (int i = 0; i < 2; ++i) { const int m0 = (mt0 + i) * 16 + 4 * kq;
              rv[i] = unpack4(*(const LAS v2u*)(L + C_RT + n * CP + m0 * 2)); av[i] = unpack4(*(const LAS v2u*)(L + C_ARKT + n * CP + m0 * 2)); kv[i] = unpack4(*(const LAS v2u*)(L + C_KHT + n * CP + m0 * 2)); }
          f32x4 p7[2], p8[2], p9[2], p10[2];
#pragma unroll
          for (int i = 0; i < 2; ++i) { p7[i] = MM(xA[i], yW1); p8[i] = MM(xK[i], yW1); p9[i] = MM(xA[i], yW2); p10[i] = MM(xK[i], yW2); }
#pragma unroll
          for (int i = 0; i < 2; ++i) { const int m0 = (mt0 + i) * 16 + 4 * kq;
              *(GAS v2u*)(og + 0 * 8192 + n * 128 + m0 * 2) = pack4(p7[i] + rv[i]);
              *(LAS v2u*)(L + C_QYT + n * CP + m0 * 2) = pack4(p8[i] + av[i]);
              f32x4 v = p9[i];
#pragma unroll
              for (int e = 0; e < 4; ++e) v[e] += (m0 + e == n) ? gm : 0.f;
              *(GAS v2u*)(og + 1 * 8192 + n * 128 + m0 * 2) = pack4(v);
              *(LAS v2u*)(L + C_QST + n * CP + m0 * 2) = pack4(p10[i] + kv[i]); } }
        CBAR();
        { const Fr yQy = LD(C_QYT, nt), yQs = LD(C_QST, nt);
          Fr xV[2];
#pragma unroll
          for (int i = 0; i < 2; ++i) xV[i] = LD(C_VT, mt0 + i);
          f32x4 p11[2], p12[2];
#pragma unroll
          for (int i = 0; i < 2; ++i) { p11[i] = MM(xV[i], yQy); p12[i] = MM(xV[i], yQs); }
#pragma unroll
          for (int i = 0; i < 2; ++i) { const int m0 = (mt0 + i) * 16 + 4 * kq;
              *(GAS v2u*)(og + 2 * 8192 + n * 128 + m0 * 2) = pack4(p11[i]);
              *(GAS v2u*)(og + 3 * 8192 + n * 128 + m0 * 2) = pack4(p12[i]); } }
        if (hy) tr8_finish(tX, mX, tscr, lane);
    }
}

constexpr int C2_SLOT = 20480;
__device__ __forceinline__ void p4b_scan(Frame& F0, const In& I) {
    PHASE_FRAME(F0);
    const int lane = F.lane, lr = lane & 15, kq = lane >> 4;
    const unsigned char* CHK = F.ws + WS_CHK; bf16* YS = (bf16*)(F.ws + WS_YSCAN);
    for (int unit = F.vcu; unit < BATCH * RH * 4; unit += F.G) {
        const int bh = unit >> 2, rq = unit & 3, b = bh >> 4, h = bh & 15;
        if (F.wave == 0) {
            LAS unsigned char* Sl = F.lds + 3 * C2_SLOT;
            f32x4 S[4]; bf16x8 sf[2];
#pragma unroll
            for (int nt = 0; nt < 4; ++nt) S[nt] = (f32x4){0.f, 0.f, 0.f, 0.f};
#pragma unroll
            for (int ks = 0; ks < 2; ++ks)
#pragma unroll
                for (int j = 0; j < 8; ++j) sf[ks][j] = 0;
#define C2_DMA(ck_) do { const int ckc_ = (ck_) < SEQ / 64 ? (ck_) : SEQ / 64 - 1; const unsigned char* ug = CHK + ((size_t)bh * 128 + ckc_) * CHK_UNIT_BYTES; \
                LAS unsigned char* sl_ = F.lds + ((ck_) % 3) * C2_SLOT; \
                _Pragma("unroll") for (int j = 0; j < 16; ++j) __builtin_amdgcn_global_load_lds((const unsigned*)(ug + j * 1024 + lane * 16), (LAS unsigned*)(sl_ + j * 1024), 16, 0, 0); \
                _Pragma("unroll") for (int j = 0; j < 2; ++j) { \
                    __builtin_amdgcn_global_load_lds((const unsigned*)(ug + 2 * 8192 + (j * 32 + (lane >> 1)) * 128 + rq * 32 + (lane & 1) * 16), (LAS unsigned*)(sl_ + 16384 + j * 1024), 16, 0, 0); \
                    __builtin_amdgcn_global_load_lds((const unsigned*)(ug + 3 * 8192 + (j * 32 + (lane >> 1)) * 128 + rq * 32 + (lane & 1) * 16), (LAS unsigned*)(sl_ + 18432 + j * 1024), 16, 0, 0); } } while (0)
            C2_DMA(0); C2_DMA(1);
#pragma unroll 1
            for (int ck = 0; ck < SEQ / 64; ++ck) {
                asm volatile("s_waitcnt lgkmcnt(0)" ::: "memory");
                C2_DMA(ck + 2);
                asm volatile("s_waitcnt vmcnt(40)" ::: "memory");
                const LAS unsigned char* sl_ = F.lds + (ck % 3) * C2_SLOT;
#pragma unroll
                for (int nt = 0; nt < 4; ++nt) {
                    const bf16x8 py0 = *(const LAS bf16x8*)(sl_ + (16 * nt + lr) * 128 + kq * 16), py1 = *(const LAS bf16x8*)(sl_ + (16 * nt + lr) * 128 + kq * 16 + 64);
                    const bf16x8 ps0 = *(const LAS bf16x8*)(sl_ + 8192 + (16 * nt + lr) * 128 + kq * 16), ps1 = *(const LAS bf16x8*)(sl_ + 8192 + (16 * nt + lr) * 128 + kq * 16 + 64);
                    f32x4 y = unpack4(*(const LAS v2u*)(sl_ + 16384 + (16 * nt + lr) * 32 + kq * 8));
                    f32x4 s2 = unpack4(*(const LAS v2u*)(sl_ + 18432 + (16 * nt + lr) * 32 + kq * 8));
                    y = __builtin_amdgcn_mfma_f32_16x16x32_bf16(sf[0], py0, y, 0, 0, 0); y = __builtin_amdgcn_mfma_f32_16x16x32_bf16(sf[1], py1, y, 0, 0, 0);
                    *(GAS v2u*)(YS + ((size_t)b * SEQ + (size_t)ck * 64 + 16 * nt + lr) * RW + h * 64 + rq * 16 + 4 * kq) = pack4(y);
                    s2 = __builtin_amdgcn_mfma_f32_16x16x32_bf16(sf[0], ps0, s2, 0, 0, 0); s2 = __builtin_amdgcn_mfma_f32_16x16x32_bf16(sf[1], ps1, s2, 0, 0, 0);
                    S[nt] = s2; }
#pragma unroll
                for (int nt = 0; nt < 4; ++nt)
#pragma unroll
                    for (int i = 0; i < 4; ++i) *(LAS unsigned short*)(Sl + (4 * kq + i) * CP + (16 * nt + lr) * 2) = (unsigned short)f2bf(S[nt][i]);
                LDS_WAIT(); asm volatile("" ::: "memory");
                sf[0] = *(const LAS bf16x8*)(Sl + lr * CP + kq * 16); sf[1] = *(const LAS bf16x8*)(Sl + lr * CP + kq * 16 + 64);
                LDS_WAIT(); asm volatile("" ::: "memory");
            }
            asm volatile("s_waitcnt vmcnt(0)" ::: "memory");
#undef C2_DMA
        }
    }
}
static_assert(3 * C2_SLOT + 4096 + 5 * 16640 <= TAB_OFF, "P4b LDS map");

__device__ __forceinline__ void p5_post(Frame& F0, const In& I) {
    PHASE_FRAME(F0);
    const int lane = F.lane; const int gw = F.vcu * NWAVES + F.wave, NGW = F.G * NWAVES;
    const bf16* RKV = (const bf16*)(F.ws + WS_RKV); const bf16* ICL = (const bf16*)(F.ws + WS_ICLR); const bf16* YS = (const bf16*)(F.ws + WS_YSCAN);
    const bf16* G = (const bf16*)(F.ws + WS_G); bf16* YB = (bf16*)(F.ws + WS_YB);
    const int c0 = lane * 16;
    float p_ka[16], p_rk[16], p_lw[16], p_lb[16];
#pragma unroll
    for (int q = 0; q < 4; ++q) { const f32x4 a = *(const GAS f32x4*)(I.k_a + c0 + 4 * q), bq = *(const GAS f32x4*)(I.r_k + c0 + 4 * q), c = *(const GAS f32x4*)(I.lnx_w + c0 + 4 * q), d = *(const GAS f32x4*)(I.lnx_b + c0 + 4 * q);
#pragma unroll
        for (int e = 0; e < 4; ++e) { p_ka[4 * q + e] = a[e]; p_rk[4 * q + e] = bq[e]; p_lw[4 * q + e] = c[e]; p_lb[4 * q + e] = d[e]; } }
    v4u raw[12];
#define P5_LOAD(tok_) do { _Pragma("unroll") for (int q = 0; q < 2; ++q) { \
        raw[q] = *(const GAS v4u*)(YS + (size_t)(tok_) * RW + c0 + 8 * q); raw[2 + q] = *(const GAS v4u*)(ICL + (size_t)(tok_) * RW + c0 + 8 * q); \
        raw[4 + q] = *(const GAS v4u*)(RKV + (size_t)(tok_) * (3 * RW) + c0 + 8 * q); raw[6 + q] = *(const GAS v4u*)(RKV + (size_t)(tok_) * (3 * RW) + RW + c0 + 8 * q); \
        raw[8 + q] = *(const GAS v4u*)(RKV + (size_t)(tok_) * (3 * RW) + 2 * RW + c0 + 8 * q); raw[10 + q] = *(const GAS v4u*)(G + (size_t)(tok_) * RW + c0 + 8 * q); } } while (0)
    if (gw < T) P5_LOAD(gw);
    for (int tok = gw; tok < T; tok += NGW) {
        float y[16], rr[16], kk[16], vv[16], ic[16], gg[16];
#pragma unroll
        for (int q = 0; q < 2; ++q) {
            const unsigned yw[4] = {raw[q].x, raw[q].y, raw[q].z, raw[q].w}, iw[4] = {raw[2 + q].x, raw[2 + q].y, raw[2 + q].z, raw[2 + q].w};
            const unsigned aw[4] = {raw[4 + q].x, raw[4 + q].y, raw[4 + q].z, raw[4 + q].w}, bw[4] = {raw[6 + q].x, raw[6 + q].y, raw[6 + q].z, raw[6 + q].w};
            const unsigned cw[4] = {raw[8 + q].x, raw[8 + q].y, raw[8 + q].z, raw[8 + q].w}, dw[4] = {raw[10 + q].x, raw[10 + q].y, raw[10 + q].z, raw[10 + q].w};
#pragma unroll
            for (int e = 0; e < 4; ++e) { y[8 * q + 2 * e] = bflo(yw[e]); y[8 * q + 2 * e + 1] = bfhi(yw[e]); ic[8 * q + 2 * e] = bflo(iw[e]); ic[8 * q + 2 * e + 1] = bfhi(iw[e]);
                rr[8 * q + 2 * e] = bflo(aw[e]); rr[8 * q + 2 * e + 1] = bfhi(aw[e]); kk[8 * q + 2 * e] = bflo(bw[e]); kk[8 * q + 2 * e + 1] = bfhi(bw[e]);
                vv[8 * q + 2 * e] = bflo(cw[e]); vv[8 * q + 2 * e + 1] = bfhi(cw[e]); gg[8 * q + 2 * e] = bflo(dw[e]); gg[8 * q + 2 * e + 1] = bfhi(dw[e]); } }
        __builtin_amdgcn_sched_barrier(0);
        if (tok + NGW < T) P5_LOAD(tok + NGW);
        __builtin_amdgcn_sched_barrier(0);
        float s = 0.f, bs = 0.f;
#pragma unroll
        for (int e = 0; e < 16; ++e) { s += y[e]; const float kp = kk[e] * (1.0f + (ic[e] - 1.0f) * p_ka[e]); bs += rr[e] * kp * p_rk[e]; }
        s = quadsum(s); bs = quadsum(bs);
        const float mean = s * (1.f / 64.f); float s2 = 0.f;
#pragma unroll
        for (int e = 0; e < 16; ++e) { y[e] -= mean; s2 += y[e] * y[e]; }
        s2 = quadsum(s2);
        const float rstd = 1.f / sqrtf(s2 * (1.f / 64.f) + GN_EPS);
        float o[16];
#pragma unroll
        for (int e = 0; e < 16; ++e) o[e] = (y[e] * rstd * p_lw[e] + p_lb[e] + bs * vv[e]) * gg[e];
        { unsigned w8[4];
#pragma unroll
          for (int q = 0; q < 4; ++q) { int t8 = __builtin_amdgcn_cvt_pk_fp8_f32(o[4 * q] * ACT8_SCALE, o[4 * q + 1] * ACT8_SCALE, 0, false); t8 = __builtin_amdgcn_cvt_pk_fp8_f32(o[4 * q + 2] * ACT8_SCALE, o[4 * q + 3] * ACT8_SCALE, t8, true); w8[q] = (unsigned)t8; }
          *(GAS v4u*)((unsigned char*)YB + (size_t)tok * RW + c0) = (v4u){w8[0], w8[1], w8[2], w8[3]}; }
    }
#undef P5_LOAD
}
#ifndef STAGE
#define STAGE 4
#endif
struct Args { In in; float* out; unsigned char* ws; };
__global__ void __launch_bounds__(NWAVES * 64, 2) mk_fwd(Args args) {
    extern __shared__ __attribute__((aligned(16))) unsigned char lds[];
    Frame F;
    F.lds = (LAS unsigned char*)lds;
    F.MISC = (volatile LAS unsigned*)(F.lds + MISC_OFF);
    F.tid = threadIdx.x; F.lane = F.tid & 63; F.wave = __builtin_amdgcn_readfirstlane(F.tid >> 6);
    F.G = gridDim.x; { const int bx = blockIdx.x; F.vcu = (F.G % 8 == 0) ? (bx % 8) * (F.G / 8) + bx / 8 : bx; }
    F.ws = args.ws;
    F.rsrc = __builtin_amdgcn_make_buffer_rsrc(args.ws, 0, 0xffffffff, 0x00020000);
    F.ctl = (gu32*)(args.ws + WS_CTL);
    for (int u = F.tid; u < (LDS_BYTES - MISC_OFF) / 4; u += NWAVES * 64) ((LAS unsigned*)(F.lds + MISC_OFF))[u] = 0u;
    __syncthreads();
    XcdBarrier bar = xcd_barrier_post((unsigned*)(F.ctl + CW_BAR), F.MISC + 8);
    const In& I = args.in;
#define GRID_BAR() xcd_barrier(bar)
#ifndef DUP_PHASE
#define DUP_PHASE -1
#endif
#define RUN(n, call) do { call; if (DUP_PHASE == (n)) { GRID_BAR(); call; } } while (0)

#if STAGE >= 2
    RUN(0, p0_prologue(F, I));
    GRID_BAR();
#endif
#if STAGE >= 3
    RUN(1, p1_proj(F, I));
    GRID_BAR();
    RUN(2, p2_shift_attn(F, I));
    GRID_BAR();
#if STAGE >= 4
    RUN(3, p3_lora(F, I));
    GRID_BAR();
    RUN(4, p4a_chunk(F, I));
    GRID_BAR();
    RUN(44, p4b_scan(F, I));
    GRID_BAR();
    RUN(5, p5_post(F, I));
    GRID_BAR();
#endif
    RUN(6, p6_merged(F, I));
    GRID_BAR();
    RUN(7, p7_mix(F, I));
    GRID_BAR();
#endif
    p8_ln_router<(STAGE < 3)>(F, I);
    GRID_BAR();
#if STAGE >= 2
    p9_scatter(F, I);
    GRID_BAR();
    RUN(10, p10_moe_up(F, I));
    GRID_BAR();
    RUN(11, p11_moe_down(F, I));
    GRID_BAR();
#endif
    RUN(12, p12_final<(STAGE < 2)>(F, I, args.out));
}

extern "C" void kernel_launch(void* const* d_in, const int* in_sizes, int n_in, void* d_out, int out_size, void* d_ws, size_t ws_size, hipStream_t stream) {
    static int grid = 0;
    if (grid == 0) {
        if (n_in != 27 || in_sizes[0] != T * D || out_size != T * D || ws_size < WS_END) { fprintf(stderr, "kernel_launch: unexpected shapes (n_in %d, in0 %d, out %d, ws %zu)\n", n_in, n_in > 0 ? in_sizes[0] : -1, out_size, ws_size); grid = -1; return; }
        int dev = 0, cus = 0, per_cu = 0;
        if (hipGetDevice(&dev) != hipSuccess || hipDeviceGetAttribute(&cus, hipDeviceAttributeMultiprocessorCount, dev) != hipSuccess) { grid = -1; return; }
        if (hipFuncSetAttribute((const void*)mk_fwd, hipFuncAttributeMaxDynamicSharedMemorySize, LDS_BYTES) != hipSuccess) { fprintf(stderr, "kernel_launch: hipFuncSetAttribute failed\n"); grid = -1; return; }
        if (hipOccupancyMaxActiveBlocksPerMultiprocessor(&per_cu, (const void*)mk_fwd, NWAVES * 64, LDS_BYTES) != hipSuccess || per_cu < 1)
            fprintf(stderr, "kernel_launch: occupancy query reports %d\n", per_cu);
        (void)hipGetLastError();
        grid = cus;
    }
    if (grid < 0) return;
    if (hipMemsetAsync((char*)d_ws + WS_CTL, 0, CTL_ZERO_BYTES, stream) != hipSuccess) return;
    Args a{};
    const float** ip = (const float**)&a.in;
    for (int i = 0; i < 27; ++i) ip[i] = (const float*)d_in[i];
    a.out = (float*)d_out; a.ws = (unsigned char*)d_ws;
    hipLaunchKernelGGL(mk_fwd, dim3(grid), dim3(NWAVES * 64), LDS_BYTES, stream, a);
    const hipError_t le = hipPeekAtLastError();
    if (le != hipSuccess) fprintf(stderr, "kernel_launch: launch failed: %s\n", hipGetErrorName(le));
}
```
